# Optimizing an MI355X kernel written in HIP

```python
import jax, jax.numpy as jnp
from jax import lax
import numpy as np

D_MODEL = 1024
BATCH = 16
SEQ = 2048
DEPTH = 1

CHUNK = 64
Q_BLOCK = 128
HEAD_DIM = 64
D_MIX = D_MODEL
SB_HEADS = 8
SB_WIDTH = SB_HEADS * HEAD_DIM
RW_WIDTH = D_MIX - SB_WIDTH
RW_HEADS = RW_WIDTH // HEAD_DIM
DECAY_LORA = 64
AAA_LORA = 64
GATE_LORA = 128
RW_PROJ = 3 * RW_WIDTH + DECAY_LORA + AAA_LORA + GATE_LORA
PROJ_WIDTH = 3 * SB_WIDTH + RW_PROJ
D_FF = 2816
FFN_HALF = 0.5
RMS_EPS = 1e-6
LNX_EPS = 64e-5

kernel_name = "hybrid_stickbreak_rwkv7_macaron"


def rms_norm(x, g, eps=RMS_EPS):
    xf = x.astype(jnp.float32)
    ms = jnp.mean(xf * xf, axis=-1, keepdims=True)
    return (xf * lax.rsqrt(ms + eps) * g.astype(jnp.float32)).astype(x.dtype)


def swiglu(x, w_gate, w_up, w_down):
    return (jax.nn.silu(x @ w_gate) * (x @ w_up)) @ w_down


def token_shift(u):
    return jnp.pad(u[:, :-1], ((0, 0), (1, 0), (0, 0)))


def stick_breaking_attention(q, k, v):
    S, Dh = q.shape[1], q.shape[-1]
    scale = Dh ** -0.5
    outs = []
    for blk in range(S // Q_BLOCK):
        q0 = blk * Q_BLOCK
        kv_len = q0 + Q_BLOCK
        qb, kb, vb = q[:, q0:kv_len], k[:, :kv_len], v[:, :kv_len]
        z = jnp.einsum('bqhd,bkhd->bhqk', qb, kb).astype(jnp.float32) * scale
        q_pos = q0 + jnp.arange(Q_BLOCK)[:, None]
        k_pos = jnp.arange(kv_len)[None, :]
        mask = k_pos < q_pos
        log_beta = jax.nn.log_sigmoid(z)
        log_1m_beta = jnp.where(mask, jax.nn.log_sigmoid(-z), 0.0)
        log_remain = lax.cumsum(log_1m_beta, axis=3, reverse=True) - log_1m_beta
        att = jnp.where(mask, jnp.exp(log_beta + log_remain), 0.0)
        outs.append(jnp.einsum('bhqk,bkhd->bqhd', att.astype(vb.dtype), vb))
    return jnp.concatenate(outs, axis=1)


def rwkv7_recurrence(r, decay, k, v, a_vec, b_vec):
    B, S, H, N = r.shape
    n_chunks = S // CHUNK

    def to_chunks(t):
        return t.astype(jnp.float32).transpose(1, 0, 2, 3).reshape(n_chunks, CHUNK, B, H, N)

    xs = (to_chunks(r), to_chunks(decay), to_chunks(k), to_chunks(v),
          to_chunks(a_vec), to_chunks(b_vec))

    def step(state, inp):
        r_t, w_t, k_t, v_t, a_t, b_t = inp
        sa = jnp.einsum('bhvk,bhk->bhv', state, a_t)
        state = (state * w_t[:, :, None, :] + sa[..., None] * b_t[:, :, None, :]
                 + v_t[..., None] * k_t[:, :, None, :])
        return state, jnp.einsum('bhvk,bhk->bhv', state, r_t)

    def chunk_step(state, chunk_xs):
        return lax.scan(step, state, chunk_xs)

    state0 = jnp.zeros((B, H, N, N), jnp.float32)
    _, y = lax.scan(chunk_step, state0, xs)
    return y.reshape(S, B, H, N).transpose(1, 0, 2, 3)


def rwkv7_time_mix(u, mu, w0, w2, a0, a2, g2, k_k, k_a, r_k, ln_w, ln_b):
    B, S, _ = u.shape
    u = u + (token_shift(u) - u) * mu
    x_r, x_k, x_v, x_w, x_a, x_g = jnp.split(
        u, [RW_WIDTH, 2 * RW_WIDTH, 3 * RW_WIDTH, 3 * RW_WIDTH + DECAY_LORA,
            3 * RW_WIDTH + DECAY_LORA + AAA_LORA], axis=-1)
    log_w = -jax.nn.softplus(-(w0 + jnp.tanh(x_w) @ w2)) - 0.5
    decay = jnp.exp(-jnp.exp(log_w.astype(jnp.float32)))
    a = jax.nn.sigmoid(a0 + x_a @ a2).astype(jnp.float32)
    g = jax.nn.sigmoid(x_g) @ g2

    def heads(t):
        return t.reshape(B, S, RW_HEADS, HEAD_DIM)

    r = heads(x_r).astype(jnp.float32)
    v = heads(x_v).astype(jnp.float32)
    kk = heads(x_k * k_k).astype(jnp.float32)
    kk = kk / jnp.maximum(jnp.linalg.norm(kk, axis=-1, keepdims=True), 1e-12)
    kf = heads(x_k * (1.0 + (a - 1.0) * k_a)).astype(jnp.float32)
    a = heads(a)
    y = rwkv7_recurrence(r, heads(decay), kf, v, -kk, kk * a)
    mean = jnp.mean(y, axis=-1, keepdims=True)
    var = jnp.mean(jnp.square(y - mean), axis=-1, keepdims=True)
    yn = (y - mean) * lax.rsqrt(var + LNX_EPS)
    yn = yn * ln_w.astype(jnp.float32).reshape(RW_HEADS, HEAD_DIM) + ln_b.astype(jnp.float32).reshape(RW_HEADS, HEAD_DIM)
    bonus = jnp.sum(r * kf * r_k.astype(jnp.float32), axis=-1, keepdims=True) * v
    return ((yn + bonus).reshape(B, S, RW_WIDTH) * g.astype(jnp.float32)).astype(u.dtype)


def setup_inputs(seed: int = 0) -> dict:
    key = jax.random.key(seed)
    ks = jax.random.split(key, 26)
    L, D = DEPTH, D_MODEL
    f32 = jnp.float32

    def nrm(k, shape, scale):
        return scale * jax.random.normal(k, shape, f32)

    def gain(k, shape):
        return 1.0 + 0.05 * jax.random.normal(k, shape, f32)

    return {
        "x": jax.random.normal(ks[0], (BATCH, SEQ, D), f32),
        "norm_ffn1": gain(ks[1], (L, D)),
        "ffn1_gate": nrm(ks[2], (L, D, D_FF), D ** -0.5),
        "ffn1_up": nrm(ks[3], (L, D, D_FF), D ** -0.5),
        "ffn1_down": nrm(ks[4], (L, D_FF, D), D_FF ** -0.5),
        "norm_mix": gain(ks[5], (L, D)),
        "w_in": nrm(ks[6], (L, D, PROJ_WIDTH), D ** -0.5),
        "sb_q_norm": gain(ks[7], (L, HEAD_DIM)),
        "sb_k_norm": gain(ks[8], (L, HEAD_DIM)),
        "sb_out_norm": gain(ks[9], (L, SB_WIDTH)),
        "rw_mu": jax.random.uniform(ks[10], (L, RW_PROJ), f32),
        "rw_w0": jax.random.uniform(ks[11], (L, RW_WIDTH), f32, minval=-5.0, maxval=-1.0),
        "rw_w2": nrm(ks[12], (L, DECAY_LORA, RW_WIDTH), 0.5 * DECAY_LORA ** -0.5),
        "rw_a0": nrm(ks[13], (L, RW_WIDTH), 0.1),
        "rw_a2": nrm(ks[14], (L, AAA_LORA, RW_WIDTH), 0.5 * AAA_LORA ** -0.5),
        "rw_g2": nrm(ks[15], (L, GATE_LORA, RW_WIDTH), GATE_LORA ** -0.5),
        "rw_k_k": 0.85 + 0.05 * jax.random.normal(ks[16], (L, RW_WIDTH), f32),
        "rw_k_a": gain(ks[17], (L, RW_WIDTH)),
        "rw_r_k": nrm(ks[18], (L, RW_HEADS, HEAD_DIM), 0.1),
        "rw_ln_w": gain(ks[19], (L, RW_WIDTH)),
        "rw_ln_b": nrm(ks[20], (L, RW_WIDTH), 0.01),
        "w_out": nrm(ks[21], (L, D_MIX, D), D_MIX ** -0.5),
        "norm_ffn2": gain(ks[22], (L, D)),
        "ffn2_gate": nrm(ks[23], (L, D, D_FF), D ** -0.5),
        "ffn2_up": nrm(ks[24], (L, D, D_FF), D ** -0.5),
        "ffn2_down": nrm(ks[25], (L, D_FF, D), D_FF ** -0.5),
    }


def reference(x, norm_ffn1, ffn1_gate, ffn1_up, ffn1_down, norm_mix, w_in,
              sb_q_norm, sb_k_norm, sb_out_norm, rw_mu, rw_w0, rw_w2, rw_a0, rw_a2,
              rw_g2, rw_k_k, rw_k_a, rw_r_k, rw_ln_w, rw_ln_b, w_out, norm_ffn2,
              ffn2_gate, ffn2_up, ffn2_down):
    B, S, _ = x.shape
    for l in range(DEPTH):
        x = x + FFN_HALF * swiglu(rms_norm(x, norm_ffn1[l]), ffn1_gate[l], ffn1_up[l], ffn1_down[l])

        h = rms_norm(x, norm_mix[l])
        p = h @ w_in[l]
        sb_q, sb_k, sb_v, rw_in = jnp.split(p, [SB_WIDTH, 2 * SB_WIDTH, 3 * SB_WIDTH], axis=-1)

        q = rms_norm(sb_q.reshape(B, S, SB_HEADS, HEAD_DIM), sb_q_norm[l])
        k = rms_norm(sb_k.reshape(B, S, SB_HEADS, HEAD_DIM), sb_k_norm[l])
        v = sb_v.reshape(B, S, SB_HEADS, HEAD_DIM)
        o_sb = stick_breaking_attention(q, k, v)
        o_sb = rms_norm(o_sb, sb_out_norm[l].reshape(SB_HEADS, HEAD_DIM)).reshape(B, S, SB_WIDTH)

        o_rw = rwkv7_time_mix(rw_in, rw_mu[l], rw_w0[l], rw_w2[l], rw_a0[l], rw_a2[l], rw_g2[l],
                              rw_k_k[l], rw_k_a[l], rw_r_k[l], rw_ln_w[l], rw_ln_b[l])

        x = x + jnp.concatenate([o_sb, o_rw], axis=-1) @ w_out[l]

        x = x + FFN_HALF * swiglu(rms_norm(x, norm_ffn2[l]), ffn2_gate[l], ffn2_up[l], ffn2_down[l])
    return x
```

```cpp
#include <hip/hip_runtime.h>
#include <hip/hip_bf16.h>
#include <cstdio>
#include <cstdint>
#include <cmath>
namespace pg8 {
#define PG8_LAS __attribute__((address_space(3)))
typedef unsigned short bf16_t;
typedef short bf16x8 __attribute__((ext_vector_type(8)));
typedef float f32x4 __attribute__((ext_vector_type(4)));
typedef unsigned u32x4 __attribute__((ext_vector_type(4)));
constexpr int BM = 256, BK = 64, HALF = 128, HTB = HALF * BK * 2  , STAGE_BYTES = 8 * HTB, NXCD = 8, WGM = 8;

__host__ __device__ __forceinline__ int lds_byte(int r, int c) { const int st = (r >> 4) * 2 + (c >> 5), rr = r & 15, cc = c & 31, ob = rr * 64 + cc * 2; return st * 1024 + (ob ^ (((ob >> 9) & 1) << 5)); }
__host__ __device__ __forceinline__ void stage_rc(int b, int& R, int& C) { const int st = b / 1024, sb = b % 1024, swz = sb ^ (((sb >> 9) & 1) << 5); R = (st >> 1) * 16 + swz / 64; C = (st & 1) * 32 + (swz % 64) / 2; }
__host__ __device__ __forceinline__ int perm32(int rho) { const int n = rho >> 4, i = rho & 15; return 8 * (i >> 2) + 4 * n + (i & 3); }

struct Unit { int pm, pn; };
struct Gemm { const bf16_t* A; const bf16_t* Bt; int M, N, K; };

struct StaticOrder {
    int nM, nN, nwg, G, c;
    __host__ __device__ void init(int M, int N, int G_, int c_) { nM = M / BM; nN = N / BM; nwg = nM * nN; G = G_; c = c_; }
    __host__ __device__ bool next(int i, Unit& u) const {
        const long L = (long)i * G + c; if (L >= nwg) return false;
        int wgid = (int)L; { const int q = nwg / NXCD, r = nwg % NXCD, xcd = wgid % NXCD, off = wgid / NXCD; wgid = (xcd < r ? xcd * (q + 1) : r * (q + 1) + (xcd - r) * q) + off; }
        const int nig = WGM * nN, gid = wgid / nig, fm = gid * WGM, gsz = (nM - fm) < WGM ? (nM - fm) : WGM;
        u.pm = fm + ((wgid % nig) % gsz); u.pn = (wgid % nig) / gsz; return true;
    }
    __device__ __forceinline__ void a_ready(const Unit&) const {}
    __device__ __forceinline__ void done(const Unit&) const {}
};


__device__ __forceinline__ unsigned cvt_pk_bf16(float lo, float hi) { unsigned r; asm volatile("v_cvt_pk_bf16_f32 %0, %1, %2" : "=v"(r) : "v"(lo), "v"(hi)); return r; }
typedef unsigned u32x2 __attribute__((ext_vector_type(2)));
constexpr float RMS_EPS_F = 1e-6f;
constexpr float LOG2E_F = 1.4426950408889634f;
__device__ __forceinline__ float row_rs(const float* ssqp, int row) {
    const f32x4* p = (const f32x4*)(ssqp + (size_t)row * 16);
    const f32x4 a = p[0], b = p[1], c = p[2], d = p[3];
    const float s = ((a[0] + a[1]) + (a[2] + a[3])) + ((b[0] + b[1]) + (b[2] + b[3])) + ((c[0] + c[1]) + (c[2] + c[3])) + ((d[0] + d[1]) + (d[2] + d[3]));
    return __builtin_amdgcn_rsqf(s * (1.0f / 1024.0f) + RMS_EPS_F);
}
__device__ __forceinline__ float silu_f(float g) { return g * __builtin_amdgcn_rcpf(1.0f + __builtin_amdgcn_exp2f(-g * LOG2E_F)); }
__device__ __forceinline__ float sigmoid_f(float g) { return __builtin_amdgcn_rcpf(1.0f + __builtin_amdgcn_exp2f(-g * LOG2E_F)); }

struct EpiSwiGLU {
    static constexpr bool PERM = true, AFTER_DRAIN = false;
    bf16_t* O; int ldo; const float* ssqp;
    __device__ __forceinline__ void operator()(const f32x4 (&acc)[2][2][4][2], const Unit& u, int wr, int wc, int fr, int fq) const {
        const int row0 = u.pm * BM + wr * 64 + fr, col0 = u.pn * HALF + wc * 32 + 8 * fq;
#pragma unroll
        for (int ai = 0; ai < 2; ++ai)
#pragma unroll
            for (int m = 0; m < 4; ++m) {
                const int row = row0 + ai * HALF + m * 16; const float rs = row_rs(ssqp, row);
                const f32x4 g0 = acc[ai][0][m][0] * rs, g1 = acc[ai][0][m][1] * rs, u0 = acc[ai][1][m][0] * rs, u1 = acc[ai][1][m][1] * rs;
                u32x4 w;
                w.x = cvt_pk_bf16(silu_f(g0[0]) * u0[0], silu_f(g0[1]) * u0[1]); w.y = cvt_pk_bf16(silu_f(g0[2]) * u0[2], silu_f(g0[3]) * u0[3]);
                w.z = cvt_pk_bf16(silu_f(g1[0]) * u1[0], silu_f(g1[1]) * u1[1]); w.w = cvt_pk_bf16(silu_f(g1[2]) * u1[2], silu_f(g1[3]) * u1[3]);
                *(u32x4*)(O + (size_t)row * ldo + col0) = w;
            }
    }
};

struct EpiResid {
    static constexpr bool PERM = false, AFTER_DRAIN = false;
    const float* base; float* out; bf16_t* xb; float* ssqp; float alpha; int aux;
    __device__ __forceinline__ void operator()(const f32x4 (&acc)[2][2][4][2], const Unit& u, int wr, int wc, int fr, int fq) const {
        const int row0 = u.pm * BM + wr * 64 + fr, col0 = u.pn * BM + wc * 32 + 4 * fq;
#pragma unroll
        for (int ai = 0; ai < 2; ++ai)
#pragma unroll
            for (int m = 0; m < 4; ++m) {
                const int row = row0 + ai * HALF + m * 16; const size_t off = (size_t)row * 1024 + col0; float ss = 0.f;
#pragma unroll
                for (int bj = 0; bj < 2; ++bj)
#pragma unroll
                    for (int n = 0; n < 2; ++n) {
                        const f32x4 b = *(const f32x4*)(base + off + bj * HALF + n * 16);
                        const f32x4 v = b + acc[ai][bj][m][n] * alpha;
                        *(f32x4*)(out + off + bj * HALF + n * 16) = v;
                        if (aux) { ss += (v[0] * v[0] + v[1] * v[1]) + (v[2] * v[2] + v[3] * v[3]);
                            u32x2 w; w.x = cvt_pk_bf16(v[0], v[1]); w.y = cvt_pk_bf16(v[2], v[3]); *(u32x2*)(xb + off + bj * HALF + n * 16) = w; }
                    }
                if (aux) { ss += __shfl_xor(ss, 16); ss += __shfl_xor(ss, 32); if (fq == 0) ssqp[(size_t)row * 16 + u.pn * 4 + wc] = ss; }
            }
    }
};

struct EpiWin {
    static constexpr bool PERM = true, AFTER_DRAIN = false;
    bf16_t* QO; bf16_t* KB; bf16_t* VB; bf16_t* RW; const float* ssqp; const float* gq; const float* gk; float qscale;
    __device__ __forceinline__ void operator()(const f32x4 (&acc)[2][2][4][2], const Unit& u, int wr, int wc, int fr, int fq) const {
        const int row0 = u.pm * BM + wr * 64 + fr; const int pn = u.pn;
        if (pn < 4) {
            const float* gp = (pn < 2) ? gq : gk; const float osc = (pn < 2) ? qscale : 1.0f;
            f32x4 gv[2][2];
#pragma unroll
            for (int bj = 0; bj < 2; ++bj)
#pragma unroll
                for (int n = 0; n < 2; ++n) gv[bj][n] = *(const f32x4*)(gp + 32 * bj + 8 * fq + 4 * n) * osc;
            bf16_t* dst = (pn < 2) ? QO : KB; const int ld = (pn < 2) ? 1024 : 512; const int colh = 64 * (4 * (pn & 1) + wc) + 8 * fq;
#pragma unroll
            for (int ai = 0; ai < 2; ++ai)
#pragma unroll
                for (int m = 0; m < 4; ++m) {
                    const int row = row0 + ai * HALF + m * 16; const float rs = row_rs(ssqp, row);
                    f32x4 y[2][2]; float ss = 0.f;
#pragma unroll
                    for (int bj = 0; bj < 2; ++bj)
#pragma unroll
                        for (int n = 0; n < 2; ++n) { y[bj][n] = acc[ai][bj][m][n] * rs; const f32x4 t = y[bj][n]; ss += (t[0] * t[0] + t[1] * t[1]) + (t[2] * t[2] + t[3] * t[3]); }
                    ss += __shfl_xor(ss, 16); ss += __shfl_xor(ss, 32);
                    const float hs = __builtin_amdgcn_rsqf(ss * (1.0f / 64.0f) + RMS_EPS_F);
#pragma unroll
                    for (int bj = 0; bj < 2; ++bj) {
                        const f32x4 a = y[bj][0] * gv[bj][0] * hs, b = y[bj][1] * gv[bj][1] * hs;
                        u32x4 w; w.x = cvt_pk_bf16(a[0], a[1]); w.y = cvt_pk_bf16(a[2], a[3]); w.z = cvt_pk_bf16(b[0], b[1]); w.w = cvt_pk_bf16(b[2], b[3]);
                        *(u32x4*)(dst + (size_t)row * ld + colh + 32 * bj) = w;
                    }
                }
        } else {
            bf16_t* dst = (pn < 6) ? VB : RW; const int ld = (pn < 6) ? 512 : 1792; const int colh = 256 * ((pn < 6) ? (pn - 4) : (pn - 6)) + 64 * wc + 8 * fq;
#pragma unroll
            for (int ai = 0; ai < 2; ++ai)
#pragma unroll
                for (int m = 0; m < 4; ++m) {
                    const int row = row0 + ai * HALF + m * 16; const float rs = row_rs(ssqp, row);
#pragma unroll
                    for (int bj = 0; bj < 2; ++bj) {
                        const f32x4 a = acc[ai][bj][m][0] * rs, b = acc[ai][bj][m][1] * rs;
                        u32x4 w; w.x = cvt_pk_bf16(a[0], a[1]); w.y = cvt_pk_bf16(a[2], a[3]); w.z = cvt_pk_bf16(b[0], b[1]); w.w = cvt_pk_bf16(b[2], b[3]);
                        *(u32x4*)(dst + (size_t)row * ld + colh + 32 * bj) = w;
                    }
                }
        }
    }
};

struct EpiLora {
    static constexpr bool PERM = true, AFTER_DRAIN = false;
    float* LW; bf16_t* AB; bf16_t* GB; const float* w0; const float* a0;
    __device__ __forceinline__ void operator()(const f32x4 (&acc)[2][2][4][2], const Unit& u, int wr, int wc, int fr, int fq) const {
        const int row0 = u.pm * BM + wr * 64 + fr; const int pn = u.pn; const int colt = 256 * (pn & 1) + wc * 32 + 8 * fq;
        const int kind = pn >> 1;
        const float* bp = (kind == 0) ? w0 : a0;
        bf16_t* ob = (kind == 1) ? AB : GB;
#pragma unroll
        for (int bj = 0; bj < 2; ++bj) {
            f32x4 b0 = (f32x4){0.f, 0.f, 0.f, 0.f}, b1 = b0;
            if (kind < 2) { b0 = *(const f32x4*)(bp + colt + bj * HALF); b1 = *(const f32x4*)(bp + colt + bj * HALF + 4); }
#pragma unroll
            for (int ai = 0; ai < 2; ++ai)
#pragma unroll
                for (int m = 0; m < 4; ++m) {
                    const int row = row0 + ai * HALF + m * 16;
                    f32x4 a = acc[ai][bj][m][0] + b0, b = acc[ai][bj][m][1] + b1;
                    if (kind < 2) {
#pragma unroll
                        for (int i = 0; i < 4; ++i) { a[i] = sigmoid_f(a[i]); b[i] = sigmoid_f(b[i]); }
                    }
                    if (kind == 0) { a = a * (-0.6065306597126334f); b = b * (-0.6065306597126334f);
                        float* p = LW + (size_t)row * 512 + colt + bj * HALF; *(f32x4*)p = a; *(f32x4*)(p + 4) = b; }
                    else { u32x4 w; w.x = cvt_pk_bf16(a[0], a[1]); w.y = cvt_pk_bf16(a[2], a[3]); w.z = cvt_pk_bf16(b[0], b[1]); w.w = cvt_pk_bf16(b[2], b[3]);
                        *(u32x4*)(ob + (size_t)row * 512 + colt + bj * HALF) = w; }
                    if (m & 1) asm volatile("" ::: "memory");
                }
        }
    }
};
template <class Epi, class Sched, bool ALIGN_EPI = false, bool SP2 = false>
__device__ __forceinline__ void gemm_phase(PG8_LAS unsigned char* lds, const Gemm g, const Sched& S, const Epi& E) {
    const int tid = threadIdx.x, wid = __builtin_amdgcn_readfirstlane(tid >> 6), lane = tid & 63, wr = wid >> 2, wc = wid & 3, fr = lane & 15, fq = lane >> 4;
    const int K = g.K, nt = K / BK;
    unsigned voffA[2], voffB[2];
#pragma unroll
    for (int i = 0; i < 2; ++i) { int R, C; stage_rc(tid * 16 + i * 8192, R, C); const int Rb = Epi::PERM ? ((R & ~31) + perm32(R & 31)) : R;
        voffA[i] = (unsigned)(R * K + C) * 2u; voffB[i] = (unsigned)(Rb * K + C) * 2u; }
    const size_t kstep = (size_t)(BK * 2);
    const size_t hstep = (size_t)HALF * K * 2;
    const size_t tstep = 2 * hstep;
    const unsigned ldsw = (unsigned)wid * 1024u;
    const int aoff = lds_byte(wr * 64 + fr, fq * 8), boff = lds_byte(wc * 32 + fr, fq * 8);
#define PG8_SA(b, h) (((b) * 2 + (h)) * HTB)
#define PG8_SB(b, h) ((4 + (b) * 2 + (h)) * HTB)
#define PG8_STAGE(bufoff, gbase, voff) do { _Pragma("unroll") for (int _i = 0; _i < 2; ++_i) \
        __builtin_amdgcn_global_load_lds((const unsigned*)((const char*)(gbase) + (voff)[_i]), (PG8_LAS unsigned*)(lds + (bufoff) + ldsw + _i * 8192), 16, 0, 0); } while (0)
#define PG8_LDA(dst, b, h) do { _Pragma("unroll") for (int m = 0; m < 4; ++m) _Pragma("unroll") for (int k = 0; k < 2; ++k) dst[m][k] = *(const PG8_LAS bf16x8*)(lds + PG8_SA(b, h) + aoff + m * 2048 + k * 1024); } while (0)
#define PG8_LDB(dst, b, h) do { _Pragma("unroll") for (int n = 0; n < 2; ++n) _Pragma("unroll") for (int k = 0; k < 2; ++k) dst[n][k] = *(const PG8_LAS bf16x8*)(lds + PG8_SB(b, h) + boff + n * 2048 + k * 1024); } while (0)
#define PG8_MMA(ai, bj, At, Bt) do { __builtin_amdgcn_s_setprio(1); _Pragma("unroll") for (int m = 0; m < 4; ++m) _Pragma("unroll") for (int n = 0; n < 2; ++n) _Pragma("unroll") for (int k = 0; k < 2; ++k) \
        acc[ai][bj][m][n] = __builtin_amdgcn_mfma_f32_16x16x32_bf16(Bt[n][k], At[m][k], acc[ai][bj][m][n], 0, 0, 0); __builtin_amdgcn_s_setprio(0); } while (0)
#define PG8_WAIT_V(n) asm volatile("s_waitcnt vmcnt(" #n ")" ::: "memory")
#define PG8_WAIT_L(n) asm volatile("s_waitcnt lgkmcnt(" #n ")" ::: "memory")
#define PG8_BAR __builtin_amdgcn_s_barrier()
#define PG8_SCHED __builtin_amdgcn_sched_barrier(0)
    Unit cur, nxt; int ui = 0;
    if (!S.next(0, cur)) return;
    f32x4 acc[2][2][4][2];
#pragma unroll
    for (int a = 0; a < 2; ++a)
#pragma unroll
        for (int b = 0; b < 2; ++b)
#pragma unroll
            for (int m = 0; m < 4; ++m)
#pragma unroll
                for (int n = 0; n < 2; ++n) acc[a][b][m][n] = (f32x4){0.f, 0.f, 0.f, 0.f};
    bf16x8 At[4][2], B0[2][2], B1[2][2];
    const char* cA = (const char*)g.A + (size_t)cur.pm * tstep; const char* cB = (const char*)g.Bt + (size_t)cur.pn * tstep;
    S.a_ready(cur);
    if constexpr (SP2) {
        PG8_STAGE(PG8_SB(0, 0), cB, voffB); PG8_STAGE(PG8_SB(0, 1), cB + hstep, voffB); PG8_STAGE(PG8_SA(0, 0), cA, voffA); PG8_STAGE(PG8_SA(0, 1), cA + hstep, voffA);
        if (wr == 1) PG8_BAR;
        PG8_WAIT_V(2); PG8_BAR;
        PG8_STAGE(PG8_SB(1, 0), cB + kstep, voffB); PG8_STAGE(PG8_SA(1, 0), cA + kstep, voffA); PG8_STAGE(PG8_SB(1, 1), cB + hstep + kstep, voffB);
        PG8_WAIT_V(6); PG8_BAR;
    } else {
        PG8_STAGE(PG8_SB(0, 0), cB, voffB); PG8_STAGE(PG8_SA(0, 0), cA, voffA); PG8_STAGE(PG8_SB(0, 1), cB + hstep, voffB); PG8_STAGE(PG8_SA(0, 1), cA + hstep, voffA);
        if (wr == 1) PG8_BAR;
        PG8_WAIT_V(4); PG8_BAR;
        PG8_STAGE(PG8_SB(1, 0), cB + kstep, voffB); PG8_STAGE(PG8_SA(1, 0), cA + kstep, voffA); PG8_STAGE(PG8_SB(1, 1), cB + hstep + kstep, voffB);
        PG8_WAIT_V(6); PG8_BAR;
    }
    for (;;) {
        const bool has_next = S.next(ui + 1, nxt);
        const char* nA = has_next ? (const char*)g.A + (size_t)nxt.pm * tstep : cA; const char* nB = has_next ? (const char*)g.Bt + (size_t)nxt.pn * tstep : cB;
        for (int t = 0; t < nt; t += 2) {
            const bool last = (t == nt - 2);
            const char* a1 = cA + (size_t)(t + 1) * kstep;
            const char* a2 = last ? nA : cA + (size_t)(t + 2) * kstep; const char* b2 = last ? nB : cB + (size_t)(t + 2) * kstep;
            const char* a3 = a2 + kstep; const char* b3 = b2 + kstep;
            if (last && has_next) S.a_ready(nxt);
            if constexpr (SP2) {
            PG8_LDB(B0, 0, 0); PG8_LDB(B1, 0, 1); PG8_SCHED; PG8_LDA(At, 0, 0); PG8_STAGE(PG8_SA(1, 1), a1 + hstep, voffA);
            PG8_WAIT_V(8); PG8_WAIT_L(0); PG8_BAR; PG8_MMA(0, 0, At, B0); PG8_MMA(0, 1, At, B1); PG8_BAR; PG8_SCHED;
            PG8_LDA(At, 0, 1); PG8_STAGE(PG8_SB(0, 0), b2, voffB); PG8_STAGE(PG8_SB(0, 1), b2 + hstep, voffB); PG8_STAGE(PG8_SA(0, 0), a2, voffA);
            PG8_WAIT_V(8); PG8_WAIT_L(0); PG8_BAR; PG8_MMA(1, 0, At, B0); PG8_MMA(1, 1, At, B1); PG8_BAR; PG8_SCHED;
            PG8_LDB(B0, 1, 0); PG8_LDB(B1, 1, 1); PG8_SCHED; PG8_LDA(At, 1, 0); PG8_STAGE(PG8_SA(0, 1), a2 + hstep, voffA);
            PG8_WAIT_V(8); PG8_WAIT_L(0); PG8_BAR; PG8_MMA(0, 0, At, B0); PG8_MMA(0, 1, At, B1); PG8_BAR; PG8_SCHED;
            PG8_LDA(At, 1, 1); PG8_STAGE(PG8_SB(1, 0), b3, voffB); PG8_STAGE(PG8_SB(1, 1), b3 + hstep, voffB); PG8_STAGE(PG8_SA(1, 0), a3, voffA);
            PG8_WAIT_V(8); PG8_WAIT_L(0); PG8_BAR; PG8_MMA(1, 0, At, B0); PG8_MMA(1, 1, At, B1); PG8_BAR; PG8_SCHED;
            } else {
            PG8_LDB(B0, 0, 0); PG8_SCHED; PG8_LDA(At, 0, 0); PG8_STAGE(PG8_SA(1, 1), a1 + hstep, voffA);
            PG8_WAIT_L(8); PG8_BAR; PG8_WAIT_L(0); PG8_MMA(0, 0, At, B0); PG8_BAR; PG8_SCHED;
            PG8_LDB(B1, 0, 1); PG8_STAGE(PG8_SB(0, 0), b2, voffB);
            PG8_BAR; PG8_WAIT_L(0); PG8_MMA(0, 1, At, B1); PG8_BAR;
            PG8_LDA(At, 0, 1); PG8_STAGE(PG8_SA(0, 0), a2, voffA);
            PG8_BAR; PG8_WAIT_L(0); PG8_MMA(1, 0, At, B0); PG8_BAR; PG8_SCHED;
            PG8_STAGE(PG8_SB(0, 1), b2 + hstep, voffB);
            PG8_WAIT_V(6); PG8_BAR; PG8_MMA(1, 1, At, B1); PG8_BAR;
            PG8_LDB(B0, 1, 0); PG8_SCHED; PG8_LDA(At, 1, 0); PG8_STAGE(PG8_SA(0, 1), a2 + hstep, voffA);
            PG8_WAIT_L(8); PG8_BAR; PG8_WAIT_L(0); PG8_MMA(0, 0, At, B0); PG8_BAR; PG8_SCHED;
            PG8_LDB(B1, 1, 1); PG8_STAGE(PG8_SB(1, 0), b3, voffB);
            PG8_BAR; PG8_WAIT_L(0); PG8_MMA(0, 1, At, B1); PG8_BAR;
            PG8_LDA(At, 1, 1); PG8_STAGE(PG8_SA(1, 0), a3, voffA);
            PG8_BAR; PG8_WAIT_L(0); PG8_MMA(1, 0, At, B0); PG8_BAR; PG8_SCHED;
            PG8_STAGE(PG8_SB(1, 1), b3 + hstep, voffB);
            PG8_WAIT_V(6); PG8_BAR; PG8_MMA(1, 1, At, B1); PG8_BAR;
            }
        }
        if constexpr (ALIGN_EPI) { if (wr == 0) PG8_BAR; }
        if constexpr (!Epi::AFTER_DRAIN) { E(acc, cur, wr, wc, fr, fq); S.done(cur); }
        if (!has_next) break;
#pragma unroll
        for (int a = 0; a < 2; ++a)
#pragma unroll
            for (int b = 0; b < 2; ++b)
#pragma unroll
                for (int m = 0; m < 4; ++m)
#pragma unroll
                    for (int n = 0; n < 2; ++n) acc[a][b][m][n] = (f32x4){0.f, 0.f, 0.f, 0.f};
        cur = nxt; cA = nA; cB = nB; ++ui;
        if constexpr (ALIGN_EPI) { if (wr == 1) PG8_BAR; }
    }
    PG8_WAIT_V(0);
    if constexpr (!ALIGN_EPI) { if (wr == 0) PG8_BAR; }
    PG8_BAR;
    if constexpr (Epi::AFTER_DRAIN) { E.fused(acc, cur, wr, wc, fr, fq, lds, wid, lane); S.done(cur); }
#undef PG8_SA
#undef PG8_SB
#undef PG8_STAGE
#undef PG8_LDA
#undef PG8_LDB
#undef PG8_MMA
#undef PG8_WAIT_V
#undef PG8_WAIT_L
#undef PG8_BAR
#undef PG8_SCHED
}
}
#define GAS __attribute__((address_space(1)))
#define LAS __attribute__((address_space(3)))
typedef unsigned short bf16;
typedef unsigned v4u __attribute__((ext_vector_type(4)));
typedef float f32x4 __attribute__((ext_vector_type(4)));
typedef short bf16x8 __attribute__((ext_vector_type(8)));
typedef GAS unsigned gu32;
typedef GAS unsigned long long gu64;
#define RLX_AGENT __ATOMIC_RELAXED, __HIP_MEMORY_SCOPE_AGENT
#define LDS_WAIT() asm volatile("s_waitcnt lgkmcnt(0)" ::: "memory")
#define VM_WAIT() asm volatile("s_waitcnt vmcnt(0)" ::: "memory")
__device__ __forceinline__ unsigned long long rt() { return __builtin_amdgcn_s_memrealtime(); }
__device__ __forceinline__ unsigned f2bf(float f) { unsigned u = __builtin_bit_cast(unsigned, f); return (u + 0x7fffu + ((u >> 16) & 1u)) >> 16; }
__device__ __forceinline__ unsigned pk2(float lo, float hi) { return f2bf(lo) | (f2bf(hi) << 16); }

#define XB_TMO      128
#define XB_XCNT(j)  (256  + 64 * (j))
#define XB_XSUB(j)  (1280 + 64 * (j))
#define XB_XGEN(j)  (2304 + 64 * (j))
#define XB_TOP      3328
#define XB_TOPGEN   3392
#define XCD_BAR_WORDS 3456
#define XB_SPIN_CAP (1u << 18)

__device__ __forceinline__ unsigned xb_ld(unsigned* p)              { return __hip_atomic_load(p, __ATOMIC_RELAXED, __HIP_MEMORY_SCOPE_AGENT); }
__device__ __forceinline__ unsigned xb_add(unsigned* p, unsigned v) { return __hip_atomic_fetch_add(p, v, __ATOMIC_RELAXED, __HIP_MEMORY_SCOPE_AGENT); }
__device__ __forceinline__ unsigned xb_xcc_id() { return (unsigned)__builtin_amdgcn_s_getreg((3 << 11) | 20) & 0xFu; }
#define XB_SPIN(cond, bar) do { unsigned _sp = 0; while (cond) { __builtin_amdgcn_s_sleep(1); \
    if ((++_sp & 255u) == 0u) { if (xb_ld(&(bar)[XB_TMO])) break; if (_sp > XB_SPIN_CAP) { atomicAdd(&(bar)[XB_TMO], 1u); break; } } } } while (0)

struct XcdBarrier {
    unsigned* bar; unsigned x;
    volatile LAS unsigned* st;
};

__device__ __forceinline__ XcdBarrier xcd_barrier_post(unsigned* bar, volatile LAS unsigned* st) {
    XcdBarrier b; b.bar = bar; b.x = xb_xcc_id(); b.st = st;
    if (threadIdx.x == 0) (void)xb_add(&bar[XB_XCNT(b.x)], 1u);
    return b;
}
__device__ __forceinline__ void xcd_barrier_complete(unsigned* bar, unsigned x, unsigned& nloc, unsigned& nx) {
    const unsigned G = gridDim.x * gridDim.y * gridDim.z;
    unsigned sum, cnt, mine, sp = 0u;
    for (;;) {
        sum = 0u; cnt = 0u; mine = 0u;
#pragma unroll
        for (unsigned j = 0; j < 16; ++j) { const unsigned c = xb_ld(&bar[XB_XCNT(j)]); sum += c; cnt += (c > 0u) ? 1u : 0u; mine = (j == x) ? c : mine; }
        if (sum == G) break;
        __builtin_amdgcn_s_sleep(1);
        if ((++sp & 255u) == 0u) { if (xb_ld(&bar[XB_TMO])) break; if (sp > XB_SPIN_CAP) { atomicAdd(&bar[XB_TMO], 1u); break; } }
    }
    nloc = mine > 0u ? mine : 1u; nx = cnt > 0u ? cnt : 1u;
}

__device__ __forceinline__ void xcd_barrier(const XcdBarrier& b) {
    asm volatile("s_waitcnt vmcnt(0)" ::: "memory");
    __syncthreads();
    if (threadIdx.x == 0) {
        unsigned* bar = b.bar;
        __builtin_amdgcn_s_waitcnt(0);
        unsigned nloc = b.st[0], nx = b.st[1];
        if (nloc == 0u) { xcd_barrier_complete(bar, b.x, nloc, nx); b.st[0] = nloc; b.st[1] = nx; }
        const unsigned old = xb_add(&bar[XB_XSUB(b.x)], 1u);
        const unsigned gen = old / nloc;
        if (old + 1u == (gen + 1u) * nloc) {
            __builtin_amdgcn_fence(__ATOMIC_RELEASE, "agent");
            asm volatile("s_waitcnt vmcnt(0)" ::: "memory");
            const unsigned og = xb_add(&bar[XB_TOP], 1u);
            const unsigned tg = og / nx;
            if (og + 1u == (tg + 1u) * nx) xb_add(&bar[XB_TOPGEN], 1u);
            else XB_SPIN(xb_ld(&bar[XB_TOPGEN]) == tg, bar);
            __builtin_amdgcn_fence(__ATOMIC_ACQUIRE, "agent");
            xb_add(&bar[XB_XGEN(b.x)], 1u);
            asm volatile("s_waitcnt vmcnt(0)" ::: "memory");
        } else {
            XB_SPIN(xb_ld(&bar[XB_XGEN(b.x)]) == gen, bar);
            __builtin_amdgcn_fence(__ATOMIC_ACQUIRE, "agent");
            asm volatile("s_waitcnt vmcnt(0)" ::: "memory");
        }
    }
    __syncthreads();
}

constexpr int NWAVES = 8;
#ifndef MK_N_LAUNCHES
#define MK_N_LAUNCHES 1
#endif
constexpr int PER_PHASE = 11;
constexpr int N_LAUNCHES = MK_N_LAUNCHES;

constexpr int BATCH = 16, SEQ = 2048, D = 1024, HD = 64, NH = 8, FF = 2816;
constexpr int M = BATCH * SEQ;
constexpr int SBW = 512, RWW = 512, RWP = 1792, PW = 3328, LORA_K = 256, LORA_N = 1536;
constexpr float LNX_EPS = 64e-5f;

constexpr size_t MiB = 1u << 20;
constexpr size_t WS_CTL = 0, CTL_ZERO_BYTES = 1 * MiB;
constexpr size_t WS_SSQ = 1 * MiB;
constexpr size_t WS_W1U = 4 * MiB;
constexpr size_t WS_W1D = 15 * MiB;
constexpr size_t WS_W2U = 21 * MiB;
constexpr size_t WS_W2D = 32 * MiB;
constexpr size_t WS_WIN = 38 * MiB;
constexpr size_t WS_WOUT = 45 * MiB;
constexpr size_t WS_WLORA = 47 * MiB;
constexpr size_t WS_XB = 48 * MiB;
constexpr size_t WS_ACT = 112 * MiB;
constexpr size_t WS_QO = 112 * MiB;
constexpr size_t WS_KB = 176 * MiB;
constexpr size_t WS_VB = 208 * MiB;
constexpr size_t WS_RW = 240 * MiB;
constexpr size_t WS_ALORA = 352 * MiB;
constexpr size_t WS_LW = 368 * MiB;
constexpr size_t WS_AB = 432 * MiB;
constexpr size_t WS_GB = 464 * MiB;
constexpr size_t WS_END = 496 * MiB;
constexpr int CW_TMO = 0, CW_CODE = 1;
constexpr int CW_BAR = 4096;

constexpr int RING_OFF = 0, RING_BYTES = 131072;
constexpr int LDSCTL_OFF = RING_BYTES, MISC_OFF = LDSCTL_OFF + 320;
constexpr int LDS_BYTES = 147456;

struct Frame {
    LAS unsigned char* lds;
    volatile LAS unsigned* MISC;
    gu32* ctl;
    int tid, lane, wave;
    int vcu, G;
};
typedef unsigned u32x2g __attribute__((ext_vector_type(2)));
__device__ __forceinline__ float bf2f(unsigned short h) { return __uint_as_float(((unsigned)h) << 16); }
__device__ __forceinline__ float bflo(unsigned w) { return __uint_as_float(w << 16); }
__device__ __forceinline__ float bfhi(unsigned w) { return __uint_as_float(w & 0xffff0000u); }
__device__ __forceinline__ float wave_sum(float v) {
#pragma unroll
    for (int o = 1; o < 64; o <<= 1) v += __shfl_xor(v, o);
    return v;
}
__device__ __forceinline__ float dpp_f(float v, const int ctrl_unused) { return v; }
#define DPP_ADD(v, ctrl) ((v) + __int_as_float(__builtin_amdgcn_update_dpp(0, __float_as_int(v), (ctrl), 0xF, 0xF, true)))
__device__ __forceinline__ float sum8(float v) { v = DPP_ADD(v, 0xB1); v = DPP_ADD(v, 0x4E); v = DPP_ADD(v, 0x141); return v; }

__device__ __forceinline__ void transpose_item(const float* W, int ldw, int k0, int n0src, const float* kscale, bf16* WT, int Kdst, int rho0, LAS float* scr, int lane) {
#pragma unroll 8
    for (int i = 0; i < 32; ++i) { const int kk = 2 * i + (lane >> 5); float v = W[(size_t)(k0 + kk) * ldw + n0src + (lane & 31)]; if (kscale) v *= kscale[k0 + kk]; scr[kk * 33 + (lane & 31)] = v; }
    LDS_WAIT(); asm volatile("" ::: "memory");
    const int c = lane & 7;
#pragma unroll
    for (int j = 0; j < 4; ++j) { const int n = (lane >> 3) + 8 * j; const LAS float* s = scr + (8 * c) * 33 + n;
        v4u o; o.x = pk2(s[0 * 33], s[1 * 33]); o.y = pk2(s[2 * 33], s[3 * 33]); o.z = pk2(s[4 * 33], s[5 * 33]); o.w = pk2(s[6 * 33], s[7 * 33]);
        *(GAS v4u*)(WT + (size_t)(rho0 + n) * Kdst + k0 + 8 * c) = o; }
    LDS_WAIT(); asm volatile("" ::: "memory");
}
#define P0_PTRS const float* Ax, const float* An1, const float* Ag1, const float* Au1, const float* Ad1, const float* Anm, const float* Awin, const float* Aw2, const float* Aa2, const float* Ag2, const float* Awout, \
    const float* An2, const float* Ag2f, const float* Au2f, const float* Ad2f, bf16* AW1U, bf16* AW1D, bf16* AW2U, bf16* AW2D, bf16* AWIN, bf16* AWOUT, bf16* AWLORA, bf16* AXB, float* ASSQ
__device__ __forceinline__ void p0_prologue(Frame& F, P0_PTRS) {
    LAS float* scr = (LAS float*)(F.lds + RING_OFF + F.wave * 16384);
    const int gw = F.vcu * NWAVES + F.wave, NGW = F.G * NWAVES;
    constexpr int I_UP = 16 * 176, I_DN = 44 * 32, I_IN = 16 * 104, I_OUT = 16 * 32;
    constexpr int NITEMS = 2 * (I_UP + I_DN) + I_IN + I_OUT;
    for (int it = gw; it < NITEMS; it += NGW) {
        int r = it;
        if (r < 2 * I_UP) { const int l2 = r >= I_UP; if (l2) r -= I_UP;
            const int kb = r / 176, nb = r % 176, rho0 = 32 * nb, pn = rho0 >> 8, bj = (rho0 >> 7) & 1, j0 = rho0 & 127;
            const float* src = l2 ? (bj ? Au2f : Ag2f) : (bj ? Au1 : Ag1);
            transpose_item(src, FF, 64 * kb, 128 * pn + j0, l2 ? An2 : An1, l2 ? AW2U : AW1U, D, rho0, scr, F.lane); continue; }
        r -= 2 * I_UP;
        if (r < 2 * I_DN) { const int l2 = r >= I_DN; if (l2) r -= I_DN;
            const int kb = r / 32, nb = r % 32;
            transpose_item(l2 ? Ad2f : Ad1, D, 64 * kb, 32 * nb, nullptr, l2 ? AW2D : AW1D, FF, 32 * nb, scr, F.lane); continue; }
        r -= 2 * I_DN;
        if (r < I_IN) { const int kb = r / 104, nb = r % 104, rho0 = 32 * nb, pn = rho0 >> 8, rem = rho0 & 255, bj = rem >> 7, wc = (rem & 127) >> 5;
            transpose_item(Awin, PW, 64 * kb, 256 * pn + 64 * wc + 32 * bj, Anm, AWIN, D, rho0, scr, F.lane); continue; }
        r -= I_IN;
        { const int kb = r / 32, nb = r % 32; transpose_item(Awout, D, 64 * kb, 32 * nb, nullptr, AWOUT, D, 32 * nb, scr, F.lane); }
    }
    for (int it = F.vcu * (NWAVES * 64) + F.tid; it < LORA_N * (LORA_K / 8); it += F.G * NWAVES * 64) {
        const int rho = it >> 5, kc = (it & 31) * 8; float v[8];
#pragma unroll
        for (int j = 0; j < 8; ++j) { const int k = kc + j; float t = 0.f;
            if (rho < 512) { if (k < 64) t = Aw2[(size_t)k * 512 + rho]; }
            else if (rho < 1024) { if (k >= 64 && k < 128) t = Aa2[(size_t)(k - 64) * 512 + (rho - 512)]; }
            else { if (k >= 128) t = Ag2[(size_t)(k - 128) * 512 + (rho - 1024)]; }
            v[j] = t; }
        v4u o; o.x = pk2(v[0], v[1]); o.y = pk2(v[2], v[3]); o.z = pk2(v[4], v[5]); o.w = pk2(v[6], v[7]);
        *(GAS v4u*)(AWLORA + (size_t)rho * LORA_K + kc) = o;
    }
    for (int m = gw; m < M; m += NGW) {
        const GAS f32x4* xr = (const GAS f32x4*)(Ax + (size_t)m * D) + F.lane;
        f32x4 v[4]; float s = 0.f;
#pragma unroll
        for (int j = 0; j < 4; ++j) { v[j] = xr[64 * j]; s += (v[j].x * v[j].x + v[j].y * v[j].y) + (v[j].z * v[j].z + v[j].w * v[j].w); }
        s = wave_sum(s);
        GAS unsigned long long* o8 = (GAS unsigned long long*)(AXB + (size_t)m * D) + F.lane;
#pragma unroll
        for (int j = 0; j < 4; ++j) o8[64 * j] = (unsigned long long)pk2(v[j].x, v[j].y) | ((unsigned long long)pk2(v[j].z, v[j].w) << 32);
        if (F.lane < 16) ASSQ[(size_t)m * 16 + F.lane] = (F.lane == 0) ? s : 0.f;
    }
}

__device__ __forceinline__ void p4_lora_prep(Frame& F, const bf16* RW, const float* mu, bf16* ALORA) {
    const int gw = F.vcu * NWAVES + F.wave, NGW = F.G * NWAVES; const int l = F.lane;
    const f32x4 muv = *(const f32x4*)(mu + 1536 + 4 * l);
    for (int m = gw; m < M; m += NGW) {
        const u32x2g c = *(const u32x2g*)(RW + (size_t)m * RWP + 1536 + 4 * l);
        u32x2g p = (u32x2g){0u, 0u};
        if ((m & (SEQ - 1)) != 0) p = *(const u32x2g*)(RW + (size_t)(m - 1) * RWP + 1536 + 4 * l);
        float x[4] = {bflo(c.x), bfhi(c.x), bflo(c.y), bfhi(c.y)}; const float q[4] = {bflo(p.x), bfhi(p.x), bflo(p.y), bfhi(p.y)};
#pragma unroll
        for (int i = 0; i < 4; ++i) { float u = x[i] + (q[i] - x[i]) * muv[i];
            if (l < 16) u = 2.0f * pg8::sigmoid_f(2.0f * u) - 1.0f; else if (l >= 32) u = pg8::sigmoid_f(u);
            x[i] = u; }
        u32x2g o; o.x = pk2(x[0], x[1]); o.y = pk2(x[2], x[3]);
        *(u32x2g*)(ALORA + (size_t)m * LORA_K + 4 * l) = o;
    }
}

struct RwArgs { const bf16* RW; const float* LW; const bf16* AB; const bf16* GB; bf16* QO; const float *mu, *k_k, *k_a, *r_k, *ln_w, *ln_b; };
__device__ __forceinline__ void ld8bf(const bf16* p, float (&o)[8]) { const v4u w = *(const v4u*)p; o[0] = bflo(w.x); o[1] = bfhi(w.x); o[2] = bflo(w.y); o[3] = bfhi(w.y); o[4] = bflo(w.z); o[5] = bfhi(w.z); o[6] = bflo(w.w); o[7] = bfhi(w.w); }
__device__ __forceinline__ void ld8f(const float* p, float (&o)[8]) { const f32x4 a = *(const f32x4*)p, b = *(const f32x4*)(p + 4); o[0] = a.x; o[1] = a.y; o[2] = a.z; o[3] = a.w; o[4] = b.x; o[5] = b.y; o[6] = b.z; o[7] = b.w; }
__device__ __forceinline__ void ld8l(const LAS float* p, float (&o)[8]) { const f32x4 a = *(const LAS f32x4*)p, b = *(const LAS f32x4*)(p + 4); o[0] = a.x; o[1] = a.y; o[2] = a.z; o[3] = a.w; o[4] = b.x; o[5] = b.y; o[6] = b.z; o[7] = b.w; }
__device__ __forceinline__ void st8l(LAS float* p, const float (&o)[8]) { *(LAS f32x4*)p = (f32x4){o[0], o[1], o[2], o[3]}; *(LAS f32x4*)(p + 4) = (f32x4){o[4], o[5], o[6], o[7]}; }
__device__ __forceinline__ void p6_rwkv_seq(Frame& F, const RwArgs& A) {
    LAS float* Rs = (LAS float*)(F.lds + RING_OFF); LAS float* Ws = Rs + 4096; LAS float* Ks = Ws + 4096; LAS float* As = Ks + 4096; LAS float* Bs = As + 4096; LAS float* Vs = Bs + 4096;
    LAS float* Ys = Vs + 4096; LAS float* bon = Ys + 4096;
    const int tid = F.tid, tok = tid >> 3, dg = tid & 7;
    const int vr = 8 * F.wave + (F.lane >> 3), kg = F.lane & 7;
    for (int unit = blockIdx.x; unit < BATCH * NH; unit += F.G) {
        const int b = unit >> 3, h = unit & 7; const int cb = 64 * h + 8 * dg;
        float S[8];
#pragma unroll
        for (int j = 0; j < 8; ++j) S[j] = 0.f;
        for (int c = 0; c < SEQ / 64; ++c) {
            const size_t grow = (size_t)b * SEQ + c * 64 + tok;
            {
                float r[8], k[8], v[8], rp[8], kp[8], vp[8], mr[8], mk[8], mv[8], lw[8], al[8], kkc[8], kac[8], rkc[8];
                ld8bf(A.RW + grow * RWP + cb, r); ld8bf(A.RW + grow * RWP + 512 + cb, k); ld8bf(A.RW + grow * RWP + 1024 + cb, v);
                if (c == 0 && tok == 0) {
#pragma unroll
                    for (int j = 0; j < 8; ++j) { rp[j] = 0.f; kp[j] = 0.f; vp[j] = 0.f; }
                } else { ld8bf(A.RW + (grow - 1) * RWP + cb, rp); ld8bf(A.RW + (grow - 1) * RWP + 512 + cb, kp); ld8bf(A.RW + (grow - 1) * RWP + 1024 + cb, vp); }
                ld8f(A.mu + cb, mr); ld8f(A.mu + 512 + cb, mk); ld8f(A.mu + 1024 + cb, mv);
                ld8f(A.LW + grow * 512 + cb, lw); ld8bf(A.AB + grow * 512 + cb, al);
                ld8f(A.k_k + cb, kkc); ld8f(A.k_a + cb, kac); ld8f(A.r_k + cb, rkc);
                float ss = 0.f, bp = 0.f; float kk[8], kf[8];
#pragma unroll
                for (int j = 0; j < 8; ++j) { r[j] = r[j] + (rp[j] - r[j]) * mr[j]; k[j] = k[j] + (kp[j] - k[j]) * mk[j]; v[j] = v[j] + (vp[j] - v[j]) * mv[j];
                    kk[j] = k[j] * kkc[j]; ss += kk[j] * kk[j]; kf[j] = k[j] * (1.0f + (al[j] - 1.0f) * kac[j]); bp += r[j] * kf[j] * rkc[j]; }
                ss = sum8(ss); bp = sum8(bp);
                const float inv = 1.0f / fmaxf(sqrtf(ss), 1e-12f);
                float aa[8], bb[8], ww[8];
#pragma unroll
                for (int j = 0; j < 8; ++j) { kk[j] *= inv; aa[j] = -kk[j]; bb[j] = kk[j] * al[j]; ww[j] = __builtin_amdgcn_exp2f(lw[j] * 1.4426950408889634f); }
                const int o = tok * 64 + 8 * dg;
                st8l(Rs + o, r); st8l(Ws + o, ww); st8l(Ks + o, kf); st8l(As + o, aa); st8l(Bs + o, bb); st8l(Vs + o, v);
                if (dg == 0) bon[tok] = bp;
            }
            __syncthreads();
            for (int t = 0; t < 64; ++t) {
                float a[8], w[8], bq[8], k[8], r[8];
                const int o = t * 64 + 8 * kg;
                ld8l(As + o, a); ld8l(Ws + o, w); ld8l(Bs + o, bq); ld8l(Ks + o, k); ld8l(Rs + o, r);
                const float vv = Vs[t * 64 + vr];
                float sa = 0.f;
#pragma unroll
                for (int j = 0; j < 8; ++j) sa += S[j] * a[j];
                sa = sum8(sa);
                float y = 0.f;
#pragma unroll
                for (int j = 0; j < 8; ++j) { S[j] = S[j] * w[j] + sa * bq[j] + vv * k[j]; y += S[j] * r[j]; }
                y = sum8(y);
                if (kg == 0) Ys[t * 64 + vr] = y;
            }
            __syncthreads();
            {
                float y[8], v[8], g[8], lnw[8], lnb[8];
                const int o = tok * 64 + 8 * dg;
                ld8l(Ys + o, y); ld8l(Vs + o, v); ld8bf(A.GB + grow * 512 + cb, g); ld8f(A.ln_w + cb, lnw); ld8f(A.ln_b + cb, lnb);
                float s = 0.f;
#pragma unroll
                for (int j = 0; j < 8; ++j) s += y[j];
                const float mean = sum8(s) * (1.0f / 64.0f); float q = 0.f;
#pragma unroll
                for (int j = 0; j < 8; ++j) { y[j] -= mean; q += y[j] * y[j]; }
                const float rstd = __builtin_amdgcn_rsqf(sum8(q) * (1.0f / 64.0f) + LNX_EPS); const float bo = bon[tok];
                float ov[8];
#pragma unroll
                for (int j = 0; j < 8; ++j) ov[j] = (y[j] * rstd * lnw[j] + lnb[j] + bo * v[j]) * g[j];
                v4u w; w.x = pk2(ov[0], ov[1]); w.y = pk2(ov[2], ov[3]); w.z = pk2(ov[4], ov[5]); w.w = pk2(ov[6], ov[7]);
                *(GAS v4u*)(A.QO + grow * D + 512 + cb) = w;
            }
            __syncthreads();
        }
    }
}

namespace sba {
using bf16x8 = __attribute__((ext_vector_type(8))) short;
using s16x4 = __attribute__((ext_vector_type(4))) short;
using f32x16 = __attribute__((ext_vector_type(16))) float;
using u32x4 = __attribute__((ext_vector_type(4))) unsigned;
constexpr int QB = 256, KVBLK = 64;
constexpr int LDS_K = 0, LDS_V = 16384, LDS_ST = 32768, ST_LD = 68, LDS_BYTES_ATT = LDS_ST + 8 * 32 * ST_LD * 4;
#define SBAR() __builtin_amdgcn_sched_barrier(0)
typedef float f32x2_t __attribute__((ext_vector_type(2))); typedef __bf16 bf16x2_t __attribute__((ext_vector_type(2)));
__device__ __forceinline__ unsigned cvtpk_s(float lo, float hi) { f32x2_t v = {lo, hi}; bf16x2_t b = __builtin_convertvector(v, bf16x2_t); return __builtin_bit_cast(unsigned, b); }
__device__ __forceinline__ void qkt(f32x16& p0, f32x16& p1, const char* Kslot, const bf16x8* qr, int r32, int hi) {
    const char* kb = Kslot + hi * 1024 + r32 * 16;
    const f32x16 z = f32x16{};
#pragma unroll
    for (int d0 = 0; d0 < 4; ++d0) {
        const bf16x8 b0 = *reinterpret_cast<const bf16x8*>(kb + d0 * 2048);
        const bf16x8 b1 = *reinterpret_cast<const bf16x8*>(kb + d0 * 2048 + 512);
        if (d0 == 0) { p0 = __builtin_amdgcn_mfma_f32_32x32x16_bf16(b0, qr[0], z, 0, 0, 0); p1 = __builtin_amdgcn_mfma_f32_32x32x16_bf16(b1, qr[0], z, 0, 0, 0); }
        else { p0 = __builtin_amdgcn_mfma_f32_32x32x16_bf16(b0, qr[d0], p0, 0, 0, 0); p1 = __builtin_amdgcn_mfma_f32_32x32x16_bf16(b1, qr[d0], p1, 0, 0, 0); }
    }
}
__device__ __forceinline__ void pv(f32x16* o, int vb, bf16x8 pa0, bf16x8 pa1, bf16x8 pa2, bf16x8 pa3) {
#pragma unroll
    for (int d0 = 0; d0 < 2; ++d0) { s16x4 lo[4], hi[4];
#pragma unroll
        for (int ks = 0; ks < 4; ++ks) {
            asm volatile("ds_read_b64_tr_b16 %0,%1 offset:%c2" : "=&v"(lo[ks]) : "v"(vb), "i"(d0 * 4096 + ks * 1024) : "memory");
            asm volatile("ds_read_b64_tr_b16 %0,%1 offset:%c2" : "=&v"(hi[ks]) : "v"(vb), "i"(d0 * 4096 + ks * 1024 + 512) : "memory"); }
        asm volatile("s_waitcnt lgkmcnt(0)" ::: "memory"); SBAR();
#define PK(k) (bf16x8){lo[k][0], lo[k][1], lo[k][2], lo[k][3], hi[k][0], hi[k][1], hi[k][2], hi[k][3]}
        o[d0] = __builtin_amdgcn_mfma_f32_32x32x16_bf16(pa0, PK(0), o[d0], 0, 0, 0);
        o[d0] = __builtin_amdgcn_mfma_f32_32x32x16_bf16(pa1, PK(1), o[d0], 0, 0, 0);
        o[d0] = __builtin_amdgcn_mfma_f32_32x32x16_bf16(pa2, PK(2), o[d0], 0, 0, 0);
        o[d0] = __builtin_amdgcn_mfma_f32_32x32x16_bf16(pa3, PK(3), o[d0], 0, 0, 0);
#undef PK
    }
}
__device__ __forceinline__ float swap_sum(float x, float& other_if_lo, int hi) {
    auto rr = __builtin_amdgcn_permlane32_swap(__float_as_uint(x), __float_as_uint(x), false, false);
    const float a = __uint_as_float(rr[0]), b = __uint_as_float(rr[1]);
    other_if_lo = hi ? 0.f : b;
    return a + b;
}
__device__ __forceinline__ void attn_unit(int b, int h, int qb, bf16* QO, const bf16* __restrict__ KB, const bf16* __restrict__ VB, const float* gout, char* shm) {
    const int tid = threadIdx.x, lane = tid & 63, r32 = lane & 31, hi = lane >> 5; const int wid = __builtin_amdgcn_readfirstlane(tid >> 6);
    const long rowbase = (long)b * SEQ; const int q0 = qb * QB;
    bf16* Qw = QO + (rowbase + q0 + wid * 32) * D + h * HD;
    const bf16* Kh = KB + rowbase * SBW + h * HD; const bf16* Vh = VB + rowbase * SBW + h * HD;
    const unsigned lds0 = (unsigned)(uintptr_t)shm;
    const int NT = 4 * qb + 4, jtop = 4 * qb + (wid >> 1);
    const bf16* ksrc = Kh + (long)lane * SBW + wid * 8;
    const bf16* vsrc = Vh + (long)(16 * (wid & 3) + (lane >> 2)) * SBW + (wid >> 2) * 32 + (lane & 3) * 8;
    char* kdst = shm + LDS_K + wid * 1024 + lane * 16; char* vdst = shm + LDS_V + wid * 1024 + lane * 16;
    const int vb0 = (int)(lds0 + LDS_V) + ((lane >> 4) & 1) * 32 + (lane & 3) * 8 + (4 * hi + ((lane & 15) >> 2)) * 64;
    bf16x8 qr[4];
#pragma unroll
    for (int d0 = 0; d0 < 4; ++d0) qr[d0] = *reinterpret_cast<const bf16x8*>(&Qw[(long)r32 * D + d0 * 16 + hi * 8]);
    u32x4 kreg = *(const u32x4*)(ksrc + (long)(NT - 1) * KVBLK * SBW), vreg = *(const u32x4*)(vsrc + (long)(NT - 1) * KVBLK * SBW);
    *(u32x4*)kdst = kreg; *(u32x4*)vdst = vreg;
    __syncthreads();
    float R = 0.f; f32x16 o[2]; o[0] = f32x16{}; o[1] = f32x16{};
    const int qrow = q0 + wid * 32 + r32;
    for (int jt = NT - 1; jt >= 0; --jt) {
        const int cur = (NT - 1 - jt) & 1;
        if (jt > 0) { kreg = *(const u32x4*)(ksrc + (long)(jt - 1) * KVBLK * SBW); vreg = *(const u32x4*)(vsrc + (long)(jt - 1) * KVBLK * SBW); }
        if (jt <= jtop) {
            f32x16 p0, p1;
            qkt(p0, p1, shm + LDS_K + cur * 8192, qr, r32, hi);
            f32x16 lb0, lb1;
            const int kb = 64 * jt + 4 * hi; const bool diag = (jt == jtop);
#pragma unroll
            for (int r = 0; r < 16; ++r) {
                { const float z = p0[r]; const float e = __builtin_amdgcn_exp2f(-__builtin_fabsf(z)); const float sp = __builtin_amdgcn_logf(1.0f + e);
                  float lb = __builtin_fminf(z, 0.f) - sp; float l1 = lb - z;
                  if (diag) { const int key = kb + (r & 3) + 8 * (r >> 2); if (key >= qrow) { l1 = 0.f; lb = -1e30f; } }
                  lb0[r] = lb; p0[r] = l1; }
                { const float z = p1[r]; const float e = __builtin_amdgcn_exp2f(-__builtin_fabsf(z)); const float sp = __builtin_amdgcn_logf(1.0f + e);
                  float lb = __builtin_fminf(z, 0.f) - sp; float l1 = lb - z;
                  if (diag) { const int key = kb + 32 + (r & 3) + 8 * (r >> 2); if (key >= qrow) { l1 = 0.f; lb = -1e30f; } }
                  lb1[r] = lb; p1[r] = l1; }
            }
            float c0[4], c1[4], x0[4], x1[4];
#pragma unroll
            for (int g = 0; g < 4; ++g) {
                const float s0 = (p0[4 * g] + p0[4 * g + 1]) + (p0[4 * g + 2] + p0[4 * g + 3]);
                const float s1 = (p1[4 * g] + p1[4 * g + 1]) + (p1[4 * g + 2] + p1[4 * g + 3]);
                c0[g] = swap_sum(s0, x0[g], hi); c1[g] = swap_sum(s1, x1[g], hi);
            }
            float suf0[4], suf1[4];
            suf1[3] = R; suf1[2] = suf1[3] + c1[3]; suf1[1] = suf1[2] + c1[2]; suf1[0] = suf1[1] + c1[1];
            suf0[3] = suf1[0] + c1[0]; suf0[2] = suf0[3] + c0[3]; suf0[1] = suf0[2] + c0[2]; suf0[0] = suf0[1] + c0[1];
            R = suf0[0] + c0[0];
#pragma unroll
            for (int g = 0; g < 4; ++g) {
                { const float e3 = suf0[g] + x0[g], e2 = e3 + p0[4 * g + 3], e1 = e2 + p0[4 * g + 2], e0 = e1 + p0[4 * g + 1];
                  p0[4 * g + 3] = __builtin_amdgcn_exp2f(lb0[4 * g + 3] + e3); p0[4 * g + 2] = __builtin_amdgcn_exp2f(lb0[4 * g + 2] + e2);
                  p0[4 * g + 1] = __builtin_amdgcn_exp2f(lb0[4 * g + 1] + e1); p0[4 * g] = __builtin_amdgcn_exp2f(lb0[4 * g] + e0); }
                { const float e3 = suf1[g] + x1[g], e2 = e3 + p1[4 * g + 3], e1 = e2 + p1[4 * g + 2], e0 = e1 + p1[4 * g + 1];
                  p1[4 * g + 3] = __builtin_amdgcn_exp2f(lb1[4 * g + 3] + e3); p1[4 * g + 2] = __builtin_amdgcn_exp2f(lb1[4 * g + 2] + e2);
                  p1[4 * g + 1] = __builtin_amdgcn_exp2f(lb1[4 * g + 1] + e1); p1[4 * g] = __builtin_amdgcn_exp2f(lb1[4 * g] + e0); }
            }
#define PKW(P, B) cvtpk_s(P[B], P[B + 1])
            const u32x4 pw0 = (u32x4){PKW(p0, 0), PKW(p0, 2), PKW(p0, 4), PKW(p0, 6)}, pw1 = (u32x4){PKW(p0, 8), PKW(p0, 10), PKW(p0, 12), PKW(p0, 14)};
            const u32x4 pw2 = (u32x4){PKW(p1, 0), PKW(p1, 2), PKW(p1, 4), PKW(p1, 6)}, pw3 = (u32x4){PKW(p1, 8), PKW(p1, 10), PKW(p1, 12), PKW(p1, 14)};
#undef PKW
            SBAR();
            pv(o, vb0 + cur * 8192, __builtin_bit_cast(bf16x8, pw0), __builtin_bit_cast(bf16x8, pw1), __builtin_bit_cast(bf16x8, pw2), __builtin_bit_cast(bf16x8, pw3));
        }
        if (jt > 0) { *(u32x4*)(kdst + (cur ^ 1) * 8192) = kreg; *(u32x4*)(vdst + (cur ^ 1) * 8192) = vreg; }
        __syncthreads();
    }
    {
        float* stg = (float*)(shm + LDS_ST) + wid * (32 * ST_LD);
#pragma unroll
        for (int r = 0; r < 16; ++r) { const int orow = (r & 3) + 8 * (r >> 2) + 4 * hi;
#pragma unroll
            for (int d0 = 0; d0 < 2; ++d0) stg[orow * ST_LD + d0 * 32 + r32] = o[d0][r]; }
        asm volatile("s_waitcnt lgkmcnt(0)" ::: "memory");
        const int ch = lane & 7;
        const f32x4 ga = *(const f32x4*)(gout + h * HD + ch * 8), gb = *(const f32x4*)(gout + h * HD + ch * 8 + 4);
#pragma unroll
        for (int i = 0; i < 4; ++i) { const int row = i * 8 + (lane >> 3);
            const f32x4 a = *(const f32x4*)(stg + row * ST_LD + ch * 8), c = *(const f32x4*)(stg + row * ST_LD + ch * 8 + 4);
            float ss = (a.x * a.x + a.y * a.y) + (a.z * a.z + a.w * a.w) + (c.x * c.x + c.y * c.y) + (c.z * c.z + c.w * c.w);
            ss = sum8(ss);
            const float hs = __builtin_amdgcn_rsqf(ss * (1.0f / 64.0f) + 1e-6f);
            u32x4 w; w.x = cvtpk_s(a.x * hs * ga.x, a.y * hs * ga.y); w.y = cvtpk_s(a.z * hs * ga.z, a.w * hs * ga.w);
            w.z = cvtpk_s(c.x * hs * gb.x, c.y * hs * gb.y); w.w = cvtpk_s(c.z * hs * gb.z, c.w * hs * gb.w);
            *(u32x4*)(Qw + (long)row * D + ch * 8) = w; }
        asm volatile("s_waitcnt lgkmcnt(0)" ::: "memory");
    }
}
#undef SBAR
__device__ __forceinline__ void attn_phase(Frame& F, bf16* QO, const bf16* KB, const bf16* VB, const float* gout) {
    char* shm = (char*)F.lds + RING_OFF;
    if (F.G == 256) {
        const int v = F.vcu, bh = v >> 1, odd = v & 1;
        for (int i = 0; i < 4; ++i) { const int qb = odd ? ((i == 0) ? 1 : (i == 1) ? 6 : (i == 2) ? 3 : 4) : ((i == 0) ? 0 : (i == 1) ? 7 : (i == 2) ? 2 : 5);
            attn_unit(bh >> 3, bh & 7, qb, QO, KB, VB, gout, shm); }
    } else {
        for (int id = blockIdx.x; id < BATCH * NH * 8; id += F.G) attn_unit(id >> 6, (id >> 3) & 7, id & 7, QO, KB, VB, gout, shm);
    }
}
}

struct Args { const float* in[26]; float* out; unsigned char* ws; int ph_lo, ph_hi, li, pad; };
__global__ void __launch_bounds__(NWAVES * 64, 2) skel_fwd(Args args) {
    extern __shared__ __attribute__((aligned(16))) unsigned char lds[];
    Frame F;
    F.lds = (LAS unsigned char*)lds;
    F.MISC = (volatile LAS unsigned*)(F.lds + MISC_OFF);
    F.tid = threadIdx.x; F.lane = F.tid & 63; F.wave = __builtin_amdgcn_readfirstlane(F.tid >> 6);
    F.G = gridDim.x; { const int bx = blockIdx.x; F.vcu = (F.G % 8 == 0) ? (bx % 8) * (F.G / 8) + bx / 8 : bx; }
    unsigned char* ws = args.ws;
    F.ctl = (gu32*)(ws + WS_CTL);
    const float* x = args.in[0];
    bf16* W1U = (bf16*)(ws + WS_W1U); bf16* W1D = (bf16*)(ws + WS_W1D); bf16* W2U = (bf16*)(ws + WS_W2U); bf16* W2D = (bf16*)(ws + WS_W2D);
    bf16* WIN = (bf16*)(ws + WS_WIN); bf16* WOUT = (bf16*)(ws + WS_WOUT); bf16* WLORA = (bf16*)(ws + WS_WLORA);
    bf16* XB = (bf16*)(ws + WS_XB); bf16* ACT = (bf16*)(ws + WS_ACT); bf16* QO = (bf16*)(ws + WS_QO); bf16* KB = (bf16*)(ws + WS_KB); bf16* VB = (bf16*)(ws + WS_VB);
    bf16* RW = (bf16*)(ws + WS_RW); bf16* ALORA = (bf16*)(ws + WS_ALORA); float* LW = (float*)(ws + WS_LW); bf16* AB = (bf16*)(ws + WS_AB); bf16* GB = (bf16*)(ws + WS_GB);
    float* SSQ = (float*)(ws + WS_SSQ); float* out = args.out;
    for (int u = F.tid; u < (LDS_BYTES - LDSCTL_OFF) / 4; u += NWAVES * 64) ((LAS unsigned*)(F.lds + LDSCTL_OFF))[u] = 0u;
    __syncthreads();
    XcdBarrier bar; bar.bar = (unsigned*)(F.ctl + CW_BAR); bar.x = 0; bar.st = nullptr;
    if (N_LAUNCHES != PER_PHASE) bar = xcd_barrier_post((unsigned*)(F.ctl + CW_BAR), F.MISC + 8);
#define GRID_BAR(seam) do { if (N_LAUNCHES == PER_PHASE) { if (F.tid == 0) __hip_atomic_store(F.ctl + CW_TMO, 0xBADBA0u | (unsigned)(seam), RLX_AGENT); } else { xcd_barrier(bar); } } while (0)
    const int lo = args.ph_lo, hi = args.ph_hi;
#define IN(k) (lo <= (k) && (k) < hi)
#define BOTH(k) (IN(k) && IN((k) + 1))
    if (IN(0)) {
        p0_prologue(F, x, args.in[1], args.in[2], args.in[3], args.in[4], args.in[5], args.in[6], args.in[12], args.in[14], args.in[15], args.in[21], args.in[22], args.in[23], args.in[24], args.in[25],
                    W1U, W1D, W2U, W2D, WIN, WOUT, WLORA, XB, SSQ); if (BOTH(0)) GRID_BAR(0);
    }
    if (IN(1)) {
        pg8::Gemm g{XB, W1U, M, 2 * FF, D}; pg8::StaticOrder S; S.init(M, 2 * FF, F.G, (int)blockIdx.x);
        pg8::EpiSwiGLU E{ACT, FF, SSQ};
        pg8::gemm_phase<pg8::EpiSwiGLU, pg8::StaticOrder, true, true>(F.lds + RING_OFF, g, S, E);
        if (BOTH(1)) GRID_BAR(1);
    }
    if (IN(2)) {
        pg8::Gemm g{ACT, W1D, M, D, FF}; pg8::StaticOrder S; S.init(M, D, F.G, (int)blockIdx.x);
        pg8::EpiResid E{x, out, XB, SSQ, 0.5f, 1};
        pg8::gemm_phase<pg8::EpiResid, pg8::StaticOrder, true, true>(F.lds + RING_OFF, g, S, E);
        if (BOTH(2)) GRID_BAR(2);
    }
    if (IN(3)) {
        pg8::Gemm g{XB, WIN, M, PW, D}; pg8::StaticOrder S; S.init(M, PW, F.G, (int)blockIdx.x);
        pg8::EpiWin E{QO, KB, VB, RW, SSQ, args.in[7], args.in[8], 0.125f * 1.4426950408889634f};
        pg8::gemm_phase<pg8::EpiWin, pg8::StaticOrder, true, true>(F.lds + RING_OFF, g, S, E);
        if (BOTH(3)) GRID_BAR(3);
    }
    if (IN(4)) { p4_lora_prep(F, RW, args.in[10], ALORA); if (BOTH(4)) GRID_BAR(4); }
    if (IN(5)) {
        int kl = LORA_K; asm volatile("" : "+s"(kl));
        pg8::Gemm g{ALORA, WLORA, M, LORA_N, kl}; pg8::StaticOrder S; S.init(M, LORA_N, F.G, (int)blockIdx.x);
        pg8::EpiLora E{LW, AB, GB, args.in[11], args.in[13]};
        pg8::gemm_phase<pg8::EpiLora, pg8::StaticOrder, true, true>(F.lds + RING_OFF, g, S, E);
        if (BOTH(5)) GRID_BAR(5);
    }
    if (IN(6)) {
        RwArgs A{RW, LW, AB, GB, QO, args.in[10], args.in[16], args.in[17], args.in[18], args.in[19], args.in[20]};
        p6_rwkv_seq(F, A);
        __syncthreads();
    }
    if (IN(7)) {
        sba::attn_phase(F, QO, KB, VB, args.in[9]);
        if (BOTH(7)) GRID_BAR(7);
    }
    if (IN(8)) {
        pg8::Gemm g{QO, WOUT, M, D, D}; pg8::StaticOrder S; S.init(M, D, F.G, (int)blockIdx.x);
        pg8::EpiResid E{out, out, XB, SSQ, 1.0f, 1};
        pg8::gemm_phase<pg8::EpiResid, pg8::StaticOrder, true, true>(F.lds + RING_OFF, g, S, E);
        if (BOTH(8)) GRID_BAR(8);
    }
    if (IN(9)) {
        pg8::Gemm g{XB, W2U, M, 2 * FF, D}; pg8::StaticOrder S; S.init(M, 2 * FF, F.G, (int)blockIdx.x);
        pg8::EpiSwiGLU E{ACT, FF, SSQ};
        pg8::gemm_phase<pg8::EpiSwiGLU, pg8::StaticOrder, true, true>(F.lds + RING_OFF, g, S, E);
        if (BOTH(9)) GRID_BAR(9);
    }
    if (IN(10)) {
        pg8::Gemm g{ACT, W2D, M, D, FF}; pg8::StaticOrder S; S.init(M, D, F.G, (int)blockIdx.x);
        pg8::EpiResid E{out, out, XB, SSQ, 0.5f, 0};
        pg8::gemm_phase<pg8::EpiResid, pg8::StaticOrder, true, true>(F.lds + RING_OFF, g, S, E);
    }
#undef IN
#undef BOTH
}

extern "C" void kernel_launch(void* const* d_in, const int* in_sizes, int n_in, void* d_out, int out_size, void* d_ws, size_t ws_size, hipStream_t stream) {
    static int grid = 0;
    if (grid == 0) {
        if (n_in != 26 || in_sizes[0] != M * D || out_size != M * D || ws_size < WS_END) { fprintf(stderr, "kernel_launch: unexpected shapes: n_in %d in0 %d out %d ws %zu (need %zu)\n", n_in, n_in > 0 ? in_sizes[0] : -1, out_size, ws_size, (size_t)WS_END); grid = -1; return; }
        int dev = 0, cus = 0, per_cu = 0;
        if (hipGetDevice(&dev) != hipSuccess || hipDeviceGetAttribute(&cus, hipDeviceAttributeMultiprocessorCount, dev) != hipSuccess) { grid = -1; return; }
        if (hipFuncSetAttribute((const void*)skel_fwd, hipFuncAttributeMaxDynamicSharedMemorySize, LDS_BYTES) != hipSuccess) { fprintf(stderr, "kernel_launch: hipFuncSetAttribute failed\n"); grid = -1; return; }
        if (hipOccupancyMaxActiveBlocksPerMultiprocessor(&per_cu, (const void*)skel_fwd, NWAVES * 64, LDS_BYTES) != hipSuccess || per_cu < 1) { fprintf(stderr, "kernel_launch: occupancy query reports %d blocks per CU\n", per_cu); per_cu = 1; }
        (void)hipGetLastError();
        grid = cus;
    }
    if (grid < 0) return;
    if (hipMemsetAsync((char*)d_ws + WS_CTL, 0, CTL_ZERO_BYTES, stream) != hipSuccess) return;
    Args a{};
    for (int i = 0; i < 26; ++i) a.in[i] = (const float*)d_in[i];
    a.out = (float*)d_out; a.ws = (unsigned char*)d_ws;
    for (int li = 0; li < N_LAUNCHES; ++li) {
        a.ph_lo = (N_LAUNCHES == PER_PHASE) ? li : 0; a.ph_hi = (N_LAUNCHES == PER_PHASE) ? li + 1 : PER_PHASE; a.li = li;
        hipLaunchKernelGGL(skel_fwd, dim3(grid), dim3(NWAVES * 64), LDS_BYTES, stream, a);
    }
}
```

```cpp
#include <hip/hip_runtime.h>
#include <hip/hip_bf16.h>
#include <cstdio>
#include <cstdint>
#include <cmath>
namespace pg8 {
#define PG8_LAS __attribute__((address_space(3)))
typedef unsigned short bf16_t;
typedef short bf16x8 __attribute__((ext_vector_type(8)));
typedef float f32x4 __attribute__((ext_vector_type(4)));
typedef unsigned u32x4 __attribute__((ext_vector_type(4)));
constexpr int BM = 256, BK = 64, HALF = 128, HTB = HALF * BK * 2  , STAGE_BYTES = 8 * HTB, NXCD = 8, WGM = 8;

__host__ __device__ __forceinline__ int lds_byte(int r, int c) { const int st = (r >> 4) * 2 + (c >> 5), rr = r & 15, cc = c & 31, ob = rr * 64 + cc * 2; return st * 1024 + (ob ^ (((ob >> 9) & 1) << 5)); }
__host__ __device__ __forceinline__ void stage_rc(int b, int& R, int& C) { const int st = b / 1024, sb = b % 1024, swz = sb ^ (((sb >> 9) & 1) << 5); R = (st >> 1) * 16 + swz / 64; C = (st & 1) * 32 + (swz % 64) / 2; }
__host__ __device__ __forceinline__ int perm32(int rho) { const int n = rho >> 4, i = rho & 15; return 8 * (i >> 2) + 4 * n + (i & 3); }

struct Unit { int pm, pn; };
struct Gemm { const bf16_t* A; const bf16_t* Bt; int M, N, K; };

struct StaticOrder {
    int nM, nN, nwg, G, c;
    __host__ __device__ void init(int M, int N, int G_, int c_) { nM = M / BM; nN = N / BM; nwg = nM * nN; G = G_; c = c_; }
    __host__ __device__ bool next(int i, Unit& u) const {
        const long L = (long)i * G + c; if (L >= nwg) return false;
        int wgid = (int)L; { const int q = nwg / NXCD, r = nwg % NXCD, xcd = wgid % NXCD, off = wgid / NXCD; wgid = (xcd < r ? xcd * (q + 1) : r * (q + 1) + (xcd - r) * q) + off; }
        const int nig = WGM * nN, gid = wgid / nig, fm = gid * WGM, gsz = (nM - fm) < WGM ? (nM - fm) : WGM;
        u.pm = fm + ((wgid % nig) % gsz); u.pn = (wgid % nig) / gsz; return true;
    }
    __device__ __forceinline__ void a_ready(const Unit&) const {}
    __device__ __forceinline__ void done(const Unit&) const {}
};


__device__ __forceinline__ unsigned cvt_pk_bf16(float lo, float hi) { unsigned r; asm volatile("v_cvt_pk_bf16_f32 %0, %1, %2" : "=v"(r) : "v"(lo), "v"(hi)); return r; }
typedef unsigned u32x2 __attribute__((ext_vector_type(2)));
constexpr float RMS_EPS_F = 1e-6f;
constexpr float LOG2E_F = 1.4426950408889634f;
__device__ __forceinline__ float row_rs(const float* ssqp, int row) {
    const f32x4* p = (const f32x4*)(ssqp + (size_t)row * 16);
    const f32x4 a = p[0], b = p[1], c = p[2], d = p[3];
    const float s = ((a[0] + a[1]) + (a[2] + a[3])) + ((b[0] + b[1]) + (b[2] + b[3])) + ((c[0] + c[1]) + (c[2] + c[3])) + ((d[0] + d[1]) + (d[2] + d[3]));
    return __builtin_amdgcn_rsqf(s * (1.0f / 1024.0f) + RMS_EPS_F);
}
__device__ __forceinline__ float silu_f(float g) { return g * __builtin_amdgcn_rcpf(1.0f + __builtin_amdgcn_exp2f(-g * LOG2E_F)); }
__device__ __forceinline__ float sigmoid_f(float g) { return __builtin_amdgcn_rcpf(1.0f + __builtin_amdgcn_exp2f(-g * LOG2E_F)); }

struct EpiSwiGLU {
    static constexpr bool PERM = true, AFTER_DRAIN = false;
    bf16_t* O; int ldo; const float* ssqp;
    __device__ __forceinline__ void operator()(const f32x4 (&acc)[2][2][4][2], const Unit& u, int wr, int wc, int fr, int fq) const {
        const int row0 = u.pm * BM + wr * 64 + fr, col0 = u.pn * HALF + wc * 32 + 8 * fq;
#pragma unroll
        for (int ai = 0; ai < 2; ++ai)
#pragma unroll
            for (int m = 0; m < 4; ++m) {
                const int row = row0 + ai * HALF + m * 16; const float rs = row_rs(ssqp, row);
                const f32x4 g0 = acc[ai][0][m][0] * rs, g1 = acc[ai][0][m][1] * rs, u0 = acc[ai][1][m][0] * rs, u1 = acc[ai][1][m][1] * rs;
                u32x4 w;
                w.x = cvt_pk_bf16(silu_f(g0[0]) * u0[0], silu_f(g0[1]) * u0[1]); w.y = cvt_pk_bf16(silu_f(g0[2]) * u0[2], silu_f(g0[3]) * u0[3]);
                w.z = cvt_pk_bf16(silu_f(g1[0]) * u1[0], silu_f(g1[1]) * u1[1]); w.w = cvt_pk_bf16(silu_f(g1[2]) * u1[2], silu_f(g1[3]) * u1[3]);
                *(u32x4*)(O + (size_t)row * ldo + col0) = w;
            }
    }
};

struct EpiResid {
    static constexpr bool PERM = false, AFTER_DRAIN = false;
    const float* base; float* out; bf16_t* xb; float* ssqp; float alpha; int aux;
    __device__ __forceinline__ void operator()(const f32x4 (&acc)[2][2][4][2], const Unit& u, int wr, int wc, int fr, int fq) const {
        const int row0 = u.pm * BM + wr * 64 + fr, col0 = u.pn * BM + wc * 32 + 4 * fq;
#pragma unroll
        for (int ai = 0; ai < 2; ++ai)
#pragma unroll
            for (int m = 0; m < 4; ++m) {
                const int row = row0 + ai * HALF + m * 16; const size_t off = (size_t)row * 1024 + col0; float ss = 0.f;
#pragma unroll
                for (int bj = 0; bj < 2; ++bj)
#pragma unroll
                    for (int n = 0; n < 2; ++n) {
                        const f32x4 b = *(const f32x4*)(base + off + bj * HALF + n * 16);
                        const f32x4 v = b + acc[ai][bj][m][n] * alpha;
                        *(f32x4*)(out + off + bj * HALF + n * 16) = v;
                        if (aux) { ss += (v[0] * v[0] + v[1] * v[1]) + (v[2] * v[2] + v[3] * v[3]);
                            u32x2 w; w.x = cvt_pk_bf16(v[0], v[1]); w.y = cvt_pk_bf16(v[2], v[3]); *(u32x2*)(xb + off + bj * HALF + n * 16) = w; }
                    }
                if (aux) { ss += __shfl_xor(ss, 16); ss += __shfl_xor(ss, 32); if (fq == 0) ssqp[(size_t)row * 16 + u.pn * 4 + wc] = ss; }
            }
    }
};

struct EpiWin {
    static constexpr bool PERM = true, AFTER_DRAIN = false;
    bf16_t* QO; bf16_t* KB; bf16_t* VB; bf16_t* RW; const float* ssqp; const float* gq; const float* gk; float qscale;
    __device__ __forceinline__ void operator()(const f32x4 (&acc)[2][2][4][2], const Unit& u, int wr, int wc, int fr, int fq) const {
        const int row0 = u.pm * BM + wr * 64 + fr; const int pn = u.pn;
        if (pn < 4) {
            const float* gp = (pn < 2) ? gq : gk; const float osc = (pn < 2) ? qscale : 1.0f;
            f32x4 gv[2][2];
#pragma unroll
            for (int bj = 0; bj < 2; ++bj)
#pragma unroll
                for (int n = 0; n < 2; ++n) gv[bj][n] = *(const f32x4*)(gp + 32 * bj + 8 * fq + 4 * n) * osc;
            bf16_t* dst = (pn < 2) ? QO : KB; const int ld = (pn < 2) ? 1024 : 512; const int colh = 64 * (4 * (pn & 1) + wc) + 8 * fq;
#pragma unroll
            for (int ai = 0; ai < 2; ++ai)
#pragma unroll
                for (int m = 0; m < 4; ++m) {
                    const int row = row0 + ai * HALF + m * 16; const float rs = row_rs(ssqp, row);
                    f32x4 y[2][2]; float ss = 0.f;
#pragma unroll
                    for (int bj = 0; bj < 2; ++bj)
#pragma unroll
                        for (int n = 0; n < 2; ++n) { y[bj][n] = acc[ai][bj][m][n] * rs; const f32x4 t = y[bj][n]; ss += (t[0] * t[0] + t[1] * t[1]) + (t[2] * t[2] + t[3] * t[3]); }
                    ss += __shfl_xor(ss, 16); ss += __shfl_xor(ss, 32);
                    const float hs = __builtin_amdgcn_rsqf(ss * (1.0f / 64.0f) + RMS_EPS_F);
#pragma unroll
                    for (int bj = 0; bj < 2; ++bj) {
                        const f32x4 a = y[bj][0] * gv[bj][0] * hs, b = y[bj][1] * gv[bj][1] * hs;
                        u32x4 w; w.x = cvt_pk_bf16(a[0], a[1]); w.y = cvt_pk_bf16(a[2], a[3]); w.z = cvt_pk_bf16(b[0], b[1]); w.w = cvt_pk_bf16(b[2], b[3]);
                        *(u32x4*)(dst + (size_t)row * ld + colh + 32 * bj) = w;
                    }
                }
        } else {
            bf16_t* dst = (pn < 6) ? VB : RW; const int ld = (pn < 6) ? 512 : 1792; const int colh = 256 * ((pn < 6) ? (pn - 4) : (pn - 6)) + 64 * wc + 8 * fq;
#pragma unroll
            for (int ai = 0; ai < 2; ++ai)
#pragma unroll
                for (int m = 0; m < 4; ++m) {
                    const int row = row0 + ai * HALF + m * 16; const float rs = row_rs(ssqp, row);
#pragma unroll
                    for (int bj = 0; bj < 2; ++bj) {
                        const f32x4 a = acc[ai][bj][m][0] * rs, b = acc[ai][bj][m][1] * rs;
                        u32x4 w; w.x = cvt_pk_bf16(a[0], a[1]); w.y = cvt_pk_bf16(a[2], a[3]); w.z = cvt_pk_bf16(b[0], b[1]); w.w = cvt_pk_bf16(b[2], b[3]);
                        *(u32x4*)(dst + (size_t)row * ld + colh + 32 * bj) = w;
                    }
                }
        }
    }
};

struct EpiLora {
    static constexpr bool PERM = true, AFTER_DRAIN = false;
    float* LW; bf16_t* AB; bf16_t* GB; const float* w0; const float* a0;
    __device__ __forceinline__ void operator()(const f32x4 (&acc)[2][2][4][2], const Unit& u, int wr, int wc, int fr, int fq) const {
        const int row0 = u.pm * BM + wr * 64 + fr; const int pn = u.pn; const int colt = 256 * (pn & 1) + wc * 32 + 8 * fq;
        const int kind = pn >> 1;
        const float* bp = (kind == 0) ? w0 : a0;
        bf16_t* ob = (kind == 1) ? AB : GB;
#pragma unroll
        for (int bj = 0; bj < 2; ++bj) {
            f32x4 b0 = (f32x4){0.f, 0.f, 0.f, 0.f}, b1 = b0;
            if (kind < 2) { b0 = *(const f32x4*)(bp + colt + bj * HALF); b1 = *(const f32x4*)(bp + colt + bj * HALF + 4); }
#pragma unroll
            for (int ai = 0; ai < 2; ++ai)
#pragma unroll
                for (int m = 0; m < 4; ++m) {
                    const int row = row0 + ai * HALF + m * 16;
                    f32x4 a = acc[ai][bj][m][0] + b0, b = acc[ai][bj][m][1] + b1;
                    if (kind < 2) {
#pragma unroll
                        for (int i = 0; i < 4; ++i) { a[i] = sigmoid_f(a[i]); b[i] = sigmoid_f(b[i]); }
                    }
                    if (kind == 0) { a = a * (-0.6065306597126334f); b = b * (-0.6065306597126334f);
                        float* p = LW + (size_t)row * 512 + colt + bj * HALF; *(f32x4*)p = a; *(f32x4*)(p + 4) = b; }
                    else { u32x4 w; w.x = cvt_pk_bf16(a[0], a[1]); w.y = cvt_pk_bf16(a[2], a[3]); w.z = cvt_pk_bf16(b[0], b[1]); w.w = cvt_pk_bf16(b[2], b[3]);
                        *(u32x4*)(ob + (size_t)row * 512 + colt + bj * HALF) = w; }
                    if (m & 1) asm volatile("" ::: "memory");
                }
        }
    }
};
template <class Epi, class Sched, bool ALIGN_EPI = false, bool SP2 = false>
__device__ __forceinline__ void gemm_phase(PG8_LAS unsigned char* lds, const Gemm g, const Sched& S, const Epi& E) {
    const int tid = threadIdx.x, wid = __builtin_amdgcn_readfirstlane(tid >> 6), lane = tid & 63, wr = wid >> 2, wc = wid & 3, fr = lane & 15, fq = lane >> 4;
    const int K = g.K, nt = K / BK;
    unsigned voffA[2], voffB[2];
#pragma unroll
    for (int i = 0; i < 2; ++i) { int R, C; stage_rc(tid * 16 + i * 8192, R, C); const int Rb = Epi::PERM ? ((R & ~31) + perm32(R & 31)) : R;
        voffA[i] = (unsigned)(R * K + C) * 2u; voffB[i] = (unsigned)(Rb * K + C) * 2u; }
    const size_t kstep = (size_t)(BK * 2);
    const size_t hstep = (size_t)HALF * K * 2;
    const size_t tstep = 2 * hstep;
    const unsigned ldsw = (unsigned)wid * 1024u;
    const int aoff = lds_byte(wr * 64 + fr, fq * 8), boff = lds_byte(wc * 32 + fr, fq * 8);
#define PG8_SA(b, h) (((b) * 2 + (h)) * HTB)
#define PG8_SB(b, h) ((4 + (b) * 2 + (h)) * HTB)
#define PG8_STAGE(bufoff, gbase, voff) do { _Pragma("unroll") for (int _i = 0; _i < 2; ++_i) \
        __builtin_amdgcn_global_load_lds((const unsigned*)((const char*)(gbase) + (voff)[_i]), (PG8_LAS unsigned*)(lds + (bufoff) + ldsw + _i * 8192), 16, 0, 0); } while (0)
#define PG8_LDA(dst, b, h) do { _Pragma("unroll") for (int m = 0; m < 4; ++m) _Pragma("unroll") for (int k = 0; k < 2; ++k) dst[m][k] = *(const PG8_LAS bf16x8*)(lds + PG8_SA(b, h) + aoff + m * 2048 + k * 1024); } while (0)
#define PG8_LDB(dst, b, h) do { _Pragma("unroll") for (int n = 0; n < 2; ++n) _Pragma("unroll") for (int k = 0; k < 2; ++k) dst[n][k] = *(const PG8_LAS bf16x8*)(lds + PG8_SB(b, h) + boff + n * 2048 + k * 1024); } while (0)
#define PG8_MMA(ai, bj, At, Bt) do { __builtin_amdgcn_s_setprio(1); _Pragma("unroll") for (int m = 0; m < 4; ++m) _Pragma("unroll") for (int n = 0; n < 2; ++n) _Pragma("unroll") for (int k = 0; k < 2; ++k) \
        acc[ai][bj][m][n] = __builtin_amdgcn_mfma_f32_16x16x32_bf16(Bt[n][k], At[m][k], acc[ai][bj][m][n], 0, 0, 0); __builtin_amdgcn_s_setprio(0); } while (0)
#define PG8_WAIT_V(n) asm volatile("s_waitcnt vmcnt(" #n ")" ::: "memory")
#define PG8_WAIT_L(n) asm volatile("s_waitcnt lgkmcnt(" #n ")" ::: "memory")
#define PG8_BAR __builtin_amdgcn_s_barrier()
#define PG8_SCHED __builtin_amdgcn_sched_barrier(0)
    Unit cur, nxt; int ui = 0;
    if (!S.next(0, cur)) return;
    f32x4 acc[2][2][4][2];
#pragma unroll
    for (int a = 0; a < 2; ++a)
#pragma unroll
        for (int b = 0; b < 2; ++b)
#pragma unroll
            for (int m = 0; m < 4; ++m)
#pragma unroll
                for (int n = 0; n < 2; ++n) acc[a][b][m][n] = (f32x4){0.f, 0.f, 0.f, 0.f};
    bf16x8 At[4][2], B0[2][2], B1[2][2];
    const char* cA = (const char*)g.A + (size_t)cur.pm * tstep; const char* cB = (const char*)g.Bt + (size_t)cur.pn * tstep;
    S.a_ready(cur);
    if constexpr (SP2) {
        PG8_STAGE(PG8_SB(0, 0), cB, voffB); PG8_STAGE(PG8_SB(0, 1), cB + hstep, voffB); PG8_STAGE(PG8_SA(0, 0), cA, voffA); PG8_STAGE(PG8_SA(0, 1), cA + hstep, voffA);
        if (wr == 1) PG8_BAR;
        PG8_WAIT_V(2); PG8_BAR;
        PG8_STAGE(PG8_SB(1, 0), cB + kstep, voffB); PG8_STAGE(PG8_SA(1, 0), cA + kstep, voffA); PG8_STAGE(PG8_SB(1, 1), cB + hstep + kstep, voffB);
        PG8_WAIT_V(6); PG8_BAR;
    } else {
        PG8_STAGE(PG8_SB(0, 0), cB, voffB); PG8_STAGE(PG8_SA(0, 0), cA, voffA); PG8_STAGE(PG8_SB(0, 1), cB + hstep, voffB); PG8_STAGE(PG8_SA(0, 1), cA + hstep, voffA);
        if (wr == 1) PG8_BAR;
        PG8_WAIT_V(4); PG8_BAR;
        PG8_STAGE(PG8_SB(1, 0), cB + kstep, voffB); PG8_STAGE(PG8_SA(1, 0), cA + kstep, voffA); PG8_STAGE(PG8_SB(1, 1), cB + hstep + kstep, voffB);
        PG8_WAIT_V(6); PG8_BAR;
    }
    for (;;) {
        const bool has_next = S.next(ui + 1, nxt);
        const char* nA = has_next ? (const char*)g.A + (size_t)nxt.pm * tstep : cA; const char* nB = has_next ? (const char*)g.Bt + (size_t)nxt.pn * tstep : cB;
        for (int t = 0; t < nt; t += 2) {
            const bool last = (t == nt - 2);
            const char* a1 = cA + (size_t)(t + 1) * kstep;
            const char* a2 = last ? nA : cA + (size_t)(t + 2) * kstep; const char* b2 = last ? nB : cB + (size_t)(t + 2) * kstep;
            const char* a3 = a2 + kstep; const char* b3 = b2 + kstep;
            if (last && has_next) S.a_ready(nxt);
            if constexpr (SP2) {
            PG8_LDB(B0, 0, 0); PG8_LDB(B1, 0, 1); PG8_SCHED; PG8_LDA(At, 0, 0); PG8_STAGE(PG8_SA(1, 1), a1 + hstep, voffA);
            PG8_WAIT_V(8); PG8_WAIT_L(0); PG8_BAR; PG8_MMA(0, 0, At, B0); PG8_MMA(0, 1, At, B1); PG8_BAR; PG8_SCHED;
            PG8_LDA(At, 0, 1); PG8_STAGE(PG8_SB(0, 0), b2, voffB); PG8_STAGE(PG8_SB(0, 1), b2 + hstep, voffB); PG8_STAGE(PG8_SA(0, 0), a2, voffA);
            PG8_WAIT_V(8); PG8_WAIT_L(0); PG8_BAR; PG8_MMA(1, 0, At, B0); PG8_MMA(1, 1, At, B1); PG8_BAR; PG8_SCHED;
            PG8_LDB(B0, 1, 0); PG8_LDB(B1, 1, 1); PG8_SCHED; PG8_LDA(At, 1, 0); PG8_STAGE(PG8_SA(0, 1), a2 + hstep, voffA);
            PG8_WAIT_V(8); PG8_WAIT_L(0); PG8_BAR; PG8_MMA(0, 0, At, B0); PG8_MMA(0, 1, At, B1); PG8_BAR; PG8_SCHED;
            PG8_LDA(At, 1, 1); PG8_STAGE(PG8_SB(1, 0), b3, voffB); PG8_STAGE(PG8_SB(1, 1), b3 + hstep, voffB); PG8_STAGE(PG8_SA(1, 0), a3, voffA);
            PG8_WAIT_V(8); PG8_WAIT_L(0); PG8_BAR; PG8_MMA(1, 0, At, B0); PG8_MMA(1, 1, At, B1); PG8_BAR; PG8_SCHED;
            } else {
            PG8_LDB(B0, 0, 0); PG8_SCHED; PG8_LDA(At, 0, 0); PG8_STAGE(PG8_SA(1, 1), a1 + hstep, voffA);
            PG8_WAIT_L(8); PG8_BAR; PG8_WAIT_L(0); PG8_MMA(0, 0, At, B0); PG8_BAR; PG8_SCHED;
            PG8_LDB(B1, 0, 1); PG8_STAGE(PG8_SB(0, 0), b2, voffB);
            PG8_BAR; PG8_WAIT_L(0); PG8_MMA(0, 1, At, B1); PG8_BAR;
            PG8_LDA(At, 0, 1); PG8_STAGE(PG8_SA(0, 0), a2, voffA);
            PG8_BAR; PG8_WAIT_L(0); PG8_MMA(1, 0, At, B0); PG8_BAR; PG8_SCHED;
            PG8_STAGE(PG8_SB(0, 1), b2 + hstep, voffB);
            PG8_WAIT_V(6); PG8_BAR; PG8_MMA(1, 1, At, B1); PG8_BAR;
            PG8_LDB(B0, 1, 0); PG8_SCHED; PG8_LDA(At, 1, 0); PG8_STAGE(PG8_SA(0, 1), a2 + hstep, voffA);
            PG8_WAIT_L(8); PG8_BAR; PG8_WAIT_L(0); PG8_MMA(0, 0, At, B0); PG8_BAR; PG8_SCHED;
            PG8_LDB(B1, 1, 1); PG8_STAGE(PG8_SB(1, 0), b3, voffB);
            PG8_BAR; PG8_WAIT_L(0); PG8_MMA(0, 1, At, B1); PG8_BAR;
            PG8_LDA(At, 1, 1); PG8_STAGE(PG8_SA(1, 0), a3, voffA);
            PG8_BAR; PG8_WAIT_L(0); PG8_MMA(1, 0, At, B0); PG8_BAR; PG8_SCHED;
            PG8_STAGE(PG8_SB(1, 1), b3 + hstep, voffB);
            PG8_WAIT_V(6); PG8_BAR; PG8_MMA(1, 1, At, B1); PG8_BAR;
            }
        }
        if constexpr (ALIGN_EPI) { if (wr == 0) PG8_BAR; }
        if constexpr (!Epi::AFTER_DRAIN) { E(acc, cur, wr, wc, fr, fq); S.done(cur); }
        if (!has_next) break;
#pragma unroll
        for (int a = 0; a < 2; ++a)
#pragma unroll
            for (int b = 0; b < 2; ++b)
#pragma unroll
                for (int m = 0; m < 4; ++m)
#pragma unroll
                    for (int n = 0; n < 2; ++n) acc[a][b][m][n] = (f32x4){0.f, 0.f, 0.f, 0.f};
        cur = nxt; cA = nA; cB = nB; ++ui;
        if constexpr (ALIGN_EPI) { if (wr == 1) PG8_BAR; }
    }
    PG8_WAIT_V(0);
    if constexpr (!ALIGN_EPI) { if (wr == 0) PG8_BAR; }
    PG8_BAR;
    if constexpr (Epi::AFTER_DRAIN) { E.fused(acc, cur, wr, wc, fr, fq, lds, wid, lane); S.done(cur); }
#undef PG8_SA
#undef PG8_SB
#undef PG8_STAGE
#undef PG8_LDA
#undef PG8_LDB
#undef PG8_MMA
#undef PG8_WAIT_V
#undef PG8_WAIT_L
#undef PG8_BAR
#undef PG8_SCHED
}
}
#define GAS __attribute__((address_space(1)))
#define LAS __attribute__((address_space(3)))
typedef unsigned short bf16;
typedef unsigned v4u __attribute__((ext_vector_type(4)));
typedef float f32x4 __attribute__((ext_vector_type(4)));
typedef short bf16x8 __attribute__((ext_vector_type(8)));
typedef GAS unsigned gu32;
typedef GAS unsigned long long gu64;
#define RLX_AGENT __ATOMIC_RELAXED, __HIP_MEMORY_SCOPE_AGENT
#define LDS_WAIT() asm volatile("s_waitcnt lgkmcnt(0)" ::: "memory")
#define VM_WAIT() asm volatile("s_waitcnt vmcnt(0)" ::: "memory")
__device__ __forceinline__ unsigned long long rt() { return __builtin_amdgcn_s_memrealtime(); }
__device__ __forceinline__ unsigned f2bf(float f) { unsigned u = __builtin_bit_cast(unsigned, f); return (u + 0x7fffu + ((u >> 16) & 1u)) >> 16; }
__device__ __forceinline__ unsigned pk2(float lo, float hi) { return f2bf(lo) | (f2bf(hi) << 16); }

#define XB_TMO      128
#define XB_XCNT(j)  (256  + 64 * (j))
#define XB_XSUB(j)  (1280 + 64 * (j))
#define XB_XGEN(j)  (2304 + 64 * (j))
#define XB_TOP      3328
#define XB_TOPGEN   3392
#define XCD_BAR_WORDS 3456
#define XB_SPIN_CAP (1u << 18)

__device__ __forceinline__ unsigned xb_ld(unsigned* p)              { return __hip_atomic_load(p, __ATOMIC_RELAXED, __HIP_MEMORY_SCOPE_AGENT); }
__device__ __forceinline__ unsigned xb_add(unsigned* p, unsigned v) { return __hip_atomic_fetch_add(p, v, __ATOMIC_RELAXED, __HIP_MEMORY_SCOPE_AGENT); }
__device__ __forceinline__ unsigned xb_xcc_id() { return (unsigned)__builtin_amdgcn_s_getreg((3 << 11) | 20) & 0xFu; }
#define XB_SPIN(cond, bar) do { unsigned _sp = 0; while (cond) { __builtin_amdgcn_s_sleep(1); \
    if ((++_sp & 255u) == 0u) { if (xb_ld(&(bar)[XB_TMO])) break; if (_sp > XB_SPIN_CAP) { atomicAdd(&(bar)[XB_TMO], 1u); break; } } } } while (0)

struct XcdBarrier {
    unsigned* bar; unsigned x;
    volatile LAS unsigned* st;
};

__device__ __forceinline__ XcdBarrier xcd_barrier_post(unsigned* bar, volatile LAS unsigned* st) {
    XcdBarrier b; b.bar = bar; b.x = xb_xcc_id(); b.st = st;
    if (threadIdx.x == 0) (void)xb_add(&bar[XB_XCNT(b.x)], 1u);
    return b;
}
__device__ __forceinline__ void xcd_barrier_complete(unsigned* bar, unsigned x, unsigned& nloc, unsigned& nx) {
    const unsigned G = gridDim.x * gridDim.y * gridDim.z;
    unsigned sum, cnt, mine, sp = 0u;
    for (;;) {
        sum = 0u; cnt = 0u; mine = 0u;
#pragma unroll
        for (unsigned j = 0; j < 16; ++j) { const unsigned c = xb_ld(&bar[XB_XCNT(j)]); sum += c; cnt += (c > 0u) ? 1u : 0u; mine = (j == x) ? c : mine; }
        if (sum == G) break;
        __builtin_amdgcn_s_sleep(1);
        if ((++sp & 255u) == 0u) { if (xb_ld(&bar[XB_TMO])) break; if (sp > XB_SPIN_CAP) { atomicAdd(&bar[XB_TMO], 1u); break; } }
    }
    nloc = mine > 0u ? mine : 1u; nx = cnt > 0u ? cnt : 1u;
}

__device__ __forceinline__ void xcd_barrier(const XcdBarrier& b) {
    asm volatile("s_waitcnt vmcnt(0)" ::: "memory");
    __syncthreads();
    if (threadIdx.x == 0) {
        unsigned* bar = b.bar;
        __builtin_amdgcn_s_waitcnt(0);
        unsigned nloc = b.st[0], nx = b.st[1];
        if (nloc == 0u) { xcd_barrier_complete(bar, b.x, nloc, nx); b.st[0] = nloc; b.st[1] = nx; }
        const unsigned old = xb_add(&bar[XB_XSUB(b.x)], 1u);
        const unsigned gen = old / nloc;
        if (old + 1u == (gen + 1u) * nloc) {
            __builtin_amdgcn_fence(__ATOMIC_RELEASE, "agent");
            asm volatile("s_waitcnt vmcnt(0)" ::: "memory");
            const unsigned og = xb_add(&bar[XB_TOP], 1u);
            const unsigned tg = og / nx;
            if (og + 1u == (tg + 1u) * nx) xb_add(&bar[XB_TOPGEN], 1u);
            else XB_SPIN(xb_ld(&bar[XB_TOPGEN]) == tg, bar);
            __builtin_amdgcn_fence(__ATOMIC_ACQUIRE, "agent");
            xb_add(&bar[XB_XGEN(b.x)], 1u);
            asm volatile("s_waitcnt vmcnt(0)" ::: "memory");
        } else {
            XB_SPIN(xb_ld(&bar[XB_XGEN(b.x)]) == gen, bar);
            __builtin_amdgcn_fence(__ATOMIC_ACQUIRE, "agent");
            asm volatile("s_waitcnt vmcnt(0)" ::: "memory");
        }
    }
    __syncthreads();
}

constexpr int NWAVES = 8;
#ifndef MK_N_LAUNCHES
#define MK_N_LAUNCHES 1
#endif
constexpr int PER_PHASE = 11;
constexpr int N_LAUNCHES = MK_N_LAUNCHES;

constexpr int BATCH = 16, SEQ = 2048, D = 1024, HD = 64, NH = 8, FF = 2816;
constexpr int M = BATCH * SEQ;
constexpr int SBW = 512, RWW = 512, RWP = 1792, PW = 3328, LORA_K = 256, LORA_N = 1536;
constexpr float LNX_EPS = 64e-5f;

constexpr size_t MiB = 1u << 20;
constexpr size_t WS_CTL = 0, CTL_ZERO_BYTES = 1 * MiB;
constexpr size_t WS_SSQ = 1 * MiB;
constexpr size_t WS_W1U = 4 * MiB;
constexpr size_t WS_W1D = 15 * MiB;
constexpr size_t WS_W2U = 21 * MiB;
constexpr size_t WS_W2D = 32 * MiB;
constexpr size_t WS_WIN = 38 * MiB;
constexpr size_t WS_WOUT = 45 * MiB;
constexpr size_t WS_WLORA = 47 * MiB;
constexpr size_t WS_XB = 48 * MiB;
constexpr size_t WS_ACT = 112 * MiB;
constexpr size_t WS_QO = 112 * MiB;
constexpr size_t WS_KB = 176 * MiB;
constexpr size_t WS_VB = 208 * MiB;
constexpr size_t WS_RW = 240 * MiB;
constexpr size_t WS_ALORA = 352 * MiB;
constexpr size_t WS_LW = 368 * MiB;
constexpr size_t WS_AB = 432 * MiB;
constexpr size_t WS_GB = 464 * MiB;
constexpr size_t WS_END = 496 * MiB;
constexpr int CW_TMO = 0, CW_CODE = 1;
constexpr int CW_BAR = 4096;

constexpr int RING_OFF = 0, RING_BYTES = 131072;
constexpr int LDSCTL_OFF = RING_BYTES, MISC_OFF = LDSCTL_OFF + 320;
constexpr int LDS_BYTES = 147456;

struct Frame {
    LAS unsigned char* lds;
    volatile LAS unsigned* MISC;
    gu32* ctl;
    int tid, lane, wave;
    int vcu, G;
};
typedef unsigned u32x2g __attribute__((ext_vector_type(2)));
__device__ __forceinline__ float bf2f(unsigned short h) { return __uint_as_float(((unsigned)h) << 16); }
__device__ __forceinline__ float bflo(unsigned w) { return __uint_as_float(w << 16); }
__device__ __forceinline__ float bfhi(unsigned w) { return __uint_as_float(w & 0xffff0000u); }
__device__ __forceinline__ float wave_sum(float v) {
#pragma unroll
    for (int o = 1; o < 64; o <<= 1) v += __shfl_xor(v, o);
    return v;
}
__device__ __forceinline__ float dpp_f(float v, const int ctrl_unused) { return v; }
#define DPP_ADD(v, ctrl) ((v) + __int_as_float(__builtin_amdgcn_update_dpp(0, __float_as_int(v), (ctrl), 0xF, 0xF, true)))
__device__ __forceinline__ float sum8(float v) { v = DPP_ADD(v, 0xB1); v = DPP_ADD(v, 0x4E); v = DPP_ADD(v, 0x141); return v; }

__device__ __forceinline__ void transpose_item(const float* W, int ldw, int k0, int n0src, const float* kscale, bf16* WT, int Kdst, int rho0, LAS float* scr, int lane) {
#pragma unroll 8
    for (int i = 0; i < 32; ++i) { const int kk = 2 * i + (lane >> 5); float v = W[(size_t)(k0 + kk) * ldw + n0src + (lane & 31)]; if (kscale) v *= kscale[k0 + kk]; scr[kk * 33 + (lane & 31)] = v; }
    LDS_WAIT(); asm volatile("" ::: "memory");
    const int c = lane & 7;
#pragma unroll
    for (int j = 0; j < 4; ++j) { const int n = (lane >> 3) + 8 * j; const LAS float* s = scr + (8 * c) * 33 + n;
        v4u o; o.x = pk2(s[0 * 33], s[1 * 33]); o.y = pk2(s[2 * 33], s[3 * 33]); o.z = pk2(s[4 * 33], s[5 * 33]); o.w = pk2(s[6 * 33], s[7 * 33]);
        *(GAS v4u*)(WT + (size_t)(rho0 + n) * Kdst + k0 + 8 * c) = o; }
    LDS_WAIT(); asm volatile("" ::: "memory");
}
#define P0_PTRS const float* Ax, const float* An1, const float* Ag1, const float* Au1, const float* Ad1, const float* Anm, const float* Awin, const float* Aw2, const float* Aa2, const float* Ag2, const float* Awout, \
    const float* An2, const float* Ag2f, const float* Au2f, const float* Ad2f, bf16* AW1U, bf16* AW1D, bf16* AW2U, bf16* AW2D, bf16* AWIN, bf16* AWOUT, bf16* AWLORA, bf16* AXB, float* ASSQ
__device__ __forceinline__ void p0_prologue(Frame& F, P0_PTRS) {
    LAS float* scr = (LAS float*)(F.lds + RING_OFF + F.wave * 16384);
    const int gw = F.vcu * NWAVES + F.wave, NGW = F.G * NWAVES;
    constexpr int I_UP = 16 * 176, I_DN = 44 * 32, I_IN = 16 * 104, I_OUT = 16 * 32;
    constexpr int NITEMS = 2 * (I_UP + I_DN) + I_IN + I_OUT;
    for (int it = gw; it < NITEMS; it += NGW) {
        int r = it;
        if (r < 2 * I_UP) { const int l2 = r >= I_UP; if (l2) r -= I_UP;
            const int kb = r / 176, nb = r % 176, rho0 = 32 * nb, pn = rho0 >> 8, bj = (rho0 >> 7) & 1, j0 = rho0 & 127;
            const float* src = l2 ? (bj ? Au2f : Ag2f) : (bj ? Au1 : Ag1);
            transpose_item(src, FF, 64 * kb, 128 * pn + j0, l2 ? An2 : An1, l2 ? AW2U : AW1U, D, rho0, scr, F.lane); continue; }
        r -= 2 * I_UP;
        if (r < 2 * I_DN) { const int l2 = r >= I_DN; if (l2) r -= I_DN;
            const int kb = r / 32, nb = r % 32;
            transpose_item(l2 ? Ad2f : Ad1, D, 64 * kb, 32 * nb, nullptr, l2 ? AW2D : AW1D, FF, 32 * nb, scr, F.lane); continue; }
        r -= 2 * I_DN;
        if (r < I_IN) { const int kb = r / 104, nb = r % 104, rho0 = 32 * nb, pn = rho0 >> 8, rem = rho0 & 255, bj = rem >> 7, wc = (rem & 127) >> 5;
            transpose_item(Awin, PW, 64 * kb, 256 * pn + 64 * wc + 32 * bj, Anm, AWIN, D, rho0, scr, F.lane); continue; }
        r -= I_IN;
        { const int kb = r / 32, nb = r % 32; transpose_item(Awout, D, 64 * kb, 32 * nb, nullptr, AWOUT, D, 32 * nb, scr, F.lane); }
    }
    for (int it = F.vcu * (NWAVES * 64) + F.tid; it < LORA_N * (LORA_K / 8); it += F.G * NWAVES * 64) {
        const int rho = it >> 5, kc = (it & 31) * 8; float v[8];
#pragma unroll
        for (int j = 0; j < 8; ++j) { const int k = kc + j; float t = 0.f;
            if (rho < 512) { if (k < 64) t = Aw2[(size_t)k * 512 + rho]; }
            else if (rho < 1024) { if (k >= 64 && k < 128) t = Aa2[(size_t)(k - 64) * 512 + (rho - 512)]; }
            else { if (k >= 128) t = Ag2[(size_t)(k - 128) * 512 + (rho - 1024)]; }
            v[j] = t; }
        v4u o; o.x = pk2(v[0], v[1]); o.y = pk2(v[2], v[3]); o.z = pk2(v[4], v[5]); o.w = pk2(v[6], v[7]);
        *(GAS v4u*)(AWLORA + (size_t)rho * LORA_K + kc) = o;
    }
    for (int m = gw; m < M; m += NGW) {
        const GAS f32x4* xr = (const GAS f32x4*)(Ax + (size_t)m * D) + F.lane;
        f32x4 v[4]; float s = 0.f;
#pragma unroll
        for (int j = 0; j < 4; ++j) { v[j] = xr[64 * j]; s += (v[j].x * v[j].x + v[j].y * v[j].y) + (v[j].z * v[j].z + v[j].w * v[j].w); }
        s = wave_sum(s);
        GAS unsigned long long* o8 = (GAS unsigned long long*)(AXB + (size_t)m * D) + F.lane;
#pragma unroll
        for (int j = 0; j < 4; ++j) o8[64 * j] = (unsigned long long)pk2(v[j].x, v[j].y) | ((unsigned long long)pk2(v[j].z, v[j].w) << 32);
        if (F.lane < 16) ASSQ[(size_t)m * 16 + F.lane] = (F.lane == 0) ? s : 0.f;
    }
}

__device__ __forceinline__ void p4_lora_prep(Frame& F, const bf16* RW, const float* mu, bf16* ALORA) {
    const int gw = F.vcu * NWAVES + F.wave, NGW = F.G * NWAVES; const int l = F.lane;
    const f32x4 muv = *(const f32x4*)(mu + 1536 + 4 * l);
    for (int m = gw; m < M; m += NGW) {
        const u32x2g c = *(const u32x2g*)(RW + (size_t)m * RWP + 1536 + 4 * l);
        u32x2g p = (u32x2g){0u, 0u};
        if ((m & (SEQ - 1)) != 0) p = *(const u32x2g*)(RW + (size_t)(m - 1) * RWP + 1536 + 4 * l);
        float x[4] = {bflo(c.x), bfhi(c.x), bflo(c.y), bfhi(c.y)}; const float q[4] = {bflo(p.x), bfhi(p.x), bflo(p.y), bfhi(p.y)};
#pragma unroll
        for (int i = 0; i < 4; ++i) { float u = x[i] + (q[i] - x[i]) * muv[i];
            if (l < 16) u = 2.0f * pg8::sigmoid_f(2.0f * u) - 1.0f; else if (l >= 32) u = pg8::sigmoid_f(u);
            x[i] = u; }
        u32x2g o; o.x = pk2(x[0], x[1]); o.y = pk2(x[2], x[3]);
        *(u32x2g*)(ALORA + (size_t)m * LORA_K + 4 * l) = o;
    }
}

struct RwArgs { const bf16* RW; const float* LW; const bf16* AB; const bf16* GB; bf16* QO; const float *mu, *k_k, *k_a, *r_k, *ln_w, *ln_b; };
__device__ __forceinline__ void ld8bf(const bf16* p, float (&o)[8]) { const v4u w = *(const v4u*)p; o[0] = bflo(w.x); o[1] = bfhi(w.x); o[2] = bflo(w.y); o[3] = bfhi(w.y); o[4] = bflo(w.z); o[5] = bfhi(w.z); o[6] = bflo(w.w); o[7] = bfhi(w.w); }
__device__ __forceinline__ void ld8f(const float* p, float (&o)[8]) { const f32x4 a = *(const f32x4*)p, b = *(const f32x4*)(p + 4); o[0] = a.x; o[1] = a.y; o[2] = a.z; o[3] = a.w; o[4] = b.x; o[5] = b.y; o[6] = b.z; o[7] = b.w; }
__device__ __forceinline__ void ld8l(const LAS float* p, float (&o)[8]) { const f32x4 a = *(const LAS f32x4*)p, b = *(const LAS f32x4*)(p + 4); o[0] = a.x; o[1] = a.y; o[2] = a.z; o[3] = a.w; o[4] = b.x; o[5] = b.y; o[6] = b.z; o[7] = b.w; }
__device__ __forceinline__ void st8l(LAS float* p, const float (&o)[8]) { *(LAS f32x4*)p = (f32x4){o[0], o[1], o[2], o[3]}; *(LAS f32x4*)(p + 4) = (f32x4){o[4], o[5], o[6], o[7]}; }
__device__ __forceinline__ void p6_rwkv_seq(Frame& F, const RwArgs& A) {
    LAS float* Rs = (LAS float*)(F.lds + RING_OFF); LAS float* Ws = Rs + 4096; LAS float* Ks = Ws + 4096; LAS float* As = Ks + 4096; LAS float* Bs = As + 4096; LAS float* Vs = Bs + 4096;
    LAS float* Ys = Vs + 4096; LAS float* bon = Ys + 4096;
    const int tid = F.tid, tok = tid >> 3, dg = tid & 7;
    const int vr = 8 * F.wave + (F.lane >> 3), kg = F.lane & 7;
    for (int unit = blockIdx.x; unit < BATCH * NH; unit += F.G) {
        const int b = unit >> 3, h = unit & 7; const int cb = 64 * h + 8 * dg;
        float S[8];
#pragma unroll
        for (int j = 0; j < 8; ++j) S[j] = 0.f;
        for (int c = 0; c < SEQ / 64; ++c) {
            const size_t grow = (size_t)b * SEQ + c * 64 + tok;
            {
                float r[8], k[8], v[8], rp[8], kp[8], vp[8], mr[8], mk[8], mv[8], lw[8], al[8], kkc[8], kac[8], rkc[8];
                ld8bf(A.RW + grow * RWP + cb, r); ld8bf(A.RW + grow * RWP + 512 + cb, k); ld8bf(A.RW + grow * RWP + 1024 + cb, v);
                if (c == 0 && tok == 0) {
#pragma unroll
                    for (int j = 0; j < 8; ++j) { rp[j] = 0.f; kp[j] = 0.f; vp[j] = 0.f; }
                } else { ld8bf(A.RW + (grow - 1) * RWP + cb, rp); ld8bf(A.RW + (grow - 1) * RWP + 512 + cb, kp); ld8bf(A.RW + (grow - 1) * RWP + 1024 + cb, vp); }
                ld8f(A.mu + cb, mr); ld8f(A.mu + 512 + cb, mk); ld8f(A.mu + 1024 + cb, mv);
                ld8f(A.LW + grow * 512 + cb, lw); ld8bf(A.AB + grow * 512 + cb, al);
                ld8f(A.k_k + cb, kkc); ld8f(A.k_a + cb, kac); ld8f(A.r_k + cb, rkc);
                float ss = 0.f, bp = 0.f; float kk[8], kf[8];
#pragma unroll
                for (int j = 0; j < 8; ++j) { r[j] = r[j] + (rp[j] - r[j]) * mr[j]; k[j] = k[j] + (kp[j] - k[j]) * mk[j]; v[j] = v[j] + (vp[j] - v[j]) * mv[j];
                    kk[j] = k[j] * kkc[j]; ss += kk[j] * kk[j]; kf[j] = k[j] * (1.0f + (al[j] - 1.0f) * kac[j]); bp += r[j] * kf[j] * rkc[j]; }
                ss = sum8(ss); bp = sum8(bp);
                const float inv = 1.0f / fmaxf(sqrtf(ss), 1e-12f);
                float aa[8], bb[8], ww[8];
#pragma unroll
                for (int j = 0; j < 8; ++j) { kk[j] *= inv; aa[j] = -kk[j]; bb[j] = kk[j] * al[j]; ww[j] = __builtin_amdgcn_exp2f(lw[j] * 1.4426950408889634f); }
                const int o = tok * 64 + 8 * dg;
                st8l(Rs + o, r); st8l(Ws + o, ww); st8l(Ks + o, kf); st8l(As + o, aa); st8l(Bs + o, bb); st8l(Vs + o, v);
                if (dg == 0) bon[tok] = bp;
            }
            __syncthreads();
            for (int t = 0; t < 64; ++t) {
                float a[8], w[8], bq[8], k[8], r[8];
                const int o = t * 64 + 8 * kg;
                ld8l(As + o, a); ld8l(Ws + o, w); ld8l(Bs + o, bq); ld8l(Ks + o, k); ld8l(Rs + o, r);
                const float vv = Vs[t * 64 + vr];
                float sa = 0.f;
#pragma unroll
                for (int j = 0; j < 8; ++j) sa += S[j] * a[j];
                sa = sum8(sa);
                float y = 0.f;
#pragma unroll
                for (int j = 0; j < 8; ++j) { S[j] = S[j] * w[j] + sa * bq[j] + vv * k[j]; y += S[j] * r[j]; }
                y = sum8(y);
                if (kg == 0) Ys[t * 64 + vr] = y;
            }
            __syncthreads();
            {
                float y[8], v[8], g[8], lnw[8], lnb[8];
                const int o = tok * 64 + 8 * dg;
                ld8l(Ys + o, y); ld8l(Vs + o, v); ld8bf(A.GB + grow * 512 + cb, g); ld8f(A.ln_w + cb, lnw); ld8f(A.ln_b + cb, lnb);
                float s = 0.f;
#pragma unroll
                for (int j = 0; j < 8; ++j) s += y[j];
                const float mean = sum8(s) * (1.0f / 64.0f); float q = 0.f;
#pragma unroll
                for (int j = 0; j < 8; ++j) { y[j] -= mean; q += y[j] * y[j]; }
                const float rstd = __builtin_amdgcn_rsqf(sum8(q) * (1.0f / 64.0f) + LNX_EPS); const float bo = bon[tok];
                float ov[8];
#pragma unroll
                for (int j = 0; j < 8; ++j) ov[j] = (y[j] * rstd * lnw[j] + lnb[j] + bo * v[j]) * g[j];
                v4u w; w.x = pk2(ov[0], ov[1]); w.y = pk2(ov[2], ov[3]); w.z = pk2(ov[4], ov[5]); w.w = pk2(ov[6], ov[7]);
                *(GAS v4u*)(A.QO + grow * D + 512 + cb) = w;
            }
            __syncthreads();
        }
    }
}

namespace sba {
using bf16x8 = __attribute__((ext_vector_type(8))) short;
using s16x4 = __attribute__((ext_vector_type(4))) short;
using f32x16 = __attribute__((ext_vector_type(16))) float;
using u32x4 = __attribute__((ext_vector_type(4))) unsigned;
constexpr int QB = 256, KVBLK = 64;
constexpr int LDS_K = 0, LDS_V = 16384, LDS_ST = 32768, ST_LD = 68, LDS_FLAG = LDS_ST + 8 * 32 * ST_LD * 4, LDS_BYTES_ATT = LDS_FLAG + 64;
constexpr float R_DEAD = -160.0f;
#define SBAR() __builtin_amdgcn_sched_barrier(0)
typedef float f32x2_t __attribute__((ext_vector_type(2))); typedef __bf16 bf16x2_t __attribute__((ext_vector_type(2)));
__device__ __forceinline__ unsigned cvtpk_s(float lo, float hi) { f32x2_t v = {lo, hi}; bf16x2_t b = __builtin_convertvector(v, bf16x2_t); return __builtin_bit_cast(unsigned, b); }
__device__ __forceinline__ void qkt(f32x16& p0, f32x16& p1, const char* Kslot, const bf16x8* qr, int r32, int hi) {
    const char* kb = Kslot + hi * 1024 + r32 * 16;
    const f32x16 z = f32x16{};
#pragma unroll
    for (int d0 = 0; d0 < 4; ++d0) {
        const bf16x8 b0 = *reinterpret_cast<const bf16x8*>(kb + d0 * 2048);
        const bf16x8 b1 = *reinterpret_cast<const bf16x8*>(kb + d0 * 2048 + 512);
        if (d0 == 0) { p0 = __builtin_amdgcn_mfma_f32_32x32x16_bf16(b0, qr[0], z, 0, 0, 0); p1 = __builtin_amdgcn_mfma_f32_32x32x16_bf16(b1, qr[0], z, 0, 0, 0); }
        else { p0 = __builtin_amdgcn_mfma_f32_32x32x16_bf16(b0, qr[d0], p0, 0, 0, 0); p1 = __builtin_amdgcn_mfma_f32_32x32x16_bf16(b1, qr[d0], p1, 0, 0, 0); }
    }
}
__device__ __forceinline__ void pv(f32x16* o, int vb, bf16x8 pa0, bf16x8 pa1, bf16x8 pa2, bf16x8 pa3) {
#pragma unroll
    for (int d0 = 0; d0 < 2; ++d0) { s16x4 lo[4], hi[4];
#pragma unroll
        for (int ks = 0; ks < 4; ++ks) {
            asm volatile("ds_read_b64_tr_b16 %0,%1 offset:%c2" : "=&v"(lo[ks]) : "v"(vb), "i"(d0 * 4096 + ks * 1024) : "memory");
            asm volatile("ds_read_b64_tr_b16 %0,%1 offset:%c2" : "=&v"(hi[ks]) : "v"(vb), "i"(d0 * 4096 + ks * 1024 + 512) : "memory"); }
        asm volatile("s_waitcnt lgkmcnt(0)" ::: "memory"); SBAR();
#define PK(k) (bf16x8){lo[k][0], lo[k][1], lo[k][2], lo[k][3], hi[k][0], hi[k][1], hi[k][2], hi[k][3]}
        o[d0] = __builtin_amdgcn_mfma_f32_32x32x16_bf16(pa0, PK(0), o[d0], 0, 0, 0);
        o[d0] = __builtin_amdgcn_mfma_f32_32x32x16_bf16(pa1, PK(1), o[d0], 0, 0, 0);
        o[d0] = __builtin_amdgcn_mfma_f32_32x32x16_bf16(pa2, PK(2), o[d0], 0, 0, 0);
        o[d0] = __builtin_amdgcn_mfma_f32_32x32x16_bf16(pa3, PK(3), o[d0], 0, 0, 0);
#undef PK
    }
}
__device__ __forceinline__ float swap_sum(float x, float& other_if_lo, int hi) {
    auto rr = __builtin_amdgcn_permlane32_swap(__float_as_uint(x), __float_as_uint(x), false, false);
    const float a = __uint_as_float(rr[0]), b = __uint_as_float(rr[1]);
    other_if_lo = hi ? 0.f : b;
    return a + b;
}
__device__ __forceinline__ void attn_unit(int b, int h, int qb, bf16* QO, const bf16* __restrict__ KB, const bf16* __restrict__ VB, const float* gout, char* shm) {
    const int tid = threadIdx.x, lane = tid & 63, r32 = lane & 31, hi = lane >> 5; const int wid = __builtin_amdgcn_readfirstlane(tid >> 6);
    const long rowbase = (long)b * SEQ; const int q0 = qb * QB;
    bf16* Qw = QO + (rowbase + q0 + wid * 32) * D + h * HD;
    const bf16* Kh = KB + rowbase * SBW + h * HD; const bf16* Vh = VB + rowbase * SBW + h * HD;
    const unsigned lds0 = (unsigned)(uintptr_t)shm;
    const int NT = 4 * qb + 4, jtop = 4 * qb + (wid >> 1);
    const bf16* ksrc = Kh + (long)lane * SBW + wid * 8;
    const bf16* vsrc = Vh + (long)(16 * (wid & 3) + (lane >> 2)) * SBW + (wid >> 2) * 32 + (lane & 3) * 8;
    char* kdst = shm + LDS_K + wid * 1024 + lane * 16; char* vdst = shm + LDS_V + wid * 1024 + lane * 16;
    const int vb0 = (int)(lds0 + LDS_V) + ((lane >> 4) & 1) * 32 + (lane & 3) * 8 + (4 * hi + ((lane & 15) >> 2)) * 64;
    bf16x8 qr[4];
#pragma unroll
    for (int d0 = 0; d0 < 4; ++d0) qr[d0] = *reinterpret_cast<const bf16x8*>(&Qw[(long)r32 * D + d0 * 16 + hi * 8]);
    u32x4 kreg = *(const u32x4*)(ksrc + (long)(NT - 1) * KVBLK * SBW), vreg = *(const u32x4*)(vsrc + (long)(NT - 1) * KVBLK * SBW);
    *(u32x4*)kdst = kreg; *(u32x4*)vdst = vreg;
    __syncthreads();
    float R = 0.f; f32x16 o[2]; o[0] = f32x16{}; o[1] = f32x16{};
    bool wdone = false; unsigned* flg = (unsigned*)(shm + LDS_FLAG);
    const int qrow = q0 + wid * 32 + r32;
    for (int jt = NT - 1; jt >= 0; --jt) {
        const int cur = (NT - 1 - jt) & 1;
        if (jt > 0) { kreg = *(const u32x4*)(ksrc + (long)(jt - 1) * KVBLK * SBW); vreg = *(const u32x4*)(vsrc + (long)(jt - 1) * KVBLK * SBW); }
        if (jt <= jtop && !wdone) {
            f32x16 p0, p1;
            qkt(p0, p1, shm + LDS_K + cur * 8192, qr, r32, hi);
            f32x16 lb0, lb1;
            const int kb = 64 * jt + 4 * hi; const bool diag = (jt == jtop);
#pragma unroll
            for (int r = 0; r < 16; ++r) {
                { const float z = p0[r]; const float L = __builtin_amdgcn_logf(1.0f + __builtin_amdgcn_exp2f(z)); float lb = z - L; float l1 = -L;
                  if (diag) { const int key = kb + (r & 3) + 8 * (r >> 2); if (key >= qrow) { l1 = 0.f; lb = -1e30f; } }
                  lb0[r] = lb; p0[r] = l1; }
                { const float z = p1[r]; const float L = __builtin_amdgcn_logf(1.0f + __builtin_amdgcn_exp2f(z)); float lb = z - L; float l1 = -L;
                  if (diag) { const int key = kb + 32 + (r & 3) + 8 * (r >> 2); if (key >= qrow) { l1 = 0.f; lb = -1e30f; } }
                  lb1[r] = lb; p1[r] = l1; }
            }
            float c0[4], c1[4], x0[4], x1[4];
#pragma unroll
            for (int g = 0; g < 4; ++g) {
                const float s0 = (p0[4 * g] + p0[4 * g + 1]) + (p0[4 * g + 2] + p0[4 * g + 3]);
                const float s1 = (p1[4 * g] + p1[4 * g + 1]) + (p1[4 * g + 2] + p1[4 * g + 3]);
                c0[g] = swap_sum(s0, x0[g], hi); c1[g] = swap_sum(s1, x1[g], hi);
            }
            float suf0[4], suf1[4];
            suf1[3] = R; suf1[2] = suf1[3] + c1[3]; suf1[1] = suf1[2] + c1[2]; suf1[0] = suf1[1] + c1[1];
            suf0[3] = suf1[0] + c1[0]; suf0[2] = suf0[3] + c0[3]; suf0[1] = suf0[2] + c0[2]; suf0[0] = suf0[1] + c0[1];
            R = suf0[0] + c0[0];
#pragma unroll
            for (int g = 0; g < 4; ++g) {
                { const float e3 = suf0[g] + x0[g], e2 = e3 + p0[4 * g + 3], e1 = e2 + p0[4 * g + 2], e0 = e1 + p0[4 * g + 1];
                  p0[4 * g + 3] = __builtin_amdgcn_exp2f(lb0[4 * g + 3] + e3); p0[4 * g + 2] = __builtin_amdgcn_exp2f(lb0[4 * g + 2] + e2);
                  p0[4 * g + 1] = __builtin_amdgcn_exp2f(lb0[4 * g + 1] + e1); p0[4 * g] = __builtin_amdgcn_exp2f(lb0[4 * g] + e0); }
                { const float e3 = suf1[g] + x1[g], e2 = e3 + p1[4 * g + 3], e1 = e2 + p1[4 * g + 2], e0 = e1 + p1[4 * g + 1];
                  p1[4 * g + 3] = __builtin_amdgcn_exp2f(lb1[4 * g + 3] + e3); p1[4 * g + 2] = __builtin_amdgcn_exp2f(lb1[4 * g + 2] + e2);
                  p1[4 * g + 1] = __builtin_amdgcn_exp2f(lb1[4 * g + 1] + e1); p1[4 * g] = __builtin_amdgcn_exp2f(lb1[4 * g] + e0); }
            }
#define PKW(P, B) cvtpk_s(P[B], P[B + 1])
            const u32x4 pw0 = (u32x4){PKW(p0, 0), PKW(p0, 2), PKW(p0, 4), PKW(p0, 6)}, pw1 = (u32x4){PKW(p0, 8), PKW(p0, 10), PKW(p0, 12), PKW(p0, 14)};
            const u32x4 pw2 = (u32x4){PKW(p1, 0), PKW(p1, 2), PKW(p1, 4), PKW(p1, 6)}, pw3 = (u32x4){PKW(p1, 8), PKW(p1, 10), PKW(p1, 12), PKW(p1, 14)};
#undef PKW
            SBAR();
            pv(o, vb0 + cur * 8192, __builtin_bit_cast(bf16x8, pw0), __builtin_bit_cast(bf16x8, pw1), __builtin_bit_cast(bf16x8, pw2), __builtin_bit_cast(bf16x8, pw3));
            wdone = __all(R < R_DEAD) != 0;
        }
        if (jt > 0) { *(u32x4*)(kdst + (cur ^ 1) * 8192) = kreg; *(u32x4*)(vdst + (cur ^ 1) * 8192) = vreg; }
        if (lane == 0) flg[cur * 8 + wid] = wdone ? 1u : 0u;
        __syncthreads();
        { const u32x4 f0 = *(const u32x4*)(flg + cur * 8), f1 = *(const u32x4*)(flg + cur * 8 + 4);
          if ((f0.x & f0.y & f0.z & f0.w & f1.x & f1.y & f1.z & f1.w) != 0u) break; }
    }
    {
        float* stg = (float*)(shm + LDS_ST) + wid * (32 * ST_LD);
#pragma unroll
        for (int r = 0; r < 16; ++r) { const int orow = (r & 3) + 8 * (r >> 2) + 4 * hi;
#pragma unroll
            for (int d0 = 0; d0 < 2; ++d0) stg[orow * ST_LD + d0 * 32 + r32] = o[d0][r]; }
        asm volatile("s_waitcnt lgkmcnt(0)" ::: "memory");
        const int ch = lane & 7;
        const f32x4 ga = *(const f32x4*)(gout + h * HD + ch * 8), gb = *(const f32x4*)(gout + h * HD + ch * 8 + 4);
#pragma unroll
        for (int i = 0; i < 4; ++i) { const int row = i * 8 + (lane >> 3);
            const f32x4 a = *(const f32x4*)(stg + row * ST_LD + ch * 8), c = *(const f32x4*)(stg + row * ST_LD + ch * 8 + 4);
            float ss = (a.x * a.x + a.y * a.y) + (a.z * a.z + a.w * a.w) + (c.x * c.x + c.y * c.y) + (c.z * c.z + c.w * c.w);
            ss = sum8(ss);
            const float hs = __builtin_amdgcn_rsqf(ss * (1.0f / 64.0f) + 1e-6f);
            u32x4 w; w.x = cvtpk_s(a.x * hs * ga.x, a.y * hs * ga.y); w.y = cvtpk_s(a.z * hs * ga.z, a.w * hs * ga.w);
            w.z = cvtpk_s(c.x * hs * gb.x, c.y * hs * gb.y); w.w = cvtpk_s(c.z * hs * gb.z, c.w * hs * gb.w);
            *(u32x4*)(Qw + (long)row * D + ch * 8) = w; }
        asm volatile("s_waitcnt lgkmcnt(0)" ::: "memory");
    }
}
#undef SBAR
__device__ __forceinline__ void attn_phase(Frame& F, bf16* QO, const bf16* KB, const bf16* VB, const float* gout) {
    char* shm = (char*)F.lds + RING_OFF;
    if (F.G == 256) {
        const int v = F.vcu, bh = v >> 1, odd = v & 1;
        for (int i = 0; i < 4; ++i) { const int qb = odd ? ((i == 0) ? 1 : (i == 1) ? 6 : (i == 2) ? 3 : 4) : ((i == 0) ? 0 : (i == 1) ? 7 : (i == 2) ? 2 : 5);
            attn_unit(bh >> 3, bh & 7, qb, QO, KB, VB, gout, shm); }
    } else {
        for (int id = blockIdx.x; id < BATCH * NH * 8; id += F.G) attn_unit(id >> 6, (id >> 3) & 7, id & 7, QO, KB, VB, gout, shm);
    }
}
}

struct Args { const float* in[26]; float* out; unsigned char* ws; int ph_lo, ph_hi, li, pad; };
__global__ void __launch_bounds__(NWAVES * 64, 2) skel_fwd(Args args) {
    extern __shared__ __attribute__((aligned(16))) unsigned char lds[];
    Frame F;
    F.lds = (LAS unsigned char*)lds;
    F.MISC = (volatile LAS unsigned*)(F.lds + MISC_OFF);
    F.tid = threadIdx.x; F.lane = F.tid & 63; F.wave = __builtin_amdgcn_readfirstlane(F.tid >> 6);
    F.G = gridDim.x; { const int bx = blockIdx.x; F.vcu = (F.G % 8 == 0) ? (bx % 8) * (F.G / 8) + bx / 8 : bx; }
    unsigned char* ws = args.ws;
    F.ctl = (gu32*)(ws + WS_CTL);
    const float* x = args.in[0];
    bf16* W1U = (bf16*)(ws + WS_W1U); bf16* W1D = (bf16*)(ws + WS_W1D); bf16* W2U = (bf16*)(ws + WS_W2U); bf16* W2D = (bf16*)(ws + WS_W2D);
    bf16* WIN = (bf16*)(ws + WS_WIN); bf16* WOUT = (bf16*)(ws + WS_WOUT); bf16* WLORA = (bf16*)(ws + WS_WLORA);
    bf16* XB = (bf16*)(ws + WS_XB); bf16* ACT = (bf16*)(ws + WS_ACT); bf16* QO = (bf16*)(ws + WS_QO); bf16* KB = (bf16*)(ws + WS_KB); bf16* VB = (bf16*)(ws + WS_VB);
    bf16* RW = (bf16*)(ws + WS_RW); bf16* ALORA = (bf16*)(ws + WS_ALORA); float* LW = (float*)(ws + WS_LW); bf16* AB = (bf16*)(ws + WS_AB); bf16* GB = (bf16*)(ws + WS_GB);
    float* SSQ = (float*)(ws + WS_SSQ); float* out = args.out;
    for (int u = F.tid; u < (LDS_BYTES - LDSCTL_OFF) / 4; u += NWAVES * 64) ((LAS unsigned*)(F.lds + LDSCTL_OFF))[u] = 0u;
    __syncthreads();
    XcdBarrier bar; bar.bar = (unsigned*)(F.ctl + CW_BAR); bar.x = 0; bar.st = nullptr;
    if (N_LAUNCHES != PER_PHASE) bar = xcd_barrier_post((unsigned*)(F.ctl + CW_BAR), F.MISC + 8);
#define GRID_BAR(seam) do { if (N_LAUNCHES == PER_PHASE) { if (F.tid == 0) __hip_atomic_store(F.ctl + CW_TMO, 0xBADBA0u | (unsigned)(seam), RLX_AGENT); } else { xcd_barrier(bar); } } while (0)
    const int lo = args.ph_lo, hi = args.ph_hi;
#define IN(k) (lo <= (k) && (k) < hi)
#define BOTH(k) (IN(k) && IN((k) + 1))
    if (IN(0)) {
        p0_prologue(F, x, args.in[1], args.in[2], args.in[3], args.in[4], args.in[5], args.in[6], args.in[12], args.in[14], args.in[15], args.in[21], args.in[22], args.in[23], args.in[24], args.in[25],
                    W1U, W1D, W2U, W2D, WIN, WOUT, WLORA, XB, SSQ); if (BOTH(0)) GRID_BAR(0);
    }
    if (IN(1)) {
        pg8::Gemm g{XB, W1U, M, 2 * FF, D}; pg8::StaticOrder S; S.init(M, 2 * FF, F.G, (int)blockIdx.x);
        pg8::EpiSwiGLU E{ACT, FF, SSQ};
        pg8::gemm_phase<pg8::EpiSwiGLU, pg8::StaticOrder, true, true>(F.lds + RING_OFF, g, S, E);
        if (BOTH(1)) GRID_BAR(1);
    }
    if (IN(2)) {
        pg8::Gemm g{ACT, W1D, M, D, FF}; pg8::StaticOrder S; S.init(M, D, F.G, (int)blockIdx.x);
        pg8::EpiResid E{x, out, XB, SSQ, 0.5f, 1};
        pg8::gemm_phase<pg8::EpiResid, pg8::StaticOrder, true, true>(F.lds + RING_OFF, g, S, E);
        if (BOTH(2)) GRID_BAR(2);
    }
    if (IN(3)) {
        pg8::Gemm g{XB, WIN, M, PW, D}; pg8::StaticOrder S; S.init(M, PW, F.G, (int)blockIdx.x);
        pg8::EpiWin E{QO, KB, VB, RW, SSQ, args.in[7], args.in[8], 0.125f * 1.4426950408889634f};
        pg8::gemm_phase<pg8::EpiWin, pg8::StaticOrder, true, true>(F.lds + RING_OFF, g, S, E);
        if (BOTH(3)) GRID_BAR(3);
    }
    if (IN(4)) { p4_lora_prep(F, RW, args.in[10], ALORA); if (BOTH(4)) GRID_BAR(4); }
    if (IN(5)) {
        int kl = LORA_K; asm volatile("" : "+s"(kl));
        pg8::Gemm g{ALORA, WLORA, M, LORA_N, kl}; pg8::StaticOrder S; S.init(M, LORA_N, F.G, (int)blockIdx.x);
        pg8::EpiLora E{LW, AB, GB, args.in[11], args.in[13]};
        pg8::gemm_phase<pg8::EpiLora, pg8::StaticOrder, true, true>(F.lds + RING_OFF, g, S, E);
        if (BOTH(5)) GRID_BAR(5);
    }
    if (IN(6)) {
        RwArgs A{RW, LW, AB, GB, QO, args.in[10], args.in[16], args.in[17], args.in[18], args.in[19], args.in[20]};
        p6_rwkv_seq(F, A);
        __syncthreads();
    }
    if (IN(7)) {
        sba::attn_phase(F, QO, KB, VB, args.in[9]);
        if (BOTH(7)) GRID_BAR(7);
    }
    if (IN(8)) {
        pg8::Gemm g{QO, WOUT, M, D, D}; pg8::StaticOrder S; S.init(M, D, F.G, (int)blockIdx.x);
        pg8::EpiResid E{out, out, XB, SSQ, 1.0f, 1};
        pg8::gemm_phase<pg8::EpiResid, pg8::StaticOrder, true, true>(F.lds + RING_OFF, g, S, E);
        if (BOTH(8)) GRID_BAR(8);
    }
    if (IN(9)) {
        pg8::Gemm g{XB, W2U, M, 2 * FF, D}; pg8::StaticOrder S; S.init(M, 2 * FF, F.G, (int)blockIdx.x);
        pg8::EpiSwiGLU E{ACT, FF, SSQ};
        pg8::gemm_phase<pg8::EpiSwiGLU, pg8::StaticOrder, true, true>(F.lds + RING_OFF, g, S, E);
        if (BOTH(9)) GRID_BAR(9);
    }
    if (IN(10)) {
        pg8::Gemm g{ACT, W2D, M, D, FF}; pg8::StaticOrder S; S.init(M, D, F.G, (int)blockIdx.x);
        pg8::EpiResid E{out, out, XB, SSQ, 0.5f, 0};
        pg8::gemm_phase<pg8::EpiResid, pg8::StaticOrder, true, true>(F.lds + RING_OFF, g, S, E);
    }
#undef IN
#undef BOTH
}

extern "C" void kernel_launch(void* const* d_in, const int* in_sizes, int n_in, void* d_out, int out_size, void* d_ws, size_t ws_size, hipStream_t stream) {
    static int grid = 0;
    if (grid == 0) {
        if (n_in != 26 || in_sizes[0] != M * D || out_size != M * D || ws_size < WS_END) { fprintf(stderr, "kernel_launch: unexpected shapes: n_in %d in0 %d out %d ws %zu (need %zu)\n", n_in, n_in > 0 ? in_sizes[0] : -1, out_size, ws_size, (size_t)WS_END); grid = -1; return; }
        int dev = 0, cus = 0, per_cu = 0;
        if (hipGetDevice(&dev) != hipSuccess || hipDeviceGetAttribute(&cus, hipDeviceAttributeMultiprocessorCount, dev) != hipSuccess) { grid = -1; return; }
        if (hipFuncSetAttribute((const void*)skel_fwd, hipFuncAttributeMaxDynamicSharedMemorySize, LDS_BYTES) != hipSuccess) { fprintf(stderr, "kernel_launch: hipFuncSetAttribute failed\n"); grid = -1; return; }
        if (hipOccupancyMaxActiveBlocksPerMultiprocessor(&per_cu, (const void*)skel_fwd, NWAVES * 64, LDS_BYTES) != hipSuccess || per_cu < 1) { fprintf(stderr, "kernel_launch: occupancy query reports %d blocks per CU\n", per_cu); per_cu = 1; }
        (void)hipGetLastError();
        grid = cus;
    }
    if (grid < 0) return;
    if (hipMemsetAsync((char*)d_ws + WS_CTL, 0, CTL_ZERO_BYTES, stream) != hipSuccess) return;
    Args a{};
    for (int i = 0; i < 26; ++i) a.in[i] = (const float*)d_in[i];
    a.out = (float*)d_out; a.ws = (unsigned char*)d_ws;
    for (int li = 0; li < N_LAUNCHES; ++li) {
        a.ph_lo = (N_LAUNCHES == PER_PHASE) ? li : 0; a.ph_hi = (N_LAUNCHES == PER_PHASE) ? li + 1 : PER_PHASE; a.li = li;
        hipLaunchKernelGGL(skel_fwd, dim3(grid), dim3(NWAVES * 64), LDS_BYTES, stream, a);
    }
}
```

```cpp
#include <hip/hip_runtime.h>
#include <hip/hip_bf16.h>
#include <cstdio>
#include <cstdint>
#include <cmath>
namespace pg8 {
#define PG8_LAS __attribute__((address_space(3)))
typedef unsigned short bf16_t;
typedef short bf16x8 __attribute__((ext_vector_type(8)));
typedef float f32x4 __attribute__((ext_vector_type(4)));
typedef unsigned u32x4 __attribute__((ext_vector_type(4)));
constexpr int BM = 256, BK = 64, HALF = 128, HTB = HALF * BK * 2  , STAGE_BYTES = 8 * HTB, NXCD = 8, WGM = 8;

__host__ __device__ __forceinline__ int lds_byte(int r, int c) { const int st = (r >> 4) * 2 + (c >> 5), rr = r & 15, cc = c & 31, ob = rr * 64 + cc * 2; return st * 1024 + (ob ^ (((ob >> 9) & 1) << 5)); }
__host__ __device__ __forceinline__ void stage_rc(int b, int& R, int& C) { const int st = b / 1024, sb = b % 1024, swz = sb ^ (((sb >> 9) & 1) << 5); R = (st >> 1) * 16 + swz / 64; C = (st & 1) * 32 + (swz % 64) / 2; }
__host__ __device__ __forceinline__ int perm32(int rho) { const int n = rho >> 4, i = rho & 15; return 8 * (i >> 2) + 4 * n + (i & 3); }

struct Unit { int pm, pn; };
struct Gemm { const bf16_t* A; const bf16_t* Bt; int M, N, K; };

struct StaticOrder {
    int nM, nN, nwg, G, c;
    __host__ __device__ void init(int M, int N, int G_, int c_) { nM = M / BM; nN = N / BM; nwg = nM * nN; G = G_; c = c_; }
    __host__ __device__ bool next(int i, Unit& u) const {
        const long L = (long)i * G + c; if (L >= nwg) return false;
        int wgid = (int)L; { const int q = nwg / NXCD, r = nwg % NXCD, xcd = wgid % NXCD, off = wgid / NXCD; wgid = (xcd < r ? xcd * (q + 1) : r * (q + 1) + (xcd - r) * q) + off; }
        const int nig = WGM * nN, gid = wgid / nig, fm = gid * WGM, gsz = (nM - fm) < WGM ? (nM - fm) : WGM;
        u.pm = fm + ((wgid % nig) % gsz); u.pn = (wgid % nig) / gsz; return true;
    }
    __device__ __forceinline__ void a_ready(const Unit&) const {}
    __device__ __forceinline__ void done(const Unit&) const {}
};


__device__ __forceinline__ unsigned cvt_pk_bf16(float lo, float hi) { unsigned r; asm volatile("v_cvt_pk_bf16_f32 %0, %1, %2" : "=v"(r) : "v"(lo), "v"(hi)); return r; }
typedef unsigned u32x2 __attribute__((ext_vector_type(2)));
constexpr float RMS_EPS_F = 1e-6f;
constexpr float LOG2E_F = 1.4426950408889634f;
__device__ __forceinline__ float row_rs(const float* ssqp, int row) {
    const f32x4* p = (const f32x4*)(ssqp + (size_t)row * 16);
    const f32x4 a = p[0], b = p[1], c = p[2], d = p[3];
    const float s = ((a[0] + a[1]) + (a[2] + a[3])) + ((b[0] + b[1]) + (b[2] + b[3])) + ((c[0] + c[1]) + (c[2] + c[3])) + ((d[0] + d[1]) + (d[2] + d[3]));
    return __builtin_amdgcn_rsqf(s * (1.0f / 1024.0f) + RMS_EPS_F);
}
__device__ __forceinline__ float silu_f(float g) { return g * __builtin_amdgcn_rcpf(1.0f + __builtin_amdgcn_exp2f(-g * LOG2E_F)); }
__device__ __forceinline__ float sigmoid_f(float g) { return __builtin_amdgcn_rcpf(1.0f + __builtin_amdgcn_exp2f(-g * LOG2E_F)); }

struct EpiSwiGLU {
    static constexpr bool PERM = true, AFTER_DRAIN = false;
    bf16_t* O; int ldo; const float* ssqp;
    __device__ __forceinline__ void operator()(const f32x4 (&acc)[2][2][4][2], const Unit& u, int wr, int wc, int fr, int fq) const {
        const int row0 = u.pm * BM + wr * 64 + fr, col0 = u.pn * HALF + wc * 32 + 8 * fq;
#pragma unroll
        for (int ai = 0; ai < 2; ++ai)
#pragma unroll
            for (int m = 0; m < 4; ++m) {
                const int row = row0 + ai * HALF + m * 16; const float rs = row_rs(ssqp, row);
                const f32x4 g0 = acc[ai][0][m][0] * rs, g1 = acc[ai][0][m][1] * rs, u0 = acc[ai][1][m][0] * rs, u1 = acc[ai][1][m][1] * rs;
                u32x4 w;
                w.x = cvt_pk_bf16(silu_f(g0[0]) * u0[0], silu_f(g0[1]) * u0[1]); w.y = cvt_pk_bf16(silu_f(g0[2]) * u0[2], silu_f(g0[3]) * u0[3]);
                w.z = cvt_pk_bf16(silu_f(g1[0]) * u1[0], silu_f(g1[1]) * u1[1]); w.w = cvt_pk_bf16(silu_f(g1[2]) * u1[2], silu_f(g1[3]) * u1[3]);
                *(u32x4*)(O + (size_t)row * ldo + col0) = w;
            }
    }
};

struct EpiResid {
    static constexpr bool PERM = false, AFTER_DRAIN = false;
    const float* base; float* out; bf16_t* xb; float* ssqp; float alpha; int aux;
    __device__ __forceinline__ void operator()(const f32x4 (&acc)[2][2][4][2], const Unit& u, int wr, int wc, int fr, int fq) const {
        const int row0 = u.pm * BM + wr * 64 + fr, col0 = u.pn * BM + wc * 32 + 4 * fq;
#pragma unroll
        for (int ai = 0; ai < 2; ++ai)
#pragma unroll
            for (int m = 0; m < 4; ++m) {
                const int row = row0 + ai * HALF + m * 16; const size_t off = (size_t)row * 1024 + col0; float ss = 0.f;
#pragma unroll
                for (int bj = 0; bj < 2; ++bj)
#pragma unroll
                    for (int n = 0; n < 2; ++n) {
                        const f32x4 b = *(const f32x4*)(base + off + bj * HALF + n * 16);
                        const f32x4 v = b + acc[ai][bj][m][n] * alpha;
                        *(f32x4*)(out + off + bj * HALF + n * 16) = v;
                        if (aux) { ss += (v[0] * v[0] + v[1] * v[1]) + (v[2] * v[2] + v[3] * v[3]);
                            u32x2 w; w.x = cvt_pk_bf16(v[0], v[1]); w.y = cvt_pk_bf16(v[2], v[3]); *(u32x2*)(xb + off + bj * HALF + n * 16) = w; }
                    }
                if (aux) { ss += __shfl_xor(ss, 16); ss += __shfl_xor(ss, 32); if (fq == 0) ssqp[(size_t)row * 16 + u.pn * 4 + wc] = ss; }
            }
    }
};

struct EpiWin {
    static constexpr bool PERM = true, AFTER_DRAIN = false;
    bf16_t* QO; bf16_t* KB; bf16_t* VB; bf16_t* RW; const float* ssqp; const float* gq; const float* gk; float qscale;
    __device__ __forceinline__ void operator()(const f32x4 (&acc)[2][2][4][2], const Unit& u, int wr, int wc, int fr, int fq) const {
        const int row0 = u.pm * BM + wr * 64 + fr; const int pn = u.pn;
        if (pn < 4) {
            const float* gp = (pn < 2) ? gq : gk; const float osc = (pn < 2) ? qscale : 1.0f;
            f32x4 gv[2][2];
#pragma unroll
            for (int bj = 0; bj < 2; ++bj)
#pragma unroll
                for (int n = 0; n < 2; ++n) gv[bj][n] = *(const f32x4*)(gp + 32 * bj + 8 * fq + 4 * n) * osc;
            bf16_t* dst = (pn < 2) ? QO : KB; const int ld = (pn < 2) ? 1024 : 512; const int colh = 64 * (4 * (pn & 1) + wc) + 8 * fq;
#pragma unroll
            for (int ai = 0; ai < 2; ++ai)
#pragma unroll
                for (int m = 0; m < 4; ++m) {
                    const int row = row0 + ai * HALF + m * 16; const float rs = row_rs(ssqp, row);
                    f32x4 y[2][2]; float ss = 0.f;
#pragma unroll
                    for (int bj = 0; bj < 2; ++bj)
#pragma unroll
                        for (int n = 0; n < 2; ++n) { y[bj][n] = acc[ai][bj][m][n] * rs; const f32x4 t = y[bj][n]; ss += (t[0] * t[0] + t[1] * t[1]) + (t[2] * t[2] + t[3] * t[3]); }
                    ss += __shfl_xor(ss, 16); ss += __shfl_xor(ss, 32);
                    const float hs = __builtin_amdgcn_rsqf(ss * (1.0f / 64.0f) + RMS_EPS_F);
#pragma unroll
                    for (int bj = 0; bj < 2; ++bj) {
                        const f32x4 a = y[bj][0] * gv[bj][0] * hs, b = y[bj][1] * gv[bj][1] * hs;
                        u32x4 w; w.x = cvt_pk_bf16(a[0], a[1]); w.y = cvt_pk_bf16(a[2], a[3]); w.z = cvt_pk_bf16(b[0], b[1]); w.w = cvt_pk_bf16(b[2], b[3]);
                        *(u32x4*)(dst + (size_t)row * ld + colh + 32 * bj) = w;
                    }
                }
        } else {
            bf16_t* dst = (pn < 6) ? VB : RW; const int ld = (pn < 6) ? 512 : 1792; const int colh = 256 * ((pn < 6) ? (pn - 4) : (pn - 6)) + 64 * wc + 8 * fq;
#pragma unroll
            for (int ai = 0; ai < 2; ++ai)
#pragma unroll
                for (int m = 0; m < 4; ++m) {
                    const int row = row0 + ai * HALF + m * 16; const float rs = row_rs(ssqp, row);
#pragma unroll
                    for (int bj = 0; bj < 2; ++bj) {
                        const f32x4 a = acc[ai][bj][m][0] * rs, b = acc[ai][bj][m][1] * rs;
                        u32x4 w; w.x = cvt_pk_bf16(a[0], a[1]); w.y = cvt_pk_bf16(a[2], a[3]); w.z = cvt_pk_bf16(b[0], b[1]); w.w = cvt_pk_bf16(b[2], b[3]);
                        *(u32x4*)(dst + (size_t)row * ld + colh + 32 * bj) = w;
                    }
                }
        }
    }
};

struct EpiLora {
    static constexpr bool PERM = true, AFTER_DRAIN = false;
    float* LW; bf16_t* AB; bf16_t* GB; const float* w0; const float* a0;
    __device__ __forceinline__ void operator()(const f32x4 (&acc)[2][2][4][2], const Unit& u, int wr, int wc, int fr, int fq) const {
        const int row0 = u.pm * BM + wr * 64 + fr; const int pn = u.pn; const int colt = 256 * (pn & 1) + wc * 32 + 8 * fq;
        const int kind = pn >> 1;
        const float* bp = (kind == 0) ? w0 : a0;
        bf16_t* ob = (kind == 1) ? AB : GB;
#pragma unroll
        for (int bj = 0; bj < 2; ++bj) {
            f32x4 b0 = (f32x4){0.f, 0.f, 0.f, 0.f}, b1 = b0;
            if (kind < 2) { b0 = *(const f32x4*)(bp + colt + bj * HALF); b1 = *(const f32x4*)(bp + colt + bj * HALF + 4); }
#pragma unroll
            for (int ai = 0; ai < 2; ++ai)
#pragma unroll
                for (int m = 0; m < 4; ++m) {
                    const int row = row0 + ai * HALF + m * 16;
                    f32x4 a = acc[ai][bj][m][0] + b0, b = acc[ai][bj][m][1] + b1;
                    if (kind < 2) {
#pragma unroll
                        for (int i = 0; i < 4; ++i) { a[i] = sigmoid_f(a[i]); b[i] = sigmoid_f(b[i]); }
                    }
                    if (kind == 0) { a = a * (-0.6065306597126334f); b = b * (-0.6065306597126334f);
                        float* p = LW + (size_t)row * 512 + colt + bj * HALF; *(f32x4*)p = a; *(f32x4*)(p + 4) = b; }
                    else { u32x4 w; w.x = cvt_pk_bf16(a[0], a[1]); w.y = cvt_pk_bf16(a[2], a[3]); w.z = cvt_pk_bf16(b[0], b[1]); w.w = cvt_pk_bf16(b[2], b[3]);
                        *(u32x4*)(ob + (size_t)row * 512 + colt + bj * HALF) = w; }
                    if (m & 1) asm volatile("" ::: "memory");
                }
        }
    }
};
template <class Epi, class Sched, bool ALIGN_EPI = false, bool SP2 = false>
__device__ __forceinline__ void gemm_phase(PG8_LAS unsigned char* lds, const Gemm g, const Sched& S, const Epi& E) {
    const int tid = threadIdx.x, wid = __builtin_amdgcn_readfirstlane(tid >> 6), lane = tid & 63, wr = wid >> 2, wc = wid & 3, fr = lane & 15, fq = lane >> 4;
    const int K = g.K, nt = K / BK;
    unsigned voffA[2], voffB[2];
#pragma unroll
    for (int i = 0; i < 2; ++i) { int R, C; stage_rc(tid * 16 + i * 8192, R, C); const int Rb = Epi::PERM ? ((R & ~31) + perm32(R & 31)) : R;
        voffA[i] = (unsigned)(R * K + C) * 2u; voffB[i] = (unsigned)(Rb * K + C) * 2u; }
    const size_t kstep = (size_t)(BK * 2);
    const size_t hstep = (size_t)HALF * K * 2;
    const size_t tstep = 2 * hstep;
    const unsigned ldsw = (unsigned)wid * 1024u;
    const int aoff = lds_byte(wr * 64 + fr, fq * 8), boff = lds_byte(wc * 32 + fr, fq * 8);
#define PG8_SA(b, h) (((b) * 2 + (h)) * HTB)
#define PG8_SB(b, h) ((4 + (b) * 2 + (h)) * HTB)
#define PG8_STAGE(bufoff, gbase, voff) do { _Pragma("unroll") for (int _i = 0; _i < 2; ++_i) \
        __builtin_amdgcn_global_load_lds((const unsigned*)((const char*)(gbase) + (voff)[_i]), (PG8_LAS unsigned*)(lds + (bufoff) + ldsw + _i * 8192), 16, 0, 0); } while (0)
#define PG8_LDA(dst, b, h) do { _Pragma("unroll") for (int m = 0; m < 4; ++m) _Pragma("unroll") for (int k = 0; k < 2; ++k) dst[m][k] = *(const PG8_LAS bf16x8*)(lds + PG8_SA(b, h) + aoff + m * 2048 + k * 1024); } while (0)
#define PG8_LDB(dst, b, h) do { _Pragma("unroll") for (int n = 0; n < 2; ++n) _Pragma("unroll") for (int k = 0; k < 2; ++k) dst[n][k] = *(const PG8_LAS bf16x8*)(lds + PG8_SB(b, h) + boff + n * 2048 + k * 1024); } while (0)
#define PG8_MMA(ai, bj, At, Bt) do { __builtin_amdgcn_s_setprio(1); _Pragma("unroll") for (int m = 0; m < 4; ++m) _Pragma("unroll") for (int n = 0; n < 2; ++n) _Pragma("unroll") for (int k = 0; k < 2; ++k) \
        acc[ai][bj][m][n] = __builtin_amdgcn_mfma_f32_16x16x32_bf16(Bt[n][k], At[m][k], acc[ai][bj][m][n], 0, 0, 0); __builtin_amdgcn_s_setprio(0); } while (0)
#define PG8_WAIT_V(n) asm volatile("s_waitcnt vmcnt(" #n ")" ::: "memory")
#define PG8_WAIT_L(n) asm volatile("s_waitcnt lgkmcnt(" #n ")" ::: "memory")
#define PG8_BAR __builtin_amdgcn_s_barrier()
#define PG8_SCHED __builtin_amdgcn_sched_barrier(0)
    Unit cur, nxt; int ui = 0;
    if (!S.next(0, cur)) return;
    f32x4 acc[2][2][4][2];
#pragma unroll
    for (int a = 0; a < 2; ++a)
#pragma unroll
        for (int b = 0; b < 2; ++b)
#pragma unroll
            for (int m = 0; m < 4; ++m)
#pragma unroll
                for (int n = 0; n < 2; ++n) acc[a][b][m][n] = (f32x4){0.f, 0.f, 0.f, 0.f};
    bf16x8 At[4][2], B0[2][2], B1[2][2];
    const char* cA = (const char*)g.A + (size_t)cur.pm * tstep; const char* cB = (const char*)g.Bt + (size_t)cur.pn * tstep;
    S.a_ready(cur);
    if constexpr (SP2) {
        PG8_STAGE(PG8_SB(0, 0), cB, voffB); PG8_STAGE(PG8_SB(0, 1), cB + hstep, voffB); PG8_STAGE(PG8_SA(0, 0), cA, voffA); PG8_STAGE(PG8_SA(0, 1), cA + hstep, voffA);
        if (wr == 1) PG8_BAR;
        PG8_WAIT_V(2); PG8_BAR;
        PG8_STAGE(PG8_SB(1, 0), cB + kstep, voffB); PG8_STAGE(PG8_SA(1, 0), cA + kstep, voffA); PG8_STAGE(PG8_SB(1, 1), cB + hstep + kstep, voffB);
        PG8_WAIT_V(6); PG8_BAR;
    } else {
        PG8_STAGE(PG8_SB(0, 0), cB, voffB); PG8_STAGE(PG8_SA(0, 0), cA, voffA); PG8_STAGE(PG8_SB(0, 1), cB + hstep, voffB); PG8_STAGE(PG8_SA(0, 1), cA + hstep, voffA);
        if (wr == 1) PG8_BAR;
        PG8_WAIT_V(4); PG8_BAR;
        PG8_STAGE(PG8_SB(1, 0), cB + kstep, voffB); PG8_STAGE(PG8_SA(1, 0), cA + kstep, voffA); PG8_STAGE(PG8_SB(1, 1), cB + hstep + kstep, voffB);
        PG8_WAIT_V(6); PG8_BAR;
    }
    for (;;) {
        const bool has_next = S.next(ui + 1, nxt);
        const char* nA = has_next ? (const char*)g.A + (size_t)nxt.pm * tstep : cA; const char* nB = has_next ? (const char*)g.Bt + (size_t)nxt.pn * tstep : cB;
        for (int t = 0; t < nt; t += 2) {
            const bool last = (t == nt - 2);
            const char* a1 = cA + (size_t)(t + 1) * kstep;
            const char* a2 = last ? nA : cA + (size_t)(t + 2) * kstep; const char* b2 = last ? nB : cB + (size_t)(t + 2) * kstep;
            const char* a3 = a2 + kstep; const char* b3 = b2 + kstep;
            if (last && has_next) S.a_ready(nxt);
            if constexpr (SP2) {
            PG8_LDB(B0, 0, 0); PG8_LDB(B1, 0, 1); PG8_SCHED; PG8_LDA(At, 0, 0); PG8_STAGE(PG8_SA(1, 1), a1 + hstep, voffA);
            PG8_WAIT_V(8); PG8_WAIT_L(0); PG8_BAR; PG8_MMA(0, 0, At, B0); PG8_MMA(0, 1, At, B1); PG8_BAR; PG8_SCHED;
            PG8_LDA(At, 0, 1); PG8_STAGE(PG8_SB(0, 0), b2, voffB); PG8_STAGE(PG8_SB(0, 1), b2 + hstep, voffB); PG8_STAGE(PG8_SA(0, 0), a2, voffA);
            PG8_WAIT_V(8); PG8_WAIT_L(0); PG8_BAR; PG8_MMA(1, 0, At, B0); PG8_MMA(1, 1, At, B1); PG8_BAR; PG8_SCHED;
            PG8_LDB(B0, 1, 0); PG8_LDB(B1, 1, 1); PG8_SCHED; PG8_LDA(At, 1, 0); PG8_STAGE(PG8_SA(0, 1), a2 + hstep, voffA);
            PG8_WAIT_V(8); PG8_WAIT_L(0); PG8_BAR; PG8_MMA(0, 0, At, B0); PG8_MMA(0, 1, At, B1); PG8_BAR; PG8_SCHED;
            PG8_LDA(At, 1, 1); PG8_STAGE(PG8_SB(1, 0), b3, voffB); PG8_STAGE(PG8_SB(1, 1), b3 + hstep, voffB); PG8_STAGE(PG8_SA(1, 0), a3, voffA);
            PG8_WAIT_V(8); PG8_WAIT_L(0); PG8_BAR; PG8_MMA(1, 0, At, B0); PG8_MMA(1, 1, At, B1); PG8_BAR; PG8_SCHED;
            } else {
            PG8_LDB(B0, 0, 0); PG8_SCHED; PG8_LDA(At, 0, 0); PG8_STAGE(PG8_SA(1, 1), a1 + hstep, voffA);
            PG8_WAIT_L(8); PG8_BAR; PG8_WAIT_L(0); PG8_MMA(0, 0, At, B0); PG8_BAR; PG8_SCHED;
            PG8_LDB(B1, 0, 1); PG8_STAGE(PG8_SB(0, 0), b2, voffB);
            PG8_BAR; PG8_WAIT_L(0); PG8_MMA(0, 1, At, B1); PG8_BAR;
            PG8_LDA(At, 0, 1); PG8_STAGE(PG8_SA(0, 0), a2, voffA);
            PG8_BAR; PG8_WAIT_L(0); PG8_MMA(1, 0, At, B0); PG8_BAR; PG8_SCHED;
            PG8_STAGE(PG8_SB(0, 1), b2 + hstep, voffB);
            PG8_WAIT_V(6); PG8_BAR; PG8_MMA(1, 1, At, B1); PG8_BAR;
            PG8_LDB(B0, 1, 0); PG8_SCHED; PG8_LDA(At, 1, 0); PG8_STAGE(PG8_SA(0, 1), a2 + hstep, voffA);
            PG8_WAIT_L(8); PG8_BAR; PG8_WAIT_L(0); PG8_MMA(0, 0, At, B0); PG8_BAR; PG8_SCHED;
            PG8_LDB(B1, 1, 1); PG8_STAGE(PG8_SB(1, 0), b3, voffB);
            PG8_BAR; PG8_WAIT_L(0); PG8_MMA(0, 1, At, B1); PG8_BAR;
            PG8_LDA(At, 1, 1); PG8_STAGE(PG8_SA(1, 0), a3, voffA);
            PG8_BAR; PG8_WAIT_L(0); PG8_MMA(1, 0, At, B0); PG8_BAR; PG8_SCHED;
            PG8_STAGE(PG8_SB(1, 1), b3 + hstep, voffB);
            PG8_WAIT_V(6); PG8_BAR; PG8_MMA(1, 1, At, B1); PG8_BAR;
            }
        }
        if constexpr (ALIGN_EPI) { if (wr == 0) PG8_BAR; }
        if constexpr (!Epi::AFTER_DRAIN) { E(acc, cur, wr, wc, fr, fq); S.done(cur); }
        if (!has_next) break;
#pragma unroll
        for (int a = 0; a < 2; ++a)
#pragma unroll
            for (int b = 0; b < 2; ++b)
#pragma unroll
                for (int m = 0; m < 4; ++m)
#pragma unroll
                    for (int n = 0; n < 2; ++n) acc[a][b][m][n] = (f32x4){0.f, 0.f, 0.f, 0.f};
        cur = nxt; cA = nA; cB = nB; ++ui;
        if constexpr (ALIGN_EPI) { if (wr == 1) PG8_BAR; }
    }
    PG8_WAIT_V(0);
    if constexpr (!ALIGN_EPI) { if (wr == 0) PG8_BAR; }
    PG8_BAR;
    if constexpr (Epi::AFTER_DRAIN) { E.fused(acc, cur, wr, wc, fr, fq, lds, wid, lane); S.done(cur); }
#undef PG8_SA
#undef PG8_SB
#undef PG8_STAGE
#undef PG8_LDA
#undef PG8_LDB
#undef PG8_MMA
#undef PG8_WAIT_V
#undef PG8_WAIT_L
#undef PG8_BAR
#undef PG8_SCHED
}
}
#define GAS __attribute__((address_space(1)))
#define LAS __attribute__((address_space(3)))
typedef unsigned short bf16;
typedef unsigned v4u __attribute__((ext_vector_type(4)));
typedef float f32x4 __attribute__((ext_vector_type(4)));
typedef short bf16x8 __attribute__((ext_vector_type(8)));
typedef GAS unsigned gu32;
typedef GAS unsigned long long gu64;
#define RLX_AGENT __ATOMIC_RELAXED, __HIP_MEMORY_SCOPE_AGENT
#define LDS_WAIT() asm volatile("s_waitcnt lgkmcnt(0)" ::: "memory")
#define VM_WAIT() asm volatile("s_waitcnt vmcnt(0)" ::: "memory")
__device__ __forceinline__ unsigned long long rt() { return __builtin_amdgcn_s_memrealtime(); }
__device__ __forceinline__ unsigned f2bf(float f) { unsigned u = __builtin_bit_cast(unsigned, f); return (u + 0x7fffu + ((u >> 16) & 1u)) >> 16; }
__device__ __forceinline__ unsigned pk2(float lo, float hi) { return f2bf(lo) | (f2bf(hi) << 16); }

#define XB_TMO      128
#define XB_XCNT(j)  (256  + 64 * (j))
#define XB_XSUB(j)  (1280 + 64 * (j))
#define XB_XGEN(j)  (2304 + 64 * (j))
#define XB_TOP      3328
#define XB_TOPGEN   3392
#define XCD_BAR_WORDS 3456
#define XB_SPIN_CAP (1u << 18)

__device__ __forceinline__ unsigned xb_ld(unsigned* p)              { return __hip_atomic_load(p, __ATOMIC_RELAXED, __HIP_MEMORY_SCOPE_AGENT); }
__device__ __forceinline__ unsigned xb_add(unsigned* p, unsigned v) { return __hip_atomic_fetch_add(p, v, __ATOMIC_RELAXED, __HIP_MEMORY_SCOPE_AGENT); }
__device__ __forceinline__ unsigned xb_xcc_id() { return (unsigned)__builtin_amdgcn_s_getreg((3 << 11) | 20) & 0xFu; }
#define XB_SPIN(cond, bar) do { unsigned _sp = 0; while (cond) { __builtin_amdgcn_s_sleep(1); \
    if ((++_sp & 255u) == 0u) { if (xb_ld(&(bar)[XB_TMO])) break; if (_sp > XB_SPIN_CAP) { atomicAdd(&(bar)[XB_TMO], 1u); break; } } } } while (0)

struct XcdBarrier {
    unsigned* bar; unsigned x;
    volatile LAS unsigned* st;
};

__device__ __forceinline__ XcdBarrier xcd_barrier_post(unsigned* bar, volatile LAS unsigned* st) {
    XcdBarrier b; b.bar = bar; b.x = xb_xcc_id(); b.st = st;
    if (threadIdx.x == 0) (void)xb_add(&bar[XB_XCNT(b.x)], 1u);
    return b;
}
__device__ __forceinline__ void xcd_barrier_complete(unsigned* bar, unsigned x, unsigned& nloc, unsigned& nx) {
    const unsigned G = gridDim.x * gridDim.y * gridDim.z;
    unsigned sum, cnt, mine, sp = 0u;
    for (;;) {
        sum = 0u; cnt = 0u; mine = 0u;
#pragma unroll
        for (unsigned j = 0; j < 16; ++j) { const unsigned c = xb_ld(&bar[XB_XCNT(j)]); sum += c; cnt += (c > 0u) ? 1u : 0u; mine = (j == x) ? c : mine; }
        if (sum == G) break;
        __builtin_amdgcn_s_sleep(1);
        if ((++sp & 255u) == 0u) { if (xb_ld(&bar[XB_TMO])) break; if (sp > XB_SPIN_CAP) { atomicAdd(&bar[XB_TMO], 1u); break; } }
    }
    nloc = mine > 0u ? mine : 1u; nx = cnt > 0u ? cnt : 1u;
}

__device__ __forceinline__ void xcd_barrier(const XcdBarrier& b) {
    asm volatile("s_waitcnt vmcnt(0)" ::: "memory");
    __syncthreads();
    if (threadIdx.x == 0) {
        unsigned* bar = b.bar;
        __builtin_amdgcn_s_waitcnt(0);
        unsigned nloc = b.st[0], nx = b.st[1];
        if (nloc == 0u) { xcd_barrier_complete(bar, b.x, nloc, nx); b.st[0] = nloc; b.st[1] = nx; }
        const unsigned old = xb_add(&bar[XB_XSUB(b.x)], 1u);
        const unsigned gen = old / nloc;
        if (old + 1u == (gen + 1u) * nloc) {
            __builtin_amdgcn_fence(__ATOMIC_RELEASE, "agent");
            asm volatile("s_waitcnt vmcnt(0)" ::: "memory");
            const unsigned og = xb_add(&bar[XB_TOP], 1u);
            const unsigned tg = og / nx;
            if (og + 1u == (tg + 1u) * nx) xb_add(&bar[XB_TOPGEN], 1u);
            else XB_SPIN(xb_ld(&bar[XB_TOPGEN]) == tg, bar);
            __builtin_amdgcn_fence(__ATOMIC_ACQUIRE, "agent");
            xb_add(&bar[XB_XGEN(b.x)], 1u);
            asm volatile("s_waitcnt vmcnt(0)" ::: "memory");
        } else {
            XB_SPIN(xb_ld(&bar[XB_XGEN(b.x)]) == gen, bar);
            __builtin_amdgcn_fence(__ATOMIC_ACQUIRE, "agent");
            asm volatile("s_waitcnt vmcnt(0)" ::: "memory");
        }
    }
    __syncthreads();
}

constexpr int NWAVES = 8;
#ifndef MK_N_LAUNCHES
#define MK_N_LAUNCHES 1
#endif
constexpr int PER_PHASE = 11;
constexpr int N_LAUNCHES = MK_N_LAUNCHES;

constexpr int BATCH = 16, SEQ = 2048, D = 1024, HD = 64, NH = 8, FF = 2816;
constexpr int M = BATCH * SEQ;
constexpr int SBW = 512, RWW = 512, RWP = 1792, PW = 3328, LORA_K = 256, LORA_N = 1536;
constexpr float LNX_EPS = 64e-5f;

constexpr size_t MiB = 1u << 20;
constexpr size_t WS_CTL = 0, CTL_ZERO_BYTES = 1 * MiB;
constexpr size_t WS_SSQ = 1 * MiB;
constexpr size_t WS_W1U = 4 * MiB;
constexpr size_t WS_W1D = 15 * MiB;
constexpr size_t WS_W2U = 21 * MiB;
constexpr size_t WS_W2D = 32 * MiB;
constexpr size_t WS_WIN = 38 * MiB;
constexpr size_t WS_WOUT = 45 * MiB;
constexpr size_t WS_WLORA = 47 * MiB;
constexpr size_t WS_XB = 48 * MiB;
constexpr size_t WS_ACT = 112 * MiB;
constexpr size_t WS_QO = 112 * MiB;
constexpr size_t WS_KB = 176 * MiB;
constexpr size_t WS_VB = 208 * MiB;
constexpr size_t WS_RW = 240 * MiB;
constexpr size_t WS_ALORA = 352 * MiB;
constexpr size_t WS_LW = 368 * MiB;
constexpr size_t WS_AB = 432 * MiB;
constexpr size_t WS_GB = 464 * MiB;
constexpr size_t WS_TAIL = 496 * MiB;
constexpr size_t WS_END = 512 * MiB;
constexpr int CW_TMO = 0, CW_CODE = 1;
constexpr int CW_BAR = 4096;

constexpr int RING_OFF = 0, RING_BYTES = 147456;
constexpr int LDSCTL_OFF = RING_BYTES, MISC_OFF = LDSCTL_OFF + 320;
constexpr int LDS_BYTES = 159744;

struct Frame {
    LAS unsigned char* lds;
    volatile LAS unsigned* MISC;
    gu32* ctl;
    int tid, lane, wave;
    int vcu, G;
};
typedef unsigned u32x2g __attribute__((ext_vector_type(2)));
__device__ __forceinline__ float bf2f(unsigned short h) { return __uint_as_float(((unsigned)h) << 16); }
typedef float f32x2h __attribute__((ext_vector_type(2))); typedef __bf16 bf16x2h __attribute__((ext_vector_type(2)));
__device__ __forceinline__ unsigned pkbf(float lo, float hi) { f32x2h v = {lo, hi}; bf16x2h b = __builtin_convertvector(v, bf16x2h); return __builtin_bit_cast(unsigned, b); }
__device__ __forceinline__ float bflo(unsigned w) { return __uint_as_float(w << 16); }
__device__ __forceinline__ float bfhi(unsigned w) { return __uint_as_float(w & 0xffff0000u); }
__device__ __forceinline__ float wave_sum(float v) {
#pragma unroll
    for (int o = 1; o < 64; o <<= 1) v += __shfl_xor(v, o);
    return v;
}
__device__ __forceinline__ float dpp_f(float v, const int ctrl_unused) { return v; }
#define DPP_ADD(v, ctrl) ((v) + __int_as_float(__builtin_amdgcn_update_dpp(0, __float_as_int(v), (ctrl), 0xF, 0xF, true)))
__device__ __forceinline__ float sum8(float v) { v = DPP_ADD(v, 0xB1); v = DPP_ADD(v, 0x4E); v = DPP_ADD(v, 0x141); return v; }

__device__ __forceinline__ void transpose_item(const float* W, int ldw, int k0, int n0src, const float* kscale, bf16* WT, int Kdst, int rho0, LAS float* scr, int lane) {
#pragma unroll 8
    for (int i = 0; i < 32; ++i) { const int kk = 2 * i + (lane >> 5); float v = W[(size_t)(k0 + kk) * ldw + n0src + (lane & 31)]; if (kscale) v *= kscale[k0 + kk]; scr[kk * 33 + (lane & 31)] = v; }
    LDS_WAIT(); asm volatile("" ::: "memory");
    const int c = lane & 7;
#pragma unroll
    for (int j = 0; j < 4; ++j) { const int n = (lane >> 3) + 8 * j; const LAS float* s = scr + (8 * c) * 33 + n;
        v4u o; o.x = pkbf(s[0 * 33], s[1 * 33]); o.y = pkbf(s[2 * 33], s[3 * 33]); o.z = pkbf(s[4 * 33], s[5 * 33]); o.w = pkbf(s[6 * 33], s[7 * 33]);
        *(GAS v4u*)(WT + (size_t)(rho0 + n) * Kdst + k0 + 8 * c) = o; }
    LDS_WAIT(); asm volatile("" ::: "memory");
}
#define P0_PTRS const float* Ax, const float* An1, const float* Ag1, const float* Au1, const float* Ad1, const float* Anm, const float* Awin, const float* Aw2, const float* Aa2, const float* Ag2, const float* Awout, \
    const float* An2, const float* Ag2f, const float* Au2f, const float* Ad2f, bf16* AW1U, bf16* AW1D, bf16* AW2U, bf16* AW2D, bf16* AWIN, bf16* AWOUT, bf16* AWLORA, bf16* AXB, float* ASSQ
__device__ __forceinline__ void p0_prologue(Frame& F, P0_PTRS) {
    LAS float* scr = (LAS float*)(F.lds + RING_OFF + F.wave * 16384);
    const int gw = F.vcu * NWAVES + F.wave, NGW = F.G * NWAVES;
    constexpr int I_UP = 16 * 176, I_DN = 44 * 32, I_IN = 16 * 104, I_OUT = 16 * 32;
    constexpr int NITEMS = 2 * (I_UP + I_DN) + I_IN + I_OUT;
    for (int it = gw; it < NITEMS; it += NGW) {
        int r = it;
        if (r < 2 * I_UP) { const int l2 = r >= I_UP; if (l2) r -= I_UP;
            const int kb = r / 176, nb = r % 176, rho0 = 32 * nb, pn = rho0 >> 8, bj = (rho0 >> 7) & 1, j0 = rho0 & 127;
            const float* src = l2 ? (bj ? Au2f : Ag2f) : (bj ? Au1 : Ag1);
            transpose_item(src, FF, 64 * kb, 128 * pn + j0, l2 ? An2 : An1, l2 ? AW2U : AW1U, D, rho0, scr, F.lane); continue; }
        r -= 2 * I_UP;
        if (r < 2 * I_DN) { const int l2 = r >= I_DN; if (l2) r -= I_DN;
            const int kb = r / 32, nb = r % 32;
            transpose_item(l2 ? Ad2f : Ad1, D, 64 * kb, 32 * nb, nullptr, l2 ? AW2D : AW1D, FF, 32 * nb, scr, F.lane); continue; }
        r -= 2 * I_DN;
        if (r < I_IN) { const int kb = r / 104, nb = r % 104, rho0 = 32 * nb, pn = rho0 >> 8, rem = rho0 & 255, bj = rem >> 7, wc = (rem & 127) >> 5;
            transpose_item(Awin, PW, 64 * kb, 256 * pn + 64 * wc + 32 * bj, Anm, AWIN, D, rho0, scr, F.lane); continue; }
        r -= I_IN;
        { const int kb = r / 32, nb = r % 32; transpose_item(Awout, D, 64 * kb, 32 * nb, nullptr, AWOUT, D, 32 * nb, scr, F.lane); }
    }
    for (int it = F.vcu * (NWAVES * 64) + F.tid; it < LORA_N * (LORA_K / 8); it += F.G * NWAVES * 64) {
        const int rho = it >> 5, kc = (it & 31) * 8; float v[8];
#pragma unroll
        for (int j = 0; j < 8; ++j) { const int k = kc + j; float t = 0.f;
            if (rho < 512) { if (k < 64) t = Aw2[(size_t)k * 512 + rho]; }
            else if (rho < 1024) { if (k >= 64 && k < 128) t = Aa2[(size_t)(k - 64) * 512 + (rho - 512)]; }
            else { if (k >= 128) t = Ag2[(size_t)(k - 128) * 512 + (rho - 1024)]; }
            v[j] = t; }
        v4u o; o.x = pkbf(v[0], v[1]); o.y = pkbf(v[2], v[3]); o.z = pkbf(v[4], v[5]); o.w = pkbf(v[6], v[7]);
        *(GAS v4u*)(AWLORA + (size_t)rho * LORA_K + kc) = o;
    }
    for (int m = gw; m < M; m += NGW) {
        const GAS f32x4* xr = (const GAS f32x4*)(Ax + (size_t)m * D) + F.lane;
        f32x4 v[4]; float s = 0.f;
#pragma unroll
        for (int j = 0; j < 4; ++j) { v[j] = xr[64 * j]; s += (v[j].x * v[j].x + v[j].y * v[j].y) + (v[j].z * v[j].z + v[j].w * v[j].w); }
        s = wave_sum(s);
        GAS unsigned long long* o8 = (GAS unsigned long long*)(AXB + (size_t)m * D) + F.lane;
#pragma unroll
        for (int j = 0; j < 4; ++j) o8[64 * j] = (unsigned long long)pkbf(v[j].x, v[j].y) | ((unsigned long long)pkbf(v[j].z, v[j].w) << 32);
        if (F.lane < 16) ASSQ[(size_t)m * 16 + F.lane] = (F.lane == 0) ? s : 0.f;
    }
}

__device__ __forceinline__ void p4_lora_prep(Frame& F, const bf16* RW, const float* mu, bf16* ALORA) {
    const int gw = F.vcu * NWAVES + F.wave, NGW = F.G * NWAVES; const int l = F.lane;
    const f32x4 muv = *(const f32x4*)(mu + 1536 + 4 * l);
    for (int m = gw; m < M; m += NGW) {
        const u32x2g c = *(const u32x2g*)(RW + (size_t)m * RWP + 1536 + 4 * l);
        u32x2g p = (u32x2g){0u, 0u};
        if ((m & (SEQ - 1)) != 0) p = *(const u32x2g*)(RW + (size_t)(m - 1) * RWP + 1536 + 4 * l);
        float x[4] = {bflo(c.x), bfhi(c.x), bflo(c.y), bfhi(c.y)}; const float q[4] = {bflo(p.x), bfhi(p.x), bflo(p.y), bfhi(p.y)};
#pragma unroll
        for (int i = 0; i < 4; ++i) { float u = x[i] + (q[i] - x[i]) * muv[i];
            if (l < 16) u = 2.0f * pg8::sigmoid_f(2.0f * u) - 1.0f; else if (l >= 32) u = pg8::sigmoid_f(u);
            x[i] = u; }
        u32x2g o; o.x = pkbf(x[0], x[1]); o.y = pkbf(x[2], x[3]);
        *(u32x2g*)(ALORA + (size_t)m * LORA_K + 4 * l) = o;
    }
}

struct RwArgs { const bf16* RW; const float* LW; const bf16* AB; const bf16* GB; bf16* QO; const float *mu, *k_k, *k_a, *r_k, *ln_w, *ln_b; };
__device__ __forceinline__ void ld8bf(const bf16* p, float (&o)[8]) { const v4u w = *(const v4u*)p; o[0] = bflo(w.x); o[1] = bfhi(w.x); o[2] = bflo(w.y); o[3] = bfhi(w.y); o[4] = bflo(w.z); o[5] = bfhi(w.z); o[6] = bflo(w.w); o[7] = bfhi(w.w); }
__device__ __forceinline__ void ld8f(const float* p, float (&o)[8]) { const f32x4 a = *(const f32x4*)p, b = *(const f32x4*)(p + 4); o[0] = a.x; o[1] = a.y; o[2] = a.z; o[3] = a.w; o[4] = b.x; o[5] = b.y; o[6] = b.z; o[7] = b.w; }
__device__ __forceinline__ void ld8l(const LAS float* p, float (&o)[8]) { const f32x4 a = *(const LAS f32x4*)p, b = *(const LAS f32x4*)(p + 4); o[0] = a.x; o[1] = a.y; o[2] = a.z; o[3] = a.w; o[4] = b.x; o[5] = b.y; o[6] = b.z; o[7] = b.w; }
__device__ __forceinline__ void st8l(LAS float* p, const float (&o)[8]) { *(LAS f32x4*)p = (f32x4){o[0], o[1], o[2], o[3]}; *(LAS f32x4*)(p + 4) = (f32x4){o[4], o[5], o[6], o[7]}; }
namespace rwk {
typedef short bf16x8 __attribute__((ext_vector_type(8)));
constexpr int LD = 144, SLOT = 64 * LD;
#define RSL(s) (lds + (s) * SLOT)
#define RFRAGO(base, off, ks) (*(const LAS bf16x8*)((base) + (off) + (ks) * 64))
#define RMFMA(a, b, c) __builtin_amdgcn_mfma_f32_16x16x32_bf16((a), (b), (c), 0, 0, 0)
template <bool SWAP> __device__ __forceinline__ f32x4 prod(const LAS unsigned char* Am, int fm, const LAS unsigned char* Bn, int fn, f32x4 acc) {
#pragma unroll
    for (int ks = 0; ks < 2; ++ks) { const bf16x8 a = RFRAGO(Am, fm, ks), b = RFRAGO(Bn, fn, ks); acc = SWAP ? RMFMA(b, a, acc) : RMFMA(a, b, acc); }
    return acc;
}
__device__ __forceinline__ void st4(LAS unsigned char* slot, int off, f32x4 v) { u32x2g w; w.x = pkbf(v[0], v[1]); w.y = pkbf(v[2], v[3]); *(LAS u32x2g*)(slot + off) = w; }
__device__ __forceinline__ f32x4 ld4(const LAS unsigned char* slot, int off) { const u32x2g w = *(const LAS u32x2g*)(slot + off); return (f32x4){bflo(w.x), bfhi(w.x), bflo(w.y), bfhi(w.y)}; }
}
struct RwX { bf16* P1; bf16* GT; bf16* Y0; bf16* H; bf16* VB0; bf16* VB1; float* GE; };
__device__ __forceinline__ void p6a_rwkv_local(Frame& F, const RwArgs& A, const RwX& X) {
    using namespace rwk;
    LAS unsigned char* lds = F.lds + RING_OFF;
    LAS float* scrA = (LAS float*)RSL(8); LAS float* scrB = (LAS float*)RSL(10);
    const int tid = F.tid, tok = tid >> 3, dg = tid & 7, lane = F.lane, fr = lane & 15, fq = lane >> 4;
    const int w = F.wave, m0 = 16 * (w >> 1), n0a = 32 * (w & 1);
    const int fm = (m0 + fr) * LD + fq * 16;
    int fn[2], orm[2], otr[2];
#pragma unroll
    for (int t = 0; t < 2; ++t) { const int n0 = n0a + 16 * t; fn[t] = (n0 + fr) * LD + fq * 16; orm[t] = (m0 + fr) * LD + (n0 + 4 * fq) * 2; otr[t] = (n0 + fr) * LD + (m0 + 4 * fq) * 2; }
    {
        for (int job = blockIdx.x; job < BATCH * NH * (SEQ / 64); job += F.G) {
            const int unit = job >> 5, c = job & 31; const int b = unit >> 3, h = unit & 7; const int cb = 64 * h + 8 * dg; const size_t jo = (size_t)job * 4096;
            const size_t grow = (size_t)b * SEQ + c * 64 + tok;
            float r[8], kf[8], v[8], aa[8], bb[8], lw[8]; float bon;
            {
                float k[8], rp[8], kp[8], vp[8], mr[8], mk[8], mv[8], al[8], kkc[8], kac[8], rkc[8];
                ld8bf(A.RW + grow * RWP + cb, r); ld8bf(A.RW + grow * RWP + 512 + cb, k); ld8bf(A.RW + grow * RWP + 1024 + cb, v);
                if (c == 0 && tok == 0) {
#pragma unroll
                    for (int j = 0; j < 8; ++j) { rp[j] = 0.f; kp[j] = 0.f; vp[j] = 0.f; }
                } else { ld8bf(A.RW + (grow - 1) * RWP + cb, rp); ld8bf(A.RW + (grow - 1) * RWP + 512 + cb, kp); ld8bf(A.RW + (grow - 1) * RWP + 1024 + cb, vp); }
                ld8f(A.mu + cb, mr); ld8f(A.mu + 512 + cb, mk); ld8f(A.mu + 1024 + cb, mv);
                ld8f(A.LW + grow * 512 + cb, lw); ld8bf(A.AB + grow * 512 + cb, al);
                ld8f(A.k_k + cb, kkc); ld8f(A.k_a + cb, kac); ld8f(A.r_k + cb, rkc);
                float ss = 0.f, bp = 0.f; float kk[8];
#pragma unroll
                for (int j = 0; j < 8; ++j) { r[j] = r[j] + (rp[j] - r[j]) * mr[j]; k[j] = k[j] + (kp[j] - k[j]) * mk[j]; v[j] = v[j] + (vp[j] - v[j]) * mv[j];
                    kk[j] = k[j] * kkc[j]; ss += kk[j] * kk[j]; kf[j] = k[j] * (1.0f + (al[j] - 1.0f) * kac[j]); bp += r[j] * kf[j] * rkc[j]; }
                ss = sum8(ss); bon = sum8(bp);
                const float inv = 1.0f / fmaxf(sqrtf(ss), 1e-12f);
#pragma unroll
                for (int j = 0; j < 8; ++j) { kk[j] *= inv; aa[j] = -kk[j]; bb[j] = kk[j] * al[j]; }
                st8l(scrA + tok * 64 + 8 * dg, lw);
            }
            __syncthreads();
            {
                const int kcol = tid & 63, seg = tid >> 6; float run = 0.f;
                for (int s = 0; s < seg; ++s) { float t8[8];
#pragma unroll
                    for (int t = 0; t < 8; ++t) t8[t] = scrA[(8 * s + t) * 64 + kcol];
                    run += ((t8[0] + t8[1]) + (t8[2] + t8[3])) + ((t8[4] + t8[5]) + (t8[6] + t8[7])); }
                float t8[8];
#pragma unroll
                for (int t = 0; t < 8; ++t) t8[t] = scrA[(8 * seg + t) * 64 + kcol];
#pragma unroll
                for (int t = 0; t < 8; ++t) { run += t8[t]; scrB[(8 * seg + t) * 64 + kcol] = run; }
            }
            __syncthreads();
            {
                float cs[8], ce[8]; ld8l(scrB + tok * 64 + 8 * dg, cs); ld8l(scrB + 63 * 64 + 8 * dg, ce);
                float at[8], rt[8], bt[8], kt[8], bh[8], kh[8];
#pragma unroll
                for (int j = 0; j < 8; ++j) {
                    const float e_cs = __builtin_amdgcn_exp2f(cs[j] * 1.4426950408889634f), e_csm = __builtin_amdgcn_exp2f((cs[j] - lw[j]) * 1.4426950408889634f);
                    const float e_neg = __builtin_amdgcn_rcpf(e_cs), e_end = __builtin_amdgcn_exp2f((ce[j] - cs[j]) * 1.4426950408889634f);
                    at[j] = aa[j] * e_csm; rt[j] = r[j] * e_cs; bt[j] = bb[j] * e_neg; kt[j] = kf[j] * e_neg; bh[j] = bb[j] * e_end; kh[j] = kf[j] * e_end;
                    if (tok == 63) X.GE[(size_t)job * 64 + 8 * dg + j] = e_cs;
                }
                const int ro = tok * LD + 16 * dg;
                *(LAS v4u*)(RSL(0) + ro) = (v4u){pkbf(at[0], at[1]), pkbf(at[2], at[3]), pkbf(at[4], at[5]), pkbf(at[6], at[7])};
                *(LAS v4u*)(RSL(2) + ro) = (v4u){pkbf(rt[0], rt[1]), pkbf(rt[2], rt[3]), pkbf(rt[4], rt[5]), pkbf(rt[6], rt[7])};
                *(LAS v4u*)(RSL(3) + ro) = (v4u){pkbf(bt[0], bt[1]), pkbf(bt[2], bt[3]), pkbf(bt[4], bt[5]), pkbf(bt[6], bt[7])};
                *(LAS v4u*)(RSL(4) + ro) = (v4u){pkbf(kt[0], kt[1]), pkbf(kt[2], kt[3]), pkbf(kt[4], kt[5]), pkbf(kt[6], kt[7])};
#pragma unroll
                for (int j = 0; j < 8; j += 2) { const int to = (8 * dg + j) * LD + tok * 2;
                    const unsigned pa = pkbf(at[j], at[j + 1]), pb = pkbf(bh[j], bh[j + 1]), pk = pkbf(kh[j], kh[j + 1]), pv = pkbf(v[j], v[j + 1]);
                    *(LAS unsigned short*)(RSL(1) + to) = (unsigned short)pa; *(LAS unsigned short*)(RSL(1) + to + LD) = (unsigned short)(pa >> 16);
                    *(LAS unsigned short*)(RSL(5) + to) = (unsigned short)pb; *(LAS unsigned short*)(RSL(5) + to + LD) = (unsigned short)(pb >> 16);
                    *(LAS unsigned short*)(RSL(6) + to) = (unsigned short)pk; *(LAS unsigned short*)(RSL(6) + to + LD) = (unsigned short)(pk >> 16);
                    *(LAS unsigned short*)(RSL(7) + to) = (unsigned short)pv; *(LAS unsigned short*)(RSL(7) + to + LD) = (unsigned short)(pv >> 16); }
            }
            __syncthreads();
            {
                const f32x4 z4 = (f32x4){0.f, 0.f, 0.f, 0.f};
#pragma unroll
                for (int t = 0; t < 2; ++t) { const int n0 = n0a + 16 * t;
                    f32x4 nab = prod<true>(RSL(0), fm, RSL(3), fn[t], z4), nabT = prod<false>(RSL(0), fm, RSL(3), fn[t], z4);
                    f32x4 nak = prod<true>(RSL(0), fm, RSL(4), fn[t], z4), mrb = prod<true>(RSL(2), fm, RSL(3), fn[t], z4), mrk = prod<true>(RSL(2), fm, RSL(4), fn[t], z4);
                    f32x4 x1;
#pragma unroll
                    for (int x = 0; x < 4; ++x) { const int i = m0 + fr, j = n0 + 4 * fq + x;
                        if (j >= i) { nab[x] = 0.f; nak[x] = 0.f; } if (j > i) { mrb[x] = 0.f; mrk[x] = 0.f; }
                        x1[x] = nab[x] + ((i == j) ? 1.0f : 0.f);
                        const int it = m0 + 4 * fq + x, jt = n0 + fr; if (jt >= it) nabT[x] = 0.f; }
                    st4(RSL(11), orm[t], x1); st4(RSL(12), orm[t], nab); st4(RSL(13), otr[t], nabT);
                    st4(RSL(8), orm[t], nak); st4(RSL(9), orm[t], mrb); st4(RSL(10), orm[t], mrk); }
            }
            __syncthreads();
            {
                const f32x4 z4 = (f32x4){0.f, 0.f, 0.f, 0.f};
#pragma unroll
                for (int t = 0; t < 2; ++t) {
                    st4(RSL(0), orm[t], prod<true>(RSL(12), fm, RSL(13), fn[t], z4));
                    st4(RSL(3), otr[t], prod<false>(RSL(12), fm, RSL(13), fn[t], z4));
                    st4(RSL(4), otr[t], prod<false>(RSL(8), fm, RSL(7), fn[t], z4)); }
            }
            __syncthreads();
#pragma unroll
            for (int kd = 0; kd < 5; ++kd) {
                const int xi = (kd & 1) ? 8 : 11, xo = (kd & 1) ? 11 : 8, pi = (kd & 1) ? 12 : 0, po = (kd & 1) ? 0 : 12, ti = (kd & 1) ? 13 : 3, to = (kd & 1) ? 3 : 13;
                const f32x4 z4 = (f32x4){0.f, 0.f, 0.f, 0.f};
#pragma unroll
                for (int t = 0; t < 2; ++t) {
                    st4(RSL(xo), orm[t], prod<true>(RSL(xi), fm, RSL(ti), fn[t], ld4(RSL(xi), orm[t])));
                    if (kd < 4) { st4(RSL(po), orm[t], prod<true>(RSL(pi), fm, RSL(ti), fn[t], z4));
                                  st4(RSL(to), otr[t], prod<false>(RSL(pi), fm, RSL(ti), fn[t], z4)); } }
                __syncthreads();
            }
            {
                const f32x4 z4 = (f32x4){0.f, 0.f, 0.f, 0.f};
#pragma unroll
                for (int t = 0; t < 2; ++t) {
                    st4(RSL(11), otr[t], prod<false>(RSL(8), fm, RSL(1), fn[t], z4));
                    st4(RSL(12), otr[t], prod<false>(RSL(8), fm, RSL(4), fn[t], z4)); }
            }
            __syncthreads();
            {
                const f32x4 z4 = (f32x4){0.f, 0.f, 0.f, 0.f};
#pragma unroll
                for (int t = 0; t < 2; ++t) { const int n0 = n0a + 16 * t;
                    const f32x4 p1 = prod<true>(RSL(9), fm, RSL(11), fn[t], ld4(RSL(2), orm[t]));
                    const f32x4 y0 = prod<true>(RSL(10), fm, RSL(7), fn[t], prod<true>(RSL(9), fm, RSL(12), fn[t], z4));
                    const f32x4 gt = prod<false>(RSL(11), fm, RSL(5), fn[t], z4);
                    const f32x4 hh = prod<true>(RSL(7), fm, RSL(6), fn[t], prod<true>(RSL(12), fm, RSL(5), fn[t], z4));
                    u32x2g q; q.x = pkbf(p1[0], p1[1]); q.y = pkbf(p1[2], p1[3]); *(u32x2g*)(X.P1 + jo + (m0 + fr) * 64 + n0 + 4 * fq) = q;
                    q.x = pkbf(gt[0], gt[1]); q.y = pkbf(gt[2], gt[3]); *(u32x2g*)(X.GT + jo + (n0 + fr) * 64 + m0 + 4 * fq) = q;
                    q.x = pkbf(y0[0], y0[1]); q.y = pkbf(y0[2], y0[3]); *(u32x2g*)(X.Y0 + jo + ((w * 2 + t) * 64 + lane) * 4) = q;
                    q.x = pkbf(hh[0], hh[1]); q.y = pkbf(hh[2], hh[3]); *(u32x2g*)(X.H + jo + ((w * 2 + t) * 64 + lane) * 4) = q; }
                v4u wv; wv.x = pkbf(bon * v[0], bon * v[1]); wv.y = pkbf(bon * v[2], bon * v[3]); wv.z = pkbf(bon * v[4], bon * v[5]); wv.w = pkbf(bon * v[6], bon * v[7]);
                bf16* vbp = (job < 2048) ? (X.VB0 + jo) : (X.VB1 + (jo - (size_t)2048 * 4096));
                *(v4u*)(vbp + tok * 64 + 8 * dg) = wv;
            }
            __syncthreads();
        }
    }
}
__device__ __forceinline__ void p6b_rwkv_seq(Frame& F, const RwArgs& A, const RwX& X, int nwg) {
    using namespace rwk;
    LAS unsigned char* lds = F.lds + RING_OFF;
    LAS float* Yf = (LAS float*)RSL(3);
    const int tid = F.tid, tok = tid >> 3, dg = tid & 7, lane = F.lane, fr = lane & 15, fq = lane >> 4;
    const int w = F.wave, m0 = 16 * (w >> 1), n0a = 32 * (w & 1);
    const int fm = (m0 + fr) * LD + fq * 16;
    int fn[2], orm[2];
#pragma unroll
    for (int t = 0; t < 2; ++t) { const int n0 = n0a + 16 * t; fn[t] = (n0 + fr) * LD + fq * 16; orm[t] = (m0 + fr) * LD + (n0 + 4 * fq) * 2; }
    for (int unit = blockIdx.x; unit < BATCH * NH; unit += nwg) {
        const int b = unit >> 3, h = unit & 7; const int cb = 64 * h + 8 * dg;
        f32x4 sacc[2]; sacc[0] = (f32x4){0.f, 0.f, 0.f, 0.f}; sacc[1] = sacc[0];
        for (int u = tid; u < SLOT / 4; u += NWAVES * 64) ((LAS unsigned*)RSL(14))[u] = 0u;
        float lnw[8], lnb[8]; ld8f(A.ln_w + cb, lnw); ld8f(A.ln_b + cb, lnb);
        v4u n_p1, n_gt, n_vb, n_g; u32x2g n_y0[2], n_h[2]; f32x4 n_ge[2];
#define P6B_LOAD(cc) do { const int job_ = unit * 32 + (cc); const size_t jo_ = (size_t)job_ * 4096; const size_t grow_ = (size_t)b * SEQ + (cc) * 64 + tok; \
            n_p1 = *(const v4u*)(X.P1 + jo_ + tid * 8); n_gt = *(const v4u*)(X.GT + jo_ + tid * 8); \
            _Pragma("unroll") for (int t = 0; t < 2; ++t) { n_y0[t] = *(const u32x2g*)(X.Y0 + jo_ + ((w * 2 + t) * 64 + lane) * 4); n_h[t] = *(const u32x2g*)(X.H + jo_ + ((w * 2 + t) * 64 + lane) * 4); \
                n_ge[t] = *(const f32x4*)(X.GE + (size_t)job_ * 64 + n0a + 16 * t + 4 * fq); } \
            const bf16* vbp_ = (job_ < 2048) ? (X.VB0 + jo_) : (X.VB1 + (jo_ - (size_t)2048 * 4096)); \
            n_vb = *(const v4u*)(vbp_ + tok * 64 + 8 * dg); n_g = *(const v4u*)(A.GB + grow_ * 512 + cb); } while (0)
        P6B_LOAD(0);
        for (int c = 0; c < SEQ / 64; ++c) {
            const int scur = 14 + (c & 1), snxt = 15 - (c & 1);
            const size_t grow = (size_t)b * SEQ + c * 64 + tok;
            *(LAS v4u*)(RSL(0) + tok * LD + dg * 16) = n_p1; *(LAS v4u*)(RSL(13) + tok * LD + dg * 16) = n_gt;
            f32x4 yacc[2], hcur[2], gecur[2];
#pragma unroll
            for (int t = 0; t < 2; ++t) { yacc[t] = (f32x4){bflo(n_y0[t].x), bfhi(n_y0[t].x), bflo(n_y0[t].y), bfhi(n_y0[t].y)}; hcur[t] = (f32x4){bflo(n_h[t].x), bfhi(n_h[t].x), bflo(n_h[t].y), bfhi(n_h[t].y)}; gecur[t] = n_ge[t]; }
            const v4u vbw = n_vb, gw = n_g;
            if (c + 1 < SEQ / 64) P6B_LOAD(c + 1);
            __syncthreads();
#pragma unroll
            for (int t = 0; t < 2; ++t) { const int n0 = n0a + 16 * t;
                yacc[t] = prod<true>(RSL(0), fm, RSL(scur), fn[t], yacc[t]);
                *(LAS f32x4*)(Yf + (m0 + fr) * 64 + n0 + 4 * fq) = yacc[t];
                sacc[t] = prod<true>(RSL(scur), fm, RSL(13), fn[t], sacc[t] * gecur[t] + hcur[t]);
                st4(RSL(snxt), orm[t], sacc[t]); }
            __syncthreads();
            {
                float y[8];
                ld8l(Yf + tok * 64 + 8 * dg, y);
                const float g[8] = {bflo(gw.x), bfhi(gw.x), bflo(gw.y), bfhi(gw.y), bflo(gw.z), bfhi(gw.z), bflo(gw.w), bfhi(gw.w)};
                const float vb[8] = {bflo(vbw.x), bfhi(vbw.x), bflo(vbw.y), bfhi(vbw.y), bflo(vbw.z), bfhi(vbw.z), bflo(vbw.w), bfhi(vbw.w)};
                float s = 0.f;
#pragma unroll
                for (int j = 0; j < 8; ++j) s += y[j];
                const float mean = sum8(s) * (1.0f / 64.0f); float q = 0.f;
#pragma unroll
                for (int j = 0; j < 8; ++j) { y[j] -= mean; q += y[j] * y[j]; }
                const float rstd = __builtin_amdgcn_rsqf(sum8(q) * (1.0f / 64.0f) + LNX_EPS);
                float ov[8];
#pragma unroll
                for (int j = 0; j < 8; ++j) ov[j] = (y[j] * rstd * lnw[j] + lnb[j] + vb[j]) * g[j];
                v4u wv; wv.x = pkbf(ov[0], ov[1]); wv.y = pkbf(ov[2], ov[3]); wv.z = pkbf(ov[4], ov[5]); wv.w = pkbf(ov[6], ov[7]);
                *(GAS v4u*)(A.QO + grow * D + 512 + cb) = wv;
            }
        }
#undef P6B_LOAD
        __syncthreads();
    }
}

namespace sba {
using bf16x8 = __attribute__((ext_vector_type(8))) short;
using s16x4 = __attribute__((ext_vector_type(4))) short;
using f32x16 = __attribute__((ext_vector_type(16))) float;
using u32x4 = __attribute__((ext_vector_type(4))) unsigned;
constexpr int QB = 256, KVBLK = 64;
constexpr int LDS_K = 0, LDS_V = 16384, LDS_ST = 32768, ST_LD = 68, LDS_FLAG = LDS_ST + 8 * 32 * ST_LD * 4, LDS_BYTES_ATT = LDS_FLAG + 64;
constexpr float R_DEAD = -160.0f;
#define SBAR() __builtin_amdgcn_sched_barrier(0)
typedef float f32x2_t __attribute__((ext_vector_type(2))); typedef __bf16 bf16x2_t __attribute__((ext_vector_type(2)));
__device__ __forceinline__ unsigned cvtpk_s(float lo, float hi) { f32x2_t v = {lo, hi}; bf16x2_t b = __builtin_convertvector(v, bf16x2_t); return __builtin_bit_cast(unsigned, b); }
__device__ __forceinline__ void qkt(f32x16& p0, f32x16& p1, const char* Kslot, const bf16x8* qr, int r32, int hi) {
    const char* kb = Kslot + hi * 1024 + r32 * 16;
    const f32x16 z = f32x16{};
#pragma unroll
    for (int d0 = 0; d0 < 4; ++d0) {
        const bf16x8 b0 = *reinterpret_cast<const bf16x8*>(kb + d0 * 2048);
        const bf16x8 b1 = *reinterpret_cast<const bf16x8*>(kb + d0 * 2048 + 512);
        if (d0 == 0) { p0 = __builtin_amdgcn_mfma_f32_32x32x16_bf16(b0, qr[0], z, 0, 0, 0); p1 = __builtin_amdgcn_mfma_f32_32x32x16_bf16(b1, qr[0], z, 0, 0, 0); }
        else { p0 = __builtin_amdgcn_mfma_f32_32x32x16_bf16(b0, qr[d0], p0, 0, 0, 0); p1 = __builtin_amdgcn_mfma_f32_32x32x16_bf16(b1, qr[d0], p1, 0, 0, 0); }
    }
}
__device__ __forceinline__ void pv(f32x16* o, int vb, bf16x8 pa0, bf16x8 pa1, bf16x8 pa2, bf16x8 pa3) {
#pragma unroll
    for (int d0 = 0; d0 < 2; ++d0) { s16x4 lo[4], hi[4];
#pragma unroll
        for (int ks = 0; ks < 4; ++ks) {
            asm volatile("ds_read_b64_tr_b16 %0,%1 offset:%c2" : "=&v"(lo[ks]) : "v"(vb), "i"(d0 * 4096 + ks * 1024) : "memory");
            asm volatile("ds_read_b64_tr_b16 %0,%1 offset:%c2" : "=&v"(hi[ks]) : "v"(vb), "i"(d0 * 4096 + ks * 1024 + 512) : "memory"); }
        asm volatile("s_waitcnt lgkmcnt(0)" ::: "memory"); SBAR();
#define PK(k) (bf16x8){lo[k][0], lo[k][1], lo[k][2], lo[k][3], hi[k][0], hi[k][1], hi[k][2], hi[k][3]}
        o[d0] = __builtin_amdgcn_mfma_f32_32x32x16_bf16(pa0, PK(0), o[d0], 0, 0, 0);
        o[d0] = __builtin_amdgcn_mfma_f32_32x32x16_bf16(pa1, PK(1), o[d0], 0, 0, 0);
        o[d0] = __builtin_amdgcn_mfma_f32_32x32x16_bf16(pa2, PK(2), o[d0], 0, 0, 0);
        o[d0] = __builtin_amdgcn_mfma_f32_32x32x16_bf16(pa3, PK(3), o[d0], 0, 0, 0);
#undef PK
    }
}
__device__ __forceinline__ float swap_sum(float x, float& other_if_lo, int hi) {
    auto rr = __builtin_amdgcn_permlane32_swap(__float_as_uint(x), __float_as_uint(x), false, false);
    const float a = __uint_as_float(rr[0]), b = __uint_as_float(rr[1]);
    other_if_lo = hi ? 0.f : b;
    return a + b;
}
__device__ __forceinline__ void attn_unit(int b, int h, int qb, bf16* QO, const bf16* __restrict__ KB, const bf16* __restrict__ VB, const float* gout, char* shm) {
    const int tid = threadIdx.x, lane = tid & 63, r32 = lane & 31, hi = lane >> 5; const int wid = __builtin_amdgcn_readfirstlane(tid >> 6);
    const long rowbase = (long)b * SEQ; const int q0 = qb * QB;
    bf16* Qw = QO + (rowbase + q0 + wid * 32) * D + h * HD;
    const bf16* Kh = KB + rowbase * SBW + h * HD; const bf16* Vh = VB + rowbase * SBW + h * HD;
    const unsigned lds0 = (unsigned)(uintptr_t)shm;
    const int NT = 4 * qb + 4, jtop = 4 * qb + (wid >> 1);
    const bf16* ksrc = Kh + (long)lane * SBW + wid * 8;
    const bf16* vsrc = Vh + (long)(16 * (wid & 3) + (lane >> 2)) * SBW + (wid >> 2) * 32 + (lane & 3) * 8;
    char* kdst = shm + LDS_K + wid * 1024 + lane * 16; char* vdst = shm + LDS_V + wid * 1024 + lane * 16;
    const int vb0 = (int)(lds0 + LDS_V) + ((lane >> 4) & 1) * 32 + (lane & 3) * 8 + (4 * hi + ((lane & 15) >> 2)) * 64;
    bf16x8 qr[4];
#pragma unroll
    for (int d0 = 0; d0 < 4; ++d0) qr[d0] = *reinterpret_cast<const bf16x8*>(&Qw[(long)r32 * D + d0 * 16 + hi * 8]);
    u32x4 kreg = *(const u32x4*)(ksrc + (long)(NT - 1) * KVBLK * SBW), vreg = *(const u32x4*)(vsrc + (long)(NT - 1) * KVBLK * SBW);
    *(u32x4*)kdst = kreg; *(u32x4*)vdst = vreg;
    __syncthreads();
    float R = 0.f; f32x16 o[2]; o[0] = f32x16{}; o[1] = f32x16{};
    bool wdone = false; unsigned* flg = (unsigned*)(shm + LDS_FLAG);
    const int qrow = q0 + wid * 32 + r32;
    for (int jt = NT - 1; jt >= 0; --jt) {
        const int cur = (NT - 1 - jt) & 1;
        if (jt > 0) { kreg = *(const u32x4*)(ksrc + (long)(jt - 1) * KVBLK * SBW); vreg = *(const u32x4*)(vsrc + (long)(jt - 1) * KVBLK * SBW); }
        if (jt <= jtop && !wdone) {
            f32x16 p0, p1;
            qkt(p0, p1, shm + LDS_K + cur * 8192, qr, r32, hi);
            f32x16 lb0, lb1;
            const int kb = 64 * jt + 4 * hi; const bool diag = (jt == jtop);
#pragma unroll
            for (int r = 0; r < 16; ++r) {
                { const float z = p0[r]; const float L = __builtin_amdgcn_logf(1.0f + __builtin_amdgcn_exp2f(z)); float lb = z - L; float l1 = -L;
                  if (diag) { const int key = kb + (r & 3) + 8 * (r >> 2); if (key >= qrow) { l1 = 0.f; lb = -1e30f; } }
                  lb0[r] = lb; p0[r] = l1; }
                { const float z = p1[r]; const float L = __builtin_amdgcn_logf(1.0f + __builtin_amdgcn_exp2f(z)); float lb = z - L; float l1 = -L;
                  if (diag) { const int key = kb + 32 + (r & 3) + 8 * (r >> 2); if (key >= qrow) { l1 = 0.f; lb = -1e30f; } }
                  lb1[r] = lb; p1[r] = l1; }
            }
            float c0[4], c1[4], x0[4], x1[4];
#pragma unroll
            for (int g = 0; g < 4; ++g) {
                const float s0 = (p0[4 * g] + p0[4 * g + 1]) + (p0[4 * g + 2] + p0[4 * g + 3]);
                const float s1 = (p1[4 * g] + p1[4 * g + 1]) + (p1[4 * g + 2] + p1[4 * g + 3]);
                c0[g] = swap_sum(s0, x0[g], hi); c1[g] = swap_sum(s1, x1[g], hi);
            }
            float suf0[4], suf1[4];
            suf1[3] = R; suf1[2] = suf1[3] + c1[3]; suf1[1] = suf1[2] + c1[2]; suf1[0] = suf1[1] + c1[1];
            suf0[3] = suf1[0] + c1[0]; suf0[2] = suf0[3] + c0[3]; suf0[1] = suf0[2] + c0[2]; suf0[0] = suf0[1] + c0[1];
            R = suf0[0] + c0[0];
#pragma unroll
            for (int g = 0; g < 4; ++g) {
                { const float e3 = suf0[g] + x0[g], e2 = e3 + p0[4 * g + 3], e1 = e2 + p0[4 * g + 2], e0 = e1 + p0[4 * g + 1];
                  p0[4 * g + 3] = __builtin_amdgcn_exp2f(lb0[4 * g + 3] + e3); p0[4 * g + 2] = __builtin_amdgcn_exp2f(lb0[4 * g + 2] + e2);
                  p0[4 * g + 1] = __builtin_amdgcn_exp2f(lb0[4 * g + 1] + e1); p0[4 * g] = __builtin_amdgcn_exp2f(lb0[4 * g] + e0); }
                { const float e3 = suf1[g] + x1[g], e2 = e3 + p1[4 * g + 3], e1 = e2 + p1[4 * g + 2], e0 = e1 + p1[4 * g + 1];
                  p1[4 * g + 3] = __builtin_amdgcn_exp2f(lb1[4 * g + 3] + e3); p1[4 * g + 2] = __builtin_amdgcn_exp2f(lb1[4 * g + 2] + e2);
                  p1[4 * g + 1] = __builtin_amdgcn_exp2f(lb1[4 * g + 1] + e1); p1[4 * g] = __builtin_amdgcn_exp2f(lb1[4 * g] + e0); }
            }
#define PKW(P, B) cvtpk_s(P[B], P[B + 1])
            const u32x4 pw0 = (u32x4){PKW(p0, 0), PKW(p0, 2), PKW(p0, 4), PKW(p0, 6)}, pw1 = (u32x4){PKW(p0, 8), PKW(p0, 10), PKW(p0, 12), PKW(p0, 14)};
            const u32x4 pw2 = (u32x4){PKW(p1, 0), PKW(p1, 2), PKW(p1, 4), PKW(p1, 6)}, pw3 = (u32x4){PKW(p1, 8), PKW(p1, 10), PKW(p1, 12), PKW(p1, 14)};
#undef PKW
            SBAR();
            pv(o, vb0 + cur * 8192, __builtin_bit_cast(bf16x8, pw0), __builtin_bit_cast(bf16x8, pw1), __builtin_bit_cast(bf16x8, pw2), __builtin_bit_cast(bf16x8, pw3));
            wdone = __all(R < R_DEAD) != 0;
        }
        if (jt > 0) { *(u32x4*)(kdst + (cur ^ 1) * 8192) = kreg; *(u32x4*)(vdst + (cur ^ 1) * 8192) = vreg; }
        if (lane == 0) flg[cur * 8 + wid] = wdone ? 1u : 0u;
        __syncthreads();
        { const u32x4 f0 = *(const u32x4*)(flg + cur * 8), f1 = *(const u32x4*)(flg + cur * 8 + 4);
          if ((f0.x & f0.y & f0.z & f0.w & f1.x & f1.y & f1.z & f1.w) != 0u) break; }
    }
    {
        float* stg = (float*)(shm + LDS_ST) + wid * (32 * ST_LD);
#pragma unroll
        for (int r = 0; r < 16; ++r) { const int orow = (r & 3) + 8 * (r >> 2) + 4 * hi;
#pragma unroll
            for (int d0 = 0; d0 < 2; ++d0) stg[orow * ST_LD + d0 * 32 + r32] = o[d0][r]; }
        asm volatile("s_waitcnt lgkmcnt(0)" ::: "memory");
        const int ch = lane & 7;
        const f32x4 ga = *(const f32x4*)(gout + h * HD + ch * 8), gb = *(const f32x4*)(gout + h * HD + ch * 8 + 4);
#pragma unroll
        for (int i = 0; i < 4; ++i) { const int row = i * 8 + (lane >> 3);
            const f32x4 a = *(const f32x4*)(stg + row * ST_LD + ch * 8), c = *(const f32x4*)(stg + row * ST_LD + ch * 8 + 4);
            float ss = (a.x * a.x + a.y * a.y) + (a.z * a.z + a.w * a.w) + (c.x * c.x + c.y * c.y) + (c.z * c.z + c.w * c.w);
            ss = sum8(ss);
            const float hs = __builtin_amdgcn_rsqf(ss * (1.0f / 64.0f) + 1e-6f);
            u32x4 w; w.x = cvtpk_s(a.x * hs * ga.x, a.y * hs * ga.y); w.y = cvtpk_s(a.z * hs * ga.z, a.w * hs * ga.w);
            w.z = cvtpk_s(c.x * hs * gb.x, c.y * hs * gb.y); w.w = cvtpk_s(c.z * hs * gb.z, c.w * hs * gb.w);
            *(u32x4*)(Qw + (long)row * D + ch * 8) = w; }
        asm volatile("s_waitcnt lgkmcnt(0)" ::: "memory");
    }
}
#undef SBAR
__device__ __forceinline__ void attn_phase(Frame& F, bf16* QO, const bf16* KB, const bf16* VB, const float* gout) {
    char* shm = (char*)F.lds + RING_OFF;
    if (F.G == 256) {
        const int v = F.vcu, bh = v >> 1, odd = v & 1;
        for (int i = 0; i < 4; ++i) { const int qb = odd ? ((i == 0) ? 1 : (i == 1) ? 6 : (i == 2) ? 3 : 4) : ((i == 0) ? 0 : (i == 1) ? 7 : (i == 2) ? 2 : 5);
            attn_unit(bh >> 3, bh & 7, qb, QO, KB, VB, gout, shm); }
    } else {
        for (int id = blockIdx.x; id < BATCH * NH * 8; id += F.G) attn_unit(id >> 6, (id >> 3) & 7, id & 7, QO, KB, VB, gout, shm);
    }
}
}

struct Args { const float* in[26]; float* out; unsigned char* ws; int ph_lo, ph_hi, li, pad; };
__global__ void __launch_bounds__(NWAVES * 64, 2) skel_fwd(Args args) {
    extern __shared__ __attribute__((aligned(16))) unsigned char lds[];
    Frame F;
    F.lds = (LAS unsigned char*)lds;
    F.MISC = (volatile LAS unsigned*)(F.lds + MISC_OFF);
    F.tid = threadIdx.x; F.lane = F.tid & 63; F.wave = __builtin_amdgcn_readfirstlane(F.tid >> 6);
    F.G = gridDim.x; { const int bx = blockIdx.x; F.vcu = (F.G % 8 == 0) ? (bx % 8) * (F.G / 8) + bx / 8 : bx; }
    unsigned char* ws = args.ws;
    F.ctl = (gu32*)(ws + WS_CTL);
    const float* x = args.in[0];
    bf16* W1U = (bf16*)(ws + WS_W1U); bf16* W1D = (bf16*)(ws + WS_W1D); bf16* W2U = (bf16*)(ws + WS_W2U); bf16* W2D = (bf16*)(ws + WS_W2D);
    bf16* WIN = (bf16*)(ws + WS_WIN); bf16* WOUT = (bf16*)(ws + WS_WOUT); bf16* WLORA = (bf16*)(ws + WS_WLORA);
    bf16* XB = (bf16*)(ws + WS_XB); bf16* ACT = (bf16*)(ws + WS_ACT); bf16* QO = (bf16*)(ws + WS_QO); bf16* KB = (bf16*)(ws + WS_KB); bf16* VB = (bf16*)(ws + WS_VB);
    bf16* RW = (bf16*)(ws + WS_RW); bf16* ALORA = (bf16*)(ws + WS_ALORA); float* LW = (float*)(ws + WS_LW); bf16* AB = (bf16*)(ws + WS_AB); bf16* GB = (bf16*)(ws + WS_GB);
    float* SSQ = (float*)(ws + WS_SSQ); float* out = args.out;
    for (int u = F.tid; u < (LDS_BYTES - LDSCTL_OFF) / 4; u += NWAVES * 64) ((LAS unsigned*)(F.lds + LDSCTL_OFF))[u] = 0u;
    __syncthreads();
    XcdBarrier bar; bar.bar = (unsigned*)(F.ctl + CW_BAR); bar.x = 0; bar.st = nullptr;
    if (N_LAUNCHES != PER_PHASE) bar = xcd_barrier_post((unsigned*)(F.ctl + CW_BAR), F.MISC + 8);
#define GRID_BAR(seam) do { if (N_LAUNCHES == PER_PHASE) { if (F.tid == 0) __hip_atomic_store(F.ctl + CW_TMO, 0xBADBA0u | (unsigned)(seam), RLX_AGENT); } else { xcd_barrier(bar); } } while (0)
    const int lo = args.ph_lo, hi = args.ph_hi;
#define IN(k) (lo <= (k) && (k) < hi)
#define BOTH(k) (IN(k) && IN((k) + 1))
    if (IN(0)) {
        p0_prologue(F, x, args.in[1], args.in[2], args.in[3], args.in[4], args.in[5], args.in[6], args.in[12], args.in[14], args.in[15], args.in[21], args.in[22], args.in[23], args.in[24], args.in[25],
                    W1U, W1D, W2U, W2D, WIN, WOUT, WLORA, XB, SSQ); if (BOTH(0)) GRID_BAR(0);
    }
    if (IN(1)) {
        pg8::Gemm g{XB, W1U, M, 2 * FF, D}; pg8::StaticOrder S; S.init(M, 2 * FF, F.G, (int)blockIdx.x);
        pg8::EpiSwiGLU E{ACT, FF, SSQ};
        pg8::gemm_phase<pg8::EpiSwiGLU, pg8::StaticOrder, true, true>(F.lds + RING_OFF, g, S, E);
        if (BOTH(1)) GRID_BAR(1);
    }
    if (IN(2)) {
        pg8::Gemm g{ACT, W1D, M, D, FF}; pg8::StaticOrder S; S.init(M, D, F.G, (int)blockIdx.x);
        pg8::EpiResid E{x, out, XB, SSQ, 0.5f, 1};
        pg8::gemm_phase<pg8::EpiResid, pg8::StaticOrder, true, true>(F.lds + RING_OFF, g, S, E);
        if (BOTH(2)) GRID_BAR(2);
    }
    if (IN(3)) {
        pg8::Gemm g{XB, WIN, M, PW, D}; pg8::StaticOrder S; S.init(M, PW, F.G, (int)blockIdx.x);
        pg8::EpiWin E{QO, KB, VB, RW, SSQ, args.in[7], args.in[8], 0.125f * 1.4426950408889634f};
        pg8::gemm_phase<pg8::EpiWin, pg8::StaticOrder, true, true>(F.lds + RING_OFF, g, S, E);
        if (BOTH(3)) GRID_BAR(3);
    }
    if (IN(4)) { p4_lora_prep(F, RW, args.in[10], ALORA); if (BOTH(4)) GRID_BAR(4); }
    if (IN(5)) {
        int kl = LORA_K; asm volatile("" : "+s"(kl));
        pg8::Gemm g{ALORA, WLORA, M, LORA_N, kl}; pg8::StaticOrder S; S.init(M, LORA_N, F.G, (int)blockIdx.x);
        pg8::EpiLora E{LW, AB, GB, args.in[11], args.in[13]};
        pg8::gemm_phase<pg8::EpiLora, pg8::StaticOrder, true, true>(F.lds + RING_OFF, g, S, E);
        if (BOTH(5)) GRID_BAR(5);
    }
    if (IN(6)) {
        sba::attn_phase(F, QO, KB, VB, args.in[9]);
        if (BOTH(6)) GRID_BAR(6);
    }
    if (IN(7)) {
        RwArgs A{RW, LW, AB, GB, QO, args.in[10], args.in[16], args.in[17], args.in[18], args.in[19], args.in[20]};
        RwX X{KB, VB, XB, XB + (size_t)16 * 1024 * 1024, ALORA, (bf16*)(ws + WS_TAIL), SSQ};
        p6a_rwkv_local(F, A, X);
        GRID_BAR(16);
        p6b_rwkv_seq(F, A, X, F.G);
        __syncthreads();
        if (BOTH(7)) GRID_BAR(7);
    }
    if (IN(8)) {
        pg8::Gemm g{QO, WOUT, M, D, D}; pg8::StaticOrder S; S.init(M, D, F.G, (int)blockIdx.x);
        pg8::EpiResid E{out, out, XB, SSQ, 1.0f, 1};
        pg8::gemm_phase<pg8::EpiResid, pg8::StaticOrder, true, true>(F.lds + RING_OFF, g, S, E);
        if (BOTH(8)) GRID_BAR(8);
    }
    if (IN(9)) {
        pg8::Gemm g{XB, W2U, M, 2 * FF, D}; pg8::StaticOrder S; S.init(M, 2 * FF, F.G, (int)blockIdx.x);
        pg8::EpiSwiGLU E{ACT, FF, SSQ};
        pg8::gemm_phase<pg8::EpiSwiGLU, pg8::StaticOrder, true, true>(F.lds + RING_OFF, g, S, E);
        if (BOTH(9)) GRID_BAR(9);
    }
    if (IN(10)) {
        pg8::Gemm g{ACT, W2D, M, D, FF}; pg8::StaticOrder S; S.init(M, D, F.G, (int)blockIdx.x);
        pg8::EpiResid E{out, out, XB, SSQ, 0.5f, 0};
        pg8::gemm_phase<pg8::EpiResid, pg8::StaticOrder, true, true>(F.lds + RING_OFF, g, S, E);
    }
#undef IN
#undef BOTH
}

extern "C" void kernel_launch(void* const* d_in, const int* in_sizes, int n_in, void* d_out, int out_size, void* d_ws, size_t ws_size, hipStream_t stream) {
    static int grid = 0;
    if (grid == 0) {
        if (n_in != 26 || in_sizes[0] != M * D || out_size != M * D || ws_size < WS_END) { fprintf(stderr, "kernel_launch: unexpected shapes: n_in %d in0 %d out %d ws %zu (need %zu)\n", n_in, n_in > 0 ? in_sizes[0] : -1, out_size, ws_size, (size_t)WS_END); grid = -1; return; }
        int dev = 0, cus = 0, per_cu = 0;
        if (hipGetDevice(&dev) != hipSuccess || hipDeviceGetAttribute(&cus, hipDeviceAttributeMultiprocessorCount, dev) != hipSuccess) { grid = -1; return; }
        if (hipFuncSetAttribute((const void*)skel_fwd, hipFuncAttributeMaxDynamicSharedMemorySize, LDS_BYTES) != hipSuccess) { fprintf(stderr, "kernel_launch: hipFuncSetAttribute failed\n"); grid = -1; return; }
        if (hipOccupancyMaxActiveBlocksPerMultiprocessor(&per_cu, (const void*)skel_fwd, NWAVES * 64, LDS_BYTES) != hipSuccess || per_cu < 1) { fprintf(stderr, "kernel_launch: occupancy query reports %d blocks per CU\n", per_cu); per_cu = 1; }
        (void)hipGetLastError();
        grid = cus;
    }
    if (grid < 0) return;
    if (hipMemsetAsync((char*)d_ws + WS_CTL, 0, CTL_ZERO_BYTES, stream) != hipSuccess) return;
    Args a{};
    for (int i = 0; i < 26; ++i) a.in[i] = (const float*)d_in[i];
    a.out = (float*)d_out; a.ws = (unsigned char*)d_ws;
    for (int li = 0; li < N_LAUNCHES; ++li) {
        a.ph_lo = (N_LAUNCHES == PER_PHASE) ? li : 0; a.ph_hi = (N_LAUNCHES == PER_PHASE) ? li + 1 : PER_PHASE; a.li = li;
        hipLaunchKernelGGL(skel_fwd, dim3(grid), dim3(NWAVES * 64), LDS_BYTES, stream, a);
    }
}
```

```cpp
#include <hip/hip_runtime.h>
#include <hip/hip_bf16.h>
#include <cstdio>
#include <cstdint>
#include <cmath>
namespace pg8 {
#define PG8_LAS __attribute__((address_space(3)))
typedef unsigned short bf16_t;
typedef short bf16x8 __attribute__((ext_vector_type(8)));
typedef float f32x4 __attribute__((ext_vector_type(4)));
typedef unsigned u32x4 __attribute__((ext_vector_type(4)));
constexpr int BM = 256, BK = 64, HALF = 128, HTB = HALF * BK * 2  , STAGE_BYTES = 8 * HTB, NXCD = 8, WGM = 4;

__host__ __device__ __forceinline__ int lds_byte(int r, int c) { const int st = (r >> 4) * 2 + (c >> 5), rr = r & 15, cc = c & 31, ob = rr * 64 + cc * 2; return st * 1024 + (ob ^ (((ob >> 9) & 1) << 5)); }
__host__ __device__ __forceinline__ void stage_rc(int b, int& R, int& C) { const int st = b / 1024, sb = b % 1024, swz = sb ^ (((sb >> 9) & 1) << 5); R = (st >> 1) * 16 + swz / 64; C = (st & 1) * 32 + (swz % 64) / 2; }
__host__ __device__ __forceinline__ int perm32(int rho) { const int n = rho >> 4, i = rho & 15; return 8 * (i >> 2) + 4 * n + (i & 3); }

struct Unit { int pm, pn; };
struct Gemm { const bf16_t* A; const bf16_t* Bt; int M, N, K; int ld; };

struct StaticOrder {
    int nM, nN, nwg, G, c;
    __host__ __device__ void init(int M, int N, int G_, int c_) { nM = M / BM; nN = N / BM; nwg = nM * nN; G = G_; c = c_; }
    __host__ __device__ bool next(int i, Unit& u) const {
        const long L = (long)i * G + c; if (L >= nwg) return false;
        int wgid = (int)L; { const int q = nwg / NXCD, r = nwg % NXCD, xcd = wgid % NXCD, off = wgid / NXCD; wgid = (xcd < r ? xcd * (q + 1) : r * (q + 1) + (xcd - r) * q) + off; }
        const int nig = WGM * nN, gid = wgid / nig, fm = gid * WGM, gsz = (nM - fm) < WGM ? (nM - fm) : WGM;
        u.pm = fm + ((wgid % nig) % gsz); u.pn = (wgid % nig) / gsz; return true;
    }
    __device__ __forceinline__ void a_ready(const Unit&) const {}
    __device__ __forceinline__ void done(const Unit&) const {}
};


__device__ __forceinline__ unsigned cvt_pk_bf16(float lo, float hi) { unsigned r; asm volatile("v_cvt_pk_bf16_f32 %0, %1, %2" : "=v"(r) : "v"(lo), "v"(hi)); return r; }
typedef unsigned u32x2 __attribute__((ext_vector_type(2)));
constexpr float RMS_EPS_F = 1e-6f;
constexpr float LOG2E_F = 1.4426950408889634f;
__device__ __forceinline__ float row_rs(const float* ssqp, int row) {
    const f32x4* p = (const f32x4*)(ssqp + (size_t)row * 16);
    const f32x4 a = p[0], b = p[1], c = p[2], d = p[3];
    const float s = ((a[0] + a[1]) + (a[2] + a[3])) + ((b[0] + b[1]) + (b[2] + b[3])) + ((c[0] + c[1]) + (c[2] + c[3])) + ((d[0] + d[1]) + (d[2] + d[3]));
    return __builtin_amdgcn_rsqf(s * (1.0f / 1024.0f) + RMS_EPS_F);
}
__device__ __forceinline__ float silu_f(float g) { return g * __builtin_amdgcn_rcpf(1.0f + __builtin_amdgcn_exp2f(-g * LOG2E_F)); }
__device__ __forceinline__ float sigmoid_f(float g) { return __builtin_amdgcn_rcpf(1.0f + __builtin_amdgcn_exp2f(-g * LOG2E_F)); }

struct EpiSwiGLU {
    static constexpr bool PERM = true, AFTER_DRAIN = false;
    bf16_t* O; int ldo; const float* ssqp;
    __device__ __forceinline__ void operator()(const f32x4 (&acc)[2][2][4][2], const Unit& u, int wr, int wc, int fr, int fq) const {
        const int row0 = u.pm * BM + wr * 64 + fr, col0 = u.pn * HALF + wc * 32 + 8 * fq;
#pragma unroll
        for (int ai = 0; ai < 2; ++ai)
#pragma unroll
            for (int m = 0; m < 4; ++m) {
                const int row = row0 + ai * HALF + m * 16; const float rs = row_rs(ssqp, row);
                const f32x4 g0 = acc[ai][0][m][0] * rs, g1 = acc[ai][0][m][1] * rs, u0 = acc[ai][1][m][0] * rs, u1 = acc[ai][1][m][1] * rs;
                u32x4 w;
                w.x = cvt_pk_bf16(silu_f(g0[0]) * u0[0], silu_f(g0[1]) * u0[1]); w.y = cvt_pk_bf16(silu_f(g0[2]) * u0[2], silu_f(g0[3]) * u0[3]);
                w.z = cvt_pk_bf16(silu_f(g1[0]) * u1[0], silu_f(g1[1]) * u1[1]); w.w = cvt_pk_bf16(silu_f(g1[2]) * u1[2], silu_f(g1[3]) * u1[3]);
                *(u32x4*)(O + (size_t)row * ldo + col0) = w;
            }
    }
};

struct EpiResid {
    static constexpr bool PERM = false, AFTER_DRAIN = false;
    const float* base; float* out; bf16_t* xb; float* ssqp; float alpha; int aux;
    __device__ __forceinline__ void operator()(const f32x4 (&acc)[2][2][4][2], const Unit& u, int wr, int wc, int fr, int fq) const {
        const int row0 = u.pm * BM + wr * 64 + fr, col0 = u.pn * BM + wc * 32 + 4 * fq;
#pragma unroll
        for (int ai = 0; ai < 2; ++ai)
#pragma unroll
            for (int m = 0; m < 4; ++m) {
                const int row = row0 + ai * HALF + m * 16; const size_t off = (size_t)row * 1024 + col0; float ss = 0.f;
#pragma unroll
                for (int bj = 0; bj < 2; ++bj)
#pragma unroll
                    for (int n = 0; n < 2; ++n) {
                        const f32x4 b = *(const f32x4*)(base + off + bj * HALF + n * 16);
                        const f32x4 v = b + acc[ai][bj][m][n] * alpha;
                        *(f32x4*)(out + off + bj * HALF + n * 16) = v;
                        if (aux) { ss += (v[0] * v[0] + v[1] * v[1]) + (v[2] * v[2] + v[3] * v[3]);
                            u32x2 w; w.x = cvt_pk_bf16(v[0], v[1]); w.y = cvt_pk_bf16(v[2], v[3]); *(u32x2*)(xb + off + bj * HALF + n * 16) = w; }
                    }
                if (aux) { ss += __shfl_xor(ss, 16); ss += __shfl_xor(ss, 32); if (fq == 0) ssqp[(size_t)row * 16 + u.pn * 4 + wc] = ss; }
            }
    }
};

struct EpiWin {
    static constexpr bool PERM = true, AFTER_DRAIN = false;
    bf16_t* QO; bf16_t* KB; bf16_t* VB; bf16_t* RW; const float* ssqp; const float* gq; const float* gk; float qscale;
    __device__ __forceinline__ void operator()(const f32x4 (&acc)[2][2][4][2], const Unit& u, int wr, int wc, int fr, int fq) const {
        const int row0 = u.pm * BM + wr * 64 + fr; const int pn = u.pn;
        if (pn < 4) {
            const float* gp = (pn < 2) ? gq : gk; const float osc = (pn < 2) ? qscale : 1.0f;
            f32x4 gv[2][2];
#pragma unroll
            for (int bj = 0; bj < 2; ++bj)
#pragma unroll
                for (int n = 0; n < 2; ++n) gv[bj][n] = *(const f32x4*)(gp + 32 * bj + 8 * fq + 4 * n) * osc;
            bf16_t* dst = (pn < 2) ? QO : KB; const int ld = (pn < 2) ? 1024 : 512; const int colh = 64 * (4 * (pn & 1) + wc) + 8 * fq;
#pragma unroll
            for (int ai = 0; ai < 2; ++ai)
#pragma unroll
                for (int m = 0; m < 4; ++m) {
                    const int row = row0 + ai * HALF + m * 16; const float rs = row_rs(ssqp, row);
                    f32x4 y[2][2]; float ss = 0.f;
#pragma unroll
                    for (int bj = 0; bj < 2; ++bj)
#pragma unroll
                        for (int n = 0; n < 2; ++n) { y[bj][n] = acc[ai][bj][m][n] * rs; const f32x4 t = y[bj][n]; ss += (t[0] * t[0] + t[1] * t[1]) + (t[2] * t[2] + t[3] * t[3]); }
                    ss += __shfl_xor(ss, 16); ss += __shfl_xor(ss, 32);
                    const float hs = __builtin_amdgcn_rsqf(ss * (1.0f / 64.0f) + RMS_EPS_F);
#pragma unroll
                    for (int bj = 0; bj < 2; ++bj) {
                        const f32x4 a = y[bj][0] * gv[bj][0] * hs, b = y[bj][1] * gv[bj][1] * hs;
                        u32x4 w; w.x = cvt_pk_bf16(a[0], a[1]); w.y = cvt_pk_bf16(a[2], a[3]); w.z = cvt_pk_bf16(b[0], b[1]); w.w = cvt_pk_bf16(b[2], b[3]);
                        *(u32x4*)(dst + (size_t)row * ld + colh + 32 * bj) = w;
                    }
                }
        } else {
            bf16_t* dst = (pn < 6) ? VB : RW; const int ld = (pn < 6) ? 512 : 1792; const int colh = 256 * ((pn < 6) ? (pn - 4) : (pn - 6)) + 64 * wc + 8 * fq;
#pragma unroll
            for (int ai = 0; ai < 2; ++ai)
#pragma unroll
                for (int m = 0; m < 4; ++m) {
                    const int row = row0 + ai * HALF + m * 16; const float rs = row_rs(ssqp, row);
#pragma unroll
                    for (int bj = 0; bj < 2; ++bj) {
                        const f32x4 a = acc[ai][bj][m][0] * rs, b = acc[ai][bj][m][1] * rs;
                        u32x4 w; w.x = cvt_pk_bf16(a[0], a[1]); w.y = cvt_pk_bf16(a[2], a[3]); w.z = cvt_pk_bf16(b[0], b[1]); w.w = cvt_pk_bf16(b[2], b[3]);
                        *(u32x4*)(dst + (size_t)row * ld + colh + 32 * bj) = w;
                    }
                }
        }
    }
};

struct EpiLora {
    static constexpr bool PERM = true, AFTER_DRAIN = false;
    float* LW; bf16_t* AB; bf16_t* GB; const float* w0; const float* a0;
    __device__ __forceinline__ void operator()(const f32x4 (&acc)[2][2][4][2], const Unit& u, int wr, int wc, int fr, int fq) const {
        const int row0 = u.pm * BM + wr * 64 + fr; const int pn = u.pn; const int colt = 256 * (pn & 1) + wc * 32 + 8 * fq;
        const int kind = pn >> 1;
        const float* bp = (kind == 0) ? w0 : a0;
        bf16_t* ob = (kind == 1) ? AB : GB;
#pragma unroll
        for (int bj = 0; bj < 2; ++bj) {
            f32x4 b0 = (f32x4){0.f, 0.f, 0.f, 0.f}, b1 = b0;
            if (kind < 2) { b0 = *(const f32x4*)(bp + colt + bj * HALF); b1 = *(const f32x4*)(bp + colt + bj * HALF + 4); }
#pragma unroll
            for (int ai = 0; ai < 2; ++ai)
#pragma unroll
                for (int m = 0; m < 4; ++m) {
                    const int row = row0 + ai * HALF + m * 16;
                    f32x4 a = acc[ai][bj][m][0] + b0, b = acc[ai][bj][m][1] + b1;
                    if (kind < 2) {
#pragma unroll
                        for (int i = 0; i < 4; ++i) { a[i] = sigmoid_f(a[i]); b[i] = sigmoid_f(b[i]); }
                    }
                    if (kind == 0) { a = a * (-0.6065306597126334f); b = b * (-0.6065306597126334f);
                        float* p = LW + (size_t)row * 512 + colt + bj * HALF; *(f32x4*)p = a; *(f32x4*)(p + 4) = b; }
                    else { u32x4 w; w.x = cvt_pk_bf16(a[0], a[1]); w.y = cvt_pk_bf16(a[2], a[3]); w.z = cvt_pk_bf16(b[0], b[1]); w.w = cvt_pk_bf16(b[2], b[3]);
                        *(u32x4*)(ob + (size_t)row * 512 + colt + bj * HALF) = w; }
                    if (m & 1) asm volatile("" ::: "memory");
                }
        }
    }
};
template <class Epi, class Sched, bool ALIGN_EPI = false, bool SP2 = false>
__device__ __forceinline__ void gemm_phase(PG8_LAS unsigned char* lds, const Gemm g, const Sched& S, const Epi& E) {
    const int tid = threadIdx.x, wid = __builtin_amdgcn_readfirstlane(tid >> 6), lane = tid & 63, wr = wid >> 2, wc = wid & 3, fr = lane & 15, fq = lane >> 4;
    const int K = g.K, nt = K / BK, LDP = g.ld ? g.ld : g.K;
    unsigned voffA[2], voffB[2];
#pragma unroll
    for (int i = 0; i < 2; ++i) { int R, C; stage_rc(tid * 16 + i * 8192, R, C); const int Rb = Epi::PERM ? ((R & ~31) + perm32(R & 31)) : R;
        voffA[i] = (unsigned)(R * LDP + C) * 2u; voffB[i] = (unsigned)(Rb * LDP + C) * 2u; }
    const size_t kstep = (size_t)(BK * 2);
    const size_t hstep = (size_t)HALF * LDP * 2;
    const size_t tstep = 2 * hstep;
    const unsigned ldsw = (unsigned)wid * 1024u;
    const int aoff = lds_byte(wr * 64 + fr, fq * 8), boff = lds_byte(wc * 32 + fr, fq * 8);
#define PG8_SA(b, h) (((b) * 2 + (h)) * HTB)
#define PG8_SB(b, h) ((4 + (b) * 2 + (h)) * HTB)
#define PG8_STAGE(bufoff, gbase, voff) do { _Pragma("unroll") for (int _i = 0; _i < 2; ++_i) \
        __builtin_amdgcn_global_load_lds((const unsigned*)((const char*)(gbase) + (voff)[_i]), (PG8_LAS unsigned*)(lds + (bufoff) + ldsw + _i * 8192), 16, 0, 0); } while (0)
#define PG8_LDA(dst, b, h) do { _Pragma("unroll") for (int m = 0; m < 4; ++m) _Pragma("unroll") for (int k = 0; k < 2; ++k) dst[m][k] = *(const PG8_LAS bf16x8*)(lds + PG8_SA(b, h) + aoff + m * 2048 + k * 1024); } while (0)
#define PG8_LDB(dst, b, h) do { _Pragma("unroll") for (int n = 0; n < 2; ++n) _Pragma("unroll") for (int k = 0; k < 2; ++k) dst[n][k] = *(const PG8_LAS bf16x8*)(lds + PG8_SB(b, h) + boff + n * 2048 + k * 1024); } while (0)
#define PG8_MMA(ai, bj, At, Bt) do { __builtin_amdgcn_s_setprio(1); _Pragma("unroll") for (int m = 0; m < 4; ++m) _Pragma("unroll") for (int n = 0; n < 2; ++n) _Pragma("unroll") for (int k = 0; k < 2; ++k) \
        acc[ai][bj][m][n] = __builtin_amdgcn_mfma_f32_16x16x32_bf16(Bt[n][k], At[m][k], acc[ai][bj][m][n], 0, 0, 0); __builtin_amdgcn_s_setprio(0); } while (0)
#define PG8_WAIT_V(n) asm volatile("s_waitcnt vmcnt(" #n ")" ::: "memory")
#define PG8_WAIT_L(n) asm volatile("s_waitcnt lgkmcnt(" #n ")" ::: "memory")
#define PG8_BAR __builtin_amdgcn_s_barrier()
#define PG8_SCHED __builtin_amdgcn_sched_barrier(0)
    Unit cur, nxt; int ui = 0;
    if (!S.next(0, cur)) return;
    f32x4 acc[2][2][4][2];
#pragma unroll
    for (int a = 0; a < 2; ++a)
#pragma unroll
        for (int b = 0; b < 2; ++b)
#pragma unroll
            for (int m = 0; m < 4; ++m)
#pragma unroll
                for (int n = 0; n < 2; ++n) acc[a][b][m][n] = (f32x4){0.f, 0.f, 0.f, 0.f};
    bf16x8 At[4][2], B0[2][2], B1[2][2];
    const char* cA = (const char*)g.A + (size_t)cur.pm * tstep; const char* cB = (const char*)g.Bt + (size_t)cur.pn * tstep;
    S.a_ready(cur);
    if constexpr (SP2) {
        PG8_STAGE(PG8_SB(0, 0), cB, voffB); PG8_STAGE(PG8_SB(0, 1), cB + hstep, voffB); PG8_STAGE(PG8_SA(0, 0), cA, voffA); PG8_STAGE(PG8_SA(0, 1), cA + hstep, voffA);
        if (wr == 1) PG8_BAR;
        PG8_WAIT_V(2); PG8_BAR;
        PG8_STAGE(PG8_SB(1, 0), cB + kstep, voffB); PG8_STAGE(PG8_SA(1, 0), cA + kstep, voffA); PG8_STAGE(PG8_SB(1, 1), cB + hstep + kstep, voffB);
        PG8_WAIT_V(6); PG8_BAR;
    } else {
        PG8_STAGE(PG8_SB(0, 0), cB, voffB); PG8_STAGE(PG8_SA(0, 0), cA, voffA); PG8_STAGE(PG8_SB(0, 1), cB + hstep, voffB); PG8_STAGE(PG8_SA(0, 1), cA + hstep, voffA);
        if (wr == 1) PG8_BAR;
        PG8_WAIT_V(4); PG8_BAR;
        PG8_STAGE(PG8_SB(1, 0), cB + kstep, voffB); PG8_STAGE(PG8_SA(1, 0), cA + kstep, voffA); PG8_STAGE(PG8_SB(1, 1), cB + hstep + kstep, voffB);
        PG8_WAIT_V(6); PG8_BAR;
    }
    for (;;) {
        const bool has_next = S.next(ui + 1, nxt);
        const char* nA = has_next ? (const char*)g.A + (size_t)nxt.pm * tstep : cA; const char* nB = has_next ? (const char*)g.Bt + (size_t)nxt.pn * tstep : cB;
        for (int t = 0; t < nt; t += 2) {
            const bool last = (t == nt - 2);
            const char* a1 = cA + (size_t)(t + 1) * kstep;
            const char* a2 = last ? nA : cA + (size_t)(t + 2) * kstep; const char* b2 = last ? nB : cB + (size_t)(t + 2) * kstep;
            const char* a3 = a2 + kstep; const char* b3 = b2 + kstep;
            if (last && has_next) S.a_ready(nxt);
            if constexpr (SP2) {
            PG8_LDB(B0, 0, 0); PG8_LDB(B1, 0, 1); PG8_SCHED; PG8_LDA(At, 0, 0); PG8_STAGE(PG8_SA(1, 1), a1 + hstep, voffA);
            PG8_WAIT_V(8); PG8_WAIT_L(0); PG8_BAR; PG8_MMA(0, 0, At, B0); PG8_MMA(0, 1, At, B1); PG8_BAR; PG8_SCHED;
            PG8_LDA(At, 0, 1); PG8_STAGE(PG8_SB(0, 0), b2, voffB); PG8_STAGE(PG8_SB(0, 1), b2 + hstep, voffB); PG8_STAGE(PG8_SA(0, 0), a2, voffA);
            PG8_WAIT_V(8); PG8_WAIT_L(0); PG8_BAR; PG8_MMA(1, 0, At, B0); PG8_MMA(1, 1, At, B1); PG8_BAR; PG8_SCHED;
            PG8_LDB(B0, 1, 0); PG8_LDB(B1, 1, 1); PG8_SCHED; PG8_LDA(At, 1, 0); PG8_STAGE(PG8_SA(0, 1), a2 + hstep, voffA);
            PG8_WAIT_V(8); PG8_WAIT_L(0); PG8_BAR; PG8_MMA(0, 0, At, B0); PG8_MMA(0, 1, At, B1); PG8_BAR; PG8_SCHED;
            PG8_LDA(At, 1, 1); PG8_STAGE(PG8_SB(1, 0), b3, voffB); PG8_STAGE(PG8_SB(1, 1), b3 + hstep, voffB); PG8_STAGE(PG8_SA(1, 0), a3, voffA);
            PG8_WAIT_V(8); PG8_WAIT_L(0); PG8_BAR; PG8_MMA(1, 0, At, B0); PG8_MMA(1, 1, At, B1); PG8_BAR; PG8_SCHED;
            } else {
            PG8_LDB(B0, 0, 0); PG8_SCHED; PG8_LDA(At, 0, 0); PG8_STAGE(PG8_SA(1, 1), a1 + hstep, voffA);
            PG8_WAIT_L(8); PG8_BAR; PG8_WAIT_L(0); PG8_MMA(0, 0, At, B0); PG8_BAR; PG8_SCHED;
            PG8_LDB(B1, 0, 1); PG8_STAGE(PG8_SB(0, 0), b2, voffB);
            PG8_BAR; PG8_WAIT_L(0); PG8_MMA(0, 1, At, B1); PG8_BAR;
            PG8_LDA(At, 0, 1); PG8_STAGE(PG8_SA(0, 0), a2, voffA);
            PG8_BAR; PG8_WAIT_L(0); PG8_MMA(1, 0, At, B0); PG8_BAR; PG8_SCHED;
            PG8_STAGE(PG8_SB(0, 1), b2 + hstep, voffB);
            PG8_WAIT_V(6); PG8_BAR; PG8_MMA(1, 1, At, B1); PG8_BAR;
            PG8_LDB(B0, 1, 0); PG8_SCHED; PG8_LDA(At, 1, 0); PG8_STAGE(PG8_SA(0, 1), a2 + hstep, voffA);
            PG8_WAIT_L(8); PG8_BAR; PG8_WAIT_L(0); PG8_MMA(0, 0, At, B0); PG8_BAR; PG8_SCHED;
            PG8_LDB(B1, 1, 1); PG8_STAGE(PG8_SB(1, 0), b3, voffB);
            PG8_BAR; PG8_WAIT_L(0); PG8_MMA(0, 1, At, B1); PG8_BAR;
            PG8_LDA(At, 1, 1); PG8_STAGE(PG8_SA(1, 0), a3, voffA);
            PG8_BAR; PG8_WAIT_L(0); PG8_MMA(1, 0, At, B0); PG8_BAR; PG8_SCHED;
            PG8_STAGE(PG8_SB(1, 1), b3 + hstep, voffB);
            PG8_WAIT_V(6); PG8_BAR; PG8_MMA(1, 1, At, B1); PG8_BAR;
            }
        }
        if constexpr (ALIGN_EPI) { if (wr == 0) PG8_BAR; }
        if constexpr (!Epi::AFTER_DRAIN) { E(acc, cur, wr, wc, fr, fq); S.done(cur); }
        if (!has_next) break;
#pragma unroll
        for (int a = 0; a < 2; ++a)
#pragma unroll
            for (int b = 0; b < 2; ++b)
#pragma unroll
                for (int m = 0; m < 4; ++m)
#pragma unroll
                    for (int n = 0; n < 2; ++n) acc[a][b][m][n] = (f32x4){0.f, 0.f, 0.f, 0.f};
        cur = nxt; cA = nA; cB = nB; ++ui;
        if constexpr (ALIGN_EPI) { if (wr == 1) PG8_BAR; }
    }
    PG8_WAIT_V(0);
    if constexpr (!ALIGN_EPI) { if (wr == 0) PG8_BAR; }
    PG8_BAR;
    if constexpr (Epi::AFTER_DRAIN) { E.fused(acc, cur, wr, wc, fr, fq, lds, wid, lane); S.done(cur); }
#undef PG8_SA
#undef PG8_SB
#undef PG8_STAGE
#undef PG8_LDA
#undef PG8_LDB
#undef PG8_MMA
#undef PG8_WAIT_V
#undef PG8_WAIT_L
#undef PG8_BAR
#undef PG8_SCHED
}
}
#define GAS __attribute__((address_space(1)))
#define LAS __attribute__((address_space(3)))
typedef unsigned short bf16;
typedef unsigned v4u __attribute__((ext_vector_type(4)));
typedef float f32x4 __attribute__((ext_vector_type(4)));
typedef short bf16x8 __attribute__((ext_vector_type(8)));
typedef GAS unsigned gu32;
typedef GAS unsigned long long gu64;
#define RLX_AGENT __ATOMIC_RELAXED, __HIP_MEMORY_SCOPE_AGENT
#define LDS_WAIT() asm volatile("s_waitcnt lgkmcnt(0)" ::: "memory")
#define VM_WAIT() asm volatile("s_waitcnt vmcnt(0)" ::: "memory")
__device__ __forceinline__ unsigned long long rt() { return __builtin_amdgcn_s_memrealtime(); }
__device__ __forceinline__ unsigned f2bf(float f) { unsigned u = __builtin_bit_cast(unsigned, f); return (u + 0x7fffu + ((u >> 16) & 1u)) >> 16; }
__device__ __forceinline__ unsigned pk2(float lo, float hi) { return f2bf(lo) | (f2bf(hi) << 16); }

#define XB_TMO      128
#define XB_XCNT(j)  (256  + 64 * (j))
#define XB_XSUB(j)  (1280 + 64 * (j))
#define XB_XGEN(j)  (2304 + 64 * (j))
#define XB_TOP      3328
#define XB_TOPGEN   3392
#define XCD_BAR_WORDS 3456
#define XB_SPIN_CAP (1u << 18)

__device__ __forceinline__ unsigned xb_ld(unsigned* p)              { return __hip_atomic_load(p, __ATOMIC_RELAXED, __HIP_MEMORY_SCOPE_AGENT); }
__device__ __forceinline__ unsigned xb_add(unsigned* p, unsigned v) { return __hip_atomic_fetch_add(p, v, __ATOMIC_RELAXED, __HIP_MEMORY_SCOPE_AGENT); }
__device__ __forceinline__ unsigned xb_xcc_id() { return (unsigned)__builtin_amdgcn_s_getreg((3 << 11) | 20) & 0xFu; }
#define XB_SPIN(cond, bar) do { unsigned _sp = 0; while (cond) { __builtin_amdgcn_s_sleep(1); \
    if ((++_sp & 255u) == 0u) { if (xb_ld(&(bar)[XB_TMO])) break; if (_sp > XB_SPIN_CAP) { atomicAdd(&(bar)[XB_TMO], 1u); break; } } } } while (0)

struct XcdBarrier {
    unsigned* bar; unsigned x;
    volatile LAS unsigned* st;
};

__device__ __forceinline__ XcdBarrier xcd_barrier_post(unsigned* bar, volatile LAS unsigned* st) {
    XcdBarrier b; b.bar = bar; b.x = xb_xcc_id(); b.st = st;
    if (threadIdx.x == 0) (void)xb_add(&bar[XB_XCNT(b.x)], 1u);
    return b;
}
__device__ __forceinline__ void xcd_barrier_complete(unsigned* bar, unsigned x, unsigned& nloc, unsigned& nx) {
    const unsigned G = gridDim.x * gridDim.y * gridDim.z;
    unsigned sum, cnt, mine, sp = 0u;
    for (;;) {
        sum = 0u; cnt = 0u; mine = 0u;
#pragma unroll
        for (unsigned j = 0; j < 16; ++j) { const unsigned c = xb_ld(&bar[XB_XCNT(j)]); sum += c; cnt += (c > 0u) ? 1u : 0u; mine = (j == x) ? c : mine; }
        if (sum == G) break;
        __builtin_amdgcn_s_sleep(1);
        if ((++sp & 255u) == 0u) { if (xb_ld(&bar[XB_TMO])) break; if (sp > XB_SPIN_CAP) { atomicAdd(&bar[XB_TMO], 1u); break; } }
    }
    nloc = mine > 0u ? mine : 1u; nx = cnt > 0u ? cnt : 1u;
}

__device__ __forceinline__ void xcd_barrier(const XcdBarrier& b) {
    asm volatile("s_waitcnt vmcnt(0)" ::: "memory");
    __syncthreads();
    if (threadIdx.x == 0) {
        unsigned* bar = b.bar;
        __builtin_amdgcn_s_waitcnt(0);
        unsigned nloc = b.st[0], nx = b.st[1];
        if (nloc == 0u) { xcd_barrier_complete(bar, b.x, nloc, nx); b.st[0] = nloc; b.st[1] = nx; }
        const unsigned old = xb_add(&bar[XB_XSUB(b.x)], 1u);
        const unsigned gen = old / nloc;
        if (old + 1u == (gen + 1u) * nloc) {
            __builtin_amdgcn_fence(__ATOMIC_RELEASE, "agent");
            asm volatile("s_waitcnt vmcnt(0)" ::: "memory");
            const unsigned og = xb_add(&bar[XB_TOP], 1u);
            const unsigned tg = og / nx;
            if (og + 1u == (tg + 1u) * nx) xb_add(&bar[XB_TOPGEN], 1u);
            else XB_SPIN(xb_ld(&bar[XB_TOPGEN]) == tg, bar);
            __builtin_amdgcn_fence(__ATOMIC_ACQUIRE, "agent");
            xb_add(&bar[XB_XGEN(b.x)], 1u);
            asm volatile("s_waitcnt vmcnt(0)" ::: "memory");
        } else {
            XB_SPIN(xb_ld(&bar[XB_XGEN(b.x)]) == gen, bar);
            __builtin_amdgcn_fence(__ATOMIC_ACQUIRE, "agent");
            asm volatile("s_waitcnt vmcnt(0)" ::: "memory");
        }
    }
    __syncthreads();
}

constexpr int NWAVES = 8;
#ifndef MK_N_LAUNCHES
#define MK_N_LAUNCHES 1
#endif
constexpr int PER_PHASE = 11;
constexpr int N_LAUNCHES = MK_N_LAUNCHES;

constexpr int BATCH = 16, SEQ = 2048, D = 1024, HD = 64, NH = 8, FF = 2816;
constexpr int M = BATCH * SEQ;
constexpr int SBW = 512, RWW = 512, RWP = 1792, PW = 3328, LORA_K = 256, LORA_N = 1536;
constexpr float LNX_EPS = 64e-5f;

constexpr size_t MiB = 1u << 20;
constexpr size_t WS_CTL = 0, CTL_ZERO_BYTES = 1 * MiB;
constexpr size_t WS_SSQ = 1 * MiB;
constexpr size_t WS_W1U = 4 * MiB;
constexpr size_t WS_W1D = 15 * MiB;
constexpr size_t WS_W2U = 21 * MiB;
constexpr size_t WS_W2D = 32 * MiB;
constexpr size_t WS_WIN = 38 * MiB;
constexpr size_t WS_WOUT = 45 * MiB;
constexpr size_t WS_WLORA = 47 * MiB;
constexpr size_t WS_XB = 48 * MiB;
constexpr size_t WS_ACT = 112 * MiB;
constexpr size_t WS_QO = 112 * MiB;
constexpr size_t WS_KB = 176 * MiB;
constexpr size_t WS_VB = 208 * MiB;
constexpr size_t WS_RW = 240 * MiB;
constexpr size_t WS_ALORA = 352 * MiB;
constexpr size_t WS_LW = 368 * MiB;
constexpr size_t WS_AB = 432 * MiB;
constexpr size_t WS_GB = 464 * MiB;
constexpr size_t WS_TAIL = 496 * MiB;
constexpr size_t WS_END = 512 * MiB;
constexpr int CW_TMO = 0, CW_CODE = 1;
constexpr int CW_BAR = 4096;

constexpr int RING_OFF = 0, RING_BYTES = 147456;
constexpr int LDSCTL_OFF = RING_BYTES, MISC_OFF = LDSCTL_OFF + 320;
constexpr int LDS_BYTES = 159744;

struct Frame {
    LAS unsigned char* lds;
    volatile LAS unsigned* MISC;
    gu32* ctl;
    int tid, lane, wave;
    int vcu, G;
};
typedef unsigned u32x2g __attribute__((ext_vector_type(2)));
__device__ __forceinline__ float bf2f(unsigned short h) { return __uint_as_float(((unsigned)h) << 16); }
typedef float f32x2h __attribute__((ext_vector_type(2))); typedef __bf16 bf16x2h __attribute__((ext_vector_type(2)));
__device__ __forceinline__ unsigned pkbf(float lo, float hi) { f32x2h v = {lo, hi}; bf16x2h b = __builtin_convertvector(v, bf16x2h); return __builtin_bit_cast(unsigned, b); }
__device__ __forceinline__ float bflo(unsigned w) { return __uint_as_float(w << 16); }
__device__ __forceinline__ float bfhi(unsigned w) { return __uint_as_float(w & 0xffff0000u); }
__device__ __forceinline__ float wave_sum(float v) {
#pragma unroll
    for (int o = 1; o < 64; o <<= 1) v += __shfl_xor(v, o);
    return v;
}
__device__ __forceinline__ float dpp_f(float v, const int ctrl_unused) { return v; }
#define DPP_ADD(v, ctrl) ((v) + __int_as_float(__builtin_amdgcn_update_dpp(0, __float_as_int(v), (ctrl), 0xF, 0xF, true)))
__device__ __forceinline__ float sum8(float v) { v = DPP_ADD(v, 0xB1); v = DPP_ADD(v, 0x4E); v = DPP_ADD(v, 0x141); return v; }

__device__ __forceinline__ void transpose_item(const float* W, int ldw, int k0, int n0src, const float* kscale, bf16* WT, int Kdst, int rho0, LAS float* scr, int lane) {
#pragma unroll 8
    for (int i = 0; i < 32; ++i) { const int kk = 2 * i + (lane >> 5); float v = W[(size_t)(k0 + kk) * ldw + n0src + (lane & 31)]; if (kscale) v *= kscale[k0 + kk]; scr[kk * 33 + (lane & 31)] = v; }
    LDS_WAIT(); asm volatile("" ::: "memory");
    const int c = lane & 7;
#pragma unroll
    for (int j = 0; j < 4; ++j) { const int n = (lane >> 3) + 8 * j; const LAS float* s = scr + (8 * c) * 33 + n;
        v4u o; o.x = pkbf(s[0 * 33], s[1 * 33]); o.y = pkbf(s[2 * 33], s[3 * 33]); o.z = pkbf(s[4 * 33], s[5 * 33]); o.w = pkbf(s[6 * 33], s[7 * 33]);
        *(GAS v4u*)(WT + (size_t)(rho0 + n) * Kdst + k0 + 8 * c) = o; }
    LDS_WAIT(); asm volatile("" ::: "memory");
}
#define P0_PTRS const float* Ax, const float* An1, const float* Ag1, const float* Au1, const float* Ad1, const float* Anm, const float* Awin, const float* Aw2, const float* Aa2, const float* Ag2, const float* Awout, \
    const float* An2, const float* Ag2f, const float* Au2f, const float* Ad2f, bf16* AW1U, bf16* AW1D, bf16* AW2U, bf16* AW2D, bf16* AWIN, bf16* AWOUT, bf16* AWLORA, bf16* AXB, float* ASSQ
__device__ __forceinline__ void p0_prologue(Frame& F, P0_PTRS) {
    LAS float* scr = (LAS float*)(F.lds + RING_OFF + F.wave * 16384);
    const int gw = F.vcu * NWAVES + F.wave, NGW = F.G * NWAVES;
    constexpr int I_UP = 16 * 176, I_DN = 44 * 32, I_IN = 16 * 104, I_OUT = 16 * 32;
    constexpr int NITEMS = 2 * (I_UP + I_DN) + I_IN + I_OUT;
    for (int it = gw; it < NITEMS; it += NGW) {
        int r = it;
        if (r < 2 * I_UP) { const int l2 = r >= I_UP; if (l2) r -= I_UP;
            const int kb = r / 176, nb = r % 176, rho0 = 32 * nb, pn = rho0 >> 8, bj = (rho0 >> 7) & 1, j0 = rho0 & 127;
            const float* src = l2 ? (bj ? Au2f : Ag2f) : (bj ? Au1 : Ag1);
            transpose_item(src, FF, 64 * kb, 128 * pn + j0, l2 ? An2 : An1, l2 ? AW2U : AW1U, D, rho0, scr, F.lane); continue; }
        r -= 2 * I_UP;
        if (r < 2 * I_DN) { const int l2 = r >= I_DN; if (l2) r -= I_DN;
            const int kb = r / 32, nb = r % 32;
            transpose_item(l2 ? Ad2f : Ad1, D, 64 * kb, 32 * nb, nullptr, l2 ? AW2D : AW1D, FF, 32 * nb, scr, F.lane); continue; }
        r -= 2 * I_DN;
        if (r < I_IN) { const int kb = r / 104, nb = r % 104, rho0 = 32 * nb, pn = rho0 >> 8, rem = rho0 & 255, bj = rem >> 7, wc = (rem & 127) >> 5;
            transpose_item(Awin, PW, 64 * kb, 256 * pn + 64 * wc + 32 * bj, Anm, AWIN, D, rho0, scr, F.lane); continue; }
        r -= I_IN;
        { const int kb = r / 32, nb = r % 32; transpose_item(Awout, D, 64 * kb, 32 * nb, nullptr, AWOUT, D, 32 * nb, scr, F.lane); }
    }
    for (int it = F.vcu * (NWAVES * 64) + F.tid; it < LORA_N * (LORA_K / 8); it += F.G * NWAVES * 64) {
        const int rho = it >> 5, kc = (it & 31) * 8; float v[8];
#pragma unroll
        for (int j = 0; j < 8; ++j) { const int k = kc + j; float t = 0.f;
            if (rho < 512) { if (k < 64) t = Aw2[(size_t)k * 512 + rho]; }
            else if (rho < 1024) { if (k >= 64 && k < 128) t = Aa2[(size_t)(k - 64) * 512 + (rho - 512)]; }
            else { if (k >= 128) t = Ag2[(size_t)(k - 128) * 512 + (rho - 1024)]; }
            v[j] = t; }
        v4u o; o.x = pkbf(v[0], v[1]); o.y = pkbf(v[2], v[3]); o.z = pkbf(v[4], v[5]); o.w = pkbf(v[6], v[7]);
        *(GAS v4u*)(AWLORA + (size_t)rho * LORA_K + kc) = o;
    }
    for (int m = gw; m < M; m += NGW) {
        const GAS f32x4* xr = (const GAS f32x4*)(Ax + (size_t)m * D) + F.lane;
        f32x4 v[4]; float s = 0.f;
#pragma unroll
        for (int j = 0; j < 4; ++j) { v[j] = xr[64 * j]; s += (v[j].x * v[j].x + v[j].y * v[j].y) + (v[j].z * v[j].z + v[j].w * v[j].w); }
        s = wave_sum(s);
        GAS unsigned long long* o8 = (GAS unsigned long long*)(AXB + (size_t)m * D) + F.lane;
#pragma unroll
        for (int j = 0; j < 4; ++j) o8[64 * j] = (unsigned long long)pkbf(v[j].x, v[j].y) | ((unsigned long long)pkbf(v[j].z, v[j].w) << 32);
        if (F.lane < 16) ASSQ[(size_t)m * 16 + F.lane] = (F.lane == 0) ? s : 0.f;
    }
}

__device__ __forceinline__ void p4_lora_prep(Frame& F, const bf16* RW, const float* mu, bf16* ALORA) {
    const int gw = F.vcu * NWAVES + F.wave, NGW = F.G * NWAVES; const int l = F.lane;
    const f32x4 muv = *(const f32x4*)(mu + 1536 + 4 * l);
    for (int m = gw; m < M; m += NGW) {
        const u32x2g c = *(const u32x2g*)(RW + (size_t)m * RWP + 1536 + 4 * l);
        u32x2g p = (u32x2g){0u, 0u};
        if ((m & (SEQ - 1)) != 0) p = *(const u32x2g*)(RW + (size_t)(m - 1) * RWP + 1536 + 4 * l);
        float x[4] = {bflo(c.x), bfhi(c.x), bflo(c.y), bfhi(c.y)}; const float q[4] = {bflo(p.x), bfhi(p.x), bflo(p.y), bfhi(p.y)};
#pragma unroll
        for (int i = 0; i < 4; ++i) { float u = x[i] + (q[i] - x[i]) * muv[i];
            if (l < 16) u = 2.0f * pg8::sigmoid_f(2.0f * u) - 1.0f; else if (l >= 32) u = pg8::sigmoid_f(u);
            x[i] = u; }
        u32x2g o; o.x = pkbf(x[0], x[1]); o.y = pkbf(x[2], x[3]);
        *(u32x2g*)(ALORA + (size_t)m * LORA_K + 4 * l) = o;
    }
}

struct RwArgs { const bf16* RW; const float* LW; const bf16* AB; const bf16* GB; bf16* QO; const float *mu, *k_k, *k_a, *r_k, *ln_w, *ln_b; };
__device__ __forceinline__ void ld8bf(const bf16* p, float (&o)[8]) { const v4u w = *(const v4u*)p; o[0] = bflo(w.x); o[1] = bfhi(w.x); o[2] = bflo(w.y); o[3] = bfhi(w.y); o[4] = bflo(w.z); o[5] = bfhi(w.z); o[6] = bflo(w.w); o[7] = bfhi(w.w); }
__device__ __forceinline__ void ld8f(const float* p, float (&o)[8]) { const f32x4 a = *(const f32x4*)p, b = *(const f32x4*)(p + 4); o[0] = a.x; o[1] = a.y; o[2] = a.z; o[3] = a.w; o[4] = b.x; o[5] = b.y; o[6] = b.z; o[7] = b.w; }
__device__ __forceinline__ void ld8l(const LAS float* p, float (&o)[8]) { const f32x4 a = *(const LAS f32x4*)p, b = *(const LAS f32x4*)(p + 4); o[0] = a.x; o[1] = a.y; o[2] = a.z; o[3] = a.w; o[4] = b.x; o[5] = b.y; o[6] = b.z; o[7] = b.w; }
__device__ __forceinline__ void st8l(LAS float* p, const float (&o)[8]) { *(LAS f32x4*)p = (f32x4){o[0], o[1], o[2], o[3]}; *(LAS f32x4*)(p + 4) = (f32x4){o[4], o[5], o[6], o[7]}; }
namespace rwk {
typedef short bf16x8 __attribute__((ext_vector_type(8)));
constexpr int LD = 144, SLOT = 64 * LD;
#define RSL(s) (lds + (s) * SLOT)
#define RFRAGO(base, off, ks) (*(const LAS bf16x8*)((base) + (off) + (ks) * 64))
#define RMFMA(a, b, c) __builtin_amdgcn_mfma_f32_16x16x32_bf16((a), (b), (c), 0, 0, 0)
template <bool SWAP> __device__ __forceinline__ f32x4 prod(const LAS unsigned char* Am, int fm, const LAS unsigned char* Bn, int fn, f32x4 acc) {
#pragma unroll
    for (int ks = 0; ks < 2; ++ks) { const bf16x8 a = RFRAGO(Am, fm, ks), b = RFRAGO(Bn, fn, ks); acc = SWAP ? RMFMA(b, a, acc) : RMFMA(a, b, acc); }
    return acc;
}
struct Fr2 { bf16x8 k0, k1; };
__device__ __forceinline__ Fr2 ldf(const LAS unsigned char* base, int off) { Fr2 f; f.k0 = RFRAGO(base, off, 0); f.k1 = RFRAGO(base, off, 1); return f; }
template <bool SWAP> __device__ __forceinline__ f32x4 mm(const Fr2& a, const Fr2& b, f32x4 c) {
    if (SWAP) { c = RMFMA(b.k0, a.k0, c); c = RMFMA(b.k1, a.k1, c); } else { c = RMFMA(a.k0, b.k0, c); c = RMFMA(a.k1, b.k1, c); } return c; }
__device__ __forceinline__ void st4(LAS unsigned char* slot, int off, f32x4 v) { u32x2g w; w.x = pkbf(v[0], v[1]); w.y = pkbf(v[2], v[3]); *(LAS u32x2g*)(slot + off) = w; }
__device__ __forceinline__ f32x4 ld4(const LAS unsigned char* slot, int off) { const u32x2g w = *(const LAS u32x2g*)(slot + off); return (f32x4){bflo(w.x), bfhi(w.x), bflo(w.y), bfhi(w.y)}; }
}
struct RwX { bf16* P1; bf16* GT; bf16* Y0; bf16* H; bf16* VB0; bf16* VB1; float* GE; };
__device__ __forceinline__ void p6a_rwkv_local(Frame& F, const RwArgs& A, const RwX& X) {
    using namespace rwk;
    LAS unsigned char* lds = F.lds + RING_OFF;
    LAS float* scrA = (LAS float*)RSL(8); LAS float* scrB = (LAS float*)RSL(10);
    const int tid = F.tid, tok = tid >> 3, dg = tid & 7, lane = F.lane, fr = lane & 15, fq = lane >> 4;
    const int w = F.wave, m0 = 16 * (w >> 1), n0a = 32 * (w & 1);
    const int fm = (m0 + fr) * LD + fq * 16;
    int fn[2], orm[2], otr[2];
#pragma unroll
    for (int t = 0; t < 2; ++t) { const int n0 = n0a + 16 * t; fn[t] = (n0 + fr) * LD + fq * 16; orm[t] = (m0 + fr) * LD + (n0 + 4 * fq) * 2; otr[t] = (n0 + fr) * LD + (m0 + 4 * fq) * 2; }
    {
        for (int job = blockIdx.x; job < BATCH * NH * (SEQ / 64); job += F.G) {
            const int unit = job >> 5, c = job & 31; const int b = unit >> 3, h = unit & 7; const int cb = 64 * h + 8 * dg; const size_t jo = (size_t)job * 4096;
            const size_t grow = (size_t)b * SEQ + c * 64 + tok;
            float r[8], kf[8], v[8], aa[8], bb[8], lw[8]; float bon;
            {
                float k[8], rp[8], kp[8], vp[8], mr[8], mk[8], mv[8], al[8], kkc[8], kac[8], rkc[8];
                ld8bf(A.RW + grow * RWP + cb, r); ld8bf(A.RW + grow * RWP + 512 + cb, k); ld8bf(A.RW + grow * RWP + 1024 + cb, v);
                if (c == 0 && tok == 0) {
#pragma unroll
                    for (int j = 0; j < 8; ++j) { rp[j] = 0.f; kp[j] = 0.f; vp[j] = 0.f; }
                } else { ld8bf(A.RW + (grow - 1) * RWP + cb, rp); ld8bf(A.RW + (grow - 1) * RWP + 512 + cb, kp); ld8bf(A.RW + (grow - 1) * RWP + 1024 + cb, vp); }
                ld8f(A.mu + cb, mr); ld8f(A.mu + 512 + cb, mk); ld8f(A.mu + 1024 + cb, mv);
                ld8f(A.LW + grow * 512 + cb, lw); ld8bf(A.AB + grow * 512 + cb, al);
                ld8f(A.k_k + cb, kkc); ld8f(A.k_a + cb, kac); ld8f(A.r_k + cb, rkc);
                float ss = 0.f, bp = 0.f; float kk[8];
#pragma unroll
                for (int j = 0; j < 8; ++j) { r[j] = r[j] + (rp[j] - r[j]) * mr[j]; k[j] = k[j] + (kp[j] - k[j]) * mk[j]; v[j] = v[j] + (vp[j] - v[j]) * mv[j];
                    kk[j] = k[j] * kkc[j]; ss += kk[j] * kk[j]; kf[j] = k[j] * (1.0f + (al[j] - 1.0f) * kac[j]); bp += r[j] * kf[j] * rkc[j]; }
                ss = sum8(ss); bon = sum8(bp);
                const float inv = 1.0f / fmaxf(sqrtf(ss), 1e-12f);
#pragma unroll
                for (int j = 0; j < 8; ++j) { kk[j] *= inv; aa[j] = -kk[j]; bb[j] = kk[j] * al[j]; }
                st8l(scrA + tok * 64 + 8 * dg, lw);
            }
            __syncthreads();
            {
                const int kcol = tid & 63, seg = tid >> 6; float run = 0.f;
                for (int s = 0; s < seg; ++s) { float t8[8];
#pragma unroll
                    for (int t = 0; t < 8; ++t) t8[t] = scrA[(8 * s + t) * 64 + kcol];
                    run += ((t8[0] + t8[1]) + (t8[2] + t8[3])) + ((t8[4] + t8[5]) + (t8[6] + t8[7])); }
                float t8[8];
#pragma unroll
                for (int t = 0; t < 8; ++t) t8[t] = scrA[(8 * seg + t) * 64 + kcol];
#pragma unroll
                for (int t = 0; t < 8; ++t) { run += t8[t]; scrB[(8 * seg + t) * 64 + kcol] = run; }
            }
            __syncthreads();
            {
                float cs[8], ce[8]; ld8l(scrB + tok * 64 + 8 * dg, cs); ld8l(scrB + 63 * 64 + 8 * dg, ce);
                float at[8], rt[8], bt[8], kt[8], bh[8], kh[8];
#pragma unroll
                for (int j = 0; j < 8; ++j) {
                    const float e_cs = __builtin_amdgcn_exp2f(cs[j] * 1.4426950408889634f), e_csm = __builtin_amdgcn_exp2f((cs[j] - lw[j]) * 1.4426950408889634f);
                    const float e_neg = __builtin_amdgcn_rcpf(e_cs), e_end = __builtin_amdgcn_exp2f((ce[j] - cs[j]) * 1.4426950408889634f);
                    at[j] = aa[j] * e_csm; rt[j] = r[j] * e_cs; bt[j] = bb[j] * e_neg; kt[j] = kf[j] * e_neg; bh[j] = bb[j] * e_end; kh[j] = kf[j] * e_end;
                    if (tok == 63) X.GE[(size_t)job * 64 + 8 * dg + j] = e_cs;
                }
                const int ro = tok * LD + 16 * dg;
                *(LAS v4u*)(RSL(0) + ro) = (v4u){pkbf(at[0], at[1]), pkbf(at[2], at[3]), pkbf(at[4], at[5]), pkbf(at[6], at[7])};
                *(LAS v4u*)(RSL(2) + ro) = (v4u){pkbf(rt[0], rt[1]), pkbf(rt[2], rt[3]), pkbf(rt[4], rt[5]), pkbf(rt[6], rt[7])};
                *(LAS v4u*)(RSL(3) + ro) = (v4u){pkbf(bt[0], bt[1]), pkbf(bt[2], bt[3]), pkbf(bt[4], bt[5]), pkbf(bt[6], bt[7])};
                *(LAS v4u*)(RSL(4) + ro) = (v4u){pkbf(kt[0], kt[1]), pkbf(kt[2], kt[3]), pkbf(kt[4], kt[5]), pkbf(kt[6], kt[7])};
#pragma unroll
                for (int j = 0; j < 8; j += 2) { const int to = (8 * dg + j) * LD + tok * 2;
                    const unsigned pa = pkbf(at[j], at[j + 1]), pb = pkbf(bh[j], bh[j + 1]), pk = pkbf(kh[j], kh[j + 1]), pv = pkbf(v[j], v[j + 1]);
                    *(LAS unsigned short*)(RSL(1) + to) = (unsigned short)pa; *(LAS unsigned short*)(RSL(1) + to + LD) = (unsigned short)(pa >> 16);
                    *(LAS unsigned short*)(RSL(5) + to) = (unsigned short)pb; *(LAS unsigned short*)(RSL(5) + to + LD) = (unsigned short)(pb >> 16);
                    *(LAS unsigned short*)(RSL(6) + to) = (unsigned short)pk; *(LAS unsigned short*)(RSL(6) + to + LD) = (unsigned short)(pk >> 16);
                    *(LAS unsigned short*)(RSL(7) + to) = (unsigned short)pv; *(LAS unsigned short*)(RSL(7) + to + LD) = (unsigned short)(pv >> 16); }
            }
            __syncthreads();
            {
                const f32x4 z4 = (f32x4){0.f, 0.f, 0.f, 0.f};
                const Fr2 aA = ldf(RSL(0), fm), aR = ldf(RSL(2), fm); Fr2 bB[2], bK[2];
#pragma unroll
                for (int t = 0; t < 2; ++t) { bB[t] = ldf(RSL(3), fn[t]); bK[t] = ldf(RSL(4), fn[t]); }
                f32x4 nab[2], nabT[2], nak[2], mrb[2], mrk[2];
#pragma unroll
                for (int t = 0; t < 2; ++t) { nab[t] = mm<true>(aA, bB[t], z4); nabT[t] = mm<false>(aA, bB[t], z4); nak[t] = mm<true>(aA, bK[t], z4); mrb[t] = mm<true>(aR, bB[t], z4); mrk[t] = mm<true>(aR, bK[t], z4); }
#pragma unroll
                for (int t = 0; t < 2; ++t) { const int n0 = n0a + 16 * t; f32x4 x1;
#pragma unroll
                    for (int x = 0; x < 4; ++x) { const int i = m0 + fr, j = n0 + 4 * fq + x;
                        if (j >= i) { nab[t][x] = 0.f; nak[t][x] = 0.f; } if (j > i) { mrb[t][x] = 0.f; mrk[t][x] = 0.f; }
                        x1[x] = nab[t][x] + ((i == j) ? 1.0f : 0.f);
                        const int it = m0 + 4 * fq + x, jt = n0 + fr; if (jt >= it) nabT[t][x] = 0.f; }
                    st4(RSL(11), orm[t], x1); st4(RSL(12), orm[t], nab[t]); st4(RSL(13), otr[t], nabT[t]);
                    st4(RSL(8), orm[t], nak[t]); st4(RSL(9), orm[t], mrb[t]); st4(RSL(10), orm[t], mrk[t]); }
            }
            __syncthreads();
            {
                const f32x4 z4 = (f32x4){0.f, 0.f, 0.f, 0.f};
                const Fr2 aP = ldf(RSL(12), fm), aN = ldf(RSL(8), fm); Fr2 bT[2], bV[2];
#pragma unroll
                for (int t = 0; t < 2; ++t) { bT[t] = ldf(RSL(13), fn[t]); bV[t] = ldf(RSL(7), fn[t]); }
                f32x4 q0[2], q1[2], q2[2];
#pragma unroll
                for (int t = 0; t < 2; ++t) { q0[t] = mm<true>(aP, bT[t], z4); q1[t] = mm<false>(aP, bT[t], z4); q2[t] = mm<false>(aN, bV[t], z4); }
#pragma unroll
                for (int t = 0; t < 2; ++t) { st4(RSL(0), orm[t], q0[t]); st4(RSL(3), otr[t], q1[t]); st4(RSL(4), otr[t], q2[t]); }
            }
            __syncthreads();
#pragma unroll
            for (int kd = 0; kd < 5; ++kd) {
                const int xi = (kd & 1) ? 8 : 11, xo = (kd & 1) ? 11 : 8, pi = (kd & 1) ? 12 : 0, po = (kd & 1) ? 0 : 12, ti = (kd & 1) ? 13 : 3, to = (kd & 1) ? 3 : 13;
                const f32x4 z4 = (f32x4){0.f, 0.f, 0.f, 0.f};
                const Fr2 aX = ldf(RSL(xi), fm), aP = ldf(RSL(pi), fm); Fr2 bT[2]; f32x4 cx[2];
#pragma unroll
                for (int t = 0; t < 2; ++t) { bT[t] = ldf(RSL(ti), fn[t]); cx[t] = ld4(RSL(xi), orm[t]); }
                f32x4 q0[2], q1[2], q2[2];
#pragma unroll
                for (int t = 0; t < 2; ++t) { q0[t] = mm<true>(aX, bT[t], cx[t]); if (kd < 4) { q1[t] = mm<true>(aP, bT[t], z4); q2[t] = mm<false>(aP, bT[t], z4); } }
#pragma unroll
                for (int t = 0; t < 2; ++t) { st4(RSL(xo), orm[t], q0[t]); if (kd < 4) { st4(RSL(po), orm[t], q1[t]); st4(RSL(to), otr[t], q2[t]); } }
                __syncthreads();
            }
            {
                const f32x4 z4 = (f32x4){0.f, 0.f, 0.f, 0.f};
                const Fr2 aT = ldf(RSL(8), fm); Fr2 bA[2], bZ[2];
#pragma unroll
                for (int t = 0; t < 2; ++t) { bA[t] = ldf(RSL(1), fn[t]); bZ[t] = ldf(RSL(4), fn[t]); }
                f32x4 q0[2], q1[2];
#pragma unroll
                for (int t = 0; t < 2; ++t) { q0[t] = mm<false>(aT, bA[t], z4); q1[t] = mm<false>(aT, bZ[t], z4); }
#pragma unroll
                for (int t = 0; t < 2; ++t) { st4(RSL(11), otr[t], q0[t]); st4(RSL(12), otr[t], q1[t]); }
            }
            __syncthreads();
            {
                const f32x4 z4 = (f32x4){0.f, 0.f, 0.f, 0.f};
                f32x4 p1[2], y0[2], gt[2], hh[2];
                {   const Fr2 aMb = ldf(RSL(9), fm), aMk = ldf(RSL(10), fm); Fr2 bW[2], bU[2], bV[2]; f32x4 cR[2];
#pragma unroll
                    for (int t = 0; t < 2; ++t) { bW[t] = ldf(RSL(11), fn[t]); bU[t] = ldf(RSL(12), fn[t]); bV[t] = ldf(RSL(7), fn[t]); cR[t] = ld4(RSL(2), orm[t]); }
#pragma unroll
                    for (int t = 0; t < 2; ++t) { p1[t] = mm<true>(aMb, bW[t], cR[t]); y0[t] = mm<true>(aMk, bV[t], mm<true>(aMb, bU[t], z4)); } }
                {   const Fr2 aW = ldf(RSL(11), fm), aU = ldf(RSL(12), fm), aV = ldf(RSL(7), fm); Fr2 bBh[2], bKh[2];
#pragma unroll
                    for (int t = 0; t < 2; ++t) { bBh[t] = ldf(RSL(5), fn[t]); bKh[t] = ldf(RSL(6), fn[t]); }
#pragma unroll
                    for (int t = 0; t < 2; ++t) { gt[t] = mm<false>(aW, bBh[t], z4); hh[t] = mm<true>(aV, bKh[t], mm<true>(aU, bBh[t], z4)); } }
#pragma unroll
                for (int t = 0; t < 2; ++t) { const int n0 = n0a + 16 * t; u32x2g q;
                    q.x = pkbf(p1[t][0], p1[t][1]); q.y = pkbf(p1[t][2], p1[t][3]); *(u32x2g*)(X.P1 + jo + (m0 + fr) * 64 + n0 + 4 * fq) = q;
                    q.x = pkbf(gt[t][0], gt[t][1]); q.y = pkbf(gt[t][2], gt[t][3]); *(u32x2g*)(X.GT + jo + (n0 + fr) * 64 + m0 + 4 * fq) = q;
                    q.x = pkbf(y0[t][0], y0[t][1]); q.y = pkbf(y0[t][2], y0[t][3]); *(u32x2g*)(X.Y0 + jo + ((w * 2 + t) * 64 + lane) * 4) = q;
                    q.x = pkbf(hh[t][0], hh[t][1]); q.y = pkbf(hh[t][2], hh[t][3]); *(u32x2g*)(X.H + jo + ((w * 2 + t) * 64 + lane) * 4) = q; }
                v4u wv; wv.x = pkbf(bon * v[0], bon * v[1]); wv.y = pkbf(bon * v[2], bon * v[3]); wv.z = pkbf(bon * v[4], bon * v[5]); wv.w = pkbf(bon * v[6], bon * v[7]);
                bf16* vbp = (job < 2048) ? (X.VB0 + jo) : (X.VB1 + (jo - (size_t)2048 * 4096));
                *(v4u*)(vbp + tok * 64 + 8 * dg) = wv;
            }
            __syncthreads();
        }
    }
}
__device__ __forceinline__ void p6b_rwkv_seq(Frame& F, const RwArgs& A, const RwX& X, int nwg) {
    using namespace rwk;
    LAS unsigned char* lds = F.lds + RING_OFF;
    LAS float* Yf = (LAS float*)RSL(3);
    const int tid = F.tid, tok = tid >> 3, dg = tid & 7, lane = F.lane, fr = lane & 15, fq = lane >> 4;
    const int w = F.wave, m0 = 16 * (w >> 1), n0a = 32 * (w & 1);
    const int fm = (m0 + fr) * LD + fq * 16;
    int fn[2], orm[2];
#pragma unroll
    for (int t = 0; t < 2; ++t) { const int n0 = n0a + 16 * t; fn[t] = (n0 + fr) * LD + fq * 16; orm[t] = (m0 + fr) * LD + (n0 + 4 * fq) * 2; }
    for (int unit = blockIdx.x; unit < BATCH * NH; unit += nwg) {
        const int b = unit >> 3, h = unit & 7; const int cb = 64 * h + 8 * dg;
        f32x4 sacc[2]; sacc[0] = (f32x4){0.f, 0.f, 0.f, 0.f}; sacc[1] = sacc[0];
        for (int u = tid; u < SLOT / 4; u += NWAVES * 64) ((LAS unsigned*)RSL(14))[u] = 0u;
        float lnw[8], lnb[8]; ld8f(A.ln_w + cb, lnw); ld8f(A.ln_b + cb, lnb);
        v4u n_p1, n_gt, n_vb, n_g; u32x2g n_y0[2], n_h[2]; f32x4 n_ge[2];
#define P6B_LOAD(cc) do { const int job_ = unit * 32 + (cc); const size_t jo_ = (size_t)job_ * 4096; const size_t grow_ = (size_t)b * SEQ + (cc) * 64 + tok; \
            n_p1 = *(const v4u*)(X.P1 + jo_ + tid * 8); n_gt = *(const v4u*)(X.GT + jo_ + tid * 8); \
            _Pragma("unroll") for (int t = 0; t < 2; ++t) { n_y0[t] = *(const u32x2g*)(X.Y0 + jo_ + ((w * 2 + t) * 64 + lane) * 4); n_h[t] = *(const u32x2g*)(X.H + jo_ + ((w * 2 + t) * 64 + lane) * 4); \
                n_ge[t] = *(const f32x4*)(X.GE + (size_t)job_ * 64 + n0a + 16 * t + 4 * fq); } \
            const bf16* vbp_ = (job_ < 2048) ? (X.VB0 + jo_) : (X.VB1 + (jo_ - (size_t)2048 * 4096)); \
            n_vb = *(const v4u*)(vbp_ + tok * 64 + 8 * dg); n_g = *(const v4u*)(A.GB + grow_ * 512 + cb); } while (0)
        P6B_LOAD(0);
        for (int c = 0; c < SEQ / 64; ++c) {
            const int scur = 14 + (c & 1), snxt = 15 - (c & 1);
            const size_t grow = (size_t)b * SEQ + c * 64 + tok;
            *(LAS v4u*)(RSL(0) + tok * LD + dg * 16) = n_p1; *(LAS v4u*)(RSL(13) + tok * LD + dg * 16) = n_gt;
            f32x4 yacc[2], hcur[2], gecur[2];
#pragma unroll
            for (int t = 0; t < 2; ++t) { yacc[t] = (f32x4){bflo(n_y0[t].x), bfhi(n_y0[t].x), bflo(n_y0[t].y), bfhi(n_y0[t].y)}; hcur[t] = (f32x4){bflo(n_h[t].x), bfhi(n_h[t].x), bflo(n_h[t].y), bfhi(n_h[t].y)}; gecur[t] = n_ge[t]; }
            const v4u vbw = n_vb, gw = n_g;
            if (c + 1 < SEQ / 64) P6B_LOAD(c + 1);
            __syncthreads();
            {   const Fr2 aP1 = ldf(RSL(0), fm), aS = ldf(RSL(scur), fm); Fr2 bS[2], bG[2];
#pragma unroll
                for (int t = 0; t < 2; ++t) { bS[t] = ldf(RSL(scur), fn[t]); bG[t] = ldf(RSL(13), fn[t]); }
#pragma unroll
                for (int t = 0; t < 2; ++t) { yacc[t] = mm<true>(aP1, bS[t], yacc[t]); sacc[t] = mm<true>(aS, bG[t], sacc[t] * gecur[t] + hcur[t]); }
#pragma unroll
                for (int t = 0; t < 2; ++t) { const int n0 = n0a + 16 * t; *(LAS f32x4*)(Yf + (m0 + fr) * 64 + n0 + 4 * fq) = yacc[t]; st4(RSL(snxt), orm[t], sacc[t]); } }
            __syncthreads();
            {
                float y[8];
                ld8l(Yf + tok * 64 + 8 * dg, y);
                const float g[8] = {bflo(gw.x), bfhi(gw.x), bflo(gw.y), bfhi(gw.y), bflo(gw.z), bfhi(gw.z), bflo(gw.w), bfhi(gw.w)};
                const float vb[8] = {bflo(vbw.x), bfhi(vbw.x), bflo(vbw.y), bfhi(vbw.y), bflo(vbw.z), bfhi(vbw.z), bflo(vbw.w), bfhi(vbw.w)};
                float s = 0.f;
#pragma unroll
                for (int j = 0; j < 8; ++j) s += y[j];
                const float mean = sum8(s) * (1.0f / 64.0f); float q = 0.f;
#pragma unroll
                for (int j = 0; j < 8; ++j) { y[j] -= mean; q += y[j] * y[j]; }
                const float rstd = __builtin_amdgcn_rsqf(sum8(q) * (1.0f / 64.0f) + LNX_EPS);
                float ov[8];
#pragma unroll
                for (int j = 0; j < 8; ++j) ov[j] = (y[j] * rstd * lnw[j] + lnb[j] + vb[j]) * g[j];
                v4u wv; wv.x = pkbf(ov[0], ov[1]); wv.y = pkbf(ov[2], ov[3]); wv.z = pkbf(ov[4], ov[5]); wv.w = pkbf(ov[6], ov[7]);
                *(GAS v4u*)(A.QO + grow * D + 512 + cb) = wv;
            }
        }
#undef P6B_LOAD
        __syncthreads();
    }
}

namespace sba {
using bf16x8 = __attribute__((ext_vector_type(8))) short;
using s16x4 = __attribute__((ext_vector_type(4))) short;
using f32x16 = __attribute__((ext_vector_type(16))) float;
using u32x4 = __attribute__((ext_vector_type(4))) unsigned;
constexpr int QB = 256, KVBLK = 64;
constexpr int LDS_K = 0, LDS_V = 16384, LDS_ST = 32768, ST_LD = 68, LDS_FLAG = LDS_ST + 8 * 32 * ST_LD * 4, LDS_BYTES_ATT = LDS_FLAG + 64;
constexpr float R_DEAD = -160.0f;
#define SBAR() __builtin_amdgcn_sched_barrier(0)
typedef float f32x2_t __attribute__((ext_vector_type(2))); typedef __bf16 bf16x2_t __attribute__((ext_vector_type(2)));
__device__ __forceinline__ unsigned cvtpk_s(float lo, float hi) { f32x2_t v = {lo, hi}; bf16x2_t b = __builtin_convertvector(v, bf16x2_t); return __builtin_bit_cast(unsigned, b); }
__device__ __forceinline__ void qkt(f32x16& p0, f32x16& p1, const char* Kslot, const bf16x8* qr, int r32, int hi) {
    const char* kb = Kslot + hi * 1024 + r32 * 16;
    const f32x16 z = f32x16{};
#pragma unroll
    for (int d0 = 0; d0 < 4; ++d0) {
        const bf16x8 b0 = *reinterpret_cast<const bf16x8*>(kb + d0 * 2048);
        const bf16x8 b1 = *reinterpret_cast<const bf16x8*>(kb + d0 * 2048 + 512);
        if (d0 == 0) { p0 = __builtin_amdgcn_mfma_f32_32x32x16_bf16(b0, qr[0], z, 0, 0, 0); p1 = __builtin_amdgcn_mfma_f32_32x32x16_bf16(b1, qr[0], z, 0, 0, 0); }
        else { p0 = __builtin_amdgcn_mfma_f32_32x32x16_bf16(b0, qr[d0], p0, 0, 0, 0); p1 = __builtin_amdgcn_mfma_f32_32x32x16_bf16(b1, qr[d0], p1, 0, 0, 0); }
    }
}
__device__ __forceinline__ void pv(f32x16* o, int vb, bf16x8 pa0, bf16x8 pa1, bf16x8 pa2, bf16x8 pa3) {
#pragma unroll
    for (int d0 = 0; d0 < 2; ++d0) { s16x4 lo[4], hi[4];
#pragma unroll
        for (int ks = 0; ks < 4; ++ks) {
            asm volatile("ds_read_b64_tr_b16 %0,%1 offset:%c2" : "=&v"(lo[ks]) : "v"(vb), "i"(d0 * 4096 + ks * 1024) : "memory");
            asm volatile("ds_read_b64_tr_b16 %0,%1 offset:%c2" : "=&v"(hi[ks]) : "v"(vb), "i"(d0 * 4096 + ks * 1024 + 512) : "memory"); }
        asm volatile("s_waitcnt lgkmcnt(0)" ::: "memory"); SBAR();
#define PK(k) (bf16x8){lo[k][0], lo[k][1], lo[k][2], lo[k][3], hi[k][0], hi[k][1], hi[k][2], hi[k][3]}
        o[d0] = __builtin_amdgcn_mfma_f32_32x32x16_bf16(pa0, PK(0), o[d0], 0, 0, 0);
        o[d0] = __builtin_amdgcn_mfma_f32_32x32x16_bf16(pa1, PK(1), o[d0], 0, 0, 0);
        o[d0] = __builtin_amdgcn_mfma_f32_32x32x16_bf16(pa2, PK(2), o[d0], 0, 0, 0);
        o[d0] = __builtin_amdgcn_mfma_f32_32x32x16_bf16(pa3, PK(3), o[d0], 0, 0, 0);
#undef PK
    }
}
__device__ __forceinline__ float swap_sum(float x, float& other_if_lo, int hi) {
    auto rr = __builtin_amdgcn_permlane32_swap(__float_as_uint(x), __float_as_uint(x), false, false);
    const float a = __uint_as_float(rr[0]), b = __uint_as_float(rr[1]);
    other_if_lo = hi ? 0.f : b;
    return a + b;
}
__device__ __forceinline__ void attn_unit(int b, int h, int qb, bf16* QO, const bf16* __restrict__ KB, const bf16* __restrict__ VB, const float* gout, char* shm) {
    const int tid = threadIdx.x, lane = tid & 63, r32 = lane & 31, hi = lane >> 5; const int wid = __builtin_amdgcn_readfirstlane(tid >> 6);
    const long rowbase = (long)b * SEQ; const int q0 = qb * QB;
    bf16* Qw = QO + (rowbase + q0 + wid * 32) * D + h * HD;
    const bf16* Kh = KB + rowbase * SBW + h * HD; const bf16* Vh = VB + rowbase * SBW + h * HD;
    const unsigned lds0 = (unsigned)(uintptr_t)shm;
    const int NT = 4 * qb + 4, jtop = 4 * qb + (wid >> 1);
    const bf16* ksrc = Kh + (long)lane * SBW + wid * 8;
    const bf16* vsrc = Vh + (long)(16 * (wid & 3) + (lane >> 2)) * SBW + (wid >> 2) * 32 + (lane & 3) * 8;
    char* kdst = shm + LDS_K + wid * 1024 + lane * 16; char* vdst = shm + LDS_V + wid * 1024 + lane * 16;
    const int vb0 = (int)(lds0 + LDS_V) + ((lane >> 4) & 1) * 32 + (lane & 3) * 8 + (4 * hi + ((lane & 15) >> 2)) * 64;
    bf16x8 qr[4];
#pragma unroll
    for (int d0 = 0; d0 < 4; ++d0) qr[d0] = *reinterpret_cast<const bf16x8*>(&Qw[(long)r32 * D + d0 * 16 + hi * 8]);
    u32x4 kreg = *(const u32x4*)(ksrc + (long)(NT - 1) * KVBLK * SBW), vreg = *(const u32x4*)(vsrc + (long)(NT - 1) * KVBLK * SBW);
    *(u32x4*)kdst = kreg; *(u32x4*)vdst = vreg;
    __syncthreads();
    float R = 0.f; f32x16 o[2]; o[0] = f32x16{}; o[1] = f32x16{};
    bool wdone = false; unsigned* flg = (unsigned*)(shm + LDS_FLAG);
    const int qrow = q0 + wid * 32 + r32;
    for (int jt = NT - 1; jt >= 0; --jt) {
        const int cur = (NT - 1 - jt) & 1;
        if (jt > 0) { kreg = *(const u32x4*)(ksrc + (long)(jt - 1) * KVBLK * SBW); vreg = *(const u32x4*)(vsrc + (long)(jt - 1) * KVBLK * SBW); }
        if (jt <= jtop && !wdone) {
            f32x16 p0, p1;
            qkt(p0, p1, shm + LDS_K + cur * 8192, qr, r32, hi);
            f32x16 lb0, lb1;
            const int kb = 64 * jt + 4 * hi; const bool diag = (jt == jtop);
#pragma unroll
            for (int r = 0; r < 16; ++r) {
                { const float z = p0[r]; const float L = __builtin_amdgcn_logf(1.0f + __builtin_amdgcn_exp2f(z)); float lb = z - L; float l1 = -L;
                  if (diag) { const int key = kb + (r & 3) + 8 * (r >> 2); if (key >= qrow) { l1 = 0.f; lb = -1e30f; } }
                  lb0[r] = lb; p0[r] = l1; }
                { const float z = p1[r]; const float L = __builtin_amdgcn_logf(1.0f + __builtin_amdgcn_exp2f(z)); float lb = z - L; float l1 = -L;
                  if (diag) { const int key = kb + 32 + (r & 3) + 8 * (r >> 2); if (key >= qrow) { l1 = 0.f; lb = -1e30f; } }
                  lb1[r] = lb; p1[r] = l1; }
            }
            float c0[4], c1[4], x0[4], x1[4];
#pragma unroll
            for (int g = 0; g < 4; ++g) {
                const float s0 = (p0[4 * g] + p0[4 * g + 1]) + (p0[4 * g + 2] + p0[4 * g + 3]);
                const float s1 = (p1[4 * g] + p1[4 * g + 1]) + (p1[4 * g + 2] + p1[4 * g + 3]);
                c0[g] = swap_sum(s0, x0[g], hi); c1[g] = swap_sum(s1, x1[g], hi);
            }
            float suf0[4], suf1[4];
            suf1[3] = R; suf1[2] = suf1[3] + c1[3]; suf1[1] = suf1[2] + c1[2]; suf1[0] = suf1[1] + c1[1];
            suf0[3] = suf1[0] + c1[0]; suf0[2] = suf0[3] + c0[3]; suf0[1] = suf0[2] + c0[2]; suf0[0] = suf0[1] + c0[1];
            R = suf0[0] + c0[0];
#pragma unroll
            for (int g = 0; g < 4; ++g) {
                { const float e3 = suf0[g] + x0[g], e2 = e3 + p0[4 * g + 3], e1 = e2 + p0[4 * g + 2], e0 = e1 + p0[4 * g + 1];
                  p0[4 * g + 3] = __builtin_amdgcn_exp2f(lb0[4 * g + 3] + e3); p0[4 * g + 2] = __builtin_amdgcn_exp2f(lb0[4 * g + 2] + e2);
                  p0[4 * g + 1] = __builtin_amdgcn_exp2f(lb0[4 * g + 1] + e1); p0[4 * g] = __builtin_amdgcn_exp2f(lb0[4 * g] + e0); }
                { const float e3 = suf1[g] + x1[g], e2 = e3 + p1[4 * g + 3], e1 = e2 + p1[4 * g + 2], e0 = e1 + p1[4 * g + 1];
                  p1[4 * g + 3] = __builtin_amdgcn_exp2f(lb1[4 * g + 3] + e3); p1[4 * g + 2] = __builtin_amdgcn_exp2f(lb1[4 * g + 2] + e2);
                  p1[4 * g + 1] = __builtin_amdgcn_exp2f(lb1[4 * g + 1] + e1); p1[4 * g] = __builtin_amdgcn_exp2f(lb1[4 * g] + e0); }
            }
#define PKW(P, B) cvtpk_s(P[B], P[B + 1])
            const u32x4 pw0 = (u32x4){PKW(p0, 0), PKW(p0, 2), PKW(p0, 4), PKW(p0, 6)}, pw1 = (u32x4){PKW(p0, 8), PKW(p0, 10), PKW(p0, 12), PKW(p0, 14)};
            const u32x4 pw2 = (u32x4){PKW(p1, 0), PKW(p1, 2), PKW(p1, 4), PKW(p1, 6)}, pw3 = (u32x4){PKW(p1, 8), PKW(p1, 10), PKW(p1, 12), PKW(p1, 14)};
#undef PKW
            SBAR();
            pv(o, vb0 + cur * 8192, __builtin_bit_cast(bf16x8, pw0), __builtin_bit_cast(bf16x8, pw1), __builtin_bit_cast(bf16x8, pw2), __builtin_bit_cast(bf16x8, pw3));
            wdone = __all(R < R_DEAD) != 0;
        }
        if (jt > 0) { *(u32x4*)(kdst + (cur ^ 1) * 8192) = kreg; *(u32x4*)(vdst + (cur ^ 1) * 8192) = vreg; }
        if (lane == 0) flg[cur * 8 + wid] = wdone ? 1u : 0u;
        __syncthreads();
        { const u32x4 f0 = *(const u32x4*)(flg + cur * 8), f1 = *(const u32x4*)(flg + cur * 8 + 4);
          if ((f0.x & f0.y & f0.z & f0.w & f1.x & f1.y & f1.z & f1.w) != 0u) break; }
    }
    {
        float* stg = (float*)(shm + LDS_ST) + wid * (32 * ST_LD);
#pragma unroll
        for (int r = 0; r < 16; ++r) { const int orow = (r & 3) + 8 * (r >> 2) + 4 * hi;
#pragma unroll
            for (int d0 = 0; d0 < 2; ++d0) stg[orow * ST_LD + d0 * 32 + r32] = o[d0][r]; }
        asm volatile("s_waitcnt lgkmcnt(0)" ::: "memory");
        const int ch = lane & 7;
        const f32x4 ga = *(const f32x4*)(gout + h * HD + ch * 8), gb = *(const f32x4*)(gout + h * HD + ch * 8 + 4);
#pragma unroll
        for (int i = 0; i < 4; ++i) { const int row = i * 8 + (lane >> 3);
            const f32x4 a = *(const f32x4*)(stg + row * ST_LD + ch * 8), c = *(const f32x4*)(stg + row * ST_LD + ch * 8 + 4);
            float ss = (a.x * a.x + a.y * a.y) + (a.z * a.z + a.w * a.w) + (c.x * c.x + c.y * c.y) + (c.z * c.z + c.w * c.w);
            ss = sum8(ss);
            const float hs = __builtin_amdgcn_rsqf(ss * (1.0f / 64.0f) + 1e-6f);
            u32x4 w; w.x = cvtpk_s(a.x * hs * ga.x, a.y * hs * ga.y); w.y = cvtpk_s(a.z * hs * ga.z, a.w * hs * ga.w);
            w.z = cvtpk_s(c.x * hs * gb.x, c.y * hs * gb.y); w.w = cvtpk_s(c.z * hs * gb.z, c.w * hs * gb.w);
            *(u32x4*)(Qw + (long)row * D + ch * 8) = w; }
        asm volatile("s_waitcnt lgkmcnt(0)" ::: "memory");
    }
}
#undef SBAR
__device__ __forceinline__ void attn_phase(Frame& F, bf16* QO, const bf16* KB, const bf16* VB, const float* gout) {
    char* shm = (char*)F.lds + RING_OFF;
    if (F.G == 256) {
        const int v = F.vcu, bh = v >> 1, odd = v & 1;
        for (int i = 0; i < 4; ++i) { const int qb = odd ? ((i == 0) ? 1 : (i == 1) ? 6 : (i == 2) ? 3 : 4) : ((i == 0) ? 0 : (i == 1) ? 7 : (i == 2) ? 2 : 5);
            attn_unit(bh >> 3, bh & 7, qb, QO, KB, VB, gout, shm); }
    } else {
        for (int id = blockIdx.x; id < BATCH * NH * 8; id += F.G) attn_unit(id >> 6, (id >> 3) & 7, id & 7, QO, KB, VB, gout, shm);
    }
}
}

struct Args { const float* in[26]; float* out; unsigned char* ws; int ph_lo, ph_hi, li, pad; };
__global__ void __launch_bounds__(NWAVES * 64, 2) skel_fwd(Args args) {
    extern __shared__ __attribute__((aligned(16))) unsigned char lds[];
    Frame F;
    F.lds = (LAS unsigned char*)lds;
    F.MISC = (volatile LAS unsigned*)(F.lds + MISC_OFF);
    F.tid = threadIdx.x; F.lane = F.tid & 63; F.wave = __builtin_amdgcn_readfirstlane(F.tid >> 6);
    F.G = gridDim.x; { const int bx = blockIdx.x; F.vcu = (F.G % 8 == 0) ? (bx % 8) * (F.G / 8) + bx / 8 : bx; }
    unsigned char* ws = args.ws;
    F.ctl = (gu32*)(ws + WS_CTL);
    const float* x = args.in[0];
    bf16* W1U = (bf16*)(ws + WS_W1U); bf16* W1D = (bf16*)(ws + WS_W1D); bf16* W2U = (bf16*)(ws + WS_W2U); bf16* W2D = (bf16*)(ws + WS_W2D);
    bf16* WIN = (bf16*)(ws + WS_WIN); bf16* WOUT = (bf16*)(ws + WS_WOUT); bf16* WLORA = (bf16*)(ws + WS_WLORA);
    bf16* XB = (bf16*)(ws + WS_XB); bf16* ACT = (bf16*)(ws + WS_ACT); bf16* QO = (bf16*)(ws + WS_QO); bf16* KB = (bf16*)(ws + WS_KB); bf16* VB = (bf16*)(ws + WS_VB);
    bf16* RW = (bf16*)(ws + WS_RW); bf16* ALORA = (bf16*)(ws + WS_ALORA); float* LW = (float*)(ws + WS_LW); bf16* AB = (bf16*)(ws + WS_AB); bf16* GB = (bf16*)(ws + WS_GB);
    float* SSQ = (float*)(ws + WS_SSQ); float* out = args.out;
    for (int u = F.tid; u < (LDS_BYTES - LDSCTL_OFF) / 4; u += NWAVES * 64) ((LAS unsigned*)(F.lds + LDSCTL_OFF))[u] = 0u;
    __syncthreads();
    XcdBarrier bar; bar.bar = (unsigned*)(F.ctl + CW_BAR); bar.x = 0; bar.st = nullptr;
    if (N_LAUNCHES != PER_PHASE) bar = xcd_barrier_post((unsigned*)(F.ctl + CW_BAR), F.MISC + 8);
#define GRID_BAR(seam) do { if (N_LAUNCHES == PER_PHASE) { if (F.tid == 0) __hip_atomic_store(F.ctl + CW_TMO, 0xBADBA0u | (unsigned)(seam), RLX_AGENT); } else { xcd_barrier(bar); } } while (0)
    const int lo = args.ph_lo, hi = args.ph_hi;
#define IN(k) (lo <= (k) && (k) < hi)
#define BOTH(k) (IN(k) && IN((k) + 1))
    if (IN(0)) {
        p0_prologue(F, x, args.in[1], args.in[2], args.in[3], args.in[4], args.in[5], args.in[6], args.in[12], args.in[14], args.in[15], args.in[21], args.in[22], args.in[23], args.in[24], args.in[25],
                    W1U, W1D, W2U, W2D, WIN, WOUT, WLORA, XB, SSQ); if (BOTH(0)) GRID_BAR(0);
    }
    if (IN(1)) {
        pg8::Gemm g{XB, W1U, M, 2 * FF, D}; pg8::StaticOrder S; S.init(M, 2 * FF, F.G, (int)blockIdx.x);
        pg8::EpiSwiGLU E{ACT, FF, SSQ};
        pg8::gemm_phase<pg8::EpiSwiGLU, pg8::StaticOrder, true, true>(F.lds + RING_OFF, g, S, E);
        if (BOTH(1)) GRID_BAR(1);
    }
    if (IN(2)) {
        pg8::Gemm g{ACT, W1D, M, D, FF}; pg8::StaticOrder S; S.init(M, D, F.G, (int)blockIdx.x);
        pg8::EpiResid E{x, out, XB, SSQ, 0.5f, 1};
        pg8::gemm_phase<pg8::EpiResid, pg8::StaticOrder, true, true>(F.lds + RING_OFF, g, S, E);
        if (BOTH(2)) GRID_BAR(2);
    }
    if (IN(3)) {
        pg8::Gemm g{XB, WIN, M, PW, D}; pg8::StaticOrder S; S.init(M, PW, F.G, (int)blockIdx.x);
        pg8::EpiWin E{QO, KB, VB, RW, SSQ, args.in[7], args.in[8], 0.125f * 1.4426950408889634f};
        pg8::gemm_phase<pg8::EpiWin, pg8::StaticOrder, true, true>(F.lds + RING_OFF, g, S, E);
        if (BOTH(3)) GRID_BAR(3);
    }
    if (IN(4)) { p4_lora_prep(F, RW, args.in[10], ALORA); if (BOTH(4)) GRID_BAR(4); }
    if (IN(5)) {
        int kl = LORA_K; asm volatile("" : "+s"(kl));
        pg8::Gemm g{ALORA, WLORA, M, LORA_N, kl}; pg8::StaticOrder S; S.init(M, LORA_N, F.G, (int)blockIdx.x);
        pg8::EpiLora E{LW, AB, GB, args.in[11], args.in[13]};
        pg8::gemm_phase<pg8::EpiLora, pg8::StaticOrder, true, true>(F.lds + RING_OFF, g, S, E);
        if (BOTH(5)) GRID_BAR(5);
    }
    if (IN(6)) {
        sba::attn_phase(F, QO, KB, VB, args.in[9]);
        if (BOTH(6)) GRID_BAR(6);
    }
    if (IN(7)) {
        RwArgs A{RW, LW, AB, GB, QO, args.in[10], args.in[16], args.in[17], args.in[18], args.in[19], args.in[20]};
        RwX X{KB, VB, XB, XB + (size_t)16 * 1024 * 1024, ALORA, (bf16*)(ws + WS_TAIL), SSQ};
        p6a_rwkv_local(F, A, X);
        GRID_BAR(16);
        p6b_rwkv_seq(F, A, X, F.G);
        __syncthreads();
        if (BOTH(7)) GRID_BAR(7);
    }
    if (IN(8)) {
        pg8::Gemm g{QO, WOUT, M, D, D}; pg8::StaticOrder S; S.init(M, D, F.G, (int)blockIdx.x);
        pg8::EpiResid E{out, out, XB, SSQ, 1.0f, 1};
        pg8::gemm_phase<pg8::EpiResid, pg8::StaticOrder, true, true>(F.lds + RING_OFF, g, S, E);
        if (BOTH(8)) GRID_BAR(8);
    }
    if (IN(9)) {
        pg8::Gemm g{XB, W2U, M, 2 * FF, D}; pg8::StaticOrder S; S.init(M, 2 * FF, F.G, (int)blockIdx.x);
        pg8::EpiSwiGLU E{ACT, FF, SSQ};
        pg8::gemm_phase<pg8::EpiSwiGLU, pg8::StaticOrder, true, true>(F.lds + RING_OFF, g, S, E);
        if (BOTH(9)) GRID_BAR(9);
    }
    if (IN(10)) {
        pg8::Gemm g{ACT, W2D, M, D, FF}; pg8::StaticOrder S; S.init(M, D, F.G, (int)blockIdx.x);
        pg8::EpiResid E{out, out, XB, SSQ, 0.5f, 0};
        pg8::gemm_phase<pg8::EpiResid, pg8::StaticOrder, true, true>(F.lds + RING_OFF, g, S, E);
    }
#undef IN
#undef BOTH
}

extern "C" void kernel_launch(void* const* d_in, const int* in_sizes, int n_in, void* d_out, int out_size, void* d_ws, size_t ws_size, hipStream_t stream) {
    static int grid = 0;
    if (grid == 0) {
        if (n_in != 26 || in_sizes[0] != M * D || out_size != M * D || ws_size < WS_END) { fprintf(stderr, "kernel_launch: unexpected shapes: n_in %d in0 %d out %d ws %zu (need %zu)\n", n_in, n_in > 0 ? in_sizes[0] : -1, out_size, ws_size, (size_t)WS_END); grid = -1; return; }
        int dev = 0, cus = 0, per_cu = 0;
        if (hipGetDevice(&dev) != hipSuccess || hipDeviceGetAttribute(&cus, hipDeviceAttributeMultiprocessorCount, dev) != hipSuccess) { grid = -1; return; }
        if (hipFuncSetAttribute((const void*)skel_fwd, hipFuncAttributeMaxDynamicSharedMemorySize, LDS_BYTES) != hipSuccess) { fprintf(stderr, "kernel_launch: hipFuncSetAttribute failed\n"); grid = -1; return; }
        if (hipOccupancyMaxActiveBlocksPerMultiprocessor(&per_cu, (const void*)skel_fwd, NWAVES * 64, LDS_BYTES) != hipSuccess || per_cu < 1) { fprintf(stderr, "kernel_launch: occupancy query reports %d blocks per CU\n", per_cu); per_cu = 1; }
        (void)hipGetLastError();
        grid = cus;
    }
    if (grid < 0) return;
    if (hipMemsetAsync((char*)d_ws + WS_CTL, 0, CTL_ZERO_BYTES, stream) != hipSuccess) return;
    Args a{};
    for (int i = 0; i < 26; ++i) a.in[i] = (const float*)d_in[i];
    a.out = (float*)d_out; a.ws = (unsigned char*)d_ws;
    for (int li = 0; li < N_LAUNCHES; ++li) {
        a.ph_lo = (N_LAUNCHES == PER_PHASE) ? li : 0; a.ph_hi = (N_LAUNCHES == PER_PHASE) ? li + 1 : PER_PHASE; a.li = li;
        hipLaunchKernelGGL(skel_fwd, dim3(grid), dim3(NWAVES * 64), LDS_BYTES, stream, a);
    }
}
```

```cpp
#include <hip/hip_runtime.h>
#include <hip/hip_bf16.h>
#include <cstdio>
#include <cstdint>
#include <cmath>
namespace pg8 {
#define PG8_LAS __attribute__((address_space(3)))
typedef unsigned short bf16_t;
typedef short bf16x8 __attribute__((ext_vector_type(8)));
typedef float f32x4 __attribute__((ext_vector_type(4)));
typedef unsigned u32x4 __attribute__((ext_vector_type(4)));
constexpr int BM = 256, BK = 64, HALF = 128, HTB = HALF * BK * 2  , STAGE_BYTES = 8 * HTB, NXCD = 8, WGM = 4;

__host__ __device__ __forceinline__ int lds_byte(int r, int c) { const int st = (r >> 4) * 2 + (c >> 5), rr = r & 15, cc = c & 31, ob = rr * 64 + cc * 2; return st * 1024 + (ob ^ (((ob >> 9) & 1) << 5)); }
__host__ __device__ __forceinline__ void stage_rc(int b, int& R, int& C) { const int st = b / 1024, sb = b % 1024, swz = sb ^ (((sb >> 9) & 1) << 5); R = (st >> 1) * 16 + swz / 64; C = (st & 1) * 32 + (swz % 64) / 2; }
__host__ __device__ __forceinline__ int perm32(int rho) { const int n = rho >> 4, i = rho & 15; return 8 * (i >> 2) + 4 * n + (i & 3); }

struct Unit { int pm, pn; };
struct Gemm { const bf16_t* A; const bf16_t* Bt; int M, N, K; int ld; };

struct StaticOrder {
    int nM, nN, nwg, G, c;
    __host__ __device__ void init(int M, int N, int G_, int c_) { nM = M / BM; nN = N / BM; nwg = nM * nN; G = G_; c = c_; }
    __host__ __device__ bool next(int i, Unit& u) const {
        const long L = (long)i * G + c; if (L >= nwg) return false;
        int wgid = (int)L; { const int q = nwg / NXCD, r = nwg % NXCD, xcd = wgid % NXCD, off = wgid / NXCD; wgid = (xcd < r ? xcd * (q + 1) : r * (q + 1) + (xcd - r) * q) + off; }
        const int nig = WGM * nN, gid = wgid / nig, fm = gid * WGM, gsz = (nM - fm) < WGM ? (nM - fm) : WGM;
        u.pm = fm + ((wgid % nig) % gsz); u.pn = (wgid % nig) / gsz; return true;
    }
    __device__ __forceinline__ void a_ready(const Unit&) const {}
    __device__ __forceinline__ void done(const Unit&) const {}
};


__device__ __forceinline__ unsigned cvt_pk_bf16(float lo, float hi) { unsigned r; asm volatile("v_cvt_pk_bf16_f32 %0, %1, %2" : "=v"(r) : "v"(lo), "v"(hi)); return r; }
typedef unsigned u32x2 __attribute__((ext_vector_type(2)));
constexpr float RMS_EPS_F = 1e-6f;
constexpr float LOG2E_F = 1.4426950408889634f;
__device__ __forceinline__ float row_rs(const float* ssqp, int row) {
    const f32x4* p = (const f32x4*)(ssqp + (size_t)row * 16);
    const f32x4 a = p[0], b = p[1], c = p[2], d = p[3];
    const float s = ((a[0] + a[1]) + (a[2] + a[3])) + ((b[0] + b[1]) + (b[2] + b[3])) + ((c[0] + c[1]) + (c[2] + c[3])) + ((d[0] + d[1]) + (d[2] + d[3]));
    return __builtin_amdgcn_rsqf(s * (1.0f / 1024.0f) + RMS_EPS_F);
}
__device__ __forceinline__ float silu_f(float g) { return g * __builtin_amdgcn_rcpf(1.0f + __builtin_amdgcn_exp2f(-g * LOG2E_F)); }
__device__ __forceinline__ float sigmoid_f(float g) { return __builtin_amdgcn_rcpf(1.0f + __builtin_amdgcn_exp2f(-g * LOG2E_F)); }

struct EpiSwiGLU {
    static constexpr bool PERM = true, AFTER_DRAIN = false;
    bf16_t* O; int ldo; const float* ssqp;
    __device__ __forceinline__ void operator()(const f32x4 (&acc)[2][2][4][2], const Unit& u, int wr, int wc, int fr, int fq) const {
        const int row0 = u.pm * BM + wr * 64 + fr, col0 = u.pn * HALF + wc * 32 + 8 * fq;
#pragma unroll
        for (int ai = 0; ai < 2; ++ai)
#pragma unroll
            for (int m = 0; m < 4; ++m) {
                const int row = row0 + ai * HALF + m * 16; const float rs = row_rs(ssqp, row);
                const f32x4 g0 = acc[ai][0][m][0] * rs, g1 = acc[ai][0][m][1] * rs, u0 = acc[ai][1][m][0] * rs, u1 = acc[ai][1][m][1] * rs;
                u32x4 w;
                w.x = cvt_pk_bf16(silu_f(g0[0]) * u0[0], silu_f(g0[1]) * u0[1]); w.y = cvt_pk_bf16(silu_f(g0[2]) * u0[2], silu_f(g0[3]) * u0[3]);
                w.z = cvt_pk_bf16(silu_f(g1[0]) * u1[0], silu_f(g1[1]) * u1[1]); w.w = cvt_pk_bf16(silu_f(g1[2]) * u1[2], silu_f(g1[3]) * u1[3]);
                *(u32x4*)(O + (size_t)row * ldo + col0) = w;
            }
    }
};

struct EpiResid {
    static constexpr bool PERM = true, AFTER_DRAIN = false;
    const float* base; float* out; bf16_t* xb; float* ssqp; float alpha; int aux;
    __device__ __forceinline__ void operator()(const f32x4 (&acc)[2][2][4][2], const Unit& u, int wr, int wc, int fr, int fq) const {
        const int row0 = u.pm * BM + wr * 64 + fr, col0 = u.pn * BM + wc * 32 + 8 * fq;
#pragma unroll
        for (int ai = 0; ai < 2; ++ai)
#pragma unroll
            for (int m = 0; m < 4; ++m) {
                const int row = row0 + ai * HALF + m * 16; const size_t off = (size_t)row * 1024 + col0; float ss = 0.f;
#pragma unroll
                for (int bj = 0; bj < 2; ++bj) {
                    const f32x4 b0 = *(const f32x4*)(base + off + bj * HALF), b1 = *(const f32x4*)(base + off + bj * HALF + 4);
                    const f32x4 v0 = b0 + acc[ai][bj][m][0] * alpha, v1 = b1 + acc[ai][bj][m][1] * alpha;
                    *(f32x4*)(out + off + bj * HALF) = v0; *(f32x4*)(out + off + bj * HALF + 4) = v1;
                    if (aux) { ss += ((v0[0] * v0[0] + v0[1] * v0[1]) + (v0[2] * v0[2] + v0[3] * v0[3])) + ((v1[0] * v1[0] + v1[1] * v1[1]) + (v1[2] * v1[2] + v1[3] * v1[3]));
                        u32x4 w; w.x = cvt_pk_bf16(v0[0], v0[1]); w.y = cvt_pk_bf16(v0[2], v0[3]); w.z = cvt_pk_bf16(v1[0], v1[1]); w.w = cvt_pk_bf16(v1[2], v1[3]); *(u32x4*)(xb + off + bj * HALF) = w; }
                }
                if (aux) { ss += __shfl_xor(ss, 16); ss += __shfl_xor(ss, 32); if (fq == 0) ssqp[(size_t)row * 16 + u.pn * 4 + wc] = ss; }
            }
    }
};

struct EpiWin {
    static constexpr bool PERM = true, AFTER_DRAIN = false;
    bf16_t* QO; bf16_t* KB; bf16_t* VB; bf16_t* RW; const float* ssqp; const float* gq; const float* gk; float qscale;
    __device__ __forceinline__ void operator()(const f32x4 (&acc)[2][2][4][2], const Unit& u, int wr, int wc, int fr, int fq) const {
        const int row0 = u.pm * BM + wr * 64 + fr; const int pn = u.pn;
        if (pn < 4) {
            const float* gp = (pn < 2) ? gq : gk; const float osc = (pn < 2) ? qscale : 1.0f;
            f32x4 gv[2][2];
#pragma unroll
            for (int bj = 0; bj < 2; ++bj)
#pragma unroll
                for (int n = 0; n < 2; ++n) gv[bj][n] = *(const f32x4*)(gp + 32 * bj + 8 * fq + 4 * n) * osc;
            bf16_t* dst = (pn < 2) ? QO : KB; const int ld = (pn < 2) ? 1024 : 512; const int colh = 64 * (4 * (pn & 1) + wc) + 8 * fq;
#pragma unroll
            for (int ai = 0; ai < 2; ++ai)
#pragma unroll
                for (int m = 0; m < 4; ++m) {
                    const int row = row0 + ai * HALF + m * 16; const float rs = row_rs(ssqp, row);
                    f32x4 y[2][2]; float ss = 0.f;
#pragma unroll
                    for (int bj = 0; bj < 2; ++bj)
#pragma unroll
                        for (int n = 0; n < 2; ++n) { y[bj][n] = acc[ai][bj][m][n] * rs; const f32x4 t = y[bj][n]; ss += (t[0] * t[0] + t[1] * t[1]) + (t[2] * t[2] + t[3] * t[3]); }
                    ss += __shfl_xor(ss, 16); ss += __shfl_xor(ss, 32);
                    const float hs = __builtin_amdgcn_rsqf(ss * (1.0f / 64.0f) + RMS_EPS_F);
#pragma unroll
                    for (int bj = 0; bj < 2; ++bj) {
                        const f32x4 a = y[bj][0] * gv[bj][0] * hs, b = y[bj][1] * gv[bj][1] * hs;
                        u32x4 w; w.x = cvt_pk_bf16(a[0], a[1]); w.y = cvt_pk_bf16(a[2], a[3]); w.z = cvt_pk_bf16(b[0], b[1]); w.w = cvt_pk_bf16(b[2], b[3]);
                        *(u32x4*)(dst + (size_t)row * ld + colh + 32 * bj) = w;
                    }
                }
        } else {
            bf16_t* dst = (pn < 6) ? VB : RW; const int ld = (pn < 6) ? 512 : 1792; const int colh = 256 * ((pn < 6) ? (pn - 4) : (pn - 6)) + 64 * wc + 8 * fq;
#pragma unroll
            for (int ai = 0; ai < 2; ++ai)
#pragma unroll
                for (int m = 0; m < 4; ++m) {
                    const int row = row0 + ai * HALF + m * 16; const float rs = row_rs(ssqp, row);
#pragma unroll
                    for (int bj = 0; bj < 2; ++bj) {
                        const f32x4 a = acc[ai][bj][m][0] * rs, b = acc[ai][bj][m][1] * rs;
                        u32x4 w; w.x = cvt_pk_bf16(a[0], a[1]); w.y = cvt_pk_bf16(a[2], a[3]); w.z = cvt_pk_bf16(b[0], b[1]); w.w = cvt_pk_bf16(b[2], b[3]);
                        *(u32x4*)(dst + (size_t)row * ld + colh + 32 * bj) = w;
                    }
                }
        }
    }
};

struct EpiLora {
    static constexpr bool PERM = true, AFTER_DRAIN = false;
    float* LW; bf16_t* AB; bf16_t* GB; const float* w0; const float* a0;
    __device__ __forceinline__ void operator()(const f32x4 (&acc)[2][2][4][2], const Unit& u, int wr, int wc, int fr, int fq) const {
        const int row0 = u.pm * BM + wr * 64 + fr; const int pn = u.pn; const int colt = 256 * (pn & 1) + wc * 32 + 8 * fq;
        const int kind = pn >> 1;
        const float* bp = (kind == 0) ? w0 : a0;
        bf16_t* ob = (kind == 1) ? AB : GB;
#pragma unroll
        for (int bj = 0; bj < 2; ++bj) {
            f32x4 b0 = (f32x4){0.f, 0.f, 0.f, 0.f}, b1 = b0;
            if (kind < 2) { b0 = *(const f32x4*)(bp + colt + bj * HALF); b1 = *(const f32x4*)(bp + colt + bj * HALF + 4); }
#pragma unroll
            for (int ai = 0; ai < 2; ++ai)
#pragma unroll
                for (int m = 0; m < 4; ++m) {
                    const int row = row0 + ai * HALF + m * 16;
                    f32x4 a = acc[ai][bj][m][0] + b0, b = acc[ai][bj][m][1] + b1;
                    if (kind < 2) {
#pragma unroll
                        for (int i = 0; i < 4; ++i) { a[i] = sigmoid_f(a[i]); b[i] = sigmoid_f(b[i]); }
                    }
                    if (kind == 0) { a = a * (-0.6065306597126334f); b = b * (-0.6065306597126334f);
                        float* p = LW + (size_t)row * 512 + colt + bj * HALF; *(f32x4*)p = a; *(f32x4*)(p + 4) = b; }
                    else { u32x4 w; w.x = cvt_pk_bf16(a[0], a[1]); w.y = cvt_pk_bf16(a[2], a[3]); w.z = cvt_pk_bf16(b[0], b[1]); w.w = cvt_pk_bf16(b[2], b[3]);
                        *(u32x4*)(ob + (size_t)row * 512 + colt + bj * HALF) = w; }
                    if (m & 1) asm volatile("" ::: "memory");
                }
        }
    }
};
template <class Epi, class Sched, bool ALIGN_EPI = false, bool SP2 = false>
__device__ __forceinline__ void gemm_phase(PG8_LAS unsigned char* lds, const Gemm g, const Sched& S, const Epi& E) {
    const int tid = threadIdx.x, wid = __builtin_amdgcn_readfirstlane(tid >> 6), lane = tid & 63, wr = wid >> 2, wc = wid & 3, fr = lane & 15, fq = lane >> 4;
    const int K = g.K, nt = K / BK, LDP = g.ld ? g.ld : g.K;
    unsigned voffA[2], voffB[2];
#pragma unroll
    for (int i = 0; i < 2; ++i) { int R, C; stage_rc(tid * 16 + i * 8192, R, C); const int Rb = Epi::PERM ? ((R & ~31) + perm32(R & 31)) : R;
        voffA[i] = (unsigned)(R * LDP + C) * 2u; voffB[i] = (unsigned)(Rb * LDP + C) * 2u; }
    const size_t kstep = (size_t)(BK * 2);
    const size_t hstep = (size_t)HALF * LDP * 2;
    const size_t tstep = 2 * hstep;
    const unsigned ldsw = (unsigned)wid * 1024u;
    const int aoff = lds_byte(wr * 64 + fr, fq * 8), boff = lds_byte(wc * 32 + fr, fq * 8);
#define PG8_SA(b, h) (((b) * 2 + (h)) * HTB)
#define PG8_SB(b, h) ((4 + (b) * 2 + (h)) * HTB)
#define PG8_STAGE(bufoff, gbase, voff) do { _Pragma("unroll") for (int _i = 0; _i < 2; ++_i) \
        __builtin_amdgcn_global_load_lds((const unsigned*)((const char*)(gbase) + (voff)[_i]), (PG8_LAS unsigned*)(lds + (bufoff) + ldsw + _i * 8192), 16, 0, 0); } while (0)
#define PG8_LDA(dst, b, h) do { _Pragma("unroll") for (int m = 0; m < 4; ++m) _Pragma("unroll") for (int k = 0; k < 2; ++k) dst[m][k] = *(const PG8_LAS bf16x8*)(lds + PG8_SA(b, h) + aoff + m * 2048 + k * 1024); } while (0)
#define PG8_LDB(dst, b, h) do { _Pragma("unroll") for (int n = 0; n < 2; ++n) _Pragma("unroll") for (int k = 0; k < 2; ++k) dst[n][k] = *(const PG8_LAS bf16x8*)(lds + PG8_SB(b, h) + boff + n * 2048 + k * 1024); } while (0)
#define PG8_MMA(ai, bj, At, Bt) do { __builtin_amdgcn_s_setprio(1); _Pragma("unroll") for (int m = 0; m < 4; ++m) _Pragma("unroll") for (int n = 0; n < 2; ++n) _Pragma("unroll") for (int k = 0; k < 2; ++k) \
        acc[ai][bj][m][n] = __builtin_amdgcn_mfma_f32_16x16x32_bf16(Bt[n][k], At[m][k], acc[ai][bj][m][n], 0, 0, 0); __builtin_amdgcn_s_setprio(0); } while (0)
#define PG8_WAIT_V(n) asm volatile("s_waitcnt vmcnt(" #n ")" ::: "memory")
#define PG8_WAIT_L(n) asm volatile("s_waitcnt lgkmcnt(" #n ")" ::: "memory")
#define PG8_BAR __builtin_amdgcn_s_barrier()
#define PG8_SCHED __builtin_amdgcn_sched_barrier(0)
    Unit cur, nxt; int ui = 0;
    if (!S.next(0, cur)) return;
    f32x4 acc[2][2][4][2];
#pragma unroll
    for (int a = 0; a < 2; ++a)
#pragma unroll
        for (int b = 0; b < 2; ++b)
#pragma unroll
            for (int m = 0; m < 4; ++m)
#pragma unroll
                for (int n = 0; n < 2; ++n) acc[a][b][m][n] = (f32x4){0.f, 0.f, 0.f, 0.f};
    bf16x8 At[4][2], B0[2][2], B1[2][2];
    const char* cA = (const char*)g.A + (size_t)cur.pm * tstep; const char* cB = (const char*)g.Bt + (size_t)cur.pn * tstep;
    S.a_ready(cur);
    if constexpr (SP2) {
        PG8_STAGE(PG8_SB(0, 0), cB, voffB); PG8_STAGE(PG8_SB(0, 1), cB + hstep, voffB); PG8_STAGE(PG8_SA(0, 0), cA, voffA); PG8_STAGE(PG8_SA(0, 1), cA + hstep, voffA);
        if (wr == 1) PG8_BAR;
        PG8_WAIT_V(2); PG8_BAR;
        PG8_STAGE(PG8_SB(1, 0), cB + kstep, voffB); PG8_STAGE(PG8_SA(1, 0), cA + kstep, voffA); PG8_STAGE(PG8_SB(1, 1), cB + hstep + kstep, voffB);
        PG8_WAIT_V(6); PG8_BAR;
    } else {
        PG8_STAGE(PG8_SB(0, 0), cB, voffB); PG8_STAGE(PG8_SA(0, 0), cA, voffA); PG8_STAGE(PG8_SB(0, 1), cB + hstep, voffB); PG8_STAGE(PG8_SA(0, 1), cA + hstep, voffA);
        if (wr == 1) PG8_BAR;
        PG8_WAIT_V(4); PG8_BAR;
        PG8_STAGE(PG8_SB(1, 0), cB + kstep, voffB); PG8_STAGE(PG8_SA(1, 0), cA + kstep, voffA); PG8_STAGE(PG8_SB(1, 1), cB + hstep + kstep, voffB);
        PG8_WAIT_V(6); PG8_BAR;
    }
    for (;;) {
        const bool has_next = S.next(ui + 1, nxt);
        const char* nA = has_next ? (const char*)g.A + (size_t)nxt.pm * tstep : cA; const char* nB = has_next ? (const char*)g.Bt + (size_t)nxt.pn * tstep : cB;
        for (int t = 0; t < nt; t += 2) {
            const bool last = (t == nt - 2);
            const char* a1 = cA + (size_t)(t + 1) * kstep;
            const char* a2 = last ? nA : cA + (size_t)(t + 2) * kstep; const char* b2 = last ? nB : cB + (size_t)(t + 2) * kstep;
            const char* a3 = a2 + kstep; const char* b3 = b2 + kstep;
            if (last && has_next) S.a_ready(nxt);
            if constexpr (SP2) {
            PG8_LDB(B0, 0, 0); PG8_LDB(B1, 0, 1); PG8_SCHED; PG8_LDA(At, 0, 0); PG8_STAGE(PG8_SA(1, 1), a1 + hstep, voffA);
            PG8_WAIT_V(8); PG8_WAIT_L(0); PG8_BAR; PG8_MMA(0, 0, At, B0); PG8_MMA(0, 1, At, B1); PG8_BAR; PG8_SCHED;
            PG8_LDA(At, 0, 1); PG8_STAGE(PG8_SB(0, 0), b2, voffB); PG8_STAGE(PG8_SB(0, 1), b2 + hstep, voffB); PG8_STAGE(PG8_SA(0, 0), a2, voffA);
            PG8_WAIT_V(8); PG8_WAIT_L(0); PG8_BAR; PG8_MMA(1, 0, At, B0); PG8_MMA(1, 1, At, B1); PG8_BAR; PG8_SCHED;
            PG8_LDB(B0, 1, 0); PG8_LDB(B1, 1, 1); PG8_SCHED; PG8_LDA(At, 1, 0); PG8_STAGE(PG8_SA(0, 1), a2 + hstep, voffA);
            PG8_WAIT_V(8); PG8_WAIT_L(0); PG8_BAR; PG8_MMA(0, 0, At, B0); PG8_MMA(0, 1, At, B1); PG8_BAR; PG8_SCHED;
            PG8_LDA(At, 1, 1); PG8_STAGE(PG8_SB(1, 0), b3, voffB); PG8_STAGE(PG8_SB(1, 1), b3 + hstep, voffB); PG8_STAGE(PG8_SA(1, 0), a3, voffA);
            PG8_WAIT_V(8); PG8_WAIT_L(0); PG8_BAR; PG8_MMA(1, 0, At, B0); PG8_MMA(1, 1, At, B1); PG8_BAR; PG8_SCHED;
            } else {
            PG8_LDB(B0, 0, 0); PG8_SCHED; PG8_LDA(At, 0, 0); PG8_STAGE(PG8_SA(1, 1), a1 + hstep, voffA);
            PG8_WAIT_L(8); PG8_BAR; PG8_WAIT_L(0); PG8_MMA(0, 0, At, B0); PG8_BAR; PG8_SCHED;
            PG8_LDB(B1, 0, 1); PG8_STAGE(PG8_SB(0, 0), b2, voffB);
            PG8_BAR; PG8_WAIT_L(0); PG8_MMA(0, 1, At, B1); PG8_BAR;
            PG8_LDA(At, 0, 1); PG8_STAGE(PG8_SA(0, 0), a2, voffA);
            PG8_BAR; PG8_WAIT_L(0); PG8_MMA(1, 0, At, B0); PG8_BAR; PG8_SCHED;
            PG8_STAGE(PG8_SB(0, 1), b2 + hstep, voffB);
            PG8_WAIT_V(6); PG8_BAR; PG8_MMA(1, 1, At, B1); PG8_BAR;
            PG8_LDB(B0, 1, 0); PG8_SCHED; PG8_LDA(At, 1, 0); PG8_STAGE(PG8_SA(0, 1), a2 + hstep, voffA);
            PG8_WAIT_L(8); PG8_BAR; PG8_WAIT_L(0); PG8_MMA(0, 0, At, B0); PG8_BAR; PG8_SCHED;
            PG8_LDB(B1, 1, 1); PG8_STAGE(PG8_SB(1, 0), b3, voffB);
            PG8_BAR; PG8_WAIT_L(0); PG8_MMA(0, 1, At, B1); PG8_BAR;
            PG8_LDA(At, 1, 1); PG8_STAGE(PG8_SA(1, 0), a3, voffA);
            PG8_BAR; PG8_WAIT_L(0); PG8_MMA(1, 0, At, B0); PG8_BAR; PG8_SCHED;
            PG8_STAGE(PG8_SB(1, 1), b3 + hstep, voffB);
            PG8_WAIT_V(6); PG8_BAR; PG8_MMA(1, 1, At, B1); PG8_BAR;
            }
        }
        if constexpr (ALIGN_EPI) { if (wr == 0) PG8_BAR; }
        if constexpr (!Epi::AFTER_DRAIN) { E(acc, cur, wr, wc, fr, fq); S.done(cur); }
        if (!has_next) break;
#pragma unroll
        for (int a = 0; a < 2; ++a)
#pragma unroll
            for (int b = 0; b < 2; ++b)
#pragma unroll
                for (int m = 0; m < 4; ++m)
#pragma unroll
                    for (int n = 0; n < 2; ++n) acc[a][b][m][n] = (f32x4){0.f, 0.f, 0.f, 0.f};
        cur = nxt; cA = nA; cB = nB; ++ui;
        if constexpr (ALIGN_EPI) { if (wr == 1) PG8_BAR; }
    }
    PG8_WAIT_V(0);
    if constexpr (!ALIGN_EPI) { if (wr == 0) PG8_BAR; }
    PG8_BAR;
    if constexpr (Epi::AFTER_DRAIN) { E.fused(acc, cur, wr, wc, fr, fq, lds, wid, lane); S.done(cur); }
#undef PG8_SA
#undef PG8_SB
#undef PG8_STAGE
#undef PG8_LDA
#undef PG8_LDB
#undef PG8_MMA
#undef PG8_WAIT_V
#undef PG8_WAIT_L
#undef PG8_BAR
#undef PG8_SCHED
}
}
#define GAS __attribute__((address_space(1)))
#define LAS __attribute__((address_space(3)))
typedef unsigned short bf16;
typedef unsigned v4u __attribute__((ext_vector_type(4)));
typedef float f32x4 __attribute__((ext_vector_type(4)));
typedef short bf16x8 __attribute__((ext_vector_type(8)));
typedef GAS unsigned gu32;
typedef GAS unsigned long long gu64;
#define RLX_AGENT __ATOMIC_RELAXED, __HIP_MEMORY_SCOPE_AGENT
#define LDS_WAIT() asm volatile("s_waitcnt lgkmcnt(0)" ::: "memory")
#define VM_WAIT() asm volatile("s_waitcnt vmcnt(0)" ::: "memory")
__device__ __forceinline__ unsigned long long rt() { return __builtin_amdgcn_s_memrealtime(); }
__device__ __forceinline__ unsigned f2bf(float f) { unsigned u = __builtin_bit_cast(unsigned, f); return (u + 0x7fffu + ((u >> 16) & 1u)) >> 16; }
__device__ __forceinline__ unsigned pk2(float lo, float hi) { return f2bf(lo) | (f2bf(hi) << 16); }

#define XB_TMO      128
#define XB_XCNT(j)  (256  + 64 * (j))
#define XB_XSUB(j)  (1280 + 64 * (j))
#define XB_XGEN(j)  (2304 + 64 * (j))
#define XB_TOP      3328
#define XB_TOPGEN   3392
#define XCD_BAR_WORDS 3456
#define XB_SPIN_CAP (1u << 18)

__device__ __forceinline__ unsigned xb_ld(unsigned* p)              { return __hip_atomic_load(p, __ATOMIC_RELAXED, __HIP_MEMORY_SCOPE_AGENT); }
__device__ __forceinline__ unsigned xb_add(unsigned* p, unsigned v) { return __hip_atomic_fetch_add(p, v, __ATOMIC_RELAXED, __HIP_MEMORY_SCOPE_AGENT); }
__device__ __forceinline__ unsigned xb_xcc_id() { return (unsigned)__builtin_amdgcn_s_getreg((3 << 11) | 20) & 0xFu; }
#define XB_SPIN(cond, bar) do { unsigned _sp = 0; while (cond) { __builtin_amdgcn_s_sleep(1); \
    if ((++_sp & 255u) == 0u) { if (xb_ld(&(bar)[XB_TMO])) break; if (_sp > XB_SPIN_CAP) { atomicAdd(&(bar)[XB_TMO], 1u); break; } } } } while (0)

struct XcdBarrier {
    unsigned* bar; unsigned x;
    volatile LAS unsigned* st;
};

__device__ __forceinline__ XcdBarrier xcd_barrier_post(unsigned* bar, volatile LAS unsigned* st) {
    XcdBarrier b; b.bar = bar; b.x = xb_xcc_id(); b.st = st;
    if (threadIdx.x == 0) (void)xb_add(&bar[XB_XCNT(b.x)], 1u);
    return b;
}
__device__ __forceinline__ void xcd_barrier_complete(unsigned* bar, unsigned x, unsigned& nloc, unsigned& nx) {
    const unsigned G = gridDim.x * gridDim.y * gridDim.z;
    unsigned sum, cnt, mine, sp = 0u;
    for (;;) {
        sum = 0u; cnt = 0u; mine = 0u;
#pragma unroll
        for (unsigned j = 0; j < 16; ++j) { const unsigned c = xb_ld(&bar[XB_XCNT(j)]); sum += c; cnt += (c > 0u) ? 1u : 0u; mine = (j == x) ? c : mine; }
        if (sum == G) break;
        __builtin_amdgcn_s_sleep(1);
        if ((++sp & 255u) == 0u) { if (xb_ld(&bar[XB_TMO])) break; if (sp > XB_SPIN_CAP) { atomicAdd(&bar[XB_TMO], 1u); break; } }
    }
    nloc = mine > 0u ? mine : 1u; nx = cnt > 0u ? cnt : 1u;
}

__device__ __forceinline__ void xcd_barrier(const XcdBarrier& b) {
    asm volatile("s_waitcnt vmcnt(0)" ::: "memory");
    __syncthreads();
    if (threadIdx.x == 0) {
        unsigned* bar = b.bar;
        __builtin_amdgcn_s_waitcnt(0);
        unsigned nloc = b.st[0], nx = b.st[1];
        if (nloc == 0u) { xcd_barrier_complete(bar, b.x, nloc, nx); b.st[0] = nloc; b.st[1] = nx; }
        const unsigned old = xb_add(&bar[XB_XSUB(b.x)], 1u);
        const unsigned gen = old / nloc;
        if (old + 1u == (gen + 1u) * nloc) {
            __builtin_amdgcn_fence(__ATOMIC_RELEASE, "agent");
            asm volatile("s_waitcnt vmcnt(0)" ::: "memory");
            const unsigned og = xb_add(&bar[XB_TOP], 1u);
            const unsigned tg = og / nx;
            if (og + 1u == (tg + 1u) * nx) xb_add(&bar[XB_TOPGEN], 1u);
            else XB_SPIN(xb_ld(&bar[XB_TOPGEN]) == tg, bar);
            __builtin_amdgcn_fence(__ATOMIC_ACQUIRE, "agent");
            xb_add(&bar[XB_XGEN(b.x)], 1u);
            asm volatile("s_waitcnt vmcnt(0)" ::: "memory");
        } else {
            XB_SPIN(xb_ld(&bar[XB_XGEN(b.x)]) == gen, bar);
            __builtin_amdgcn_fence(__ATOMIC_ACQUIRE, "agent");
            asm volatile("s_waitcnt vmcnt(0)" ::: "memory");
        }
    }
    __syncthreads();
}

constexpr int NWAVES = 8;
#ifndef MK_N_LAUNCHES
#define MK_N_LAUNCHES 1
#endif
constexpr int PER_PHASE = 11;
constexpr int N_LAUNCHES = MK_N_LAUNCHES;

constexpr int BATCH = 16, SEQ = 2048, D = 1024, HD = 64, NH = 8, FF = 2816;
constexpr int M = BATCH * SEQ;
constexpr int SBW = 512, RWW = 512, RWP = 1792, PW = 3328, LORA_K = 256, LORA_N = 1536;
constexpr float LNX_EPS = 64e-5f;

constexpr size_t MiB = 1u << 20;
constexpr size_t WS_CTL = 0, CTL_ZERO_BYTES = 1 * MiB;
constexpr size_t WS_SSQ = 1 * MiB;
constexpr size_t WS_W1U = 4 * MiB;
constexpr size_t WS_W1D = 15 * MiB;
constexpr size_t WS_W2U = 21 * MiB;
constexpr size_t WS_W2D = 32 * MiB;
constexpr size_t WS_WIN = 38 * MiB;
constexpr size_t WS_WOUT = 45 * MiB;
constexpr size_t WS_WLORA = 47 * MiB;
constexpr size_t WS_XB = 48 * MiB;
constexpr size_t WS_ACT = 112 * MiB;
constexpr size_t WS_QO = 112 * MiB;
constexpr size_t WS_KB = 176 * MiB;
constexpr size_t WS_VB = 208 * MiB;
constexpr size_t WS_RW = 240 * MiB;
constexpr size_t WS_ALORA = 352 * MiB;
constexpr size_t WS_LW = 368 * MiB;
constexpr size_t WS_AB = 432 * MiB;
constexpr size_t WS_GB = 464 * MiB;
constexpr size_t WS_TAIL = 496 * MiB;
constexpr size_t WS_END = 512 * MiB;
constexpr int CW_TMO = 0, CW_CODE = 1;
constexpr int CW_BAR = 4096;

constexpr int RING_OFF = 0, RING_BYTES = 155648;
constexpr int LDSCTL_OFF = RING_BYTES, MISC_OFF = LDSCTL_OFF + 320;
constexpr int LDS_BYTES = 163840;

struct Frame {
    LAS unsigned char* lds;
    volatile LAS unsigned* MISC;
    gu32* ctl;
    int tid, lane, wave;
    int vcu, G;
};
typedef unsigned u32x2g __attribute__((ext_vector_type(2)));
__device__ __forceinline__ float bf2f(unsigned short h) { return __uint_as_float(((unsigned)h) << 16); }
typedef float f32x2h __attribute__((ext_vector_type(2))); typedef __bf16 bf16x2h __attribute__((ext_vector_type(2)));
__device__ __forceinline__ unsigned pkbf(float lo, float hi) { f32x2h v = {lo, hi}; bf16x2h b = __builtin_convertvector(v, bf16x2h); return __builtin_bit_cast(unsigned, b); }
__device__ __forceinline__ float bflo(unsigned w) { return __uint_as_float(w << 16); }
__device__ __forceinline__ float bfhi(unsigned w) { return __uint_as_float(w & 0xffff0000u); }
__device__ __forceinline__ float wave_sum(float v) {
#pragma unroll
    for (int o = 1; o < 64; o <<= 1) v += __shfl_xor(v, o);
    return v;
}
__device__ __forceinline__ float dpp_f(float v, const int ctrl_unused) { return v; }
#define DPP_ADD(v, ctrl) ((v) + __int_as_float(__builtin_amdgcn_update_dpp(0, __float_as_int(v), (ctrl), 0xF, 0xF, true)))
__device__ __forceinline__ float sum8(float v) { v = DPP_ADD(v, 0xB1); v = DPP_ADD(v, 0x4E); v = DPP_ADD(v, 0x141); return v; }

struct TItem { const float* W; int ldw, k0, n0; const float* sc; bf16* WT; int Kd, rho0; };
__device__ __forceinline__ void ti_load(const TItem& T, float (&t)[32], int lane) {
#pragma unroll
    for (int i = 0; i < 32; ++i) t[i] = T.W[(size_t)(T.k0 + 2 * i + (lane >> 5)) * T.ldw + T.n0 + (lane & 31)];
}
__device__ __forceinline__ void ti_finish(const TItem& T, const float (&t)[32], LAS float* scr, int lane) {
#pragma unroll
    for (int i = 0; i < 32; ++i) scr[(2 * i + (lane >> 5)) * 33 + (lane & 31)] = t[i];
    LDS_WAIT(); asm volatile("" ::: "memory");
    const int c = lane & 7;
    f32x4 s0 = (f32x4){1.f, 1.f, 1.f, 1.f}, s1 = s0;
    if (T.sc) { s0 = *(const f32x4*)(T.sc + T.k0 + 8 * c); s1 = *(const f32x4*)(T.sc + T.k0 + 8 * c + 4); }
#pragma unroll
    for (int j = 0; j < 4; ++j) { const int n = (lane >> 3) + 8 * j; const LAS float* s = scr + (8 * c) * 33 + n;
        v4u o; o.x = pkbf(s[0 * 33] * s0.x, s[1 * 33] * s0.y); o.y = pkbf(s[2 * 33] * s0.z, s[3 * 33] * s0.w); o.z = pkbf(s[4 * 33] * s1.x, s[5 * 33] * s1.y); o.w = pkbf(s[6 * 33] * s1.z, s[7 * 33] * s1.w);
        *(GAS v4u*)(T.WT + (size_t)(T.rho0 + n) * T.Kd + T.k0 + 8 * c) = o; }
    LDS_WAIT(); asm volatile("" ::: "memory");
}
#define P0_PTRS const float* Ax, const float* An1, const float* Ag1, const float* Au1, const float* Ad1, const float* Anm, const float* Awin, const float* Aw2, const float* Aa2, const float* Ag2, const float* Awout, \
    const float* An2, const float* Ag2f, const float* Au2f, const float* Ad2f, bf16* AW1U, bf16* AW1D, bf16* AW2U, bf16* AW2D, bf16* AWIN, bf16* AWOUT, bf16* AWLORA, bf16* AXB, float* ASSQ
__device__ __forceinline__ void p0_prologue(Frame& F, P0_PTRS) {
    LAS float* scr = (LAS float*)(F.lds + RING_OFF + F.wave * 16384);
    const int gw = F.vcu * NWAVES + F.wave, NGW = F.G * NWAVES;
    constexpr int I_UP = 16 * 176, I_DN = 44 * 32, I_IN = 16 * 104, I_OUT = 16 * 32;
    constexpr int NITEMS = 2 * (I_UP + I_DN) + I_IN + I_OUT;
#define P0_DECODE(it_, T) do { int r = (it_); \
        if (r < 2 * I_UP) { const int l2 = r >= I_UP; if (l2) r -= I_UP; \
            const int kb = r / 176, nb = r % 176, rho0 = 32 * nb, pn = rho0 >> 8, bj = (rho0 >> 7) & 1, j0 = rho0 & 127; \
            T = TItem{l2 ? (bj ? Au2f : Ag2f) : (bj ? Au1 : Ag1), FF, 64 * kb, 128 * pn + j0, l2 ? An2 : An1, l2 ? AW2U : AW1U, D, rho0}; } \
        else if ((r -= 2 * I_UP) < 2 * I_DN) { const int l2 = r >= I_DN; if (l2) r -= I_DN; const int kb = r / 32, nb = r % 32; \
            T = TItem{l2 ? Ad2f : Ad1, D, 64 * kb, 32 * nb, nullptr, l2 ? AW2D : AW1D, FF, 32 * nb}; } \
        else if ((r -= 2 * I_DN) < I_IN) { const int kb = r / 104, nb = r % 104, rho0 = 32 * nb, pn = rho0 >> 8, rem = rho0 & 255, bj = rem >> 7, wc = (rem & 127) >> 5; \
            T = TItem{Awin, PW, 64 * kb, 256 * pn + 64 * wc + 32 * bj, Anm, AWIN, D, rho0}; } \
        else { r -= I_IN; const int kb = r / 32, nb = r % 32; T = TItem{Awout, D, 64 * kb, 32 * nb, nullptr, AWOUT, D, 32 * nb}; } } while (0)
    for (int it = gw; it < NITEMS; it += 2 * NGW) {
        TItem T0, T1; float t0[32], t1[32]; const bool two = (it + NGW < NITEMS);
        P0_DECODE(it, T0); ti_load(T0, t0, F.lane);
        if (two) { P0_DECODE(it + NGW, T1); ti_load(T1, t1, F.lane); }
        ti_finish(T0, t0, scr, F.lane);
        if (two) ti_finish(T1, t1, scr, F.lane);
    }
#undef P0_DECODE
    for (int it = F.vcu * (NWAVES * 64) + F.tid; it < LORA_N * (LORA_K / 8); it += F.G * NWAVES * 64) {
        const int rho = it >> 5, kc = (it & 31) * 8; float v[8];
#pragma unroll
        for (int j = 0; j < 8; ++j) { const int k = kc + j; float t = 0.f;
            if (rho < 512) { if (k < 64) t = Aw2[(size_t)k * 512 + rho]; }
            else if (rho < 1024) { if (k >= 64 && k < 128) t = Aa2[(size_t)(k - 64) * 512 + (rho - 512)]; }
            else { if (k >= 128) t = Ag2[(size_t)(k - 128) * 512 + (rho - 1024)]; }
            v[j] = t; }
        v4u o; o.x = pkbf(v[0], v[1]); o.y = pkbf(v[2], v[3]); o.z = pkbf(v[4], v[5]); o.w = pkbf(v[6], v[7]);
        *(GAS v4u*)(AWLORA + (size_t)rho * LORA_K + kc) = o;
    }
    for (int mb = gw; mb < M; mb += 4 * NGW) {
        f32x4 v[4][4]; float s[4];
#pragma unroll
        for (int q = 0; q < 4; ++q) { const int m = mb + q * NGW; const GAS f32x4* xr = (const GAS f32x4*)(Ax + (size_t)(m < M ? m : mb) * D) + F.lane;
#pragma unroll
            for (int j = 0; j < 4; ++j) v[q][j] = xr[64 * j]; }
#pragma unroll
        for (int q = 0; q < 4; ++q) { float a = 0.f;
#pragma unroll
            for (int j = 0; j < 4; ++j) a += (v[q][j].x * v[q][j].x + v[q][j].y * v[q][j].y) + (v[q][j].z * v[q][j].z + v[q][j].w * v[q][j].w);
            s[q] = a; }
#pragma unroll
        for (int o = 1; o < 64; o <<= 1) {
#pragma unroll
            for (int q = 0; q < 4; ++q) s[q] += __shfl_xor(s[q], o); }
#pragma unroll
        for (int q = 0; q < 4; ++q) { const int m = mb + q * NGW; if (m < M) {
            GAS unsigned long long* o8 = (GAS unsigned long long*)(AXB + (size_t)m * D) + F.lane;
#pragma unroll
            for (int j = 0; j < 4; ++j) o8[64 * j] = (unsigned long long)pkbf(v[q][j].x, v[q][j].y) | ((unsigned long long)pkbf(v[q][j].z, v[q][j].w) << 32);
            if (F.lane < 16) ASSQ[(size_t)m * 16 + F.lane] = (F.lane == 0) ? s[q] : 0.f; } }
    }
}

__device__ __forceinline__ void p4_lora_prep(Frame& F, const bf16* RW, const float* mu, bf16* ALORA) {
    const int gw = F.vcu * NWAVES + F.wave, NGW = F.G * NWAVES; const int l = F.lane;
    const f32x4 muv = *(const f32x4*)(mu + 1536 + 4 * l);
    for (int m = gw; m < M; m += NGW) {
        const u32x2g c = *(const u32x2g*)(RW + (size_t)m * RWP + 1536 + 4 * l);
        u32x2g p = (u32x2g){0u, 0u};
        if ((m & (SEQ - 1)) != 0) p = *(const u32x2g*)(RW + (size_t)(m - 1) * RWP + 1536 + 4 * l);
        float x[4] = {bflo(c.x), bfhi(c.x), bflo(c.y), bfhi(c.y)}; const float q[4] = {bflo(p.x), bfhi(p.x), bflo(p.y), bfhi(p.y)};
#pragma unroll
        for (int i = 0; i < 4; ++i) { float u = x[i] + (q[i] - x[i]) * muv[i];
            if (l < 16) u = 2.0f * pg8::sigmoid_f(2.0f * u) - 1.0f; else if (l >= 32) u = pg8::sigmoid_f(u);
            x[i] = u; }
        u32x2g o; o.x = pkbf(x[0], x[1]); o.y = pkbf(x[2], x[3]);
        *(u32x2g*)(ALORA + (size_t)m * LORA_K + 4 * l) = o;
    }
}

struct RwArgs { const bf16* RW; const float* LW; const bf16* AB; const bf16* GB; bf16* QO; const float *mu, *k_k, *k_a, *r_k, *ln_w, *ln_b; };
__device__ __forceinline__ void ld8bf(const bf16* p, float (&o)[8]) { const v4u w = *(const v4u*)p; o[0] = bflo(w.x); o[1] = bfhi(w.x); o[2] = bflo(w.y); o[3] = bfhi(w.y); o[4] = bflo(w.z); o[5] = bfhi(w.z); o[6] = bflo(w.w); o[7] = bfhi(w.w); }
__device__ __forceinline__ void ld8f(const float* p, float (&o)[8]) { const f32x4 a = *(const f32x4*)p, b = *(const f32x4*)(p + 4); o[0] = a.x; o[1] = a.y; o[2] = a.z; o[3] = a.w; o[4] = b.x; o[5] = b.y; o[6] = b.z; o[7] = b.w; }
__device__ __forceinline__ void ld8l(const LAS float* p, float (&o)[8]) { const f32x4 a = *(const LAS f32x4*)p, b = *(const LAS f32x4*)(p + 4); o[0] = a.x; o[1] = a.y; o[2] = a.z; o[3] = a.w; o[4] = b.x; o[5] = b.y; o[6] = b.z; o[7] = b.w; }
__device__ __forceinline__ void st8l(LAS float* p, const float (&o)[8]) { *(LAS f32x4*)p = (f32x4){o[0], o[1], o[2], o[3]}; *(LAS f32x4*)(p + 4) = (f32x4){o[4], o[5], o[6], o[7]}; }
namespace rwk {
typedef short bf16x8 __attribute__((ext_vector_type(8)));
typedef short s16x4 __attribute__((ext_vector_type(4)));
typedef short v4i16_t __attribute__((ext_vector_type(4)));
constexpr int SLOT = 8192;
#define RSL(s) (lds + (s) * SLOT)
#define RMFMA(a, b, c) __builtin_amdgcn_mfma_f32_16x16x32_bf16((a), (b), (c), 0, 0, 0)
__device__ __forceinline__ int swz(int row, int cb) { return row * 128 + (cb ^ ((row & 7) << 4)); }
struct Fr2 { bf16x8 k0, k1; };
__device__ __forceinline__ Fr2 ldf(const LAS unsigned char* base, int off) { Fr2 f; f.k0 = *(const LAS bf16x8*)(base + off); f.k1 = *(const LAS bf16x8*)(base + (off ^ 64)); return f; }
__device__ __forceinline__ s16x4 trd(const LAS unsigned char* p) { return __builtin_bit_cast(s16x4, __builtin_amdgcn_ds_read_tr16_b64_v4i16((LAS v4i16_t*)p)); }
__device__ __forceinline__ Fr2 ldt(const LAS unsigned char* base, int o0, int o1) {
    const s16x4 a = trd(base + o0), b = trd(base + o1), c = trd(base + o0 + 4096), d = trd(base + o1 + 4096);
    Fr2 f; f.k0 = (bf16x8){a[0], a[1], a[2], a[3], b[0], b[1], b[2], b[3]}; f.k1 = (bf16x8){c[0], c[1], c[2], c[3], d[0], d[1], d[2], d[3]}; return f; }
template <bool SWAP> __device__ __forceinline__ f32x4 mm(const Fr2& a, const Fr2& b, f32x4 c) {
    if (SWAP) { c = RMFMA(b.k0, a.k0, c); c = RMFMA(b.k1, a.k1, c); } else { c = RMFMA(a.k0, b.k0, c); c = RMFMA(a.k1, b.k1, c); } return c; }
__device__ __forceinline__ void st4(LAS unsigned char* slot, int off, f32x4 v) { u32x2g w; w.x = pkbf(v[0], v[1]); w.y = pkbf(v[2], v[3]); *(LAS u32x2g*)(slot + off) = w; }
__device__ __forceinline__ f32x4 ld4(const LAS unsigned char* slot, int off) { const u32x2g w = *(const LAS u32x2g*)(slot + off); return (f32x4){bflo(w.x), bfhi(w.x), bflo(w.y), bfhi(w.y)}; }
#define LBAR() asm volatile("s_waitcnt lgkmcnt(0)\n\ts_barrier" ::: "memory")
#define DPPF(x, ctrl, rmask) __int_as_float(__builtin_amdgcn_update_dpp(0, __float_as_int(x), (ctrl), (rmask), 0xF, true))
__device__ __forceinline__ float wave_scan(float x) {
    x += DPPF(x, 0x111, 0xF); x += DPPF(x, 0x112, 0xF); x += DPPF(x, 0x114, 0xF); x += DPPF(x, 0x118, 0xF);
    x += DPPF(x, 0x142, 0xA);
    x += DPPF(x, 0x143, 0xC);
    return x; }
__device__ __forceinline__ void unp8(const v4u w, float (&o)[8]) { o[0] = bflo(w.x); o[1] = bfhi(w.x); o[2] = bflo(w.y); o[3] = bfhi(w.y); o[4] = bflo(w.z); o[5] = bfhi(w.z); o[6] = bflo(w.w); o[7] = bfhi(w.w); }
__device__ __forceinline__ v4u pk8(const float (&o)[8]) { return (v4u){pkbf(o[0], o[1]), pkbf(o[2], o[3]), pkbf(o[4], o[5]), pkbf(o[6], o[7])}; }
}
struct RwX { bf16* P1; bf16* GT; bf16* Y0; bf16* H; bf16* VB0; bf16* VB1; float* GE; };
__device__ __forceinline__ void p6a_rwkv_local(Frame& F, const RwArgs& A, const RwX& X) {
    using namespace rwk;
    LAS unsigned char* lds = F.lds + RING_OFF;
    LAS float* part = (LAS float*)(F.lds + LDSCTL_OFF + 512);
    const int lane = F.lane, fr = lane & 15, fq = lane >> 4, w = F.wave, m0 = 16 * (w >> 1), n0a = 32 * (w & 1);
    const int fm = swz(m0 + fr, fq * 16);
    const int ta0 = swz(8 * fq + (fr >> 2), 2 * (m0 + 4 * (fr & 3))), ta1 = swz(8 * fq + 4 + (fr >> 2), 2 * (m0 + 4 * (fr & 3)));
    int fn[2], orm[2], otr[2], tb0[2], tb1[2];
#pragma unroll
    for (int t = 0; t < 2; ++t) { const int n0 = n0a + 16 * t; fn[t] = swz(n0 + fr, fq * 16); orm[t] = swz(m0 + fr, 2 * (n0 + 4 * fq)); otr[t] = swz(n0 + fr, 2 * (m0 + 4 * fq));
        tb0[t] = swz(8 * fq + (fr >> 2), 2 * (n0 + 4 * (fr & 3))); tb1[t] = swz(8 * fq + 4 + (fr >> 2), 2 * (n0 + 4 * (fr & 3))); }
    const int NJ = BATCH * NH * (SEQ / 64);
    const int tid = F.tid, ltok = tid >> 3, ldg = tid & 7;
    v4u g_r, g_k, g_v, g_al, g_pr; f32x4 g_lw0, g_lw1;
#define P6A_LOAD(jj) do { const int u_ = (jj) >> 5, c_ = (jj) & 31; const size_t gr_ = (size_t)(u_ >> 3) * SEQ + c_ * 64 + ltok; const int cb_ = 64 * (u_ & 7) + 8 * ldg; \
        g_r = *(const v4u*)(A.RW + gr_ * RWP + cb_); g_k = *(const v4u*)(A.RW + gr_ * RWP + 512 + cb_); g_v = *(const v4u*)(A.RW + gr_ * RWP + 1024 + cb_); \
        g_al = *(const v4u*)(A.AB + gr_ * 512 + cb_); g_lw0 = *(const f32x4*)(A.LW + gr_ * 512 + cb_); g_lw1 = *(const f32x4*)(A.LW + gr_ * 512 + cb_ + 4); \
        g_pr = (v4u){0u, 0u, 0u, 0u}; if (ltok < 3 && c_ > 0) g_pr = *(const v4u*)(A.RW + ((size_t)(u_ >> 3) * SEQ + c_ * 64 - 1) * RWP + 512 * ltok + cb_); } while (0)
    if ((int)blockIdx.x < NJ) P6A_LOAD((int)blockIdx.x);
    float mr[8], mk[8], mv[8], kkc[8], kac[8], rkc[8]; int hcur = -1;
    LAS unsigned char* prow = (LAS unsigned char*)(F.lds + LDSCTL_OFF + 512 + 4096);
    u32x2g s_p1[2], s_gt[2], s_y0[2], s_hh[2]; size_t s_jo = 0; bool s_have = false;
#define P6A_STORE() do { _Pragma("unroll") for (int t = 0; t < 2; ++t) { \
            *(u32x2g*)(X.P1 + s_jo + ((w * 2 + t) * 64 + lane) * 4) = s_p1[t]; *(u32x2g*)(X.GT + s_jo + ((w * 2 + t) * 64 + lane) * 4) = s_gt[t]; \
            *(u32x2g*)(X.Y0 + s_jo + ((w * 2 + t) * 64 + lane) * 4) = s_y0[t]; *(u32x2g*)(X.H + s_jo + ((w * 2 + t) * 64 + lane) * 4) = s_hh[t]; } } while (0)
    for (int job = blockIdx.x; job < NJ; job += F.G) {
        const int unit = job >> 5, c = job & 31; const int h = unit & 7; const int cb = 64 * h + 8 * w; const size_t jo = (size_t)job * 4096;
        {
            const int so = swz(ltok, 16 * ldg);
            *(LAS v4u*)(RSL(12) + so) = g_r; *(LAS v4u*)(RSL(2) + so) = g_k; *(LAS v4u*)(RSL(3) + so) = g_v; *(LAS v4u*)(RSL(7) + so) = g_al;
            LAS unsigned char* lwp = RSL(10) + ltok * 256 + ((ldg ^ (ltok & 7)) << 5);
            *(LAS f32x4*)lwp = g_lw0; *(LAS f32x4*)(lwp + 16) = g_lw1;
            if (ltok < 3) *(LAS v4u*)(prow + ltok * 128 + 16 * ldg) = g_pr;
        }
        if (s_have) P6A_STORE();
        { const int nj = job + F.G; if (nj < NJ) P6A_LOAD(nj); }
        LBAR();
        float r[8], kf[8], v[8], kk[8], al[8], lw[8]; float ssp = 0.f, bpp = 0.f;
        {
            float k[8], rp[8], kp[8], vp[8];
            const int so = swz(lane, 16 * w), sp = swz((lane + 63) & 63, 16 * w);
            unp8(*(const LAS v4u*)(RSL(12) + so), r); unp8(*(const LAS v4u*)(RSL(2) + so), k); unp8(*(const LAS v4u*)(RSL(3) + so), v); unp8(*(const LAS v4u*)(RSL(7) + so), al);
            v4u wr_ = *(const LAS v4u*)(RSL(12) + sp), wk_ = *(const LAS v4u*)(RSL(2) + sp), wv_ = *(const LAS v4u*)(RSL(3) + sp);
            if (lane == 0) { wr_ = *(const LAS v4u*)(prow + 16 * w); wk_ = *(const LAS v4u*)(prow + 128 + 16 * w); wv_ = *(const LAS v4u*)(prow + 256 + 16 * w); }
            unp8(wr_, rp); unp8(wk_, kp); unp8(wv_, vp);
            { const LAS unsigned char* lwp = RSL(10) + lane * 256 + ((w ^ (lane & 7)) << 5); const f32x4 a_ = *(const LAS f32x4*)lwp, b_ = *(const LAS f32x4*)(lwp + 16);
              lw[0] = a_.x; lw[1] = a_.y; lw[2] = a_.z; lw[3] = a_.w; lw[4] = b_.x; lw[5] = b_.y; lw[6] = b_.z; lw[7] = b_.w; }
            if (h != hcur) { hcur = h; ld8f(A.mu + cb, mr); ld8f(A.mu + 512 + cb, mk); ld8f(A.mu + 1024 + cb, mv); ld8f(A.k_k + cb, kkc); ld8f(A.k_a + cb, kac); ld8f(A.r_k + cb, rkc); }
#pragma unroll
            for (int j = 0; j < 8; ++j) { r[j] = r[j] + (rp[j] - r[j]) * mr[j]; k[j] = k[j] + (kp[j] - k[j]) * mk[j]; v[j] = v[j] + (vp[j] - v[j]) * mv[j];
                kk[j] = k[j] * kkc[j]; ssp += kk[j] * kk[j]; kf[j] = k[j] * (1.0f + (al[j] - 1.0f) * kac[j]); bpp += r[j] * kf[j] * rkc[j]; }
            part[w * 64 + lane] = ssp; part[512 + w * 64 + lane] = bpp;
        }
        LBAR();
        {
            float ss = 0.f, bon = 0.f;
#pragma unroll
            for (int i = 0; i < 8; ++i) { ss += part[i * 64 + lane]; bon += part[512 + i * 64 + lane]; }
            const float inv = 1.0f / fmaxf(sqrtf(ss), 1e-12f);
            float at[8], rt[8], bt[8], kt[8], bh[8], kh[8], ge[8], vb[8];
#pragma unroll
            for (int j = 0; j < 8; ++j) {
                const float cs = wave_scan(lw[j]);
                const float ce = __int_as_float(__builtin_amdgcn_readlane(__float_as_int(cs), 63));
                const float e_cs = __builtin_amdgcn_exp2f(cs * 1.4426950408889634f), e_csm = __builtin_amdgcn_exp2f((cs - lw[j]) * 1.4426950408889634f);
                const float e_neg = __builtin_amdgcn_rcpf(e_cs), e_end = __builtin_amdgcn_exp2f((ce - cs) * 1.4426950408889634f);
                const float kn = kk[j] * inv, bb = kn * al[j];
                at[j] = -kn * e_csm; rt[j] = r[j] * e_cs; bt[j] = bb * e_neg; kt[j] = kf[j] * e_neg; bh[j] = bb * e_end; kh[j] = kf[j] * e_end; ge[j] = e_cs; vb[j] = bon * v[j];
            }
            const int ro = swz(lane, 16 * w);
            *(LAS v4u*)(RSL(0) + ro) = pk8(at); *(LAS v4u*)(RSL(1) + ro) = pk8(rt); *(LAS v4u*)(RSL(2) + ro) = pk8(bt); *(LAS v4u*)(RSL(3) + ro) = pk8(kt);
            *(LAS v4u*)(RSL(4) + ro) = pk8(bh); *(LAS v4u*)(RSL(5) + ro) = pk8(kh); *(LAS v4u*)(RSL(6) + ro) = pk8(v);
            if (lane == 63) { *(f32x4*)(X.GE + (size_t)job * 64 + 8 * w) = (f32x4){ge[0], ge[1], ge[2], ge[3]}; *(f32x4*)(X.GE + (size_t)job * 64 + 8 * w + 4) = (f32x4){ge[4], ge[5], ge[6], ge[7]}; }
            *(LAS v4u*)(RSL(16) + ro) = pk8(vb);
        }
        LBAR();
        {
            { bf16* vbp = (job < 2048) ? (X.VB0 + jo) : (X.VB1 + (jo - (size_t)2048 * 4096)); *(v4u*)(vbp + tid * 8) = *(const LAS v4u*)(RSL(16) + swz(ltok, 16 * ldg)); }
            const f32x4 z4 = (f32x4){0.f, 0.f, 0.f, 0.f};
            const Fr2 aA = ldf(RSL(0), fm), aR = ldf(RSL(1), fm); Fr2 bB[2], bK[2];
#pragma unroll
            for (int t = 0; t < 2; ++t) { bB[t] = ldf(RSL(2), fn[t]); bK[t] = ldf(RSL(3), fn[t]); }
            f32x4 nab[2], nabT[2], nak[2], mrb[2], mrk[2];
#pragma unroll
            for (int t = 0; t < 2; ++t) { nab[t] = mm<true>(aA, bB[t], z4); nabT[t] = mm<false>(aA, bB[t], z4); nak[t] = mm<true>(aA, bK[t], z4); mrb[t] = mm<true>(aR, bB[t], z4); mrk[t] = mm<true>(aR, bK[t], z4); }
#pragma unroll
            for (int t = 0; t < 2; ++t) { const int n0 = n0a + 16 * t; f32x4 x1;
#pragma unroll
                for (int x = 0; x < 4; ++x) { const int i = m0 + fr, j = n0 + 4 * fq + x;
                    if (j >= i) { nab[t][x] = 0.f; nak[t][x] = 0.f; } if (j > i) { mrb[t][x] = 0.f; mrk[t][x] = 0.f; }
                    x1[x] = nab[t][x] + ((i == j) ? 1.0f : 0.f);
                    const int it = m0 + 4 * fq + x, jt = n0 + fr; if (jt >= it) nabT[t][x] = 0.f; }
                st4(RSL(10), orm[t], x1); st4(RSL(12), orm[t], nab[t]); st4(RSL(14), otr[t], nabT[t]);
                st4(RSL(7), orm[t], nak[t]); st4(RSL(8), orm[t], mrb[t]); st4(RSL(9), orm[t], mrk[t]); }
        }
        LBAR();
        {
            const f32x4 z4 = (f32x4){0.f, 0.f, 0.f, 0.f};
            const Fr2 aP = ldf(RSL(12), fm), aN = ldf(RSL(7), fm); Fr2 bT[2], bV[2];
#pragma unroll
            for (int t = 0; t < 2; ++t) { bT[t] = ldf(RSL(14), fn[t]); bV[t] = ldt(RSL(6), tb0[t], tb1[t]); }
            f32x4 q0[2], q1[2], q2[2];
#pragma unroll
            for (int t = 0; t < 2; ++t) { q0[t] = mm<true>(aP, bT[t], z4); q1[t] = mm<false>(aP, bT[t], z4); q2[t] = mm<false>(aN, bV[t], z4); }
#pragma unroll
            for (int t = 0; t < 2; ++t) { st4(RSL(13), orm[t], q0[t]); st4(RSL(15), otr[t], q1[t]); st4(RSL(16), otr[t], q2[t]); }
        }
        LBAR();
#pragma unroll
        for (int kd = 0; kd < 5; ++kd) {
            const int xi = (kd & 1) ? 11 : 10, xo = (kd & 1) ? 10 : 11, pi = (kd & 1) ? 12 : 13, po = (kd & 1) ? 13 : 12, ti = (kd & 1) ? 14 : 15, to = (kd & 1) ? 15 : 14;
            const f32x4 z4 = (f32x4){0.f, 0.f, 0.f, 0.f};
            const Fr2 aX = ldf(RSL(xi), fm), aP = ldf(RSL(pi), fm); Fr2 bT[2]; f32x4 cx[2];
#pragma unroll
            for (int t = 0; t < 2; ++t) { bT[t] = ldf(RSL(ti), fn[t]); cx[t] = ld4(RSL(xi), orm[t]); }
            f32x4 q0[2], q1[2], q2[2];
#pragma unroll
            for (int t = 0; t < 2; ++t) { q0[t] = mm<true>(aX, bT[t], cx[t]); if (kd < 4) { q1[t] = mm<true>(aP, bT[t], z4); q2[t] = mm<false>(aP, bT[t], z4); } }
#pragma unroll
            for (int t = 0; t < 2; ++t) { st4(RSL(xo), orm[t], q0[t]); if (kd < 4) { st4(RSL(po), orm[t], q1[t]); st4(RSL(to), otr[t], q2[t]); } }
            LBAR();
        }
        {
            const f32x4 z4 = (f32x4){0.f, 0.f, 0.f, 0.f};
            const Fr2 aT = ldf(RSL(11), fm); Fr2 bA[2], bZ[2];
#pragma unroll
            for (int t = 0; t < 2; ++t) { bA[t] = ldt(RSL(0), tb0[t], tb1[t]); bZ[t] = ldf(RSL(16), fn[t]); }
            f32x4 q0[2], q1[2];
#pragma unroll
            for (int t = 0; t < 2; ++t) { q0[t] = mm<false>(aT, bA[t], z4); q1[t] = mm<false>(aT, bZ[t], z4); }
#pragma unroll
            for (int t = 0; t < 2; ++t) { st4(RSL(17), otr[t], q0[t]); st4(RSL(18), otr[t], q1[t]); }
        }
        LBAR();
        {
            const f32x4 z4 = (f32x4){0.f, 0.f, 0.f, 0.f};
            f32x4 p1[2], y0[2], gt[2], hh[2];
            {   const Fr2 aMb = ldf(RSL(8), fm), aMk = ldf(RSL(9), fm); Fr2 bW[2], bU[2], bV[2]; f32x4 cR[2];
#pragma unroll
                for (int t = 0; t < 2; ++t) { bW[t] = ldf(RSL(17), fn[t]); bU[t] = ldf(RSL(18), fn[t]); bV[t] = ldt(RSL(6), tb0[t], tb1[t]); cR[t] = ld4(RSL(1), orm[t]); }
#pragma unroll
                for (int t = 0; t < 2; ++t) { p1[t] = mm<true>(aMb, bW[t], cR[t]); y0[t] = mm<true>(aMk, bV[t], mm<true>(aMb, bU[t], z4)); } }
            {   const Fr2 aW = ldf(RSL(17), fm), aU = ldf(RSL(18), fm), aV = ldt(RSL(6), ta0, ta1); Fr2 bBh[2], bKh[2];
#pragma unroll
                for (int t = 0; t < 2; ++t) { bBh[t] = ldt(RSL(4), tb0[t], tb1[t]); bKh[t] = ldt(RSL(5), tb0[t], tb1[t]); }
#pragma unroll
                for (int t = 0; t < 2; ++t) { gt[t] = mm<false>(aW, bBh[t], z4); hh[t] = mm<true>(aV, bKh[t], mm<true>(aU, bBh[t], z4)); } }
#pragma unroll
            for (int t = 0; t < 2; ++t) {
                s_p1[t].x = pkbf(p1[t][0], p1[t][1]); s_p1[t].y = pkbf(p1[t][2], p1[t][3]); s_gt[t].x = pkbf(gt[t][0], gt[t][1]); s_gt[t].y = pkbf(gt[t][2], gt[t][3]);
                s_y0[t].x = pkbf(y0[t][0], y0[t][1]); s_y0[t].y = pkbf(y0[t][2], y0[t][3]); s_hh[t].x = pkbf(hh[t][0], hh[t][1]); s_hh[t].y = pkbf(hh[t][2], hh[t][3]); }
            s_jo = jo; s_have = true;
        }
    }
    if (s_have) P6A_STORE();
#undef P6A_LOAD
#undef P6A_STORE
    LBAR();
}
__device__ __forceinline__ void p6b_rwkv_seq(Frame& F, const RwArgs& A, const RwX& X, int nwg) {
    using namespace rwk;
    LAS unsigned char* lds = F.lds + RING_OFF;
    LAS float* Yf = (LAS float*)RSL(4);
    const int tid = F.tid, tok = tid >> 3, dg = tid & 7, lane = F.lane, fr = lane & 15, fq = lane >> 4;
    const int w = F.wave, m0 = 16 * (w >> 1), n0a = 32 * (w & 1);
    const int fm = swz(m0 + fr, fq * 16), tin = swz(tok, 16 * dg);
    int fn[2], orm[2], otr[2];
#pragma unroll
    for (int t = 0; t < 2; ++t) { const int n0 = n0a + 16 * t; fn[t] = swz(n0 + fr, fq * 16); orm[t] = swz(m0 + fr, 2 * (n0 + 4 * fq)); otr[t] = swz(n0 + fr, 2 * (m0 + 4 * fq)); }
    for (int unit = blockIdx.x; unit < BATCH * NH; unit += nwg) {
        const int b = unit >> 3, h = unit & 7; const int cb = 64 * h + 8 * dg;
        f32x4 sacc[2]; sacc[0] = (f32x4){0.f, 0.f, 0.f, 0.f}; sacc[1] = sacc[0];
        for (int u = tid; u < SLOT / 4; u += NWAVES * 64) ((LAS unsigned*)RSL(2))[u] = 0u;
        float lnw[8], lnb[8]; ld8f(A.ln_w + cb, lnw); ld8f(A.ln_b + cb, lnb);
        v4u n_vb, n_g; u32x2g n_p1[2], n_gt[2], n_y0[2], n_h[2]; f32x4 n_ge[2];
#define P6B_LOAD(cc) do { const int job_ = unit * 32 + (cc); const size_t jo_ = (size_t)job_ * 4096; const size_t grow_ = (size_t)b * SEQ + (cc) * 64 + tok; \
            _Pragma("unroll") for (int t = 0; t < 2; ++t) { n_y0[t] = *(const u32x2g*)(X.Y0 + jo_ + ((w * 2 + t) * 64 + lane) * 4); n_h[t] = *(const u32x2g*)(X.H + jo_ + ((w * 2 + t) * 64 + lane) * 4); \
                n_p1[t] = *(const u32x2g*)(X.P1 + jo_ + ((w * 2 + t) * 64 + lane) * 4); n_gt[t] = *(const u32x2g*)(X.GT + jo_ + ((w * 2 + t) * 64 + lane) * 4); \
                n_ge[t] = *(const f32x4*)(X.GE + (size_t)job_ * 64 + n0a + 16 * t + 4 * fq); } \
            const bf16* vbp_ = (job_ < 2048) ? (X.VB0 + jo_) : (X.VB1 + (jo_ - (size_t)2048 * 4096)); \
            n_vb = *(const v4u*)(vbp_ + tok * 64 + 8 * dg); n_g = *(const v4u*)(A.GB + grow_ * 512 + cb); } while (0)
        P6B_LOAD(0);
        v4u o_w = (v4u){0u, 0u, 0u, 0u}; size_t o_row = 0; bool o_have = false;
        for (int c = 0; c < SEQ / 64; ++c) {
            const int scur = 2 + (c & 1), snxt = 3 - (c & 1);
            const size_t grow = (size_t)b * SEQ + c * 64 + tok;
#pragma unroll
            for (int t = 0; t < 2; ++t) { *(LAS u32x2g*)(RSL(0) + orm[t]) = n_p1[t]; *(LAS u32x2g*)(RSL(1) + otr[t]) = n_gt[t]; }
            f32x4 yacc[2], hcur[2], gecur[2];
#pragma unroll
            for (int t = 0; t < 2; ++t) { yacc[t] = (f32x4){bflo(n_y0[t].x), bfhi(n_y0[t].x), bflo(n_y0[t].y), bfhi(n_y0[t].y)}; hcur[t] = (f32x4){bflo(n_h[t].x), bfhi(n_h[t].x), bflo(n_h[t].y), bfhi(n_h[t].y)}; gecur[t] = n_ge[t]; }
            const v4u vbw = n_vb, gw = n_g;
            if (o_have) *(GAS v4u*)(A.QO + o_row * D + 512 + cb) = o_w;
            if (c + 1 < SEQ / 64) P6B_LOAD(c + 1);
            LBAR();
            {   const Fr2 aP1 = ldf(RSL(0), fm), aS = ldf(RSL(scur), fm); Fr2 bS[2], bG[2];
#pragma unroll
                for (int t = 0; t < 2; ++t) { bS[t] = ldf(RSL(scur), fn[t]); bG[t] = ldf(RSL(1), fn[t]); }
#pragma unroll
                for (int t = 0; t < 2; ++t) { yacc[t] = mm<true>(aP1, bS[t], yacc[t]); sacc[t] = mm<true>(aS, bG[t], sacc[t] * gecur[t] + hcur[t]); }
#pragma unroll
                for (int t = 0; t < 2; ++t) { const int n0 = n0a + 16 * t; *(LAS f32x4*)(Yf + (m0 + fr) * 64 + n0 + 4 * fq) = yacc[t]; st4(RSL(snxt), orm[t], sacc[t]); } }
            LBAR();
            {
                float y[8];
                ld8l(Yf + tok * 64 + 8 * dg, y);
                const float g[8] = {bflo(gw.x), bfhi(gw.x), bflo(gw.y), bfhi(gw.y), bflo(gw.z), bfhi(gw.z), bflo(gw.w), bfhi(gw.w)};
                const float vb[8] = {bflo(vbw.x), bfhi(vbw.x), bflo(vbw.y), bfhi(vbw.y), bflo(vbw.z), bfhi(vbw.z), bflo(vbw.w), bfhi(vbw.w)};
                float s = 0.f;
#pragma unroll
                for (int j = 0; j < 8; ++j) s += y[j];
                const float mean = sum8(s) * (1.0f / 64.0f); float q = 0.f;
#pragma unroll
                for (int j = 0; j < 8; ++j) { y[j] -= mean; q += y[j] * y[j]; }
                const float rstd = __builtin_amdgcn_rsqf(sum8(q) * (1.0f / 64.0f) + LNX_EPS);
                float ov[8];
#pragma unroll
                for (int j = 0; j < 8; ++j) ov[j] = (y[j] * rstd * lnw[j] + lnb[j] + vb[j]) * g[j];
                o_w.x = pkbf(ov[0], ov[1]); o_w.y = pkbf(ov[2], ov[3]); o_w.z = pkbf(ov[4], ov[5]); o_w.w = pkbf(ov[6], ov[7]); o_row = grow; o_have = true;
            }
        }
        if (o_have) *(GAS v4u*)(A.QO + o_row * D + 512 + cb) = o_w;
#undef P6B_LOAD
        LBAR();
    }
}

namespace sba {
using bf16x8 = __attribute__((ext_vector_type(8))) short;
using s16x4 = __attribute__((ext_vector_type(4))) short;
using f32x16 = __attribute__((ext_vector_type(16))) float;
using u32x4 = __attribute__((ext_vector_type(4))) unsigned;
constexpr int QB = 256, KVBLK = 64;
constexpr int LDS_K = 0, LDS_V = 16384, LDS_ST = 32768, ST_LD = 68, LDS_FLAG = LDS_ST + 8 * 32 * ST_LD * 4, LDS_BYTES_ATT = LDS_FLAG + 64;
constexpr float R_DEAD = -160.0f;
#define SBAR() __builtin_amdgcn_sched_barrier(0)
typedef float f32x2_t __attribute__((ext_vector_type(2))); typedef __bf16 bf16x2_t __attribute__((ext_vector_type(2)));
__device__ __forceinline__ unsigned cvtpk_s(float lo, float hi) { f32x2_t v = {lo, hi}; bf16x2_t b = __builtin_convertvector(v, bf16x2_t); return __builtin_bit_cast(unsigned, b); }
__device__ __forceinline__ void qkt(f32x16& p0, f32x16& p1, const char* Kslot, const bf16x8* qr, int r32, int hi) {
    const char* kb = Kslot + hi * 1024 + r32 * 16;
    const f32x16 z = f32x16{};
#pragma unroll
    for (int d0 = 0; d0 < 4; ++d0) {
        const bf16x8 b0 = *reinterpret_cast<const bf16x8*>(kb + d0 * 2048);
        const bf16x8 b1 = *reinterpret_cast<const bf16x8*>(kb + d0 * 2048 + 512);
        if (d0 == 0) { p0 = __builtin_amdgcn_mfma_f32_32x32x16_bf16(b0, qr[0], z, 0, 0, 0); p1 = __builtin_amdgcn_mfma_f32_32x32x16_bf16(b1, qr[0], z, 0, 0, 0); }
        else { p0 = __builtin_amdgcn_mfma_f32_32x32x16_bf16(b0, qr[d0], p0, 0, 0, 0); p1 = __builtin_amdgcn_mfma_f32_32x32x16_bf16(b1, qr[d0], p1, 0, 0, 0); }
    }
}
__device__ __forceinline__ void pv(f32x16* o, int vb, bf16x8 pa0, bf16x8 pa1, bf16x8 pa2, bf16x8 pa3) {
#pragma unroll
    for (int d0 = 0; d0 < 2; ++d0) { s16x4 lo[4], hi[4];
#pragma unroll
        for (int ks = 0; ks < 4; ++ks) {
            asm volatile("ds_read_b64_tr_b16 %0,%1 offset:%c2" : "=&v"(lo[ks]) : "v"(vb), "i"(d0 * 4096 + ks * 1024) : "memory");
            asm volatile("ds_read_b64_tr_b16 %0,%1 offset:%c2" : "=&v"(hi[ks]) : "v"(vb), "i"(d0 * 4096 + ks * 1024 + 512) : "memory"); }
        asm volatile("s_waitcnt lgkmcnt(0)" ::: "memory"); SBAR();
#define PK(k) (bf16x8){lo[k][0], lo[k][1], lo[k][2], lo[k][3], hi[k][0], hi[k][1], hi[k][2], hi[k][3]}
        o[d0] = __builtin_amdgcn_mfma_f32_32x32x16_bf16(pa0, PK(0), o[d0], 0, 0, 0);
        o[d0] = __builtin_amdgcn_mfma_f32_32x32x16_bf16(pa1, PK(1), o[d0], 0, 0, 0);
        o[d0] = __builtin_amdgcn_mfma_f32_32x32x16_bf16(pa2, PK(2), o[d0], 0, 0, 0);
        o[d0] = __builtin_amdgcn_mfma_f32_32x32x16_bf16(pa3, PK(3), o[d0], 0, 0, 0);
#undef PK
    }
}
__device__ __forceinline__ float swap_sum(float x, float& other_if_lo, int hi) {
    auto rr = __builtin_amdgcn_permlane32_swap(__float_as_uint(x), __float_as_uint(x), false, false);
    const float a = __uint_as_float(rr[0]), b = __uint_as_float(rr[1]);
    other_if_lo = hi ? 0.f : b;
    return a + b;
}
__device__ __forceinline__ void attn_wave_unit(int b, int h, int qblk, bf16* QO, const bf16* __restrict__ KB, const bf16* __restrict__ VB, const float* gout, char* wsm  ) {
    const int lane = threadIdx.x & 63, r32 = lane & 31, hi = lane >> 5;
    const long rowbase = (long)b * SEQ; const int q0 = qblk * 32;
    bf16* Qw = QO + (rowbase + q0) * D + h * HD;
    const bf16* Kh = KB + rowbase * SBW + h * HD; const bf16* Vh = VB + rowbase * SBW + h * HD;
    const unsigned lds0 = (unsigned)(uintptr_t)wsm;
    const int jtop = (q0 + 30) >> 6;
    const bf16* vsrc = Vh + (long)(lane >> 3) * SBW + (lane & 7) * 8;
    const int vdst0 = ((lane & 7) >> 2) * 4096 + ((lane >> 3) & 15) * 64 + (lane & 3) * 16;
    const int vb0 = (int)lds0 + ((lane >> 4) & 1) * 32 + (lane & 3) * 8 + (4 * hi + ((lane & 15) >> 2)) * 64;
    const bf16* ksrc = Kh + (long)r32 * SBW + hi * 8;
    bf16x8 qr[4];
#pragma unroll
    for (int d0 = 0; d0 < 4; ++d0) qr[d0] = *reinterpret_cast<const bf16x8*>(&Qw[(long)r32 * D + d0 * 16 + hi * 8]);
    bf16x8 kf[8]; u32x4 vr[8];
#define SBA_LOAD(t) do { const bf16* kp_ = ksrc + (long)(t) * KVBLK * SBW; const bf16* vp_ = vsrc + (long)(t) * KVBLK * SBW; \
        _Pragma("unroll") for (int d0 = 0; d0 < 4; ++d0) { kf[2 * d0] = *reinterpret_cast<const bf16x8*>(kp_ + d0 * 16); kf[2 * d0 + 1] = *reinterpret_cast<const bf16x8*>(kp_ + 32 * SBW + d0 * 16); } \
        _Pragma("unroll") for (int i = 0; i < 8; ++i) vr[i] = *(const u32x4*)(vp_ + (long)(8 * i) * SBW); } while (0)
    SBA_LOAD(jtop);
    float R = 0.f; f32x16 o[2]; o[0] = f32x16{}; o[1] = f32x16{};
    const int qrow = q0 + r32;
    for (int jt = jtop; jt >= 0; --jt) {
        const int cur = (jtop - jt) & 1;
#pragma unroll
        for (int i = 0; i < 8; ++i) *(u32x4*)(wsm + cur * 8192 + vdst0 + (i >> 1) * 1024 + (i & 1) * 512) = vr[i];
        f32x16 p0, p1;
        {   const f32x16 z = f32x16{};
            p0 = __builtin_amdgcn_mfma_f32_32x32x16_bf16(kf[0], qr[0], z, 0, 0, 0); p1 = __builtin_amdgcn_mfma_f32_32x32x16_bf16(kf[1], qr[0], z, 0, 0, 0);
#pragma unroll
            for (int d0 = 1; d0 < 4; ++d0) { p0 = __builtin_amdgcn_mfma_f32_32x32x16_bf16(kf[2 * d0], qr[d0], p0, 0, 0, 0); p1 = __builtin_amdgcn_mfma_f32_32x32x16_bf16(kf[2 * d0 + 1], qr[d0], p1, 0, 0, 0); } }
        if (jt > 0) SBA_LOAD(jt - 1);
        f32x16 lb0, lb1;
        const int kb = 64 * jt + 4 * hi; const bool diag = (jt == jtop);
#pragma unroll
        for (int r = 0; r < 16; ++r) {
            { const float z = p0[r]; const float L = __builtin_amdgcn_logf(1.0f + __builtin_amdgcn_exp2f(z)); float lb = z - L; float l1 = -L;
              if (diag) { const int key = kb + (r & 3) + 8 * (r >> 2); if (key >= qrow) { l1 = 0.f; lb = -1e30f; } }
              lb0[r] = lb; p0[r] = l1; }
            { const float z = p1[r]; const float L = __builtin_amdgcn_logf(1.0f + __builtin_amdgcn_exp2f(z)); float lb = z - L; float l1 = -L;
              if (diag) { const int key = kb + 32 + (r & 3) + 8 * (r >> 2); if (key >= qrow) { l1 = 0.f; lb = -1e30f; } }
              lb1[r] = lb; p1[r] = l1; }
        }
        float c0[4], c1[4], x0[4], x1[4];
#pragma unroll
        for (int g = 0; g < 4; ++g) {
            const float s0 = (p0[4 * g] + p0[4 * g + 1]) + (p0[4 * g + 2] + p0[4 * g + 3]);
            const float s1 = (p1[4 * g] + p1[4 * g + 1]) + (p1[4 * g + 2] + p1[4 * g + 3]);
            c0[g] = swap_sum(s0, x0[g], hi); c1[g] = swap_sum(s1, x1[g], hi);
        }
        float suf0[4], suf1[4];
        suf1[3] = R; suf1[2] = suf1[3] + c1[3]; suf1[1] = suf1[2] + c1[2]; suf1[0] = suf1[1] + c1[1];
        suf0[3] = suf1[0] + c1[0]; suf0[2] = suf0[3] + c0[3]; suf0[1] = suf0[2] + c0[2]; suf0[0] = suf0[1] + c0[1];
        R = suf0[0] + c0[0];
#pragma unroll
        for (int g = 0; g < 4; ++g) {
            { const float e3 = suf0[g] + x0[g], e2 = e3 + p0[4 * g + 3], e1 = e2 + p0[4 * g + 2], e0 = e1 + p0[4 * g + 1];
              p0[4 * g + 3] = __builtin_amdgcn_exp2f(lb0[4 * g + 3] + e3); p0[4 * g + 2] = __builtin_amdgcn_exp2f(lb0[4 * g + 2] + e2);
              p0[4 * g + 1] = __builtin_amdgcn_exp2f(lb0[4 * g + 1] + e1); p0[4 * g] = __builtin_amdgcn_exp2f(lb0[4 * g] + e0); }
            { const float e3 = suf1[g] + x1[g], e2 = e3 + p1[4 * g + 3], e1 = e2 + p1[4 * g + 2], e0 = e1 + p1[4 * g + 1];
              p1[4 * g + 3] = __builtin_amdgcn_exp2f(lb1[4 * g + 3] + e3); p1[4 * g + 2] = __builtin_amdgcn_exp2f(lb1[4 * g + 2] + e2);
              p1[4 * g + 1] = __builtin_amdgcn_exp2f(lb1[4 * g + 1] + e1); p1[4 * g] = __builtin_amdgcn_exp2f(lb1[4 * g] + e0); }
        }
#define PKW(P, B) cvtpk_s(P[B], P[B + 1])
        const u32x4 pw0 = (u32x4){PKW(p0, 0), PKW(p0, 2), PKW(p0, 4), PKW(p0, 6)}, pw1 = (u32x4){PKW(p0, 8), PKW(p0, 10), PKW(p0, 12), PKW(p0, 14)};
        const u32x4 pw2 = (u32x4){PKW(p1, 0), PKW(p1, 2), PKW(p1, 4), PKW(p1, 6)}, pw3 = (u32x4){PKW(p1, 8), PKW(p1, 10), PKW(p1, 12), PKW(p1, 14)};
#undef PKW
        SBAR();
        asm volatile("s_waitcnt lgkmcnt(0)" ::: "memory");
        pv(o, vb0 + cur * 8192, __builtin_bit_cast(bf16x8, pw0), __builtin_bit_cast(bf16x8, pw1), __builtin_bit_cast(bf16x8, pw2), __builtin_bit_cast(bf16x8, pw3));
        if (__all(R < R_DEAD)) break;
    }
#undef SBA_LOAD
    {
        float* stg = (float*)wsm;
        asm volatile("s_waitcnt lgkmcnt(0)" ::: "memory");
#pragma unroll
        for (int r = 0; r < 16; ++r) { const int orow = (r & 3) + 8 * (r >> 2) + 4 * hi;
#pragma unroll
            for (int d0 = 0; d0 < 2; ++d0) stg[orow * ST_LD + d0 * 32 + r32] = o[d0][r]; }
        asm volatile("s_waitcnt lgkmcnt(0)" ::: "memory");
        const int ch = lane & 7;
        const f32x4 ga = *(const f32x4*)(gout + h * HD + ch * 8), gb = *(const f32x4*)(gout + h * HD + ch * 8 + 4);
#pragma unroll
        for (int i = 0; i < 4; ++i) { const int row = i * 8 + (lane >> 3);
            const f32x4 a = *(const f32x4*)(stg + row * ST_LD + ch * 8), c = *(const f32x4*)(stg + row * ST_LD + ch * 8 + 4);
            float ss = (a.x * a.x + a.y * a.y) + (a.z * a.z + a.w * a.w) + (c.x * c.x + c.y * c.y) + (c.z * c.z + c.w * c.w);
            ss = sum8(ss);
            const float hs = __builtin_amdgcn_rsqf(ss * (1.0f / 64.0f) + 1e-6f);
            u32x4 w; w.x = cvtpk_s(a.x * hs * ga.x, a.y * hs * ga.y); w.y = cvtpk_s(a.z * hs * ga.z, a.w * hs * ga.w);
            w.z = cvtpk_s(c.x * hs * gb.x, c.y * hs * gb.y); w.w = cvtpk_s(c.z * hs * gb.z, c.w * hs * gb.w);
            *(u32x4*)(Qw + (long)row * D + ch * 8) = w; }
        asm volatile("s_waitcnt lgkmcnt(0)" ::: "memory");
    }
}
#undef SBAR
__device__ __forceinline__ void attn_phase(Frame& F, bf16* QO, const bf16* KB, const bf16* VB, const float* gout) {
    char* wsm = (char*)F.lds + RING_OFF + F.wave * 16384;
    const int nunits = BATCH * NH * (SEQ / 32);
    for (int u = F.vcu * NWAVES + F.wave; u < nunits; u += F.G * NWAVES) attn_wave_unit(u >> 9, (u >> 6) & 7, u & 63, QO, KB, VB, gout, wsm);
    __syncthreads();
}
}

struct Args { const float* in[26]; float* out; unsigned char* ws; int ph_lo, ph_hi, li, pad; };
__global__ void __launch_bounds__(NWAVES * 64, 2) skel_fwd(Args args) {
    extern __shared__ __attribute__((aligned(16))) unsigned char lds[];
    Frame F;
    F.lds = (LAS unsigned char*)lds;
    F.MISC = (volatile LAS unsigned*)(F.lds + MISC_OFF);
    F.tid = threadIdx.x; F.lane = F.tid & 63; F.wave = __builtin_amdgcn_readfirstlane(F.tid >> 6);
    F.G = gridDim.x; { const int bx = blockIdx.x; F.vcu = (F.G % 8 == 0) ? (bx % 8) * (F.G / 8) + bx / 8 : bx; }
    unsigned char* ws = args.ws;
    F.ctl = (gu32*)(ws + WS_CTL);
    const float* x = args.in[0];
    bf16* W1U = (bf16*)(ws + WS_W1U); bf16* W1D = (bf16*)(ws + WS_W1D); bf16* W2U = (bf16*)(ws + WS_W2U); bf16* W2D = (bf16*)(ws + WS_W2D);
    bf16* WIN = (bf16*)(ws + WS_WIN); bf16* WOUT = (bf16*)(ws + WS_WOUT); bf16* WLORA = (bf16*)(ws + WS_WLORA);
    bf16* XB = (bf16*)(ws + WS_XB); bf16* ACT = (bf16*)(ws + WS_ACT); bf16* QO = (bf16*)(ws + WS_QO); bf16* KB = (bf16*)(ws + WS_KB); bf16* VB = (bf16*)(ws + WS_VB);
    bf16* RW = (bf16*)(ws + WS_RW); bf16* ALORA = (bf16*)(ws + WS_ALORA); float* LW = (float*)(ws + WS_LW); bf16* AB = (bf16*)(ws + WS_AB); bf16* GB = (bf16*)(ws + WS_GB);
    float* SSQ = (float*)(ws + WS_SSQ); float* out = args.out;
    for (int u = F.tid; u < (LDS_BYTES - LDSCTL_OFF) / 4; u += NWAVES * 64) ((LAS unsigned*)(F.lds + LDSCTL_OFF))[u] = 0u;
    __syncthreads();
    XcdBarrier bar; bar.bar = (unsigned*)(F.ctl + CW_BAR); bar.x = 0; bar.st = nullptr;
    if (N_LAUNCHES != PER_PHASE) bar = xcd_barrier_post((unsigned*)(F.ctl + CW_BAR), F.MISC + 8);
#define GRID_BAR(seam) do { if (N_LAUNCHES == PER_PHASE) { if (F.tid == 0) __hip_atomic_store(F.ctl + CW_TMO, 0xBADBA0u | (unsigned)(seam), RLX_AGENT); } else { xcd_barrier(bar); } } while (0)
    const int lo = args.ph_lo, hi = args.ph_hi;
#define IN(k) (lo <= (k) && (k) < hi)
#define BOTH(k) (IN(k) && IN((k) + 1))
    if (IN(0)) {
        p0_prologue(F, x, args.in[1], args.in[2], args.in[3], args.in[4], args.in[5], args.in[6], args.in[12], args.in[14], args.in[15], args.in[21], args.in[22], args.in[23], args.in[24], args.in[25],
                    W1U, W1D, W2U, W2D, WIN, WOUT, WLORA, XB, SSQ); if (BOTH(0)) GRID_BAR(0);
    }
    if (IN(1)) {
        pg8::Gemm g{XB, W1U, M, 2 * FF, D}; pg8::StaticOrder S; S.init(M, 2 * FF, F.G, (int)blockIdx.x);
        pg8::EpiSwiGLU E{ACT, FF, SSQ};
        pg8::gemm_phase<pg8::EpiSwiGLU, pg8::StaticOrder, true, true>(F.lds + RING_OFF, g, S, E);
        if (BOTH(1)) GRID_BAR(1);
    }
    if (IN(2)) {
        pg8::Gemm g{ACT, W1D, M, D, FF}; pg8::StaticOrder S; S.init(M, D, F.G, (int)blockIdx.x);
        pg8::EpiResid E{x, out, XB, SSQ, 0.5f, 1};
        pg8::gemm_phase<pg8::EpiResid, pg8::StaticOrder, true, true>(F.lds + RING_OFF, g, S, E);
        if (BOTH(2)) GRID_BAR(2);
    }
    if (IN(3)) {
        pg8::Gemm g{XB, WIN, M, PW, D}; pg8::StaticOrder S; S.init(M, PW, F.G, (int)blockIdx.x);
        pg8::EpiWin E{QO, KB, VB, RW, SSQ, args.in[7], args.in[8], 0.125f * 1.4426950408889634f};
        pg8::gemm_phase<pg8::EpiWin, pg8::StaticOrder, true, true>(F.lds + RING_OFF, g, S, E);
        if (BOTH(3)) GRID_BAR(3);
    }
    if (IN(4)) { p4_lora_prep(F, RW, args.in[10], ALORA); if (BOTH(4)) GRID_BAR(4); }
    if (IN(5)) {
        int kl = LORA_K; asm volatile("" : "+s"(kl));
        pg8::Gemm g{ALORA, WLORA, M, LORA_N, kl}; pg8::StaticOrder S; S.init(M, LORA_N, F.G, (int)blockIdx.x);
        pg8::EpiLora E{LW, AB, GB, args.in[11], args.in[13]};
        pg8::gemm_phase<pg8::EpiLora, pg8::StaticOrder, true, true>(F.lds + RING_OFF, g, S, E);
        if (BOTH(5)) GRID_BAR(5);
    }
    if (IN(6)) {
        sba::attn_phase(F, QO, KB, VB, args.in[9]);
        if (BOTH(6)) GRID_BAR(6);
    }
    if (IN(7)) {
        RwArgs A{RW, LW, AB, GB, QO, args.in[10], args.in[16], args.in[17], args.in[18], args.in[19], args.in[20]};
        RwX X{KB, VB, XB, XB + (size_t)16 * 1024 * 1024, ALORA, (bf16*)(ws + WS_TAIL), SSQ};
        p6a_rwkv_local(F, A, X);
        GRID_BAR(16);
        p6b_rwkv_seq(F, A, X, F.G);
        __syncthreads();
        if (BOTH(7)) GRID_BAR(7);
    }
    if (IN(8)) {
        pg8::Gemm g{QO, WOUT, M, D, D}; pg8::StaticOrder S; S.init(M, D, F.G, (int)blockIdx.x);
        pg8::EpiResid E{out, out, XB, SSQ, 1.0f, 1};
        pg8::gemm_phase<pg8::EpiResid, pg8::StaticOrder, true, true>(F.lds + RING_OFF, g, S, E);
        if (BOTH(8)) GRID_BAR(8);
    }
    if (IN(9)) {
        pg8::Gemm g{XB, W2U, M, 2 * FF, D}; pg8::StaticOrder S; S.init(M, 2 * FF, F.G, (int)blockIdx.x);
        pg8::EpiSwiGLU E{ACT, FF, SSQ};
        pg8::gemm_phase<pg8::EpiSwiGLU, pg8::StaticOrder, true, true>(F.lds + RING_OFF, g, S, E);
        if (BOTH(9)) GRID_BAR(9);
    }
    if (IN(10)) {
        pg8::Gemm g{ACT, W2D, M, D, FF}; pg8::StaticOrder S; S.init(M, D, F.G, (int)blockIdx.x);
        pg8::EpiResid E{out, out, XB, SSQ, 0.5f, 0};
        pg8::gemm_phase<pg8::EpiResid, pg8::StaticOrder, true, true>(F.lds + RING_OFF, g, S, E);
    }
#undef IN
#undef BOTH
}

extern "C" void kernel_launch(void* const* d_in, const int* in_sizes, int n_in, void* d_out, int out_size, void* d_ws, size_t ws_size, hipStream_t stream) {
    static int grid = 0;
    if (grid == 0) {
        if (n_in != 26 || in_sizes[0] != M * D || out_size != M * D || ws_size < WS_END) { fprintf(stderr, "kernel_launch: unexpected shapes: n_in %d in0 %d out %d ws %zu (need %zu)\n", n_in, n_in > 0 ? in_sizes[0] : -1, out_size, ws_size, (size_t)WS_END); grid = -1; return; }
        int dev = 0, cus = 0, per_cu = 0;
        if (hipGetDevice(&dev) != hipSuccess || hipDeviceGetAttribute(&cus, hipDeviceAttributeMultiprocessorCount, dev) != hipSuccess) { grid = -1; return; }
        if (hipFuncSetAttribute((const void*)skel_fwd, hipFuncAttributeMaxDynamicSharedMemorySize, LDS_BYTES) != hipSuccess) { fprintf(stderr, "kernel_launch: hipFuncSetAttribute failed\n"); grid = -1; return; }
        if (hipOccupancyMaxActiveBlocksPerMultiprocessor(&per_cu, (const void*)skel_fwd, NWAVES * 64, LDS_BYTES) != hipSuccess || per_cu < 1) { fprintf(stderr, "kernel_launch: occupancy query reports %d blocks per CU\n", per_cu); per_cu = 1; }
        (void)hipGetLastError();
        grid = cus;
    }
    if (grid < 0) return;
    if (hipMemsetAsync((char*)d_ws + WS_CTL, 0, CTL_ZERO_BYTES, stream) != hipSuccess) return;
    Args a{};
    for (int i = 0; i < 26; ++i) a.in[i] = (const float*)d_in[i];
    a.out = (float*)d_out; a.ws = (unsigned char*)d_ws;
    for (int li = 0; li < N_LAUNCHES; ++li) {
        a.ph_lo = (N_LAUNCHES == PER_PHASE) ? li : 0; a.ph_hi = (N_LAUNCHES == PER_PHASE) ? li + 1 : PER_PHASE; a.li = li;
        hipLaunchKernelGGL(skel_fwd, dim3(grid), dim3(NWAVES * 64), LDS_BYTES, stream, a);
    }
}
```

```cpp
#include <hip/hip_runtime.h>
#include <hip/hip_bf16.h>
#include <cstdio>
#include <cstdint>
#include <cmath>
namespace pg8 {
#define PG8_LAS __attribute__((address_space(3)))
typedef unsigned short bf16_t;
typedef short bf16x8 __attribute__((ext_vector_type(8)));
typedef float f32x4 __attribute__((ext_vector_type(4)));
typedef unsigned u32x4 __attribute__((ext_vector_type(4)));
constexpr int BM = 256, BK = 64, HALF = 128, HTB = HALF * BK * 2  , STAGE_BYTES = 8 * HTB, NXCD = 8, WGM = 4;

__host__ __device__ __forceinline__ int lds_byte(int r, int c) { const int st = (r >> 4) * 2 + (c >> 5), rr = r & 15, cc = c & 31, ob = rr * 64 + cc * 2; return st * 1024 + (ob ^ (((ob >> 9) & 1) << 5)); }
__host__ __device__ __forceinline__ void stage_rc(int b, int& R, int& C) { const int st = b / 1024, sb = b % 1024, swz = sb ^ (((sb >> 9) & 1) << 5); R = (st >> 1) * 16 + swz / 64; C = (st & 1) * 32 + (swz % 64) / 2; }
__host__ __device__ __forceinline__ int perm32(int rho) { const int n = rho >> 4, i = rho & 15; return 8 * (i >> 2) + 4 * n + (i & 3); }

struct Unit { int pm, pn; };
struct Gemm { const bf16_t* A; const bf16_t* Bt; int M, N, K; int ld; };

struct StaticOrder {
    int nM, nN, nwg, G, c;
    __host__ __device__ void init(int M, int N, int G_, int c_) { nM = M / BM; nN = N / BM; nwg = nM * nN; G = G_; c = c_; }
    __host__ __device__ bool next(int i, Unit& u) const {
        const long L = (long)i * G + c; if (L >= nwg) return false;
        int wgid = (int)L; { const int q = nwg / NXCD, r = nwg % NXCD, xcd = wgid % NXCD, off = wgid / NXCD; wgid = (xcd < r ? xcd * (q + 1) : r * (q + 1) + (xcd - r) * q) + off; }
        const int nig = WGM * nN, gid = wgid / nig, fm = gid * WGM, gsz = (nM - fm) < WGM ? (nM - fm) : WGM;
        u.pm = fm + ((wgid % nig) % gsz); u.pn = (wgid % nig) / gsz; return true;
    }
    __device__ __forceinline__ void a_ready(const Unit&) const {}
    __device__ __forceinline__ void done(const Unit&) const {}
};


__device__ __forceinline__ unsigned cvt_pk_bf16(float lo, float hi) { unsigned r; asm volatile("v_cvt_pk_bf16_f32 %0, %1, %2" : "=v"(r) : "v"(lo), "v"(hi)); return r; }
typedef unsigned u32x2 __attribute__((ext_vector_type(2)));
constexpr float RMS_EPS_F = 1e-6f;
constexpr float LOG2E_F = 1.4426950408889634f;
__device__ __forceinline__ float row_rs(const float* ssqp, int row) {
    const f32x4* p = (const f32x4*)(ssqp + (size_t)row * 16);
    const f32x4 a = p[0], b = p[1], c = p[2], d = p[3];
    const float s = ((a[0] + a[1]) + (a[2] + a[3])) + ((b[0] + b[1]) + (b[2] + b[3])) + ((c[0] + c[1]) + (c[2] + c[3])) + ((d[0] + d[1]) + (d[2] + d[3]));
    return __builtin_amdgcn_rsqf(s * (1.0f / 1024.0f) + RMS_EPS_F);
}
__device__ __forceinline__ float silu_f(float g) { return g * __builtin_amdgcn_rcpf(1.0f + __builtin_amdgcn_exp2f(-g * LOG2E_F)); }
__device__ __forceinline__ float sigmoid_f(float g) { return __builtin_amdgcn_rcpf(1.0f + __builtin_amdgcn_exp2f(-g * LOG2E_F)); }

struct EpiSwiGLU {
    static constexpr bool PERM = true, AFTER_DRAIN = false;
    bf16_t* O; int ldo; const float* ssqp;
    __device__ __forceinline__ void operator()(const f32x4 (&acc)[2][2][4][2], const Unit& u, int wr, int wc, int fr, int fq) const {
        const int row0 = u.pm * BM + wr * 64 + fr, col0 = u.pn * HALF + wc * 32 + 8 * fq;
#pragma unroll
        for (int ai = 0; ai < 2; ++ai)
#pragma unroll
            for (int m = 0; m < 4; ++m) {
                const int row = row0 + ai * HALF + m * 16; const float rs = row_rs(ssqp, row);
                const f32x4 g0 = acc[ai][0][m][0] * rs, g1 = acc[ai][0][m][1] * rs, u0 = acc[ai][1][m][0] * rs, u1 = acc[ai][1][m][1] * rs;
                u32x4 w;
                w.x = cvt_pk_bf16(silu_f(g0[0]) * u0[0], silu_f(g0[1]) * u0[1]); w.y = cvt_pk_bf16(silu_f(g0[2]) * u0[2], silu_f(g0[3]) * u0[3]);
                w.z = cvt_pk_bf16(silu_f(g1[0]) * u1[0], silu_f(g1[1]) * u1[1]); w.w = cvt_pk_bf16(silu_f(g1[2]) * u1[2], silu_f(g1[3]) * u1[3]);
                *(u32x4*)(O + (size_t)row * ldo + col0) = w;
            }
    }
};

struct EpiResid {
    static constexpr bool PERM = true, AFTER_DRAIN = false;
    const float* base; float* out; bf16_t* xb; float* ssqp; float alpha; int aux;
    __device__ __forceinline__ void operator()(const f32x4 (&acc)[2][2][4][2], const Unit& u, int wr, int wc, int fr, int fq) const {
        const int row0 = u.pm * BM + wr * 64 + fr, col0 = u.pn * BM + wc * 32 + 8 * fq;
#pragma unroll
        for (int ai = 0; ai < 2; ++ai)
#pragma unroll
            for (int m = 0; m < 4; ++m) {
                const int row = row0 + ai * HALF + m * 16; const size_t off = (size_t)row * 1024 + col0; float ss = 0.f;
#pragma unroll
                for (int bj = 0; bj < 2; ++bj) {
                    const f32x4 b0 = *(const f32x4*)(base + off + bj * HALF), b1 = *(const f32x4*)(base + off + bj * HALF + 4);
                    const f32x4 v0 = b0 + acc[ai][bj][m][0] * alpha, v1 = b1 + acc[ai][bj][m][1] * alpha;
                    *(f32x4*)(out + off + bj * HALF) = v0; *(f32x4*)(out + off + bj * HALF + 4) = v1;
                    if (aux) { ss += ((v0[0] * v0[0] + v0[1] * v0[1]) + (v0[2] * v0[2] + v0[3] * v0[3])) + ((v1[0] * v1[0] + v1[1] * v1[1]) + (v1[2] * v1[2] + v1[3] * v1[3]));
                        u32x4 w; w.x = cvt_pk_bf16(v0[0], v0[1]); w.y = cvt_pk_bf16(v0[2], v0[3]); w.z = cvt_pk_bf16(v1[0], v1[1]); w.w = cvt_pk_bf16(v1[2], v1[3]); *(u32x4*)(xb + off + bj * HALF) = w; }
                }
                if (aux) { ss += __shfl_xor(ss, 16); ss += __shfl_xor(ss, 32); if (fq == 0) ssqp[(size_t)row * 16 + u.pn * 4 + wc] = ss; }
            }
    }
};

struct EpiWin {
    static constexpr bool PERM = true, AFTER_DRAIN = false;
    bf16_t* QO; bf16_t* KB; bf16_t* VB; bf16_t* RW; const float* ssqp; const float* gq; const float* gk; float qscale;
    __device__ __forceinline__ void operator()(const f32x4 (&acc)[2][2][4][2], const Unit& u, int wr, int wc, int fr, int fq) const {
        const int row0 = u.pm * BM + wr * 64 + fr; const int pn = u.pn;
        if (pn < 4) {
            const float* gp = (pn < 2) ? gq : gk; const float osc = (pn < 2) ? qscale : 1.0f;
            f32x4 gv[2][2];
#pragma unroll
            for (int bj = 0; bj < 2; ++bj)
#pragma unroll
                for (int n = 0; n < 2; ++n) gv[bj][n] = *(const f32x4*)(gp + 32 * bj + 8 * fq + 4 * n) * osc;
            bf16_t* dst = (pn < 2) ? QO : KB; const int ld = (pn < 2) ? 1024 : 512; const int colh = 64 * (4 * (pn & 1) + wc) + 8 * fq;
#pragma unroll
            for (int ai = 0; ai < 2; ++ai)
#pragma unroll
                for (int m = 0; m < 4; ++m) {
                    const int row = row0 + ai * HALF + m * 16; const float rs = row_rs(ssqp, row);
                    f32x4 y[2][2]; float ss = 0.f;
#pragma unroll
                    for (int bj = 0; bj < 2; ++bj)
#pragma unroll
                        for (int n = 0; n < 2; ++n) { y[bj][n] = acc[ai][bj][m][n] * rs; const f32x4 t = y[bj][n]; ss += (t[0] * t[0] + t[1] * t[1]) + (t[2] * t[2] + t[3] * t[3]); }
                    ss += __shfl_xor(ss, 16); ss += __shfl_xor(ss, 32);
                    const float hs = __builtin_amdgcn_rsqf(ss * (1.0f / 64.0f) + RMS_EPS_F);
#pragma unroll
                    for (int bj = 0; bj < 2; ++bj) {
                        const f32x4 a = y[bj][0] * gv[bj][0] * hs, b = y[bj][1] * gv[bj][1] * hs;
                        u32x4 w; w.x = cvt_pk_bf16(a[0], a[1]); w.y = cvt_pk_bf16(a[2], a[3]); w.z = cvt_pk_bf16(b[0], b[1]); w.w = cvt_pk_bf16(b[2], b[3]);
                        *(u32x4*)(dst + (size_t)row * ld + colh + 32 * bj) = w;
                    }
                }
        } else {
            bf16_t* dst = (pn < 6) ? VB : RW; const int ld = (pn < 6) ? 512 : 1792; const int colh = 256 * ((pn < 6) ? (pn - 4) : (pn - 6)) + 64 * wc + 8 * fq;
#pragma unroll
            for (int ai = 0; ai < 2; ++ai)
#pragma unroll
                for (int m = 0; m < 4; ++m) {
                    const int row = row0 + ai * HALF + m * 16; const float rs = row_rs(ssqp, row);
#pragma unroll
                    for (int bj = 0; bj < 2; ++bj) {
                        const f32x4 a = acc[ai][bj][m][0] * rs, b = acc[ai][bj][m][1] * rs;
                        u32x4 w; w.x = cvt_pk_bf16(a[0], a[1]); w.y = cvt_pk_bf16(a[2], a[3]); w.z = cvt_pk_bf16(b[0], b[1]); w.w = cvt_pk_bf16(b[2], b[3]);
                        *(u32x4*)(dst + (size_t)row * ld + colh + 32 * bj) = w;
                    }
                }
        }
    }
};

struct EpiLora {
    static constexpr bool PERM = true, AFTER_DRAIN = false;
    float* LW; bf16_t* AB; bf16_t* GB; const float* w0; const float* a0;
    __device__ __forceinline__ void operator()(const f32x4 (&acc)[2][2][4][2], const Unit& u, int wr, int wc, int fr, int fq) const {
        const int row0 = u.pm * BM + wr * 64 + fr; const int pn = u.pn; const int colt = 256 * (pn & 1) + wc * 32 + 8 * fq;
        const int kind = pn >> 1;
        const float* bp = (kind == 0) ? w0 : a0;
        bf16_t* ob = (kind == 1) ? AB : GB;
#pragma unroll
        for (int bj = 0; bj < 2; ++bj) {
            f32x4 b0 = (f32x4){0.f, 0.f, 0.f, 0.f}, b1 = b0;
            if (kind < 2) { b0 = *(const f32x4*)(bp + colt + bj * HALF); b1 = *(const f32x4*)(bp + colt + bj * HALF + 4); }
#pragma unroll
            for (int ai = 0; ai < 2; ++ai)
#pragma unroll
                for (int m = 0; m < 4; ++m) {
                    const int row = row0 + ai * HALF + m * 16;
                    f32x4 a = acc[ai][bj][m][0] + b0, b = acc[ai][bj][m][1] + b1;
                    if (kind < 2) {
#pragma unroll
                        for (int i = 0; i < 4; ++i) { a[i] = sigmoid_f(a[i]); b[i] = sigmoid_f(b[i]); }
                    }
                    if (kind == 0) { a = a * (-0.6065306597126334f); b = b * (-0.6065306597126334f);
                        float* p = LW + (size_t)row * 512 + colt + bj * HALF; *(f32x4*)p = a; *(f32x4*)(p + 4) = b; }
                    else { u32x4 w; w.x = cvt_pk_bf16(a[0], a[1]); w.y = cvt_pk_bf16(a[2], a[3]); w.z = cvt_pk_bf16(b[0], b[1]); w.w = cvt_pk_bf16(b[2], b[3]);
                        *(u32x4*)(ob + (size_t)row * 512 + colt + bj * HALF) = w; }
                    if (m & 1) asm volatile("" ::: "memory");
                }
        }
    }
};
template <class Epi, class Sched, bool ALIGN_EPI = false, bool SP2 = false>
__device__ __forceinline__ void gemm_phase(PG8_LAS unsigned char* lds, const Gemm g, const Sched& S, const Epi& E) {
    const int tid = threadIdx.x, wid = __builtin_amdgcn_readfirstlane(tid >> 6), lane = tid & 63, wr = wid >> 2, wc = wid & 3, fr = lane & 15, fq = lane >> 4;
    const int K = g.K, nt = K / BK, LDP = g.ld ? g.ld : g.K;
    unsigned voffA[2], voffB[2];
#pragma unroll
    for (int i = 0; i < 2; ++i) { int R, C; stage_rc(tid * 16 + i * 8192, R, C); const int Rb = Epi::PERM ? ((R & ~31) + perm32(R & 31)) : R;
        voffA[i] = (unsigned)(R * LDP + C) * 2u; voffB[i] = (unsigned)(Rb * LDP + C) * 2u; }
    const size_t kstep = (size_t)(BK * 2);
    const size_t hstep = (size_t)HALF * LDP * 2;
    const size_t tstep = 2 * hstep;
    const unsigned ldsw = (unsigned)wid * 1024u;
    const int aoff = lds_byte(wr * 64 + fr, fq * 8), boff = lds_byte(wc * 32 + fr, fq * 8);
#define PG8_SA(b, h) (((b) * 2 + (h)) * HTB)
#define PG8_SB(b, h) ((4 + (b) * 2 + (h)) * HTB)
#define PG8_STAGE(bufoff, gbase, voff) do { _Pragma("unroll") for (int _i = 0; _i < 2; ++_i) \
        __builtin_amdgcn_global_load_lds((const unsigned*)((const char*)(gbase) + (voff)[_i]), (PG8_LAS unsigned*)(lds + (bufoff) + ldsw + _i * 8192), 16, 0, 0); } while (0)
#define PG8_LDA(dst, b, h) do { _Pragma("unroll") for (int m = 0; m < 4; ++m) _Pragma("unroll") for (int k = 0; k < 2; ++k) dst[m][k] = *(const PG8_LAS bf16x8*)(lds + PG8_SA(b, h) + aoff + m * 2048 + k * 1024); } while (0)
#define PG8_LDB(dst, b, h) do { _Pragma("unroll") for (int n = 0; n < 2; ++n) _Pragma("unroll") for (int k = 0; k < 2; ++k) dst[n][k] = *(const PG8_LAS bf16x8*)(lds + PG8_SB(b, h) + boff + n * 2048 + k * 1024); } while (0)
#define PG8_MMA(ai, bj, At, Bt) do { __builtin_amdgcn_s_setprio(1); _Pragma("unroll") for (int m = 0; m < 4; ++m) _Pragma("unroll") for (int n = 0; n < 2; ++n) _Pragma("unroll") for (int k = 0; k < 2; ++k) \
        acc[ai][bj][m][n] = __builtin_amdgcn_mfma_f32_16x16x32_bf16(Bt[n][k], At[m][k], acc[ai][bj][m][n], 0, 0, 0); __builtin_amdgcn_s_setprio(0); } while (0)
#define PG8_WAIT_V(n) asm volatile("s_waitcnt vmcnt(" #n ")" ::: "memory")
#define PG8_WAIT_L(n) asm volatile("s_waitcnt lgkmcnt(" #n ")" ::: "memory")
#define PG8_BAR __builtin_amdgcn_s_barrier()
#define PG8_SCHED __builtin_amdgcn_sched_barrier(0)
    Unit cur, nxt; int ui = 0;
    if (!S.next(0, cur)) return;
    f32x4 acc[2][2][4][2];
#pragma unroll
    for (int a = 0; a < 2; ++a)
#pragma unroll
        for (int b = 0; b < 2; ++b)
#pragma unroll
            for (int m = 0; m < 4; ++m)
#pragma unroll
                for (int n = 0; n < 2; ++n) acc[a][b][m][n] = (f32x4){0.f, 0.f, 0.f, 0.f};
    bf16x8 At[4][2], B0[2][2], B1[2][2];
    const char* cA = (const char*)g.A + (size_t)cur.pm * tstep; const char* cB = (const char*)g.Bt + (size_t)cur.pn * tstep;
    S.a_ready(cur);
    if constexpr (SP2) {
        PG8_STAGE(PG8_SB(0, 0), cB, voffB); PG8_STAGE(PG8_SB(0, 1), cB + hstep, voffB); PG8_STAGE(PG8_SA(0, 0), cA, voffA); PG8_STAGE(PG8_SA(0, 1), cA + hstep, voffA);
        if (wr == 1) PG8_BAR;
        PG8_WAIT_V(2); PG8_BAR;
        PG8_STAGE(PG8_SB(1, 0), cB + kstep, voffB); PG8_STAGE(PG8_SA(1, 0), cA + kstep, voffA); PG8_STAGE(PG8_SB(1, 1), cB + hstep + kstep, voffB);
        PG8_WAIT_V(6); PG8_BAR;
    } else {
        PG8_STAGE(PG8_SB(0, 0), cB, voffB); PG8_STAGE(PG8_SA(0, 0), cA, voffA); PG8_STAGE(PG8_SB(0, 1), cB + hstep, voffB); PG8_STAGE(PG8_SA(0, 1), cA + hstep, voffA);
        if (wr == 1) PG8_BAR;
        PG8_WAIT_V(4); PG8_BAR;
        PG8_STAGE(PG8_SB(1, 0), cB + kstep, voffB); PG8_STAGE(PG8_SA(1, 0), cA + kstep, voffA); PG8_STAGE(PG8_SB(1, 1), cB + hstep + kstep, voffB);
        PG8_WAIT_V(6); PG8_BAR;
    }
    for (;;) {
        const bool has_next = S.next(ui + 1, nxt);
        const char* nA = has_next ? (const char*)g.A + (size_t)nxt.pm * tstep : cA; const char* nB = has_next ? (const char*)g.Bt + (size_t)nxt.pn * tstep : cB;
        for (int t = 0; t < nt; t += 2) {
            const bool last = (t == nt - 2);
            const char* a1 = cA + (size_t)(t + 1) * kstep;
            const char* a2 = last ? nA : cA + (size_t)(t + 2) * kstep; const char* b2 = last ? nB : cB + (size_t)(t + 2) * kstep;
            const char* a3 = a2 + kstep; const char* b3 = b2 + kstep;
            if (last && has_next) S.a_ready(nxt);
            if constexpr (SP2) {
            PG8_LDB(B0, 0, 0); PG8_LDB(B1, 0, 1); PG8_SCHED; PG8_LDA(At, 0, 0); PG8_STAGE(PG8_SA(1, 1), a1 + hstep, voffA);
            PG8_WAIT_V(8); PG8_WAIT_L(0); PG8_BAR; PG8_MMA(0, 0, At, B0); PG8_MMA(0, 1, At, B1); PG8_BAR; PG8_SCHED;
            PG8_LDA(At, 0, 1); PG8_STAGE(PG8_SB(0, 0), b2, voffB); PG8_STAGE(PG8_SB(0, 1), b2 + hstep, voffB); PG8_STAGE(PG8_SA(0, 0), a2, voffA);
            PG8_WAIT_V(8); PG8_WAIT_L(0); PG8_BAR; PG8_MMA(1, 0, At, B0); PG8_MMA(1, 1, At, B1); PG8_BAR; PG8_SCHED;
            PG8_LDB(B0, 1, 0); PG8_LDB(B1, 1, 1); PG8_SCHED; PG8_LDA(At, 1, 0); PG8_STAGE(PG8_SA(0, 1), a2 + hstep, voffA);
            PG8_WAIT_V(8); PG8_WAIT_L(0); PG8_BAR; PG8_MMA(0, 0, At, B0); PG8_MMA(0, 1, At, B1); PG8_BAR; PG8_SCHED;
            PG8_LDA(At, 1, 1); PG8_STAGE(PG8_SB(1, 0), b3, voffB); PG8_STAGE(PG8_SB(1, 1), b3 + hstep, voffB); PG8_STAGE(PG8_SA(1, 0), a3, voffA);
            PG8_WAIT_V(8); PG8_WAIT_L(0); PG8_BAR; PG8_MMA(1, 0, At, B0); PG8_MMA(1, 1, At, B1); PG8_BAR; PG8_SCHED;
            } else {
            PG8_LDB(B0, 0, 0); PG8_SCHED; PG8_LDA(At, 0, 0); PG8_STAGE(PG8_SA(1, 1), a1 + hstep, voffA);
            PG8_WAIT_L(8); PG8_BAR; PG8_WAIT_L(0); PG8_MMA(0, 0, At, B0); PG8_BAR; PG8_SCHED;
            PG8_LDB(B1, 0, 1); PG8_STAGE(PG8_SB(0, 0), b2, voffB);
            PG8_BAR; PG8_WAIT_L(0); PG8_MMA(0, 1, At, B1); PG8_BAR;
            PG8_LDA(At, 0, 1); PG8_STAGE(PG8_SA(0, 0), a2, voffA);
            PG8_BAR; PG8_WAIT_L(0); PG8_MMA(1, 0, At, B0); PG8_BAR; PG8_SCHED;
            PG8_STAGE(PG8_SB(0, 1), b2 + hstep, voffB);
            PG8_WAIT_V(6); PG8_BAR; PG8_MMA(1, 1, At, B1); PG8_BAR;
            PG8_LDB(B0, 1, 0); PG8_SCHED; PG8_LDA(At, 1, 0); PG8_STAGE(PG8_SA(0, 1), a2 + hstep, voffA);
            PG8_WAIT_L(8); PG8_BAR; PG8_WAIT_L(0); PG8_MMA(0, 0, At, B0); PG8_BAR; PG8_SCHED;
            PG8_LDB(B1, 1, 1); PG8_STAGE(PG8_SB(1, 0), b3, voffB);
            PG8_BAR; PG8_WAIT_L(0); PG8_MMA(0, 1, At, B1); PG8_BAR;
            PG8_LDA(At, 1, 1); PG8_STAGE(PG8_SA(1, 0), a3, voffA);
            PG8_BAR; PG8_WAIT_L(0); PG8_MMA(1, 0, At, B0); PG8_BAR; PG8_SCHED;
            PG8_STAGE(PG8_SB(1, 1), b3 + hstep, voffB);
            PG8_WAIT_V(6); PG8_BAR; PG8_MMA(1, 1, At, B1); PG8_BAR;
            }
        }
        if constexpr (ALIGN_EPI) { if (wr == 0) PG8_BAR; }
        if constexpr (!Epi::AFTER_DRAIN) { E(acc, cur, wr, wc, fr, fq); S.done(cur); }
        if (!has_next) break;
#pragma unroll
        for (int a = 0; a < 2; ++a)
#pragma unroll
            for (int b = 0; b < 2; ++b)
#pragma unroll
                for (int m = 0; m < 4; ++m)
#pragma unroll
                    for (int n = 0; n < 2; ++n) acc[a][b][m][n] = (f32x4){0.f, 0.f, 0.f, 0.f};
        cur = nxt; cA = nA; cB = nB; ++ui;
        if constexpr (ALIGN_EPI) { if (wr == 1) PG8_BAR; }
    }
    PG8_WAIT_V(0);
    if constexpr (!ALIGN_EPI) { if (wr == 0) PG8_BAR; }
    PG8_BAR;
    if constexpr (Epi::AFTER_DRAIN) { E.fused(acc, cur, wr, wc, fr, fq, lds, wid, lane); S.done(cur); }
#undef PG8_SA
#undef PG8_SB
#undef PG8_STAGE
#undef PG8_LDA
#undef PG8_LDB
#undef PG8_MMA
#undef PG8_WAIT_V
#undef PG8_WAIT_L
#undef PG8_BAR
#undef PG8_SCHED
}
}
#define GAS __attribute__((address_space(1)))
#define LAS __attribute__((address_space(3)))
typedef unsigned short bf16;
typedef unsigned v4u __attribute__((ext_vector_type(4)));
typedef float f32x4 __attribute__((ext_vector_type(4)));
typedef short bf16x8 __attribute__((ext_vector_type(8)));
typedef GAS unsigned gu32;
typedef GAS unsigned long long gu64;
#define RLX_AGENT __ATOMIC_RELAXED, __HIP_MEMORY_SCOPE_AGENT
#define LDS_WAIT() asm volatile("s_waitcnt lgkmcnt(0)" ::: "memory")
#define VM_WAIT() asm volatile("s_waitcnt vmcnt(0)" ::: "memory")
__device__ __forceinline__ unsigned long long rt() { return __builtin_amdgcn_s_memrealtime(); }
__device__ __forceinline__ unsigned f2bf(float f) { unsigned u = __builtin_bit_cast(unsigned, f); return (u + 0x7fffu + ((u >> 16) & 1u)) >> 16; }
__device__ __forceinline__ unsigned pk2(float lo, float hi) { return f2bf(lo) | (f2bf(hi) << 16); }

#define XB_TMO      128
#define XB_XCNT(j)  (256  + 64 * (j))
#define XB_XSUB(j)  (1280 + 64 * (j))
#define XB_XGEN(j)  (2304 + 64 * (j))
#define XB_TOP      3328
#define XB_TOPGEN   3392
#define XCD_BAR_WORDS 3456
#define XB_SPIN_CAP (1u << 18)

__device__ __forceinline__ unsigned xb_ld(unsigned* p)              { return __hip_atomic_load(p, __ATOMIC_RELAXED, __HIP_MEMORY_SCOPE_AGENT); }
__device__ __forceinline__ unsigned xb_add(unsigned* p, unsigned v) { return __hip_atomic_fetch_add(p, v, __ATOMIC_RELAXED, __HIP_MEMORY_SCOPE_AGENT); }
__device__ __forceinline__ unsigned xb_xcc_id() { return (unsigned)__builtin_amdgcn_s_getreg((3 << 11) | 20) & 0xFu; }
#define XB_SPIN(cond, bar) do { unsigned _sp = 0; while (cond) { __builtin_amdgcn_s_sleep(1); \
    if ((++_sp & 255u) == 0u) { if (xb_ld(&(bar)[XB_TMO])) break; if (_sp > XB_SPIN_CAP) { atomicAdd(&(bar)[XB_TMO], 1u); break; } } } } while (0)

struct XcdBarrier {
    unsigned* bar; unsigned x;
    volatile LAS unsigned* st;
};

__device__ __forceinline__ XcdBarrier xcd_barrier_post(unsigned* bar, volatile LAS unsigned* st) {
    XcdBarrier b; b.bar = bar; b.x = xb_xcc_id(); b.st = st;
    if (threadIdx.x == 0) (void)xb_add(&bar[XB_XCNT(b.x)], 1u);
    return b;
}
__device__ __forceinline__ void xcd_barrier_complete(unsigned* bar, unsigned x, unsigned& nloc, unsigned& nx) {
    const unsigned G = gridDim.x * gridDim.y * gridDim.z;
    unsigned sum, cnt, mine, sp = 0u;
    for (;;) {
        sum = 0u; cnt = 0u; mine = 0u;
#pragma unroll
        for (unsigned j = 0; j < 16; ++j) { const unsigned c = xb_ld(&bar[XB_XCNT(j)]); sum += c; cnt += (c > 0u) ? 1u : 0u; mine = (j == x) ? c : mine; }
        if (sum == G) break;
        __builtin_amdgcn_s_sleep(1);
        if ((++sp & 255u) == 0u) { if (xb_ld(&bar[XB_TMO])) break; if (sp > XB_SPIN_CAP) { atomicAdd(&bar[XB_TMO], 1u); break; } }
    }
    nloc = mine > 0u ? mine : 1u; nx = cnt > 0u ? cnt : 1u;
}

__device__ __forceinline__ void xcd_barrier(const XcdBarrier& b) {
    asm volatile("s_waitcnt vmcnt(0)" ::: "memory");
    __syncthreads();
    if (threadIdx.x == 0) {
        unsigned* bar = b.bar;
        __builtin_amdgcn_s_waitcnt(0);
        unsigned nloc = b.st[0], nx = b.st[1];
        if (nloc == 0u) { xcd_barrier_complete(bar, b.x, nloc, nx); b.st[0] = nloc; b.st[1] = nx; }
        const unsigned old = xb_add(&bar[XB_XSUB(b.x)], 1u);
        const unsigned gen = old / nloc;
        if (old + 1u == (gen + 1u) * nloc) {
            __builtin_amdgcn_fence(__ATOMIC_RELEASE, "agent");
            asm volatile("s_waitcnt vmcnt(0)" ::: "memory");
            const unsigned og = xb_add(&bar[XB_TOP], 1u);
            const unsigned tg = og / nx;
            if (og + 1u == (tg + 1u) * nx) xb_add(&bar[XB_TOPGEN], 1u);
            else XB_SPIN(xb_ld(&bar[XB_TOPGEN]) == tg, bar);
            __builtin_amdgcn_fence(__ATOMIC_ACQUIRE, "agent");
            xb_add(&bar[XB_XGEN(b.x)], 1u);
            asm volatile("s_waitcnt vmcnt(0)" ::: "memory");
        } else {
            XB_SPIN(xb_ld(&bar[XB_XGEN(b.x)]) == gen, bar);
            __builtin_amdgcn_fence(__ATOMIC_ACQUIRE, "agent");
            asm volatile("s_waitcnt vmcnt(0)" ::: "memory");
        }
    }
    __syncthreads();
}

constexpr int NWAVES = 8;
#ifndef MK_N_LAUNCHES
#define MK_N_LAUNCHES 1
#endif
constexpr int PER_PHASE = 11;
constexpr int N_LAUNCHES = MK_N_LAUNCHES;

constexpr int BATCH = 16, SEQ = 2048, D = 1024, HD = 64, NH = 8, FF = 2816;
constexpr int M = BATCH * SEQ;
constexpr int SBW = 512, RWW = 512, RWP = 1792, PW = 3328, LORA_K = 256, LORA_N = 1536;
constexpr float LNX_EPS = 64e-5f;

constexpr size_t MiB = 1u << 20;
constexpr size_t WS_CTL = 0, CTL_ZERO_BYTES = 1 * MiB;
constexpr size_t WS_SSQ = 1 * MiB;
constexpr size_t WS_W1U = 4 * MiB;
constexpr size_t WS_W1D = 15 * MiB;
constexpr size_t WS_W2U = 21 * MiB;
constexpr size_t WS_W2D = 32 * MiB;
constexpr size_t WS_WIN = 38 * MiB;
constexpr size_t WS_WOUT = 45 * MiB;
constexpr size_t WS_WLORA = 47 * MiB;
constexpr size_t WS_XB = 48 * MiB;
constexpr size_t WS_ACT = 112 * MiB;
constexpr size_t WS_QO = 112 * MiB;
constexpr size_t WS_KB = 176 * MiB;
constexpr size_t WS_VB = 208 * MiB;
constexpr size_t WS_RW = 240 * MiB;
constexpr size_t WS_ALORA = 352 * MiB;
constexpr size_t WS_LW = 368 * MiB;
constexpr size_t WS_AB = 432 * MiB;
constexpr size_t WS_GB = 464 * MiB;
constexpr size_t WS_TAIL = 496 * MiB;
constexpr size_t WS_END = 512 * MiB;
constexpr int CW_TMO = 0, CW_CODE = 1;
constexpr int CW_BAR = 4096;

constexpr int RING_OFF = 0, RING_BYTES = 155648;
constexpr int LDSCTL_OFF = RING_BYTES, MISC_OFF = LDSCTL_OFF;
constexpr int LDS_BYTES = 163840;

struct Frame {
    LAS unsigned char* lds;
    volatile LAS unsigned* MISC;
    gu32* ctl;
    int tid, lane, wave;
    int vcu, G;
};
typedef unsigned u32x2g __attribute__((ext_vector_type(2)));
__device__ __forceinline__ float bf2f(unsigned short h) { return __uint_as_float(((unsigned)h) << 16); }
typedef float f32x2h __attribute__((ext_vector_type(2))); typedef __bf16 bf16x2h __attribute__((ext_vector_type(2)));
__device__ __forceinline__ unsigned pkbf(float lo, float hi) { f32x2h v = {lo, hi}; bf16x2h b = __builtin_convertvector(v, bf16x2h); return __builtin_bit_cast(unsigned, b); }
__device__ __forceinline__ float bflo(unsigned w) { return __uint_as_float(w << 16); }
__device__ __forceinline__ float bfhi(unsigned w) { return __uint_as_float(w & 0xffff0000u); }
__device__ __forceinline__ float wave_sum(float v) {
#pragma unroll
    for (int o = 1; o < 64; o <<= 1) v += __shfl_xor(v, o);
    return v;
}
__device__ __forceinline__ float dpp_f(float v, const int ctrl_unused) { return v; }
#define DPP_ADD(v, ctrl) ((v) + __int_as_float(__builtin_amdgcn_update_dpp(0, __float_as_int(v), (ctrl), 0xF, 0xF, true)))
__device__ __forceinline__ float sum8(float v) { v = DPP_ADD(v, 0xB1); v = DPP_ADD(v, 0x4E); v = DPP_ADD(v, 0x141); return v; }

struct TItem { const float* W; int ldw, k0, n0; const float* sc; bf16* WT; int Kd, rho0; };
__device__ __forceinline__ void ti_load(const TItem& T, float (&t)[32], int lane) {
#pragma unroll
    for (int i = 0; i < 32; ++i) t[i] = T.W[(size_t)(T.k0 + 2 * i + (lane >> 5)) * T.ldw + T.n0 + (lane & 31)];
}
__device__ __forceinline__ void ti_finish(const TItem& T, const float (&t)[32], LAS float* scr, int lane) {
#pragma unroll
    for (int i = 0; i < 32; ++i) scr[(2 * i + (lane >> 5)) * 33 + (lane & 31)] = t[i];
    LDS_WAIT(); asm volatile("" ::: "memory");
    const int c = lane & 7;
    f32x4 s0 = (f32x4){1.f, 1.f, 1.f, 1.f}, s1 = s0;
    if (T.sc) { s0 = *(const f32x4*)(T.sc + T.k0 + 8 * c); s1 = *(const f32x4*)(T.sc + T.k0 + 8 * c + 4); }
#pragma unroll
    for (int j = 0; j < 4; ++j) { const int n = (lane >> 3) + 8 * j; const LAS float* s = scr + (8 * c) * 33 + n;
        v4u o; o.x = pkbf(s[0 * 33] * s0.x, s[1 * 33] * s0.y); o.y = pkbf(s[2 * 33] * s0.z, s[3 * 33] * s0.w); o.z = pkbf(s[4 * 33] * s1.x, s[5 * 33] * s1.y); o.w = pkbf(s[6 * 33] * s1.z, s[7 * 33] * s1.w);
        *(GAS v4u*)(T.WT + (size_t)(T.rho0 + n) * T.Kd + T.k0 + 8 * c) = o; }
    LDS_WAIT(); asm volatile("" ::: "memory");
}
#define P0_PTRS const float* Ax, const float* An1, const float* Ag1, const float* Au1, const float* Ad1, const float* Anm, const float* Awin, const float* Aw2, const float* Aa2, const float* Ag2, const float* Awout, \
    const float* An2, const float* Ag2f, const float* Au2f, const float* Ad2f, bf16* AW1U, bf16* AW1D, bf16* AW2U, bf16* AW2D, bf16* AWIN, bf16* AWOUT, bf16* AWLORA, bf16* AXB, float* ASSQ
__device__ __forceinline__ void p0_prologue(Frame& F, P0_PTRS) {
    LAS float* scr = (LAS float*)(F.lds + RING_OFF + F.wave * 16384);
    const int gw = F.vcu * NWAVES + F.wave, NGW = F.G * NWAVES;
    constexpr int I_UP = 16 * 176, I_DN = 44 * 32, I_IN = 16 * 104, I_OUT = 16 * 32;
    constexpr int NITEMS = 2 * (I_UP + I_DN) + I_IN + I_OUT;
#define P0_DECODE(it_, T) do { int r = (it_); \
        if (r < 2 * I_UP) { const int l2 = r >= I_UP; if (l2) r -= I_UP; \
            const int kb = r / 176, nb = r % 176, rho0 = 32 * nb, pn = rho0 >> 8, bj = (rho0 >> 7) & 1, j0 = rho0 & 127; \
            T = TItem{l2 ? (bj ? Au2f : Ag2f) : (bj ? Au1 : Ag1), FF, 64 * kb, 128 * pn + j0, l2 ? An2 : An1, l2 ? AW2U : AW1U, D, rho0}; } \
        else if ((r -= 2 * I_UP) < 2 * I_DN) { const int l2 = r >= I_DN; if (l2) r -= I_DN; const int kb = r / 32, nb = r % 32; \
            T = TItem{l2 ? Ad2f : Ad1, D, 64 * kb, 32 * nb, nullptr, l2 ? AW2D : AW1D, FF, 32 * nb}; } \
        else if ((r -= 2 * I_DN) < I_IN) { const int kb = r / 104, nb = r % 104, rho0 = 32 * nb, pn = rho0 >> 8, rem = rho0 & 255, bj = rem >> 7, wc = (rem & 127) >> 5; \
            T = TItem{Awin, PW, 64 * kb, 256 * pn + 64 * wc + 32 * bj, Anm, AWIN, D, rho0}; } \
        else { r -= I_IN; const int kb = r / 32, nb = r % 32; T = TItem{Awout, D, 64 * kb, 32 * nb, nullptr, AWOUT, D, 32 * nb}; } } while (0)
    for (int it = gw; it < NITEMS; it += 2 * NGW) {
        TItem T0, T1; float t0[32], t1[32]; const bool two = (it + NGW < NITEMS);
        P0_DECODE(it, T0); ti_load(T0, t0, F.lane);
        if (two) { P0_DECODE(it + NGW, T1); ti_load(T1, t1, F.lane); }
        ti_finish(T0, t0, scr, F.lane);
        if (two) ti_finish(T1, t1, scr, F.lane);
    }
#undef P0_DECODE
    for (int it = F.vcu * (NWAVES * 64) + F.tid; it < 512 * 32; it += F.G * NWAVES * 64) {
        int ch, kc, Kk; const float* src; bf16* dst;
        if (it < 512 * 8) { ch = it >> 3; kc = (it & 7) * 8; Kk = 64; src = Aw2; dst = AWLORA; }
        else if (it < 512 * 16) { const int i2 = it - 512 * 8; ch = i2 >> 3; kc = (i2 & 7) * 8; Kk = 64; src = Aa2; dst = AWLORA + 512 * 64; }
        else { const int i2 = it - 512 * 16; ch = i2 >> 4; kc = (i2 & 15) * 8; Kk = 128; src = Ag2; dst = AWLORA + 2 * 512 * 64; }
        float v[8];
#pragma unroll
        for (int j = 0; j < 8; ++j) v[j] = src[(size_t)(kc + j) * 512 + ch];
        v4u o; o.x = pkbf(v[0], v[1]); o.y = pkbf(v[2], v[3]); o.z = pkbf(v[4], v[5]); o.w = pkbf(v[6], v[7]);
        *(GAS v4u*)(dst + (size_t)ch * Kk + kc) = o;
    }
    for (int mb = gw; mb < M; mb += 4 * NGW) {
        f32x4 v[4][4]; float s[4];
#pragma unroll
        for (int q = 0; q < 4; ++q) { const int m = mb + q * NGW; const GAS f32x4* xr = (const GAS f32x4*)(Ax + (size_t)(m < M ? m : mb) * D) + F.lane;
#pragma unroll
            for (int j = 0; j < 4; ++j) v[q][j] = xr[64 * j]; }
#pragma unroll
        for (int q = 0; q < 4; ++q) { float a = 0.f;
#pragma unroll
            for (int j = 0; j < 4; ++j) a += (v[q][j].x * v[q][j].x + v[q][j].y * v[q][j].y) + (v[q][j].z * v[q][j].z + v[q][j].w * v[q][j].w);
            s[q] = a; }
#pragma unroll
        for (int o = 1; o < 64; o <<= 1) {
#pragma unroll
            for (int q = 0; q < 4; ++q) s[q] += __shfl_xor(s[q], o); }
#pragma unroll
        for (int q = 0; q < 4; ++q) { const int m = mb + q * NGW; if (m < M) {
            GAS unsigned long long* o8 = (GAS unsigned long long*)(AXB + (size_t)m * D) + F.lane;
#pragma unroll
            for (int j = 0; j < 4; ++j) o8[64 * j] = (unsigned long long)pkbf(v[q][j].x, v[q][j].y) | ((unsigned long long)pkbf(v[q][j].z, v[q][j].w) << 32);
            if (F.lane < 16) ASSQ[(size_t)m * 16 + F.lane] = (F.lane == 0) ? s[q] : 0.f; } }
    }
}

__device__ __forceinline__ void p4_lora_prep(Frame& F, const bf16* RW, const float* mu, bf16* ALORA) {
    const int gw = F.vcu * NWAVES + F.wave, NGW = F.G * NWAVES; const int l = F.lane;
    const f32x4 muv = *(const f32x4*)(mu + 1536 + 4 * l);
    for (int m = gw; m < M; m += NGW) {
        const u32x2g c = *(const u32x2g*)(RW + (size_t)m * RWP + 1536 + 4 * l);
        u32x2g p = (u32x2g){0u, 0u};
        if ((m & (SEQ - 1)) != 0) p = *(const u32x2g*)(RW + (size_t)(m - 1) * RWP + 1536 + 4 * l);
        float x[4] = {bflo(c.x), bfhi(c.x), bflo(c.y), bfhi(c.y)}; const float q[4] = {bflo(p.x), bfhi(p.x), bflo(p.y), bfhi(p.y)};
#pragma unroll
        for (int i = 0; i < 4; ++i) { float u = x[i] + (q[i] - x[i]) * muv[i];
            if (l < 16) u = 2.0f * pg8::sigmoid_f(2.0f * u) - 1.0f; else if (l >= 32) u = pg8::sigmoid_f(u);
            x[i] = u; }
        u32x2g o; o.x = pkbf(x[0], x[1]); o.y = pkbf(x[2], x[3]);
        *(u32x2g*)(ALORA + (size_t)m * LORA_K + 4 * l) = o;
    }
}

struct RwArgs { const bf16* RW; const bf16* W2T; const bf16* A2T; const bf16* G2T; const float* w0; const float* a0; bf16* QO; const float *mu, *k_k, *k_a, *r_k, *ln_w, *ln_b; };
__device__ __forceinline__ void ld8bf(const bf16* p, float (&o)[8]) { const v4u w = *(const v4u*)p; o[0] = bflo(w.x); o[1] = bfhi(w.x); o[2] = bflo(w.y); o[3] = bfhi(w.y); o[4] = bflo(w.z); o[5] = bfhi(w.z); o[6] = bflo(w.w); o[7] = bfhi(w.w); }
__device__ __forceinline__ void ld8f(const float* p, float (&o)[8]) { const f32x4 a = *(const f32x4*)p, b = *(const f32x4*)(p + 4); o[0] = a.x; o[1] = a.y; o[2] = a.z; o[3] = a.w; o[4] = b.x; o[5] = b.y; o[6] = b.z; o[7] = b.w; }
__device__ __forceinline__ void ld8l(const LAS float* p, float (&o)[8]) { const f32x4 a = *(const LAS f32x4*)p, b = *(const LAS f32x4*)(p + 4); o[0] = a.x; o[1] = a.y; o[2] = a.z; o[3] = a.w; o[4] = b.x; o[5] = b.y; o[6] = b.z; o[7] = b.w; }
__device__ __forceinline__ void st8l(LAS float* p, const float (&o)[8]) { *(LAS f32x4*)p = (f32x4){o[0], o[1], o[2], o[3]}; *(LAS f32x4*)(p + 4) = (f32x4){o[4], o[5], o[6], o[7]}; }
namespace rwk {
typedef short bf16x8 __attribute__((ext_vector_type(8)));
typedef short s16x4 __attribute__((ext_vector_type(4)));
typedef short v4i16_t __attribute__((ext_vector_type(4)));
constexpr int SLOT = 8192;
#define RSL(s) (lds + (s) * SLOT)
#define RMFMA(a, b, c) __builtin_amdgcn_mfma_f32_16x16x32_bf16((a), (b), (c), 0, 0, 0)
__device__ __forceinline__ int swz(int row, int cb) { return row * 128 + (cb ^ ((row & 7) << 4)); }
struct Fr2 { bf16x8 k0, k1; };
__device__ __forceinline__ Fr2 ldf(const LAS unsigned char* base, int off) { Fr2 f; f.k0 = *(const LAS bf16x8*)(base + off); f.k1 = *(const LAS bf16x8*)(base + (off ^ 64)); return f; }
__device__ __forceinline__ s16x4 trd(const LAS unsigned char* p) { return __builtin_bit_cast(s16x4, __builtin_amdgcn_ds_read_tr16_b64_v4i16((LAS v4i16_t*)p)); }
__device__ __forceinline__ Fr2 ldt(const LAS unsigned char* base, int o0, int o1) {
    const s16x4 a = trd(base + o0), b = trd(base + o1), c = trd(base + o0 + 4096), d = trd(base + o1 + 4096);
    Fr2 f; f.k0 = (bf16x8){a[0], a[1], a[2], a[3], b[0], b[1], b[2], b[3]}; f.k1 = (bf16x8){c[0], c[1], c[2], c[3], d[0], d[1], d[2], d[3]}; return f; }
template <bool SWAP> __device__ __forceinline__ f32x4 mm(const Fr2& a, const Fr2& b, f32x4 c) {
    if (SWAP) { c = RMFMA(b.k0, a.k0, c); c = RMFMA(b.k1, a.k1, c); } else { c = RMFMA(a.k0, b.k0, c); c = RMFMA(a.k1, b.k1, c); } return c; }
__device__ __forceinline__ void st4(LAS unsigned char* slot, int off, f32x4 v) { u32x2g w; w.x = pkbf(v[0], v[1]); w.y = pkbf(v[2], v[3]); *(LAS u32x2g*)(slot + off) = w; }
__device__ __forceinline__ f32x4 ld4(const LAS unsigned char* slot, int off) { const u32x2g w = *(const LAS u32x2g*)(slot + off); return (f32x4){bflo(w.x), bfhi(w.x), bflo(w.y), bfhi(w.y)}; }
#define LBAR() asm volatile("s_waitcnt lgkmcnt(0)\n\ts_barrier" ::: "memory")
#define DPPF(x, ctrl, rmask) __int_as_float(__builtin_amdgcn_update_dpp(0, __float_as_int(x), (ctrl), (rmask), 0xF, true))
__device__ __forceinline__ float wave_scan(float x) {
    x += DPPF(x, 0x111, 0xF); x += DPPF(x, 0x112, 0xF); x += DPPF(x, 0x114, 0xF); x += DPPF(x, 0x118, 0xF);
    x += DPPF(x, 0x142, 0xA);
    x += DPPF(x, 0x143, 0xC);
    return x; }
__device__ __forceinline__ void unp8(const v4u w, float (&o)[8]) { o[0] = bflo(w.x); o[1] = bfhi(w.x); o[2] = bflo(w.y); o[3] = bfhi(w.y); o[4] = bflo(w.z); o[5] = bfhi(w.z); o[6] = bflo(w.w); o[7] = bfhi(w.w); }
__device__ __forceinline__ v4u pk8(const float (&o)[8]) { return (v4u){pkbf(o[0], o[1]), pkbf(o[2], o[3]), pkbf(o[4], o[5]), pkbf(o[6], o[7])}; }
}
struct RwX { bf16* P1; bf16* GT; bf16* Y0; bf16* H; bf16* VB0; bf16* VB1; float* GE; bf16* G; };
__device__ __forceinline__ void p6a_rwkv_local(Frame& F, const RwArgs& A, const RwX& X) {
    using namespace rwk;
    LAS unsigned char* lds = F.lds + RING_OFF;
    LAS float* part = (LAS float*)(F.lds + LDSCTL_OFF + 128);
    LAS float* cst = (LAS float*)(F.lds + LDSCTL_OFF + 128 + 4096 + 896);
    const int lane = F.lane, fr = lane & 15, fq = lane >> 4, w = F.wave, m0 = 16 * (w >> 1), n0a = 32 * (w & 1);
    const int fm = swz(m0 + fr, fq * 16);
    const int ta0 = swz(8 * fq + (fr >> 2), 2 * (m0 + 4 * (fr & 3))), ta1 = swz(8 * fq + 4 + (fr >> 2), 2 * (m0 + 4 * (fr & 3)));
    int fn[2], orm[2], otr[2], tb0[2], tb1[2];
#pragma unroll
    for (int t = 0; t < 2; ++t) { const int n0 = n0a + 16 * t; fn[t] = swz(n0 + fr, fq * 16); orm[t] = swz(m0 + fr, 2 * (n0 + 4 * fq)); otr[t] = swz(n0 + fr, 2 * (m0 + 4 * fq));
        tb0[t] = swz(8 * fq + (fr >> 2), 2 * (n0 + 4 * (fr & 3))); tb1[t] = swz(8 * fq + 4 + (fr >> 2), 2 * (n0 + 4 * (fr & 3))); }
    const int NJ = BATCH * NH * (SEQ / 64);
    const int tid = F.tid, ltok = tid >> 3, ldg = tid & 7;
    v4u g_r, g_k, g_v, g_xw, g_xa, g_xg0, g_xg1, g_pr;
#define P6A_LOAD(jj) do { const int u_ = (jj) >> 5, c_ = (jj) & 31; const size_t gr_ = (size_t)(u_ >> 3) * SEQ + c_ * 64 + ltok; const int cb_ = 64 * (u_ & 7) + 8 * ldg; const bf16* rp_ = A.RW + gr_ * RWP; \
        g_r = *(const v4u*)(rp_ + cb_); g_k = *(const v4u*)(rp_ + 512 + cb_); g_v = *(const v4u*)(rp_ + 1024 + cb_); \
        g_xw = *(const v4u*)(rp_ + 1536 + 8 * ldg); g_xa = *(const v4u*)(rp_ + 1600 + 8 * ldg); g_xg0 = *(const v4u*)(rp_ + 1664 + 8 * ldg); g_xg1 = *(const v4u*)(rp_ + 1728 + 8 * ldg); \
        g_pr = (v4u){0u, 0u, 0u, 0u}; if (ltok < 7 && c_ > 0) g_pr = *(const v4u*)(A.RW + ((size_t)(u_ >> 3) * SEQ + c_ * 64 - 1) * RWP + (ltok < 3 ? 512 * ltok + cb_ : 1536 + 64 * (ltok - 3) + 8 * ldg)); } while (0)
    if ((int)blockIdx.x < NJ) P6A_LOAD((int)blockIdx.x);
    int hcur = -1;
    LAS unsigned char* prow = (LAS unsigned char*)(F.lds + LDSCTL_OFF + 128 + 4096);
    if (tid < 256) cst[512 + tid] = A.mu[1536 + tid];
    u32x2g s_p1[2], s_gt[2], s_y0[2], s_hh[2]; size_t s_jo = 0; bool s_have = false;
#define P6A_STORE() do { _Pragma("unroll") for (int t = 0; t < 2; ++t) { \
            *(u32x2g*)(X.P1 + s_jo + ((w * 2 + t) * 64 + lane) * 4) = s_p1[t]; *(u32x2g*)(X.GT + s_jo + ((w * 2 + t) * 64 + lane) * 4) = s_gt[t]; \
            *(u32x2g*)(X.Y0 + s_jo + ((w * 2 + t) * 64 + lane) * 4) = s_y0[t]; *(u32x2g*)(X.H + s_jo + ((w * 2 + t) * 64 + lane) * 4) = s_hh[t]; } } while (0)
    for (int job = blockIdx.x; job < NJ; job += F.G) {
        const int unit = job >> 5, c = job & 31; const int h = unit & 7; const int cb = 64 * h + 8 * w; const size_t jo = (size_t)job * 4096;
        {
            const int so = swz(ltok, 16 * ldg);
            *(LAS v4u*)(RSL(12) + so) = g_r; *(LAS v4u*)(RSL(2) + so) = g_k; *(LAS v4u*)(RSL(0) + so) = g_v;
            *(LAS v4u*)(RSL(14) + so) = g_xw; *(LAS v4u*)(RSL(13) + so) = g_xa; *(LAS v4u*)(RSL(10) + so) = g_xg0; *(LAS v4u*)(RSL(11) + so) = g_xg1;
            if (ltok < 7) *(LAS v4u*)(prow + ltok * 128 + 16 * ldg) = g_pr;
            if (h != hcur) {
                *(LAS v4u*)(RSL(16) + so) = *(const v4u*)(A.W2T + (size_t)(64 * h + ltok) * 64 + 8 * ldg); *(LAS v4u*)(RSL(17) + so) = *(const v4u*)(A.A2T + (size_t)(64 * h + ltok) * 64 + 8 * ldg);
                { const int a_ = tid >> 6, i_ = tid & 63;
                  const float* src_ = (a_ == 0) ? A.mu : (a_ == 1) ? A.mu + 512 : (a_ == 2) ? A.mu + 1024 : (a_ == 3) ? A.k_k : (a_ == 4) ? A.k_a : (a_ == 5) ? A.r_k : (a_ == 6) ? A.w0 : A.a0;
                  cst[a_ * 64 + i_] = src_[64 * h + i_]; } }
            hcur = h;
        }
        if (s_have) P6A_STORE();
        { const int nj = job + F.G; if (nj < NJ) P6A_LOAD(nj); }
        LBAR();
        float r[8], k[8], v[8];
        {
            const int so = swz(lane, 16 * w), sp = swz((lane + 63) & 63, 16 * w);
#define P6A_SHIFT(slot, pi, moff, dst) do { float c_[8], p_[8], m_[8]; v4u wc_ = *(const LAS v4u*)(RSL(slot) + so), wp_ = *(const LAS v4u*)(RSL(slot) + sp); \
                if (lane == 0) wp_ = *(const LAS v4u*)(prow + 128 * (pi) + 16 * w); \
                unp8(wc_, c_); unp8(wp_, p_); ld8l(cst + (moff) + 8 * w, m_); \
                _Pragma("unroll") for (int j = 0; j < 8; ++j) dst[j] = c_[j] + (p_[j] - c_[j]) * m_[j]; } while (0)
            P6A_SHIFT(12, 0, 0, r); asm volatile("" ::: "memory");
            P6A_SHIFT(2, 1, 64, k); asm volatile("" ::: "memory");
            P6A_SHIFT(0, 2, 128, v); asm volatile("" ::: "memory");
            { float x_[8]; P6A_SHIFT(14, 3, 512, x_);
#pragma unroll
              for (int j = 0; j < 8; ++j) x_[j] = 2.0f * pg8::sigmoid_f(2.0f * x_[j]) - 1.0f;
              *(LAS v4u*)(RSL(14) + so) = pk8(x_); } asm volatile("" ::: "memory");
            { float x_[8]; P6A_SHIFT(13, 4, 576, x_); *(LAS v4u*)(RSL(13) + so) = pk8(x_); } asm volatile("" ::: "memory");
            { float x_[8]; P6A_SHIFT(10, 5, 640, x_);
#pragma unroll
              for (int j = 0; j < 8; ++j) x_[j] = pg8::sigmoid_f(x_[j]);
              *(LAS v4u*)(RSL(10) + so) = pk8(x_); } asm volatile("" ::: "memory");
            { float x_[8]; P6A_SHIFT(11, 6, 704, x_);
#pragma unroll
              for (int j = 0; j < 8; ++j) x_[j] = pg8::sigmoid_f(x_[j]);
              *(LAS v4u*)(RSL(11) + so) = pk8(x_); }
#undef P6A_SHIFT
        }
        LBAR();
        {
            const f32x4 z4 = (f32x4){0.f, 0.f, 0.f, 0.f};
            bf16x8 gq[2][4];
#pragma unroll
            for (int t = 0; t < 2; ++t) { const bf16* gp = A.G2T + (size_t)(64 * h + n0a + 16 * t + fr) * 128 + 8 * fq;
#pragma unroll
                for (int q = 0; q < 4; ++q) gq[t][q] = *reinterpret_cast<const bf16x8*>(gp + 32 * q); }
            {   const Fr2 aW = ldf(RSL(14), fm), aA = ldf(RSL(13), fm); Fr2 bW[2], bA[2];
#pragma unroll
                for (int t = 0; t < 2; ++t) { bW[t] = ldf(RSL(16), fn[t]); bA[t] = ldf(RSL(17), fn[t]); }
#pragma unroll
                for (int t = 0; t < 2; ++t) { const int row = m0 + fr, ch = n0a + 16 * t + 4 * fq; const f32x4 lwq = mm<true>(aW, bW[t], z4), alq = mm<true>(aA, bA[t], z4);
                    const f32x4 w0c = *(const LAS f32x4*)(cst + 384 + ch), a0c = *(const LAS f32x4*)(cst + 448 + ch); f32x4 lwv, alv;
#pragma unroll
                    for (int x = 0; x < 4; ++x) { lwv[x] = -0.6065306597126334f * pg8::sigmoid_f(w0c[x] + lwq[x]); alv[x] = pg8::sigmoid_f(a0c[x] + alq[x]); }
                    const int fo = row * 256 + (((ch >> 3) ^ (row & 7)) << 5) + ((ch >> 2) & 1) * 16;
                    *(LAS f32x4*)(RSL(4) + fo) = lwv; *(LAS f32x4*)(RSL(8) + fo) = alv; } }
            asm volatile("" ::: "memory");
            {   const Fr2 aG0 = ldf(RSL(10), fm), aG1 = ldf(RSL(11), fm);
#pragma unroll
                for (int t = 0; t < 2; ++t) { Fr2 bG0, bG1; bG0.k0 = gq[t][0]; bG0.k1 = gq[t][1]; bG1.k0 = gq[t][2]; bG1.k1 = gq[t][3];
                    st4(RSL(3), orm[t], mm<true>(aG1, bG1, mm<true>(aG0, bG0, z4))); } }
        }
        LBAR();
        float kf[8], kk[8], al[8], lw[8]; float ssp = 0.f, bpp = 0.f;
        {
            { const int fo = lane * 256 + ((w ^ (lane & 7)) << 5); const f32x4 a_ = *(const LAS f32x4*)(RSL(4) + fo), b_ = *(const LAS f32x4*)(RSL(4) + fo + 16), c_ = *(const LAS f32x4*)(RSL(8) + fo), d_ = *(const LAS f32x4*)(RSL(8) + fo + 16);
              lw[0] = a_.x; lw[1] = a_.y; lw[2] = a_.z; lw[3] = a_.w; lw[4] = b_.x; lw[5] = b_.y; lw[6] = b_.z; lw[7] = b_.w;
              al[0] = c_.x; al[1] = c_.y; al[2] = c_.z; al[3] = c_.w; al[4] = d_.x; al[5] = d_.y; al[6] = d_.z; al[7] = d_.w; }
            *(v4u*)(X.G + jo + tid * 8) = *(const LAS v4u*)(RSL(3) + swz(ltok, 16 * ldg));
            float kkc[8], kac[8], rkc[8]; ld8l(cst + 192 + 8 * w, kkc); ld8l(cst + 256 + 8 * w, kac); ld8l(cst + 320 + 8 * w, rkc);
#pragma unroll
            for (int j = 0; j < 8; ++j) { kk[j] = k[j] * kkc[j]; ssp += kk[j] * kk[j]; kf[j] = k[j] * (1.0f + (al[j] - 1.0f) * kac[j]); bpp += r[j] * kf[j] * rkc[j]; }
            part[w * 64 + lane] = ssp; part[512 + w * 64 + lane] = bpp;
        }
        LBAR();
        {
            float ss = 0.f, bon = 0.f;
#pragma unroll
            for (int i = 0; i < 8; ++i) { ss += part[i * 64 + lane]; bon += part[512 + i * 64 + lane]; }
            const float inv = 1.0f / fmaxf(sqrtf(ss), 1e-12f);
            float at[8], rt[8], bt[8], kt[8], bh[8], kh[8], ge[8], vb[8];
#pragma unroll
            for (int j = 0; j < 8; ++j) {
                const float cs = wave_scan(lw[j]);
                const float ce = __int_as_float(__builtin_amdgcn_readlane(__float_as_int(cs), 63));
                const float e_cs = __builtin_amdgcn_exp2f(cs * 1.4426950408889634f), e_csm = __builtin_amdgcn_exp2f((cs - lw[j]) * 1.4426950408889634f);
                const float e_neg = __builtin_amdgcn_rcpf(e_cs), e_end = __builtin_amdgcn_exp2f((ce - cs) * 1.4426950408889634f);
                const float kn = kk[j] * inv, bb = kn * al[j];
                at[j] = -kn * e_csm; rt[j] = r[j] * e_cs; bt[j] = bb * e_neg; kt[j] = kf[j] * e_neg; bh[j] = bb * e_end; kh[j] = kf[j] * e_end; ge[j] = e_cs; vb[j] = bon * v[j];
            }
            const int ro = swz(lane, 16 * w);
            *(LAS v4u*)(RSL(0) + ro) = pk8(at); *(LAS v4u*)(RSL(1) + ro) = pk8(rt); *(LAS v4u*)(RSL(2) + ro) = pk8(bt); *(LAS v4u*)(RSL(3) + ro) = pk8(kt);
            *(LAS v4u*)(RSL(4) + ro) = pk8(bh); *(LAS v4u*)(RSL(5) + ro) = pk8(kh); *(LAS v4u*)(RSL(6) + ro) = pk8(v);
            if (lane == 63) { *(f32x4*)(X.GE + (size_t)job * 64 + 8 * w) = (f32x4){ge[0], ge[1], ge[2], ge[3]}; *(f32x4*)(X.GE + (size_t)job * 64 + 8 * w + 4) = (f32x4){ge[4], ge[5], ge[6], ge[7]}; }
            *(LAS v4u*)(RSL(18) + ro) = pk8(vb);
        }
        LBAR();
        {
            { bf16* vbp = (job < 2048) ? (X.VB0 + jo) : (X.VB1 + (jo - (size_t)2048 * 4096)); *(v4u*)(vbp + tid * 8) = *(const LAS v4u*)(RSL(18) + swz(ltok, 16 * ldg)); }
            const f32x4 z4 = (f32x4){0.f, 0.f, 0.f, 0.f};
            const Fr2 aA = ldf(RSL(0), fm), aR = ldf(RSL(1), fm); Fr2 bB[2], bK[2];
#pragma unroll
            for (int t = 0; t < 2; ++t) { bB[t] = ldf(RSL(2), fn[t]); bK[t] = ldf(RSL(3), fn[t]); }
            f32x4 nab[2], nabT[2], nak[2], mrb[2], mrk[2];
#pragma unroll
            for (int t = 0; t < 2; ++t) { nab[t] = mm<true>(aA, bB[t], z4); nabT[t] = mm<false>(aA, bB[t], z4); nak[t] = mm<true>(aA, bK[t], z4); mrb[t] = mm<true>(aR, bB[t], z4); mrk[t] = mm<true>(aR, bK[t], z4); }
#pragma unroll
            for (int t = 0; t < 2; ++t) { const int n0 = n0a + 16 * t; f32x4 x1;
#pragma unroll
                for (int x = 0; x < 4; ++x) { const int i = m0 + fr, j = n0 + 4 * fq + x;
                    if (j >= i) { nab[t][x] = 0.f; nak[t][x] = 0.f; } if (j > i) { mrb[t][x] = 0.f; mrk[t][x] = 0.f; }
                    x1[x] = nab[t][x] + ((i == j) ? 1.0f : 0.f);
                    const int it = m0 + 4 * fq + x, jt = n0 + fr; if (jt >= it) nabT[t][x] = 0.f; }
                st4(RSL(10), orm[t], x1); st4(RSL(12), orm[t], nab[t]); st4(RSL(14), otr[t], nabT[t]);
                st4(RSL(7), orm[t], nak[t]); st4(RSL(8), orm[t], mrb[t]); st4(RSL(9), orm[t], mrk[t]); }
        }
        LBAR();
        {
            const f32x4 z4 = (f32x4){0.f, 0.f, 0.f, 0.f};
            const Fr2 aP = ldf(RSL(12), fm), aN = ldf(RSL(7), fm); Fr2 bT[2], bV[2];
#pragma unroll
            for (int t = 0; t < 2; ++t) { bT[t] = ldf(RSL(14), fn[t]); bV[t] = ldt(RSL(6), tb0[t], tb1[t]); }
            f32x4 q0[2], q1[2], q2[2];
#pragma unroll
            for (int t = 0; t < 2; ++t) { q0[t] = mm<true>(aP, bT[t], z4); q1[t] = mm<false>(aP, bT[t], z4); q2[t] = mm<false>(aN, bV[t], z4); }
#pragma unroll
            for (int t = 0; t < 2; ++t) { st4(RSL(13), orm[t], q0[t]); st4(RSL(15), otr[t], q1[t]); st4(RSL(2), otr[t], q2[t]); }
        }
        LBAR();
#pragma unroll
        for (int kd = 0; kd < 5; ++kd) {
            const int xi = (kd & 1) ? 11 : 10, xo = (kd & 1) ? 10 : 11, pi = (kd & 1) ? 12 : 13, po = (kd & 1) ? 13 : 12, ti = (kd & 1) ? 14 : 15, to = (kd & 1) ? 15 : 14;
            const f32x4 z4 = (f32x4){0.f, 0.f, 0.f, 0.f};
            const Fr2 aX = ldf(RSL(xi), fm), aP = ldf(RSL(pi), fm); Fr2 bT[2]; f32x4 cx[2];
#pragma unroll
            for (int t = 0; t < 2; ++t) { bT[t] = ldf(RSL(ti), fn[t]); cx[t] = ld4(RSL(xi), orm[t]); }
            f32x4 q0[2], q1[2], q2[2];
#pragma unroll
            for (int t = 0; t < 2; ++t) { q0[t] = mm<true>(aX, bT[t], cx[t]); if (kd < 4) { q1[t] = mm<true>(aP, bT[t], z4); q2[t] = mm<false>(aP, bT[t], z4); } }
#pragma unroll
            for (int t = 0; t < 2; ++t) { st4(RSL(xo), orm[t], q0[t]); if (kd < 4) { st4(RSL(po), orm[t], q1[t]); st4(RSL(to), otr[t], q2[t]); } }
            LBAR();
        }
        {
            const f32x4 z4 = (f32x4){0.f, 0.f, 0.f, 0.f};
            const Fr2 aT = ldf(RSL(11), fm); Fr2 bA[2], bZ[2];
#pragma unroll
            for (int t = 0; t < 2; ++t) { bA[t] = ldt(RSL(0), tb0[t], tb1[t]); bZ[t] = ldf(RSL(2), fn[t]); }
            f32x4 q0[2], q1[2];
#pragma unroll
            for (int t = 0; t < 2; ++t) { q0[t] = mm<false>(aT, bA[t], z4); q1[t] = mm<false>(aT, bZ[t], z4); }
#pragma unroll
            for (int t = 0; t < 2; ++t) { st4(RSL(3), otr[t], q0[t]); st4(RSL(7), otr[t], q1[t]); }
        }
        LBAR();
        {
            const f32x4 z4 = (f32x4){0.f, 0.f, 0.f, 0.f};
            f32x4 p1[2], y0[2], gt[2], hh[2];
            {   const Fr2 aMb = ldf(RSL(8), fm), aMk = ldf(RSL(9), fm); Fr2 bW[2], bU[2], bV[2]; f32x4 cR[2];
#pragma unroll
                for (int t = 0; t < 2; ++t) { bW[t] = ldf(RSL(3), fn[t]); bU[t] = ldf(RSL(7), fn[t]); bV[t] = ldt(RSL(6), tb0[t], tb1[t]); cR[t] = ld4(RSL(1), orm[t]); }
#pragma unroll
                for (int t = 0; t < 2; ++t) { p1[t] = mm<true>(aMb, bW[t], cR[t]); y0[t] = mm<true>(aMk, bV[t], mm<true>(aMb, bU[t], z4)); } }
            {   const Fr2 aW = ldf(RSL(3), fm), aU = ldf(RSL(7), fm), aV = ldt(RSL(6), ta0, ta1); Fr2 bBh[2], bKh[2];
#pragma unroll
                for (int t = 0; t < 2; ++t) { bBh[t] = ldt(RSL(4), tb0[t], tb1[t]); bKh[t] = ldt(RSL(5), tb0[t], tb1[t]); }
#pragma unroll
                for (int t = 0; t < 2; ++t) { gt[t] = mm<false>(aW, bBh[t], z4); hh[t] = mm<true>(aV, bKh[t], mm<true>(aU, bBh[t], z4)); } }
#pragma unroll
            for (int t = 0; t < 2; ++t) {
                s_p1[t].x = pkbf(p1[t][0], p1[t][1]); s_p1[t].y = pkbf(p1[t][2], p1[t][3]); s_gt[t].x = pkbf(gt[t][0], gt[t][1]); s_gt[t].y = pkbf(gt[t][2], gt[t][3]);
                s_y0[t].x = pkbf(y0[t][0], y0[t][1]); s_y0[t].y = pkbf(y0[t][2], y0[t][3]); s_hh[t].x = pkbf(hh[t][0], hh[t][1]); s_hh[t].y = pkbf(hh[t][2], hh[t][3]); }
            s_jo = jo; s_have = true;
        }
    }
    if (s_have) P6A_STORE();
#undef P6A_LOAD
#undef P6A_STORE
    LBAR();
}
__device__ __forceinline__ void p6b_rwkv_seq(Frame& F, const RwArgs& A, const RwX& X, int nwg) {
    using namespace rwk;
    LAS unsigned char* lds = F.lds + RING_OFF;
    constexpr int YLD = 68;
    LAS float* Yf0 = (LAS float*)RSL(6);
    const int tid = F.tid, tok = tid >> 3, dg = tid & 7, lane = F.lane, fr = lane & 15, fq = lane >> 4;
    const int w = F.wave, m0 = 16 * (w >> 1), n0a = 32 * (w & 1);
    const int fm = swz(m0 + fr, fq * 16);
    int fn[2], orm[2], otr[2];
#pragma unroll
    for (int t = 0; t < 2; ++t) { const int n0 = n0a + 16 * t; fn[t] = swz(n0 + fr, fq * 16); orm[t] = swz(m0 + fr, 2 * (n0 + 4 * fq)); otr[t] = swz(n0 + fr, 2 * (m0 + 4 * fq)); }
    for (int unit = blockIdx.x; unit < BATCH * NH; unit += nwg) {
        const int b = unit >> 3, h = unit & 7; const int cb = 64 * h + 8 * dg;
        f32x4 sacc[2]; sacc[0] = (f32x4){0.f, 0.f, 0.f, 0.f}; sacc[1] = sacc[0];
        for (int u = tid; u < SLOT / 4; u += NWAVES * 64) ((LAS unsigned*)RSL(4))[u] = 0u;
        float lnw[8], lnb[8]; ld8f(A.ln_w + cb, lnw); ld8f(A.ln_b + cb, lnb);
        struct Nx { v4u vb, g; u32x2g p1[2], gt[2], y0[2], h[2]; f32x4 ge[2]; };
        Nx nA, nB;
#define P6B_LOAD(cc, N) do { const int job_ = unit * 32 + (cc); const size_t jo_ = (size_t)job_ * 4096; const size_t grow_ = (size_t)b * SEQ + (cc) * 64 + tok; \
            _Pragma("unroll") for (int t = 0; t < 2; ++t) { N.y0[t] = *(const u32x2g*)(X.Y0 + jo_ + ((w * 2 + t) * 64 + lane) * 4); N.h[t] = *(const u32x2g*)(X.H + jo_ + ((w * 2 + t) * 64 + lane) * 4); \
                N.p1[t] = *(const u32x2g*)(X.P1 + jo_ + ((w * 2 + t) * 64 + lane) * 4); N.gt[t] = *(const u32x2g*)(X.GT + jo_ + ((w * 2 + t) * 64 + lane) * 4); \
                N.ge[t] = *(const f32x4*)(X.GE + (size_t)job_ * 64 + n0a + 16 * t + 4 * fq); } \
            const bf16* vbp_ = (job_ < 2048) ? (X.VB0 + jo_) : (X.VB1 + (jo_ - (size_t)2048 * 4096)); \
            N.vb = *(const v4u*)(vbp_ + tok * 64 + 8 * dg); N.g = *(const v4u*)(X.G + jo_ + tok * 64 + 8 * dg); } while (0)
#define P6B_OUT(par, vbw_, gw_, grow_) do { float y[8]; ld8l(Yf0 + (par) * (64 * YLD) + tok * YLD + 8 * dg, y); \
            const float g[8] = {bflo(gw_.x), bfhi(gw_.x), bflo(gw_.y), bfhi(gw_.y), bflo(gw_.z), bfhi(gw_.z), bflo(gw_.w), bfhi(gw_.w)}; \
            const float vb[8] = {bflo(vbw_.x), bfhi(vbw_.x), bflo(vbw_.y), bfhi(vbw_.y), bflo(vbw_.z), bfhi(vbw_.z), bflo(vbw_.w), bfhi(vbw_.w)}; \
            float s_ = 0.f; _Pragma("unroll") for (int j = 0; j < 8; ++j) s_ += y[j]; \
            const float mean = sum8(s_) * (1.0f / 64.0f); float q_ = 0.f; \
            _Pragma("unroll") for (int j = 0; j < 8; ++j) { y[j] -= mean; q_ += y[j] * y[j]; } \
            const float rstd = __builtin_amdgcn_rsqf(sum8(q_) * (1.0f / 64.0f) + LNX_EPS); float ov[8]; \
            _Pragma("unroll") for (int j = 0; j < 8; ++j) ov[j] = (y[j] * rstd * lnw[j] + lnb[j] + vb[j]) * g[j]; \
            v4u wv_; wv_.x = pkbf(ov[0], ov[1]); wv_.y = pkbf(ov[2], ov[3]); wv_.z = pkbf(ov[4], ov[5]); wv_.w = pkbf(ov[6], ov[7]); \
            *(GAS v4u*)(A.QO + (grow_) * D + 512 + cb) = wv_; } while (0)
        v4u p_vb = (v4u){0u, 0u, 0u, 0u}, p_g = p_vb; size_t p_row = 0;
#define P6B_STEP(c, N) do { const int par = (c) & 1, scur = 4 + par, snxt = 5 - par; const size_t grow = (size_t)b * SEQ + (c) * 64 + tok; \
            _Pragma("unroll") for (int t = 0; t < 2; ++t) { *(LAS u32x2g*)(RSL(par) + orm[t]) = N.p1[t]; *(LAS u32x2g*)(RSL(2 + par) + otr[t]) = N.gt[t]; } \
            f32x4 yacc[2], hcur[2], gecur[2]; \
            _Pragma("unroll") for (int t = 0; t < 2; ++t) { yacc[t] = (f32x4){bflo(N.y0[t].x), bfhi(N.y0[t].x), bflo(N.y0[t].y), bfhi(N.y0[t].y)}; hcur[t] = (f32x4){bflo(N.h[t].x), bfhi(N.h[t].x), bflo(N.h[t].y), bfhi(N.h[t].y)}; gecur[t] = N.ge[t]; } \
            const v4u vbw = N.vb, gw = N.g; \
            if ((c) + 2 < SEQ / 64) P6B_LOAD((c) + 2, N); \
            LBAR(); \
            {   const Fr2 aP1 = ldf(RSL(par), fm), aS = ldf(RSL(scur), fm); Fr2 bS[2], bG[2]; \
                _Pragma("unroll") for (int t = 0; t < 2; ++t) { bS[t] = ldf(RSL(scur), fn[t]); bG[t] = ldf(RSL(2 + par), fn[t]); } \
                _Pragma("unroll") for (int t = 0; t < 2; ++t) { yacc[t] = mm<true>(aP1, bS[t], yacc[t]); sacc[t] = mm<true>(aS, bG[t], sacc[t] * gecur[t] + hcur[t]); } \
                _Pragma("unroll") for (int t = 0; t < 2; ++t) { const int n0 = n0a + 16 * t; *(LAS f32x4*)(Yf0 + par * (64 * YLD) + (m0 + fr) * YLD + n0 + 4 * fq) = yacc[t]; st4(RSL(snxt), orm[t], sacc[t]); } } \
            if ((c) > 0) P6B_OUT(par ^ 1, p_vb, p_g, p_row);                    \
            p_vb = vbw; p_g = gw; p_row = grow; } while (0)
        P6B_LOAD(0, nA); P6B_LOAD(1, nB);
        for (int c = 0; c < SEQ / 64; c += 2) {
            P6B_STEP(c, nA);
            P6B_STEP(c + 1, nB);
        }
#undef P6B_STEP
        LBAR();
        P6B_OUT(1, p_vb, p_g, p_row);
#undef P6B_LOAD
#undef P6B_OUT
        LBAR();
    }
}

namespace sba {
using bf16x8 = __attribute__((ext_vector_type(8))) short;
using s16x4 = __attribute__((ext_vector_type(4))) short;
using f32x16 = __attribute__((ext_vector_type(16))) float;
using u32x4 = __attribute__((ext_vector_type(4))) unsigned;
constexpr int QB = 256, KVBLK = 64;
constexpr int LDS_K = 0, LDS_V = 16384, LDS_ST = 32768, ST_LD = 68, LDS_FLAG = LDS_ST + 8 * 32 * ST_LD * 4, LDS_BYTES_ATT = LDS_FLAG + 64;
constexpr float R_DEAD = -160.0f;
#define SBAR() __builtin_amdgcn_sched_barrier(0)
typedef float f32x2_t __attribute__((ext_vector_type(2))); typedef __bf16 bf16x2_t __attribute__((ext_vector_type(2)));
__device__ __forceinline__ unsigned cvtpk_s(float lo, float hi) { f32x2_t v = {lo, hi}; bf16x2_t b = __builtin_convertvector(v, bf16x2_t); return __builtin_bit_cast(unsigned, b); }
__device__ __forceinline__ void qkt(f32x16& p0, f32x16& p1, const char* Kslot, const bf16x8* qr, int r32, int hi) {
    const char* kb = Kslot + hi * 1024 + r32 * 16;
    const f32x16 z = f32x16{};
#pragma unroll
    for (int d0 = 0; d0 < 4; ++d0) {
        const bf16x8 b0 = *reinterpret_cast<const bf16x8*>(kb + d0 * 2048);
        const bf16x8 b1 = *reinterpret_cast<const bf16x8*>(kb + d0 * 2048 + 512);
        if (d0 == 0) { p0 = __builtin_amdgcn_mfma_f32_32x32x16_bf16(b0, qr[0], z, 0, 0, 0); p1 = __builtin_amdgcn_mfma_f32_32x32x16_bf16(b1, qr[0], z, 0, 0, 0); }
        else { p0 = __builtin_amdgcn_mfma_f32_32x32x16_bf16(b0, qr[d0], p0, 0, 0, 0); p1 = __builtin_amdgcn_mfma_f32_32x32x16_bf16(b1, qr[d0], p1, 0, 0, 0); }
    }
}
__device__ __forceinline__ void pv(f32x16* o, int vb, bf16x8 pa0, bf16x8 pa1, bf16x8 pa2, bf16x8 pa3) {
#pragma unroll
    for (int d0 = 0; d0 < 2; ++d0) { s16x4 lo[4], hi[4];
#pragma unroll
        for (int ks = 0; ks < 4; ++ks) {
            asm volatile("ds_read_b64_tr_b16 %0,%1 offset:%c2" : "=&v"(lo[ks]) : "v"(vb), "i"(d0 * 4096 + ks * 1024) : "memory");
            asm volatile("ds_read_b64_tr_b16 %0,%1 offset:%c2" : "=&v"(hi[ks]) : "v"(vb), "i"(d0 * 4096 + ks * 1024 + 512) : "memory"); }
        asm volatile("s_waitcnt lgkmcnt(0)" ::: "memory"); SBAR();
#define PK(k) (bf16x8){lo[k][0], lo[k][1], lo[k][2], lo[k][3], hi[k][0], hi[k][1], hi[k][2], hi[k][3]}
        o[d0] = __builtin_amdgcn_mfma_f32_32x32x16_bf16(pa0, PK(0), o[d0], 0, 0, 0);
        o[d0] = __builtin_amdgcn_mfma_f32_32x32x16_bf16(pa1, PK(1), o[d0], 0, 0, 0);
        o[d0] = __builtin_amdgcn_mfma_f32_32x32x16_bf16(pa2, PK(2), o[d0], 0, 0, 0);
        o[d0] = __builtin_amdgcn_mfma_f32_32x32x16_bf16(pa3, PK(3), o[d0], 0, 0, 0);
#undef PK
    }
}
__device__ __forceinline__ float swap_sum(float x, float& other_if_lo, int hi) {
    auto rr = __builtin_amdgcn_permlane32_swap(__float_as_uint(x), __float_as_uint(x), false, false);
    const float a = __uint_as_float(rr[0]), b = __uint_as_float(rr[1]);
    other_if_lo = hi ? 0.f : b;
    return a + b;
}
__device__ __forceinline__ void attn_wave_unit(int b, int h, int qblk, bf16* QO, const bf16* __restrict__ KB, const bf16* __restrict__ VB, const float* gout, char* wsm  ) {
    const int lane = threadIdx.x & 63, r32 = lane & 31, hi = lane >> 5;
    const long rowbase = (long)b * SEQ; const int q0 = qblk * 32;
    bf16* Qw = QO + (rowbase + q0) * D + h * HD;
    const bf16* Kh = KB + rowbase * SBW + h * HD; const bf16* Vh = VB + rowbase * SBW + h * HD;
    const unsigned lds0 = (unsigned)(uintptr_t)wsm;
    const int jtop = (q0 + 30) >> 6;
    const bf16* vsrc = Vh + (long)(lane >> 3) * SBW + (lane & 7) * 8;
    const int vdst0 = ((lane & 7) >> 2) * 4096 + ((lane >> 3) & 15) * 64 + (lane & 3) * 16;
    const int vb0 = (int)lds0 + ((lane >> 4) & 1) * 32 + (lane & 3) * 8 + (4 * hi + ((lane & 15) >> 2)) * 64;
    const bf16* ksrc = Kh + (long)r32 * SBW + hi * 8;
    bf16x8 qr[4];
#pragma unroll
    for (int d0 = 0; d0 < 4; ++d0) qr[d0] = *reinterpret_cast<const bf16x8*>(&Qw[(long)r32 * D + d0 * 16 + hi * 8]);
    bf16x8 kf[8]; u32x4 vr[8];
#define SBA_LOAD(t) do { const bf16* kp_ = ksrc + (long)(t) * KVBLK * SBW; const bf16* vp_ = vsrc + (long)(t) * KVBLK * SBW; \
        _Pragma("unroll") for (int d0 = 0; d0 < 4; ++d0) { kf[2 * d0] = *reinterpret_cast<const bf16x8*>(kp_ + d0 * 16); kf[2 * d0 + 1] = *reinterpret_cast<const bf16x8*>(kp_ + 32 * SBW + d0 * 16); } \
        _Pragma("unroll") for (int i = 0; i < 8; ++i) vr[i] = *(const u32x4*)(vp_ + (long)(8 * i) * SBW); } while (0)
    SBA_LOAD(jtop);
    float R = 0.f; f32x16 o[2]; o[0] = f32x16{}; o[1] = f32x16{};
    const int qrow = q0 + r32;
    for (int jt = jtop; jt >= 0; --jt) {
        const int cur = (jtop - jt) & 1;
#pragma unroll
        for (int i = 0; i < 8; ++i) *(u32x4*)(wsm + cur * 8192 + vdst0 + (i >> 1) * 1024 + (i & 1) * 512) = vr[i];
        f32x16 p0, p1;
        {   const f32x16 z = f32x16{};
            p0 = __builtin_amdgcn_mfma_f32_32x32x16_bf16(kf[0], qr[0], z, 0, 0, 0); p1 = __builtin_amdgcn_mfma_f32_32x32x16_bf16(kf[1], qr[0], z, 0, 0, 0);
#pragma unroll
            for (int d0 = 1; d0 < 4; ++d0) { p0 = __builtin_amdgcn_mfma_f32_32x32x16_bf16(kf[2 * d0], qr[d0], p0, 0, 0, 0); p1 = __builtin_amdgcn_mfma_f32_32x32x16_bf16(kf[2 * d0 + 1], qr[d0], p1, 0, 0, 0); } }
        if (jt > 0) SBA_LOAD(jt - 1);
        f32x16 lb0, lb1;
        const int kb = 64 * jt + 4 * hi; const bool diag = (jt == jtop);
#pragma unroll
        for (int r = 0; r < 16; ++r) {
            { const float z = p0[r]; const float L = __builtin_amdgcn_logf(1.0f + __builtin_amdgcn_exp2f(z)); float lb = z - L; float l1 = -L;
              if (diag) { const int key = kb + (r & 3) + 8 * (r >> 2); if (key >= qrow) { l1 = 0.f; lb = -1e30f; } }
              lb0[r] = lb; p0[r] = l1; }
            { const float z = p1[r]; const float L = __builtin_amdgcn_logf(1.0f + __builtin_amdgcn_exp2f(z)); float lb = z - L; float l1 = -L;
              if (diag) { const int key = kb + 32 + (r & 3) + 8 * (r >> 2); if (key >= qrow) { l1 = 0.f; lb = -1e30f; } }
              lb1[r] = lb; p1[r] = l1; }
        }
        float c0[4], c1[4], x0[4], x1[4];
#pragma unroll
        for (int g = 0; g < 4; ++g) {
            const float s0 = (p0[4 * g] + p0[4 * g + 1]) + (p0[4 * g + 2] + p0[4 * g + 3]);
            const float s1 = (p1[4 * g] + p1[4 * g + 1]) + (p1[4 * g + 2] + p1[4 * g + 3]);
            c0[g] = swap_sum(s0, x0[g], hi); c1[g] = swap_sum(s1, x1[g], hi);
        }
        float suf0[4], suf1[4];
        suf1[3] = R; suf1[2] = suf1[3] + c1[3]; suf1[1] = suf1[2] + c1[2]; suf1[0] = suf1[1] + c1[1];
        suf0[3] = suf1[0] + c1[0]; suf0[2] = suf0[3] + c0[3]; suf0[1] = suf0[2] + c0[2]; suf0[0] = suf0[1] + c0[1];
        R = suf0[0] + c0[0];
#pragma unroll
        for (int g = 0; g < 4; ++g) {
            { const float e3 = suf0[g] + x0[g], e2 = e3 + p0[4 * g + 3], e1 = e2 + p0[4 * g + 2], e0 = e1 + p0[4 * g + 1];
              p0[4 * g + 3] = __builtin_amdgcn_exp2f(lb0[4 * g + 3] + e3); p0[4 * g + 2] = __builtin_amdgcn_exp2f(lb0[4 * g + 2] + e2);
              p0[4 * g + 1] = __builtin_amdgcn_exp2f(lb0[4 * g + 1] + e1); p0[4 * g] = __builtin_amdgcn_exp2f(lb0[4 * g] + e0); }
            { const float e3 = suf1[g] + x1[g], e2 = e3 + p1[4 * g + 3], e1 = e2 + p1[4 * g + 2], e0 = e1 + p1[4 * g + 1];
              p1[4 * g + 3] = __builtin_amdgcn_exp2f(lb1[4 * g + 3] + e3); p1[4 * g + 2] = __builtin_amdgcn_exp2f(lb1[4 * g + 2] + e2);
              p1[4 * g + 1] = __builtin_amdgcn_exp2f(lb1[4 * g + 1] + e1); p1[4 * g] = __builtin_amdgcn_exp2f(lb1[4 * g] + e0); }
        }
#define PKW(P, B) cvtpk_s(P[B], P[B + 1])
        const u32x4 pw0 = (u32x4){PKW(p0, 0), PKW(p0, 2), PKW(p0, 4), PKW(p0, 6)}, pw1 = (u32x4){PKW(p0, 8), PKW(p0, 10), PKW(p0, 12), PKW(p0, 14)};
        const u32x4 pw2 = (u32x4){PKW(p1, 0), PKW(p1, 2), PKW(p1, 4), PKW(p1, 6)}, pw3 = (u32x4){PKW(p1, 8), PKW(p1, 10), PKW(p1, 12), PKW(p1, 14)};
#undef PKW
        SBAR();
        asm volatile("s_waitcnt lgkmcnt(0)" ::: "memory");
        pv(o, vb0 + cur * 8192, __builtin_bit_cast(bf16x8, pw0), __builtin_bit_cast(bf16x8, pw1), __builtin_bit_cast(bf16x8, pw2), __builtin_bit_cast(bf16x8, pw3));
        if (__all(R < R_DEAD)) break;
    }
#undef SBA_LOAD
    {
        float* stg = (float*)wsm;
        asm volatile("s_waitcnt lgkmcnt(0)" ::: "memory");
#pragma unroll
        for (int r = 0; r < 16; ++r) { const int orow = (r & 3) + 8 * (r >> 2) + 4 * hi;
#pragma unroll
            for (int d0 = 0; d0 < 2; ++d0) stg[orow * ST_LD + d0 * 32 + r32] = o[d0][r]; }
        asm volatile("s_waitcnt lgkmcnt(0)" ::: "memory");
        const int ch = lane & 7;
        const f32x4 ga = *(const f32x4*)(gout + h * HD + ch * 8), gb = *(const f32x4*)(gout + h * HD + ch * 8 + 4);
#pragma unroll
        for (int i = 0; i < 4; ++i) { const int row = i * 8 + (lane >> 3);
            const f32x4 a = *(const f32x4*)(stg + row * ST_LD + ch * 8), c = *(const f32x4*)(stg + row * ST_LD + ch * 8 + 4);
            float ss = (a.x * a.x + a.y * a.y) + (a.z * a.z + a.w * a.w) + (c.x * c.x + c.y * c.y) + (c.z * c.z + c.w * c.w);
            ss = sum8(ss);
            const float hs = __builtin_amdgcn_rsqf(ss * (1.0f / 64.0f) + 1e-6f);
            u32x4 w; w.x = cvtpk_s(a.x * hs * ga.x, a.y * hs * ga.y); w.y = cvtpk_s(a.z * hs * ga.z, a.w * hs * ga.w);
            w.z = cvtpk_s(c.x * hs * gb.x, c.y * hs * gb.y); w.w = cvtpk_s(c.z * hs * gb.z, c.w * hs * gb.w);
            *(u32x4*)(Qw + (long)row * D + ch * 8) = w; }
        asm volatile("s_waitcnt lgkmcnt(0)" ::: "memory");
    }
}
#undef SBAR
__device__ __forceinline__ void attn_phase(Frame& F, bf16* QO, const bf16* KB, const bf16* VB, const float* gout) {
    char* wsm = (char*)F.lds + RING_OFF + F.wave * 16384;
    const int nunits = BATCH * NH * (SEQ / 32);
    for (int u = F.vcu * NWAVES + F.wave; u < nunits; u += F.G * NWAVES) attn_wave_unit(u >> 9, (u >> 6) & 7, u & 63, QO, KB, VB, gout, wsm);
    __syncthreads();
}
}

struct Args { const float* in[26]; float* out; unsigned char* ws; int ph_lo, ph_hi, li, pad; };
__global__ void __launch_bounds__(NWAVES * 64, 2) skel_fwd(Args args) {
    extern __shared__ __attribute__((aligned(16))) unsigned char lds[];
    Frame F;
    F.lds = (LAS unsigned char*)lds;
    F.MISC = (volatile LAS unsigned*)(F.lds + MISC_OFF);
    F.tid = threadIdx.x; F.lane = F.tid & 63; F.wave = __builtin_amdgcn_readfirstlane(F.tid >> 6);
    F.G = gridDim.x; { const int bx = blockIdx.x; F.vcu = (F.G % 8 == 0) ? (bx % 8) * (F.G / 8) + bx / 8 : bx; }
    unsigned char* ws = args.ws;
    F.ctl = (gu32*)(ws + WS_CTL);
    const float* x = args.in[0];
    bf16* W1U = (bf16*)(ws + WS_W1U); bf16* W1D = (bf16*)(ws + WS_W1D); bf16* W2U = (bf16*)(ws + WS_W2U); bf16* W2D = (bf16*)(ws + WS_W2D);
    bf16* WIN = (bf16*)(ws + WS_WIN); bf16* WOUT = (bf16*)(ws + WS_WOUT); bf16* WLORA = (bf16*)(ws + WS_WLORA);
    bf16* XB = (bf16*)(ws + WS_XB); bf16* ACT = (bf16*)(ws + WS_ACT); bf16* QO = (bf16*)(ws + WS_QO); bf16* KB = (bf16*)(ws + WS_KB); bf16* VB = (bf16*)(ws + WS_VB);
    bf16* RW = (bf16*)(ws + WS_RW); bf16* ALORA = (bf16*)(ws + WS_ALORA); float* LW = (float*)(ws + WS_LW); bf16* AB = (bf16*)(ws + WS_AB); bf16* GB = (bf16*)(ws + WS_GB);
    float* SSQ = (float*)(ws + WS_SSQ); float* out = args.out;
    for (int u = F.tid; u < (LDS_BYTES - LDSCTL_OFF) / 4; u += NWAVES * 64) ((LAS unsigned*)(F.lds + LDSCTL_OFF))[u] = 0u;
    __syncthreads();
    XcdBarrier bar; bar.bar = (unsigned*)(F.ctl + CW_BAR); bar.x = 0; bar.st = nullptr;
    if (N_LAUNCHES != PER_PHASE) bar = xcd_barrier_post((unsigned*)(F.ctl + CW_BAR), F.MISC + 8);
#define GRID_BAR(seam) do { if (N_LAUNCHES == PER_PHASE) { if (F.tid == 0) __hip_atomic_store(F.ctl + CW_TMO, 0xBADBA0u | (unsigned)(seam), RLX_AGENT); } else { xcd_barrier(bar); } } while (0)
    const int lo = args.ph_lo, hi = args.ph_hi;
#define IN(k) (lo <= (k) && (k) < hi)
#define BOTH(k) (IN(k) && IN((k) + 1))
    if (IN(0)) {
        p0_prologue(F, x, args.in[1], args.in[2], args.in[3], args.in[4], args.in[5], args.in[6], args.in[12], args.in[14], args.in[15], args.in[21], args.in[22], args.in[23], args.in[24], args.in[25],
                    W1U, W1D, W2U, W2D, WIN, WOUT, WLORA, XB, SSQ); if (BOTH(0)) GRID_BAR(0);
    }
    if (IN(1)) {
        pg8::Gemm g{XB, W1U, M, 2 * FF, D}; pg8::StaticOrder S; S.init(M, 2 * FF, F.G, (int)blockIdx.x);
        pg8::EpiSwiGLU E{ACT, FF, SSQ};
        pg8::gemm_phase<pg8::EpiSwiGLU, pg8::StaticOrder, true, true>(F.lds + RING_OFF, g, S, E);
        if (BOTH(1)) GRID_BAR(1);
    }
    if (IN(2)) {
        pg8::Gemm g{ACT, W1D, M, D, FF}; pg8::StaticOrder S; S.init(M, D, F.G, (int)blockIdx.x);
        pg8::EpiResid E{x, out, XB, SSQ, 0.5f, 1};
        pg8::gemm_phase<pg8::EpiResid, pg8::StaticOrder, true, true>(F.lds + RING_OFF, g, S, E);
        if (BOTH(2)) GRID_BAR(2);
    }
    if (IN(3)) {
        pg8::Gemm g{XB, WIN, M, PW, D}; pg8::StaticOrder S; S.init(M, PW, F.G, (int)blockIdx.x);
        pg8::EpiWin E{QO, KB, VB, RW, SSQ, args.in[7], args.in[8], 0.125f * 1.4426950408889634f};
        pg8::gemm_phase<pg8::EpiWin, pg8::StaticOrder, true, true>(F.lds + RING_OFF, g, S, E);
        if (BOTH(3)) GRID_BAR(3);
    }
    if (IN(6)) {
        sba::attn_phase(F, QO, KB, VB, args.in[9]);
        if (BOTH(6)) GRID_BAR(6);
    }
    if (IN(7)) {
        RwArgs A{RW, WLORA, WLORA + 512 * 64, WLORA + 2 * 512 * 64, args.in[11], args.in[13], QO, args.in[10], args.in[16], args.in[17], args.in[18], args.in[19], args.in[20]};
        RwX X{KB, VB, XB, XB + (size_t)16 * 1024 * 1024, ALORA, (bf16*)(ws + WS_TAIL), SSQ, (bf16*)LW};
        p6a_rwkv_local(F, A, X);
        GRID_BAR(16);
        p6b_rwkv_seq(F, A, X, F.G);
        __syncthreads();
        if (BOTH(7)) GRID_BAR(7);
    }
    if (IN(8)) {
        pg8::Gemm g{QO, WOUT, M, D, D}; pg8::StaticOrder S; S.init(M, D, F.G, (int)blockIdx.x);
        pg8::EpiResid E{out, out, XB, SSQ, 1.0f, 1};
        pg8::gemm_phase<pg8::EpiResid, pg8::StaticOrder, true, true>(F.lds + RING_OFF, g, S, E);
        if (BOTH(8)) GRID_BAR(8);
    }
    if (IN(9)) {
        pg8::Gemm g{XB, W2U, M, 2 * FF, D}; pg8::StaticOrder S; S.init(M, 2 * FF, F.G, (int)blockIdx.x);
        pg8::EpiSwiGLU E{ACT, FF, SSQ};
        pg8::gemm_phase<pg8::EpiSwiGLU, pg8::StaticOrder, true, true>(F.lds + RING_OFF, g, S, E);
        if (BOTH(9)) GRID_BAR(9);
    }
    if (IN(10)) {
        pg8::Gemm g{ACT, W2D, M, D, FF}; pg8::StaticOrder S; S.init(M, D, F.G, (int)blockIdx.x);
        pg8::EpiResid E{out, out, XB, SSQ, 0.5f, 0};
        pg8::gemm_phase<pg8::EpiResid, pg8::StaticOrder, true, true>(F.lds + RING_OFF, g, S, E);
    }
#undef IN
#undef BOTH
}

extern "C" void kernel_launch(void* const* d_in, const int* in_sizes, int n_in, void* d_out, int out_size, void* d_ws, size_t ws_size, hipStream_t stream) {
    static int grid = 0;
    if (grid == 0) {
        if (n_in != 26 || in_sizes[0] != M * D || out_size != M * D || ws_size < WS_END) { fprintf(stderr, "kernel_launch: unexpected shapes: n_in %d in0 %d out %d ws %zu (need %zu)\n", n_in, n_in > 0 ? in_sizes[0] : -1, out_size, ws_size, (size_t)WS_END); grid = -1; return; }
        int dev = 0, cus = 0, per_cu = 0;
        if (hipGetDevice(&dev) != hipSuccess || hipDeviceGetAttribute(&cus, hipDeviceAttributeMultiprocessorCount, dev) != hipSuccess) { grid = -1; return; }
        if (hipFuncSetAttribute((const void*)skel_fwd, hipFuncAttributeMaxDynamicSharedMemorySize, LDS_BYTES) != hipSuccess) { fprintf(stderr, "kernel_launch: hipFuncSetAttribute failed\n"); grid = -1; return; }
        if (hipOccupancyMaxActiveBlocksPerMultiprocessor(&per_cu, (const void*)skel_fwd, NWAVES * 64, LDS_BYTES) != hipSuccess || per_cu < 1) { fprintf(stderr, "kernel_launch: occupancy query reports %d blocks per CU\n", per_cu); per_cu = 1; }
        (void)hipGetLastError();
        grid = cus;
    }
    if (grid < 0) return;
    if (hipMemsetAsync((char*)d_ws + WS_CTL, 0, CTL_ZERO_BYTES, stream) != hipSuccess) return;
    Args a{};
    for (int i = 0; i < 26; ++i) a.in[i] = (const float*)d_in[i];
    a.out = (float*)d_out; a.ws = (unsigned char*)d_ws;
    for (int li = 0; li < N_LAUNCHES; ++li) {
        a.ph_lo = (N_LAUNCHES == PER_PHASE) ? li : 0; a.ph_hi = (N_LAUNCHES == PER_PHASE) ? li + 1 : PER_PHASE; a.li = li;
        hipLaunchKernelGGL(skel_fwd, dim3(grid), dim3(NWAVES * 64), LDS_BYTES, stream, a);
    }
}
```

```cpp
#include <hip/hip_runtime.h>
#include <hip/hip_bf16.h>
#include <cstdio>
#include <cstdint>
#include <cmath>
namespace pg8 {
#define PG8_LAS __attribute__((address_space(3)))
typedef unsigned short bf16_t;
typedef short bf16x8 __attribute__((ext_vector_type(8)));
typedef float f32x4 __attribute__((ext_vector_type(4)));
typedef unsigned u32x4 __attribute__((ext_vector_type(4)));
constexpr int BM = 256, BK = 64, HALF = 128, HTB = HALF * BK * 2  , STAGE_BYTES = 8 * HTB, NXCD = 8, WGM = 4;

__host__ __device__ __forceinline__ int lds_byte(int r, int c) { const int st = (r >> 4) * 2 + (c >> 5), rr = r & 15, cc = c & 31, ob = rr * 64 + cc * 2; return st * 1024 + (ob ^ (((ob >> 9) & 1) << 5)); }
__host__ __device__ __forceinline__ void stage_rc(int b, int& R, int& C) { const int st = b / 1024, sb = b % 1024, swz = sb ^ (((sb >> 9) & 1) << 5); R = (st >> 1) * 16 + swz / 64; C = (st & 1) * 32 + (swz % 64) / 2; }
__host__ __device__ __forceinline__ int perm32(int rho) { const int n = rho >> 4, i = rho & 15; return 8 * (i >> 2) + 4 * n + (i & 3); }

struct Unit { int pm, pn; };
struct Gemm { const bf16_t* A; const bf16_t* Bt; int M, N, K; int ld; };

struct StaticOrder {
    int nM, nN, nwg, G, c;
    __host__ __device__ void init(int M, int N, int G_, int c_) { nM = M / BM; nN = N / BM; nwg = nM * nN; G = G_; c = c_; }
    __host__ __device__ bool next(int i, Unit& u) const {
        const long L = (long)i * G + c; if (L >= nwg) return false;
        int wgid = (int)L; { const int q = nwg / NXCD, r = nwg % NXCD, xcd = wgid % NXCD, off = wgid / NXCD; wgid = (xcd < r ? xcd * (q + 1) : r * (q + 1) + (xcd - r) * q) + off; }
        const int nig = WGM * nN, gid = wgid / nig, fm = gid * WGM, gsz = (nM - fm) < WGM ? (nM - fm) : WGM;
        u.pm = fm + ((wgid % nig) % gsz); u.pn = (wgid % nig) / gsz; return true;
    }
    __device__ __forceinline__ void a_ready(const Unit&) const {}
    __device__ __forceinline__ void done(const Unit&) const {}
};


__device__ __forceinline__ unsigned cvt_pk_bf16(float lo, float hi) { unsigned r; asm volatile("v_cvt_pk_bf16_f32 %0, %1, %2" : "=v"(r) : "v"(lo), "v"(hi)); return r; }
typedef unsigned u32x2 __attribute__((ext_vector_type(2)));
constexpr float RMS_EPS_F = 1e-6f;
constexpr float LOG2E_F = 1.4426950408889634f;
__device__ __forceinline__ float row_rs(const float* ssqp, int row) {
    const f32x4* p = (const f32x4*)(ssqp + (size_t)row * 16);
    const f32x4 a = p[0], b = p[1], c = p[2], d = p[3];
    const float s = ((a[0] + a[1]) + (a[2] + a[3])) + ((b[0] + b[1]) + (b[2] + b[3])) + ((c[0] + c[1]) + (c[2] + c[3])) + ((d[0] + d[1]) + (d[2] + d[3]));
    return __builtin_amdgcn_rsqf(s * (1.0f / 1024.0f) + RMS_EPS_F);
}
__device__ __forceinline__ float silu_f(float g) { return g * __builtin_amdgcn_rcpf(1.0f + __builtin_amdgcn_exp2f(-g * LOG2E_F)); }
__device__ __forceinline__ float sigmoid_f(float g) { return __builtin_amdgcn_rcpf(1.0f + __builtin_amdgcn_exp2f(-g * LOG2E_F)); }

struct EpiSwiGLU {
    static constexpr bool PERM = true, AFTER_DRAIN = false;
    bf16_t* O; int ldo; const float* ssqp;
    __device__ __forceinline__ void operator()(const f32x4 (&acc)[2][2][4][2], const Unit& u, int wr, int wc, int fr, int fq) const {
        const int row0 = u.pm * BM + wr * 64 + fr, col0 = u.pn * HALF + wc * 32 + 8 * fq;
#pragma unroll
        for (int ai = 0; ai < 2; ++ai)
#pragma unroll
            for (int m = 0; m < 4; ++m) {
                const int row = row0 + ai * HALF + m * 16; const float rs = row_rs(ssqp, row);
                const f32x4 g0 = acc[ai][0][m][0] * rs, g1 = acc[ai][0][m][1] * rs, u0 = acc[ai][1][m][0] * rs, u1 = acc[ai][1][m][1] * rs;
                u32x4 w;
                w.x = cvt_pk_bf16(silu_f(g0[0]) * u0[0], silu_f(g0[1]) * u0[1]); w.y = cvt_pk_bf16(silu_f(g0[2]) * u0[2], silu_f(g0[3]) * u0[3]);
                w.z = cvt_pk_bf16(silu_f(g1[0]) * u1[0], silu_f(g1[1]) * u1[1]); w.w = cvt_pk_bf16(silu_f(g1[2]) * u1[2], silu_f(g1[3]) * u1[3]);
                *(u32x4*)(O + (size_t)row * ldo + col0) = w;
            }
    }
};

struct EpiResid {
    static constexpr bool PERM = true, AFTER_DRAIN = false;
    const float* basef; const bf16_t* bhi; const bf16_t* blo; float* outf; bf16_t* ohi; bf16_t* olo; float* ssqp; float alpha; int aux;
    __device__ __forceinline__ static f32x4 up_lo(unsigned a, unsigned b) { return (f32x4){__uint_as_float(a << 16), __uint_as_float(a & 0xffff0000u), __uint_as_float(b << 16), __uint_as_float(b & 0xffff0000u)}; }
    __device__ __forceinline__ void operator()(const f32x4 (&acc)[2][2][4][2], const Unit& u, int wr, int wc, int fr, int fq) const {
        const int row0 = u.pm * BM + wr * 64 + fr, col0 = u.pn * BM + wc * 32 + 8 * fq;
#pragma unroll
        for (int ai = 0; ai < 2; ++ai)
#pragma unroll
            for (int m = 0; m < 4; ++m) {
                const int row = row0 + ai * HALF + m * 16; const size_t off = (size_t)row * 1024 + col0; float ss = 0.f;
#pragma unroll
                for (int bj = 0; bj < 2; ++bj) {
                    f32x4 b0, b1;
                    if (basef) { b0 = *(const f32x4*)(basef + off + bj * HALF); b1 = *(const f32x4*)(basef + off + bj * HALF + 4); }
                    else { const u32x4 h = *(const u32x4*)(bhi + off + bj * HALF), l = *(const u32x4*)(blo + off + bj * HALF); b0 = up_lo(h.x, h.y) + up_lo(l.x, l.y); b1 = up_lo(h.z, h.w) + up_lo(l.z, l.w); }
                    const f32x4 v0 = b0 + acc[ai][bj][m][0] * alpha, v1 = b1 + acc[ai][bj][m][1] * alpha;
                    if (aux) ss += ((v0[0] * v0[0] + v0[1] * v0[1]) + (v0[2] * v0[2] + v0[3] * v0[3])) + ((v1[0] * v1[0] + v1[1] * v1[1]) + (v1[2] * v1[2] + v1[3] * v1[3]));
                    if (outf) { *(f32x4*)(outf + off + bj * HALF) = v0; *(f32x4*)(outf + off + bj * HALF + 4) = v1; }
                    else { u32x4 h; h.x = cvt_pk_bf16(v0[0], v0[1]); h.y = cvt_pk_bf16(v0[2], v0[3]); h.z = cvt_pk_bf16(v1[0], v1[1]); h.w = cvt_pk_bf16(v1[2], v1[3]);
                        const f32x4 r0 = v0 - up_lo(h.x, h.y), r1 = v1 - up_lo(h.z, h.w);
                        u32x4 l; l.x = cvt_pk_bf16(r0[0], r0[1]); l.y = cvt_pk_bf16(r0[2], r0[3]); l.z = cvt_pk_bf16(r1[0], r1[1]); l.w = cvt_pk_bf16(r1[2], r1[3]);
                        *(u32x4*)(ohi + off + bj * HALF) = h; *(u32x4*)(olo + off + bj * HALF) = l; }
                }
                if (aux) { ss += __shfl_xor(ss, 16); ss += __shfl_xor(ss, 32); if (fq == 0) ssqp[(size_t)row * 16 + u.pn * 4 + wc] = ss; }
            }
    }
};

struct EpiWin {
    static constexpr bool PERM = true, AFTER_DRAIN = false;
    bf16_t* QO; bf16_t* KB; bf16_t* VB; bf16_t* RW; const float* ssqp; const float* gq; const float* gk; float qscale;
    __device__ __forceinline__ void operator()(const f32x4 (&acc)[2][2][4][2], const Unit& u, int wr, int wc, int fr, int fq) const {
        const int row0 = u.pm * BM + wr * 64 + fr; const int pn = u.pn;
        if (pn < 4) {
            const float* gp = (pn < 2) ? gq : gk; const float osc = (pn < 2) ? qscale : 1.0f;
            f32x4 gv[2][2];
#pragma unroll
            for (int bj = 0; bj < 2; ++bj)
#pragma unroll
                for (int n = 0; n < 2; ++n) gv[bj][n] = *(const f32x4*)(gp + 32 * bj + 8 * fq + 4 * n) * osc;
            bf16_t* dst = (pn < 2) ? QO : KB; const int ld = (pn < 2) ? 1024 : 512; const int colh = 64 * (4 * (pn & 1) + wc) + 8 * fq;
#pragma unroll
            for (int ai = 0; ai < 2; ++ai)
#pragma unroll
                for (int m = 0; m < 4; ++m) {
                    const int row = row0 + ai * HALF + m * 16; const float rs = row_rs(ssqp, row);
                    f32x4 y[2][2]; float ss = 0.f;
#pragma unroll
                    for (int bj = 0; bj < 2; ++bj)
#pragma unroll
                        for (int n = 0; n < 2; ++n) { y[bj][n] = acc[ai][bj][m][n] * rs; const f32x4 t = y[bj][n]; ss += (t[0] * t[0] + t[1] * t[1]) + (t[2] * t[2] + t[3] * t[3]); }
                    ss += __shfl_xor(ss, 16); ss += __shfl_xor(ss, 32);
                    const float hs = __builtin_amdgcn_rsqf(ss * (1.0f / 64.0f) + RMS_EPS_F);
#pragma unroll
                    for (int bj = 0; bj < 2; ++bj) {
                        const f32x4 a = y[bj][0] * gv[bj][0] * hs, b = y[bj][1] * gv[bj][1] * hs;
                        u32x4 w; w.x = cvt_pk_bf16(a[0], a[1]); w.y = cvt_pk_bf16(a[2], a[3]); w.z = cvt_pk_bf16(b[0], b[1]); w.w = cvt_pk_bf16(b[2], b[3]);
                        *(u32x4*)(dst + (size_t)row * ld + colh + 32 * bj) = w;
                    }
                }
        } else {
            bf16_t* dst = (pn < 6) ? VB : RW; const int ld = (pn < 6) ? 512 : 1792; const int colh = 256 * ((pn < 6) ? (pn - 4) : (pn - 6)) + 64 * wc + 8 * fq;
#pragma unroll
            for (int ai = 0; ai < 2; ++ai)
#pragma unroll
                for (int m = 0; m < 4; ++m) {
                    const int row = row0 + ai * HALF + m * 16; const float rs = row_rs(ssqp, row);
#pragma unroll
                    for (int bj = 0; bj < 2; ++bj) {
                        const f32x4 a = acc[ai][bj][m][0] * rs, b = acc[ai][bj][m][1] * rs;
                        u32x4 w; w.x = cvt_pk_bf16(a[0], a[1]); w.y = cvt_pk_bf16(a[2], a[3]); w.z = cvt_pk_bf16(b[0], b[1]); w.w = cvt_pk_bf16(b[2], b[3]);
                        *(u32x4*)(dst + (size_t)row * ld + colh + 32 * bj) = w;
                    }
                }
        }
    }
};

struct EpiLora {
    static constexpr bool PERM = true, AFTER_DRAIN = false;
    float* LW; bf16_t* AB; bf16_t* GB; const float* w0; const float* a0;
    __device__ __forceinline__ void operator()(const f32x4 (&acc)[2][2][4][2], const Unit& u, int wr, int wc, int fr, int fq) const {
        const int row0 = u.pm * BM + wr * 64 + fr; const int pn = u.pn; const int colt = 256 * (pn & 1) + wc * 32 + 8 * fq;
        const int kind = pn >> 1;
        const float* bp = (kind == 0) ? w0 : a0;
        bf16_t* ob = (kind == 1) ? AB : GB;
#pragma unroll
        for (int bj = 0; bj < 2; ++bj) {
            f32x4 b0 = (f32x4){0.f, 0.f, 0.f, 0.f}, b1 = b0;
            if (kind < 2) { b0 = *(const f32x4*)(bp + colt + bj * HALF); b1 = *(const f32x4*)(bp + colt + bj * HALF + 4); }
#pragma unroll
            for (int ai = 0; ai < 2; ++ai)
#pragma unroll
                for (int m = 0; m < 4; ++m) {
                    const int row = row0 + ai * HALF + m * 16;
                    f32x4 a = acc[ai][bj][m][0] + b0, b = acc[ai][bj][m][1] + b1;
                    if (kind < 2) {
#pragma unroll
                        for (int i = 0; i < 4; ++i) { a[i] = sigmoid_f(a[i]); b[i] = sigmoid_f(b[i]); }
                    }
                    if (kind == 0) { a = a * (-0.6065306597126334f); b = b * (-0.6065306597126334f);
                        float* p = LW + (size_t)row * 512 + colt + bj * HALF; *(f32x4*)p = a; *(f32x4*)(p + 4) = b; }
                    else { u32x4 w; w.x = cvt_pk_bf16(a[0], a[1]); w.y = cvt_pk_bf16(a[2], a[3]); w.z = cvt_pk_bf16(b[0], b[1]); w.w = cvt_pk_bf16(b[2], b[3]);
                        *(u32x4*)(ob + (size_t)row * 512 + colt + bj * HALF) = w; }
                    if (m & 1) asm volatile("" ::: "memory");
                }
        }
    }
};
template <class Epi, class Sched, bool ALIGN_EPI = false, bool SP2 = false>
__device__ __forceinline__ void gemm_phase(PG8_LAS unsigned char* lds, const Gemm g, const Sched& S, const Epi& E) {
    const int tid = threadIdx.x, wid = __builtin_amdgcn_readfirstlane(tid >> 6), lane = tid & 63, wr = wid >> 2, wc = wid & 3, fr = lane & 15, fq = lane >> 4;
    const int K = g.K, nt = K / BK, LDP = g.ld ? g.ld : g.K;
    unsigned voffA[2], voffB[2];
#pragma unroll
    for (int i = 0; i < 2; ++i) { int R, C; stage_rc(tid * 16 + i * 8192, R, C); const int Rb = Epi::PERM ? ((R & ~31) + perm32(R & 31)) : R;
        voffA[i] = (unsigned)(R * LDP + C) * 2u; voffB[i] = (unsigned)(Rb * LDP + C) * 2u; }
    const size_t kstep = (size_t)(BK * 2);
    const size_t hstep = (size_t)HALF * LDP * 2;
    const size_t tstep = 2 * hstep;
    const unsigned ldsw = (unsigned)wid * 1024u;
    const int aoff = lds_byte(wr * 64 + fr, fq * 8), boff = lds_byte(wc * 32 + fr, fq * 8);
#define PG8_SA(b, h) (((b) * 2 + (h)) * HTB)
#define PG8_SB(b, h) ((4 + (b) * 2 + (h)) * HTB)
#define PG8_STAGE(bufoff, gbase, voff) do { _Pragma("unroll") for (int _i = 0; _i < 2; ++_i) \
        __builtin_amdgcn_global_load_lds((const unsigned*)((const char*)(gbase) + (voff)[_i]), (PG8_LAS unsigned*)(lds + (bufoff) + ldsw + _i * 8192), 16, 0, 0); } while (0)
#define PG8_LDA(dst, b, h) do { _Pragma("unroll") for (int m = 0; m < 4; ++m) _Pragma("unroll") for (int k = 0; k < 2; ++k) dst[m][k] = *(const PG8_LAS bf16x8*)(lds + PG8_SA(b, h) + aoff + m * 2048 + k * 1024); } while (0)
#define PG8_LDB(dst, b, h) do { _Pragma("unroll") for (int n = 0; n < 2; ++n) _Pragma("unroll") for (int k = 0; k < 2; ++k) dst[n][k] = *(const PG8_LAS bf16x8*)(lds + PG8_SB(b, h) + boff + n * 2048 + k * 1024); } while (0)
#define PG8_MMA(ai, bj, At, Bt) do { __builtin_amdgcn_s_setprio(1); _Pragma("unroll") for (int m = 0; m < 4; ++m) _Pragma("unroll") for (int n = 0; n < 2; ++n) _Pragma("unroll") for (int k = 0; k < 2; ++k) \
        acc[ai][bj][m][n] = __builtin_amdgcn_mfma_f32_16x16x32_bf16(Bt[n][k], At[m][k], acc[ai][bj][m][n], 0, 0, 0); __builtin_amdgcn_s_setprio(0); } while (0)
#define PG8_WAIT_V(n) asm volatile("s_waitcnt vmcnt(" #n ")" ::: "memory")
#define PG8_WAIT_L(n) asm volatile("s_waitcnt lgkmcnt(" #n ")" ::: "memory")
#define PG8_BAR __builtin_amdgcn_s_barrier()
#define PG8_SCHED __builtin_amdgcn_sched_barrier(0)
    Unit cur, nxt; int ui = 0;
    if (!S.next(0, cur)) return;
    f32x4 acc[2][2][4][2];
#pragma unroll
    for (int a = 0; a < 2; ++a)
#pragma unroll
        for (int b = 0; b < 2; ++b)
#pragma unroll
            for (int m = 0; m < 4; ++m)
#pragma unroll
                for (int n = 0; n < 2; ++n) acc[a][b][m][n] = (f32x4){0.f, 0.f, 0.f, 0.f};
    bf16x8 At[4][2], B0[2][2], B1[2][2];
    const char* cA = (const char*)g.A + (size_t)cur.pm * tstep; const char* cB = (const char*)g.Bt + (size_t)cur.pn * tstep;
    S.a_ready(cur);
    if constexpr (SP2) {
        PG8_STAGE(PG8_SB(0, 0), cB, voffB); PG8_STAGE(PG8_SB(0, 1), cB + hstep, voffB); PG8_STAGE(PG8_SA(0, 0), cA, voffA); PG8_STAGE(PG8_SA(0, 1), cA + hstep, voffA);
        if (wr == 1) PG8_BAR;
        PG8_WAIT_V(2); PG8_BAR;
        PG8_STAGE(PG8_SB(1, 0), cB + kstep, voffB); PG8_STAGE(PG8_SA(1, 0), cA + kstep, voffA); PG8_STAGE(PG8_SB(1, 1), cB + hstep + kstep, voffB);
        PG8_WAIT_V(6); PG8_BAR;
    } else {
        PG8_STAGE(PG8_SB(0, 0), cB, voffB); PG8_STAGE(PG8_SA(0, 0), cA, voffA); PG8_STAGE(PG8_SB(0, 1), cB + hstep, voffB); PG8_STAGE(PG8_SA(0, 1), cA + hstep, voffA);
        if (wr == 1) PG8_BAR;
        PG8_WAIT_V(4); PG8_BAR;
        PG8_STAGE(PG8_SB(1, 0), cB + kstep, voffB); PG8_STAGE(PG8_SA(1, 0), cA + kstep, voffA); PG8_STAGE(PG8_SB(1, 1), cB + hstep + kstep, voffB);
        PG8_WAIT_V(6); PG8_BAR;
    }
    for (;;) {
        const bool has_next = S.next(ui + 1, nxt);
        const char* nA = has_next ? (const char*)g.A + (size_t)nxt.pm * tstep : cA; const char* nB = has_next ? (const char*)g.Bt + (size_t)nxt.pn * tstep : cB;
        for (int t = 0; t < nt; t += 2) {
            const bool last = (t == nt - 2);
            const char* a1 = cA + (size_t)(t + 1) * kstep;
            const char* a2 = last ? nA : cA + (size_t)(t + 2) * kstep; const char* b2 = last ? nB : cB + (size_t)(t + 2) * kstep;
            const char* a3 = a2 + kstep; const char* b3 = b2 + kstep;
            if (last && has_next) S.a_ready(nxt);
            if constexpr (SP2) {
            PG8_LDB(B0, 0, 0); PG8_LDB(B1, 0, 1); PG8_SCHED; PG8_LDA(At, 0, 0); PG8_STAGE(PG8_SA(1, 1), a1 + hstep, voffA);
            PG8_WAIT_V(8); PG8_WAIT_L(0); PG8_BAR; PG8_MMA(0, 0, At, B0); PG8_MMA(0, 1, At, B1); PG8_BAR; PG8_SCHED;
            PG8_LDA(At, 0, 1); PG8_STAGE(PG8_SB(0, 0), b2, voffB); PG8_STAGE(PG8_SB(0, 1), b2 + hstep, voffB); PG8_STAGE(PG8_SA(0, 0), a2, voffA);
            PG8_WAIT_V(8); PG8_WAIT_L(0); PG8_BAR; PG8_MMA(1, 0, At, B0); PG8_MMA(1, 1, At, B1); PG8_BAR; PG8_SCHED;
            PG8_LDB(B0, 1, 0); PG8_LDB(B1, 1, 1); PG8_SCHED; PG8_LDA(At, 1, 0); PG8_STAGE(PG8_SA(0, 1), a2 + hstep, voffA);
            PG8_WAIT_V(8); PG8_WAIT_L(0); PG8_BAR; PG8_MMA(0, 0, At, B0); PG8_MMA(0, 1, At, B1); PG8_BAR; PG8_SCHED;
            PG8_LDA(At, 1, 1); PG8_STAGE(PG8_SB(1, 0), b3, voffB); PG8_STAGE(PG8_SB(1, 1), b3 + hstep, voffB); PG8_STAGE(PG8_SA(1, 0), a3, voffA);
            PG8_WAIT_V(8); PG8_WAIT_L(0); PG8_BAR; PG8_MMA(1, 0, At, B0); PG8_MMA(1, 1, At, B1); PG8_BAR; PG8_SCHED;
            } else {
            PG8_LDB(B0, 0, 0); PG8_SCHED; PG8_LDA(At, 0, 0); PG8_STAGE(PG8_SA(1, 1), a1 + hstep, voffA);
            PG8_WAIT_L(8); PG8_BAR; PG8_WAIT_L(0); PG8_MMA(0, 0, At, B0); PG8_BAR; PG8_SCHED;
            PG8_LDB(B1, 0, 1); PG8_STAGE(PG8_SB(0, 0), b2, voffB);
            PG8_BAR; PG8_WAIT_L(0); PG8_MMA(0, 1, At, B1); PG8_BAR;
            PG8_LDA(At, 0, 1); PG8_STAGE(PG8_SA(0, 0), a2, voffA);
            PG8_BAR; PG8_WAIT_L(0); PG8_MMA(1, 0, At, B0); PG8_BAR; PG8_SCHED;
            PG8_STAGE(PG8_SB(0, 1), b2 + hstep, voffB);
            PG8_WAIT_V(6); PG8_BAR; PG8_MMA(1, 1, At, B1); PG8_BAR;
            PG8_LDB(B0, 1, 0); PG8_SCHED; PG8_LDA(At, 1, 0); PG8_STAGE(PG8_SA(0, 1), a2 + hstep, voffA);
            PG8_WAIT_L(8); PG8_BAR; PG8_WAIT_L(0); PG8_MMA(0, 0, At, B0); PG8_BAR; PG8_SCHED;
            PG8_LDB(B1, 1, 1); PG8_STAGE(PG8_SB(1, 0), b3, voffB);
            PG8_BAR; PG8_WAIT_L(0); PG8_MMA(0, 1, At, B1); PG8_BAR;
            PG8_LDA(At, 1, 1); PG8_STAGE(PG8_SA(1, 0), a3, voffA);
            PG8_BAR; PG8_WAIT_L(0); PG8_MMA(1, 0, At, B0); PG8_BAR; PG8_SCHED;
            PG8_STAGE(PG8_SB(1, 1), b3 + hstep, voffB);
            PG8_WAIT_V(6); PG8_BAR; PG8_MMA(1, 1, At, B1); PG8_BAR;
            }
        }
        if constexpr (ALIGN_EPI) { if (wr == 0) PG8_BAR; }
        if constexpr (!Epi::AFTER_DRAIN) { E(acc, cur, wr, wc, fr, fq); S.done(cur); }
        if (!has_next) break;
#pragma unroll
        for (int a = 0; a < 2; ++a)
#pragma unroll
            for (int b = 0; b < 2; ++b)
#pragma unroll
                for (int m = 0; m < 4; ++m)
#pragma unroll
                    for (int n = 0; n < 2; ++n) acc[a][b][m][n] = (f32x4){0.f, 0.f, 0.f, 0.f};
        cur = nxt; cA = nA; cB = nB; ++ui;
        if constexpr (ALIGN_EPI) { if (wr == 1) PG8_BAR; }
    }
    PG8_WAIT_V(0);
    if constexpr (!ALIGN_EPI) { if (wr == 0) PG8_BAR; }
    PG8_BAR;
    if constexpr (Epi::AFTER_DRAIN) { E.fused(acc, cur, wr, wc, fr, fq, lds, wid, lane); S.done(cur); }
#undef PG8_SA
#undef PG8_SB
#undef PG8_STAGE
#undef PG8_LDA
#undef PG8_LDB
#undef PG8_MMA
#undef PG8_WAIT_V
#undef PG8_WAIT_L
#undef PG8_BAR
#undef PG8_SCHED
}
}
#define GAS __attribute__((address_space(1)))
#define LAS __attribute__((address_space(3)))
typedef unsigned short bf16;
typedef unsigned v4u __attribute__((ext_vector_type(4)));
typedef float f32x4 __attribute__((ext_vector_type(4)));
typedef short bf16x8 __attribute__((ext_vector_type(8)));
typedef GAS unsigned gu32;
typedef GAS unsigned long long gu64;
#define RLX_AGENT __ATOMIC_RELAXED, __HIP_MEMORY_SCOPE_AGENT
#define LDS_WAIT() asm volatile("s_waitcnt lgkmcnt(0)" ::: "memory")
#define VM_WAIT() asm volatile("s_waitcnt vmcnt(0)" ::: "memory")
__device__ __forceinline__ unsigned long long rt() { return __builtin_amdgcn_s_memrealtime(); }
__device__ __forceinline__ unsigned f2bf(float f) { unsigned u = __builtin_bit_cast(unsigned, f); return (u + 0x7fffu + ((u >> 16) & 1u)) >> 16; }
__device__ __forceinline__ unsigned pk2(float lo, float hi) { return f2bf(lo) | (f2bf(hi) << 16); }

#define XB_TMO      128
#define XB_XCNT(j)  (256  + 64 * (j))
#define XB_XSUB(j)  (1280 + 64 * (j))
#define XB_XGEN(j)  (2304 + 64 * (j))
#define XB_TOP      3328
#define XB_TOPGEN   3392
#define XCD_BAR_WORDS 3456
#define XB_SPIN_CAP (1u << 18)

__device__ __forceinline__ unsigned xb_ld(unsigned* p)              { return __hip_atomic_load(p, __ATOMIC_RELAXED, __HIP_MEMORY_SCOPE_AGENT); }
__device__ __forceinline__ unsigned xb_add(unsigned* p, unsigned v) { return __hip_atomic_fetch_add(p, v, __ATOMIC_RELAXED, __HIP_MEMORY_SCOPE_AGENT); }
__device__ __forceinline__ unsigned xb_xcc_id() { return (unsigned)__builtin_amdgcn_s_getreg((3 << 11) | 20) & 0xFu; }
#define XB_SPIN(cond, bar) do { unsigned _sp = 0; while (cond) { __builtin_amdgcn_s_sleep(1); \
    if ((++_sp & 255u) == 0u) { if (xb_ld(&(bar)[XB_TMO])) break; if (_sp > XB_SPIN_CAP) { atomicAdd(&(bar)[XB_TMO], 1u); break; } } } } while (0)

struct XcdBarrier {
    unsigned* bar; unsigned x;
    volatile LAS unsigned* st;
};

__device__ __forceinline__ XcdBarrier xcd_barrier_post(unsigned* bar, volatile LAS unsigned* st) {
    XcdBarrier b; b.bar = bar; b.x = xb_xcc_id(); b.st = st;
    if (threadIdx.x == 0) (void)xb_add(&bar[XB_XCNT(b.x)], 1u);
    return b;
}
__device__ __forceinline__ void xcd_barrier_complete(unsigned* bar, unsigned x, unsigned& nloc, unsigned& nx) {
    const unsigned G = gridDim.x * gridDim.y * gridDim.z;
    unsigned sum, cnt, mine, sp = 0u;
    for (;;) {
        sum = 0u; cnt = 0u; mine = 0u;
#pragma unroll
        for (unsigned j = 0; j < 16; ++j) { const unsigned c = xb_ld(&bar[XB_XCNT(j)]); sum += c; cnt += (c > 0u) ? 1u : 0u; mine = (j == x) ? c : mine; }
        if (sum == G) break;
        __builtin_amdgcn_s_sleep(1);
        if ((++sp & 255u) == 0u) { if (xb_ld(&bar[XB_TMO])) break; if (sp > XB_SPIN_CAP) { atomicAdd(&bar[XB_TMO], 1u); break; } }
    }
    nloc = mine > 0u ? mine : 1u; nx = cnt > 0u ? cnt : 1u;
}

__device__ __forceinline__ void xcd_barrier(const XcdBarrier& b) {
    asm volatile("s_waitcnt vmcnt(0)" ::: "memory");
    __syncthreads();
    if (threadIdx.x == 0) {
        unsigned* bar = b.bar;
        __builtin_amdgcn_s_waitcnt(0);
        unsigned nloc = b.st[0], nx = b.st[1];
        if (nloc == 0u) { xcd_barrier_complete(bar, b.x, nloc, nx); b.st[0] = nloc; b.st[1] = nx; }
        const unsigned old = xb_add(&bar[XB_XSUB(b.x)], 1u);
        const unsigned gen = old / nloc;
        if (old + 1u == (gen + 1u) * nloc) {
            __builtin_amdgcn_fence(__ATOMIC_RELEASE, "agent");
            asm volatile("s_waitcnt vmcnt(0)" ::: "memory");
            const unsigned og = xb_add(&bar[XB_TOP], 1u);
            const unsigned tg = og / nx;
            if (og + 1u == (tg + 1u) * nx) xb_add(&bar[XB_TOPGEN], 1u);
            else XB_SPIN(xb_ld(&bar[XB_TOPGEN]) == tg, bar);
            __builtin_amdgcn_fence(__ATOMIC_ACQUIRE, "agent");
            xb_add(&bar[XB_XGEN(b.x)], 1u);
            asm volatile("s_waitcnt vmcnt(0)" ::: "memory");
        } else {
            XB_SPIN(xb_ld(&bar[XB_XGEN(b.x)]) == gen, bar);
            __builtin_amdgcn_fence(__ATOMIC_ACQUIRE, "agent");
            asm volatile("s_waitcnt vmcnt(0)" ::: "memory");
        }
    }
    __syncthreads();
}

constexpr int NWAVES = 8;
#ifndef MK_N_LAUNCHES
#define MK_N_LAUNCHES 1
#endif
constexpr int PER_PHASE = 11;
constexpr int N_LAUNCHES = MK_N_LAUNCHES;

constexpr int BATCH = 16, SEQ = 2048, D = 1024, HD = 64, NH = 8, FF = 2816;
constexpr int M = BATCH * SEQ;
constexpr int SBW = 512, RWW = 512, RWP = 1792, PW = 3328, LORA_K = 256, LORA_N = 1536;
constexpr float LNX_EPS = 64e-5f;

constexpr size_t MiB = 1u << 20;
constexpr size_t WS_CTL = 0, CTL_ZERO_BYTES = 1 * MiB;
constexpr size_t WS_SSQ = 1 * MiB;
constexpr size_t WS_W1U = 4 * MiB;
constexpr size_t WS_W1D = 15 * MiB;
constexpr size_t WS_W2U = 21 * MiB;
constexpr size_t WS_W2D = 32 * MiB;
constexpr size_t WS_WIN = 38 * MiB;
constexpr size_t WS_WOUT = 45 * MiB;
constexpr size_t WS_WLORA = 47 * MiB;
constexpr size_t WS_XB = 48 * MiB;
constexpr size_t WS_ACT = 112 * MiB;
constexpr size_t WS_QO = 112 * MiB;
constexpr size_t WS_KB = 176 * MiB;
constexpr size_t WS_VB = 208 * MiB;
constexpr size_t WS_RW = 240 * MiB;
constexpr size_t WS_ALORA = 352 * MiB;
constexpr size_t WS_LW = 368 * MiB;
constexpr size_t WS_AB = 432 * MiB;
constexpr size_t WS_GB = 464 * MiB;
constexpr size_t WS_TAIL = 496 * MiB;
constexpr size_t WS_END = 512 * MiB;
constexpr int CW_TMO = 0, CW_CODE = 1;
constexpr int CW_BAR = 4096;
constexpr int CW_QUEUE = 16384;

constexpr int RING_OFF = 0, RING_BYTES = 155648;
constexpr int LDSCTL_OFF = RING_BYTES, MISC_OFF = LDSCTL_OFF;
constexpr int LDS_BYTES = 163840;

struct Frame {
    LAS unsigned char* lds;
    volatile LAS unsigned* MISC;
    gu32* ctl;
    int tid, lane, wave;
    int vcu, G;
};
typedef unsigned u32x2g __attribute__((ext_vector_type(2)));
__device__ __forceinline__ float bf2f(unsigned short h) { return __uint_as_float(((unsigned)h) << 16); }
typedef float f32x2h __attribute__((ext_vector_type(2))); typedef __bf16 bf16x2h __attribute__((ext_vector_type(2)));
__device__ __forceinline__ unsigned pkbf(float lo, float hi) { f32x2h v = {lo, hi}; bf16x2h b = __builtin_convertvector(v, bf16x2h); return __builtin_bit_cast(unsigned, b); }
__device__ __forceinline__ float bflo(unsigned w) { return __uint_as_float(w << 16); }
__device__ __forceinline__ float bfhi(unsigned w) { return __uint_as_float(w & 0xffff0000u); }
__device__ __forceinline__ float wave_sum(float v) {
#pragma unroll
    for (int o = 1; o < 64; o <<= 1) v += __shfl_xor(v, o);
    return v;
}
__device__ __forceinline__ float dpp_f(float v, const int ctrl_unused) { return v; }
#define DPP_ADD(v, ctrl) ((v) + __int_as_float(__builtin_amdgcn_update_dpp(0, __float_as_int(v), (ctrl), 0xF, 0xF, true)))
__device__ __forceinline__ float sum8(float v) { v = DPP_ADD(v, 0xB1); v = DPP_ADD(v, 0x4E); v = DPP_ADD(v, 0x141); return v; }

struct TItem { const float* W; int ldw, k0, n0; const float* sc; bf16* WT; int Kd, rho0; };
__device__ __forceinline__ void ti_load(const TItem& T, float (&t)[32], int lane) {
#pragma unroll
    for (int i = 0; i < 32; ++i) t[i] = T.W[(size_t)(T.k0 + 2 * i + (lane >> 5)) * T.ldw + T.n0 + (lane & 31)];
}
__device__ __forceinline__ void ti_finish(const TItem& T, const float (&t)[32], LAS float* scr, int lane) {
#pragma unroll
    for (int i = 0; i < 32; ++i) scr[(2 * i + (lane >> 5)) * 33 + (lane & 31)] = t[i];
    LDS_WAIT(); asm volatile("" ::: "memory");
    const int c = lane & 7;
    f32x4 s0 = (f32x4){1.f, 1.f, 1.f, 1.f}, s1 = s0;
    if (T.sc) { s0 = *(const f32x4*)(T.sc + T.k0 + 8 * c); s1 = *(const f32x4*)(T.sc + T.k0 + 8 * c + 4); }
#pragma unroll
    for (int j = 0; j < 4; ++j) { const int n = (lane >> 3) + 8 * j; const LAS float* s = scr + (8 * c) * 33 + n;
        v4u o; o.x = pkbf(s[0 * 33] * s0.x, s[1 * 33] * s0.y); o.y = pkbf(s[2 * 33] * s0.z, s[3 * 33] * s0.w); o.z = pkbf(s[4 * 33] * s1.x, s[5 * 33] * s1.y); o.w = pkbf(s[6 * 33] * s1.z, s[7 * 33] * s1.w);
        *(GAS v4u*)(T.WT + (size_t)(T.rho0 + n) * T.Kd + T.k0 + 8 * c) = o; }
    LDS_WAIT(); asm volatile("" ::: "memory");
}
#define P0_PTRS const float* Ax, const float* An1, const float* Ag1, const float* Au1, const float* Ad1, const float* Anm, const float* Awin, const float* Aw2, const float* Aa2, const float* Ag2, const float* Awout, \
    const float* An2, const float* Ag2f, const float* Au2f, const float* Ad2f, bf16* AW1U, bf16* AW1D, bf16* AW2U, bf16* AW2D, bf16* AWIN, bf16* AWOUT, bf16* AWLORA, bf16* AXB, float* ASSQ
__device__ __forceinline__ void p0_prologue(Frame& F, P0_PTRS) {
    LAS float* scr = (LAS float*)(F.lds + RING_OFF + F.wave * 16384);
    const int gw = F.vcu * NWAVES + F.wave, NGW = F.G * NWAVES;
    constexpr int I_UP = 16 * 176, I_DN = 44 * 32, I_IN = 16 * 104, I_OUT = 16 * 32;
    constexpr int NITEMS = 2 * (I_UP + I_DN) + I_IN + I_OUT;
#define P0_DECODE(it_, T) do { int r = (it_); \
        if (r < 2 * I_UP) { const int l2 = r >= I_UP; if (l2) r -= I_UP; \
            const int kb = r / 176, nb = r % 176, rho0 = 32 * nb, pn = rho0 >> 8, bj = (rho0 >> 7) & 1, j0 = rho0 & 127; \
            T = TItem{l2 ? (bj ? Au2f : Ag2f) : (bj ? Au1 : Ag1), FF, 64 * kb, 128 * pn + j0, l2 ? An2 : An1, l2 ? AW2U : AW1U, D, rho0}; } \
        else if ((r -= 2 * I_UP) < 2 * I_DN) { const int l2 = r >= I_DN; if (l2) r -= I_DN; const int kb = r / 32, nb = r % 32; \
            T = TItem{l2 ? Ad2f : Ad1, D, 64 * kb, 32 * nb, nullptr, l2 ? AW2D : AW1D, FF, 32 * nb}; } \
        else if ((r -= 2 * I_DN) < I_IN) { const int kb = r / 104, nb = r % 104, rho0 = 32 * nb, pn = rho0 >> 8, rem = rho0 & 255, bj = rem >> 7, wc = (rem & 127) >> 5; \
            T = TItem{Awin, PW, 64 * kb, 256 * pn + 64 * wc + 32 * bj, Anm, AWIN, D, rho0}; } \
        else { r -= I_IN; const int kb = r / 32, nb = r % 32; T = TItem{Awout, D, 64 * kb, 32 * nb, nullptr, AWOUT, D, 32 * nb}; } } while (0)
    for (int it = gw; it < NITEMS; it += 2 * NGW) {
        TItem T0, T1; float t0[32], t1[32]; const bool two = (it + NGW < NITEMS);
        P0_DECODE(it, T0); ti_load(T0, t0, F.lane);
        if (two) { P0_DECODE(it + NGW, T1); ti_load(T1, t1, F.lane); }
        ti_finish(T0, t0, scr, F.lane);
        if (two) ti_finish(T1, t1, scr, F.lane);
    }
#undef P0_DECODE
    for (int it = F.vcu * (NWAVES * 64) + F.tid; it < 512 * 32; it += F.G * NWAVES * 64) {
        int ch, kc, Kk; const float* src; bf16* dst;
        if (it < 512 * 8) { ch = it >> 3; kc = (it & 7) * 8; Kk = 64; src = Aw2; dst = AWLORA; }
        else if (it < 512 * 16) { const int i2 = it - 512 * 8; ch = i2 >> 3; kc = (i2 & 7) * 8; Kk = 64; src = Aa2; dst = AWLORA + 512 * 64; }
        else { const int i2 = it - 512 * 16; ch = i2 >> 4; kc = (i2 & 15) * 8; Kk = 128; src = Ag2; dst = AWLORA + 2 * 512 * 64; }
        float v[8];
#pragma unroll
        for (int j = 0; j < 8; ++j) v[j] = src[(size_t)(kc + j) * 512 + ch];
        v4u o; o.x = pkbf(v[0], v[1]); o.y = pkbf(v[2], v[3]); o.z = pkbf(v[4], v[5]); o.w = pkbf(v[6], v[7]);
        *(GAS v4u*)(dst + (size_t)ch * Kk + kc) = o;
    }
    for (int mb = gw; mb < M; mb += 4 * NGW) {
        f32x4 v[4][4]; float s[4];
#pragma unroll
        for (int q = 0; q < 4; ++q) { const int m = mb + q * NGW; const GAS f32x4* xr = (const GAS f32x4*)(Ax + (size_t)(m < M ? m : mb) * D) + F.lane;
#pragma unroll
            for (int j = 0; j < 4; ++j) v[q][j] = xr[64 * j]; }
#pragma unroll
        for (int q = 0; q < 4; ++q) { float a = 0.f;
#pragma unroll
            for (int j = 0; j < 4; ++j) a += (v[q][j].x * v[q][j].x + v[q][j].y * v[q][j].y) + (v[q][j].z * v[q][j].z + v[q][j].w * v[q][j].w);
            s[q] = a; }
#pragma unroll
        for (int o = 1; o < 64; o <<= 1) {
#pragma unroll
            for (int q = 0; q < 4; ++q) s[q] += __shfl_xor(s[q], o); }
#pragma unroll
        for (int q = 0; q < 4; ++q) { const int m = mb + q * NGW; if (m < M) {
            GAS unsigned long long* o8 = (GAS unsigned long long*)(AXB + (size_t)m * D) + F.lane;
#pragma unroll
            for (int j = 0; j < 4; ++j) o8[64 * j] = (unsigned long long)pkbf(v[q][j].x, v[q][j].y) | ((unsigned long long)pkbf(v[q][j].z, v[q][j].w) << 32);
            if (F.lane < 16) ASSQ[(size_t)m * 16 + F.lane] = (F.lane == 0) ? s[q] : 0.f; } }
    }
}

__device__ __forceinline__ void p4_lora_prep(Frame& F, const bf16* RW, const float* mu, bf16* ALORA) {
    const int gw = F.vcu * NWAVES + F.wave, NGW = F.G * NWAVES; const int l = F.lane;
    const f32x4 muv = *(const f32x4*)(mu + 1536 + 4 * l);
    for (int m = gw; m < M; m += NGW) {
        const u32x2g c = *(const u32x2g*)(RW + (size_t)m * RWP + 1536 + 4 * l);
        u32x2g p = (u32x2g){0u, 0u};
        if ((m & (SEQ - 1)) != 0) p = *(const u32x2g*)(RW + (size_t)(m - 1) * RWP + 1536 + 4 * l);
        float x[4] = {bflo(c.x), bfhi(c.x), bflo(c.y), bfhi(c.y)}; const float q[4] = {bflo(p.x), bfhi(p.x), bflo(p.y), bfhi(p.y)};
#pragma unroll
        for (int i = 0; i < 4; ++i) { float u = x[i] + (q[i] - x[i]) * muv[i];
            if (l < 16) u = 2.0f * pg8::sigmoid_f(2.0f * u) - 1.0f; else if (l >= 32) u = pg8::sigmoid_f(u);
            x[i] = u; }
        u32x2g o; o.x = pkbf(x[0], x[1]); o.y = pkbf(x[2], x[3]);
        *(u32x2g*)(ALORA + (size_t)m * LORA_K + 4 * l) = o;
    }
}

struct RwArgs { const bf16* RW; const bf16* W2T; const bf16* A2T; const bf16* G2T; const float* w0; const float* a0; bf16* QO; const float *mu, *k_k, *k_a, *r_k, *ln_w, *ln_b; };
__device__ __forceinline__ void ld8bf(const bf16* p, float (&o)[8]) { const v4u w = *(const v4u*)p; o[0] = bflo(w.x); o[1] = bfhi(w.x); o[2] = bflo(w.y); o[3] = bfhi(w.y); o[4] = bflo(w.z); o[5] = bfhi(w.z); o[6] = bflo(w.w); o[7] = bfhi(w.w); }
__device__ __forceinline__ void ld8f(const float* p, float (&o)[8]) { const f32x4 a = *(const f32x4*)p, b = *(const f32x4*)(p + 4); o[0] = a.x; o[1] = a.y; o[2] = a.z; o[3] = a.w; o[4] = b.x; o[5] = b.y; o[6] = b.z; o[7] = b.w; }
__device__ __forceinline__ void ld8l(const LAS float* p, float (&o)[8]) { const f32x4 a = *(const LAS f32x4*)p, b = *(const LAS f32x4*)(p + 4); o[0] = a.x; o[1] = a.y; o[2] = a.z; o[3] = a.w; o[4] = b.x; o[5] = b.y; o[6] = b.z; o[7] = b.w; }
__device__ __forceinline__ void st8l(LAS float* p, const float (&o)[8]) { *(LAS f32x4*)p = (f32x4){o[0], o[1], o[2], o[3]}; *(LAS f32x4*)(p + 4) = (f32x4){o[4], o[5], o[6], o[7]}; }
namespace rwk {
typedef short bf16x8 __attribute__((ext_vector_type(8)));
typedef short s16x4 __attribute__((ext_vector_type(4)));
typedef short v4i16_t __attribute__((ext_vector_type(4)));
constexpr int SLOT = 8192;
#define RSL(s) (lds + (s) * SLOT)
#define RMFMA(a, b, c) __builtin_amdgcn_mfma_f32_16x16x32_bf16((a), (b), (c), 0, 0, 0)
__device__ __forceinline__ int swz(int row, int cb) { return row * 128 + (cb ^ ((row & 7) << 4)); }
struct Fr2 { bf16x8 k0, k1; };
__device__ __forceinline__ Fr2 ldf(const LAS unsigned char* base, int off) { Fr2 f; f.k0 = *(const LAS bf16x8*)(base + off); f.k1 = *(const LAS bf16x8*)(base + (off ^ 64)); return f; }
__device__ __forceinline__ s16x4 trd(const LAS unsigned char* p) { return __builtin_bit_cast(s16x4, __builtin_amdgcn_ds_read_tr16_b64_v4i16((LAS v4i16_t*)p)); }
__device__ __forceinline__ Fr2 ldt(const LAS unsigned char* base, int o0, int o1) {
    const s16x4 a = trd(base + o0), b = trd(base + o1), c = trd(base + o0 + 4096), d = trd(base + o1 + 4096);
    Fr2 f; f.k0 = (bf16x8){a[0], a[1], a[2], a[3], b[0], b[1], b[2], b[3]}; f.k1 = (bf16x8){c[0], c[1], c[2], c[3], d[0], d[1], d[2], d[3]}; return f; }
template <bool SWAP> __device__ __forceinline__ f32x4 mm(const Fr2& a, const Fr2& b, f32x4 c) {
    if (SWAP) { c = RMFMA(b.k0, a.k0, c); c = RMFMA(b.k1, a.k1, c); } else { c = RMFMA(a.k0, b.k0, c); c = RMFMA(a.k1, b.k1, c); } return c; }
__device__ __forceinline__ void st4(LAS unsigned char* slot, int off, f32x4 v) { u32x2g w; w.x = pkbf(v[0], v[1]); w.y = pkbf(v[2], v[3]); *(LAS u32x2g*)(slot + off) = w; }
__device__ __forceinline__ f32x4 ld4(const LAS unsigned char* slot, int off) { const u32x2g w = *(const LAS u32x2g*)(slot + off); return (f32x4){bflo(w.x), bfhi(w.x), bflo(w.y), bfhi(w.y)}; }
#define LBAR() asm volatile("s_waitcnt lgkmcnt(0)\n\ts_barrier" ::: "memory")
#define DPPF(x, ctrl, rmask) __int_as_float(__builtin_amdgcn_update_dpp(0, __float_as_int(x), (ctrl), (rmask), 0xF, true))
__device__ __forceinline__ float wave_scan(float x) {
    x += DPPF(x, 0x111, 0xF); x += DPPF(x, 0x112, 0xF); x += DPPF(x, 0x114, 0xF); x += DPPF(x, 0x118, 0xF);
    x += DPPF(x, 0x142, 0xA);
    x += DPPF(x, 0x143, 0xC);
    return x; }
__device__ __forceinline__ void unp8(const v4u w, float (&o)[8]) { o[0] = bflo(w.x); o[1] = bfhi(w.x); o[2] = bflo(w.y); o[3] = bfhi(w.y); o[4] = bflo(w.z); o[5] = bfhi(w.z); o[6] = bflo(w.w); o[7] = bfhi(w.w); }
__device__ __forceinline__ v4u pk8(const float (&o)[8]) { return (v4u){pkbf(o[0], o[1]), pkbf(o[2], o[3]), pkbf(o[4], o[5]), pkbf(o[6], o[7])}; }
}
struct RwX { bf16* P1; bf16* GT; bf16* Y0; bf16* H; bf16* VB0; bf16* VB1; float* GE; bf16* G; };
__device__ __forceinline__ void p6a_rwkv_local(Frame& F, const RwArgs& A, const RwX& X) {
    using namespace rwk;
    LAS unsigned char* lds = F.lds + RING_OFF;
    LAS float* part = (LAS float*)(F.lds + LDSCTL_OFF + 128);
    LAS float* cst = (LAS float*)(F.lds + LDSCTL_OFF + 128 + 4096 + 896);
    const int lane = F.lane, fr = lane & 15, fq = lane >> 4, w = F.wave, m0 = 16 * (w >> 1), n0a = 32 * (w & 1);
    const int fm = swz(m0 + fr, fq * 16);
    const int ta0 = swz(8 * fq + (fr >> 2), 2 * (m0 + 4 * (fr & 3))), ta1 = swz(8 * fq + 4 + (fr >> 2), 2 * (m0 + 4 * (fr & 3)));
    int fn[2], orm[2], otr[2], tb0[2], tb1[2];
#pragma unroll
    for (int t = 0; t < 2; ++t) { const int n0 = n0a + 16 * t; fn[t] = swz(n0 + fr, fq * 16); orm[t] = swz(m0 + fr, 2 * (n0 + 4 * fq)); otr[t] = swz(n0 + fr, 2 * (m0 + 4 * fq));
        tb0[t] = swz(8 * fq + (fr >> 2), 2 * (n0 + 4 * (fr & 3))); tb1[t] = swz(8 * fq + 4 + (fr >> 2), 2 * (n0 + 4 * (fr & 3))); }
    const int NJ = BATCH * NH * (SEQ / 64);
    const int tid = F.tid, ltok = tid >> 3, ldg = tid & 7;
    v4u g_r, g_k, g_v, g_xw, g_xa, g_xg0, g_xg1, g_pr;
#define P6A_LOAD(jj) do { const int u_ = (jj) >> 5, c_ = (jj) & 31; const size_t gr_ = (size_t)(u_ >> 3) * SEQ + c_ * 64 + ltok; const int cb_ = 64 * (u_ & 7) + 8 * ldg; const bf16* rp_ = A.RW + gr_ * RWP; \
        g_r = *(const v4u*)(rp_ + cb_); g_k = *(const v4u*)(rp_ + 512 + cb_); g_v = *(const v4u*)(rp_ + 1024 + cb_); \
        g_xw = *(const v4u*)(rp_ + 1536 + 8 * ldg); g_xa = *(const v4u*)(rp_ + 1600 + 8 * ldg); g_xg0 = *(const v4u*)(rp_ + 1664 + 8 * ldg); g_xg1 = *(const v4u*)(rp_ + 1728 + 8 * ldg); \
        g_pr = (v4u){0u, 0u, 0u, 0u}; if (ltok < 7 && c_ > 0) g_pr = *(const v4u*)(A.RW + ((size_t)(u_ >> 3) * SEQ + c_ * 64 - 1) * RWP + (ltok < 3 ? 512 * ltok + cb_ : 1536 + 64 * (ltok - 3) + 8 * ldg)); } while (0)
    if ((int)blockIdx.x < NJ) P6A_LOAD((int)blockIdx.x);
    int hcur = -1;
    LAS unsigned char* prow = (LAS unsigned char*)(F.lds + LDSCTL_OFF + 128 + 4096);
    if (tid < 256) cst[512 + tid] = A.mu[1536 + tid];
    u32x2g s_p1[2], s_gt[2], s_y0[2], s_hh[2]; size_t s_jo = 0; bool s_have = false;
#define P6A_STORE() do { _Pragma("unroll") for (int t = 0; t < 2; ++t) { \
            *(u32x2g*)(X.P1 + s_jo + ((w * 2 + t) * 64 + lane) * 4) = s_p1[t]; *(u32x2g*)(X.GT + s_jo + ((w * 2 + t) * 64 + lane) * 4) = s_gt[t]; \
            *(u32x2g*)(X.Y0 + s_jo + ((w * 2 + t) * 64 + lane) * 4) = s_y0[t]; *(u32x2g*)(X.H + s_jo + ((w * 2 + t) * 64 + lane) * 4) = s_hh[t]; } } while (0)
    for (int job = blockIdx.x; job < NJ; job += F.G) {
        const int unit = job >> 5, c = job & 31; const int h = unit & 7; const int cb = 64 * h + 8 * w; const size_t jo = (size_t)job * 4096;
        {
            const int so = swz(ltok, 16 * ldg);
            *(LAS v4u*)(RSL(12) + so) = g_r; *(LAS v4u*)(RSL(2) + so) = g_k; *(LAS v4u*)(RSL(0) + so) = g_v;
            *(LAS v4u*)(RSL(14) + so) = g_xw; *(LAS v4u*)(RSL(13) + so) = g_xa; *(LAS v4u*)(RSL(10) + so) = g_xg0; *(LAS v4u*)(RSL(11) + so) = g_xg1;
            if (ltok < 7) *(LAS v4u*)(prow + ltok * 128 + 16 * ldg) = g_pr;
            if (h != hcur) {
                *(LAS v4u*)(RSL(16) + so) = *(const v4u*)(A.W2T + (size_t)(64 * h + ltok) * 64 + 8 * ldg); *(LAS v4u*)(RSL(17) + so) = *(const v4u*)(A.A2T + (size_t)(64 * h + ltok) * 64 + 8 * ldg);
                { const int a_ = tid >> 6, i_ = tid & 63;
                  const float* src_ = (a_ == 0) ? A.mu : (a_ == 1) ? A.mu + 512 : (a_ == 2) ? A.mu + 1024 : (a_ == 3) ? A.k_k : (a_ == 4) ? A.k_a : (a_ == 5) ? A.r_k : (a_ == 6) ? A.w0 : A.a0;
                  cst[a_ * 64 + i_] = src_[64 * h + i_]; } }
            hcur = h;
        }
        if (s_have) P6A_STORE();
        { const int nj = job + F.G; if (nj < NJ) P6A_LOAD(nj); }
        LBAR();
        float r[8], k[8], v[8];
        {
            const int so = swz(lane, 16 * w), sp = swz((lane + 63) & 63, 16 * w);
#define P6A_SHIFT(slot, pi, moff, dst) do { float c_[8], p_[8], m_[8]; v4u wc_ = *(const LAS v4u*)(RSL(slot) + so), wp_ = *(const LAS v4u*)(RSL(slot) + sp); \
                if (lane == 0) wp_ = *(const LAS v4u*)(prow + 128 * (pi) + 16 * w); \
                unp8(wc_, c_); unp8(wp_, p_); ld8l(cst + (moff) + 8 * w, m_); \
                _Pragma("unroll") for (int j = 0; j < 8; ++j) dst[j] = c_[j] + (p_[j] - c_[j]) * m_[j]; } while (0)
            P6A_SHIFT(12, 0, 0, r); asm volatile("" ::: "memory");
            P6A_SHIFT(2, 1, 64, k); asm volatile("" ::: "memory");
            P6A_SHIFT(0, 2, 128, v); asm volatile("" ::: "memory");
            { float x_[8]; P6A_SHIFT(14, 3, 512, x_);
#pragma unroll
              for (int j = 0; j < 8; ++j) x_[j] = 2.0f * pg8::sigmoid_f(2.0f * x_[j]) - 1.0f;
              *(LAS v4u*)(RSL(14) + so) = pk8(x_); } asm volatile("" ::: "memory");
            { float x_[8]; P6A_SHIFT(13, 4, 576, x_); *(LAS v4u*)(RSL(13) + so) = pk8(x_); } asm volatile("" ::: "memory");
            { float x_[8]; P6A_SHIFT(10, 5, 640, x_);
#pragma unroll
              for (int j = 0; j < 8; ++j) x_[j] = pg8::sigmoid_f(x_[j]);
              *(LAS v4u*)(RSL(10) + so) = pk8(x_); } asm volatile("" ::: "memory");
            { float x_[8]; P6A_SHIFT(11, 6, 704, x_);
#pragma unroll
              for (int j = 0; j < 8; ++j) x_[j] = pg8::sigmoid_f(x_[j]);
              *(LAS v4u*)(RSL(11) + so) = pk8(x_); }
#undef P6A_SHIFT
        }
        LBAR();
        {
            const f32x4 z4 = (f32x4){0.f, 0.f, 0.f, 0.f};
            bf16x8 gq[2][4];
#pragma unroll
            for (int t = 0; t < 2; ++t) { const bf16* gp = A.G2T + (size_t)(64 * h + n0a + 16 * t + fr) * 128 + 8 * fq;
#pragma unroll
                for (int q = 0; q < 4; ++q) gq[t][q] = *reinterpret_cast<const bf16x8*>(gp + 32 * q); }
            {   const Fr2 aW = ldf(RSL(14), fm), aA = ldf(RSL(13), fm); Fr2 bW[2], bA[2];
#pragma unroll
                for (int t = 0; t < 2; ++t) { bW[t] = ldf(RSL(16), fn[t]); bA[t] = ldf(RSL(17), fn[t]); }
#pragma unroll
                for (int t = 0; t < 2; ++t) { const int row = m0 + fr, ch = n0a + 16 * t + 4 * fq; const f32x4 lwq = mm<true>(aW, bW[t], z4), alq = mm<true>(aA, bA[t], z4);
                    const f32x4 w0c = *(const LAS f32x4*)(cst + 384 + ch), a0c = *(const LAS f32x4*)(cst + 448 + ch); f32x4 lwv, alv;
#pragma unroll
                    for (int x = 0; x < 4; ++x) { lwv[x] = -0.6065306597126334f * pg8::sigmoid_f(w0c[x] + lwq[x]); alv[x] = pg8::sigmoid_f(a0c[x] + alq[x]); }
                    const int fo = row * 256 + (((ch >> 3) ^ (row & 7)) << 5) + ((ch >> 2) & 1) * 16;
                    *(LAS f32x4*)(RSL(4) + fo) = lwv; *(LAS f32x4*)(RSL(8) + fo) = alv; } }
            asm volatile("" ::: "memory");
            {   const Fr2 aG0 = ldf(RSL(10), fm), aG1 = ldf(RSL(11), fm);
#pragma unroll
                for (int t = 0; t < 2; ++t) { Fr2 bG0, bG1; bG0.k0 = gq[t][0]; bG0.k1 = gq[t][1]; bG1.k0 = gq[t][2]; bG1.k1 = gq[t][3];
                    st4(RSL(3), orm[t], mm<true>(aG1, bG1, mm<true>(aG0, bG0, z4))); } }
        }
        LBAR();
        float kf[8], kk[8], al[8], lw[8]; float ssp = 0.f, bpp = 0.f;
        {
            { const int fo = lane * 256 + ((w ^ (lane & 7)) << 5); const f32x4 a_ = *(const LAS f32x4*)(RSL(4) + fo), b_ = *(const LAS f32x4*)(RSL(4) + fo + 16), c_ = *(const LAS f32x4*)(RSL(8) + fo), d_ = *(const LAS f32x4*)(RSL(8) + fo + 16);
              lw[0] = a_.x; lw[1] = a_.y; lw[2] = a_.z; lw[3] = a_.w; lw[4] = b_.x; lw[5] = b_.y; lw[6] = b_.z; lw[7] = b_.w;
              al[0] = c_.x; al[1] = c_.y; al[2] = c_.z; al[3] = c_.w; al[4] = d_.x; al[5] = d_.y; al[6] = d_.z; al[7] = d_.w; }
            *(v4u*)(X.G + jo + tid * 8) = *(const LAS v4u*)(RSL(3) + swz(ltok, 16 * ldg));
            float kkc[8], kac[8], rkc[8]; ld8l(cst + 192 + 8 * w, kkc); ld8l(cst + 256 + 8 * w, kac); ld8l(cst + 320 + 8 * w, rkc);
#pragma unroll
            for (int j = 0; j < 8; ++j) { kk[j] = k[j] * kkc[j]; ssp += kk[j] * kk[j]; kf[j] = k[j] * (1.0f + (al[j] - 1.0f) * kac[j]); bpp += r[j] * kf[j] * rkc[j]; }
            part[w * 64 + lane] = ssp; part[512 + w * 64 + lane] = bpp;
        }
        LBAR();
        {
            float ss = 0.f, bon = 0.f;
#pragma unroll
            for (int i = 0; i < 8; ++i) { ss += part[i * 64 + lane]; bon += part[512 + i * 64 + lane]; }
            const float inv = 1.0f / fmaxf(sqrtf(ss), 1e-12f);
            float at[8], rt[8], bt[8], kt[8], bh[8], kh[8], ge[8], vb[8];
#pragma unroll
            for (int j = 0; j < 8; ++j) {
                const float cs = wave_scan(lw[j]);
                const float ce = __int_as_float(__builtin_amdgcn_readlane(__float_as_int(cs), 63));
                const float e_cs = __builtin_amdgcn_exp2f(cs * 1.4426950408889634f), e_csm = __builtin_amdgcn_exp2f((cs - lw[j]) * 1.4426950408889634f);
                const float e_neg = __builtin_amdgcn_rcpf(e_cs), e_end = __builtin_amdgcn_exp2f((ce - cs) * 1.4426950408889634f);
                const float kn = kk[j] * inv, bb = kn * al[j];
                at[j] = -kn * e_csm; rt[j] = r[j] * e_cs; bt[j] = bb * e_neg; kt[j] = kf[j] * e_neg; bh[j] = bb * e_end; kh[j] = kf[j] * e_end; ge[j] = e_cs; vb[j] = bon * v[j];
            }
            const int ro = swz(lane, 16 * w);
            *(LAS v4u*)(RSL(0) + ro) = pk8(at); *(LAS v4u*)(RSL(1) + ro) = pk8(rt); *(LAS v4u*)(RSL(2) + ro) = pk8(bt); *(LAS v4u*)(RSL(3) + ro) = pk8(kt);
            *(LAS v4u*)(RSL(4) + ro) = pk8(bh); *(LAS v4u*)(RSL(5) + ro) = pk8(kh); *(LAS v4u*)(RSL(6) + ro) = pk8(v);
            if (lane == 63) { *(f32x4*)(X.GE + (size_t)job * 64 + 8 * w) = (f32x4){ge[0], ge[1], ge[2], ge[3]}; *(f32x4*)(X.GE + (size_t)job * 64 + 8 * w + 4) = (f32x4){ge[4], ge[5], ge[6], ge[7]}; }
            *(LAS v4u*)(RSL(18) + ro) = pk8(vb);
        }
        LBAR();
        {
            { bf16* vbp = (job < 2048) ? (X.VB0 + jo) : (X.VB1 + (jo - (size_t)2048 * 4096)); *(v4u*)(vbp + tid * 8) = *(const LAS v4u*)(RSL(18) + swz(ltok, 16 * ldg)); }
            const f32x4 z4 = (f32x4){0.f, 0.f, 0.f, 0.f};
            const Fr2 aA = ldf(RSL(0), fm), aR = ldf(RSL(1), fm); Fr2 bB[2], bK[2];
#pragma unroll
            for (int t = 0; t < 2; ++t) { bB[t] = ldf(RSL(2), fn[t]); bK[t] = ldf(RSL(3), fn[t]); }
            f32x4 nab[2], nabT[2], nak[2], mrb[2], mrk[2];
#pragma unroll
            for (int t = 0; t < 2; ++t) { nab[t] = mm<true>(aA, bB[t], z4); nabT[t] = mm<false>(aA, bB[t], z4); nak[t] = mm<true>(aA, bK[t], z4); mrb[t] = mm<true>(aR, bB[t], z4); mrk[t] = mm<true>(aR, bK[t], z4); }
#pragma unroll
            for (int t = 0; t < 2; ++t) { const int n0 = n0a + 16 * t; f32x4 x1;
#pragma unroll
                for (int x = 0; x < 4; ++x) { const int i = m0 + fr, j = n0 + 4 * fq + x;
                    if (j >= i) { nab[t][x] = 0.f; nak[t][x] = 0.f; } if (j > i) { mrb[t][x] = 0.f; mrk[t][x] = 0.f; }
                    x1[x] = nab[t][x] + ((i == j) ? 1.0f : 0.f);
                    const int it = m0 + 4 * fq + x, jt = n0 + fr; if (jt >= it) nabT[t][x] = 0.f; }
                st4(RSL(10), orm[t], x1); st4(RSL(12), orm[t], nab[t]); st4(RSL(14), otr[t], nabT[t]);
                st4(RSL(7), orm[t], nak[t]); st4(RSL(8), orm[t], mrb[t]); st4(RSL(9), orm[t], mrk[t]); }
        }
        LBAR();
        {
            const f32x4 z4 = (f32x4){0.f, 0.f, 0.f, 0.f};
            const Fr2 aP = ldf(RSL(12), fm), aN = ldf(RSL(7), fm); Fr2 bT[2], bV[2];
#pragma unroll
            for (int t = 0; t < 2; ++t) { bT[t] = ldf(RSL(14), fn[t]); bV[t] = ldt(RSL(6), tb0[t], tb1[t]); }
            f32x4 q0[2], q1[2], q2[2];
#pragma unroll
            for (int t = 0; t < 2; ++t) { q0[t] = mm<true>(aP, bT[t], z4); q1[t] = mm<false>(aP, bT[t], z4); q2[t] = mm<false>(aN, bV[t], z4); }
#pragma unroll
            for (int t = 0; t < 2; ++t) { st4(RSL(13), orm[t], q0[t]); st4(RSL(15), otr[t], q1[t]); st4(RSL(2), otr[t], q2[t]); }
        }
        LBAR();
#pragma unroll
        for (int kd = 0; kd < 5; ++kd) {
            const int xi = (kd & 1) ? 11 : 10, xo = (kd & 1) ? 10 : 11, pi = (kd & 1) ? 12 : 13, po = (kd & 1) ? 13 : 12, ti = (kd & 1) ? 14 : 15, to = (kd & 1) ? 15 : 14;
            const f32x4 z4 = (f32x4){0.f, 0.f, 0.f, 0.f};
            const Fr2 aX = ldf(RSL(xi), fm), aP = ldf(RSL(pi), fm); Fr2 bT[2]; f32x4 cx[2];
#pragma unroll
            for (int t = 0; t < 2; ++t) { bT[t] = ldf(RSL(ti), fn[t]); cx[t] = ld4(RSL(xi), orm[t]); }
            f32x4 q0[2], q1[2], q2[2];
#pragma unroll
            for (int t = 0; t < 2; ++t) { q0[t] = mm<true>(aX, bT[t], cx[t]); if (kd < 4) { q1[t] = mm<true>(aP, bT[t], z4); q2[t] = mm<false>(aP, bT[t], z4); } }
#pragma unroll
            for (int t = 0; t < 2; ++t) { st4(RSL(xo), orm[t], q0[t]); if (kd < 4) { st4(RSL(po), orm[t], q1[t]); st4(RSL(to), otr[t], q2[t]); } }
            LBAR();
        }
        {
            const f32x4 z4 = (f32x4){0.f, 0.f, 0.f, 0.f};
            const Fr2 aT = ldf(RSL(11), fm); Fr2 bA[2], bZ[2];
#pragma unroll
            for (int t = 0; t < 2; ++t) { bA[t] = ldt(RSL(0), tb0[t], tb1[t]); bZ[t] = ldf(RSL(2), fn[t]); }
            f32x4 q0[2], q1[2];
#pragma unroll
            for (int t = 0; t < 2; ++t) { q0[t] = mm<false>(aT, bA[t], z4); q1[t] = mm<false>(aT, bZ[t], z4); }
#pragma unroll
            for (int t = 0; t < 2; ++t) { st4(RSL(3), otr[t], q0[t]); st4(RSL(7), otr[t], q1[t]); }
        }
        LBAR();
        {
            const f32x4 z4 = (f32x4){0.f, 0.f, 0.f, 0.f};
            f32x4 p1[2], y0[2], gt[2], hh[2];
            {   const Fr2 aMb = ldf(RSL(8), fm), aMk = ldf(RSL(9), fm); Fr2 bW[2], bU[2], bV[2]; f32x4 cR[2];
#pragma unroll
                for (int t = 0; t < 2; ++t) { bW[t] = ldf(RSL(3), fn[t]); bU[t] = ldf(RSL(7), fn[t]); bV[t] = ldt(RSL(6), tb0[t], tb1[t]); cR[t] = ld4(RSL(1), orm[t]); }
#pragma unroll
                for (int t = 0; t < 2; ++t) { p1[t] = mm<true>(aMb, bW[t], cR[t]); y0[t] = mm<true>(aMk, bV[t], mm<true>(aMb, bU[t], z4)); } }
            {   const Fr2 aW = ldf(RSL(3), fm), aU = ldf(RSL(7), fm), aV = ldt(RSL(6), ta0, ta1); Fr2 bBh[2], bKh[2];
#pragma unroll
                for (int t = 0; t < 2; ++t) { bBh[t] = ldt(RSL(4), tb0[t], tb1[t]); bKh[t] = ldt(RSL(5), tb0[t], tb1[t]); }
#pragma unroll
                for (int t = 0; t < 2; ++t) { gt[t] = mm<false>(aW, bBh[t], z4); hh[t] = mm<true>(aV, bKh[t], mm<true>(aU, bBh[t], z4)); } }
#pragma unroll
            for (int t = 0; t < 2; ++t) {
                s_p1[t].x = pkbf(p1[t][0], p1[t][1]); s_p1[t].y = pkbf(p1[t][2], p1[t][3]); s_gt[t].x = pkbf(gt[t][0], gt[t][1]); s_gt[t].y = pkbf(gt[t][2], gt[t][3]);
                s_y0[t].x = pkbf(y0[t][0], y0[t][1]); s_y0[t].y = pkbf(y0[t][2], y0[t][3]); s_hh[t].x = pkbf(hh[t][0], hh[t][1]); s_hh[t].y = pkbf(hh[t][2], hh[t][3]); }
            s_jo = jo; s_have = true;
        }
    }
    if (s_have) P6A_STORE();
#undef P6A_LOAD
#undef P6A_STORE
    LBAR();
}
__device__ __forceinline__ void p6b_rwkv_seq(Frame& F, const RwArgs& A, const RwX& X, int nwg) {
    using namespace rwk;
    LAS unsigned char* lds = F.lds + RING_OFF;
    constexpr int YLD = 68;
    LAS float* Yf0 = (LAS float*)RSL(6);
    const int tid = F.tid, tok = tid >> 3, dg = tid & 7, lane = F.lane, fr = lane & 15, fq = lane >> 4;
    const int w = F.wave, m0 = 16 * (w >> 1), n0a = 32 * (w & 1);
    const int fm = swz(m0 + fr, fq * 16);
    int fn[2], orm[2], otr[2];
#pragma unroll
    for (int t = 0; t < 2; ++t) { const int n0 = n0a + 16 * t; fn[t] = swz(n0 + fr, fq * 16); orm[t] = swz(m0 + fr, 2 * (n0 + 4 * fq)); otr[t] = swz(n0 + fr, 2 * (m0 + 4 * fq)); }
    for (int unit = blockIdx.x; unit < BATCH * NH; unit += nwg) {
        const int b = unit >> 3, h = unit & 7; const int cb = 64 * h + 8 * dg;
        f32x4 sacc[2]; sacc[0] = (f32x4){0.f, 0.f, 0.f, 0.f}; sacc[1] = sacc[0];
        for (int u = tid; u < SLOT / 4; u += NWAVES * 64) ((LAS unsigned*)RSL(4))[u] = 0u;
        float lnw[8], lnb[8]; ld8f(A.ln_w + cb, lnw); ld8f(A.ln_b + cb, lnb);
        struct Nx { v4u vb, g; u32x2g p1[2], gt[2], y0[2], h[2]; f32x4 ge[2]; };
        Nx nA, nB;
#define P6B_LOAD(cc, N) do { const int job_ = unit * 32 + (cc); const size_t jo_ = (size_t)job_ * 4096; const size_t grow_ = (size_t)b * SEQ + (cc) * 64 + tok; \
            _Pragma("unroll") for (int t = 0; t < 2; ++t) { N.y0[t] = *(const u32x2g*)(X.Y0 + jo_ + ((w * 2 + t) * 64 + lane) * 4); N.h[t] = *(const u32x2g*)(X.H + jo_ + ((w * 2 + t) * 64 + lane) * 4); \
                N.p1[t] = *(const u32x2g*)(X.P1 + jo_ + ((w * 2 + t) * 64 + lane) * 4); N.gt[t] = *(const u32x2g*)(X.GT + jo_ + ((w * 2 + t) * 64 + lane) * 4); \
                N.ge[t] = *(const f32x4*)(X.GE + (size_t)job_ * 64 + n0a + 16 * t + 4 * fq); } \
            const bf16* vbp_ = (job_ < 2048) ? (X.VB0 + jo_) : (X.VB1 + (jo_ - (size_t)2048 * 4096)); \
            N.vb = *(const v4u*)(vbp_ + tok * 64 + 8 * dg); N.g = *(const v4u*)(X.G + jo_ + tok * 64 + 8 * dg); } while (0)
#define P6B_OUT(par, vbw_, gw_, grow_) do { float y[8]; ld8l(Yf0 + (par) * (64 * YLD) + tok * YLD + 8 * dg, y); \
            const float g[8] = {bflo(gw_.x), bfhi(gw_.x), bflo(gw_.y), bfhi(gw_.y), bflo(gw_.z), bfhi(gw_.z), bflo(gw_.w), bfhi(gw_.w)}; \
            const float vb[8] = {bflo(vbw_.x), bfhi(vbw_.x), bflo(vbw_.y), bfhi(vbw_.y), bflo(vbw_.z), bfhi(vbw_.z), bflo(vbw_.w), bfhi(vbw_.w)}; \
            float s_ = 0.f; _Pragma("unroll") for (int j = 0; j < 8; ++j) s_ += y[j]; \
            const float mean = sum8(s_) * (1.0f / 64.0f); float q_ = 0.f; \
            _Pragma("unroll") for (int j = 0; j < 8; ++j) { y[j] -= mean; q_ += y[j] * y[j]; } \
            const float rstd = __builtin_amdgcn_rsqf(sum8(q_) * (1.0f / 64.0f) + LNX_EPS); float ov[8]; \
            _Pragma("unroll") for (int j = 0; j < 8; ++j) ov[j] = (y[j] * rstd * lnw[j] + lnb[j] + vb[j]) * g[j]; \
            v4u wv_; wv_.x = pkbf(ov[0], ov[1]); wv_.y = pkbf(ov[2], ov[3]); wv_.z = pkbf(ov[4], ov[5]); wv_.w = pkbf(ov[6], ov[7]); \
            *(GAS v4u*)(A.QO + (grow_) * D + 512 + cb) = wv_; } while (0)
        v4u p_vb = (v4u){0u, 0u, 0u, 0u}, p_g = p_vb; size_t p_row = 0;
#define P6B_STEP(c, N) do { const int par = (c) & 1, scur = 4 + par, snxt = 5 - par; const size_t grow = (size_t)b * SEQ + (c) * 64 + tok; \
            _Pragma("unroll") for (int t = 0; t < 2; ++t) { *(LAS u32x2g*)(RSL(par) + orm[t]) = N.p1[t]; *(LAS u32x2g*)(RSL(2 + par) + otr[t]) = N.gt[t]; } \
            f32x4 yacc[2], hcur[2], gecur[2]; \
            _Pragma("unroll") for (int t = 0; t < 2; ++t) { yacc[t] = (f32x4){bflo(N.y0[t].x), bfhi(N.y0[t].x), bflo(N.y0[t].y), bfhi(N.y0[t].y)}; hcur[t] = (f32x4){bflo(N.h[t].x), bfhi(N.h[t].x), bflo(N.h[t].y), bfhi(N.h[t].y)}; gecur[t] = N.ge[t]; } \
            const v4u vbw = N.vb, gw = N.g; \
            if ((c) + 2 < SEQ / 64) P6B_LOAD((c) + 2, N); \
            LBAR(); \
            {   const Fr2 aP1 = ldf(RSL(par), fm), aS = ldf(RSL(scur), fm); Fr2 bS[2], bG[2]; \
                _Pragma("unroll") for (int t = 0; t < 2; ++t) { bS[t] = ldf(RSL(scur), fn[t]); bG[t] = ldf(RSL(2 + par), fn[t]); } \
                _Pragma("unroll") for (int t = 0; t < 2; ++t) { yacc[t] = mm<true>(aP1, bS[t], yacc[t]); sacc[t] = mm<true>(aS, bG[t], sacc[t] * gecur[t] + hcur[t]); } \
                _Pragma("unroll") for (int t = 0; t < 2; ++t) { const int n0 = n0a + 16 * t; *(LAS f32x4*)(Yf0 + par * (64 * YLD) + (m0 + fr) * YLD + n0 + 4 * fq) = yacc[t]; st4(RSL(snxt), orm[t], sacc[t]); } } \
            if ((c) > 0) P6B_OUT(par ^ 1, p_vb, p_g, p_row);                    \
            p_vb = vbw; p_g = gw; p_row = grow; } while (0)
        P6B_LOAD(0, nA); P6B_LOAD(1, nB);
        for (int c = 0; c < SEQ / 64; c += 2) {
            P6B_STEP(c, nA);
            P6B_STEP(c + 1, nB);
        }
#undef P6B_STEP
        LBAR();
        P6B_OUT(1, p_vb, p_g, p_row);
#undef P6B_LOAD
#undef P6B_OUT
        LBAR();
    }
}

namespace sba {
using bf16x8 = __attribute__((ext_vector_type(8))) short;
using s16x4 = __attribute__((ext_vector_type(4))) short;
using f32x16 = __attribute__((ext_vector_type(16))) float;
using u32x4 = __attribute__((ext_vector_type(4))) unsigned;
constexpr int QB = 256, KVBLK = 64;
constexpr int LDS_K = 0, LDS_V = 16384, LDS_ST = 32768, ST_LD = 68, LDS_FLAG = LDS_ST + 8 * 32 * ST_LD * 4, LDS_BYTES_ATT = LDS_FLAG + 64;
constexpr float R_DEAD = -160.0f;
#define SBAR() __builtin_amdgcn_sched_barrier(0)
typedef float f32x2_t __attribute__((ext_vector_type(2))); typedef __bf16 bf16x2_t __attribute__((ext_vector_type(2)));
__device__ __forceinline__ unsigned cvtpk_s(float lo, float hi) { f32x2_t v = {lo, hi}; bf16x2_t b = __builtin_convertvector(v, bf16x2_t); return __builtin_bit_cast(unsigned, b); }
__device__ __forceinline__ void qkt(f32x16& p0, f32x16& p1, const char* Kslot, const bf16x8* qr, int r32, int hi) {
    const char* kb = Kslot + hi * 1024 + r32 * 16;
    const f32x16 z = f32x16{};
#pragma unroll
    for (int d0 = 0; d0 < 4; ++d0) {
        const bf16x8 b0 = *reinterpret_cast<const bf16x8*>(kb + d0 * 2048);
        const bf16x8 b1 = *reinterpret_cast<const bf16x8*>(kb + d0 * 2048 + 512);
        if (d0 == 0) { p0 = __builtin_amdgcn_mfma_f32_32x32x16_bf16(b0, qr[0], z, 0, 0, 0); p1 = __builtin_amdgcn_mfma_f32_32x32x16_bf16(b1, qr[0], z, 0, 0, 0); }
        else { p0 = __builtin_amdgcn_mfma_f32_32x32x16_bf16(b0, qr[d0], p0, 0, 0, 0); p1 = __builtin_amdgcn_mfma_f32_32x32x16_bf16(b1, qr[d0], p1, 0, 0, 0); }
    }
}
__device__ __forceinline__ void pv(f32x16* o, int vb, bf16x8 pa0, bf16x8 pa1, bf16x8 pa2, bf16x8 pa3) {
#pragma unroll
    for (int d0 = 0; d0 < 2; ++d0) { s16x4 lo[4], hi[4];
#pragma unroll
        for (int ks = 0; ks < 4; ++ks) {
            asm volatile("ds_read_b64_tr_b16 %0,%1 offset:%c2" : "=&v"(lo[ks]) : "v"(vb), "i"(d0 * 4096 + ks * 1024) : "memory");
            asm volatile("ds_read_b64_tr_b16 %0,%1 offset:%c2" : "=&v"(hi[ks]) : "v"(vb), "i"(d0 * 4096 + ks * 1024 + 512) : "memory"); }
        asm volatile("s_waitcnt lgkmcnt(0)" ::: "memory"); SBAR();
#define PK(k) (bf16x8){lo[k][0], lo[k][1], lo[k][2], lo[k][3], hi[k][0], hi[k][1], hi[k][2], hi[k][3]}
        o[d0] = __builtin_amdgcn_mfma_f32_32x32x16_bf16(pa0, PK(0), o[d0], 0, 0, 0);
        o[d0] = __builtin_amdgcn_mfma_f32_32x32x16_bf16(pa1, PK(1), o[d0], 0, 0, 0);
        o[d0] = __builtin_amdgcn_mfma_f32_32x32x16_bf16(pa2, PK(2), o[d0], 0, 0, 0);
        o[d0] = __builtin_amdgcn_mfma_f32_32x32x16_bf16(pa3, PK(3), o[d0], 0, 0, 0);
#undef PK
    }
}
__device__ __forceinline__ float swap_sum(float x, float& other_if_lo, int hi) {
    auto rr = __builtin_amdgcn_permlane32_swap(__float_as_uint(x), __float_as_uint(x), false, false);
    const float a = __uint_as_float(rr[0]), b = __uint_as_float(rr[1]);
    other_if_lo = hi ? 0.f : b;
    return a + b;
}
__device__ __forceinline__ void attn_wave_unit(int b, int h, int qblk, bf16* QO, const bf16* __restrict__ KB, const bf16* __restrict__ VB, const float* gout, char* wsm  ) {
    const int lane = threadIdx.x & 63, r32 = lane & 31, hi = lane >> 5;
    const long rowbase = (long)b * SEQ; const int q0 = qblk * 32;
    bf16* Qw = QO + (rowbase + q0) * D + h * HD;
    const bf16* Kh = KB + rowbase * SBW + h * HD; const bf16* Vh = VB + rowbase * SBW + h * HD;
    const unsigned lds0 = (unsigned)(uintptr_t)wsm;
    const int jtop = (q0 + 30) >> 6;
    const bf16* vsrc = Vh + (long)(lane >> 3) * SBW + (lane & 7) * 8;
    const int vdst0 = ((lane & 7) >> 2) * 4096 + ((lane >> 3) & 15) * 64 + (lane & 3) * 16;
    const int vb0 = (int)lds0 + ((lane >> 4) & 1) * 32 + (lane & 3) * 8 + (4 * hi + ((lane & 15) >> 2)) * 64;
    const bf16* ksrc = Kh + (long)r32 * SBW + hi * 8;
    bf16x8 qr[4];
#pragma unroll
    for (int d0 = 0; d0 < 4; ++d0) qr[d0] = *reinterpret_cast<const bf16x8*>(&Qw[(long)r32 * D + d0 * 16 + hi * 8]);
    bf16x8 kf[8]; u32x4 vr[8];
#define SBA_LOAD(t) do { const bf16* kp_ = ksrc + (long)(t) * KVBLK * SBW; const bf16* vp_ = vsrc + (long)(t) * KVBLK * SBW; \
        _Pragma("unroll") for (int d0 = 0; d0 < 4; ++d0) { kf[2 * d0] = *reinterpret_cast<const bf16x8*>(kp_ + d0 * 16); kf[2 * d0 + 1] = *reinterpret_cast<const bf16x8*>(kp_ + 32 * SBW + d0 * 16); } \
        _Pragma("unroll") for (int i = 0; i < 8; ++i) vr[i] = *(const u32x4*)(vp_ + (long)(8 * i) * SBW); } while (0)
    SBA_LOAD(jtop);
    float R = 0.f; f32x16 o[2]; o[0] = f32x16{}; o[1] = f32x16{};
    const int qrow = q0 + r32;
    for (int jt = jtop; jt >= 0; --jt) {
        const int cur = (jtop - jt) & 1;
#pragma unroll
        for (int i = 0; i < 8; ++i) *(u32x4*)(wsm + cur * 8192 + vdst0 + (i >> 1) * 1024 + (i & 1) * 512) = vr[i];
        f32x16 p0, p1;
        {   const f32x16 z = f32x16{};
            p0 = __builtin_amdgcn_mfma_f32_32x32x16_bf16(kf[0], qr[0], z, 0, 0, 0); p1 = __builtin_amdgcn_mfma_f32_32x32x16_bf16(kf[1], qr[0], z, 0, 0, 0);
#pragma unroll
            for (int d0 = 1; d0 < 4; ++d0) { p0 = __builtin_amdgcn_mfma_f32_32x32x16_bf16(kf[2 * d0], qr[d0], p0, 0, 0, 0); p1 = __builtin_amdgcn_mfma_f32_32x32x16_bf16(kf[2 * d0 + 1], qr[d0], p1, 0, 0, 0); } }
        if (jt > 0) SBA_LOAD(jt - 1);
        f32x16 lb0, lb1;
        const int kb = 64 * jt + 4 * hi; const bool diag = (jt == jtop);
#pragma unroll
        for (int r = 0; r < 16; ++r) {
            { const float z = p0[r]; const float L = __builtin_amdgcn_logf(1.0f + __builtin_amdgcn_exp2f(z)); float lb = z - L; float l1 = -L;
              if (diag) { const int key = kb + (r & 3) + 8 * (r >> 2); if (key >= qrow) { l1 = 0.f; lb = -1e30f; } }
              lb0[r] = lb; p0[r] = l1; }
            { const float z = p1[r]; const float L = __builtin_amdgcn_logf(1.0f + __builtin_amdgcn_exp2f(z)); float lb = z - L; float l1 = -L;
              if (diag) { const int key = kb + 32 + (r & 3) + 8 * (r >> 2); if (key >= qrow) { l1 = 0.f; lb = -1e30f; } }
              lb1[r] = lb; p1[r] = l1; }
        }
        float c0[4], c1[4], x0[4], x1[4];
#pragma unroll
        for (int g = 0; g < 4; ++g) {
            const float s0 = (p0[4 * g] + p0[4 * g + 1]) + (p0[4 * g + 2] + p0[4 * g + 3]);
            const float s1 = (p1[4 * g] + p1[4 * g + 1]) + (p1[4 * g + 2] + p1[4 * g + 3]);
            c0[g] = swap_sum(s0, x0[g], hi); c1[g] = swap_sum(s1, x1[g], hi);
        }
        float suf0[4], suf1[4];
        suf1[3] = R; suf1[2] = suf1[3] + c1[3]; suf1[1] = suf1[2] + c1[2]; suf1[0] = suf1[1] + c1[1];
        suf0[3] = suf1[0] + c1[0]; suf0[2] = suf0[3] + c0[3]; suf0[1] = suf0[2] + c0[2]; suf0[0] = suf0[1] + c0[1];
        R = suf0[0] + c0[0];
#pragma unroll
        for (int g = 0; g < 4; ++g) {
            { const float e3 = suf0[g] + x0[g], e2 = e3 + p0[4 * g + 3], e1 = e2 + p0[4 * g + 2], e0 = e1 + p0[4 * g + 1];
              p0[4 * g + 3] = __builtin_amdgcn_exp2f(lb0[4 * g + 3] + e3); p0[4 * g + 2] = __builtin_amdgcn_exp2f(lb0[4 * g + 2] + e2);
              p0[4 * g + 1] = __builtin_amdgcn_exp2f(lb0[4 * g + 1] + e1); p0[4 * g] = __builtin_amdgcn_exp2f(lb0[4 * g] + e0); }
            { const float e3 = suf1[g] + x1[g], e2 = e3 + p1[4 * g + 3], e1 = e2 + p1[4 * g + 2], e0 = e1 + p1[4 * g + 1];
              p1[4 * g + 3] = __builtin_amdgcn_exp2f(lb1[4 * g + 3] + e3); p1[4 * g + 2] = __builtin_amdgcn_exp2f(lb1[4 * g + 2] + e2);
              p1[4 * g + 1] = __builtin_amdgcn_exp2f(lb1[4 * g + 1] + e1); p1[4 * g] = __builtin_amdgcn_exp2f(lb1[4 * g] + e0); }
        }
#define PKW(P, B) cvtpk_s(P[B], P[B + 1])
        const u32x4 pw0 = (u32x4){PKW(p0, 0), PKW(p0, 2), PKW(p0, 4), PKW(p0, 6)}, pw1 = (u32x4){PKW(p0, 8), PKW(p0, 10), PKW(p0, 12), PKW(p0, 14)};
        const u32x4 pw2 = (u32x4){PKW(p1, 0), PKW(p1, 2), PKW(p1, 4), PKW(p1, 6)}, pw3 = (u32x4){PKW(p1, 8), PKW(p1, 10), PKW(p1, 12), PKW(p1, 14)};
#undef PKW
        SBAR();
        asm volatile("s_waitcnt lgkmcnt(0)" ::: "memory");
        pv(o, vb0 + cur * 8192, __builtin_bit_cast(bf16x8, pw0), __builtin_bit_cast(bf16x8, pw1), __builtin_bit_cast(bf16x8, pw2), __builtin_bit_cast(bf16x8, pw3));
        if (__all(R < R_DEAD)) break;
    }
#undef SBA_LOAD
    {
        float* stg = (float*)wsm;
        asm volatile("s_waitcnt lgkmcnt(0)" ::: "memory");
#pragma unroll
        for (int r = 0; r < 16; ++r) { const int orow = (r & 3) + 8 * (r >> 2) + 4 * hi;
#pragma unroll
            for (int d0 = 0; d0 < 2; ++d0) stg[orow * ST_LD + d0 * 32 + r32] = o[d0][r]; }
        asm volatile("s_waitcnt lgkmcnt(0)" ::: "memory");
        const int ch = lane & 7;
        const f32x4 ga = *(const f32x4*)(gout + h * HD + ch * 8), gb = *(const f32x4*)(gout + h * HD + ch * 8 + 4);
#pragma unroll
        for (int i = 0; i < 4; ++i) { const int row = i * 8 + (lane >> 3);
            const f32x4 a = *(const f32x4*)(stg + row * ST_LD + ch * 8), c = *(const f32x4*)(stg + row * ST_LD + ch * 8 + 4);
            float ss = (a.x * a.x + a.y * a.y) + (a.z * a.z + a.w * a.w) + (c.x * c.x + c.y * c.y) + (c.z * c.z + c.w * c.w);
            ss = sum8(ss);
            const float hs = __builtin_amdgcn_rsqf(ss * (1.0f / 64.0f) + 1e-6f);
            u32x4 w; w.x = cvtpk_s(a.x * hs * ga.x, a.y * hs * ga.y); w.y = cvtpk_s(a.z * hs * ga.z, a.w * hs * ga.w);
            w.z = cvtpk_s(c.x * hs * gb.x, c.y * hs * gb.y); w.w = cvtpk_s(c.z * hs * gb.z, c.w * hs * gb.w);
            *(u32x4*)(Qw + (long)row * D + ch * 8) = w; }
        asm volatile("s_waitcnt lgkmcnt(0)" ::: "memory");
    }
}
#undef SBAR
__device__ __forceinline__ void attn_phase(Frame& F, bf16* QO, const bf16* KB, const bf16* VB, const float* gout, unsigned* queue, int first_ticket, int ticket_base) {
    char* wsm = (char*)F.lds + RING_OFF + F.wave * 16384;
    const int nunits = BATCH * NH * (SEQ / 32);
    int pend = -1; int tfirst = first_ticket;
    for (;;) {
        int uu;
        if (pend >= 0) { uu = pend; pend = -1; }
        else { unsigned t;
               if (tfirst >= 0) { t = (unsigned)tfirst; tfirst = -1; }
               else { t = 0u; if (F.lane == 0) t = __hip_atomic_fetch_add(queue, 1u, __ATOMIC_RELAXED, __HIP_MEMORY_SCOPE_AGENT); t = (unsigned)__builtin_amdgcn_readfirstlane((int)t) + (unsigned)ticket_base; }
               if (2u * t >= (unsigned)nunits) break; uu = (int)(2u * t); pend = uu + 1; }
        attn_wave_unit(uu >> 9, (uu >> 6) & 7, uu & 63, QO, KB, VB, gout, wsm);
    }
    __syncthreads();
}
}

struct Args { const float* in[26]; float* out; unsigned char* ws; int ph_lo, ph_hi, li, pad; };
__global__ void __launch_bounds__(NWAVES * 64, 2) skel_fwd(Args args) {
    extern __shared__ __attribute__((aligned(16))) unsigned char lds[];
    Frame F;
    F.lds = (LAS unsigned char*)lds;
    F.MISC = (volatile LAS unsigned*)(F.lds + MISC_OFF);
    F.tid = threadIdx.x; F.lane = F.tid & 63; F.wave = __builtin_amdgcn_readfirstlane(F.tid >> 6);
    F.G = gridDim.x; { const int bx = blockIdx.x; F.vcu = (F.G % 8 == 0) ? (bx % 8) * (F.G / 8) + bx / 8 : bx; }
    unsigned char* ws = args.ws;
    F.ctl = (gu32*)(ws + WS_CTL);
    const float* x = args.in[0];
    bf16* W1U = (bf16*)(ws + WS_W1U); bf16* W1D = (bf16*)(ws + WS_W1D); bf16* W2U = (bf16*)(ws + WS_W2U); bf16* W2D = (bf16*)(ws + WS_W2D);
    bf16* WIN = (bf16*)(ws + WS_WIN); bf16* WOUT = (bf16*)(ws + WS_WOUT); bf16* WLORA = (bf16*)(ws + WS_WLORA);
    bf16* XB = (bf16*)(ws + WS_XB); bf16* ACT = (bf16*)(ws + WS_ACT); bf16* QO = (bf16*)(ws + WS_QO); bf16* KB = (bf16*)(ws + WS_KB); bf16* VB = (bf16*)(ws + WS_VB);
    bf16* RW = (bf16*)(ws + WS_RW); bf16* ALORA = (bf16*)(ws + WS_ALORA); float* LW = (float*)(ws + WS_LW); bf16* AB = (bf16*)(ws + WS_AB); bf16* GB = (bf16*)(ws + WS_GB);
    float* SSQ = (float*)(ws + WS_SSQ); float* out = args.out;
    for (int u = F.tid; u < (LDS_BYTES - LDSCTL_OFF) / 4; u += NWAVES * 64) ((LAS unsigned*)(F.lds + LDSCTL_OFF))[u] = 0u;
    __syncthreads();
    XcdBarrier bar; bar.bar = (unsigned*)(F.ctl + CW_BAR); bar.x = 0; bar.st = nullptr;
    if (N_LAUNCHES != PER_PHASE) bar = xcd_barrier_post((unsigned*)(F.ctl + CW_BAR), F.MISC + 8);
#define GRID_BAR(seam) do { if (N_LAUNCHES == PER_PHASE) { if (F.tid == 0) __hip_atomic_store(F.ctl + CW_TMO, 0xBADBA0u | (unsigned)(seam), RLX_AGENT); } else { xcd_barrier(bar); } } while (0)
    const int lo = args.ph_lo, hi = args.ph_hi;
#define IN(k) (lo <= (k) && (k) < hi)
#define BOTH(k) (IN(k) && IN((k) + 1))
    if (IN(0)) {
        p0_prologue(F, x, args.in[1], args.in[2], args.in[3], args.in[4], args.in[5], args.in[6], args.in[12], args.in[14], args.in[15], args.in[21], args.in[22], args.in[23], args.in[24], args.in[25],
                    W1U, W1D, W2U, W2D, WIN, WOUT, WLORA, XB, SSQ); if (BOTH(0)) GRID_BAR(0);
    }
    if (IN(1)) {
        pg8::Gemm g{XB, W1U, M, 2 * FF, D}; pg8::StaticOrder S; S.init(M, 2 * FF, F.G, (int)blockIdx.x);
        pg8::EpiSwiGLU E{ACT, FF, SSQ};
        pg8::gemm_phase<pg8::EpiSwiGLU, pg8::StaticOrder, true, true>(F.lds + RING_OFF, g, S, E);
        if (BOTH(1)) GRID_BAR(1);
    }
    if (IN(2)) {
        pg8::Gemm g{ACT, W1D, M, D, FF}; pg8::StaticOrder S; S.init(M, D, F.G, (int)blockIdx.x);
        pg8::EpiResid E{x, nullptr, nullptr, nullptr, XB, (bf16*)out, SSQ, 0.5f, 1};
        pg8::gemm_phase<pg8::EpiResid, pg8::StaticOrder, true, true>(F.lds + RING_OFF, g, S, E);
        if (BOTH(2)) GRID_BAR(2);
    }
    if (IN(3)) {
        pg8::Gemm g{XB, WIN, M, PW, D}; pg8::StaticOrder S; S.init(M, PW, F.G, (int)blockIdx.x);
        pg8::EpiWin E{QO, KB, VB, RW, SSQ, args.in[7], args.in[8], 0.125f * 1.4426950408889634f};
        pg8::gemm_phase<pg8::EpiWin, pg8::StaticOrder, true, true>(F.lds + RING_OFF, g, S, E);
        if (BOTH(3)) GRID_BAR(3);
    }
    if (IN(6)) {
        RwArgs A{RW, WLORA, WLORA + 512 * 64, WLORA + 2 * 512 * 64, args.in[11], args.in[13], QO, args.in[10], args.in[16], args.in[17], args.in[18], args.in[19], args.in[20]};
        bf16* ob = (bf16*)out;
        RwX X{ob + (size_t)32 * 1024 * 1024, ob + (size_t)48 * 1024 * 1024, (bf16*)LW, (bf16*)LW + (size_t)16 * 1024 * 1024, AB, AB + (size_t)8 * 1024 * 1024, SSQ, GB};
        p6a_rwkv_local(F, A, X);
        GRID_BAR(16);
        const int nseq = (F.G >= 2 * BATCH * NH) ? BATCH * NH : F.G;
        if ((int)blockIdx.x < nseq) { p6b_rwkv_seq(F, A, X, nseq); __syncthreads(); }
        const int nfree = (F.G - nseq) * NWAVES;
        sba::attn_phase(F, QO, KB, VB, args.in[9], (unsigned*)(F.ctl + CW_QUEUE), ((int)blockIdx.x >= nseq) ? ((int)blockIdx.x - nseq) * NWAVES + F.wave : -1, nfree);
        if (BOTH(6)) GRID_BAR(6);
    }
    if (IN(8)) {
        pg8::Gemm g{QO, WOUT, M, D, D}; pg8::StaticOrder S; S.init(M, D, F.G, (int)blockIdx.x);
        pg8::EpiResid E{nullptr, XB, (const bf16*)out, nullptr, XB, (bf16*)LW, SSQ, 1.0f, 1};
        pg8::gemm_phase<pg8::EpiResid, pg8::StaticOrder, true, true>(F.lds + RING_OFF, g, S, E);
        if (BOTH(8)) GRID_BAR(8);
    }
    if (IN(9)) {
        pg8::Gemm g{XB, W2U, M, 2 * FF, D}; pg8::StaticOrder S; S.init(M, 2 * FF, F.G, (int)blockIdx.x);
        pg8::EpiSwiGLU E{ACT, FF, SSQ};
        pg8::gemm_phase<pg8::EpiSwiGLU, pg8::StaticOrder, true, true>(F.lds + RING_OFF, g, S, E);
        if (BOTH(9)) GRID_BAR(9);
    }
    if (IN(10)) {
        pg8::Gemm g{ACT, W2D, M, D, FF}; pg8::StaticOrder S; S.init(M, D, F.G, (int)blockIdx.x);
        pg8::EpiResid E{nullptr, XB, (const bf16*)LW, out, nullptr, nullptr, SSQ, 0.5f, 0};
        pg8::gemm_phase<pg8::EpiResid, pg8::StaticOrder, true, true>(F.lds + RING_OFF, g, S, E);
    }
#undef IN
#undef BOTH
}

extern "C" void kernel_launch(void* const* d_in, const int* in_sizes, int n_in, void* d_out, int out_size, void* d_ws, size_t ws_size, hipStream_t stream) {
    static int grid = 0;
    if (grid == 0) {
        if (n_in != 26 || in_sizes[0] != M * D || out_size != M * D || ws_size < WS_END) { fprintf(stderr, "kernel_launch: unexpected shapes: n_in %d in0 %d out %d ws %zu (need %zu)\n", n_in, n_in > 0 ? in_sizes[0] : -1, out_size, ws_size, (size_t)WS_END); grid = -1; return; }
        int dev = 0, cus = 0, per_cu = 0;
        if (hipGetDevice(&dev) != hipSuccess || hipDeviceGetAttribute(&cus, hipDeviceAttributeMultiprocessorCount, dev) != hipSuccess) { grid = -1; return; }
        if (hipFuncSetAttribute((const void*)skel_fwd, hipFuncAttributeMaxDynamicSharedMemorySize, LDS_BYTES) != hipSuccess) { fprintf(stderr, "kernel_launch: hipFuncSetAttribute failed\n"); grid = -1; return; }
        if (hipOccupancyMaxActiveBlocksPerMultiprocessor(&per_cu, (const void*)skel_fwd, NWAVES * 64, LDS_BYTES) != hipSuccess || per_cu < 1) { fprintf(stderr, "kernel_launch: occupancy query reports %d blocks per CU\n", per_cu); per_cu = 1; }
        (void)hipGetLastError();
        grid = cus;
    }
    if (grid < 0) return;
    if (hipMemsetAsync((char*)d_ws + WS_CTL, 0, CTL_ZERO_BYTES, stream) != hipSuccess) return;
    Args a{};
    for (int i = 0; i < 26; ++i) a.in[i] = (const float*)d_in[i];
    a.out = (float*)d_out; a.ws = (unsigned char*)d_ws;
    for (int li = 0; li < N_LAUNCHES; ++li) {
        a.ph_lo = (N_LAUNCHES == PER_PHASE) ? li : 0; a.ph_hi = (N_LAUNCHES == PER_PHASE) ? li + 1 : PER_PHASE; a.li = li;
        hipLaunchKernelGGL(skel_fwd, dim3(grid), dim3(NWAVES * 64), LDS_BYTES, stream, a);
    }
}
```

```cpp
#include <hip/hip_runtime.h>
#include <hip/hip_bf16.h>
#include <cstdio>
#include <cstdint>
#include <cmath>
namespace pg8 {
#define PG8_LAS __attribute__((address_space(3)))
typedef unsigned short bf16_t;
typedef short bf16x8 __attribute__((ext_vector_type(8)));
typedef float f32x4 __attribute__((ext_vector_type(4)));
typedef unsigned u32x4 __attribute__((ext_vector_type(4)));
constexpr int BM = 256, BK = 64, HALF = 128, HTB = HALF * BK * 2  , STAGE_BYTES = 8 * HTB, NXCD = 8, WGM = 4;

__host__ __device__ __forceinline__ int lds_byte(int r, int c) { const int st = (r >> 4) * 2 + (c >> 5), rr = r & 15, cc = c & 31, ob = rr * 64 + cc * 2; return st * 1024 + (ob ^ (((ob >> 9) & 1) << 5)); }
__host__ __device__ __forceinline__ void stage_rc(int b, int& R, int& C) { const int st = b / 1024, sb = b % 1024, swz = sb ^ (((sb >> 9) & 1) << 5); R = (st >> 1) * 16 + swz / 64; C = (st & 1) * 32 + (swz % 64) / 2; }
__host__ __device__ __forceinline__ int perm32(int rho) { const int n = rho >> 4, i = rho & 15; return 8 * (i >> 2) + 4 * n + (i & 3); }

struct Unit { int pm, pn; };
struct Gemm { const bf16_t* A; const bf16_t* Bt; int M, N, K; int ld; };

struct StaticOrder {
    int nM, nN, nwg, G, c;
    __host__ __device__ void init(int M, int N, int G_, int c_) { nM = M / BM; nN = N / BM; nwg = nM * nN; G = G_; c = c_; }
    __host__ __device__ bool next(int i, Unit& u) const {
        const long L = (long)i * G + c; if (L >= nwg) return false;
        int wgid = (int)L; { const int q = nwg / NXCD, r = nwg % NXCD, xcd = wgid % NXCD, off = wgid / NXCD; wgid = (xcd < r ? xcd * (q + 1) : r * (q + 1) + (xcd - r) * q) + off; }
        const int nig = WGM * nN, gid = wgid / nig, fm = gid * WGM, gsz = (nM - fm) < WGM ? (nM - fm) : WGM;
        u.pm = fm + ((wgid % nig) % gsz); u.pn = (wgid % nig) / gsz; return true;
    }
    __device__ __forceinline__ void a_ready(const Unit&) const {}
    __device__ __forceinline__ void done(const Unit&) const {}
};


__device__ __forceinline__ unsigned cvt_pk_bf16(float lo, float hi) { unsigned r; asm volatile("v_cvt_pk_bf16_f32 %0, %1, %2" : "=v"(r) : "v"(lo), "v"(hi)); return r; }
typedef unsigned u32x2 __attribute__((ext_vector_type(2)));
constexpr float RMS_EPS_F = 1e-6f;
constexpr float LOG2E_F = 1.4426950408889634f;
__device__ __forceinline__ float row_rs(const float* ssqp, int row) {
    const f32x4* p = (const f32x4*)(ssqp + (size_t)row * 16);
    const f32x4 a = p[0], b = p[1], c = p[2], d = p[3];
    const float s = ((a[0] + a[1]) + (a[2] + a[3])) + ((b[0] + b[1]) + (b[2] + b[3])) + ((c[0] + c[1]) + (c[2] + c[3])) + ((d[0] + d[1]) + (d[2] + d[3]));
    return __builtin_amdgcn_rsqf(s * (1.0f / 1024.0f) + RMS_EPS_F);
}
__device__ __forceinline__ float silu_f(float g) { return g * __builtin_amdgcn_rcpf(1.0f + __builtin_amdgcn_exp2f(-g * LOG2E_F)); }
__device__ __forceinline__ float sigmoid_f(float g) { return __builtin_amdgcn_rcpf(1.0f + __builtin_amdgcn_exp2f(-g * LOG2E_F)); }

struct EpiSwiGLU {
    static constexpr bool PERM = true, AFTER_DRAIN = false;
    bf16_t* O; int ldo; const float* ssqp;
    __device__ __forceinline__ void operator()(const f32x4 (&acc)[2][2][4][2], const Unit& u, int wr, int wc, int fr, int fq) const {
        const int row0 = u.pm * BM + wr * 64 + fr, col0 = u.pn * HALF + wc * 32 + 8 * fq;
#pragma unroll
        for (int ai = 0; ai < 2; ++ai)
#pragma unroll
            for (int m = 0; m < 4; ++m) {
                const int row = row0 + ai * HALF + m * 16; const float rs = row_rs(ssqp, row);
                const f32x4 g0 = acc[ai][0][m][0] * rs, g1 = acc[ai][0][m][1] * rs, u0 = acc[ai][1][m][0] * rs, u1 = acc[ai][1][m][1] * rs;
                u32x4 w;
                w.x = cvt_pk_bf16(silu_f(g0[0]) * u0[0], silu_f(g0[1]) * u0[1]); w.y = cvt_pk_bf16(silu_f(g0[2]) * u0[2], silu_f(g0[3]) * u0[3]);
                w.z = cvt_pk_bf16(silu_f(g1[0]) * u1[0], silu_f(g1[1]) * u1[1]); w.w = cvt_pk_bf16(silu_f(g1[2]) * u1[2], silu_f(g1[3]) * u1[3]);
                *(u32x4*)(O + (size_t)row * ldo + col0) = w;
            }
    }
};

struct EpiResid {
    static constexpr bool PERM = true, AFTER_DRAIN = false;
    const float* basef; const bf16_t* bhi; const bf16_t* blo; float* outf; bf16_t* ohi; bf16_t* olo; float* ssqp; float alpha; int aux;
    __device__ __forceinline__ static f32x4 up_lo(unsigned a, unsigned b) { return (f32x4){__uint_as_float(a << 16), __uint_as_float(a & 0xffff0000u), __uint_as_float(b << 16), __uint_as_float(b & 0xffff0000u)}; }
    __device__ __forceinline__ void operator()(const f32x4 (&acc)[2][2][4][2], const Unit& u, int wr, int wc, int fr, int fq) const {
        const int row0 = u.pm * BM + wr * 64 + fr, col0 = u.pn * BM + wc * 32 + 8 * fq;
#pragma unroll
        for (int ai = 0; ai < 2; ++ai)
#pragma unroll
            for (int m = 0; m < 4; ++m) {
                const int row = row0 + ai * HALF + m * 16; const size_t off = (size_t)row * 1024 + col0; float ss = 0.f;
#pragma unroll
                for (int bj = 0; bj < 2; ++bj) {
                    f32x4 b0, b1;
                    if (basef) { b0 = *(const f32x4*)(basef + off + bj * HALF); b1 = *(const f32x4*)(basef + off + bj * HALF + 4); }
                    else { const u32x4 h = *(const u32x4*)(bhi + off + bj * HALF), l = *(const u32x4*)(blo + off + bj * HALF); b0 = up_lo(h.x, h.y) + up_lo(l.x, l.y); b1 = up_lo(h.z, h.w) + up_lo(l.z, l.w); }
                    const f32x4 v0 = b0 + acc[ai][bj][m][0] * alpha, v1 = b1 + acc[ai][bj][m][1] * alpha;
                    if (aux) ss += ((v0[0] * v0[0] + v0[1] * v0[1]) + (v0[2] * v0[2] + v0[3] * v0[3])) + ((v1[0] * v1[0] + v1[1] * v1[1]) + (v1[2] * v1[2] + v1[3] * v1[3]));
                    if (outf) { *(f32x4*)(outf + off + bj * HALF) = v0; *(f32x4*)(outf + off + bj * HALF + 4) = v1; }
                    else { u32x4 h; h.x = cvt_pk_bf16(v0[0], v0[1]); h.y = cvt_pk_bf16(v0[2], v0[3]); h.z = cvt_pk_bf16(v1[0], v1[1]); h.w = cvt_pk_bf16(v1[2], v1[3]);
                        const f32x4 r0 = v0 - up_lo(h.x, h.y), r1 = v1 - up_lo(h.z, h.w);
                        u32x4 l; l.x = cvt_pk_bf16(r0[0], r0[1]); l.y = cvt_pk_bf16(r0[2], r0[3]); l.z = cvt_pk_bf16(r1[0], r1[1]); l.w = cvt_pk_bf16(r1[2], r1[3]);
                        *(u32x4*)(ohi + off + bj * HALF) = h; *(u32x4*)(olo + off + bj * HALF) = l; }
                }
                if (aux) { ss += __shfl_xor(ss, 16); ss += __shfl_xor(ss, 32); if (fq == 0) ssqp[(size_t)row * 16 + u.pn * 4 + wc] = ss; }
            }
    }
};

struct EpiWin {
    static constexpr bool PERM = true, AFTER_DRAIN = false;
    bf16_t* QO; bf16_t* KB; bf16_t* VB; bf16_t* RW; const float* ssqp; const float* gq; const float* gk; float qscale;
    __device__ __forceinline__ void operator()(const f32x4 (&acc)[2][2][4][2], const Unit& u, int wr, int wc, int fr, int fq) const {
        const int row0 = u.pm * BM + wr * 64 + fr; const int pn = u.pn;
        if (pn < 4) {
            const float* gp = (pn < 2) ? gq : gk; const float osc = (pn < 2) ? qscale : 1.0f;
            f32x4 gv[2][2];
#pragma unroll
            for (int bj = 0; bj < 2; ++bj)
#pragma unroll
                for (int n = 0; n < 2; ++n) gv[bj][n] = *(const f32x4*)(gp + 32 * bj + 8 * fq + 4 * n) * osc;
            bf16_t* dst = (pn < 2) ? QO : KB; const int ld = (pn < 2) ? 1024 : 512; const int colh = 64 * (4 * (pn & 1) + wc) + 8 * fq;
#pragma unroll
            for (int ai = 0; ai < 2; ++ai)
#pragma unroll
                for (int m = 0; m < 4; ++m) {
                    const int row = row0 + ai * HALF + m * 16; const float rs = row_rs(ssqp, row);
                    f32x4 y[2][2]; float ss = 0.f;
#pragma unroll
                    for (int bj = 0; bj < 2; ++bj)
#pragma unroll
                        for (int n = 0; n < 2; ++n) { y[bj][n] = acc[ai][bj][m][n] * rs; const f32x4 t = y[bj][n]; ss += (t[0] * t[0] + t[1] * t[1]) + (t[2] * t[2] + t[3] * t[3]); }
                    ss += __shfl_xor(ss, 16); ss += __shfl_xor(ss, 32);
                    const float hs = __builtin_amdgcn_rsqf(ss * (1.0f / 64.0f) + RMS_EPS_F);
#pragma unroll
                    for (int bj = 0; bj < 2; ++bj) {
                        const f32x4 a = y[bj][0] * gv[bj][0] * hs, b = y[bj][1] * gv[bj][1] * hs;
                        u32x4 w; w.x = cvt_pk_bf16(a[0], a[1]); w.y = cvt_pk_bf16(a[2], a[3]); w.z = cvt_pk_bf16(b[0], b[1]); w.w = cvt_pk_bf16(b[2], b[3]);
                        *(u32x4*)(dst + (size_t)row * ld + colh + 32 * bj) = w;
                    }
                }
        } else {
            bf16_t* dst = (pn < 6) ? VB : RW; const int ld = (pn < 6) ? 512 : 1792; const int colh = 256 * ((pn < 6) ? (pn - 4) : (pn - 6)) + 64 * wc + 8 * fq;
#pragma unroll
            for (int ai = 0; ai < 2; ++ai)
#pragma unroll
                for (int m = 0; m < 4; ++m) {
                    const int row = row0 + ai * HALF + m * 16; const float rs = row_rs(ssqp, row);
#pragma unroll
                    for (int bj = 0; bj < 2; ++bj) {
                        const f32x4 a = acc[ai][bj][m][0] * rs, b = acc[ai][bj][m][1] * rs;
                        u32x4 w; w.x = cvt_pk_bf16(a[0], a[1]); w.y = cvt_pk_bf16(a[2], a[3]); w.z = cvt_pk_bf16(b[0], b[1]); w.w = cvt_pk_bf16(b[2], b[3]);
                        *(u32x4*)(dst + (size_t)row * ld + colh + 32 * bj) = w;
                    }
                }
        }
    }
};

struct EpiLora {
    static constexpr bool PERM = true, AFTER_DRAIN = false;
    float* LW; bf16_t* AB; bf16_t* GB; const float* w0; const float* a0;
    __device__ __forceinline__ void operator()(const f32x4 (&acc)[2][2][4][2], const Unit& u, int wr, int wc, int fr, int fq) const {
        const int row0 = u.pm * BM + wr * 64 + fr; const int pn = u.pn; const int colt = 256 * (pn & 1) + wc * 32 + 8 * fq;
        const int kind = pn >> 1;
        const float* bp = (kind == 0) ? w0 : a0;
        bf16_t* ob = (kind == 1) ? AB : GB;
#pragma unroll
        for (int bj = 0; bj < 2; ++bj) {
            f32x4 b0 = (f32x4){0.f, 0.f, 0.f, 0.f}, b1 = b0;
            if (kind < 2) { b0 = *(const f32x4*)(bp + colt + bj * HALF); b1 = *(const f32x4*)(bp + colt + bj * HALF + 4); }
#pragma unroll
            for (int ai = 0; ai < 2; ++ai)
#pragma unroll
                for (int m = 0; m < 4; ++m) {
                    const int row = row0 + ai * HALF + m * 16;
                    f32x4 a = acc[ai][bj][m][0] + b0, b = acc[ai][bj][m][1] + b1;
                    if (kind < 2) {
#pragma unroll
                        for (int i = 0; i < 4; ++i) { a[i] = sigmoid_f(a[i]); b[i] = sigmoid_f(b[i]); }
                    }
                    if (kind == 0) { a = a * (-0.6065306597126334f); b = b * (-0.6065306597126334f);
                        float* p = LW + (size_t)row * 512 + colt + bj * HALF; *(f32x4*)p = a; *(f32x4*)(p + 4) = b; }
                    else { u32x4 w; w.x = cvt_pk_bf16(a[0], a[1]); w.y = cvt_pk_bf16(a[2], a[3]); w.z = cvt_pk_bf16(b[0], b[1]); w.w = cvt_pk_bf16(b[2], b[3]);
                        *(u32x4*)(ob + (size_t)row * 512 + colt + bj * HALF) = w; }
                    if (m & 1) asm volatile("" ::: "memory");
                }
        }
    }
};
template <class Epi, class Sched, bool ALIGN_EPI = false, bool SP2 = false>
__device__ __forceinline__ void gemm_phase(PG8_LAS unsigned char* lds, const Gemm g, const Sched& S, const Epi& E) {
    const int tid = threadIdx.x, wid = __builtin_amdgcn_readfirstlane(tid >> 6), lane = tid & 63, wr = wid >> 2, wc = wid & 3, fr = lane & 15, fq = lane >> 4;
    const int K = g.K, nt = K / BK, LDP = g.ld ? g.ld : g.K;
    unsigned voffA[2], voffB[2];
#pragma unroll
    for (int i = 0; i < 2; ++i) { int R, C; stage_rc(tid * 16 + i * 8192, R, C); const int Rb = Epi::PERM ? ((R & ~31) + perm32(R & 31)) : R;
        voffA[i] = (unsigned)(R * LDP + C) * 2u; voffB[i] = (unsigned)(Rb * LDP + C) * 2u; }
    const size_t kstep = (size_t)(BK * 2);
    const size_t hstep = (size_t)HALF * LDP * 2;
    const size_t tstep = 2 * hstep;
    const unsigned ldsw = (unsigned)wid * 1024u;
    const int aoff = lds_byte(wr * 64 + fr, fq * 8), boff = lds_byte(wc * 32 + fr, fq * 8);
#define PG8_SA(b, h) (((b) * 2 + (h)) * HTB)
#define PG8_SB(b, h) ((4 + (b) * 2 + (h)) * HTB)
#define PG8_STAGE(bufoff, gbase, voff) do { _Pragma("unroll") for (int _i = 0; _i < 2; ++_i) \
        __builtin_amdgcn_global_load_lds((const unsigned*)((const char*)(gbase) + (voff)[_i]), (PG8_LAS unsigned*)(lds + (bufoff) + ldsw + _i * 8192), 16, 0, 0); } while (0)
#define PG8_LDA(dst, b, h) do { _Pragma("unroll") for (int m = 0; m < 4; ++m) _Pragma("unroll") for (int k = 0; k < 2; ++k) dst[m][k] = *(const PG8_LAS bf16x8*)(lds + PG8_SA(b, h) + aoff + m * 2048 + k * 1024); } while (0)
#define PG8_LDB(dst, b, h) do { _Pragma("unroll") for (int n = 0; n < 2; ++n) _Pragma("unroll") for (int k = 0; k < 2; ++k) dst[n][k] = *(const PG8_LAS bf16x8*)(lds + PG8_SB(b, h) + boff + n * 2048 + k * 1024); } while (0)
#define PG8_MMA(ai, bj, At, Bt) do { __builtin_amdgcn_s_setprio(1); _Pragma("unroll") for (int m = 0; m < 4; ++m) _Pragma("unroll") for (int n = 0; n < 2; ++n) _Pragma("unroll") for (int k = 0; k < 2; ++k) \
        acc[ai][bj][m][n] = __builtin_amdgcn_mfma_f32_16x16x32_bf16(Bt[n][k], At[m][k], acc[ai][bj][m][n], 0, 0, 0); __builtin_amdgcn_s_setprio(0); } while (0)
#define PG8_WAIT_V(n) asm volatile("s_waitcnt vmcnt(" #n ")" ::: "memory")
#define PG8_WAIT_L(n) asm volatile("s_waitcnt lgkmcnt(" #n ")" ::: "memory")
#define PG8_BAR __builtin_amdgcn_s_barrier()
#define PG8_SCHED __builtin_amdgcn_sched_barrier(0)
    Unit cur, nxt; int ui = 0;
    if (!S.next(0, cur)) return;
    f32x4 acc[2][2][4][2];
#pragma unroll
    for (int a = 0; a < 2; ++a)
#pragma unroll
        for (int b = 0; b < 2; ++b)
#pragma unroll
            for (int m = 0; m < 4; ++m)
#pragma unroll
                for (int n = 0; n < 2; ++n) acc[a][b][m][n] = (f32x4){0.f, 0.f, 0.f, 0.f};
    bf16x8 At[4][2], B0[2][2], B1[2][2];
    const char* cA = (const char*)g.A + (size_t)cur.pm * tstep; const char* cB = (const char*)g.Bt + (size_t)cur.pn * tstep;
    S.a_ready(cur);
    if constexpr (SP2) {
        PG8_STAGE(PG8_SB(0, 0), cB, voffB); PG8_STAGE(PG8_SB(0, 1), cB + hstep, voffB); PG8_STAGE(PG8_SA(0, 0), cA, voffA); PG8_STAGE(PG8_SA(0, 1), cA + hstep, voffA);
        if (wr == 1) PG8_BAR;
        PG8_WAIT_V(2); PG8_BAR;
        PG8_STAGE(PG8_SB(1, 0), cB + kstep, voffB); PG8_STAGE(PG8_SA(1, 0), cA + kstep, voffA); PG8_STAGE(PG8_SB(1, 1), cB + hstep + kstep, voffB);
        PG8_WAIT_V(6); PG8_BAR;
    } else {
        PG8_STAGE(PG8_SB(0, 0), cB, voffB); PG8_STAGE(PG8_SA(0, 0), cA, voffA); PG8_STAGE(PG8_SB(0, 1), cB + hstep, voffB); PG8_STAGE(PG8_SA(0, 1), cA + hstep, voffA);
        if (wr == 1) PG8_BAR;
        PG8_WAIT_V(4); PG8_BAR;
        PG8_STAGE(PG8_SB(1, 0), cB + kstep, voffB); PG8_STAGE(PG8_SA(1, 0), cA + kstep, voffA); PG8_STAGE(PG8_SB(1, 1), cB + hstep + kstep, voffB);
        PG8_WAIT_V(6); PG8_BAR;
    }
    for (;;) {
        const bool has_next = S.next(ui + 1, nxt);
        const char* nA = has_next ? (const char*)g.A + (size_t)nxt.pm * tstep : cA; const char* nB = has_next ? (const char*)g.Bt + (size_t)nxt.pn * tstep : cB;
        for (int t = 0; t < nt; t += 2) {
            const bool last = (t == nt - 2);
            const char* a1 = cA + (size_t)(t + 1) * kstep;
            const char* a2 = last ? nA : cA + (size_t)(t + 2) * kstep; const char* b2 = last ? nB : cB + (size_t)(t + 2) * kstep;
            const char* a3 = a2 + kstep; const char* b3 = b2 + kstep;
            if (last && has_next) S.a_ready(nxt);
            if constexpr (SP2) {
            PG8_LDB(B0, 0, 0); PG8_LDB(B1, 0, 1); PG8_SCHED; PG8_LDA(At, 0, 0); PG8_STAGE(PG8_SA(1, 1), a1 + hstep, voffA);
            PG8_WAIT_V(8); PG8_WAIT_L(0); PG8_BAR; PG8_MMA(0, 0, At, B0); PG8_MMA(0, 1, At, B1); PG8_BAR; PG8_SCHED;
            PG8_LDA(At, 0, 1); PG8_STAGE(PG8_SB(0, 0), b2, voffB); PG8_STAGE(PG8_SB(0, 1), b2 + hstep, voffB); PG8_STAGE(PG8_SA(0, 0), a2, voffA);
            PG8_WAIT_V(8); PG8_WAIT_L(0); PG8_BAR; PG8_MMA(1, 0, At, B0); PG8_MMA(1, 1, At, B1); PG8_BAR; PG8_SCHED;
            PG8_LDB(B0, 1, 0); PG8_LDB(B1, 1, 1); PG8_SCHED; PG8_LDA(At, 1, 0); PG8_STAGE(PG8_SA(0, 1), a2 + hstep, voffA);
            PG8_WAIT_V(8); PG8_WAIT_L(0); PG8_BAR; PG8_MMA(0, 0, At, B0); PG8_MMA(0, 1, At, B1); PG8_BAR; PG8_SCHED;
            PG8_LDA(At, 1, 1); PG8_STAGE(PG8_SB(1, 0), b3, voffB); PG8_STAGE(PG8_SB(1, 1), b3 + hstep, voffB); PG8_STAGE(PG8_SA(1, 0), a3, voffA);
            PG8_WAIT_V(8); PG8_WAIT_L(0); PG8_BAR; PG8_MMA(1, 0, At, B0); PG8_MMA(1, 1, At, B1); PG8_BAR; PG8_SCHED;
            } else {
            PG8_LDB(B0, 0, 0); PG8_SCHED; PG8_LDA(At, 0, 0); PG8_STAGE(PG8_SA(1, 1), a1 + hstep, voffA);
            PG8_WAIT_L(8); PG8_BAR; PG8_WAIT_L(0); PG8_MMA(0, 0, At, B0); PG8_BAR; PG8_SCHED;
            PG8_LDB(B1, 0, 1); PG8_STAGE(PG8_SB(0, 0), b2, voffB);
            PG8_BAR; PG8_WAIT_L(0); PG8_MMA(0, 1, At, B1); PG8_BAR;
            PG8_LDA(At, 0, 1); PG8_STAGE(PG8_SA(0, 0), a2, voffA);
            PG8_BAR; PG8_WAIT_L(0); PG8_MMA(1, 0, At, B0); PG8_BAR; PG8_SCHED;
            PG8_STAGE(PG8_SB(0, 1), b2 + hstep, voffB);
            PG8_WAIT_V(6); PG8_BAR; PG8_MMA(1, 1, At, B1); PG8_BAR;
            PG8_LDB(B0, 1, 0); PG8_SCHED; PG8_LDA(At, 1, 0); PG8_STAGE(PG8_SA(0, 1), a2 + hstep, voffA);
            PG8_WAIT_L(8); PG8_BAR; PG8_WAIT_L(0); PG8_MMA(0, 0, At, B0); PG8_BAR; PG8_SCHED;
            PG8_LDB(B1, 1, 1); PG8_STAGE(PG8_SB(1, 0), b3, voffB);
            PG8_BAR; PG8_WAIT_L(0); PG8_MMA(0, 1, At, B1); PG8_BAR;
            PG8_LDA(At, 1, 1); PG8_STAGE(PG8_SA(1, 0), a3, voffA);
            PG8_BAR; PG8_WAIT_L(0); PG8_MMA(1, 0, At, B0); PG8_BAR; PG8_SCHED;
            PG8_STAGE(PG8_SB(1, 1), b3 + hstep, voffB);
            PG8_WAIT_V(6); PG8_BAR; PG8_MMA(1, 1, At, B1); PG8_BAR;
            }
        }
        if constexpr (ALIGN_EPI) { if (wr == 0) PG8_BAR; }
        if constexpr (!Epi::AFTER_DRAIN) { E(acc, cur, wr, wc, fr, fq); S.done(cur); }
        if (!has_next) break;
#pragma unroll
        for (int a = 0; a < 2; ++a)
#pragma unroll
            for (int b = 0; b < 2; ++b)
#pragma unroll
                for (int m = 0; m < 4; ++m)
#pragma unroll
                    for (int n = 0; n < 2; ++n) acc[a][b][m][n] = (f32x4){0.f, 0.f, 0.f, 0.f};
        cur = nxt; cA = nA; cB = nB; ++ui;
        if constexpr (ALIGN_EPI) { if (wr == 1) PG8_BAR; }
    }
    PG8_WAIT_V(0);
    if constexpr (!ALIGN_EPI) { if (wr == 0) PG8_BAR; }
    PG8_BAR;
    if constexpr (Epi::AFTER_DRAIN) { E.fused(acc, cur, wr, wc, fr, fq, lds, wid, lane); S.done(cur); }
#undef PG8_SA
#undef PG8_SB
#undef PG8_STAGE
#undef PG8_LDA
#undef PG8_LDB
#undef PG8_MMA
#undef PG8_WAIT_V
#undef PG8_WAIT_L
#undef PG8_BAR
#undef PG8_SCHED
}
}
#define GAS __attribute__((address_space(1)))
#define LAS __attribute__((address_space(3)))
typedef unsigned short bf16;
typedef unsigned v4u __attribute__((ext_vector_type(4)));
typedef float f32x4 __attribute__((ext_vector_type(4)));
typedef short bf16x8 __attribute__((ext_vector_type(8)));
typedef GAS unsigned gu32;
typedef GAS unsigned long long gu64;
#define RLX_AGENT __ATOMIC_RELAXED, __HIP_MEMORY_SCOPE_AGENT
#define LDS_WAIT() asm volatile("s_waitcnt lgkmcnt(0)" ::: "memory")
#define VM_WAIT() asm volatile("s_waitcnt vmcnt(0)" ::: "memory")
__device__ __forceinline__ unsigned long long rt() { return __builtin_amdgcn_s_memrealtime(); }
__device__ __forceinline__ unsigned f2bf(float f) { unsigned u = __builtin_bit_cast(unsigned, f); return (u + 0x7fffu + ((u >> 16) & 1u)) >> 16; }
__device__ __forceinline__ unsigned pk2(float lo, float hi) { return f2bf(lo) | (f2bf(hi) << 16); }

#define XB_TMO      128
#define XB_XCNT(j)  (256  + 64 * (j))
#define XB_XSUB(j)  (1280 + 64 * (j))
#define XB_XGEN(j)  (2304 + 64 * (j))
#define XB_TOP      3328
#define XB_TOPGEN   3392
#define XCD_BAR_WORDS 3456
#define XB_SPIN_CAP (1u << 18)

__device__ __forceinline__ unsigned xb_ld(unsigned* p)              { return __hip_atomic_load(p, __ATOMIC_RELAXED, __HIP_MEMORY_SCOPE_AGENT); }
__device__ __forceinline__ unsigned xb_add(unsigned* p, unsigned v) { return __hip_atomic_fetch_add(p, v, __ATOMIC_RELAXED, __HIP_MEMORY_SCOPE_AGENT); }
__device__ __forceinline__ unsigned xb_xcc_id() { return (unsigned)__builtin_amdgcn_s_getreg((3 << 11) | 20) & 0xFu; }
#define XB_SPIN(cond, bar) do { unsigned _sp = 0; while (cond) { __builtin_amdgcn_s_sleep(1); \
    if ((++_sp & 255u) == 0u) { if (xb_ld(&(bar)[XB_TMO])) break; if (_sp > XB_SPIN_CAP) { atomicAdd(&(bar)[XB_TMO], 1u); break; } } } } while (0)

struct XcdBarrier {
    unsigned* bar; unsigned x;
    volatile LAS unsigned* st;
};

__device__ __forceinline__ XcdBarrier xcd_barrier_post(unsigned* bar, volatile LAS unsigned* st) {
    XcdBarrier b; b.bar = bar; b.x = xb_xcc_id(); b.st = st;
    if (threadIdx.x == 0) (void)xb_add(&bar[XB_XCNT(b.x)], 1u);
    return b;
}
__device__ __forceinline__ void xcd_barrier_complete(unsigned* bar, unsigned x, unsigned& nloc, unsigned& nx) {
    const unsigned G = gridDim.x * gridDim.y * gridDim.z;
    unsigned sum, cnt, mine, sp = 0u;
    for (;;) {
        sum = 0u; cnt = 0u; mine = 0u;
#pragma unroll
        for (unsigned j = 0; j < 16; ++j) { const unsigned c = xb_ld(&bar[XB_XCNT(j)]); sum += c; cnt += (c > 0u) ? 1u : 0u; mine = (j == x) ? c : mine; }
        if (sum == G) break;
        __builtin_amdgcn_s_sleep(1);
        if ((++sp & 255u) == 0u) { if (xb_ld(&bar[XB_TMO])) break; if (sp > XB_SPIN_CAP) { atomicAdd(&bar[XB_TMO], 1u); break; } }
    }
    nloc = mine > 0u ? mine : 1u; nx = cnt > 0u ? cnt : 1u;
}

__device__ __forceinline__ void xcd_barrier(const XcdBarrier& b) {
    asm volatile("s_waitcnt vmcnt(0)" ::: "memory");
    __syncthreads();
    if (threadIdx.x == 0) {
        unsigned* bar = b.bar;
        __builtin_amdgcn_s_waitcnt(0);
        unsigned nloc = b.st[0], nx = b.st[1];
        if (nloc == 0u) { xcd_barrier_complete(bar, b.x, nloc, nx); b.st[0] = nloc; b.st[1] = nx; }
        const unsigned old = xb_add(&bar[XB_XSUB(b.x)], 1u);
        const unsigned gen = old / nloc;
        if (old + 1u == (gen + 1u) * nloc) {
            __builtin_amdgcn_fence(__ATOMIC_RELEASE, "agent");
            asm volatile("s_waitcnt vmcnt(0)" ::: "memory");
            const unsigned og = xb_add(&bar[XB_TOP], 1u);
            const unsigned tg = og / nx;
            if (og + 1u == (tg + 1u) * nx) xb_add(&bar[XB_TOPGEN], 1u);
            else XB_SPIN(xb_ld(&bar[XB_TOPGEN]) == tg, bar);
            __builtin_amdgcn_fence(__ATOMIC_ACQUIRE, "agent");
            xb_add(&bar[XB_XGEN(b.x)], 1u);
            asm volatile("s_waitcnt vmcnt(0)" ::: "memory");
        } else {
            XB_SPIN(xb_ld(&bar[XB_XGEN(b.x)]) == gen, bar);
            __builtin_amdgcn_fence(__ATOMIC_ACQUIRE, "agent");
            asm volatile("s_waitcnt vmcnt(0)" ::: "memory");
        }
    }
    __syncthreads();
}

constexpr int NWAVES = 8;
#ifndef MK_N_LAUNCHES
#define MK_N_LAUNCHES 1
#endif
constexpr int PER_PHASE = 11;
constexpr int N_LAUNCHES = MK_N_LAUNCHES;

constexpr int BATCH = 16, SEQ = 2048, D = 1024, HD = 64, NH = 8, FF = 2816;
constexpr int M = BATCH * SEQ;
constexpr int SBW = 512, RWW = 512, RWP = 1792, PW = 3328, LORA_K = 256, LORA_N = 1536;
constexpr float LNX_EPS = 64e-5f;

constexpr size_t MiB = 1u << 20;
constexpr size_t WS_CTL = 0, CTL_ZERO_BYTES = 1 * MiB;
constexpr size_t WS_SSQ = 1 * MiB;
constexpr size_t WS_W1U = 4 * MiB;
constexpr size_t WS_W1D = 15 * MiB;
constexpr size_t WS_W2U = 21 * MiB;
constexpr size_t WS_W2D = 32 * MiB;
constexpr size_t WS_WIN = 38 * MiB;
constexpr size_t WS_WOUT = 45 * MiB;
constexpr size_t WS_WLORA = 47 * MiB;
constexpr size_t WS_XB = 48 * MiB;
constexpr size_t WS_ACT = 112 * MiB;
constexpr size_t WS_QO = 112 * MiB;
constexpr size_t WS_KB = 176 * MiB;
constexpr size_t WS_VB = 208 * MiB;
constexpr size_t WS_RW = 240 * MiB;
constexpr size_t WS_ALORA = 352 * MiB;
constexpr size_t WS_LW = 368 * MiB;
constexpr size_t WS_AB = 432 * MiB;
constexpr size_t WS_GB = 464 * MiB;
constexpr size_t WS_TAIL = 496 * MiB;
constexpr size_t WS_END = 512 * MiB;
constexpr int CW_TMO = 0, CW_CODE = 1;
constexpr int CW_BAR = 4096;
constexpr int CW_QUEUE = 16384;

constexpr int RING_OFF = 0, RING_BYTES = 155648;
constexpr int LDSCTL_OFF = RING_BYTES, MISC_OFF = LDSCTL_OFF;
constexpr int LDS_BYTES = 163840;

struct Frame {
    LAS unsigned char* lds;
    volatile LAS unsigned* MISC;
    gu32* ctl;
    int tid, lane, wave;
    int vcu, G;
};
typedef unsigned u32x2g __attribute__((ext_vector_type(2)));
__device__ __forceinline__ float bf2f(unsigned short h) { return __uint_as_float(((unsigned)h) << 16); }
typedef float f32x2h __attribute__((ext_vector_type(2))); typedef __bf16 bf16x2h __attribute__((ext_vector_type(2)));
__device__ __forceinline__ unsigned pkbf(float lo, float hi) { f32x2h v = {lo, hi}; bf16x2h b = __builtin_convertvector(v, bf16x2h); return __builtin_bit_cast(unsigned, b); }
__device__ __forceinline__ float bflo(unsigned w) { return __uint_as_float(w << 16); }
__device__ __forceinline__ float bfhi(unsigned w) { return __uint_as_float(w & 0xffff0000u); }
__device__ __forceinline__ float wave_sum(float v) {
#pragma unroll
    for (int o = 1; o < 64; o <<= 1) v += __shfl_xor(v, o);
    return v;
}
__device__ __forceinline__ float dpp_f(float v, const int ctrl_unused) { return v; }
#define DPP_ADD(v, ctrl) ((v) + __int_as_float(__builtin_amdgcn_update_dpp(0, __float_as_int(v), (ctrl), 0xF, 0xF, true)))
__device__ __forceinline__ float sum8(float v) { v = DPP_ADD(v, 0xB1); v = DPP_ADD(v, 0x4E); v = DPP_ADD(v, 0x141); return v; }

struct TItem { const float* W; int ldw, k0, n0; const float* sc; bf16* WT; int Kd, rho0; };
__device__ __forceinline__ void ti_load(const TItem& T, float (&t)[32], int lane) {
#pragma unroll
    for (int i = 0; i < 32; ++i) t[i] = T.W[(size_t)(T.k0 + 2 * i + (lane >> 5)) * T.ldw + T.n0 + (lane & 31)];
}
__device__ __forceinline__ void ti_finish(const TItem& T, const float (&t)[32], LAS float* scr, int lane) {
#pragma unroll
    for (int i = 0; i < 32; ++i) scr[(2 * i + (lane >> 5)) * 33 + (lane & 31)] = t[i];
    LDS_WAIT(); asm volatile("" ::: "memory");
    const int c = lane & 7;
    f32x4 s0 = (f32x4){1.f, 1.f, 1.f, 1.f}, s1 = s0;
    if (T.sc) { s0 = *(const f32x4*)(T.sc + T.k0 + 8 * c); s1 = *(const f32x4*)(T.sc + T.k0 + 8 * c + 4); }
#pragma unroll
    for (int j = 0; j < 4; ++j) { const int n = (lane >> 3) + 8 * j; const LAS float* s = scr + (8 * c) * 33 + n;
        v4u o; o.x = pkbf(s[0 * 33] * s0.x, s[1 * 33] * s0.y); o.y = pkbf(s[2 * 33] * s0.z, s[3 * 33] * s0.w); o.z = pkbf(s[4 * 33] * s1.x, s[5 * 33] * s1.y); o.w = pkbf(s[6 * 33] * s1.z, s[7 * 33] * s1.w);
        *(GAS v4u*)(T.WT + (size_t)(T.rho0 + n) * T.Kd + T.k0 + 8 * c) = o; }
    LDS_WAIT(); asm volatile("" ::: "memory");
}
#define P0_PTRS const float* Ax, const float* An1, const float* Ag1, const float* Au1, const float* Ad1, const float* Anm, const float* Awin, const float* Aw2, const float* Aa2, const float* Ag2, const float* Awout, \
    const float* An2, const float* Ag2f, const float* Au2f, const float* Ad2f, bf16* AW1U, bf16* AW1D, bf16* AW2U, bf16* AW2D, bf16* AWIN, bf16* AWOUT, bf16* AWLORA, bf16* AXB, float* ASSQ
__device__ __forceinline__ void p0_items(Frame& F, P0_PTRS, int set, int gw, int NGW) {
    LAS float* scr = (LAS float*)(F.lds + RING_OFF + F.wave * 16384);
    constexpr int I_UP = 16 * 176, I_DN = 44 * 32, I_IN = 16 * 104, I_OUT = 16 * 32;
    const int NITEMS = set ? (I_UP + I_DN) : (I_UP + I_DN + I_IN + I_OUT);
#define P0_DECODE(it_, T) do { int r = (it_); const int l2 = set; \
        if (r < I_UP) { const int kb = r / 176, nb = r % 176, rho0 = 32 * nb, pn = rho0 >> 8, bj = (rho0 >> 7) & 1, j0 = rho0 & 127; \
            T = TItem{l2 ? (bj ? Au2f : Ag2f) : (bj ? Au1 : Ag1), FF, 64 * kb, 128 * pn + j0, l2 ? An2 : An1, l2 ? AW2U : AW1U, D, rho0}; } \
        else if ((r -= I_UP) < I_DN) { const int kb = r / 32, nb = r % 32; \
            T = TItem{l2 ? Ad2f : Ad1, D, 64 * kb, 32 * nb, nullptr, l2 ? AW2D : AW1D, FF, 32 * nb}; } \
        else if ((r -= I_DN) < I_IN) { const int kb = r / 104, nb = r % 104, rho0 = 32 * nb, pn = rho0 >> 8, rem = rho0 & 255, bj = rem >> 7, wc = (rem & 127) >> 5; \
            T = TItem{Awin, PW, 64 * kb, 256 * pn + 64 * wc + 32 * bj, Anm, AWIN, D, rho0}; } \
        else { r -= I_IN; const int kb = r / 32, nb = r % 32; T = TItem{Awout, D, 64 * kb, 32 * nb, nullptr, AWOUT, D, 32 * nb}; } } while (0)
    for (int it = gw; it < NITEMS; it += 2 * NGW) {
        TItem T0, T1; float t0[32], t1[32]; const bool two = (it + NGW < NITEMS);
        P0_DECODE(it, T0); ti_load(T0, t0, F.lane);
        if (two) { P0_DECODE(it + NGW, T1); ti_load(T1, t1, F.lane); }
        ti_finish(T0, t0, scr, F.lane);
        if (two) ti_finish(T1, t1, scr, F.lane);
    }
#undef P0_DECODE
}
__device__ __forceinline__ void p0_prologue(Frame& F, P0_PTRS) {
    const int gw = F.vcu * NWAVES + F.wave, NGW = F.G * NWAVES;
    p0_items(F, Ax, An1, Ag1, Au1, Ad1, Anm, Awin, Aw2, Aa2, Ag2, Awout, An2, Ag2f, Au2f, Ad2f, AW1U, AW1D, AW2U, AW2D, AWIN, AWOUT, AWLORA, AXB, ASSQ, (F.G >= 256) ? 0 : 0, gw, NGW);
    if (F.G < 256) p0_items(F, Ax, An1, Ag1, Au1, Ad1, Anm, Awin, Aw2, Aa2, Ag2, Awout, An2, Ag2f, Au2f, Ad2f, AW1U, AW1D, AW2U, AW2D, AWIN, AWOUT, AWLORA, AXB, ASSQ, 1, gw, NGW);
    for (int it = F.vcu * (NWAVES * 64) + F.tid; it < 512 * 32; it += F.G * NWAVES * 64) {
        int ch, kc, Kk; const float* src; bf16* dst;
        if (it < 512 * 8) { ch = it >> 3; kc = (it & 7) * 8; Kk = 64; src = Aw2; dst = AWLORA; }
        else if (it < 512 * 16) { const int i2 = it - 512 * 8; ch = i2 >> 3; kc = (i2 & 7) * 8; Kk = 64; src = Aa2; dst = AWLORA + 512 * 64; }
        else { const int i2 = it - 512 * 16; ch = i2 >> 4; kc = (i2 & 15) * 8; Kk = 128; src = Ag2; dst = AWLORA + 2 * 512 * 64; }
        float v[8];
#pragma unroll
        for (int j = 0; j < 8; ++j) v[j] = src[(size_t)(kc + j) * 512 + ch];
        v4u o; o.x = pkbf(v[0], v[1]); o.y = pkbf(v[2], v[3]); o.z = pkbf(v[4], v[5]); o.w = pkbf(v[6], v[7]);
        *(GAS v4u*)(dst + (size_t)ch * Kk + kc) = o;
    }
    for (int mb = gw; mb < M; mb += 4 * NGW) {
        f32x4 v[4][4]; float s[4];
#pragma unroll
        for (int q = 0; q < 4; ++q) { const int m = mb + q * NGW; const GAS f32x4* xr = (const GAS f32x4*)(Ax + (size_t)(m < M ? m : mb) * D) + F.lane;
#pragma unroll
            for (int j = 0; j < 4; ++j) v[q][j] = xr[64 * j]; }
#pragma unroll
        for (int q = 0; q < 4; ++q) { float a = 0.f;
#pragma unroll
            for (int j = 0; j < 4; ++j) a += (v[q][j].x * v[q][j].x + v[q][j].y * v[q][j].y) + (v[q][j].z * v[q][j].z + v[q][j].w * v[q][j].w);
            s[q] = a; }
#pragma unroll
        for (int o = 1; o < 64; o <<= 1) {
#pragma unroll
            for (int q = 0; q < 4; ++q) s[q] += __shfl_xor(s[q], o); }
#pragma unroll
        for (int q = 0; q < 4; ++q) { const int m = mb + q * NGW; if (m < M) {
            GAS unsigned long long* o8 = (GAS unsigned long long*)(AXB + (size_t)m * D) + F.lane;
#pragma unroll
            for (int j = 0; j < 4; ++j) o8[64 * j] = (unsigned long long)pkbf(v[q][j].x, v[q][j].y) | ((unsigned long long)pkbf(v[q][j].z, v[q][j].w) << 32);
            if (F.lane < 16) ASSQ[(size_t)m * 16 + F.lane] = (F.lane == 0) ? s[q] : 0.f; } }
    }
}

__device__ __forceinline__ void p4_lora_prep(Frame& F, const bf16* RW, const float* mu, bf16* ALORA) {
    const int gw = F.vcu * NWAVES + F.wave, NGW = F.G * NWAVES; const int l = F.lane;
    const f32x4 muv = *(const f32x4*)(mu + 1536 + 4 * l);
    for (int m = gw; m < M; m += NGW) {
        const u32x2g c = *(const u32x2g*)(RW + (size_t)m * RWP + 1536 + 4 * l);
        u32x2g p = (u32x2g){0u, 0u};
        if ((m & (SEQ - 1)) != 0) p = *(const u32x2g*)(RW + (size_t)(m - 1) * RWP + 1536 + 4 * l);
        float x[4] = {bflo(c.x), bfhi(c.x), bflo(c.y), bfhi(c.y)}; const float q[4] = {bflo(p.x), bfhi(p.x), bflo(p.y), bfhi(p.y)};
#pragma unroll
        for (int i = 0; i < 4; ++i) { float u = x[i] + (q[i] - x[i]) * muv[i];
            if (l < 16) u = 2.0f * pg8::sigmoid_f(2.0f * u) - 1.0f; else if (l >= 32) u = pg8::sigmoid_f(u);
            x[i] = u; }
        u32x2g o; o.x = pkbf(x[0], x[1]); o.y = pkbf(x[2], x[3]);
        *(u32x2g*)(ALORA + (size_t)m * LORA_K + 4 * l) = o;
    }
}

struct RwArgs { const bf16* RW; const bf16* W2T; const bf16* A2T; const bf16* G2T; const float* w0; const float* a0; bf16* QO; const float *mu, *k_k, *k_a, *r_k, *ln_w, *ln_b; };
__device__ __forceinline__ void ld8bf(const bf16* p, float (&o)[8]) { const v4u w = *(const v4u*)p; o[0] = bflo(w.x); o[1] = bfhi(w.x); o[2] = bflo(w.y); o[3] = bfhi(w.y); o[4] = bflo(w.z); o[5] = bfhi(w.z); o[6] = bflo(w.w); o[7] = bfhi(w.w); }
__device__ __forceinline__ void ld8f(const float* p, float (&o)[8]) { const f32x4 a = *(const f32x4*)p, b = *(const f32x4*)(p + 4); o[0] = a.x; o[1] = a.y; o[2] = a.z; o[3] = a.w; o[4] = b.x; o[5] = b.y; o[6] = b.z; o[7] = b.w; }
__device__ __forceinline__ void ld8l(const LAS float* p, float (&o)[8]) { const f32x4 a = *(const LAS f32x4*)p, b = *(const LAS f32x4*)(p + 4); o[0] = a.x; o[1] = a.y; o[2] = a.z; o[3] = a.w; o[4] = b.x; o[5] = b.y; o[6] = b.z; o[7] = b.w; }
__device__ __forceinline__ void st8l(LAS float* p, const float (&o)[8]) { *(LAS f32x4*)p = (f32x4){o[0], o[1], o[2], o[3]}; *(LAS f32x4*)(p + 4) = (f32x4){o[4], o[5], o[6], o[7]}; }
namespace rwk {
typedef short bf16x8 __attribute__((ext_vector_type(8)));
typedef short s16x4 __attribute__((ext_vector_type(4)));
typedef short v4i16_t __attribute__((ext_vector_type(4)));
constexpr int SLOT = 8192;
#define RSL(s) (lds + (s) * SLOT)
#define RMFMA(a, b, c) __builtin_amdgcn_mfma_f32_16x16x32_bf16((a), (b), (c), 0, 0, 0)
__device__ __forceinline__ int swz(int row, int cb) { return row * 128 + (cb ^ ((row & 7) << 4)); }
struct Fr2 { bf16x8 k0, k1; };
__device__ __forceinline__ Fr2 ldf(const LAS unsigned char* base, int off) { Fr2 f; f.k0 = *(const LAS bf16x8*)(base + off); f.k1 = *(const LAS bf16x8*)(base + (off ^ 64)); return f; }
__device__ __forceinline__ s16x4 trd(const LAS unsigned char* p) { return __builtin_bit_cast(s16x4, __builtin_amdgcn_ds_read_tr16_b64_v4i16((LAS v4i16_t*)p)); }
__device__ __forceinline__ Fr2 ldt(const LAS unsigned char* base, int o0, int o1) {
    const s16x4 a = trd(base + o0), b = trd(base + o1), c = trd(base + o0 + 4096), d = trd(base + o1 + 4096);
    Fr2 f; f.k0 = (bf16x8){a[0], a[1], a[2], a[3], b[0], b[1], b[2], b[3]}; f.k1 = (bf16x8){c[0], c[1], c[2], c[3], d[0], d[1], d[2], d[3]}; return f; }
template <bool SWAP> __device__ __forceinline__ f32x4 mm(const Fr2& a, const Fr2& b, f32x4 c) {
    if (SWAP) { c = RMFMA(b.k0, a.k0, c); c = RMFMA(b.k1, a.k1, c); } else { c = RMFMA(a.k0, b.k0, c); c = RMFMA(a.k1, b.k1, c); } return c; }
__device__ __forceinline__ void st4(LAS unsigned char* slot, int off, f32x4 v) { u32x2g w; w.x = pkbf(v[0], v[1]); w.y = pkbf(v[2], v[3]); *(LAS u32x2g*)(slot + off) = w; }
__device__ __forceinline__ f32x4 ld4(const LAS unsigned char* slot, int off) { const u32x2g w = *(const LAS u32x2g*)(slot + off); return (f32x4){bflo(w.x), bfhi(w.x), bflo(w.y), bfhi(w.y)}; }
#define LBAR() asm volatile("s_waitcnt lgkmcnt(0)\n\ts_barrier" ::: "memory")
#define DPPF(x, ctrl, rmask) __int_as_float(__builtin_amdgcn_update_dpp(0, __float_as_int(x), (ctrl), (rmask), 0xF, true))
__device__ __forceinline__ float wave_scan(float x) {
    x += DPPF(x, 0x111, 0xF); x += DPPF(x, 0x112, 0xF); x += DPPF(x, 0x114, 0xF); x += DPPF(x, 0x118, 0xF);
    x += DPPF(x, 0x142, 0xA);
    x += DPPF(x, 0x143, 0xC);
    return x; }
__device__ __forceinline__ void unp8(const v4u w, float (&o)[8]) { o[0] = bflo(w.x); o[1] = bfhi(w.x); o[2] = bflo(w.y); o[3] = bfhi(w.y); o[4] = bflo(w.z); o[5] = bfhi(w.z); o[6] = bflo(w.w); o[7] = bfhi(w.w); }
__device__ __forceinline__ v4u pk8(const float (&o)[8]) { return (v4u){pkbf(o[0], o[1]), pkbf(o[2], o[3]), pkbf(o[4], o[5]), pkbf(o[6], o[7])}; }
}
struct RwX { bf16* P1; bf16* GT; bf16* Y0; bf16* H; bf16* VB0; bf16* VB1; float* GE; bf16* G; };
__device__ __forceinline__ void p6a_rwkv_local(Frame& F, const RwArgs& A, const RwX& X) {
    using namespace rwk;
    LAS unsigned char* lds = F.lds + RING_OFF;
    LAS float* part = (LAS float*)(F.lds + LDSCTL_OFF + 128);
    LAS float* cst = (LAS float*)(F.lds + LDSCTL_OFF + 128 + 4096 + 896);
    const int lane = F.lane, fr = lane & 15, fq = lane >> 4, w = F.wave, m0 = 16 * (w >> 1), n0a = 32 * (w & 1);
    const int fm = swz(m0 + fr, fq * 16);
    const int ta0 = swz(8 * fq + (fr >> 2), 2 * (m0 + 4 * (fr & 3))), ta1 = swz(8 * fq + 4 + (fr >> 2), 2 * (m0 + 4 * (fr & 3)));
    int fn[2], orm[2], otr[2], tb0[2], tb1[2];
#pragma unroll
    for (int t = 0; t < 2; ++t) { const int n0 = n0a + 16 * t; fn[t] = swz(n0 + fr, fq * 16); orm[t] = swz(m0 + fr, 2 * (n0 + 4 * fq)); otr[t] = swz(n0 + fr, 2 * (m0 + 4 * fq));
        tb0[t] = swz(8 * fq + (fr >> 2), 2 * (n0 + 4 * (fr & 3))); tb1[t] = swz(8 * fq + 4 + (fr >> 2), 2 * (n0 + 4 * (fr & 3))); }
    const int NJ = BATCH * NH * (SEQ / 64);
    const int tid = F.tid, ltok = tid >> 3, ldg = tid & 7;
    v4u g_r, g_k, g_v, g_xw, g_xa, g_xg0, g_xg1, g_pr;
#define P6A_LOAD(jj) do { const int u_ = (jj) >> 5, c_ = (jj) & 31; const size_t gr_ = (size_t)(u_ >> 3) * SEQ + c_ * 64 + ltok; const int cb_ = 64 * (u_ & 7) + 8 * ldg; const bf16* rp_ = A.RW + gr_ * RWP; \
        g_r = *(const v4u*)(rp_ + cb_); g_k = *(const v4u*)(rp_ + 512 + cb_); g_v = *(const v4u*)(rp_ + 1024 + cb_); \
        g_xw = *(const v4u*)(rp_ + 1536 + 8 * ldg); g_xa = *(const v4u*)(rp_ + 1600 + 8 * ldg); g_xg0 = *(const v4u*)(rp_ + 1664 + 8 * ldg); g_xg1 = *(const v4u*)(rp_ + 1728 + 8 * ldg); \
        g_pr = (v4u){0u, 0u, 0u, 0u}; if (ltok < 7 && c_ > 0) g_pr = *(const v4u*)(A.RW + ((size_t)(u_ >> 3) * SEQ + c_ * 64 - 1) * RWP + (ltok < 3 ? 512 * ltok + cb_ : 1536 + 64 * (ltok - 3) + 8 * ldg)); } while (0)
    if ((int)blockIdx.x < NJ) P6A_LOAD((int)blockIdx.x);
    int hcur = -1;
    LAS unsigned char* prow = (LAS unsigned char*)(F.lds + LDSCTL_OFF + 128 + 4096);
    if (tid < 256) cst[512 + tid] = A.mu[1536 + tid];
    u32x2g s_p1[2], s_gt[2], s_y0[2], s_hh[2]; size_t s_jo = 0; bool s_have = false;
#define P6A_STORE() do { _Pragma("unroll") for (int t = 0; t < 2; ++t) { \
            *(u32x2g*)(X.P1 + s_jo + ((w * 2 + t) * 64 + lane) * 4) = s_p1[t]; *(u32x2g*)(X.GT + s_jo + ((w * 2 + t) * 64 + lane) * 4) = s_gt[t]; \
            *(u32x2g*)(X.Y0 + s_jo + ((w * 2 + t) * 64 + lane) * 4) = s_y0[t]; *(u32x2g*)(X.H + s_jo + ((w * 2 + t) * 64 + lane) * 4) = s_hh[t]; } } while (0)
    for (int job = blockIdx.x; job < NJ; job += F.G) {
        const int unit = job >> 5, c = job & 31; const int h = unit & 7; const int cb = 64 * h + 8 * w; const size_t jo = (size_t)job * 4096;
        {
            const int so = swz(ltok, 16 * ldg);
            *(LAS v4u*)(RSL(12) + so) = g_r; *(LAS v4u*)(RSL(2) + so) = g_k; *(LAS v4u*)(RSL(0) + so) = g_v;
            *(LAS v4u*)(RSL(14) + so) = g_xw; *(LAS v4u*)(RSL(13) + so) = g_xa; *(LAS v4u*)(RSL(10) + so) = g_xg0; *(LAS v4u*)(RSL(11) + so) = g_xg1;
            if (ltok < 7) *(LAS v4u*)(prow + ltok * 128 + 16 * ldg) = g_pr;
            if (h != hcur) {
                *(LAS v4u*)(RSL(16) + so) = *(const v4u*)(A.W2T + (size_t)(64 * h + ltok) * 64 + 8 * ldg); *(LAS v4u*)(RSL(17) + so) = *(const v4u*)(A.A2T + (size_t)(64 * h + ltok) * 64 + 8 * ldg);
                { const int a_ = tid >> 6, i_ = tid & 63;
                  const float* src_ = (a_ == 0) ? A.mu : (a_ == 1) ? A.mu + 512 : (a_ == 2) ? A.mu + 1024 : (a_ == 3) ? A.k_k : (a_ == 4) ? A.k_a : (a_ == 5) ? A.r_k : (a_ == 6) ? A.w0 : A.a0;
                  cst[a_ * 64 + i_] = src_[64 * h + i_]; } }
            hcur = h;
        }
        if (s_have) P6A_STORE();
        { const int nj = job + F.G; if (nj < NJ) P6A_LOAD(nj); }
        LBAR();
        float r[8], k[8], v[8];
        {
            const int so = swz(lane, 16 * w), sp = swz((lane + 63) & 63, 16 * w);
#define P6A_SHIFT(slot, pi, moff, dst) do { float c_[8], p_[8], m_[8]; v4u wc_ = *(const LAS v4u*)(RSL(slot) + so), wp_ = *(const LAS v4u*)(RSL(slot) + sp); \
                if (lane == 0) wp_ = *(const LAS v4u*)(prow + 128 * (pi) + 16 * w); \
                unp8(wc_, c_); unp8(wp_, p_); ld8l(cst + (moff) + 8 * w, m_); \
                _Pragma("unroll") for (int j = 0; j < 8; ++j) dst[j] = c_[j] + (p_[j] - c_[j]) * m_[j]; } while (0)
            P6A_SHIFT(12, 0, 0, r);
            P6A_SHIFT(2, 1, 64, k);
            P6A_SHIFT(0, 2, 128, v); asm volatile("" ::: "memory");
            { float x_[8]; P6A_SHIFT(14, 3, 512, x_);
#pragma unroll
              for (int j = 0; j < 8; ++j) x_[j] = 2.0f * pg8::sigmoid_f(2.0f * x_[j]) - 1.0f;
              *(LAS v4u*)(RSL(14) + so) = pk8(x_); }
            { float x_[8]; P6A_SHIFT(13, 4, 576, x_); *(LAS v4u*)(RSL(13) + so) = pk8(x_); } asm volatile("" ::: "memory");
            { float x_[8]; P6A_SHIFT(10, 5, 640, x_);
#pragma unroll
              for (int j = 0; j < 8; ++j) x_[j] = pg8::sigmoid_f(x_[j]);
              *(LAS v4u*)(RSL(10) + so) = pk8(x_); }
            { float x_[8]; P6A_SHIFT(11, 6, 704, x_);
#pragma unroll
              for (int j = 0; j < 8; ++j) x_[j] = pg8::sigmoid_f(x_[j]);
              *(LAS v4u*)(RSL(11) + so) = pk8(x_); }
#undef P6A_SHIFT
        }
        LBAR();
        {
            const f32x4 z4 = (f32x4){0.f, 0.f, 0.f, 0.f};
            bf16x8 gq[2][4];
#pragma unroll
            for (int t = 0; t < 2; ++t) { const bf16* gp = A.G2T + (size_t)(64 * h + n0a + 16 * t + fr) * 128 + 8 * fq;
#pragma unroll
                for (int q = 0; q < 4; ++q) gq[t][q] = *reinterpret_cast<const bf16x8*>(gp + 32 * q); }
            {   const Fr2 aW = ldf(RSL(14), fm), aA = ldf(RSL(13), fm); Fr2 bW[2], bA[2];
#pragma unroll
                for (int t = 0; t < 2; ++t) { bW[t] = ldf(RSL(16), fn[t]); bA[t] = ldf(RSL(17), fn[t]); }
#pragma unroll
                for (int t = 0; t < 2; ++t) { const int row = m0 + fr, ch = n0a + 16 * t + 4 * fq; const f32x4 lwq = mm<true>(aW, bW[t], z4), alq = mm<true>(aA, bA[t], z4);
                    const f32x4 w0c = *(const LAS f32x4*)(cst + 384 + ch), a0c = *(const LAS f32x4*)(cst + 448 + ch); f32x4 lwv, alv;
#pragma unroll
                    for (int x = 0; x < 4; ++x) { lwv[x] = -0.6065306597126334f * pg8::sigmoid_f(w0c[x] + lwq[x]); alv[x] = pg8::sigmoid_f(a0c[x] + alq[x]); }
                    const int fo = row * 256 + (((ch >> 3) ^ (row & 7)) << 5) + ((ch >> 2) & 1) * 16;
                    *(LAS f32x4*)(RSL(4) + fo) = lwv; *(LAS f32x4*)(RSL(8) + fo) = alv; } }
            asm volatile("" ::: "memory");
            {   const Fr2 aG0 = ldf(RSL(10), fm), aG1 = ldf(RSL(11), fm);
#pragma unroll
                for (int t = 0; t < 2; ++t) { Fr2 bG0, bG1; bG0.k0 = gq[t][0]; bG0.k1 = gq[t][1]; bG1.k0 = gq[t][2]; bG1.k1 = gq[t][3];
                    st4(RSL(3), orm[t], mm<true>(aG1, bG1, mm<true>(aG0, bG0, z4))); } }
        }
        LBAR();
        float kf[8], kk[8], al[8], lw[8]; float ssp = 0.f, bpp = 0.f;
        {
            { const int fo = lane * 256 + ((w ^ (lane & 7)) << 5); const f32x4 a_ = *(const LAS f32x4*)(RSL(4) + fo), b_ = *(const LAS f32x4*)(RSL(4) + fo + 16), c_ = *(const LAS f32x4*)(RSL(8) + fo), d_ = *(const LAS f32x4*)(RSL(8) + fo + 16);
              lw[0] = a_.x; lw[1] = a_.y; lw[2] = a_.z; lw[3] = a_.w; lw[4] = b_.x; lw[5] = b_.y; lw[6] = b_.z; lw[7] = b_.w;
              al[0] = c_.x; al[1] = c_.y; al[2] = c_.z; al[3] = c_.w; al[4] = d_.x; al[5] = d_.y; al[6] = d_.z; al[7] = d_.w; }
            *(v4u*)(X.G + jo + tid * 8) = *(const LAS v4u*)(RSL(3) + swz(ltok, 16 * ldg));
            float kkc[8], kac[8], rkc[8]; ld8l(cst + 192 + 8 * w, kkc); ld8l(cst + 256 + 8 * w, kac); ld8l(cst + 320 + 8 * w, rkc);
#pragma unroll
            for (int j = 0; j < 8; ++j) { kk[j] = k[j] * kkc[j]; ssp += kk[j] * kk[j]; kf[j] = k[j] * (1.0f + (al[j] - 1.0f) * kac[j]); bpp += r[j] * kf[j] * rkc[j]; }
            part[w * 64 + lane] = ssp; part[512 + w * 64 + lane] = bpp;
        }
        LBAR();
        {
            float ss = 0.f, bon = 0.f;
#pragma unroll
            for (int i = 0; i < 8; ++i) { ss += part[i * 64 + lane]; bon += part[512 + i * 64 + lane]; }
            const float inv = 1.0f / fmaxf(sqrtf(ss), 1e-12f);
            float at[8], rt[8], bt[8], kt[8], bh[8], kh[8], ge[8], vb[8];
#pragma unroll
            for (int j = 0; j < 8; ++j) {
                const float cs = wave_scan(lw[j]);
                const float ce = __int_as_float(__builtin_amdgcn_readlane(__float_as_int(cs), 63));
                const float e_cs = __builtin_amdgcn_exp2f(cs * 1.4426950408889634f), e_csm = __builtin_amdgcn_exp2f((cs - lw[j]) * 1.4426950408889634f);
                const float e_neg = __builtin_amdgcn_rcpf(e_cs), e_end = __builtin_amdgcn_exp2f((ce - cs) * 1.4426950408889634f);
                const float kn = kk[j] * inv, bb = kn * al[j];
                at[j] = -kn * e_csm; rt[j] = r[j] * e_cs; bt[j] = bb * e_neg; kt[j] = kf[j] * e_neg; bh[j] = bb * e_end; kh[j] = kf[j] * e_end; ge[j] = e_cs; vb[j] = bon * v[j];
            }
            const int ro = swz(lane, 16 * w);
            *(LAS v4u*)(RSL(0) + ro) = pk8(at); *(LAS v4u*)(RSL(1) + ro) = pk8(rt); *(LAS v4u*)(RSL(2) + ro) = pk8(bt); *(LAS v4u*)(RSL(3) + ro) = pk8(kt);
            *(LAS v4u*)(RSL(4) + ro) = pk8(bh); *(LAS v4u*)(RSL(5) + ro) = pk8(kh); *(LAS v4u*)(RSL(6) + ro) = pk8(v);
            if (lane == 63) { *(f32x4*)(X.GE + (size_t)job * 64 + 8 * w) = (f32x4){ge[0], ge[1], ge[2], ge[3]}; *(f32x4*)(X.GE + (size_t)job * 64 + 8 * w + 4) = (f32x4){ge[4], ge[5], ge[6], ge[7]}; }
            *(LAS v4u*)(RSL(18) + ro) = pk8(vb);
        }
        LBAR();
        {
            { bf16* vbp = (job < 2048) ? (X.VB0 + jo) : (X.VB1 + (jo - (size_t)2048 * 4096)); *(v4u*)(vbp + tid * 8) = *(const LAS v4u*)(RSL(18) + swz(ltok, 16 * ldg)); }
            const f32x4 z4 = (f32x4){0.f, 0.f, 0.f, 0.f};
            const Fr2 aA = ldf(RSL(0), fm), aR = ldf(RSL(1), fm); Fr2 bB[2], bK[2];
#pragma unroll
            for (int t = 0; t < 2; ++t) { bB[t] = ldf(RSL(2), fn[t]); bK[t] = ldf(RSL(3), fn[t]); }
            f32x4 nab[2], nabT[2], nak[2], mrb[2], mrk[2];
#pragma unroll
            for (int t = 0; t < 2; ++t) { nab[t] = mm<true>(aA, bB[t], z4); nabT[t] = mm<false>(aA, bB[t], z4); nak[t] = mm<true>(aA, bK[t], z4); mrb[t] = mm<true>(aR, bB[t], z4); mrk[t] = mm<true>(aR, bK[t], z4); }
#pragma unroll
            for (int t = 0; t < 2; ++t) { const int n0 = n0a + 16 * t; f32x4 x1;
#pragma unroll
                for (int x = 0; x < 4; ++x) { const int i = m0 + fr, j = n0 + 4 * fq + x;
                    if (j >= i) { nab[t][x] = 0.f; nak[t][x] = 0.f; } if (j > i) { mrb[t][x] = 0.f; mrk[t][x] = 0.f; }
                    x1[x] = nab[t][x] + ((i == j) ? 1.0f : 0.f);
                    const int it = m0 + 4 * fq + x, jt = n0 + fr; if (jt >= it) nabT[t][x] = 0.f; }
                st4(RSL(10), orm[t], x1); st4(RSL(12), orm[t], nab[t]); st4(RSL(14), otr[t], nabT[t]);
                st4(RSL(7), orm[t], nak[t]); st4(RSL(8), orm[t], mrb[t]); st4(RSL(9), orm[t], mrk[t]); }
        }
        LBAR();
        {
            const f32x4 z4 = (f32x4){0.f, 0.f, 0.f, 0.f};
            const Fr2 aP = ldf(RSL(12), fm), aN = ldf(RSL(7), fm); Fr2 bT[2], bV[2];
#pragma unroll
            for (int t = 0; t < 2; ++t) { bT[t] = ldf(RSL(14), fn[t]); bV[t] = ldt(RSL(6), tb0[t], tb1[t]); }
            f32x4 q0[2], q1[2], q2[2];
#pragma unroll
            for (int t = 0; t < 2; ++t) { q0[t] = mm<true>(aP, bT[t], z4); q1[t] = mm<false>(aP, bT[t], z4); q2[t] = mm<false>(aN, bV[t], z4); }
#pragma unroll
            for (int t = 0; t < 2; ++t) { st4(RSL(13), orm[t], q0[t]); st4(RSL(15), otr[t], q1[t]); st4(RSL(2), otr[t], q2[t]); }
        }
        LBAR();
#pragma unroll
        for (int kd = 0; kd < 5; ++kd) {
            const int xi = (kd & 1) ? 11 : 10, xo = (kd & 1) ? 10 : 11, pi = (kd & 1) ? 12 : 13, po = (kd & 1) ? 13 : 12, ti = (kd & 1) ? 14 : 15, to = (kd & 1) ? 15 : 14;
            const f32x4 z4 = (f32x4){0.f, 0.f, 0.f, 0.f};
            const Fr2 aX = ldf(RSL(xi), fm), aP = ldf(RSL(pi), fm); Fr2 bT[2]; f32x4 cx[2];
#pragma unroll
            for (int t = 0; t < 2; ++t) { bT[t] = ldf(RSL(ti), fn[t]); cx[t] = ld4(RSL(xi), orm[t]); }
            f32x4 q0[2], q1[2], q2[2];
#pragma unroll
            for (int t = 0; t < 2; ++t) { q0[t] = mm<true>(aX, bT[t], cx[t]); if (kd < 4) { q1[t] = mm<true>(aP, bT[t], z4); q2[t] = mm<false>(aP, bT[t], z4); } }
#pragma unroll
            for (int t = 0; t < 2; ++t) { st4(RSL(xo), orm[t], q0[t]); if (kd < 4) { st4(RSL(po), orm[t], q1[t]); st4(RSL(to), otr[t], q2[t]); } }
            LBAR();
        }
        {
            const f32x4 z4 = (f32x4){0.f, 0.f, 0.f, 0.f};
            const Fr2 aT = ldf(RSL(11), fm); Fr2 bA[2], bZ[2];
#pragma unroll
            for (int t = 0; t < 2; ++t) { bA[t] = ldt(RSL(0), tb0[t], tb1[t]); bZ[t] = ldf(RSL(2), fn[t]); }
            f32x4 q0[2], q1[2];
#pragma unroll
            for (int t = 0; t < 2; ++t) { q0[t] = mm<false>(aT, bA[t], z4); q1[t] = mm<false>(aT, bZ[t], z4); }
#pragma unroll
            for (int t = 0; t < 2; ++t) { st4(RSL(3), otr[t], q0[t]); st4(RSL(7), otr[t], q1[t]); }
        }
        LBAR();
        {
            const f32x4 z4 = (f32x4){0.f, 0.f, 0.f, 0.f};
            f32x4 p1[2], y0[2], gt[2], hh[2];
            {   const Fr2 aMb = ldf(RSL(8), fm), aMk = ldf(RSL(9), fm); Fr2 bW[2], bU[2], bV[2]; f32x4 cR[2];
#pragma unroll
                for (int t = 0; t < 2; ++t) { bW[t] = ldf(RSL(3), fn[t]); bU[t] = ldf(RSL(7), fn[t]); bV[t] = ldt(RSL(6), tb0[t], tb1[t]); cR[t] = ld4(RSL(1), orm[t]); }
#pragma unroll
                for (int t = 0; t < 2; ++t) { p1[t] = mm<true>(aMb, bW[t], cR[t]); y0[t] = mm<true>(aMk, bV[t], mm<true>(aMb, bU[t], z4)); } }
            {   const Fr2 aW = ldf(RSL(3), fm), aU = ldf(RSL(7), fm), aV = ldt(RSL(6), ta0, ta1); Fr2 bBh[2], bKh[2];
#pragma unroll
                for (int t = 0; t < 2; ++t) { bBh[t] = ldt(RSL(4), tb0[t], tb1[t]); bKh[t] = ldt(RSL(5), tb0[t], tb1[t]); }
#pragma unroll
                for (int t = 0; t < 2; ++t) { gt[t] = mm<false>(aW, bBh[t], z4); hh[t] = mm<true>(aV, bKh[t], mm<true>(aU, bBh[t], z4)); } }
#pragma unroll
            for (int t = 0; t < 2; ++t) {
                s_p1[t].x = pkbf(p1[t][0], p1[t][1]); s_p1[t].y = pkbf(p1[t][2], p1[t][3]); s_gt[t].x = pkbf(gt[t][0], gt[t][1]); s_gt[t].y = pkbf(gt[t][2], gt[t][3]);
                s_y0[t].x = pkbf(y0[t][0], y0[t][1]); s_y0[t].y = pkbf(y0[t][2], y0[t][3]); s_hh[t].x = pkbf(hh[t][0], hh[t][1]); s_hh[t].y = pkbf(hh[t][2], hh[t][3]); }
            s_jo = jo; s_have = true;
        }
    }
    if (s_have) P6A_STORE();
#undef P6A_LOAD
#undef P6A_STORE
    LBAR();
}
__device__ __forceinline__ void p6b_rwkv_seq(Frame& F, const RwArgs& A, const RwX& X, int nwg) {
    using namespace rwk;
    LAS unsigned char* lds = F.lds + RING_OFF;
    constexpr int YLD = 68;
    LAS float* Yf0 = (LAS float*)RSL(6);
    const int tid = F.tid, tok = tid >> 3, dg = tid & 7, lane = F.lane, fr = lane & 15, fq = lane >> 4;
    const int w = F.wave, m0 = 16 * (w >> 1), n0a = 32 * (w & 1);
    const int fm = swz(m0 + fr, fq * 16);
    int fn[2], orm[2], otr[2];
#pragma unroll
    for (int t = 0; t < 2; ++t) { const int n0 = n0a + 16 * t; fn[t] = swz(n0 + fr, fq * 16); orm[t] = swz(m0 + fr, 2 * (n0 + 4 * fq)); otr[t] = swz(n0 + fr, 2 * (m0 + 4 * fq)); }
    for (int unit = blockIdx.x; unit < BATCH * NH; unit += nwg) {
        const int b = unit >> 3, h = unit & 7; const int cb = 64 * h + 8 * dg;
        f32x4 sacc[2]; sacc[0] = (f32x4){0.f, 0.f, 0.f, 0.f}; sacc[1] = sacc[0];
        for (int u = tid; u < SLOT / 4; u += NWAVES * 64) ((LAS unsigned*)RSL(4))[u] = 0u;
        float lnw[8], lnb[8]; ld8f(A.ln_w + cb, lnw); ld8f(A.ln_b + cb, lnb);
        struct Nx { v4u vb, g; u32x2g p1[2], gt[2], y0[2], h[2]; f32x4 ge[2]; };
        Nx nA, nB;
#define P6B_LOAD(cc, N) do { const int job_ = unit * 32 + (cc); const size_t jo_ = (size_t)job_ * 4096; const size_t grow_ = (size_t)b * SEQ + (cc) * 64 + tok; \
            _Pragma("unroll") for (int t = 0; t < 2; ++t) { N.y0[t] = *(const u32x2g*)(X.Y0 + jo_ + ((w * 2 + t) * 64 + lane) * 4); N.h[t] = *(const u32x2g*)(X.H + jo_ + ((w * 2 + t) * 64 + lane) * 4); \
                N.p1[t] = *(const u32x2g*)(X.P1 + jo_ + ((w * 2 + t) * 64 + lane) * 4); N.gt[t] = *(const u32x2g*)(X.GT + jo_ + ((w * 2 + t) * 64 + lane) * 4); \
                N.ge[t] = *(const f32x4*)(X.GE + (size_t)job_ * 64 + n0a + 16 * t + 4 * fq); } \
            const bf16* vbp_ = (job_ < 2048) ? (X.VB0 + jo_) : (X.VB1 + (jo_ - (size_t)2048 * 4096)); \
            N.vb = *(const v4u*)(vbp_ + tok * 64 + 8 * dg); N.g = *(const v4u*)(X.G + jo_ + tok * 64 + 8 * dg); } while (0)
#define P6B_OUT(par, vbw_, gw_, grow_) do { float y[8]; ld8l(Yf0 + (par) * (64 * YLD) + tok * YLD + 8 * dg, y); \
            const float g[8] = {bflo(gw_.x), bfhi(gw_.x), bflo(gw_.y), bfhi(gw_.y), bflo(gw_.z), bfhi(gw_.z), bflo(gw_.w), bfhi(gw_.w)}; \
            const float vb[8] = {bflo(vbw_.x), bfhi(vbw_.x), bflo(vbw_.y), bfhi(vbw_.y), bflo(vbw_.z), bfhi(vbw_.z), bflo(vbw_.w), bfhi(vbw_.w)}; \
            float s_ = 0.f; _Pragma("unroll") for (int j = 0; j < 8; ++j) s_ += y[j]; \
            const float mean = sum8(s_) * (1.0f / 64.0f); float q_ = 0.f; \
            _Pragma("unroll") for (int j = 0; j < 8; ++j) { y[j] -= mean; q_ += y[j] * y[j]; } \
            const float rstd = __builtin_amdgcn_rsqf(sum8(q_) * (1.0f / 64.0f) + LNX_EPS); float ov[8]; \
            _Pragma("unroll") for (int j = 0; j < 8; ++j) ov[j] = (y[j] * rstd * lnw[j] + lnb[j] + vb[j]) * g[j]; \
            v4u wv_; wv_.x = pkbf(ov[0], ov[1]); wv_.y = pkbf(ov[2], ov[3]); wv_.z = pkbf(ov[4], ov[5]); wv_.w = pkbf(ov[6], ov[7]); \
            *(GAS v4u*)(A.QO + (grow_) * D + 512 + cb) = wv_; } while (0)
        v4u p_vb = (v4u){0u, 0u, 0u, 0u}, p_g = p_vb; size_t p_row = 0;
#define P6B_STEP(c, N) do { const int par = (c) & 1, scur = 4 + par, snxt = 5 - par; const size_t grow = (size_t)b * SEQ + (c) * 64 + tok; \
            _Pragma("unroll") for (int t = 0; t < 2; ++t) { *(LAS u32x2g*)(RSL(par) + orm[t]) = N.p1[t]; *(LAS u32x2g*)(RSL(2 + par) + otr[t]) = N.gt[t]; } \
            f32x4 yacc[2], hcur[2], gecur[2]; \
            _Pragma("unroll") for (int t = 0; t < 2; ++t) { yacc[t] = (f32x4){bflo(N.y0[t].x), bfhi(N.y0[t].x), bflo(N.y0[t].y), bfhi(N.y0[t].y)}; hcur[t] = (f32x4){bflo(N.h[t].x), bfhi(N.h[t].x), bflo(N.h[t].y), bfhi(N.h[t].y)}; gecur[t] = N.ge[t]; } \
            const v4u vbw = N.vb, gw = N.g; \
            if ((c) + 2 < SEQ / 64) P6B_LOAD((c) + 2, N); \
            LBAR(); \
            {   const Fr2 aP1 = ldf(RSL(par), fm), aS = ldf(RSL(scur), fm); Fr2 bS[2], bG[2]; \
                _Pragma("unroll") for (int t = 0; t < 2; ++t) { bS[t] = ldf(RSL(scur), fn[t]); bG[t] = ldf(RSL(2 + par), fn[t]); } \
                _Pragma("unroll") for (int t = 0; t < 2; ++t) { yacc[t] = mm<true>(aP1, bS[t], yacc[t]); sacc[t] = mm<true>(aS, bG[t], sacc[t] * gecur[t] + hcur[t]); } \
                _Pragma("unroll") for (int t = 0; t < 2; ++t) { const int n0 = n0a + 16 * t; *(LAS f32x4*)(Yf0 + par * (64 * YLD) + (m0 + fr) * YLD + n0 + 4 * fq) = yacc[t]; st4(RSL(snxt), orm[t], sacc[t]); } } \
            if ((c) > 0) P6B_OUT(par ^ 1, p_vb, p_g, p_row);                    \
            p_vb = vbw; p_g = gw; p_row = grow; } while (0)
        P6B_LOAD(0, nA); P6B_LOAD(1, nB);
        for (int c = 0; c < SEQ / 64; c += 2) {
            P6B_STEP(c, nA);
            P6B_STEP(c + 1, nB);
        }
#undef P6B_STEP
        LBAR();
        P6B_OUT(1, p_vb, p_g, p_row);
#undef P6B_LOAD
#undef P6B_OUT
        LBAR();
    }
}

namespace sba {
using bf16x8 = __attribute__((ext_vector_type(8))) short;
using s16x4 = __attribute__((ext_vector_type(4))) short;
using f32x16 = __attribute__((ext_vector_type(16))) float;
using u32x4 = __attribute__((ext_vector_type(4))) unsigned;
constexpr int QB = 256, KVBLK = 64;
constexpr int LDS_K = 0, LDS_V = 16384, LDS_ST = 32768, ST_LD = 68, LDS_FLAG = LDS_ST + 8 * 32 * ST_LD * 4, LDS_BYTES_ATT = LDS_FLAG + 64;
constexpr float R_DEAD = -160.0f;
#define SBAR() __builtin_amdgcn_sched_barrier(0)
typedef float f32x2_t __attribute__((ext_vector_type(2))); typedef __bf16 bf16x2_t __attribute__((ext_vector_type(2)));
__device__ __forceinline__ unsigned cvtpk_s(float lo, float hi) { f32x2_t v = {lo, hi}; bf16x2_t b = __builtin_convertvector(v, bf16x2_t); return __builtin_bit_cast(unsigned, b); }
__device__ __forceinline__ void qkt(f32x16& p0, f32x16& p1, const char* Kslot, const bf16x8* qr, int r32, int hi) {
    const char* kb = Kslot + hi * 1024 + r32 * 16;
    const f32x16 z = f32x16{};
#pragma unroll
    for (int d0 = 0; d0 < 4; ++d0) {
        const bf16x8 b0 = *reinterpret_cast<const bf16x8*>(kb + d0 * 2048);
        const bf16x8 b1 = *reinterpret_cast<const bf16x8*>(kb + d0 * 2048 + 512);
        if (d0 == 0) { p0 = __builtin_amdgcn_mfma_f32_32x32x16_bf16(b0, qr[0], z, 0, 0, 0); p1 = __builtin_amdgcn_mfma_f32_32x32x16_bf16(b1, qr[0], z, 0, 0, 0); }
        else { p0 = __builtin_amdgcn_mfma_f32_32x32x16_bf16(b0, qr[d0], p0, 0, 0, 0); p1 = __builtin_amdgcn_mfma_f32_32x32x16_bf16(b1, qr[d0], p1, 0, 0, 0); }
    }
}
__device__ __forceinline__ void pv(f32x16* o, int vb, bf16x8 pa0, bf16x8 pa1, bf16x8 pa2, bf16x8 pa3) {
#pragma unroll
    for (int d0 = 0; d0 < 2; ++d0) { s16x4 lo[4], hi[4];
#pragma unroll
        for (int ks = 0; ks < 4; ++ks) {
            asm volatile("ds_read_b64_tr_b16 %0,%1 offset:%c2" : "=&v"(lo[ks]) : "v"(vb), "i"(d0 * 4096 + ks * 1024) : "memory");
            asm volatile("ds_read_b64_tr_b16 %0,%1 offset:%c2" : "=&v"(hi[ks]) : "v"(vb), "i"(d0 * 4096 + ks * 1024 + 512) : "memory"); }
        asm volatile("s_waitcnt lgkmcnt(0)" ::: "memory"); SBAR();
#define PK(k) (bf16x8){lo[k][0], lo[k][1], lo[k][2], lo[k][3], hi[k][0], hi[k][1], hi[k][2], hi[k][3]}
        o[d0] = __builtin_amdgcn_mfma_f32_32x32x16_bf16(pa0, PK(0), o[d0], 0, 0, 0);
        o[d0] = __builtin_amdgcn_mfma_f32_32x32x16_bf16(pa1, PK(1), o[d0], 0, 0, 0);
        o[d0] = __builtin_amdgcn_mfma_f32_32x32x16_bf16(pa2, PK(2), o[d0], 0, 0, 0);
        o[d0] = __builtin_amdgcn_mfma_f32_32x32x16_bf16(pa3, PK(3), o[d0], 0, 0, 0);
#undef PK
    }
}
__device__ __forceinline__ float swap_sum(float x, float& other_if_lo, int hi) {
    auto rr = __builtin_amdgcn_permlane32_swap(__float_as_uint(x), __float_as_uint(x), false, false);
    const float a = __uint_as_float(rr[0]), b = __uint_as_float(rr[1]);
    other_if_lo = hi ? 0.f : b;
    return a + b;
}
__device__ __forceinline__ float swap_prod(float x, float& other_if_lo, int hi) {
    auto rr = __builtin_amdgcn_permlane32_swap(__float_as_uint(x), __float_as_uint(x), false, false);
    const float a = __uint_as_float(rr[0]), b = __uint_as_float(rr[1]);
    other_if_lo = hi ? 1.0f : b;
    return a * b;
}
__device__ __forceinline__ void attn_wave_unit(int b, int h, int qblk, bf16* QO, const bf16* __restrict__ KB, const bf16* __restrict__ VB, const float* gout, char* wsm  ) {
    const int lane = threadIdx.x & 63, r32 = lane & 31, hi = lane >> 5;
    const long rowbase = (long)b * SEQ; const int q0 = qblk * 32;
    bf16* Qw = QO + (rowbase + q0) * D + h * HD;
    const bf16* Kh = KB + rowbase * SBW + h * HD; const bf16* Vh = VB + rowbase * SBW + h * HD;
    const unsigned lds0 = (unsigned)(uintptr_t)wsm;
    const int jtop = (q0 + 30) >> 6;
    const bf16* vsrc = Vh + (long)(lane >> 3) * SBW + (lane & 7) * 8;
    const int vdst0 = ((lane & 7) >> 2) * 4096 + ((lane >> 3) & 15) * 64 + (lane & 3) * 16;
    const int vb0 = (int)lds0 + ((lane >> 4) & 1) * 32 + (lane & 3) * 8 + (4 * hi + ((lane & 15) >> 2)) * 64;
    const bf16* ksrc = Kh + (long)r32 * SBW + hi * 8;
    bf16x8 qr[4];
#pragma unroll
    for (int d0 = 0; d0 < 4; ++d0) qr[d0] = *reinterpret_cast<const bf16x8*>(&Qw[(long)r32 * D + d0 * 16 + hi * 8]);
    bf16x8 kf[8]; u32x4 vr[8];
#define SBA_LOAD(t) do { const bf16* kp_ = ksrc + (long)(t) * KVBLK * SBW; const bf16* vp_ = vsrc + (long)(t) * KVBLK * SBW; \
        _Pragma("unroll") for (int d0 = 0; d0 < 4; ++d0) { kf[2 * d0] = *reinterpret_cast<const bf16x8*>(kp_ + d0 * 16); kf[2 * d0 + 1] = *reinterpret_cast<const bf16x8*>(kp_ + 32 * SBW + d0 * 16); } \
        _Pragma("unroll") for (int i = 0; i < 8; ++i) vr[i] = *(const u32x4*)(vp_ + (long)(8 * i) * SBW); } while (0)
    SBA_LOAD(jtop);
    float R = 0.f; f32x16 o[2]; o[0] = f32x16{}; o[1] = f32x16{};
    const int qrow = q0 + r32;
    for (int jt = jtop; jt >= 0; --jt) {
        const int cur = (jtop - jt) & 1;
#pragma unroll
        for (int i = 0; i < 8; ++i) *(u32x4*)(wsm + cur * 8192 + vdst0 + (i >> 1) * 1024 + (i & 1) * 512) = vr[i];
        f32x16 p0, p1;
        {   const f32x16 z = f32x16{};
            p0 = __builtin_amdgcn_mfma_f32_32x32x16_bf16(kf[0], qr[0], z, 0, 0, 0); p1 = __builtin_amdgcn_mfma_f32_32x32x16_bf16(kf[1], qr[0], z, 0, 0, 0);
#pragma unroll
            for (int d0 = 1; d0 < 4; ++d0) { p0 = __builtin_amdgcn_mfma_f32_32x32x16_bf16(kf[2 * d0], qr[d0], p0, 0, 0, 0); p1 = __builtin_amdgcn_mfma_f32_32x32x16_bf16(kf[2 * d0 + 1], qr[d0], p1, 0, 0, 0); } }
        if (jt > 0) SBA_LOAD(jt - 1);
        const int kb = 64 * jt + 4 * hi; const bool diag = (jt == jtop);
#pragma unroll
        for (int r = 0; r < 16; ++r) {
            { float rr = __builtin_amdgcn_rcpf(1.0f + __builtin_amdgcn_exp2f(p0[r]));
              if (diag) { const int key = kb + (r & 3) + 8 * (r >> 2); if (key >= qrow) rr = 1.0f; }
              p0[r] = rr; }
            { float rr = __builtin_amdgcn_rcpf(1.0f + __builtin_amdgcn_exp2f(p1[r]));
              if (diag) { const int key = kb + 32 + (r & 3) + 8 * (r >> 2); if (key >= qrow) rr = 1.0f; }
              p1[r] = rr; }
        }
        float c0[4], c1[4], x0[4], x1[4];
#pragma unroll
        for (int g = 0; g < 4; ++g) {
            const float s0 = (p0[4 * g] * p0[4 * g + 1]) * (p0[4 * g + 2] * p0[4 * g + 3]);
            const float s1 = (p1[4 * g] * p1[4 * g + 1]) * (p1[4 * g + 2] * p1[4 * g + 3]);
            c0[g] = swap_prod(s0, x0[g], hi); c1[g] = swap_prod(s1, x1[g], hi);
        }
        const float Cr = __builtin_amdgcn_exp2f(R);
        float suf0[4], suf1[4];
        suf1[3] = Cr; suf1[2] = suf1[3] * c1[3]; suf1[1] = suf1[2] * c1[2]; suf1[0] = suf1[1] * c1[1];
        suf0[3] = suf1[0] * c1[0]; suf0[2] = suf0[3] * c0[3]; suf0[1] = suf0[2] * c0[2]; suf0[0] = suf0[1] * c0[1];
        R += __builtin_amdgcn_logf(((c0[0] * c0[1]) * (c0[2] * c0[3])) * ((c1[0] * c1[1]) * (c1[2] * c1[3])));
#pragma unroll
        for (int g = 0; g < 4; ++g) {
            { const float e3 = suf0[g] * x0[g], e2 = e3 * p0[4 * g + 3], e1 = e2 * p0[4 * g + 2], e0 = e1 * p0[4 * g + 1];
              p0[4 * g + 3] = (1.0f - p0[4 * g + 3]) * e3; p0[4 * g + 2] = (1.0f - p0[4 * g + 2]) * e2; p0[4 * g + 1] = (1.0f - p0[4 * g + 1]) * e1; p0[4 * g] = (1.0f - p0[4 * g]) * e0; }
            { const float e3 = suf1[g] * x1[g], e2 = e3 * p1[4 * g + 3], e1 = e2 * p1[4 * g + 2], e0 = e1 * p1[4 * g + 1];
              p1[4 * g + 3] = (1.0f - p1[4 * g + 3]) * e3; p1[4 * g + 2] = (1.0f - p1[4 * g + 2]) * e2; p1[4 * g + 1] = (1.0f - p1[4 * g + 1]) * e1; p1[4 * g] = (1.0f - p1[4 * g]) * e0; }
        }
#define PKW(P, B) cvtpk_s(P[B], P[B + 1])
        const u32x4 pw0 = (u32x4){PKW(p0, 0), PKW(p0, 2), PKW(p0, 4), PKW(p0, 6)}, pw1 = (u32x4){PKW(p0, 8), PKW(p0, 10), PKW(p0, 12), PKW(p0, 14)};
        const u32x4 pw2 = (u32x4){PKW(p1, 0), PKW(p1, 2), PKW(p1, 4), PKW(p1, 6)}, pw3 = (u32x4){PKW(p1, 8), PKW(p1, 10), PKW(p1, 12), PKW(p1, 14)};
#undef PKW
        SBAR();
        asm volatile("s_waitcnt lgkmcnt(0)" ::: "memory");
        pv(o, vb0 + cur * 8192, __builtin_bit_cast(bf16x8, pw0), __builtin_bit_cast(bf16x8, pw1), __builtin_bit_cast(bf16x8, pw2), __builtin_bit_cast(bf16x8, pw3));
        if (__all(R < R_DEAD)) break;
    }
#undef SBA_LOAD
    {
        float* stg = (float*)wsm;
        asm volatile("s_waitcnt lgkmcnt(0)" ::: "memory");
#pragma unroll
        for (int r = 0; r < 16; ++r) { const int orow = (r & 3) + 8 * (r >> 2) + 4 * hi;
#pragma unroll
            for (int d0 = 0; d0 < 2; ++d0) stg[orow * ST_LD + d0 * 32 + r32] = o[d0][r]; }
        asm volatile("s_waitcnt lgkmcnt(0)" ::: "memory");
        const int ch = lane & 7;
        const f32x4 ga = *(const f32x4*)(gout + h * HD + ch * 8), gb = *(const f32x4*)(gout + h * HD + ch * 8 + 4);
#pragma unroll
        for (int i = 0; i < 4; ++i) { const int row = i * 8 + (lane >> 3);
            const f32x4 a = *(const f32x4*)(stg + row * ST_LD + ch * 8), c = *(const f32x4*)(stg + row * ST_LD + ch * 8 + 4);
            float ss = (a.x * a.x + a.y * a.y) + (a.z * a.z + a.w * a.w) + (c.x * c.x + c.y * c.y) + (c.z * c.z + c.w * c.w);
            ss = sum8(ss);
            const float hs = __builtin_amdgcn_rsqf(ss * (1.0f / 64.0f) + 1e-6f);
            u32x4 w; w.x = cvtpk_s(a.x * hs * ga.x, a.y * hs * ga.y); w.y = cvtpk_s(a.z * hs * ga.z, a.w * hs * ga.w);
            w.z = cvtpk_s(c.x * hs * gb.x, c.y * hs * gb.y); w.w = cvtpk_s(c.z * hs * gb.z, c.w * hs * gb.w);
            *(u32x4*)(Qw + (long)row * D + ch * 8) = w; }
        asm volatile("s_waitcnt lgkmcnt(0)" ::: "memory");
    }
}
#undef SBAR
__device__ __forceinline__ void attn_phase(Frame& F, bf16* QO, const bf16* KB, const bf16* VB, const float* gout, unsigned* queue, int first_ticket, int ticket_base) {
    char* wsm = (char*)F.lds + RING_OFF + F.wave * 16384;
    const int nunits = BATCH * NH * (SEQ / 32);
    int pend = -1; int tfirst = first_ticket;
    for (;;) {
        int uu;
        if (pend >= 0) { uu = pend; pend = -1; }
        else { unsigned t;
               if (tfirst >= 0) { t = (unsigned)tfirst; tfirst = -1; }
               else { t = 0u; if (F.lane == 0) t = __hip_atomic_fetch_add(queue, 1u, __ATOMIC_RELAXED, __HIP_MEMORY_SCOPE_AGENT); t = (unsigned)__builtin_amdgcn_readfirstlane((int)t) + (unsigned)ticket_base; }
               if (2u * t >= (unsigned)nunits) break; uu = (int)(2u * t); pend = uu + 1; }
        attn_wave_unit(uu >> 9, (uu >> 6) & 7, uu & 63, QO, KB, VB, gout, wsm);
    }
    __syncthreads();
}
}

struct Args { const float* in[26]; float* out; unsigned char* ws; int ph_lo, ph_hi, li, pad; };
__global__ void __launch_bounds__(NWAVES * 64, 2) skel_fwd(Args args) {
    extern __shared__ __attribute__((aligned(16))) unsigned char lds[];
    Frame F;
    F.lds = (LAS unsigned char*)lds;
    F.MISC = (volatile LAS unsigned*)(F.lds + MISC_OFF);
    F.tid = threadIdx.x; F.lane = F.tid & 63; F.wave = __builtin_amdgcn_readfirstlane(F.tid >> 6);
    F.G = gridDim.x; { const int bx = blockIdx.x; F.vcu = (F.G % 8 == 0) ? (bx % 8) * (F.G / 8) + bx / 8 : bx; }
    unsigned char* ws = args.ws;
    F.ctl = (gu32*)(ws + WS_CTL);
    const float* x = args.in[0];
    bf16* W1U = (bf16*)(ws + WS_W1U); bf16* W1D = (bf16*)(ws + WS_W1D); bf16* W2U = (bf16*)(ws + WS_W2U); bf16* W2D = (bf16*)(ws + WS_W2D);
    bf16* WIN = (bf16*)(ws + WS_WIN); bf16* WOUT = (bf16*)(ws + WS_WOUT); bf16* WLORA = (bf16*)(ws + WS_WLORA);
    bf16* XB = (bf16*)(ws + WS_XB); bf16* ACT = (bf16*)(ws + WS_ACT); bf16* QO = (bf16*)(ws + WS_QO); bf16* KB = (bf16*)(ws + WS_KB); bf16* VB = (bf16*)(ws + WS_VB);
    bf16* RW = (bf16*)(ws + WS_RW); bf16* ALORA = (bf16*)(ws + WS_ALORA); float* LW = (float*)(ws + WS_LW); bf16* AB = (bf16*)(ws + WS_AB); bf16* GB = (bf16*)(ws + WS_GB);
    float* SSQ = (float*)(ws + WS_SSQ); float* out = args.out;
    for (int u = F.tid; u < (LDS_BYTES - LDSCTL_OFF) / 4; u += NWAVES * 64) ((LAS unsigned*)(F.lds + LDSCTL_OFF))[u] = 0u;
    __syncthreads();
    XcdBarrier bar; bar.bar = (unsigned*)(F.ctl + CW_BAR); bar.x = 0; bar.st = nullptr;
    if (N_LAUNCHES != PER_PHASE) bar = xcd_barrier_post((unsigned*)(F.ctl + CW_BAR), F.MISC + 8);
#define GRID_BAR(seam) do { if (N_LAUNCHES == PER_PHASE) { if (F.tid == 0) __hip_atomic_store(F.ctl + CW_TMO, 0xBADBA0u | (unsigned)(seam), RLX_AGENT); } else { xcd_barrier(bar); } } while (0)
    const int lo = args.ph_lo, hi = args.ph_hi;
#define IN(k) (lo <= (k) && (k) < hi)
#define BOTH(k) (IN(k) && IN((k) + 1))
    if (IN(0)) {
        p0_prologue(F, x, args.in[1], args.in[2], args.in[3], args.in[4], args.in[5], args.in[6], args.in[12], args.in[14], args.in[15], args.in[21], args.in[22], args.in[23], args.in[24], args.in[25],
                    W1U, W1D, W2U, W2D, WIN, WOUT, WLORA, XB, SSQ); if (BOTH(0)) GRID_BAR(0);
    }
    if (IN(1)) {
        pg8::Gemm g{XB, W1U, M, 2 * FF, D}; pg8::StaticOrder S; S.init(M, 2 * FF, F.G, (int)blockIdx.x);
        pg8::EpiSwiGLU E{ACT, FF, SSQ};
        pg8::gemm_phase<pg8::EpiSwiGLU, pg8::StaticOrder, true, true>(F.lds + RING_OFF, g, S, E);
        if (BOTH(1)) GRID_BAR(1);
    }
    if (IN(2)) {
        pg8::Gemm g{ACT, W1D, M, D, FF}; pg8::StaticOrder S; S.init(M, D, F.G, (int)blockIdx.x);
        pg8::EpiResid E{x, nullptr, nullptr, nullptr, XB, (bf16*)out, SSQ, 0.5f, 1};
        pg8::gemm_phase<pg8::EpiResid, pg8::StaticOrder, true, true>(F.lds + RING_OFF, g, S, E);
        if (BOTH(2)) GRID_BAR(2);
    }
    if (IN(3)) {
        pg8::Gemm g{XB, WIN, M, PW, D}; pg8::StaticOrder S; S.init(M, PW, F.G, (int)blockIdx.x);
        pg8::EpiWin E{QO, KB, VB, RW, SSQ, args.in[7], args.in[8], 0.125f * 1.4426950408889634f};
        pg8::gemm_phase<pg8::EpiWin, pg8::StaticOrder, true, true>(F.lds + RING_OFF, g, S, E);
        if (F.G >= 256) {
            const int nlo = (M / 256) * (PW / 256) - 6 * F.G;
            if ((int)blockIdx.x >= nlo) { __syncthreads();
                p0_items(F, x, args.in[1], args.in[2], args.in[3], args.in[4], args.in[5], args.in[6], args.in[12], args.in[14], args.in[15], args.in[21], args.in[22], args.in[23], args.in[24], args.in[25],
                         W1U, W1D, W2U, W2D, WIN, WOUT, WLORA, XB, SSQ, 1, ((int)blockIdx.x - nlo) * NWAVES + F.wave, (F.G - nlo) * NWAVES); }
        }
        if (BOTH(3)) GRID_BAR(3);
    }
    if (IN(6)) {
        RwArgs A{RW, WLORA, WLORA + 512 * 64, WLORA + 2 * 512 * 64, args.in[11], args.in[13], QO, args.in[10], args.in[16], args.in[17], args.in[18], args.in[19], args.in[20]};
        bf16* ob = (bf16*)out;
        RwX X{ob + (size_t)32 * 1024 * 1024, ob + (size_t)48 * 1024 * 1024, (bf16*)LW, (bf16*)LW + (size_t)16 * 1024 * 1024, AB, AB + (size_t)8 * 1024 * 1024, SSQ, GB};
        p6a_rwkv_local(F, A, X);
        GRID_BAR(16);
        const int nseq = (F.G >= 2 * BATCH * NH) ? BATCH * NH : F.G;
        if ((int)blockIdx.x < nseq) { p6b_rwkv_seq(F, A, X, nseq); __syncthreads(); }
        const int nfree = (F.G - nseq) * NWAVES;
        sba::attn_phase(F, QO, KB, VB, args.in[9], (unsigned*)(F.ctl + CW_QUEUE), ((int)blockIdx.x >= nseq) ? ((int)blockIdx.x - nseq) * NWAVES + F.wave : -1, nfree);
        if (BOTH(6)) GRID_BAR(6);
    }
    if (IN(8)) {
        pg8::Gemm g{QO, WOUT, M, D, D}; pg8::StaticOrder S; S.init(M, D, F.G, (int)blockIdx.x);
        pg8::EpiResid E{nullptr, XB, (const bf16*)out, nullptr, XB, (bf16*)LW, SSQ, 1.0f, 1};
        pg8::gemm_phase<pg8::EpiResid, pg8::StaticOrder, true, true>(F.lds + RING_OFF, g, S, E);
        if (BOTH(8)) GRID_BAR(8);
    }
    if (IN(9)) {
        pg8::Gemm g{XB, W2U, M, 2 * FF, D}; pg8::StaticOrder S; S.init(M, 2 * FF, F.G, (int)blockIdx.x);
        pg8::EpiSwiGLU E{ACT, FF, SSQ};
        pg8::gemm_phase<pg8::EpiSwiGLU, pg8::StaticOrder, true, true>(F.lds + RING_OFF, g, S, E);
        if (BOTH(9)) GRID_BAR(9);
    }
    if (IN(10)) {
        pg8::Gemm g{ACT, W2D, M, D, FF}; pg8::StaticOrder S; S.init(M, D, F.G, (int)blockIdx.x);
        pg8::EpiResid E{nullptr, XB, (const bf16*)LW, out, nullptr, nullptr, SSQ, 0.5f, 0};
        pg8::gemm_phase<pg8::EpiResid, pg8::StaticOrder, true, true>(F.lds + RING_OFF, g, S, E);
    }
#undef IN
#undef BOTH
}

extern "C" void kernel_launch(void* const* d_in, const int* in_sizes, int n_in, void* d_out, int out_size, void* d_ws, size_t ws_size, hipStream_t stream) {
    static int grid = 0;
    if (grid == 0) {
        if (n_in != 26 || in_sizes[0] != M * D || out_size != M * D || ws_size < WS_END) { fprintf(stderr, "kernel_launch: unexpected shapes: n_in %d in0 %d out %d ws %zu (need %zu)\n", n_in, n_in > 0 ? in_sizes[0] : -1, out_size, ws_size, (size_t)WS_END); grid = -1; return; }
        int dev = 0, cus = 0, per_cu = 0;
        if (hipGetDevice(&dev) != hipSuccess || hipDeviceGetAttribute(&cus, hipDeviceAttributeMultiprocessorCount, dev) != hipSuccess) { grid = -1; return; }
        if (hipFuncSetAttribute((const void*)skel_fwd, hipFuncAttributeMaxDynamicSharedMemorySize, LDS_BYTES) != hipSuccess) { fprintf(stderr, "kernel_launch: hipFuncSetAttribute failed\n"); grid = -1; return; }
        if (hipOccupancyMaxActiveBlocksPerMultiprocessor(&per_cu, (const void*)skel_fwd, NWAVES * 64, LDS_BYTES) != hipSuccess || per_cu < 1) { fprintf(stderr, "kernel_launch: occupancy query reports %d blocks per CU\n", per_cu); per_cu = 1; }
        (void)hipGetLastError();
        grid = cus;
    }
    if (grid < 0) return;
    if (hipMemsetAsync((char*)d_ws + WS_CTL, 0, CTL_ZERO_BYTES, stream) != hipSuccess) return;
    Args a{};
    for (int i = 0; i < 26; ++i) a.in[i] = (const float*)d_in[i];
    a.out = (float*)d_out; a.ws = (unsigned char*)d_ws;
    for (int li = 0; li < N_LAUNCHES; ++li) {
        a.ph_lo = (N_LAUNCHES == PER_PHASE) ? li : 0; a.ph_hi = (N_LAUNCHES == PER_PHASE) ? li + 1 : PER_PHASE; a.li = li;
        hipLaunchKernelGGL(skel_fwd, dim3(grid), dim3(NWAVES * 64), LDS_BYTES, stream, a);
    }
}
```

```cpp
#include <hip/hip_runtime.h>
#include <hip/hip_bf16.h>
#include <cstdio>
#include <cstdint>
#include <cmath>
namespace pg8 {
#define PG8_LAS __attribute__((address_space(3)))
typedef unsigned short bf16_t;
typedef short bf16x8 __attribute__((ext_vector_type(8)));
typedef float f32x4 __attribute__((ext_vector_type(4)));
typedef unsigned u32x4 __attribute__((ext_vector_type(4)));
constexpr int BM = 256, BK = 64, HALF = 128, HTB = HALF * BK * 2  , STAGE_BYTES = 8 * HTB, NXCD = 8, WGM = 4;

__host__ __device__ __forceinline__ int lds_byte(int r, int c) { const int st = (r >> 4) * 2 + (c >> 5), rr = r & 15, cc = c & 31, ob = rr * 64 + cc * 2; return st * 1024 + (ob ^ (((ob >> 9) & 1) << 5)); }
__host__ __device__ __forceinline__ void stage_rc(int b, int& R, int& C) { const int st = b / 1024, sb = b % 1024, swz = sb ^ (((sb >> 9) & 1) << 5); R = (st >> 1) * 16 + swz / 64; C = (st & 1) * 32 + (swz % 64) / 2; }
__host__ __device__ __forceinline__ int perm32(int rho) { const int n = rho >> 4, i = rho & 15; return 8 * (i >> 2) + 4 * n + (i & 3); }

struct Unit { int pm, pn; };
struct Gemm { const bf16_t* A; const bf16_t* Bt; int M, N, K; int ld; };

struct StaticOrder {
    int nM, nN, nwg, G, c;
    __host__ __device__ void init(int M, int N, int G_, int c_) { nM = M / BM; nN = N / BM; nwg = nM * nN; G = G_; c = c_; }
    __host__ __device__ bool next(int i, Unit& u) const {
        const long L = (long)i * G + c; if (L >= nwg) return false;
        int wgid = (int)L; { const int q = nwg / NXCD, r = nwg % NXCD, xcd = wgid % NXCD, off = wgid / NXCD; wgid = (xcd < r ? xcd * (q + 1) : r * (q + 1) + (xcd - r) * q) + off; }
        const int nig = WGM * nN, gid = wgid / nig, fm = gid * WGM, gsz = (nM - fm) < WGM ? (nM - fm) : WGM;
        u.pm = fm + ((wgid % nig) % gsz); u.pn = (wgid % nig) / gsz; return true;
    }
    __device__ __forceinline__ void a_ready(const Unit&) const {}
    __device__ __forceinline__ void done(const Unit&) const {}
};


__device__ __forceinline__ unsigned cvt_pk_bf16(float lo, float hi) { unsigned r; asm volatile("v_cvt_pk_bf16_f32 %0, %1, %2" : "=v"(r) : "v"(lo), "v"(hi)); return r; }
typedef unsigned u32x2 __attribute__((ext_vector_type(2)));
constexpr float RMS_EPS_F = 1e-6f;
constexpr float LOG2E_F = 1.4426950408889634f;
__device__ __forceinline__ float row_rs(const float* ssqp, int row) {
    const f32x4* p = (const f32x4*)(ssqp + (size_t)row * 16);
    const f32x4 a = p[0], b = p[1], c = p[2], d = p[3];
    const float s = ((a[0] + a[1]) + (a[2] + a[3])) + ((b[0] + b[1]) + (b[2] + b[3])) + ((c[0] + c[1]) + (c[2] + c[3])) + ((d[0] + d[1]) + (d[2] + d[3]));
    return __builtin_amdgcn_rsqf(s * (1.0f / 1024.0f) + RMS_EPS_F);
}
__device__ __forceinline__ float silu_f(float g) { return g * __builtin_amdgcn_rcpf(1.0f + __builtin_amdgcn_exp2f(-g * LOG2E_F)); }
__device__ __forceinline__ float sigmoid_f(float g) { return __builtin_amdgcn_rcpf(1.0f + __builtin_amdgcn_exp2f(-g * LOG2E_F)); }

struct EpiSwiGLU {
    static constexpr bool PERM = true, AFTER_DRAIN = false;
    bf16_t* O; int ldo; const float* ssqp;
    __device__ __forceinline__ void operator()(const f32x4 (&acc)[2][2][4][2], const Unit& u, int wr, int wc, int fr, int fq) const {
        const int row0 = u.pm * BM + wr * 64 + fr, col0 = u.pn * HALF + wc * 32 + 8 * fq;
#pragma unroll
        for (int ai = 0; ai < 2; ++ai)
#pragma unroll
            for (int m = 0; m < 4; ++m) {
                const int row = row0 + ai * HALF + m * 16; const float rs = row_rs(ssqp, row);
                const f32x4 g0 = acc[ai][0][m][0] * rs, g1 = acc[ai][0][m][1] * rs, u0 = acc[ai][1][m][0] * rs, u1 = acc[ai][1][m][1] * rs;
                u32x4 w;
                w.x = cvt_pk_bf16(silu_f(g0[0]) * u0[0], silu_f(g0[1]) * u0[1]); w.y = cvt_pk_bf16(silu_f(g0[2]) * u0[2], silu_f(g0[3]) * u0[3]);
                w.z = cvt_pk_bf16(silu_f(g1[0]) * u1[0], silu_f(g1[1]) * u1[1]); w.w = cvt_pk_bf16(silu_f(g1[2]) * u1[2], silu_f(g1[3]) * u1[3]);
                *(u32x4*)(O + (size_t)row * ldo + col0) = w;
            }
    }
};

struct EpiResid {
    static constexpr bool PERM = true, AFTER_DRAIN = false;
    const float* basef; const bf16_t* bhi; const bf16_t* blo; float* outf; bf16_t* ohi; bf16_t* olo; float* ssqp; float alpha; int aux;
    __device__ __forceinline__ static f32x4 up_lo(unsigned a, unsigned b) { return (f32x4){__uint_as_float(a << 16), __uint_as_float(a & 0xffff0000u), __uint_as_float(b << 16), __uint_as_float(b & 0xffff0000u)}; }
    __device__ __forceinline__ void operator()(const f32x4 (&acc)[2][2][4][2], const Unit& u, int wr, int wc, int fr, int fq) const {
        const int row0 = u.pm * BM + wr * 64 + fr, col0 = u.pn * BM + wc * 32 + 8 * fq;
#pragma unroll
        for (int ai = 0; ai < 2; ++ai)
#pragma unroll
            for (int m = 0; m < 4; ++m) {
                const int row = row0 + ai * HALF + m * 16; const size_t off = (size_t)row * 1024 + col0; float ss = 0.f;
#pragma unroll
                for (int bj = 0; bj < 2; ++bj) {
                    f32x4 b0, b1;
                    if (basef) { b0 = *(const f32x4*)(basef + off + bj * HALF); b1 = *(const f32x4*)(basef + off + bj * HALF + 4); }
                    else { const u32x4 h = *(const u32x4*)(bhi + off + bj * HALF), l = *(const u32x4*)(blo + off + bj * HALF); b0 = up_lo(h.x, h.y) + up_lo(l.x, l.y); b1 = up_lo(h.z, h.w) + up_lo(l.z, l.w); }
                    const f32x4 v0 = b0 + acc[ai][bj][m][0] * alpha, v1 = b1 + acc[ai][bj][m][1] * alpha;
                    if (aux) ss += ((v0[0] * v0[0] + v0[1] * v0[1]) + (v0[2] * v0[2] + v0[3] * v0[3])) + ((v1[0] * v1[0] + v1[1] * v1[1]) + (v1[2] * v1[2] + v1[3] * v1[3]));
                    if (outf) { *(f32x4*)(outf + off + bj * HALF) = v0; *(f32x4*)(outf + off + bj * HALF + 4) = v1; }
                    else { u32x4 h; h.x = cvt_pk_bf16(v0[0], v0[1]); h.y = cvt_pk_bf16(v0[2], v0[3]); h.z = cvt_pk_bf16(v1[0], v1[1]); h.w = cvt_pk_bf16(v1[2], v1[3]);
                        const f32x4 r0 = v0 - up_lo(h.x, h.y), r1 = v1 - up_lo(h.z, h.w);
                        u32x4 l; l.x = cvt_pk_bf16(r0[0], r0[1]); l.y = cvt_pk_bf16(r0[2], r0[3]); l.z = cvt_pk_bf16(r1[0], r1[1]); l.w = cvt_pk_bf16(r1[2], r1[3]);
                        *(u32x4*)(ohi + off + bj * HALF) = h; *(u32x4*)(olo + off + bj * HALF) = l; }
                }
                if (aux) { ss += __shfl_xor(ss, 16); ss += __shfl_xor(ss, 32); if (fq == 0) ssqp[(size_t)row * 16 + u.pn * 4 + wc] = ss; }
            }
    }
};

struct EpiWin {
    static constexpr bool PERM = true, AFTER_DRAIN = false;
    bf16_t* QO; bf16_t* KB; bf16_t* VB; bf16_t* RW; const float* ssqp; const float* gq; const float* gk; float qscale;
    __device__ __forceinline__ void operator()(const f32x4 (&acc)[2][2][4][2], const Unit& u, int wr, int wc, int fr, int fq) const {
        const int row0 = u.pm * BM + wr * 64 + fr; const int pn = u.pn;
        if (pn < 4) {
            const float* gp = (pn < 2) ? gq : gk; const float osc = (pn < 2) ? qscale : 1.0f;
            f32x4 gv[2][2];
#pragma unroll
            for (int bj = 0; bj < 2; ++bj)
#pragma unroll
                for (int n = 0; n < 2; ++n) gv[bj][n] = *(const f32x4*)(gp + 32 * bj + 8 * fq + 4 * n) * osc;
            bf16_t* dst = (pn < 2) ? QO : KB; const int ld = (pn < 2) ? 1024 : 512; const int colh = 64 * (4 * (pn & 1) + wc) + 8 * fq;
#pragma unroll
            for (int ai = 0; ai < 2; ++ai)
#pragma unroll
                for (int m = 0; m < 4; ++m) {
                    const int row = row0 + ai * HALF + m * 16; const float rs = row_rs(ssqp, row);
                    f32x4 y[2][2]; float ss = 0.f;
#pragma unroll
                    for (int bj = 0; bj < 2; ++bj)
#pragma unroll
                        for (int n = 0; n < 2; ++n) { y[bj][n] = acc[ai][bj][m][n] * rs; const f32x4 t = y[bj][n]; ss += (t[0] * t[0] + t[1] * t[1]) + (t[2] * t[2] + t[3] * t[3]); }
                    ss += __shfl_xor(ss, 16); ss += __shfl_xor(ss, 32);
                    const float hs = __builtin_amdgcn_rsqf(ss * (1.0f / 64.0f) + RMS_EPS_F);
#pragma unroll
                    for (int bj = 0; bj < 2; ++bj) {
                        const f32x4 a = y[bj][0] * gv[bj][0] * hs, b = y[bj][1] * gv[bj][1] * hs;
                        u32x4 w; w.x = cvt_pk_bf16(a[0], a[1]); w.y = cvt_pk_bf16(a[2], a[3]); w.z = cvt_pk_bf16(b[0], b[1]); w.w = cvt_pk_bf16(b[2], b[3]);
                        *(u32x4*)(dst + (size_t)row * ld + colh + 32 * bj) = w;
                    }
                }
        } else {
            bf16_t* dst = (pn < 6) ? VB : RW; const int ld = (pn < 6) ? 512 : 1792; const int colh = 256 * ((pn < 6) ? (pn - 4) : (pn - 6)) + 64 * wc + 8 * fq;
#pragma unroll
            for (int ai = 0; ai < 2; ++ai)
#pragma unroll
                for (int m = 0; m < 4; ++m) {
                    const int row = row0 + ai * HALF + m * 16; const float rs = row_rs(ssqp, row);
#pragma unroll
                    for (int bj = 0; bj < 2; ++bj) {
                        const f32x4 a = acc[ai][bj][m][0] * rs, b = acc[ai][bj][m][1] * rs;
                        u32x4 w; w.x = cvt_pk_bf16(a[0], a[1]); w.y = cvt_pk_bf16(a[2], a[3]); w.z = cvt_pk_bf16(b[0], b[1]); w.w = cvt_pk_bf16(b[2], b[3]);
                        *(u32x4*)(dst + (size_t)row * ld + colh + 32 * bj) = w;
                    }
                }
        }
    }
};

template <class Epi, class Sched, bool ALIGN_EPI = false, bool SP2 = false>
__device__ __forceinline__ void gemm_phase(PG8_LAS unsigned char* lds, const Gemm g, const Sched& S, const Epi& E) {
    const int tid = threadIdx.x, wid = __builtin_amdgcn_readfirstlane(tid >> 6), lane = tid & 63, wr = wid >> 2, wc = wid & 3, fr = lane & 15, fq = lane >> 4;
    const int K = g.K, nt = K / BK, LDP = g.ld ? g.ld : g.K;
    unsigned voffA[2], voffB[2];
#pragma unroll
    for (int i = 0; i < 2; ++i) { int R, C; stage_rc(tid * 16 + i * 8192, R, C); const int Rb = Epi::PERM ? ((R & ~31) + perm32(R & 31)) : R;
        voffA[i] = (unsigned)(R * LDP + C) * 2u; voffB[i] = (unsigned)(Rb * LDP + C) * 2u; }
    const size_t kstep = (size_t)(BK * 2);
    const size_t hstep = (size_t)HALF * LDP * 2;
    const size_t tstep = 2 * hstep;
    const unsigned ldsw = (unsigned)wid * 1024u;
    const int aoff = lds_byte(wr * 64 + fr, fq * 8), boff = lds_byte(wc * 32 + fr, fq * 8);
#define PG8_SA(b, h) (((b) * 2 + (h)) * HTB)
#define PG8_SB(b, h) ((4 + (b) * 2 + (h)) * HTB)
#define PG8_STAGE(bufoff, gbase, voff) do { _Pragma("unroll") for (int _i = 0; _i < 2; ++_i) \
        __builtin_amdgcn_global_load_lds((const unsigned*)((const char*)(gbase) + (voff)[_i]), (PG8_LAS unsigned*)(lds + (bufoff) + ldsw + _i * 8192), 16, 0, 0); } while (0)
#define PG8_LDA(dst, b, h) do { _Pragma("unroll") for (int m = 0; m < 4; ++m) _Pragma("unroll") for (int k = 0; k < 2; ++k) dst[m][k] = *(const PG8_LAS bf16x8*)(lds + PG8_SA(b, h) + aoff + m * 2048 + k * 1024); } while (0)
#define PG8_LDB(dst, b, h) do { _Pragma("unroll") for (int n = 0; n < 2; ++n) _Pragma("unroll") for (int k = 0; k < 2; ++k) dst[n][k] = *(const PG8_LAS bf16x8*)(lds + PG8_SB(b, h) + boff + n * 2048 + k * 1024); } while (0)
#define PG8_MMA(ai, bj, At, Bt) do { __builtin_amdgcn_s_setprio(1); _Pragma("unroll") for (int m = 0; m < 4; ++m) _Pragma("unroll") for (int n = 0; n < 2; ++n) _Pragma("unroll") for (int k = 0; k < 2; ++k) \
        acc[ai][bj][m][n] = __builtin_amdgcn_mfma_f32_16x16x32_bf16(Bt[n][k], At[m][k], acc[ai][bj][m][n], 0, 0, 0); __builtin_amdgcn_s_setprio(0); } while (0)
#define PG8_WAIT_V(n) asm volatile("s_waitcnt vmcnt(" #n ")" ::: "memory")
#define PG8_WAIT_L(n) asm volatile("s_waitcnt lgkmcnt(" #n ")" ::: "memory")
#define PG8_BAR __builtin_amdgcn_s_barrier()
#define PG8_SCHED __builtin_amdgcn_sched_barrier(0)
    Unit cur, nxt; int ui = 0;
    if (!S.next(0, cur)) return;
    f32x4 acc[2][2][4][2];
#pragma unroll
    for (int a = 0; a < 2; ++a)
#pragma unroll
        for (int b = 0; b < 2; ++b)
#pragma unroll
            for (int m = 0; m < 4; ++m)
#pragma unroll
                for (int n = 0; n < 2; ++n) acc[a][b][m][n] = (f32x4){0.f, 0.f, 0.f, 0.f};
    bf16x8 At[4][2], B0[2][2], B1[2][2];
    const char* cA = (const char*)g.A + (size_t)cur.pm * tstep; const char* cB = (const char*)g.Bt + (size_t)cur.pn * tstep;
    S.a_ready(cur);
    if constexpr (SP2) {
        PG8_STAGE(PG8_SB(0, 0), cB, voffB); PG8_STAGE(PG8_SB(0, 1), cB + hstep, voffB); PG8_STAGE(PG8_SA(0, 0), cA, voffA); PG8_STAGE(PG8_SA(0, 1), cA + hstep, voffA);
        if (wr == 1) PG8_BAR;
        PG8_WAIT_V(2); PG8_BAR;
        PG8_STAGE(PG8_SB(1, 0), cB + kstep, voffB); PG8_STAGE(PG8_SA(1, 0), cA + kstep, voffA); PG8_STAGE(PG8_SB(1, 1), cB + hstep + kstep, voffB);
        PG8_WAIT_V(6); PG8_BAR;
    } else {
        PG8_STAGE(PG8_SB(0, 0), cB, voffB); PG8_STAGE(PG8_SA(0, 0), cA, voffA); PG8_STAGE(PG8_SB(0, 1), cB + hstep, voffB); PG8_STAGE(PG8_SA(0, 1), cA + hstep, voffA);
        if (wr == 1) PG8_BAR;
        PG8_WAIT_V(4); PG8_BAR;
        PG8_STAGE(PG8_SB(1, 0), cB + kstep, voffB); PG8_STAGE(PG8_SA(1, 0), cA + kstep, voffA); PG8_STAGE(PG8_SB(1, 1), cB + hstep + kstep, voffB);
        PG8_WAIT_V(6); PG8_BAR;
    }
    for (;;) {
        const bool has_next = S.next(ui + 1, nxt);
        const char* nA = has_next ? (const char*)g.A + (size_t)nxt.pm * tstep : cA; const char* nB = has_next ? (const char*)g.Bt + (size_t)nxt.pn * tstep : cB;
        for (int t = 0; t < nt; t += 2) {
            const bool last = (t == nt - 2);
            const char* a1 = cA + (size_t)(t + 1) * kstep;
            const char* a2 = last ? nA : cA + (size_t)(t + 2) * kstep; const char* b2 = last ? nB : cB + (size_t)(t + 2) * kstep;
            const char* a3 = a2 + kstep; const char* b3 = b2 + kstep;
            if (last && has_next) S.a_ready(nxt);
            if constexpr (SP2) {
            PG8_LDB(B0, 0, 0); PG8_LDB(B1, 0, 1); PG8_SCHED; PG8_LDA(At, 0, 0); PG8_STAGE(PG8_SA(1, 1), a1 + hstep, voffA);
            PG8_WAIT_V(8); PG8_WAIT_L(0); PG8_BAR; PG8_MMA(0, 0, At, B0); PG8_MMA(0, 1, At, B1); PG8_BAR; PG8_SCHED;
            PG8_LDA(At, 0, 1); PG8_STAGE(PG8_SB(0, 0), b2, voffB); PG8_STAGE(PG8_SB(0, 1), b2 + hstep, voffB); PG8_STAGE(PG8_SA(0, 0), a2, voffA);
            PG8_WAIT_V(8); PG8_WAIT_L(0); PG8_BAR; PG8_MMA(1, 0, At, B0); PG8_MMA(1, 1, At, B1); PG8_BAR; PG8_SCHED;
            PG8_LDB(B0, 1, 0); PG8_LDB(B1, 1, 1); PG8_SCHED; PG8_LDA(At, 1, 0); PG8_STAGE(PG8_SA(0, 1), a2 + hstep, voffA);
            PG8_WAIT_V(8); PG8_WAIT_L(0); PG8_BAR; PG8_MMA(0, 0, At, B0); PG8_MMA(0, 1, At, B1); PG8_BAR; PG8_SCHED;
            PG8_LDA(At, 1, 1); PG8_STAGE(PG8_SB(1, 0), b3, voffB); PG8_STAGE(PG8_SB(1, 1), b3 + hstep, voffB); PG8_STAGE(PG8_SA(1, 0), a3, voffA);
            PG8_WAIT_V(8); PG8_WAIT_L(0); PG8_BAR; PG8_MMA(1, 0, At, B0); PG8_MMA(1, 1, At, B1); PG8_BAR; PG8_SCHED;
            } else {
            PG8_LDB(B0, 0, 0); PG8_SCHED; PG8_LDA(At, 0, 0); PG8_STAGE(PG8_SA(1, 1), a1 + hstep, voffA);
            PG8_WAIT_L(8); PG8_BAR; PG8_WAIT_L(0); PG8_MMA(0, 0, At, B0); PG8_BAR; PG8_SCHED;
            PG8_LDB(B1, 0, 1); PG8_STAGE(PG8_SB(0, 0), b2, voffB);
            PG8_BAR; PG8_WAIT_L(0); PG8_MMA(0, 1, At, B1); PG8_BAR;
            PG8_LDA(At, 0, 1); PG8_STAGE(PG8_SA(0, 0), a2, voffA);
            PG8_BAR; PG8_WAIT_L(0); PG8_MMA(1, 0, At, B0); PG8_BAR; PG8_SCHED;
            PG8_STAGE(PG8_SB(0, 1), b2 + hstep, voffB);
            PG8_WAIT_V(6); PG8_BAR; PG8_MMA(1, 1, At, B1); PG8_BAR;
            PG8_LDB(B0, 1, 0); PG8_SCHED; PG8_LDA(At, 1, 0); PG8_STAGE(PG8_SA(0, 1), a2 + hstep, voffA);
            PG8_WAIT_L(8); PG8_BAR; PG8_WAIT_L(0); PG8_MMA(0, 0, At, B0); PG8_BAR; PG8_SCHED;
            PG8_LDB(B1, 1, 1); PG8_STAGE(PG8_SB(1, 0), b3, voffB);
            PG8_BAR; PG8_WAIT_L(0); PG8_MMA(0, 1, At, B1); PG8_BAR;
            PG8_LDA(At, 1, 1); PG8_STAGE(PG8_SA(1, 0), a3, voffA);
            PG8_BAR; PG8_WAIT_L(0); PG8_MMA(1, 0, At, B0); PG8_BAR; PG8_SCHED;
            PG8_STAGE(PG8_SB(1, 1), b3 + hstep, voffB);
            PG8_WAIT_V(6); PG8_BAR; PG8_MMA(1, 1, At, B1); PG8_BAR;
            }
        }
        if constexpr (ALIGN_EPI) { if (wr == 0) PG8_BAR; }
        if constexpr (!Epi::AFTER_DRAIN) { E(acc, cur, wr, wc, fr, fq); S.done(cur); }
        if (!has_next) break;
#pragma unroll
        for (int a = 0; a < 2; ++a)
#pragma unroll
            for (int b = 0; b < 2; ++b)
#pragma unroll
                for (int m = 0; m < 4; ++m)
#pragma unroll
                    for (int n = 0; n < 2; ++n) acc[a][b][m][n] = (f32x4){0.f, 0.f, 0.f, 0.f};
        cur = nxt; cA = nA; cB = nB; ++ui;
        if constexpr (ALIGN_EPI) { if (wr == 1) PG8_BAR; }
    }
    PG8_WAIT_V(0);
    if constexpr (!ALIGN_EPI) { if (wr == 0) PG8_BAR; }
    PG8_BAR;
    if constexpr (Epi::AFTER_DRAIN) { E.fused(acc, cur, wr, wc, fr, fq, lds, wid, lane); S.done(cur); }
#undef PG8_SA
#undef PG8_SB
#undef PG8_STAGE
#undef PG8_LDA
#undef PG8_LDB
#undef PG8_MMA
#undef PG8_WAIT_V
#undef PG8_WAIT_L
#undef PG8_BAR
#undef PG8_SCHED
}
}
#define GAS __attribute__((address_space(1)))
#define LAS __attribute__((address_space(3)))
typedef unsigned short bf16;
typedef unsigned v4u __attribute__((ext_vector_type(4)));
typedef float f32x4 __attribute__((ext_vector_type(4)));
typedef short bf16x8 __attribute__((ext_vector_type(8)));
typedef GAS unsigned gu32;
typedef GAS unsigned long long gu64;
#define RLX_AGENT __ATOMIC_RELAXED, __HIP_MEMORY_SCOPE_AGENT
#define LDS_WAIT() asm volatile("s_waitcnt lgkmcnt(0)" ::: "memory")
#define VM_WAIT() asm volatile("s_waitcnt vmcnt(0)" ::: "memory")
__device__ __forceinline__ unsigned long long rt() { return __builtin_amdgcn_s_memrealtime(); }
__device__ __forceinline__ unsigned f2bf(float f) { unsigned u = __builtin_bit_cast(unsigned, f); return (u + 0x7fffu + ((u >> 16) & 1u)) >> 16; }
__device__ __forceinline__ unsigned pk2(float lo, float hi) { return f2bf(lo) | (f2bf(hi) << 16); }

#define XB_TMO      128
#define XB_XCNT(j)  (256  + 64 * (j))
#define XB_XSUB(j)  (1280 + 64 * (j))
#define XB_XGEN(j)  (2304 + 64 * (j))
#define XB_TOP      3328
#define XB_TOPGEN   3392
#define XCD_BAR_WORDS 3456
#define XB_SPIN_CAP (1u << 18)

__device__ __forceinline__ unsigned xb_ld(unsigned* p)              { return __hip_atomic_load(p, __ATOMIC_RELAXED, __HIP_MEMORY_SCOPE_AGENT); }
__device__ __forceinline__ unsigned xb_add(unsigned* p, unsigned v) { return __hip_atomic_fetch_add(p, v, __ATOMIC_RELAXED, __HIP_MEMORY_SCOPE_AGENT); }
__device__ __forceinline__ unsigned xb_xcc_id() { return (unsigned)__builtin_amdgcn_s_getreg((3 << 11) | 20) & 0xFu; }
#define XB_SPIN(cond, bar) do { unsigned _sp = 0; while (cond) { __builtin_amdgcn_s_sleep(1); \
    if ((++_sp & 255u) == 0u) { if (xb_ld(&(bar)[XB_TMO])) break; if (_sp > XB_SPIN_CAP) { atomicAdd(&(bar)[XB_TMO], 1u); break; } } } } while (0)

struct XcdBarrier {
    unsigned* bar; unsigned x;
    volatile LAS unsigned* st;
};

__device__ __forceinline__ XcdBarrier xcd_barrier_post(unsigned* bar, volatile LAS unsigned* st) {
    XcdBarrier b; b.bar = bar; b.x = xb_xcc_id(); b.st = st;
    if (threadIdx.x == 0) (void)xb_add(&bar[XB_XCNT(b.x)], 1u);
    return b;
}
__device__ __forceinline__ void xcd_barrier_complete(unsigned* bar, unsigned x, unsigned& nloc, unsigned& nx) {
    const unsigned G = gridDim.x * gridDim.y * gridDim.z;
    unsigned sum, cnt, mine, sp = 0u;
    for (;;) {
        sum = 0u; cnt = 0u; mine = 0u;
#pragma unroll
        for (unsigned j = 0; j < 16; ++j) { const unsigned c = xb_ld(&bar[XB_XCNT(j)]); sum += c; cnt += (c > 0u) ? 1u : 0u; mine = (j == x) ? c : mine; }
        if (sum == G) break;
        __builtin_amdgcn_s_sleep(1);
        if ((++sp & 255u) == 0u) { if (xb_ld(&bar[XB_TMO])) break; if (sp > XB_SPIN_CAP) { atomicAdd(&bar[XB_TMO], 1u); break; } }
    }
    nloc = mine > 0u ? mine : 1u; nx = cnt > 0u ? cnt : 1u;
}

__device__ __forceinline__ void xcd_barrier(const XcdBarrier& b) {
    asm volatile("s_waitcnt vmcnt(0)" ::: "memory");
    __syncthreads();
    if (threadIdx.x == 0) {
        unsigned* bar = b.bar;
        __builtin_amdgcn_s_waitcnt(0);
        unsigned nloc = b.st[0], nx = b.st[1];
        if (nloc == 0u) { xcd_barrier_complete(bar, b.x, nloc, nx); b.st[0] = nloc; b.st[1] = nx; }
        const unsigned old = xb_add(&bar[XB_XSUB(b.x)], 1u);
        const unsigned gen = old / nloc;
        if (old + 1u == (gen + 1u) * nloc) {
            __builtin_amdgcn_fence(__ATOMIC_RELEASE, "agent");
            asm volatile("s_waitcnt vmcnt(0)" ::: "memory");
            const unsigned og = xb_add(&bar[XB_TOP], 1u);
            const unsigned tg = og / nx;
            if (og + 1u == (tg + 1u) * nx) xb_add(&bar[XB_TOPGEN], 1u);
            else XB_SPIN(xb_ld(&bar[XB_TOPGEN]) == tg, bar);
            __builtin_amdgcn_fence(__ATOMIC_ACQUIRE, "agent");
            xb_add(&bar[XB_XGEN(b.x)], 1u);
            asm volatile("s_waitcnt vmcnt(0)" ::: "memory");
        } else {
            XB_SPIN(xb_ld(&bar[XB_XGEN(b.x)]) == gen, bar);
            __builtin_amdgcn_fence(__ATOMIC_ACQUIRE, "agent");
            asm volatile("s_waitcnt vmcnt(0)" ::: "memory");
        }
    }
    __syncthreads();
}

constexpr int NWAVES = 8;
#ifndef MK_N_LAUNCHES
#define MK_N_LAUNCHES 1
#endif
constexpr int PER_PHASE = 11;
constexpr int N_LAUNCHES = MK_N_LAUNCHES;

constexpr int BATCH = 16, SEQ = 2048, D = 1024, HD = 64, NH = 8, FF = 2816;
constexpr int M = BATCH * SEQ;
constexpr int SBW = 512, RWW = 512, RWP = 1792, PW = 3328, LORA_K = 256, LORA_N = 1536;
constexpr float LNX_EPS = 64e-5f;

constexpr size_t MiB = 1u << 20;
constexpr size_t WS_CTL = 0, CTL_ZERO_BYTES = 1 * MiB;
constexpr size_t WS_SSQ = 1 * MiB;
constexpr size_t WS_W1U = 4 * MiB;
constexpr size_t WS_W1D = 15 * MiB;
constexpr size_t WS_W2U = 21 * MiB;
constexpr size_t WS_W2D = 32 * MiB;
constexpr size_t WS_WIN = 38 * MiB;
constexpr size_t WS_WOUT = 45 * MiB;
constexpr size_t WS_WLORA = 47 * MiB;
constexpr size_t WS_XB = 48 * MiB;
constexpr size_t WS_ACT = 112 * MiB;
constexpr size_t WS_QO = 112 * MiB;
constexpr size_t WS_KB = 176 * MiB;
constexpr size_t WS_VB = 208 * MiB;
constexpr size_t WS_RW = 240 * MiB;
constexpr size_t WS_ALORA = 352 * MiB;
constexpr size_t WS_LW = 368 * MiB;
constexpr size_t WS_AB = 432 * MiB;
constexpr size_t WS_GB = 464 * MiB;
constexpr size_t WS_TAIL = 496 * MiB;
constexpr size_t WS_END = 512 * MiB;
constexpr int CW_TMO = 0, CW_CODE = 1;
constexpr int CW_BAR = 4096;
constexpr int CW_QUEUE = 16384;

constexpr int RING_OFF = 0, RING_BYTES = 155648;
constexpr int LDSCTL_OFF = RING_BYTES, MISC_OFF = LDSCTL_OFF;
constexpr int LDS_BYTES = 163840;

struct Frame {
    LAS unsigned char* lds;
    volatile LAS unsigned* MISC;
    gu32* ctl;
    int tid, lane, wave;
    int vcu, G;
};
typedef unsigned u32x2g __attribute__((ext_vector_type(2)));
__device__ __forceinline__ float bf2f(unsigned short h) { return __uint_as_float(((unsigned)h) << 16); }
typedef float f32x2h __attribute__((ext_vector_type(2))); typedef __bf16 bf16x2h __attribute__((ext_vector_type(2)));
__device__ __forceinline__ unsigned pkbf(float lo, float hi) { f32x2h v = {lo, hi}; bf16x2h b = __builtin_convertvector(v, bf16x2h); return __builtin_bit_cast(unsigned, b); }
__device__ __forceinline__ float bflo(unsigned w) { return __uint_as_float(w << 16); }
__device__ __forceinline__ float bfhi(unsigned w) { return __uint_as_float(w & 0xffff0000u); }
__device__ __forceinline__ float wave_sum(float v) {
#pragma unroll
    for (int o = 1; o < 64; o <<= 1) v += __shfl_xor(v, o);
    return v;
}
#define DPP_ADD(v, ctrl) ((v) + __int_as_float(__builtin_amdgcn_update_dpp(0, __float_as_int(v), (ctrl), 0xF, 0xF, true)))
__device__ __forceinline__ float sum8(float v) { v = DPP_ADD(v, 0xB1); v = DPP_ADD(v, 0x4E); v = DPP_ADD(v, 0x141); return v; }

struct TItem { const float* W; int ldw, k0, n0; const float* sc; bf16* WT; int Kd, rho0; };
__device__ __forceinline__ void ti_load(const TItem& T, float (&t)[32], int lane) {
#pragma unroll
    for (int i = 0; i < 32; ++i) t[i] = T.W[(size_t)(T.k0 + 2 * i + (lane >> 5)) * T.ldw + T.n0 + (lane & 31)];
}
__device__ __forceinline__ void ti_finish(const TItem& T, const float (&t)[32], LAS float* scr, int lane) {
#pragma unroll
    for (int i = 0; i < 32; ++i) scr[(2 * i + (lane >> 5)) * 33 + (lane & 31)] = t[i];
    LDS_WAIT(); asm volatile("" ::: "memory");
    const int c = lane & 7;
    f32x4 s0 = (f32x4){1.f, 1.f, 1.f, 1.f}, s1 = s0;
    if (T.sc) { s0 = *(const f32x4*)(T.sc + T.k0 + 8 * c); s1 = *(const f32x4*)(T.sc + T.k0 + 8 * c + 4); }
#pragma unroll
    for (int j = 0; j < 4; ++j) { const int n = (lane >> 3) + 8 * j; const LAS float* s = scr + (8 * c) * 33 + n;
        v4u o; o.x = pkbf(s[0 * 33] * s0.x, s[1 * 33] * s0.y); o.y = pkbf(s[2 * 33] * s0.z, s[3 * 33] * s0.w); o.z = pkbf(s[4 * 33] * s1.x, s[5 * 33] * s1.y); o.w = pkbf(s[6 * 33] * s1.z, s[7 * 33] * s1.w);
        *(GAS v4u*)(T.WT + (size_t)(T.rho0 + n) * T.Kd + T.k0 + 8 * c) = o; }
    LDS_WAIT(); asm volatile("" ::: "memory");
}
#define P0_PTRS const float* Ax, const float* An1, const float* Ag1, const float* Au1, const float* Ad1, const float* Anm, const float* Awin, const float* Aw2, const float* Aa2, const float* Ag2, const float* Awout, \
    const float* An2, const float* Ag2f, const float* Au2f, const float* Ad2f, bf16* AW1U, bf16* AW1D, bf16* AW2U, bf16* AW2D, bf16* AWIN, bf16* AWOUT, bf16* AWLORA, bf16* AXB, float* ASSQ
__device__ __forceinline__ void p0_items(Frame& F, P0_PTRS, int set, int gw, int NGW) {
    LAS float* scr = (LAS float*)(F.lds + RING_OFF + F.wave * 16384);
    constexpr int I_UP = 16 * 176, I_DN = 44 * 32, I_IN = 16 * 104, I_OUT = 16 * 32;
    const int NITEMS = set ? (I_UP + I_DN) : (I_UP + I_DN + I_IN + I_OUT);
#define P0_DECODE(it_, T) do { int r = (it_); const int l2 = set; \
        if (r < I_UP) { const int kb = r / 176, nb = r % 176, rho0 = 32 * nb, pn = rho0 >> 8, bj = (rho0 >> 7) & 1, j0 = rho0 & 127; \
            T = TItem{l2 ? (bj ? Au2f : Ag2f) : (bj ? Au1 : Ag1), FF, 64 * kb, 128 * pn + j0, l2 ? An2 : An1, l2 ? AW2U : AW1U, D, rho0}; } \
        else if ((r -= I_UP) < I_DN) { const int kb = r / 32, nb = r % 32; \
            T = TItem{l2 ? Ad2f : Ad1, D, 64 * kb, 32 * nb, nullptr, l2 ? AW2D : AW1D, FF, 32 * nb}; } \
        else if ((r -= I_DN) < I_IN) { const int kb = r / 104, nb = r % 104, rho0 = 32 * nb, pn = rho0 >> 8, rem = rho0 & 255, bj = rem >> 7, wc = (rem & 127) >> 5; \
            T = TItem{Awin, PW, 64 * kb, 256 * pn + 64 * wc + 32 * bj, Anm, AWIN, D, rho0}; } \
        else { r -= I_IN; const int kb = r / 32, nb = r % 32; T = TItem{Awout, D, 64 * kb, 32 * nb, nullptr, AWOUT, D, 32 * nb}; } } while (0)
    for (int it = gw; it < NITEMS; it += 2 * NGW) {
        TItem T0, T1; float t0[32], t1[32]; const bool two = (it + NGW < NITEMS);
        P0_DECODE(it, T0); ti_load(T0, t0, F.lane);
        if (two) { P0_DECODE(it + NGW, T1); ti_load(T1, t1, F.lane); }
        ti_finish(T0, t0, scr, F.lane);
        if (two) ti_finish(T1, t1, scr, F.lane);
    }
#undef P0_DECODE
}
__device__ __forceinline__ void p0_prologue(Frame& F, P0_PTRS) {
    const int gw = F.vcu * NWAVES + F.wave, NGW = F.G * NWAVES;
    p0_items(F, Ax, An1, Ag1, Au1, Ad1, Anm, Awin, Aw2, Aa2, Ag2, Awout, An2, Ag2f, Au2f, Ad2f, AW1U, AW1D, AW2U, AW2D, AWIN, AWOUT, AWLORA, AXB, ASSQ, (F.G >= 256) ? 0 : 0, gw, NGW);
    if (F.G < 256) p0_items(F, Ax, An1, Ag1, Au1, Ad1, Anm, Awin, Aw2, Aa2, Ag2, Awout, An2, Ag2f, Au2f, Ad2f, AW1U, AW1D, AW2U, AW2D, AWIN, AWOUT, AWLORA, AXB, ASSQ, 1, gw, NGW);
    for (int it = F.vcu * (NWAVES * 64) + F.tid; it < 512 * 32; it += F.G * NWAVES * 64) {
        int ch, kc, Kk; const float* src; bf16* dst;
        if (it < 512 * 8) { ch = it >> 3; kc = (it & 7) * 8; Kk = 64; src = Aw2; dst = AWLORA; }
        else if (it < 512 * 16) { const int i2 = it - 512 * 8; ch = i2 >> 3; kc = (i2 & 7) * 8; Kk = 64; src = Aa2; dst = AWLORA + 512 * 64; }
        else { const int i2 = it - 512 * 16; ch = i2 >> 4; kc = (i2 & 15) * 8; Kk = 128; src = Ag2; dst = AWLORA + 2 * 512 * 64; }
        float v[8];
#pragma unroll
        for (int j = 0; j < 8; ++j) v[j] = src[(size_t)(kc + j) * 512 + ch];
        v4u o; o.x = pkbf(v[0], v[1]); o.y = pkbf(v[2], v[3]); o.z = pkbf(v[4], v[5]); o.w = pkbf(v[6], v[7]);
        *(GAS v4u*)(dst + (size_t)ch * Kk + kc) = o;
    }
    for (int mb = gw; mb < M; mb += 4 * NGW) {
        f32x4 v[4][4]; float s[4];
#pragma unroll
        for (int q = 0; q < 4; ++q) { const int m = mb + q * NGW; const GAS f32x4* xr = (const GAS f32x4*)(Ax + (size_t)(m < M ? m : mb) * D) + F.lane;
#pragma unroll
            for (int j = 0; j < 4; ++j) v[q][j] = xr[64 * j]; }
#pragma unroll
        for (int q = 0; q < 4; ++q) { float a = 0.f;
#pragma unroll
            for (int j = 0; j < 4; ++j) a += (v[q][j].x * v[q][j].x + v[q][j].y * v[q][j].y) + (v[q][j].z * v[q][j].z + v[q][j].w * v[q][j].w);
            s[q] = a; }
#pragma unroll
        for (int o = 1; o < 64; o <<= 1) {
#pragma unroll
            for (int q = 0; q < 4; ++q) s[q] += __shfl_xor(s[q], o); }
#pragma unroll
        for (int q = 0; q < 4; ++q) { const int m = mb + q * NGW; if (m < M) {
            GAS unsigned long long* o8 = (GAS unsigned long long*)(AXB + (size_t)m * D) + F.lane;
#pragma unroll
            for (int j = 0; j < 4; ++j) o8[64 * j] = (unsigned long long)pkbf(v[q][j].x, v[q][j].y) | ((unsigned long long)pkbf(v[q][j].z, v[q][j].w) << 32);
            if (F.lane < 16) ASSQ[(size_t)m * 16 + F.lane] = (F.lane == 0) ? s[q] : 0.f; } }
    }
}

struct RwArgs { const bf16* RW; const bf16* W2T; const bf16* A2T; const bf16* G2T; const float* w0; const float* a0; bf16* QO; const float *mu, *k_k, *k_a, *r_k, *ln_w, *ln_b; };
__device__ __forceinline__ void ld8bf(const bf16* p, float (&o)[8]) { const v4u w = *(const v4u*)p; o[0] = bflo(w.x); o[1] = bfhi(w.x); o[2] = bflo(w.y); o[3] = bfhi(w.y); o[4] = bflo(w.z); o[5] = bfhi(w.z); o[6] = bflo(w.w); o[7] = bfhi(w.w); }
__device__ __forceinline__ void ld8f(const float* p, float (&o)[8]) { const f32x4 a = *(const f32x4*)p, b = *(const f32x4*)(p + 4); o[0] = a.x; o[1] = a.y; o[2] = a.z; o[3] = a.w; o[4] = b.x; o[5] = b.y; o[6] = b.z; o[7] = b.w; }
__device__ __forceinline__ void ld8l(const LAS float* p, float (&o)[8]) { const f32x4 a = *(const LAS f32x4*)p, b = *(const LAS f32x4*)(p + 4); o[0] = a.x; o[1] = a.y; o[2] = a.z; o[3] = a.w; o[4] = b.x; o[5] = b.y; o[6] = b.z; o[7] = b.w; }
__device__ __forceinline__ void st8l(LAS float* p, const float (&o)[8]) { *(LAS f32x4*)p = (f32x4){o[0], o[1], o[2], o[3]}; *(LAS f32x4*)(p + 4) = (f32x4){o[4], o[5], o[6], o[7]}; }
namespace rwk {
typedef short bf16x8 __attribute__((ext_vector_type(8)));
typedef short s16x4 __attribute__((ext_vector_type(4)));
typedef short v4i16_t __attribute__((ext_vector_type(4)));
constexpr int SLOT = 8192;
#define RSL(s) (lds + (s) * SLOT)
#define RMFMA(a, b, c) __builtin_amdgcn_mfma_f32_16x16x32_bf16((a), (b), (c), 0, 0, 0)
__device__ __forceinline__ int swz(int row, int cb) { return row * 128 + (cb ^ ((row & 7) << 4)); }
struct Fr2 { bf16x8 k0, k1; };
__device__ __forceinline__ Fr2 ldf(const LAS unsigned char* base, int off) { Fr2 f; f.k0 = *(const LAS bf16x8*)(base + off); f.k1 = *(const LAS bf16x8*)(base + (off ^ 64)); return f; }
__device__ __forceinline__ s16x4 trd(const LAS unsigned char* p) { return __builtin_bit_cast(s16x4, __builtin_amdgcn_ds_read_tr16_b64_v4i16((LAS v4i16_t*)p)); }
__device__ __forceinline__ Fr2 ldt(const LAS unsigned char* base, int o0, int o1) {
    const s16x4 a = trd(base + o0), b = trd(base + o1), c = trd(base + o0 + 4096), d = trd(base + o1 + 4096);
    Fr2 f; f.k0 = (bf16x8){a[0], a[1], a[2], a[3], b[0], b[1], b[2], b[3]}; f.k1 = (bf16x8){c[0], c[1], c[2], c[3], d[0], d[1], d[2], d[3]}; return f; }
template <bool SWAP> __device__ __forceinline__ f32x4 mm(const Fr2& a, const Fr2& b, f32x4 c) {
    if (SWAP) { c = RMFMA(b.k0, a.k0, c); c = RMFMA(b.k1, a.k1, c); } else { c = RMFMA(a.k0, b.k0, c); c = RMFMA(a.k1, b.k1, c); } return c; }
__device__ __forceinline__ void st4(LAS unsigned char* slot, int off, f32x4 v) { u32x2g w; w.x = pkbf(v[0], v[1]); w.y = pkbf(v[2], v[3]); *(LAS u32x2g*)(slot + off) = w; }
__device__ __forceinline__ f32x4 ld4(const LAS unsigned char* slot, int off) { const u32x2g w = *(const LAS u32x2g*)(slot + off); return (f32x4){bflo(w.x), bfhi(w.x), bflo(w.y), bfhi(w.y)}; }
#define LBAR() asm volatile("s_waitcnt lgkmcnt(0)\n\ts_barrier" ::: "memory")
#define DPPF(x, ctrl, rmask) __int_as_float(__builtin_amdgcn_update_dpp(0, __float_as_int(x), (ctrl), (rmask), 0xF, true))
__device__ __forceinline__ float wave_scan(float x) {
    x += DPPF(x, 0x111, 0xF); x += DPPF(x, 0x112, 0xF); x += DPPF(x, 0x114, 0xF); x += DPPF(x, 0x118, 0xF);
    x += DPPF(x, 0x142, 0xA);
    x += DPPF(x, 0x143, 0xC);
    return x; }
__device__ __forceinline__ void unp8(const v4u w, float (&o)[8]) { o[0] = bflo(w.x); o[1] = bfhi(w.x); o[2] = bflo(w.y); o[3] = bfhi(w.y); o[4] = bflo(w.z); o[5] = bfhi(w.z); o[6] = bflo(w.w); o[7] = bfhi(w.w); }
__device__ __forceinline__ v4u pk8(const float (&o)[8]) { return (v4u){pkbf(o[0], o[1]), pkbf(o[2], o[3]), pkbf(o[4], o[5]), pkbf(o[6], o[7])}; }
}
struct RwX { bf16* P1; bf16* GT; bf16* Y0; bf16* H; bf16* VB0; bf16* VB1; float* GE; bf16* G; };
__device__ __forceinline__ void p6a_rwkv_local(Frame& F, const RwArgs& A, const RwX& X) {
    using namespace rwk;
    LAS unsigned char* lds = F.lds + RING_OFF;
    LAS float* part = (LAS float*)(F.lds + LDSCTL_OFF + 128);
    LAS float* cst = (LAS float*)(F.lds + LDSCTL_OFF + 128 + 4096 + 896);
    const int lane = F.lane, fr = lane & 15, fq = lane >> 4, w = F.wave, m0 = 16 * (w >> 1), n0a = 32 * (w & 1);
    const int fm = swz(m0 + fr, fq * 16);
    const int ta0 = swz(8 * fq + (fr >> 2), 2 * (m0 + 4 * (fr & 3))), ta1 = swz(8 * fq + 4 + (fr >> 2), 2 * (m0 + 4 * (fr & 3)));
    int fn[2], orm[2], otr[2], tb0[2], tb1[2];
#pragma unroll
    for (int t = 0; t < 2; ++t) { const int n0 = n0a + 16 * t; fn[t] = swz(n0 + fr, fq * 16); orm[t] = swz(m0 + fr, 2 * (n0 + 4 * fq)); otr[t] = swz(n0 + fr, 2 * (m0 + 4 * fq));
        tb0[t] = swz(8 * fq + (fr >> 2), 2 * (n0 + 4 * (fr & 3))); tb1[t] = swz(8 * fq + 4 + (fr >> 2), 2 * (n0 + 4 * (fr & 3))); }
    const int NJ = BATCH * NH * (SEQ / 64);
    const int tid = F.tid, ltok = tid >> 3, ldg = tid & 7;
    v4u g_r, g_k, g_v, g_xw, g_xa, g_xg0, g_xg1, g_pr;
#define P6A_LOAD(jj) do { const int u_ = (jj) >> 5, c_ = (jj) & 31; const size_t gr_ = (size_t)(u_ >> 3) * SEQ + c_ * 64 + ltok; const int cb_ = 64 * (u_ & 7) + 8 * ldg; const bf16* rp_ = A.RW + gr_ * RWP; \
        g_r = *(const v4u*)(rp_ + cb_); g_k = *(const v4u*)(rp_ + 512 + cb_); g_v = *(const v4u*)(rp_ + 1024 + cb_); \
        g_xw = *(const v4u*)(rp_ + 1536 + 8 * ldg); g_xa = *(const v4u*)(rp_ + 1600 + 8 * ldg); g_xg0 = *(const v4u*)(rp_ + 1664 + 8 * ldg); g_xg1 = *(const v4u*)(rp_ + 1728 + 8 * ldg); \
        g_pr = (v4u){0u, 0u, 0u, 0u}; if (ltok < 7 && c_ > 0) g_pr = *(const v4u*)(A.RW + ((size_t)(u_ >> 3) * SEQ + c_ * 64 - 1) * RWP + (ltok < 3 ? 512 * ltok + cb_ : 1536 + 64 * (ltok - 3) + 8 * ldg)); } while (0)
    if ((int)blockIdx.x < NJ) P6A_LOAD((int)blockIdx.x);
    int hcur = -1;
    LAS unsigned char* prow = (LAS unsigned char*)(F.lds + LDSCTL_OFF + 128 + 4096);
    if (tid < 256) cst[512 + tid] = A.mu[1536 + tid];
    u32x2g s_p1[2], s_gt[2], s_y0[2], s_hh[2]; size_t s_jo = 0; bool s_have = false;
#define P6A_STORE() do { _Pragma("unroll") for (int t = 0; t < 2; ++t) { \
            *(u32x2g*)(X.P1 + s_jo + ((w * 2 + t) * 64 + lane) * 4) = s_p1[t]; *(u32x2g*)(X.GT + s_jo + ((w * 2 + t) * 64 + lane) * 4) = s_gt[t]; \
            *(u32x2g*)(X.Y0 + s_jo + ((w * 2 + t) * 64 + lane) * 4) = s_y0[t]; *(u32x2g*)(X.H + s_jo + ((w * 2 + t) * 64 + lane) * 4) = s_hh[t]; } } while (0)
    for (int job = blockIdx.x; job < NJ; job += F.G) {
        const int unit = job >> 5, c = job & 31; const int h = unit & 7; const int cb = 64 * h + 8 * w; const size_t jo = (size_t)job * 4096;
        {
            const int so = swz(ltok, 16 * ldg);
            *(LAS v4u*)(RSL(12) + so) = g_r; *(LAS v4u*)(RSL(2) + so) = g_k; *(LAS v4u*)(RSL(0) + so) = g_v;
            *(LAS v4u*)(RSL(14) + so) = g_xw; *(LAS v4u*)(RSL(13) + so) = g_xa; *(LAS v4u*)(RSL(10) + so) = g_xg0; *(LAS v4u*)(RSL(11) + so) = g_xg1;
            if (ltok < 7) *(LAS v4u*)(prow + ltok * 128 + 16 * ldg) = g_pr;
            if (h != hcur) {
                *(LAS v4u*)(RSL(16) + so) = *(const v4u*)(A.W2T + (size_t)(64 * h + ltok) * 64 + 8 * ldg); *(LAS v4u*)(RSL(17) + so) = *(const v4u*)(A.A2T + (size_t)(64 * h + ltok) * 64 + 8 * ldg);
                { const int a_ = tid >> 6, i_ = tid & 63;
                  const float* src_ = (a_ == 0) ? A.mu : (a_ == 1) ? A.mu + 512 : (a_ == 2) ? A.mu + 1024 : (a_ == 3) ? A.k_k : (a_ == 4) ? A.k_a : (a_ == 5) ? A.r_k : (a_ == 6) ? A.w0 : A.a0;
                  cst[a_ * 64 + i_] = src_[64 * h + i_]; } }
            hcur = h;
        }
        if (s_have) P6A_STORE();
        { const int nj = job + F.G; if (nj < NJ) P6A_LOAD(nj); }
        LBAR();
        float r[8], k[8], v[8];
        {
            const int so = swz(lane, 16 * w), sp = swz((lane + 63) & 63, 16 * w);
#define P6A_SHIFT(slot, pi, moff, dst) do { float c_[8], p_[8], m_[8]; v4u wc_ = *(const LAS v4u*)(RSL(slot) + so), wp_ = *(const LAS v4u*)(RSL(slot) + sp); \
                if (lane == 0) wp_ = *(const LAS v4u*)(prow + 128 * (pi) + 16 * w); \
                unp8(wc_, c_); unp8(wp_, p_); ld8l(cst + (moff) + 8 * w, m_); \
                _Pragma("unroll") for (int j = 0; j < 8; ++j) dst[j] = c_[j] + (p_[j] - c_[j]) * m_[j]; } while (0)
            P6A_SHIFT(12, 0, 0, r);
            P6A_SHIFT(2, 1, 64, k);
            P6A_SHIFT(0, 2, 128, v); asm volatile("" ::: "memory");
            { float x_[8]; P6A_SHIFT(14, 3, 512, x_);
#pragma unroll
              for (int j = 0; j < 8; ++j) x_[j] = 2.0f * pg8::sigmoid_f(2.0f * x_[j]) - 1.0f;
              *(LAS v4u*)(RSL(14) + so) = pk8(x_); }
            { float x_[8]; P6A_SHIFT(13, 4, 576, x_); *(LAS v4u*)(RSL(13) + so) = pk8(x_); } asm volatile("" ::: "memory");
            { float x_[8]; P6A_SHIFT(10, 5, 640, x_);
#pragma unroll
              for (int j = 0; j < 8; ++j) x_[j] = pg8::sigmoid_f(x_[j]);
              *(LAS v4u*)(RSL(10) + so) = pk8(x_); }
            { float x_[8]; P6A_SHIFT(11, 6, 704, x_);
#pragma unroll
              for (int j = 0; j < 8; ++j) x_[j] = pg8::sigmoid_f(x_[j]);
              *(LAS v4u*)(RSL(11) + so) = pk8(x_); }
#undef P6A_SHIFT
        }
        LBAR();
        {
            const f32x4 z4 = (f32x4){0.f, 0.f, 0.f, 0.f};
            bf16x8 gq[2][4];
#pragma unroll
            for (int t = 0; t < 2; ++t) { const bf16* gp = A.G2T + (size_t)(64 * h + n0a + 16 * t + fr) * 128 + 8 * fq;
#pragma unroll
                for (int q = 0; q < 4; ++q) gq[t][q] = *reinterpret_cast<const bf16x8*>(gp + 32 * q); }
            {   const Fr2 aW = ldf(RSL(14), fm), aA = ldf(RSL(13), fm); Fr2 bW[2], bA[2];
#pragma unroll
                for (int t = 0; t < 2; ++t) { bW[t] = ldf(RSL(16), fn[t]); bA[t] = ldf(RSL(17), fn[t]); }
#pragma unroll
                for (int t = 0; t < 2; ++t) { const int row = m0 + fr, ch = n0a + 16 * t + 4 * fq; const f32x4 lwq = mm<true>(aW, bW[t], z4), alq = mm<true>(aA, bA[t], z4);
                    const f32x4 w0c = *(const LAS f32x4*)(cst + 384 + ch), a0c = *(const LAS f32x4*)(cst + 448 + ch); f32x4 lwv, alv;
#pragma unroll
                    for (int x = 0; x < 4; ++x) { lwv[x] = -0.6065306597126334f * pg8::sigmoid_f(w0c[x] + lwq[x]); alv[x] = pg8::sigmoid_f(a0c[x] + alq[x]); }
                    const int fo = row * 256 + (((ch >> 3) ^ (row & 7)) << 5) + ((ch >> 2) & 1) * 16;
                    *(LAS f32x4*)(RSL(4) + fo) = lwv; *(LAS f32x4*)(RSL(8) + fo) = alv; } }
            asm volatile("" ::: "memory");
            {   const Fr2 aG0 = ldf(RSL(10), fm), aG1 = ldf(RSL(11), fm);
#pragma unroll
                for (int t = 0; t < 2; ++t) { Fr2 bG0, bG1; bG0.k0 = gq[t][0]; bG0.k1 = gq[t][1]; bG1.k0 = gq[t][2]; bG1.k1 = gq[t][3];
                    st4(RSL(3), orm[t], mm<true>(aG1, bG1, mm<true>(aG0, bG0, z4))); } }
        }
        LBAR();
        float kf[8], kk[8], al[8], lw[8]; float ssp = 0.f, bpp = 0.f;
        {
            { const int fo = lane * 256 + ((w ^ (lane & 7)) << 5); const f32x4 a_ = *(const LAS f32x4*)(RSL(4) + fo), b_ = *(const LAS f32x4*)(RSL(4) + fo + 16), c_ = *(const LAS f32x4*)(RSL(8) + fo), d_ = *(const LAS f32x4*)(RSL(8) + fo + 16);
              lw[0] = a_.x; lw[1] = a_.y; lw[2] = a_.z; lw[3] = a_.w; lw[4] = b_.x; lw[5] = b_.y; lw[6] = b_.z; lw[7] = b_.w;
              al[0] = c_.x; al[1] = c_.y; al[2] = c_.z; al[3] = c_.w; al[4] = d_.x; al[5] = d_.y; al[6] = d_.z; al[7] = d_.w; }
            *(v4u*)(X.G + jo + tid * 8) = *(const LAS v4u*)(RSL(3) + swz(ltok, 16 * ldg));
            float kkc[8], kac[8], rkc[8]; ld8l(cst + 192 + 8 * w, kkc); ld8l(cst + 256 + 8 * w, kac); ld8l(cst + 320 + 8 * w, rkc);
#pragma unroll
            for (int j = 0; j < 8; ++j) { kk[j] = k[j] * kkc[j]; ssp += kk[j] * kk[j]; kf[j] = k[j] * (1.0f + (al[j] - 1.0f) * kac[j]); bpp += r[j] * kf[j] * rkc[j]; }
            part[w * 64 + lane] = ssp; part[512 + w * 64 + lane] = bpp;
        }
        LBAR();
        {
            float ss = 0.f, bon = 0.f;
#pragma unroll
            for (int i = 0; i < 8; ++i) { ss += part[i * 64 + lane]; bon += part[512 + i * 64 + lane]; }
            const float inv = 1.0f / fmaxf(sqrtf(ss), 1e-12f);
            float at[8], rt[8], bt[8], kt[8], bh[8], kh[8], ge[8], vb[8];
#pragma unroll
            for (int j = 0; j < 8; ++j) {
                const float cs = wave_scan(lw[j]);
                const float ce = __int_as_float(__builtin_amdgcn_readlane(__float_as_int(cs), 63));
                const float e_cs = __builtin_amdgcn_exp2f(cs * 1.4426950408889634f), e_csm = __builtin_amdgcn_exp2f((cs - lw[j]) * 1.4426950408889634f);
                const float e_neg = __builtin_amdgcn_rcpf(e_cs), e_end = __builtin_amdgcn_exp2f((ce - cs) * 1.4426950408889634f);
                const float kn = kk[j] * inv, bb = kn * al[j];
                at[j] = -kn * e_csm; rt[j] = r[j] * e_cs; bt[j] = bb * e_neg; kt[j] = kf[j] * e_neg; bh[j] = bb * e_end; kh[j] = kf[j] * e_end; ge[j] = e_cs; vb[j] = bon * v[j];
            }
            const int ro = swz(lane, 16 * w);
            *(LAS v4u*)(RSL(0) + ro) = pk8(at); *(LAS v4u*)(RSL(1) + ro) = pk8(rt); *(LAS v4u*)(RSL(2) + ro) = pk8(bt); *(LAS v4u*)(RSL(3) + ro) = pk8(kt);
            *(LAS v4u*)(RSL(4) + ro) = pk8(bh); *(LAS v4u*)(RSL(5) + ro) = pk8(kh); *(LAS v4u*)(RSL(6) + ro) = pk8(v);
            if (lane == 63) { *(f32x4*)(X.GE + (size_t)job * 64 + 8 * w) = (f32x4){ge[0], ge[1], ge[2], ge[3]}; *(f32x4*)(X.GE + (size_t)job * 64 + 8 * w + 4) = (f32x4){ge[4], ge[5], ge[6], ge[7]}; }
            *(LAS v4u*)(RSL(18) + ro) = pk8(vb);
        }
        LBAR();
        {
            { bf16* vbp = (job < 2048) ? (X.VB0 + jo) : (X.VB1 + (jo - (size_t)2048 * 4096)); *(v4u*)(vbp + tid * 8) = *(const LAS v4u*)(RSL(18) + swz(ltok, 16 * ldg)); }
            const f32x4 z4 = (f32x4){0.f, 0.f, 0.f, 0.f};
            const Fr2 aA = ldf(RSL(0), fm), aR = ldf(RSL(1), fm); Fr2 bB[2], bK[2];
#pragma unroll
            for (int t = 0; t < 2; ++t) { bB[t] = ldf(RSL(2), fn[t]); bK[t] = ldf(RSL(3), fn[t]); }
            f32x4 nab[2], nabT[2], nak[2], mrb[2], mrk[2];
#pragma unroll
            for (int t = 0; t < 2; ++t) { nab[t] = mm<true>(aA, bB[t], z4); nabT[t] = mm<false>(aA, bB[t], z4); nak[t] = mm<true>(aA, bK[t], z4); mrb[t] = mm<true>(aR, bB[t], z4); mrk[t] = mm<true>(aR, bK[t], z4); }
#pragma unroll
            for (int t = 0; t < 2; ++t) { const int n0 = n0a + 16 * t; f32x4 x1;
#pragma unroll
                for (int x = 0; x < 4; ++x) { const int i = m0 + fr, j = n0 + 4 * fq + x;
                    if (j >= i) { nab[t][x] = 0.f; nak[t][x] = 0.f; } if (j > i) { mrb[t][x] = 0.f; mrk[t][x] = 0.f; }
                    x1[x] = nab[t][x] + ((i == j) ? 1.0f : 0.f);
                    const int it = m0 + 4 * fq + x, jt = n0 + fr; if (jt >= it) nabT[t][x] = 0.f; }
                st4(RSL(10), orm[t], x1); st4(RSL(12), orm[t], nab[t]); st4(RSL(14), otr[t], nabT[t]);
                st4(RSL(7), orm[t], nak[t]); st4(RSL(8), orm[t], mrb[t]); st4(RSL(9), orm[t], mrk[t]); }
        }
        LBAR();
        {
            const f32x4 z4 = (f32x4){0.f, 0.f, 0.f, 0.f};
            const Fr2 aP = ldf(RSL(12), fm), aN = ldf(RSL(7), fm); Fr2 bT[2], bV[2];
#pragma unroll
            for (int t = 0; t < 2; ++t) { bT[t] = ldf(RSL(14), fn[t]); bV[t] = ldt(RSL(6), tb0[t], tb1[t]); }
            f32x4 q0[2], q1[2], q2[2];
#pragma unroll
            for (int t = 0; t < 2; ++t) { q0[t] = mm<true>(aP, bT[t], z4); q1[t] = mm<false>(aP, bT[t], z4); q2[t] = mm<false>(aN, bV[t], z4); }
#pragma unroll
            for (int t = 0; t < 2; ++t) { st4(RSL(13), orm[t], q0[t]); st4(RSL(15), otr[t], q1[t]); st4(RSL(2), otr[t], q2[t]); }
        }
        LBAR();
#pragma unroll
        for (int kd = 0; kd < 5; ++kd) {
            const int xi = (kd & 1) ? 11 : 10, xo = (kd & 1) ? 10 : 11, pi = (kd & 1) ? 12 : 13, po = (kd & 1) ? 13 : 12, ti = (kd & 1) ? 14 : 15, to = (kd & 1) ? 15 : 14;
            const f32x4 z4 = (f32x4){0.f, 0.f, 0.f, 0.f};
            const Fr2 aX = ldf(RSL(xi), fm), aP = ldf(RSL(pi), fm); Fr2 bT[2]; f32x4 cx[2];
#pragma unroll
            for (int t = 0; t < 2; ++t) { bT[t] = ldf(RSL(ti), fn[t]); cx[t] = ld4(RSL(xi), orm[t]); }
            f32x4 q0[2], q1[2], q2[2];
#pragma unroll
            for (int t = 0; t < 2; ++t) { q0[t] = mm<true>(aX, bT[t], cx[t]); if (kd < 4) { q1[t] = mm<true>(aP, bT[t], z4); q2[t] = mm<false>(aP, bT[t], z4); } }
#pragma unroll
            for (int t = 0; t < 2; ++t) { st4(RSL(xo), orm[t], q0[t]); if (kd < 4) { st4(RSL(po), orm[t], q1[t]); st4(RSL(to), otr[t], q2[t]); } }
            LBAR();
        }
        {
            const f32x4 z4 = (f32x4){0.f, 0.f, 0.f, 0.f};
            const Fr2 aT = ldf(RSL(11), fm); Fr2 bA[2], bZ[2];
#pragma unroll
            for (int t = 0; t < 2; ++t) { bA[t] = ldt(RSL(0), tb0[t], tb1[t]); bZ[t] = ldf(RSL(2), fn[t]); }
            f32x4 q0[2], q1[2];
#pragma unroll
            for (int t = 0; t < 2; ++t) { q0[t] = mm<false>(aT, bA[t], z4); q1[t] = mm<false>(aT, bZ[t], z4); }
#pragma unroll
            for (int t = 0; t < 2; ++t) { st4(RSL(3), otr[t], q0[t]); st4(RSL(7), otr[t], q1[t]); }
        }
        LBAR();
        {
            const f32x4 z4 = (f32x4){0.f, 0.f, 0.f, 0.f};
            f32x4 p1[2], y0[2], gt[2], hh[2];
            {   const Fr2 aMb = ldf(RSL(8), fm), aMk = ldf(RSL(9), fm); Fr2 bW[2], bU[2], bV[2]; f32x4 cR[2];
#pragma unroll
                for (int t = 0; t < 2; ++t) { bW[t] = ldf(RSL(3), fn[t]); bU[t] = ldf(RSL(7), fn[t]); bV[t] = ldt(RSL(6), tb0[t], tb1[t]); cR[t] = ld4(RSL(1), orm[t]); }
#pragma unroll
                for (int t = 0; t < 2; ++t) { p1[t] = mm<true>(aMb, bW[t], cR[t]); y0[t] = mm<true>(aMk, bV[t], mm<true>(aMb, bU[t], z4)); } }
            {   const Fr2 aW = ldf(RSL(3), fm), aU = ldf(RSL(7), fm), aV = ldt(RSL(6), ta0, ta1); Fr2 bBh[2], bKh[2];
#pragma unroll
                for (int t = 0; t < 2; ++t) { bBh[t] = ldt(RSL(4), tb0[t], tb1[t]); bKh[t] = ldt(RSL(5), tb0[t], tb1[t]); }
#pragma unroll
                for (int t = 0; t < 2; ++t) { gt[t] = mm<false>(aW, bBh[t], z4); hh[t] = mm<true>(aV, bKh[t], mm<true>(aU, bBh[t], z4)); } }
#pragma unroll
            for (int t = 0; t < 2; ++t) {
                s_p1[t].x = pkbf(p1[t][0], p1[t][1]); s_p1[t].y = pkbf(p1[t][2], p1[t][3]); s_gt[t].x = pkbf(gt[t][0], gt[t][1]); s_gt[t].y = pkbf(gt[t][2], gt[t][3]);
                s_y0[t].x = pkbf(y0[t][0], y0[t][1]); s_y0[t].y = pkbf(y0[t][2], y0[t][3]); s_hh[t].x = pkbf(hh[t][0], hh[t][1]); s_hh[t].y = pkbf(hh[t][2], hh[t][3]); }
            s_jo = jo; s_have = true;
        }
    }
    if (s_have) P6A_STORE();
#undef P6A_LOAD
#undef P6A_STORE
    LBAR();
}
__device__ __forceinline__ void p6b_rwkv_seq(Frame& F, const RwArgs& A, const RwX& X, int nwg) {
    using namespace rwk;
    LAS unsigned char* lds = F.lds + RING_OFF;
    constexpr int YLD = 68;
    LAS float* Yf0 = (LAS float*)RSL(6);
    const int tid = F.tid, tok = tid >> 3, dg = tid & 7, lane = F.lane, fr = lane & 15, fq = lane >> 4;
    const int w = F.wave, m0 = 16 * (w >> 1), n0a = 32 * (w & 1);
    const int fm = swz(m0 + fr, fq * 16);
    int fn[2], orm[2], otr[2];
#pragma unroll
    for (int t = 0; t < 2; ++t) { const int n0 = n0a + 16 * t; fn[t] = swz(n0 + fr, fq * 16); orm[t] = swz(m0 + fr, 2 * (n0 + 4 * fq)); otr[t] = swz(n0 + fr, 2 * (m0 + 4 * fq)); }
    for (int unit = blockIdx.x; unit < BATCH * NH; unit += nwg) {
        const int b = unit >> 3, h = unit & 7; const int cb = 64 * h + 8 * dg;
        f32x4 sacc[2]; sacc[0] = (f32x4){0.f, 0.f, 0.f, 0.f}; sacc[1] = sacc[0];
        for (int u = tid; u < SLOT / 4; u += NWAVES * 64) ((LAS unsigned*)RSL(4))[u] = 0u;
        float lnw[8], lnb[8]; ld8f(A.ln_w + cb, lnw); ld8f(A.ln_b + cb, lnb);
        struct Nx { v4u vb, g; u32x2g p1[2], gt[2], y0[2], h[2]; f32x4 ge[2]; };
        Nx nA, nB;
#define P6B_LOAD(cc, N) do { const int job_ = unit * 32 + (cc); const size_t jo_ = (size_t)job_ * 4096; const size_t grow_ = (size_t)b * SEQ + (cc) * 64 + tok; \
            _Pragma("unroll") for (int t = 0; t < 2; ++t) { N.y0[t] = *(const u32x2g*)(X.Y0 + jo_ + ((w * 2 + t) * 64 + lane) * 4); N.h[t] = *(const u32x2g*)(X.H + jo_ + ((w * 2 + t) * 64 + lane) * 4); \
                N.p1[t] = *(const u32x2g*)(X.P1 + jo_ + ((w * 2 + t) * 64 + lane) * 4); N.gt[t] = *(const u32x2g*)(X.GT + jo_ + ((w * 2 + t) * 64 + lane) * 4); \
                N.ge[t] = *(const f32x4*)(X.GE + (size_t)job_ * 64 + n0a + 16 * t + 4 * fq); } \
            const bf16* vbp_ = (job_ < 2048) ? (X.VB0 + jo_) : (X.VB1 + (jo_ - (size_t)2048 * 4096)); \
            N.vb = *(const v4u*)(vbp_ + tok * 64 + 8 * dg); N.g = *(const v4u*)(X.G + jo_ + tok * 64 + 8 * dg); } while (0)
#define P6B_OUT(par, vbw_, gw_, grow_) do { float y[8]; ld8l(Yf0 + (par) * (64 * YLD) + tok * YLD + 8 * dg, y); \
            const float g[8] = {bflo(gw_.x), bfhi(gw_.x), bflo(gw_.y), bfhi(gw_.y), bflo(gw_.z), bfhi(gw_.z), bflo(gw_.w), bfhi(gw_.w)}; \
            const float vb[8] = {bflo(vbw_.x), bfhi(vbw_.x), bflo(vbw_.y), bfhi(vbw_.y), bflo(vbw_.z), bfhi(vbw_.z), bflo(vbw_.w), bfhi(vbw_.w)}; \
            float s_ = 0.f; _Pragma("unroll") for (int j = 0; j < 8; ++j) s_ += y[j]; \
            const float mean = sum8(s_) * (1.0f / 64.0f); float q_ = 0.f; \
            _Pragma("unroll") for (int j = 0; j < 8; ++j) { y[j] -= mean; q_ += y[j] * y[j]; } \
            const float rstd = __builtin_amdgcn_rsqf(sum8(q_) * (1.0f / 64.0f) + LNX_EPS); float ov[8]; \
            _Pragma("unroll") for (int j = 0; j < 8; ++j) ov[j] = (y[j] * rstd * lnw[j] + lnb[j] + vb[j]) * g[j]; \
            v4u wv_; wv_.x = pkbf(ov[0], ov[1]); wv_.y = pkbf(ov[2], ov[3]); wv_.z = pkbf(ov[4], ov[5]); wv_.w = pkbf(ov[6], ov[7]); \
            *(GAS v4u*)(A.QO + (grow_) * D + 512 + cb) = wv_; } while (0)
        v4u p_vb = (v4u){0u, 0u, 0u, 0u}, p_g = p_vb; size_t p_row = 0;
#define P6B_STEP(c, N) do { const int par = (c) & 1, scur = 4 + par, snxt = 5 - par; const size_t grow = (size_t)b * SEQ + (c) * 64 + tok; \
            _Pragma("unroll") for (int t = 0; t < 2; ++t) { *(LAS u32x2g*)(RSL(par) + orm[t]) = N.p1[t]; *(LAS u32x2g*)(RSL(2 + par) + otr[t]) = N.gt[t]; } \
            f32x4 yacc[2], hcur[2], gecur[2]; \
            _Pragma("unroll") for (int t = 0; t < 2; ++t) { yacc[t] = (f32x4){bflo(N.y0[t].x), bfhi(N.y0[t].x), bflo(N.y0[t].y), bfhi(N.y0[t].y)}; hcur[t] = (f32x4){bflo(N.h[t].x), bfhi(N.h[t].x), bflo(N.h[t].y), bfhi(N.h[t].y)}; gecur[t] = N.ge[t]; } \
            const v4u vbw = N.vb, gw = N.g; \
            if ((c) + 2 < SEQ / 64) P6B_LOAD((c) + 2, N); \
            LBAR(); \
            {   const Fr2 aP1 = ldf(RSL(par), fm), aS = ldf(RSL(scur), fm); Fr2 bS[2], bG[2]; \
                _Pragma("unroll") for (int t = 0; t < 2; ++t) { bS[t] = ldf(RSL(scur), fn[t]); bG[t] = ldf(RSL(2 + par), fn[t]); } \
                _Pragma("unroll") for (int t = 0; t < 2; ++t) { yacc[t] = mm<true>(aP1, bS[t], yacc[t]); sacc[t] = mm<true>(aS, bG[t], sacc[t] * gecur[t] + hcur[t]); } \
                _Pragma("unroll") for (int t = 0; t < 2; ++t) { const int n0 = n0a + 16 * t; *(LAS f32x4*)(Yf0 + par * (64 * YLD) + (m0 + fr) * YLD + n0 + 4 * fq) = yacc[t]; st4(RSL(snxt), orm[t], sacc[t]); } } \
            if ((c) > 0) P6B_OUT(par ^ 1, p_vb, p_g, p_row);                    \
            p_vb = vbw; p_g = gw; p_row = grow; } while (0)
        P6B_LOAD(0, nA); P6B_LOAD(1, nB);
        for (int c = 0; c < SEQ / 64; c += 2) {
            P6B_STEP(c, nA);
            P6B_STEP(c + 1, nB);
        }
#undef P6B_STEP
        LBAR();
        P6B_OUT(1, p_vb, p_g, p_row);
#undef P6B_LOAD
#undef P6B_OUT
        LBAR();
    }
}

namespace sba {
using bf16x8 = __attribute__((ext_vector_type(8))) short;
using s16x4 = __attribute__((ext_vector_type(4))) short;
using f32x16 = __attribute__((ext_vector_type(16))) float;
using u32x4 = __attribute__((ext_vector_type(4))) unsigned;
constexpr int QB = 256, KVBLK = 64;
constexpr int LDS_K = 0, LDS_V = 16384, LDS_ST = 32768, ST_LD = 68, LDS_FLAG = LDS_ST + 8 * 32 * ST_LD * 4, LDS_BYTES_ATT = LDS_FLAG + 64;
constexpr float R_DEAD = -160.0f;
#define SBAR() __builtin_amdgcn_sched_barrier(0)
typedef float f32x2_t __attribute__((ext_vector_type(2))); typedef __bf16 bf16x2_t __attribute__((ext_vector_type(2)));
__device__ __forceinline__ unsigned cvtpk_s(float lo, float hi) { f32x2_t v = {lo, hi}; bf16x2_t b = __builtin_convertvector(v, bf16x2_t); return __builtin_bit_cast(unsigned, b); }
__device__ __forceinline__ void qkt(f32x16& p0, f32x16& p1, const char* Kslot, const bf16x8* qr, int r32, int hi) {
    const char* kb = Kslot + hi * 1024 + r32 * 16;
    const f32x16 z = f32x16{};
#pragma unroll
    for (int d0 = 0; d0 < 4; ++d0) {
        const bf16x8 b0 = *reinterpret_cast<const bf16x8*>(kb + d0 * 2048);
        const bf16x8 b1 = *reinterpret_cast<const bf16x8*>(kb + d0 * 2048 + 512);
        if (d0 == 0) { p0 = __builtin_amdgcn_mfma_f32_32x32x16_bf16(b0, qr[0], z, 0, 0, 0); p1 = __builtin_amdgcn_mfma_f32_32x32x16_bf16(b1, qr[0], z, 0, 0, 0); }
        else { p0 = __builtin_amdgcn_mfma_f32_32x32x16_bf16(b0, qr[d0], p0, 0, 0, 0); p1 = __builtin_amdgcn_mfma_f32_32x32x16_bf16(b1, qr[d0], p1, 0, 0, 0); }
    }
}
__device__ __forceinline__ void pv(f32x16* o, int vb, bf16x8 pa0, bf16x8 pa1, bf16x8 pa2, bf16x8 pa3) {
#pragma unroll
    for (int d0 = 0; d0 < 2; ++d0) { s16x4 lo[4], hi[4];
#pragma unroll
        for (int ks = 0; ks < 4; ++ks) {
            asm volatile("ds_read_b64_tr_b16 %0,%1 offset:%c2" : "=&v"(lo[ks]) : "v"(vb), "i"(d0 * 4096 + ks * 1024) : "memory");
            asm volatile("ds_read_b64_tr_b16 %0,%1 offset:%c2" : "=&v"(hi[ks]) : "v"(vb), "i"(d0 * 4096 + ks * 1024 + 512) : "memory"); }
        asm volatile("s_waitcnt lgkmcnt(0)" ::: "memory"); SBAR();
#define PK(k) (bf16x8){lo[k][0], lo[k][1], lo[k][2], lo[k][3], hi[k][0], hi[k][1], hi[k][2], hi[k][3]}
        o[d0] = __builtin_amdgcn_mfma_f32_32x32x16_bf16(pa0, PK(0), o[d0], 0, 0, 0);
        o[d0] = __builtin_amdgcn_mfma_f32_32x32x16_bf16(pa1, PK(1), o[d0], 0, 0, 0);
        o[d0] = __builtin_amdgcn_mfma_f32_32x32x16_bf16(pa2, PK(2), o[d0], 0, 0, 0);
        o[d0] = __builtin_amdgcn_mfma_f32_32x32x16_bf16(pa3, PK(3), o[d0], 0, 0, 0);
#undef PK
    }
}
__device__ __forceinline__ float swap_sum(float x, float& other_if_lo, int hi) {
    auto rr = __builtin_amdgcn_permlane32_swap(__float_as_uint(x), __float_as_uint(x), false, false);
    const float a = __uint_as_float(rr[0]), b = __uint_as_float(rr[1]);
    other_if_lo = hi ? 0.f : b;
    return a + b;
}
__device__ __forceinline__ float swap_prod(float x, float& other_if_lo, int hi) {
    auto rr = __builtin_amdgcn_permlane32_swap(__float_as_uint(x), __float_as_uint(x), false, false);
    const float a = __uint_as_float(rr[0]), b = __uint_as_float(rr[1]);
    other_if_lo = hi ? 1.0f : b;
    return a * b;
}
__device__ __forceinline__ void attn_wave_unit(int b, int h, int qblk, bf16* QO, const bf16* __restrict__ KB, const bf16* __restrict__ VB, const float* gout, char* wsm  ) {
    const int lane = threadIdx.x & 63, r32 = lane & 31, hi = lane >> 5;
    const long rowbase = (long)b * SEQ; const int q0 = qblk * 32;
    bf16* Qw = QO + (rowbase + q0) * D + h * HD;
    const bf16* Kh = KB + rowbase * SBW + h * HD; const bf16* Vh = VB + rowbase * SBW + h * HD;
    const unsigned lds0 = (unsigned)(uintptr_t)wsm;
    const int jtop = (q0 + 30) >> 6;
    const bf16* vsrc = Vh + (long)(lane >> 3) * SBW + (lane & 7) * 8;
    const int vdst0 = ((lane & 7) >> 2) * 4096 + ((lane >> 3) & 15) * 64 + (lane & 3) * 16;
    const int vb0 = (int)lds0 + ((lane >> 4) & 1) * 32 + (lane & 3) * 8 + (4 * hi + ((lane & 15) >> 2)) * 64;
    const bf16* ksrc = Kh + (long)r32 * SBW + hi * 8;
    bf16x8 qr[4];
#pragma unroll
    for (int d0 = 0; d0 < 4; ++d0) qr[d0] = *reinterpret_cast<const bf16x8*>(&Qw[(long)r32 * D + d0 * 16 + hi * 8]);
    bf16x8 kf[8]; u32x4 vr[8];
#define SBA_LOAD(t) do { const bf16* kp_ = ksrc + (long)(t) * KVBLK * SBW; const bf16* vp_ = vsrc + (long)(t) * KVBLK * SBW; \
        _Pragma("unroll") for (int d0 = 0; d0 < 4; ++d0) { kf[2 * d0] = *reinterpret_cast<const bf16x8*>(kp_ + d0 * 16); kf[2 * d0 + 1] = *reinterpret_cast<const bf16x8*>(kp_ + 32 * SBW + d0 * 16); } \
        _Pragma("unroll") for (int i = 0; i < 8; ++i) vr[i] = *(const u32x4*)(vp_ + (long)(8 * i) * SBW); } while (0)
    SBA_LOAD(jtop);
    float R = 0.f; f32x16 o[2]; o[0] = f32x16{}; o[1] = f32x16{};
    const int qrow = q0 + r32;
    for (int jt = jtop; jt >= 0; --jt) {
        const int cur = (jtop - jt) & 1;
#pragma unroll
        for (int i = 0; i < 8; ++i) *(u32x4*)(wsm + cur * 8192 + vdst0 + (i >> 1) * 1024 + (i & 1) * 512) = vr[i];
        f32x16 p0, p1;
        {   const f32x16 z = f32x16{};
            p0 = __builtin_amdgcn_mfma_f32_32x32x16_bf16(kf[0], qr[0], z, 0, 0, 0); p1 = __builtin_amdgcn_mfma_f32_32x32x16_bf16(kf[1], qr[0], z, 0, 0, 0);
#pragma unroll
            for (int d0 = 1; d0 < 4; ++d0) { p0 = __builtin_amdgcn_mfma_f32_32x32x16_bf16(kf[2 * d0], qr[d0], p0, 0, 0, 0); p1 = __builtin_amdgcn_mfma_f32_32x32x16_bf16(kf[2 * d0 + 1], qr[d0], p1, 0, 0, 0); } }
        if (jt > 0) SBA_LOAD(jt - 1);
        const int kb = 64 * jt + 4 * hi; const bool diag = (jt == jtop);
#pragma unroll
        for (int r = 0; r < 16; ++r) {
            { float rr = __builtin_amdgcn_rcpf(1.0f + __builtin_amdgcn_exp2f(p0[r]));
              if (diag) { const int key = kb + (r & 3) + 8 * (r >> 2); if (key >= qrow) rr = 1.0f; }
              p0[r] = rr; }
            { float rr = __builtin_amdgcn_rcpf(1.0f + __builtin_amdgcn_exp2f(p1[r]));
              if (diag) { const int key = kb + 32 + (r & 3) + 8 * (r >> 2); if (key >= qrow) rr = 1.0f; }
              p1[r] = rr; }
        }
        float c0[4], c1[4], x0[4], x1[4];
#pragma unroll
        for (int g = 0; g < 4; ++g) {
            const float s0 = (p0[4 * g] * p0[4 * g + 1]) * (p0[4 * g + 2] * p0[4 * g + 3]);
            const float s1 = (p1[4 * g] * p1[4 * g + 1]) * (p1[4 * g + 2] * p1[4 * g + 3]);
            c0[g] = swap_prod(s0, x0[g], hi); c1[g] = swap_prod(s1, x1[g], hi);
        }
        const float Cr = __builtin_amdgcn_exp2f(R);
        float suf0[4], suf1[4];
        suf1[3] = Cr; suf1[2] = suf1[3] * c1[3]; suf1[1] = suf1[2] * c1[2]; suf1[0] = suf1[1] * c1[1];
        suf0[3] = suf1[0] * c1[0]; suf0[2] = suf0[3] * c0[3]; suf0[1] = suf0[2] * c0[2]; suf0[0] = suf0[1] * c0[1];
        R += __builtin_amdgcn_logf(((c0[0] * c0[1]) * (c0[2] * c0[3])) * ((c1[0] * c1[1]) * (c1[2] * c1[3])));
#pragma unroll
        for (int g = 0; g < 4; ++g) {
            { const float e3 = suf0[g] * x0[g], e2 = e3 * p0[4 * g + 3], e1 = e2 * p0[4 * g + 2], e0 = e1 * p0[4 * g + 1];
              p0[4 * g + 3] = (1.0f - p0[4 * g + 3]) * e3; p0[4 * g + 2] = (1.0f - p0[4 * g + 2]) * e2; p0[4 * g + 1] = (1.0f - p0[4 * g + 1]) * e1; p0[4 * g] = (1.0f - p0[4 * g]) * e0; }
            { const float e3 = suf1[g] * x1[g], e2 = e3 * p1[4 * g + 3], e1 = e2 * p1[4 * g + 2], e0 = e1 * p1[4 * g + 1];
              p1[4 * g + 3] = (1.0f - p1[4 * g + 3]) * e3; p1[4 * g + 2] = (1.0f - p1[4 * g + 2]) * e2; p1[4 * g + 1] = (1.0f - p1[4 * g + 1]) * e1; p1[4 * g] = (1.0f - p1[4 * g]) * e0; }
        }
#define PKW(P, B) cvtpk_s(P[B], P[B + 1])
        const u32x4 pw0 = (u32x4){PKW(p0, 0), PKW(p0, 2), PKW(p0, 4), PKW(p0, 6)}, pw1 = (u32x4){PKW(p0, 8), PKW(p0, 10), PKW(p0, 12), PKW(p0, 14)};
        const u32x4 pw2 = (u32x4){PKW(p1, 0), PKW(p1, 2), PKW(p1, 4), PKW(p1, 6)}, pw3 = (u32x4){PKW(p1, 8), PKW(p1, 10), PKW(p1, 12), PKW(p1, 14)};
#undef PKW
        SBAR();
        asm volatile("s_waitcnt lgkmcnt(0)" ::: "memory");
        pv(o, vb0 + cur * 8192, __builtin_bit_cast(bf16x8, pw0), __builtin_bit_cast(bf16x8, pw1), __builtin_bit_cast(bf16x8, pw2), __builtin_bit_cast(bf16x8, pw3));
        if (__all(R < R_DEAD)) break;
    }
#undef SBA_LOAD
    {
        float* stg = (float*)wsm;
        asm volatile("s_waitcnt lgkmcnt(0)" ::: "memory");
#pragma unroll
        for (int r = 0; r < 16; ++r) { const int orow = (r & 3) + 8 * (r >> 2) + 4 * hi;
#pragma unroll
            for (int d0 = 0; d0 < 2; ++d0) stg[orow * ST_LD + d0 * 32 + r32] = o[d0][r]; }
        asm volatile("s_waitcnt lgkmcnt(0)" ::: "memory");
        const int ch = lane & 7;
        const f32x4 ga = *(const f32x4*)(gout + h * HD + ch * 8), gb = *(const f32x4*)(gout + h * HD + ch * 8 + 4);
#pragma unroll
        for (int i = 0; i < 4; ++i) { const int row = i * 8 + (lane >> 3);
            const f32x4 a = *(const f32x4*)(stg + row * ST_LD + ch * 8), c = *(const f32x4*)(stg + row * ST_LD + ch * 8 + 4);
            float ss = (a.x * a.x + a.y * a.y) + (a.z * a.z + a.w * a.w) + (c.x * c.x + c.y * c.y) + (c.z * c.z + c.w * c.w);
            ss = sum8(ss);
            const float hs = __builtin_amdgcn_rsqf(ss * (1.0f / 64.0f) + 1e-6f);
            u32x4 w; w.x = cvtpk_s(a.x * hs * ga.x, a.y * hs * ga.y); w.y = cvtpk_s(a.z * hs * ga.z, a.w * hs * ga.w);
            w.z = cvtpk_s(c.x * hs * gb.x, c.y * hs * gb.y); w.w = cvtpk_s(c.z * hs * gb.z, c.w * hs * gb.w);
            *(u32x4*)(Qw + (long)row * D + ch * 8) = w; }
        asm volatile("s_waitcnt lgkmcnt(0)" ::: "memory");
    }
}
#undef SBAR
__device__ __forceinline__ void attn_phase(Frame& F, bf16* QO, const bf16* KB, const bf16* VB, const float* gout, unsigned* queue, int first_ticket, int ticket_base) {
    char* wsm = (char*)F.lds + RING_OFF + F.wave * 16384;
    const int nunits = BATCH * NH * (SEQ / 32);
    int pend = -1; int tfirst = first_ticket;
    for (;;) {
        int uu;
        if (pend >= 0) { uu = pend; pend = -1; }
        else { unsigned t;
               if (tfirst >= 0) { t = (unsigned)tfirst; tfirst = -1; }
               else { t = 0u; if (F.lane == 0) t = __hip_atomic_fetch_add(queue, 1u, __ATOMIC_RELAXED, __HIP_MEMORY_SCOPE_AGENT); t = (unsigned)__builtin_amdgcn_readfirstlane((int)t) + (unsigned)ticket_base; }
               if (2u * t >= (unsigned)nunits) break; uu = (int)(2u * t); pend = uu + 1; }
        attn_wave_unit(uu >> 9, (uu >> 6) & 7, uu & 63, QO, KB, VB, gout, wsm);
    }
    __syncthreads();
}
}

struct Args { const float* in[26]; float* out; unsigned char* ws; int ph_lo, ph_hi, li, pad; };
__global__ void __launch_bounds__(NWAVES * 64, 2) skel_fwd(Args args) {
    extern __shared__ __attribute__((aligned(16))) unsigned char lds[];
    Frame F;
    F.lds = (LAS unsigned char*)lds;
    F.MISC = (volatile LAS unsigned*)(F.lds + MISC_OFF);
    F.tid = threadIdx.x; F.lane = F.tid & 63; F.wave = __builtin_amdgcn_readfirstlane(F.tid >> 6);
    F.G = gridDim.x; { const int bx = blockIdx.x; F.vcu = (F.G % 8 == 0) ? (bx % 8) * (F.G / 8) + bx / 8 : bx; }
    unsigned char* ws = args.ws;
    F.ctl = (gu32*)(ws + WS_CTL);
    const float* x = args.in[0];
    bf16* W1U = (bf16*)(ws + WS_W1U); bf16* W1D = (bf16*)(ws + WS_W1D); bf16* W2U = (bf16*)(ws + WS_W2U); bf16* W2D = (bf16*)(ws + WS_W2D);
    bf16* WIN = (bf16*)(ws + WS_WIN); bf16* WOUT = (bf16*)(ws + WS_WOUT); bf16* WLORA = (bf16*)(ws + WS_WLORA);
    bf16* XB = (bf16*)(ws + WS_XB); bf16* ACT = (bf16*)(ws + WS_ACT); bf16* QO = (bf16*)(ws + WS_QO); bf16* KB = (bf16*)(ws + WS_KB); bf16* VB = (bf16*)(ws + WS_VB);
    bf16* RW = (bf16*)(ws + WS_RW); bf16* ALORA = (bf16*)(ws + WS_ALORA); float* LW = (float*)(ws + WS_LW); bf16* AB = (bf16*)(ws + WS_AB); bf16* GB = (bf16*)(ws + WS_GB);
    float* SSQ = (float*)(ws + WS_SSQ); float* out = args.out;
    for (int u = F.tid; u < (LDS_BYTES - LDSCTL_OFF) / 4; u += NWAVES * 64) ((LAS unsigned*)(F.lds + LDSCTL_OFF))[u] = 0u;
    __syncthreads();
    XcdBarrier bar; bar.bar = (unsigned*)(F.ctl + CW_BAR); bar.x = 0; bar.st = nullptr;
    if (N_LAUNCHES != PER_PHASE) bar = xcd_barrier_post((unsigned*)(F.ctl + CW_BAR), F.MISC + 8);
#define GRID_BAR(seam) do { if (N_LAUNCHES == PER_PHASE) { if (F.tid == 0) __hip_atomic_store(F.ctl + CW_TMO, 0xBADBA0u | (unsigned)(seam), RLX_AGENT); } else { xcd_barrier(bar); } } while (0)
    const int lo = args.ph_lo, hi = args.ph_hi;
#define IN(k) (lo <= (k) && (k) < hi)
#define BOTH(k) (IN(k) && IN((k) + 1))
    if (IN(0)) {
        p0_prologue(F, x, args.in[1], args.in[2], args.in[3], args.in[4], args.in[5], args.in[6], args.in[12], args.in[14], args.in[15], args.in[21], args.in[22], args.in[23], args.in[24], args.in[25],
                    W1U, W1D, W2U, W2D, WIN, WOUT, WLORA, XB, SSQ); if (BOTH(0)) GRID_BAR(0);
    }
    if (IN(1)) {
        pg8::Gemm g{XB, W1U, M, 2 * FF, D}; pg8::StaticOrder S; S.init(M, 2 * FF, F.G, (int)blockIdx.x);
        pg8::EpiSwiGLU E{ACT, FF, SSQ};
        pg8::gemm_phase<pg8::EpiSwiGLU, pg8::StaticOrder, true, true>(F.lds + RING_OFF, g, S, E);
        if (BOTH(1)) GRID_BAR(1);
    }
    if (IN(2)) {
        pg8::Gemm g{ACT, W1D, M, D, FF}; pg8::StaticOrder S; S.init(M, D, F.G, (int)blockIdx.x);
        pg8::EpiResid E{x, nullptr, nullptr, nullptr, XB, (bf16*)out, SSQ, 0.5f, 1};
        pg8::gemm_phase<pg8::EpiResid, pg8::StaticOrder, true, true>(F.lds + RING_OFF, g, S, E);
        if (BOTH(2)) GRID_BAR(2);
    }
    if (IN(3)) {
        pg8::Gemm g{XB, WIN, M, PW, D}; pg8::StaticOrder S; S.init(M, PW, F.G, (int)blockIdx.x);
        pg8::EpiWin E{QO, KB, VB, RW, SSQ, args.in[7], args.in[8], 0.125f * 1.4426950408889634f};
        pg8::gemm_phase<pg8::EpiWin, pg8::StaticOrder, true, true>(F.lds + RING_OFF, g, S, E);
        if (F.G >= 256) {
            const int nlo = (M / 256) * (PW / 256) - 6 * F.G;
            if ((int)blockIdx.x >= nlo) { __syncthreads();
                p0_items(F, x, args.in[1], args.in[2], args.in[3], args.in[4], args.in[5], args.in[6], args.in[12], args.in[14], args.in[15], args.in[21], args.in[22], args.in[23], args.in[24], args.in[25],
                         W1U, W1D, W2U, W2D, WIN, WOUT, WLORA, XB, SSQ, 1, ((int)blockIdx.x - nlo) * NWAVES + F.wave, (F.G - nlo) * NWAVES); }
        }
        if (BOTH(3)) GRID_BAR(3);
    }
    if (IN(6)) {
        RwArgs A{RW, WLORA, WLORA + 512 * 64, WLORA + 2 * 512 * 64, args.in[11], args.in[13], QO, args.in[10], args.in[16], args.in[17], args.in[18], args.in[19], args.in[20]};
        bf16* ob = (bf16*)out;
        RwX X{ob + (size_t)32 * 1024 * 1024, ob + (size_t)48 * 1024 * 1024, (bf16*)LW, (bf16*)LW + (size_t)16 * 1024 * 1024, AB, AB + (size_t)8 * 1024 * 1024, SSQ, GB};
        p6a_rwkv_local(F, A, X);
        GRID_BAR(16);
        const int nseq = (F.G >= 2 * BATCH * NH) ? BATCH * NH : F.G;
        if ((int)blockIdx.x < nseq) { p6b_rwkv_seq(F, A, X, nseq); __syncthreads(); }
        const int nfree = (F.G - nseq) * NWAVES;
        sba::attn_phase(F, QO, KB, VB, args.in[9], (unsigned*)(F.ctl + CW_QUEUE), ((int)blockIdx.x >= nseq) ? ((int)blockIdx.x - nseq) * NWAVES + F.wave : -1, nfree);
        if (BOTH(6)) GRID_BAR(6);
    }
    if (IN(8)) {
        pg8::Gemm g{QO, WOUT, M, D, D}; pg8::StaticOrder S; S.init(M, D, F.G, (int)blockIdx.x);
        pg8::EpiResid E{nullptr, XB, (const bf16*)out, nullptr, XB, (bf16*)LW, SSQ, 1.0f, 1};
        pg8::gemm_phase<pg8::EpiResid, pg8::StaticOrder, true, true>(F.lds + RING_OFF, g, S, E);
        if (BOTH(8)) GRID_BAR(8);
    }
    if (IN(9)) {
        pg8::Gemm g{XB, W2U, M, 2 * FF, D}; pg8::StaticOrder S; S.init(M, 2 * FF, F.G, (int)blockIdx.x);
        pg8::EpiSwiGLU E{ACT, FF, SSQ};
        pg8::gemm_phase<pg8::EpiSwiGLU, pg8::StaticOrder, true, true>(F.lds + RING_OFF, g, S, E);
        if (BOTH(9)) GRID_BAR(9);
    }
    if (IN(10)) {
        pg8::Gemm g{ACT, W2D, M, D, FF}; pg8::StaticOrder S; S.init(M, D, F.G, (int)blockIdx.x);
        pg8::EpiResid E{nullptr, XB, (const bf16*)LW, out, nullptr, nullptr, SSQ, 0.5f, 0};
        pg8::gemm_phase<pg8::EpiResid, pg8::StaticOrder, true, true>(F.lds + RING_OFF, g, S, E);
    }
#undef IN
#undef BOTH
}

extern "C" void kernel_launch(void* const* d_in, const int* in_sizes, int n_in, void* d_out, int out_size, void* d_ws, size_t ws_size, hipStream_t stream) {
    static int grid = 0;
    if (grid == 0) {
        if (n_in != 26 || in_sizes[0] != M * D || out_size != M * D || ws_size < WS_END) { fprintf(stderr, "kernel_launch: unexpected shapes: n_in %d in0 %d out %d ws %zu (need %zu)\n", n_in, n_in > 0 ? in_sizes[0] : -1, out_size, ws_size, (size_t)WS_END); grid = -1; return; }
        int dev = 0, cus = 0, per_cu = 0;
        if (hipGetDevice(&dev) != hipSuccess || hipDeviceGetAttribute(&cus, hipDeviceAttributeMultiprocessorCount, dev) != hipSuccess) { grid = -1; return; }
        if (hipFuncSetAttribute((const void*)skel_fwd, hipFuncAttributeMaxDynamicSharedMemorySize, LDS_BYTES) != hipSuccess) { fprintf(stderr, "kernel_launch: hipFuncSetAttribute failed\n"); grid = -1; return; }
        if (hipOccupancyMaxActiveBlocksPerMultiprocessor(&per_cu, (const void*)skel_fwd, NWAVES * 64, LDS_BYTES) != hipSuccess || per_cu < 1) { fprintf(stderr, "kernel_launch: occupancy query reports %d blocks per CU\n", per_cu); per_cu = 1; }
        (void)hipGetLastError();
        grid = cus;
    }
    if (grid < 0) return;
    if (hipMemsetAsync((char*)d_ws + WS_CTL, 0, CTL_ZERO_BYTES, stream) != hipSuccess) return;
    Args a{};
    for (int i = 0; i < 26; ++i) a.in[i] = (const float*)d_in[i];
    a.out = (float*)d_out; a.ws = (unsigned char*)d_ws;
    for (int li = 0; li < N_LAUNCHES; ++li) {
        a.ph_lo = (N_LAUNCHES == PER_PHASE) ? li : 0; a.ph_hi = (N_LAUNCHES == PER_PHASE) ? li + 1 : PER_PHASE; a.li = li;
        hipLaunchKernelGGL(skel_fwd, dim3(grid), dim3(NWAVES * 64), LDS_BYTES, stream, a);
    }
}
```

```cpp
#include <hip/hip_runtime.h>
#include <hip/hip_bf16.h>
#include <cstdio>
#include <cstdint>
#include <cmath>
namespace pg8 {
#define PG8_LAS __attribute__((address_space(3)))
typedef unsigned short bf16_t;
typedef short bf16x8 __attribute__((ext_vector_type(8)));
typedef float f32x4 __attribute__((ext_vector_type(4)));
typedef unsigned u32x4 __attribute__((ext_vector_type(4)));
constexpr int BM = 256, BK = 64, HALF = 128, HTB = HALF * BK * 2  , STAGE_BYTES = 8 * HTB, NXCD = 8, WGM = 4;

__host__ __device__ __forceinline__ int lds_byte(int r, int c) { const int st = (r >> 4) * 2 + (c >> 5), rr = r & 15, cc = c & 31, ob = rr * 64 + cc * 2; return st * 1024 + (ob ^ (((ob >> 9) & 1) << 5)); }
__host__ __device__ __forceinline__ void stage_rc(int b, int& R, int& C) { const int st = b / 1024, sb = b % 1024, swz = sb ^ (((sb >> 9) & 1) << 5); R = (st >> 1) * 16 + swz / 64; C = (st & 1) * 32 + (swz % 64) / 2; }
__host__ __device__ __forceinline__ int perm32(int rho) { const int n = rho >> 4, i = rho & 15; return 8 * (i >> 2) + 4 * n + (i & 3); }

struct Unit { int pm, pn; };
struct Gemm { const bf16_t* A; const bf16_t* Bt; int M, N, K; int ld; };

struct StaticOrder {
    int nM, nN, nwg, G, c;
    __host__ __device__ void init(int M, int N, int G_, int c_) { nM = M / BM; nN = N / BM; nwg = nM * nN; G = G_; c = c_; }
    __host__ __device__ bool next(int i, Unit& u) const {
        const long L = (long)i * G + c; if (L >= nwg) return false;
        int wgid = (int)L; { const int q = nwg / NXCD, r = nwg % NXCD, xcd = wgid % NXCD, off = wgid / NXCD; wgid = (xcd < r ? xcd * (q + 1) : r * (q + 1) + (xcd - r) * q) + off; }
        const int nig = WGM * nN, gid = wgid / nig, fm = gid * WGM, gsz = (nM - fm) < WGM ? (nM - fm) : WGM;
        u.pm = fm + ((wgid % nig) % gsz); u.pn = (wgid % nig) / gsz; return true;
    }
    __device__ __forceinline__ void a_ready(const Unit&) const {}
    __device__ __forceinline__ void done(const Unit&) const {}
};


__device__ __forceinline__ unsigned cvt_pk_bf16(float lo, float hi) { unsigned r; asm volatile("v_cvt_pk_bf16_f32 %0, %1, %2" : "=v"(r) : "v"(lo), "v"(hi)); return r; }
typedef unsigned u32x2 __attribute__((ext_vector_type(2)));
constexpr float RMS_EPS_F = 1e-6f;
constexpr float LOG2E_F = 1.4426950408889634f;
__device__ __forceinline__ float row_rs(const float* ssqp, int row) {
    const f32x4* p = (const f32x4*)(ssqp + (size_t)row * 16);
    const f32x4 a = p[0], b = p[1], c = p[2], d = p[3];
    const float s = ((a[0] + a[1]) + (a[2] + a[3])) + ((b[0] + b[1]) + (b[2] + b[3])) + ((c[0] + c[1]) + (c[2] + c[3])) + ((d[0] + d[1]) + (d[2] + d[3]));
    return __builtin_amdgcn_rsqf(s * (1.0f / 1024.0f) + RMS_EPS_F);
}
__device__ __forceinline__ float silu_f(float g) { return g * __builtin_amdgcn_rcpf(1.0f + __builtin_amdgcn_exp2f(-g * LOG2E_F)); }
__device__ __forceinline__ float sigmoid_f(float g) { return __builtin_amdgcn_rcpf(1.0f + __builtin_amdgcn_exp2f(-g * LOG2E_F)); }

struct EpiSwiGLU {
    static constexpr bool PERM = true, AFTER_DRAIN = false;
    bf16_t* O; int ldo; const float* ssqp;
    __device__ __forceinline__ void operator()(const f32x4 (&acc)[2][2][4][2], const Unit& u, int wr, int wc, int fr, int fq) const {
        const int row0 = u.pm * BM + wr * 64 + fr, col0 = u.pn * HALF + wc * 32 + 8 * fq;
#pragma unroll
        for (int ai = 0; ai < 2; ++ai)
#pragma unroll
            for (int m = 0; m < 4; ++m) {
                const int row = row0 + ai * HALF + m * 16; const float rs = row_rs(ssqp, row);
                const f32x4 g0 = acc[ai][0][m][0] * rs, g1 = acc[ai][0][m][1] * rs, u0 = acc[ai][1][m][0] * rs, u1 = acc[ai][1][m][1] * rs;
                u32x4 w;
                w.x = cvt_pk_bf16(silu_f(g0[0]) * u0[0], silu_f(g0[1]) * u0[1]); w.y = cvt_pk_bf16(silu_f(g0[2]) * u0[2], silu_f(g0[3]) * u0[3]);
                w.z = cvt_pk_bf16(silu_f(g1[0]) * u1[0], silu_f(g1[1]) * u1[1]); w.w = cvt_pk_bf16(silu_f(g1[2]) * u1[2], silu_f(g1[3]) * u1[3]);
                *(u32x4*)(O + (size_t)row * ldo + col0) = w;
            }
    }
};

struct EpiResid {
    static constexpr bool PERM = true, AFTER_DRAIN = false;
    const float* basef; const bf16_t* bhi; const unsigned char* blo; float* outf; bf16_t* ohi; unsigned char* olo; float* ssqp; float alpha; int aux;
    static constexpr float LOS = 4096.0f, LOI = 1.0f / 4096.0f;
    __device__ __forceinline__ static f32x4 up_bf(unsigned a, unsigned b) { return (f32x4){__uint_as_float(a << 16), __uint_as_float(a & 0xffff0000u), __uint_as_float(b << 16), __uint_as_float(b & 0xffff0000u)}; }
    __device__ __forceinline__ static f32x4 up_f8(unsigned w) { return (f32x4){__builtin_amdgcn_cvt_f32_fp8((int)w, 0), __builtin_amdgcn_cvt_f32_fp8((int)w, 1), __builtin_amdgcn_cvt_f32_fp8((int)w, 2), __builtin_amdgcn_cvt_f32_fp8((int)w, 3)} * LOI; }
    __device__ __forceinline__ static unsigned pk_f8(f32x4 r) {
        r = r * LOS;
#pragma unroll
        for (int i = 0; i < 4; ++i) r[i] = __builtin_amdgcn_fmed3f(r[i], -440.0f, 440.0f);
        int p = __builtin_amdgcn_cvt_pk_fp8_f32(r[0], r[1], 0, false); p = __builtin_amdgcn_cvt_pk_fp8_f32(r[2], r[3], p, true); return (unsigned)p; }
    __device__ __forceinline__ void operator()(const f32x4 (&acc)[2][2][4][2], const Unit& u, int wr, int wc, int fr, int fq) const {
        const int row0 = u.pm * BM + wr * 64 + fr, col0 = u.pn * BM + wc * 32 + 8 * fq;
#pragma unroll
        for (int ai = 0; ai < 2; ++ai)
#pragma unroll
            for (int m = 0; m < 4; ++m) {
                const int row = row0 + ai * HALF + m * 16; const size_t off = (size_t)row * 1024 + col0; float ss = 0.f;
#pragma unroll
                for (int bj = 0; bj < 2; ++bj) {
                    f32x4 b0, b1;
                    if (basef) { b0 = *(const f32x4*)(basef + off + bj * HALF); b1 = *(const f32x4*)(basef + off + bj * HALF + 4); }
                    else { const u32x4 h = *(const u32x4*)(bhi + off + bj * HALF); const u32x2 l = *(const u32x2*)(blo + off + bj * HALF); b0 = up_bf(h.x, h.y) + up_f8(l.x); b1 = up_bf(h.z, h.w) + up_f8(l.y); }
                    const f32x4 v0 = b0 + acc[ai][bj][m][0] * alpha, v1 = b1 + acc[ai][bj][m][1] * alpha;
                    if (aux) ss += ((v0[0] * v0[0] + v0[1] * v0[1]) + (v0[2] * v0[2] + v0[3] * v0[3])) + ((v1[0] * v1[0] + v1[1] * v1[1]) + (v1[2] * v1[2] + v1[3] * v1[3]));
                    if (outf) { *(f32x4*)(outf + off + bj * HALF) = v0; *(f32x4*)(outf + off + bj * HALF + 4) = v1; }
                    else { u32x4 h; h.x = cvt_pk_bf16(v0[0], v0[1]); h.y = cvt_pk_bf16(v0[2], v0[3]); h.z = cvt_pk_bf16(v1[0], v1[1]); h.w = cvt_pk_bf16(v1[2], v1[3]);
                        u32x2 l; l.x = pk_f8(v0 - up_bf(h.x, h.y)); l.y = pk_f8(v1 - up_bf(h.z, h.w));
                        *(u32x4*)(ohi + off + bj * HALF) = h; *(u32x2*)(olo + off + bj * HALF) = l; }
                }
                if (aux) { ss += __shfl_xor(ss, 16); ss += __shfl_xor(ss, 32); if (fq == 0) ssqp[(size_t)row * 16 + u.pn * 4 + wc] = ss; }
            }
    }
};

struct EpiWin {
    static constexpr bool PERM = true, AFTER_DRAIN = false;
    bf16_t* QO; bf16_t* KB; bf16_t* VB; bf16_t* RW; const float* ssqp; const float* gq; const float* gk; float qscale;
    __device__ __forceinline__ void operator()(const f32x4 (&acc)[2][2][4][2], const Unit& u, int wr, int wc, int fr, int fq) const {
        const int row0 = u.pm * BM + wr * 64 + fr; const int pn = u.pn;
        if (pn < 4) {
            const float* gp = (pn < 2) ? gq : gk; const float osc = (pn < 2) ? qscale : 1.0f;
            f32x4 gv[2][2];
#pragma unroll
            for (int bj = 0; bj < 2; ++bj)
#pragma unroll
                for (int n = 0; n < 2; ++n) gv[bj][n] = *(const f32x4*)(gp + 32 * bj + 8 * fq + 4 * n) * osc;
            bf16_t* dst = (pn < 2) ? QO : KB; const int ld = (pn < 2) ? 1024 : 512; const int colh = 64 * (4 * (pn & 1) + wc) + 8 * fq;
#pragma unroll
            for (int ai = 0; ai < 2; ++ai)
#pragma unroll
                for (int m = 0; m < 4; ++m) {
                    const int row = row0 + ai * HALF + m * 16; const float rs = row_rs(ssqp, row);
                    f32x4 y[2][2]; float ss = 0.f;
#pragma unroll
                    for (int bj = 0; bj < 2; ++bj)
#pragma unroll
                        for (int n = 0; n < 2; ++n) { y[bj][n] = acc[ai][bj][m][n] * rs; const f32x4 t = y[bj][n]; ss += (t[0] * t[0] + t[1] * t[1]) + (t[2] * t[2] + t[3] * t[3]); }
                    ss += __shfl_xor(ss, 16); ss += __shfl_xor(ss, 32);
                    const float hs = __builtin_amdgcn_rsqf(ss * (1.0f / 64.0f) + RMS_EPS_F);
#pragma unroll
                    for (int bj = 0; bj < 2; ++bj) {
                        const f32x4 a = y[bj][0] * gv[bj][0] * hs, b = y[bj][1] * gv[bj][1] * hs;
                        u32x4 w; w.x = cvt_pk_bf16(a[0], a[1]); w.y = cvt_pk_bf16(a[2], a[3]); w.z = cvt_pk_bf16(b[0], b[1]); w.w = cvt_pk_bf16(b[2], b[3]);
                        *(u32x4*)(dst + (size_t)row * ld + colh + 32 * bj) = w;
                    }
                }
        } else {
            bf16_t* dst = (pn < 6) ? VB : RW; const int ld = (pn < 6) ? 512 : 1792; const int colh = 256 * ((pn < 6) ? (pn - 4) : (pn - 6)) + 64 * wc + 8 * fq;
#pragma unroll
            for (int ai = 0; ai < 2; ++ai)
#pragma unroll
                for (int m = 0; m < 4; ++m) {
                    const int row = row0 + ai * HALF + m * 16; const float rs = row_rs(ssqp, row);
#pragma unroll
                    for (int bj = 0; bj < 2; ++bj) {
                        const f32x4 a = acc[ai][bj][m][0] * rs, b = acc[ai][bj][m][1] * rs;
                        u32x4 w; w.x = cvt_pk_bf16(a[0], a[1]); w.y = cvt_pk_bf16(a[2], a[3]); w.z = cvt_pk_bf16(b[0], b[1]); w.w = cvt_pk_bf16(b[2], b[3]);
                        *(u32x4*)(dst + (size_t)row * ld + colh + 32 * bj) = w;
                    }
                }
        }
    }
};

template <class Epi, class Sched, bool ALIGN_EPI = false, bool SP2 = false>
__device__ __forceinline__ void gemm_phase(PG8_LAS unsigned char* lds, const Gemm g, const Sched& S, const Epi& E) {
    const int tid = threadIdx.x, wid = __builtin_amdgcn_readfirstlane(tid >> 6), lane = tid & 63, wr = wid >> 2, wc = wid & 3, fr = lane & 15, fq = lane >> 4;
    const int K = g.K, nt = K / BK, LDP = g.ld ? g.ld : g.K;
    unsigned voffA[2], voffB[2];
#pragma unroll
    for (int i = 0; i < 2; ++i) { int R, C; stage_rc(tid * 16 + i * 8192, R, C); const int Rb = Epi::PERM ? ((R & ~31) + perm32(R & 31)) : R;
        voffA[i] = (unsigned)(R * LDP + C) * 2u; voffB[i] = (unsigned)(Rb * LDP + C) * 2u; }
    const size_t kstep = (size_t)(BK * 2);
    const size_t hstep = (size_t)HALF * LDP * 2;
    const size_t tstep = 2 * hstep;
    const unsigned ldsw = (unsigned)wid * 1024u;
    const int aoff = lds_byte(wr * 64 + fr, fq * 8), boff = lds_byte(wc * 32 + fr, fq * 8);
#define PG8_SA(b, h) (((b) * 2 + (h)) * HTB)
#define PG8_SB(b, h) ((4 + (b) * 2 + (h)) * HTB)
#define PG8_STAGE(bufoff, gbase, voff) do { _Pragma("unroll") for (int _i = 0; _i < 2; ++_i) \
        __builtin_amdgcn_global_load_lds((const unsigned*)((const char*)(gbase) + (voff)[_i]), (PG8_LAS unsigned*)(lds + (bufoff) + ldsw + _i * 8192), 16, 0, 0); } while (0)
#define PG8_LDA(dst, b, h) do { _Pragma("unroll") for (int m = 0; m < 4; ++m) _Pragma("unroll") for (int k = 0; k < 2; ++k) dst[m][k] = *(const PG8_LAS bf16x8*)(lds + PG8_SA(b, h) + aoff + m * 2048 + k * 1024); } while (0)
#define PG8_LDB(dst, b, h) do { _Pragma("unroll") for (int n = 0; n < 2; ++n) _Pragma("unroll") for (int k = 0; k < 2; ++k) dst[n][k] = *(const PG8_LAS bf16x8*)(lds + PG8_SB(b, h) + boff + n * 2048 + k * 1024); } while (0)
#define PG8_MMA(ai, bj, At, Bt) do { __builtin_amdgcn_s_setprio(1); _Pragma("unroll") for (int m = 0; m < 4; ++m) _Pragma("unroll") for (int n = 0; n < 2; ++n) _Pragma("unroll") for (int k = 0; k < 2; ++k) \
        acc[ai][bj][m][n] = __builtin_amdgcn_mfma_f32_16x16x32_bf16(Bt[n][k], At[m][k], acc[ai][bj][m][n], 0, 0, 0); __builtin_amdgcn_s_setprio(0); } while (0)
#define PG8_WAIT_V(n) asm volatile("s_waitcnt vmcnt(" #n ")" ::: "memory")
#define PG8_WAIT_L(n) asm volatile("s_waitcnt lgkmcnt(" #n ")" ::: "memory")
#define PG8_BAR __builtin_amdgcn_s_barrier()
#define PG8_SCHED __builtin_amdgcn_sched_barrier(0)
    Unit cur, nxt; int ui = 0;
    if (!S.next(0, cur)) return;
    f32x4 acc[2][2][4][2];
#pragma unroll
    for (int a = 0; a < 2; ++a)
#pragma unroll
        for (int b = 0; b < 2; ++b)
#pragma unroll
            for (int m = 0; m < 4; ++m)
#pragma unroll
                for (int n = 0; n < 2; ++n) acc[a][b][m][n] = (f32x4){0.f, 0.f, 0.f, 0.f};
    bf16x8 At[4][2], B0[2][2], B1[2][2];
    const char* cA = (const char*)g.A + (size_t)cur.pm * tstep; const char* cB = (const char*)g.Bt + (size_t)cur.pn * tstep;
    S.a_ready(cur);
    if constexpr (SP2) {
        PG8_STAGE(PG8_SB(0, 0), cB, voffB); PG8_STAGE(PG8_SB(0, 1), cB + hstep, voffB); PG8_STAGE(PG8_SA(0, 0), cA, voffA); PG8_STAGE(PG8_SA(0, 1), cA + hstep, voffA);
        if (wr == 1) PG8_BAR;
        PG8_WAIT_V(2); PG8_BAR;
        PG8_STAGE(PG8_SB(1, 0), cB + kstep, voffB); PG8_STAGE(PG8_SA(1, 0), cA + kstep, voffA); PG8_STAGE(PG8_SB(1, 1), cB + hstep + kstep, voffB);
        PG8_WAIT_V(6); PG8_BAR;
    } else {
        PG8_STAGE(PG8_SB(0, 0), cB, voffB); PG8_STAGE(PG8_SA(0, 0), cA, voffA); PG8_STAGE(PG8_SB(0, 1), cB + hstep, voffB); PG8_STAGE(PG8_SA(0, 1), cA + hstep, voffA);
        if (wr == 1) PG8_BAR;
        PG8_WAIT_V(4); PG8_BAR;
        PG8_STAGE(PG8_SB(1, 0), cB + kstep, voffB); PG8_STAGE(PG8_SA(1, 0), cA + kstep, voffA); PG8_STAGE(PG8_SB(1, 1), cB + hstep + kstep, voffB);
        PG8_WAIT_V(6); PG8_BAR;
    }
    for (;;) {
        const bool has_next = S.next(ui + 1, nxt);
        const char* nA = has_next ? (const char*)g.A + (size_t)nxt.pm * tstep : cA; const char* nB = has_next ? (const char*)g.Bt + (size_t)nxt.pn * tstep : cB;
        for (int t = 0; t < nt; t += 2) {
            const bool last = (t == nt - 2);
            const char* a1 = cA + (size_t)(t + 1) * kstep;
            const char* a2 = last ? nA : cA + (size_t)(t + 2) * kstep; const char* b2 = last ? nB : cB + (size_t)(t + 2) * kstep;
            const char* a3 = a2 + kstep; const char* b3 = b2 + kstep;
            if (last && has_next) S.a_ready(nxt);
            if constexpr (SP2) {
            PG8_LDB(B0, 0, 0); PG8_LDB(B1, 0, 1); PG8_SCHED; PG8_LDA(At, 0, 0); PG8_STAGE(PG8_SA(1, 1), a1 + hstep, voffA);
            PG8_WAIT_V(8); PG8_WAIT_L(0); PG8_BAR; PG8_MMA(0, 0, At, B0); PG8_MMA(0, 1, At, B1); PG8_BAR; PG8_SCHED;
            PG8_LDA(At, 0, 1); PG8_STAGE(PG8_SB(0, 0), b2, voffB); PG8_STAGE(PG8_SB(0, 1), b2 + hstep, voffB); PG8_STAGE(PG8_SA(0, 0), a2, voffA);
            PG8_WAIT_V(8); PG8_WAIT_L(0); PG8_BAR; PG8_MMA(1, 0, At, B0); PG8_MMA(1, 1, At, B1); PG8_BAR; PG8_SCHED;
            PG8_LDB(B0, 1, 0); PG8_LDB(B1, 1, 1); PG8_SCHED; PG8_LDA(At, 1, 0); PG8_STAGE(PG8_SA(0, 1), a2 + hstep, voffA);
            PG8_WAIT_V(8); PG8_WAIT_L(0); PG8_BAR; PG8_MMA(0, 0, At, B0); PG8_MMA(0, 1, At, B1); PG8_BAR; PG8_SCHED;
            PG8_LDA(At, 1, 1); PG8_STAGE(PG8_SB(1, 0), b3, voffB); PG8_STAGE(PG8_SB(1, 1), b3 + hstep, voffB); PG8_STAGE(PG8_SA(1, 0), a3, voffA);
            PG8_WAIT_V(8); PG8_WAIT_L(0); PG8_BAR; PG8_MMA(1, 0, At, B0); PG8_MMA(1, 1, At, B1); PG8_BAR; PG8_SCHED;
            } else {
            PG8_LDB(B0, 0, 0); PG8_SCHED; PG8_LDA(At, 0, 0); PG8_STAGE(PG8_SA(1, 1), a1 + hstep, voffA);
            PG8_WAIT_L(8); PG8_BAR; PG8_WAIT_L(0); PG8_MMA(0, 0, At, B0); PG8_BAR; PG8_SCHED;
            PG8_LDB(B1, 0, 1); PG8_STAGE(PG8_SB(0, 0), b2, voffB);
            PG8_BAR; PG8_WAIT_L(0); PG8_MMA(0, 1, At, B1); PG8_BAR;
            PG8_LDA(At, 0, 1); PG8_STAGE(PG8_SA(0, 0), a2, voffA);
            PG8_BAR; PG8_WAIT_L(0); PG8_MMA(1, 0, At, B0); PG8_BAR; PG8_SCHED;
            PG8_STAGE(PG8_SB(0, 1), b2 + hstep, voffB);
            PG8_WAIT_V(6); PG8_BAR; PG8_MMA(1, 1, At, B1); PG8_BAR;
            PG8_LDB(B0, 1, 0); PG8_SCHED; PG8_LDA(At, 1, 0); PG8_STAGE(PG8_SA(0, 1), a2 + hstep, voffA);
            PG8_WAIT_L(8); PG8_BAR; PG8_WAIT_L(0); PG8_MMA(0, 0, At, B0); PG8_BAR; PG8_SCHED;
            PG8_LDB(B1, 1, 1); PG8_STAGE(PG8_SB(1, 0), b3, voffB);
            PG8_BAR; PG8_WAIT_L(0); PG8_MMA(0, 1, At, B1); PG8_BAR;
            PG8_LDA(At, 1, 1); PG8_STAGE(PG8_SA(1, 0), a3, voffA);
            PG8_BAR; PG8_WAIT_L(0); PG8_MMA(1, 0, At, B0); PG8_BAR; PG8_SCHED;
            PG8_STAGE(PG8_SB(1, 1), b3 + hstep, voffB);
            PG8_WAIT_V(6); PG8_BAR; PG8_MMA(1, 1, At, B1); PG8_BAR;
            }
        }
        if constexpr (ALIGN_EPI) { if (wr == 0) PG8_BAR; }
        if constexpr (!Epi::AFTER_DRAIN) { E(acc, cur, wr, wc, fr, fq); S.done(cur); }
        if (!has_next) break;
#pragma unroll
        for (int a = 0; a < 2; ++a)
#pragma unroll
            for (int b = 0; b < 2; ++b)
#pragma unroll
                for (int m = 0; m < 4; ++m)
#pragma unroll
                    for (int n = 0; n < 2; ++n) acc[a][b][m][n] = (f32x4){0.f, 0.f, 0.f, 0.f};
        cur = nxt; cA = nA; cB = nB; ++ui;
        if constexpr (ALIGN_EPI) { if (wr == 1) PG8_BAR; }
    }
    PG8_WAIT_V(0);
    if constexpr (!ALIGN_EPI) { if (wr == 0) PG8_BAR; }
    PG8_BAR;
    if constexpr (Epi::AFTER_DRAIN) { E.fused(acc, cur, wr, wc, fr, fq, lds, wid, lane); S.done(cur); }
#undef PG8_SA
#undef PG8_SB
#undef PG8_STAGE
#undef PG8_LDA
#undef PG8_LDB
#undef PG8_MMA
#undef PG8_WAIT_V
#undef PG8_WAIT_L
#undef PG8_BAR
#undef PG8_SCHED
}
}
#define GAS __attribute__((address_space(1)))
#define LAS __attribute__((address_space(3)))
typedef unsigned short bf16;
typedef unsigned v4u __attribute__((ext_vector_type(4)));
typedef float f32x4 __attribute__((ext_vector_type(4)));
typedef short bf16x8 __attribute__((ext_vector_type(8)));
typedef GAS unsigned gu32;
typedef GAS unsigned long long gu64;
#define RLX_AGENT __ATOMIC_RELAXED, __HIP_MEMORY_SCOPE_AGENT
#define LDS_WAIT() asm volatile("s_waitcnt lgkmcnt(0)" ::: "memory")
#define VM_WAIT() asm volatile("s_waitcnt vmcnt(0)" ::: "memory")
__device__ __forceinline__ unsigned long long rt() { return __builtin_amdgcn_s_memrealtime(); }
__device__ __forceinline__ unsigned f2bf(float f) { unsigned u = __builtin_bit_cast(unsigned, f); return (u + 0x7fffu + ((u >> 16) & 1u)) >> 16; }
__device__ __forceinline__ unsigned pk2(float lo, float hi) { return f2bf(lo) | (f2bf(hi) << 16); }

#define XB_TMO      128
#define XB_XCNT(j)  (256  + 64 * (j))
#define XB_XSUB(j)  (1280 + 64 * (j))
#define XB_XGEN(j)  (2304 + 64 * (j))
#define XB_TOP      3328
#define XB_TOPGEN   3392
#define XCD_BAR_WORDS 3456
#define XB_SPIN_CAP (1u << 18)

__device__ __forceinline__ unsigned xb_ld(unsigned* p)              { return __hip_atomic_load(p, __ATOMIC_RELAXED, __HIP_MEMORY_SCOPE_AGENT); }
__device__ __forceinline__ unsigned xb_add(unsigned* p, unsigned v) { return __hip_atomic_fetch_add(p, v, __ATOMIC_RELAXED, __HIP_MEMORY_SCOPE_AGENT); }
__device__ __forceinline__ unsigned xb_xcc_id() { return (unsigned)__builtin_amdgcn_s_getreg((3 << 11) | 20) & 0xFu; }
#define XB_SPIN(cond, bar) do { unsigned _sp = 0; while (cond) { __builtin_amdgcn_s_sleep(1); \
    if ((++_sp & 255u) == 0u) { if (xb_ld(&(bar)[XB_TMO])) break; if (_sp > XB_SPIN_CAP) { atomicAdd(&(bar)[XB_TMO], 1u); break; } } } } while (0)

struct XcdBarrier {
    unsigned* bar; unsigned x;
    volatile LAS unsigned* st;
};

__device__ __forceinline__ XcdBarrier xcd_barrier_post(unsigned* bar, volatile LAS unsigned* st) {
    XcdBarrier b; b.bar = bar; b.x = xb_xcc_id(); b.st = st;
    if (threadIdx.x == 0) (void)xb_add(&bar[XB_XCNT(b.x)], 1u);
    return b;
}
__device__ __forceinline__ void xcd_barrier_complete(unsigned* bar, unsigned x, unsigned& nloc, unsigned& nx) {
    const unsigned G = gridDim.x * gridDim.y * gridDim.z;
    unsigned sum, cnt, mine, sp = 0u;
    for (;;) {
        sum = 0u; cnt = 0u; mine = 0u;
#pragma unroll
        for (unsigned j = 0; j < 16; ++j) { const unsigned c = xb_ld(&bar[XB_XCNT(j)]); sum += c; cnt += (c > 0u) ? 1u : 0u; mine = (j == x) ? c : mine; }
        if (sum == G) break;
        __builtin_amdgcn_s_sleep(1);
        if ((++sp & 255u) == 0u) { if (xb_ld(&bar[XB_TMO])) break; if (sp > XB_SPIN_CAP) { atomicAdd(&bar[XB_TMO], 1u); break; } }
    }
    nloc = mine > 0u ? mine : 1u; nx = cnt > 0u ? cnt : 1u;
}

__device__ __forceinline__ void xcd_barrier(const XcdBarrier& b) {
    asm volatile("s_waitcnt vmcnt(0)" ::: "memory");
    __syncthreads();
    if (threadIdx.x == 0) {
        unsigned* bar = b.bar;
        __builtin_amdgcn_s_waitcnt(0);
        unsigned nloc = b.st[0], nx = b.st[1];
        if (nloc == 0u) { xcd_barrier_complete(bar, b.x, nloc, nx); b.st[0] = nloc; b.st[1] = nx; }
        const unsigned old = xb_add(&bar[XB_XSUB(b.x)], 1u);
        const unsigned gen = old / nloc;
        if (old + 1u == (gen + 1u) * nloc) {
            __builtin_amdgcn_fence(__ATOMIC_RELEASE, "agent");
            asm volatile("s_waitcnt vmcnt(0)" ::: "memory");
            const unsigned og = xb_add(&bar[XB_TOP], 1u);
            const unsigned tg = og / nx;
            if (og + 1u == (tg + 1u) * nx) xb_add(&bar[XB_TOPGEN], 1u);
            else XB_SPIN(xb_ld(&bar[XB_TOPGEN]) == tg, bar);
            __builtin_amdgcn_fence(__ATOMIC_ACQUIRE, "agent");
            xb_add(&bar[XB_XGEN(b.x)], 1u);
            asm volatile("s_waitcnt vmcnt(0)" ::: "memory");
        } else {
            XB_SPIN(xb_ld(&bar[XB_XGEN(b.x)]) == gen, bar);
            __builtin_amdgcn_fence(__ATOMIC_ACQUIRE, "agent");
            asm volatile("s_waitcnt vmcnt(0)" ::: "memory");
        }
    }
    __syncthreads();
}

constexpr int NWAVES = 8;
#ifndef MK_N_LAUNCHES
#define MK_N_LAUNCHES 1
#endif
constexpr int PER_PHASE = 11;
constexpr int N_LAUNCHES = MK_N_LAUNCHES;

constexpr int BATCH = 16, SEQ = 2048, D = 1024, HD = 64, NH = 8, FF = 2816;
constexpr int M = BATCH * SEQ;
constexpr int SBW = 512, RWW = 512, RWP = 1792, PW = 3328, LORA_K = 256, LORA_N = 1536;
constexpr float LNX_EPS = 64e-5f;

constexpr size_t MiB = 1u << 20;
constexpr size_t WS_CTL = 0, CTL_ZERO_BYTES = 1 * MiB;
constexpr size_t WS_SSQ = 1 * MiB;
constexpr size_t WS_W1U = 4 * MiB;
constexpr size_t WS_W1D = 15 * MiB;
constexpr size_t WS_W2U = 21 * MiB;
constexpr size_t WS_W2D = 32 * MiB;
constexpr size_t WS_WIN = 38 * MiB;
constexpr size_t WS_WOUT = 45 * MiB;
constexpr size_t WS_WLORA = 47 * MiB;
constexpr size_t WS_XB = 48 * MiB;
constexpr size_t WS_ACT = 112 * MiB;
constexpr size_t WS_QO = 112 * MiB;
constexpr size_t WS_KB = 176 * MiB;
constexpr size_t WS_VB = 208 * MiB;
constexpr size_t WS_RW = 240 * MiB;
constexpr size_t WS_ALORA = 352 * MiB;
constexpr size_t WS_LW = 368 * MiB;
constexpr size_t WS_AB = 432 * MiB;
constexpr size_t WS_GB = 464 * MiB;
constexpr size_t WS_TAIL = 496 * MiB;
constexpr size_t WS_END = 512 * MiB;
constexpr int CW_TMO = 0, CW_CODE = 1;
constexpr int CW_BAR = 4096;
constexpr int CW_QUEUE = 16384;

constexpr int RING_OFF = 0, RING_BYTES = 155648;
constexpr int LDSCTL_OFF = RING_BYTES, MISC_OFF = LDSCTL_OFF;
constexpr int LDS_BYTES = 163840;

struct Frame {
    LAS unsigned char* lds;
    volatile LAS unsigned* MISC;
    gu32* ctl;
    int tid, lane, wave;
    int vcu, G;
};
typedef unsigned u32x2g __attribute__((ext_vector_type(2)));
__device__ __forceinline__ float bf2f(unsigned short h) { return __uint_as_float(((unsigned)h) << 16); }
typedef float f32x2h __attribute__((ext_vector_type(2))); typedef __bf16 bf16x2h __attribute__((ext_vector_type(2)));
__device__ __forceinline__ unsigned pkbf(float lo, float hi) { f32x2h v = {lo, hi}; bf16x2h b = __builtin_convertvector(v, bf16x2h); return __builtin_bit_cast(unsigned, b); }
__device__ __forceinline__ float bflo(unsigned w) { return __uint_as_float(w << 16); }
__device__ __forceinline__ float bfhi(unsigned w) { return __uint_as_float(w & 0xffff0000u); }
__device__ __forceinline__ float wave_sum(float v) {
#pragma unroll
    for (int o = 1; o < 64; o <<= 1) v += __shfl_xor(v, o);
    return v;
}
#define DPP_ADD(v, ctrl) ((v) + __int_as_float(__builtin_amdgcn_update_dpp(0, __float_as_int(v), (ctrl), 0xF, 0xF, true)))
__device__ __forceinline__ float sum8(float v) { v = DPP_ADD(v, 0xB1); v = DPP_ADD(v, 0x4E); v = DPP_ADD(v, 0x141); return v; }

struct TItem { const float* W; int ldw, k0, n0; const float* sc; bf16* WT; int Kd, rho0; };
__device__ __forceinline__ void ti_load(const TItem& T, float (&t)[32], int lane) {
#pragma unroll
    for (int i = 0; i < 32; ++i) t[i] = T.W[(size_t)(T.k0 + 2 * i + (lane >> 5)) * T.ldw + T.n0 + (lane & 31)];
}
__device__ __forceinline__ void ti_finish(const TItem& T, const float (&t)[32], LAS float* scr, int lane) {
#pragma unroll
    for (int i = 0; i < 32; ++i) scr[(2 * i + (lane >> 5)) * 33 + (lane & 31)] = t[i];
    LDS_WAIT(); asm volatile("" ::: "memory");
    const int c = lane & 7;
    f32x4 s0 = (f32x4){1.f, 1.f, 1.f, 1.f}, s1 = s0;
    if (T.sc) { s0 = *(const f32x4*)(T.sc + T.k0 + 8 * c); s1 = *(const f32x4*)(T.sc + T.k0 + 8 * c + 4); }
#pragma unroll
    for (int j = 0; j < 4; ++j) { const int n = (lane >> 3) + 8 * j; const LAS float* s = scr + (8 * c) * 33 + n;
        v4u o; o.x = pkbf(s[0 * 33] * s0.x, s[1 * 33] * s0.y); o.y = pkbf(s[2 * 33] * s0.z, s[3 * 33] * s0.w); o.z = pkbf(s[4 * 33] * s1.x, s[5 * 33] * s1.y); o.w = pkbf(s[6 * 33] * s1.z, s[7 * 33] * s1.w);
        *(GAS v4u*)(T.WT + (size_t)(T.rho0 + n) * T.Kd + T.k0 + 8 * c) = o; }
    LDS_WAIT(); asm volatile("" ::: "memory");
}
#define P0_PTRS const float* Ax, const float* An1, const float* Ag1, const float* Au1, const float* Ad1, const float* Anm, const float* Awin, const float* Aw2, const float* Aa2, const float* Ag2, const float* Awout, \
    const float* An2, const float* Ag2f, const float* Au2f, const float* Ad2f, bf16* AW1U, bf16* AW1D, bf16* AW2U, bf16* AW2D, bf16* AWIN, bf16* AWOUT, bf16* AWLORA, bf16* AXB, float* ASSQ
__device__ __forceinline__ void p0_items(Frame& F, P0_PTRS, int set, int gw, int NGW) {
    LAS float* scr = (LAS float*)(F.lds + RING_OFF + F.wave * 16384);
    constexpr int I_UP = 16 * 176, I_DN = 44 * 32, I_IN = 16 * 104, I_OUT = 16 * 32;
    const int NITEMS = set ? (I_UP + I_DN) : (I_UP + I_DN + I_IN + I_OUT);
#define P0_DECODE(it_, T) do { int r = (it_); const int l2 = set; \
        if (r < I_UP) { const int kb = r / 176, nb = r % 176, rho0 = 32 * nb, pn = rho0 >> 8, bj = (rho0 >> 7) & 1, j0 = rho0 & 127; \
            T = TItem{l2 ? (bj ? Au2f : Ag2f) : (bj ? Au1 : Ag1), FF, 64 * kb, 128 * pn + j0, l2 ? An2 : An1, l2 ? AW2U : AW1U, D, rho0}; } \
        else if ((r -= I_UP) < I_DN) { const int kb = r / 32, nb = r % 32; \
            T = TItem{l2 ? Ad2f : Ad1, D, 64 * kb, 32 * nb, nullptr, l2 ? AW2D : AW1D, FF, 32 * nb}; } \
        else if ((r -= I_DN) < I_IN) { const int kb = r / 104, nb = r % 104, rho0 = 32 * nb, pn = rho0 >> 8, rem = rho0 & 255, bj = rem >> 7, wc = (rem & 127) >> 5; \
            T = TItem{Awin, PW, 64 * kb, 256 * pn + 64 * wc + 32 * bj, Anm, AWIN, D, rho0}; } \
        else { r -= I_IN; const int kb = r / 32, nb = r % 32; T = TItem{Awout, D, 64 * kb, 32 * nb, nullptr, AWOUT, D, 32 * nb}; } } while (0)
    for (int it = gw; it < NITEMS; it += 2 * NGW) {
        TItem T0, T1; float t0[32], t1[32]; const bool two = (it + NGW < NITEMS);
        P0_DECODE(it, T0); ti_load(T0, t0, F.lane);
        if (two) { P0_DECODE(it + NGW, T1); ti_load(T1, t1, F.lane); }
        ti_finish(T0, t0, scr, F.lane);
        if (two) ti_finish(T1, t1, scr, F.lane);
    }
#undef P0_DECODE
}
__device__ __forceinline__ void p0_prologue(Frame& F, P0_PTRS) {
    const int gw = F.vcu * NWAVES + F.wave, NGW = F.G * NWAVES;
    p0_items(F, Ax, An1, Ag1, Au1, Ad1, Anm, Awin, Aw2, Aa2, Ag2, Awout, An2, Ag2f, Au2f, Ad2f, AW1U, AW1D, AW2U, AW2D, AWIN, AWOUT, AWLORA, AXB, ASSQ, (F.G >= 256) ? 0 : 0, gw, NGW);
    if (F.G < 256) p0_items(F, Ax, An1, Ag1, Au1, Ad1, Anm, Awin, Aw2, Aa2, Ag2, Awout, An2, Ag2f, Au2f, Ad2f, AW1U, AW1D, AW2U, AW2D, AWIN, AWOUT, AWLORA, AXB, ASSQ, 1, gw, NGW);
    for (int it = F.vcu * (NWAVES * 64) + F.tid; it < 512 * 32; it += F.G * NWAVES * 64) {
        int ch, kc, Kk; const float* src; bf16* dst;
        if (it < 512 * 8) { ch = it >> 3; kc = (it & 7) * 8; Kk = 64; src = Aw2; dst = AWLORA; }
        else if (it < 512 * 16) { const int i2 = it - 512 * 8; ch = i2 >> 3; kc = (i2 & 7) * 8; Kk = 64; src = Aa2; dst = AWLORA + 512 * 64; }
        else { const int i2 = it - 512 * 16; ch = i2 >> 4; kc = (i2 & 15) * 8; Kk = 128; src = Ag2; dst = AWLORA + 2 * 512 * 64; }
        float v[8];
#pragma unroll
        for (int j = 0; j < 8; ++j) v[j] = src[(size_t)(kc + j) * 512 + ch];
        v4u o; o.x = pkbf(v[0], v[1]); o.y = pkbf(v[2], v[3]); o.z = pkbf(v[4], v[5]); o.w = pkbf(v[6], v[7]);
        *(GAS v4u*)(dst + (size_t)ch * Kk + kc) = o;
    }
    for (int mb = gw; mb < M; mb += 4 * NGW) {
        f32x4 v[4][4]; float s[4];
#pragma unroll
        for (int q = 0; q < 4; ++q) { const int m = mb + q * NGW; const GAS f32x4* xr = (const GAS f32x4*)(Ax + (size_t)(m < M ? m : mb) * D) + F.lane;
#pragma unroll
            for (int j = 0; j < 4; ++j) v[q][j] = xr[64 * j]; }
#pragma unroll
        for (int q = 0; q < 4; ++q) { float a = 0.f;
#pragma unroll
            for (int j = 0; j < 4; ++j) a += (v[q][j].x * v[q][j].x + v[q][j].y * v[q][j].y) + (v[q][j].z * v[q][j].z + v[q][j].w * v[q][j].w);
            s[q] = a; }
#pragma unroll
        for (int o = 1; o < 64; o <<= 1) {
#pragma unroll
            for (int q = 0; q < 4; ++q) s[q] += __shfl_xor(s[q], o); }
#pragma unroll
        for (int q = 0; q < 4; ++q) { const int m = mb + q * NGW; if (m < M) {
            GAS unsigned long long* o8 = (GAS unsigned long long*)(AXB + (size_t)m * D) + F.lane;
#pragma unroll
            for (int j = 0; j < 4; ++j) o8[64 * j] = (unsigned long long)pkbf(v[q][j].x, v[q][j].y) | ((unsigned long long)pkbf(v[q][j].z, v[q][j].w) << 32);
            if (F.lane < 16) ASSQ[(size_t)m * 16 + F.lane] = (F.lane == 0) ? s[q] : 0.f; } }
    }
}

struct RwArgs { const bf16* RW; const bf16* W2T; const bf16* A2T; const bf16* G2T; const float* w0; const float* a0; bf16* QO; const float *mu, *k_k, *k_a, *r_k, *ln_w, *ln_b; };
__device__ __forceinline__ void ld8bf(const bf16* p, float (&o)[8]) { const v4u w = *(const v4u*)p; o[0] = bflo(w.x); o[1] = bfhi(w.x); o[2] = bflo(w.y); o[3] = bfhi(w.y); o[4] = bflo(w.z); o[5] = bfhi(w.z); o[6] = bflo(w.w); o[7] = bfhi(w.w); }
__device__ __forceinline__ void ld8f(const float* p, float (&o)[8]) { const f32x4 a = *(const f32x4*)p, b = *(const f32x4*)(p + 4); o[0] = a.x; o[1] = a.y; o[2] = a.z; o[3] = a.w; o[4] = b.x; o[5] = b.y; o[6] = b.z; o[7] = b.w; }
__device__ __forceinline__ void ld8l(const LAS float* p, float (&o)[8]) { const f32x4 a = *(const LAS f32x4*)p, b = *(const LAS f32x4*)(p + 4); o[0] = a.x; o[1] = a.y; o[2] = a.z; o[3] = a.w; o[4] = b.x; o[5] = b.y; o[6] = b.z; o[7] = b.w; }
__device__ __forceinline__ void st8l(LAS float* p, const float (&o)[8]) { *(LAS f32x4*)p = (f32x4){o[0], o[1], o[2], o[3]}; *(LAS f32x4*)(p + 4) = (f32x4){o[4], o[5], o[6], o[7]}; }
namespace rwk {
typedef short bf16x8 __attribute__((ext_vector_type(8)));
typedef short s16x4 __attribute__((ext_vector_type(4)));
typedef short v4i16_t __attribute__((ext_vector_type(4)));
constexpr int SLOT = 8192;
#define RSL(s) (lds + (s) * SLOT)
#define RMFMA(a, b, c) __builtin_amdgcn_mfma_f32_16x16x32_bf16((a), (b), (c), 0, 0, 0)
__device__ __forceinline__ int swz(int row, int cb) { return row * 128 + (cb ^ ((row & 7) << 4)); }
struct Fr2 { bf16x8 k0, k1; };
__device__ __forceinline__ Fr2 ldf(const LAS unsigned char* base, int off) { Fr2 f; f.k0 = *(const LAS bf16x8*)(base + off); f.k1 = *(const LAS bf16x8*)(base + (off ^ 64)); return f; }
__device__ __forceinline__ s16x4 trd(const LAS unsigned char* p) { return __builtin_bit_cast(s16x4, __builtin_amdgcn_ds_read_tr16_b64_v4i16((LAS v4i16_t*)p)); }
__device__ __forceinline__ Fr2 ldt(const LAS unsigned char* base, int o0, int o1) {
    const s16x4 a = trd(base + o0), b = trd(base + o1), c = trd(base + o0 + 4096), d = trd(base + o1 + 4096);
    Fr2 f; f.k0 = (bf16x8){a[0], a[1], a[2], a[3], b[0], b[1], b[2], b[3]}; f.k1 = (bf16x8){c[0], c[1], c[2], c[3], d[0], d[1], d[2], d[3]}; return f; }
template <bool SWAP> __device__ __forceinline__ f32x4 mm(const Fr2& a, const Fr2& b, f32x4 c) {
    if (SWAP) { c = RMFMA(b.k0, a.k0, c); c = RMFMA(b.k1, a.k1, c); } else { c = RMFMA(a.k0, b.k0, c); c = RMFMA(a.k1, b.k1, c); } return c; }
__device__ __forceinline__ void st4(LAS unsigned char* slot, int off, f32x4 v) { u32x2g w; w.x = pkbf(v[0], v[1]); w.y = pkbf(v[2], v[3]); *(LAS u32x2g*)(slot + off) = w; }
__device__ __forceinline__ f32x4 ld4(const LAS unsigned char* slot, int off) { const u32x2g w = *(const LAS u32x2g*)(slot + off); return (f32x4){bflo(w.x), bfhi(w.x), bflo(w.y), bfhi(w.y)}; }
#define LBAR() asm volatile("s_waitcnt lgkmcnt(0)\n\ts_barrier" ::: "memory")
#define DPPF(x, ctrl, rmask) __int_as_float(__builtin_amdgcn_update_dpp(0, __float_as_int(x), (ctrl), (rmask), 0xF, true))
__device__ __forceinline__ float wave_scan(float x) {
    x += DPPF(x, 0x111, 0xF); x += DPPF(x, 0x112, 0xF); x += DPPF(x, 0x114, 0xF); x += DPPF(x, 0x118, 0xF);
    x += DPPF(x, 0x142, 0xA);
    x += DPPF(x, 0x143, 0xC);
    return x; }
__device__ __forceinline__ void unp8(const v4u w, float (&o)[8]) { o[0] = bflo(w.x); o[1] = bfhi(w.x); o[2] = bflo(w.y); o[3] = bfhi(w.y); o[4] = bflo(w.z); o[5] = bfhi(w.z); o[6] = bflo(w.w); o[7] = bfhi(w.w); }
__device__ __forceinline__ v4u pk8(const float (&o)[8]) { return (v4u){pkbf(o[0], o[1]), pkbf(o[2], o[3]), pkbf(o[4], o[5]), pkbf(o[6], o[7])}; }
}
struct RwX { bf16* P1; bf16* GT; bf16* Y0; bf16* H; bf16* VB0; bf16* VB1; float* GE; bf16* G; };
__device__ __forceinline__ void p6a_rwkv_local(Frame& F, const RwArgs& A, const RwX& X) {
    using namespace rwk;
    LAS unsigned char* lds = F.lds + RING_OFF;
    LAS float* part = (LAS float*)(F.lds + LDSCTL_OFF + 128);
    LAS float* cst = (LAS float*)(F.lds + LDSCTL_OFF + 128 + 4096 + 896);
    const int lane = F.lane, fr = lane & 15, fq = lane >> 4, w = F.wave, m0 = 16 * (w >> 1), n0a = 32 * (w & 1);
    const int fm = swz(m0 + fr, fq * 16);
    const int ta0 = swz(8 * fq + (fr >> 2), 2 * (m0 + 4 * (fr & 3))), ta1 = swz(8 * fq + 4 + (fr >> 2), 2 * (m0 + 4 * (fr & 3)));
    int fn[2], orm[2], otr[2], tb0[2], tb1[2];
#pragma unroll
    for (int t = 0; t < 2; ++t) { const int n0 = n0a + 16 * t; fn[t] = swz(n0 + fr, fq * 16); orm[t] = swz(m0 + fr, 2 * (n0 + 4 * fq)); otr[t] = swz(n0 + fr, 2 * (m0 + 4 * fq));
        tb0[t] = swz(8 * fq + (fr >> 2), 2 * (n0 + 4 * (fr & 3))); tb1[t] = swz(8 * fq + 4 + (fr >> 2), 2 * (n0 + 4 * (fr & 3))); }
    const int NJ = BATCH * NH * (SEQ / 64);
    const int tid = F.tid, ltok = tid >> 3, ldg = tid & 7;
    v4u g_r, g_k, g_v, g_xw, g_xa, g_xg0, g_xg1, g_pr;
#define P6A_LOAD(jj) do { const int u_ = (jj) >> 5, c_ = (jj) & 31; const size_t gr_ = (size_t)(u_ >> 3) * SEQ + c_ * 64 + ltok; const int cb_ = 64 * (u_ & 7) + 8 * ldg; const bf16* rp_ = A.RW + gr_ * RWP; \
        g_r = *(const v4u*)(rp_ + cb_); g_k = *(const v4u*)(rp_ + 512 + cb_); g_v = *(const v4u*)(rp_ + 1024 + cb_); \
        g_xw = *(const v4u*)(rp_ + 1536 + 8 * ldg); g_xa = *(const v4u*)(rp_ + 1600 + 8 * ldg); g_xg0 = *(const v4u*)(rp_ + 1664 + 8 * ldg); g_xg1 = *(const v4u*)(rp_ + 1728 + 8 * ldg); \
        g_pr = (v4u){0u, 0u, 0u, 0u}; if (ltok < 7 && c_ > 0) g_pr = *(const v4u*)(A.RW + ((size_t)(u_ >> 3) * SEQ + c_ * 64 - 1) * RWP + (ltok < 3 ? 512 * ltok + cb_ : 1536 + 64 * (ltok - 3) + 8 * ldg)); } while (0)
    if ((int)blockIdx.x < NJ) P6A_LOAD((int)blockIdx.x);
    int hcur = -1;
    LAS unsigned char* prow = (LAS unsigned char*)(F.lds + LDSCTL_OFF + 128 + 4096);
    if (tid < 256) cst[512 + tid] = A.mu[1536 + tid];
    u32x2g s_p1[2], s_gt[2], s_y0[2], s_hh[2]; size_t s_jo = 0; bool s_have = false;
#define P6A_STORE() do { _Pragma("unroll") for (int t = 0; t < 2; ++t) { \
            *(u32x2g*)(X.P1 + s_jo + ((w * 2 + t) * 64 + lane) * 4) = s_p1[t]; *(u32x2g*)(X.GT + s_jo + ((w * 2 + t) * 64 + lane) * 4) = s_gt[t]; \
            *(u32x2g*)(X.Y0 + s_jo + ((w * 2 + t) * 64 + lane) * 4) = s_y0[t]; *(u32x2g*)(X.H + s_jo + ((w * 2 + t) * 64 + lane) * 4) = s_hh[t]; } } while (0)
    for (int job = blockIdx.x; job < NJ; job += F.G) {
        const int unit = job >> 5, c = job & 31; const int h = unit & 7; const int cb = 64 * h + 8 * w; const size_t jo = (size_t)job * 4096;
        {
            const int so = swz(ltok, 16 * ldg);
            *(LAS v4u*)(RSL(12) + so) = g_r; *(LAS v4u*)(RSL(2) + so) = g_k; *(LAS v4u*)(RSL(0) + so) = g_v;
            *(LAS v4u*)(RSL(14) + so) = g_xw; *(LAS v4u*)(RSL(13) + so) = g_xa; *(LAS v4u*)(RSL(10) + so) = g_xg0; *(LAS v4u*)(RSL(11) + so) = g_xg1;
            if (ltok < 7) *(LAS v4u*)(prow + ltok * 128 + 16 * ldg) = g_pr;
            if (h != hcur) {
                *(LAS v4u*)(RSL(16) + so) = *(const v4u*)(A.W2T + (size_t)(64 * h + ltok) * 64 + 8 * ldg); *(LAS v4u*)(RSL(17) + so) = *(const v4u*)(A.A2T + (size_t)(64 * h + ltok) * 64 + 8 * ldg);
                { const int a_ = tid >> 6, i_ = tid & 63;
                  const float* src_ = (a_ == 0) ? A.mu : (a_ == 1) ? A.mu + 512 : (a_ == 2) ? A.mu + 1024 : (a_ == 3) ? A.k_k : (a_ == 4) ? A.k_a : (a_ == 5) ? A.r_k : (a_ == 6) ? A.w0 : A.a0;
                  cst[a_ * 64 + i_] = src_[64 * h + i_]; } }
            hcur = h;
        }
        if (s_have) P6A_STORE();
        { const int nj = job + F.G; if (nj < NJ) P6A_LOAD(nj); }
        LBAR();
        float r[8], k[8], v[8];
        {
            const int so = swz(lane, 16 * w), sp = swz((lane + 63) & 63, 16 * w);
#define P6A_SHIFT(slot, pi, moff, dst) do { float c_[8], p_[8], m_[8]; v4u wc_ = *(const LAS v4u*)(RSL(slot) + so), wp_ = *(const LAS v4u*)(RSL(slot) + sp); \
                if (lane == 0) wp_ = *(const LAS v4u*)(prow + 128 * (pi) + 16 * w); \
                unp8(wc_, c_); unp8(wp_, p_); ld8l(cst + (moff) + 8 * w, m_); \
                _Pragma("unroll") for (int j = 0; j < 8; ++j) dst[j] = c_[j] + (p_[j] - c_[j]) * m_[j]; } while (0)
            P6A_SHIFT(12, 0, 0, r);
            P6A_SHIFT(2, 1, 64, k);
            P6A_SHIFT(0, 2, 128, v); asm volatile("" ::: "memory");
            { float x_[8]; P6A_SHIFT(14, 3, 512, x_);
#pragma unroll
              for (int j = 0; j < 8; ++j) x_[j] = 2.0f * pg8::sigmoid_f(2.0f * x_[j]) - 1.0f;
              *(LAS v4u*)(RSL(14) + so) = pk8(x_); }
            { float x_[8]; P6A_SHIFT(13, 4, 576, x_); *(LAS v4u*)(RSL(13) + so) = pk8(x_); } asm volatile("" ::: "memory");
            { float x_[8]; P6A_SHIFT(10, 5, 640, x_);
#pragma unroll
              for (int j = 0; j < 8; ++j) x_[j] = pg8::sigmoid_f(x_[j]);
              *(LAS v4u*)(RSL(10) + so) = pk8(x_); }
            { float x_[8]; P6A_SHIFT(11, 6, 704, x_);
#pragma unroll
              for (int j = 0; j < 8; ++j) x_[j] = pg8::sigmoid_f(x_[j]);
              *(LAS v4u*)(RSL(11) + so) = pk8(x_); }
#undef P6A_SHIFT
        }
        LBAR();
        {
            const f32x4 z4 = (f32x4){0.f, 0.f, 0.f, 0.f};
            bf16x8 gq[2][4];
#pragma unroll
            for (int t = 0; t < 2; ++t) { const bf16* gp = A.G2T + (size_t)(64 * h + n0a + 16 * t + fr) * 128 + 8 * fq;
#pragma unroll
                for (int q = 0; q < 4; ++q) gq[t][q] = *reinterpret_cast<const bf16x8*>(gp + 32 * q); }
            {   const Fr2 aW = ldf(RSL(14), fm), aA = ldf(RSL(13), fm); Fr2 bW[2], bA[2];
#pragma unroll
                for (int t = 0; t < 2; ++t) { bW[t] = ldf(RSL(16), fn[t]); bA[t] = ldf(RSL(17), fn[t]); }
#pragma unroll
                for (int t = 0; t < 2; ++t) { const int row = m0 + fr, ch = n0a + 16 * t + 4 * fq; const f32x4 lwq = mm<true>(aW, bW[t], z4), alq = mm<true>(aA, bA[t], z4);
                    const f32x4 w0c = *(const LAS f32x4*)(cst + 384 + ch), a0c = *(const LAS f32x4*)(cst + 448 + ch); f32x4 lwv, alv;
#pragma unroll
                    for (int x = 0; x < 4; ++x) { lwv[x] = -0.6065306597126334f * pg8::sigmoid_f(w0c[x] + lwq[x]); alv[x] = pg8::sigmoid_f(a0c[x] + alq[x]); }
                    const int fo = row * 256 + (((ch >> 3) ^ (row & 7)) << 5) + ((ch >> 2) & 1) * 16;
                    *(LAS f32x4*)(RSL(4) + fo) = lwv; *(LAS f32x4*)(RSL(8) + fo) = alv; } }
            asm volatile("" ::: "memory");
            {   const Fr2 aG0 = ldf(RSL(10), fm), aG1 = ldf(RSL(11), fm);
#pragma unroll
                for (int t = 0; t < 2; ++t) { Fr2 bG0, bG1; bG0.k0 = gq[t][0]; bG0.k1 = gq[t][1]; bG1.k0 = gq[t][2]; bG1.k1 = gq[t][3];
                    st4(RSL(3), orm[t], mm<true>(aG1, bG1, mm<true>(aG0, bG0, z4))); } }
        }
        LBAR();
        float kf[8], kk[8], al[8], lw[8]; float ssp = 0.f, bpp = 0.f;
        {
            { const int fo = lane * 256 + ((w ^ (lane & 7)) << 5); const f32x4 a_ = *(const LAS f32x4*)(RSL(4) + fo), b_ = *(const LAS f32x4*)(RSL(4) + fo + 16), c_ = *(const LAS f32x4*)(RSL(8) + fo), d_ = *(const LAS f32x4*)(RSL(8) + fo + 16);
              lw[0] = a_.x; lw[1] = a_.y; lw[2] = a_.z; lw[3] = a_.w; lw[4] = b_.x; lw[5] = b_.y; lw[6] = b_.z; lw[7] = b_.w;
              al[0] = c_.x; al[1] = c_.y; al[2] = c_.z; al[3] = c_.w; al[4] = d_.x; al[5] = d_.y; al[6] = d_.z; al[7] = d_.w; }
            *(v4u*)(X.G + jo + tid * 8) = *(const LAS v4u*)(RSL(3) + swz(ltok, 16 * ldg));
            float kkc[8], kac[8], rkc[8]; ld8l(cst + 192 + 8 * w, kkc); ld8l(cst + 256 + 8 * w, kac); ld8l(cst + 320 + 8 * w, rkc);
#pragma unroll
            for (int j = 0; j < 8; ++j) { kk[j] = k[j] * kkc[j]; ssp += kk[j] * kk[j]; kf[j] = k[j] * (1.0f + (al[j] - 1.0f) * kac[j]); bpp += r[j] * kf[j] * rkc[j]; }
            part[w * 64 + lane] = ssp; part[512 + w * 64 + lane] = bpp;
        }
        LBAR();
        {
            float ss = 0.f, bon = 0.f;
#pragma unroll
            for (int i = 0; i < 8; ++i) { ss += part[i * 64 + lane]; bon += part[512 + i * 64 + lane]; }
            const float inv = 1.0f / fmaxf(sqrtf(ss), 1e-12f);
            float at[8], rt[8], bt[8], kt[8], bh[8], kh[8], ge[8], vb[8];
#pragma unroll
            for (int j = 0; j < 8; ++j) {
                const float cs = wave_scan(lw[j]);
                const float ce = __int_as_float(__builtin_amdgcn_readlane(__float_as_int(cs), 63));
                const float e_cs = __builtin_amdgcn_exp2f(cs * 1.4426950408889634f), e_csm = __builtin_amdgcn_exp2f((cs - lw[j]) * 1.4426950408889634f);
                const float e_neg = __builtin_amdgcn_rcpf(e_cs), e_end = __builtin_amdgcn_exp2f((ce - cs) * 1.4426950408889634f);
                const float kn = kk[j] * inv, bb = kn * al[j];
                at[j] = -kn * e_csm; rt[j] = r[j] * e_cs; bt[j] = bb * e_neg; kt[j] = kf[j] * e_neg; bh[j] = bb * e_end; kh[j] = kf[j] * e_end; ge[j] = e_cs; vb[j] = bon * v[j];
            }
            const int ro = swz(lane, 16 * w);
            *(LAS v4u*)(RSL(0) + ro) = pk8(at); *(LAS v4u*)(RSL(1) + ro) = pk8(rt); *(LAS v4u*)(RSL(2) + ro) = pk8(bt); *(LAS v4u*)(RSL(3) + ro) = pk8(kt);
            *(LAS v4u*)(RSL(4) + ro) = pk8(bh); *(LAS v4u*)(RSL(5) + ro) = pk8(kh); *(LAS v4u*)(RSL(6) + ro) = pk8(v);
            if (lane == 63) { *(f32x4*)(X.GE + (size_t)job * 64 + 8 * w) = (f32x4){ge[0], ge[1], ge[2], ge[3]}; *(f32x4*)(X.GE + (size_t)job * 64 + 8 * w + 4) = (f32x4){ge[4], ge[5], ge[6], ge[7]}; }
            *(LAS v4u*)(RSL(18) + ro) = pk8(vb);
        }
        LBAR();
        {
            { bf16* vbp = (job < 2048) ? (X.VB0 + jo) : (X.VB1 + (jo - (size_t)2048 * 4096)); *(v4u*)(vbp + tid * 8) = *(const LAS v4u*)(RSL(18) + swz(ltok, 16 * ldg)); }
            const f32x4 z4 = (f32x4){0.f, 0.f, 0.f, 0.f};
            const Fr2 aA = ldf(RSL(0), fm), aR = ldf(RSL(1), fm); Fr2 bB[2], bK[2];
#pragma unroll
            for (int t = 0; t < 2; ++t) { bB[t] = ldf(RSL(2), fn[t]); bK[t] = ldf(RSL(3), fn[t]); }
            f32x4 nab[2], nabT[2], nak[2], mrb[2], mrk[2];
#pragma unroll
            for (int t = 0; t < 2; ++t) { nab[t] = mm<true>(aA, bB[t], z4); nabT[t] = mm<false>(aA, bB[t], z4); nak[t] = mm<true>(aA, bK[t], z4); mrb[t] = mm<true>(aR, bB[t], z4); mrk[t] = mm<true>(aR, bK[t], z4); }
#pragma unroll
            for (int t = 0; t < 2; ++t) { const int n0 = n0a + 16 * t; f32x4 x1;
#pragma unroll
                for (int x = 0; x < 4; ++x) { const int i = m0 + fr, j = n0 + 4 * fq + x;
                    if (j >= i) { nab[t][x] = 0.f; nak[t][x] = 0.f; } if (j > i) { mrb[t][x] = 0.f; mrk[t][x] = 0.f; }
                    x1[x] = nab[t][x] + ((i == j) ? 1.0f : 0.f);
                    const int it = m0 + 4 * fq + x, jt = n0 + fr; if (jt >= it) nabT[t][x] = 0.f; }
                st4(RSL(10), orm[t], x1); st4(RSL(12), orm[t], nab[t]); st4(RSL(14), otr[t], nabT[t]);
                st4(RSL(7), orm[t], nak[t]); st4(RSL(8), orm[t], mrb[t]); st4(RSL(9), orm[t], mrk[t]); }
        }
        LBAR();
        {
            const f32x4 z4 = (f32x4){0.f, 0.f, 0.f, 0.f};
            const Fr2 aP = ldf(RSL(12), fm), aN = ldf(RSL(7), fm); Fr2 bT[2], bV[2];
#pragma unroll
            for (int t = 0; t < 2; ++t) { bT[t] = ldf(RSL(14), fn[t]); bV[t] = ldt(RSL(6), tb0[t], tb1[t]); }
            f32x4 q0[2], q1[2], q2[2];
#pragma unroll
            for (int t = 0; t < 2; ++t) { q0[t] = mm<true>(aP, bT[t], z4); q1[t] = mm<false>(aP, bT[t], z4); q2[t] = mm<false>(aN, bV[t], z4); }
#pragma unroll
            for (int t = 0; t < 2; ++t) { st4(RSL(13), orm[t], q0[t]); st4(RSL(15), otr[t], q1[t]); st4(RSL(2), otr[t], q2[t]); }
        }
        LBAR();
#pragma unroll
        for (int kd = 0; kd < 5; ++kd) {
            const int xi = (kd & 1) ? 11 : 10, xo = (kd & 1) ? 10 : 11, pi = (kd & 1) ? 12 : 13, po = (kd & 1) ? 13 : 12, ti = (kd & 1) ? 14 : 15, to = (kd & 1) ? 15 : 14;
            const f32x4 z4 = (f32x4){0.f, 0.f, 0.f, 0.f};
            const Fr2 aX = ldf(RSL(xi), fm), aP = ldf(RSL(pi), fm); Fr2 bT[2]; f32x4 cx[2];
#pragma unroll
            for (int t = 0; t < 2; ++t) { bT[t] = ldf(RSL(ti), fn[t]); cx[t] = ld4(RSL(xi), orm[t]); }
            f32x4 q0[2], q1[2], q2[2];
#pragma unroll
            for (int t = 0; t < 2; ++t) { q0[t] = mm<true>(aX, bT[t], cx[t]); if (kd < 4) { q1[t] = mm<true>(aP, bT[t], z4); q2[t] = mm<false>(aP, bT[t], z4); } }
#pragma unroll
            for (int t = 0; t < 2; ++t) { st4(RSL(xo), orm[t], q0[t]); if (kd < 4) { st4(RSL(po), orm[t], q1[t]); st4(RSL(to), otr[t], q2[t]); } }
            LBAR();
        }
        {
            const f32x4 z4 = (f32x4){0.f, 0.f, 0.f, 0.f};
            const Fr2 aT = ldf(RSL(11), fm); Fr2 bA[2], bZ[2];
#pragma unroll
            for (int t = 0; t < 2; ++t) { bA[t] = ldt(RSL(0), tb0[t], tb1[t]); bZ[t] = ldf(RSL(2), fn[t]); }
            f32x4 q0[2], q1[2];
#pragma unroll
            for (int t = 0; t < 2; ++t) { q0[t] = mm<false>(aT, bA[t], z4); q1[t] = mm<false>(aT, bZ[t], z4); }
#pragma unroll
            for (int t = 0; t < 2; ++t) { st4(RSL(3), otr[t], q0[t]); st4(RSL(7), otr[t], q1[t]); }
        }
        LBAR();
        {
            const f32x4 z4 = (f32x4){0.f, 0.f, 0.f, 0.f};
            f32x4 p1[2], y0[2], gt[2], hh[2];
            {   const Fr2 aMb = ldf(RSL(8), fm), aMk = ldf(RSL(9), fm); Fr2 bW[2], bU[2], bV[2]; f32x4 cR[2];
#pragma unroll
                for (int t = 0; t < 2; ++t) { bW[t] = ldf(RSL(3), fn[t]); bU[t] = ldf(RSL(7), fn[t]); bV[t] = ldt(RSL(6), tb0[t], tb1[t]); cR[t] = ld4(RSL(1), orm[t]); }
#pragma unroll
                for (int t = 0; t < 2; ++t) { p1[t] = mm<true>(aMb, bW[t], cR[t]); y0[t] = mm<true>(aMk, bV[t], mm<true>(aMb, bU[t], z4)); } }
            {   const Fr2 aW = ldf(RSL(3), fm), aU = ldf(RSL(7), fm), aV = ldt(RSL(6), ta0, ta1); Fr2 bBh[2], bKh[2];
#pragma unroll
                for (int t = 0; t < 2; ++t) { bBh[t] = ldt(RSL(4), tb0[t], tb1[t]); bKh[t] = ldt(RSL(5), tb0[t], tb1[t]); }
#pragma unroll
                for (int t = 0; t < 2; ++t) { gt[t] = mm<false>(aW, bBh[t], z4); hh[t] = mm<true>(aV, bKh[t], mm<true>(aU, bBh[t], z4)); } }
#pragma unroll
            for (int t = 0; t < 2; ++t) {
                s_p1[t].x = pkbf(p1[t][0], p1[t][1]); s_p1[t].y = pkbf(p1[t][2], p1[t][3]); s_gt[t].x = pkbf(gt[t][0], gt[t][1]); s_gt[t].y = pkbf(gt[t][2], gt[t][3]);
                s_y0[t].x = pkbf(y0[t][0], y0[t][1]); s_y0[t].y = pkbf(y0[t][2], y0[t][3]); s_hh[t].x = pkbf(hh[t][0], hh[t][1]); s_hh[t].y = pkbf(hh[t][2], hh[t][3]); }
            s_jo = jo; s_have = true;
        }
    }
    if (s_have) P6A_STORE();
#undef P6A_LOAD
#undef P6A_STORE
    LBAR();
}
__device__ __forceinline__ void p6b_rwkv_seq(Frame& F, const RwArgs& A, const RwX& X, int nwg) {
    using namespace rwk;
    LAS unsigned char* lds = F.lds + RING_OFF;
    constexpr int YLD = 68;
    LAS float* Yf0 = (LAS float*)RSL(6);
    const int tid = F.tid, tok = tid >> 3, dg = tid & 7, lane = F.lane, fr = lane & 15, fq = lane >> 4;
    const int w = F.wave, m0 = 16 * (w >> 1), n0a = 32 * (w & 1);
    const int fm = swz(m0 + fr, fq * 16);
    int fn[2], orm[2], otr[2];
#pragma unroll
    for (int t = 0; t < 2; ++t) { const int n0 = n0a + 16 * t; fn[t] = swz(n0 + fr, fq * 16); orm[t] = swz(m0 + fr, 2 * (n0 + 4 * fq)); otr[t] = swz(n0 + fr, 2 * (m0 + 4 * fq)); }
    for (int unit = blockIdx.x; unit < BATCH * NH; unit += nwg) {
        const int b = unit >> 3, h = unit & 7; const int cb = 64 * h + 8 * dg;
        f32x4 sacc[2]; sacc[0] = (f32x4){0.f, 0.f, 0.f, 0.f}; sacc[1] = sacc[0];
        for (int u = tid; u < SLOT / 4; u += NWAVES * 64) ((LAS unsigned*)RSL(4))[u] = 0u;
        float lnw[8], lnb[8]; ld8f(A.ln_w + cb, lnw); ld8f(A.ln_b + cb, lnb);
        struct Nx { v4u vb, g; u32x2g p1[2], gt[2], y0[2], h[2]; f32x4 ge[2]; };
        Nx nA, nB;
#define P6B_LOAD(cc, N) do { const int job_ = unit * 32 + (cc); const size_t jo_ = (size_t)job_ * 4096; const size_t grow_ = (size_t)b * SEQ + (cc) * 64 + tok; \
            _Pragma("unroll") for (int t = 0; t < 2; ++t) { N.y0[t] = *(const u32x2g*)(X.Y0 + jo_ + ((w * 2 + t) * 64 + lane) * 4); N.h[t] = *(const u32x2g*)(X.H + jo_ + ((w * 2 + t) * 64 + lane) * 4); \
                N.p1[t] = *(const u32x2g*)(X.P1 + jo_ + ((w * 2 + t) * 64 + lane) * 4); N.gt[t] = *(const u32x2g*)(X.GT + jo_ + ((w * 2 + t) * 64 + lane) * 4); \
                N.ge[t] = *(const f32x4*)(X.GE + (size_t)job_ * 64 + n0a + 16 * t + 4 * fq); } \
            const bf16* vbp_ = (job_ < 2048) ? (X.VB0 + jo_) : (X.VB1 + (jo_ - (size_t)2048 * 4096)); \
            N.vb = *(const v4u*)(vbp_ + tok * 64 + 8 * dg); N.g = *(const v4u*)(X.G + jo_ + tok * 64 + 8 * dg); } while (0)
#define P6B_OUT(par, vbw_, gw_, grow_) do { float y[8]; ld8l(Yf0 + (par) * (64 * YLD) + tok * YLD + 8 * dg, y); \
            const float g[8] = {bflo(gw_.x), bfhi(gw_.x), bflo(gw_.y), bfhi(gw_.y), bflo(gw_.z), bfhi(gw_.z), bflo(gw_.w), bfhi(gw_.w)}; \
            const float vb[8] = {bflo(vbw_.x), bfhi(vbw_.x), bflo(vbw_.y), bfhi(vbw_.y), bflo(vbw_.z), bfhi(vbw_.z), bflo(vbw_.w), bfhi(vbw_.w)}; \
            float s_ = 0.f; _Pragma("unroll") for (int j = 0; j < 8; ++j) s_ += y[j]; \
            const float mean = sum8(s_) * (1.0f / 64.0f); float q_ = 0.f; \
            _Pragma("unroll") for (int j = 0; j < 8; ++j) { y[j] -= mean; q_ += y[j] * y[j]; } \
            const float rstd = __builtin_amdgcn_rsqf(sum8(q_) * (1.0f / 64.0f) + LNX_EPS); float ov[8]; \
            _Pragma("unroll") for (int j = 0; j < 8; ++j) ov[j] = (y[j] * rstd * lnw[j] + lnb[j] + vb[j]) * g[j]; \
            v4u wv_; wv_.x = pkbf(ov[0], ov[1]); wv_.y = pkbf(ov[2], ov[3]); wv_.z = pkbf(ov[4], ov[5]); wv_.w = pkbf(ov[6], ov[7]); \
            *(GAS v4u*)(A.QO + (grow_) * D + 512 + cb) = wv_; } while (0)
        v4u p_vb = (v4u){0u, 0u, 0u, 0u}, p_g = p_vb; size_t p_row = 0;
#define P6B_STEP(c, N) do { const int par = (c) & 1, scur = 4 + par, snxt = 5 - par; const size_t grow = (size_t)b * SEQ + (c) * 64 + tok; \
            _Pragma("unroll") for (int t = 0; t < 2; ++t) { *(LAS u32x2g*)(RSL(par) + orm[t]) = N.p1[t]; *(LAS u32x2g*)(RSL(2 + par) + otr[t]) = N.gt[t]; } \
            f32x4 yacc[2], hcur[2], gecur[2]; \
            _Pragma("unroll") for (int t = 0; t < 2; ++t) { yacc[t] = (f32x4){bflo(N.y0[t].x), bfhi(N.y0[t].x), bflo(N.y0[t].y), bfhi(N.y0[t].y)}; hcur[t] = (f32x4){bflo(N.h[t].x), bfhi(N.h[t].x), bflo(N.h[t].y), bfhi(N.h[t].y)}; gecur[t] = N.ge[t]; } \
            const v4u vbw = N.vb, gw = N.g; \
            if ((c) + 2 < SEQ / 64) P6B_LOAD((c) + 2, N); \
            LBAR(); \
            {   const Fr2 aP1 = ldf(RSL(par), fm), aS = ldf(RSL(scur), fm); Fr2 bS[2], bG[2]; \
                _Pragma("unroll") for (int t = 0; t < 2; ++t) { bS[t] = ldf(RSL(scur), fn[t]); bG[t] = ldf(RSL(2 + par), fn[t]); } \
                _Pragma("unroll") for (int t = 0; t < 2; ++t) { yacc[t] = mm<true>(aP1, bS[t], yacc[t]); sacc[t] = mm<true>(aS, bG[t], sacc[t] * gecur[t] + hcur[t]); } \
                _Pragma("unroll") for (int t = 0; t < 2; ++t) { const int n0 = n0a + 16 * t; *(LAS f32x4*)(Yf0 + par * (64 * YLD) + (m0 + fr) * YLD + n0 + 4 * fq) = yacc[t]; st4(RSL(snxt), orm[t], sacc[t]); } } \
            if ((c) > 0) P6B_OUT(par ^ 1, p_vb, p_g, p_row);                    \
            p_vb = vbw; p_g = gw; p_row = grow; } while (0)
        P6B_LOAD(0, nA); P6B_LOAD(1, nB);
        for (int c = 0; c < SEQ / 64; c += 2) {
            P6B_STEP(c, nA);
            P6B_STEP(c + 1, nB);
        }
#undef P6B_STEP
        LBAR();
        P6B_OUT(1, p_vb, p_g, p_row);
#undef P6B_LOAD
#undef P6B_OUT
        LBAR();
    }
}

namespace sba {
using bf16x8 = __attribute__((ext_vector_type(8))) short;
using s16x4 = __attribute__((ext_vector_type(4))) short;
using f32x16 = __attribute__((ext_vector_type(16))) float;
using u32x4 = __attribute__((ext_vector_type(4))) unsigned;
constexpr int QB = 256, KVBLK = 64;
constexpr int LDS_K = 0, LDS_V = 16384, LDS_ST = 32768, ST_LD = 68, LDS_FLAG = LDS_ST + 8 * 32 * ST_LD * 4, LDS_BYTES_ATT = LDS_FLAG + 64;
constexpr float R_DEAD = -160.0f;
#define SBAR() __builtin_amdgcn_sched_barrier(0)
typedef float f32x2_t __attribute__((ext_vector_type(2))); typedef __bf16 bf16x2_t __attribute__((ext_vector_type(2)));
__device__ __forceinline__ unsigned cvtpk_s(float lo, float hi) { f32x2_t v = {lo, hi}; bf16x2_t b = __builtin_convertvector(v, bf16x2_t); return __builtin_bit_cast(unsigned, b); }
__device__ __forceinline__ void qkt(f32x16& p0, f32x16& p1, const char* Kslot, const bf16x8* qr, int r32, int hi) {
    const char* kb = Kslot + hi * 1024 + r32 * 16;
    const f32x16 z = f32x16{};
#pragma unroll
    for (int d0 = 0; d0 < 4; ++d0) {
        const bf16x8 b0 = *reinterpret_cast<const bf16x8*>(kb + d0 * 2048);
        const bf16x8 b1 = *reinterpret_cast<const bf16x8*>(kb + d0 * 2048 + 512);
        if (d0 == 0) { p0 = __builtin_amdgcn_mfma_f32_32x32x16_bf16(b0, qr[0], z, 0, 0, 0); p1 = __builtin_amdgcn_mfma_f32_32x32x16_bf16(b1, qr[0], z, 0, 0, 0); }
        else { p0 = __builtin_amdgcn_mfma_f32_32x32x16_bf16(b0, qr[d0], p0, 0, 0, 0); p1 = __builtin_amdgcn_mfma_f32_32x32x16_bf16(b1, qr[d0], p1, 0, 0, 0); }
    }
}
__device__ __forceinline__ void pv(f32x16* o, int vb, bf16x8 pa0, bf16x8 pa1, bf16x8 pa2, bf16x8 pa3) {
#pragma unroll
    for (int d0 = 0; d0 < 2; ++d0) { s16x4 lo[4], hi[4];
#pragma unroll
        for (int ks = 0; ks < 4; ++ks) {
            asm volatile("ds_read_b64_tr_b16 %0,%1 offset:%c2" : "=&v"(lo[ks]) : "v"(vb), "i"(d0 * 4096 + ks * 1024) : "memory");
            asm volatile("ds_read_b64_tr_b16 %0,%1 offset:%c2" : "=&v"(hi[ks]) : "v"(vb), "i"(d0 * 4096 + ks * 1024 + 512) : "memory"); }
        asm volatile("s_waitcnt lgkmcnt(0)" ::: "memory"); SBAR();
#define PK(k) (bf16x8){lo[k][0], lo[k][1], lo[k][2], lo[k][3], hi[k][0], hi[k][1], hi[k][2], hi[k][3]}
        o[d0] = __builtin_amdgcn_mfma_f32_32x32x16_bf16(pa0, PK(0), o[d0], 0, 0, 0);
        o[d0] = __builtin_amdgcn_mfma_f32_32x32x16_bf16(pa1, PK(1), o[d0], 0, 0, 0);
        o[d0] = __builtin_amdgcn_mfma_f32_32x32x16_bf16(pa2, PK(2), o[d0], 0, 0, 0);
        o[d0] = __builtin_amdgcn_mfma_f32_32x32x16_bf16(pa3, PK(3), o[d0], 0, 0, 0);
#undef PK
    }
}
__device__ __forceinline__ float swap_sum(float x, float& other_if_lo, int hi) {
    auto rr = __builtin_amdgcn_permlane32_swap(__float_as_uint(x), __float_as_uint(x), false, false);
    const float a = __uint_as_float(rr[0]), b = __uint_as_float(rr[1]);
    other_if_lo = hi ? 0.f : b;
    return a + b;
}
__device__ __forceinline__ float swap_prod(float x, float& other_if_lo, int hi) {
    auto rr = __builtin_amdgcn_permlane32_swap(__float_as_uint(x), __float_as_uint(x), false, false);
    const float a = __uint_as_float(rr[0]), b = __uint_as_float(rr[1]);
    other_if_lo = hi ? 1.0f : b;
    return a * b;
}
__device__ __forceinline__ void attn_wave_unit(int b, int h, int qblk, bf16* QO, const bf16* __restrict__ KB, const bf16* __restrict__ VB, const float* gout, char* wsm  ) {
    const int lane = threadIdx.x & 63, r32 = lane & 31, hi = lane >> 5;
    const long rowbase = (long)b * SEQ; const int q0 = qblk * 32;
    bf16* Qw = QO + (rowbase + q0) * D + h * HD;
    const bf16* Kh = KB + rowbase * SBW + h * HD; const bf16* Vh = VB + rowbase * SBW + h * HD;
    const unsigned lds0 = (unsigned)(uintptr_t)wsm;
    const int jtop = (q0 + 30) >> 6;
    const bf16* vsrc = Vh + (long)(lane >> 3) * SBW + (lane & 7) * 8;
    const int vdst0 = ((lane & 7) >> 2) * 4096 + ((lane >> 3) & 15) * 64 + (lane & 3) * 16;
    const int vb0 = (int)lds0 + ((lane >> 4) & 1) * 32 + (lane & 3) * 8 + (4 * hi + ((lane & 15) >> 2)) * 64;
    const bf16* ksrc = Kh + (long)r32 * SBW + hi * 8;
    bf16x8 qr[4];
#pragma unroll
    for (int d0 = 0; d0 < 4; ++d0) qr[d0] = *reinterpret_cast<const bf16x8*>(&Qw[(long)r32 * D + d0 * 16 + hi * 8]);
    bf16x8 kf[8]; u32x4 vr[8];
#define SBA_LOAD(t) do { const bf16* kp_ = ksrc + (long)(t) * KVBLK * SBW; const bf16* vp_ = vsrc + (long)(t) * KVBLK * SBW; \
        _Pragma("unroll") for (int d0 = 0; d0 < 4; ++d0) { kf[2 * d0] = *reinterpret_cast<const bf16x8*>(kp_ + d0 * 16); kf[2 * d0 + 1] = *reinterpret_cast<const bf16x8*>(kp_ + 32 * SBW + d0 * 16); } \
        _Pragma("unroll") for (int i = 0; i < 8; ++i) vr[i] = *(const u32x4*)(vp_ + (long)(8 * i) * SBW); } while (0)
    SBA_LOAD(jtop);
    float R = 0.f; f32x16 o[2]; o[0] = f32x16{}; o[1] = f32x16{};
    const int qrow = q0 + r32;
    for (int jt = jtop; jt >= 0; --jt) {
        const int cur = (jtop - jt) & 1;
#pragma unroll
        for (int i = 0; i < 8; ++i) *(u32x4*)(wsm + cur * 8192 + vdst0 + (i >> 1) * 1024 + (i & 1) * 512) = vr[i];
        f32x16 p0, p1;
        {   const f32x16 z = f32x16{};
            p0 = __builtin_amdgcn_mfma_f32_32x32x16_bf16(kf[0], qr[0], z, 0, 0, 0); p1 = __builtin_amdgcn_mfma_f32_32x32x16_bf16(kf[1], qr[0], z, 0, 0, 0);
#pragma unroll
            for (int d0 = 1; d0 < 4; ++d0) { p0 = __builtin_amdgcn_mfma_f32_32x32x16_bf16(kf[2 * d0], qr[d0], p0, 0, 0, 0); p1 = __builtin_amdgcn_mfma_f32_32x32x16_bf16(kf[2 * d0 + 1], qr[d0], p1, 0, 0, 0); } }
        if (jt > 0) SBA_LOAD(jt - 1);
        const int kb = 64 * jt + 4 * hi; const bool diag = (jt == jtop);
#pragma unroll
        for (int r = 0; r < 16; ++r) {
            { float rr = __builtin_amdgcn_rcpf(1.0f + __builtin_amdgcn_exp2f(p0[r]));
              if (diag) { const int key = kb + (r & 3) + 8 * (r >> 2); if (key >= qrow) rr = 1.0f; }
              p0[r] = rr; }
            { float rr = __builtin_amdgcn_rcpf(1.0f + __builtin_amdgcn_exp2f(p1[r]));
              if (diag) { const int key = kb + 32 + (r & 3) + 8 * (r >> 2); if (key >= qrow) rr = 1.0f; }
              p1[r] = rr; }
        }
        float c0[4], c1[4], x0[4], x1[4];
#pragma unroll
        for (int g = 0; g < 4; ++g) {
            const float s0 = (p0[4 * g] * p0[4 * g + 1]) * (p0[4 * g + 2] * p0[4 * g + 3]);
            const float s1 = (p1[4 * g] * p1[4 * g + 1]) * (p1[4 * g + 2] * p1[4 * g + 3]);
            c0[g] = swap_prod(s0, x0[g], hi); c1[g] = swap_prod(s1, x1[g], hi);
        }
        const float Cr = __builtin_amdgcn_exp2f(R);
        float suf0[4], suf1[4];
        suf1[3] = Cr; suf1[2] = suf1[3] * c1[3]; suf1[1] = suf1[2] * c1[2]; suf1[0] = suf1[1] * c1[1];
        suf0[3] = suf1[0] * c1[0]; suf0[2] = suf0[3] * c0[3]; suf0[1] = suf0[2] * c0[2]; suf0[0] = suf0[1] * c0[1];
        R += __builtin_amdgcn_logf(((c0[0] * c0[1]) * (c0[2] * c0[3])) * ((c1[0] * c1[1]) * (c1[2] * c1[3])));
#pragma unroll
        for (int g = 0; g < 4; ++g) {
            { const float e3 = suf0[g] * x0[g], e2 = e3 * p0[4 * g + 3], e1 = e2 * p0[4 * g + 2], e0 = e1 * p0[4 * g + 1];
              p0[4 * g + 3] = (1.0f - p0[4 * g + 3]) * e3; p0[4 * g + 2] = (1.0f - p0[4 * g + 2]) * e2; p0[4 * g + 1] = (1.0f - p0[4 * g + 1]) * e1; p0[4 * g] = (1.0f - p0[4 * g]) * e0; }
            { const float e3 = suf1[g] * x1[g], e2 = e3 * p1[4 * g + 3], e1 = e2 * p1[4 * g + 2], e0 = e1 * p1[4 * g + 1];
              p1[4 * g + 3] = (1.0f - p1[4 * g + 3]) * e3; p1[4 * g + 2] = (1.0f - p1[4 * g + 2]) * e2; p1[4 * g + 1] = (1.0f - p1[4 * g + 1]) * e1; p1[4 * g] = (1.0f - p1[4 * g]) * e0; }
        }
#define PKW(P, B) cvtpk_s(P[B], P[B + 1])
        const u32x4 pw0 = (u32x4){PKW(p0, 0), PKW(p0, 2), PKW(p0, 4), PKW(p0, 6)}, pw1 = (u32x4){PKW(p0, 8), PKW(p0, 10), PKW(p0, 12), PKW(p0, 14)};
        const u32x4 pw2 = (u32x4){PKW(p1, 0), PKW(p1, 2), PKW(p1, 4), PKW(p1, 6)}, pw3 = (u32x4){PKW(p1, 8), PKW(p1, 10), PKW(p1, 12), PKW(p1, 14)};
#undef PKW
        SBAR();
        asm volatile("s_waitcnt lgkmcnt(0)" ::: "memory");
        pv(o, vb0 + cur * 8192, __builtin_bit_cast(bf16x8, pw0), __builtin_bit_cast(bf16x8, pw1), __builtin_bit_cast(bf16x8, pw2), __builtin_bit_cast(bf16x8, pw3));
        if (__all(R < R_DEAD)) break;
    }
#undef SBA_LOAD
    {
        float* stg = (float*)wsm;
        asm volatile("s_waitcnt lgkmcnt(0)" ::: "memory");
#pragma unroll
        for (int r = 0; r < 16; ++r) { const int orow = (r & 3) + 8 * (r >> 2) + 4 * hi;
#pragma unroll
            for (int d0 = 0; d0 < 2; ++d0) stg[orow * ST_LD + d0 * 32 + r32] = o[d0][r]; }
        asm volatile("s_waitcnt lgkmcnt(0)" ::: "memory");
        const int ch = lane & 7;
        const f32x4 ga = *(const f32x4*)(gout + h * HD + ch * 8), gb = *(const f32x4*)(gout + h * HD + ch * 8 + 4);
#pragma unroll
        for (int i = 0; i < 4; ++i) { const int row = i * 8 + (lane >> 3);
            const f32x4 a = *(const f32x4*)(stg + row * ST_LD + ch * 8), c = *(const f32x4*)(stg + row * ST_LD + ch * 8 + 4);
            float ss = (a.x * a.x + a.y * a.y) + (a.z * a.z + a.w * a.w) + (c.x * c.x + c.y * c.y) + (c.z * c.z + c.w * c.w);
            ss = sum8(ss);
            const float hs = __builtin_amdgcn_rsqf(ss * (1.0f / 64.0f) + 1e-6f);
            u32x4 w; w.x = cvtpk_s(a.x * hs * ga.x, a.y * hs * ga.y); w.y = cvtpk_s(a.z * hs * ga.z, a.w * hs * ga.w);
            w.z = cvtpk_s(c.x * hs * gb.x, c.y * hs * gb.y); w.w = cvtpk_s(c.z * hs * gb.z, c.w * hs * gb.w);
            *(u32x4*)(Qw + (long)row * D + ch * 8) = w; }
        asm volatile("s_waitcnt lgkmcnt(0)" ::: "memory");
    }
}
#undef SBAR
__device__ __forceinline__ void attn_phase(Frame& F, bf16* QO, const bf16* KB, const bf16* VB, const float* gout, unsigned* queue, int first_ticket, int ticket_base) {
    char* wsm = (char*)F.lds + RING_OFF + F.wave * 16384;
    const int nunits = BATCH * NH * (SEQ / 32);
    int pend = -1; int tfirst = first_ticket;
    for (;;) {
        int uu;
        if (pend >= 0) { uu = pend; pend = -1; }
        else { unsigned t;
               if (tfirst >= 0) { t = (unsigned)tfirst; tfirst = -1; }
               else { t = 0u; if (F.lane == 0) t = __hip_atomic_fetch_add(queue, 1u, __ATOMIC_RELAXED, __HIP_MEMORY_SCOPE_AGENT); t = (unsigned)__builtin_amdgcn_readfirstlane((int)t) + (unsigned)ticket_base; }
               if (2u * t >= (unsigned)nunits) break; uu = (int)(2u * t); pend = uu + 1; }
        attn_wave_unit(uu >> 9, (uu >> 6) & 7, uu & 63, QO, KB, VB, gout, wsm);
    }
    __syncthreads();
}
}

struct Args { const float* in[26]; float* out; unsigned char* ws; int ph_lo, ph_hi, li, pad; };
__global__ void __launch_bounds__(NWAVES * 64, 2) skel_fwd(Args args) {
    extern __shared__ __attribute__((aligned(16))) unsigned char lds[];
    Frame F;
    F.lds = (LAS unsigned char*)lds;
    F.MISC = (volatile LAS unsigned*)(F.lds + MISC_OFF);
    F.tid = threadIdx.x; F.lane = F.tid & 63; F.wave = __builtin_amdgcn_readfirstlane(F.tid >> 6);
    F.G = gridDim.x; { const int bx = blockIdx.x; F.vcu = (F.G % 8 == 0) ? (bx % 8) * (F.G / 8) + bx / 8 : bx; }
    unsigned char* ws = args.ws;
    F.ctl = (gu32*)(ws + WS_CTL);
    const float* x = args.in[0];
    bf16* W1U = (bf16*)(ws + WS_W1U); bf16* W1D = (bf16*)(ws + WS_W1D); bf16* W2U = (bf16*)(ws + WS_W2U); bf16* W2D = (bf16*)(ws + WS_W2D);
    bf16* WIN = (bf16*)(ws + WS_WIN); bf16* WOUT = (bf16*)(ws + WS_WOUT); bf16* WLORA = (bf16*)(ws + WS_WLORA);
    bf16* XB = (bf16*)(ws + WS_XB); bf16* ACT = (bf16*)(ws + WS_ACT); bf16* QO = (bf16*)(ws + WS_QO); bf16* KB = (bf16*)(ws + WS_KB); bf16* VB = (bf16*)(ws + WS_VB);
    bf16* RW = (bf16*)(ws + WS_RW); bf16* ALORA = (bf16*)(ws + WS_ALORA); float* LW = (float*)(ws + WS_LW); bf16* AB = (bf16*)(ws + WS_AB); bf16* GB = (bf16*)(ws + WS_GB);
    float* SSQ = (float*)(ws + WS_SSQ); float* out = args.out;
    for (int u = F.tid; u < (LDS_BYTES - LDSCTL_OFF) / 4; u += NWAVES * 64) ((LAS unsigned*)(F.lds + LDSCTL_OFF))[u] = 0u;
    __syncthreads();
    XcdBarrier bar; bar.bar = (unsigned*)(F.ctl + CW_BAR); bar.x = 0; bar.st = nullptr;
    if (N_LAUNCHES != PER_PHASE) bar = xcd_barrier_post((unsigned*)(F.ctl + CW_BAR), F.MISC + 8);
#define GRID_BAR(seam) do { if (N_LAUNCHES == PER_PHASE) { if (F.tid == 0) __hip_atomic_store(F.ctl + CW_TMO, 0xBADBA0u | (unsigned)(seam), RLX_AGENT); } else { xcd_barrier(bar); } } while (0)
    const int lo = args.ph_lo, hi = args.ph_hi;
#define IN(k) (lo <= (k) && (k) < hi)
#define BOTH(k) (IN(k) && IN((k) + 1))
    if (IN(0)) {
        p0_prologue(F, x, args.in[1], args.in[2], args.in[3], args.in[4], args.in[5], args.in[6], args.in[12], args.in[14], args.in[15], args.in[21], args.in[22], args.in[23], args.in[24], args.in[25],
                    W1U, W1D, W2U, W2D, WIN, WOUT, WLORA, XB, SSQ); if (BOTH(0)) GRID_BAR(0);
    }
    if (IN(1)) {
        pg8::Gemm g{XB, W1U, M, 2 * FF, D}; pg8::StaticOrder S; S.init(M, 2 * FF, F.G, (int)blockIdx.x);
        pg8::EpiSwiGLU E{ACT, FF, SSQ};
        pg8::gemm_phase<pg8::EpiSwiGLU, pg8::StaticOrder, true, true>(F.lds + RING_OFF, g, S, E);
        if (BOTH(1)) GRID_BAR(1);
    }
    if (IN(2)) {
        pg8::Gemm g{ACT, W1D, M, D, FF}; pg8::StaticOrder S; S.init(M, D, F.G, (int)blockIdx.x);
        pg8::EpiResid E{x, nullptr, nullptr, nullptr, XB, (unsigned char*)out, SSQ, 0.5f, 1};
        pg8::gemm_phase<pg8::EpiResid, pg8::StaticOrder, true, true>(F.lds + RING_OFF, g, S, E);
        if (BOTH(2)) GRID_BAR(2);
    }
    if (IN(3)) {
        pg8::Gemm g{XB, WIN, M, PW, D}; pg8::StaticOrder S; S.init(M, PW, F.G, (int)blockIdx.x);
        pg8::EpiWin E{QO, KB, VB, RW, SSQ, args.in[7], args.in[8], 0.125f * 1.4426950408889634f};
        pg8::gemm_phase<pg8::EpiWin, pg8::StaticOrder, true, true>(F.lds + RING_OFF, g, S, E);
        if (F.G >= 256) {
            const int nlo = (M / 256) * (PW / 256) - 6 * F.G;
            if ((int)blockIdx.x >= nlo) { __syncthreads();
                p0_items(F, x, args.in[1], args.in[2], args.in[3], args.in[4], args.in[5], args.in[6], args.in[12], args.in[14], args.in[15], args.in[21], args.in[22], args.in[23], args.in[24], args.in[25],
                         W1U, W1D, W2U, W2D, WIN, WOUT, WLORA, XB, SSQ, 1, ((int)blockIdx.x - nlo) * NWAVES + F.wave, (F.G - nlo) * NWAVES); }
        }
        if (BOTH(3)) GRID_BAR(3);
    }
    if (IN(6)) {
        RwArgs A{RW, WLORA, WLORA + 512 * 64, WLORA + 2 * 512 * 64, args.in[11], args.in[13], QO, args.in[10], args.in[16], args.in[17], args.in[18], args.in[19], args.in[20]};
        bf16* ob = (bf16*)out;
        RwX X{ob + (size_t)32 * 1024 * 1024, ob + (size_t)48 * 1024 * 1024, (bf16*)LW, (bf16*)LW + (size_t)16 * 1024 * 1024, AB, AB + (size_t)8 * 1024 * 1024, SSQ, GB};
        p6a_rwkv_local(F, A, X);
        GRID_BAR(16);
        const int nseq = (F.G >= 2 * BATCH * NH) ? BATCH * NH : F.G;
        if ((int)blockIdx.x < nseq) { p6b_rwkv_seq(F, A, X, nseq); __syncthreads(); }
        const int nfree = (F.G - nseq) * NWAVES;
        sba::attn_phase(F, QO, KB, VB, args.in[9], (unsigned*)(F.ctl + CW_QUEUE), ((int)blockIdx.x >= nseq) ? ((int)blockIdx.x - nseq) * NWAVES + F.wave : -1, nfree);
        if (BOTH(6)) GRID_BAR(6);
    }
    if (IN(8)) {
        pg8::Gemm g{QO, WOUT, M, D, D}; pg8::StaticOrder S; S.init(M, D, F.G, (int)blockIdx.x);
        pg8::EpiResid E{nullptr, XB, (const unsigned char*)out, nullptr, XB, (unsigned char*)LW, SSQ, 1.0f, 1};
        pg8::gemm_phase<pg8::EpiResid, pg8::StaticOrder, true, true>(F.lds + RING_OFF, g, S, E);
        if (BOTH(8)) GRID_BAR(8);
    }
    if (IN(9)) {
        pg8::Gemm g{XB, W2U, M, 2 * FF, D}; pg8::StaticOrder S; S.init(M, 2 * FF, F.G, (int)blockIdx.x);
        pg8::EpiSwiGLU E{ACT, FF, SSQ};
        pg8::gemm_phase<pg8::EpiSwiGLU, pg8::StaticOrder, true, true>(F.lds + RING_OFF, g, S, E);
        if (BOTH(9)) GRID_BAR(9);
    }
    if (IN(10)) {
        pg8::Gemm g{ACT, W2D, M, D, FF}; pg8::StaticOrder S; S.init(M, D, F.G, (int)blockIdx.x);
        pg8::EpiResid E{nullptr, XB, (const unsigned char*)LW, out, nullptr, nullptr, SSQ, 0.5f, 0};
        pg8::gemm_phase<pg8::EpiResid, pg8::StaticOrder, true, true>(F.lds + RING_OFF, g, S, E);
    }
#undef IN
#undef BOTH
}

extern "C" void kernel_launch(void* const* d_in, const int* in_sizes, int n_in, void* d_out, int out_size, void* d_ws, size_t ws_size, hipStream_t stream) {
    static int grid = 0;
    if (grid == 0) {
        if (n_in != 26 || in_sizes[0] != M * D || out_size != M * D || ws_size < WS_END) { fprintf(stderr, "kernel_launch: unexpected shapes: n_in %d in0 %d out %d ws %zu (need %zu)\n", n_in, n_in > 0 ? in_sizes[0] : -1, out_size, ws_size, (size_t)WS_END); grid = -1; return; }
        int dev = 0, cus = 0, per_cu = 0;
        if (hipGetDevice(&dev) != hipSuccess || hipDeviceGetAttribute(&cus, hipDeviceAttributeMultiprocessorCount, dev) != hipSuccess) { grid = -1; return; }
        if (hipFuncSetAttribute((const void*)skel_fwd, hipFuncAttributeMaxDynamicSharedMemorySize, LDS_BYTES) != hipSuccess) { fprintf(stderr, "kernel_launch: hipFuncSetAttribute failed\n"); grid = -1; return; }
        if (hipOccupancyMaxActiveBlocksPerMultiprocessor(&per_cu, (const void*)skel_fwd, NWAVES * 64, LDS_BYTES) != hipSuccess || per_cu < 1) { fprintf(stderr, "kernel_launch: occupancy query reports %d blocks per CU\n", per_cu); per_cu = 1; }
        (void)hipGetLastError();
        grid = cus;
    }
    if (grid < 0) return;
    if (hipMemsetAsync((char*)d_ws + WS_CTL, 0, CTL_ZERO_BYTES, stream) != hipSuccess) return;
    Args a{};
    for (int i = 0; i < 26; ++i) a.in[i] = (const float*)d_in[i];
    a.out = (float*)d_out; a.ws = (unsigned char*)d_ws;
    for (int li = 0; li < N_LAUNCHES; ++li) {
        a.ph_lo = (N_LAUNCHES == PER_PHASE) ? li : 0; a.ph_hi = (N_LAUNCHES == PER_PHASE) ? li + 1 : PER_PHASE; a.li = li;
        hipLaunchKernelGGL(skel_fwd, dim3(grid), dim3(NWAVES * 64), LDS_BYTES, stream, a);
    }
}
```

```cpp
#include <hip/hip_runtime.h>
#include <hip/hip_bf16.h>
#include <cstdio>
#include <cstdint>
#include <cmath>
namespace pg8 {
#define PG8_LAS __attribute__((address_space(3)))
typedef unsigned short bf16_t;
typedef short bf16x8 __attribute__((ext_vector_type(8)));
typedef float f32x4 __attribute__((ext_vector_type(4)));
typedef unsigned u32x4 __attribute__((ext_vector_type(4)));
constexpr int BM = 256, BK = 64, HALF = 128, HTB = HALF * BK * 2  , STAGE_BYTES = 8 * HTB, NXCD = 8, WGM = 4;

__host__ __device__ __forceinline__ int lds_byte(int r, int c) { const int st = (r >> 4) * 2 + (c >> 5), rr = r & 15, cc = c & 31, ob = rr * 64 + cc * 2; return st * 1024 + (ob ^ (((ob >> 9) & 1) << 5)); }
__host__ __device__ __forceinline__ void stage_rc(int b, int& R, int& C) { const int st = b / 1024, sb = b % 1024, swz = sb ^ (((sb >> 9) & 1) << 5); R = (st >> 1) * 16 + swz / 64; C = (st & 1) * 32 + (swz % 64) / 2; }
__host__ __device__ __forceinline__ int perm32(int rho) { const int n = rho >> 4, i = rho & 15; return 8 * (i >> 2) + 4 * n + (i & 3); }

struct Unit { int pm, pn; };
struct Gemm { const bf16_t* A; const bf16_t* Bt; int M, N, K; int ld; };

struct StaticOrder {
    int nM, nN, nwg, G, c;
    __host__ __device__ void init(int M, int N, int G_, int c_) { nM = M / BM; nN = N / BM; nwg = nM * nN; G = G_; c = c_; }
    __host__ __device__ bool next(int i, Unit& u) const {
        const long L = (long)i * G + c; if (L >= nwg) return false;
        int wgid = (int)L; { const int q = nwg / NXCD, r = nwg % NXCD, xcd = wgid % NXCD, off = wgid / NXCD; wgid = (xcd < r ? xcd * (q + 1) : r * (q + 1) + (xcd - r) * q) + off; }
        const int nig = WGM * nN, gid = wgid / nig, fm = gid * WGM, gsz = (nM - fm) < WGM ? (nM - fm) : WGM;
        u.pm = fm + ((wgid % nig) % gsz); u.pn = (wgid % nig) / gsz; return true;
    }
    __device__ __forceinline__ void a_ready(const Unit&) const {}
    __device__ __forceinline__ void done(const Unit&) const {}
};


__device__ __forceinline__ unsigned cvt_pk_bf16(float lo, float hi) { unsigned r; asm volatile("v_cvt_pk_bf16_f32 %0, %1, %2" : "=v"(r) : "v"(lo), "v"(hi)); return r; }
typedef unsigned u32x2 __attribute__((ext_vector_type(2)));
constexpr float RMS_EPS_F = 1e-6f;
constexpr float LOG2E_F = 1.4426950408889634f;
__device__ __forceinline__ float row_rs(const float* ssqp, int row) {
    const f32x4* p = (const f32x4*)(ssqp + (size_t)row * 16);
    const f32x4 a = p[0], b = p[1], c = p[2], d = p[3];
    const float s = ((a[0] + a[1]) + (a[2] + a[3])) + ((b[0] + b[1]) + (b[2] + b[3])) + ((c[0] + c[1]) + (c[2] + c[3])) + ((d[0] + d[1]) + (d[2] + d[3]));
    return __builtin_amdgcn_rsqf(s * (1.0f / 1024.0f) + RMS_EPS_F);
}
__device__ __forceinline__ float silu_f(float g) { return g * __builtin_amdgcn_rcpf(1.0f + __builtin_amdgcn_exp2f(-g * LOG2E_F)); }
__device__ __forceinline__ float sigmoid_f(float g) { return __builtin_amdgcn_rcpf(1.0f + __builtin_amdgcn_exp2f(-g * LOG2E_F)); }

struct EpiSwiGLU {
    static constexpr bool PERM = true, AFTER_DRAIN = false;
    bf16_t* O; int ldo; const float* ssqp;
    __device__ __forceinline__ void operator()(const f32x4 (&acc)[2][2][4][2], const Unit& u, int wr, int wc, int fr, int fq) const {
        const int row0 = u.pm * BM + wr * 64 + fr, col0 = u.pn * HALF + wc * 32 + 8 * fq;
#pragma unroll
        for (int ai = 0; ai < 2; ++ai)
#pragma unroll
            for (int m = 0; m < 4; ++m) {
                const int row = row0 + ai * HALF + m * 16; const float rs = row_rs(ssqp, row);
                const f32x4 g0 = acc[ai][0][m][0] * rs, g1 = acc[ai][0][m][1] * rs, u0 = acc[ai][1][m][0] * rs, u1 = acc[ai][1][m][1] * rs;
                u32x4 w;
                w.x = cvt_pk_bf16(silu_f(g0[0]) * u0[0], silu_f(g0[1]) * u0[1]); w.y = cvt_pk_bf16(silu_f(g0[2]) * u0[2], silu_f(g0[3]) * u0[3]);
                w.z = cvt_pk_bf16(silu_f(g1[0]) * u1[0], silu_f(g1[1]) * u1[1]); w.w = cvt_pk_bf16(silu_f(g1[2]) * u1[2], silu_f(g1[3]) * u1[3]);
                *(u32x4*)(O + (size_t)row * ldo + col0) = w;
            }
    }
};

struct EpiResid {
    static constexpr bool PERM = true, AFTER_DRAIN = false;
    const float* basef; const bf16_t* bhi; const unsigned char* blo; float* outf; bf16_t* ohi; unsigned char* olo; float* ssqp; float alpha; int aux;
    static constexpr float LOS = 4096.0f, LOI = 1.0f / 4096.0f;
    __device__ __forceinline__ static f32x4 up_bf(unsigned a, unsigned b) { return (f32x4){__uint_as_float(a << 16), __uint_as_float(a & 0xffff0000u), __uint_as_float(b << 16), __uint_as_float(b & 0xffff0000u)}; }
    __device__ __forceinline__ static f32x4 up_f8(unsigned w) { return (f32x4){__builtin_amdgcn_cvt_f32_fp8((int)w, 0), __builtin_amdgcn_cvt_f32_fp8((int)w, 1), __builtin_amdgcn_cvt_f32_fp8((int)w, 2), __builtin_amdgcn_cvt_f32_fp8((int)w, 3)} * LOI; }
    __device__ __forceinline__ static unsigned pk_f8(f32x4 r) {
        r = r * LOS;
#pragma unroll
        for (int i = 0; i < 4; ++i) r[i] = __builtin_amdgcn_fmed3f(r[i], -440.0f, 440.0f);
        int p = __builtin_amdgcn_cvt_pk_fp8_f32(r[0], r[1], 0, false); p = __builtin_amdgcn_cvt_pk_fp8_f32(r[2], r[3], p, true); return (unsigned)p; }
    __device__ __forceinline__ void operator()(const f32x4 (&acc)[2][2][4][2], const Unit& u, int wr, int wc, int fr, int fq) const {
        const int row0 = u.pm * BM + wr * 64 + fr, col0 = u.pn * BM + wc * 32 + 8 * fq;
#pragma unroll
        for (int ai = 0; ai < 2; ++ai)
#pragma unroll
            for (int m = 0; m < 4; ++m) {
                const int row = row0 + ai * HALF + m * 16; const size_t off = (size_t)row * 1024 + col0; float ss = 0.f;
#pragma unroll
                for (int bj = 0; bj < 2; ++bj) {
                    f32x4 b0, b1;
                    if (basef) { b0 = *(const f32x4*)(basef + off + bj * HALF); b1 = *(const f32x4*)(basef + off + bj * HALF + 4); }
                    else { const u32x4 h = *(const u32x4*)(bhi + off + bj * HALF); const u32x2 l = *(const u32x2*)(blo + off + bj * HALF); b0 = up_bf(h.x, h.y) + up_f8(l.x); b1 = up_bf(h.z, h.w) + up_f8(l.y); }
                    const f32x4 v0 = b0 + acc[ai][bj][m][0] * alpha, v1 = b1 + acc[ai][bj][m][1] * alpha;
                    if (aux) ss += ((v0[0] * v0[0] + v0[1] * v0[1]) + (v0[2] * v0[2] + v0[3] * v0[3])) + ((v1[0] * v1[0] + v1[1] * v1[1]) + (v1[2] * v1[2] + v1[3] * v1[3]));
                    if (outf) { *(f32x4*)(outf + off + bj * HALF) = v0; *(f32x4*)(outf + off + bj * HALF + 4) = v1; }
                    else { u32x4 h; h.x = cvt_pk_bf16(v0[0], v0[1]); h.y = cvt_pk_bf16(v0[2], v0[3]); h.z = cvt_pk_bf16(v1[0], v1[1]); h.w = cvt_pk_bf16(v1[2], v1[3]);
                        u32x2 l; l.x = pk_f8(v0 - up_bf(h.x, h.y)); l.y = pk_f8(v1 - up_bf(h.z, h.w));
                        *(u32x4*)(ohi + off + bj * HALF) = h; *(u32x2*)(olo + off + bj * HALF) = l; }
                }
                if (aux) { ss += __shfl_xor(ss, 16); ss += __shfl_xor(ss, 32); if (fq == 0) ssqp[(size_t)row * 16 + u.pn * 4 + wc] = ss; }
            }
    }
};

struct EpiWin {
    static constexpr bool PERM = true, AFTER_DRAIN = false;
    bf16_t* QO; bf16_t* KB; bf16_t* VB; bf16_t* RW; const float* ssqp; const float* gq; const float* gk; float qscale;
    __device__ __forceinline__ void operator()(const f32x4 (&acc)[2][2][4][2], const Unit& u, int wr, int wc, int fr, int fq) const {
        const int row0 = u.pm * BM + wr * 64 + fr; const int pn = u.pn;
        if (pn < 4) {
            const float* gp = (pn < 2) ? gq : gk; const float osc = (pn < 2) ? qscale : 1.0f;
            f32x4 gv[2][2];
#pragma unroll
            for (int bj = 0; bj < 2; ++bj)
#pragma unroll
                for (int n = 0; n < 2; ++n) gv[bj][n] = *(const f32x4*)(gp + 32 * bj + 8 * fq + 4 * n) * osc;
            bf16_t* dst = (pn < 2) ? QO : KB; const int ld = (pn < 2) ? 1024 : 512; const int colh = 64 * (4 * (pn & 1) + wc) + 8 * fq;
#pragma unroll
            for (int ai = 0; ai < 2; ++ai)
#pragma unroll
                for (int m = 0; m < 4; ++m) {
                    const int row = row0 + ai * HALF + m * 16; const float rs = row_rs(ssqp, row);
                    f32x4 y[2][2]; float ss = 0.f;
#pragma unroll
                    for (int bj = 0; bj < 2; ++bj)
#pragma unroll
                        for (int n = 0; n < 2; ++n) { y[bj][n] = acc[ai][bj][m][n] * rs; const f32x4 t = y[bj][n]; ss += (t[0] * t[0] + t[1] * t[1]) + (t[2] * t[2] + t[3] * t[3]); }
                    ss += __shfl_xor(ss, 16); ss += __shfl_xor(ss, 32);
                    const float hs = __builtin_amdgcn_rsqf(ss * (1.0f / 64.0f) + RMS_EPS_F);
#pragma unroll
                    for (int bj = 0; bj < 2; ++bj) {
                        const f32x4 a = y[bj][0] * gv[bj][0] * hs, b = y[bj][1] * gv[bj][1] * hs;
                        u32x4 w; w.x = cvt_pk_bf16(a[0], a[1]); w.y = cvt_pk_bf16(a[2], a[3]); w.z = cvt_pk_bf16(b[0], b[1]); w.w = cvt_pk_bf16(b[2], b[3]);
                        *(u32x4*)(dst + (size_t)row * ld + colh + 32 * bj) = w;
                    }
                }
        } else {
            bf16_t* dst = (pn < 6) ? VB : RW; const int ld = (pn < 6) ? 512 : 1792; const int colh = 256 * ((pn < 6) ? (pn - 4) : (pn - 6)) + 64 * wc + 8 * fq;
#pragma unroll
            for (int ai = 0; ai < 2; ++ai)
#pragma unroll
                for (int m = 0; m < 4; ++m) {
                    const int row = row0 + ai * HALF + m * 16; const float rs = row_rs(ssqp, row);
#pragma unroll
                    for (int bj = 0; bj < 2; ++bj) {
                        const f32x4 a = acc[ai][bj][m][0] * rs, b = acc[ai][bj][m][1] * rs;
                        u32x4 w; w.x = cvt_pk_bf16(a[0], a[1]); w.y = cvt_pk_bf16(a[2], a[3]); w.z = cvt_pk_bf16(b[0], b[1]); w.w = cvt_pk_bf16(b[2], b[3]);
                        *(u32x4*)(dst + (size_t)row * ld + colh + 32 * bj) = w;
                    }
                }
        }
    }
};

template <class Epi, class Sched, bool ALIGN_EPI = false, bool SP2 = false>
__device__ __forceinline__ void gemm_phase(PG8_LAS unsigned char* lds, const Gemm g, const Sched& S, const Epi& E) {
    const int tid = threadIdx.x, wid = __builtin_amdgcn_readfirstlane(tid >> 6), lane = tid & 63, wr = wid >> 2, wc = wid & 3, fr = lane & 15, fq = lane >> 4;
    const int K = g.K, nt = K / BK, LDP = g.ld ? g.ld : g.K;
    unsigned voffA[2], voffB[2];
#pragma unroll
    for (int i = 0; i < 2; ++i) { int R, C; stage_rc(tid * 16 + i * 8192, R, C); const int Rb = Epi::PERM ? ((R & ~31) + perm32(R & 31)) : R;
        voffA[i] = (unsigned)(R * LDP + C) * 2u; voffB[i] = (unsigned)(Rb * LDP + C) * 2u; }
    const size_t kstep = (size_t)(BK * 2);
    const size_t hstep = (size_t)HALF * LDP * 2;
    const size_t tstep = 2 * hstep;
    const unsigned ldsw = (unsigned)wid * 1024u;
    const int aoff = lds_byte(wr * 64 + fr, fq * 8), boff = lds_byte(wc * 32 + fr, fq * 8);
#define PG8_SA(b, h) (((b) * 2 + (h)) * HTB)
#define PG8_SB(b, h) ((4 + (b) * 2 + (h)) * HTB)
#define PG8_STAGE(bufoff, gbase, voff) do { _Pragma("unroll") for (int _i = 0; _i < 2; ++_i) \
        __builtin_amdgcn_global_load_lds((const unsigned*)((const char*)(gbase) + (voff)[_i]), (PG8_LAS unsigned*)(lds + (bufoff) + ldsw + _i * 8192), 16, 0, 0); } while (0)
#define PG8_LDA(dst, b, h) do { _Pragma("unroll") for (int m = 0; m < 4; ++m) _Pragma("unroll") for (int k = 0; k < 2; ++k) dst[m][k] = *(const PG8_LAS bf16x8*)(lds + PG8_SA(b, h) + aoff + m * 2048 + k * 1024); } while (0)
#define PG8_LDB(dst, b, h) do { _Pragma("unroll") for (int n = 0; n < 2; ++n) _Pragma("unroll") for (int k = 0; k < 2; ++k) dst[n][k] = *(const PG8_LAS bf16x8*)(lds + PG8_SB(b, h) + boff + n * 2048 + k * 1024); } while (0)
#define PG8_MMA(ai, bj, At, Bt) do { __builtin_amdgcn_s_setprio(1); _Pragma("unroll") for (int m = 0; m < 4; ++m) _Pragma("unroll") for (int n = 0; n < 2; ++n) _Pragma("unroll") for (int k = 0; k < 2; ++k) \
        acc[ai][bj][m][n] = __builtin_amdgcn_mfma_f32_16x16x32_bf16(Bt[n][k], At[m][k], acc[ai][bj][m][n], 0, 0, 0); __builtin_amdgcn_s_setprio(0); } while (0)
#define PG8_WAIT_V(n) asm volatile("s_waitcnt vmcnt(" #n ")" ::: "memory")
#define PG8_WAIT_L(n) asm volatile("s_waitcnt lgkmcnt(" #n ")" ::: "memory")
#define PG8_BAR __builtin_amdgcn_s_barrier()
#define PG8_SCHED __builtin_amdgcn_sched_barrier(0)
    Unit cur, nxt; int ui = 0;
    if (!S.next(0, cur)) return;
    f32x4 acc[2][2][4][2];
#pragma unroll
    for (int a = 0; a < 2; ++a)
#pragma unroll
        for (int b = 0; b < 2; ++b)
#pragma unroll
            for (int m = 0; m < 4; ++m)
#pragma unroll
                for (int n = 0; n < 2; ++n) acc[a][b][m][n] = (f32x4){0.f, 0.f, 0.f, 0.f};
    bf16x8 At[4][2], B0[2][2], B1[2][2];
    const char* cA = (const char*)g.A + (size_t)cur.pm * tstep; const char* cB = (const char*)g.Bt + (size_t)cur.pn * tstep;
    S.a_ready(cur);
    if constexpr (SP2) {
        PG8_STAGE(PG8_SB(0, 0), cB, voffB); PG8_STAGE(PG8_SB(0, 1), cB + hstep, voffB); PG8_STAGE(PG8_SA(0, 0), cA, voffA); PG8_STAGE(PG8_SA(0, 1), cA + hstep, voffA);
        if (wr == 1) PG8_BAR;
        PG8_WAIT_V(2); PG8_BAR;
        PG8_STAGE(PG8_SB(1, 0), cB + kstep, voffB); PG8_STAGE(PG8_SA(1, 0), cA + kstep, voffA); PG8_STAGE(PG8_SB(1, 1), cB + hstep + kstep, voffB);
        PG8_WAIT_V(6); PG8_BAR;
    } else {
        PG8_STAGE(PG8_SB(0, 0), cB, voffB); PG8_STAGE(PG8_SA(0, 0), cA, voffA); PG8_STAGE(PG8_SB(0, 1), cB + hstep, voffB); PG8_STAGE(PG8_SA(0, 1), cA + hstep, voffA);
        if (wr == 1) PG8_BAR;
        PG8_WAIT_V(4); PG8_BAR;
        PG8_STAGE(PG8_SB(1, 0), cB + kstep, voffB); PG8_STAGE(PG8_SA(1, 0), cA + kstep, voffA); PG8_STAGE(PG8_SB(1, 1), cB + hstep + kstep, voffB);
        PG8_WAIT_V(6); PG8_BAR;
    }
    for (;;) {
        const bool has_next = S.next(ui + 1, nxt);
        const char* nA = has_next ? (const char*)g.A + (size_t)nxt.pm * tstep : cA; const char* nB = has_next ? (const char*)g.Bt + (size_t)nxt.pn * tstep : cB;
        for (int t = 0; t < nt; t += 2) {
            const bool last = (t == nt - 2);
            const char* a1 = cA + (size_t)(t + 1) * kstep;
            const char* a2 = last ? nA : cA + (size_t)(t + 2) * kstep; const char* b2 = last ? nB : cB + (size_t)(t + 2) * kstep;
            const char* a3 = a2 + kstep; const char* b3 = b2 + kstep;
            if (last && has_next) S.a_ready(nxt);
            if constexpr (SP2) {
            PG8_LDB(B0, 0, 0); PG8_LDB(B1, 0, 1); PG8_SCHED; PG8_LDA(At, 0, 0); PG8_STAGE(PG8_SA(1, 1), a1 + hstep, voffA);
            PG8_WAIT_V(8); PG8_WAIT_L(0); PG8_BAR; PG8_MMA(0, 0, At, B0); PG8_MMA(0, 1, At, B1); PG8_BAR; PG8_SCHED;
            PG8_LDA(At, 0, 1); PG8_STAGE(PG8_SB(0, 0), b2, voffB); PG8_STAGE(PG8_SB(0, 1), b2 + hstep, voffB); PG8_STAGE(PG8_SA(0, 0), a2, voffA);
            PG8_WAIT_V(8); PG8_WAIT_L(0); PG8_BAR; PG8_MMA(1, 0, At, B0); PG8_MMA(1, 1, At, B1); PG8_BAR; PG8_SCHED;
            PG8_LDB(B0, 1, 0); PG8_LDB(B1, 1, 1); PG8_SCHED; PG8_LDA(At, 1, 0); PG8_STAGE(PG8_SA(0, 1), a2 + hstep, voffA);
            PG8_WAIT_V(8); PG8_WAIT_L(0); PG8_BAR; PG8_MMA(0, 0, At, B0); PG8_MMA(0, 1, At, B1); PG8_BAR; PG8_SCHED;
            PG8_LDA(At, 1, 1); PG8_STAGE(PG8_SB(1, 0), b3, voffB); PG8_STAGE(PG8_SB(1, 1), b3 + hstep, voffB); PG8_STAGE(PG8_SA(1, 0), a3, voffA);
            PG8_WAIT_V(8); PG8_WAIT_L(0); PG8_BAR; PG8_MMA(1, 0, At, B0); PG8_MMA(1, 1, At, B1); PG8_BAR; PG8_SCHED;
            } else {
            PG8_LDB(B0, 0, 0); PG8_SCHED; PG8_LDA(At, 0, 0); PG8_STAGE(PG8_SA(1, 1), a1 + hstep, voffA);
            PG8_WAIT_L(8); PG8_BAR; PG8_WAIT_L(0); PG8_MMA(0, 0, At, B0); PG8_BAR; PG8_SCHED;
            PG8_LDB(B1, 0, 1); PG8_STAGE(PG8_SB(0, 0), b2, voffB);
            PG8_BAR; PG8_WAIT_L(0); PG8_MMA(0, 1, At, B1); PG8_BAR;
            PG8_LDA(At, 0, 1); PG8_STAGE(PG8_SA(0, 0), a2, voffA);
            PG8_BAR; PG8_WAIT_L(0); PG8_MMA(1, 0, At, B0); PG8_BAR; PG8_SCHED;
            PG8_STAGE(PG8_SB(0, 1), b2 + hstep, voffB);
            PG8_WAIT_V(6); PG8_BAR; PG8_MMA(1, 1, At, B1); PG8_BAR;
            PG8_LDB(B0, 1, 0); PG8_SCHED; PG8_LDA(At, 1, 0); PG8_STAGE(PG8_SA(0, 1), a2 + hstep, voffA);
            PG8_WAIT_L(8); PG8_BAR; PG8_WAIT_L(0); PG8_MMA(0, 0, At, B0); PG8_BAR; PG8_SCHED;
            PG8_LDB(B1, 1, 1); PG8_STAGE(PG8_SB(1, 0), b3, voffB);
            PG8_BAR; PG8_WAIT_L(0); PG8_MMA(0, 1, At, B1); PG8_BAR;
            PG8_LDA(At, 1, 1); PG8_STAGE(PG8_SA(1, 0), a3, voffA);
            PG8_BAR; PG8_WAIT_L(0); PG8_MMA(1, 0, At, B0); PG8_BAR; PG8_SCHED;
            PG8_STAGE(PG8_SB(1, 1), b3 + hstep, voffB);
            PG8_WAIT_V(6); PG8_BAR; PG8_MMA(1, 1, At, B1); PG8_BAR;
            }
        }
        if constexpr (ALIGN_EPI) { if (wr == 0) PG8_BAR; }
        if constexpr (!Epi::AFTER_DRAIN) { E(acc, cur, wr, wc, fr, fq); S.done(cur); }
        if (!has_next) break;
#pragma unroll
        for (int a = 0; a < 2; ++a)
#pragma unroll
            for (int b = 0; b < 2; ++b)
#pragma unroll
                for (int m = 0; m < 4; ++m)
#pragma unroll
                    for (int n = 0; n < 2; ++n) acc[a][b][m][n] = (f32x4){0.f, 0.f, 0.f, 0.f};
        cur = nxt; cA = nA; cB = nB; ++ui;
        if constexpr (ALIGN_EPI) { if (wr == 1) PG8_BAR; }
    }
    PG8_WAIT_V(0);
    if constexpr (!ALIGN_EPI) { if (wr == 0) PG8_BAR; }
    PG8_BAR;
    if constexpr (Epi::AFTER_DRAIN) { E.fused(acc, cur, wr, wc, fr, fq, lds, wid, lane); S.done(cur); }
#undef PG8_SA
#undef PG8_SB
#undef PG8_STAGE
#undef PG8_LDA
#undef PG8_LDB
#undef PG8_MMA
#undef PG8_WAIT_V
#undef PG8_WAIT_L
#undef PG8_BAR
#undef PG8_SCHED
}
}
#define GAS __attribute__((address_space(1)))
#define LAS __attribute__((address_space(3)))
typedef unsigned short bf16;
typedef unsigned v4u __attribute__((ext_vector_type(4)));
typedef float f32x4 __attribute__((ext_vector_type(4)));
typedef short bf16x8 __attribute__((ext_vector_type(8)));
typedef GAS unsigned gu32;
typedef GAS unsigned long long gu64;
#define RLX_AGENT __ATOMIC_RELAXED, __HIP_MEMORY_SCOPE_AGENT
#define LDS_WAIT() asm volatile("s_waitcnt lgkmcnt(0)" ::: "memory")
#define VM_WAIT() asm volatile("s_waitcnt vmcnt(0)" ::: "memory")
__device__ __forceinline__ unsigned long long rt() { return __builtin_amdgcn_s_memrealtime(); }
__device__ __forceinline__ unsigned f2bf(float f) { unsigned u = __builtin_bit_cast(unsigned, f); return (u + 0x7fffu + ((u >> 16) & 1u)) >> 16; }
__device__ __forceinline__ unsigned pk2(float lo, float hi) { return f2bf(lo) | (f2bf(hi) << 16); }

#define XB_TMO      128
#define XB_XCNT(j)  (256  + 64 * (j))
#define XB_XSUB(j)  (1280 + 64 * (j))
#define XB_XGEN(j)  (2304 + 64 * (j))
#define XB_TOP      3328
#define XB_TOPGEN   3392
#define XCD_BAR_WORDS 3456
#define XB_SPIN_CAP (1u << 18)

__device__ __forceinline__ unsigned xb_ld(unsigned* p)              { return __hip_atomic_load(p, __ATOMIC_RELAXED, __HIP_MEMORY_SCOPE_AGENT); }
__device__ __forceinline__ unsigned xb_add(unsigned* p, unsigned v) { return __hip_atomic_fetch_add(p, v, __ATOMIC_RELAXED, __HIP_MEMORY_SCOPE_AGENT); }
__device__ __forceinline__ unsigned xb_xcc_id() { return (unsigned)__builtin_amdgcn_s_getreg((3 << 11) | 20) & 0xFu; }
#define XB_SPIN(cond, bar) do { unsigned _sp = 0; while (cond) { __builtin_amdgcn_s_sleep(1); \
    if ((++_sp & 255u) == 0u) { if (xb_ld(&(bar)[XB_TMO])) break; if (_sp > XB_SPIN_CAP) { atomicAdd(&(bar)[XB_TMO], 1u); break; } } } } while (0)

struct XcdBarrier {
    unsigned* bar; unsigned x;
    volatile LAS unsigned* st;
};

__device__ __forceinline__ XcdBarrier xcd_barrier_post(unsigned* bar, volatile LAS unsigned* st) {
    XcdBarrier b; b.bar = bar; b.x = xb_xcc_id(); b.st = st;
    if (threadIdx.x == 0) (void)xb_add(&bar[XB_XCNT(b.x)], 1u);
    return b;
}
__device__ __forceinline__ void xcd_barrier_complete(unsigned* bar, unsigned x, unsigned& nloc, unsigned& nx) {
    const unsigned G = gridDim.x * gridDim.y * gridDim.z;
    unsigned sum, cnt, mine, sp = 0u;
    for (;;) {
        sum = 0u; cnt = 0u; mine = 0u;
#pragma unroll
        for (unsigned j = 0; j < 16; ++j) { const unsigned c = xb_ld(&bar[XB_XCNT(j)]); sum += c; cnt += (c > 0u) ? 1u : 0u; mine = (j == x) ? c : mine; }
        if (sum == G) break;
        __builtin_amdgcn_s_sleep(1);
        if ((++sp & 255u) == 0u) { if (xb_ld(&bar[XB_TMO])) break; if (sp > XB_SPIN_CAP) { atomicAdd(&bar[XB_TMO], 1u); break; } }
    }
    nloc = mine > 0u ? mine : 1u; nx = cnt > 0u ? cnt : 1u;
}

__device__ __forceinline__ void xcd_barrier(const XcdBarrier& b) {
    asm volatile("s_waitcnt vmcnt(0)" ::: "memory");
    __syncthreads();
    if (threadIdx.x == 0) {
        unsigned* bar = b.bar;
        __builtin_amdgcn_s_waitcnt(0);
        unsigned nloc = b.st[0], nx = b.st[1];
        if (nloc == 0u) { xcd_barrier_complete(bar, b.x, nloc, nx); b.st[0] = nloc; b.st[1] = nx; }
        const unsigned old = xb_add(&bar[XB_XSUB(b.x)], 1u);
        const unsigned gen = old / nloc;
        if (old + 1u == (gen + 1u) * nloc) {
            __builtin_amdgcn_fence(__ATOMIC_RELEASE, "agent");
            asm volatile("s_waitcnt vmcnt(0)" ::: "memory");
            const unsigned og = xb_add(&bar[XB_TOP], 1u);
            const unsigned tg = og / nx;
            if (og + 1u == (tg + 1u) * nx) xb_add(&bar[XB_TOPGEN], 1u);
            else XB_SPIN(xb_ld(&bar[XB_TOPGEN]) == tg, bar);
            __builtin_amdgcn_fence(__ATOMIC_ACQUIRE, "agent");
            xb_add(&bar[XB_XGEN(b.x)], 1u);
            asm volatile("s_waitcnt vmcnt(0)" ::: "memory");
        } else {
            XB_SPIN(xb_ld(&bar[XB_XGEN(b.x)]) == gen, bar);
            __builtin_amdgcn_fence(__ATOMIC_ACQUIRE, "agent");
            asm volatile("s_waitcnt vmcnt(0)" ::: "memory");
        }
    }
    __syncthreads();
}

constexpr int NWAVES = 8;
#ifndef MK_N_LAUNCHES
#define MK_N_LAUNCHES 1
#endif
constexpr int PER_PHASE = 11;
constexpr int N_LAUNCHES = MK_N_LAUNCHES;

constexpr int BATCH = 16, SEQ = 2048, D = 1024, HD = 64, NH = 8, FF = 2816;
constexpr int M = BATCH * SEQ;
constexpr int SBW = 512, RWW = 512, RWP = 1792, PW = 3328, LORA_K = 256, LORA_N = 1536;
constexpr float LNX_EPS = 64e-5f;

constexpr size_t MiB = 1u << 20;
constexpr size_t WS_CTL = 0, CTL_ZERO_BYTES = 128 * 1024;
constexpr size_t WS_SSQ = 1 * MiB;
constexpr size_t WS_W1U = 4 * MiB;
constexpr size_t WS_W1D = 15 * MiB;
constexpr size_t WS_W2U = 21 * MiB;
constexpr size_t WS_W2D = 32 * MiB;
constexpr size_t WS_WIN = 38 * MiB;
constexpr size_t WS_WOUT = 45 * MiB;
constexpr size_t WS_WLORA = 47 * MiB;
constexpr size_t WS_XB = 48 * MiB;
constexpr size_t WS_ACT = 112 * MiB;
constexpr size_t WS_QO = 112 * MiB;
constexpr size_t WS_KB = 176 * MiB;
constexpr size_t WS_VB = 208 * MiB;
constexpr size_t WS_RW = 240 * MiB;
constexpr size_t WS_ALORA = 352 * MiB;
constexpr size_t WS_LW = 368 * MiB;
constexpr size_t WS_AB = 432 * MiB;
constexpr size_t WS_GB = 464 * MiB;
constexpr size_t WS_TAIL = 496 * MiB;
constexpr size_t WS_END = 512 * MiB;
constexpr int CW_TMO = 0, CW_CODE = 1;
constexpr int CW_BAR = 4096;
constexpr int CW_QUEUE = 16384;

constexpr int RING_OFF = 0, RING_BYTES = 155648;
constexpr int LDSCTL_OFF = RING_BYTES, MISC_OFF = LDSCTL_OFF;
constexpr int LDS_BYTES = 163840;

struct Frame {
    LAS unsigned char* lds;
    volatile LAS unsigned* MISC;
    gu32* ctl;
    int tid, lane, wave;
    int vcu, G;
};
typedef unsigned u32x2g __attribute__((ext_vector_type(2)));
__device__ __forceinline__ float bf2f(unsigned short h) { return __uint_as_float(((unsigned)h) << 16); }
typedef float f32x2h __attribute__((ext_vector_type(2))); typedef __bf16 bf16x2h __attribute__((ext_vector_type(2)));
__device__ __forceinline__ unsigned pkbf(float lo, float hi) { f32x2h v = {lo, hi}; bf16x2h b = __builtin_convertvector(v, bf16x2h); return __builtin_bit_cast(unsigned, b); }
__device__ __forceinline__ float bflo(unsigned w) { return __uint_as_float(w << 16); }
__device__ __forceinline__ float bfhi(unsigned w) { return __uint_as_float(w & 0xffff0000u); }
__device__ __forceinline__ float wave_sum(float v) {
#pragma unroll
    for (int o = 1; o < 64; o <<= 1) v += __shfl_xor(v, o);
    return v;
}
#define DPP_ADD(v, ctrl) ((v) + __int_as_float(__builtin_amdgcn_update_dpp(0, __float_as_int(v), (ctrl), 0xF, 0xF, true)))
__device__ __forceinline__ float sum8(float v) { v = DPP_ADD(v, 0xB1); v = DPP_ADD(v, 0x4E); v = DPP_ADD(v, 0x141); return v; }

struct TItem { const float* W; int ldw, k0, n0; const float* sc; bf16* WT; int Kd, rho0; };
__device__ __forceinline__ void ti_load(const TItem& T, float (&t)[32], int lane) {
#pragma unroll
    for (int i = 0; i < 32; ++i) t[i] = T.W[(size_t)(T.k0 + 2 * i + (lane >> 5)) * T.ldw + T.n0 + (lane & 31)];
}
__device__ __forceinline__ void ti_finish(const TItem& T, const float (&t)[32], LAS float* scr, int lane) {
#pragma unroll
    for (int i = 0; i < 32; ++i) scr[(2 * i + (lane >> 5)) * 33 + (lane & 31)] = t[i];
    LDS_WAIT(); asm volatile("" ::: "memory");
    const int c = lane & 7;
    f32x4 s0 = (f32x4){1.f, 1.f, 1.f, 1.f}, s1 = s0;
    if (T.sc) { s0 = *(const f32x4*)(T.sc + T.k0 + 8 * c); s1 = *(const f32x4*)(T.sc + T.k0 + 8 * c + 4); }
#pragma unroll
    for (int j = 0; j < 4; ++j) { const int n = (lane >> 3) + 8 * j; const LAS float* s = scr + (8 * c) * 33 + n;
        v4u o; o.x = pkbf(s[0 * 33] * s0.x, s[1 * 33] * s0.y); o.y = pkbf(s[2 * 33] * s0.z, s[3 * 33] * s0.w); o.z = pkbf(s[4 * 33] * s1.x, s[5 * 33] * s1.y); o.w = pkbf(s[6 * 33] * s1.z, s[7 * 33] * s1.w);
        *(GAS v4u*)(T.WT + (size_t)(T.rho0 + n) * T.Kd + T.k0 + 8 * c) = o; }
    LDS_WAIT(); asm volatile("" ::: "memory");
}
#define P0_PTRS const float* Ax, const float* An1, const float* Ag1, const float* Au1, const float* Ad1, const float* Anm, const float* Awin, const float* Aw2, const float* Aa2, const float* Ag2, const float* Awout, \
    const float* An2, const float* Ag2f, const float* Au2f, const float* Ad2f, bf16* AW1U, bf16* AW1D, bf16* AW2U, bf16* AW2D, bf16* AWIN, bf16* AWOUT, bf16* AWLORA, bf16* AXB, float* ASSQ
__device__ __forceinline__ void p0_items(Frame& F, P0_PTRS, int set, int gw, int NGW) {
    LAS float* scr = (LAS float*)(F.lds + RING_OFF + F.wave * 16384);
    constexpr int I_UP = 16 * 176, I_DN = 44 * 32, I_IN = 16 * 104, I_OUT = 16 * 32;
    const int NITEMS = set ? (I_UP + I_DN) : (I_UP + I_DN + I_IN + I_OUT);
#define P0_DECODE(it_, T) do { int r = (it_); const int l2 = set; \
        if (r < I_UP) { const int kb = r / 176, nb = r % 176, rho0 = 32 * nb, pn = rho0 >> 8, bj = (rho0 >> 7) & 1, j0 = rho0 & 127; \
            T = TItem{l2 ? (bj ? Au2f : Ag2f) : (bj ? Au1 : Ag1), FF, 64 * kb, 128 * pn + j0, l2 ? An2 : An1, l2 ? AW2U : AW1U, D, rho0}; } \
        else if ((r -= I_UP) < I_DN) { const int kb = r / 32, nb = r % 32; \
            T = TItem{l2 ? Ad2f : Ad1, D, 64 * kb, 32 * nb, nullptr, l2 ? AW2D : AW1D, FF, 32 * nb}; } \
        else if ((r -= I_DN) < I_IN) { const int kb = r / 104, nb = r % 104, rho0 = 32 * nb, pn = rho0 >> 8, rem = rho0 & 255, bj = rem >> 7, wc = (rem & 127) >> 5; \
            T = TItem{Awin, PW, 64 * kb, 256 * pn + 64 * wc + 32 * bj, Anm, AWIN, D, rho0}; } \
        else { r -= I_IN; const int kb = r / 32, nb = r % 32; T = TItem{Awout, D, 64 * kb, 32 * nb, nullptr, AWOUT, D, 32 * nb}; } } while (0)
    for (int it = gw; it < NITEMS; it += 2 * NGW) {
        TItem T0, T1; float t0[32], t1[32]; const bool two = (it + NGW < NITEMS);
        P0_DECODE(it, T0); ti_load(T0, t0, F.lane);
        if (two) { P0_DECODE(it + NGW, T1); ti_load(T1, t1, F.lane); }
        ti_finish(T0, t0, scr, F.lane);
        if (two) ti_finish(T1, t1, scr, F.lane);
    }
#undef P0_DECODE
}
__device__ __forceinline__ void p0_prologue(Frame& F, P0_PTRS) {
    const int gw = F.vcu * NWAVES + F.wave, NGW = F.G * NWAVES;
    p0_items(F, Ax, An1, Ag1, Au1, Ad1, Anm, Awin, Aw2, Aa2, Ag2, Awout, An2, Ag2f, Au2f, Ad2f, AW1U, AW1D, AW2U, AW2D, AWIN, AWOUT, AWLORA, AXB, ASSQ, (F.G >= 256) ? 0 : 0, gw, NGW);
    if (F.G < 256) p0_items(F, Ax, An1, Ag1, Au1, Ad1, Anm, Awin, Aw2, Aa2, Ag2, Awout, An2, Ag2f, Au2f, Ad2f, AW1U, AW1D, AW2U, AW2D, AWIN, AWOUT, AWLORA, AXB, ASSQ, 1, gw, NGW);
    for (int it = F.vcu * (NWAVES * 64) + F.tid; it < 512 * 32; it += F.G * NWAVES * 64) {
        int ch, kc, Kk; const float* src; bf16* dst;
        if (it < 512 * 8) { ch = it >> 3; kc = (it & 7) * 8; Kk = 64; src = Aw2; dst = AWLORA; }
        else if (it < 512 * 16) { const int i2 = it - 512 * 8; ch = i2 >> 3; kc = (i2 & 7) * 8; Kk = 64; src = Aa2; dst = AWLORA + 512 * 64; }
        else { const int i2 = it - 512 * 16; ch = i2 >> 4; kc = (i2 & 15) * 8; Kk = 128; src = Ag2; dst = AWLORA + 2 * 512 * 64; }
        float v[8];
#pragma unroll
        for (int j = 0; j < 8; ++j) v[j] = src[(size_t)(kc + j) * 512 + ch];
        v4u o; o.x = pkbf(v[0], v[1]); o.y = pkbf(v[2], v[3]); o.z = pkbf(v[4], v[5]); o.w = pkbf(v[6], v[7]);
        *(GAS v4u*)(dst + (size_t)ch * Kk + kc) = o;
    }
    for (int mb = gw; mb < M; mb += 4 * NGW) {
        f32x4 v[4][4]; float s[4];
#pragma unroll
        for (int q = 0; q < 4; ++q) { const int m = mb + q * NGW; const GAS f32x4* xr = (const GAS f32x4*)(Ax + (size_t)(m < M ? m : mb) * D) + F.lane;
#pragma unroll
            for (int j = 0; j < 4; ++j) v[q][j] = xr[64 * j]; }
#pragma unroll
        for (int q = 0; q < 4; ++q) { float a = 0.f;
#pragma unroll
            for (int j = 0; j < 4; ++j) a += (v[q][j].x * v[q][j].x + v[q][j].y * v[q][j].y) + (v[q][j].z * v[q][j].z + v[q][j].w * v[q][j].w);
            s[q] = a; }
#pragma unroll
        for (int o = 1; o < 64; o <<= 1) {
#pragma unroll
            for (int q = 0; q < 4; ++q) s[q] += __shfl_xor(s[q], o); }
#pragma unroll
        for (int q = 0; q < 4; ++q) { const int m = mb + q * NGW; if (m < M) {
            GAS unsigned long long* o8 = (GAS unsigned long long*)(AXB + (size_t)m * D) + F.lane;
#pragma unroll
            for (int j = 0; j < 4; ++j) o8[64 * j] = (unsigned long long)pkbf(v[q][j].x, v[q][j].y) | ((unsigned long long)pkbf(v[q][j].z, v[q][j].w) << 32);
            if (F.lane < 16) ASSQ[(size_t)m * 16 + F.lane] = (F.lane == 0) ? s[q] : 0.f; } }
    }
}

struct RwArgs { const bf16* RW; const bf16* W2T; const bf16* A2T; const bf16* G2T; const float* w0; const float* a0; bf16* QO; const float *mu, *k_k, *k_a, *r_k, *ln_w, *ln_b; };
__device__ __forceinline__ void ld8bf(const bf16* p, float (&o)[8]) { const v4u w = *(const v4u*)p; o[0] = bflo(w.x); o[1] = bfhi(w.x); o[2] = bflo(w.y); o[3] = bfhi(w.y); o[4] = bflo(w.z); o[5] = bfhi(w.z); o[6] = bflo(w.w); o[7] = bfhi(w.w); }
__device__ __forceinline__ void ld8f(const float* p, float (&o)[8]) { const f32x4 a = *(const f32x4*)p, b = *(const f32x4*)(p + 4); o[0] = a.x; o[1] = a.y; o[2] = a.z; o[3] = a.w; o[4] = b.x; o[5] = b.y; o[6] = b.z; o[7] = b.w; }
__device__ __forceinline__ void ld8l(const LAS float* p, float (&o)[8]) { const f32x4 a = *(const LAS f32x4*)p, b = *(const LAS f32x4*)(p + 4); o[0] = a.x; o[1] = a.y; o[2] = a.z; o[3] = a.w; o[4] = b.x; o[5] = b.y; o[6] = b.z; o[7] = b.w; }
__device__ __forceinline__ void st8l(LAS float* p, const float (&o)[8]) { *(LAS f32x4*)p = (f32x4){o[0], o[1], o[2], o[3]}; *(LAS f32x4*)(p + 4) = (f32x4){o[4], o[5], o[6], o[7]}; }
namespace rwk {
typedef short bf16x8 __attribute__((ext_vector_type(8)));
typedef short s16x4 __attribute__((ext_vector_type(4)));
typedef short v4i16_t __attribute__((ext_vector_type(4)));
constexpr int SLOT = 8192;
#define RSL(s) (lds + (s) * SLOT)
#define RMFMA(a, b, c) __builtin_amdgcn_mfma_f32_16x16x32_bf16((a), (b), (c), 0, 0, 0)
__device__ __forceinline__ int swz(int row, int cb) { return row * 128 + (cb ^ ((row & 7) << 4)); }
struct Fr2 { bf16x8 k0, k1; };
__device__ __forceinline__ Fr2 ldf(const LAS unsigned char* base, int off) { Fr2 f; f.k0 = *(const LAS bf16x8*)(base + off); f.k1 = *(const LAS bf16x8*)(base + (off ^ 64)); return f; }
__device__ __forceinline__ s16x4 trd(const LAS unsigned char* p) { return __builtin_bit_cast(s16x4, __builtin_amdgcn_ds_read_tr16_b64_v4i16((LAS v4i16_t*)p)); }
__device__ __forceinline__ Fr2 ldt(const LAS unsigned char* base, int o0, int o1) {
    const s16x4 a = trd(base + o0), b = trd(base + o1), c = trd(base + o0 + 4096), d = trd(base + o1 + 4096);
    Fr2 f; f.k0 = (bf16x8){a[0], a[1], a[2], a[3], b[0], b[1], b[2], b[3]}; f.k1 = (bf16x8){c[0], c[1], c[2], c[3], d[0], d[1], d[2], d[3]}; return f; }
template <bool SWAP> __device__ __forceinline__ f32x4 mm(const Fr2& a, const Fr2& b, f32x4 c) {
    if (SWAP) { c = RMFMA(b.k0, a.k0, c); c = RMFMA(b.k1, a.k1, c); } else { c = RMFMA(a.k0, b.k0, c); c = RMFMA(a.k1, b.k1, c); } return c; }
__device__ __forceinline__ void st4(LAS unsigned char* slot, int off, f32x4 v) { u32x2g w; w.x = pkbf(v[0], v[1]); w.y = pkbf(v[2], v[3]); *(LAS u32x2g*)(slot + off) = w; }
__device__ __forceinline__ f32x4 ld4(const LAS unsigned char* slot, int off) { const u32x2g w = *(const LAS u32x2g*)(slot + off); return (f32x4){bflo(w.x), bfhi(w.x), bflo(w.y), bfhi(w.y)}; }
#define LBAR() asm volatile("s_waitcnt lgkmcnt(0)\n\ts_barrier" ::: "memory")
#define DPPF(x, ctrl, rmask) __int_as_float(__builtin_amdgcn_update_dpp(0, __float_as_int(x), (ctrl), (rmask), 0xF, true))
__device__ __forceinline__ float wave_scan(float x) {
    x += DPPF(x, 0x111, 0xF); x += DPPF(x, 0x112, 0xF); x += DPPF(x, 0x114, 0xF); x += DPPF(x, 0x118, 0xF);
    x += DPPF(x, 0x142, 0xA);
    x += DPPF(x, 0x143, 0xC);
    return x; }
__device__ __forceinline__ void unp8(const v4u w, float (&o)[8]) { o[0] = bflo(w.x); o[1] = bfhi(w.x); o[2] = bflo(w.y); o[3] = bfhi(w.y); o[4] = bflo(w.z); o[5] = bfhi(w.z); o[6] = bflo(w.w); o[7] = bfhi(w.w); }
__device__ __forceinline__ v4u pk8(const float (&o)[8]) { return (v4u){pkbf(o[0], o[1]), pkbf(o[2], o[3]), pkbf(o[4], o[5]), pkbf(o[6], o[7])}; }
}
struct RwX { bf16* P1; bf16* GT; bf16* Y0; bf16* H; bf16* VB0; bf16* VB1; float* GE; bf16* G; };
__device__ __forceinline__ void p6a_rwkv_local(Frame& F, const RwArgs& A, const RwX& X) {
    using namespace rwk;
    LAS unsigned char* lds = F.lds + RING_OFF;
    LAS float* part = (LAS float*)(F.lds + LDSCTL_OFF + 128);
    LAS float* cst = (LAS float*)(F.lds + LDSCTL_OFF + 128 + 4096 + 896);
    const int lane = F.lane, fr = lane & 15, fq = lane >> 4, w = F.wave, m0 = 16 * (w >> 1), n0a = 32 * (w & 1);
    const int fm = swz(m0 + fr, fq * 16);
    const int ta0 = swz(8 * fq + (fr >> 2), 2 * (m0 + 4 * (fr & 3))), ta1 = swz(8 * fq + 4 + (fr >> 2), 2 * (m0 + 4 * (fr & 3)));
    int fn[2], orm[2], otr[2], tb0[2], tb1[2];
#pragma unroll
    for (int t = 0; t < 2; ++t) { const int n0 = n0a + 16 * t; fn[t] = swz(n0 + fr, fq * 16); orm[t] = swz(m0 + fr, 2 * (n0 + 4 * fq)); otr[t] = swz(n0 + fr, 2 * (m0 + 4 * fq));
        tb0[t] = swz(8 * fq + (fr >> 2), 2 * (n0 + 4 * (fr & 3))); tb1[t] = swz(8 * fq + 4 + (fr >> 2), 2 * (n0 + 4 * (fr & 3))); }
    const int NJ = BATCH * NH * (SEQ / 64);
    const int tid = F.tid, ltok = tid >> 3, ldg = tid & 7;
    v4u g_r, g_k, g_v, g_xw, g_xa, g_xg0, g_xg1, g_pr;
#define P6A_LOAD(jj) do { const int u_ = (jj) >> 5, c_ = (jj) & 31; const size_t gr_ = (size_t)(u_ >> 3) * SEQ + c_ * 64 + ltok; const int cb_ = 64 * (u_ & 7) + 8 * ldg; const bf16* rp_ = A.RW + gr_ * RWP; \
        g_r = *(const v4u*)(rp_ + cb_); g_k = *(const v4u*)(rp_ + 512 + cb_); g_v = *(const v4u*)(rp_ + 1024 + cb_); \
        g_xw = *(const v4u*)(rp_ + 1536 + 8 * ldg); g_xa = *(const v4u*)(rp_ + 1600 + 8 * ldg); g_xg0 = *(const v4u*)(rp_ + 1664 + 8 * ldg); g_xg1 = *(const v4u*)(rp_ + 1728 + 8 * ldg); \
        g_pr = (v4u){0u, 0u, 0u, 0u}; if (ltok < 7 && c_ > 0) g_pr = *(const v4u*)(A.RW + ((size_t)(u_ >> 3) * SEQ + c_ * 64 - 1) * RWP + (ltok < 3 ? 512 * ltok + cb_ : 1536 + 64 * (ltok - 3) + 8 * ldg)); } while (0)
    if ((int)blockIdx.x < NJ) P6A_LOAD((int)blockIdx.x);
    int hcur = -1;
    LAS unsigned char* prow = (LAS unsigned char*)(F.lds + LDSCTL_OFF + 128 + 4096);
    if (tid < 256) cst[512 + tid] = A.mu[1536 + tid];
    u32x2g s_p1[2], s_gt[2], s_y0[2], s_hh[2]; size_t s_jo = 0; bool s_have = false;
#define P6A_STORE() do { _Pragma("unroll") for (int t = 0; t < 2; ++t) { \
            *(u32x2g*)(X.P1 + s_jo + ((w * 2 + t) * 64 + lane) * 4) = s_p1[t]; *(u32x2g*)(X.GT + s_jo + ((w * 2 + t) * 64 + lane) * 4) = s_gt[t]; \
            *(u32x2g*)(X.Y0 + s_jo + ((w * 2 + t) * 64 + lane) * 4) = s_y0[t]; *(u32x2g*)(X.H + s_jo + ((w * 2 + t) * 64 + lane) * 4) = s_hh[t]; } } while (0)
    for (int job = blockIdx.x; job < NJ; job += F.G) {
        const int unit = job >> 5, c = job & 31; const int h = unit & 7; const int cb = 64 * h + 8 * w; const size_t jo = (size_t)job * 4096;
        {
            const int so = swz(ltok, 16 * ldg);
            *(LAS v4u*)(RSL(12) + so) = g_r; *(LAS v4u*)(RSL(2) + so) = g_k; *(LAS v4u*)(RSL(0) + so) = g_v;
            *(LAS v4u*)(RSL(14) + so) = g_xw; *(LAS v4u*)(RSL(13) + so) = g_xa; *(LAS v4u*)(RSL(10) + so) = g_xg0; *(LAS v4u*)(RSL(11) + so) = g_xg1;
            if (ltok < 7) *(LAS v4u*)(prow + ltok * 128 + 16 * ldg) = g_pr;
            if (h != hcur) {
                *(LAS v4u*)(RSL(16) + so) = *(const v4u*)(A.W2T + (size_t)(64 * h + ltok) * 64 + 8 * ldg); *(LAS v4u*)(RSL(17) + so) = *(const v4u*)(A.A2T + (size_t)(64 * h + ltok) * 64 + 8 * ldg);
                { const int a_ = tid >> 6, i_ = tid & 63;
                  const float* src_ = (a_ == 0) ? A.mu : (a_ == 1) ? A.mu + 512 : (a_ == 2) ? A.mu + 1024 : (a_ == 3) ? A.k_k : (a_ == 4) ? A.k_a : (a_ == 5) ? A.r_k : (a_ == 6) ? A.w0 : A.a0;
                  cst[a_ * 64 + i_] = src_[64 * h + i_]; } }
            hcur = h;
        }
        if (s_have) P6A_STORE();
        { const int nj = job + F.G; if (nj < NJ) P6A_LOAD(nj); }
        LBAR();
        float r[8], k[8], v[8];
        {
            const int so = swz(lane, 16 * w), sp = swz((lane + 63) & 63, 16 * w);
#define P6A_SHIFT(slot, pi, moff, dst) do { float c_[8], p_[8], m_[8]; v4u wc_ = *(const LAS v4u*)(RSL(slot) + so), wp_ = *(const LAS v4u*)(RSL(slot) + sp); \
                if (lane == 0) wp_ = *(const LAS v4u*)(prow + 128 * (pi) + 16 * w); \
                unp8(wc_, c_); unp8(wp_, p_); ld8l(cst + (moff) + 8 * w, m_); \
                _Pragma("unroll") for (int j = 0; j < 8; ++j) dst[j] = c_[j] + (p_[j] - c_[j]) * m_[j]; } while (0)
            P6A_SHIFT(12, 0, 0, r);
            P6A_SHIFT(2, 1, 64, k);
            P6A_SHIFT(0, 2, 128, v); asm volatile("" ::: "memory");
            { float x_[8]; P6A_SHIFT(14, 3, 512, x_);
#pragma unroll
              for (int j = 0; j < 8; ++j) x_[j] = 2.0f * pg8::sigmoid_f(2.0f * x_[j]) - 1.0f;
              *(LAS v4u*)(RSL(14) + so) = pk8(x_); }
            { float x_[8]; P6A_SHIFT(13, 4, 576, x_); *(LAS v4u*)(RSL(13) + so) = pk8(x_); } asm volatile("" ::: "memory");
            { float x_[8]; P6A_SHIFT(10, 5, 640, x_);
#pragma unroll
              for (int j = 0; j < 8; ++j) x_[j] = pg8::sigmoid_f(x_[j]);
              *(LAS v4u*)(RSL(10) + so) = pk8(x_); }
            { float x_[8]; P6A_SHIFT(11, 6, 704, x_);
#pragma unroll
              for (int j = 0; j < 8; ++j) x_[j] = pg8::sigmoid_f(x_[j]);
              *(LAS v4u*)(RSL(11) + so) = pk8(x_); }
#undef P6A_SHIFT
        }
        LBAR();
        {
            const f32x4 z4 = (f32x4){0.f, 0.f, 0.f, 0.f};
            bf16x8 gq[2][4];
#pragma unroll
            for (int t = 0; t < 2; ++t) { const bf16* gp = A.G2T + (size_t)(64 * h + n0a + 16 * t + fr) * 128 + 8 * fq;
#pragma unroll
                for (int q = 0; q < 4; ++q) gq[t][q] = *reinterpret_cast<const bf16x8*>(gp + 32 * q); }
            {   const Fr2 aW = ldf(RSL(14), fm), aA = ldf(RSL(13), fm); Fr2 bW[2], bA[2];
#pragma unroll
                for (int t = 0; t < 2; ++t) { bW[t] = ldf(RSL(16), fn[t]); bA[t] = ldf(RSL(17), fn[t]); }
#pragma unroll
                for (int t = 0; t < 2; ++t) { const int row = m0 + fr, ch = n0a + 16 * t + 4 * fq; const f32x4 lwq = mm<true>(aW, bW[t], z4), alq = mm<true>(aA, bA[t], z4);
                    const f32x4 w0c = *(const LAS f32x4*)(cst + 384 + ch), a0c = *(const LAS f32x4*)(cst + 448 + ch); f32x4 lwv, alv;
#pragma unroll
                    for (int x = 0; x < 4; ++x) { lwv[x] = -0.6065306597126334f * pg8::sigmoid_f(w0c[x] + lwq[x]); alv[x] = pg8::sigmoid_f(a0c[x] + alq[x]); }
                    const int fo = row * 256 + (((ch >> 3) ^ (row & 7)) << 5) + ((ch >> 2) & 1) * 16;
                    *(LAS f32x4*)(RSL(4) + fo) = lwv; *(LAS f32x4*)(RSL(8) + fo) = alv; } }
            asm volatile("" ::: "memory");
            {   const Fr2 aG0 = ldf(RSL(10), fm), aG1 = ldf(RSL(11), fm);
#pragma unroll
                for (int t = 0; t < 2; ++t) { Fr2 bG0, bG1; bG0.k0 = gq[t][0]; bG0.k1 = gq[t][1]; bG1.k0 = gq[t][2]; bG1.k1 = gq[t][3];
                    st4(RSL(3), orm[t], mm<true>(aG1, bG1, mm<true>(aG0, bG0, z4))); } }
        }
        LBAR();
        float kf[8], kk[8], al[8], lw[8]; float ssp = 0.f, bpp = 0.f;
        {
            { const int fo = lane * 256 + ((w ^ (lane & 7)) << 5); const f32x4 a_ = *(const LAS f32x4*)(RSL(4) + fo), b_ = *(const LAS f32x4*)(RSL(4) + fo + 16), c_ = *(const LAS f32x4*)(RSL(8) + fo), d_ = *(const LAS f32x4*)(RSL(8) + fo + 16);
              lw[0] = a_.x; lw[1] = a_.y; lw[2] = a_.z; lw[3] = a_.w; lw[4] = b_.x; lw[5] = b_.y; lw[6] = b_.z; lw[7] = b_.w;
              al[0] = c_.x; al[1] = c_.y; al[2] = c_.z; al[3] = c_.w; al[4] = d_.x; al[5] = d_.y; al[6] = d_.z; al[7] = d_.w; }
            *(v4u*)(X.G + jo + tid * 8) = *(const LAS v4u*)(RSL(3) + swz(ltok, 16 * ldg));
            float kkc[8], kac[8], rkc[8]; ld8l(cst + 192 + 8 * w, kkc); ld8l(cst + 256 + 8 * w, kac); ld8l(cst + 320 + 8 * w, rkc);
#pragma unroll
            for (int j = 0; j < 8; ++j) { kk[j] = k[j] * kkc[j]; ssp += kk[j] * kk[j]; kf[j] = k[j] * (1.0f + (al[j] - 1.0f) * kac[j]); bpp += r[j] * kf[j] * rkc[j]; }
            part[w * 64 + lane] = ssp; part[512 + w * 64 + lane] = bpp;
        }
        LBAR();
        {
            float ss = 0.f, bon = 0.f;
#pragma unroll
            for (int i = 0; i < 8; ++i) { ss += part[i * 64 + lane]; bon += part[512 + i * 64 + lane]; }
            const float inv = 1.0f / fmaxf(sqrtf(ss), 1e-12f);
            float at[8], rt[8], bt[8], kt[8], bh[8], kh[8], ge[8], vb[8];
#pragma unroll
            for (int j = 0; j < 8; ++j) {
                const float cs = wave_scan(lw[j]);
                const float ce = __int_as_float(__builtin_amdgcn_readlane(__float_as_int(cs), 63));
                const float e_cs = __builtin_amdgcn_exp2f(cs * 1.4426950408889634f), e_csm = __builtin_amdgcn_exp2f((cs - lw[j]) * 1.4426950408889634f);
                const float e_neg = __builtin_amdgcn_rcpf(e_cs), e_end = __builtin_amdgcn_exp2f((ce - cs) * 1.4426950408889634f);
                const float kn = kk[j] * inv, bb = kn * al[j];
                at[j] = -kn * e_csm; rt[j] = r[j] * e_cs; bt[j] = bb * e_neg; kt[j] = kf[j] * e_neg; bh[j] = bb * e_end; kh[j] = kf[j] * e_end; ge[j] = e_cs; vb[j] = bon * v[j];
            }
            const int ro = swz(lane, 16 * w);
            *(LAS v4u*)(RSL(0) + ro) = pk8(at); *(LAS v4u*)(RSL(1) + ro) = pk8(rt); *(LAS v4u*)(RSL(2) + ro) = pk8(bt); *(LAS v4u*)(RSL(3) + ro) = pk8(kt);
            *(LAS v4u*)(RSL(4) + ro) = pk8(bh); *(LAS v4u*)(RSL(5) + ro) = pk8(kh); *(LAS v4u*)(RSL(6) + ro) = pk8(v);
            if (lane == 63) { *(f32x4*)(X.GE + (size_t)job * 64 + 8 * w) = (f32x4){ge[0], ge[1], ge[2], ge[3]}; *(f32x4*)(X.GE + (size_t)job * 64 + 8 * w + 4) = (f32x4){ge[4], ge[5], ge[6], ge[7]}; }
            *(LAS v4u*)(RSL(18) + ro) = pk8(vb);
        }
        LBAR();
        {
            { bf16* vbp = (job < 2048) ? (X.VB0 + jo) : (X.VB1 + (jo - (size_t)2048 * 4096)); *(v4u*)(vbp + tid * 8) = *(const LAS v4u*)(RSL(18) + swz(ltok, 16 * ldg)); }
            const f32x4 z4 = (f32x4){0.f, 0.f, 0.f, 0.f};
            const Fr2 aA = ldf(RSL(0), fm), aR = ldf(RSL(1), fm); Fr2 bB[2], bK[2];
#pragma unroll
            for (int t = 0; t < 2; ++t) { bB[t] = ldf(RSL(2), fn[t]); bK[t] = ldf(RSL(3), fn[t]); }
            f32x4 nab[2], nabT[2], nak[2], mrb[2], mrk[2];
#pragma unroll
            for (int t = 0; t < 2; ++t) { nab[t] = mm<true>(aA, bB[t], z4); nabT[t] = mm<false>(aA, bB[t], z4); nak[t] = mm<true>(aA, bK[t], z4); mrb[t] = mm<true>(aR, bB[t], z4); mrk[t] = mm<true>(aR, bK[t], z4); }
#pragma unroll
            for (int t = 0; t < 2; ++t) { const int n0 = n0a + 16 * t; f32x4 x1;
#pragma unroll
                for (int x = 0; x < 4; ++x) { const int i = m0 + fr, j = n0 + 4 * fq + x;
                    if (j >= i) { nab[t][x] = 0.f; nak[t][x] = 0.f; } if (j > i) { mrb[t][x] = 0.f; mrk[t][x] = 0.f; }
                    x1[x] = nab[t][x] + ((i == j) ? 1.0f : 0.f);
                    const int it = m0 + 4 * fq + x, jt = n0 + fr; if (jt >= it) nabT[t][x] = 0.f; }
                st4(RSL(10), orm[t], x1); st4(RSL(12), orm[t], nab[t]); st4(RSL(14), otr[t], nabT[t]);
                st4(RSL(7), orm[t], nak[t]); st4(RSL(8), orm[t], mrb[t]); st4(RSL(9), orm[t], mrk[t]); }
        }
        LBAR();
        {
            const f32x4 z4 = (f32x4){0.f, 0.f, 0.f, 0.f};
            const Fr2 aP = ldf(RSL(12), fm), aN = ldf(RSL(7), fm); Fr2 bT[2], bV[2];
#pragma unroll
            for (int t = 0; t < 2; ++t) { bT[t] = ldf(RSL(14), fn[t]); bV[t] = ldt(RSL(6), tb0[t], tb1[t]); }
            f32x4 q0[2], q1[2], q2[2];
#pragma unroll
            for (int t = 0; t < 2; ++t) { q0[t] = mm<true>(aP, bT[t], z4); q1[t] = mm<false>(aP, bT[t], z4); q2[t] = mm<false>(aN, bV[t], z4); }
#pragma unroll
            for (int t = 0; t < 2; ++t) { st4(RSL(13), orm[t], q0[t]); st4(RSL(15), otr[t], q1[t]); st4(RSL(2), otr[t], q2[t]); }
        }
        LBAR();
#pragma unroll
        for (int kd = 0; kd < 5; ++kd) {
            const int xi = (kd & 1) ? 11 : 10, xo = (kd & 1) ? 10 : 11, pi = (kd & 1) ? 12 : 13, po = (kd & 1) ? 13 : 12, ti = (kd & 1) ? 14 : 15, to = (kd & 1) ? 15 : 14;
            const f32x4 z4 = (f32x4){0.f, 0.f, 0.f, 0.f};
            const Fr2 aX = ldf(RSL(xi), fm), aP = ldf(RSL(pi), fm); Fr2 bT[2]; f32x4 cx[2];
#pragma unroll
            for (int t = 0; t < 2; ++t) { bT[t] = ldf(RSL(ti), fn[t]); cx[t] = ld4(RSL(xi), orm[t]); }
            f32x4 q0[2], q1[2], q2[2];
#pragma unroll
            for (int t = 0; t < 2; ++t) { q0[t] = mm<true>(aX, bT[t], cx[t]); if (kd < 4) { q1[t] = mm<true>(aP, bT[t], z4); q2[t] = mm<false>(aP, bT[t], z4); } }
#pragma unroll
            for (int t = 0; t < 2; ++t) { st4(RSL(xo), orm[t], q0[t]); if (kd < 4) { st4(RSL(po), orm[t], q1[t]); st4(RSL(to), otr[t], q2[t]); } }
            LBAR();
        }
        {
            const f32x4 z4 = (f32x4){0.f, 0.f, 0.f, 0.f};
            const Fr2 aT = ldf(RSL(11), fm); Fr2 bA[2], bZ[2];
#pragma unroll
            for (int t = 0; t < 2; ++t) { bA[t] = ldt(RSL(0), tb0[t], tb1[t]); bZ[t] = ldf(RSL(2), fn[t]); }
            f32x4 q0[2], q1[2];
#pragma unroll
            for (int t = 0; t < 2; ++t) { q0[t] = mm<false>(aT, bA[t], z4); q1[t] = mm<false>(aT, bZ[t], z4); }
#pragma unroll
            for (int t = 0; t < 2; ++t) { st4(RSL(3), otr[t], q0[t]); st4(RSL(7), otr[t], q1[t]); }
        }
        LBAR();
        {
            const f32x4 z4 = (f32x4){0.f, 0.f, 0.f, 0.f};
            f32x4 p1[2], y0[2], gt[2], hh[2];
            {   const Fr2 aMb = ldf(RSL(8), fm), aMk = ldf(RSL(9), fm); Fr2 bW[2], bU[2], bV[2]; f32x4 cR[2];
#pragma unroll
                for (int t = 0; t < 2; ++t) { bW[t] = ldf(RSL(3), fn[t]); bU[t] = ldf(RSL(7), fn[t]); bV[t] = ldt(RSL(6), tb0[t], tb1[t]); cR[t] = ld4(RSL(1), orm[t]); }
#pragma unroll
                for (int t = 0; t < 2; ++t) { p1[t] = mm<true>(aMb, bW[t], cR[t]); y0[t] = mm<true>(aMk, bV[t], mm<true>(aMb, bU[t], z4)); } }
            {   const Fr2 aW = ldf(RSL(3), fm), aU = ldf(RSL(7), fm), aV = ldt(RSL(6), ta0, ta1); Fr2 bBh[2], bKh[2];
#pragma unroll
                for (int t = 0; t < 2; ++t) { bBh[t] = ldt(RSL(4), tb0[t], tb1[t]); bKh[t] = ldt(RSL(5), tb0[t], tb1[t]); }
#pragma unroll
                for (int t = 0; t < 2; ++t) { gt[t] = mm<false>(aW, bBh[t], z4); hh[t] = mm<true>(aV, bKh[t], mm<true>(aU, bBh[t], z4)); } }
#pragma unroll
            for (int t = 0; t < 2; ++t) {
                s_p1[t].x = pkbf(p1[t][0], p1[t][1]); s_p1[t].y = pkbf(p1[t][2], p1[t][3]); s_gt[t].x = pkbf(gt[t][0], gt[t][1]); s_gt[t].y = pkbf(gt[t][2], gt[t][3]);
                s_y0[t].x = pkbf(y0[t][0], y0[t][1]); s_y0[t].y = pkbf(y0[t][2], y0[t][3]); s_hh[t].x = pkbf(hh[t][0], hh[t][1]); s_hh[t].y = pkbf(hh[t][2], hh[t][3]); }
            s_jo = jo; s_have = true;
        }
    }
    if (s_have) P6A_STORE();
#undef P6A_LOAD
#undef P6A_STORE
    LBAR();
}
__device__ __forceinline__ void p6b_rwkv_seq(Frame& F, const RwArgs& A, const RwX& X, int nwg) {
    using namespace rwk;
    LAS unsigned char* lds = F.lds + RING_OFF;
    constexpr int YLD = 68;
    LAS float* Yf0 = (LAS float*)RSL(6);
    const int tid = F.tid, tok = tid >> 3, dg = tid & 7, lane = F.lane, fr = lane & 15, fq = lane >> 4;
    const int w = F.wave, m0 = 16 * (w >> 1), n0a = 32 * (w & 1);
    const int fm = swz(m0 + fr, fq * 16);
    int fn[2], orm[2], otr[2];
#pragma unroll
    for (int t = 0; t < 2; ++t) { const int n0 = n0a + 16 * t; fn[t] = swz(n0 + fr, fq * 16); orm[t] = swz(m0 + fr, 2 * (n0 + 4 * fq)); otr[t] = swz(n0 + fr, 2 * (m0 + 4 * fq)); }
    for (int unit = blockIdx.x; unit < BATCH * NH; unit += nwg) {
        const int b = unit >> 3, h = unit & 7; const int cb = 64 * h + 8 * dg;
        f32x4 sacc[2]; sacc[0] = (f32x4){0.f, 0.f, 0.f, 0.f}; sacc[1] = sacc[0];
        for (int u = tid; u < SLOT / 4; u += NWAVES * 64) ((LAS unsigned*)RSL(4))[u] = 0u;
        float lnw[8], lnb[8]; ld8f(A.ln_w + cb, lnw); ld8f(A.ln_b + cb, lnb);
        struct Nx { v4u vb, g; u32x2g p1[2], gt[2], y0[2], h[2]; f32x4 ge[2]; };
        Nx nA, nB;
#define P6B_LOAD(cc, N) do { const int job_ = unit * 32 + (cc); const size_t jo_ = (size_t)job_ * 4096; const size_t grow_ = (size_t)b * SEQ + (cc) * 64 + tok; \
            _Pragma("unroll") for (int t = 0; t < 2; ++t) { N.y0[t] = *(const u32x2g*)(X.Y0 + jo_ + ((w * 2 + t) * 64 + lane) * 4); N.h[t] = *(const u32x2g*)(X.H + jo_ + ((w * 2 + t) * 64 + lane) * 4); \
                N.p1[t] = *(const u32x2g*)(X.P1 + jo_ + ((w * 2 + t) * 64 + lane) * 4); N.gt[t] = *(const u32x2g*)(X.GT + jo_ + ((w * 2 + t) * 64 + lane) * 4); \
                N.ge[t] = *(const f32x4*)(X.GE + (size_t)job_ * 64 + n0a + 16 * t + 4 * fq); } \
            const bf16* vbp_ = (job_ < 2048) ? (X.VB0 + jo_) : (X.VB1 + (jo_ - (size_t)2048 * 4096)); \
            N.vb = *(const v4u*)(vbp_ + tok * 64 + 8 * dg); N.g = *(const v4u*)(X.G + jo_ + tok * 64 + 8 * dg); } while (0)
#define P6B_OUT(par, vbw_, gw_, grow_) do { float y[8]; ld8l(Yf0 + (par) * (64 * YLD) + tok * YLD + 8 * dg, y); \
            const float g[8] = {bflo(gw_.x), bfhi(gw_.x), bflo(gw_.y), bfhi(gw_.y), bflo(gw_.z), bfhi(gw_.z), bflo(gw_.w), bfhi(gw_.w)}; \
            const float vb[8] = {bflo(vbw_.x), bfhi(vbw_.x), bflo(vbw_.y), bfhi(vbw_.y), bflo(vbw_.z), bfhi(vbw_.z), bflo(vbw_.w), bfhi(vbw_.w)}; \
            float s_ = 0.f; _Pragma("unroll") for (int j = 0; j < 8; ++j) s_ += y[j]; \
            const float mean = sum8(s_) * (1.0f / 64.0f); float q_ = 0.f; \
            _Pragma("unroll") for (int j = 0; j < 8; ++j) { y[j] -= mean; q_ += y[j] * y[j]; } \
            const float rstd = __builtin_amdgcn_rsqf(sum8(q_) * (1.0f / 64.0f) + LNX_EPS); float ov[8]; \
            _Pragma("unroll") for (int j = 0; j < 8; ++j) ov[j] = (y[j] * rstd * lnw[j] + lnb[j] + vb[j]) * g[j]; \
            v4u wv_; wv_.x = pkbf(ov[0], ov[1]); wv_.y = pkbf(ov[2], ov[3]); wv_.z = pkbf(ov[4], ov[5]); wv_.w = pkbf(ov[6], ov[7]); \
            *(GAS v4u*)(A.QO + (grow_) * D + 512 + cb) = wv_; } while (0)
        v4u p_vb = (v4u){0u, 0u, 0u, 0u}, p_g = p_vb; size_t p_row = 0;
#define P6B_STEP(c, N) do { const int par = (c) & 1, scur = 4 + par, snxt = 5 - par; const size_t grow = (size_t)b * SEQ + (c) * 64 + tok; \
            _Pragma("unroll") for (int t = 0; t < 2; ++t) { *(LAS u32x2g*)(RSL(par) + orm[t]) = N.p1[t]; *(LAS u32x2g*)(RSL(2 + par) + otr[t]) = N.gt[t]; } \
            f32x4 yacc[2], hcur[2], gecur[2]; \
            _Pragma("unroll") for (int t = 0; t < 2; ++t) { yacc[t] = (f32x4){bflo(N.y0[t].x), bfhi(N.y0[t].x), bflo(N.y0[t].y), bfhi(N.y0[t].y)}; hcur[t] = (f32x4){bflo(N.h[t].x), bfhi(N.h[t].x), bflo(N.h[t].y), bfhi(N.h[t].y)}; gecur[t] = N.ge[t]; } \
            const v4u vbw = N.vb, gw = N.g; \
            if ((c) + 2 < SEQ / 64) P6B_LOAD((c) + 2, N); \
            LBAR(); \
            {   const Fr2 aP1 = ldf(RSL(par), fm), aS = ldf(RSL(scur), fm); Fr2 bS[2], bG[2]; \
                _Pragma("unroll") for (int t = 0; t < 2; ++t) { bS[t] = ldf(RSL(scur), fn[t]); bG[t] = ldf(RSL(2 + par), fn[t]); } \
                _Pragma("unroll") for (int t = 0; t < 2; ++t) { yacc[t] = mm<true>(aP1, bS[t], yacc[t]); sacc[t] = mm<true>(aS, bG[t], sacc[t] * gecur[t] + hcur[t]); } \
                _Pragma("unroll") for (int t = 0; t < 2; ++t) { const int n0 = n0a + 16 * t; *(LAS f32x4*)(Yf0 + par * (64 * YLD) + (m0 + fr) * YLD + n0 + 4 * fq) = yacc[t]; st4(RSL(snxt), orm[t], sacc[t]); } } \
            if ((c) > 0) P6B_OUT(par ^ 1, p_vb, p_g, p_row);                    \
            p_vb = vbw; p_g = gw; p_row = grow; } while (0)
        P6B_LOAD(0, nA); P6B_LOAD(1, nB);
        for (int c = 0; c < SEQ / 64; c += 2) {
            P6B_STEP(c, nA);
            P6B_STEP(c + 1, nB);
        }
#undef P6B_STEP
        LBAR();
        P6B_OUT(1, p_vb, p_g, p_row);
#undef P6B_LOAD
#undef P6B_OUT
        LBAR();
    }
}

namespace sba {
using bf16x8 = __attribute__((ext_vector_type(8))) short;
using s16x4 = __attribute__((ext_vector_type(4))) short;
using f32x16 = __attribute__((ext_vector_type(16))) float;
using u32x4 = __attribute__((ext_vector_type(4))) unsigned;
constexpr int QB = 256, KVBLK = 64;
constexpr int LDS_K = 0, LDS_V = 16384, LDS_ST = 32768, ST_LD = 68, LDS_FLAG = LDS_ST + 8 * 32 * ST_LD * 4, LDS_BYTES_ATT = LDS_FLAG + 64;
constexpr float R_DEAD = -160.0f;
#define SBAR() __builtin_amdgcn_sched_barrier(0)
typedef float f32x2_t __attribute__((ext_vector_type(2))); typedef __bf16 bf16x2_t __attribute__((ext_vector_type(2)));
__device__ __forceinline__ unsigned cvtpk_s(float lo, float hi) { f32x2_t v = {lo, hi}; bf16x2_t b = __builtin_convertvector(v, bf16x2_t); return __builtin_bit_cast(unsigned, b); }
__device__ __forceinline__ void qkt(f32x16& p0, f32x16& p1, const char* Kslot, const bf16x8* qr, int r32, int hi) {
    const char* kb = Kslot + hi * 1024 + r32 * 16;
    const f32x16 z = f32x16{};
#pragma unroll
    for (int d0 = 0; d0 < 4; ++d0) {
        const bf16x8 b0 = *reinterpret_cast<const bf16x8*>(kb + d0 * 2048);
        const bf16x8 b1 = *reinterpret_cast<const bf16x8*>(kb + d0 * 2048 + 512);
        if (d0 == 0) { p0 = __builtin_amdgcn_mfma_f32_32x32x16_bf16(b0, qr[0], z, 0, 0, 0); p1 = __builtin_amdgcn_mfma_f32_32x32x16_bf16(b1, qr[0], z, 0, 0, 0); }
        else { p0 = __builtin_amdgcn_mfma_f32_32x32x16_bf16(b0, qr[d0], p0, 0, 0, 0); p1 = __builtin_amdgcn_mfma_f32_32x32x16_bf16(b1, qr[d0], p1, 0, 0, 0); }
    }
}
__device__ __forceinline__ void pv(f32x16* o, int vb, bf16x8 pa0, bf16x8 pa1, bf16x8 pa2, bf16x8 pa3) {
#pragma unroll
    for (int d0 = 0; d0 < 2; ++d0) { s16x4 lo[4], hi[4];
#pragma unroll
        for (int ks = 0; ks < 4; ++ks) {
            asm volatile("ds_read_b64_tr_b16 %0,%1 offset:%c2" : "=&v"(lo[ks]) : "v"(vb), "i"(d0 * 4096 + ks * 1024) : "memory");
            asm volatile("ds_read_b64_tr_b16 %0,%1 offset:%c2" : "=&v"(hi[ks]) : "v"(vb), "i"(d0 * 4096 + ks * 1024 + 512) : "memory"); }
        asm volatile("s_waitcnt lgkmcnt(0)" ::: "memory"); SBAR();
#define PK(k) (bf16x8){lo[k][0], lo[k][1], lo[k][2], lo[k][3], hi[k][0], hi[k][1], hi[k][2], hi[k][3]}
        o[d0] = __builtin_amdgcn_mfma_f32_32x32x16_bf16(pa0, PK(0), o[d0], 0, 0, 0);
        o[d0] = __builtin_amdgcn_mfma_f32_32x32x16_bf16(pa1, PK(1), o[d0], 0, 0, 0);
        o[d0] = __builtin_amdgcn_mfma_f32_32x32x16_bf16(pa2, PK(2), o[d0], 0, 0, 0);
        o[d0] = __builtin_amdgcn_mfma_f32_32x32x16_bf16(pa3, PK(3), o[d0], 0, 0, 0);
#undef PK
    }
}
__device__ __forceinline__ float swap_sum(float x, float& other_if_lo, int hi) {
    auto rr = __builtin_amdgcn_permlane32_swap(__float_as_uint(x), __float_as_uint(x), false, false);
    const float a = __uint_as_float(rr[0]), b = __uint_as_float(rr[1]);
    other_if_lo = hi ? 0.f : b;
    return a + b;
}
__device__ __forceinline__ float swap_prod(float x, float& other_if_lo, int hi) {
    auto rr = __builtin_amdgcn_permlane32_swap(__float_as_uint(x), __float_as_uint(x), false, false);
    const float a = __uint_as_float(rr[0]), b = __uint_as_float(rr[1]);
    other_if_lo = hi ? 1.0f : b;
    return a * b;
}
__device__ __forceinline__ void attn_wave_unit(int b, int h, int qblk, bf16* QO, const bf16* __restrict__ KB, const bf16* __restrict__ VB, const float* gout, char* wsm  ) {
    const int lane = threadIdx.x & 63, r32 = lane & 31, hi = lane >> 5;
    const long rowbase = (long)b * SEQ; const int q0 = qblk * 32;
    bf16* Qw = QO + (rowbase + q0) * D + h * HD;
    const bf16* Kh = KB + rowbase * SBW + h * HD; const bf16* Vh = VB + rowbase * SBW + h * HD;
    const unsigned lds0 = (unsigned)(uintptr_t)wsm;
    const int jtop = (q0 + 30) >> 6;
    const bf16* vsrc = Vh + (long)(lane >> 3) * SBW + (lane & 7) * 8;
    const int vdst0 = ((lane & 7) >> 2) * 4096 + ((lane >> 3) & 15) * 64 + (lane & 3) * 16;
    const int vb0 = (int)lds0 + ((lane >> 4) & 1) * 32 + (lane & 3) * 8 + (4 * hi + ((lane & 15) >> 2)) * 64;
    const bf16* ksrc = Kh + (long)r32 * SBW + hi * 8;
    bf16x8 qr[4];
#pragma unroll
    for (int d0 = 0; d0 < 4; ++d0) qr[d0] = *reinterpret_cast<const bf16x8*>(&Qw[(long)r32 * D + d0 * 16 + hi * 8]);
    bf16x8 kf[8]; u32x4 vr[8];
#define SBA_LOAD(t) do { const bf16* kp_ = ksrc + (long)(t) * KVBLK * SBW; const bf16* vp_ = vsrc + (long)(t) * KVBLK * SBW; \
        _Pragma("unroll") for (int d0 = 0; d0 < 4; ++d0) { kf[2 * d0] = *reinterpret_cast<const bf16x8*>(kp_ + d0 * 16); kf[2 * d0 + 1] = *reinterpret_cast<const bf16x8*>(kp_ + 32 * SBW + d0 * 16); } \
        _Pragma("unroll") for (int i = 0; i < 8; ++i) vr[i] = *(const u32x4*)(vp_ + (long)(8 * i) * SBW); } while (0)
    SBA_LOAD(jtop);
    float R = 0.f; f32x16 o[2]; o[0] = f32x16{}; o[1] = f32x16{};
    const int qrow = q0 + r32;
    for (int jt = jtop; jt >= 0; --jt) {
        const int cur = (jtop - jt) & 1;
#pragma unroll
        for (int i = 0; i < 8; ++i) *(u32x4*)(wsm + cur * 8192 + vdst0 + (i >> 1) * 1024 + (i & 1) * 512) = vr[i];
        f32x16 p0, p1;
        {   const f32x16 z = f32x16{};
            p0 = __builtin_amdgcn_mfma_f32_32x32x16_bf16(kf[0], qr[0], z, 0, 0, 0); p1 = __builtin_amdgcn_mfma_f32_32x32x16_bf16(kf[1], qr[0], z, 0, 0, 0);
#pragma unroll
            for (int d0 = 1; d0 < 4; ++d0) { p0 = __builtin_amdgcn_mfma_f32_32x32x16_bf16(kf[2 * d0], qr[d0], p0, 0, 0, 0); p1 = __builtin_amdgcn_mfma_f32_32x32x16_bf16(kf[2 * d0 + 1], qr[d0], p1, 0, 0, 0); } }
        if (jt > 0) SBA_LOAD(jt - 1);
        const int kb = 64 * jt + 4 * hi; const bool diag = (jt == jtop);
#pragma unroll
        for (int r = 0; r < 16; ++r) {
            { float rr = __builtin_amdgcn_rcpf(1.0f + __builtin_amdgcn_exp2f(p0[r]));
              if (diag) { const int key = kb + (r & 3) + 8 * (r >> 2); if (key >= qrow) rr = 1.0f; }
              p0[r] = rr; }
            { float rr = __builtin_amdgcn_rcpf(1.0f + __builtin_amdgcn_exp2f(p1[r]));
              if (diag) { const int key = kb + 32 + (r & 3) + 8 * (r >> 2); if (key >= qrow) rr = 1.0f; }
              p1[r] = rr; }
        }
        float c0[4], c1[4], x0[4], x1[4];
#pragma unroll
        for (int g = 0; g < 4; ++g) {
            const float s0 = (p0[4 * g] * p0[4 * g + 1]) * (p0[4 * g + 2] * p0[4 * g + 3]);
            const float s1 = (p1[4 * g] * p1[4 * g + 1]) * (p1[4 * g + 2] * p1[4 * g + 3]);
            c0[g] = swap_prod(s0, x0[g], hi); c1[g] = swap_prod(s1, x1[g], hi);
        }
        const float Cr = __builtin_amdgcn_exp2f(R);
        float suf0[4], suf1[4];
        suf1[3] = Cr; suf1[2] = suf1[3] * c1[3]; suf1[1] = suf1[2] * c1[2]; suf1[0] = suf1[1] * c1[1];
        suf0[3] = suf1[0] * c1[0]; suf0[2] = suf0[3] * c0[3]; suf0[1] = suf0[2] * c0[2]; suf0[0] = suf0[1] * c0[1];
        R += __builtin_amdgcn_logf(((c0[0] * c0[1]) * (c0[2] * c0[3])) * ((c1[0] * c1[1]) * (c1[2] * c1[3])));
#pragma unroll
        for (int g = 0; g < 4; ++g) {
            { const float e3 = suf0[g] * x0[g], e2 = e3 * p0[4 * g + 3], e1 = e2 * p0[4 * g + 2], e0 = e1 * p0[4 * g + 1];
              p0[4 * g + 3] = (1.0f - p0[4 * g + 3]) * e3; p0[4 * g + 2] = (1.0f - p0[4 * g + 2]) * e2; p0[4 * g + 1] = (1.0f - p0[4 * g + 1]) * e1; p0[4 * g] = (1.0f - p0[4 * g]) * e0; }
            { const float e3 = suf1[g] * x1[g], e2 = e3 * p1[4 * g + 3], e1 = e2 * p1[4 * g + 2], e0 = e1 * p1[4 * g + 1];
              p1[4 * g + 3] = (1.0f - p1[4 * g + 3]) * e3; p1[4 * g + 2] = (1.0f - p1[4 * g + 2]) * e2; p1[4 * g + 1] = (1.0f - p1[4 * g + 1]) * e1; p1[4 * g] = (1.0f - p1[4 * g]) * e0; }
        }
#define PKW(P, B) cvtpk_s(P[B], P[B + 1])
        const u32x4 pw0 = (u32x4){PKW(p0, 0), PKW(p0, 2), PKW(p0, 4), PKW(p0, 6)}, pw1 = (u32x4){PKW(p0, 8), PKW(p0, 10), PKW(p0, 12), PKW(p0, 14)};
        const u32x4 pw2 = (u32x4){PKW(p1, 0), PKW(p1, 2), PKW(p1, 4), PKW(p1, 6)}, pw3 = (u32x4){PKW(p1, 8), PKW(p1, 10), PKW(p1, 12), PKW(p1, 14)};
#undef PKW
        SBAR();
        asm volatile("s_waitcnt lgkmcnt(0)" ::: "memory");
        pv(o, vb0 + cur * 8192, __builtin_bit_cast(bf16x8, pw0), __builtin_bit_cast(bf16x8, pw1), __builtin_bit_cast(bf16x8, pw2), __builtin_bit_cast(bf16x8, pw3));
        if (__all(R < R_DEAD)) break;
    }
#undef SBA_LOAD
    {
        float* stg = (float*)wsm;
        asm volatile("s_waitcnt lgkmcnt(0)" ::: "memory");
#pragma unroll
        for (int r = 0; r < 16; ++r) { const int orow = (r & 3) + 8 * (r >> 2) + 4 * hi;
#pragma unroll
            for (int d0 = 0; d0 < 2; ++d0) stg[orow * ST_LD + d0 * 32 + r32] = o[d0][r]; }
        asm volatile("s_waitcnt lgkmcnt(0)" ::: "memory");
        const int ch = lane & 7;
        const f32x4 ga = *(const f32x4*)(gout + h * HD + ch * 8), gb = *(const f32x4*)(gout + h * HD + ch * 8 + 4);
#pragma unroll
        for (int i = 0; i < 4; ++i) { const int row = i * 8 + (lane >> 3);
            const f32x4 a = *(const f32x4*)(stg + row * ST_LD + ch * 8), c = *(const f32x4*)(stg + row * ST_LD + ch * 8 + 4);
            float ss = (a.x * a.x + a.y * a.y) + (a.z * a.z + a.w * a.w) + (c.x * c.x + c.y * c.y) + (c.z * c.z + c.w * c.w);
            ss = sum8(ss);
            const float hs = __builtin_amdgcn_rsqf(ss * (1.0f / 64.0f) + 1e-6f);
            u32x4 w; w.x = cvtpk_s(a.x * hs * ga.x, a.y * hs * ga.y); w.y = cvtpk_s(a.z * hs * ga.z, a.w * hs * ga.w);
            w.z = cvtpk_s(c.x * hs * gb.x, c.y * hs * gb.y); w.w = cvtpk_s(c.z * hs * gb.z, c.w * hs * gb.w);
            *(u32x4*)(Qw + (long)row * D + ch * 8) = w; }
        asm volatile("s_waitcnt lgkmcnt(0)" ::: "memory");
    }
}
#undef SBAR
__device__ __forceinline__ void attn_phase(Frame& F, bf16* QO, const bf16* KB, const bf16* VB, const float* gout, unsigned* queue, int first_ticket, int ticket_base) {
    char* wsm = (char*)F.lds + RING_OFF + F.wave * 16384;
    const int nunits = BATCH * NH * (SEQ / 32);
    int pend = -1; int tfirst = first_ticket;
    for (;;) {
        int uu;
        if (pend >= 0) { uu = pend; pend = -1; }
        else { unsigned t;
               if (tfirst >= 0) { t = (unsigned)tfirst; tfirst = -1; }
               else { t = 0u; if (F.lane == 0) t = __hip_atomic_fetch_add(queue, 1u, __ATOMIC_RELAXED, __HIP_MEMORY_SCOPE_AGENT); t = (unsigned)__builtin_amdgcn_readfirstlane((int)t) + (unsigned)ticket_base; }
               if (2u * t >= (unsigned)nunits) break; uu = (int)(2u * t); pend = uu + 1; }
        attn_wave_unit(uu >> 9, (uu >> 6) & 7, uu & 63, QO, KB, VB, gout, wsm);
    }
    __syncthreads();
}
}

struct Args { const float* in[26]; float* out; unsigned char* ws; int ph_lo, ph_hi, li, pad; };
__global__ void __launch_bounds__(NWAVES * 64, 2) skel_fwd(Args args) {
    extern __shared__ __attribute__((aligned(16))) unsigned char lds[];
    Frame F;
    F.lds = (LAS unsigned char*)lds;
    F.MISC = (volatile LAS unsigned*)(F.lds + MISC_OFF);
    F.tid = threadIdx.x; F.lane = F.tid & 63; F.wave = __builtin_amdgcn_readfirstlane(F.tid >> 6);
    F.G = gridDim.x; { const int bx = blockIdx.x; F.vcu = (F.G % 8 == 0) ? (bx % 8) * (F.G / 8) + bx / 8 : bx; }
    unsigned char* ws = args.ws;
    F.ctl = (gu32*)(ws + WS_CTL);
    const float* x = args.in[0];
    bf16* W1U = (bf16*)(ws + WS_W1U); bf16* W1D = (bf16*)(ws + WS_W1D); bf16* W2U = (bf16*)(ws + WS_W2U); bf16* W2D = (bf16*)(ws + WS_W2D);
    bf16* WIN = (bf16*)(ws + WS_WIN); bf16* WOUT = (bf16*)(ws + WS_WOUT); bf16* WLORA = (bf16*)(ws + WS_WLORA);
    bf16* XB = (bf16*)(ws + WS_XB); bf16* ACT = (bf16*)(ws + WS_ACT); bf16* QO = (bf16*)(ws + WS_QO); bf16* KB = (bf16*)(ws + WS_KB); bf16* VB = (bf16*)(ws + WS_VB);
    bf16* RW = (bf16*)(ws + WS_RW); bf16* ALORA = (bf16*)(ws + WS_ALORA); float* LW = (float*)(ws + WS_LW); bf16* AB = (bf16*)(ws + WS_AB); bf16* GB = (bf16*)(ws + WS_GB);
    float* SSQ = (float*)(ws + WS_SSQ); float* out = args.out;
    for (int u = F.tid; u < (LDS_BYTES - LDSCTL_OFF) / 4; u += NWAVES * 64) ((LAS unsigned*)(F.lds + LDSCTL_OFF))[u] = 0u;
    __syncthreads();
    XcdBarrier bar; bar.bar = (unsigned*)(F.ctl + CW_BAR); bar.x = 0; bar.st = nullptr;
    if (N_LAUNCHES != PER_PHASE) bar = xcd_barrier_post((unsigned*)(F.ctl + CW_BAR), F.MISC + 8);
#define GRID_BAR(seam) do { if (N_LAUNCHES == PER_PHASE) { if (F.tid == 0) __hip_atomic_store(F.ctl + CW_TMO, 0xBADBA0u | (unsigned)(seam), RLX_AGENT); } else { xcd_barrier(bar); } } while (0)
    const int lo = args.ph_lo, hi = args.ph_hi;
#define IN(k) (lo <= (k) && (k) < hi)
#define BOTH(k) (IN(k) && IN((k) + 1))
    if (IN(0)) {
        p0_prologue(F, x, args.in[1], args.in[2], args.in[3], args.in[4], args.in[5], args.in[6], args.in[12], args.in[14], args.in[15], args.in[21], args.in[22], args.in[23], args.in[24], args.in[25],
                    W1U, W1D, W2U, W2D, WIN, WOUT, WLORA, XB, SSQ); if (BOTH(0)) GRID_BAR(0);
    }
    if (IN(1)) {
        pg8::Gemm g{XB, W1U, M, 2 * FF, D}; pg8::StaticOrder S; S.init(M, 2 * FF, F.G, (int)blockIdx.x);
        pg8::EpiSwiGLU E{ACT, FF, SSQ};
        pg8::gemm_phase<pg8::EpiSwiGLU, pg8::StaticOrder, true, true>(F.lds + RING_OFF, g, S, E);
        if (BOTH(1)) GRID_BAR(1);
    }
    if (IN(2)) {
        pg8::Gemm g{ACT, W1D, M, D, FF}; pg8::StaticOrder S; S.init(M, D, F.G, (int)blockIdx.x);
        pg8::EpiResid E{x, nullptr, nullptr, nullptr, XB, (unsigned char*)out, SSQ, 0.5f, 1};
        pg8::gemm_phase<pg8::EpiResid, pg8::StaticOrder, true, true>(F.lds + RING_OFF, g, S, E);
        if (BOTH(2)) GRID_BAR(2);
    }
    if (IN(3)) {
        pg8::Gemm g{XB, WIN, M, PW, D}; pg8::StaticOrder S; S.init(M, PW, F.G, (int)blockIdx.x);
        pg8::EpiWin E{QO, KB, VB, RW, SSQ, args.in[7], args.in[8], 0.125f * 1.4426950408889634f};
        pg8::gemm_phase<pg8::EpiWin, pg8::StaticOrder, true, true>(F.lds + RING_OFF, g, S, E);
        if (F.G >= 256) {
            const int nlo = (M / 256) * (PW / 256) - 6 * F.G;
            if ((int)blockIdx.x >= nlo) { __syncthreads();
                p0_items(F, x, args.in[1], args.in[2], args.in[3], args.in[4], args.in[5], args.in[6], args.in[12], args.in[14], args.in[15], args.in[21], args.in[22], args.in[23], args.in[24], args.in[25],
                         W1U, W1D, W2U, W2D, WIN, WOUT, WLORA, XB, SSQ, 1, ((int)blockIdx.x - nlo) * NWAVES + F.wave, (F.G - nlo) * NWAVES); }
        }
        if (BOTH(3)) GRID_BAR(3);
    }
    if (IN(6)) {
        RwArgs A{RW, WLORA, WLORA + 512 * 64, WLORA + 2 * 512 * 64, args.in[11], args.in[13], QO, args.in[10], args.in[16], args.in[17], args.in[18], args.in[19], args.in[20]};
        bf16* ob = (bf16*)out;
        RwX X{ob + (size_t)32 * 1024 * 1024, ob + (size_t)48 * 1024 * 1024, (bf16*)LW, (bf16*)LW + (size_t)16 * 1024 * 1024, AB, AB + (size_t)8 * 1024 * 1024, SSQ, GB};
        p6a_rwkv_local(F, A, X);
        GRID_BAR(16);
        const int nseq = (F.G >= 2 * BATCH * NH) ? BATCH * NH : F.G;
        if ((int)blockIdx.x < nseq) { p6b_rwkv_seq(F, A, X, nseq); __syncthreads(); }
        const int nfree = (F.G - nseq) * NWAVES;
        sba::attn_phase(F, QO, KB, VB, args.in[9], (unsigned*)(F.ctl + CW_QUEUE), ((int)blockIdx.x >= nseq) ? ((int)blockIdx.x - nseq) * NWAVES + F.wave : -1, nfree);
        if (BOTH(6)) GRID_BAR(6);
    }
    if (IN(8)) {
        pg8::Gemm g{QO, WOUT, M, D, D}; pg8::StaticOrder S; S.init(M, D, F.G, (int)blockIdx.x);
        pg8::EpiResid E{nullptr, XB, (const unsigned char*)out, nullptr, XB, (unsigned char*)LW, SSQ, 1.0f, 1};
        pg8::gemm_phase<pg8::EpiResid, pg8::StaticOrder, true, true>(F.lds + RING_OFF, g, S, E);
        if (BOTH(8)) GRID_BAR(8);
    }
    if (IN(9)) {
        pg8::Gemm g{XB, W2U, M, 2 * FF, D}; pg8::StaticOrder S; S.init(M, 2 * FF, F.G, (int)blockIdx.x);
        pg8::EpiSwiGLU E{ACT, FF, SSQ};
        pg8::gemm_phase<pg8::EpiSwiGLU, pg8::StaticOrder, true, true>(F.lds + RING_OFF, g, S, E);
        if (BOTH(9)) GRID_BAR(9);
    }
    if (IN(10)) {
        pg8::Gemm g{ACT, W2D, M, D, FF}; pg8::StaticOrder S; S.init(M, D, F.G, (int)blockIdx.x);
        pg8::EpiResid E{nullptr, XB, (const unsigned char*)LW, out, nullptr, nullptr, SSQ, 0.5f, 0};
        pg8::gemm_phase<pg8::EpiResid, pg8::StaticOrder, true, true>(F.lds + RING_OFF, g, S, E);
    }
#undef IN
#undef BOTH
}

extern "C" void kernel_launch(void* const* d_in, const int* in_sizes, int n_in, void* d_out, int out_size, void* d_ws, size_t ws_size, hipStream_t stream) {
    static int grid = 0;
    if (grid == 0) {
        if (n_in != 26 || in_sizes[0] != M * D || out_size != M * D || ws_size < WS_END) { fprintf(stderr, "kernel_launch: unexpected shapes: n_in %d in0 %d out %d ws %zu (need %zu)\n", n_in, n_in > 0 ? in_sizes[0] : -1, out_size, ws_size, (size_t)WS_END); grid = -1; return; }
        int dev = 0, cus = 0, per_cu = 0;
        if (hipGetDevice(&dev) != hipSuccess || hipDeviceGetAttribute(&cus, hipDeviceAttributeMultiprocessorCount, dev) != hipSuccess) { grid = -1; return; }
        if (hipFuncSetAttribute((const void*)skel_fwd, hipFuncAttributeMaxDynamicSharedMemorySize, LDS_BYTES) != hipSuccess) { fprintf(stderr, "kernel_launch: hipFuncSetAttribute failed\n"); grid = -1; return; }
        if (hipOccupancyMaxActiveBlocksPerMultiprocessor(&per_cu, (const void*)skel_fwd, NWAVES * 64, LDS_BYTES) != hipSuccess || per_cu < 1) { fprintf(stderr, "kernel_launch: occupancy query reports %d blocks per CU\n", per_cu); per_cu = 1; }
        (void)hipGetLastError();
        grid = cus;
    }
    if (grid < 0) return;
    if (hipMemsetAsync((char*)d_ws + WS_CTL, 0, CTL_ZERO_BYTES, stream) != hipSuccess) return;
    Args a{};
    for (int i = 0; i < 26; ++i) a.in[i] = (const float*)d_in[i];
    a.out = (float*)d_out; a.ws = (unsigned char*)d_ws;
    for (int li = 0; li < N_LAUNCHES; ++li) {
        a.ph_lo = (N_LAUNCHES == PER_PHASE) ? li : 0; a.ph_hi = (N_LAUNCHES == PER_PHASE) ? li + 1 : PER_PHASE; a.li = li;
        hipLaunchKernelGGL(skel_fwd, dim3(grid), dim3(NWAVES * 64), LDS_BYTES, stream, a);
    }
}
```

```cpp
#include <hip/hip_runtime.h>
#include <hip/hip_bf16.h>
#include <cstdio>
#include <cstdint>
#include <cmath>
namespace pg8 {
#define PG8_LAS __attribute__((address_space(3)))
typedef unsigned short bf16_t;
typedef short bf16x8 __attribute__((ext_vector_type(8)));
typedef float f32x4 __attribute__((ext_vector_type(4)));
typedef unsigned u32x4 __attribute__((ext_vector_type(4)));
constexpr int BM = 256, BK = 64, HALF = 128, HTB = HALF * BK * 2  , STAGE_BYTES = 8 * HTB, NXCD = 8, WGM = 4;

__host__ __device__ __forceinline__ int lds_byte(int r, int c) { const int st = (r >> 4) * 2 + (c >> 5), rr = r & 15, cc = c & 31, ob = rr * 64 + cc * 2; return st * 1024 + (ob ^ (((ob >> 9) & 1) << 5)); }
__host__ __device__ __forceinline__ void stage_rc(int b, int& R, int& C) { const int st = b / 1024, sb = b % 1024, swz = sb ^ (((sb >> 9) & 1) << 5); R = (st >> 1) * 16 + swz / 64; C = (st & 1) * 32 + (swz % 64) / 2; }
__host__ __device__ __forceinline__ int perm32(int rho) { const int n = rho >> 4, i = rho & 15; return 8 * (i >> 2) + 4 * n + (i & 3); }

struct Unit { int pm, pn; };
struct Gemm { const bf16_t* A; const bf16_t* Bt; int M, N, K; int ld; };

struct StaticOrder {
    int nM, nN, nwg, G, c;
    __host__ __device__ void init(int M, int N, int G_, int c_) { nM = M / BM; nN = N / BM; nwg = nM * nN; G = G_; c = c_; }
    __host__ __device__ bool next(int i, Unit& u) const {
        const long L = (long)i * G + c; if (L >= nwg) return false;
        int wgid = (int)L; { const int q = nwg / NXCD, r = nwg % NXCD, xcd = wgid % NXCD, off = wgid / NXCD; wgid = (xcd < r ? xcd * (q + 1) : r * (q + 1) + (xcd - r) * q) + off; }
        const int nig = WGM * nN, gid = wgid / nig, fm = gid * WGM, gsz = (nM - fm) < WGM ? (nM - fm) : WGM;
        u.pm = fm + ((wgid % nig) % gsz); u.pn = (wgid % nig) / gsz; return true;
    }
    __device__ __forceinline__ void a_ready(const Unit&) const {}
    __device__ __forceinline__ void done(const Unit&) const {}
};


__device__ __forceinline__ unsigned cvt_pk_bf16(float lo, float hi) { unsigned r; asm volatile("v_cvt_pk_bf16_f32 %0, %1, %2" : "=v"(r) : "v"(lo), "v"(hi)); return r; }
typedef unsigned u32x2 __attribute__((ext_vector_type(2)));
constexpr float RMS_EPS_F = 1e-6f;
constexpr float LOG2E_F = 1.4426950408889634f;
__device__ __forceinline__ float row_rs(const float* ssqp, int row) {
    const f32x4* p = (const f32x4*)(ssqp + (size_t)row * 16);
    const f32x4 a = p[0], b = p[1], c = p[2], d = p[3];
    const float s = ((a[0] + a[1]) + (a[2] + a[3])) + ((b[0] + b[1]) + (b[2] + b[3])) + ((c[0] + c[1]) + (c[2] + c[3])) + ((d[0] + d[1]) + (d[2] + d[3]));
    return __builtin_amdgcn_rsqf(s * (1.0f / 1024.0f) + RMS_EPS_F);
}
__device__ __forceinline__ float silu_f(float g) { return g * __builtin_amdgcn_rcpf(1.0f + __builtin_amdgcn_exp2f(-g * LOG2E_F)); }
__device__ __forceinline__ float sigmoid_f(float g) { return __builtin_amdgcn_rcpf(1.0f + __builtin_amdgcn_exp2f(-g * LOG2E_F)); }

struct EpiSwiGLU {
    static constexpr bool PERM = true, AFTER_DRAIN = false;
    bf16_t* O; int ldo; const float* ssqp;
    __device__ __forceinline__ void operator()(const f32x4 (&acc)[2][2][4][2], const Unit& u, int wr, int wc, int fr, int fq) const {
        const int row0 = u.pm * BM + wr * 64 + fr, col0 = u.pn * HALF + wc * 32 + 8 * fq;
#pragma unroll
        for (int ai = 0; ai < 2; ++ai)
#pragma unroll
            for (int m = 0; m < 4; ++m) {
                const int row = row0 + ai * HALF + m * 16; const float rs = row_rs(ssqp, row);
                const f32x4 g0 = acc[ai][0][m][0] * rs, g1 = acc[ai][0][m][1] * rs, u0 = acc[ai][1][m][0] * rs, u1 = acc[ai][1][m][1] * rs;
                u32x4 w;
                w.x = cvt_pk_bf16(silu_f(g0[0]) * u0[0], silu_f(g0[1]) * u0[1]); w.y = cvt_pk_bf16(silu_f(g0[2]) * u0[2], silu_f(g0[3]) * u0[3]);
                w.z = cvt_pk_bf16(silu_f(g1[0]) * u1[0], silu_f(g1[1]) * u1[1]); w.w = cvt_pk_bf16(silu_f(g1[2]) * u1[2], silu_f(g1[3]) * u1[3]);
                *(u32x4*)(O + (size_t)row * ldo + col0) = w;
            }
    }
};

struct EpiResid {
    static constexpr bool PERM = true, AFTER_DRAIN = false;
    const bf16_t* bhi; float* outf; bf16_t* ohi; float* ssqp; float alpha; int aux;
    __device__ __forceinline__ static f32x4 up_bf(unsigned a, unsigned b) { return (f32x4){__uint_as_float(a << 16), __uint_as_float(a & 0xffff0000u), __uint_as_float(b << 16), __uint_as_float(b & 0xffff0000u)}; }
    __device__ __forceinline__ void operator()(const f32x4 (&acc)[2][2][4][2], const Unit& u, int wr, int wc, int fr, int fq) const {
        const int row0 = u.pm * BM + wr * 64 + fr, col0 = u.pn * BM + wc * 32 + 8 * fq;
        u32x4 bv[2][4][2];
#pragma unroll
        for (int ai = 0; ai < 2; ++ai)
#pragma unroll
            for (int m = 0; m < 4; ++m)
#pragma unroll
                for (int bj = 0; bj < 2; ++bj) bv[ai][m][bj] = *(const u32x4*)(bhi + (size_t)(row0 + ai * HALF + m * 16) * 1024 + col0 + bj * HALF);
        asm volatile("" ::: "memory");
#pragma unroll
        for (int ai = 0; ai < 2; ++ai)
#pragma unroll
            for (int m = 0; m < 4; ++m) {
                const int row = row0 + ai * HALF + m * 16; const size_t off = (size_t)row * 1024 + col0; float ss = 0.f;
#pragma unroll
                for (int bj = 0; bj < 2; ++bj) {
                    const u32x4 h = bv[ai][m][bj];
                    const f32x4 v0 = up_bf(h.x, h.y) + acc[ai][bj][m][0] * alpha, v1 = up_bf(h.z, h.w) + acc[ai][bj][m][1] * alpha;
                    if (aux) ss += ((v0[0] * v0[0] + v0[1] * v0[1]) + (v0[2] * v0[2] + v0[3] * v0[3])) + ((v1[0] * v1[0] + v1[1] * v1[1]) + (v1[2] * v1[2] + v1[3] * v1[3]));
                    if (outf) { *(f32x4*)(outf + off + bj * HALF) = v0; *(f32x4*)(outf + off + bj * HALF + 4) = v1; }
                    else { u32x4 w; w.x = cvt_pk_bf16(v0[0], v0[1]); w.y = cvt_pk_bf16(v0[2], v0[3]); w.z = cvt_pk_bf16(v1[0], v1[1]); w.w = cvt_pk_bf16(v1[2], v1[3]); *(u32x4*)(ohi + off + bj * HALF) = w; }
                }
                if (aux) { ss += __shfl_xor(ss, 16); ss += __shfl_xor(ss, 32); if (fq == 0) ssqp[(size_t)row * 16 + u.pn * 4 + wc] = ss; }
            }
    }
};

struct EpiWin {
    static constexpr bool PERM = true, AFTER_DRAIN = false;
    bf16_t* QO; bf16_t* KB; bf16_t* VB; bf16_t* RW; const float* ssqp; const float* gq; const float* gk; float qscale;
    __device__ __forceinline__ void operator()(const f32x4 (&acc)[2][2][4][2], const Unit& u, int wr, int wc, int fr, int fq) const {
        const int row0 = u.pm * BM + wr * 64 + fr; const int pn = u.pn;
        if (pn < 4) {
            const float* gp = (pn < 2) ? gq : gk; const float osc = (pn < 2) ? qscale : 1.0f;
            f32x4 gv[2][2];
#pragma unroll
            for (int bj = 0; bj < 2; ++bj)
#pragma unroll
                for (int n = 0; n < 2; ++n) gv[bj][n] = *(const f32x4*)(gp + 32 * bj + 8 * fq + 4 * n) * osc;
            bf16_t* dst = (pn < 2) ? QO : KB; const int ld = (pn < 2) ? 1024 : 512; const int colh = 64 * (4 * (pn & 1) + wc) + 8 * fq;
#pragma unroll
            for (int ai = 0; ai < 2; ++ai)
#pragma unroll
                for (int m = 0; m < 4; ++m) {
                    const int row = row0 + ai * HALF + m * 16; const float rs = row_rs(ssqp, row);
                    f32x4 y[2][2]; float ss = 0.f;
#pragma unroll
                    for (int bj = 0; bj < 2; ++bj)
#pragma unroll
                        for (int n = 0; n < 2; ++n) { y[bj][n] = acc[ai][bj][m][n] * rs; const f32x4 t = y[bj][n]; ss += (t[0] * t[0] + t[1] * t[1]) + (t[2] * t[2] + t[3] * t[3]); }
                    ss += __shfl_xor(ss, 16); ss += __shfl_xor(ss, 32);
                    const float hs = __builtin_amdgcn_rsqf(ss * (1.0f / 64.0f) + RMS_EPS_F);
#pragma unroll
                    for (int bj = 0; bj < 2; ++bj) {
                        const f32x4 a = y[bj][0] * gv[bj][0] * hs, b = y[bj][1] * gv[bj][1] * hs;
                        u32x4 w; w.x = cvt_pk_bf16(a[0], a[1]); w.y = cvt_pk_bf16(a[2], a[3]); w.z = cvt_pk_bf16(b[0], b[1]); w.w = cvt_pk_bf16(b[2], b[3]);
                        *(u32x4*)(dst + (size_t)row * ld + colh + 32 * bj) = w;
                    }
                }
        } else {
            bf16_t* dst = (pn < 6) ? VB : RW; const int ld = (pn < 6) ? 512 : 1792; const int colh = 256 * ((pn < 6) ? (pn - 4) : (pn - 6)) + 64 * wc + 8 * fq;
#pragma unroll
            for (int ai = 0; ai < 2; ++ai)
#pragma unroll
                for (int m = 0; m < 4; ++m) {
                    const int row = row0 + ai * HALF + m * 16; const float rs = row_rs(ssqp, row);
#pragma unroll
                    for (int bj = 0; bj < 2; ++bj) {
                        const f32x4 a = acc[ai][bj][m][0] * rs, b = acc[ai][bj][m][1] * rs;
                        u32x4 w; w.x = cvt_pk_bf16(a[0], a[1]); w.y = cvt_pk_bf16(a[2], a[3]); w.z = cvt_pk_bf16(b[0], b[1]); w.w = cvt_pk_bf16(b[2], b[3]);
                        *(u32x4*)(dst + (size_t)row * ld + colh + 32 * bj) = w;
                    }
                }
        }
    }
};

template <class Epi, class Sched, bool ALIGN_EPI = false, bool SP2 = false>
__device__ __forceinline__ void gemm_phase(PG8_LAS unsigned char* lds, const Gemm g, const Sched& S, const Epi& E) {
    const int tid = threadIdx.x, wid = __builtin_amdgcn_readfirstlane(tid >> 6), lane = tid & 63, wr = wid >> 2, wc = wid & 3, fr = lane & 15, fq = lane >> 4;
    const int K = g.K, nt = K / BK, LDP = g.ld ? g.ld : g.K;
    unsigned voffA[2], voffB[2];
#pragma unroll
    for (int i = 0; i < 2; ++i) { int R, C; stage_rc(tid * 16 + i * 8192, R, C); const int Rb = Epi::PERM ? ((R & ~31) + perm32(R & 31)) : R;
        voffA[i] = (unsigned)(R * LDP + C) * 2u; voffB[i] = (unsigned)(Rb * LDP + C) * 2u; }
    const size_t kstep = (size_t)(BK * 2);
    const size_t hstep = (size_t)HALF * LDP * 2;
    const size_t tstep = 2 * hstep;
    const unsigned ldsw = (unsigned)wid * 1024u;
    const int aoff = lds_byte(wr * 64 + fr, fq * 8), boff = lds_byte(wc * 32 + fr, fq * 8);
#define PG8_SA(b, h) (((b) * 2 + (h)) * HTB)
#define PG8_SB(b, h) ((4 + (b) * 2 + (h)) * HTB)
#define PG8_STAGE(bufoff, gbase, voff) do { _Pragma("unroll") for (int _i = 0; _i < 2; ++_i) \
        __builtin_amdgcn_global_load_lds((const unsigned*)((const char*)(gbase) + (voff)[_i]), (PG8_LAS unsigned*)(lds + (bufoff) + ldsw + _i * 8192), 16, 0, 0); } while (0)
#define PG8_LDA(dst, b, h) do { _Pragma("unroll") for (int m = 0; m < 4; ++m) _Pragma("unroll") for (int k = 0; k < 2; ++k) dst[m][k] = *(const PG8_LAS bf16x8*)(lds + PG8_SA(b, h) + aoff + m * 2048 + k * 1024); } while (0)
#define PG8_LDB(dst, b, h) do { _Pragma("unroll") for (int n = 0; n < 2; ++n) _Pragma("unroll") for (int k = 0; k < 2; ++k) dst[n][k] = *(const PG8_LAS bf16x8*)(lds + PG8_SB(b, h) + boff + n * 2048 + k * 1024); } while (0)
#define PG8_MMA(ai, bj, At, Bt) do { __builtin_amdgcn_s_setprio(1); _Pragma("unroll") for (int m = 0; m < 4; ++m) _Pragma("unroll") for (int n = 0; n < 2; ++n) _Pragma("unroll") for (int k = 0; k < 2; ++k) \
        acc[ai][bj][m][n] = __builtin_amdgcn_mfma_f32_16x16x32_bf16(Bt[n][k], At[m][k], acc[ai][bj][m][n], 0, 0, 0); __builtin_amdgcn_s_setprio(0); } while (0)
#define PG8_WAIT_V(n) asm volatile("s_waitcnt vmcnt(" #n ")" ::: "memory")
#define PG8_WAIT_L(n) asm volatile("s_waitcnt lgkmcnt(" #n ")" ::: "memory")
#define PG8_BAR __builtin_amdgcn_s_barrier()
#define PG8_SCHED __builtin_amdgcn_sched_barrier(0)
    Unit cur, nxt; int ui = 0;
    if (!S.next(0, cur)) return;
    f32x4 acc[2][2][4][2];
#pragma unroll
    for (int a = 0; a < 2; ++a)
#pragma unroll
        for (int b = 0; b < 2; ++b)
#pragma unroll
            for (int m = 0; m < 4; ++m)
#pragma unroll
                for (int n = 0; n < 2; ++n) acc[a][b][m][n] = (f32x4){0.f, 0.f, 0.f, 0.f};
    bf16x8 At[4][2], B0[2][2], B1[2][2];
    const char* cA = (const char*)g.A + (size_t)cur.pm * tstep; const char* cB = (const char*)g.Bt + (size_t)cur.pn * tstep;
    S.a_ready(cur);
    if constexpr (SP2) {
        PG8_STAGE(PG8_SB(0, 0), cB, voffB); PG8_STAGE(PG8_SB(0, 1), cB + hstep, voffB); PG8_STAGE(PG8_SA(0, 0), cA, voffA); PG8_STAGE(PG8_SA(0, 1), cA + hstep, voffA);
        if (wr == 1) PG8_BAR;
        PG8_WAIT_V(2); PG8_BAR;
        PG8_STAGE(PG8_SB(1, 0), cB + kstep, voffB); PG8_STAGE(PG8_SA(1, 0), cA + kstep, voffA); PG8_STAGE(PG8_SB(1, 1), cB + hstep + kstep, voffB);
        PG8_WAIT_V(6); PG8_BAR;
    } else {
        PG8_STAGE(PG8_SB(0, 0), cB, voffB); PG8_STAGE(PG8_SA(0, 0), cA, voffA); PG8_STAGE(PG8_SB(0, 1), cB + hstep, voffB); PG8_STAGE(PG8_SA(0, 1), cA + hstep, voffA);
        if (wr == 1) PG8_BAR;
        PG8_WAIT_V(4); PG8_BAR;
        PG8_STAGE(PG8_SB(1, 0), cB + kstep, voffB); PG8_STAGE(PG8_SA(1, 0), cA + kstep, voffA); PG8_STAGE(PG8_SB(1, 1), cB + hstep + kstep, voffB);
        PG8_WAIT_V(6); PG8_BAR;
    }
    for (;;) {
        const bool has_next = S.next(ui + 1, nxt);
        const char* nA = has_next ? (const char*)g.A + (size_t)nxt.pm * tstep : cA; const char* nB = has_next ? (const char*)g.Bt + (size_t)nxt.pn * tstep : cB;
        for (int t = 0; t < nt; t += 2) {
            const bool last = (t == nt - 2);
            const char* a1 = cA + (size_t)(t + 1) * kstep;
            const char* a2 = last ? nA : cA + (size_t)(t + 2) * kstep; const char* b2 = last ? nB : cB + (size_t)(t + 2) * kstep;
            const char* a3 = a2 + kstep; const char* b3 = b2 + kstep;
            if (last && has_next) S.a_ready(nxt);
            if constexpr (SP2) {
            PG8_LDB(B0, 0, 0); PG8_LDB(B1, 0, 1); PG8_SCHED; PG8_LDA(At, 0, 0); PG8_STAGE(PG8_SA(1, 1), a1 + hstep, voffA);
            PG8_WAIT_V(8); PG8_WAIT_L(0); PG8_BAR; PG8_MMA(0, 0, At, B0); PG8_MMA(0, 1, At, B1); PG8_BAR; PG8_SCHED;
            PG8_LDA(At, 0, 1); PG8_STAGE(PG8_SB(0, 0), b2, voffB); PG8_STAGE(PG8_SB(0, 1), b2 + hstep, voffB); PG8_STAGE(PG8_SA(0, 0), a2, voffA);
            PG8_WAIT_V(8); PG8_WAIT_L(0); PG8_BAR; PG8_MMA(1, 0, At, B0); PG8_MMA(1, 1, At, B1); PG8_BAR; PG8_SCHED;
            PG8_LDB(B0, 1, 0); PG8_LDB(B1, 1, 1); PG8_SCHED; PG8_LDA(At, 1, 0); PG8_STAGE(PG8_SA(0, 1), a2 + hstep, voffA);
            PG8_WAIT_V(8); PG8_WAIT_L(0); PG8_BAR; PG8_MMA(0, 0, At, B0); PG8_MMA(0, 1, At, B1); PG8_BAR; PG8_SCHED;
            PG8_LDA(At, 1, 1); PG8_STAGE(PG8_SB(1, 0), b3, voffB); PG8_STAGE(PG8_SB(1, 1), b3 + hstep, voffB); PG8_STAGE(PG8_SA(1, 0), a3, voffA);
            PG8_WAIT_V(8); PG8_WAIT_L(0); PG8_BAR; PG8_MMA(1, 0, At, B0); PG8_MMA(1, 1, At, B1); PG8_BAR; PG8_SCHED;
            } else {
            PG8_LDB(B0, 0, 0); PG8_SCHED; PG8_LDA(At, 0, 0); PG8_STAGE(PG8_SA(1, 1), a1 + hstep, voffA);
            PG8_WAIT_L(8); PG8_BAR; PG8_WAIT_L(0); PG8_MMA(0, 0, At, B0); PG8_BAR; PG8_SCHED;
            PG8_LDB(B1, 0, 1); PG8_STAGE(PG8_SB(0, 0), b2, voffB);
            PG8_BAR; PG8_WAIT_L(0); PG8_MMA(0, 1, At, B1); PG8_BAR;
            PG8_LDA(At, 0, 1); PG8_STAGE(PG8_SA(0, 0), a2, voffA);
            PG8_BAR; PG8_WAIT_L(0); PG8_MMA(1, 0, At, B0); PG8_BAR; PG8_SCHED;
            PG8_STAGE(PG8_SB(0, 1), b2 + hstep, voffB);
            PG8_WAIT_V(6); PG8_BAR; PG8_MMA(1, 1, At, B1); PG8_BAR;
            PG8_LDB(B0, 1, 0); PG8_SCHED; PG8_LDA(At, 1, 0); PG8_STAGE(PG8_SA(0, 1), a2 + hstep, voffA);
            PG8_WAIT_L(8); PG8_BAR; PG8_WAIT_L(0); PG8_MMA(0, 0, At, B0); PG8_BAR; PG8_SCHED;
            PG8_LDB(B1, 1, 1); PG8_STAGE(PG8_SB(1, 0), b3, voffB);
            PG8_BAR; PG8_WAIT_L(0); PG8_MMA(0, 1, At, B1); PG8_BAR;
            PG8_LDA(At, 1, 1); PG8_STAGE(PG8_SA(1, 0), a3, voffA);
            PG8_BAR; PG8_WAIT_L(0); PG8_MMA(1, 0, At, B0); PG8_BAR; PG8_SCHED;
            PG8_STAGE(PG8_SB(1, 1), b3 + hstep, voffB);
            PG8_WAIT_V(6); PG8_BAR; PG8_MMA(1, 1, At, B1); PG8_BAR;
            }
        }
        if constexpr (ALIGN_EPI) { if (wr == 0) PG8_BAR; }
        if constexpr (!Epi::AFTER_DRAIN) { E(acc, cur, wr, wc, fr, fq); S.done(cur); }
        if (!has_next) break;
#pragma unroll
        for (int a = 0; a < 2; ++a)
#pragma unroll
            for (int b = 0; b < 2; ++b)
#pragma unroll
                for (int m = 0; m < 4; ++m)
#pragma unroll
                    for (int n = 0; n < 2; ++n) acc[a][b][m][n] = (f32x4){0.f, 0.f, 0.f, 0.f};
        cur = nxt; cA = nA; cB = nB; ++ui;
        if constexpr (ALIGN_EPI) { if (wr == 1) PG8_BAR; }
    }
    PG8_WAIT_V(0);
    if constexpr (!ALIGN_EPI) { if (wr == 0) PG8_BAR; }
    PG8_BAR;
    if constexpr (Epi::AFTER_DRAIN) { E.fused(acc, cur, wr, wc, fr, fq, lds, wid, lane); S.done(cur); }
#undef PG8_SA
#undef PG8_SB
#undef PG8_STAGE
#undef PG8_LDA
#undef PG8_LDB
#undef PG8_MMA
#undef PG8_WAIT_V
#undef PG8_WAIT_L
#undef PG8_BAR
#undef PG8_SCHED
}
}
#define GAS __attribute__((address_space(1)))
#define LAS __attribute__((address_space(3)))
typedef unsigned short bf16;
typedef unsigned v4u __attribute__((ext_vector_type(4)));
typedef float f32x4 __attribute__((ext_vector_type(4)));
typedef short bf16x8 __attribute__((ext_vector_type(8)));
typedef GAS unsigned gu32;
typedef GAS unsigned long long gu64;
#define RLX_AGENT __ATOMIC_RELAXED, __HIP_MEMORY_SCOPE_AGENT
#define LDS_WAIT() asm volatile("s_waitcnt lgkmcnt(0)" ::: "memory")
#define VM_WAIT() asm volatile("s_waitcnt vmcnt(0)" ::: "memory")
__device__ __forceinline__ unsigned long long rt() { return __builtin_amdgcn_s_memrealtime(); }
__device__ __forceinline__ unsigned f2bf(float f) { unsigned u = __builtin_bit_cast(unsigned, f); return (u + 0x7fffu + ((u >> 16) & 1u)) >> 16; }
__device__ __forceinline__ unsigned pk2(float lo, float hi) { return f2bf(lo) | (f2bf(hi) << 16); }

#define XB_TMO      128
#define XB_XCNT(j)  (256  + 64 * (j))
#define XB_XSUB(j)  (1280 + 64 * (j))
#define XB_XGEN(j)  (2304 + 64 * (j))
#define XB_TOP      3328
#define XB_TOPGEN   3392
#define XCD_BAR_WORDS 3456
#define XB_SPIN_CAP (1u << 18)

__device__ __forceinline__ unsigned xb_ld(unsigned* p)              { return __hip_atomic_load(p, __ATOMIC_RELAXED, __HIP_MEMORY_SCOPE_AGENT); }
__device__ __forceinline__ unsigned xb_add(unsigned* p, unsigned v) { return __hip_atomic_fetch_add(p, v, __ATOMIC_RELAXED, __HIP_MEMORY_SCOPE_AGENT); }
__device__ __forceinline__ unsigned xb_xcc_id() { return (unsigned)__builtin_amdgcn_s_getreg((3 << 11) | 20) & 0xFu; }
#define XB_SPIN(cond, bar) do { unsigned _sp = 0; while (cond) { __builtin_amdgcn_s_sleep(1); \
    if ((++_sp & 255u) == 0u) { if (xb_ld(&(bar)[XB_TMO])) break; if (_sp > XB_SPIN_CAP) { atomicAdd(&(bar)[XB_TMO], 1u); break; } } } } while (0)

struct XcdBarrier {
    unsigned* bar; unsigned x;
    volatile LAS unsigned* st;
};

__device__ __forceinline__ XcdBarrier xcd_barrier_post(unsigned* bar, volatile LAS unsigned* st) {
    XcdBarrier b; b.bar = bar; b.x = xb_xcc_id(); b.st = st;
    if (threadIdx.x == 0) (void)xb_add(&bar[XB_XCNT(b.x)], 1u);
    return b;
}
__device__ __forceinline__ void xcd_barrier_complete(unsigned* bar, unsigned x, unsigned& nloc, unsigned& nx) {
    const unsigned G = gridDim.x * gridDim.y * gridDim.z;
    unsigned sum, cnt, mine, sp = 0u;
    for (;;) {
        sum = 0u; cnt = 0u; mine = 0u;
#pragma unroll
        for (unsigned j = 0; j < 16; ++j) { const unsigned c = xb_ld(&bar[XB_XCNT(j)]); sum += c; cnt += (c > 0u) ? 1u : 0u; mine = (j == x) ? c : mine; }
        if (sum == G) break;
        __builtin_amdgcn_s_sleep(1);
        if ((++sp & 255u) == 0u) { if (xb_ld(&bar[XB_TMO])) break; if (sp > XB_SPIN_CAP) { atomicAdd(&bar[XB_TMO], 1u); break; } }
    }
    nloc = mine > 0u ? mine : 1u; nx = cnt > 0u ? cnt : 1u;
}

__device__ __forceinline__ void xcd_barrier(const XcdBarrier& b) {
    asm volatile("s_waitcnt vmcnt(0)" ::: "memory");
    __syncthreads();
    if (threadIdx.x == 0) {
        unsigned* bar = b.bar;
        __builtin_amdgcn_s_waitcnt(0);
        unsigned nloc = b.st[0], nx = b.st[1];
        if (nloc == 0u) { xcd_barrier_complete(bar, b.x, nloc, nx); b.st[0] = nloc; b.st[1] = nx; }
        const unsigned old = xb_add(&bar[XB_XSUB(b.x)], 1u);
        const unsigned gen = old / nloc;
        if (old + 1u == (gen + 1u) * nloc) {
            __builtin_amdgcn_fence(__ATOMIC_RELEASE, "agent");
            asm volatile("s_waitcnt vmcnt(0)" ::: "memory");
            const unsigned og = xb_add(&bar[XB_TOP], 1u);
            const unsigned tg = og / nx;
            if (og + 1u == (tg + 1u) * nx) xb_add(&bar[XB_TOPGEN], 1u);
            else XB_SPIN(xb_ld(&bar[XB_TOPGEN]) == tg, bar);
            __builtin_amdgcn_fence(__ATOMIC_ACQUIRE, "agent");
            xb_add(&bar[XB_XGEN(b.x)], 1u);
            asm volatile("s_waitcnt vmcnt(0)" ::: "memory");
        } else {
            XB_SPIN(xb_ld(&bar[XB_XGEN(b.x)]) == gen, bar);
            __builtin_amdgcn_fence(__ATOMIC_ACQUIRE, "agent");
            asm volatile("s_waitcnt vmcnt(0)" ::: "memory");
        }
    }
    __syncthreads();
}

constexpr int NWAVES = 8;
#ifndef MK_N_LAUNCHES
#define MK_N_LAUNCHES 1
#endif
constexpr int PER_PHASE = 11;
constexpr int N_LAUNCHES = MK_N_LAUNCHES;

constexpr int BATCH = 16, SEQ = 2048, D = 1024, HD = 64, NH = 8, FF = 2816;
constexpr int M = BATCH * SEQ;
constexpr int SBW = 512, RWW = 512, RWP = 1792, PW = 3328, LORA_K = 256, LORA_N = 1536;
constexpr float LNX_EPS = 64e-5f;

constexpr size_t MiB = 1u << 20;
constexpr size_t WS_CTL = 0, CTL_ZERO_BYTES = 128 * 1024;
constexpr size_t WS_SSQ = 1 * MiB;
constexpr size_t WS_W1U = 4 * MiB;
constexpr size_t WS_W1D = 15 * MiB;
constexpr size_t WS_W2U = 21 * MiB;
constexpr size_t WS_W2D = 32 * MiB;
constexpr size_t WS_WIN = 38 * MiB;
constexpr size_t WS_WOUT = 45 * MiB;
constexpr size_t WS_WLORA = 47 * MiB;
constexpr size_t WS_XB = 48 * MiB;
constexpr size_t WS_ACT = 112 * MiB;
constexpr size_t WS_QO = 112 * MiB;
constexpr size_t WS_KB = 176 * MiB;
constexpr size_t WS_VB = 208 * MiB;
constexpr size_t WS_RW = 240 * MiB;
constexpr size_t WS_ALORA = 352 * MiB;
constexpr size_t WS_LW = 368 * MiB;
constexpr size_t WS_AB = 432 * MiB;
constexpr size_t WS_GB = 464 * MiB;
constexpr size_t WS_TAIL = 496 * MiB;
constexpr size_t WS_END = 512 * MiB;
constexpr int CW_TMO = 0, CW_CODE = 1;
constexpr int CW_BAR = 4096;
constexpr int CW_QUEUE = 16384;

constexpr int RING_OFF = 0, RING_BYTES = 155648;
constexpr int LDSCTL_OFF = RING_BYTES, MISC_OFF = LDSCTL_OFF;
constexpr int LDS_BYTES = 163840;

struct Frame {
    LAS unsigned char* lds;
    volatile LAS unsigned* MISC;
    gu32* ctl;
    int tid, lane, wave;
    int vcu, G;
};
typedef unsigned u32x2g __attribute__((ext_vector_type(2)));
__device__ __forceinline__ float bf2f(unsigned short h) { return __uint_as_float(((unsigned)h) << 16); }
typedef float f32x2h __attribute__((ext_vector_type(2))); typedef __bf16 bf16x2h __attribute__((ext_vector_type(2)));
__device__ __forceinline__ unsigned pkbf(float lo, float hi) { f32x2h v = {lo, hi}; bf16x2h b = __builtin_convertvector(v, bf16x2h); return __builtin_bit_cast(unsigned, b); }
__device__ __forceinline__ float bflo(unsigned w) { return __uint_as_float(w << 16); }
__device__ __forceinline__ float bfhi(unsigned w) { return __uint_as_float(w & 0xffff0000u); }
__device__ __forceinline__ float wave_sum(float v) {
#pragma unroll
    for (int o = 1; o < 64; o <<= 1) v += __shfl_xor(v, o);
    return v;
}
#define DPP_ADD(v, ctrl) ((v) + __int_as_float(__builtin_amdgcn_update_dpp(0, __float_as_int(v), (ctrl), 0xF, 0xF, true)))
__device__ __forceinline__ float sum8(float v) { v = DPP_ADD(v, 0xB1); v = DPP_ADD(v, 0x4E); v = DPP_ADD(v, 0x141); return v; }

struct TItem { const float* W; int ldw, k0, n0; const float* sc; bf16* WT; int Kd, rho0; };
__device__ __forceinline__ void ti_load(const TItem& T, float (&t)[32], int lane) {
#pragma unroll
    for (int i = 0; i < 32; ++i) t[i] = T.W[(size_t)(T.k0 + 2 * i + (lane >> 5)) * T.ldw + T.n0 + (lane & 31)];
}
__device__ __forceinline__ void ti_finish(const TItem& T, const float (&t)[32], LAS float* scr, int lane) {
#pragma unroll
    for (int i = 0; i < 32; ++i) scr[(2 * i + (lane >> 5)) * 33 + (lane & 31)] = t[i];
    LDS_WAIT(); asm volatile("" ::: "memory");
    const int c = lane & 7;
    f32x4 s0 = (f32x4){1.f, 1.f, 1.f, 1.f}, s1 = s0;
    if (T.sc) { s0 = *(const f32x4*)(T.sc + T.k0 + 8 * c); s1 = *(const f32x4*)(T.sc + T.k0 + 8 * c + 4); }
#pragma unroll
    for (int j = 0; j < 4; ++j) { const int n = (lane >> 3) + 8 * j; const LAS float* s = scr + (8 * c) * 33 + n;
        v4u o; o.x = pkbf(s[0 * 33] * s0.x, s[1 * 33] * s0.y); o.y = pkbf(s[2 * 33] * s0.z, s[3 * 33] * s0.w); o.z = pkbf(s[4 * 33] * s1.x, s[5 * 33] * s1.y); o.w = pkbf(s[6 * 33] * s1.z, s[7 * 33] * s1.w);
        *(GAS v4u*)(T.WT + (size_t)(T.rho0 + n) * T.Kd + T.k0 + 8 * c) = o; }
    LDS_WAIT(); asm volatile("" ::: "memory");
}
#define P0_PTRS const float* Ax, const float* An1, const float* Ag1, const float* Au1, const float* Ad1, const float* Anm, const float* Awin, const float* Aw2, const float* Aa2, const float* Ag2, const float* Awout, \
    const float* An2, const float* Ag2f, const float* Au2f, const float* Ad2f, bf16* AW1U, bf16* AW1D, bf16* AW2U, bf16* AW2D, bf16* AWIN, bf16* AWOUT, bf16* AWLORA, bf16* AXB, float* ASSQ
__device__ __forceinline__ void p0_items(Frame& F, P0_PTRS, int set, int gw, int NGW) {
    LAS float* scr = (LAS float*)(F.lds + RING_OFF + F.wave * 16384);
    constexpr int I_UP = 16 * 176, I_DN = 44 * 32, I_IN = 16 * 104, I_OUT = 16 * 32;
    const int NITEMS = set ? (I_UP + I_DN) : (I_UP + I_DN + I_IN + I_OUT);
#define P0_DECODE(it_, T) do { int r = (it_); const int l2 = set; \
        if (r < I_UP) { const int kb = r / 176, nb = r % 176, rho0 = 32 * nb, pn = rho0 >> 8, bj = (rho0 >> 7) & 1, j0 = rho0 & 127; \
            T = TItem{l2 ? (bj ? Au2f : Ag2f) : (bj ? Au1 : Ag1), FF, 64 * kb, 128 * pn + j0, l2 ? An2 : An1, l2 ? AW2U : AW1U, D, rho0}; } \
        else if ((r -= I_UP) < I_DN) { const int kb = r / 32, nb = r % 32; \
            T = TItem{l2 ? Ad2f : Ad1, D, 64 * kb, 32 * nb, nullptr, l2 ? AW2D : AW1D, FF, 32 * nb}; } \
        else if ((r -= I_DN) < I_IN) { const int kb = r / 104, nb = r % 104, rho0 = 32 * nb, pn = rho0 >> 8, rem = rho0 & 255, bj = rem >> 7, wc = (rem & 127) >> 5; \
            T = TItem{Awin, PW, 64 * kb, 256 * pn + 64 * wc + 32 * bj, Anm, AWIN, D, rho0}; } \
        else { r -= I_IN; const int kb = r / 32, nb = r % 32; T = TItem{Awout, D, 64 * kb, 32 * nb, nullptr, AWOUT, D, 32 * nb}; } } while (0)
    for (int it = gw; it < NITEMS; it += 2 * NGW) {
        TItem T0, T1; float t0[32], t1[32]; const bool two = (it + NGW < NITEMS);
        P0_DECODE(it, T0); ti_load(T0, t0, F.lane);
        if (two) { P0_DECODE(it + NGW, T1); ti_load(T1, t1, F.lane); }
        ti_finish(T0, t0, scr, F.lane);
        if (two) ti_finish(T1, t1, scr, F.lane);
    }
#undef P0_DECODE
}
__device__ __forceinline__ void p0_prologue(Frame& F, P0_PTRS) {
    const int gw = F.vcu * NWAVES + F.wave, NGW = F.G * NWAVES;
    p0_items(F, Ax, An1, Ag1, Au1, Ad1, Anm, Awin, Aw2, Aa2, Ag2, Awout, An2, Ag2f, Au2f, Ad2f, AW1U, AW1D, AW2U, AW2D, AWIN, AWOUT, AWLORA, AXB, ASSQ, (F.G >= 256) ? 0 : 0, gw, NGW);
    if (F.G < 256) p0_items(F, Ax, An1, Ag1, Au1, Ad1, Anm, Awin, Aw2, Aa2, Ag2, Awout, An2, Ag2f, Au2f, Ad2f, AW1U, AW1D, AW2U, AW2D, AWIN, AWOUT, AWLORA, AXB, ASSQ, 1, gw, NGW);
    for (int it = F.vcu * (NWAVES * 64) + F.tid; it < 512 * 32; it += F.G * NWAVES * 64) {
        int ch, kc, Kk; const float* src; bf16* dst;
        if (it < 512 * 8) { ch = it >> 3; kc = (it & 7) * 8; Kk = 64; src = Aw2; dst = AWLORA; }
        else if (it < 512 * 16) { const int i2 = it - 512 * 8; ch = i2 >> 3; kc = (i2 & 7) * 8; Kk = 64; src = Aa2; dst = AWLORA + 512 * 64; }
        else { const int i2 = it - 512 * 16; ch = i2 >> 4; kc = (i2 & 15) * 8; Kk = 128; src = Ag2; dst = AWLORA + 2 * 512 * 64; }
        float v[8];
#pragma unroll
        for (int j = 0; j < 8; ++j) v[j] = src[(size_t)(kc + j) * 512 + ch];
        v4u o; o.x = pkbf(v[0], v[1]); o.y = pkbf(v[2], v[3]); o.z = pkbf(v[4], v[5]); o.w = pkbf(v[6], v[7]);
        *(GAS v4u*)(dst + (size_t)ch * Kk + kc) = o;
    }
    for (int mb = gw; mb < M; mb += 4 * NGW) {
        f32x4 v[4][4]; float s[4];
#pragma unroll
        for (int q = 0; q < 4; ++q) { const int m = mb + q * NGW; const GAS f32x4* xr = (const GAS f32x4*)(Ax + (size_t)(m < M ? m : mb) * D) + F.lane;
#pragma unroll
            for (int j = 0; j < 4; ++j) v[q][j] = xr[64 * j]; }
#pragma unroll
        for (int q = 0; q < 4; ++q) { float a = 0.f;
#pragma unroll
            for (int j = 0; j < 4; ++j) a += (v[q][j].x * v[q][j].x + v[q][j].y * v[q][j].y) + (v[q][j].z * v[q][j].z + v[q][j].w * v[q][j].w);
            s[q] = a; }
#pragma unroll
        for (int o = 1; o < 64; o <<= 1) {
#pragma unroll
            for (int q = 0; q < 4; ++q) s[q] += __shfl_xor(s[q], o); }
#pragma unroll
        for (int q = 0; q < 4; ++q) { const int m = mb + q * NGW; if (m < M) {
            GAS unsigned long long* o8 = (GAS unsigned long long*)(AXB + (size_t)m * D) + F.lane;
#pragma unroll
            for (int j = 0; j < 4; ++j) o8[64 * j] = (unsigned long long)pkbf(v[q][j].x, v[q][j].y) | ((unsigned long long)pkbf(v[q][j].z, v[q][j].w) << 32);
            if (F.lane < 16) ASSQ[(size_t)m * 16 + F.lane] = (F.lane == 0) ? s[q] : 0.f; } }
    }
}

struct RwArgs { const bf16* RW; const bf16* W2T; const bf16* A2T; const bf16* G2T; const float* w0; const float* a0; bf16* QO; const float *mu, *k_k, *k_a, *r_k, *ln_w, *ln_b; };
__device__ __forceinline__ void ld8bf(const bf16* p, float (&o)[8]) { const v4u w = *(const v4u*)p; o[0] = bflo(w.x); o[1] = bfhi(w.x); o[2] = bflo(w.y); o[3] = bfhi(w.y); o[4] = bflo(w.z); o[5] = bfhi(w.z); o[6] = bflo(w.w); o[7] = bfhi(w.w); }
__device__ __forceinline__ void ld8f(const float* p, float (&o)[8]) { const f32x4 a = *(const f32x4*)p, b = *(const f32x4*)(p + 4); o[0] = a.x; o[1] = a.y; o[2] = a.z; o[3] = a.w; o[4] = b.x; o[5] = b.y; o[6] = b.z; o[7] = b.w; }
__device__ __forceinline__ void ld8l(const LAS float* p, float (&o)[8]) { const f32x4 a = *(const LAS f32x4*)p, b = *(const LAS f32x4*)(p + 4); o[0] = a.x; o[1] = a.y; o[2] = a.z; o[3] = a.w; o[4] = b.x; o[5] = b.y; o[6] = b.z; o[7] = b.w; }
__device__ __forceinline__ void st8l(LAS float* p, const float (&o)[8]) { *(LAS f32x4*)p = (f32x4){o[0], o[1], o[2], o[3]}; *(LAS f32x4*)(p + 4) = (f32x4){o[4], o[5], o[6], o[7]}; }
namespace rwk {
typedef short bf16x8 __attribute__((ext_vector_type(8)));
typedef short s16x4 __attribute__((ext_vector_type(4)));
typedef short v4i16_t __attribute__((ext_vector_type(4)));
constexpr int SLOT = 8192;
#define RSL(s) (lds + (s) * SLOT)
#define RMFMA(a, b, c) __builtin_amdgcn_mfma_f32_16x16x32_bf16((a), (b), (c), 0, 0, 0)
__device__ __forceinline__ int swz(int row, int cb) { return row * 128 + (cb ^ ((row & 7) << 4)); }
struct Fr2 { bf16x8 k0, k1; };
__device__ __forceinline__ Fr2 ldf(const LAS unsigned char* base, int off) { Fr2 f; f.k0 = *(const LAS bf16x8*)(base + off); f.k1 = *(const LAS bf16x8*)(base + (off ^ 64)); return f; }
__device__ __forceinline__ s16x4 trd(const LAS unsigned char* p) { return __builtin_bit_cast(s16x4, __builtin_amdgcn_ds_read_tr16_b64_v4i16((LAS v4i16_t*)p)); }
__device__ __forceinline__ Fr2 ldt(const LAS unsigned char* base, int o0, int o1) {
    const s16x4 a = trd(base + o0), b = trd(base + o1), c = trd(base + o0 + 4096), d = trd(base + o1 + 4096);
    Fr2 f; f.k0 = (bf16x8){a[0], a[1], a[2], a[3], b[0], b[1], b[2], b[3]}; f.k1 = (bf16x8){c[0], c[1], c[2], c[3], d[0], d[1], d[2], d[3]}; return f; }
template <bool SWAP> __device__ __forceinline__ f32x4 mm(const Fr2& a, const Fr2& b, f32x4 c) {
    if (SWAP) { c = RMFMA(b.k0, a.k0, c); c = RMFMA(b.k1, a.k1, c); } else { c = RMFMA(a.k0, b.k0, c); c = RMFMA(a.k1, b.k1, c); } return c; }
__device__ __forceinline__ void st4(LAS unsigned char* slot, int off, f32x4 v) { u32x2g w; w.x = pkbf(v[0], v[1]); w.y = pkbf(v[2], v[3]); *(LAS u32x2g*)(slot + off) = w; }
__device__ __forceinline__ f32x4 ld4(const LAS unsigned char* slot, int off) { const u32x2g w = *(const LAS u32x2g*)(slot + off); return (f32x4){bflo(w.x), bfhi(w.x), bflo(w.y), bfhi(w.y)}; }
#define LBAR() asm volatile("s_waitcnt lgkmcnt(0)\n\ts_barrier" ::: "memory")
#define DPPF(x, ctrl, rmask) __int_as_float(__builtin_amdgcn_update_dpp(0, __float_as_int(x), (ctrl), (rmask), 0xF, true))
__device__ __forceinline__ float wave_scan(float x) {
    x += DPPF(x, 0x111, 0xF); x += DPPF(x, 0x112, 0xF); x += DPPF(x, 0x114, 0xF); x += DPPF(x, 0x118, 0xF);
    x += DPPF(x, 0x142, 0xA);
    x += DPPF(x, 0x143, 0xC);
    return x; }
__device__ __forceinline__ void unp8(const v4u w, float (&o)[8]) { o[0] = bflo(w.x); o[1] = bfhi(w.x); o[2] = bflo(w.y); o[3] = bfhi(w.y); o[4] = bflo(w.z); o[5] = bfhi(w.z); o[6] = bflo(w.w); o[7] = bfhi(w.w); }
__device__ __forceinline__ v4u pk8(const float (&o)[8]) { return (v4u){pkbf(o[0], o[1]), pkbf(o[2], o[3]), pkbf(o[4], o[5]), pkbf(o[6], o[7])}; }
}
struct RwX { bf16* P1; bf16* GT; bf16* Y0; bf16* H; bf16* VB0; bf16* VB1; float* GE; bf16* G; };
__device__ __forceinline__ void p6a_rwkv_local(Frame& F, const RwArgs& A, const RwX& X) {
    using namespace rwk;
    LAS unsigned char* lds = F.lds + RING_OFF;
    LAS float* part = (LAS float*)(F.lds + LDSCTL_OFF + 128);
    LAS float* cst = (LAS float*)(F.lds + LDSCTL_OFF + 128 + 4096 + 896);
    const int lane = F.lane, fr = lane & 15, fq = lane >> 4, w = F.wave, m0 = 16 * (w >> 1), n0a = 32 * (w & 1);
    const int fm = swz(m0 + fr, fq * 16);
    const int ta0 = swz(8 * fq + (fr >> 2), 2 * (m0 + 4 * (fr & 3))), ta1 = swz(8 * fq + 4 + (fr >> 2), 2 * (m0 + 4 * (fr & 3)));
    int fn[2], orm[2], otr[2], tb0[2], tb1[2];
#pragma unroll
    for (int t = 0; t < 2; ++t) { const int n0 = n0a + 16 * t; fn[t] = swz(n0 + fr, fq * 16); orm[t] = swz(m0 + fr, 2 * (n0 + 4 * fq)); otr[t] = swz(n0 + fr, 2 * (m0 + 4 * fq));
        tb0[t] = swz(8 * fq + (fr >> 2), 2 * (n0 + 4 * (fr & 3))); tb1[t] = swz(8 * fq + 4 + (fr >> 2), 2 * (n0 + 4 * (fr & 3))); }
    const int NJ = BATCH * NH * (SEQ / 64);
    const int tid = F.tid, ltok = tid >> 3, ldg = tid & 7;
    v4u g_r, g_k, g_v, g_xw, g_xa, g_xg0, g_xg1, g_pr;
#define P6A_LOAD(jj) do { const int u_ = (jj) >> 5, c_ = (jj) & 31; const size_t gr_ = (size_t)(u_ >> 3) * SEQ + c_ * 64 + ltok; const int cb_ = 64 * (u_ & 7) + 8 * ldg; const bf16* rp_ = A.RW + gr_ * RWP; \
        g_r = *(const v4u*)(rp_ + cb_); g_k = *(const v4u*)(rp_ + 512 + cb_); g_v = *(const v4u*)(rp_ + 1024 + cb_); \
        g_xw = *(const v4u*)(rp_ + 1536 + 8 * ldg); g_xa = *(const v4u*)(rp_ + 1600 + 8 * ldg); g_xg0 = *(const v4u*)(rp_ + 1664 + 8 * ldg); g_xg1 = *(const v4u*)(rp_ + 1728 + 8 * ldg); \
        g_pr = (v4u){0u, 0u, 0u, 0u}; if (ltok < 7 && c_ > 0) g_pr = *(const v4u*)(A.RW + ((size_t)(u_ >> 3) * SEQ + c_ * 64 - 1) * RWP + (ltok < 3 ? 512 * ltok + cb_ : 1536 + 64 * (ltok - 3) + 8 * ldg)); } while (0)
    if ((int)blockIdx.x < NJ) P6A_LOAD((int)blockIdx.x);
    int hcur = -1;
    LAS unsigned char* prow = (LAS unsigned char*)(F.lds + LDSCTL_OFF + 128 + 4096);
    if (tid < 256) cst[512 + tid] = A.mu[1536 + tid];
    u32x2g s_p1[2], s_gt[2], s_y0[2], s_hh[2]; size_t s_jo = 0; bool s_have = false;
#define P6A_STORE() do { _Pragma("unroll") for (int t = 0; t < 2; ++t) { \
            *(u32x2g*)(X.P1 + s_jo + ((w * 2 + t) * 64 + lane) * 4) = s_p1[t]; *(u32x2g*)(X.GT + s_jo + ((w * 2 + t) * 64 + lane) * 4) = s_gt[t]; \
            *(u32x2g*)(X.Y0 + s_jo + ((w * 2 + t) * 64 + lane) * 4) = s_y0[t]; *(u32x2g*)(X.H + s_jo + ((w * 2 + t) * 64 + lane) * 4) = s_hh[t]; } } while (0)
    for (int job = blockIdx.x; job < NJ; job += F.G) {
        const int unit = job >> 5, c = job & 31; const int h = unit & 7; const int cb = 64 * h + 8 * w; const size_t jo = (size_t)job * 4096;
        {
            const int so = swz(ltok, 16 * ldg);
            *(LAS v4u*)(RSL(12) + so) = g_r; *(LAS v4u*)(RSL(2) + so) = g_k; *(LAS v4u*)(RSL(0) + so) = g_v;
            *(LAS v4u*)(RSL(14) + so) = g_xw; *(LAS v4u*)(RSL(13) + so) = g_xa; *(LAS v4u*)(RSL(10) + so) = g_xg0; *(LAS v4u*)(RSL(11) + so) = g_xg1;
            if (ltok < 7) *(LAS v4u*)(prow + ltok * 128 + 16 * ldg) = g_pr;
            if (h != hcur) {
                *(LAS v4u*)(RSL(16) + so) = *(const v4u*)(A.W2T + (size_t)(64 * h + ltok) * 64 + 8 * ldg); *(LAS v4u*)(RSL(17) + so) = *(const v4u*)(A.A2T + (size_t)(64 * h + ltok) * 64 + 8 * ldg);
                { const int a_ = tid >> 6, i_ = tid & 63;
                  const float* src_ = (a_ == 0) ? A.mu : (a_ == 1) ? A.mu + 512 : (a_ == 2) ? A.mu + 1024 : (a_ == 3) ? A.k_k : (a_ == 4) ? A.k_a : (a_ == 5) ? A.r_k : (a_ == 6) ? A.w0 : A.a0;
                  cst[a_ * 64 + i_] = src_[64 * h + i_]; } }
            hcur = h;
        }
        if (s_have) P6A_STORE();
        { const int nj = job + F.G; if (nj < NJ) P6A_LOAD(nj); }
        LBAR();
        float r[8], k[8], v[8];
        {
            const int so = swz(lane, 16 * w), sp = swz((lane + 63) & 63, 16 * w);
#define P6A_SHIFT(slot, pi, moff, dst) do { float c_[8], p_[8], m_[8]; v4u wc_ = *(const LAS v4u*)(RSL(slot) + so), wp_ = *(const LAS v4u*)(RSL(slot) + sp); \
                if (lane == 0) wp_ = *(const LAS v4u*)(prow + 128 * (pi) + 16 * w); \
                unp8(wc_, c_); unp8(wp_, p_); ld8l(cst + (moff) + 8 * w, m_); \
                _Pragma("unroll") for (int j = 0; j < 8; ++j) dst[j] = c_[j] + (p_[j] - c_[j]) * m_[j]; } while (0)
            P6A_SHIFT(12, 0, 0, r);
            P6A_SHIFT(2, 1, 64, k);
            P6A_SHIFT(0, 2, 128, v); asm volatile("" ::: "memory");
            { float x_[8]; P6A_SHIFT(14, 3, 512, x_);
#pragma unroll
              for (int j = 0; j < 8; ++j) x_[j] = 2.0f * pg8::sigmoid_f(2.0f * x_[j]) - 1.0f;
              *(LAS v4u*)(RSL(14) + so) = pk8(x_); }
            { float x_[8]; P6A_SHIFT(13, 4, 576, x_); *(LAS v4u*)(RSL(13) + so) = pk8(x_); } asm volatile("" ::: "memory");
            { float x_[8]; P6A_SHIFT(10, 5, 640, x_);
#pragma unroll
              for (int j = 0; j < 8; ++j) x_[j] = pg8::sigmoid_f(x_[j]);
              *(LAS v4u*)(RSL(10) + so) = pk8(x_); }
            { float x_[8]; P6A_SHIFT(11, 6, 704, x_);
#pragma unroll
              for (int j = 0; j < 8; ++j) x_[j] = pg8::sigmoid_f(x_[j]);
              *(LAS v4u*)(RSL(11) + so) = pk8(x_); }
#undef P6A_SHIFT
        }
        LBAR();
        {
            const f32x4 z4 = (f32x4){0.f, 0.f, 0.f, 0.f};
            bf16x8 gq[2][4];
#pragma unroll
            for (int t = 0; t < 2; ++t) { const bf16* gp = A.G2T + (size_t)(64 * h + n0a + 16 * t + fr) * 128 + 8 * fq;
#pragma unroll
                for (int q = 0; q < 4; ++q) gq[t][q] = *reinterpret_cast<const bf16x8*>(gp + 32 * q); }
            {   const Fr2 aW = ldf(RSL(14), fm), aA = ldf(RSL(13), fm); Fr2 bW[2], bA[2];
#pragma unroll
                for (int t = 0; t < 2; ++t) { bW[t] = ldf(RSL(16), fn[t]); bA[t] = ldf(RSL(17), fn[t]); }
#pragma unroll
                for (int t = 0; t < 2; ++t) { const int row = m0 + fr, ch = n0a + 16 * t + 4 * fq; const f32x4 lwq = mm<true>(aW, bW[t], z4), alq = mm<true>(aA, bA[t], z4);
                    const f32x4 w0c = *(const LAS f32x4*)(cst + 384 + ch), a0c = *(const LAS f32x4*)(cst + 448 + ch); f32x4 lwv, alv;
#pragma unroll
                    for (int x = 0; x < 4; ++x) { lwv[x] = -0.6065306597126334f * pg8::sigmoid_f(w0c[x] + lwq[x]); alv[x] = pg8::sigmoid_f(a0c[x] + alq[x]); }
                    const int fo = row * 256 + (((ch >> 3) ^ (row & 7)) << 5) + ((ch >> 2) & 1) * 16;
                    *(LAS f32x4*)(RSL(4) + fo) = lwv; *(LAS f32x4*)(RSL(8) + fo) = alv; } }
            asm volatile("" ::: "memory");
            {   const Fr2 aG0 = ldf(RSL(10), fm), aG1 = ldf(RSL(11), fm);
#pragma unroll
                for (int t = 0; t < 2; ++t) { Fr2 bG0, bG1; bG0.k0 = gq[t][0]; bG0.k1 = gq[t][1]; bG1.k0 = gq[t][2]; bG1.k1 = gq[t][3];
                    st4(RSL(3), orm[t], mm<true>(aG1, bG1, mm<true>(aG0, bG0, z4))); } }
        }
        LBAR();
        float kf[8], kk[8], al[8], lw[8]; float ssp = 0.f, bpp = 0.f;
        {
            { const int fo = lane * 256 + ((w ^ (lane & 7)) << 5); const f32x4 a_ = *(const LAS f32x4*)(RSL(4) + fo), b_ = *(const LAS f32x4*)(RSL(4) + fo + 16), c_ = *(const LAS f32x4*)(RSL(8) + fo), d_ = *(const LAS f32x4*)(RSL(8) + fo + 16);
              lw[0] = a_.x; lw[1] = a_.y; lw[2] = a_.z; lw[3] = a_.w; lw[4] = b_.x; lw[5] = b_.y; lw[6] = b_.z; lw[7] = b_.w;
              al[0] = c_.x; al[1] = c_.y; al[2] = c_.z; al[3] = c_.w; al[4] = d_.x; al[5] = d_.y; al[6] = d_.z; al[7] = d_.w; }
            *(v4u*)(X.G + jo + tid * 8) = *(const LAS v4u*)(RSL(3) + swz(ltok, 16 * ldg));
            float kkc[8], kac[8], rkc[8]; ld8l(cst + 192 + 8 * w, kkc); ld8l(cst + 256 + 8 * w, kac); ld8l(cst + 320 + 8 * w, rkc);
#pragma unroll
            for (int j = 0; j < 8; ++j) { kk[j] = k[j] * kkc[j]; ssp += kk[j] * kk[j]; kf[j] = k[j] * (1.0f + (al[j] - 1.0f) * kac[j]); bpp += r[j] * kf[j] * rkc[j]; }
            part[w * 64 + lane] = ssp; part[512 + w * 64 + lane] = bpp;
        }
        LBAR();
        {
            float ss = 0.f, bon = 0.f;
#pragma unroll
            for (int i = 0; i < 8; ++i) { ss += part[i * 64 + lane]; bon += part[512 + i * 64 + lane]; }
            const float inv = 1.0f / fmaxf(sqrtf(ss), 1e-12f);
            float at[8], rt[8], bt[8], kt[8], bh[8], kh[8], ge[8], vb[8];
#pragma unroll
            for (int j = 0; j < 8; ++j) {
                const float cs = wave_scan(lw[j]);
                const float ce = __int_as_float(__builtin_amdgcn_readlane(__float_as_int(cs), 63));
                const float e_cs = __builtin_amdgcn_exp2f(cs * 1.4426950408889634f), e_csm = __builtin_amdgcn_exp2f((cs - lw[j]) * 1.4426950408889634f);
                const float e_neg = __builtin_amdgcn_rcpf(e_cs), e_end = __builtin_amdgcn_exp2f((ce - cs) * 1.4426950408889634f);
                const float kn = kk[j] * inv, bb = kn * al[j];
                at[j] = -kn * e_csm; rt[j] = r[j] * e_cs; bt[j] = bb * e_neg; kt[j] = kf[j] * e_neg; bh[j] = bb * e_end; kh[j] = kf[j] * e_end; ge[j] = e_cs; vb[j] = bon * v[j];
            }
            const int ro = swz(lane, 16 * w);
            *(LAS v4u*)(RSL(0) + ro) = pk8(at); *(LAS v4u*)(RSL(1) + ro) = pk8(rt); *(LAS v4u*)(RSL(2) + ro) = pk8(bt); *(LAS v4u*)(RSL(3) + ro) = pk8(kt);
            *(LAS v4u*)(RSL(4) + ro) = pk8(bh); *(LAS v4u*)(RSL(5) + ro) = pk8(kh); *(LAS v4u*)(RSL(6) + ro) = pk8(v);
            if (lane == 63) { *(f32x4*)(X.GE + (size_t)job * 64 + 8 * w) = (f32x4){ge[0], ge[1], ge[2], ge[3]}; *(f32x4*)(X.GE + (size_t)job * 64 + 8 * w + 4) = (f32x4){ge[4], ge[5], ge[6], ge[7]}; }
            *(LAS v4u*)(RSL(18) + ro) = pk8(vb);
        }
        LBAR();
        {
            { bf16* vbp = (job < 2048) ? (X.VB0 + jo) : (X.VB1 + (jo - (size_t)2048 * 4096)); *(v4u*)(vbp + tid * 8) = *(const LAS v4u*)(RSL(18) + swz(ltok, 16 * ldg)); }
            const f32x4 z4 = (f32x4){0.f, 0.f, 0.f, 0.f};
            const Fr2 aA = ldf(RSL(0), fm), aR = ldf(RSL(1), fm); Fr2 bB[2], bK[2];
#pragma unroll
            for (int t = 0; t < 2; ++t) { bB[t] = ldf(RSL(2), fn[t]); bK[t] = ldf(RSL(3), fn[t]); }
            f32x4 nab[2], nabT[2], nak[2], mrb[2], mrk[2];
#pragma unroll
            for (int t = 0; t < 2; ++t) { nab[t] = mm<true>(aA, bB[t], z4); nabT[t] = mm<false>(aA, bB[t], z4); nak[t] = mm<true>(aA, bK[t], z4); mrb[t] = mm<true>(aR, bB[t], z4); mrk[t] = mm<true>(aR, bK[t], z4); }
#pragma unroll
            for (int t = 0; t < 2; ++t) { const int n0 = n0a + 16 * t; f32x4 x1;
#pragma unroll
                for (int x = 0; x < 4; ++x) { const int i = m0 + fr, j = n0 + 4 * fq + x;
                    if (j >= i) { nab[t][x] = 0.f; nak[t][x] = 0.f; } if (j > i) { mrb[t][x] = 0.f; mrk[t][x] = 0.f; }
                    x1[x] = nab[t][x] + ((i == j) ? 1.0f : 0.f);
                    const int it = m0 + 4 * fq + x, jt = n0 + fr; if (jt >= it) nabT[t][x] = 0.f; }
                st4(RSL(10), orm[t], x1); st4(RSL(12), orm[t], nab[t]); st4(RSL(14), otr[t], nabT[t]);
                st4(RSL(7), orm[t], nak[t]); st4(RSL(8), orm[t], mrb[t]); st4(RSL(9), orm[t], mrk[t]); }
        }
        LBAR();
        {
            const f32x4 z4 = (f32x4){0.f, 0.f, 0.f, 0.f};
            const Fr2 aP = ldf(RSL(12), fm), aN = ldf(RSL(7), fm); Fr2 bT[2], bV[2];
#pragma unroll
            for (int t = 0; t < 2; ++t) { bT[t] = ldf(RSL(14), fn[t]); bV[t] = ldt(RSL(6), tb0[t], tb1[t]); }
            f32x4 q0[2], q1[2], q2[2];
#pragma unroll
            for (int t = 0; t < 2; ++t) { q0[t] = mm<true>(aP, bT[t], z4); q1[t] = mm<false>(aP, bT[t], z4); q2[t] = mm<false>(aN, bV[t], z4); }
#pragma unroll
            for (int t = 0; t < 2; ++t) { st4(RSL(13), orm[t], q0[t]); st4(RSL(15), otr[t], q1[t]); st4(RSL(2), otr[t], q2[t]); }
        }
        LBAR();
#pragma unroll
        for (int kd = 0; kd < 5; ++kd) {
            const int xi = (kd & 1) ? 11 : 10, xo = (kd & 1) ? 10 : 11, pi = (kd & 1) ? 12 : 13, po = (kd & 1) ? 13 : 12, ti = (kd & 1) ? 14 : 15, to = (kd & 1) ? 15 : 14;
            const f32x4 z4 = (f32x4){0.f, 0.f, 0.f, 0.f};
            const Fr2 aX = ldf(RSL(xi), fm), aP = ldf(RSL(pi), fm); Fr2 bT[2]; f32x4 cx[2];
#pragma unroll
            for (int t = 0; t < 2; ++t) { bT[t] = ldf(RSL(ti), fn[t]); cx[t] = ld4(RSL(xi), orm[t]); }
            f32x4 q0[2], q1[2], q2[2];
#pragma unroll
            for (int t = 0; t < 2; ++t) { q0[t] = mm<true>(aX, bT[t], cx[t]); if (kd < 4) { q1[t] = mm<true>(aP, bT[t], z4); q2[t] = mm<false>(aP, bT[t], z4); } }
#pragma unroll
            for (int t = 0; t < 2; ++t) { st4(RSL(xo), orm[t], q0[t]); if (kd < 4) { st4(RSL(po), orm[t], q1[t]); st4(RSL(to), otr[t], q2[t]); } }
            LBAR();
        }
        {
            const f32x4 z4 = (f32x4){0.f, 0.f, 0.f, 0.f};
            const Fr2 aT = ldf(RSL(11), fm); Fr2 bA[2], bZ[2];
#pragma unroll
            for (int t = 0; t < 2; ++t) { bA[t] = ldt(RSL(0), tb0[t], tb1[t]); bZ[t] = ldf(RSL(2), fn[t]); }
            f32x4 q0[2], q1[2];
#pragma unroll
            for (int t = 0; t < 2; ++t) { q0[t] = mm<false>(aT, bA[t], z4); q1[t] = mm<false>(aT, bZ[t], z4); }
#pragma unroll
            for (int t = 0; t < 2; ++t) { st4(RSL(3), otr[t], q0[t]); st4(RSL(7), otr[t], q1[t]); }
        }
        LBAR();
        {
            const f32x4 z4 = (f32x4){0.f, 0.f, 0.f, 0.f};
            f32x4 p1[2], y0[2], gt[2], hh[2];
            {   const Fr2 aMb = ldf(RSL(8), fm), aMk = ldf(RSL(9), fm); Fr2 bW[2], bU[2], bV[2]; f32x4 cR[2];
#pragma unroll
                for (int t = 0; t < 2; ++t) { bW[t] = ldf(RSL(3), fn[t]); bU[t] = ldf(RSL(7), fn[t]); bV[t] = ldt(RSL(6), tb0[t], tb1[t]); cR[t] = ld4(RSL(1), orm[t]); }
#pragma unroll
                for (int t = 0; t < 2; ++t) { p1[t] = mm<true>(aMb, bW[t], cR[t]); y0[t] = mm<true>(aMk, bV[t], mm<true>(aMb, bU[t], z4)); } }
            {   const Fr2 aW = ldf(RSL(3), fm), aU = ldf(RSL(7), fm), aV = ldt(RSL(6), ta0, ta1); Fr2 bBh[2], bKh[2];
#pragma unroll
                for (int t = 0; t < 2; ++t) { bBh[t] = ldt(RSL(4), tb0[t], tb1[t]); bKh[t] = ldt(RSL(5), tb0[t], tb1[t]); }
#pragma unroll
                for (int t = 0; t < 2; ++t) { gt[t] = mm<false>(aW, bBh[t], z4); hh[t] = mm<true>(aV, bKh[t], mm<true>(aU, bBh[t], z4)); } }
#pragma unroll
            for (int t = 0; t < 2; ++t) {
                s_p1[t].x = pkbf(p1[t][0], p1[t][1]); s_p1[t].y = pkbf(p1[t][2], p1[t][3]); s_gt[t].x = pkbf(gt[t][0], gt[t][1]); s_gt[t].y = pkbf(gt[t][2], gt[t][3]);
                s_y0[t].x = pkbf(y0[t][0], y0[t][1]); s_y0[t].y = pkbf(y0[t][2], y0[t][3]); s_hh[t].x = pkbf(hh[t][0], hh[t][1]); s_hh[t].y = pkbf(hh[t][2], hh[t][3]); }
            s_jo = jo; s_have = true;
        }
    }
    if (s_have) P6A_STORE();
#undef P6A_LOAD
#undef P6A_STORE
    LBAR();
}
__device__ __forceinline__ void p6b_rwkv_seq(Frame& F, const RwArgs& A, const RwX& X, int nwg) {
    using namespace rwk;
    LAS unsigned char* lds = F.lds + RING_OFF;
    constexpr int YLD = 68;
    LAS float* Yf0 = (LAS float*)RSL(6);
    const int tid = F.tid, tok = tid >> 3, dg = tid & 7, lane = F.lane, fr = lane & 15, fq = lane >> 4;
    const int w = F.wave, m0 = 16 * (w >> 1), n0a = 32 * (w & 1);
    const int fm = swz(m0 + fr, fq * 16);
    int fn[2], orm[2], otr[2];
#pragma unroll
    for (int t = 0; t < 2; ++t) { const int n0 = n0a + 16 * t; fn[t] = swz(n0 + fr, fq * 16); orm[t] = swz(m0 + fr, 2 * (n0 + 4 * fq)); otr[t] = swz(n0 + fr, 2 * (m0 + 4 * fq)); }
    for (int unit = blockIdx.x; unit < BATCH * NH; unit += nwg) {
        const int b = unit >> 3, h = unit & 7; const int cb = 64 * h + 8 * dg;
        f32x4 sacc[2]; sacc[0] = (f32x4){0.f, 0.f, 0.f, 0.f}; sacc[1] = sacc[0];
        for (int u = tid; u < SLOT / 4; u += NWAVES * 64) ((LAS unsigned*)RSL(4))[u] = 0u;
        float lnw[8], lnb[8]; ld8f(A.ln_w + cb, lnw); ld8f(A.ln_b + cb, lnb);
        struct Nx { v4u vb, g; u32x2g p1[2], gt[2], y0[2], h[2]; f32x4 ge[2]; };
        Nx nA, nB;
#define P6B_LOAD(cc, N) do { const int job_ = unit * 32 + (cc); const size_t jo_ = (size_t)job_ * 4096; const size_t grow_ = (size_t)b * SEQ + (cc) * 64 + tok; \
            _Pragma("unroll") for (int t = 0; t < 2; ++t) { N.y0[t] = *(const u32x2g*)(X.Y0 + jo_ + ((w * 2 + t) * 64 + lane) * 4); N.h[t] = *(const u32x2g*)(X.H + jo_ + ((w * 2 + t) * 64 + lane) * 4); \
                N.p1[t] = *(const u32x2g*)(X.P1 + jo_ + ((w * 2 + t) * 64 + lane) * 4); N.gt[t] = *(const u32x2g*)(X.GT + jo_ + ((w * 2 + t) * 64 + lane) * 4); \
                N.ge[t] = *(const f32x4*)(X.GE + (size_t)job_ * 64 + n0a + 16 * t + 4 * fq); } \
            const bf16* vbp_ = (job_ < 2048) ? (X.VB0 + jo_) : (X.VB1 + (jo_ - (size_t)2048 * 4096)); \
            N.vb = *(const v4u*)(vbp_ + tok * 64 + 8 * dg); N.g = *(const v4u*)(X.G + jo_ + tok * 64 + 8 * dg); } while (0)
#define P6B_OUT(par, vbw_, gw_, grow_) do { float y[8]; ld8l(Yf0 + (par) * (64 * YLD) + tok * YLD + 8 * dg, y); \
            const float g[8] = {bflo(gw_.x), bfhi(gw_.x), bflo(gw_.y), bfhi(gw_.y), bflo(gw_.z), bfhi(gw_.z), bflo(gw_.w), bfhi(gw_.w)}; \
            const float vb[8] = {bflo(vbw_.x), bfhi(vbw_.x), bflo(vbw_.y), bfhi(vbw_.y), bflo(vbw_.z), bfhi(vbw_.z), bflo(vbw_.w), bfhi(vbw_.w)}; \
            float s_ = 0.f; _Pragma("unroll") for (int j = 0; j < 8; ++j) s_ += y[j]; \
            const float mean = sum8(s_) * (1.0f / 64.0f); float q_ = 0.f; \
            _Pragma("unroll") for (int j = 0; j < 8; ++j) { y[j] -= mean; q_ += y[j] * y[j]; } \
            const float rstd = __builtin_amdgcn_rsqf(sum8(q_) * (1.0f / 64.0f) + LNX_EPS); float ov[8]; \
            _Pragma("unroll") for (int j = 0; j < 8; ++j) ov[j] = (y[j] * rstd * lnw[j] + lnb[j] + vb[j]) * g[j]; \
            v4u wv_; wv_.x = pkbf(ov[0], ov[1]); wv_.y = pkbf(ov[2], ov[3]); wv_.z = pkbf(ov[4], ov[5]); wv_.w = pkbf(ov[6], ov[7]); \
            *(GAS v4u*)(A.QO + (grow_) * D + 512 + cb) = wv_; } while (0)
        v4u p_vb = (v4u){0u, 0u, 0u, 0u}, p_g = p_vb; size_t p_row = 0;
#define P6B_STEP(c, N) do { const int par = (c) & 1, scur = 4 + par, snxt = 5 - par; const size_t grow = (size_t)b * SEQ + (c) * 64 + tok; \
            _Pragma("unroll") for (int t = 0; t < 2; ++t) { *(LAS u32x2g*)(RSL(par) + orm[t]) = N.p1[t]; *(LAS u32x2g*)(RSL(2 + par) + otr[t]) = N.gt[t]; } \
            f32x4 yacc[2], hcur[2], gecur[2]; \
            _Pragma("unroll") for (int t = 0; t < 2; ++t) { yacc[t] = (f32x4){bflo(N.y0[t].x), bfhi(N.y0[t].x), bflo(N.y0[t].y), bfhi(N.y0[t].y)}; hcur[t] = (f32x4){bflo(N.h[t].x), bfhi(N.h[t].x), bflo(N.h[t].y), bfhi(N.h[t].y)}; gecur[t] = N.ge[t]; } \
            const v4u vbw = N.vb, gw = N.g; \
            if ((c) + 2 < SEQ / 64) P6B_LOAD((c) + 2, N); \
            LBAR(); \
            {   const Fr2 aP1 = ldf(RSL(par), fm), aS = ldf(RSL(scur), fm); Fr2 bS[2], bG[2]; \
                _Pragma("unroll") for (int t = 0; t < 2; ++t) { bS[t] = ldf(RSL(scur), fn[t]); bG[t] = ldf(RSL(2 + par), fn[t]); } \
                _Pragma("unroll") for (int t = 0; t < 2; ++t) { yacc[t] = mm<true>(aP1, bS[t], yacc[t]); sacc[t] = mm<true>(aS, bG[t], sacc[t] * gecur[t] + hcur[t]); } \
                _Pragma("unroll") for (int t = 0; t < 2; ++t) { const int n0 = n0a + 16 * t; *(LAS f32x4*)(Yf0 + par * (64 * YLD) + (m0 + fr) * YLD + n0 + 4 * fq) = yacc[t]; st4(RSL(snxt), orm[t], sacc[t]); } } \
            if ((c) > 0) P6B_OUT(par ^ 1, p_vb, p_g, p_row);                    \
            p_vb = vbw; p_g = gw; p_row = grow; } while (0)
        P6B_LOAD(0, nA); P6B_LOAD(1, nB);
        for (int c = 0; c < SEQ / 64; c += 2) {
            P6B_STEP(c, nA);
            P6B_STEP(c + 1, nB);
        }
#undef P6B_STEP
        LBAR();
        P6B_OUT(1, p_vb, p_g, p_row);
#undef P6B_LOAD
#undef P6B_OUT
        LBAR();
    }
}

namespace sba {
using bf16x8 = __attribute__((ext_vector_type(8))) short;
using s16x4 = __attribute__((ext_vector_type(4))) short;
using f32x16 = __attribute__((ext_vector_type(16))) float;
using u32x4 = __attribute__((ext_vector_type(4))) unsigned;
constexpr int QB = 256, KVBLK = 64;
constexpr int LDS_K = 0, LDS_V = 16384, LDS_ST = 32768, ST_LD = 68, LDS_FLAG = LDS_ST + 8 * 32 * ST_LD * 4, LDS_BYTES_ATT = LDS_FLAG + 64;
constexpr float R_DEAD = -160.0f;
#define SBAR() __builtin_amdgcn_sched_barrier(0)
typedef float f32x2_t __attribute__((ext_vector_type(2))); typedef __bf16 bf16x2_t __attribute__((ext_vector_type(2)));
__device__ __forceinline__ unsigned cvtpk_s(float lo, float hi) { f32x2_t v = {lo, hi}; bf16x2_t b = __builtin_convertvector(v, bf16x2_t); return __builtin_bit_cast(unsigned, b); }
__device__ __forceinline__ void qkt(f32x16& p0, f32x16& p1, const char* Kslot, const bf16x8* qr, int r32, int hi) {
    const char* kb = Kslot + hi * 1024 + r32 * 16;
    const f32x16 z = f32x16{};
#pragma unroll
    for (int d0 = 0; d0 < 4; ++d0) {
        const bf16x8 b0 = *reinterpret_cast<const bf16x8*>(kb + d0 * 2048);
        const bf16x8 b1 = *reinterpret_cast<const bf16x8*>(kb + d0 * 2048 + 512);
        if (d0 == 0) { p0 = __builtin_amdgcn_mfma_f32_32x32x16_bf16(b0, qr[0], z, 0, 0, 0); p1 = __builtin_amdgcn_mfma_f32_32x32x16_bf16(b1, qr[0], z, 0, 0, 0); }
        else { p0 = __builtin_amdgcn_mfma_f32_32x32x16_bf16(b0, qr[d0], p0, 0, 0, 0); p1 = __builtin_amdgcn_mfma_f32_32x32x16_bf16(b1, qr[d0], p1, 0, 0, 0); }
    }
}
__device__ __forceinline__ void pv(f32x16* o, int vb, bf16x8 pa0, bf16x8 pa1, bf16x8 pa2, bf16x8 pa3) {
#pragma unroll
    for (int d0 = 0; d0 < 2; ++d0) { s16x4 lo[4], hi[4];
#pragma unroll
        for (int ks = 0; ks < 4; ++ks) {
            asm volatile("ds_read_b64_tr_b16 %0,%1 offset:%c2" : "=&v"(lo[ks]) : "v"(vb), "i"(d0 * 4096 + ks * 1024) : "memory");
            asm volatile("ds_read_b64_tr_b16 %0,%1 offset:%c2" : "=&v"(hi[ks]) : "v"(vb), "i"(d0 * 4096 + ks * 1024 + 512) : "memory"); }
        asm volatile("s_waitcnt lgkmcnt(0)" ::: "memory"); SBAR();
#define PK(k) (bf16x8){lo[k][0], lo[k][1], lo[k][2], lo[k][3], hi[k][0], hi[k][1], hi[k][2], hi[k][3]}
        o[d0] = __builtin_amdgcn_mfma_f32_32x32x16_bf16(pa0, PK(0), o[d0], 0, 0, 0);
        o[d0] = __builtin_amdgcn_mfma_f32_32x32x16_bf16(pa1, PK(1), o[d0], 0, 0, 0);
        o[d0] = __builtin_amdgcn_mfma_f32_32x32x16_bf16(pa2, PK(2), o[d0], 0, 0, 0);
        o[d0] = __builtin_amdgcn_mfma_f32_32x32x16_bf16(pa3, PK(3), o[d0], 0, 0, 0);
#undef PK
    }
}
__device__ __forceinline__ float swap_sum(float x, float& other_if_lo, int hi) {
    auto rr = __builtin_amdgcn_permlane32_swap(__float_as_uint(x), __float_as_uint(x), false, false);
    const float a = __uint_as_float(rr[0]), b = __uint_as_float(rr[1]);
    other_if_lo = hi ? 0.f : b;
    return a + b;
}
__device__ __forceinline__ float swap_prod(float x, float& other_if_lo, int hi) {
    auto rr = __builtin_amdgcn_permlane32_swap(__float_as_uint(x), __float_as_uint(x), false, false);
    const float a = __uint_as_float(rr[0]), b = __uint_as_float(rr[1]);
    other_if_lo = hi ? 1.0f : b;
    return a * b;
}
__device__ __forceinline__ void attn_wave_unit(int b, int h, int qblk, bf16* QO, const bf16* __restrict__ KB, const bf16* __restrict__ VB, const float* gout, char* wsm  ) {
    const int lane = threadIdx.x & 63, r32 = lane & 31, hi = lane >> 5;
    const long rowbase = (long)b * SEQ; const int q0 = qblk * 32;
    bf16* Qw = QO + (rowbase + q0) * D + h * HD;
    const bf16* Kh = KB + rowbase * SBW + h * HD; const bf16* Vh = VB + rowbase * SBW + h * HD;
    const unsigned lds0 = (unsigned)(uintptr_t)wsm;
    const int jtop = (q0 + 30) >> 6;
    const bf16* vsrc = Vh + (long)(lane >> 3) * SBW + (lane & 7) * 8;
    const int vdst0 = ((lane & 7) >> 2) * 4096 + ((lane >> 3) & 15) * 64 + (lane & 3) * 16;
    const int vb0 = (int)lds0 + ((lane >> 4) & 1) * 32 + (lane & 3) * 8 + (4 * hi + ((lane & 15) >> 2)) * 64;
    const bf16* ksrc = Kh + (long)r32 * SBW + hi * 8;
    bf16x8 qr[4];
#pragma unroll
    for (int d0 = 0; d0 < 4; ++d0) qr[d0] = *reinterpret_cast<const bf16x8*>(&Qw[(long)r32 * D + d0 * 16 + hi * 8]);
    bf16x8 kf[8]; u32x4 vr[8];
#define SBA_LOAD(t) do { const bf16* kp_ = ksrc + (long)(t) * KVBLK * SBW; const bf16* vp_ = vsrc + (long)(t) * KVBLK * SBW; \
        _Pragma("unroll") for (int d0 = 0; d0 < 4; ++d0) { kf[2 * d0] = *reinterpret_cast<const bf16x8*>(kp_ + d0 * 16); kf[2 * d0 + 1] = *reinterpret_cast<const bf16x8*>(kp_ + 32 * SBW + d0 * 16); } \
        _Pragma("unroll") for (int i = 0; i < 8; ++i) vr[i] = *(const u32x4*)(vp_ + (long)(8 * i) * SBW); } while (0)
    SBA_LOAD(jtop);
    float R = 0.f; f32x16 o[2]; o[0] = f32x16{}; o[1] = f32x16{};
    const int qrow = q0 + r32;
    for (int jt = jtop; jt >= 0; --jt) {
        const int cur = (jtop - jt) & 1;
#pragma unroll
        for (int i = 0; i < 8; ++i) *(u32x4*)(wsm + cur * 8192 + vdst0 + (i >> 1) * 1024 + (i & 1) * 512) = vr[i];
        f32x16 p0, p1;
        {   const f32x16 z = f32x16{};
            p0 = __builtin_amdgcn_mfma_f32_32x32x16_bf16(kf[0], qr[0], z, 0, 0, 0); p1 = __builtin_amdgcn_mfma_f32_32x32x16_bf16(kf[1], qr[0], z, 0, 0, 0);
#pragma unroll
            for (int d0 = 1; d0 < 4; ++d0) { p0 = __builtin_amdgcn_mfma_f32_32x32x16_bf16(kf[2 * d0], qr[d0], p0, 0, 0, 0); p1 = __builtin_amdgcn_mfma_f32_32x32x16_bf16(kf[2 * d0 + 1], qr[d0], p1, 0, 0, 0); } }
        if (jt > 0) SBA_LOAD(jt - 1);
        const int kb = 64 * jt + 4 * hi; const bool diag = (jt == jtop);
#pragma unroll
        for (int r = 0; r < 16; ++r) {
            { float rr = __builtin_amdgcn_rcpf(1.0f + __builtin_amdgcn_exp2f(p0[r]));
              if (diag) { const int key = kb + (r & 3) + 8 * (r >> 2); if (key >= qrow) rr = 1.0f; }
              p0[r] = rr; }
            { float rr = __builtin_amdgcn_rcpf(1.0f + __builtin_amdgcn_exp2f(p1[r]));
              if (diag) { const int key = kb + 32 + (r & 3) + 8 * (r >> 2); if (key >= qrow) rr = 1.0f; }
              p1[r] = rr; }
        }
        float c0[4], c1[4], x0[4], x1[4];
#pragma unroll
        for (int g = 0; g < 4; ++g) {
            const float s0 = (p0[4 * g] * p0[4 * g + 1]) * (p0[4 * g + 2] * p0[4 * g + 3]);
            const float s1 = (p1[4 * g] * p1[4 * g + 1]) * (p1[4 * g + 2] * p1[4 * g + 3]);
            c0[g] = swap_prod(s0, x0[g], hi); c1[g] = swap_prod(s1, x1[g], hi);
        }
        const float Cr = __builtin_amdgcn_exp2f(R);
        float suf0[4], suf1[4];
        suf1[3] = Cr; suf1[2] = suf1[3] * c1[3]; suf1[1] = suf1[2] * c1[2]; suf1[0] = suf1[1] * c1[1];
        suf0[3] = suf1[0] * c1[0]; suf0[2] = suf0[3] * c0[3]; suf0[1] = suf0[2] * c0[2]; suf0[0] = suf0[1] * c0[1];
        R += __builtin_amdgcn_logf(((c0[0] * c0[1]) * (c0[2] * c0[3])) * ((c1[0] * c1[1]) * (c1[2] * c1[3])));
#pragma unroll
        for (int g = 0; g < 4; ++g) {
            { const float e3 = suf0[g] * x0[g], e2 = e3 * p0[4 * g + 3], e1 = e2 * p0[4 * g + 2], e0 = e1 * p0[4 * g + 1];
              p0[4 * g + 3] = (1.0f - p0[4 * g + 3]) * e3; p0[4 * g + 2] = (1.0f - p0[4 * g + 2]) * e2; p0[4 * g + 1] = (1.0f - p0[4 * g + 1]) * e1; p0[4 * g] = (1.0f - p0[4 * g]) * e0; }
            { const float e3 = suf1[g] * x1[g], e2 = e3 * p1[4 * g + 3], e1 = e2 * p1[4 * g + 2], e0 = e1 * p1[4 * g + 1];
              p1[4 * g + 3] = (1.0f - p1[4 * g + 3]) * e3; p1[4 * g + 2] = (1.0f - p1[4 * g + 2]) * e2; p1[4 * g + 1] = (1.0f - p1[4 * g + 1]) * e1; p1[4 * g] = (1.0f - p1[4 * g]) * e0; }
        }
#define PKW(P, B) cvtpk_s(P[B], P[B + 1])
        const u32x4 pw0 = (u32x4){PKW(p0, 0), PKW(p0, 2), PKW(p0, 4), PKW(p0, 6)}, pw1 = (u32x4){PKW(p0, 8), PKW(p0, 10), PKW(p0, 12), PKW(p0, 14)};
        const u32x4 pw2 = (u32x4){PKW(p1, 0), PKW(p1, 2), PKW(p1, 4), PKW(p1, 6)}, pw3 = (u32x4){PKW(p1, 8), PKW(p1, 10), PKW(p1, 12), PKW(p1, 14)};
#undef PKW
        SBAR();
        asm volatile("s_waitcnt lgkmcnt(0)" ::: "memory");
        pv(o, vb0 + cur * 8192, __builtin_bit_cast(bf16x8, pw0), __builtin_bit_cast(bf16x8, pw1), __builtin_bit_cast(bf16x8, pw2), __builtin_bit_cast(bf16x8, pw3));
        if (__all(R < R_DEAD)) break;
    }
#undef SBA_LOAD
    {
        float* stg = (float*)wsm;
        asm volatile("s_waitcnt lgkmcnt(0)" ::: "memory");
#pragma unroll
        for (int r = 0; r < 16; ++r) { const int orow = (r & 3) + 8 * (r >> 2) + 4 * hi;
#pragma unroll
            for (int d0 = 0; d0 < 2; ++d0) stg[orow * ST_LD + d0 * 32 + r32] = o[d0][r]; }
        asm volatile("s_waitcnt lgkmcnt(0)" ::: "memory");
        const int ch = lane & 7;
        const f32x4 ga = *(const f32x4*)(gout + h * HD + ch * 8), gb = *(const f32x4*)(gout + h * HD + ch * 8 + 4);
#pragma unroll
        for (int i = 0; i < 4; ++i) { const int row = i * 8 + (lane >> 3);
            const f32x4 a = *(const f32x4*)(stg + row * ST_LD + ch * 8), c = *(const f32x4*)(stg + row * ST_LD + ch * 8 + 4);
            float ss = (a.x * a.x + a.y * a.y) + (a.z * a.z + a.w * a.w) + (c.x * c.x + c.y * c.y) + (c.z * c.z + c.w * c.w);
            ss = sum8(ss);
            const float hs = __builtin_amdgcn_rsqf(ss * (1.0f / 64.0f) + 1e-6f);
            u32x4 w; w.x = cvtpk_s(a.x * hs * ga.x, a.y * hs * ga.y); w.y = cvtpk_s(a.z * hs * ga.z, a.w * hs * ga.w);
            w.z = cvtpk_s(c.x * hs * gb.x, c.y * hs * gb.y); w.w = cvtpk_s(c.z * hs * gb.z, c.w * hs * gb.w);
            *(u32x4*)(Qw + (long)row * D + ch * 8) = w; }
        asm volatile("s_waitcnt lgkmcnt(0)" ::: "memory");
    }
}
#undef SBAR
__device__ __forceinline__ void attn_phase(Frame& F, bf16* QO, const bf16* KB, const bf16* VB, const float* gout, unsigned* queue, int first_ticket, int ticket_base) {
    char* wsm = (char*)F.lds + RING_OFF + F.wave * 16384;
    const int nunits = BATCH * NH * (SEQ / 32);
    int pend = -1; int tfirst = first_ticket;
    for (;;) {
        int uu;
        if (pend >= 0) { uu = pend; pend = -1; }
        else { unsigned t;
               if (tfirst >= 0) { t = (unsigned)tfirst; tfirst = -1; }
               else { t = 0u; if (F.lane == 0) t = __hip_atomic_fetch_add(queue, 1u, __ATOMIC_RELAXED, __HIP_MEMORY_SCOPE_AGENT); t = (unsigned)__builtin_amdgcn_readfirstlane((int)t) + (unsigned)ticket_base; }
               if (2u * t >= (unsigned)nunits) break; uu = (int)(2u * t); pend = uu + 1; }
        attn_wave_unit(uu >> 9, (uu >> 6) & 7, uu & 63, QO, KB, VB, gout, wsm);
    }
    __syncthreads();
}
}

struct Args { const float* in[26]; float* out; unsigned char* ws; int ph_lo, ph_hi, li, pad; };
__global__ void __launch_bounds__(NWAVES * 64, 2) skel_fwd(Args args) {
    extern __shared__ __attribute__((aligned(16))) unsigned char lds[];
    Frame F;
    F.lds = (LAS unsigned char*)lds;
    F.MISC = (volatile LAS unsigned*)(F.lds + MISC_OFF);
    F.tid = threadIdx.x; F.lane = F.tid & 63; F.wave = __builtin_amdgcn_readfirstlane(F.tid >> 6);
    F.G = gridDim.x; { const int bx = blockIdx.x; F.vcu = (F.G % 8 == 0) ? (bx % 8) * (F.G / 8) + bx / 8 : bx; }
    unsigned char* ws = args.ws;
    F.ctl = (gu32*)(ws + WS_CTL);
    const float* x = args.in[0];
    bf16* W1U = (bf16*)(ws + WS_W1U); bf16* W1D = (bf16*)(ws + WS_W1D); bf16* W2U = (bf16*)(ws + WS_W2U); bf16* W2D = (bf16*)(ws + WS_W2D);
    bf16* WIN = (bf16*)(ws + WS_WIN); bf16* WOUT = (bf16*)(ws + WS_WOUT); bf16* WLORA = (bf16*)(ws + WS_WLORA);
    bf16* XB = (bf16*)(ws + WS_XB); bf16* ACT = (bf16*)(ws + WS_ACT); bf16* QO = (bf16*)(ws + WS_QO); bf16* KB = (bf16*)(ws + WS_KB); bf16* VB = (bf16*)(ws + WS_VB);
    bf16* RW = (bf16*)(ws + WS_RW); bf16* ALORA = (bf16*)(ws + WS_ALORA); float* LW = (float*)(ws + WS_LW); bf16* AB = (bf16*)(ws + WS_AB); bf16* GB = (bf16*)(ws + WS_GB);
    float* SSQ = (float*)(ws + WS_SSQ); float* out = args.out;
    for (int u = F.tid; u < (LDS_BYTES - LDSCTL_OFF) / 4; u += NWAVES * 64) ((LAS unsigned*)(F.lds + LDSCTL_OFF))[u] = 0u;
    __syncthreads();
    XcdBarrier bar; bar.bar = (unsigned*)(F.ctl + CW_BAR); bar.x = 0; bar.st = nullptr;
    if (N_LAUNCHES != PER_PHASE) bar = xcd_barrier_post((unsigned*)(F.ctl + CW_BAR), F.MISC + 8);
#define GRID_BAR(seam) do { if (N_LAUNCHES == PER_PHASE) { if (F.tid == 0) __hip_atomic_store(F.ctl + CW_TMO, 0xBADBA0u | (unsigned)(seam), RLX_AGENT); } else { xcd_barrier(bar); } } while (0)
    const int lo = args.ph_lo, hi = args.ph_hi;
#define IN(k) (lo <= (k) && (k) < hi)
#define BOTH(k) (IN(k) && IN((k) + 1))
    if (IN(0)) {
        p0_prologue(F, x, args.in[1], args.in[2], args.in[3], args.in[4], args.in[5], args.in[6], args.in[12], args.in[14], args.in[15], args.in[21], args.in[22], args.in[23], args.in[24], args.in[25],
                    W1U, W1D, W2U, W2D, WIN, WOUT, WLORA, XB, SSQ); if (BOTH(0)) GRID_BAR(0);
    }
    if (IN(1)) {
        pg8::Gemm g{XB, W1U, M, 2 * FF, D}; pg8::StaticOrder S; S.init(M, 2 * FF, F.G, (int)blockIdx.x);
        pg8::EpiSwiGLU E{ACT, FF, SSQ};
        pg8::gemm_phase<pg8::EpiSwiGLU, pg8::StaticOrder, true, true>(F.lds + RING_OFF, g, S, E);
        if (BOTH(1)) GRID_BAR(1);
    }
    if (IN(2)) {
        pg8::Gemm g{ACT, W1D, M, D, FF}; pg8::StaticOrder S; S.init(M, D, F.G, (int)blockIdx.x);
        pg8::EpiResid E{XB, nullptr, XB, SSQ, 0.5f, 1};
        pg8::gemm_phase<pg8::EpiResid, pg8::StaticOrder, true, true>(F.lds + RING_OFF, g, S, E);
        if (BOTH(2)) GRID_BAR(2);
    }
    if (IN(3)) {
        pg8::Gemm g{XB, WIN, M, PW, D}; pg8::StaticOrder S; S.init(M, PW, F.G, (int)blockIdx.x);
        pg8::EpiWin E{QO, KB, VB, RW, SSQ, args.in[7], args.in[8], 0.125f * 1.4426950408889634f};
        pg8::gemm_phase<pg8::EpiWin, pg8::StaticOrder, true, true>(F.lds + RING_OFF, g, S, E);
        if (F.G >= 256) {
            const int nlo = (M / 256) * (PW / 256) - 6 * F.G;
            if ((int)blockIdx.x >= nlo) { __syncthreads();
                p0_items(F, x, args.in[1], args.in[2], args.in[3], args.in[4], args.in[5], args.in[6], args.in[12], args.in[14], args.in[15], args.in[21], args.in[22], args.in[23], args.in[24], args.in[25],
                         W1U, W1D, W2U, W2D, WIN, WOUT, WLORA, XB, SSQ, 1, ((int)blockIdx.x - nlo) * NWAVES + F.wave, (F.G - nlo) * NWAVES); }
        }
        if (BOTH(3)) GRID_BAR(3);
    }
    if (IN(6)) {
        RwArgs A{RW, WLORA, WLORA + 512 * 64, WLORA + 2 * 512 * 64, args.in[11], args.in[13], QO, args.in[10], args.in[16], args.in[17], args.in[18], args.in[19], args.in[20]};
        bf16* ob = (bf16*)out;
        RwX X{ob + (size_t)32 * 1024 * 1024, ob + (size_t)48 * 1024 * 1024, (bf16*)LW, (bf16*)LW + (size_t)16 * 1024 * 1024, AB, AB + (size_t)8 * 1024 * 1024, SSQ, GB};
        p6a_rwkv_local(F, A, X);
        GRID_BAR(16);
        const int nseq = (F.G >= 2 * BATCH * NH) ? BATCH * NH : F.G;
        if ((int)blockIdx.x < nseq) { p6b_rwkv_seq(F, A, X, nseq); __syncthreads(); }
        const int nfree = (F.G - nseq) * NWAVES;
        sba::attn_phase(F, QO, KB, VB, args.in[9], (unsigned*)(F.ctl + CW_QUEUE), ((int)blockIdx.x >= nseq) ? ((int)blockIdx.x - nseq) * NWAVES + F.wave : -1, nfree);
        if (BOTH(6)) GRID_BAR(6);
    }
    if (IN(8)) {
        pg8::Gemm g{QO, WOUT, M, D, D}; pg8::StaticOrder S; S.init(M, D, F.G, (int)blockIdx.x);
        pg8::EpiResid E{XB, nullptr, XB, SSQ, 1.0f, 1};
        pg8::gemm_phase<pg8::EpiResid, pg8::StaticOrder, true, true>(F.lds + RING_OFF, g, S, E);
        if (BOTH(8)) GRID_BAR(8);
    }
    if (IN(9)) {
        pg8::Gemm g{XB, W2U, M, 2 * FF, D}; pg8::StaticOrder S; S.init(M, 2 * FF, F.G, (int)blockIdx.x);
        pg8::EpiSwiGLU E{ACT, FF, SSQ};
        pg8::gemm_phase<pg8::EpiSwiGLU, pg8::StaticOrder, true, true>(F.lds + RING_OFF, g, S, E);
        if (BOTH(9)) GRID_BAR(9);
    }
    if (IN(10)) {
        pg8::Gemm g{ACT, W2D, M, D, FF}; pg8::StaticOrder S; S.init(M, D, F.G, (int)blockIdx.x);
        pg8::EpiResid E{XB, out, nullptr, SSQ, 0.5f, 0};
        pg8::gemm_phase<pg8::EpiResid, pg8::StaticOrder, true, true>(F.lds + RING_OFF, g, S, E);
    }
#undef IN
#undef BOTH
}

extern "C" void kernel_launch(void* const* d_in, const int* in_sizes, int n_in, void* d_out, int out_size, void* d_ws, size_t ws_size, hipStream_t stream) {
    static int grid = 0;
    if (grid == 0) {
        if (n_in != 26 || in_sizes[0] != M * D || out_size != M * D || ws_size < WS_END) { fprintf(stderr, "kernel_launch: unexpected shapes: n_in %d in0 %d out %d ws %zu (need %zu)\n", n_in, n_in > 0 ? in_sizes[0] : -1, out_size, ws_size, (size_t)WS_END); grid = -1; return; }
        int dev = 0, cus = 0, per_cu = 0;
        if (hipGetDevice(&dev) != hipSuccess || hipDeviceGetAttribute(&cus, hipDeviceAttributeMultiprocessorCount, dev) != hipSuccess) { grid = -1; return; }
        if (hipFuncSetAttribute((const void*)skel_fwd, hipFuncAttributeMaxDynamicSharedMemorySize, LDS_BYTES) != hipSuccess) { fprintf(stderr, "kernel_launch: hipFuncSetAttribute failed\n"); grid = -1; return; }
        if (hipOccupancyMaxActiveBlocksPerMultiprocessor(&per_cu, (const void*)skel_fwd, NWAVES * 64, LDS_BYTES) != hipSuccess || per_cu < 1) { fprintf(stderr, "kernel_launch: occupancy query reports %d blocks per CU\n", per_cu); per_cu = 1; }
        (void)hipGetLastError();
        grid = cus;
    }
    if (grid < 0) return;
    if (hipMemsetAsync((char*)d_ws + WS_CTL, 0, CTL_ZERO_BYTES, stream) != hipSuccess) return;
    Args a{};
    for (int i = 0; i < 26; ++i) a.in[i] = (const float*)d_in[i];
    a.out = (float*)d_out; a.ws = (unsigned char*)d_ws;
    for (int li = 0; li < N_LAUNCHES; ++li) {
        a.ph_lo = (N_LAUNCHES == PER_PHASE) ? li : 0; a.ph_hi = (N_LAUNCHES == PER_PHASE) ? li + 1 : PER_PHASE; a.li = li;
        hipLaunchKernelGGL(skel_fwd, dim3(grid), dim3(NWAVES * 64), LDS_BYTES, stream, a);
    }
}
```

```cpp
#include <hip/hip_runtime.h>
#include <hip/hip_bf16.h>
#include <cstdio>
#include <cstdint>
#include <cmath>
namespace pg8 {
#define PG8_LAS __attribute__((address_space(3)))
typedef unsigned short bf16_t;
typedef short bf16x8 __attribute__((ext_vector_type(8)));
typedef float f32x4 __attribute__((ext_vector_type(4)));
typedef unsigned u32x4 __attribute__((ext_vector_type(4)));
constexpr int BM = 256, BK = 64, HALF = 128, HTB = HALF * BK * 2  , STAGE_BYTES = 8 * HTB, NXCD = 8, WGM = 4;

__host__ __device__ __forceinline__ int lds_byte(int r, int c) { const int st = (r >> 4) * 2 + (c >> 5), rr = r & 15, cc = c & 31, ob = rr * 64 + cc * 2; return st * 1024 + (ob ^ (((ob >> 9) & 1) << 5)); }
__host__ __device__ __forceinline__ void stage_rc(int b, int& R, int& C) { const int st = b / 1024, sb = b % 1024, swz = sb ^ (((sb >> 9) & 1) << 5); R = (st >> 1) * 16 + swz / 64; C = (st & 1) * 32 + (swz % 64) / 2; }
__host__ __device__ __forceinline__ int perm32(int rho) { const int n = rho >> 4, i = rho & 15; return 8 * (i >> 2) + 4 * n + (i & 3); }

struct Unit { int pm, pn; };
struct Gemm { const bf16_t* A; const bf16_t* Bt; int M, N, K; int ld; };

struct StaticOrder {
    int nM, nN, nwg, G, c;
    __host__ __device__ void init(int M, int N, int G_, int c_) { nM = M / BM; nN = N / BM; nwg = nM * nN; G = G_; c = c_; }
    __host__ __device__ bool next(int i, Unit& u) const {
        const long L = (long)i * G + c; if (L >= nwg) return false;
        int wgid = (int)L; { const int q = nwg / NXCD, r = nwg % NXCD, xcd = wgid % NXCD, off = wgid / NXCD; wgid = (xcd < r ? xcd * (q + 1) : r * (q + 1) + (xcd - r) * q) + off; }
        const int nig = WGM * nN, gid = wgid / nig, fm = gid * WGM, gsz = (nM - fm) < WGM ? (nM - fm) : WGM;
        u.pm = fm + ((wgid % nig) % gsz); u.pn = (wgid % nig) / gsz; return true;
    }
    __device__ __forceinline__ void a_ready(const Unit&) const {}
    __device__ __forceinline__ void done(const Unit&) const {}
};


__device__ __forceinline__ unsigned cvt_pk_bf16(float lo, float hi) { unsigned r; asm volatile("v_cvt_pk_bf16_f32 %0, %1, %2" : "=v"(r) : "v"(lo), "v"(hi)); return r; }
typedef unsigned u32x2 __attribute__((ext_vector_type(2)));
constexpr float RMS_EPS_F = 1e-6f;
constexpr float LOG2E_F = 1.4426950408889634f;
__device__ __forceinline__ f32x4 row_q(const float* ssqp, int row, int fq) { return *(const f32x4*)(ssqp + (size_t)row * 16 + 4 * fq); }
__device__ __forceinline__ float rs_fin(const f32x4 q) {
    float s = (q[0] + q[1]) + (q[2] + q[3]);
    auto a = __builtin_amdgcn_permlane16_swap(__float_as_uint(s), __float_as_uint(s), false, false); s = __uint_as_float(a[0]) + __uint_as_float(a[1]);
    auto b = __builtin_amdgcn_permlane32_swap(__float_as_uint(s), __float_as_uint(s), false, false); s = __uint_as_float(b[0]) + __uint_as_float(b[1]);
    return __builtin_amdgcn_rsqf(s * (1.0f / 1024.0f) + RMS_EPS_F);
}
__device__ __forceinline__ float silu_f(float g) { return g * __builtin_amdgcn_rcpf(1.0f + __builtin_amdgcn_exp2f(-g * LOG2E_F)); }
__device__ __forceinline__ float sigmoid_f(float g) { return __builtin_amdgcn_rcpf(1.0f + __builtin_amdgcn_exp2f(-g * LOG2E_F)); }

struct EpiSwiGLU {
    static constexpr bool PERM = true, AFTER_DRAIN = false;
    bf16_t* O; int ldo; const float* ssqp;
    __device__ __forceinline__ static f32x4 swiglu4(const f32x4 g, const f32x4 uu, float nrs, float rs2) {
        const f32x4 t = g * nrs, gu = g * uu; f32x4 r;
#pragma unroll
        for (int i = 0; i < 4; ++i) r[i] = __builtin_amdgcn_rcpf(1.0f + __builtin_amdgcn_exp2f(t[i]));
        return gu * (r * rs2);
    }
    __device__ __forceinline__ void operator()(const f32x4 (&acc)[2][2][4][2], const Unit& u, int wr, int wc, int fr, int fq) const {
        const int row0 = u.pm * BM + wr * 64 + fr, col0 = u.pn * HALF + wc * 32 + 8 * fq;
        f32x4 q[2][4];
#pragma unroll
        for (int ai = 0; ai < 2; ++ai)
#pragma unroll
            for (int m = 0; m < 4; ++m) q[ai][m] = row_q(ssqp, row0 + ai * HALF + m * 16, fq);
        float rsv[2][4];
#pragma unroll
        for (int ai = 0; ai < 2; ++ai)
#pragma unroll
            for (int m = 0; m < 4; ++m) rsv[ai][m] = rs_fin(q[ai][m]);
#pragma unroll
        for (int ai = 0; ai < 2; ++ai)
#pragma unroll
            for (int m = 0; m < 4; ++m) {
                const int row = row0 + ai * HALF + m * 16; const float rs = rsv[ai][m], nrs = -LOG2E_F * rs, rs2 = rs * rs;
                const f32x4 o0 = swiglu4(acc[ai][0][m][0], acc[ai][1][m][0], nrs, rs2), o1 = swiglu4(acc[ai][0][m][1], acc[ai][1][m][1], nrs, rs2);
                u32x4 w; w.x = cvt_pk_bf16(o0[0], o0[1]); w.y = cvt_pk_bf16(o0[2], o0[3]); w.z = cvt_pk_bf16(o1[0], o1[1]); w.w = cvt_pk_bf16(o1[2], o1[3]);
                *(u32x4*)(O + (size_t)row * ldo + col0) = w;
            }
    }
};

struct EpiResid {
    static constexpr bool PERM = true, AFTER_DRAIN = false;
    const bf16_t* bhi; float* outf; bf16_t* ohi; float* ssqp; float alpha; int aux;
    __device__ __forceinline__ static f32x4 up_bf(unsigned a, unsigned b) { return (f32x4){__uint_as_float(a << 16), __uint_as_float(a & 0xffff0000u), __uint_as_float(b << 16), __uint_as_float(b & 0xffff0000u)}; }
    __device__ __forceinline__ void operator()(const f32x4 (&acc)[2][2][4][2], const Unit& u, int wr, int wc, int fr, int fq) const {
        const int row0 = u.pm * BM + wr * 64 + fr, col0 = u.pn * BM + wc * 32 + 8 * fq;
        u32x4 bv[2][4][2];
#pragma unroll
        for (int ai = 0; ai < 2; ++ai)
#pragma unroll
            for (int m = 0; m < 4; ++m)
#pragma unroll
                for (int bj = 0; bj < 2; ++bj) bv[ai][m][bj] = *(const u32x4*)(bhi + (size_t)(row0 + ai * HALF + m * 16) * 1024 + col0 + bj * HALF);
        asm volatile("" ::: "memory");
#pragma unroll
        for (int ai = 0; ai < 2; ++ai)
#pragma unroll
            for (int m = 0; m < 4; ++m) {
                const int row = row0 + ai * HALF + m * 16; const size_t off = (size_t)row * 1024 + col0; float ss = 0.f;
#pragma unroll
                for (int bj = 0; bj < 2; ++bj) {
                    const u32x4 h = bv[ai][m][bj];
                    const f32x4 v0 = up_bf(h.x, h.y) + acc[ai][bj][m][0] * alpha, v1 = up_bf(h.z, h.w) + acc[ai][bj][m][1] * alpha;
                    if (aux) ss += ((v0[0] * v0[0] + v0[1] * v0[1]) + (v0[2] * v0[2] + v0[3] * v0[3])) + ((v1[0] * v1[0] + v1[1] * v1[1]) + (v1[2] * v1[2] + v1[3] * v1[3]));
                    if (outf) { *(f32x4*)(outf + off + bj * HALF) = v0; *(f32x4*)(outf + off + bj * HALF + 4) = v1; }
                    else { u32x4 w; w.x = cvt_pk_bf16(v0[0], v0[1]); w.y = cvt_pk_bf16(v0[2], v0[3]); w.z = cvt_pk_bf16(v1[0], v1[1]); w.w = cvt_pk_bf16(v1[2], v1[3]); *(u32x4*)(ohi + off + bj * HALF) = w; }
                }
                if (aux) { ss += __shfl_xor(ss, 16); ss += __shfl_xor(ss, 32); if (fq == 0) ssqp[(size_t)row * 16 + u.pn * 4 + wc] = ss; }
            }
    }
};

struct EpiWin {
    static constexpr bool PERM = true, AFTER_DRAIN = false;
    bf16_t* QO; bf16_t* KB; bf16_t* VB; bf16_t* RW; const float* ssqp; const float* gq; const float* gk; float qscale;
    __device__ __forceinline__ void operator()(const f32x4 (&acc)[2][2][4][2], const Unit& u, int wr, int wc, int fr, int fq) const {
        const int row0 = u.pm * BM + wr * 64 + fr; const int pn = u.pn;
        f32x4 q[2][4];
#pragma unroll
        for (int ai = 0; ai < 2; ++ai)
#pragma unroll
            for (int m = 0; m < 4; ++m) q[ai][m] = row_q(ssqp, row0 + ai * HALF + m * 16, fq);
        float rsv[2][4];
#pragma unroll
        for (int ai = 0; ai < 2; ++ai)
#pragma unroll
            for (int m = 0; m < 4; ++m) rsv[ai][m] = rs_fin(q[ai][m]);
        if (pn < 4) {
            const float* gp = (pn < 2) ? gq : gk; const float osc = (pn < 2) ? qscale : 1.0f;
            f32x4 gv[2][2];
#pragma unroll
            for (int bj = 0; bj < 2; ++bj)
#pragma unroll
                for (int n = 0; n < 2; ++n) gv[bj][n] = *(const f32x4*)(gp + 32 * bj + 8 * fq + 4 * n) * osc;
            bf16_t* dst = (pn < 2) ? QO : KB; const int ld = (pn < 2) ? 1024 : 512; const int colh = 64 * (4 * (pn & 1) + wc) + 8 * fq;
#pragma unroll
            for (int ai = 0; ai < 2; ++ai)
#pragma unroll
                for (int m = 0; m < 4; ++m) {
                    const int row = row0 + ai * HALF + m * 16; const float rs = rsv[ai][m];
                    f32x4 y[2][2]; float ss = 0.f;
#pragma unroll
                    for (int bj = 0; bj < 2; ++bj)
#pragma unroll
                        for (int n = 0; n < 2; ++n) { y[bj][n] = acc[ai][bj][m][n] * rs; const f32x4 t = y[bj][n]; ss += (t[0] * t[0] + t[1] * t[1]) + (t[2] * t[2] + t[3] * t[3]); }
                    ss += __shfl_xor(ss, 16); ss += __shfl_xor(ss, 32);
                    const float hs = __builtin_amdgcn_rsqf(ss * (1.0f / 64.0f) + RMS_EPS_F);
#pragma unroll
                    for (int bj = 0; bj < 2; ++bj) {
                        const f32x4 a = y[bj][0] * gv[bj][0] * hs, b = y[bj][1] * gv[bj][1] * hs;
                        u32x4 w; w.x = cvt_pk_bf16(a[0], a[1]); w.y = cvt_pk_bf16(a[2], a[3]); w.z = cvt_pk_bf16(b[0], b[1]); w.w = cvt_pk_bf16(b[2], b[3]);
                        *(u32x4*)(dst + (size_t)row * ld + colh + 32 * bj) = w;
                    }
                }
        } else {
            bf16_t* dst = (pn < 6) ? VB : RW; const int ld = (pn < 6) ? 512 : 1792; const int colh = 256 * ((pn < 6) ? (pn - 4) : (pn - 6)) + 64 * wc + 8 * fq;
#pragma unroll
            for (int ai = 0; ai < 2; ++ai)
#pragma unroll
                for (int m = 0; m < 4; ++m) {
                    const int row = row0 + ai * HALF + m * 16; const float rs = rsv[ai][m];
#pragma unroll
                    for (int bj = 0; bj < 2; ++bj) {
                        const f32x4 a = acc[ai][bj][m][0] * rs, b = acc[ai][bj][m][1] * rs;
                        u32x4 w; w.x = cvt_pk_bf16(a[0], a[1]); w.y = cvt_pk_bf16(a[2], a[3]); w.z = cvt_pk_bf16(b[0], b[1]); w.w = cvt_pk_bf16(b[2], b[3]);
                        *(u32x4*)(dst + (size_t)row * ld + colh + 32 * bj) = w;
                    }
                }
        }
    }
};

template <class Epi, class Sched, bool ALIGN_EPI = false, bool SP2 = false>
__device__ __forceinline__ void gemm_phase(PG8_LAS unsigned char* lds, const Gemm g, const Sched& S, const Epi& E) {
    const int tid = threadIdx.x, wid = __builtin_amdgcn_readfirstlane(tid >> 6), lane = tid & 63, wr = wid >> 2, wc = wid & 3, fr = lane & 15, fq = lane >> 4;
    const int K = g.K, nt = K / BK, LDP = g.ld ? g.ld : g.K;
    unsigned voffA[2], voffB[2];
#pragma unroll
    for (int i = 0; i < 2; ++i) { int R, C; stage_rc(tid * 16 + i * 8192, R, C); const int Rb = Epi::PERM ? ((R & ~31) + perm32(R & 31)) : R;
        voffA[i] = (unsigned)(R * LDP + C) * 2u; voffB[i] = (unsigned)(Rb * LDP + C) * 2u; }
    const size_t kstep = (size_t)(BK * 2);
    const size_t hstep = (size_t)HALF * LDP * 2;
    const size_t tstep = 2 * hstep;
    const unsigned ldsw = (unsigned)wid * 1024u;
    const int aoff = lds_byte(wr * 64 + fr, fq * 8), boff = lds_byte(wc * 32 + fr, fq * 8);
#define PG8_SA(b, h) (((b) * 2 + (h)) * HTB)
#define PG8_SB(b, h) ((4 + (b) * 2 + (h)) * HTB)
#define PG8_STAGE(bufoff, gbase, voff) do { _Pragma("unroll") for (int _i = 0; _i < 2; ++_i) \
        __builtin_amdgcn_global_load_lds((const unsigned*)((const char*)(gbase) + (voff)[_i]), (PG8_LAS unsigned*)(lds + (bufoff) + ldsw + _i * 8192), 16, 0, 0); } while (0)
#define PG8_LDA(dst, b, h) do { _Pragma("unroll") for (int m = 0; m < 4; ++m) _Pragma("unroll") for (int k = 0; k < 2; ++k) dst[m][k] = *(const PG8_LAS bf16x8*)(lds + PG8_SA(b, h) + aoff + m * 2048 + k * 1024); } while (0)
#define PG8_LDB(dst, b, h) do { _Pragma("unroll") for (int n = 0; n < 2; ++n) _Pragma("unroll") for (int k = 0; k < 2; ++k) dst[n][k] = *(const PG8_LAS bf16x8*)(lds + PG8_SB(b, h) + boff + n * 2048 + k * 1024); } while (0)
#define PG8_MMA(ai, bj, At, Bt) do { __builtin_amdgcn_s_setprio(1); _Pragma("unroll") for (int m = 0; m < 4; ++m) _Pragma("unroll") for (int n = 0; n < 2; ++n) _Pragma("unroll") for (int k = 0; k < 2; ++k) \
        acc[ai][bj][m][n] = __builtin_amdgcn_mfma_f32_16x16x32_bf16(Bt[n][k], At[m][k], acc[ai][bj][m][n], 0, 0, 0); __builtin_amdgcn_s_setprio(0); } while (0)
#define PG8_WAIT_V(n) asm volatile("s_waitcnt vmcnt(" #n ")" ::: "memory")
#define PG8_WAIT_L(n) asm volatile("s_waitcnt lgkmcnt(" #n ")" ::: "memory")
#define PG8_BAR __builtin_amdgcn_s_barrier()
#define PG8_SCHED __builtin_amdgcn_sched_barrier(0)
    Unit cur, nxt; int ui = 0;
    if (!S.next(0, cur)) return;
    f32x4 acc[2][2][4][2];
#pragma unroll
    for (int a = 0; a < 2; ++a)
#pragma unroll
        for (int b = 0; b < 2; ++b)
#pragma unroll
            for (int m = 0; m < 4; ++m)
#pragma unroll
                for (int n = 0; n < 2; ++n) acc[a][b][m][n] = (f32x4){0.f, 0.f, 0.f, 0.f};
    bf16x8 At[4][2], B0[2][2], B1[2][2];
    const char* cA = (const char*)g.A + (size_t)cur.pm * tstep; const char* cB = (const char*)g.Bt + (size_t)cur.pn * tstep;
    S.a_ready(cur);
    if constexpr (SP2) {
        PG8_STAGE(PG8_SB(0, 0), cB, voffB); PG8_STAGE(PG8_SB(0, 1), cB + hstep, voffB); PG8_STAGE(PG8_SA(0, 0), cA, voffA); PG8_STAGE(PG8_SA(0, 1), cA + hstep, voffA);
        if (wr == 1) PG8_BAR;
        PG8_WAIT_V(2); PG8_BAR;
        PG8_STAGE(PG8_SB(1, 0), cB + kstep, voffB); PG8_STAGE(PG8_SA(1, 0), cA + kstep, voffA); PG8_STAGE(PG8_SB(1, 1), cB + hstep + kstep, voffB);
        PG8_WAIT_V(6); PG8_BAR;
    } else {
        PG8_STAGE(PG8_SB(0, 0), cB, voffB); PG8_STAGE(PG8_SA(0, 0), cA, voffA); PG8_STAGE(PG8_SB(0, 1), cB + hstep, voffB); PG8_STAGE(PG8_SA(0, 1), cA + hstep, voffA);
        if (wr == 1) PG8_BAR;
        PG8_WAIT_V(4); PG8_BAR;
        PG8_STAGE(PG8_SB(1, 0), cB + kstep, voffB); PG8_STAGE(PG8_SA(1, 0), cA + kstep, voffA); PG8_STAGE(PG8_SB(1, 1), cB + hstep + kstep, voffB);
        PG8_WAIT_V(6); PG8_BAR;
    }
    for (;;) {
        const bool has_next = S.next(ui + 1, nxt);
        const char* nA = has_next ? (const char*)g.A + (size_t)nxt.pm * tstep : cA; const char* nB = has_next ? (const char*)g.Bt + (size_t)nxt.pn * tstep : cB;
        for (int t = 0; t < nt; t += 2) {
            const bool last = (t == nt - 2);
            const char* a1 = cA + (size_t)(t + 1) * kstep;
            const char* a2 = last ? nA : cA + (size_t)(t + 2) * kstep; const char* b2 = last ? nB : cB + (size_t)(t + 2) * kstep;
            const char* a3 = a2 + kstep; const char* b3 = b2 + kstep;
            if (last && has_next) S.a_ready(nxt);
            if constexpr (SP2) {
            PG8_LDB(B0, 0, 0); PG8_LDB(B1, 0, 1); PG8_SCHED; PG8_LDA(At, 0, 0); PG8_STAGE(PG8_SA(1, 1), a1 + hstep, voffA);
            PG8_WAIT_V(8); PG8_WAIT_L(0); PG8_BAR; PG8_MMA(0, 0, At, B0); PG8_MMA(0, 1, At, B1); PG8_BAR; PG8_SCHED;
            PG8_LDA(At, 0, 1); PG8_STAGE(PG8_SB(0, 0), b2, voffB); PG8_STAGE(PG8_SB(0, 1), b2 + hstep, voffB); PG8_STAGE(PG8_SA(0, 0), a2, voffA);
            PG8_WAIT_V(8); PG8_WAIT_L(0); PG8_BAR; PG8_MMA(1, 0, At, B0); PG8_MMA(1, 1, At, B1); PG8_BAR; PG8_SCHED;
            PG8_LDB(B0, 1, 0); PG8_LDB(B1, 1, 1); PG8_SCHED; PG8_LDA(At, 1, 0); PG8_STAGE(PG8_SA(0, 1), a2 + hstep, voffA);
            PG8_WAIT_V(8); PG8_WAIT_L(0); PG8_BAR; PG8_MMA(0, 0, At, B0); PG8_MMA(0, 1, At, B1); PG8_BAR; PG8_SCHED;
            PG8_LDA(At, 1, 1); PG8_STAGE(PG8_SB(1, 0), b3, voffB); PG8_STAGE(PG8_SB(1, 1), b3 + hstep, voffB); PG8_STAGE(PG8_SA(1, 0), a3, voffA);
            PG8_WAIT_V(8); PG8_WAIT_L(0); PG8_BAR; PG8_MMA(1, 0, At, B0); PG8_MMA(1, 1, At, B1); PG8_BAR; PG8_SCHED;
            } else {
            PG8_LDB(B0, 0, 0); PG8_SCHED; PG8_LDA(At, 0, 0); PG8_STAGE(PG8_SA(1, 1), a1 + hstep, voffA);
            PG8_WAIT_L(8); PG8_BAR; PG8_WAIT_L(0); PG8_MMA(0, 0, At, B0); PG8_BAR; PG8_SCHED;
            PG8_LDB(B1, 0, 1); PG8_STAGE(PG8_SB(0, 0), b2, voffB);
            PG8_BAR; PG8_WAIT_L(0); PG8_MMA(0, 1, At, B1); PG8_BAR;
            PG8_LDA(At, 0, 1); PG8_STAGE(PG8_SA(0, 0), a2, voffA);
            PG8_BAR; PG8_WAIT_L(0); PG8_MMA(1, 0, At, B0); PG8_BAR; PG8_SCHED;
            PG8_STAGE(PG8_SB(0, 1), b2 + hstep, voffB);
            PG8_WAIT_V(6); PG8_BAR; PG8_MMA(1, 1, At, B1); PG8_BAR;
            PG8_LDB(B0, 1, 0); PG8_SCHED; PG8_LDA(At, 1, 0); PG8_STAGE(PG8_SA(0, 1), a2 + hstep, voffA);
            PG8_WAIT_L(8); PG8_BAR; PG8_WAIT_L(0); PG8_MMA(0, 0, At, B0); PG8_BAR; PG8_SCHED;
            PG8_LDB(B1, 1, 1); PG8_STAGE(PG8_SB(1, 0), b3, voffB);
            PG8_BAR; PG8_WAIT_L(0); PG8_MMA(0, 1, At, B1); PG8_BAR;
            PG8_LDA(At, 1, 1); PG8_STAGE(PG8_SA(1, 0), a3, voffA);
            PG8_BAR; PG8_WAIT_L(0); PG8_MMA(1, 0, At, B0); PG8_BAR; PG8_SCHED;
            PG8_STAGE(PG8_SB(1, 1), b3 + hstep, voffB);
            PG8_WAIT_V(6); PG8_BAR; PG8_MMA(1, 1, At, B1); PG8_BAR;
            }
        }
        if constexpr (ALIGN_EPI) { if (wr == 0) PG8_BAR; }
        if constexpr (!Epi::AFTER_DRAIN) { E(acc, cur, wr, wc, fr, fq); S.done(cur); }
        if (!has_next) break;
#pragma unroll
        for (int a = 0; a < 2; ++a)
#pragma unroll
            for (int b = 0; b < 2; ++b)
#pragma unroll
                for (int m = 0; m < 4; ++m)
#pragma unroll
                    for (int n = 0; n < 2; ++n) acc[a][b][m][n] = (f32x4){0.f, 0.f, 0.f, 0.f};
        cur = nxt; cA = nA; cB = nB; ++ui;
        if constexpr (ALIGN_EPI) { if (wr == 1) PG8_BAR; }
    }
    PG8_WAIT_V(0);
    if constexpr (!ALIGN_EPI) { if (wr == 0) PG8_BAR; }
    PG8_BAR;
    if constexpr (Epi::AFTER_DRAIN) { E.fused(acc, cur, wr, wc, fr, fq, lds, wid, lane); S.done(cur); }
#undef PG8_SA
#undef PG8_SB
#undef PG8_STAGE
#undef PG8_LDA
#undef PG8_LDB
#undef PG8_MMA
#undef PG8_WAIT_V
#undef PG8_WAIT_L
#undef PG8_BAR
#undef PG8_SCHED
}
}
#define GAS __attribute__((address_space(1)))
#define LAS __attribute__((address_space(3)))
typedef unsigned short bf16;
typedef unsigned v4u __attribute__((ext_vector_type(4)));
typedef float f32x4 __attribute__((ext_vector_type(4)));
typedef short bf16x8 __attribute__((ext_vector_type(8)));
typedef GAS unsigned gu32;
typedef GAS unsigned long long gu64;
#define RLX_AGENT __ATOMIC_RELAXED, __HIP_MEMORY_SCOPE_AGENT
#define LDS_WAIT() asm volatile("s_waitcnt lgkmcnt(0)" ::: "memory")
#define VM_WAIT() asm volatile("s_waitcnt vmcnt(0)" ::: "memory")
__device__ __forceinline__ unsigned long long rt() { return __builtin_amdgcn_s_memrealtime(); }
__device__ __forceinline__ unsigned f2bf(float f) { unsigned u = __builtin_bit_cast(unsigned, f); return (u + 0x7fffu + ((u >> 16) & 1u)) >> 16; }
__device__ __forceinline__ unsigned pk2(float lo, float hi) { return f2bf(lo) | (f2bf(hi) << 16); }

#define XB_TMO      128
#define XB_XCNT(j)  (256  + 64 * (j))
#define XB_XSUB(j)  (1280 + 64 * (j))
#define XB_XGEN(j)  (2304 + 64 * (j))
#define XB_TOP      3328
#define XB_TOPGEN   3392
#define XCD_BAR_WORDS 3456
#define XB_SPIN_CAP (1u << 18)

__device__ __forceinline__ unsigned xb_ld(unsigned* p)              { return __hip_atomic_load(p, __ATOMIC_RELAXED, __HIP_MEMORY_SCOPE_AGENT); }
__device__ __forceinline__ unsigned xb_add(unsigned* p, unsigned v) { return __hip_atomic_fetch_add(p, v, __ATOMIC_RELAXED, __HIP_MEMORY_SCOPE_AGENT); }
__device__ __forceinline__ unsigned xb_xcc_id() { return (unsigned)__builtin_amdgcn_s_getreg((3 << 11) | 20) & 0xFu; }
#define XB_SPIN(cond, bar) do { unsigned _sp = 0; while (cond) { __builtin_amdgcn_s_sleep(1); \
    if ((++_sp & 255u) == 0u) { if (xb_ld(&(bar)[XB_TMO])) break; if (_sp > XB_SPIN_CAP) { atomicAdd(&(bar)[XB_TMO], 1u); break; } } } } while (0)

struct XcdBarrier {
    unsigned* bar; unsigned x;
    volatile LAS unsigned* st;
};

__device__ __forceinline__ XcdBarrier xcd_barrier_post(unsigned* bar, volatile LAS unsigned* st) {
    XcdBarrier b; b.bar = bar; b.x = xb_xcc_id(); b.st = st;
    if (threadIdx.x == 0) (void)xb_add(&bar[XB_XCNT(b.x)], 1u);
    return b;
}
__device__ __forceinline__ void xcd_barrier_complete(unsigned* bar, unsigned x, unsigned& nloc, unsigned& nx) {
    const unsigned G = gridDim.x * gridDim.y * gridDim.z;
    unsigned sum, cnt, mine, sp = 0u;
    for (;;) {
        sum = 0u; cnt = 0u; mine = 0u;
#pragma unroll
        for (unsigned j = 0; j < 16; ++j) { const unsigned c = xb_ld(&bar[XB_XCNT(j)]); sum += c; cnt += (c > 0u) ? 1u : 0u; mine = (j == x) ? c : mine; }
        if (sum == G) break;
        __builtin_amdgcn_s_sleep(1);
        if ((++sp & 255u) == 0u) { if (xb_ld(&bar[XB_TMO])) break; if (sp > XB_SPIN_CAP) { atomicAdd(&bar[XB_TMO], 1u); break; } }
    }
    nloc = mine > 0u ? mine : 1u; nx = cnt > 0u ? cnt : 1u;
}

__device__ __forceinline__ void xcd_barrier(const XcdBarrier& b) {
    asm volatile("s_waitcnt vmcnt(0)" ::: "memory");
    __syncthreads();
    if (threadIdx.x == 0) {
        unsigned* bar = b.bar;
        __builtin_amdgcn_s_waitcnt(0);
        unsigned nloc = b.st[0], nx = b.st[1];
        if (nloc == 0u) { xcd_barrier_complete(bar, b.x, nloc, nx); b.st[0] = nloc; b.st[1] = nx; }
        const unsigned old = xb_add(&bar[XB_XSUB(b.x)], 1u);
        const unsigned gen = old / nloc;
        if (old + 1u == (gen + 1u) * nloc) {
            __builtin_amdgcn_fence(__ATOMIC_RELEASE, "agent");
            asm volatile("s_waitcnt vmcnt(0)" ::: "memory");
            const unsigned og = xb_add(&bar[XB_TOP], 1u);
            const unsigned tg = og / nx;
            if (og + 1u == (tg + 1u) * nx) xb_add(&bar[XB_TOPGEN], 1u);
            else XB_SPIN(xb_ld(&bar[XB_TOPGEN]) == tg, bar);
            __builtin_amdgcn_fence(__ATOMIC_ACQUIRE, "agent");
            xb_add(&bar[XB_XGEN(b.x)], 1u);
            asm volatile("s_waitcnt vmcnt(0)" ::: "memory");
        } else {
            XB_SPIN(xb_ld(&bar[XB_XGEN(b.x)]) == gen, bar);
            __builtin_amdgcn_fence(__ATOMIC_ACQUIRE, "agent");
            asm volatile("s_waitcnt vmcnt(0)" ::: "memory");
        }
    }
    __syncthreads();
}

constexpr int NWAVES = 8;
#ifndef MK_N_LAUNCHES
#define MK_N_LAUNCHES 1
#endif
constexpr int PER_PHASE = 11;
constexpr int N_LAUNCHES = MK_N_LAUNCHES;

constexpr int BATCH = 16, SEQ = 2048, D = 1024, HD = 64, NH = 8, FF = 2816;
constexpr int M = BATCH * SEQ;
constexpr int SBW = 512, RWW = 512, RWP = 1792, PW = 3328, LORA_K = 256, LORA_N = 1536;
constexpr float LNX_EPS = 64e-5f;

constexpr size_t MiB = 1u << 20;
constexpr size_t WS_CTL = 0, CTL_ZERO_BYTES = 128 * 1024;
constexpr size_t WS_SSQ = 1 * MiB;
constexpr size_t WS_W1U = 4 * MiB;
constexpr size_t WS_W1D = 15 * MiB;
constexpr size_t WS_W2U = 21 * MiB;
constexpr size_t WS_W2D = 32 * MiB;
constexpr size_t WS_WIN = 38 * MiB;
constexpr size_t WS_WOUT = 45 * MiB;
constexpr size_t WS_WLORA = 47 * MiB;
constexpr size_t WS_XB = 48 * MiB;
constexpr size_t WS_ACT = 112 * MiB;
constexpr size_t WS_QO = 112 * MiB;
constexpr size_t WS_KB = 176 * MiB;
constexpr size_t WS_VB = 208 * MiB;
constexpr size_t WS_RW = 240 * MiB;
constexpr size_t WS_ALORA = 352 * MiB;
constexpr size_t WS_LW = 368 * MiB;
constexpr size_t WS_AB = 432 * MiB;
constexpr size_t WS_GB = 464 * MiB;
constexpr size_t WS_TAIL = 496 * MiB;
constexpr size_t WS_END = 512 * MiB;
constexpr int CW_TMO = 0, CW_CODE = 1;
constexpr int CW_BAR = 4096;
constexpr int CW_QUEUE = 16384;

constexpr int RING_OFF = 0, RING_BYTES = 155648;
constexpr int LDSCTL_OFF = RING_BYTES, MISC_OFF = LDSCTL_OFF;
constexpr int LDS_BYTES = 163840;

struct Frame {
    LAS unsigned char* lds;
    volatile LAS unsigned* MISC;
    gu32* ctl;
    int tid, lane, wave;
    int vcu, G;
};
typedef unsigned u32x2g __attribute__((ext_vector_type(2)));
__device__ __forceinline__ float bf2f(unsigned short h) { return __uint_as_float(((unsigned)h) << 16); }
typedef float f32x2h __attribute__((ext_vector_type(2))); typedef __bf16 bf16x2h __attribute__((ext_vector_type(2)));
__device__ __forceinline__ unsigned pkbf(float lo, float hi) { f32x2h v = {lo, hi}; bf16x2h b = __builtin_convertvector(v, bf16x2h); return __builtin_bit_cast(unsigned, b); }
__device__ __forceinline__ float bflo(unsigned w) { return __uint_as_float(w << 16); }
__device__ __forceinline__ float bfhi(unsigned w) { return __uint_as_float(w & 0xffff0000u); }
__device__ __forceinline__ float wave_sum(float v) {
#pragma unroll
    for (int o = 1; o < 64; o <<= 1) v += __shfl_xor(v, o);
    return v;
}
#define DPP_ADD(v, ctrl) ((v) + __int_as_float(__builtin_amdgcn_update_dpp(0, __float_as_int(v), (ctrl), 0xF, 0xF, true)))
__device__ __forceinline__ float sum8(float v) { v = DPP_ADD(v, 0xB1); v = DPP_ADD(v, 0x4E); v = DPP_ADD(v, 0x141); return v; }

struct TItem { const float* W; int ldw, k0, n0; const float* sc; bf16* WT; int Kd, rho0; };
__device__ __forceinline__ void ti_load(const TItem& T, float (&t)[32], int lane) {
#pragma unroll
    for (int i = 0; i < 32; ++i) t[i] = T.W[(size_t)(T.k0 + 2 * i + (lane >> 5)) * T.ldw + T.n0 + (lane & 31)];
}
__device__ __forceinline__ void ti_finish(const TItem& T, const float (&t)[32], LAS float* scr, int lane) {
#pragma unroll
    for (int i = 0; i < 32; ++i) scr[(2 * i + (lane >> 5)) * 33 + (lane & 31)] = t[i];
    LDS_WAIT(); asm volatile("" ::: "memory");
    const int c = lane & 7;
    f32x4 s0 = (f32x4){1.f, 1.f, 1.f, 1.f}, s1 = s0;
    if (T.sc) { s0 = *(const f32x4*)(T.sc + T.k0 + 8 * c); s1 = *(const f32x4*)(T.sc + T.k0 + 8 * c + 4); }
#pragma unroll
    for (int j = 0; j < 4; ++j) { const int n = (lane >> 3) + 8 * j; const LAS float* s = scr + (8 * c) * 33 + n;
        v4u o; o.x = pkbf(s[0 * 33] * s0.x, s[1 * 33] * s0.y); o.y = pkbf(s[2 * 33] * s0.z, s[3 * 33] * s0.w); o.z = pkbf(s[4 * 33] * s1.x, s[5 * 33] * s1.y); o.w = pkbf(s[6 * 33] * s1.z, s[7 * 33] * s1.w);
        *(GAS v4u*)(T.WT + (size_t)(T.rho0 + n) * T.Kd + T.k0 + 8 * c) = o; }
    LDS_WAIT(); asm volatile("" ::: "memory");
}
#define P0_PTRS const float* Ax, const float* An1, const float* Ag1, const float* Au1, const float* Ad1, const float* Anm, const float* Awin, const float* Aw2, const float* Aa2, const float* Ag2, const float* Awout, \
    const float* An2, const float* Ag2f, const float* Au2f, const float* Ad2f, bf16* AW1U, bf16* AW1D, bf16* AW2U, bf16* AW2D, bf16* AWIN, bf16* AWOUT, bf16* AWLORA, bf16* AXB, float* ASSQ
__device__ __forceinline__ void p0_items(Frame& F, P0_PTRS, int set, int gw, int NGW) {
    LAS float* scr = (LAS float*)(F.lds + RING_OFF + F.wave * 16384);
    constexpr int I_UP = 16 * 176, I_DN = 44 * 32, I_IN = 16 * 104, I_OUT = 16 * 32;
    const int NITEMS = set ? (I_UP + I_DN) : (I_UP + I_DN + I_IN + I_OUT);
#define P0_DECODE(it_, T) do { int r = (it_); const int l2 = set; \
        if (r < I_UP) { const int kb = r / 176, nb = r % 176, rho0 = 32 * nb, pn = rho0 >> 8, bj = (rho0 >> 7) & 1, j0 = rho0 & 127; \
            T = TItem{l2 ? (bj ? Au2f : Ag2f) : (bj ? Au1 : Ag1), FF, 64 * kb, 128 * pn + j0, l2 ? An2 : An1, l2 ? AW2U : AW1U, D, rho0}; } \
        else if ((r -= I_UP) < I_DN) { const int kb = r / 32, nb = r % 32; \
            T = TItem{l2 ? Ad2f : Ad1, D, 64 * kb, 32 * nb, nullptr, l2 ? AW2D : AW1D, FF, 32 * nb}; } \
        else if ((r -= I_DN) < I_IN) { const int kb = r / 104, nb = r % 104, rho0 = 32 * nb, pn = rho0 >> 8, rem = rho0 & 255, bj = rem >> 7, wc = (rem & 127) >> 5; \
            T = TItem{Awin, PW, 64 * kb, 256 * pn + 64 * wc + 32 * bj, Anm, AWIN, D, rho0}; } \
        else { r -= I_IN; const int kb = r / 32, nb = r % 32; T = TItem{Awout, D, 64 * kb, 32 * nb, nullptr, AWOUT, D, 32 * nb}; } } while (0)
    for (int it = gw; it < NITEMS; it += 2 * NGW) {
        TItem T0, T1; float t0[32], t1[32]; const bool two = (it + NGW < NITEMS);
        P0_DECODE(it, T0); ti_load(T0, t0, F.lane);
        if (two) { P0_DECODE(it + NGW, T1); ti_load(T1, t1, F.lane); }
        ti_finish(T0, t0, scr, F.lane);
        if (two) ti_finish(T1, t1, scr, F.lane);
    }
#undef P0_DECODE
}
__device__ __forceinline__ void p0_prologue(Frame& F, P0_PTRS) {
    const int gw = F.vcu * NWAVES + F.wave, NGW = F.G * NWAVES;
    p0_items(F, Ax, An1, Ag1, Au1, Ad1, Anm, Awin, Aw2, Aa2, Ag2, Awout, An2, Ag2f, Au2f, Ad2f, AW1U, AW1D, AW2U, AW2D, AWIN, AWOUT, AWLORA, AXB, ASSQ, (F.G >= 256) ? 0 : 0, gw, NGW);
    if (F.G < 256) p0_items(F, Ax, An1, Ag1, Au1, Ad1, Anm, Awin, Aw2, Aa2, Ag2, Awout, An2, Ag2f, Au2f, Ad2f, AW1U, AW1D, AW2U, AW2D, AWIN, AWOUT, AWLORA, AXB, ASSQ, 1, gw, NGW);
    for (int it = F.vcu * (NWAVES * 64) + F.tid; it < 512 * 32; it += F.G * NWAVES * 64) {
        int ch, kc, Kk; const float* src; bf16* dst;
        if (it < 512 * 8) { ch = it >> 3; kc = (it & 7) * 8; Kk = 64; src = Aw2; dst = AWLORA; }
        else if (it < 512 * 16) { const int i2 = it - 512 * 8; ch = i2 >> 3; kc = (i2 & 7) * 8; Kk = 64; src = Aa2; dst = AWLORA + 512 * 64; }
        else { const int i2 = it - 512 * 16; ch = i2 >> 4; kc = (i2 & 15) * 8; Kk = 128; src = Ag2; dst = AWLORA + 2 * 512 * 64; }
        float v[8];
#pragma unroll
        for (int j = 0; j < 8; ++j) v[j] = src[(size_t)(kc + j) * 512 + ch];
        v4u o; o.x = pkbf(v[0], v[1]); o.y = pkbf(v[2], v[3]); o.z = pkbf(v[4], v[5]); o.w = pkbf(v[6], v[7]);
        *(GAS v4u*)(dst + (size_t)ch * Kk + kc) = o;
    }
    for (int mb = gw; mb < M; mb += 4 * NGW) {
        f32x4 v[4][4]; float s[4];
#pragma unroll
        for (int q = 0; q < 4; ++q) { const int m = mb + q * NGW; const GAS f32x4* xr = (const GAS f32x4*)(Ax + (size_t)(m < M ? m : mb) * D) + F.lane;
#pragma unroll
            for (int j = 0; j < 4; ++j) v[q][j] = xr[64 * j]; }
#pragma unroll
        for (int q = 0; q < 4; ++q) { float a = 0.f;
#pragma unroll
            for (int j = 0; j < 4; ++j) a += (v[q][j].x * v[q][j].x + v[q][j].y * v[q][j].y) + (v[q][j].z * v[q][j].z + v[q][j].w * v[q][j].w);
            s[q] = a; }
#pragma unroll
        for (int o = 1; o < 64; o <<= 1) {
#pragma unroll
            for (int q = 0; q < 4; ++q) s[q] += __shfl_xor(s[q], o); }
#pragma unroll
        for (int q = 0; q < 4; ++q) { const int m = mb + q * NGW; if (m < M) {
            GAS unsigned long long* o8 = (GAS unsigned long long*)(AXB + (size_t)m * D) + F.lane;
#pragma unroll
            for (int j = 0; j < 4; ++j) o8[64 * j] = (unsigned long long)pkbf(v[q][j].x, v[q][j].y) | ((unsigned long long)pkbf(v[q][j].z, v[q][j].w) << 32);
            if (F.lane < 16) ASSQ[(size_t)m * 16 + F.lane] = (F.lane == 0) ? s[q] : 0.f; } }
    }
}

struct RwArgs { const bf16* RW; const bf16* W2T; const bf16* A2T; const bf16* G2T; const float* w0; const float* a0; bf16* QO; const float *mu, *k_k, *k_a, *r_k, *ln_w, *ln_b; };
__device__ __forceinline__ void ld8bf(const bf16* p, float (&o)[8]) { const v4u w = *(const v4u*)p; o[0] = bflo(w.x); o[1] = bfhi(w.x); o[2] = bflo(w.y); o[3] = bfhi(w.y); o[4] = bflo(w.z); o[5] = bfhi(w.z); o[6] = bflo(w.w); o[7] = bfhi(w.w); }
__device__ __forceinline__ void ld8f(const float* p, float (&o)[8]) { const f32x4 a = *(const f32x4*)p, b = *(const f32x4*)(p + 4); o[0] = a.x; o[1] = a.y; o[2] = a.z; o[3] = a.w; o[4] = b.x; o[5] = b.y; o[6] = b.z; o[7] = b.w; }
__device__ __forceinline__ void ld8l(const LAS float* p, float (&o)[8]) { const f32x4 a = *(const LAS f32x4*)p, b = *(const LAS f32x4*)(p + 4); o[0] = a.x; o[1] = a.y; o[2] = a.z; o[3] = a.w; o[4] = b.x; o[5] = b.y; o[6] = b.z; o[7] = b.w; }
__device__ __forceinline__ void st8l(LAS float* p, const float (&o)[8]) { *(LAS f32x4*)p = (f32x4){o[0], o[1], o[2], o[3]}; *(LAS f32x4*)(p + 4) = (f32x4){o[4], o[5], o[6], o[7]}; }
namespace rwk {
typedef short bf16x8 __attribute__((ext_vector_type(8)));
typedef short s16x4 __attribute__((ext_vector_type(4)));
typedef short v4i16_t __attribute__((ext_vector_type(4)));
constexpr int SLOT = 8192;
#define RSL(s) (lds + (s) * SLOT)
#define RMFMA(a, b, c) __builtin_amdgcn_mfma_f32_16x16x32_bf16((a), (b), (c), 0, 0, 0)
__device__ __forceinline__ int swz(int row, int cb) { return row * 128 + (cb ^ ((row & 7) << 4)); }
struct Fr2 { bf16x8 k0, k1; };
__device__ __forceinline__ Fr2 ldf(const LAS unsigned char* base, int off) { Fr2 f; f.k0 = *(const LAS bf16x8*)(base + off); f.k1 = *(const LAS bf16x8*)(base + (off ^ 64)); return f; }
__device__ __forceinline__ s16x4 trd(const LAS unsigned char* p) { return __builtin_bit_cast(s16x4, __builtin_amdgcn_ds_read_tr16_b64_v4i16((LAS v4i16_t*)p)); }
__device__ __forceinline__ Fr2 ldt(const LAS unsigned char* base, int o0, int o1) {
    const s16x4 a = trd(base + o0), b = trd(base + o1), c = trd(base + o0 + 4096), d = trd(base + o1 + 4096);
    Fr2 f; f.k0 = (bf16x8){a[0], a[1], a[2], a[3], b[0], b[1], b[2], b[3]}; f.k1 = (bf16x8){c[0], c[1], c[2], c[3], d[0], d[1], d[2], d[3]}; return f; }
template <bool SWAP> __device__ __forceinline__ f32x4 mm(const Fr2& a, const Fr2& b, f32x4 c) {
    if (SWAP) { c = RMFMA(b.k0, a.k0, c); c = RMFMA(b.k1, a.k1, c); } else { c = RMFMA(a.k0, b.k0, c); c = RMFMA(a.k1, b.k1, c); } return c; }
__device__ __forceinline__ void st4(LAS unsigned char* slot, int off, f32x4 v) { u32x2g w; w.x = pkbf(v[0], v[1]); w.y = pkbf(v[2], v[3]); *(LAS u32x2g*)(slot + off) = w; }
__device__ __forceinline__ f32x4 ld4(const LAS unsigned char* slot, int off) { const u32x2g w = *(const LAS u32x2g*)(slot + off); return (f32x4){bflo(w.x), bfhi(w.x), bflo(w.y), bfhi(w.y)}; }
#define LBAR() asm volatile("s_waitcnt lgkmcnt(0)\n\ts_barrier" ::: "memory")
#define DPPF(x, ctrl, rmask) __int_as_float(__builtin_amdgcn_update_dpp(0, __float_as_int(x), (ctrl), (rmask), 0xF, true))
__device__ __forceinline__ float wave_scan(float x) {
    x += DPPF(x, 0x111, 0xF); x += DPPF(x, 0x112, 0xF); x += DPPF(x, 0x114, 0xF); x += DPPF(x, 0x118, 0xF);
    x += DPPF(x, 0x142, 0xA);
    x += DPPF(x, 0x143, 0xC);
    return x; }
__device__ __forceinline__ void unp8(const v4u w, float (&o)[8]) { o[0] = bflo(w.x); o[1] = bfhi(w.x); o[2] = bflo(w.y); o[3] = bfhi(w.y); o[4] = bflo(w.z); o[5] = bfhi(w.z); o[6] = bflo(w.w); o[7] = bfhi(w.w); }
__device__ __forceinline__ v4u pk8(const float (&o)[8]) { return (v4u){pkbf(o[0], o[1]), pkbf(o[2], o[3]), pkbf(o[4], o[5]), pkbf(o[6], o[7])}; }
}
struct RwX { bf16* P1; bf16* GT; bf16* Y0; bf16* H; bf16* VB0; bf16* VB1; float* GE; bf16* G; };
__device__ __forceinline__ void p6a_rwkv_local(Frame& F, const RwArgs& A, const RwX& X) {
    using namespace rwk;
    LAS unsigned char* lds = F.lds + RING_OFF;
    LAS float* part = (LAS float*)(F.lds + LDSCTL_OFF + 128);
    LAS float* cst = (LAS float*)(F.lds + LDSCTL_OFF + 128 + 4096 + 896);
    const int lane = F.lane, fr = lane & 15, fq = lane >> 4, w = F.wave, m0 = 16 * (w >> 1), n0a = 32 * (w & 1);
    const int fm = swz(m0 + fr, fq * 16);
    const int ta0 = swz(8 * fq + (fr >> 2), 2 * (m0 + 4 * (fr & 3))), ta1 = swz(8 * fq + 4 + (fr >> 2), 2 * (m0 + 4 * (fr & 3)));
    int fn[2], orm[2], otr[2], tb0[2], tb1[2];
#pragma unroll
    for (int t = 0; t < 2; ++t) { const int n0 = n0a + 16 * t; fn[t] = swz(n0 + fr, fq * 16); orm[t] = swz(m0 + fr, 2 * (n0 + 4 * fq)); otr[t] = swz(n0 + fr, 2 * (m0 + 4 * fq));
        tb0[t] = swz(8 * fq + (fr >> 2), 2 * (n0 + 4 * (fr & 3))); tb1[t] = swz(8 * fq + 4 + (fr >> 2), 2 * (n0 + 4 * (fr & 3))); }
    const int NJ = BATCH * NH * (SEQ / 64);
    const int tid = F.tid, ltok = tid >> 3, ldg = tid & 7;
    v4u g_r, g_k, g_v, g_xw, g_xa, g_xg0, g_xg1, g_pr;
#define P6A_LOAD(jj) do { const int u_ = (jj) >> 5, c_ = (jj) & 31; const size_t gr_ = (size_t)(u_ >> 3) * SEQ + c_ * 64 + ltok; const int cb_ = 64 * (u_ & 7) + 8 * ldg; const bf16* rp_ = A.RW + gr_ * RWP; \
        g_r = *(const v4u*)(rp_ + cb_); g_k = *(const v4u*)(rp_ + 512 + cb_); g_v = *(const v4u*)(rp_ + 1024 + cb_); \
        g_xw = *(const v4u*)(rp_ + 1536 + 8 * ldg); g_xa = *(const v4u*)(rp_ + 1600 + 8 * ldg); g_xg0 = *(const v4u*)(rp_ + 1664 + 8 * ldg); g_xg1 = *(const v4u*)(rp_ + 1728 + 8 * ldg); \
        g_pr = (v4u){0u, 0u, 0u, 0u}; if (ltok < 7 && c_ > 0) g_pr = *(const v4u*)(A.RW + ((size_t)(u_ >> 3) * SEQ + c_ * 64 - 1) * RWP + (ltok < 3 ? 512 * ltok + cb_ : 1536 + 64 * (ltok - 3) + 8 * ldg)); } while (0)
    if ((int)blockIdx.x < NJ) P6A_LOAD((int)blockIdx.x);
    int hcur = -1;
    LAS unsigned char* prow = (LAS unsigned char*)(F.lds + LDSCTL_OFF + 128 + 4096);
    if (tid < 256) cst[512 + tid] = A.mu[1536 + tid];
    u32x2g s_p1[2], s_gt[2], s_y0[2], s_hh[2]; size_t s_jo = 0; bool s_have = false;
#define P6A_STORE() do { _Pragma("unroll") for (int t = 0; t < 2; ++t) { \
            *(u32x2g*)(X.P1 + s_jo + ((w * 2 + t) * 64 + lane) * 4) = s_p1[t]; *(u32x2g*)(X.GT + s_jo + ((w * 2 + t) * 64 + lane) * 4) = s_gt[t]; \
            *(u32x2g*)(X.Y0 + s_jo + ((w * 2 + t) * 64 + lane) * 4) = s_y0[t]; *(u32x2g*)(X.H + s_jo + ((w * 2 + t) * 64 + lane) * 4) = s_hh[t]; } } while (0)
    for (int job = blockIdx.x; job < NJ; job += F.G) {
        const int unit = job >> 5, c = job & 31; const int h = unit & 7; const int cb = 64 * h + 8 * w; const size_t jo = (size_t)job * 4096;
        {
            const int so = swz(ltok, 16 * ldg);
            *(LAS v4u*)(RSL(12) + so) = g_r; *(LAS v4u*)(RSL(2) + so) = g_k; *(LAS v4u*)(RSL(0) + so) = g_v;
            *(LAS v4u*)(RSL(14) + so) = g_xw; *(LAS v4u*)(RSL(13) + so) = g_xa; *(LAS v4u*)(RSL(10) + so) = g_xg0; *(LAS v4u*)(RSL(11) + so) = g_xg1;
            if (ltok < 7) *(LAS v4u*)(prow + ltok * 128 + 16 * ldg) = g_pr;
            if (h != hcur) {
                *(LAS v4u*)(RSL(16) + so) = *(const v4u*)(A.W2T + (size_t)(64 * h + ltok) * 64 + 8 * ldg); *(LAS v4u*)(RSL(17) + so) = *(const v4u*)(A.A2T + (size_t)(64 * h + ltok) * 64 + 8 * ldg);
                { const int a_ = tid >> 6, i_ = tid & 63;
                  const float* src_ = (a_ == 0) ? A.mu : (a_ == 1) ? A.mu + 512 : (a_ == 2) ? A.mu + 1024 : (a_ == 3) ? A.k_k : (a_ == 4) ? A.k_a : (a_ == 5) ? A.r_k : (a_ == 6) ? A.w0 : A.a0;
                  cst[a_ * 64 + i_] = src_[64 * h + i_]; } }
            hcur = h;
        }
        if (s_have) P6A_STORE();
        { const int nj = job + F.G; if (nj < NJ) P6A_LOAD(nj); }
        LBAR();
        float r[8], k[8], v[8];
        {
            const int so = swz(lane, 16 * w), sp = swz((lane + 63) & 63, 16 * w);
#define P6A_SHIFT(slot, pi, moff, dst) do { float c_[8], p_[8], m_[8]; v4u wc_ = *(const LAS v4u*)(RSL(slot) + so), wp_ = *(const LAS v4u*)(RSL(slot) + sp); \
                if (lane == 0) wp_ = *(const LAS v4u*)(prow + 128 * (pi) + 16 * w); \
                unp8(wc_, c_); unp8(wp_, p_); ld8l(cst + (moff) + 8 * w, m_); \
                _Pragma("unroll") for (int j = 0; j < 8; ++j) dst[j] = c_[j] + (p_[j] - c_[j]) * m_[j]; } while (0)
            P6A_SHIFT(12, 0, 0, r);
            P6A_SHIFT(2, 1, 64, k);
            P6A_SHIFT(0, 2, 128, v); asm volatile("" ::: "memory");
            { float x_[8]; P6A_SHIFT(14, 3, 512, x_);
#pragma unroll
              for (int j = 0; j < 8; ++j) x_[j] = 2.0f * pg8::sigmoid_f(2.0f * x_[j]) - 1.0f;
              *(LAS v4u*)(RSL(14) + so) = pk8(x_); }
            { float x_[8]; P6A_SHIFT(13, 4, 576, x_); *(LAS v4u*)(RSL(13) + so) = pk8(x_); } asm volatile("" ::: "memory");
            { float x_[8]; P6A_SHIFT(10, 5, 640, x_);
#pragma unroll
              for (int j = 0; j < 8; ++j) x_[j] = pg8::sigmoid_f(x_[j]);
              *(LAS v4u*)(RSL(10) + so) = pk8(x_); }
            { float x_[8]; P6A_SHIFT(11, 6, 704, x_);
#pragma unroll
              for (int j = 0; j < 8; ++j) x_[j] = pg8::sigmoid_f(x_[j]);
              *(LAS v4u*)(RSL(11) + so) = pk8(x_); }
#undef P6A_SHIFT
        }
        LBAR();
        {
            const f32x4 z4 = (f32x4){0.f, 0.f, 0.f, 0.f};
            bf16x8 gq[2][4];
#pragma unroll
            for (int t = 0; t < 2; ++t) { const bf16* gp = A.G2T + (size_t)(64 * h + n0a + 16 * t + fr) * 128 + 8 * fq;
#pragma unroll
                for (int q = 0; q < 4; ++q) gq[t][q] = *reinterpret_cast<const bf16x8*>(gp + 32 * q); }
            {   const Fr2 aW = ldf(RSL(14), fm), aA = ldf(RSL(13), fm); Fr2 bW[2], bA[2];
#pragma unroll
                for (int t = 0; t < 2; ++t) { bW[t] = ldf(RSL(16), fn[t]); bA[t] = ldf(RSL(17), fn[t]); }
#pragma unroll
                for (int t = 0; t < 2; ++t) { const int row = m0 + fr, ch = n0a + 16 * t + 4 * fq; const f32x4 lwq = mm<true>(aW, bW[t], z4), alq = mm<true>(aA, bA[t], z4);
                    const f32x4 w0c = *(const LAS f32x4*)(cst + 384 + ch), a0c = *(const LAS f32x4*)(cst + 448 + ch); f32x4 lwv, alv;
#pragma unroll
                    for (int x = 0; x < 4; ++x) { lwv[x] = -0.6065306597126334f * pg8::sigmoid_f(w0c[x] + lwq[x]); alv[x] = pg8::sigmoid_f(a0c[x] + alq[x]); }
                    const int fo = row * 256 + (((ch >> 3) ^ (row & 7)) << 5) + ((ch >> 2) & 1) * 16;
                    *(LAS f32x4*)(RSL(4) + fo) = lwv; *(LAS f32x4*)(RSL(8) + fo) = alv; } }
            asm volatile("" ::: "memory");
            {   const Fr2 aG0 = ldf(RSL(10), fm), aG1 = ldf(RSL(11), fm);
#pragma unroll
                for (int t = 0; t < 2; ++t) { Fr2 bG0, bG1; bG0.k0 = gq[t][0]; bG0.k1 = gq[t][1]; bG1.k0 = gq[t][2]; bG1.k1 = gq[t][3];
                    st4(RSL(3), orm[t], mm<true>(aG1, bG1, mm<true>(aG0, bG0, z4))); } }
        }
        LBAR();
        float kf[8], kk[8], al[8], lw[8]; float ssp = 0.f, bpp = 0.f;
        {
            { const int fo = lane * 256 + ((w ^ (lane & 7)) << 5); const f32x4 a_ = *(const LAS f32x4*)(RSL(4) + fo), b_ = *(const LAS f32x4*)(RSL(4) + fo + 16), c_ = *(const LAS f32x4*)(RSL(8) + fo), d_ = *(const LAS f32x4*)(RSL(8) + fo + 16);
              lw[0] = a_.x; lw[1] = a_.y; lw[2] = a_.z; lw[3] = a_.w; lw[4] = b_.x; lw[5] = b_.y; lw[6] = b_.z; lw[7] = b_.w;
              al[0] = c_.x; al[1] = c_.y; al[2] = c_.z; al[3] = c_.w; al[4] = d_.x; al[5] = d_.y; al[6] = d_.z; al[7] = d_.w; }
            *(v4u*)(X.G + jo + tid * 8) = *(const LAS v4u*)(RSL(3) + swz(ltok, 16 * ldg));
            float kkc[8], kac[8], rkc[8]; ld8l(cst + 192 + 8 * w, kkc); ld8l(cst + 256 + 8 * w, kac); ld8l(cst + 320 + 8 * w, rkc);
#pragma unroll
            for (int j = 0; j < 8; ++j) { kk[j] = k[j] * kkc[j]; ssp += kk[j] * kk[j]; kf[j] = k[j] * (1.0f + (al[j] - 1.0f) * kac[j]); bpp += r[j] * kf[j] * rkc[j]; }
            part[w * 64 + lane] = ssp; part[512 + w * 64 + lane] = bpp;
        }
        LBAR();
        {
            float ss = 0.f, bon = 0.f;
#pragma unroll
            for (int i = 0; i < 8; ++i) { ss += part[i * 64 + lane]; bon += part[512 + i * 64 + lane]; }
            const float inv = 1.0f / fmaxf(sqrtf(ss), 1e-12f);
            float at[8], rt[8], bt[8], kt[8], bh[8], kh[8], ge[8], vb[8];
#pragma unroll
            for (int j = 0; j < 8; ++j) {
                const float cs = wave_scan(lw[j]);
                const float ce = __int_as_float(__builtin_amdgcn_readlane(__float_as_int(cs), 63));
                const float e_cs = __builtin_amdgcn_exp2f(cs * 1.4426950408889634f), e_csm = __builtin_amdgcn_exp2f((cs - lw[j]) * 1.4426950408889634f);
                const float e_neg = __builtin_amdgcn_rcpf(e_cs), e_end = __builtin_amdgcn_exp2f((ce - cs) * 1.4426950408889634f);
                const float kn = kk[j] * inv, bb = kn * al[j];
                at[j] = -kn * e_csm; rt[j] = r[j] * e_cs; bt[j] = bb * e_neg; kt[j] = kf[j] * e_neg; bh[j] = bb * e_end; kh[j] = kf[j] * e_end; ge[j] = e_cs; vb[j] = bon * v[j];
            }
            const int ro = swz(lane, 16 * w);
            *(LAS v4u*)(RSL(0) + ro) = pk8(at); *(LAS v4u*)(RSL(1) + ro) = pk8(rt); *(LAS v4u*)(RSL(2) + ro) = pk8(bt); *(LAS v4u*)(RSL(3) + ro) = pk8(kt);
            *(LAS v4u*)(RSL(4) + ro) = pk8(bh); *(LAS v4u*)(RSL(5) + ro) = pk8(kh); *(LAS v4u*)(RSL(6) + ro) = pk8(v);
            if (lane == 63) { *(f32x4*)(X.GE + (size_t)job * 64 + 8 * w) = (f32x4){ge[0], ge[1], ge[2], ge[3]}; *(f32x4*)(X.GE + (size_t)job * 64 + 8 * w + 4) = (f32x4){ge[4], ge[5], ge[6], ge[7]}; }
            *(LAS v4u*)(RSL(18) + ro) = pk8(vb);
        }
        LBAR();
        {
            { bf16* vbp = (job < 2048) ? (X.VB0 + jo) : (X.VB1 + (jo - (size_t)2048 * 4096)); *(v4u*)(vbp + tid * 8) = *(const LAS v4u*)(RSL(18) + swz(ltok, 16 * ldg)); }
            const f32x4 z4 = (f32x4){0.f, 0.f, 0.f, 0.f};
            const Fr2 aA = ldf(RSL(0), fm), aR = ldf(RSL(1), fm); Fr2 bB[2], bK[2];
#pragma unroll
            for (int t = 0; t < 2; ++t) { bB[t] = ldf(RSL(2), fn[t]); bK[t] = ldf(RSL(3), fn[t]); }
            f32x4 nab[2], nabT[2], nak[2], mrb[2], mrk[2];
#pragma unroll
            for (int t = 0; t < 2; ++t) { nab[t] = mm<true>(aA, bB[t], z4); nabT[t] = mm<false>(aA, bB[t], z4); nak[t] = mm<true>(aA, bK[t], z4); mrb[t] = mm<true>(aR, bB[t], z4); mrk[t] = mm<true>(aR, bK[t], z4); }
#pragma unroll
            for (int t = 0; t < 2; ++t) { const int n0 = n0a + 16 * t; f32x4 x1;
#pragma unroll
                for (int x = 0; x < 4; ++x) { const int i = m0 + fr, j = n0 + 4 * fq + x;
                    if (j >= i) { nab[t][x] = 0.f; nak[t][x] = 0.f; } if (j > i) { mrb[t][x] = 0.f; mrk[t][x] = 0.f; }
                    x1[x] = nab[t][x] + ((i == j) ? 1.0f : 0.f);
                    const int it = m0 + 4 * fq + x, jt = n0 + fr; if (jt >= it) nabT[t][x] = 0.f; }
                st4(RSL(10), orm[t], x1); st4(RSL(12), orm[t], nab[t]); st4(RSL(14), otr[t], nabT[t]);
                st4(RSL(7), orm[t], nak[t]); st4(RSL(8), orm[t], mrb[t]); st4(RSL(9), orm[t], mrk[t]); }
        }
        LBAR();
        {
            const f32x4 z4 = (f32x4){0.f, 0.f, 0.f, 0.f};
            const Fr2 aP = ldf(RSL(12), fm), aN = ldf(RSL(7), fm); Fr2 bT[2], bV[2];
#pragma unroll
            for (int t = 0; t < 2; ++t) { bT[t] = ldf(RSL(14), fn[t]); bV[t] = ldt(RSL(6), tb0[t], tb1[t]); }
            f32x4 q0[2], q1[2], q2[2];
#pragma unroll
            for (int t = 0; t < 2; ++t) { q0[t] = mm<true>(aP, bT[t], z4); q1[t] = mm<false>(aP, bT[t], z4); q2[t] = mm<false>(aN, bV[t], z4); }
#pragma unroll
            for (int t = 0; t < 2; ++t) { st4(RSL(13), orm[t], q0[t]); st4(RSL(15), otr[t], q1[t]); st4(RSL(2), otr[t], q2[t]); }
        }
        LBAR();
#pragma unroll
        for (int kd = 0; kd < 5; ++kd) {
            const int xi = (kd & 1) ? 11 : 10, xo = (kd & 1) ? 10 : 11, pi = (kd & 1) ? 12 : 13, po = (kd & 1) ? 13 : 12, ti = (kd & 1) ? 14 : 15, to = (kd & 1) ? 15 : 14;
            const f32x4 z4 = (f32x4){0.f, 0.f, 0.f, 0.f};
            const Fr2 aX = ldf(RSL(xi), fm), aP = ldf(RSL(pi), fm); Fr2 bT[2]; f32x4 cx[2];
#pragma unroll
            for (int t = 0; t < 2; ++t) { bT[t] = ldf(RSL(ti), fn[t]); cx[t] = ld4(RSL(xi), orm[t]); }
            f32x4 q0[2], q1[2], q2[2];
#pragma unroll
            for (int t = 0; t < 2; ++t) { q0[t] = mm<true>(aX, bT[t], cx[t]); if (kd < 4) { q1[t] = mm<true>(aP, bT[t], z4); q2[t] = mm<false>(aP, bT[t], z4); } }
#pragma unroll
            for (int t = 0; t < 2; ++t) { st4(RSL(xo), orm[t], q0[t]); if (kd < 4) { st4(RSL(po), orm[t], q1[t]); st4(RSL(to), otr[t], q2[t]); } }
            LBAR();
        }
        {
            const f32x4 z4 = (f32x4){0.f, 0.f, 0.f, 0.f};
            const Fr2 aT = ldf(RSL(11), fm); Fr2 bA[2], bZ[2];
#pragma unroll
            for (int t = 0; t < 2; ++t) { bA[t] = ldt(RSL(0), tb0[t], tb1[t]); bZ[t] = ldf(RSL(2), fn[t]); }
            f32x4 q0[2], q1[2];
#pragma unroll
            for (int t = 0; t < 2; ++t) { q0[t] = mm<false>(aT, bA[t], z4); q1[t] = mm<false>(aT, bZ[t], z4); }
#pragma unroll
            for (int t = 0; t < 2; ++t) { st4(RSL(3), otr[t], q0[t]); st4(RSL(7), otr[t], q1[t]); }
        }
        LBAR();
        {
            const f32x4 z4 = (f32x4){0.f, 0.f, 0.f, 0.f};
            f32x4 p1[2], y0[2], gt[2], hh[2];
            {   const Fr2 aMb = ldf(RSL(8), fm), aMk = ldf(RSL(9), fm); Fr2 bW[2], bU[2], bV[2]; f32x4 cR[2];
#pragma unroll
                for (int t = 0; t < 2; ++t) { bW[t] = ldf(RSL(3), fn[t]); bU[t] = ldf(RSL(7), fn[t]); bV[t] = ldt(RSL(6), tb0[t], tb1[t]); cR[t] = ld4(RSL(1), orm[t]); }
#pragma unroll
                for (int t = 0; t < 2; ++t) { p1[t] = mm<true>(aMb, bW[t], cR[t]); y0[t] = mm<true>(aMk, bV[t], mm<true>(aMb, bU[t], z4)); } }
            {   const Fr2 aW = ldf(RSL(3), fm), aU = ldf(RSL(7), fm), aV = ldt(RSL(6), ta0, ta1); Fr2 bBh[2], bKh[2];
#pragma unroll
                for (int t = 0; t < 2; ++t) { bBh[t] = ldt(RSL(4), tb0[t], tb1[t]); bKh[t] = ldt(RSL(5), tb0[t], tb1[t]); }
#pragma unroll
                for (int t = 0; t < 2; ++t) { gt[t] = mm<false>(aW, bBh[t], z4); hh[t] = mm<true>(aV, bKh[t], mm<true>(aU, bBh[t], z4)); } }
#pragma unroll
            for (int t = 0; t < 2; ++t) {
                s_p1[t].x = pkbf(p1[t][0], p1[t][1]); s_p1[t].y = pkbf(p1[t][2], p1[t][3]); s_gt[t].x = pkbf(gt[t][0], gt[t][1]); s_gt[t].y = pkbf(gt[t][2], gt[t][3]);
                s_y0[t].x = pkbf(y0[t][0], y0[t][1]); s_y0[t].y = pkbf(y0[t][2], y0[t][3]); s_hh[t].x = pkbf(hh[t][0], hh[t][1]); s_hh[t].y = pkbf(hh[t][2], hh[t][3]); }
            s_jo = jo; s_have = true;
        }
    }
    if (s_have) P6A_STORE();
#undef P6A_LOAD
#undef P6A_STORE
    LBAR();
}
__device__ __forceinline__ void p6b_rwkv_seq(Frame& F, const RwArgs& A, const RwX& X, int nwg) {
    using namespace rwk;
    LAS unsigned char* lds = F.lds + RING_OFF;
    constexpr int YLD = 68;
    LAS float* Yf0 = (LAS float*)RSL(6);
    const int tid = F.tid, tok = tid >> 3, dg = tid & 7, lane = F.lane, fr = lane & 15, fq = lane >> 4;
    const int w = F.wave, m0 = 16 * (w >> 1), n0a = 32 * (w & 1);
    const int fm = swz(m0 + fr, fq * 16);
    int fn[2], orm[2], otr[2];
#pragma unroll
    for (int t = 0; t < 2; ++t) { const int n0 = n0a + 16 * t; fn[t] = swz(n0 + fr, fq * 16); orm[t] = swz(m0 + fr, 2 * (n0 + 4 * fq)); otr[t] = swz(n0 + fr, 2 * (m0 + 4 * fq)); }
    for (int unit = blockIdx.x; unit < BATCH * NH; unit += nwg) {
        const int b = unit >> 3, h = unit & 7; const int cb = 64 * h + 8 * dg;
        f32x4 sacc[2]; sacc[0] = (f32x4){0.f, 0.f, 0.f, 0.f}; sacc[1] = sacc[0];
        for (int u = tid; u < SLOT / 4; u += NWAVES * 64) ((LAS unsigned*)RSL(4))[u] = 0u;
        float lnw[8], lnb[8]; ld8f(A.ln_w + cb, lnw); ld8f(A.ln_b + cb, lnb);
        struct Nx { v4u vb, g; u32x2g p1[2], gt[2], y0[2], h[2]; f32x4 ge[2]; };
        Nx nA, nB;
#define P6B_LOAD(cc, N) do { const int job_ = unit * 32 + (cc); const size_t jo_ = (size_t)job_ * 4096; const size_t grow_ = (size_t)b * SEQ + (cc) * 64 + tok; \
            _Pragma("unroll") for (int t = 0; t < 2; ++t) { N.y0[t] = *(const u32x2g*)(X.Y0 + jo_ + ((w * 2 + t) * 64 + lane) * 4); N.h[t] = *(const u32x2g*)(X.H + jo_ + ((w * 2 + t) * 64 + lane) * 4); \
                N.p1[t] = *(const u32x2g*)(X.P1 + jo_ + ((w * 2 + t) * 64 + lane) * 4); N.gt[t] = *(const u32x2g*)(X.GT + jo_ + ((w * 2 + t) * 64 + lane) * 4); \
                N.ge[t] = *(const f32x4*)(X.GE + (size_t)job_ * 64 + n0a + 16 * t + 4 * fq); } \
            const bf16* vbp_ = (job_ < 2048) ? (X.VB0 + jo_) : (X.VB1 + (jo_ - (size_t)2048 * 4096)); \
            N.vb = *(const v4u*)(vbp_ + tok * 64 + 8 * dg); N.g = *(const v4u*)(X.G + jo_ + tok * 64 + 8 * dg); } while (0)
#define P6B_OUT(par, vbw_, gw_, grow_) do { float y[8]; ld8l(Yf0 + (par) * (64 * YLD) + tok * YLD + 8 * dg, y); \
            const float g[8] = {bflo(gw_.x), bfhi(gw_.x), bflo(gw_.y), bfhi(gw_.y), bflo(gw_.z), bfhi(gw_.z), bflo(gw_.w), bfhi(gw_.w)}; \
            const float vb[8] = {bflo(vbw_.x), bfhi(vbw_.x), bflo(vbw_.y), bfhi(vbw_.y), bflo(vbw_.z), bfhi(vbw_.z), bflo(vbw_.w), bfhi(vbw_.w)}; \
            float s_ = 0.f; _Pragma("unroll") for (int j = 0; j < 8; ++j) s_ += y[j]; \
            const float mean = sum8(s_) * (1.0f / 64.0f); float q_ = 0.f; \
            _Pragma("unroll") for (int j = 0; j < 8; ++j) { y[j] -= mean; q_ += y[j] * y[j]; } \
            const float rstd = __builtin_amdgcn_rsqf(sum8(q_) * (1.0f / 64.0f) + LNX_EPS); float ov[8]; \
            _Pragma("unroll") for (int j = 0; j < 8; ++j) ov[j] = (y[j] * rstd * lnw[j] + lnb[j] + vb[j]) * g[j]; \
            v4u wv_; wv_.x = pkbf(ov[0], ov[1]); wv_.y = pkbf(ov[2], ov[3]); wv_.z = pkbf(ov[4], ov[5]); wv_.w = pkbf(ov[6], ov[7]); \
            *(GAS v4u*)(A.QO + (grow_) * D + 512 + cb) = wv_; } while (0)
        v4u p_vb = (v4u){0u, 0u, 0u, 0u}, p_g = p_vb; size_t p_row = 0;
#define P6B_STEP(c, N) do { const int par = (c) & 1, scur = 4 + par, snxt = 5 - par; const size_t grow = (size_t)b * SEQ + (c) * 64 + tok; \
            _Pragma("unroll") for (int t = 0; t < 2; ++t) { *(LAS u32x2g*)(RSL(par) + orm[t]) = N.p1[t]; *(LAS u32x2g*)(RSL(2 + par) + otr[t]) = N.gt[t]; } \
            f32x4 yacc[2], hcur[2], gecur[2]; \
            _Pragma("unroll") for (int t = 0; t < 2; ++t) { yacc[t] = (f32x4){bflo(N.y0[t].x), bfhi(N.y0[t].x), bflo(N.y0[t].y), bfhi(N.y0[t].y)}; hcur[t] = (f32x4){bflo(N.h[t].x), bfhi(N.h[t].x), bflo(N.h[t].y), bfhi(N.h[t].y)}; gecur[t] = N.ge[t]; } \
            const v4u vbw = N.vb, gw = N.g; \
            if ((c) + 2 < SEQ / 64) P6B_LOAD((c) + 2, N); \
            LBAR(); \
            {   const Fr2 aP1 = ldf(RSL(par), fm), aS = ldf(RSL(scur), fm); Fr2 bS[2], bG[2]; \
                _Pragma("unroll") for (int t = 0; t < 2; ++t) { bS[t] = ldf(RSL(scur), fn[t]); bG[t] = ldf(RSL(2 + par), fn[t]); } \
                _Pragma("unroll") for (int t = 0; t < 2; ++t) { yacc[t] = mm<true>(aP1, bS[t], yacc[t]); sacc[t] = mm<true>(aS, bG[t], sacc[t] * gecur[t] + hcur[t]); } \
                _Pragma("unroll") for (int t = 0; t < 2; ++t) { const int n0 = n0a + 16 * t; *(LAS f32x4*)(Yf0 + par * (64 * YLD) + (m0 + fr) * YLD + n0 + 4 * fq) = yacc[t]; st4(RSL(snxt), orm[t], sacc[t]); } } \
            if ((c) > 0) P6B_OUT(par ^ 1, p_vb, p_g, p_row);                    \
            p_vb = vbw; p_g = gw; p_row = grow; } while (0)
        P6B_LOAD(0, nA); P6B_LOAD(1, nB);
        for (int c = 0; c < SEQ / 64; c += 2) {
            P6B_STEP(c, nA);
            P6B_STEP(c + 1, nB);
        }
#undef P6B_STEP
        LBAR();
        P6B_OUT(1, p_vb, p_g, p_row);
#undef P6B_LOAD
#undef P6B_OUT
        LBAR();
    }
}

namespace sba {
using bf16x8 = __attribute__((ext_vector_type(8))) short;
using s16x4 = __attribute__((ext_vector_type(4))) short;
using f32x16 = __attribute__((ext_vector_type(16))) float;
using u32x4 = __attribute__((ext_vector_type(4))) unsigned;
constexpr int QB = 256, KVBLK = 64;
constexpr int LDS_K = 0, LDS_V = 16384, LDS_ST = 32768, ST_LD = 68, LDS_FLAG = LDS_ST + 8 * 32 * ST_LD * 4, LDS_BYTES_ATT = LDS_FLAG + 64;
constexpr float R_DEAD = -160.0f;
#define SBAR() __builtin_amdgcn_sched_barrier(0)
typedef float f32x2_t __attribute__((ext_vector_type(2))); typedef __bf16 bf16x2_t __attribute__((ext_vector_type(2)));
__device__ __forceinline__ unsigned cvtpk_s(float lo, float hi) { f32x2_t v = {lo, hi}; bf16x2_t b = __builtin_convertvector(v, bf16x2_t); return __builtin_bit_cast(unsigned, b); }
__device__ __forceinline__ void qkt(f32x16& p0, f32x16& p1, const char* Kslot, const bf16x8* qr, int r32, int hi) {
    const char* kb = Kslot + hi * 1024 + r32 * 16;
    const f32x16 z = f32x16{};
#pragma unroll
    for (int d0 = 0; d0 < 4; ++d0) {
        const bf16x8 b0 = *reinterpret_cast<const bf16x8*>(kb + d0 * 2048);
        const bf16x8 b1 = *reinterpret_cast<const bf16x8*>(kb + d0 * 2048 + 512);
        if (d0 == 0) { p0 = __builtin_amdgcn_mfma_f32_32x32x16_bf16(b0, qr[0], z, 0, 0, 0); p1 = __builtin_amdgcn_mfma_f32_32x32x16_bf16(b1, qr[0], z, 0, 0, 0); }
        else { p0 = __builtin_amdgcn_mfma_f32_32x32x16_bf16(b0, qr[d0], p0, 0, 0, 0); p1 = __builtin_amdgcn_mfma_f32_32x32x16_bf16(b1, qr[d0], p1, 0, 0, 0); }
    }
}
__device__ __forceinline__ void pv(f32x16* o, int vb, bf16x8 pa0, bf16x8 pa1, bf16x8 pa2, bf16x8 pa3) {
#pragma unroll
    for (int d0 = 0; d0 < 2; ++d0) { s16x4 lo[4], hi[4];
#pragma unroll
        for (int ks = 0; ks < 4; ++ks) {
            asm volatile("ds_read_b64_tr_b16 %0,%1 offset:%c2" : "=&v"(lo[ks]) : "v"(vb), "i"(d0 * 4096 + ks * 1024) : "memory");
            asm volatile("ds_read_b64_tr_b16 %0,%1 offset:%c2" : "=&v"(hi[ks]) : "v"(vb), "i"(d0 * 4096 + ks * 1024 + 512) : "memory"); }
        asm volatile("s_waitcnt lgkmcnt(0)" ::: "memory"); SBAR();
#define PK(k) (bf16x8){lo[k][0], lo[k][1], lo[k][2], lo[k][3], hi[k][0], hi[k][1], hi[k][2], hi[k][3]}
        o[d0] = __builtin_amdgcn_mfma_f32_32x32x16_bf16(pa0, PK(0), o[d0], 0, 0, 0);
        o[d0] = __builtin_amdgcn_mfma_f32_32x32x16_bf16(pa1, PK(1), o[d0], 0, 0, 0);
        o[d0] = __builtin_amdgcn_mfma_f32_32x32x16_bf16(pa2, PK(2), o[d0], 0, 0, 0);
        o[d0] = __builtin_amdgcn_mfma_f32_32x32x16_bf16(pa3, PK(3), o[d0], 0, 0, 0);
#undef PK
    }
}
__device__ __forceinline__ float swap_sum(float x, float& other_if_lo, int hi) {
    auto rr = __builtin_amdgcn_permlane32_swap(__float_as_uint(x), __float_as_uint(x), false, false);
    const float a = __uint_as_float(rr[0]), b = __uint_as_float(rr[1]);
    other_if_lo = hi ? 0.f : b;
    return a + b;
}
__device__ __forceinline__ float swap_prod(float x, float& other_if_lo, int hi) {
    auto rr = __builtin_amdgcn_permlane32_swap(__float_as_uint(x), __float_as_uint(x), false, false);
    const float a = __uint_as_float(rr[0]), b = __uint_as_float(rr[1]);
    other_if_lo = hi ? 1.0f : b;
    return a * b;
}
__device__ __forceinline__ void attn_wave_unit(int b, int h, int qblk, bf16* QO, const bf16* __restrict__ KB, const bf16* __restrict__ VB, const float* gout, char* wsm  ) {
    const int lane = threadIdx.x & 63, r32 = lane & 31, hi = lane >> 5;
    const long rowbase = (long)b * SEQ; const int q0 = qblk * 32;
    bf16* Qw = QO + (rowbase + q0) * D + h * HD;
    const bf16* Kh = KB + rowbase * SBW + h * HD; const bf16* Vh = VB + rowbase * SBW + h * HD;
    const unsigned lds0 = (unsigned)(uintptr_t)wsm;
    const int jtop = (q0 + 30) >> 6;
    const bf16* vsrc = Vh + (long)(lane >> 3) * SBW + (lane & 7) * 8;
    const int vdst0 = ((lane & 7) >> 2) * 4096 + ((lane >> 3) & 15) * 64 + (lane & 3) * 16;
    const int vb0 = (int)lds0 + ((lane >> 4) & 1) * 32 + (lane & 3) * 8 + (4 * hi + ((lane & 15) >> 2)) * 64;
    const bf16* ksrc = Kh + (long)r32 * SBW + hi * 8;
    bf16x8 qr[4];
#pragma unroll
    for (int d0 = 0; d0 < 4; ++d0) qr[d0] = *reinterpret_cast<const bf16x8*>(&Qw[(long)r32 * D + d0 * 16 + hi * 8]);
    bf16x8 kf[8]; u32x4 vr[8];
#define SBA_LOAD(t) do { const bf16* kp_ = ksrc + (long)(t) * KVBLK * SBW; const bf16* vp_ = vsrc + (long)(t) * KVBLK * SBW; \
        _Pragma("unroll") for (int d0 = 0; d0 < 4; ++d0) { kf[2 * d0] = *reinterpret_cast<const bf16x8*>(kp_ + d0 * 16); kf[2 * d0 + 1] = *reinterpret_cast<const bf16x8*>(kp_ + 32 * SBW + d0 * 16); } \
        _Pragma("unroll") for (int i = 0; i < 8; ++i) vr[i] = *(const u32x4*)(vp_ + (long)(8 * i) * SBW); } while (0)
    SBA_LOAD(jtop);
    float R = 0.f; f32x16 o[2]; o[0] = f32x16{}; o[1] = f32x16{};
    const int qrow = q0 + r32;
    for (int jt = jtop; jt >= 0; --jt) {
        const int cur = (jtop - jt) & 1;
#pragma unroll
        for (int i = 0; i < 8; ++i) *(u32x4*)(wsm + cur * 8192 + vdst0 + (i >> 1) * 1024 + (i & 1) * 512) = vr[i];
        f32x16 p0, p1;
        {   const f32x16 z = f32x16{};
            p0 = __builtin_amdgcn_mfma_f32_32x32x16_bf16(kf[0], qr[0], z, 0, 0, 0); p1 = __builtin_amdgcn_mfma_f32_32x32x16_bf16(kf[1], qr[0], z, 0, 0, 0);
#pragma unroll
            for (int d0 = 1; d0 < 4; ++d0) { p0 = __builtin_amdgcn_mfma_f32_32x32x16_bf16(kf[2 * d0], qr[d0], p0, 0, 0, 0); p1 = __builtin_amdgcn_mfma_f32_32x32x16_bf16(kf[2 * d0 + 1], qr[d0], p1, 0, 0, 0); } }
        if (jt > 0) SBA_LOAD(jt - 1);
        const int kb = 64 * jt + 4 * hi; const bool diag = (jt == jtop);
#pragma unroll
        for (int r = 0; r < 16; ++r) {
            { float rr = __builtin_amdgcn_rcpf(1.0f + __builtin_amdgcn_exp2f(p0[r]));
              if (diag) { const int key = kb + (r & 3) + 8 * (r >> 2); if (key >= qrow) rr = 1.0f; }
              p0[r] = rr; }
            { float rr = __builtin_amdgcn_rcpf(1.0f + __builtin_amdgcn_exp2f(p1[r]));
              if (diag) { const int key = kb + 32 + (r & 3) + 8 * (r >> 2); if (key >= qrow) rr = 1.0f; }
              p1[r] = rr; }
        }
        float c0[4], c1[4], x0[4], x1[4];
#pragma unroll
        for (int g = 0; g < 4; ++g) {
            const float s0 = (p0[4 * g] * p0[4 * g + 1]) * (p0[4 * g + 2] * p0[4 * g + 3]);
            const float s1 = (p1[4 * g] * p1[4 * g + 1]) * (p1[4 * g + 2] * p1[4 * g + 3]);
            c0[g] = swap_prod(s0, x0[g], hi); c1[g] = swap_prod(s1, x1[g], hi);
        }
        const float Cr = __builtin_amdgcn_exp2f(R);
        float suf0[4], suf1[4];
        suf1[3] = Cr; suf1[2] = suf1[3] * c1[3]; suf1[1] = suf1[2] * c1[2]; suf1[0] = suf1[1] * c1[1];
        suf0[3] = suf1[0] * c1[0]; suf0[2] = suf0[3] * c0[3]; suf0[1] = suf0[2] * c0[2]; suf0[0] = suf0[1] * c0[1];
        R += __builtin_amdgcn_logf(((c0[0] * c0[1]) * (c0[2] * c0[3])) * ((c1[0] * c1[1]) * (c1[2] * c1[3])));
#pragma unroll
        for (int g = 0; g < 4; ++g) {
            { const float e3 = suf0[g] * x0[g], e2 = e3 * p0[4 * g + 3], e1 = e2 * p0[4 * g + 2], e0 = e1 * p0[4 * g + 1];
              p0[4 * g + 3] = (1.0f - p0[4 * g + 3]) * e3; p0[4 * g + 2] = (1.0f - p0[4 * g + 2]) * e2; p0[4 * g + 1] = (1.0f - p0[4 * g + 1]) * e1; p0[4 * g] = (1.0f - p0[4 * g]) * e0; }
            { const float e3 = suf1[g] * x1[g], e2 = e3 * p1[4 * g + 3], e1 = e2 * p1[4 * g + 2], e0 = e1 * p1[4 * g + 1];
              p1[4 * g + 3] = (1.0f - p1[4 * g + 3]) * e3; p1[4 * g + 2] = (1.0f - p1[4 * g + 2]) * e2; p1[4 * g + 1] = (1.0f - p1[4 * g + 1]) * e1; p1[4 * g] = (1.0f - p1[4 * g]) * e0; }
        }
#define PKW(P, B) cvtpk_s(P[B], P[B + 1])
        const u32x4 pw0 = (u32x4){PKW(p0, 0), PKW(p0, 2), PKW(p0, 4), PKW(p0, 6)}, pw1 = (u32x4){PKW(p0, 8), PKW(p0, 10), PKW(p0, 12), PKW(p0, 14)};
        const u32x4 pw2 = (u32x4){PKW(p1, 0), PKW(p1, 2), PKW(p1, 4), PKW(p1, 6)}, pw3 = (u32x4){PKW(p1, 8), PKW(p1, 10), PKW(p1, 12), PKW(p1, 14)};
#undef PKW
        SBAR();
        asm volatile("s_waitcnt lgkmcnt(0)" ::: "memory");
        pv(o, vb0 + cur * 8192, __builtin_bit_cast(bf16x8, pw0), __builtin_bit_cast(bf16x8, pw1), __builtin_bit_cast(bf16x8, pw2), __builtin_bit_cast(bf16x8, pw3));
        if (__all(R < R_DEAD)) break;
    }
#undef SBA_LOAD
    {
        float* stg = (float*)wsm;
        asm volatile("s_waitcnt lgkmcnt(0)" ::: "memory");
#pragma unroll
        for (int r = 0; r < 16; ++r) { const int orow = (r & 3) + 8 * (r >> 2) + 4 * hi;
#pragma unroll
            for (int d0 = 0; d0 < 2; ++d0) stg[orow * ST_LD + d0 * 32 + r32] = o[d0][r]; }
        asm volatile("s_waitcnt lgkmcnt(0)" ::: "memory");
        const int ch = lane & 7;
        const f32x4 ga = *(const f32x4*)(gout + h * HD + ch * 8), gb = *(const f32x4*)(gout + h * HD + ch * 8 + 4);
#pragma unroll
        for (int i = 0; i < 4; ++i) { const int row = i * 8 + (lane >> 3);
            const f32x4 a = *(const f32x4*)(stg + row * ST_LD + ch * 8), c = *(const f32x4*)(stg + row * ST_LD + ch * 8 + 4);
            float ss = (a.x * a.x + a.y * a.y) + (a.z * a.z + a.w * a.w) + (c.x * c.x + c.y * c.y) + (c.z * c.z + c.w * c.w);
            ss = sum8(ss);
            const float hs = __builtin_amdgcn_rsqf(ss * (1.0f / 64.0f) + 1e-6f);
            u32x4 w; w.x = cvtpk_s(a.x * hs * ga.x, a.y * hs * ga.y); w.y = cvtpk_s(a.z * hs * ga.z, a.w * hs * ga.w);
            w.z = cvtpk_s(c.x * hs * gb.x, c.y * hs * gb.y); w.w = cvtpk_s(c.z * hs * gb.z, c.w * hs * gb.w);
            *(u32x4*)(Qw + (long)row * D + ch * 8) = w; }
        asm volatile("s_waitcnt lgkmcnt(0)" ::: "memory");
    }
}
#undef SBAR
__device__ __forceinline__ void attn_phase(Frame& F, bf16* QO, const bf16* KB, const bf16* VB, const float* gout, unsigned* queue, int first_ticket, int ticket_base) {
    char* wsm = (char*)F.lds + RING_OFF + F.wave * 16384;
    const int nunits = BATCH * NH * (SEQ / 32);
    int pend = -1; int tfirst = first_ticket;
    for (;;) {
        int uu;
        if (pend >= 0) { uu = pend; pend = -1; }
        else { unsigned t;
               if (tfirst >= 0) { t = (unsigned)tfirst; tfirst = -1; }
               else { t = 0u; if (F.lane == 0) t = __hip_atomic_fetch_add(queue, 1u, __ATOMIC_RELAXED, __HIP_MEMORY_SCOPE_AGENT); t = (unsigned)__builtin_amdgcn_readfirstlane((int)t) + (unsigned)ticket_base; }
               if (2u * t >= (unsigned)nunits) break; uu = (int)(2u * t); pend = uu + 1; }
        attn_wave_unit(uu >> 9, (uu >> 6) & 7, uu & 63, QO, KB, VB, gout, wsm);
    }
    __syncthreads();
}
}

struct Args { const float* in[26]; float* out; unsigned char* ws; int ph_lo, ph_hi, li, pad; };
__global__ void __launch_bounds__(NWAVES * 64, 2) skel_fwd(Args args) {
    extern __shared__ __attribute__((aligned(16))) unsigned char lds[];
    Frame F;
    F.lds = (LAS unsigned char*)lds;
    F.MISC = (volatile LAS unsigned*)(F.lds + MISC_OFF);
    F.tid = threadIdx.x; F.lane = F.tid & 63; F.wave = __builtin_amdgcn_readfirstlane(F.tid >> 6);
    F.G = gridDim.x; { const int bx = blockIdx.x; F.vcu = (F.G % 8 == 0) ? (bx % 8) * (F.G / 8) + bx / 8 : bx; }
    unsigned char* ws = args.ws;
    F.ctl = (gu32*)(ws + WS_CTL);
    const float* x = args.in[0];
    bf16* W1U = (bf16*)(ws + WS_W1U); bf16* W1D = (bf16*)(ws + WS_W1D); bf16* W2U = (bf16*)(ws + WS_W2U); bf16* W2D = (bf16*)(ws + WS_W2D);
    bf16* WIN = (bf16*)(ws + WS_WIN); bf16* WOUT = (bf16*)(ws + WS_WOUT); bf16* WLORA = (bf16*)(ws + WS_WLORA);
    bf16* XB = (bf16*)(ws + WS_XB); bf16* ACT = (bf16*)(ws + WS_ACT); bf16* QO = (bf16*)(ws + WS_QO); bf16* KB = (bf16*)(ws + WS_KB); bf16* VB = (bf16*)(ws + WS_VB);
    bf16* RW = (bf16*)(ws + WS_RW); bf16* ALORA = (bf16*)(ws + WS_ALORA); float* LW = (float*)(ws + WS_LW); bf16* AB = (bf16*)(ws + WS_AB); bf16* GB = (bf16*)(ws + WS_GB);
    float* SSQ = (float*)(ws + WS_SSQ); float* out = args.out;
    for (int u = F.tid; u < (LDS_BYTES - LDSCTL_OFF) / 4; u += NWAVES * 64) ((LAS unsigned*)(F.lds + LDSCTL_OFF))[u] = 0u;
    __syncthreads();
    XcdBarrier bar; bar.bar = (unsigned*)(F.ctl + CW_BAR); bar.x = 0; bar.st = nullptr;
    if (N_LAUNCHES != PER_PHASE) bar = xcd_barrier_post((unsigned*)(F.ctl + CW_BAR), F.MISC + 8);
#define GRID_BAR(seam) do { if (N_LAUNCHES == PER_PHASE) { if (F.tid == 0) __hip_atomic_store(F.ctl + CW_TMO, 0xBADBA0u | (unsigned)(seam), RLX_AGENT); } else { xcd_barrier(bar); } } while (0)
    const int lo = args.ph_lo, hi = args.ph_hi;
#define IN(k) (lo <= (k) && (k) < hi)
#define BOTH(k) (IN(k) && IN((k) + 1))
    if (IN(0)) {
        p0_prologue(F, x, args.in[1], args.in[2], args.in[3], args.in[4], args.in[5], args.in[6], args.in[12], args.in[14], args.in[15], args.in[21], args.in[22], args.in[23], args.in[24], args.in[25],
                    W1U, W1D, W2U, W2D, WIN, WOUT, WLORA, XB, SSQ); if (BOTH(0)) GRID_BAR(0);
    }
    if (IN(1)) {
        pg8::Gemm g{XB, W1U, M, 2 * FF, D}; pg8::StaticOrder S; S.init(M, 2 * FF, F.G, (int)blockIdx.x);
        pg8::EpiSwiGLU E{ACT, FF, SSQ};
        pg8::gemm_phase<pg8::EpiSwiGLU, pg8::StaticOrder, true, true>(F.lds + RING_OFF, g, S, E);
        if (BOTH(1)) GRID_BAR(1);
    }
    if (IN(2)) {
        pg8::Gemm g{ACT, W1D, M, D, FF}; pg8::StaticOrder S; S.init(M, D, F.G, (int)blockIdx.x);
        pg8::EpiResid E{XB, nullptr, XB, SSQ, 0.5f, 1};
        pg8::gemm_phase<pg8::EpiResid, pg8::StaticOrder, true, true>(F.lds + RING_OFF, g, S, E);
        if (BOTH(2)) GRID_BAR(2);
    }
    if (IN(3)) {
        pg8::Gemm g{XB, WIN, M, PW, D}; pg8::StaticOrder S; S.init(M, PW, F.G, (int)blockIdx.x);
        pg8::EpiWin E{QO, KB, VB, RW, SSQ, args.in[7], args.in[8], 0.125f * 1.4426950408889634f};
        pg8::gemm_phase<pg8::EpiWin, pg8::StaticOrder, true, true>(F.lds + RING_OFF, g, S, E);
        if (F.G >= 256) {
            const int nlo = (M / 256) * (PW / 256) - 6 * F.G;
            if ((int)blockIdx.x >= nlo) { __syncthreads();
                p0_items(F, x, args.in[1], args.in[2], args.in[3], args.in[4], args.in[5], args.in[6], args.in[12], args.in[14], args.in[15], args.in[21], args.in[22], args.in[23], args.in[24], args.in[25],
                         W1U, W1D, W2U, W2D, WIN, WOUT, WLORA, XB, SSQ, 1, ((int)blockIdx.x - nlo) * NWAVES + F.wave, (F.G - nlo) * NWAVES); }
        }
        if (BOTH(3)) GRID_BAR(3);
    }
    if (IN(6)) {
        RwArgs A{RW, WLORA, WLORA + 512 * 64, WLORA + 2 * 512 * 64, args.in[11], args.in[13], QO, args.in[10], args.in[16], args.in[17], args.in[18], args.in[19], args.in[20]};
        bf16* ob = (bf16*)out;
        RwX X{ob + (size_t)32 * 1024 * 1024, ob + (size_t)48 * 1024 * 1024, (bf16*)LW, (bf16*)LW + (size_t)16 * 1024 * 1024, AB, AB + (size_t)8 * 1024 * 1024, SSQ, GB};
        p6a_rwkv_local(F, A, X);
        GRID_BAR(16);
        const int nseq = (F.G >= 2 * BATCH * NH) ? BATCH * NH : F.G;
        if ((int)blockIdx.x < nseq) { p6b_rwkv_seq(F, A, X, nseq); __syncthreads(); }
        const int nfree = (F.G - nseq) * NWAVES;
        sba::attn_phase(F, QO, KB, VB, args.in[9], (unsigned*)(F.ctl + CW_QUEUE), ((int)blockIdx.x >= nseq) ? ((int)blockIdx.x - nseq) * NWAVES + F.wave : -1, nfree);
        if (BOTH(6)) GRID_BAR(6);
    }
    if (IN(8)) {
        pg8::Gemm g{QO, WOUT, M, D, D}; pg8::StaticOrder S; S.init(M, D, F.G, (int)blockIdx.x);
        pg8::EpiResid E{XB, nullptr, XB, SSQ, 1.0f, 1};
        pg8::gemm_phase<pg8::EpiResid, pg8::StaticOrder, true, true>(F.lds + RING_OFF, g, S, E);
        if (BOTH(8)) GRID_BAR(8);
    }
    if (IN(9)) {
        pg8::Gemm g{XB, W2U, M, 2 * FF, D}; pg8::StaticOrder S; S.init(M, 2 * FF, F.G, (int)blockIdx.x);
        pg8::EpiSwiGLU E{ACT, FF, SSQ};
        pg8::gemm_phase<pg8::EpiSwiGLU, pg8::StaticOrder, true, true>(F.lds + RING_OFF, g, S, E);
        if (BOTH(9)) GRID_BAR(9);
    }
    if (IN(10)) {
        pg8::Gemm g{ACT, W2D, M, D, FF}; pg8::StaticOrder S; S.init(M, D, F.G, (int)blockIdx.x);
        pg8::EpiResid E{XB, out, nullptr, SSQ, 0.5f, 0};
        pg8::gemm_phase<pg8::EpiResid, pg8::StaticOrder, true, true>(F.lds + RING_OFF, g, S, E);
    }
#undef IN
#undef BOTH
}

extern "C" void kernel_launch(void* const* d_in, const int* in_sizes, int n_in, void* d_out, int out_size, void* d_ws, size_t ws_size, hipStream_t stream) {
    static int grid = 0;
    if (grid == 0) {
        if (n_in != 26 || in_sizes[0] != M * D || out_size != M * D || ws_size < WS_END) { fprintf(stderr, "kernel_launch: unexpected shapes: n_in %d in0 %d out %d ws %zu (need %zu)\n", n_in, n_in > 0 ? in_sizes[0] : -1, out_size, ws_size, (size_t)WS_END); grid = -1; return; }
        int dev = 0, cus = 0, per_cu = 0;
        if (hipGetDevice(&dev) != hipSuccess || hipDeviceGetAttribute(&cus, hipDeviceAttributeMultiprocessorCount, dev) != hipSuccess) { grid = -1; return; }
        if (hipFuncSetAttribute((const void*)skel_fwd, hipFuncAttributeMaxDynamicSharedMemorySize, LDS_BYTES) != hipSuccess) { fprintf(stderr, "kernel_launch: hipFuncSetAttribute failed\n"); grid = -1; return; }
        if (hipOccupancyMaxActiveBlocksPerMultiprocessor(&per_cu, (const void*)skel_fwd, NWAVES * 64, LDS_BYTES) != hipSuccess || per_cu < 1) { fprintf(stderr, "kernel_launch: occupancy query reports %d blocks per CU\n", per_cu); per_cu = 1; }
        (void)hipGetLastError();
        grid = cus;
    }
    if (grid < 0) return;
    if (hipMemsetAsync((char*)d_ws + WS_CTL, 0, CTL_ZERO_BYTES, stream) != hipSuccess) return;
    Args a{};
    for (int i = 0; i < 26; ++i) a.in[i] = (const float*)d_in[i];
    a.out = (float*)d_out; a.ws = (unsigned char*)d_ws;
    for (int li = 0; li < N_LAUNCHES; ++li) {
        a.ph_lo = (N_LAUNCHES == PER_PHASE) ? li : 0; a.ph_hi = (N_LAUNCHES == PER_PHASE) ? li + 1 : PER_PHASE; a.li = li;
        hipLaunchKernelGGL(skel_fwd, dim3(grid), dim3(NWAVES * 64), LDS_BYTES, stream, a);
    }
}
```

```cpp
#include <hip/hip_runtime.h>
#include <hip/hip_bf16.h>
#include <cstdio>
#include <cstdint>
#include <cmath>
namespace pg8 {
#define PG8_LAS __attribute__((address_space(3)))
typedef unsigned short bf16_t;
typedef short bf16x8 __attribute__((ext_vector_type(8)));
typedef float f32x4 __attribute__((ext_vector_type(4)));
typedef unsigned u32x4 __attribute__((ext_vector_type(4)));
constexpr int BM = 256, BK = 64, HALF = 128, HTB = HALF * BK * 2  , STAGE_BYTES = 8 * HTB, NXCD = 8, WGM = 4;

__host__ __device__ __forceinline__ int lds_byte(int r, int c) { const int st = (r >> 4) * 2 + (c >> 5), rr = r & 15, cc = c & 31, ob = rr * 64 + cc * 2; return st * 1024 + (ob ^ (((ob >> 9) & 1) << 5)); }
__host__ __device__ __forceinline__ void stage_rc(int b, int& R, int& C) { const int st = b / 1024, sb = b % 1024, swz = sb ^ (((sb >> 9) & 1) << 5); R = (st >> 1) * 16 + swz / 64; C = (st & 1) * 32 + (swz % 64) / 2; }
__host__ __device__ __forceinline__ int perm32(int rho) { const int n = rho >> 4, i = rho & 15; return 8 * (i >> 2) + 4 * n + (i & 3); }

struct Unit { int pm, pn; };
struct Gemm { const bf16_t* A; const bf16_t* Bt; int M, N, K; int ld; int ablk; };

struct StaticOrder {
    int nM, nN, nwg, G, c, rev;
    __host__ __device__ void init(int M, int N, int G_, int c_, int rev_ = 0) { nM = M / BM; nN = N / BM; nwg = nM * nN; G = G_; c = c_; rev = (rev_ && nwg % G_ == 0) ? nwg / G_ : 0; }
    __host__ __device__ bool next(int i, Unit& u) const {
        if (rev) { if (i >= rev) return false; i = rev - 1 - i; }
        const long L = (long)i * G + c; if (L >= nwg) return false;
        int wgid = (int)L; { const int q = nwg / NXCD, r = nwg % NXCD, xcd = wgid % NXCD, off = wgid / NXCD; wgid = (xcd < r ? xcd * (q + 1) : r * (q + 1) + (xcd - r) * q) + off; }
        const int nig = WGM * nN, gid = wgid / nig, fm = gid * WGM, gsz = (nM - fm) < WGM ? (nM - fm) : WGM;
        u.pm = fm + ((wgid % nig) % gsz); u.pn = (wgid % nig) / gsz; return true;
    }
    __device__ __forceinline__ void a_ready(const Unit&) const {}
    __device__ __forceinline__ void done(const Unit&) const {}
};


__device__ __forceinline__ unsigned cvt_pk_bf16(float lo, float hi) { unsigned r; asm volatile("v_cvt_pk_bf16_f32 %0, %1, %2" : "=v"(r) : "v"(lo), "v"(hi)); return r; }
typedef unsigned u32x2 __attribute__((ext_vector_type(2)));
constexpr float RMS_EPS_F = 1e-6f;
constexpr float LOG2E_F = 1.4426950408889634f;
__device__ __forceinline__ f32x4 row_q(const float* ssqp, int row, int fq) { return *(const f32x4*)(ssqp + (size_t)row * 16 + 4 * fq); }
__device__ __forceinline__ float rs_fin(const f32x4 q) {
    float s = (q[0] + q[1]) + (q[2] + q[3]);
    auto a = __builtin_amdgcn_permlane16_swap(__float_as_uint(s), __float_as_uint(s), false, false); s = __uint_as_float(a[0]) + __uint_as_float(a[1]);
    auto b = __builtin_amdgcn_permlane32_swap(__float_as_uint(s), __float_as_uint(s), false, false); s = __uint_as_float(b[0]) + __uint_as_float(b[1]);
    return __builtin_amdgcn_rsqf(s * (1.0f / 1024.0f) + RMS_EPS_F);
}
__device__ __forceinline__ float silu_f(float g) { return g * __builtin_amdgcn_rcpf(1.0f + __builtin_amdgcn_exp2f(-g * LOG2E_F)); }
__device__ __forceinline__ float sigmoid_f(float g) { return __builtin_amdgcn_rcpf(1.0f + __builtin_amdgcn_exp2f(-g * LOG2E_F)); }

struct EpiSwiGLU {
    static constexpr bool PERM = true, AFTER_DRAIN = false;
    bf16_t* O; int ldo; const float* ssqp;
    __device__ __forceinline__ static f32x4 swiglu4(const f32x4 g, const f32x4 uu, float nrs, float rs2) {
        const f32x4 t = g * nrs, gu = g * uu; f32x4 r;
#pragma unroll
        for (int i = 0; i < 4; ++i) r[i] = __builtin_amdgcn_rcpf(1.0f + __builtin_amdgcn_exp2f(t[i]));
        return gu * (r * rs2);
    }
    __device__ __forceinline__ void operator()(const f32x4 (&acc)[2][2][4][2], const Unit& u, int wr, int wc, int fr, int fq) const {
        const int row0 = u.pm * BM + wr * 64 + fr;
        const size_t obase = ((size_t)u.pm * (ldo / BK) + 2 * u.pn + (wc >> 1)) * (BM * BK) + (wc & 1) * 32 + 8 * fq;
        f32x4 q[2][4];
#pragma unroll
        for (int ai = 0; ai < 2; ++ai)
#pragma unroll
            for (int m = 0; m < 4; ++m) q[ai][m] = row_q(ssqp, row0 + ai * HALF + m * 16, fq);
        float rsv[2][4];
#pragma unroll
        for (int ai = 0; ai < 2; ++ai)
#pragma unroll
            for (int m = 0; m < 4; ++m) rsv[ai][m] = rs_fin(q[ai][m]);
#pragma unroll
        for (int ai = 0; ai < 2; ++ai)
#pragma unroll
            for (int m = 0; m < 4; ++m) {
                const int row = row0 + ai * HALF + m * 16; const float rs = rsv[ai][m], nrs = -LOG2E_F * rs, rs2 = rs * rs;
                const f32x4 o0 = swiglu4(acc[ai][0][m][0], acc[ai][1][m][0], nrs, rs2), o1 = swiglu4(acc[ai][0][m][1], acc[ai][1][m][1], nrs, rs2);
                u32x4 w; w.x = cvt_pk_bf16(o0[0], o0[1]); w.y = cvt_pk_bf16(o0[2], o0[3]); w.z = cvt_pk_bf16(o1[0], o1[1]); w.w = cvt_pk_bf16(o1[2], o1[3]);
                *(u32x4*)(O + obase + (size_t)(row - u.pm * BM) * BK) = w;
            }
    }
};

struct EpiResid {
    static constexpr bool PERM = true, AFTER_DRAIN = false;
    const bf16_t* bhi; float* outf; bf16_t* ohi; float* ssqp; float alpha; int aux;
    __device__ __forceinline__ static f32x4 up_bf(unsigned a, unsigned b) { return (f32x4){__uint_as_float(a << 16), __uint_as_float(a & 0xffff0000u), __uint_as_float(b << 16), __uint_as_float(b & 0xffff0000u)}; }
    __device__ __forceinline__ void operator()(const f32x4 (&acc)[2][2][4][2], const Unit& u, int wr, int wc, int fr, int fq) const {
        const int row0 = u.pm * BM + wr * 64 + fr, col0 = u.pn * BM + wc * 32 + 8 * fq;
        u32x4 bv[2][4][2];
#pragma unroll
        for (int ai = 0; ai < 2; ++ai)
#pragma unroll
            for (int m = 0; m < 4; ++m)
#pragma unroll
                for (int bj = 0; bj < 2; ++bj) bv[ai][m][bj] = *(const u32x4*)(bhi + (size_t)(row0 + ai * HALF + m * 16) * 1024 + col0 + bj * HALF);
        asm volatile("" ::: "memory");
#pragma unroll
        for (int ai = 0; ai < 2; ++ai)
#pragma unroll
            for (int m = 0; m < 4; ++m) {
                const int row = row0 + ai * HALF + m * 16; const size_t off = (size_t)row * 1024 + col0; float ss = 0.f;
#pragma unroll
                for (int bj = 0; bj < 2; ++bj) {
                    const u32x4 h = bv[ai][m][bj];
                    const f32x4 v0 = up_bf(h.x, h.y) + acc[ai][bj][m][0] * alpha, v1 = up_bf(h.z, h.w) + acc[ai][bj][m][1] * alpha;
                    if (aux) ss += ((v0[0] * v0[0] + v0[1] * v0[1]) + (v0[2] * v0[2] + v0[3] * v0[3])) + ((v1[0] * v1[0] + v1[1] * v1[1]) + (v1[2] * v1[2] + v1[3] * v1[3]));
                    if (outf) { *(f32x4*)(outf + off + bj * HALF) = v0; *(f32x4*)(outf + off + bj * HALF + 4) = v1; }
                    else { u32x4 w; w.x = cvt_pk_bf16(v0[0], v0[1]); w.y = cvt_pk_bf16(v0[2], v0[3]); w.z = cvt_pk_bf16(v1[0], v1[1]); w.w = cvt_pk_bf16(v1[2], v1[3]); *(u32x4*)(ohi + off + bj * HALF) = w; }
                }
                if (aux) { ss += __shfl_xor(ss, 16); ss += __shfl_xor(ss, 32); if (fq == 0) ssqp[(size_t)row * 16 + u.pn * 4 + wc] = ss; }
            }
    }
};

struct EpiWin {
    static constexpr bool PERM = true, AFTER_DRAIN = false;
    bf16_t* QO; bf16_t* KB; bf16_t* VB; bf16_t* RW; const float* ssqp; const float* gq; const float* gk; float qscale;
    __device__ __forceinline__ void operator()(const f32x4 (&acc)[2][2][4][2], const Unit& u, int wr, int wc, int fr, int fq) const {
        const int row0 = u.pm * BM + wr * 64 + fr; const int pn = u.pn;
        f32x4 q[2][4];
#pragma unroll
        for (int ai = 0; ai < 2; ++ai)
#pragma unroll
            for (int m = 0; m < 4; ++m) q[ai][m] = row_q(ssqp, row0 + ai * HALF + m * 16, fq);
        float rsv[2][4];
#pragma unroll
        for (int ai = 0; ai < 2; ++ai)
#pragma unroll
            for (int m = 0; m < 4; ++m) rsv[ai][m] = rs_fin(q[ai][m]);
        if (pn < 4) {
            const float* gp = (pn < 2) ? gq : gk; const float osc = (pn < 2) ? qscale : 1.0f;
            f32x4 gv[2][2];
#pragma unroll
            for (int bj = 0; bj < 2; ++bj)
#pragma unroll
                for (int n = 0; n < 2; ++n) gv[bj][n] = *(const f32x4*)(gp + 32 * bj + 8 * fq + 4 * n) * osc;
            bf16_t* dst = (pn < 2) ? QO : KB; const int ld = (pn < 2) ? 1024 : 512; const int colh = 64 * (4 * (pn & 1) + wc) + 8 * fq;
#pragma unroll
            for (int ai = 0; ai < 2; ++ai)
#pragma unroll
                for (int m = 0; m < 4; ++m) {
                    const int row = row0 + ai * HALF + m * 16; const float rs = rsv[ai][m];
                    f32x4 y[2][2]; float ss = 0.f;
#pragma unroll
                    for (int bj = 0; bj < 2; ++bj)
#pragma unroll
                        for (int n = 0; n < 2; ++n) { y[bj][n] = acc[ai][bj][m][n] * rs; const f32x4 t = y[bj][n]; ss += (t[0] * t[0] + t[1] * t[1]) + (t[2] * t[2] + t[3] * t[3]); }
                    ss += __shfl_xor(ss, 16); ss += __shfl_xor(ss, 32);
                    const float hs = __builtin_amdgcn_rsqf(ss * (1.0f / 64.0f) + RMS_EPS_F);
#pragma unroll
                    for (int bj = 0; bj < 2; ++bj) {
                        const f32x4 a = y[bj][0] * gv[bj][0] * hs, b = y[bj][1] * gv[bj][1] * hs;
                        u32x4 w; w.x = cvt_pk_bf16(a[0], a[1]); w.y = cvt_pk_bf16(a[2], a[3]); w.z = cvt_pk_bf16(b[0], b[1]); w.w = cvt_pk_bf16(b[2], b[3]);
                        *(u32x4*)(dst + (size_t)row * ld + colh + 32 * bj) = w;
                    }
                }
        } else {
            bf16_t* dst = (pn < 6) ? VB : RW; const int ld = (pn < 6) ? 512 : 1792; const int colh = 256 * ((pn < 6) ? (pn - 4) : (pn - 6)) + 64 * wc + 8 * fq;
#pragma unroll
            for (int ai = 0; ai < 2; ++ai)
#pragma unroll
                for (int m = 0; m < 4; ++m) {
                    const int row = row0 + ai * HALF + m * 16; const float rs = rsv[ai][m];
#pragma unroll
                    for (int bj = 0; bj < 2; ++bj) {
                        const f32x4 a = acc[ai][bj][m][0] * rs, b = acc[ai][bj][m][1] * rs;
                        u32x4 w; w.x = cvt_pk_bf16(a[0], a[1]); w.y = cvt_pk_bf16(a[2], a[3]); w.z = cvt_pk_bf16(b[0], b[1]); w.w = cvt_pk_bf16(b[2], b[3]);
                        *(u32x4*)(dst + (size_t)row * ld + colh + 32 * bj) = w;
                    }
                }
        }
    }
};

template <class Epi, class Sched, bool ALIGN_EPI = false, bool SP2 = false>
__device__ __forceinline__ void gemm_phase(PG8_LAS unsigned char* lds, const Gemm g, const Sched& S, const Epi& E) {
    const int tid = threadIdx.x, wid = __builtin_amdgcn_readfirstlane(tid >> 6), lane = tid & 63, wr = wid >> 2, wc = wid & 3, fr = lane & 15, fq = lane >> 4;
    const int K = g.K, nt = K / BK, LDP = g.ld ? g.ld : g.K, LDA = g.ablk ? BK : LDP;
    unsigned voffA[2], voffB[2];
#pragma unroll
    for (int i = 0; i < 2; ++i) { int R, C; stage_rc(tid * 16 + i * 8192, R, C); const int Rb = Epi::PERM ? ((R & ~31) + perm32(R & 31)) : R;
        voffA[i] = (unsigned)(R * LDA + C) * 2u; voffB[i] = (unsigned)(Rb * LDP + C) * 2u; }
    const size_t kstep = (size_t)(BK * 2);
    const size_t hstep = (size_t)HALF * LDP * 2;
    const size_t tstep = 2 * hstep;
    const size_t kstepA = g.ablk ? (size_t)BM * BK * 2 : kstep, hstepA = (size_t)HALF * LDA * 2, tstepA = g.ablk ? (size_t)BM * K * 2 : tstep;
    const unsigned ldsw = (unsigned)wid * 1024u;
    const int aoff = lds_byte(wr * 64 + fr, fq * 8), boff = lds_byte(wc * 32 + fr, fq * 8);
#define PG8_SA(b, h) (((b) * 2 + (h)) * HTB)
#define PG8_SB(b, h) ((4 + (b) * 2 + (h)) * HTB)
#define PG8_STAGE(bufoff, gbase, voff) do { _Pragma("unroll") for (int _i = 0; _i < 2; ++_i) \
        __builtin_amdgcn_global_load_lds((const unsigned*)((const char*)(gbase) + (voff)[_i]), (PG8_LAS unsigned*)(lds + (bufoff) + ldsw + _i * 8192), 16, 0, 0); } while (0)
#define PG8_LDA(dst, b, h) do { _Pragma("unroll") for (int m = 0; m < 4; ++m) _Pragma("unroll") for (int k = 0; k < 2; ++k) dst[m][k] = *(const PG8_LAS bf16x8*)(lds + PG8_SA(b, h) + aoff + m * 2048 + k * 1024); } while (0)
#define PG8_LDB(dst, b, h) do { _Pragma("unroll") for (int n = 0; n < 2; ++n) _Pragma("unroll") for (int k = 0; k < 2; ++k) dst[n][k] = *(const PG8_LAS bf16x8*)(lds + PG8_SB(b, h) + boff + n * 2048 + k * 1024); } while (0)
#define PG8_MMA(ai, bj, At, Bt) do { __builtin_amdgcn_s_setprio(1); _Pragma("unroll") for (int m = 0; m < 4; ++m) _Pragma("unroll") for (int n = 0; n < 2; ++n) _Pragma("unroll") for (int k = 0; k < 2; ++k) \
        acc[ai][bj][m][n] = __builtin_amdgcn_mfma_f32_16x16x32_bf16(Bt[n][k], At[m][k], acc[ai][bj][m][n], 0, 0, 0); __builtin_amdgcn_s_setprio(0); } while (0)
#define PG8_WAIT_V(n) asm volatile("s_waitcnt vmcnt(" #n ")" ::: "memory")
#define PG8_WAIT_L(n) asm volatile("s_waitcnt lgkmcnt(" #n ")" ::: "memory")
#define PG8_BAR __builtin_amdgcn_s_barrier()
#define PG8_SCHED __builtin_amdgcn_sched_barrier(0)
    Unit cur, nxt; int ui = 0;
    if (!S.next(0, cur)) return;
    f32x4 acc[2][2][4][2];
#pragma unroll
    for (int a = 0; a < 2; ++a)
#pragma unroll
        for (int b = 0; b < 2; ++b)
#pragma unroll
            for (int m = 0; m < 4; ++m)
#pragma unroll
                for (int n = 0; n < 2; ++n) acc[a][b][m][n] = (f32x4){0.f, 0.f, 0.f, 0.f};
    bf16x8 At[4][2], B0[2][2], B1[2][2];
    const char* cA = (const char*)g.A + (size_t)cur.pm * tstepA; const char* cB = (const char*)g.Bt + (size_t)cur.pn * tstep;
    S.a_ready(cur);
    if constexpr (SP2) {
        PG8_STAGE(PG8_SB(0, 0), cB, voffB); PG8_STAGE(PG8_SB(0, 1), cB + hstep, voffB); PG8_STAGE(PG8_SA(0, 0), cA, voffA); PG8_STAGE(PG8_SA(0, 1), cA + hstepA, voffA);
        if (wr == 1) PG8_BAR;
        PG8_WAIT_V(2); PG8_BAR;
        PG8_STAGE(PG8_SB(1, 0), cB + kstep, voffB); PG8_STAGE(PG8_SA(1, 0), cA + kstepA, voffA); PG8_STAGE(PG8_SB(1, 1), cB + hstep + kstep, voffB);
        PG8_WAIT_V(6); PG8_BAR;
    } else {
        PG8_STAGE(PG8_SB(0, 0), cB, voffB); PG8_STAGE(PG8_SA(0, 0), cA, voffA); PG8_STAGE(PG8_SB(0, 1), cB + hstep, voffB); PG8_STAGE(PG8_SA(0, 1), cA + hstepA, voffA);
        if (wr == 1) PG8_BAR;
        PG8_WAIT_V(4); PG8_BAR;
        PG8_STAGE(PG8_SB(1, 0), cB + kstep, voffB); PG8_STAGE(PG8_SA(1, 0), cA + kstepA, voffA); PG8_STAGE(PG8_SB(1, 1), cB + hstep + kstep, voffB);
        PG8_WAIT_V(6); PG8_BAR;
    }
    for (;;) {
        const bool has_next = S.next(ui + 1, nxt);
        const char* nA = has_next ? (const char*)g.A + (size_t)nxt.pm * tstepA : cA; const char* nB = has_next ? (const char*)g.Bt + (size_t)nxt.pn * tstep : cB;
        for (int t = 0; t < nt; t += 2) {
            const bool last = (t == nt - 2);
            const char* a1 = cA + (size_t)(t + 1) * kstepA;
            const char* a2 = last ? nA : cA + (size_t)(t + 2) * kstepA; const char* b2 = last ? nB : cB + (size_t)(t + 2) * kstep;
            const char* a3 = a2 + kstepA; const char* b3 = b2 + kstep;
            if (last && has_next) S.a_ready(nxt);
            if constexpr (SP2) {
            PG8_LDB(B0, 0, 0); PG8_LDB(B1, 0, 1); PG8_SCHED; PG8_LDA(At, 0, 0); PG8_STAGE(PG8_SA(1, 1), a1 + hstepA, voffA);
            PG8_WAIT_V(8); PG8_WAIT_L(0); PG8_BAR; PG8_MMA(0, 0, At, B0); PG8_MMA(0, 1, At, B1); PG8_BAR; PG8_SCHED;
            PG8_LDA(At, 0, 1); PG8_STAGE(PG8_SB(0, 0), b2, voffB); PG8_STAGE(PG8_SB(0, 1), b2 + hstep, voffB); PG8_STAGE(PG8_SA(0, 0), a2, voffA);
            PG8_WAIT_V(8); PG8_WAIT_L(0); PG8_BAR; PG8_MMA(1, 0, At, B0); PG8_MMA(1, 1, At, B1); PG8_BAR; PG8_SCHED;
            PG8_LDB(B0, 1, 0); PG8_LDB(B1, 1, 1); PG8_SCHED; PG8_LDA(At, 1, 0); PG8_STAGE(PG8_SA(0, 1), a2 + hstepA, voffA);
            PG8_WAIT_V(8); PG8_WAIT_L(0); PG8_BAR; PG8_MMA(0, 0, At, B0); PG8_MMA(0, 1, At, B1); PG8_BAR; PG8_SCHED;
            PG8_LDA(At, 1, 1); PG8_STAGE(PG8_SB(1, 0), b3, voffB); PG8_STAGE(PG8_SB(1, 1), b3 + hstep, voffB); PG8_STAGE(PG8_SA(1, 0), a3, voffA);
            PG8_WAIT_V(8); PG8_WAIT_L(0); PG8_BAR; PG8_MMA(1, 0, At, B0); PG8_MMA(1, 1, At, B1); PG8_BAR; PG8_SCHED;
            } else {
            PG8_LDB(B0, 0, 0); PG8_SCHED; PG8_LDA(At, 0, 0); PG8_STAGE(PG8_SA(1, 1), a1 + hstepA, voffA);
            PG8_WAIT_L(8); PG8_BAR; PG8_WAIT_L(0); PG8_MMA(0, 0, At, B0); PG8_BAR; PG8_SCHED;
            PG8_LDB(B1, 0, 1); PG8_STAGE(PG8_SB(0, 0), b2, voffB);
            PG8_BAR; PG8_WAIT_L(0); PG8_MMA(0, 1, At, B1); PG8_BAR;
            PG8_LDA(At, 0, 1); PG8_STAGE(PG8_SA(0, 0), a2, voffA);
            PG8_BAR; PG8_WAIT_L(0); PG8_MMA(1, 0, At, B0); PG8_BAR; PG8_SCHED;
            PG8_STAGE(PG8_SB(0, 1), b2 + hstep, voffB);
            PG8_WAIT_V(6); PG8_BAR; PG8_MMA(1, 1, At, B1); PG8_BAR;
            PG8_LDB(B0, 1, 0); PG8_SCHED; PG8_LDA(At, 1, 0); PG8_STAGE(PG8_SA(0, 1), a2 + hstepA, voffA);
            PG8_WAIT_L(8); PG8_BAR; PG8_WAIT_L(0); PG8_MMA(0, 0, At, B0); PG8_BAR; PG8_SCHED;
            PG8_LDB(B1, 1, 1); PG8_STAGE(PG8_SB(1, 0), b3, voffB);
            PG8_BAR; PG8_WAIT_L(0); PG8_MMA(0, 1, At, B1); PG8_BAR;
            PG8_LDA(At, 1, 1); PG8_STAGE(PG8_SA(1, 0), a3, voffA);
            PG8_BAR; PG8_WAIT_L(0); PG8_MMA(1, 0, At, B0); PG8_BAR; PG8_SCHED;
            PG8_STAGE(PG8_SB(1, 1), b3 + hstep, voffB);
            PG8_WAIT_V(6); PG8_BAR; PG8_MMA(1, 1, At, B1); PG8_BAR;
            }
        }
        if constexpr (ALIGN_EPI) { if (wr == 0) PG8_BAR; }
        if constexpr (!Epi::AFTER_DRAIN) { E(acc, cur, wr, wc, fr, fq); S.done(cur); }
        if (!has_next) break;
#pragma unroll
        for (int a = 0; a < 2; ++a)
#pragma unroll
            for (int b = 0; b < 2; ++b)
#pragma unroll
                for (int m = 0; m < 4; ++m)
#pragma unroll
                    for (int n = 0; n < 2; ++n) acc[a][b][m][n] = (f32x4){0.f, 0.f, 0.f, 0.f};
        cur = nxt; cA = nA; cB = nB; ++ui;
        if constexpr (ALIGN_EPI) { if (wr == 1) PG8_BAR; }
    }
    PG8_WAIT_V(0);
    if constexpr (!ALIGN_EPI) { if (wr == 0) PG8_BAR; }
    PG8_BAR;
    if constexpr (Epi::AFTER_DRAIN) { E.fused(acc, cur, wr, wc, fr, fq, lds, wid, lane); S.done(cur); }
#undef PG8_SA
#undef PG8_SB
#undef PG8_STAGE
#undef PG8_LDA
#undef PG8_LDB
#undef PG8_MMA
#undef PG8_WAIT_V
#undef PG8_WAIT_L
#undef PG8_BAR
#undef PG8_SCHED
}
}
#define GAS __attribute__((address_space(1)))
#define LAS __attribute__((address_space(3)))
typedef unsigned short bf16;
typedef unsigned v4u __attribute__((ext_vector_type(4)));
typedef float f32x4 __attribute__((ext_vector_type(4)));
typedef short bf16x8 __attribute__((ext_vector_type(8)));
typedef GAS unsigned gu32;
typedef GAS unsigned long long gu64;
#define RLX_AGENT __ATOMIC_RELAXED, __HIP_MEMORY_SCOPE_AGENT
#define LDS_WAIT() asm volatile("s_waitcnt lgkmcnt(0)" ::: "memory")
#define VM_WAIT() asm volatile("s_waitcnt vmcnt(0)" ::: "memory")
__device__ __forceinline__ unsigned long long rt() { return __builtin_amdgcn_s_memrealtime(); }
__device__ __forceinline__ unsigned f2bf(float f) { unsigned u = __builtin_bit_cast(unsigned, f); return (u + 0x7fffu + ((u >> 16) & 1u)) >> 16; }
__device__ __forceinline__ unsigned pk2(float lo, float hi) { return f2bf(lo) | (f2bf(hi) << 16); }

#define XB_TMO      128
#define XB_XCNT(j)  (256  + 64 * (j))
#define XB_XSUB(j)  (1280 + 64 * (j))
#define XB_XGEN(j)  (2304 + 64 * (j))
#define XB_TOP      3328
#define XB_TOPGEN   3392
#define XCD_BAR_WORDS 3456
#define XB_SPIN_CAP (1u << 18)

__device__ __forceinline__ unsigned xb_ld(unsigned* p)              { return __hip_atomic_load(p, __ATOMIC_RELAXED, __HIP_MEMORY_SCOPE_AGENT); }
__device__ __forceinline__ unsigned xb_add(unsigned* p, unsigned v) { return __hip_atomic_fetch_add(p, v, __ATOMIC_RELAXED, __HIP_MEMORY_SCOPE_AGENT); }
__device__ __forceinline__ unsigned xb_xcc_id() { return (unsigned)__builtin_amdgcn_s_getreg((3 << 11) | 20) & 0xFu; }
#define XB_SPIN(cond, bar) do { unsigned _sp = 0; while (cond) { __builtin_amdgcn_s_sleep(1); \
    if ((++_sp & 255u) == 0u) { if (xb_ld(&(bar)[XB_TMO])) break; if (_sp > XB_SPIN_CAP) { atomicAdd(&(bar)[XB_TMO], 1u); break; } } } } while (0)

struct XcdBarrier {
    unsigned* bar; unsigned x;
    volatile LAS unsigned* st;
};

__device__ __forceinline__ XcdBarrier xcd_barrier_post(unsigned* bar, volatile LAS unsigned* st) {
    XcdBarrier b; b.bar = bar; b.x = xb_xcc_id(); b.st = st;
    if (threadIdx.x == 0) (void)xb_add(&bar[XB_XCNT(b.x)], 1u);
    return b;
}
__device__ __forceinline__ void xcd_barrier_complete(unsigned* bar, unsigned x, unsigned& nloc, unsigned& nx) {
    const unsigned G = gridDim.x * gridDim.y * gridDim.z;
    unsigned sum, cnt, mine, sp = 0u;
    for (;;) {
        sum = 0u; cnt = 0u; mine = 0u;
#pragma unroll
        for (unsigned j = 0; j < 16; ++j) { const unsigned c = xb_ld(&bar[XB_XCNT(j)]); sum += c; cnt += (c > 0u) ? 1u : 0u; mine = (j == x) ? c : mine; }
        if (sum == G) break;
        __builtin_amdgcn_s_sleep(1);
        if ((++sp & 255u) == 0u) { if (xb_ld(&bar[XB_TMO])) break; if (sp > XB_SPIN_CAP) { atomicAdd(&bar[XB_TMO], 1u); break; } }
    }
    nloc = mine > 0u ? mine : 1u; nx = cnt > 0u ? cnt : 1u;
}

__device__ __forceinline__ void xcd_barrier(const XcdBarrier& b) {
    asm volatile("s_waitcnt vmcnt(0)" ::: "memory");
    __syncthreads();
    if (threadIdx.x == 0) {
        unsigned* bar = b.bar;
        __builtin_amdgcn_s_waitcnt(0);
        unsigned nloc = b.st[0], nx = b.st[1];
        if (nloc == 0u) { xcd_barrier_complete(bar, b.x, nloc, nx); b.st[0] = nloc; b.st[1] = nx; }
        const unsigned old = xb_add(&bar[XB_XSUB(b.x)], 1u);
        const unsigned gen = old / nloc;
        if (old + 1u == (gen + 1u) * nloc) {
            __builtin_amdgcn_fence(__ATOMIC_RELEASE, "agent");
            asm volatile("s_waitcnt vmcnt(0)" ::: "memory");
            const unsigned og = xb_add(&bar[XB_TOP], 1u);
            const unsigned tg = og / nx;
            if (og + 1u == (tg + 1u) * nx) xb_add(&bar[XB_TOPGEN], 1u);
            else XB_SPIN(xb_ld(&bar[XB_TOPGEN]) == tg, bar);
            __builtin_amdgcn_fence(__ATOMIC_ACQUIRE, "agent");
            xb_add(&bar[XB_XGEN(b.x)], 1u);
            asm volatile("s_waitcnt vmcnt(0)" ::: "memory");
        } else {
            XB_SPIN(xb_ld(&bar[XB_XGEN(b.x)]) == gen, bar);
            __builtin_amdgcn_fence(__ATOMIC_ACQUIRE, "agent");
            asm volatile("s_waitcnt vmcnt(0)" ::: "memory");
        }
    }
    __syncthreads();
}

constexpr int NWAVES = 8;
#ifndef MK_N_LAUNCHES
#define MK_N_LAUNCHES 1
#endif
constexpr int PER_PHASE = 11;
constexpr int N_LAUNCHES = MK_N_LAUNCHES;

constexpr int BATCH = 16, SEQ = 2048, D = 1024, HD = 64, NH = 8, FF = 2816;
constexpr int M = BATCH * SEQ;
constexpr int SBW = 512, RWW = 512, RWP = 1792, PW = 3328, LORA_K = 256, LORA_N = 1536;
constexpr float LNX_EPS = 64e-5f;

constexpr size_t MiB = 1u << 20;
constexpr size_t WS_CTL = 0, CTL_ZERO_BYTES = 128 * 1024;
constexpr size_t WS_SSQ = 1 * MiB;
constexpr size_t WS_W1U = 4 * MiB;
constexpr size_t WS_W1D = 15 * MiB;
constexpr size_t WS_W2U = 21 * MiB;
constexpr size_t WS_W2D = 32 * MiB;
constexpr size_t WS_WIN = 38 * MiB;
constexpr size_t WS_WOUT = 45 * MiB;
constexpr size_t WS_WLORA = 47 * MiB;
constexpr size_t WS_XB = 48 * MiB;
constexpr size_t WS_ACT = 112 * MiB;
constexpr size_t WS_QO = 112 * MiB;
constexpr size_t WS_KB = 176 * MiB;
constexpr size_t WS_VB = 208 * MiB;
constexpr size_t WS_RW = 240 * MiB;
constexpr size_t WS_ALORA = 352 * MiB;
constexpr size_t WS_LW = 368 * MiB;
constexpr size_t WS_AB = 432 * MiB;
constexpr size_t WS_GB = 464 * MiB;
constexpr size_t WS_TAIL = 496 * MiB;
constexpr size_t WS_END = 512 * MiB;
constexpr int CW_TMO = 0, CW_CODE = 1;
constexpr int CW_BAR = 4096;
constexpr int CW_QUEUE = 16384;

constexpr int RING_OFF = 0, RING_BYTES = 155648;
constexpr int LDSCTL_OFF = RING_BYTES, MISC_OFF = LDSCTL_OFF;
constexpr int LDS_BYTES = 163840;

struct Frame {
    LAS unsigned char* lds;
    volatile LAS unsigned* MISC;
    gu32* ctl;
    int tid, lane, wave;
    int vcu, G;
};
typedef unsigned u32x2g __attribute__((ext_vector_type(2)));
__device__ __forceinline__ float bf2f(unsigned short h) { return __uint_as_float(((unsigned)h) << 16); }
typedef float f32x2h __attribute__((ext_vector_type(2))); typedef __bf16 bf16x2h __attribute__((ext_vector_type(2)));
__device__ __forceinline__ unsigned pkbf(float lo, float hi) { f32x2h v = {lo, hi}; bf16x2h b = __builtin_convertvector(v, bf16x2h); return __builtin_bit_cast(unsigned, b); }
__device__ __forceinline__ float bflo(unsigned w) { return __uint_as_float(w << 16); }
__device__ __forceinline__ float bfhi(unsigned w) { return __uint_as_float(w & 0xffff0000u); }
__device__ __forceinline__ float wave_sum(float v) {
#pragma unroll
    for (int o = 1; o < 64; o <<= 1) v += __shfl_xor(v, o);
    return v;
}
#define DPP_ADD(v, ctrl) ((v) + __int_as_float(__builtin_amdgcn_update_dpp(0, __float_as_int(v), (ctrl), 0xF, 0xF, true)))
__device__ __forceinline__ float sum8(float v) { v = DPP_ADD(v, 0xB1); v = DPP_ADD(v, 0x4E); v = DPP_ADD(v, 0x141); return v; }

struct TItem { const float* W; int ldw, k0, n0; const float* sc; bf16* WT; int Kd, rho0; };
__device__ __forceinline__ void ti_load(const TItem& T, float (&t)[32], int lane) {
#pragma unroll
    for (int i = 0; i < 32; ++i) t[i] = T.W[(size_t)(T.k0 + 2 * i + (lane >> 5)) * T.ldw + T.n0 + (lane & 31)];
}
__device__ __forceinline__ void ti_finish(const TItem& T, const float (&t)[32], LAS float* scr, int lane) {
#pragma unroll
    for (int i = 0; i < 32; ++i) scr[(2 * i + (lane >> 5)) * 33 + (lane & 31)] = t[i];
    LDS_WAIT(); asm volatile("" ::: "memory");
    const int c = lane & 7;
    f32x4 s0 = (f32x4){1.f, 1.f, 1.f, 1.f}, s1 = s0;
    if (T.sc) { s0 = *(const f32x4*)(T.sc + T.k0 + 8 * c); s1 = *(const f32x4*)(T.sc + T.k0 + 8 * c + 4); }
#pragma unroll
    for (int j = 0; j < 4; ++j) { const int n = (lane >> 3) + 8 * j; const LAS float* s = scr + (8 * c) * 33 + n;
        v4u o; o.x = pkbf(s[0 * 33] * s0.x, s[1 * 33] * s0.y); o.y = pkbf(s[2 * 33] * s0.z, s[3 * 33] * s0.w); o.z = pkbf(s[4 * 33] * s1.x, s[5 * 33] * s1.y); o.w = pkbf(s[6 * 33] * s1.z, s[7 * 33] * s1.w);
        *(GAS v4u*)(T.WT + (size_t)(T.rho0 + n) * T.Kd + T.k0 + 8 * c) = o; }
    LDS_WAIT(); asm volatile("" ::: "memory");
}
#define P0_PTRS const float* Ax, const float* An1, const float* Ag1, const float* Au1, const float* Ad1, const float* Anm, const float* Awin, const float* Aw2, const float* Aa2, const float* Ag2, const float* Awout, \
    const float* An2, const float* Ag2f, const float* Au2f, const float* Ad2f, bf16* AW1U, bf16* AW1D, bf16* AW2U, bf16* AW2D, bf16* AWIN, bf16* AWOUT, bf16* AWLORA, bf16* AXB, float* ASSQ
__device__ __forceinline__ void p0_items(Frame& F, P0_PTRS, int set, int gw, int NGW) {
    LAS float* scr = (LAS float*)(F.lds + RING_OFF + F.wave * 16384);
    constexpr int I_UP = 16 * 176, I_DN = 44 * 32, I_IN = 16 * 104, I_OUT = 16 * 32;
    const int NITEMS = set ? (I_UP + I_DN) : (I_UP + I_DN + I_IN + I_OUT);
#define P0_DECODE(it_, T) do { int r = (it_); const int l2 = set; \
        if (r < I_UP) { const int kb = r / 176, nb = r % 176, rho0 = 32 * nb, pn = rho0 >> 8, bj = (rho0 >> 7) & 1, j0 = rho0 & 127; \
            T = TItem{l2 ? (bj ? Au2f : Ag2f) : (bj ? Au1 : Ag1), FF, 64 * kb, 128 * pn + j0, l2 ? An2 : An1, l2 ? AW2U : AW1U, D, rho0}; } \
        else if ((r -= I_UP) < I_DN) { const int kb = r / 32, nb = r % 32; \
            T = TItem{l2 ? Ad2f : Ad1, D, 64 * kb, 32 * nb, nullptr, l2 ? AW2D : AW1D, FF, 32 * nb}; } \
        else if ((r -= I_DN) < I_IN) { const int kb = r / 104, nb = r % 104, rho0 = 32 * nb, pn = rho0 >> 8, rem = rho0 & 255, bj = rem >> 7, wc = (rem & 127) >> 5; \
            T = TItem{Awin, PW, 64 * kb, 256 * pn + 64 * wc + 32 * bj, Anm, AWIN, D, rho0}; } \
        else { r -= I_IN; const int kb = r / 32, nb = r % 32; T = TItem{Awout, D, 64 * kb, 32 * nb, nullptr, AWOUT, D, 32 * nb}; } } while (0)
    for (int it = gw; it < NITEMS; it += 2 * NGW) {
        TItem T0, T1; float t0[32], t1[32]; const bool two = (it + NGW < NITEMS);
        P0_DECODE(it, T0); ti_load(T0, t0, F.lane);
        if (two) { P0_DECODE(it + NGW, T1); ti_load(T1, t1, F.lane); }
        ti_finish(T0, t0, scr, F.lane);
        if (two) ti_finish(T1, t1, scr, F.lane);
    }
#undef P0_DECODE
}
__device__ __forceinline__ void p0_prologue(Frame& F, P0_PTRS) {
    const int gw = F.vcu * NWAVES + F.wave, NGW = F.G * NWAVES;
    p0_items(F, Ax, An1, Ag1, Au1, Ad1, Anm, Awin, Aw2, Aa2, Ag2, Awout, An2, Ag2f, Au2f, Ad2f, AW1U, AW1D, AW2U, AW2D, AWIN, AWOUT, AWLORA, AXB, ASSQ, (F.G >= 256) ? 0 : 0, gw, NGW);
    if (F.G < 256) p0_items(F, Ax, An1, Ag1, Au1, Ad1, Anm, Awin, Aw2, Aa2, Ag2, Awout, An2, Ag2f, Au2f, Ad2f, AW1U, AW1D, AW2U, AW2D, AWIN, AWOUT, AWLORA, AXB, ASSQ, 1, gw, NGW);
    for (int it = F.vcu * (NWAVES * 64) + F.tid; it < 512 * 32; it += F.G * NWAVES * 64) {
        int ch, kc, Kk; const float* src; bf16* dst;
        if (it < 512 * 8) { ch = it >> 3; kc = (it & 7) * 8; Kk = 64; src = Aw2; dst = AWLORA; }
        else if (it < 512 * 16) { const int i2 = it - 512 * 8; ch = i2 >> 3; kc = (i2 & 7) * 8; Kk = 64; src = Aa2; dst = AWLORA + 512 * 64; }
        else { const int i2 = it - 512 * 16; ch = i2 >> 4; kc = (i2 & 15) * 8; Kk = 128; src = Ag2; dst = AWLORA + 2 * 512 * 64; }
        float v[8];
#pragma unroll
        for (int j = 0; j < 8; ++j) v[j] = src[(size_t)(kc + j) * 512 + ch];
        v4u o; o.x = pkbf(v[0], v[1]); o.y = pkbf(v[2], v[3]); o.z = pkbf(v[4], v[5]); o.w = pkbf(v[6], v[7]);
        *(GAS v4u*)(dst + (size_t)ch * Kk + kc) = o;
    }
    for (int mb = gw; mb < M; mb += 4 * NGW) {
        f32x4 v[4][4]; float s[4];
#pragma unroll
        for (int q = 0; q < 4; ++q) { const int m = mb + q * NGW; const GAS f32x4* xr = (const GAS f32x4*)(Ax + (size_t)(m < M ? m : mb) * D) + F.lane;
#pragma unroll
            for (int j = 0; j < 4; ++j) v[q][j] = xr[64 * j]; }
#pragma unroll
        for (int q = 0; q < 4; ++q) { float a = 0.f;
#pragma unroll
            for (int j = 0; j < 4; ++j) a += (v[q][j].x * v[q][j].x + v[q][j].y * v[q][j].y) + (v[q][j].z * v[q][j].z + v[q][j].w * v[q][j].w);
            s[q] = a; }
#pragma unroll
        for (int o = 1; o < 64; o <<= 1) {
#pragma unroll
            for (int q = 0; q < 4; ++q) s[q] += __shfl_xor(s[q], o); }
#pragma unroll
        for (int q = 0; q < 4; ++q) { const int m = mb + q * NGW; if (m < M) {
            GAS unsigned long long* o8 = (GAS unsigned long long*)(AXB + (size_t)m * D) + F.lane;
#pragma unroll
            for (int j = 0; j < 4; ++j) o8[64 * j] = (unsigned long long)pkbf(v[q][j].x, v[q][j].y) | ((unsigned long long)pkbf(v[q][j].z, v[q][j].w) << 32);
            if (F.lane < 16) ASSQ[(size_t)m * 16 + F.lane] = (F.lane == 0) ? s[q] : 0.f; } }
    }
}

struct RwArgs { const bf16* RW; const bf16* W2T; const bf16* A2T; const bf16* G2T; const float* w0; const float* a0; bf16* QO; const float *mu, *k_k, *k_a, *r_k, *ln_w, *ln_b; };
__device__ __forceinline__ void ld8bf(const bf16* p, float (&o)[8]) { const v4u w = *(const v4u*)p; o[0] = bflo(w.x); o[1] = bfhi(w.x); o[2] = bflo(w.y); o[3] = bfhi(w.y); o[4] = bflo(w.z); o[5] = bfhi(w.z); o[6] = bflo(w.w); o[7] = bfhi(w.w); }
__device__ __forceinline__ void ld8f(const float* p, float (&o)[8]) { const f32x4 a = *(const f32x4*)p, b = *(const f32x4*)(p + 4); o[0] = a.x; o[1] = a.y; o[2] = a.z; o[3] = a.w; o[4] = b.x; o[5] = b.y; o[6] = b.z; o[7] = b.w; }
__device__ __forceinline__ void ld8l(const LAS float* p, float (&o)[8]) { const f32x4 a = *(const LAS f32x4*)p, b = *(const LAS f32x4*)(p + 4); o[0] = a.x; o[1] = a.y; o[2] = a.z; o[3] = a.w; o[4] = b.x; o[5] = b.y; o[6] = b.z; o[7] = b.w; }
__device__ __forceinline__ void st8l(LAS float* p, const float (&o)[8]) { *(LAS f32x4*)p = (f32x4){o[0], o[1], o[2], o[3]}; *(LAS f32x4*)(p + 4) = (f32x4){o[4], o[5], o[6], o[7]}; }
namespace rwk {
typedef short bf16x8 __attribute__((ext_vector_type(8)));
typedef short s16x4 __attribute__((ext_vector_type(4)));
typedef short v4i16_t __attribute__((ext_vector_type(4)));
constexpr int SLOT = 8192;
#define RSL(s) (lds + (s) * SLOT)
#define RMFMA(a, b, c) __builtin_amdgcn_mfma_f32_16x16x32_bf16((a), (b), (c), 0, 0, 0)
__device__ __forceinline__ int swz(int row, int cb) { return row * 128 + (cb ^ ((row & 7) << 4)); }
struct Fr2 { bf16x8 k0, k1; };
__device__ __forceinline__ Fr2 ldf(const LAS unsigned char* base, int off) { Fr2 f; f.k0 = *(const LAS bf16x8*)(base + off); f.k1 = *(const LAS bf16x8*)(base + (off ^ 64)); return f; }
__device__ __forceinline__ s16x4 trd(const LAS unsigned char* p) { return __builtin_bit_cast(s16x4, __builtin_amdgcn_ds_read_tr16_b64_v4i16((LAS v4i16_t*)p)); }
__device__ __forceinline__ Fr2 ldt(const LAS unsigned char* base, int o0, int o1) {
    const s16x4 a = trd(base + o0), b = trd(base + o1), c = trd(base + o0 + 4096), d = trd(base + o1 + 4096);
    Fr2 f; f.k0 = (bf16x8){a[0], a[1], a[2], a[3], b[0], b[1], b[2], b[3]}; f.k1 = (bf16x8){c[0], c[1], c[2], c[3], d[0], d[1], d[2], d[3]}; return f; }
template <bool SWAP> __device__ __forceinline__ f32x4 mm(const Fr2& a, const Fr2& b, f32x4 c) {
    if (SWAP) { c = RMFMA(b.k0, a.k0, c); c = RMFMA(b.k1, a.k1, c); } else { c = RMFMA(a.k0, b.k0, c); c = RMFMA(a.k1, b.k1, c); } return c; }
__device__ __forceinline__ void st4(LAS unsigned char* slot, int off, f32x4 v) { u32x2g w; w.x = pkbf(v[0], v[1]); w.y = pkbf(v[2], v[3]); *(LAS u32x2g*)(slot + off) = w; }
__device__ __forceinline__ f32x4 M16(s16x4 a, s16x4 b, f32x4 c) { return __builtin_amdgcn_mfma_f32_16x16x16bf16_1k(a, b, c, 0, 0, 0); }
__device__ __forceinline__ s16x4 cv4(f32x4 v) { const u32x2g w = (u32x2g){pkbf(v[0], v[1]), pkbf(v[2], v[3])}; return __builtin_bit_cast(s16x4, w); }
__device__ __forceinline__ float bf1(short s) { return __uint_as_float(((unsigned)(unsigned short)s) << 16); }
__device__ __forceinline__ f32x4 ld4(const LAS unsigned char* slot, int off) { const u32x2g w = *(const LAS u32x2g*)(slot + off); return (f32x4){bflo(w.x), bfhi(w.x), bflo(w.y), bfhi(w.y)}; }
#define LBAR() asm volatile("s_waitcnt lgkmcnt(0)\n\ts_barrier" ::: "memory")
#define DPPF(x, ctrl, rmask) __int_as_float(__builtin_amdgcn_update_dpp(0, __float_as_int(x), (ctrl), (rmask), 0xF, true))
__device__ __forceinline__ float wave_scan(float x) {
    x += DPPF(x, 0x111, 0xF); x += DPPF(x, 0x112, 0xF); x += DPPF(x, 0x114, 0xF); x += DPPF(x, 0x118, 0xF);
    x += DPPF(x, 0x142, 0xA);
    x += DPPF(x, 0x143, 0xC);
    return x; }
__device__ __forceinline__ void unp8(const v4u w, float (&o)[8]) { o[0] = bflo(w.x); o[1] = bfhi(w.x); o[2] = bflo(w.y); o[3] = bfhi(w.y); o[4] = bflo(w.z); o[5] = bfhi(w.z); o[6] = bflo(w.w); o[7] = bfhi(w.w); }
__device__ __forceinline__ v4u pk8(const float (&o)[8]) { return (v4u){pkbf(o[0], o[1]), pkbf(o[2], o[3]), pkbf(o[4], o[5]), pkbf(o[6], o[7])}; }
}
struct RwX { bf16* P1; bf16* GT; bf16* Y0; bf16* H; bf16* VB0; bf16* VB1; float* GE; bf16* G; };
__device__ __forceinline__ void p6a_rwkv_local(Frame& F, const RwArgs& A, const RwX& X) {
    using namespace rwk;
    LAS unsigned char* lds = F.lds + RING_OFF;
    LAS float* part = (LAS float*)(F.lds + LDSCTL_OFF + 128);
    LAS float* cst = (LAS float*)(F.lds + LDSCTL_OFF + 128 + 4096 + 896);
    const int lane = F.lane, fr = lane & 15, fq = lane >> 4, w = F.wave, m0 = 16 * (w >> 1), n0a = 32 * (w & 1);
    const int fm = swz(m0 + fr, fq * 16);
    const int ta0 = swz(8 * fq + (fr >> 2), 2 * (m0 + 4 * (fr & 3))), ta1 = swz(8 * fq + 4 + (fr >> 2), 2 * (m0 + 4 * (fr & 3)));
    int fn[2], orm[2], otr[2], tb0[2], tb1[2];
#pragma unroll
    for (int t = 0; t < 2; ++t) { const int n0 = n0a + 16 * t; fn[t] = swz(n0 + fr, fq * 16); orm[t] = swz(m0 + fr, 2 * (n0 + 4 * fq)); otr[t] = swz(n0 + fr, 2 * (m0 + 4 * fq));
        tb0[t] = swz(8 * fq + (fr >> 2), 2 * (n0 + 4 * (fr & 3))); tb1[t] = swz(8 * fq + 4 + (fr >> 2), 2 * (n0 + 4 * (fr & 3))); }
    const int NJ = BATCH * NH * (SEQ / 64);
    const int tid = F.tid, ltok = tid >> 3, ldg = tid & 7;
    v4u g_r, g_k, g_v, g_xw, g_xa, g_xg0, g_xg1, g_pr;
#define P6A_LOAD(jj) do { const int u_ = (jj) >> 5, c_ = (jj) & 31; const size_t gr_ = (size_t)(u_ >> 3) * SEQ + c_ * 64 + ltok; const int cb_ = 64 * (u_ & 7) + 8 * ldg; const bf16* rp_ = A.RW + gr_ * RWP; \
        g_r = *(const v4u*)(rp_ + cb_); g_k = *(const v4u*)(rp_ + 512 + cb_); g_v = *(const v4u*)(rp_ + 1024 + cb_); \
        g_xw = *(const v4u*)(rp_ + 1536 + 8 * ldg); g_xa = *(const v4u*)(rp_ + 1600 + 8 * ldg); g_xg0 = *(const v4u*)(rp_ + 1664 + 8 * ldg); g_xg1 = *(const v4u*)(rp_ + 1728 + 8 * ldg); \
        g_pr = (v4u){0u, 0u, 0u, 0u}; if (ltok < 7 && c_ > 0) g_pr = *(const v4u*)(A.RW + ((size_t)(u_ >> 3) * SEQ + c_ * 64 - 1) * RWP + (ltok < 3 ? 512 * ltok + cb_ : 1536 + 64 * (ltok - 3) + 8 * ldg)); } while (0)
    if ((int)blockIdx.x < NJ) P6A_LOAD((int)blockIdx.x);
    int hcur = -1;
    LAS unsigned char* prow = (LAS unsigned char*)(F.lds + LDSCTL_OFF + 128 + 4096);
    if (tid < 256) cst[512 + tid] = A.mu[1536 + tid];
    u32x2g s_p1[2], s_gt[2], s_y0[2], s_hh[2]; size_t s_jo = 0; bool s_have = false;
#define P6A_STORE() do { _Pragma("unroll") for (int t = 0; t < 2; ++t) { \
            *(u32x2g*)(X.P1 + s_jo + ((w * 2 + t) * 64 + lane) * 4) = s_p1[t]; *(u32x2g*)(X.GT + s_jo + ((w * 2 + t) * 64 + lane) * 4) = s_gt[t]; \
            *(u32x2g*)(X.Y0 + s_jo + ((w * 2 + t) * 64 + lane) * 4) = s_y0[t]; *(u32x2g*)(X.H + s_jo + ((w * 2 + t) * 64 + lane) * 4) = s_hh[t]; } } while (0)
    for (int job = blockIdx.x; job < NJ; job += F.G) {
        const int unit = job >> 5, c = job & 31; const int h = unit & 7; const int cb = 64 * h + 8 * w; const size_t jo = (size_t)job * 4096;
        {
            const int so = swz(ltok, 16 * ldg);
            *(LAS v4u*)(RSL(12) + so) = g_r; *(LAS v4u*)(RSL(2) + so) = g_k; *(LAS v4u*)(RSL(0) + so) = g_v;
            *(LAS v4u*)(RSL(14) + so) = g_xw; *(LAS v4u*)(RSL(13) + so) = g_xa; *(LAS v4u*)(RSL(10) + so) = g_xg0; *(LAS v4u*)(RSL(11) + so) = g_xg1;
            if (ltok < 7) *(LAS v4u*)(prow + ltok * 128 + 16 * ldg) = g_pr;
            if (h != hcur) {
                *(LAS v4u*)(RSL(16) + so) = *(const v4u*)(A.W2T + (size_t)(64 * h + ltok) * 64 + 8 * ldg); *(LAS v4u*)(RSL(17) + so) = *(const v4u*)(A.A2T + (size_t)(64 * h + ltok) * 64 + 8 * ldg);
                { const int a_ = tid >> 6, i_ = tid & 63;
                  const float* src_ = (a_ == 0) ? A.mu : (a_ == 1) ? A.mu + 512 : (a_ == 2) ? A.mu + 1024 : (a_ == 3) ? A.k_k : (a_ == 4) ? A.k_a : (a_ == 5) ? A.r_k : (a_ == 6) ? A.w0 : A.a0;
                  cst[a_ * 64 + i_] = src_[64 * h + i_]; } }
            hcur = h;
        }
        if (s_have) P6A_STORE();
        { const int nj = job + F.G; if (nj < NJ) P6A_LOAD(nj); }
        LBAR();
        float r[8], k[8], v[8];
        {
            const int so = swz(lane, 16 * w), sp = swz((lane + 63) & 63, 16 * w);
#define P6A_SHIFT(slot, pi, moff, dst) do { float c_[8], p_[8], m_[8]; v4u wc_ = *(const LAS v4u*)(RSL(slot) + so), wp_ = *(const LAS v4u*)(RSL(slot) + sp); \
                if (lane == 0) wp_ = *(const LAS v4u*)(prow + 128 * (pi) + 16 * w); \
                unp8(wc_, c_); unp8(wp_, p_); ld8l(cst + (moff) + 8 * w, m_); \
                _Pragma("unroll") for (int j = 0; j < 8; ++j) dst[j] = c_[j] + (p_[j] - c_[j]) * m_[j]; } while (0)
            P6A_SHIFT(12, 0, 0, r);
            P6A_SHIFT(2, 1, 64, k);
            P6A_SHIFT(0, 2, 128, v); asm volatile("" ::: "memory");
            { float x_[8]; P6A_SHIFT(14, 3, 512, x_);
#pragma unroll
              for (int j = 0; j < 8; ++j) x_[j] = 2.0f * pg8::sigmoid_f(2.0f * x_[j]) - 1.0f;
              *(LAS v4u*)(RSL(14) + so) = pk8(x_); }
            { float x_[8]; P6A_SHIFT(13, 4, 576, x_); *(LAS v4u*)(RSL(13) + so) = pk8(x_); } asm volatile("" ::: "memory");
            { float x_[8]; P6A_SHIFT(10, 5, 640, x_);
#pragma unroll
              for (int j = 0; j < 8; ++j) x_[j] = pg8::sigmoid_f(x_[j]);
              *(LAS v4u*)(RSL(10) + so) = pk8(x_); }
            { float x_[8]; P6A_SHIFT(11, 6, 704, x_);
#pragma unroll
              for (int j = 0; j < 8; ++j) x_[j] = pg8::sigmoid_f(x_[j]);
              *(LAS v4u*)(RSL(11) + so) = pk8(x_); }
#undef P6A_SHIFT
        }
        LBAR();
        {
            const f32x4 z4 = (f32x4){0.f, 0.f, 0.f, 0.f};
            bf16x8 gq[2][4];
#pragma unroll
            for (int t = 0; t < 2; ++t) { const bf16* gp = A.G2T + (size_t)(64 * h + n0a + 16 * t + fr) * 128 + 8 * fq;
#pragma unroll
                for (int q = 0; q < 4; ++q) gq[t][q] = *reinterpret_cast<const bf16x8*>(gp + 32 * q); }
            {   const Fr2 aW = ldf(RSL(14), fm), aA = ldf(RSL(13), fm); Fr2 bW[2], bA[2];
#pragma unroll
                for (int t = 0; t < 2; ++t) { bW[t] = ldf(RSL(16), fn[t]); bA[t] = ldf(RSL(17), fn[t]); }
#pragma unroll
                for (int t = 0; t < 2; ++t) { const int row = m0 + fr, ch = n0a + 16 * t + 4 * fq; const f32x4 lwq = mm<true>(aW, bW[t], z4), alq = mm<true>(aA, bA[t], z4);
                    const f32x4 w0c = *(const LAS f32x4*)(cst + 384 + ch), a0c = *(const LAS f32x4*)(cst + 448 + ch); f32x4 lwv, alv;
#pragma unroll
                    for (int x = 0; x < 4; ++x) { lwv[x] = -0.6065306597126334f * pg8::sigmoid_f(w0c[x] + lwq[x]); alv[x] = pg8::sigmoid_f(a0c[x] + alq[x]); }
                    const int fo = row * 256 + (((ch >> 3) ^ (row & 7)) << 5) + ((ch >> 2) & 1) * 16;
                    *(LAS f32x4*)(RSL(4) + fo) = lwv; *(LAS f32x4*)(RSL(8) + fo) = alv; } }
            asm volatile("" ::: "memory");
            {   const Fr2 aG0 = ldf(RSL(10), fm), aG1 = ldf(RSL(11), fm);
#pragma unroll
                for (int t = 0; t < 2; ++t) { Fr2 bG0, bG1; bG0.k0 = gq[t][0]; bG0.k1 = gq[t][1]; bG1.k0 = gq[t][2]; bG1.k1 = gq[t][3];
                    st4(RSL(3), orm[t], mm<true>(aG1, bG1, mm<true>(aG0, bG0, z4))); } }
        }
        LBAR();
        float kf[8], kk[8], al[8], lw[8]; float ssp = 0.f, bpp = 0.f;
        {
            { const int fo = lane * 256 + ((w ^ (lane & 7)) << 5); const f32x4 a_ = *(const LAS f32x4*)(RSL(4) + fo), b_ = *(const LAS f32x4*)(RSL(4) + fo + 16), c_ = *(const LAS f32x4*)(RSL(8) + fo), d_ = *(const LAS f32x4*)(RSL(8) + fo + 16);
              lw[0] = a_.x; lw[1] = a_.y; lw[2] = a_.z; lw[3] = a_.w; lw[4] = b_.x; lw[5] = b_.y; lw[6] = b_.z; lw[7] = b_.w;
              al[0] = c_.x; al[1] = c_.y; al[2] = c_.z; al[3] = c_.w; al[4] = d_.x; al[5] = d_.y; al[6] = d_.z; al[7] = d_.w; }
            *(v4u*)(X.G + jo + tid * 8) = *(const LAS v4u*)(RSL(3) + swz(ltok, 16 * ldg));
            float kkc[8], kac[8], rkc[8]; ld8l(cst + 192 + 8 * w, kkc); ld8l(cst + 256 + 8 * w, kac); ld8l(cst + 320 + 8 * w, rkc);
#pragma unroll
            for (int j = 0; j < 8; ++j) { kk[j] = k[j] * kkc[j]; ssp += kk[j] * kk[j]; kf[j] = k[j] * (1.0f + (al[j] - 1.0f) * kac[j]); bpp += r[j] * kf[j] * rkc[j]; }
            part[w * 64 + lane] = ssp; part[512 + w * 64 + lane] = bpp;
        }
        LBAR();
        {
            float ss = 0.f, bon = 0.f;
#pragma unroll
            for (int i = 0; i < 8; ++i) { ss += part[i * 64 + lane]; bon += part[512 + i * 64 + lane]; }
            const float inv = 1.0f / fmaxf(sqrtf(ss), 1e-12f);
            float at[8], rt[8], bt[8], kt[8], bh[8], kh[8], ge[8], vb[8];
#pragma unroll
            for (int j = 0; j < 8; ++j) {
                const float cs = wave_scan(lw[j]);
                const float ce = __int_as_float(__builtin_amdgcn_readlane(__float_as_int(cs), 63));
                const float e_cs = __builtin_amdgcn_exp2f(cs * 1.4426950408889634f), e_csm = __builtin_amdgcn_exp2f((cs - lw[j]) * 1.4426950408889634f);
                const float e_neg = __builtin_amdgcn_rcpf(e_cs), e_end = __builtin_amdgcn_exp2f((ce - cs) * 1.4426950408889634f);
                const float kn = kk[j] * inv, bb = kn * al[j];
                at[j] = -kn * e_csm; rt[j] = r[j] * e_cs; bt[j] = bb * e_neg; kt[j] = kf[j] * e_neg; bh[j] = bb * e_end; kh[j] = kf[j] * e_end; ge[j] = e_cs; vb[j] = bon * v[j];
            }
            const int ro = swz(lane, 16 * w);
            *(LAS v4u*)(RSL(0) + ro) = pk8(at); *(LAS v4u*)(RSL(1) + ro) = pk8(rt); *(LAS v4u*)(RSL(2) + ro) = pk8(bt); *(LAS v4u*)(RSL(3) + ro) = pk8(kt);
            *(LAS v4u*)(RSL(4) + ro) = pk8(bh); *(LAS v4u*)(RSL(5) + ro) = pk8(kh); *(LAS v4u*)(RSL(6) + ro) = pk8(v);
            if (lane == 63) { *(f32x4*)(X.GE + (size_t)job * 64 + 8 * w) = (f32x4){ge[0], ge[1], ge[2], ge[3]}; *(f32x4*)(X.GE + (size_t)job * 64 + 8 * w + 4) = (f32x4){ge[4], ge[5], ge[6], ge[7]}; }
            *(LAS v4u*)(RSL(18) + ro) = pk8(vb);
        }
        LBAR();
        {
            { bf16* vbp = (job < 2048) ? (X.VB0 + jo) : (X.VB1 + (jo - (size_t)2048 * 4096)); *(v4u*)(vbp + tid * 8) = *(const LAS v4u*)(RSL(18) + swz(ltok, 16 * ldg)); }
            const f32x4 z4 = (f32x4){0.f, 0.f, 0.f, 0.f};
            const Fr2 aA = ldf(RSL(0), fm), aR = ldf(RSL(1), fm); Fr2 bB[2], bK[2];
#pragma unroll
            for (int t = 0; t < 2; ++t) { bB[t] = ldf(RSL(2), fn[t]); bK[t] = ldf(RSL(3), fn[t]); }
            f32x4 nab[2], nabT[2], nak[2], mrb[2], mrk[2];
#pragma unroll
            for (int t = 0; t < 2; ++t) { nab[t] = mm<true>(aA, bB[t], z4); nabT[t] = mm<false>(aA, bB[t], z4); nak[t] = mm<true>(aA, bK[t], z4); mrb[t] = mm<true>(aR, bB[t], z4); mrk[t] = mm<true>(aR, bK[t], z4); }
#pragma unroll
            for (int t = 0; t < 2; ++t) { const int n0 = n0a + 16 * t;
#pragma unroll
                for (int x = 0; x < 4; ++x) { const int i = m0 + fr, j = n0 + 4 * fq + x;
                    if (j >= i) { nab[t][x] = 0.f; nak[t][x] = 0.f; } if (j > i) { mrb[t][x] = 0.f; mrk[t][x] = 0.f; }
                    const int it = m0 + 4 * fq + x, jt = n0 + fr; if (jt >= it) nabT[t][x] = 0.f; }
                st4(RSL(12), orm[t], nab[t]);
                st4(RSL(7), orm[t], nak[t]); st4(RSL(8), orm[t], mrb[t]); st4(RSL(9), orm[t], mrk[t]); }
            const int dsel = (w == 2 || w == 7) ? 1 : 0;
            if (w == 0 || w == 2 || w == 5 || w == 7) {
                const f32x4 dPT = dsel ? nab[1] : nab[0], dP = dsel ? nabT[1] : nabT[0];
                f32x4 XT;
#pragma unroll
                for (int x = 0; x < 4; ++x) XT[x] = dPT[x] + ((4 * fq + x == fr) ? 1.0f : 0.f);
                const s16x4 bP = cv4(dP), bPT = cv4(dPT);
                const f32x4 P2 = M16(bPT, bP, z4), P2T = M16(bP, bPT, z4);
                const s16x4 bP2 = cv4(P2), bP2T = cv4(P2T);
                XT = M16(bP2, cv4(XT), XT);
                const f32x4 P4 = M16(bP2T, bP2, z4), P4T = M16(bP2, bP2T, z4);
                const s16x4 bP4 = cv4(P4), bP4T = cv4(P4T);
                XT = M16(bP4, cv4(XT), XT);
                const f32x4 P8 = M16(bP4T, bP4, z4);
                XT = M16(cv4(P8), cv4(XT), XT);
                *(LAS s16x4*)(RSL(13) + (m0 >> 4) * 512 + fr * 32 + fq * 8) = cv4(XT);
            }
        }
        LBAR();
        {
            const f32x4 z4 = (f32x4){0.f, 0.f, 0.f, 0.f};
            const int cs = 16 * (w & 3);
            s16x4 tA[4], nA[6];
#pragma unroll
            for (int i = 0; i < 4; ++i) tA[i] = *(const LAS s16x4*)(RSL(13) + i * 512 + fr * 32 + fq * 8);
            {   int q = 0;
#pragma unroll
                for (int i = 1; i < 4; ++i)
#pragma unroll
                    for (int j = 0; j < i; ++j) nA[q++] = *(const LAS s16x4*)(RSL(12) + swz(16 * i + fr, 2 * (16 * j + 4 * fq))); }
            f32x4 acc[4];
            if (w < 4) {
#pragma unroll
                for (int i = 0; i < 4; ++i) { const s16x4 r = trd(RSL(0) + swz(16 * i + 4 * fq + (fr >> 2), 2 * (cs + 4 * (fr & 3))));
                    acc[i] = (f32x4){bf1(r[0]), bf1(r[1]), bf1(r[2]), bf1(r[3])}; }
            } else {
                s16x4 vB[4], kA[10];
#pragma unroll
                for (int j = 0; j < 4; ++j) vB[j] = trd(RSL(6) + swz(16 * j + 4 * fq + (fr >> 2), 2 * (cs + 4 * (fr & 3))));
                {   int q = 0;
#pragma unroll
                    for (int i = 0; i < 4; ++i)
#pragma unroll
                        for (int j = 0; j <= i; ++j) kA[q++] = *(const LAS s16x4*)(RSL(7) + swz(16 * i + fr, 2 * (16 * j + 4 * fq))); }
                {   int q = 0;
#pragma unroll
                    for (int i = 0; i < 4; ++i) { acc[i] = z4;
#pragma unroll
                        for (int j = 0; j <= i; ++j) acc[i] = M16(kA[q++], vB[j], acc[i]); } }
            }
            s16x4 yB[4];
            {   int q = 0;
#pragma unroll
                for (int i = 0; i < 4; ++i) {
#pragma unroll
                    for (int j = 0; j < i; ++j) acc[i] = M16(nA[q++], yB[j], acc[i]);
                    const f32x4 y = M16(tA[i], cv4(acc[i]), z4); yB[i] = cv4(y);
                    *(LAS s16x4*)(RSL(w < 4 ? 3 : 15) + swz(cs + fr, 2 * (16 * i + 4 * fq))) = yB[i]; } }
        }
        LBAR();
        {
            const f32x4 z4 = (f32x4){0.f, 0.f, 0.f, 0.f};
            f32x4 p1[2], y0[2], gt[2], hh[2];
            {   const Fr2 aMb = ldf(RSL(8), fm), aMk = ldf(RSL(9), fm); Fr2 bW[2], bU[2], bV[2]; f32x4 cR[2];
#pragma unroll
                for (int t = 0; t < 2; ++t) { bW[t] = ldf(RSL(3), fn[t]); bU[t] = ldf(RSL(15), fn[t]); bV[t] = ldt(RSL(6), tb0[t], tb1[t]); cR[t] = ld4(RSL(1), orm[t]); }
#pragma unroll
                for (int t = 0; t < 2; ++t) { p1[t] = mm<true>(aMb, bW[t], cR[t]); y0[t] = mm<true>(aMk, bV[t], mm<true>(aMb, bU[t], z4)); } }
            {   const Fr2 aW = ldf(RSL(3), fm), aU = ldf(RSL(15), fm), aV = ldt(RSL(6), ta0, ta1); Fr2 bBh[2], bKh[2];
#pragma unroll
                for (int t = 0; t < 2; ++t) { bBh[t] = ldt(RSL(4), tb0[t], tb1[t]); bKh[t] = ldt(RSL(5), tb0[t], tb1[t]); }
#pragma unroll
                for (int t = 0; t < 2; ++t) { gt[t] = mm<false>(aW, bBh[t], z4); hh[t] = mm<true>(aV, bKh[t], mm<true>(aU, bBh[t], z4)); } }
#pragma unroll
            for (int t = 0; t < 2; ++t) {
                s_p1[t].x = pkbf(p1[t][0], p1[t][1]); s_p1[t].y = pkbf(p1[t][2], p1[t][3]); s_gt[t].x = pkbf(gt[t][0], gt[t][1]); s_gt[t].y = pkbf(gt[t][2], gt[t][3]);
                s_y0[t].x = pkbf(y0[t][0], y0[t][1]); s_y0[t].y = pkbf(y0[t][2], y0[t][3]); s_hh[t].x = pkbf(hh[t][0], hh[t][1]); s_hh[t].y = pkbf(hh[t][2], hh[t][3]); }
            s_jo = jo; s_have = true;
        }
    }
    if (s_have) P6A_STORE();
#undef P6A_LOAD
#undef P6A_STORE
    LBAR();
}
__device__ __forceinline__ void p6b_rwkv_seq(Frame& F, const RwArgs& A, const RwX& X, int nwg) {
    using namespace rwk;
    LAS unsigned char* lds = F.lds + RING_OFF;
    constexpr int YLD = 68;
    LAS float* Yf0 = (LAS float*)RSL(6);
    const int tid = F.tid, tok = tid >> 3, dg = tid & 7, lane = F.lane, fr = lane & 15, fq = lane >> 4;
    const int w = F.wave, m0 = 16 * (w >> 1), n0a = 32 * (w & 1);
    const int fm = swz(m0 + fr, fq * 16);
    int fn[2], orm[2], otr[2];
#pragma unroll
    for (int t = 0; t < 2; ++t) { const int n0 = n0a + 16 * t; fn[t] = swz(n0 + fr, fq * 16); orm[t] = swz(m0 + fr, 2 * (n0 + 4 * fq)); otr[t] = swz(n0 + fr, 2 * (m0 + 4 * fq)); }
    for (int unit = blockIdx.x; unit < BATCH * NH; unit += nwg) {
        const int b = unit >> 3, h = unit & 7; const int cb = 64 * h + 8 * dg;
        f32x4 sacc[2]; sacc[0] = (f32x4){0.f, 0.f, 0.f, 0.f}; sacc[1] = sacc[0];
        for (int u = tid; u < SLOT / 4; u += NWAVES * 64) ((LAS unsigned*)RSL(4))[u] = 0u;
        float lnw[8], lnb[8]; ld8f(A.ln_w + cb, lnw); ld8f(A.ln_b + cb, lnb);
        struct Nx { v4u vb, g; u32x2g p1[2], gt[2], y0[2], h[2]; f32x4 ge[2]; };
        Nx nA, nB;
#define P6B_LOAD(cc, N) do { const int job_ = unit * 32 + (cc); const size_t jo_ = (size_t)job_ * 4096; const size_t grow_ = (size_t)b * SEQ + (cc) * 64 + tok; \
            _Pragma("unroll") for (int t = 0; t < 2; ++t) { N.y0[t] = *(const u32x2g*)(X.Y0 + jo_ + ((w * 2 + t) * 64 + lane) * 4); N.h[t] = *(const u32x2g*)(X.H + jo_ + ((w * 2 + t) * 64 + lane) * 4); \
                N.p1[t] = *(const u32x2g*)(X.P1 + jo_ + ((w * 2 + t) * 64 + lane) * 4); N.gt[t] = *(const u32x2g*)(X.GT + jo_ + ((w * 2 + t) * 64 + lane) * 4); \
                N.ge[t] = *(const f32x4*)(X.GE + (size_t)job_ * 64 + n0a + 16 * t + 4 * fq); } \
            const bf16* vbp_ = (job_ < 2048) ? (X.VB0 + jo_) : (X.VB1 + (jo_ - (size_t)2048 * 4096)); \
            N.vb = *(const v4u*)(vbp_ + tok * 64 + 8 * dg); N.g = *(const v4u*)(X.G + jo_ + tok * 64 + 8 * dg); } while (0)
#define P6B_OUT(par, vbw_, gw_, grow_) do { float y[8]; ld8l(Yf0 + (par) * (64 * YLD) + tok * YLD + 8 * dg, y); \
            const float g[8] = {bflo(gw_.x), bfhi(gw_.x), bflo(gw_.y), bfhi(gw_.y), bflo(gw_.z), bfhi(gw_.z), bflo(gw_.w), bfhi(gw_.w)}; \
            const float vb[8] = {bflo(vbw_.x), bfhi(vbw_.x), bflo(vbw_.y), bfhi(vbw_.y), bflo(vbw_.z), bfhi(vbw_.z), bflo(vbw_.w), bfhi(vbw_.w)}; \
            float s_ = 0.f; _Pragma("unroll") for (int j = 0; j < 8; ++j) s_ += y[j]; \
            const float mean = sum8(s_) * (1.0f / 64.0f); float q_ = 0.f; \
            _Pragma("unroll") for (int j = 0; j < 8; ++j) { y[j] -= mean; q_ += y[j] * y[j]; } \
            const float rstd = __builtin_amdgcn_rsqf(sum8(q_) * (1.0f / 64.0f) + LNX_EPS); float ov[8]; \
            _Pragma("unroll") for (int j = 0; j < 8; ++j) ov[j] = (y[j] * rstd * lnw[j] + lnb[j] + vb[j]) * g[j]; \
            v4u wv_; wv_.x = pkbf(ov[0], ov[1]); wv_.y = pkbf(ov[2], ov[3]); wv_.z = pkbf(ov[4], ov[5]); wv_.w = pkbf(ov[6], ov[7]); \
            *(GAS v4u*)(A.QO + (grow_) * D + 512 + cb) = wv_; } while (0)
        v4u p_vb = (v4u){0u, 0u, 0u, 0u}, p_g = p_vb; size_t p_row = 0;
#define P6B_STEP(c, N) do { const int par = (c) & 1, scur = 4 + par, snxt = 5 - par; const size_t grow = (size_t)b * SEQ + (c) * 64 + tok; \
            _Pragma("unroll") for (int t = 0; t < 2; ++t) { *(LAS u32x2g*)(RSL(par) + orm[t]) = N.p1[t]; *(LAS u32x2g*)(RSL(2 + par) + otr[t]) = N.gt[t]; } \
            f32x4 yacc[2], hcur[2], gecur[2]; \
            _Pragma("unroll") for (int t = 0; t < 2; ++t) { yacc[t] = (f32x4){bflo(N.y0[t].x), bfhi(N.y0[t].x), bflo(N.y0[t].y), bfhi(N.y0[t].y)}; hcur[t] = (f32x4){bflo(N.h[t].x), bfhi(N.h[t].x), bflo(N.h[t].y), bfhi(N.h[t].y)}; gecur[t] = N.ge[t]; } \
            const v4u vbw = N.vb, gw = N.g; \
            if ((c) + 2 < SEQ / 64) P6B_LOAD((c) + 2, N); \
            LBAR(); \
            {   const Fr2 aP1 = ldf(RSL(par), fm), aS = ldf(RSL(scur), fm); Fr2 bS[2], bG[2]; \
                _Pragma("unroll") for (int t = 0; t < 2; ++t) { bS[t] = ldf(RSL(scur), fn[t]); bG[t] = ldf(RSL(2 + par), fn[t]); } \
                _Pragma("unroll") for (int t = 0; t < 2; ++t) { yacc[t] = mm<true>(aP1, bS[t], yacc[t]); sacc[t] = mm<true>(aS, bG[t], sacc[t] * gecur[t] + hcur[t]); } \
                _Pragma("unroll") for (int t = 0; t < 2; ++t) { const int n0 = n0a + 16 * t; *(LAS f32x4*)(Yf0 + par * (64 * YLD) + (m0 + fr) * YLD + n0 + 4 * fq) = yacc[t]; st4(RSL(snxt), orm[t], sacc[t]); } } \
            if ((c) > 0) P6B_OUT(par ^ 1, p_vb, p_g, p_row);                    \
            p_vb = vbw; p_g = gw; p_row = grow; } while (0)
        P6B_LOAD(0, nA); P6B_LOAD(1, nB);
        for (int c = 0; c < SEQ / 64; c += 2) {
            P6B_STEP(c, nA);
            P6B_STEP(c + 1, nB);
        }
#undef P6B_STEP
        LBAR();
        P6B_OUT(1, p_vb, p_g, p_row);
#undef P6B_LOAD
#undef P6B_OUT
        LBAR();
    }
}

namespace sba {
using bf16x8 = __attribute__((ext_vector_type(8))) short;
using s16x4 = __attribute__((ext_vector_type(4))) short;
using f32x16 = __attribute__((ext_vector_type(16))) float;
using u32x4 = __attribute__((ext_vector_type(4))) unsigned;
constexpr int QB = 256, KVBLK = 64;
constexpr int LDS_K = 0, LDS_V = 16384, LDS_ST = 32768, ST_LD = 68, LDS_FLAG = LDS_ST + 8 * 32 * ST_LD * 4, LDS_BYTES_ATT = LDS_FLAG + 64;
constexpr float R_DEAD = -160.0f;
#define SBAR() __builtin_amdgcn_sched_barrier(0)
typedef float f32x2_t __attribute__((ext_vector_type(2))); typedef __bf16 bf16x2_t __attribute__((ext_vector_type(2)));
__device__ __forceinline__ unsigned cvtpk_s(float lo, float hi) { f32x2_t v = {lo, hi}; bf16x2_t b = __builtin_convertvector(v, bf16x2_t); return __builtin_bit_cast(unsigned, b); }
__device__ __forceinline__ void qkt(f32x16& p0, f32x16& p1, const char* Kslot, const bf16x8* qr, int r32, int hi) {
    const char* kb = Kslot + hi * 1024 + r32 * 16;
    const f32x16 z = f32x16{};
#pragma unroll
    for (int d0 = 0; d0 < 4; ++d0) {
        const bf16x8 b0 = *reinterpret_cast<const bf16x8*>(kb + d0 * 2048);
        const bf16x8 b1 = *reinterpret_cast<const bf16x8*>(kb + d0 * 2048 + 512);
        if (d0 == 0) { p0 = __builtin_amdgcn_mfma_f32_32x32x16_bf16(b0, qr[0], z, 0, 0, 0); p1 = __builtin_amdgcn_mfma_f32_32x32x16_bf16(b1, qr[0], z, 0, 0, 0); }
        else { p0 = __builtin_amdgcn_mfma_f32_32x32x16_bf16(b0, qr[d0], p0, 0, 0, 0); p1 = __builtin_amdgcn_mfma_f32_32x32x16_bf16(b1, qr[d0], p1, 0, 0, 0); }
    }
}
__device__ __forceinline__ void pv(f32x16* o, int vb, bf16x8 pa0, bf16x8 pa1, bf16x8 pa2, bf16x8 pa3) {
#pragma unroll
    for (int d0 = 0; d0 < 2; ++d0) { s16x4 lo[4], hi[4];
#pragma unroll
        for (int ks = 0; ks < 4; ++ks) {
            asm volatile("ds_read_b64_tr_b16 %0,%1 offset:%c2" : "=&v"(lo[ks]) : "v"(vb), "i"(d0 * 4096 + ks * 1024) : "memory");
            asm volatile("ds_read_b64_tr_b16 %0,%1 offset:%c2" : "=&v"(hi[ks]) : "v"(vb), "i"(d0 * 4096 + ks * 1024 + 512) : "memory"); }
        asm volatile("s_waitcnt lgkmcnt(0)" ::: "memory"); SBAR();
#define PK(k) (bf16x8){lo[k][0], lo[k][1], lo[k][2], lo[k][3], hi[k][0], hi[k][1], hi[k][2], hi[k][3]}
        o[d0] = __builtin_amdgcn_mfma_f32_32x32x16_bf16(pa0, PK(0), o[d0], 0, 0, 0);
        o[d0] = __builtin_amdgcn_mfma_f32_32x32x16_bf16(pa1, PK(1), o[d0], 0, 0, 0);
        o[d0] = __builtin_amdgcn_mfma_f32_32x32x16_bf16(pa2, PK(2), o[d0], 0, 0, 0);
        o[d0] = __builtin_amdgcn_mfma_f32_32x32x16_bf16(pa3, PK(3), o[d0], 0, 0, 0);
#undef PK
    }
}
__device__ __forceinline__ float swap_sum(float x, float& other_if_lo, int hi) {
    auto rr = __builtin_amdgcn_permlane32_swap(__float_as_uint(x), __float_as_uint(x), false, false);
    const float a = __uint_as_float(rr[0]), b = __uint_as_float(rr[1]);
    other_if_lo = hi ? 0.f : b;
    return a + b;
}
__device__ __forceinline__ float swap_prod(float x, float& other_if_lo, int hi) {
    auto rr = __builtin_amdgcn_permlane32_swap(__float_as_uint(x), __float_as_uint(x), false, false);
    const float a = __uint_as_float(rr[0]), b = __uint_as_float(rr[1]);
    other_if_lo = hi ? 1.0f : b;
    return a * b;
}
__device__ __forceinline__ void attn_wave_unit(int b, int h, int qblk, bf16* QO, const bf16* __restrict__ KB, const bf16* __restrict__ VB, const float* gout, char* wsm  ) {
    const int lane = threadIdx.x & 63, r32 = lane & 31, hi = lane >> 5;
    const long rowbase = (long)b * SEQ; const int q0 = qblk * 32;
    bf16* Qw = QO + (rowbase + q0) * D + h * HD;
    const bf16* Kh = KB + rowbase * SBW + h * HD; const bf16* Vh = VB + rowbase * SBW + h * HD;
    const unsigned lds0 = (unsigned)(uintptr_t)wsm;
    const int jtop = (q0 + 30) >> 6;
    const bf16* vsrc = Vh + (long)(lane >> 3) * SBW + (lane & 7) * 8;
    const int vdst0 = ((lane & 7) >> 2) * 4096 + ((lane >> 3) & 15) * 64 + (lane & 3) * 16;
    const int vb0 = (int)lds0 + ((lane >> 4) & 1) * 32 + (lane & 3) * 8 + (4 * hi + ((lane & 15) >> 2)) * 64;
    const bf16* ksrc = Kh + (long)r32 * SBW + hi * 8;
    bf16x8 qr[4];
#pragma unroll
    for (int d0 = 0; d0 < 4; ++d0) qr[d0] = *reinterpret_cast<const bf16x8*>(&Qw[(long)r32 * D + d0 * 16 + hi * 8]);
    bf16x8 kf[8]; u32x4 vr[8];
#define SBA_LOAD(t) do { const bf16* kp_ = ksrc + (long)(t) * KVBLK * SBW; const bf16* vp_ = vsrc + (long)(t) * KVBLK * SBW; \
        _Pragma("unroll") for (int d0 = 0; d0 < 4; ++d0) { kf[2 * d0] = *reinterpret_cast<const bf16x8*>(kp_ + d0 * 16); kf[2 * d0 + 1] = *reinterpret_cast<const bf16x8*>(kp_ + 32 * SBW + d0 * 16); } \
        _Pragma("unroll") for (int i = 0; i < 8; ++i) vr[i] = *(const u32x4*)(vp_ + (long)(8 * i) * SBW); } while (0)
    SBA_LOAD(jtop);
    float R = 0.f; f32x16 o[2]; o[0] = f32x16{}; o[1] = f32x16{};
    const int qrow = q0 + r32;
    for (int jt = jtop; jt >= 0; --jt) {
        const int cur = (jtop - jt) & 1;
#pragma unroll
        for (int i = 0; i < 8; ++i) *(u32x4*)(wsm + cur * 8192 + vdst0 + (i >> 1) * 1024 + (i & 1) * 512) = vr[i];
        f32x16 p0, p1;
        {   const f32x16 z = f32x16{};
            p0 = __builtin_amdgcn_mfma_f32_32x32x16_bf16(kf[0], qr[0], z, 0, 0, 0); p1 = __builtin_amdgcn_mfma_f32_32x32x16_bf16(kf[1], qr[0], z, 0, 0, 0);
#pragma unroll
            for (int d0 = 1; d0 < 4; ++d0) { p0 = __builtin_amdgcn_mfma_f32_32x32x16_bf16(kf[2 * d0], qr[d0], p0, 0, 0, 0); p1 = __builtin_amdgcn_mfma_f32_32x32x16_bf16(kf[2 * d0 + 1], qr[d0], p1, 0, 0, 0); } }
        if (jt > 0) SBA_LOAD(jt - 1);
        const int kb = 64 * jt + 4 * hi; const bool diag = (jt == jtop);
#pragma unroll
        for (int r = 0; r < 16; ++r) {
            { float rr = __builtin_amdgcn_rcpf(1.0f + __builtin_amdgcn_exp2f(p0[r]));
              if (diag) { const int key = kb + (r & 3) + 8 * (r >> 2); if (key >= qrow) rr = 1.0f; }
              p0[r] = rr; }
            { float rr = __builtin_amdgcn_rcpf(1.0f + __builtin_amdgcn_exp2f(p1[r]));
              if (diag) { const int key = kb + 32 + (r & 3) + 8 * (r >> 2); if (key >= qrow) rr = 1.0f; }
              p1[r] = rr; }
        }
        float c0[4], c1[4], x0[4], x1[4];
#pragma unroll
        for (int g = 0; g < 4; ++g) {
            const float s0 = (p0[4 * g] * p0[4 * g + 1]) * (p0[4 * g + 2] * p0[4 * g + 3]);
            const float s1 = (p1[4 * g] * p1[4 * g + 1]) * (p1[4 * g + 2] * p1[4 * g + 3]);
            c0[g] = swap_prod(s0, x0[g], hi); c1[g] = swap_prod(s1, x1[g], hi);
        }
        const float Cr = __builtin_amdgcn_exp2f(R);
        float suf0[4], suf1[4];
        suf1[3] = Cr; suf1[2] = suf1[3] * c1[3]; suf1[1] = suf1[2] * c1[2]; suf1[0] = suf1[1] * c1[1];
        suf0[3] = suf1[0] * c1[0]; suf0[2] = suf0[3] * c0[3]; suf0[1] = suf0[2] * c0[2]; suf0[0] = suf0[1] * c0[1];
        R += __builtin_amdgcn_logf(((c0[0] * c0[1]) * (c0[2] * c0[3])) * ((c1[0] * c1[1]) * (c1[2] * c1[3])));
#pragma unroll
        for (int g = 0; g < 4; ++g) {
            { const float e3 = suf0[g] * x0[g], e2 = e3 * p0[4 * g + 3], e1 = e2 * p0[4 * g + 2], e0 = e1 * p0[4 * g + 1];
              p0[4 * g + 3] = (1.0f - p0[4 * g + 3]) * e3; p0[4 * g + 2] = (1.0f - p0[4 * g + 2]) * e2; p0[4 * g + 1] = (1.0f - p0[4 * g + 1]) * e1; p0[4 * g] = (1.0f - p0[4 * g]) * e0; }
            { const float e3 = suf1[g] * x1[g], e2 = e3 * p1[4 * g + 3], e1 = e2 * p1[4 * g + 2], e0 = e1 * p1[4 * g + 1];
              p1[4 * g + 3] = (1.0f - p1[4 * g + 3]) * e3; p1[4 * g + 2] = (1.0f - p1[4 * g + 2]) * e2; p1[4 * g + 1] = (1.0f - p1[4 * g + 1]) * e1; p1[4 * g] = (1.0f - p1[4 * g]) * e0; }
        }
#define PKW(P, B) cvtpk_s(P[B], P[B + 1])
        const u32x4 pw0 = (u32x4){PKW(p0, 0), PKW(p0, 2), PKW(p0, 4), PKW(p0, 6)}, pw1 = (u32x4){PKW(p0, 8), PKW(p0, 10), PKW(p0, 12), PKW(p0, 14)};
        const u32x4 pw2 = (u32x4){PKW(p1, 0), PKW(p1, 2), PKW(p1, 4), PKW(p1, 6)}, pw3 = (u32x4){PKW(p1, 8), PKW(p1, 10), PKW(p1, 12), PKW(p1, 14)};
#undef PKW
        SBAR();
        asm volatile("s_waitcnt lgkmcnt(0)" ::: "memory");
        pv(o, vb0 + cur * 8192, __builtin_bit_cast(bf16x8, pw0), __builtin_bit_cast(bf16x8, pw1), __builtin_bit_cast(bf16x8, pw2), __builtin_bit_cast(bf16x8, pw3));
        if (__all(R < R_DEAD)) break;
    }
#undef SBA_LOAD
    {
        float* stg = (float*)wsm;
        asm volatile("s_waitcnt lgkmcnt(0)" ::: "memory");
#pragma unroll
        for (int r = 0; r < 16; ++r) { const int orow = (r & 3) + 8 * (r >> 2) + 4 * hi;
#pragma unroll
            for (int d0 = 0; d0 < 2; ++d0) stg[orow * ST_LD + d0 * 32 + r32] = o[d0][r]; }
        asm volatile("s_waitcnt lgkmcnt(0)" ::: "memory");
        const int ch = lane & 7;
        const f32x4 ga = *(const f32x4*)(gout + h * HD + ch * 8), gb = *(const f32x4*)(gout + h * HD + ch * 8 + 4);
#pragma unroll
        for (int i = 0; i < 4; ++i) { const int row = i * 8 + (lane >> 3);
            const f32x4 a = *(const f32x4*)(stg + row * ST_LD + ch * 8), c = *(const f32x4*)(stg + row * ST_LD + ch * 8 + 4);
            float ss = (a.x * a.x + a.y * a.y) + (a.z * a.z + a.w * a.w) + (c.x * c.x + c.y * c.y) + (c.z * c.z + c.w * c.w);
            ss = sum8(ss);
            const float hs = __builtin_amdgcn_rsqf(ss * (1.0f / 64.0f) + 1e-6f);
            u32x4 w; w.x = cvtpk_s(a.x * hs * ga.x, a.y * hs * ga.y); w.y = cvtpk_s(a.z * hs * ga.z, a.w * hs * ga.w);
            w.z = cvtpk_s(c.x * hs * gb.x, c.y * hs * gb.y); w.w = cvtpk_s(c.z * hs * gb.z, c.w * hs * gb.w);
            *(u32x4*)(Qw + (long)row * D + ch * 8) = w; }
        asm volatile("s_waitcnt lgkmcnt(0)" ::: "memory");
    }
}
#undef SBAR
__device__ __forceinline__ void attn_phase(Frame& F, bf16* QO, const bf16* KB, const bf16* VB, const float* gout, unsigned* queue, int first_ticket, int ticket_base) {
    char* wsm = (char*)F.lds + RING_OFF + F.wave * 16384;
    const int nunits = BATCH * NH * (SEQ / 32);
    int pend = -1; int tfirst = first_ticket;
    for (;;) {
        int uu;
        if (pend >= 0) { uu = pend; pend = -1; }
        else { unsigned t;
               if (tfirst >= 0) { t = (unsigned)tfirst; tfirst = -1; }
               else { t = 0u; if (F.lane == 0) t = __hip_atomic_fetch_add(queue, 1u, __ATOMIC_RELAXED, __HIP_MEMORY_SCOPE_AGENT); t = (unsigned)__builtin_amdgcn_readfirstlane((int)t) + (unsigned)ticket_base; }
               if (2u * t >= (unsigned)nunits) break; uu = (int)(2u * t); pend = uu + 1; }
        attn_wave_unit(uu >> 9, (uu >> 6) & 7, uu & 63, QO, KB, VB, gout, wsm);
    }
    __syncthreads();
}
}

struct Args { const float* in[26]; float* out; unsigned char* ws; int ph_lo, ph_hi, li, pad; };
__global__ void __launch_bounds__(NWAVES * 64, 2) skel_fwd(Args args) {
    extern __shared__ __attribute__((aligned(16))) unsigned char lds[];
    Frame F;
    F.lds = (LAS unsigned char*)lds;
    F.MISC = (volatile LAS unsigned*)(F.lds + MISC_OFF);
    F.tid = threadIdx.x; F.lane = F.tid & 63; F.wave = __builtin_amdgcn_readfirstlane(F.tid >> 6);
    F.G = gridDim.x; { const int bx = blockIdx.x; F.vcu = (F.G % 8 == 0) ? (bx % 8) * (F.G / 8) + bx / 8 : bx; }
    unsigned char* ws = args.ws;
    F.ctl = (gu32*)(ws + WS_CTL);
    const float* x = args.in[0];
    bf16* W1U = (bf16*)(ws + WS_W1U); bf16* W1D = (bf16*)(ws + WS_W1D); bf16* W2U = (bf16*)(ws + WS_W2U); bf16* W2D = (bf16*)(ws + WS_W2D);
    bf16* WIN = (bf16*)(ws + WS_WIN); bf16* WOUT = (bf16*)(ws + WS_WOUT); bf16* WLORA = (bf16*)(ws + WS_WLORA);
    bf16* XB = (bf16*)(ws + WS_XB); bf16* ACT = (bf16*)(ws + WS_ACT); bf16* QO = (bf16*)(ws + WS_QO); bf16* KB = (bf16*)(ws + WS_KB); bf16* VB = (bf16*)(ws + WS_VB);
    bf16* RW = (bf16*)(ws + WS_RW); bf16* ALORA = (bf16*)(ws + WS_ALORA); float* LW = (float*)(ws + WS_LW); bf16* AB = (bf16*)(ws + WS_AB); bf16* GB = (bf16*)(ws + WS_GB);
    float* SSQ = (float*)(ws + WS_SSQ); float* out = args.out;
    for (int u = F.tid; u < (LDS_BYTES - LDSCTL_OFF) / 4; u += NWAVES * 64) ((LAS unsigned*)(F.lds + LDSCTL_OFF))[u] = 0u;
    __syncthreads();
    XcdBarrier bar; bar.bar = (unsigned*)(F.ctl + CW_BAR); bar.x = 0; bar.st = nullptr;
    if (N_LAUNCHES != PER_PHASE) bar = xcd_barrier_post((unsigned*)(F.ctl + CW_BAR), F.MISC + 8);
#define GRID_BAR(seam) do { if (N_LAUNCHES == PER_PHASE) { if (F.tid == 0) __hip_atomic_store(F.ctl + CW_TMO, 0xBADBA0u | (unsigned)(seam), RLX_AGENT); } else { xcd_barrier(bar); } } while (0)
    const int lo = args.ph_lo, hi = args.ph_hi;
#define IN(k) (lo <= (k) && (k) < hi)
#define BOTH(k) (IN(k) && IN((k) + 1))
    if (IN(0)) {
        p0_prologue(F, x, args.in[1], args.in[2], args.in[3], args.in[4], args.in[5], args.in[6], args.in[12], args.in[14], args.in[15], args.in[21], args.in[22], args.in[23], args.in[24], args.in[25],
                    W1U, W1D, W2U, W2D, WIN, WOUT, WLORA, XB, SSQ); if (BOTH(0)) GRID_BAR(0);
    }
    if (IN(1)) {
        pg8::Gemm g{XB, W1U, M, 2 * FF, D}; pg8::StaticOrder S; S.init(M, 2 * FF, F.G, (int)blockIdx.x);
        pg8::EpiSwiGLU E{ACT, FF, SSQ};
        pg8::gemm_phase<pg8::EpiSwiGLU, pg8::StaticOrder, true, true>(F.lds + RING_OFF, g, S, E);
        if (BOTH(1)) GRID_BAR(1);
    }
    if (IN(2)) {
        pg8::Gemm g{ACT, W1D, M, D, FF, 0, 1}; pg8::StaticOrder S; S.init(M, D, F.G, (int)blockIdx.x, 1);
        pg8::EpiResid E{XB, nullptr, XB, SSQ, 0.5f, 1};
        pg8::gemm_phase<pg8::EpiResid, pg8::StaticOrder, true, true>(F.lds + RING_OFF, g, S, E);
        if (BOTH(2)) GRID_BAR(2);
    }
    if (IN(3)) {
        pg8::Gemm g{XB, WIN, M, PW, D}; pg8::StaticOrder S; S.init(M, PW, F.G, (int)blockIdx.x);
        pg8::EpiWin E{QO, KB, VB, RW, SSQ, args.in[7], args.in[8], 0.125f * 1.4426950408889634f};
        pg8::gemm_phase<pg8::EpiWin, pg8::StaticOrder, true, true>(F.lds + RING_OFF, g, S, E);
        if (F.G >= 256) {
            const int nlo = (M / 256) * (PW / 256) - 6 * F.G;
            if ((int)blockIdx.x >= nlo) { __syncthreads();
                p0_items(F, x, args.in[1], args.in[2], args.in[3], args.in[4], args.in[5], args.in[6], args.in[12], args.in[14], args.in[15], args.in[21], args.in[22], args.in[23], args.in[24], args.in[25],
                         W1U, W1D, W2U, W2D, WIN, WOUT, WLORA, XB, SSQ, 1, ((int)blockIdx.x - nlo) * NWAVES + F.wave, (F.G - nlo) * NWAVES); }
        }
        if (BOTH(3)) GRID_BAR(3);
    }
    if (IN(6)) {
        RwArgs A{RW, WLORA, WLORA + 512 * 64, WLORA + 2 * 512 * 64, args.in[11], args.in[13], QO, args.in[10], args.in[16], args.in[17], args.in[18], args.in[19], args.in[20]};
        bf16* ob = (bf16*)out;
        RwX X{ob + (size_t)32 * 1024 * 1024, ob + (size_t)48 * 1024 * 1024, (bf16*)LW, (bf16*)LW + (size_t)16 * 1024 * 1024, AB, AB + (size_t)8 * 1024 * 1024, SSQ, GB};
        p6a_rwkv_local(F, A, X);
        GRID_BAR(16);
        const int nseq = (F.G >= 2 * BATCH * NH) ? BATCH * NH : F.G;
        if ((int)blockIdx.x < nseq) { p6b_rwkv_seq(F, A, X, nseq); __syncthreads(); }
        const int nfree = (F.G - nseq) * NWAVES;
        sba::attn_phase(F, QO, KB, VB, args.in[9], (unsigned*)(F.ctl + CW_QUEUE), ((int)blockIdx.x >= nseq) ? ((int)blockIdx.x - nseq) * NWAVES + F.wave : -1, nfree);
        if (BOTH(6)) GRID_BAR(6);
    }
    if (IN(8)) {
        pg8::Gemm g{QO, WOUT, M, D, D}; pg8::StaticOrder S; S.init(M, D, F.G, (int)blockIdx.x, 1);
        pg8::EpiResid E{XB, nullptr, XB, SSQ, 1.0f, 1};
        pg8::gemm_phase<pg8::EpiResid, pg8::StaticOrder, true, true>(F.lds + RING_OFF, g, S, E);
        if (BOTH(8)) GRID_BAR(8);
    }
    if (IN(9)) {
        pg8::Gemm g{XB, W2U, M, 2 * FF, D}; pg8::StaticOrder S; S.init(M, 2 * FF, F.G, (int)blockIdx.x);
        pg8::EpiSwiGLU E{ACT, FF, SSQ};
        pg8::gemm_phase<pg8::EpiSwiGLU, pg8::StaticOrder, true, true>(F.lds + RING_OFF, g, S, E);
        if (BOTH(9)) GRID_BAR(9);
    }
    if (IN(10)) {
        pg8::Gemm g{ACT, W2D, M, D, FF, 0, 1}; pg8::StaticOrder S; S.init(M, D, F.G, (int)blockIdx.x, 1);
        pg8::EpiResid E{XB, out, nullptr, SSQ, 0.5f, 0};
        pg8::gemm_phase<pg8::EpiResid, pg8::StaticOrder, true, true>(F.lds + RING_OFF, g, S, E);
    }
#undef IN
#undef BOTH
}

extern "C" void kernel_launch(void* const* d_in, const int* in_sizes, int n_in, void* d_out, int out_size, void* d_ws, size_t ws_size, hipStream_t stream) {
    static int grid = 0;
    if (grid == 0) {
        if (n_in != 26 || in_sizes[0] != M * D || out_size != M * D || ws_size < WS_END) { fprintf(stderr, "kernel_launch: unexpected shapes: n_in %d in0 %d out %d ws %zu (need %zu)\n", n_in, n_in > 0 ? in_sizes[0] : -1, out_size, ws_size, (size_t)WS_END); grid = -1; return; }
        int dev = 0, cus = 0, per_cu = 0;
        if (hipGetDevice(&dev) != hipSuccess || hipDeviceGetAttribute(&cus, hipDeviceAttributeMultiprocessorCount, dev) != hipSuccess) { grid = -1; return; }
        if (hipFuncSetAttribute((const void*)skel_fwd, hipFuncAttributeMaxDynamicSharedMemorySize, LDS_BYTES) != hipSuccess) { fprintf(stderr, "kernel_launch: hipFuncSetAttribute failed\n"); grid = -1; return; }
        if (hipOccupancyMaxActiveBlocksPerMultiprocessor(&per_cu, (const void*)skel_fwd, NWAVES * 64, LDS_BYTES) != hipSuccess || per_cu < 1) { fprintf(stderr, "kernel_launch: occupancy query reports %d blocks per CU\n", per_cu); per_cu = 1; }
        (void)hipGetLastError();
        grid = cus;
    }
    if (grid < 0) return;
    if (hipMemsetAsync((char*)d_ws + WS_CTL, 0, CTL_ZERO_BYTES, stream) != hipSuccess) return;
    Args a{};
    for (int i = 0; i < 26; ++i) a.in[i] = (const float*)d_in[i];
    a.out = (float*)d_out; a.ws = (unsigned char*)d_ws;
    for (int li = 0; li < N_LAUNCHES; ++li) {
        a.ph_lo = (N_LAUNCHES == PER_PHASE) ? li : 0; a.ph_hi = (N_LAUNCHES == PER_PHASE) ? li + 1 : PER_PHASE; a.li = li;
        hipLaunchKernelGGL(skel_fwd, dim3(grid), dim3(NWAVES * 64), LDS_BYTES, stream, a);
    }
}
```

```cpp
#include <hip/hip_runtime.h>
#include <hip/hip_bf16.h>
#include <cstdio>
#include <cstdint>
#include <cmath>
namespace pg8 {
#define PG8_LAS __attribute__((address_space(3)))
typedef unsigned short bf16_t;
typedef short bf16x8 __attribute__((ext_vector_type(8)));
typedef float f32x4 __attribute__((ext_vector_type(4)));
typedef unsigned u32x4 __attribute__((ext_vector_type(4)));
constexpr int BM = 256, BK = 64, HALF = 128, HTB = HALF * BK * 2  , STAGE_BYTES = 8 * HTB, NXCD = 8, WGM = 4;

__host__ __device__ __forceinline__ int lds_byte(int r, int c) { const int st = (r >> 4) * 2 + (c >> 5), rr = r & 15, cc = c & 31, ob = rr * 64 + cc * 2; return st * 1024 + (ob ^ (((ob >> 9) & 1) << 5)); }
__host__ __device__ __forceinline__ void stage_rc(int b, int& R, int& C) { const int st = b / 1024, sb = b % 1024, swz = sb ^ (((sb >> 9) & 1) << 5); R = (st >> 1) * 16 + swz / 64; C = (st & 1) * 32 + (swz % 64) / 2; }
__host__ __device__ __forceinline__ int perm32(int rho) { const int n = rho >> 4, i = rho & 15; return 8 * (i >> 2) + 4 * n + (i & 3); }

struct Unit { int pm, pn; };
struct Gemm { const bf16_t* A; const bf16_t* Bt; int M, N, K; int ld; int ablk; };

struct StaticOrder {
    int nM, nN, nwg, G, c, rev;
    __host__ __device__ void init(int M, int N, int G_, int c_, int rev_ = 0) { nM = M / BM; nN = N / BM; nwg = nM * nN; G = G_; c = c_; rev = (rev_ && nwg % G_ == 0) ? nwg / G_ : 0; }
    __host__ __device__ bool next(int i, Unit& u) const {
        if (rev) { if (i >= rev) return false; i = rev - 1 - i; }
        const long L = (long)i * G + c; if (L >= nwg) return false;
        int wgid = (int)L; { const int q = nwg / NXCD, r = nwg % NXCD, xcd = wgid % NXCD, off = wgid / NXCD; wgid = (xcd < r ? xcd * (q + 1) : r * (q + 1) + (xcd - r) * q) + off; }
        const int nig = WGM * nN, gid = wgid / nig, fm = gid * WGM, gsz = (nM - fm) < WGM ? (nM - fm) : WGM;
        u.pm = fm + ((wgid % nig) % gsz); u.pn = (wgid % nig) / gsz; return true;
    }
    __device__ __forceinline__ void a_ready(const Unit&) const {}
    __device__ __forceinline__ void done(const Unit&) const {}
};


__device__ __forceinline__ unsigned cvt_pk_bf16(float lo, float hi) { unsigned r; asm volatile("v_cvt_pk_bf16_f32 %0, %1, %2" : "=v"(r) : "v"(lo), "v"(hi)); return r; }
typedef unsigned u32x2 __attribute__((ext_vector_type(2)));
constexpr float RMS_EPS_F = 1e-6f;
constexpr float LOG2E_F = 1.4426950408889634f;
__device__ __forceinline__ f32x4 row_q(const float* ssqp, int row, int fq) { return *(const f32x4*)(ssqp + (size_t)row * 16 + 4 * fq); }
__device__ __forceinline__ float rs_fin(const f32x4 q) {
    float s = (q[0] + q[1]) + (q[2] + q[3]);
    auto a = __builtin_amdgcn_permlane16_swap(__float_as_uint(s), __float_as_uint(s), false, false); s = __uint_as_float(a[0]) + __uint_as_float(a[1]);
    auto b = __builtin_amdgcn_permlane32_swap(__float_as_uint(s), __float_as_uint(s), false, false); s = __uint_as_float(b[0]) + __uint_as_float(b[1]);
    return __builtin_amdgcn_rsqf(s * (1.0f / 1024.0f) + RMS_EPS_F);
}
__device__ __forceinline__ float silu_f(float g) { return g * __builtin_amdgcn_rcpf(1.0f + __builtin_amdgcn_exp2f(-g * LOG2E_F)); }
__device__ __forceinline__ float sigmoid_f(float g) { return __builtin_amdgcn_rcpf(1.0f + __builtin_amdgcn_exp2f(-g * LOG2E_F)); }

struct EpiSwiGLU {
    static constexpr bool PERM = true, AFTER_DRAIN = false;
    bf16_t* O; int ldo; const float* ssqp;
    __device__ __forceinline__ static f32x4 swiglu4(const f32x4 g, const f32x4 uu, float nrs, float rs2) {
        const f32x4 t = g * nrs, gu = g * uu; f32x4 r;
#pragma unroll
        for (int i = 0; i < 4; ++i) r[i] = __builtin_amdgcn_rcpf(1.0f + __builtin_amdgcn_exp2f(t[i]));
        return gu * (r * rs2);
    }
    __device__ __forceinline__ void operator()(const f32x4 (&acc)[2][2][4][2], const Unit& u, int wr, int wc, int fr, int fq) const {
        const int row0 = u.pm * BM + wr * 64 + fr;
        const size_t obase = ((size_t)u.pm * (ldo / BK) + 2 * u.pn + (wc >> 1)) * (BM * BK) + (wc & 1) * 32 + 8 * fq;
        f32x4 q[2][4];
#pragma unroll
        for (int ai = 0; ai < 2; ++ai)
#pragma unroll
            for (int m = 0; m < 4; ++m) q[ai][m] = row_q(ssqp, row0 + ai * HALF + m * 16, fq);
        float rsv[2][4];
#pragma unroll
        for (int ai = 0; ai < 2; ++ai)
#pragma unroll
            for (int m = 0; m < 4; ++m) rsv[ai][m] = rs_fin(q[ai][m]);
#pragma unroll
        for (int ai = 0; ai < 2; ++ai)
#pragma unroll
            for (int m = 0; m < 4; ++m) {
                const int row = row0 + ai * HALF + m * 16; const float rs = rsv[ai][m], nrs = -LOG2E_F * rs, rs2 = rs * rs;
                const f32x4 o0 = swiglu4(acc[ai][0][m][0], acc[ai][1][m][0], nrs, rs2), o1 = swiglu4(acc[ai][0][m][1], acc[ai][1][m][1], nrs, rs2);
                u32x4 w; w.x = cvt_pk_bf16(o0[0], o0[1]); w.y = cvt_pk_bf16(o0[2], o0[3]); w.z = cvt_pk_bf16(o1[0], o1[1]); w.w = cvt_pk_bf16(o1[2], o1[3]);
                *(u32x4*)(O + obase + (size_t)(row - u.pm * BM) * BK) = w;
            }
    }
};

struct EpiResid {
    static constexpr bool PERM = true, AFTER_DRAIN = false;
    const bf16_t* bhi; float* outf; bf16_t* ohi; float* ssqp; float alpha; int aux;
    __device__ __forceinline__ static f32x4 up_bf(unsigned a, unsigned b) { return (f32x4){__uint_as_float(a << 16), __uint_as_float(a & 0xffff0000u), __uint_as_float(b << 16), __uint_as_float(b & 0xffff0000u)}; }
    __device__ __forceinline__ void operator()(const f32x4 (&acc)[2][2][4][2], const Unit& u, int wr, int wc, int fr, int fq) const {
        const int row0 = u.pm * BM + wr * 64 + fr, col0 = u.pn * BM + wc * 32 + 8 * fq;
        u32x4 bv[2][4][2];
#pragma unroll
        for (int ai = 0; ai < 2; ++ai)
#pragma unroll
            for (int m = 0; m < 4; ++m)
#pragma unroll
                for (int bj = 0; bj < 2; ++bj) bv[ai][m][bj] = *(const u32x4*)(bhi + (size_t)(row0 + ai * HALF + m * 16) * 1024 + col0 + bj * HALF);
        asm volatile("" ::: "memory");
#pragma unroll
        for (int ai = 0; ai < 2; ++ai)
#pragma unroll
            for (int m = 0; m < 4; ++m) {
                const int row = row0 + ai * HALF + m * 16; const size_t off = (size_t)row * 1024 + col0; float ss = 0.f;
#pragma unroll
                for (int bj = 0; bj < 2; ++bj) {
                    const u32x4 h = bv[ai][m][bj];
                    const f32x4 v0 = up_bf(h.x, h.y) + acc[ai][bj][m][0] * alpha, v1 = up_bf(h.z, h.w) + acc[ai][bj][m][1] * alpha;
                    if (aux) ss += ((v0[0] * v0[0] + v0[1] * v0[1]) + (v0[2] * v0[2] + v0[3] * v0[3])) + ((v1[0] * v1[0] + v1[1] * v1[1]) + (v1[2] * v1[2] + v1[3] * v1[3]));
                    if (outf) { *(f32x4*)(outf + off + bj * HALF) = v0; *(f32x4*)(outf + off + bj * HALF + 4) = v1; }
                    else { u32x4 w; w.x = cvt_pk_bf16(v0[0], v0[1]); w.y = cvt_pk_bf16(v0[2], v0[3]); w.z = cvt_pk_bf16(v1[0], v1[1]); w.w = cvt_pk_bf16(v1[2], v1[3]); *(u32x4*)(ohi + off + bj * HALF) = w; }
                }
                if (aux) { ss += __shfl_xor(ss, 16); ss += __shfl_xor(ss, 32); if (fq == 0) ssqp[(size_t)row * 16 + u.pn * 4 + wc] = ss; }
            }
    }
};

struct EpiWin {
    static constexpr bool PERM = true, AFTER_DRAIN = false;
    bf16_t* QO; bf16_t* KB; bf16_t* VB; bf16_t* RW; const float* ssqp; const float* gq; const float* gk; float qscale;
    __device__ __forceinline__ void operator()(const f32x4 (&acc)[2][2][4][2], const Unit& u, int wr, int wc, int fr, int fq) const {
        const int row0 = u.pm * BM + wr * 64 + fr; const int pn = u.pn;
        f32x4 q[2][4];
#pragma unroll
        for (int ai = 0; ai < 2; ++ai)
#pragma unroll
            for (int m = 0; m < 4; ++m) q[ai][m] = row_q(ssqp, row0 + ai * HALF + m * 16, fq);
        float rsv[2][4];
#pragma unroll
        for (int ai = 0; ai < 2; ++ai)
#pragma unroll
            for (int m = 0; m < 4; ++m) rsv[ai][m] = rs_fin(q[ai][m]);
        if (pn < 4) {
            const float* gp = (pn < 2) ? gq : gk; const float osc = (pn < 2) ? qscale : 1.0f;
            f32x4 gv[2][2];
#pragma unroll
            for (int bj = 0; bj < 2; ++bj)
#pragma unroll
                for (int n = 0; n < 2; ++n) gv[bj][n] = *(const f32x4*)(gp + 32 * bj + 8 * fq + 4 * n) * osc;
            bf16_t* dst = (pn < 2) ? QO : KB; const int ld = (pn < 2) ? 1024 : 512; const int colh = 64 * (4 * (pn & 1) + wc) + 8 * fq;
#pragma unroll
            for (int ai = 0; ai < 2; ++ai)
#pragma unroll
                for (int m = 0; m < 4; ++m) {
                    const int row = row0 + ai * HALF + m * 16; const float rs = rsv[ai][m];
                    f32x4 y[2][2]; float ss = 0.f;
#pragma unroll
                    for (int bj = 0; bj < 2; ++bj)
#pragma unroll
                        for (int n = 0; n < 2; ++n) { y[bj][n] = acc[ai][bj][m][n] * rs; const f32x4 t = y[bj][n]; ss += (t[0] * t[0] + t[1] * t[1]) + (t[2] * t[2] + t[3] * t[3]); }
                    ss += __shfl_xor(ss, 16); ss += __shfl_xor(ss, 32);
                    const float hs = __builtin_amdgcn_rsqf(ss * (1.0f / 64.0f) + RMS_EPS_F);
#pragma unroll
                    for (int bj = 0; bj < 2; ++bj) {
                        const f32x4 a = y[bj][0] * gv[bj][0] * hs, b = y[bj][1] * gv[bj][1] * hs;
                        u32x4 w; w.x = cvt_pk_bf16(a[0], a[1]); w.y = cvt_pk_bf16(a[2], a[3]); w.z = cvt_pk_bf16(b[0], b[1]); w.w = cvt_pk_bf16(b[2], b[3]);
                        *(u32x4*)(dst + (size_t)row * ld + colh + 32 * bj) = w;
                    }
                }
        } else {
            bf16_t* dst = (pn < 6) ? VB : RW; const int ld = (pn < 6) ? 512 : 1792; const int colh = 256 * ((pn < 6) ? (pn - 4) : (pn - 6)) + 64 * wc + 8 * fq;
#pragma unroll
            for (int ai = 0; ai < 2; ++ai)
#pragma unroll
                for (int m = 0; m < 4; ++m) {
                    const int row = row0 + ai * HALF + m * 16; const float rs = rsv[ai][m];
#pragma unroll
                    for (int bj = 0; bj < 2; ++bj) {
                        const f32x4 a = acc[ai][bj][m][0] * rs, b = acc[ai][bj][m][1] * rs;
                        u32x4 w; w.x = cvt_pk_bf16(a[0], a[1]); w.y = cvt_pk_bf16(a[2], a[3]); w.z = cvt_pk_bf16(b[0], b[1]); w.w = cvt_pk_bf16(b[2], b[3]);
                        *(u32x4*)(dst + (size_t)row * ld + colh + 32 * bj) = w;
                    }
                }
        }
    }
};

template <class Epi, class Sched, bool ALIGN_EPI = false, bool SP2 = false>
__device__ __forceinline__ void gemm_phase(PG8_LAS unsigned char* lds, const Gemm g, const Sched& S, const Epi& E) {
    const int tid = threadIdx.x, wid = __builtin_amdgcn_readfirstlane(tid >> 6), lane = tid & 63, wr = wid >> 2, wc = wid & 3, fr = lane & 15, fq = lane >> 4;
    const int K = g.K, nt = K / BK, LDP = g.ld ? g.ld : g.K, LDA = g.ablk ? BK : LDP;
    unsigned voffA[2], voffB[2];
#pragma unroll
    for (int i = 0; i < 2; ++i) { int R, C; stage_rc(tid * 16 + i * 8192, R, C); const int Rb = Epi::PERM ? ((R & ~31) + perm32(R & 31)) : R;
        voffA[i] = (unsigned)(R * LDA + C) * 2u; voffB[i] = (unsigned)(Rb * LDP + C) * 2u; }
    const size_t kstep = (size_t)(BK * 2);
    const size_t hstep = (size_t)HALF * LDP * 2;
    const size_t tstep = 2 * hstep;
    const size_t kstepA = g.ablk ? (size_t)BM * BK * 2 : kstep, hstepA = (size_t)HALF * LDA * 2, tstepA = g.ablk ? (size_t)BM * K * 2 : tstep;
    const unsigned ldsw = (unsigned)wid * 1024u;
    const int aoff = lds_byte(wr * 64 + fr, fq * 8), boff = lds_byte(wc * 32 + fr, fq * 8);
#define PG8_SA(b, h) (((b) * 2 + (h)) * HTB)
#define PG8_SB(b, h) ((4 + (b) * 2 + (h)) * HTB)
#define PG8_STAGE(bufoff, gbase, voff) do { _Pragma("unroll") for (int _i = 0; _i < 2; ++_i) \
        __builtin_amdgcn_global_load_lds((const unsigned*)((const char*)(gbase) + (voff)[_i]), (PG8_LAS unsigned*)(lds + (bufoff) + ldsw + _i * 8192), 16, 0, 0); } while (0)
#define PG8_LDA(dst, b, h) do { _Pragma("unroll") for (int m = 0; m < 4; ++m) _Pragma("unroll") for (int k = 0; k < 2; ++k) dst[m][k] = *(const PG8_LAS bf16x8*)(lds + PG8_SA(b, h) + aoff + m * 2048 + k * 1024); } while (0)
#define PG8_LDB(dst, b, h) do { _Pragma("unroll") for (int n = 0; n < 2; ++n) _Pragma("unroll") for (int k = 0; k < 2; ++k) dst[n][k] = *(const PG8_LAS bf16x8*)(lds + PG8_SB(b, h) + boff + n * 2048 + k * 1024); } while (0)
#define PG8_MMA(ai, bj, At, Bt) do { __builtin_amdgcn_s_setprio(1); _Pragma("unroll") for (int m = 0; m < 4; ++m) _Pragma("unroll") for (int n = 0; n < 2; ++n) _Pragma("unroll") for (int k = 0; k < 2; ++k) \
        acc[ai][bj][m][n] = __builtin_amdgcn_mfma_f32_16x16x32_bf16(Bt[n][k], At[m][k], acc[ai][bj][m][n], 0, 0, 0); __builtin_amdgcn_s_setprio(0); } while (0)
#define PG8_WAIT_V(n) asm volatile("s_waitcnt vmcnt(" #n ")" ::: "memory")
#define PG8_WAIT_L(n) asm volatile("s_waitcnt lgkmcnt(" #n ")" ::: "memory")
#define PG8_BAR __builtin_amdgcn_s_barrier()
#define PG8_SCHED __builtin_amdgcn_sched_barrier(0)
    Unit cur, nxt; int ui = 0;
    if (!S.next(0, cur)) return;
    f32x4 acc[2][2][4][2];
#pragma unroll
    for (int a = 0; a < 2; ++a)
#pragma unroll
        for (int b = 0; b < 2; ++b)
#pragma unroll
            for (int m = 0; m < 4; ++m)
#pragma unroll
                for (int n = 0; n < 2; ++n) acc[a][b][m][n] = (f32x4){0.f, 0.f, 0.f, 0.f};
    bf16x8 At[4][2], B0[2][2], B1[2][2];
    const char* cA = (const char*)g.A + (size_t)cur.pm * tstepA; const char* cB = (const char*)g.Bt + (size_t)cur.pn * tstep;
    S.a_ready(cur);
    if constexpr (SP2) {
        PG8_STAGE(PG8_SB(0, 0), cB, voffB); PG8_STAGE(PG8_SB(0, 1), cB + hstep, voffB); PG8_STAGE(PG8_SA(0, 0), cA, voffA); PG8_STAGE(PG8_SA(0, 1), cA + hstepA, voffA);
        if (wr == 1) PG8_BAR;
        PG8_WAIT_V(2); PG8_BAR;
        PG8_STAGE(PG8_SB(1, 0), cB + kstep, voffB); PG8_STAGE(PG8_SA(1, 0), cA + kstepA, voffA); PG8_STAGE(PG8_SB(1, 1), cB + hstep + kstep, voffB);
        PG8_WAIT_V(6); PG8_BAR;
    } else {
        PG8_STAGE(PG8_SB(0, 0), cB, voffB); PG8_STAGE(PG8_SA(0, 0), cA, voffA); PG8_STAGE(PG8_SB(0, 1), cB + hstep, voffB); PG8_STAGE(PG8_SA(0, 1), cA + hstepA, voffA);
        if (wr == 1) PG8_BAR;
        PG8_WAIT_V(4); PG8_BAR;
        PG8_STAGE(PG8_SB(1, 0), cB + kstep, voffB); PG8_STAGE(PG8_SA(1, 0), cA + kstepA, voffA); PG8_STAGE(PG8_SB(1, 1), cB + hstep + kstep, voffB);
        PG8_WAIT_V(6); PG8_BAR;
    }
    for (;;) {
        const bool has_next = S.next(ui + 1, nxt);
        const char* nA = has_next ? (const char*)g.A + (size_t)nxt.pm * tstepA : cA; const char* nB = has_next ? (const char*)g.Bt + (size_t)nxt.pn * tstep : cB;
        for (int t = 0; t < nt; t += 2) {
            const bool last = (t == nt - 2);
            const char* a1 = cA + (size_t)(t + 1) * kstepA;
            const char* a2 = last ? nA : cA + (size_t)(t + 2) * kstepA; const char* b2 = last ? nB : cB + (size_t)(t + 2) * kstep;
            const char* a3 = a2 + kstepA; const char* b3 = b2 + kstep;
            if (last && has_next) S.a_ready(nxt);
            if constexpr (SP2) {
            PG8_LDB(B0, 0, 0); PG8_LDB(B1, 0, 1); PG8_SCHED; PG8_LDA(At, 0, 0); PG8_STAGE(PG8_SA(1, 1), a1 + hstepA, voffA);
            PG8_WAIT_V(8); PG8_WAIT_L(0); PG8_BAR; PG8_MMA(0, 0, At, B0); PG8_MMA(0, 1, At, B1); PG8_BAR; PG8_SCHED;
            PG8_LDA(At, 0, 1); PG8_STAGE(PG8_SB(0, 0), b2, voffB); PG8_STAGE(PG8_SB(0, 1), b2 + hstep, voffB); PG8_STAGE(PG8_SA(0, 0), a2, voffA);
            PG8_WAIT_V(8); PG8_WAIT_L(0); PG8_BAR; PG8_MMA(1, 0, At, B0); PG8_MMA(1, 1, At, B1); PG8_BAR; PG8_SCHED;
            PG8_LDB(B0, 1, 0); PG8_LDB(B1, 1, 1); PG8_SCHED; PG8_LDA(At, 1, 0); PG8_STAGE(PG8_SA(0, 1), a2 + hstepA, voffA);
            PG8_WAIT_V(8); PG8_WAIT_L(0); PG8_BAR; PG8_MMA(0, 0, At, B0); PG8_MMA(0, 1, At, B1); PG8_BAR; PG8_SCHED;
            PG8_LDA(At, 1, 1); PG8_STAGE(PG8_SB(1, 0), b3, voffB); PG8_STAGE(PG8_SB(1, 1), b3 + hstep, voffB); PG8_STAGE(PG8_SA(1, 0), a3, voffA);
            PG8_WAIT_V(8); PG8_WAIT_L(0); PG8_BAR; PG8_MMA(1, 0, At, B0); PG8_MMA(1, 1, At, B1); PG8_BAR; PG8_SCHED;
            } else {
            PG8_LDB(B0, 0, 0); PG8_SCHED; PG8_LDA(At, 0, 0); PG8_STAGE(PG8_SA(1, 1), a1 + hstepA, voffA);
            PG8_WAIT_L(8); PG8_BAR; PG8_WAIT_L(0); PG8_MMA(0, 0, At, B0); PG8_BAR; PG8_SCHED;
            PG8_LDB(B1, 0, 1); PG8_STAGE(PG8_SB(0, 0), b2, voffB);
            PG8_BAR; PG8_WAIT_L(0); PG8_MMA(0, 1, At, B1); PG8_BAR;
            PG8_LDA(At, 0, 1); PG8_STAGE(PG8_SA(0, 0), a2, voffA);
            PG8_BAR; PG8_WAIT_L(0); PG8_MMA(1, 0, At, B0); PG8_BAR; PG8_SCHED;
            PG8_STAGE(PG8_SB(0, 1), b2 + hstep, voffB);
            PG8_WAIT_V(6); PG8_BAR; PG8_MMA(1, 1, At, B1); PG8_BAR;
            PG8_LDB(B0, 1, 0); PG8_SCHED; PG8_LDA(At, 1, 0); PG8_STAGE(PG8_SA(0, 1), a2 + hstepA, voffA);
            PG8_WAIT_L(8); PG8_BAR; PG8_WAIT_L(0); PG8_MMA(0, 0, At, B0); PG8_BAR; PG8_SCHED;
            PG8_LDB(B1, 1, 1); PG8_STAGE(PG8_SB(1, 0), b3, voffB);
            PG8_BAR; PG8_WAIT_L(0); PG8_MMA(0, 1, At, B1); PG8_BAR;
            PG8_LDA(At, 1, 1); PG8_STAGE(PG8_SA(1, 0), a3, voffA);
            PG8_BAR; PG8_WAIT_L(0); PG8_MMA(1, 0, At, B0); PG8_BAR; PG8_SCHED;
            PG8_STAGE(PG8_SB(1, 1), b3 + hstep, voffB);
            PG8_WAIT_V(6); PG8_BAR; PG8_MMA(1, 1, At, B1); PG8_BAR;
            }
        }
        if constexpr (ALIGN_EPI) { if (wr == 0) PG8_BAR; }
        if constexpr (!Epi::AFTER_DRAIN) { E(acc, cur, wr, wc, fr, fq); S.done(cur); }
        if (!has_next) break;
#pragma unroll
        for (int a = 0; a < 2; ++a)
#pragma unroll
            for (int b = 0; b < 2; ++b)
#pragma unroll
                for (int m = 0; m < 4; ++m)
#pragma unroll
                    for (int n = 0; n < 2; ++n) acc[a][b][m][n] = (f32x4){0.f, 0.f, 0.f, 0.f};
        cur = nxt; cA = nA; cB = nB; ++ui;
        if constexpr (ALIGN_EPI) { if (wr == 1) PG8_BAR; }
    }
    PG8_WAIT_V(0);
    if constexpr (!ALIGN_EPI) { if (wr == 0) PG8_BAR; }
    PG8_BAR;
    if constexpr (Epi::AFTER_DRAIN) { E.fused(acc, cur, wr, wc, fr, fq, lds, wid, lane); S.done(cur); }
#undef PG8_SA
#undef PG8_SB
#undef PG8_STAGE
#undef PG8_LDA
#undef PG8_LDB
#undef PG8_MMA
#undef PG8_WAIT_V
#undef PG8_WAIT_L
#undef PG8_BAR
#undef PG8_SCHED
}
}
#define GAS __attribute__((address_space(1)))
#define LAS __attribute__((address_space(3)))
typedef unsigned short bf16;
typedef unsigned v4u __attribute__((ext_vector_type(4)));
typedef float f32x4 __attribute__((ext_vector_type(4)));
typedef short bf16x8 __attribute__((ext_vector_type(8)));
typedef GAS unsigned gu32;
typedef GAS unsigned long long gu64;
#define RLX_AGENT __ATOMIC_RELAXED, __HIP_MEMORY_SCOPE_AGENT
#define LDS_WAIT() asm volatile("s_waitcnt lgkmcnt(0)" ::: "memory")
#define VM_WAIT() asm volatile("s_waitcnt vmcnt(0)" ::: "memory")
__device__ __forceinline__ unsigned long long rt() { return __builtin_amdgcn_s_memrealtime(); }
__device__ __forceinline__ unsigned f2bf(float f) { unsigned u = __builtin_bit_cast(unsigned, f); return (u + 0x7fffu + ((u >> 16) & 1u)) >> 16; }
__device__ __forceinline__ unsigned pk2(float lo, float hi) { return f2bf(lo) | (f2bf(hi) << 16); }

#define XB_TMO      128
#define XB_XCNT(j)  (256  + 64 * (j))
#define XB_XSUB(j)  (1280 + 64 * (j))
#define XB_XGEN(j)  (2304 + 64 * (j))
#define XB_TOP      3328
#define XB_TOPGEN   3392
#define XCD_BAR_WORDS 3456
#define XB_SPIN_CAP (1u << 18)

__device__ __forceinline__ unsigned xb_ld(unsigned* p)              { return __hip_atomic_load(p, __ATOMIC_RELAXED, __HIP_MEMORY_SCOPE_AGENT); }
__device__ __forceinline__ unsigned xb_add(unsigned* p, unsigned v) { return __hip_atomic_fetch_add(p, v, __ATOMIC_RELAXED, __HIP_MEMORY_SCOPE_AGENT); }
__device__ __forceinline__ unsigned xb_xcc_id() { return (unsigned)__builtin_amdgcn_s_getreg((3 << 11) | 20) & 0xFu; }
#define XB_SPIN(cond, bar) do { unsigned _sp = 0; while (cond) { __builtin_amdgcn_s_sleep(1); \
    if ((++_sp & 255u) == 0u) { if (xb_ld(&(bar)[XB_TMO])) break; if (_sp > XB_SPIN_CAP) { atomicAdd(&(bar)[XB_TMO], 1u); break; } } } } while (0)

struct XcdBarrier {
    unsigned* bar; unsigned x;
    volatile LAS unsigned* st;
};

__device__ __forceinline__ XcdBarrier xcd_barrier_post(unsigned* bar, volatile LAS unsigned* st) {
    XcdBarrier b; b.bar = bar; b.x = xb_xcc_id(); b.st = st;
    if (threadIdx.x == 0) (void)xb_add(&bar[XB_XCNT(b.x)], 1u);
    return b;
}
__device__ __forceinline__ void xcd_barrier_complete(unsigned* bar, unsigned x, unsigned& nloc, unsigned& nx) {
    const unsigned G = gridDim.x * gridDim.y * gridDim.z;
    unsigned sum, cnt, mine, sp = 0u;
    for (;;) {
        sum = 0u; cnt = 0u; mine = 0u;
#pragma unroll
        for (unsigned j = 0; j < 16; ++j) { const unsigned c = xb_ld(&bar[XB_XCNT(j)]); sum += c; cnt += (c > 0u) ? 1u : 0u; mine = (j == x) ? c : mine; }
        if (sum == G) break;
        __builtin_amdgcn_s_sleep(1);
        if ((++sp & 255u) == 0u) { if (xb_ld(&bar[XB_TMO])) break; if (sp > XB_SPIN_CAP) { atomicAdd(&bar[XB_TMO], 1u); break; } }
    }
    nloc = mine > 0u ? mine : 1u; nx = cnt > 0u ? cnt : 1u;
}

__device__ __forceinline__ void xcd_barrier(const XcdBarrier& b) {
    asm volatile("s_waitcnt vmcnt(0)" ::: "memory");
    __syncthreads();
    if (threadIdx.x == 0) {
        unsigned* bar = b.bar;
        __builtin_amdgcn_s_waitcnt(0);
        unsigned nloc = b.st[0], nx = b.st[1];
        if (nloc == 0u) { xcd_barrier_complete(bar, b.x, nloc, nx); b.st[0] = nloc; b.st[1] = nx; }
        const unsigned old = xb_add(&bar[XB_XSUB(b.x)], 1u);
        const unsigned gen = old / nloc;
        if (old + 1u == (gen + 1u) * nloc) {
            __builtin_amdgcn_fence(__ATOMIC_RELEASE, "agent");
            asm volatile("s_waitcnt vmcnt(0)" ::: "memory");
            const unsigned og = xb_add(&bar[XB_TOP], 1u);
            const unsigned tg = og / nx;
            if (og + 1u == (tg + 1u) * nx) xb_add(&bar[XB_TOPGEN], 1u);
            else XB_SPIN(xb_ld(&bar[XB_TOPGEN]) == tg, bar);
            __builtin_amdgcn_fence(__ATOMIC_ACQUIRE, "agent");
            xb_add(&bar[XB_XGEN(b.x)], 1u);
            asm volatile("s_waitcnt vmcnt(0)" ::: "memory");
        } else {
            XB_SPIN(xb_ld(&bar[XB_XGEN(b.x)]) == gen, bar);
            __builtin_amdgcn_fence(__ATOMIC_ACQUIRE, "agent");
            asm volatile("s_waitcnt vmcnt(0)" ::: "memory");
        }
    }
    __syncthreads();
}

constexpr int NWAVES = 8;
#ifndef MK_N_LAUNCHES
#define MK_N_LAUNCHES 1
#endif
constexpr int PER_PHASE = 11;
constexpr int N_LAUNCHES = MK_N_LAUNCHES;

constexpr int BATCH = 16, SEQ = 2048, D = 1024, HD = 64, NH = 8, FF = 2816;
constexpr int M = BATCH * SEQ;
constexpr int SBW = 512, RWW = 512, RWP = 1792, PW = 3328, LORA_K = 256, LORA_N = 1536;
constexpr float LNX_EPS = 64e-5f;

constexpr size_t MiB = 1u << 20;
constexpr size_t WS_CTL = 0, CTL_ZERO_BYTES = 128 * 1024;
constexpr size_t WS_SSQ = 1 * MiB;
constexpr size_t WS_W1U = 4 * MiB;
constexpr size_t WS_W1D = 15 * MiB;
constexpr size_t WS_W2U = 21 * MiB;
constexpr size_t WS_W2D = 32 * MiB;
constexpr size_t WS_WIN = 38 * MiB;
constexpr size_t WS_WOUT = 45 * MiB;
constexpr size_t WS_WLORA = 47 * MiB;
constexpr size_t WS_XB = 48 * MiB;
constexpr size_t WS_ACT = 112 * MiB;
constexpr size_t WS_QO = 112 * MiB;
constexpr size_t WS_KB = 176 * MiB;
constexpr size_t WS_VB = 208 * MiB;
constexpr size_t WS_RW = 240 * MiB;
constexpr size_t WS_ALORA = 352 * MiB;
constexpr size_t WS_LW = 368 * MiB;
constexpr size_t WS_AB = 432 * MiB;
constexpr size_t WS_GB = 464 * MiB;
constexpr size_t WS_TAIL = 496 * MiB;
constexpr size_t WS_END = 512 * MiB;
constexpr int CW_TMO = 0, CW_CODE = 1;
constexpr int CW_BAR = 4096;
constexpr int CW_QUEUE = 16384;

constexpr int RING_OFF = 0, RING_BYTES = 155648;
constexpr int LDSCTL_OFF = RING_BYTES, MISC_OFF = LDSCTL_OFF;
constexpr int LDS_BYTES = 163840;

struct Frame {
    LAS unsigned char* lds;
    volatile LAS unsigned* MISC;
    gu32* ctl;
    int tid, lane, wave;
    int vcu, G;
};
typedef unsigned u32x2g __attribute__((ext_vector_type(2)));
__device__ __forceinline__ float bf2f(unsigned short h) { return __uint_as_float(((unsigned)h) << 16); }
typedef float f32x2h __attribute__((ext_vector_type(2))); typedef __bf16 bf16x2h __attribute__((ext_vector_type(2)));
__device__ __forceinline__ unsigned pkbf(float lo, float hi) { f32x2h v = {lo, hi}; bf16x2h b = __builtin_convertvector(v, bf16x2h); return __builtin_bit_cast(unsigned, b); }
__device__ __forceinline__ float bflo(unsigned w) { return __uint_as_float(w << 16); }
__device__ __forceinline__ float bfhi(unsigned w) { return __uint_as_float(w & 0xffff0000u); }
__device__ __forceinline__ float wave_sum(float v) {
#pragma unroll
    for (int o = 1; o < 64; o <<= 1) v += __shfl_xor(v, o);
    return v;
}
#define DPP_ADD(v, ctrl) ((v) + __int_as_float(__builtin_amdgcn_update_dpp(0, __float_as_int(v), (ctrl), 0xF, 0xF, true)))
__device__ __forceinline__ float sum8(float v) { v = DPP_ADD(v, 0xB1); v = DPP_ADD(v, 0x4E); v = DPP_ADD(v, 0x141); return v; }

struct TItem { const float* W; int ldw, k0, n0; const float* sc; bf16* WT; int Kd, rho0; };
__device__ __forceinline__ void ti_load(const TItem& T, float (&t)[32], int lane) {
#pragma unroll
    for (int i = 0; i < 32; ++i) t[i] = T.W[(size_t)(T.k0 + 2 * i + (lane >> 5)) * T.ldw + T.n0 + (lane & 31)];
}
__device__ __forceinline__ void ti_finish(const TItem& T, const float (&t)[32], LAS float* scr, int lane) {
#pragma unroll
    for (int i = 0; i < 32; ++i) scr[(2 * i + (lane >> 5)) * 33 + (lane & 31)] = t[i];
    LDS_WAIT(); asm volatile("" ::: "memory");
    const int c = lane & 7;
    f32x4 s0 = (f32x4){1.f, 1.f, 1.f, 1.f}, s1 = s0;
    if (T.sc) { s0 = *(const f32x4*)(T.sc + T.k0 + 8 * c); s1 = *(const f32x4*)(T.sc + T.k0 + 8 * c + 4); }
#pragma unroll
    for (int j = 0; j < 4; ++j) { const int n = (lane >> 3) + 8 * j; const LAS float* s = scr + (8 * c) * 33 + n;
        v4u o; o.x = pkbf(s[0 * 33] * s0.x, s[1 * 33] * s0.y); o.y = pkbf(s[2 * 33] * s0.z, s[3 * 33] * s0.w); o.z = pkbf(s[4 * 33] * s1.x, s[5 * 33] * s1.y); o.w = pkbf(s[6 * 33] * s1.z, s[7 * 33] * s1.w);
        *(GAS v4u*)(T.WT + (size_t)(T.rho0 + n) * T.Kd + T.k0 + 8 * c) = o; }
    LDS_WAIT(); asm volatile("" ::: "memory");
}
#define P0_PTRS const float* Ax, const float* An1, const float* Ag1, const float* Au1, const float* Ad1, const float* Anm, const float* Awin, const float* Aw2, const float* Aa2, const float* Ag2, const float* Awout, \
    const float* An2, const float* Ag2f, const float* Au2f, const float* Ad2f, bf16* AW1U, bf16* AW1D, bf16* AW2U, bf16* AW2D, bf16* AWIN, bf16* AWOUT, bf16* AWLORA, bf16* AXB, float* ASSQ
__device__ __forceinline__ void p0_items(Frame& F, P0_PTRS, int set, int gw, int NGW) {
    LAS float* scr = (LAS float*)(F.lds + RING_OFF + F.wave * 16384);
    constexpr int I_UP = 16 * 176, I_DN = 44 * 32, I_IN = 16 * 104, I_OUT = 16 * 32;
    const int NITEMS = set ? (I_UP + I_DN) : (I_UP + I_DN + I_IN + I_OUT);
#define P0_DECODE(it_, T) do { int r = (it_); const int l2 = set; \
        if (r < I_UP) { const int kb = r / 176, nb = r % 176, rho0 = 32 * nb, pn = rho0 >> 8, bj = (rho0 >> 7) & 1, j0 = rho0 & 127; \
            T = TItem{l2 ? (bj ? Au2f : Ag2f) : (bj ? Au1 : Ag1), FF, 64 * kb, 128 * pn + j0, l2 ? An2 : An1, l2 ? AW2U : AW1U, D, rho0}; } \
        else if ((r -= I_UP) < I_DN) { const int kb = r / 32, nb = r % 32; \
            T = TItem{l2 ? Ad2f : Ad1, D, 64 * kb, 32 * nb, nullptr, l2 ? AW2D : AW1D, FF, 32 * nb}; } \
        else if ((r -= I_DN) < I_IN) { const int kb = r / 104, nb = r % 104, rho0 = 32 * nb, pn = rho0 >> 8, rem = rho0 & 255, bj = rem >> 7, wc = (rem & 127) >> 5; \
            T = TItem{Awin, PW, 64 * kb, 256 * pn + 64 * wc + 32 * bj, Anm, AWIN, D, rho0}; } \
        else { r -= I_IN; const int kb = r / 32, nb = r % 32; T = TItem{Awout, D, 64 * kb, 32 * nb, nullptr, AWOUT, D, 32 * nb}; } } while (0)
    for (int it = gw; it < NITEMS; it += 2 * NGW) {
        TItem T0, T1; float t0[32], t1[32]; const bool two = (it + NGW < NITEMS);
        P0_DECODE(it, T0); ti_load(T0, t0, F.lane);
        if (two) { P0_DECODE(it + NGW, T1); ti_load(T1, t1, F.lane); }
        ti_finish(T0, t0, scr, F.lane);
        if (two) ti_finish(T1, t1, scr, F.lane);
    }
#undef P0_DECODE
}
__device__ __forceinline__ void p0_prologue(Frame& F, P0_PTRS) {
    const int gw = F.vcu * NWAVES + F.wave, NGW = F.G * NWAVES;
    p0_items(F, Ax, An1, Ag1, Au1, Ad1, Anm, Awin, Aw2, Aa2, Ag2, Awout, An2, Ag2f, Au2f, Ad2f, AW1U, AW1D, AW2U, AW2D, AWIN, AWOUT, AWLORA, AXB, ASSQ, (F.G >= 256) ? 0 : 0, gw, NGW);
    if (F.G < 256) p0_items(F, Ax, An1, Ag1, Au1, Ad1, Anm, Awin, Aw2, Aa2, Ag2, Awout, An2, Ag2f, Au2f, Ad2f, AW1U, AW1D, AW2U, AW2D, AWIN, AWOUT, AWLORA, AXB, ASSQ, 1, gw, NGW);
    for (int it = F.vcu * (NWAVES * 64) + F.tid; it < 512 * 32; it += F.G * NWAVES * 64) {
        int ch, kc, Kk; const float* src; bf16* dst;
        if (it < 512 * 8) { ch = it >> 3; kc = (it & 7) * 8; Kk = 64; src = Aw2; dst = AWLORA; }
        else if (it < 512 * 16) { const int i2 = it - 512 * 8; ch = i2 >> 3; kc = (i2 & 7) * 8; Kk = 64; src = Aa2; dst = AWLORA + 512 * 64; }
        else { const int i2 = it - 512 * 16; ch = i2 >> 4; kc = (i2 & 15) * 8; Kk = 128; src = Ag2; dst = AWLORA + 2 * 512 * 64; }
        float v[8];
#pragma unroll
        for (int j = 0; j < 8; ++j) v[j] = src[(size_t)(kc + j) * 512 + ch];
        v4u o; o.x = pkbf(v[0], v[1]); o.y = pkbf(v[2], v[3]); o.z = pkbf(v[4], v[5]); o.w = pkbf(v[6], v[7]);
        *(GAS v4u*)(dst + (size_t)ch * Kk + kc) = o;
    }
    for (int mb = gw; mb < M; mb += 4 * NGW) {
        f32x4 v[4][4]; float s[4];
#pragma unroll
        for (int q = 0; q < 4; ++q) { const int m = mb + q * NGW; const GAS f32x4* xr = (const GAS f32x4*)(Ax + (size_t)(m < M ? m : mb) * D) + F.lane;
#pragma unroll
            for (int j = 0; j < 4; ++j) v[q][j] = xr[64 * j]; }
#pragma unroll
        for (int q = 0; q < 4; ++q) { float a = 0.f;
#pragma unroll
            for (int j = 0; j < 4; ++j) a += (v[q][j].x * v[q][j].x + v[q][j].y * v[q][j].y) + (v[q][j].z * v[q][j].z + v[q][j].w * v[q][j].w);
            s[q] = a; }
#pragma unroll
        for (int o = 1; o < 64; o <<= 1) {
#pragma unroll
            for (int q = 0; q < 4; ++q) s[q] += __shfl_xor(s[q], o); }
#pragma unroll
        for (int q = 0; q < 4; ++q) { const int m = mb + q * NGW; if (m < M) {
            GAS unsigned long long* o8 = (GAS unsigned long long*)(AXB + (size_t)m * D) + F.lane;
#pragma unroll
            for (int j = 0; j < 4; ++j) o8[64 * j] = (unsigned long long)pkbf(v[q][j].x, v[q][j].y) | ((unsigned long long)pkbf(v[q][j].z, v[q][j].w) << 32);
            if (F.lane < 16) ASSQ[(size_t)m * 16 + F.lane] = (F.lane == 0) ? s[q] : 0.f; } }
    }
}

struct RwArgs { const bf16* RW; const bf16* W2T; const bf16* A2T; const bf16* G2T; const float* w0; const float* a0; bf16* QO; const float *mu, *k_k, *k_a, *r_k, *ln_w, *ln_b; };
__device__ __forceinline__ void ld8bf(const bf16* p, float (&o)[8]) { const v4u w = *(const v4u*)p; o[0] = bflo(w.x); o[1] = bfhi(w.x); o[2] = bflo(w.y); o[3] = bfhi(w.y); o[4] = bflo(w.z); o[5] = bfhi(w.z); o[6] = bflo(w.w); o[7] = bfhi(w.w); }
__device__ __forceinline__ void ld8f(const float* p, float (&o)[8]) { const f32x4 a = *(const f32x4*)p, b = *(const f32x4*)(p + 4); o[0] = a.x; o[1] = a.y; o[2] = a.z; o[3] = a.w; o[4] = b.x; o[5] = b.y; o[6] = b.z; o[7] = b.w; }
__device__ __forceinline__ void ld8l(const LAS float* p, float (&o)[8]) { const f32x4 a = *(const LAS f32x4*)p, b = *(const LAS f32x4*)(p + 4); o[0] = a.x; o[1] = a.y; o[2] = a.z; o[3] = a.w; o[4] = b.x; o[5] = b.y; o[6] = b.z; o[7] = b.w; }
__device__ __forceinline__ void st8l(LAS float* p, const float (&o)[8]) { *(LAS f32x4*)p = (f32x4){o[0], o[1], o[2], o[3]}; *(LAS f32x4*)(p + 4) = (f32x4){o[4], o[5], o[6], o[7]}; }
namespace rwk {
typedef short bf16x8 __attribute__((ext_vector_type(8)));
typedef short s16x4 __attribute__((ext_vector_type(4)));
typedef short v4i16_t __attribute__((ext_vector_type(4)));
constexpr int SLOT = 8192;
#define RSL(s) (lds + (s) * SLOT)
#define RMFMA(a, b, c) __builtin_amdgcn_mfma_f32_16x16x32_bf16((a), (b), (c), 0, 0, 0)
__device__ __forceinline__ int swz(int row, int cb) { return row * 128 + (cb ^ ((row & 7) << 4)); }
struct Fr2 { bf16x8 k0, k1; };
__device__ __forceinline__ Fr2 ldf(const LAS unsigned char* base, int off) { Fr2 f; f.k0 = *(const LAS bf16x8*)(base + off); f.k1 = *(const LAS bf16x8*)(base + (off ^ 64)); return f; }
__device__ __forceinline__ s16x4 trd(const LAS unsigned char* p) { return __builtin_bit_cast(s16x4, __builtin_amdgcn_ds_read_tr16_b64_v4i16((LAS v4i16_t*)p)); }
__device__ __forceinline__ Fr2 ldt(const LAS unsigned char* base, int o0, int o1) {
    const s16x4 a = trd(base + o0), b = trd(base + o1), c = trd(base + o0 + 4096), d = trd(base + o1 + 4096);
    Fr2 f; f.k0 = (bf16x8){a[0], a[1], a[2], a[3], b[0], b[1], b[2], b[3]}; f.k1 = (bf16x8){c[0], c[1], c[2], c[3], d[0], d[1], d[2], d[3]}; return f; }
template <bool SWAP> __device__ __forceinline__ f32x4 mm(const Fr2& a, const Fr2& b, f32x4 c) {
    if (SWAP) { c = RMFMA(b.k0, a.k0, c); c = RMFMA(b.k1, a.k1, c); } else { c = RMFMA(a.k0, b.k0, c); c = RMFMA(a.k1, b.k1, c); } return c; }
__device__ __forceinline__ void st4(LAS unsigned char* slot, int off, f32x4 v) { u32x2g w; w.x = pkbf(v[0], v[1]); w.y = pkbf(v[2], v[3]); *(LAS u32x2g*)(slot + off) = w; }
__device__ __forceinline__ f32x4 M16(s16x4 a, s16x4 b, f32x4 c) { return __builtin_amdgcn_mfma_f32_16x16x16bf16_1k(a, b, c, 0, 0, 0); }
__device__ __forceinline__ s16x4 cv4(f32x4 v) { const u32x2g w = (u32x2g){pkbf(v[0], v[1]), pkbf(v[2], v[3])}; return __builtin_bit_cast(s16x4, w); }
__device__ __forceinline__ float bf1(short s) { return __uint_as_float(((unsigned)(unsigned short)s) << 16); }
__device__ __forceinline__ f32x4 ld4(const LAS unsigned char* slot, int off) { const u32x2g w = *(const LAS u32x2g*)(slot + off); return (f32x4){bflo(w.x), bfhi(w.x), bflo(w.y), bfhi(w.y)}; }
#define LBAR() asm volatile("s_waitcnt lgkmcnt(0)\n\ts_barrier" ::: "memory")
#define DPPF(x, ctrl, rmask) __int_as_float(__builtin_amdgcn_update_dpp(0, __float_as_int(x), (ctrl), (rmask), 0xF, true))
__device__ __forceinline__ float wave_scan(float x) {
    x += DPPF(x, 0x111, 0xF); x += DPPF(x, 0x112, 0xF); x += DPPF(x, 0x114, 0xF); x += DPPF(x, 0x118, 0xF);
    x += DPPF(x, 0x142, 0xA);
    x += DPPF(x, 0x143, 0xC);
    return x; }
__device__ __forceinline__ void unp8(const v4u w, float (&o)[8]) { o[0] = bflo(w.x); o[1] = bfhi(w.x); o[2] = bflo(w.y); o[3] = bfhi(w.y); o[4] = bflo(w.z); o[5] = bfhi(w.z); o[6] = bflo(w.w); o[7] = bfhi(w.w); }
__device__ __forceinline__ v4u pk8(const float (&o)[8]) { return (v4u){pkbf(o[0], o[1]), pkbf(o[2], o[3]), pkbf(o[4], o[5]), pkbf(o[6], o[7])}; }
}
struct RwX { bf16* P1; bf16* GT; bf16* Y0; bf16* H; bf16* VB0; bf16* VB1; float* GE; bf16* G; };
__device__ __forceinline__ void p6a_rwkv_local(Frame& F, const RwArgs& A, const RwX& X) {
    using namespace rwk;
    LAS unsigned char* lds = F.lds + RING_OFF;
    LAS float* part = (LAS float*)(F.lds + LDSCTL_OFF + 128);
    LAS float* cst = (LAS float*)(F.lds + LDSCTL_OFF + 128 + 4096 + 896);
    const int lane = F.lane, fr = lane & 15, fq = lane >> 4, w = F.wave, m0 = 16 * (w >> 1), n0a = 32 * (w & 1);
    const int fm = swz(m0 + fr, fq * 16);
    const int ta0 = swz(8 * fq + (fr >> 2), 2 * (m0 + 4 * (fr & 3))), ta1 = swz(8 * fq + 4 + (fr >> 2), 2 * (m0 + 4 * (fr & 3)));
    int fn[2], orm[2], otr[2], tb0[2], tb1[2];
#pragma unroll
    for (int t = 0; t < 2; ++t) { const int n0 = n0a + 16 * t; fn[t] = swz(n0 + fr, fq * 16); orm[t] = swz(m0 + fr, 2 * (n0 + 4 * fq)); otr[t] = swz(n0 + fr, 2 * (m0 + 4 * fq));
        tb0[t] = swz(8 * fq + (fr >> 2), 2 * (n0 + 4 * (fr & 3))); tb1[t] = swz(8 * fq + 4 + (fr >> 2), 2 * (n0 + 4 * (fr & 3))); }
    const int NJ = BATCH * NH * (SEQ / 64);
    const int tid = F.tid, ltok = tid >> 3, ldg = tid & 7;
    v4u g_r, g_k, g_v, g_xw, g_xa, g_xg0, g_xg1, g_pr;
#define P6A_LOAD(jj) do { const int u_ = (jj) >> 5, c_ = (jj) & 31; const size_t gr_ = (size_t)(u_ >> 3) * SEQ + c_ * 64 + ltok; const int cb_ = 64 * (u_ & 7) + 8 * ldg; const bf16* rp_ = A.RW + gr_ * RWP; \
        g_r = *(const v4u*)(rp_ + cb_); g_k = *(const v4u*)(rp_ + 512 + cb_); g_v = *(const v4u*)(rp_ + 1024 + cb_); \
        g_xw = *(const v4u*)(rp_ + 1536 + 8 * ldg); g_xa = *(const v4u*)(rp_ + 1600 + 8 * ldg); g_xg0 = *(const v4u*)(rp_ + 1664 + 8 * ldg); g_xg1 = *(const v4u*)(rp_ + 1728 + 8 * ldg); \
        g_pr = (v4u){0u, 0u, 0u, 0u}; if (ltok < 7 && c_ > 0) g_pr = *(const v4u*)(A.RW + ((size_t)(u_ >> 3) * SEQ + c_ * 64 - 1) * RWP + (ltok < 3 ? 512 * ltok + cb_ : 1536 + 64 * (ltok - 3) + 8 * ldg)); } while (0)
    if ((int)blockIdx.x < NJ) P6A_LOAD((int)blockIdx.x);
    int hcur = -1;
    LAS unsigned char* prow = (LAS unsigned char*)(F.lds + LDSCTL_OFF + 128 + 4096);
    if (tid < 256) cst[512 + tid] = A.mu[1536 + tid];
    u32x2g s_p1[2], s_gt[2], s_y0[2], s_hh[2]; size_t s_jo = 0; bool s_have = false;
#define P6A_STORE() do { _Pragma("unroll") for (int t = 0; t < 2; ++t) { \
            *(u32x2g*)(X.P1 + s_jo + ((w * 2 + t) * 64 + lane) * 4) = s_p1[t]; *(u32x2g*)(X.GT + s_jo + ((w * 2 + t) * 64 + lane) * 4) = s_gt[t]; \
            *(u32x2g*)(X.Y0 + s_jo + ((w * 2 + t) * 64 + lane) * 4) = s_y0[t]; *(u32x2g*)(X.H + s_jo + ((w * 2 + t) * 64 + lane) * 4) = s_hh[t]; } } while (0)
    for (int job = blockIdx.x; job < NJ; job += F.G) {
        const int unit = job >> 5, c = job & 31; const int h = unit & 7; const int cb = 64 * h + 8 * w; const size_t jo = (size_t)job * 4096;
        {
            const int so = swz(ltok, 16 * ldg);
            *(LAS v4u*)(RSL(12) + so) = g_r; *(LAS v4u*)(RSL(2) + so) = g_k; *(LAS v4u*)(RSL(0) + so) = g_v;
            *(LAS v4u*)(RSL(14) + so) = g_xw; *(LAS v4u*)(RSL(13) + so) = g_xa; *(LAS v4u*)(RSL(7) + so) = g_xg0; *(LAS v4u*)(RSL(18) + so) = g_xg1;
            if (ltok < 7) *(LAS v4u*)(prow + ltok * 128 + 16 * ldg) = g_pr;
            if (h != hcur) {
                *(LAS v4u*)(RSL(16) + so) = *(const v4u*)(A.W2T + (size_t)(64 * h + ltok) * 64 + 8 * ldg); *(LAS v4u*)(RSL(17) + so) = *(const v4u*)(A.A2T + (size_t)(64 * h + ltok) * 64 + 8 * ldg);
                *(LAS v4u*)(RSL(10) + so) = *(const v4u*)(A.G2T + (size_t)(64 * h + ltok) * 128 + 8 * ldg); *(LAS v4u*)(RSL(11) + so) = *(const v4u*)(A.G2T + (size_t)(64 * h + ltok) * 128 + 64 + 8 * ldg);
                { const int a_ = tid >> 6, i_ = tid & 63;
                  const float* src_ = (a_ == 0) ? A.mu : (a_ == 1) ? A.mu + 512 : (a_ == 2) ? A.mu + 1024 : (a_ == 3) ? A.k_k : (a_ == 4) ? A.k_a : (a_ == 5) ? A.r_k : (a_ == 6) ? A.w0 : A.a0;
                  cst[a_ * 64 + i_] = src_[64 * h + i_]; } }
            hcur = h;
        }
        if (s_have) P6A_STORE();
        { const int nj = job + F.G; if (nj < NJ) P6A_LOAD(nj); }
        LBAR();
        float r[8], k[8], v[8];
        {
            const int so = swz(lane, 16 * w), sp = swz((lane + 63) & 63, 16 * w);
#define P6A_SHIFT(slot, pi, moff, dst) do { float c_[8], p_[8], m_[8]; v4u wc_ = *(const LAS v4u*)(RSL(slot) + so), wp_ = *(const LAS v4u*)(RSL(slot) + sp); \
                if (lane == 0) wp_ = *(const LAS v4u*)(prow + 128 * (pi) + 16 * w); \
                unp8(wc_, c_); unp8(wp_, p_); ld8l(cst + (moff) + 8 * w, m_); \
                _Pragma("unroll") for (int j = 0; j < 8; ++j) dst[j] = c_[j] + (p_[j] - c_[j]) * m_[j]; } while (0)
            P6A_SHIFT(12, 0, 0, r);
            P6A_SHIFT(2, 1, 64, k);
            P6A_SHIFT(0, 2, 128, v); asm volatile("" ::: "memory");
            { float x_[8]; P6A_SHIFT(14, 3, 512, x_);
#pragma unroll
              for (int j = 0; j < 8; ++j) x_[j] = 2.0f * pg8::sigmoid_f(2.0f * x_[j]) - 1.0f;
              *(LAS v4u*)(RSL(14) + so) = pk8(x_); }
            { float x_[8]; P6A_SHIFT(13, 4, 576, x_); *(LAS v4u*)(RSL(13) + so) = pk8(x_); } asm volatile("" ::: "memory");
            { float x_[8]; P6A_SHIFT(7, 5, 640, x_);
#pragma unroll
              for (int j = 0; j < 8; ++j) x_[j] = pg8::sigmoid_f(x_[j]);
              *(LAS v4u*)(RSL(7) + so) = pk8(x_); }
            { float x_[8]; P6A_SHIFT(18, 6, 704, x_);
#pragma unroll
              for (int j = 0; j < 8; ++j) x_[j] = pg8::sigmoid_f(x_[j]);
              *(LAS v4u*)(RSL(18) + so) = pk8(x_); }
#undef P6A_SHIFT
        }
        LBAR();
        {
            const f32x4 z4 = (f32x4){0.f, 0.f, 0.f, 0.f};
            {   const Fr2 aW = ldf(RSL(14), fm), aA = ldf(RSL(13), fm); Fr2 bW[2], bA[2];
#pragma unroll
                for (int t = 0; t < 2; ++t) { bW[t] = ldf(RSL(16), fn[t]); bA[t] = ldf(RSL(17), fn[t]); }
#pragma unroll
                for (int t = 0; t < 2; ++t) { const int row = m0 + fr, ch = n0a + 16 * t + 4 * fq; const f32x4 lwq = mm<true>(aW, bW[t], z4), alq = mm<true>(aA, bA[t], z4);
                    const f32x4 w0c = *(const LAS f32x4*)(cst + 384 + ch), a0c = *(const LAS f32x4*)(cst + 448 + ch); f32x4 lwv, alv;
#pragma unroll
                    for (int x = 0; x < 4; ++x) { lwv[x] = -0.6065306597126334f * pg8::sigmoid_f(w0c[x] + lwq[x]); alv[x] = pg8::sigmoid_f(a0c[x] + alq[x]); }
                    const int fo = row * 256 + (((ch >> 3) ^ (row & 7)) << 5) + ((ch >> 2) & 1) * 16;
                    *(LAS f32x4*)(RSL(4) + fo) = lwv; *(LAS f32x4*)(RSL(8) + fo) = alv; } }
            asm volatile("" ::: "memory");
            {   const Fr2 aG0 = ldf(RSL(7), fm), aG1 = ldf(RSL(18), fm); Fr2 bG0[2], bG1[2];
#pragma unroll
                for (int t = 0; t < 2; ++t) { bG0[t] = ldf(RSL(10), fn[t]); bG1[t] = ldf(RSL(11), fn[t]); }
#pragma unroll
                for (int t = 0; t < 2; ++t) st4(RSL(3), orm[t], mm<true>(aG1, bG1[t], mm<true>(aG0, bG0[t], z4))); }
        }
        LBAR();
        float kf[8], kk[8], al[8], lw[8]; float ssp = 0.f, bpp = 0.f;
        {
            { const int fo = lane * 256 + ((w ^ (lane & 7)) << 5); const f32x4 a_ = *(const LAS f32x4*)(RSL(4) + fo), b_ = *(const LAS f32x4*)(RSL(4) + fo + 16), c_ = *(const LAS f32x4*)(RSL(8) + fo), d_ = *(const LAS f32x4*)(RSL(8) + fo + 16);
              lw[0] = a_.x; lw[1] = a_.y; lw[2] = a_.z; lw[3] = a_.w; lw[4] = b_.x; lw[5] = b_.y; lw[6] = b_.z; lw[7] = b_.w;
              al[0] = c_.x; al[1] = c_.y; al[2] = c_.z; al[3] = c_.w; al[4] = d_.x; al[5] = d_.y; al[6] = d_.z; al[7] = d_.w; }
            *(v4u*)(X.G + jo + tid * 8) = *(const LAS v4u*)(RSL(3) + swz(ltok, 16 * ldg));
            float kkc[8], kac[8], rkc[8]; ld8l(cst + 192 + 8 * w, kkc); ld8l(cst + 256 + 8 * w, kac); ld8l(cst + 320 + 8 * w, rkc);
#pragma unroll
            for (int j = 0; j < 8; ++j) { kk[j] = k[j] * kkc[j]; ssp += kk[j] * kk[j]; kf[j] = k[j] * (1.0f + (al[j] - 1.0f) * kac[j]); bpp += r[j] * kf[j] * rkc[j]; }
            part[w * 64 + lane] = ssp; part[512 + w * 64 + lane] = bpp;
        }
        LBAR();
        {
            float ss = 0.f, bon = 0.f;
#pragma unroll
            for (int i = 0; i < 8; ++i) { ss += part[i * 64 + lane]; bon += part[512 + i * 64 + lane]; }
            const float inv = 1.0f / fmaxf(sqrtf(ss), 1e-12f);
            float at[8], rt[8], bt[8], kt[8], bh[8], kh[8], ge[8], vb[8];
#pragma unroll
            for (int j = 0; j < 8; ++j) {
                const float cs = wave_scan(lw[j]);
                const float ce = __int_as_float(__builtin_amdgcn_readlane(__float_as_int(cs), 63));
                const float e_cs = __builtin_amdgcn_exp2f(cs * 1.4426950408889634f), e_csm = __builtin_amdgcn_exp2f((cs - lw[j]) * 1.4426950408889634f);
                const float e_neg = __builtin_amdgcn_rcpf(e_cs), e_end = __builtin_amdgcn_exp2f((ce - cs) * 1.4426950408889634f);
                const float kn = kk[j] * inv, bb = kn * al[j];
                at[j] = -kn * e_csm; rt[j] = r[j] * e_cs; bt[j] = bb * e_neg; kt[j] = kf[j] * e_neg; bh[j] = bb * e_end; kh[j] = kf[j] * e_end; ge[j] = e_cs; vb[j] = bon * v[j];
            }
            const int ro = swz(lane, 16 * w);
            *(LAS v4u*)(RSL(0) + ro) = pk8(at); *(LAS v4u*)(RSL(1) + ro) = pk8(rt); *(LAS v4u*)(RSL(2) + ro) = pk8(bt); *(LAS v4u*)(RSL(3) + ro) = pk8(kt);
            *(LAS v4u*)(RSL(4) + ro) = pk8(bh); *(LAS v4u*)(RSL(5) + ro) = pk8(kh); *(LAS v4u*)(RSL(6) + ro) = pk8(v);
            if (lane == 63) { *(f32x4*)(X.GE + (size_t)job * 64 + 8 * w) = (f32x4){ge[0], ge[1], ge[2], ge[3]}; *(f32x4*)(X.GE + (size_t)job * 64 + 8 * w + 4) = (f32x4){ge[4], ge[5], ge[6], ge[7]}; }
            *(LAS v4u*)(RSL(18) + ro) = pk8(vb);
        }
        LBAR();
        {
            { bf16* vbp = (job < 2048) ? (X.VB0 + jo) : (X.VB1 + (jo - (size_t)2048 * 4096)); *(v4u*)(vbp + tid * 8) = *(const LAS v4u*)(RSL(18) + swz(ltok, 16 * ldg)); }
            const f32x4 z4 = (f32x4){0.f, 0.f, 0.f, 0.f};
            const Fr2 aA = ldf(RSL(0), fm), aR = ldf(RSL(1), fm); Fr2 bB[2], bK[2];
#pragma unroll
            for (int t = 0; t < 2; ++t) { bB[t] = ldf(RSL(2), fn[t]); bK[t] = ldf(RSL(3), fn[t]); }
            f32x4 nab[2], nabT[2], nak[2], mrb[2], mrk[2];
#pragma unroll
            for (int t = 0; t < 2; ++t) { nab[t] = mm<true>(aA, bB[t], z4); nabT[t] = mm<false>(aA, bB[t], z4); nak[t] = mm<true>(aA, bK[t], z4); mrb[t] = mm<true>(aR, bB[t], z4); mrk[t] = mm<true>(aR, bK[t], z4); }
#pragma unroll
            for (int t = 0; t < 2; ++t) { const int n0 = n0a + 16 * t;
#pragma unroll
                for (int x = 0; x < 4; ++x) { const int i = m0 + fr, j = n0 + 4 * fq + x;
                    if (j >= i) { nab[t][x] = 0.f; nak[t][x] = 0.f; } if (j > i) { mrb[t][x] = 0.f; mrk[t][x] = 0.f; }
                    const int it = m0 + 4 * fq + x, jt = n0 + fr; if (jt >= it) nabT[t][x] = 0.f; }
                st4(RSL(12), orm[t], nab[t]);
                st4(RSL(7), orm[t], nak[t]); st4(RSL(8), orm[t], mrb[t]); st4(RSL(9), orm[t], mrk[t]); }
            const int dsel = (w == 2 || w == 7) ? 1 : 0;
            if (w == 0 || w == 2 || w == 5 || w == 7) {
                const f32x4 dPT = dsel ? nab[1] : nab[0], dP = dsel ? nabT[1] : nabT[0];
                f32x4 XT;
#pragma unroll
                for (int x = 0; x < 4; ++x) XT[x] = dPT[x] + ((4 * fq + x == fr) ? 1.0f : 0.f);
                const s16x4 bP = cv4(dP), bPT = cv4(dPT);
                const f32x4 P2 = M16(bPT, bP, z4), P2T = M16(bP, bPT, z4);
                const s16x4 bP2 = cv4(P2), bP2T = cv4(P2T);
                XT = M16(bP2, cv4(XT), XT);
                const f32x4 P4 = M16(bP2T, bP2, z4), P4T = M16(bP2, bP2T, z4);
                const s16x4 bP4 = cv4(P4), bP4T = cv4(P4T);
                XT = M16(bP4, cv4(XT), XT);
                const f32x4 P8 = M16(bP4T, bP4, z4);
                XT = M16(cv4(P8), cv4(XT), XT);
                *(LAS s16x4*)(RSL(13) + (m0 >> 4) * 512 + fr * 32 + fq * 8) = cv4(XT);
            }
        }
        LBAR();
        {
            const f32x4 z4 = (f32x4){0.f, 0.f, 0.f, 0.f};
            const int cs = 16 * (w & 3);
            s16x4 tA[4], nA[6];
#pragma unroll
            for (int i = 0; i < 4; ++i) tA[i] = *(const LAS s16x4*)(RSL(13) + i * 512 + fr * 32 + fq * 8);
            {   int q = 0;
#pragma unroll
                for (int i = 1; i < 4; ++i)
#pragma unroll
                    for (int j = 0; j < i; ++j) nA[q++] = *(const LAS s16x4*)(RSL(12) + swz(16 * i + fr, 2 * (16 * j + 4 * fq))); }
            f32x4 acc[4];
            if (w < 4) {
#pragma unroll
                for (int i = 0; i < 4; ++i) { const s16x4 r = trd(RSL(0) + swz(16 * i + 4 * fq + (fr >> 2), 2 * (cs + 4 * (fr & 3))));
                    acc[i] = (f32x4){bf1(r[0]), bf1(r[1]), bf1(r[2]), bf1(r[3])}; }
            } else {
                s16x4 vB[4], kA[10];
#pragma unroll
                for (int j = 0; j < 4; ++j) vB[j] = trd(RSL(6) + swz(16 * j + 4 * fq + (fr >> 2), 2 * (cs + 4 * (fr & 3))));
                {   int q = 0;
#pragma unroll
                    for (int i = 0; i < 4; ++i)
#pragma unroll
                        for (int j = 0; j <= i; ++j) kA[q++] = *(const LAS s16x4*)(RSL(7) + swz(16 * i + fr, 2 * (16 * j + 4 * fq))); }
                {   int q = 0;
#pragma unroll
                    for (int i = 0; i < 4; ++i) { acc[i] = z4;
#pragma unroll
                        for (int j = 0; j <= i; ++j) acc[i] = M16(kA[q++], vB[j], acc[i]); } }
            }
            s16x4 yB[4];
            {   int q = 0;
#pragma unroll
                for (int i = 0; i < 4; ++i) {
#pragma unroll
                    for (int j = 0; j < i; ++j) acc[i] = M16(nA[q++], yB[j], acc[i]);
                    const f32x4 y = M16(tA[i], cv4(acc[i]), z4); yB[i] = cv4(y);
                    *(LAS s16x4*)(RSL(w < 4 ? 3 : 15) + swz(cs + fr, 2 * (16 * i + 4 * fq))) = yB[i]; } }
        }
        LBAR();
        {
            const f32x4 z4 = (f32x4){0.f, 0.f, 0.f, 0.f};
            f32x4 p1[2], y0[2], gt[2], hh[2];
            {   const Fr2 aMb = ldf(RSL(8), fm), aMk = ldf(RSL(9), fm); Fr2 bW[2], bU[2], bV[2]; f32x4 cR[2];
#pragma unroll
                for (int t = 0; t < 2; ++t) { bW[t] = ldf(RSL(3), fn[t]); bU[t] = ldf(RSL(15), fn[t]); bV[t] = ldt(RSL(6), tb0[t], tb1[t]); cR[t] = ld4(RSL(1), orm[t]); }
#pragma unroll
                for (int t = 0; t < 2; ++t) { p1[t] = mm<true>(aMb, bW[t], cR[t]); y0[t] = mm<true>(aMk, bV[t], mm<true>(aMb, bU[t], z4)); } }
            {   const Fr2 aW = ldf(RSL(3), fm), aU = ldf(RSL(15), fm), aV = ldt(RSL(6), ta0, ta1); Fr2 bBh[2], bKh[2];
#pragma unroll
                for (int t = 0; t < 2; ++t) { bBh[t] = ldt(RSL(4), tb0[t], tb1[t]); bKh[t] = ldt(RSL(5), tb0[t], tb1[t]); }
#pragma unroll
                for (int t = 0; t < 2; ++t) { gt[t] = mm<false>(aW, bBh[t], z4); hh[t] = mm<true>(aV, bKh[t], mm<true>(aU, bBh[t], z4)); } }
#pragma unroll
            for (int t = 0; t < 2; ++t) {
                s_p1[t].x = pkbf(p1[t][0], p1[t][1]); s_p1[t].y = pkbf(p1[t][2], p1[t][3]); s_gt[t].x = pkbf(gt[t][0], gt[t][1]); s_gt[t].y = pkbf(gt[t][2], gt[t][3]);
                s_y0[t].x = pkbf(y0[t][0], y0[t][1]); s_y0[t].y = pkbf(y0[t][2], y0[t][3]); s_hh[t].x = pkbf(hh[t][0], hh[t][1]); s_hh[t].y = pkbf(hh[t][2], hh[t][3]); }
            s_jo = jo; s_have = true;
        }
    }
    if (s_have) P6A_STORE();
#undef P6A_LOAD
#undef P6A_STORE
    LBAR();
}
__device__ __forceinline__ void p6b_rwkv_seq(Frame& F, const RwArgs& A, const RwX& X, int nwg) {
    using namespace rwk;
    LAS unsigned char* lds = F.lds + RING_OFF;
    constexpr int YLD = 68;
    LAS float* Yf0 = (LAS float*)RSL(6);
    const int tid = F.tid, tok = tid >> 3, dg = tid & 7, lane = F.lane, fr = lane & 15, fq = lane >> 4;
    const int w = F.wave, m0 = 16 * (w >> 1), n0a = 32 * (w & 1);
    const int fm = swz(m0 + fr, fq * 16);
    int fn[2], orm[2], otr[2];
#pragma unroll
    for (int t = 0; t < 2; ++t) { const int n0 = n0a + 16 * t; fn[t] = swz(n0 + fr, fq * 16); orm[t] = swz(m0 + fr, 2 * (n0 + 4 * fq)); otr[t] = swz(n0 + fr, 2 * (m0 + 4 * fq)); }
    for (int unit = blockIdx.x; unit < BATCH * NH; unit += nwg) {
        const int b = unit >> 3, h = unit & 7; const int cb = 64 * h + 8 * dg;
        f32x4 sacc[2]; sacc[0] = (f32x4){0.f, 0.f, 0.f, 0.f}; sacc[1] = sacc[0];
        for (int u = tid; u < SLOT / 4; u += NWAVES * 64) ((LAS unsigned*)RSL(4))[u] = 0u;
        float lnw[8], lnb[8]; ld8f(A.ln_w + cb, lnw); ld8f(A.ln_b + cb, lnb);
        struct Nx { v4u vb, g; u32x2g p1[2], gt[2], y0[2], h[2]; f32x4 ge[2]; };
        Nx nA, nB;
#define P6B_LOAD(cc, N) do { const int job_ = unit * 32 + (cc); const size_t jo_ = (size_t)job_ * 4096; const size_t grow_ = (size_t)b * SEQ + (cc) * 64 + tok; \
            _Pragma("unroll") for (int t = 0; t < 2; ++t) { N.y0[t] = *(const u32x2g*)(X.Y0 + jo_ + ((w * 2 + t) * 64 + lane) * 4); N.h[t] = *(const u32x2g*)(X.H + jo_ + ((w * 2 + t) * 64 + lane) * 4); \
                N.p1[t] = *(const u32x2g*)(X.P1 + jo_ + ((w * 2 + t) * 64 + lane) * 4); N.gt[t] = *(const u32x2g*)(X.GT + jo_ + ((w * 2 + t) * 64 + lane) * 4); \
                N.ge[t] = *(const f32x4*)(X.GE + (size_t)job_ * 64 + n0a + 16 * t + 4 * fq); } \
            const bf16* vbp_ = (job_ < 2048) ? (X.VB0 + jo_) : (X.VB1 + (jo_ - (size_t)2048 * 4096)); \
            N.vb = *(const v4u*)(vbp_ + tok * 64 + 8 * dg); N.g = *(const v4u*)(X.G + jo_ + tok * 64 + 8 * dg); } while (0)
#define P6B_OUT(par, vbw_, gw_, grow_) do { float y[8]; ld8l(Yf0 + (par) * (64 * YLD) + tok * YLD + 8 * dg, y); \
            const float g[8] = {bflo(gw_.x), bfhi(gw_.x), bflo(gw_.y), bfhi(gw_.y), bflo(gw_.z), bfhi(gw_.z), bflo(gw_.w), bfhi(gw_.w)}; \
            const float vb[8] = {bflo(vbw_.x), bfhi(vbw_.x), bflo(vbw_.y), bfhi(vbw_.y), bflo(vbw_.z), bfhi(vbw_.z), bflo(vbw_.w), bfhi(vbw_.w)}; \
            float s_ = 0.f; _Pragma("unroll") for (int j = 0; j < 8; ++j) s_ += y[j]; \
            const float mean = sum8(s_) * (1.0f / 64.0f); float q_ = 0.f; \
            _Pragma("unroll") for (int j = 0; j < 8; ++j) { y[j] -= mean; q_ += y[j] * y[j]; } \
            const float rstd = __builtin_amdgcn_rsqf(sum8(q_) * (1.0f / 64.0f) + LNX_EPS); float ov[8]; \
            _Pragma("unroll") for (int j = 0; j < 8; ++j) ov[j] = (y[j] * rstd * lnw[j] + lnb[j] + vb[j]) * g[j]; \
            v4u wv_; wv_.x = pkbf(ov[0], ov[1]); wv_.y = pkbf(ov[2], ov[3]); wv_.z = pkbf(ov[4], ov[5]); wv_.w = pkbf(ov[6], ov[7]); \
            *(GAS v4u*)(A.QO + (grow_) * D + 512 + cb) = wv_; } while (0)
        v4u p_vb = (v4u){0u, 0u, 0u, 0u}, p_g = p_vb; size_t p_row = 0;
#define P6B_STEP(c, N) do { const int par = (c) & 1, scur = 4 + par, snxt = 5 - par; const size_t grow = (size_t)b * SEQ + (c) * 64 + tok; \
            _Pragma("unroll") for (int t = 0; t < 2; ++t) { *(LAS u32x2g*)(RSL(par) + orm[t]) = N.p1[t]; *(LAS u32x2g*)(RSL(2 + par) + otr[t]) = N.gt[t]; } \
            f32x4 yacc[2], hcur[2], gecur[2]; \
            _Pragma("unroll") for (int t = 0; t < 2; ++t) { yacc[t] = (f32x4){bflo(N.y0[t].x), bfhi(N.y0[t].x), bflo(N.y0[t].y), bfhi(N.y0[t].y)}; hcur[t] = (f32x4){bflo(N.h[t].x), bfhi(N.h[t].x), bflo(N.h[t].y), bfhi(N.h[t].y)}; gecur[t] = N.ge[t]; } \
            const v4u vbw = N.vb, gw = N.g; \
            if ((c) + 2 < SEQ / 64) P6B_LOAD((c) + 2, N); \
            LBAR(); \
            {   const Fr2 aP1 = ldf(RSL(par), fm), aS = ldf(RSL(scur), fm); Fr2 bS[2], bG[2]; \
                _Pragma("unroll") for (int t = 0; t < 2; ++t) { bS[t] = ldf(RSL(scur), fn[t]); bG[t] = ldf(RSL(2 + par), fn[t]); } \
                _Pragma("unroll") for (int t = 0; t < 2; ++t) { yacc[t] = mm<true>(aP1, bS[t], yacc[t]); sacc[t] = mm<true>(aS, bG[t], sacc[t] * gecur[t] + hcur[t]); } \
                _Pragma("unroll") for (int t = 0; t < 2; ++t) { const int n0 = n0a + 16 * t; *(LAS f32x4*)(Yf0 + par * (64 * YLD) + (m0 + fr) * YLD + n0 + 4 * fq) = yacc[t]; st4(RSL(snxt), orm[t], sacc[t]); } } \
            if ((c) > 0) P6B_OUT(par ^ 1, p_vb, p_g, p_row);                    \
            p_vb = vbw; p_g = gw; p_row = grow; } while (0)
        P6B_LOAD(0, nA); P6B_LOAD(1, nB);
        for (int c = 0; c < SEQ / 64; c += 2) {
            P6B_STEP(c, nA);
            P6B_STEP(c + 1, nB);
        }
#undef P6B_STEP
        LBAR();
        P6B_OUT(1, p_vb, p_g, p_row);
#undef P6B_LOAD
#undef P6B_OUT
        LBAR();
    }
}

namespace sba {
using bf16x8 = __attribute__((ext_vector_type(8))) short;
using s16x4 = __attribute__((ext_vector_type(4))) short;
using f32x16 = __attribute__((ext_vector_type(16))) float;
using u32x4 = __attribute__((ext_vector_type(4))) unsigned;
constexpr int QB = 256, KVBLK = 64;
constexpr int LDS_K = 0, LDS_V = 16384, LDS_ST = 32768, ST_LD = 68, LDS_FLAG = LDS_ST + 8 * 32 * ST_LD * 4, LDS_BYTES_ATT = LDS_FLAG + 64;
constexpr float R_DEAD = -160.0f;
#define SBAR() __builtin_amdgcn_sched_barrier(0)
typedef float f32x2_t __attribute__((ext_vector_type(2))); typedef __bf16 bf16x2_t __attribute__((ext_vector_type(2)));
__device__ __forceinline__ unsigned cvtpk_s(float lo, float hi) { f32x2_t v = {lo, hi}; bf16x2_t b = __builtin_convertvector(v, bf16x2_t); return __builtin_bit_cast(unsigned, b); }
__device__ __forceinline__ void qkt(f32x16& p0, f32x16& p1, const char* Kslot, const bf16x8* qr, int r32, int hi) {
    const char* kb = Kslot + hi * 1024 + r32 * 16;
    const f32x16 z = f32x16{};
#pragma unroll
    for (int d0 = 0; d0 < 4; ++d0) {
        const bf16x8 b0 = *reinterpret_cast<const bf16x8*>(kb + d0 * 2048);
        const bf16x8 b1 = *reinterpret_cast<const bf16x8*>(kb + d0 * 2048 + 512);
        if (d0 == 0) { p0 = __builtin_amdgcn_mfma_f32_32x32x16_bf16(b0, qr[0], z, 0, 0, 0); p1 = __builtin_amdgcn_mfma_f32_32x32x16_bf16(b1, qr[0], z, 0, 0, 0); }
        else { p0 = __builtin_amdgcn_mfma_f32_32x32x16_bf16(b0, qr[d0], p0, 0, 0, 0); p1 = __builtin_amdgcn_mfma_f32_32x32x16_bf16(b1, qr[d0], p1, 0, 0, 0); }
    }
}
__device__ __forceinline__ void pv(f32x16* o, int vb, bf16x8 pa0, bf16x8 pa1, bf16x8 pa2, bf16x8 pa3) {
#pragma unroll
    for (int d0 = 0; d0 < 2; ++d0) { s16x4 lo[4], hi[4];
#pragma unroll
        for (int ks = 0; ks < 4; ++ks) {
            asm volatile("ds_read_b64_tr_b16 %0,%1 offset:%c2" : "=&v"(lo[ks]) : "v"(vb), "i"(d0 * 4096 + ks * 1024) : "memory");
            asm volatile("ds_read_b64_tr_b16 %0,%1 offset:%c2" : "=&v"(hi[ks]) : "v"(vb), "i"(d0 * 4096 + ks * 1024 + 512) : "memory"); }
        asm volatile("s_waitcnt lgkmcnt(0)" ::: "memory"); SBAR();
#define PK(k) (bf16x8){lo[k][0], lo[k][1], lo[k][2], lo[k][3], hi[k][0], hi[k][1], hi[k][2], hi[k][3]}
        o[d0] = __builtin_amdgcn_mfma_f32_32x32x16_bf16(pa0, PK(0), o[d0], 0, 0, 0);
        o[d0] = __builtin_amdgcn_mfma_f32_32x32x16_bf16(pa1, PK(1), o[d0], 0, 0, 0);
        o[d0] = __builtin_amdgcn_mfma_f32_32x32x16_bf16(pa2, PK(2), o[d0], 0, 0, 0);
        o[d0] = __builtin_amdgcn_mfma_f32_32x32x16_bf16(pa3, PK(3), o[d0], 0, 0, 0);
#undef PK
    }
}
__device__ __forceinline__ float swap_sum(float x, float& other_if_lo, int hi) {
    auto rr = __builtin_amdgcn_permlane32_swap(__float_as_uint(x), __float_as_uint(x), false, false);
    const float a = __uint_as_float(rr[0]), b = __uint_as_float(rr[1]);
    other_if_lo = hi ? 0.f : b;
    return a + b;
}
__device__ __forceinline__ float swap_prod(float x, float& other_if_lo, int hi) {
    auto rr = __builtin_amdgcn_permlane32_swap(__float_as_uint(x), __float_as_uint(x), false, false);
    const float a = __uint_as_float(rr[0]), b = __uint_as_float(rr[1]);
    other_if_lo = hi ? 1.0f : b;
    return a * b;
}
__device__ __forceinline__ void attn_wave_unit(int b, int h, int qblk, bf16* QO, const bf16* __restrict__ KB, const bf16* __restrict__ VB, const float* gout, char* wsm  ) {
    const int lane = threadIdx.x & 63, r32 = lane & 31, hi = lane >> 5;
    const long rowbase = (long)b * SEQ; const int q0 = qblk * 32;
    bf16* Qw = QO + (rowbase + q0) * D + h * HD;
    const bf16* Kh = KB + rowbase * SBW + h * HD; const bf16* Vh = VB + rowbase * SBW + h * HD;
    const unsigned lds0 = (unsigned)(uintptr_t)wsm;
    const int jtop = (q0 + 30) >> 6;
    const bf16* vsrc = Vh + (long)(lane >> 3) * SBW + (lane & 7) * 8;
    const int vdst0 = ((lane & 7) >> 2) * 4096 + ((lane >> 3) & 15) * 64 + (lane & 3) * 16;
    const int vb0 = (int)lds0 + ((lane >> 4) & 1) * 32 + (lane & 3) * 8 + (4 * hi + ((lane & 15) >> 2)) * 64;
    const bf16* ksrc = Kh + (long)r32 * SBW + hi * 8;
    bf16x8 qr[4];
#pragma unroll
    for (int d0 = 0; d0 < 4; ++d0) qr[d0] = *reinterpret_cast<const bf16x8*>(&Qw[(long)r32 * D + d0 * 16 + hi * 8]);
    bf16x8 kf[8]; u32x4 vr[8];
#define SBA_LOAD(t) do { const bf16* kp_ = ksrc + (long)(t) * KVBLK * SBW; const bf16* vp_ = vsrc + (long)(t) * KVBLK * SBW; \
        _Pragma("unroll") for (int d0 = 0; d0 < 4; ++d0) { kf[2 * d0] = *reinterpret_cast<const bf16x8*>(kp_ + d0 * 16); kf[2 * d0 + 1] = *reinterpret_cast<const bf16x8*>(kp_ + 32 * SBW + d0 * 16); } \
        _Pragma("unroll") for (int i = 0; i < 8; ++i) vr[i] = *(const u32x4*)(vp_ + (long)(8 * i) * SBW); } while (0)
    SBA_LOAD(jtop);
    float R = 0.f; f32x16 o[2]; o[0] = f32x16{}; o[1] = f32x16{};
    const int qrow = q0 + r32;
    for (int jt = jtop; jt >= 0; --jt) {
        const int cur = (jtop - jt) & 1;
#pragma unroll
        for (int i = 0; i < 8; ++i) *(u32x4*)(wsm + cur * 8192 + vdst0 + (i >> 1) * 1024 + (i & 1) * 512) = vr[i];
        f32x16 p0, p1;
        {   const f32x16 z = f32x16{};
            p0 = __builtin_amdgcn_mfma_f32_32x32x16_bf16(kf[0], qr[0], z, 0, 0, 0); p1 = __builtin_amdgcn_mfma_f32_32x32x16_bf16(kf[1], qr[0], z, 0, 0, 0);
#pragma unroll
            for (int d0 = 1; d0 < 4; ++d0) { p0 = __builtin_amdgcn_mfma_f32_32x32x16_bf16(kf[2 * d0], qr[d0], p0, 0, 0, 0); p1 = __builtin_amdgcn_mfma_f32_32x32x16_bf16(kf[2 * d0 + 1], qr[d0], p1, 0, 0, 0); } }
        if (jt > 0) SBA_LOAD(jt - 1);
        const int kb = 64 * jt + 4 * hi; const bool diag = (jt == jtop);
#pragma unroll
        for (int r = 0; r < 16; ++r) {
            { float rr = __builtin_amdgcn_rcpf(1.0f + __builtin_amdgcn_exp2f(p0[r]));
              if (diag) { const int key = kb + (r & 3) + 8 * (r >> 2); if (key >= qrow) rr = 1.0f; }
              p0[r] = rr; }
            { float rr = __builtin_amdgcn_rcpf(1.0f + __builtin_amdgcn_exp2f(p1[r]));
              if (diag) { const int key = kb + 32 + (r & 3) + 8 * (r >> 2); if (key >= qrow) rr = 1.0f; }
              p1[r] = rr; }
        }
        float c0[4], c1[4], x0[4], x1[4];
#pragma unroll
        for (int g = 0; g < 4; ++g) {
            const float s0 = (p0[4 * g] * p0[4 * g + 1]) * (p0[4 * g + 2] * p0[4 * g + 3]);
            const float s1 = (p1[4 * g] * p1[4 * g + 1]) * (p1[4 * g + 2] * p1[4 * g + 3]);
            c0[g] = swap_prod(s0, x0[g], hi); c1[g] = swap_prod(s1, x1[g], hi);
        }
        const float Cr = __builtin_amdgcn_exp2f(R);
        float suf0[4], suf1[4];
        suf1[3] = Cr; suf1[2] = suf1[3] * c1[3]; suf1[1] = suf1[2] * c1[2]; suf1[0] = suf1[1] * c1[1];
        suf0[3] = suf1[0] * c1[0]; suf0[2] = suf0[3] * c0[3]; suf0[1] = suf0[2] * c0[2]; suf0[0] = suf0[1] * c0[1];
        R += __builtin_amdgcn_logf(((c0[0] * c0[1]) * (c0[2] * c0[3])) * ((c1[0] * c1[1]) * (c1[2] * c1[3])));
#pragma unroll
        for (int g = 0; g < 4; ++g) {
            { const float e3 = suf0[g] * x0[g], e2 = e3 * p0[4 * g + 3], e1 = e2 * p0[4 * g + 2], e0 = e1 * p0[4 * g + 1];
              p0[4 * g + 3] = (1.0f - p0[4 * g + 3]) * e3; p0[4 * g + 2] = (1.0f - p0[4 * g + 2]) * e2; p0[4 * g + 1] = (1.0f - p0[4 * g + 1]) * e1; p0[4 * g] = (1.0f - p0[4 * g]) * e0; }
            { const float e3 = suf1[g] * x1[g], e2 = e3 * p1[4 * g + 3], e1 = e2 * p1[4 * g + 2], e0 = e1 * p1[4 * g + 1];
              p1[4 * g + 3] = (1.0f - p1[4 * g + 3]) * e3; p1[4 * g + 2] = (1.0f - p1[4 * g + 2]) * e2; p1[4 * g + 1] = (1.0f - p1[4 * g + 1]) * e1; p1[4 * g] = (1.0f - p1[4 * g]) * e0; }
        }
#define PKW(P, B) cvtpk_s(P[B], P[B + 1])
        const u32x4 pw0 = (u32x4){PKW(p0, 0), PKW(p0, 2), PKW(p0, 4), PKW(p0, 6)}, pw1 = (u32x4){PKW(p0, 8), PKW(p0, 10), PKW(p0, 12), PKW(p0, 14)};
        const u32x4 pw2 = (u32x4){PKW(p1, 0), PKW(p1, 2), PKW(p1, 4), PKW(p1, 6)}, pw3 = (u32x4){PKW(p1, 8), PKW(p1, 10), PKW(p1, 12), PKW(p1, 14)};
#undef PKW
        SBAR();
        asm volatile("s_waitcnt lgkmcnt(0)" ::: "memory");
        pv(o, vb0 + cur * 8192, __builtin_bit_cast(bf16x8, pw0), __builtin_bit_cast(bf16x8, pw1), __builtin_bit_cast(bf16x8, pw2), __builtin_bit_cast(bf16x8, pw3));
        if (__all(R < R_DEAD)) break;
    }
#undef SBA_LOAD
    {
        float* stg = (float*)wsm;
        asm volatile("s_waitcnt lgkmcnt(0)" ::: "memory");
#pragma unroll
        for (int r = 0; r < 16; ++r) { const int orow = (r & 3) + 8 * (r >> 2) + 4 * hi;
#pragma unroll
            for (int d0 = 0; d0 < 2; ++d0) stg[orow * ST_LD + d0 * 32 + r32] = o[d0][r]; }
        asm volatile("s_waitcnt lgkmcnt(0)" ::: "memory");
        const int ch = lane & 7;
        const f32x4 ga = *(const f32x4*)(gout + h * HD + ch * 8), gb = *(const f32x4*)(gout + h * HD + ch * 8 + 4);
#pragma unroll
        for (int i = 0; i < 4; ++i) { const int row = i * 8 + (lane >> 3);
            const f32x4 a = *(const f32x4*)(stg + row * ST_LD + ch * 8), c = *(const f32x4*)(stg + row * ST_LD + ch * 8 + 4);
            float ss = (a.x * a.x + a.y * a.y) + (a.z * a.z + a.w * a.w) + (c.x * c.x + c.y * c.y) + (c.z * c.z + c.w * c.w);
            ss = sum8(ss);
            const float hs = __builtin_amdgcn_rsqf(ss * (1.0f / 64.0f) + 1e-6f);
            u32x4 w; w.x = cvtpk_s(a.x * hs * ga.x, a.y * hs * ga.y); w.y = cvtpk_s(a.z * hs * ga.z, a.w * hs * ga.w);
            w.z = cvtpk_s(c.x * hs * gb.x, c.y * hs * gb.y); w.w = cvtpk_s(c.z * hs * gb.z, c.w * hs * gb.w);
            *(u32x4*)(Qw + (long)row * D + ch * 8) = w; }
        asm volatile("s_waitcnt lgkmcnt(0)" ::: "memory");
    }
}
#undef SBAR
__device__ __forceinline__ void attn_phase(Frame& F, bf16* QO, const bf16* KB, const bf16* VB, const float* gout, unsigned* queue, int first_ticket, int ticket_base) {
    char* wsm = (char*)F.lds + RING_OFF + F.wave * 16384;
    const int nunits = BATCH * NH * (SEQ / 32);
    int pend = -1; int tfirst = first_ticket;
    for (;;) {
        int uu;
        if (pend >= 0) { uu = pend; pend = -1; }
        else { unsigned t;
               if (tfirst >= 0) { t = (unsigned)tfirst; tfirst = -1; }
               else { t = 0u; if (F.lane == 0) t = __hip_atomic_fetch_add(queue, 1u, __ATOMIC_RELAXED, __HIP_MEMORY_SCOPE_AGENT); t = (unsigned)__builtin_amdgcn_readfirstlane((int)t) + (unsigned)ticket_base; }
               if (2u * t >= (unsigned)nunits) break; uu = (int)(2u * t); pend = uu + 1; }
        attn_wave_unit(uu >> 9, (uu >> 6) & 7, uu & 63, QO, KB, VB, gout, wsm);
    }
    __syncthreads();
}
}

struct Args { const float* in[26]; float* out; unsigned char* ws; int ph_lo, ph_hi, li, pad; };
__global__ void __launch_bounds__(NWAVES * 64, 2) skel_fwd(Args args) {
    extern __shared__ __attribute__((aligned(16))) unsigned char lds[];
    Frame F;
    F.lds = (LAS unsigned char*)lds;
    F.MISC = (volatile LAS unsigned*)(F.lds + MISC_OFF);
    F.tid = threadIdx.x; F.lane = F.tid & 63; F.wave = __builtin_amdgcn_readfirstlane(F.tid >> 6);
    F.G = gridDim.x; { const int bx = blockIdx.x; F.vcu = (F.G % 8 == 0) ? (bx % 8) * (F.G / 8) + bx / 8 : bx; }
    unsigned char* ws = args.ws;
    F.ctl = (gu32*)(ws + WS_CTL);
    const float* x = args.in[0];
    bf16* W1U = (bf16*)(ws + WS_W1U); bf16* W1D = (bf16*)(ws + WS_W1D); bf16* W2U = (bf16*)(ws + WS_W2U); bf16* W2D = (bf16*)(ws + WS_W2D);
    bf16* WIN = (bf16*)(ws + WS_WIN); bf16* WOUT = (bf16*)(ws + WS_WOUT); bf16* WLORA = (bf16*)(ws + WS_WLORA);
    bf16* XB = (bf16*)(ws + WS_XB); bf16* ACT = (bf16*)(ws + WS_ACT); bf16* QO = (bf16*)(ws + WS_QO); bf16* KB = (bf16*)(ws + WS_KB); bf16* VB = (bf16*)(ws + WS_VB);
    bf16* RW = (bf16*)(ws + WS_RW); bf16* ALORA = (bf16*)(ws + WS_ALORA); float* LW = (float*)(ws + WS_LW); bf16* AB = (bf16*)(ws + WS_AB); bf16* GB = (bf16*)(ws + WS_GB);
    float* SSQ = (float*)(ws + WS_SSQ); float* out = args.out;
    for (int u = F.tid; u < (LDS_BYTES - LDSCTL_OFF) / 4; u += NWAVES * 64) ((LAS unsigned*)(F.lds + LDSCTL_OFF))[u] = 0u;
    __syncthreads();
    XcdBarrier bar; bar.bar = (unsigned*)(F.ctl + CW_BAR); bar.x = 0; bar.st = nullptr;
    if (N_LAUNCHES != PER_PHASE) bar = xcd_barrier_post((unsigned*)(F.ctl + CW_BAR), F.MISC + 8);
#define GRID_BAR(seam) do { if (N_LAUNCHES == PER_PHASE) { if (F.tid == 0) __hip_atomic_store(F.ctl + CW_TMO, 0xBADBA0u | (unsigned)(seam), RLX_AGENT); } else { xcd_barrier(bar); } } while (0)
    const int lo = args.ph_lo, hi = args.ph_hi;
#define IN(k) (lo <= (k) && (k) < hi)
#define BOTH(k) (IN(k) && IN((k) + 1))
    if (IN(0)) {
        p0_prologue(F, x, args.in[1], args.in[2], args.in[3], args.in[4], args.in[5], args.in[6], args.in[12], args.in[14], args.in[15], args.in[21], args.in[22], args.in[23], args.in[24], args.in[25],
                    W1U, W1D, W2U, W2D, WIN, WOUT, WLORA, XB, SSQ); if (BOTH(0)) GRID_BAR(0);
    }
    if (IN(1)) {
        pg8::Gemm g{XB, W1U, M, 2 * FF, D}; pg8::StaticOrder S; S.init(M, 2 * FF, F.G, (int)blockIdx.x);
        pg8::EpiSwiGLU E{ACT, FF, SSQ};
        pg8::gemm_phase<pg8::EpiSwiGLU, pg8::StaticOrder, true, true>(F.lds + RING_OFF, g, S, E);
        if (BOTH(1)) GRID_BAR(1);
    }
    if (IN(2)) {
        pg8::Gemm g{ACT, W1D, M, D, FF, 0, 1}; pg8::StaticOrder S; S.init(M, D, F.G, (int)blockIdx.x, 1);
        pg8::EpiResid E{XB, nullptr, XB, SSQ, 0.5f, 1};
        pg8::gemm_phase<pg8::EpiResid, pg8::StaticOrder, true, true>(F.lds + RING_OFF, g, S, E);
        if (BOTH(2)) GRID_BAR(2);
    }
    if (IN(3)) {
        pg8::Gemm g{XB, WIN, M, PW, D}; pg8::StaticOrder S; S.init(M, PW, F.G, (int)blockIdx.x);
        pg8::EpiWin E{QO, KB, VB, RW, SSQ, args.in[7], args.in[8], 0.125f * 1.4426950408889634f};
        pg8::gemm_phase<pg8::EpiWin, pg8::StaticOrder, true, true>(F.lds + RING_OFF, g, S, E);
        if (F.G >= 256) {
            const int nlo = (M / 256) * (PW / 256) - 6 * F.G;
            if ((int)blockIdx.x >= nlo) { __syncthreads();
                p0_items(F, x, args.in[1], args.in[2], args.in[3], args.in[4], args.in[5], args.in[6], args.in[12], args.in[14], args.in[15], args.in[21], args.in[22], args.in[23], args.in[24], args.in[25],
                         W1U, W1D, W2U, W2D, WIN, WOUT, WLORA, XB, SSQ, 1, ((int)blockIdx.x - nlo) * NWAVES + F.wave, (F.G - nlo) * NWAVES); }
        }
        if (BOTH(3)) GRID_BAR(3);
    }
    if (IN(6)) {
        RwArgs A{RW, WLORA, WLORA + 512 * 64, WLORA + 2 * 512 * 64, args.in[11], args.in[13], QO, args.in[10], args.in[16], args.in[17], args.in[18], args.in[19], args.in[20]};
        bf16* ob = (bf16*)out;
        RwX X{ob + (size_t)32 * 1024 * 1024, ob + (size_t)48 * 1024 * 1024, (bf16*)LW, (bf16*)LW + (size_t)16 * 1024 * 1024, AB, AB + (size_t)8 * 1024 * 1024, SSQ, GB};
        p6a_rwkv_local(F, A, X);
        GRID_BAR(16);
        const int nseq = (F.G >= 2 * BATCH * NH) ? BATCH * NH : F.G;
        if ((int)blockIdx.x < nseq) { p6b_rwkv_seq(F, A, X, nseq); __syncthreads(); }
        const int nfree = (F.G - nseq) * NWAVES;
        sba::attn_phase(F, QO, KB, VB, args.in[9], (unsigned*)(F.ctl + CW_QUEUE), ((int)blockIdx.x >= nseq) ? ((int)blockIdx.x - nseq) * NWAVES + F.wave : -1, nfree);
        if (BOTH(6)) GRID_BAR(6);
    }
    if (IN(8)) {
        pg8::Gemm g{QO, WOUT, M, D, D}; pg8::StaticOrder S; S.init(M, D, F.G, (int)blockIdx.x, 1);
        pg8::EpiResid E{XB, nullptr, XB, SSQ, 1.0f, 1};
        pg8::gemm_phase<pg8::EpiResid, pg8::StaticOrder, true, true>(F.lds + RING_OFF, g, S, E);
        if (BOTH(8)) GRID_BAR(8);
    }
    if (IN(9)) {
        pg8::Gemm g{XB, W2U, M, 2 * FF, D}; pg8::StaticOrder S; S.init(M, 2 * FF, F.G, (int)blockIdx.x);
        pg8::EpiSwiGLU E{ACT, FF, SSQ};
        pg8::gemm_phase<pg8::EpiSwiGLU, pg8::StaticOrder, true, true>(F.lds + RING_OFF, g, S, E);
        if (BOTH(9)) GRID_BAR(9);
    }
    if (IN(10)) {
        pg8::Gemm g{ACT, W2D, M, D, FF, 0, 1}; pg8::StaticOrder S; S.init(M, D, F.G, (int)blockIdx.x, 1);
        pg8::EpiResid E{XB, out, nullptr, SSQ, 0.5f, 0};
        pg8::gemm_phase<pg8::EpiResid, pg8::StaticOrder, true, true>(F.lds + RING_OFF, g, S, E);
    }
#undef IN
#undef BOTH
}

extern "C" void kernel_launch(void* const* d_in, const int* in_sizes, int n_in, void* d_out, int out_size, void* d_ws, size_t ws_size, hipStream_t stream) {
    static int grid = 0;
    if (grid == 0) {
        if (n_in != 26 || in_sizes[0] != M * D || out_size != M * D || ws_size < WS_END) { fprintf(stderr, "kernel_launch: unexpected shapes: n_in %d in0 %d out %d ws %zu (need %zu)\n", n_in, n_in > 0 ? in_sizes[0] : -1, out_size, ws_size, (size_t)WS_END); grid = -1; return; }
        int dev = 0, cus = 0, per_cu = 0;
        if (hipGetDevice(&dev) != hipSuccess || hipDeviceGetAttribute(&cus, hipDeviceAttributeMultiprocessorCount, dev) != hipSuccess) { grid = -1; return; }
        if (hipFuncSetAttribute((const void*)skel_fwd, hipFuncAttributeMaxDynamicSharedMemorySize, LDS_BYTES) != hipSuccess) { fprintf(stderr, "kernel_launch: hipFuncSetAttribute failed\n"); grid = -1; return; }
        if (hipOccupancyMaxActiveBlocksPerMultiprocessor(&per_cu, (const void*)skel_fwd, NWAVES * 64, LDS_BYTES) != hipSuccess || per_cu < 1) { fprintf(stderr, "kernel_launch: occupancy query reports %d blocks per CU\n", per_cu); per_cu = 1; }
        (void)hipGetLastError();
        grid = cus;
    }
    if (grid < 0) return;
    if (hipMemsetAsync((char*)d_ws + WS_CTL, 0, CTL_ZERO_BYTES, stream) != hipSuccess) return;
    Args a{};
    for (int i = 0; i < 26; ++i) a.in[i] = (const float*)d_in[i];
    a.out = (float*)d_out; a.ws = (unsigned char*)d_ws;
    for (int li = 0; li < N_LAUNCHES; ++li) {
        a.ph_lo = (N_LAUNCHES == PER_PHASE) ? li : 0; a.ph_hi = (N_LAUNCHES == PER_PHASE) ? li + 1 : PER_PHASE; a.li = li;
        hipLaunchKernelGGL(skel_fwd, dim3(grid), dim3(NWAVES * 64), LDS_BYTES, stream, a);
    }
}
```

```cpp
#include <hip/hip_runtime.h>
#include <hip/hip_bf16.h>
#include <cstdio>
#include <cstdint>
#include <cmath>
namespace pg8 {
#define PG8_LAS __attribute__((address_space(3)))
typedef unsigned short bf16_t;
typedef short bf16x8 __attribute__((ext_vector_type(8)));
typedef float f32x4 __attribute__((ext_vector_type(4)));
typedef unsigned u32x4 __attribute__((ext_vector_type(4)));
constexpr int BM = 256, BK = 64, HALF = 128, HTB = HALF * BK * 2  , STAGE_BYTES = 8 * HTB, NXCD = 8, WGM = 4;

__host__ __device__ __forceinline__ int lds_byte(int r, int c) { const int st = (r >> 4) * 2 + (c >> 5), rr = r & 15, cc = c & 31, ob = rr * 64 + cc * 2; return st * 1024 + (ob ^ (((ob >> 9) & 1) << 5)); }
__host__ __device__ __forceinline__ void stage_rc(int b, int& R, int& C) { const int st = b / 1024, sb = b % 1024, swz = sb ^ (((sb >> 9) & 1) << 5); R = (st >> 1) * 16 + swz / 64; C = (st & 1) * 32 + (swz % 64) / 2; }
__host__ __device__ __forceinline__ int perm32(int rho) { const int n = rho >> 4, i = rho & 15; return 8 * (i >> 2) + 4 * n + (i & 3); }

struct Unit { int pm, pn; };
struct Gemm { const bf16_t* A; const bf16_t* Bt; int M, N, K; int ld; int ablk; };

struct StaticOrder {
    int nM, nN, nwg, G, c, rev;
    __host__ __device__ void init(int M, int N, int G_, int c_, int rev_ = 0) { nM = M / BM; nN = N / BM; nwg = nM * nN; G = G_; c = c_; rev = (rev_ && nwg % G_ == 0) ? nwg / G_ : 0; }
    __host__ __device__ bool next(int i, Unit& u) const {
        if (rev) { if (i >= rev) return false; i = rev - 1 - i; }
        const long L = (long)i * G + c; if (L >= nwg) return false;
        int wgid = (int)L; { const int q = nwg / NXCD, r = nwg % NXCD, xcd = wgid % NXCD, off = wgid / NXCD; wgid = (xcd < r ? xcd * (q + 1) : r * (q + 1) + (xcd - r) * q) + off; }
        const int nig = WGM * nN, gid = wgid / nig, fm = gid * WGM, gsz = (nM - fm) < WGM ? (nM - fm) : WGM;
        u.pm = fm + ((wgid % nig) % gsz); u.pn = (wgid % nig) / gsz; return true;
    }
    __device__ __forceinline__ void a_ready(const Unit&) const {}
    __device__ __forceinline__ void done(const Unit&) const {}
};


__device__ __forceinline__ unsigned cvt_pk_bf16(float lo, float hi) { unsigned r; asm volatile("v_cvt_pk_bf16_f32 %0, %1, %2" : "=v"(r) : "v"(lo), "v"(hi)); return r; }
typedef unsigned u32x2 __attribute__((ext_vector_type(2)));
constexpr float RMS_EPS_F = 1e-6f;
constexpr float LOG2E_F = 1.4426950408889634f;
__device__ __forceinline__ f32x4 row_q(const float* ssqp, int row, int fq) { return *(const f32x4*)(ssqp + (size_t)row * 16 + 4 * fq); }
__device__ __forceinline__ float rs_fin(const f32x4 q) {
    float s = (q[0] + q[1]) + (q[2] + q[3]);
    auto a = __builtin_amdgcn_permlane16_swap(__float_as_uint(s), __float_as_uint(s), false, false); s = __uint_as_float(a[0]) + __uint_as_float(a[1]);
    auto b = __builtin_amdgcn_permlane32_swap(__float_as_uint(s), __float_as_uint(s), false, false); s = __uint_as_float(b[0]) + __uint_as_float(b[1]);
    return __builtin_amdgcn_rsqf(s * (1.0f / 1024.0f) + RMS_EPS_F);
}
__device__ __forceinline__ float silu_f(float g) { return g * __builtin_amdgcn_rcpf(1.0f + __builtin_amdgcn_exp2f(-g * LOG2E_F)); }
__device__ __forceinline__ float sigmoid_f(float g) { return __builtin_amdgcn_rcpf(1.0f + __builtin_amdgcn_exp2f(-g * LOG2E_F)); }

struct EpiSwiGLU {
    static constexpr bool PERM = true, AFTER_DRAIN = false;
    bf16_t* O; int ldo; const float* ssqp;
    __device__ __forceinline__ static f32x4 swiglu4(const f32x4 g, const f32x4 uu, float nrs, float rs2) {
        const f32x4 t = g * nrs, gu = g * uu; f32x4 r;
#pragma unroll
        for (int i = 0; i < 4; ++i) r[i] = __builtin_amdgcn_rcpf(1.0f + __builtin_amdgcn_exp2f(t[i]));
        return gu * (r * rs2);
    }
    __device__ __forceinline__ void operator()(const f32x4 (&acc)[2][2][4][2], const Unit& u, int wr, int wc, int fr, int fq) const {
        const int row0 = u.pm * BM + wr * 64 + fr;
        const size_t obase = ((size_t)u.pm * (ldo / BK) + 2 * u.pn + (wc >> 1)) * (BM * BK) + (wc & 1) * 32 + 8 * fq;
        f32x4 q[2][4];
#pragma unroll
        for (int ai = 0; ai < 2; ++ai)
#pragma unroll
            for (int m = 0; m < 4; ++m) q[ai][m] = row_q(ssqp, row0 + ai * HALF + m * 16, fq);
        float rsv[2][4];
#pragma unroll
        for (int ai = 0; ai < 2; ++ai)
#pragma unroll
            for (int m = 0; m < 4; ++m) rsv[ai][m] = rs_fin(q[ai][m]);
#pragma unroll
        for (int ai = 0; ai < 2; ++ai)
#pragma unroll
            for (int m = 0; m < 4; ++m) {
                const int row = row0 + ai * HALF + m * 16; const float rs = rsv[ai][m], nrs = -LOG2E_F * rs, rs2 = rs * rs;
                const f32x4 o0 = swiglu4(acc[ai][0][m][0], acc[ai][1][m][0], nrs, rs2), o1 = swiglu4(acc[ai][0][m][1], acc[ai][1][m][1], nrs, rs2);
                u32x4 w; w.x = cvt_pk_bf16(o0[0], o0[1]); w.y = cvt_pk_bf16(o0[2], o0[3]); w.z = cvt_pk_bf16(o1[0], o1[1]); w.w = cvt_pk_bf16(o1[2], o1[3]);
                *(u32x4*)(O + obase + (size_t)(row - u.pm * BM) * BK) = w;
            }
    }
};

struct EpiResid {
    static constexpr bool PERM = true, AFTER_DRAIN = false;
    const bf16_t* bhi; float* outf; bf16_t* ohi; float* ssqp; float alpha; int aux;
    __device__ __forceinline__ static f32x4 up_bf(unsigned a, unsigned b) { return (f32x4){__uint_as_float(a << 16), __uint_as_float(a & 0xffff0000u), __uint_as_float(b << 16), __uint_as_float(b & 0xffff0000u)}; }
    __device__ __forceinline__ void operator()(const f32x4 (&acc)[2][2][4][2], const Unit& u, int wr, int wc, int fr, int fq) const {
        const int row0 = u.pm * BM + wr * 64 + fr, col0 = u.pn * BM + wc * 32 + 8 * fq;
        u32x4 bv[2][4][2];
#pragma unroll
        for (int ai = 0; ai < 2; ++ai)
#pragma unroll
            for (int m = 0; m < 4; ++m)
#pragma unroll
                for (int bj = 0; bj < 2; ++bj) bv[ai][m][bj] = *(const u32x4*)(bhi + (size_t)(row0 + ai * HALF + m * 16) * 1024 + col0 + bj * HALF);
        asm volatile("" ::: "memory");
#pragma unroll
        for (int ai = 0; ai < 2; ++ai)
#pragma unroll
            for (int m = 0; m < 4; ++m) {
                const int row = row0 + ai * HALF + m * 16; const size_t off = (size_t)row * 1024 + col0; float ss = 0.f;
#pragma unroll
                for (int bj = 0; bj < 2; ++bj) {
                    const u32x4 h = bv[ai][m][bj];
                    const f32x4 v0 = up_bf(h.x, h.y) + acc[ai][bj][m][0] * alpha, v1 = up_bf(h.z, h.w) + acc[ai][bj][m][1] * alpha;
                    if (aux) ss += ((v0[0] * v0[0] + v0[1] * v0[1]) + (v0[2] * v0[2] + v0[3] * v0[3])) + ((v1[0] * v1[0] + v1[1] * v1[1]) + (v1[2] * v1[2] + v1[3] * v1[3]));
                    if (outf) { *(f32x4*)(outf + off + bj * HALF) = v0; *(f32x4*)(outf + off + bj * HALF + 4) = v1; }
                    else { u32x4 w; w.x = cvt_pk_bf16(v0[0], v0[1]); w.y = cvt_pk_bf16(v0[2], v0[3]); w.z = cvt_pk_bf16(v1[0], v1[1]); w.w = cvt_pk_bf16(v1[2], v1[3]); *(u32x4*)(ohi + off + bj * HALF) = w; }
                }
                if (aux) { ss += __shfl_xor(ss, 16); ss += __shfl_xor(ss, 32); if (fq == 0) ssqp[(size_t)row * 16 + u.pn * 4 + wc] = ss; }
            }
    }
};

struct EpiWin {
    static constexpr bool PERM = true, AFTER_DRAIN = false;
    bf16_t* QO; bf16_t* KB; bf16_t* VB; bf16_t* RW; const float* ssqp; const float* gq; const float* gk; float qscale;
    __device__ __forceinline__ void operator()(const f32x4 (&acc)[2][2][4][2], const Unit& u, int wr, int wc, int fr, int fq) const {
        const int row0 = u.pm * BM + wr * 64 + fr; const int pn = u.pn;
        f32x4 q[2][4];
#pragma unroll
        for (int ai = 0; ai < 2; ++ai)
#pragma unroll
            for (int m = 0; m < 4; ++m) q[ai][m] = row_q(ssqp, row0 + ai * HALF + m * 16, fq);
        float rsv[2][4];
#pragma unroll
        for (int ai = 0; ai < 2; ++ai)
#pragma unroll
            for (int m = 0; m < 4; ++m) rsv[ai][m] = rs_fin(q[ai][m]);
        if (pn < 4) {
            const float* gp = (pn < 2) ? gq : gk; const float osc = (pn < 2) ? qscale : 1.0f;
            f32x4 gv[2][2];
#pragma unroll
            for (int bj = 0; bj < 2; ++bj)
#pragma unroll
                for (int n = 0; n < 2; ++n) gv[bj][n] = *(const f32x4*)(gp + 32 * bj + 8 * fq + 4 * n) * osc;
            bf16_t* dst = (pn < 2) ? QO : KB; const int ld = (pn < 2) ? 1024 : 512; const int colh = 64 * (4 * (pn & 1) + wc) + 8 * fq;
#pragma unroll
            for (int ai = 0; ai < 2; ++ai)
#pragma unroll
                for (int m = 0; m < 4; ++m) {
                    const int row = row0 + ai * HALF + m * 16; const float rs = rsv[ai][m];
                    f32x4 y[2][2]; float ss = 0.f;
#pragma unroll
                    for (int bj = 0; bj < 2; ++bj)
#pragma unroll
                        for (int n = 0; n < 2; ++n) { y[bj][n] = acc[ai][bj][m][n] * rs; const f32x4 t = y[bj][n]; ss += (t[0] * t[0] + t[1] * t[1]) + (t[2] * t[2] + t[3] * t[3]); }
                    ss += __shfl_xor(ss, 16); ss += __shfl_xor(ss, 32);
                    const float hs = __builtin_amdgcn_rsqf(ss * (1.0f / 64.0f) + RMS_EPS_F);
#pragma unroll
                    for (int bj = 0; bj < 2; ++bj) {
                        const f32x4 a = y[bj][0] * gv[bj][0] * hs, b = y[bj][1] * gv[bj][1] * hs;
                        u32x4 w; w.x = cvt_pk_bf16(a[0], a[1]); w.y = cvt_pk_bf16(a[2], a[3]); w.z = cvt_pk_bf16(b[0], b[1]); w.w = cvt_pk_bf16(b[2], b[3]);
                        *(u32x4*)(dst + (size_t)row * ld + colh + 32 * bj) = w;
                    }
                }
        } else {
            bf16_t* dst = (pn < 6) ? VB : RW; const int ld = (pn < 6) ? 512 : 1792; const int colh = 256 * ((pn < 6) ? (pn - 4) : (pn - 6)) + 64 * wc + 8 * fq;
#pragma unroll
            for (int ai = 0; ai < 2; ++ai)
#pragma unroll
                for (int m = 0; m < 4; ++m) {
                    const int row = row0 + ai * HALF + m * 16; const float rs = rsv[ai][m];
#pragma unroll
                    for (int bj = 0; bj < 2; ++bj) {
                        const f32x4 a = acc[ai][bj][m][0] * rs, b = acc[ai][bj][m][1] * rs;
                        u32x4 w; w.x = cvt_pk_bf16(a[0], a[1]); w.y = cvt_pk_bf16(a[2], a[3]); w.z = cvt_pk_bf16(b[0], b[1]); w.w = cvt_pk_bf16(b[2], b[3]);
                        *(u32x4*)(dst + (size_t)row * ld + colh + 32 * bj) = w;
                    }
                }
        }
    }
};

template <class Epi, class Sched, bool ALIGN_EPI = false, bool SP2 = false>
__device__ __forceinline__ void gemm_phase(PG8_LAS unsigned char* lds, const Gemm g, const Sched& S, const Epi& E) {
    const int tid = threadIdx.x, wid = __builtin_amdgcn_readfirstlane(tid >> 6), lane = tid & 63, wr = wid >> 2, wc = wid & 3, fr = lane & 15, fq = lane >> 4;
    const int K = g.K, nt = K / BK, LDP = g.ld ? g.ld : g.K, LDA = g.ablk ? BK : LDP;
    unsigned voffA[2], voffB[2];
#pragma unroll
    for (int i = 0; i < 2; ++i) { int R, C; stage_rc(tid * 16 + i * 8192, R, C); const int Rb = Epi::PERM ? ((R & ~31) + perm32(R & 31)) : R;
        voffA[i] = (unsigned)(R * LDA + C) * 2u; voffB[i] = (unsigned)(Rb * LDP + C) * 2u; }
    const size_t kstep = (size_t)(BK * 2);
    const size_t hstep = (size_t)HALF * LDP * 2;
    const size_t tstep = 2 * hstep;
    const size_t kstepA = g.ablk ? (size_t)BM * BK * 2 : kstep, hstepA = (size_t)HALF * LDA * 2, tstepA = g.ablk ? (size_t)BM * K * 2 : tstep;
    const unsigned ldsw = (unsigned)wid * 1024u;
    const int aoff = lds_byte(wr * 64 + fr, fq * 8), boff = lds_byte(wc * 32 + fr, fq * 8);
#define PG8_SA(b, h) (((b) * 2 + (h)) * HTB)
#define PG8_SB(b, h) ((4 + (b) * 2 + (h)) * HTB)
#define PG8_STAGE(bufoff, gbase, voff) do { _Pragma("unroll") for (int _i = 0; _i < 2; ++_i) \
        __builtin_amdgcn_global_load_lds((const unsigned*)((const char*)(gbase) + (voff)[_i]), (PG8_LAS unsigned*)(lds + (bufoff) + ldsw + _i * 8192), 16, 0, 0); } while (0)
#define PG8_LDA(dst, b, h) do { _Pragma("unroll") for (int m = 0; m < 4; ++m) _Pragma("unroll") for (int k = 0; k < 2; ++k) dst[m][k] = *(const PG8_LAS bf16x8*)(lds + PG8_SA(b, h) + aoff + m * 2048 + k * 1024); } while (0)
#define PG8_LDB(dst, b, h) do { _Pragma("unroll") for (int n = 0; n < 2; ++n) _Pragma("unroll") for (int k = 0; k < 2; ++k) dst[n][k] = *(const PG8_LAS bf16x8*)(lds + PG8_SB(b, h) + boff + n * 2048 + k * 1024); } while (0)
#define PG8_MMA(ai, bj, At, Bt) do { __builtin_amdgcn_s_setprio(0); _Pragma("unroll") for (int m = 0; m < 4; ++m) _Pragma("unroll") for (int n = 0; n < 2; ++n) _Pragma("unroll") for (int k = 0; k < 2; ++k) \
        acc[ai][bj][m][n] = __builtin_amdgcn_mfma_f32_16x16x32_bf16(Bt[n][k], At[m][k], acc[ai][bj][m][n], 0, 0, 0); __builtin_amdgcn_s_setprio(1); } while (0)
#define PG8_WAIT_V(n) asm volatile("s_waitcnt vmcnt(" #n ")" ::: "memory")
#define PG8_WAIT_L(n) asm volatile("s_waitcnt lgkmcnt(" #n ")" ::: "memory")
#define PG8_BAR __builtin_amdgcn_s_barrier()
#define PG8_SCHED __builtin_amdgcn_sched_barrier(0)
    Unit cur, nxt; int ui = 0;
    if (!S.next(0, cur)) return;
    f32x4 acc[2][2][4][2];
#pragma unroll
    for (int a = 0; a < 2; ++a)
#pragma unroll
        for (int b = 0; b < 2; ++b)
#pragma unroll
            for (int m = 0; m < 4; ++m)
#pragma unroll
                for (int n = 0; n < 2; ++n) acc[a][b][m][n] = (f32x4){0.f, 0.f, 0.f, 0.f};
    bf16x8 At[4][2], B0[2][2], B1[2][2];
    const char* cA = (const char*)g.A + (size_t)cur.pm * tstepA; const char* cB = (const char*)g.Bt + (size_t)cur.pn * tstep;
    S.a_ready(cur);
    if constexpr (SP2) {
        PG8_STAGE(PG8_SB(0, 0), cB, voffB); PG8_STAGE(PG8_SB(0, 1), cB + hstep, voffB); PG8_STAGE(PG8_SA(0, 0), cA, voffA); PG8_STAGE(PG8_SA(0, 1), cA + hstepA, voffA);
        if (wr == 1) PG8_BAR;
        PG8_WAIT_V(2); PG8_BAR;
        PG8_STAGE(PG8_SB(1, 0), cB + kstep, voffB); PG8_STAGE(PG8_SA(1, 0), cA + kstepA, voffA); PG8_STAGE(PG8_SB(1, 1), cB + hstep + kstep, voffB);
        PG8_WAIT_V(6); PG8_BAR;
    } else {
        PG8_STAGE(PG8_SB(0, 0), cB, voffB); PG8_STAGE(PG8_SA(0, 0), cA, voffA); PG8_STAGE(PG8_SB(0, 1), cB + hstep, voffB); PG8_STAGE(PG8_SA(0, 1), cA + hstepA, voffA);
        if (wr == 1) PG8_BAR;
        PG8_WAIT_V(4); PG8_BAR;
        PG8_STAGE(PG8_SB(1, 0), cB + kstep, voffB); PG8_STAGE(PG8_SA(1, 0), cA + kstepA, voffA); PG8_STAGE(PG8_SB(1, 1), cB + hstep + kstep, voffB);
        PG8_WAIT_V(6); PG8_BAR;
    }
    for (;;) {
        const bool has_next = S.next(ui + 1, nxt);
        const char* nA = has_next ? (const char*)g.A + (size_t)nxt.pm * tstepA : cA; const char* nB = has_next ? (const char*)g.Bt + (size_t)nxt.pn * tstep : cB;
        for (int t = 0; t < nt; t += 2) {
            const bool last = (t == nt - 2);
            const char* a1 = cA + (size_t)(t + 1) * kstepA;
            const char* a2 = last ? nA : cA + (size_t)(t + 2) * kstepA; const char* b2 = last ? nB : cB + (size_t)(t + 2) * kstep;
            const char* a3 = a2 + kstepA; const char* b3 = b2 + kstep;
            if (last && has_next) S.a_ready(nxt);
            if constexpr (SP2) {
            PG8_LDB(B0, 0, 0); PG8_LDB(B1, 0, 1); PG8_SCHED; PG8_LDA(At, 0, 0); PG8_STAGE(PG8_SA(1, 1), a1 + hstepA, voffA);
            PG8_WAIT_V(8); PG8_WAIT_L(0); PG8_BAR; PG8_MMA(0, 0, At, B0); PG8_MMA(0, 1, At, B1); PG8_BAR; PG8_SCHED;
            PG8_LDA(At, 0, 1); PG8_STAGE(PG8_SB(0, 0), b2, voffB); PG8_STAGE(PG8_SB(0, 1), b2 + hstep, voffB); PG8_STAGE(PG8_SA(0, 0), a2, voffA);
            PG8_WAIT_V(8); PG8_WAIT_L(0); PG8_BAR; PG8_MMA(1, 0, At, B0); PG8_MMA(1, 1, At, B1); PG8_BAR; PG8_SCHED;
            PG8_LDB(B0, 1, 0); PG8_LDB(B1, 1, 1); PG8_SCHED; PG8_LDA(At, 1, 0); PG8_STAGE(PG8_SA(0, 1), a2 + hstepA, voffA);
            PG8_WAIT_V(8); PG8_WAIT_L(0); PG8_BAR; PG8_MMA(0, 0, At, B0); PG8_MMA(0, 1, At, B1); PG8_BAR; PG8_SCHED;
            PG8_LDA(At, 1, 1); PG8_STAGE(PG8_SB(1, 0), b3, voffB); PG8_STAGE(PG8_SB(1, 1), b3 + hstep, voffB); PG8_STAGE(PG8_SA(1, 0), a3, voffA);
            PG8_WAIT_V(8); PG8_WAIT_L(0); PG8_BAR; PG8_MMA(1, 0, At, B0); PG8_MMA(1, 1, At, B1); PG8_BAR; PG8_SCHED;
            } else {
            PG8_LDB(B0, 0, 0); PG8_SCHED; PG8_LDA(At, 0, 0); PG8_STAGE(PG8_SA(1, 1), a1 + hstepA, voffA);
            PG8_WAIT_L(8); PG8_BAR; PG8_WAIT_L(0); PG8_MMA(0, 0, At, B0); PG8_BAR; PG8_SCHED;
            PG8_LDB(B1, 0, 1); PG8_STAGE(PG8_SB(0, 0), b2, voffB);
            PG8_BAR; PG8_WAIT_L(0); PG8_MMA(0, 1, At, B1); PG8_BAR;
            PG8_LDA(At, 0, 1); PG8_STAGE(PG8_SA(0, 0), a2, voffA);
            PG8_BAR; PG8_WAIT_L(0); PG8_MMA(1, 0, At, B0); PG8_BAR; PG8_SCHED;
            PG8_STAGE(PG8_SB(0, 1), b2 + hstep, voffB);
            PG8_WAIT_V(6); PG8_BAR; PG8_MMA(1, 1, At, B1); PG8_BAR;
            PG8_LDB(B0, 1, 0); PG8_SCHED; PG8_LDA(At, 1, 0); PG8_STAGE(PG8_SA(0, 1), a2 + hstepA, voffA);
            PG8_WAIT_L(8); PG8_BAR; PG8_WAIT_L(0); PG8_MMA(0, 0, At, B0); PG8_BAR; PG8_SCHED;
            PG8_LDB(B1, 1, 1); PG8_STAGE(PG8_SB(1, 0), b3, voffB);
            PG8_BAR; PG8_WAIT_L(0); PG8_MMA(0, 1, At, B1); PG8_BAR;
            PG8_LDA(At, 1, 1); PG8_STAGE(PG8_SA(1, 0), a3, voffA);
            PG8_BAR; PG8_WAIT_L(0); PG8_MMA(1, 0, At, B0); PG8_BAR; PG8_SCHED;
            PG8_STAGE(PG8_SB(1, 1), b3 + hstep, voffB);
            PG8_WAIT_V(6); PG8_BAR; PG8_MMA(1, 1, At, B1); PG8_BAR;
            }
        }
        if constexpr (ALIGN_EPI) { if (wr == 0) PG8_BAR; }
        if constexpr (!Epi::AFTER_DRAIN) { E(acc, cur, wr, wc, fr, fq); S.done(cur); }
        if (!has_next) break;
#pragma unroll
        for (int a = 0; a < 2; ++a)
#pragma unroll
            for (int b = 0; b < 2; ++b)
#pragma unroll
                for (int m = 0; m < 4; ++m)
#pragma unroll
                    for (int n = 0; n < 2; ++n) acc[a][b][m][n] = (f32x4){0.f, 0.f, 0.f, 0.f};
        cur = nxt; cA = nA; cB = nB; ++ui;
        if constexpr (ALIGN_EPI) { if (wr == 1) PG8_BAR; }
    }
    __builtin_amdgcn_s_setprio(0);
    PG8_WAIT_V(0);
    if constexpr (!ALIGN_EPI) { if (wr == 0) PG8_BAR; }
    PG8_BAR;
    if constexpr (Epi::AFTER_DRAIN) { E.fused(acc, cur, wr, wc, fr, fq, lds, wid, lane); S.done(cur); }
#undef PG8_SA
#undef PG8_SB
#undef PG8_STAGE
#undef PG8_LDA
#undef PG8_LDB
#undef PG8_MMA
#undef PG8_WAIT_V
#undef PG8_WAIT_L
#undef PG8_BAR
#undef PG8_SCHED
}
}
#define GAS __attribute__((address_space(1)))
#define LAS __attribute__((address_space(3)))
typedef unsigned short bf16;
typedef unsigned v4u __attribute__((ext_vector_type(4)));
typedef float f32x4 __attribute__((ext_vector_type(4)));
typedef short bf16x8 __attribute__((ext_vector_type(8)));
typedef GAS unsigned gu32;
typedef GAS unsigned long long gu64;
#define RLX_AGENT __ATOMIC_RELAXED, __HIP_MEMORY_SCOPE_AGENT
#define LDS_WAIT() asm volatile("s_waitcnt lgkmcnt(0)" ::: "memory")
#define VM_WAIT() asm volatile("s_waitcnt vmcnt(0)" ::: "memory")
__device__ __forceinline__ unsigned long long rt() { return __builtin_amdgcn_s_memrealtime(); }
__device__ __forceinline__ unsigned f2bf(float f) { unsigned u = __builtin_bit_cast(unsigned, f); return (u + 0x7fffu + ((u >> 16) & 1u)) >> 16; }
__device__ __forceinline__ unsigned pk2(float lo, float hi) { return f2bf(lo) | (f2bf(hi) << 16); }

#define XB_TMO      128
#define XB_XCNT(j)  (256  + 64 * (j))
#define XB_XSUB(j)  (1280 + 64 * (j))
#define XB_XGEN(j)  (2304 + 64 * (j))
#define XB_TOP      3328
#define XB_TOPGEN   3392
#define XCD_BAR_WORDS 3456
#define XB_SPIN_CAP (1u << 18)

__device__ __forceinline__ unsigned xb_ld(unsigned* p)              { return __hip_atomic_load(p, __ATOMIC_RELAXED, __HIP_MEMORY_SCOPE_AGENT); }
__device__ __forceinline__ unsigned xb_add(unsigned* p, unsigned v) { return __hip_atomic_fetch_add(p, v, __ATOMIC_RELAXED, __HIP_MEMORY_SCOPE_AGENT); }
__device__ __forceinline__ unsigned xb_xcc_id() { return (unsigned)__builtin_amdgcn_s_getreg((3 << 11) | 20) & 0xFu; }
#define XB_SPIN(cond, bar) do { unsigned _sp = 0; while (cond) { __builtin_amdgcn_s_sleep(1); \
    if ((++_sp & 255u) == 0u) { if (xb_ld(&(bar)[XB_TMO])) break; if (_sp > XB_SPIN_CAP) { atomicAdd(&(bar)[XB_TMO], 1u); break; } } } } while (0)

struct XcdBarrier {
    unsigned* bar; unsigned x;
    volatile LAS unsigned* st;
};

__device__ __forceinline__ XcdBarrier xcd_barrier_post(unsigned* bar, volatile LAS unsigned* st) {
    XcdBarrier b; b.bar = bar; b.x = xb_xcc_id(); b.st = st;
    if (threadIdx.x == 0) (void)xb_add(&bar[XB_XCNT(b.x)], 1u);
    return b;
}
__device__ __forceinline__ void xcd_barrier_complete(unsigned* bar, unsigned x, unsigned& nloc, unsigned& nx) {
    const unsigned G = gridDim.x * gridDim.y * gridDim.z;
    unsigned sum, cnt, mine, sp = 0u;
    for (;;) {
        sum = 0u; cnt = 0u; mine = 0u;
#pragma unroll
        for (unsigned j = 0; j < 16; ++j) { const unsigned c = xb_ld(&bar[XB_XCNT(j)]); sum += c; cnt += (c > 0u) ? 1u : 0u; mine = (j == x) ? c : mine; }
        if (sum == G) break;
        __builtin_amdgcn_s_sleep(1);
        if ((++sp & 255u) == 0u) { if (xb_ld(&bar[XB_TMO])) break; if (sp > XB_SPIN_CAP) { atomicAdd(&bar[XB_TMO], 1u); break; } }
    }
    nloc = mine > 0u ? mine : 1u; nx = cnt > 0u ? cnt : 1u;
}

__device__ __forceinline__ void xcd_barrier(const XcdBarrier& b) {
    asm volatile("s_waitcnt vmcnt(0)" ::: "memory");
    __syncthreads();
    if (threadIdx.x == 0) {
        unsigned* bar = b.bar;
        __builtin_amdgcn_s_waitcnt(0);
        unsigned nloc = b.st[0], nx = b.st[1];
        if (nloc == 0u) { xcd_barrier_complete(bar, b.x, nloc, nx); b.st[0] = nloc; b.st[1] = nx; }
        const unsigned old = xb_add(&bar[XB_XSUB(b.x)], 1u);
        const unsigned gen = old / nloc;
        if (old + 1u == (gen + 1u) * nloc) {
            __builtin_amdgcn_fence(__ATOMIC_RELEASE, "agent");
            asm volatile("s_waitcnt vmcnt(0)" ::: "memory");
            const unsigned og = xb_add(&bar[XB_TOP], 1u);
            const unsigned tg = og / nx;
            if (og + 1u == (tg + 1u) * nx) xb_add(&bar[XB_TOPGEN], 1u);
            else XB_SPIN(xb_ld(&bar[XB_TOPGEN]) == tg, bar);
            __builtin_amdgcn_fence(__ATOMIC_ACQUIRE, "agent");
            xb_add(&bar[XB_XGEN(b.x)], 1u);
            asm volatile("s_waitcnt vmcnt(0)" ::: "memory");
        } else {
            XB_SPIN(xb_ld(&bar[XB_XGEN(b.x)]) == gen, bar);
            __builtin_amdgcn_fence(__ATOMIC_ACQUIRE, "agent");
            asm volatile("s_waitcnt vmcnt(0)" ::: "memory");
        }
    }
    __syncthreads();
}

constexpr int NWAVES = 8;
#ifndef MK_N_LAUNCHES
#define MK_N_LAUNCHES 1
#endif
constexpr int PER_PHASE = 11;
constexpr int N_LAUNCHES = MK_N_LAUNCHES;

constexpr int BATCH = 16, SEQ = 2048, D = 1024, HD = 64, NH = 8, FF = 2816;
constexpr int M = BATCH * SEQ;
constexpr int SBW = 512, RWW = 512, RWP = 1792, PW = 3328, LORA_K = 256, LORA_N = 1536;
constexpr float LNX_EPS = 64e-5f;

constexpr size_t MiB = 1u << 20;
constexpr size_t WS_CTL = 0, CTL_ZERO_BYTES = 128 * 1024;
constexpr size_t WS_SSQ = 1 * MiB;
constexpr size_t WS_W1U = 4 * MiB;
constexpr size_t WS_W1D = 15 * MiB;
constexpr size_t WS_W2U = 21 * MiB;
constexpr size_t WS_W2D = 32 * MiB;
constexpr size_t WS_WIN = 38 * MiB;
constexpr size_t WS_WOUT = 45 * MiB;
constexpr size_t WS_WLORA = 47 * MiB;
constexpr size_t WS_XB = 48 * MiB;
constexpr size_t WS_ACT = 112 * MiB;
constexpr size_t WS_QO = 112 * MiB;
constexpr size_t WS_KB = 176 * MiB;
constexpr size_t WS_VB = 208 * MiB;
constexpr size_t WS_RW = 240 * MiB;
constexpr size_t WS_ALORA = 352 * MiB;
constexpr size_t WS_LW = 368 * MiB;
constexpr size_t WS_AB = 432 * MiB;
constexpr size_t WS_GB = 464 * MiB;
constexpr size_t WS_TAIL = 496 * MiB;
constexpr size_t WS_END = 512 * MiB;
constexpr int CW_TMO = 0, CW_CODE = 1;
constexpr int CW_BAR = 4096;
constexpr int CW_QUEUE = 16384;

constexpr int RING_OFF = 0, RING_BYTES = 155648;
constexpr int LDSCTL_OFF = RING_BYTES, MISC_OFF = LDSCTL_OFF;
constexpr int LDS_BYTES = 163840;

struct Frame {
    LAS unsigned char* lds;
    volatile LAS unsigned* MISC;
    gu32* ctl;
    int tid, lane, wave;
    int vcu, G;
};
typedef unsigned u32x2g __attribute__((ext_vector_type(2)));
__device__ __forceinline__ float bf2f(unsigned short h) { return __uint_as_float(((unsigned)h) << 16); }
typedef float f32x2h __attribute__((ext_vector_type(2))); typedef __bf16 bf16x2h __attribute__((ext_vector_type(2)));
__device__ __forceinline__ unsigned pkbf(float lo, float hi) { f32x2h v = {lo, hi}; bf16x2h b = __builtin_convertvector(v, bf16x2h); return __builtin_bit_cast(unsigned, b); }
__device__ __forceinline__ float bflo(unsigned w) { return __uint_as_float(w << 16); }
__device__ __forceinline__ float bfhi(unsigned w) { return __uint_as_float(w & 0xffff0000u); }
__device__ __forceinline__ float wave_sum(float v) {
#pragma unroll
    for (int o = 1; o < 64; o <<= 1) v += __shfl_xor(v, o);
    return v;
}
#define DPP_ADD(v, ctrl) ((v) + __int_as_float(__builtin_amdgcn_update_dpp(0, __float_as_int(v), (ctrl), 0xF, 0xF, true)))
__device__ __forceinline__ float sum8(float v) { v = DPP_ADD(v, 0xB1); v = DPP_ADD(v, 0x4E); v = DPP_ADD(v, 0x141); return v; }

struct TItem { const float* W; int ldw, k0, n0; const float* sc; bf16* WT; int Kd, rho0; };
__device__ __forceinline__ void ti_load(const TItem& T, float (&t)[32], int lane) {
#pragma unroll
    for (int i = 0; i < 32; ++i) t[i] = T.W[(size_t)(T.k0 + 2 * i + (lane >> 5)) * T.ldw + T.n0 + (lane & 31)];
}
__device__ __forceinline__ void ti_finish(const TItem& T, const float (&t)[32], LAS float* scr, int lane) {
#pragma unroll
    for (int i = 0; i < 32; ++i) scr[(2 * i + (lane >> 5)) * 33 + (lane & 31)] = t[i];
    LDS_WAIT(); asm volatile("" ::: "memory");
    const int c = lane & 7;
    f32x4 s0 = (f32x4){1.f, 1.f, 1.f, 1.f}, s1 = s0;
    if (T.sc) { s0 = *(const f32x4*)(T.sc + T.k0 + 8 * c); s1 = *(const f32x4*)(T.sc + T.k0 + 8 * c + 4); }
#pragma unroll
    for (int j = 0; j < 4; ++j) { const int n = (lane >> 3) + 8 * j; const LAS float* s = scr + (8 * c) * 33 + n;
        v4u o; o.x = pkbf(s[0 * 33] * s0.x, s[1 * 33] * s0.y); o.y = pkbf(s[2 * 33] * s0.z, s[3 * 33] * s0.w); o.z = pkbf(s[4 * 33] * s1.x, s[5 * 33] * s1.y); o.w = pkbf(s[6 * 33] * s1.z, s[7 * 33] * s1.w);
        *(GAS v4u*)(T.WT + (size_t)(T.rho0 + n) * T.Kd + T.k0 + 8 * c) = o; }
    LDS_WAIT(); asm volatile("" ::: "memory");
}
#define P0_PTRS const float* Ax, const float* An1, const float* Ag1, const float* Au1, const float* Ad1, const float* Anm, const float* Awin, const float* Aw2, const float* Aa2, const float* Ag2, const float* Awout, \
    const float* An2, const float* Ag2f, const float* Au2f, const float* Ad2f, bf16* AW1U, bf16* AW1D, bf16* AW2U, bf16* AW2D, bf16* AWIN, bf16* AWOUT, bf16* AWLORA, bf16* AXB, float* ASSQ
__device__ __forceinline__ void p0_items(Frame& F, P0_PTRS, int set, int gw, int NGW) {
    LAS float* scr = (LAS float*)(F.lds + RING_OFF + F.wave * 16384);
    constexpr int I_UP = 16 * 176, I_DN = 44 * 32, I_IN = 16 * 104, I_OUT = 16 * 32;
    const int NITEMS = set ? (I_UP + I_DN) : (I_UP + I_DN + I_IN + I_OUT);
#define P0_DECODE(it_, T) do { int r = (it_); const int l2 = set; \
        if (r < I_UP) { const int kb = r / 176, nb = r % 176, rho0 = 32 * nb, pn = rho0 >> 8, bj = (rho0 >> 7) & 1, j0 = rho0 & 127; \
            T = TItem{l2 ? (bj ? Au2f : Ag2f) : (bj ? Au1 : Ag1), FF, 64 * kb, 128 * pn + j0, l2 ? An2 : An1, l2 ? AW2U : AW1U, D, rho0}; } \
        else if ((r -= I_UP) < I_DN) { const int kb = r / 32, nb = r % 32; \
            T = TItem{l2 ? Ad2f : Ad1, D, 64 * kb, 32 * nb, nullptr, l2 ? AW2D : AW1D, FF, 32 * nb}; } \
        else if ((r -= I_DN) < I_IN) { const int kb = r / 104, nb = r % 104, rho0 = 32 * nb, pn = rho0 >> 8, rem = rho0 & 255, bj = rem >> 7, wc = (rem & 127) >> 5; \
            T = TItem{Awin, PW, 64 * kb, 256 * pn + 64 * wc + 32 * bj, Anm, AWIN, D, rho0}; } \
        else { r -= I_IN; const int kb = r / 32, nb = r % 32; T = TItem{Awout, D, 64 * kb, 32 * nb, nullptr, AWOUT, D, 32 * nb}; } } while (0)
    for (int it = gw; it < NITEMS; it += 2 * NGW) {
        TItem T0, T1; float t0[32], t1[32]; const bool two = (it + NGW < NITEMS);
        P0_DECODE(it, T0); ti_load(T0, t0, F.lane);
        if (two) { P0_DECODE(it + NGW, T1); ti_load(T1, t1, F.lane); }
        ti_finish(T0, t0, scr, F.lane);
        if (two) ti_finish(T1, t1, scr, F.lane);
    }
#undef P0_DECODE
}
__device__ __forceinline__ void p0_prologue(Frame& F, P0_PTRS) {
    const int gw = F.vcu * NWAVES + F.wave, NGW = F.G * NWAVES;
    p0_items(F, Ax, An1, Ag1, Au1, Ad1, Anm, Awin, Aw2, Aa2, Ag2, Awout, An2, Ag2f, Au2f, Ad2f, AW1U, AW1D, AW2U, AW2D, AWIN, AWOUT, AWLORA, AXB, ASSQ, (F.G >= 256) ? 0 : 0, gw, NGW);
    if (F.G < 256) p0_items(F, Ax, An1, Ag1, Au1, Ad1, Anm, Awin, Aw2, Aa2, Ag2, Awout, An2, Ag2f, Au2f, Ad2f, AW1U, AW1D, AW2U, AW2D, AWIN, AWOUT, AWLORA, AXB, ASSQ, 1, gw, NGW);
    for (int it = F.vcu * (NWAVES * 64) + F.tid; it < 512 * 32; it += F.G * NWAVES * 64) {
        int ch, kc, Kk; const float* src; bf16* dst;
        if (it < 512 * 8) { ch = it >> 3; kc = (it & 7) * 8; Kk = 64; src = Aw2; dst = AWLORA; }
        else if (it < 512 * 16) { const int i2 = it - 512 * 8; ch = i2 >> 3; kc = (i2 & 7) * 8; Kk = 64; src = Aa2; dst = AWLORA + 512 * 64; }
        else { const int i2 = it - 512 * 16; ch = i2 >> 4; kc = (i2 & 15) * 8; Kk = 128; src = Ag2; dst = AWLORA + 2 * 512 * 64; }
        float v[8];
#pragma unroll
        for (int j = 0; j < 8; ++j) v[j] = src[(size_t)(kc + j) * 512 + ch];
        v4u o; o.x = pkbf(v[0], v[1]); o.y = pkbf(v[2], v[3]); o.z = pkbf(v[4], v[5]); o.w = pkbf(v[6], v[7]);
        *(GAS v4u*)(dst + (size_t)ch * Kk + kc) = o;
    }
    for (int mb = gw; mb < M; mb += 4 * NGW) {
        f32x4 v[4][4]; float s[4];
#pragma unroll
        for (int q = 0; q < 4; ++q) { const int m = mb + q * NGW; const GAS f32x4* xr = (const GAS f32x4*)(Ax + (size_t)(m < M ? m : mb) * D) + F.lane;
#pragma unroll
            for (int j = 0; j < 4; ++j) v[q][j] = xr[64 * j]; }
#pragma unroll
        for (int q = 0; q < 4; ++q) { float a = 0.f;
#pragma unroll
            for (int j = 0; j < 4; ++j) a += (v[q][j].x * v[q][j].x + v[q][j].y * v[q][j].y) + (v[q][j].z * v[q][j].z + v[q][j].w * v[q][j].w);
            s[q] = a; }
#pragma unroll
        for (int o = 1; o < 64; o <<= 1) {
#pragma unroll
            for (int q = 0; q < 4; ++q) s[q] += __shfl_xor(s[q], o); }
#pragma unroll
        for (int q = 0; q < 4; ++q) { const int m = mb + q * NGW; if (m < M) {
            GAS unsigned long long* o8 = (GAS unsigned long long*)(AXB + (size_t)m * D) + F.lane;
#pragma unroll
            for (int j = 0; j < 4; ++j) o8[64 * j] = (unsigned long long)pkbf(v[q][j].x, v[q][j].y) | ((unsigned long long)pkbf(v[q][j].z, v[q][j].w) << 32);
            if (F.lane < 16) ASSQ[(size_t)m * 16 + F.lane] = (F.lane == 0) ? s[q] : 0.f; } }
    }
}

struct RwArgs { const bf16* RW; const bf16* W2T; const bf16* A2T; const bf16* G2T; const float* w0; const float* a0; bf16* QO; const float *mu, *k_k, *k_a, *r_k, *ln_w, *ln_b; };
__device__ __forceinline__ void ld8bf(const bf16* p, float (&o)[8]) { const v4u w = *(const v4u*)p; o[0] = bflo(w.x); o[1] = bfhi(w.x); o[2] = bflo(w.y); o[3] = bfhi(w.y); o[4] = bflo(w.z); o[5] = bfhi(w.z); o[6] = bflo(w.w); o[7] = bfhi(w.w); }
__device__ __forceinline__ void ld8f(const float* p, float (&o)[8]) { const f32x4 a = *(const f32x4*)p, b = *(const f32x4*)(p + 4); o[0] = a.x; o[1] = a.y; o[2] = a.z; o[3] = a.w; o[4] = b.x; o[5] = b.y; o[6] = b.z; o[7] = b.w; }
__device__ __forceinline__ void ld8l(const LAS float* p, float (&o)[8]) { const f32x4 a = *(const LAS f32x4*)p, b = *(const LAS f32x4*)(p + 4); o[0] = a.x; o[1] = a.y; o[2] = a.z; o[3] = a.w; o[4] = b.x; o[5] = b.y; o[6] = b.z; o[7] = b.w; }
__device__ __forceinline__ void st8l(LAS float* p, const float (&o)[8]) { *(LAS f32x4*)p = (f32x4){o[0], o[1], o[2], o[3]}; *(LAS f32x4*)(p + 4) = (f32x4){o[4], o[5], o[6], o[7]}; }
namespace rwk {
typedef short bf16x8 __attribute__((ext_vector_type(8)));
typedef short s16x4 __attribute__((ext_vector_type(4)));
typedef short v4i16_t __attribute__((ext_vector_type(4)));
constexpr int SLOT = 8192;
#define RSL(s) (lds + (s) * SLOT)
#define RMFMA(a, b, c) __builtin_amdgcn_mfma_f32_16x16x32_bf16((a), (b), (c), 0, 0, 0)
__device__ __forceinline__ int swz(int row, int cb) { return row * 128 + (cb ^ ((row & 7) << 4)); }
struct Fr2 { bf16x8 k0, k1; };
__device__ __forceinline__ Fr2 ldf(const LAS unsigned char* base, int off) { Fr2 f; f.k0 = *(const LAS bf16x8*)(base + off); f.k1 = *(const LAS bf16x8*)(base + (off ^ 64)); return f; }
__device__ __forceinline__ s16x4 trd(const LAS unsigned char* p) { return __builtin_bit_cast(s16x4, __builtin_amdgcn_ds_read_tr16_b64_v4i16((LAS v4i16_t*)p)); }
__device__ __forceinline__ Fr2 ldt(const LAS unsigned char* base, int o0, int o1) {
    const s16x4 a = trd(base + o0), b = trd(base + o1), c = trd(base + o0 + 4096), d = trd(base + o1 + 4096);
    Fr2 f; f.k0 = (bf16x8){a[0], a[1], a[2], a[3], b[0], b[1], b[2], b[3]}; f.k1 = (bf16x8){c[0], c[1], c[2], c[3], d[0], d[1], d[2], d[3]}; return f; }
template <bool SWAP> __device__ __forceinline__ f32x4 mm(const Fr2& a, const Fr2& b, f32x4 c) {
    if (SWAP) { c = RMFMA(b.k0, a.k0, c); c = RMFMA(b.k1, a.k1, c); } else { c = RMFMA(a.k0, b.k0, c); c = RMFMA(a.k1, b.k1, c); } return c; }
__device__ __forceinline__ void st4(LAS unsigned char* slot, int off, f32x4 v) { u32x2g w; w.x = pkbf(v[0], v[1]); w.y = pkbf(v[2], v[3]); *(LAS u32x2g*)(slot + off) = w; }
__device__ __forceinline__ f32x4 M16(s16x4 a, s16x4 b, f32x4 c) { return __builtin_amdgcn_mfma_f32_16x16x16bf16_1k(a, b, c, 0, 0, 0); }
__device__ __forceinline__ s16x4 cv4(f32x4 v) { const u32x2g w = (u32x2g){pkbf(v[0], v[1]), pkbf(v[2], v[3])}; return __builtin_bit_cast(s16x4, w); }
__device__ __forceinline__ float bf1(short s) { return __uint_as_float(((unsigned)(unsigned short)s) << 16); }
__device__ __forceinline__ f32x4 ld4(const LAS unsigned char* slot, int off) { const u32x2g w = *(const LAS u32x2g*)(slot + off); return (f32x4){bflo(w.x), bfhi(w.x), bflo(w.y), bfhi(w.y)}; }
#define LBAR() asm volatile("s_waitcnt lgkmcnt(0)\n\ts_barrier" ::: "memory")
#define DPPF(x, ctrl, rmask) __int_as_float(__builtin_amdgcn_update_dpp(0, __float_as_int(x), (ctrl), (rmask), 0xF, true))
__device__ __forceinline__ float wave_scan(float x) {
    x += DPPF(x, 0x111, 0xF); x += DPPF(x, 0x112, 0xF); x += DPPF(x, 0x114, 0xF); x += DPPF(x, 0x118, 0xF);
    x += DPPF(x, 0x142, 0xA);
    x += DPPF(x, 0x143, 0xC);
    return x; }
__device__ __forceinline__ void unp8(const v4u w, float (&o)[8]) { o[0] = bflo(w.x); o[1] = bfhi(w.x); o[2] = bflo(w.y); o[3] = bfhi(w.y); o[4] = bflo(w.z); o[5] = bfhi(w.z); o[6] = bflo(w.w); o[7] = bfhi(w.w); }
__device__ __forceinline__ v4u pk8(const float (&o)[8]) { return (v4u){pkbf(o[0], o[1]), pkbf(o[2], o[3]), pkbf(o[4], o[5]), pkbf(o[6], o[7])}; }
}
struct RwX { bf16* P1; bf16* GT; bf16* Y0; bf16* H; bf16* VB0; bf16* VB1; float* GE; bf16* G; };
__device__ __forceinline__ void p6a_rwkv_local(Frame& F, const RwArgs& A, const RwX& X) {
    using namespace rwk;
    LAS unsigned char* lds = F.lds + RING_OFF;
    LAS float* part = (LAS float*)(F.lds + LDSCTL_OFF + 128);
    LAS float* cst = (LAS float*)(F.lds + LDSCTL_OFF + 128 + 4096 + 896);
    const int lane = F.lane, fr = lane & 15, fq = lane >> 4, w = F.wave, m0 = 16 * (w >> 1), n0a = 32 * (w & 1);
    const int fm = swz(m0 + fr, fq * 16);
    const int ta0 = swz(8 * fq + (fr >> 2), 2 * (m0 + 4 * (fr & 3))), ta1 = swz(8 * fq + 4 + (fr >> 2), 2 * (m0 + 4 * (fr & 3)));
    int fn[2], orm[2], otr[2], tb0[2], tb1[2];
#pragma unroll
    for (int t = 0; t < 2; ++t) { const int n0 = n0a + 16 * t; fn[t] = swz(n0 + fr, fq * 16); orm[t] = swz(m0 + fr, 2 * (n0 + 4 * fq)); otr[t] = swz(n0 + fr, 2 * (m0 + 4 * fq));
        tb0[t] = swz(8 * fq + (fr >> 2), 2 * (n0 + 4 * (fr & 3))); tb1[t] = swz(8 * fq + 4 + (fr >> 2), 2 * (n0 + 4 * (fr & 3))); }
    const int NJ = BATCH * NH * (SEQ / 64);
    const int tid = F.tid, ltok = tid >> 3, ldg = tid & 7;
    v4u g_r, g_k, g_v, g_xw, g_xa, g_xg0, g_xg1, g_pr;
#define P6A_LOAD(jj) do { const int u_ = (jj) >> 5, c_ = (jj) & 31; const size_t gr_ = (size_t)(u_ >> 3) * SEQ + c_ * 64 + ltok; const int cb_ = 64 * (u_ & 7) + 8 * ldg; const bf16* rp_ = A.RW + gr_ * RWP; \
        g_r = *(const v4u*)(rp_ + cb_); g_k = *(const v4u*)(rp_ + 512 + cb_); g_v = *(const v4u*)(rp_ + 1024 + cb_); \
        g_xw = *(const v4u*)(rp_ + 1536 + 8 * ldg); g_xa = *(const v4u*)(rp_ + 1600 + 8 * ldg); g_xg0 = *(const v4u*)(rp_ + 1664 + 8 * ldg); g_xg1 = *(const v4u*)(rp_ + 1728 + 8 * ldg); \
        g_pr = (v4u){0u, 0u, 0u, 0u}; if (ltok < 7 && c_ > 0) g_pr = *(const v4u*)(A.RW + ((size_t)(u_ >> 3) * SEQ + c_ * 64 - 1) * RWP + (ltok < 3 ? 512 * ltok + cb_ : 1536 + 64 * (ltok - 3) + 8 * ldg)); } while (0)
    if ((int)blockIdx.x < NJ) P6A_LOAD((int)blockIdx.x);
    int hcur = -1;
    LAS unsigned char* prow = (LAS unsigned char*)(F.lds + LDSCTL_OFF + 128 + 4096);
    if (tid < 256) cst[512 + tid] = A.mu[1536 + tid];
    u32x2g s_p1[2], s_gt[2], s_y0[2], s_hh[2]; size_t s_jo = 0; bool s_have = false;
#define P6A_STORE() do { _Pragma("unroll") for (int t = 0; t < 2; ++t) { \
            *(u32x2g*)(X.P1 + s_jo + ((w * 2 + t) * 64 + lane) * 4) = s_p1[t]; *(u32x2g*)(X.GT + s_jo + ((w * 2 + t) * 64 + lane) * 4) = s_gt[t]; \
            *(u32x2g*)(X.Y0 + s_jo + ((w * 2 + t) * 64 + lane) * 4) = s_y0[t]; *(u32x2g*)(X.H + s_jo + ((w * 2 + t) * 64 + lane) * 4) = s_hh[t]; } } while (0)
    for (int job = blockIdx.x; job < NJ; job += F.G) {
        const int unit = job >> 5, c = job & 31; const int h = unit & 7; const int cb = 64 * h + 8 * w; const size_t jo = (size_t)job * 4096;
        {
            const int so = swz(ltok, 16 * ldg);
            *(LAS v4u*)(RSL(12) + so) = g_r; *(LAS v4u*)(RSL(2) + so) = g_k; *(LAS v4u*)(RSL(0) + so) = g_v;
            *(LAS v4u*)(RSL(14) + so) = g_xw; *(LAS v4u*)(RSL(13) + so) = g_xa; *(LAS v4u*)(RSL(7) + so) = g_xg0; *(LAS v4u*)(RSL(18) + so) = g_xg1;
            if (ltok < 7) *(LAS v4u*)(prow + ltok * 128 + 16 * ldg) = g_pr;
            if (h != hcur) {
                *(LAS v4u*)(RSL(16) + so) = *(const v4u*)(A.W2T + (size_t)(64 * h + ltok) * 64 + 8 * ldg); *(LAS v4u*)(RSL(17) + so) = *(const v4u*)(A.A2T + (size_t)(64 * h + ltok) * 64 + 8 * ldg);
                *(LAS v4u*)(RSL(10) + so) = *(const v4u*)(A.G2T + (size_t)(64 * h + ltok) * 128 + 8 * ldg); *(LAS v4u*)(RSL(11) + so) = *(const v4u*)(A.G2T + (size_t)(64 * h + ltok) * 128 + 64 + 8 * ldg);
                { const int a_ = tid >> 6, i_ = tid & 63;
                  const float* src_ = (a_ == 0) ? A.mu : (a_ == 1) ? A.mu + 512 : (a_ == 2) ? A.mu + 1024 : (a_ == 3) ? A.k_k : (a_ == 4) ? A.k_a : (a_ == 5) ? A.r_k : (a_ == 6) ? A.w0 : A.a0;
                  cst[a_ * 64 + i_] = src_[64 * h + i_]; } }
            hcur = h;
        }
        if (s_have) P6A_STORE();
        { const int nj = job + F.G; if (nj < NJ) P6A_LOAD(nj); }
        LBAR();
        float r[8], k[8], v[8];
        {
            const int so = swz(lane, 16 * w), sp = swz((lane + 63) & 63, 16 * w);
#define P6A_SHIFT(slot, pi, moff, dst) do { float c_[8], p_[8], m_[8]; v4u wc_ = *(const LAS v4u*)(RSL(slot) + so), wp_ = *(const LAS v4u*)(RSL(slot) + sp); \
                if (lane == 0) wp_ = *(const LAS v4u*)(prow + 128 * (pi) + 16 * w); \
                unp8(wc_, c_); unp8(wp_, p_); ld8l(cst + (moff) + 8 * w, m_); \
                _Pragma("unroll") for (int j = 0; j < 8; ++j) dst[j] = c_[j] + (p_[j] - c_[j]) * m_[j]; } while (0)
            P6A_SHIFT(12, 0, 0, r);
            P6A_SHIFT(2, 1, 64, k);
            P6A_SHIFT(0, 2, 128, v); asm volatile("" ::: "memory");
            { float x_[8]; P6A_SHIFT(14, 3, 512, x_);
#pragma unroll
              for (int j = 0; j < 8; ++j) x_[j] = 2.0f * pg8::sigmoid_f(2.0f * x_[j]) - 1.0f;
              *(LAS v4u*)(RSL(14) + so) = pk8(x_); }
            { float x_[8]; P6A_SHIFT(13, 4, 576, x_); *(LAS v4u*)(RSL(13) + so) = pk8(x_); } asm volatile("" ::: "memory");
            { float x_[8]; P6A_SHIFT(7, 5, 640, x_);
#pragma unroll
              for (int j = 0; j < 8; ++j) x_[j] = pg8::sigmoid_f(x_[j]);
              *(LAS v4u*)(RSL(7) + so) = pk8(x_); }
            { float x_[8]; P6A_SHIFT(18, 6, 704, x_);
#pragma unroll
              for (int j = 0; j < 8; ++j) x_[j] = pg8::sigmoid_f(x_[j]);
              *(LAS v4u*)(RSL(18) + so) = pk8(x_); }
#undef P6A_SHIFT
        }
        LBAR();
        {
            const f32x4 z4 = (f32x4){0.f, 0.f, 0.f, 0.f};
            {   const Fr2 aW = ldf(RSL(14), fm), aA = ldf(RSL(13), fm); Fr2 bW[2], bA[2];
#pragma unroll
                for (int t = 0; t < 2; ++t) { bW[t] = ldf(RSL(16), fn[t]); bA[t] = ldf(RSL(17), fn[t]); }
#pragma unroll
                for (int t = 0; t < 2; ++t) { const int row = m0 + fr, ch = n0a + 16 * t + 4 * fq; const f32x4 lwq = mm<true>(aW, bW[t], z4), alq = mm<true>(aA, bA[t], z4);
                    const f32x4 w0c = *(const LAS f32x4*)(cst + 384 + ch), a0c = *(const LAS f32x4*)(cst + 448 + ch); f32x4 lwv, alv;
#pragma unroll
                    for (int x = 0; x < 4; ++x) { lwv[x] = -0.6065306597126334f * pg8::sigmoid_f(w0c[x] + lwq[x]); alv[x] = pg8::sigmoid_f(a0c[x] + alq[x]); }
                    const int fo = row * 256 + (((ch >> 3) ^ (row & 7)) << 5) + ((ch >> 2) & 1) * 16;
                    *(LAS f32x4*)(RSL(4) + fo) = lwv; *(LAS f32x4*)(RSL(8) + fo) = alv; } }
            asm volatile("" ::: "memory");
            {   const Fr2 aG0 = ldf(RSL(7), fm), aG1 = ldf(RSL(18), fm); Fr2 bG0[2], bG1[2];
#pragma unroll
                for (int t = 0; t < 2; ++t) { bG0[t] = ldf(RSL(10), fn[t]); bG1[t] = ldf(RSL(11), fn[t]); }
#pragma unroll
                for (int t = 0; t < 2; ++t) st4(RSL(3), orm[t], mm<true>(aG1, bG1[t], mm<true>(aG0, bG0[t], z4))); }
        }
        LBAR();
        float kf[8], kk[8], al[8], lw[8]; float ssp = 0.f, bpp = 0.f;
        {
            { const int fo = lane * 256 + ((w ^ (lane & 7)) << 5); const f32x4 a_ = *(const LAS f32x4*)(RSL(4) + fo), b_ = *(const LAS f32x4*)(RSL(4) + fo + 16), c_ = *(const LAS f32x4*)(RSL(8) + fo), d_ = *(const LAS f32x4*)(RSL(8) + fo + 16);
              lw[0] = a_.x; lw[1] = a_.y; lw[2] = a_.z; lw[3] = a_.w; lw[4] = b_.x; lw[5] = b_.y; lw[6] = b_.z; lw[7] = b_.w;
              al[0] = c_.x; al[1] = c_.y; al[2] = c_.z; al[3] = c_.w; al[4] = d_.x; al[5] = d_.y; al[6] = d_.z; al[7] = d_.w; }
            *(v4u*)(X.G + jo + tid * 8) = *(const LAS v4u*)(RSL(3) + swz(ltok, 16 * ldg));
            float kkc[8], kac[8], rkc[8]; ld8l(cst + 192 + 8 * w, kkc); ld8l(cst + 256 + 8 * w, kac); ld8l(cst + 320 + 8 * w, rkc);
#pragma unroll
            for (int j = 0; j < 8; ++j) { kk[j] = k[j] * kkc[j]; ssp += kk[j] * kk[j]; kf[j] = k[j] * (1.0f + (al[j] - 1.0f) * kac[j]); bpp += r[j] * kf[j] * rkc[j]; }
            part[w * 64 + lane] = ssp; part[512 + w * 64 + lane] = bpp;
        }
        LBAR();
        {
            float ss = 0.f, bon = 0.f;
#pragma unroll
            for (int i = 0; i < 8; ++i) { ss += part[i * 64 + lane]; bon += part[512 + i * 64 + lane]; }
            const float inv = 1.0f / fmaxf(sqrtf(ss), 1e-12f);
            float at[8], rt[8], bt[8], kt[8], bh[8], kh[8], ge[8], vb[8];
#pragma unroll
            for (int j = 0; j < 8; ++j) {
                const float cs = wave_scan(lw[j]);
                const float ce = __int_as_float(__builtin_amdgcn_readlane(__float_as_int(cs), 63));
                const float e_cs = __builtin_amdgcn_exp2f(cs * 1.4426950408889634f), e_csm = __builtin_amdgcn_exp2f((cs - lw[j]) * 1.4426950408889634f);
                const float e_neg = __builtin_amdgcn_rcpf(e_cs), e_end = __builtin_amdgcn_exp2f((ce - cs) * 1.4426950408889634f);
                const float kn = kk[j] * inv, bb = kn * al[j];
                at[j] = -kn * e_csm; rt[j] = r[j] * e_cs; bt[j] = bb * e_neg; kt[j] = kf[j] * e_neg; bh[j] = bb * e_end; kh[j] = kf[j] * e_end; ge[j] = e_cs; vb[j] = bon * v[j];
            }
            const int ro = swz(lane, 16 * w);
            *(LAS v4u*)(RSL(0) + ro) = pk8(at); *(LAS v4u*)(RSL(1) + ro) = pk8(rt); *(LAS v4u*)(RSL(2) + ro) = pk8(bt); *(LAS v4u*)(RSL(3) + ro) = pk8(kt);
            *(LAS v4u*)(RSL(4) + ro) = pk8(bh); *(LAS v4u*)(RSL(5) + ro) = pk8(kh); *(LAS v4u*)(RSL(6) + ro) = pk8(v);
            if (lane == 63) { *(f32x4*)(X.GE + (size_t)job * 64 + 8 * w) = (f32x4){ge[0], ge[1], ge[2], ge[3]}; *(f32x4*)(X.GE + (size_t)job * 64 + 8 * w + 4) = (f32x4){ge[4], ge[5], ge[6], ge[7]}; }
            *(LAS v4u*)(RSL(18) + ro) = pk8(vb);
        }
        LBAR();
        {
            { bf16* vbp = (job < 2048) ? (X.VB0 + jo) : (X.VB1 + (jo - (size_t)2048 * 4096)); *(v4u*)(vbp + tid * 8) = *(const LAS v4u*)(RSL(18) + swz(ltok, 16 * ldg)); }
            const f32x4 z4 = (f32x4){0.f, 0.f, 0.f, 0.f};
            const Fr2 aA = ldf(RSL(0), fm), aR = ldf(RSL(1), fm); Fr2 bB[2], bK[2];
#pragma unroll
            for (int t = 0; t < 2; ++t) { bB[t] = ldf(RSL(2), fn[t]); bK[t] = ldf(RSL(3), fn[t]); }
            f32x4 nab[2], nabT[2], nak[2], mrb[2], mrk[2];
#pragma unroll
            for (int t = 0; t < 2; ++t) { nab[t] = mm<true>(aA, bB[t], z4); nabT[t] = mm<false>(aA, bB[t], z4); nak[t] = mm<true>(aA, bK[t], z4); mrb[t] = mm<true>(aR, bB[t], z4); mrk[t] = mm<true>(aR, bK[t], z4); }
#pragma unroll
            for (int t = 0; t < 2; ++t) { const int n0 = n0a + 16 * t;
#pragma unroll
                for (int x = 0; x < 4; ++x) { const int i = m0 + fr, j = n0 + 4 * fq + x;
                    if (j >= i) { nab[t][x] = 0.f; nak[t][x] = 0.f; } if (j > i) { mrb[t][x] = 0.f; mrk[t][x] = 0.f; }
                    const int it = m0 + 4 * fq + x, jt = n0 + fr; if (jt >= it) nabT[t][x] = 0.f; }
                st4(RSL(12), orm[t], nab[t]);
                st4(RSL(7), orm[t], nak[t]); st4(RSL(8), orm[t], mrb[t]); st4(RSL(9), orm[t], mrk[t]); }
            const int dsel = (w == 2 || w == 7) ? 1 : 0;
            if (w == 0 || w == 2 || w == 5 || w == 7) {
                const f32x4 dPT = dsel ? nab[1] : nab[0], dP = dsel ? nabT[1] : nabT[0];
                f32x4 XT;
#pragma unroll
                for (int x = 0; x < 4; ++x) XT[x] = dPT[x] + ((4 * fq + x == fr) ? 1.0f : 0.f);
                const s16x4 bP = cv4(dP), bPT = cv4(dPT);
                const f32x4 P2 = M16(bPT, bP, z4), P2T = M16(bP, bPT, z4);
                const s16x4 bP2 = cv4(P2), bP2T = cv4(P2T);
                XT = M16(bP2, cv4(XT), XT);
                const f32x4 P4 = M16(bP2T, bP2, z4), P4T = M16(bP2, bP2T, z4);
                const s16x4 bP4 = cv4(P4), bP4T = cv4(P4T);
                XT = M16(bP4, cv4(XT), XT);
                const f32x4 P8 = M16(bP4T, bP4, z4);
                XT = M16(cv4(P8), cv4(XT), XT);
                *(LAS s16x4*)(RSL(13) + (m0 >> 4) * 512 + fr * 32 + fq * 8) = cv4(XT);
            }
        }
        LBAR();
        {
            const f32x4 z4 = (f32x4){0.f, 0.f, 0.f, 0.f};
            const int cs = 16 * (w & 3);
            s16x4 tA[4], nA[6];
#pragma unroll
            for (int i = 0; i < 4; ++i) tA[i] = *(const LAS s16x4*)(RSL(13) + i * 512 + fr * 32 + fq * 8);
            {   int q = 0;
#pragma unroll
                for (int i = 1; i < 4; ++i)
#pragma unroll
                    for (int j = 0; j < i; ++j) nA[q++] = *(const LAS s16x4*)(RSL(12) + swz(16 * i + fr, 2 * (16 * j + 4 * fq))); }
            f32x4 acc[4];
            if (w < 4) {
#pragma unroll
                for (int i = 0; i < 4; ++i) { const s16x4 r = trd(RSL(0) + swz(16 * i + 4 * fq + (fr >> 2), 2 * (cs + 4 * (fr & 3))));
                    acc[i] = (f32x4){bf1(r[0]), bf1(r[1]), bf1(r[2]), bf1(r[3])}; }
            } else {
                s16x4 vB[4], kA[10];
#pragma unroll
                for (int j = 0; j < 4; ++j) vB[j] = trd(RSL(6) + swz(16 * j + 4 * fq + (fr >> 2), 2 * (cs + 4 * (fr & 3))));
                {   int q = 0;
#pragma unroll
                    for (int i = 0; i < 4; ++i)
#pragma unroll
                        for (int j = 0; j <= i; ++j) kA[q++] = *(const LAS s16x4*)(RSL(7) + swz(16 * i + fr, 2 * (16 * j + 4 * fq))); }
                {   int q = 0;
#pragma unroll
                    for (int i = 0; i < 4; ++i) { acc[i] = z4;
#pragma unroll
                        for (int j = 0; j <= i; ++j) acc[i] = M16(kA[q++], vB[j], acc[i]); } }
            }
            s16x4 yB[4];
            {   int q = 0;
#pragma unroll
                for (int i = 0; i < 4; ++i) {
#pragma unroll
                    for (int j = 0; j < i; ++j) acc[i] = M16(nA[q++], yB[j], acc[i]);
                    const f32x4 y = M16(tA[i], cv4(acc[i]), z4); yB[i] = cv4(y);
                    *(LAS s16x4*)(RSL(w < 4 ? 3 : 15) + swz(cs + fr, 2 * (16 * i + 4 * fq))) = yB[i]; } }
        }
        LBAR();
        {
            const f32x4 z4 = (f32x4){0.f, 0.f, 0.f, 0.f};
            f32x4 p1[2], y0[2], gt[2], hh[2];
            {   const Fr2 aMb = ldf(RSL(8), fm), aMk = ldf(RSL(9), fm); Fr2 bW[2], bU[2], bV[2]; f32x4 cR[2];
#pragma unroll
                for (int t = 0; t < 2; ++t) { bW[t] = ldf(RSL(3), fn[t]); bU[t] = ldf(RSL(15), fn[t]); bV[t] = ldt(RSL(6), tb0[t], tb1[t]); cR[t] = ld4(RSL(1), orm[t]); }
#pragma unroll
                for (int t = 0; t < 2; ++t) { p1[t] = mm<true>(aMb, bW[t], cR[t]); y0[t] = mm<true>(aMk, bV[t], mm<true>(aMb, bU[t], z4)); } }
            {   const Fr2 aW = ldf(RSL(3), fm), aU = ldf(RSL(15), fm), aV = ldt(RSL(6), ta0, ta1); Fr2 bBh[2], bKh[2];
#pragma unroll
                for (int t = 0; t < 2; ++t) { bBh[t] = ldt(RSL(4), tb0[t], tb1[t]); bKh[t] = ldt(RSL(5), tb0[t], tb1[t]); }
#pragma unroll
                for (int t = 0; t < 2; ++t) { gt[t] = mm<false>(aW, bBh[t], z4); hh[t] = mm<true>(aV, bKh[t], mm<true>(aU, bBh[t], z4)); } }
#pragma unroll
            for (int t = 0; t < 2; ++t) {
                s_p1[t].x = pkbf(p1[t][0], p1[t][1]); s_p1[t].y = pkbf(p1[t][2], p1[t][3]); s_gt[t].x = pkbf(gt[t][0], gt[t][1]); s_gt[t].y = pkbf(gt[t][2], gt[t][3]);
                s_y0[t].x = pkbf(y0[t][0], y0[t][1]); s_y0[t].y = pkbf(y0[t][2], y0[t][3]); s_hh[t].x = pkbf(hh[t][0], hh[t][1]); s_hh[t].y = pkbf(hh[t][2], hh[t][3]); }
            s_jo = jo; s_have = true;
        }
    }
    if (s_have) P6A_STORE();
#undef P6A_LOAD
#undef P6A_STORE
    LBAR();
}
__device__ __forceinline__ void p6b_rwkv_seq(Frame& F, const RwArgs& A, const RwX& X, int nwg) {
    using namespace rwk;
    LAS unsigned char* lds = F.lds + RING_OFF;
    constexpr int YLD = 68, NC = SEQ / 64;
    LAS float* Yf0 = (LAS float*)RSL(6);
    LAS float* gel = (LAS float*)RSL(14); LAS float* lnl = gel + 128;
    const int tid = F.tid, lane = F.lane, fr = lane & 15, fq = lane >> 4;
    const int w = F.wave, ws = w & 3;
    const int t2 = tid & 255, otok = t2 >> 2, oq = t2 & 3;
    for (int unit = blockIdx.x; unit < BATCH * NH; unit += nwg) {
        const int b = unit >> 3, h = unit & 7; const int cb = 64 * h + 16 * oq;
        if (tid < 128) lnl[tid] = (tid < 64) ? A.ln_w[64 * h + tid] : A.ln_b[64 * h + tid - 64];
        if (w < 4) {
            int orm[4], otr[4];
#pragma unroll
            for (int i = 0; i < 4; ++i) { orm[i] = swz(16 * ws + fr, 2 * (16 * i + 4 * fq)); otr[i] = swz(16 * i + fr, 2 * (16 * ws + 4 * fq)); }
            f32x4 sT[4];
#pragma unroll
            for (int jb = 0; jb < 4; ++jb) sT[jb] = (f32x4){0.f, 0.f, 0.f, 0.f};
            struct Nx { u32x2g p1[4], gt[4], y0[4], h[4]; float ge; };
            Nx nA, nB, nC;
#define P6B_LOAD(cc, N) do { const int job_ = unit * 32 + (cc); const size_t jo_ = (size_t)job_ * 4096; \
                _Pragma("unroll") for (int i = 0; i < 4; ++i) { const int fo_ = ((4 * ws + i) * 64 + lane) * 4; \
                    N.p1[i] = *(const u32x2g*)(X.P1 + jo_ + fo_); N.gt[i] = *(const u32x2g*)(X.GT + jo_ + fo_); N.y0[i] = *(const u32x2g*)(X.Y0 + jo_ + fo_); N.h[i] = *(const u32x2g*)(X.H + jo_ + fo_); } \
                if (w == 0) N.ge = X.GE[(size_t)job_ * 64 + lane]; } while (0)
#define P6B_STEP(c, N) do { if ((c) >= NC) break; const int par = (c) & 1; \
                _Pragma("unroll") for (int i = 0; i < 4; ++i) { *(LAS u32x2g*)(RSL(par) + orm[i]) = N.p1[i]; *(LAS u32x2g*)(RSL(2 + par) + otr[i]) = N.gt[i]; *(LAS u32x2g*)(RSL(4 + par) + orm[i]) = N.y0[i]; } \
                if (w == 0) gel[par * 64 + lane] = N.ge; \
                u32x2g hc[4]; _Pragma("unroll") for (int i = 0; i < 4; ++i) hc[i] = N.h[i]; \
                if ((c) + 3 < NC) P6B_LOAD((c) + 3, N); \
                LBAR(); \
                s16x4 sb[4]; _Pragma("unroll") for (int jb = 0; jb < 4; ++jb) sb[jb] = cv4(sT[jb]);                     \
                _Pragma("unroll") for (int tb = 0; tb < 4; ++tb) { \
                    const s16x4 y0r = trd(RSL(4 + par) + swz(16 * tb + 4 * fq + (fr >> 2), 2 * (16 * ws + 4 * (fr & 3))));       \
                    f32x4 ya = (f32x4){bf1(y0r[0]), bf1(y0r[1]), bf1(y0r[2]), bf1(y0r[3])}; \
                    _Pragma("unroll") for (int jb = 0; jb < 4; ++jb) ya = M16(*(const LAS s16x4*)(RSL(par) + swz(16 * tb + fr, 2 * (16 * jb + 4 * fq))), sb[jb], ya); \
                    _Pragma("unroll") for (int x = 0; x < 4; ++x) Yf0[par * (64 * YLD) + (16 * tb + 4 * fq + x) * YLD + 16 * ws + fr] = ya[x]; } \
                _Pragma("unroll") for (int jb = 0; jb < 4; ++jb) { \
                    const f32x4 gej = *(const LAS f32x4*)(gel + par * 64 + 16 * jb + 4 * fq); \
                    f32x4 sa = sT[jb] * gej + (f32x4){bflo(hc[jb].x), bfhi(hc[jb].x), bflo(hc[jb].y), bfhi(hc[jb].y)}; \
                    _Pragma("unroll") for (int kb = 0; kb < 4; ++kb) sa = M16(*(const LAS s16x4*)(RSL(2 + par) + swz(16 * jb + fr, 2 * (16 * kb + 4 * fq))), sb[kb], sa); \
                    sT[jb] = sa; } } while (0)
            P6B_LOAD(0, nA); P6B_LOAD(1, nB); P6B_LOAD(2, nC);
            for (int c = 0; c < NC; c += 3) { P6B_STEP(c, nA); P6B_STEP(c + 1, nB); P6B_STEP(c + 2, nC); }
#undef P6B_STEP
#undef P6B_LOAD
            LBAR();
        } else {
#define P6B_LOADV(cc, V) do { const int job_ = unit * 32 + (cc); const size_t jo_ = (size_t)job_ * 4096; const bf16* vbp_ = (job_ < 2048) ? (X.VB0 + jo_) : (X.VB1 + (jo_ - (size_t)2048 * 4096)); \
                _Pragma("unroll") for (int q = 0; q < 2; ++q) { V[q] = *(const v4u*)(vbp_ + otok * 64 + 16 * oq + 8 * q); V[2 + q] = *(const v4u*)(X.G + jo_ + otok * 64 + 16 * oq + 8 * q); } } while (0)
#define P6B_OUT(par, V, grow_) do { float y[16]; \
                { float t8[8]; ld8l(Yf0 + (par) * (64 * YLD) + otok * YLD + 16 * oq, t8); _Pragma("unroll") for (int j = 0; j < 8; ++j) y[j] = t8[j]; \
                  ld8l(Yf0 + (par) * (64 * YLD) + otok * YLD + 16 * oq + 8, t8); _Pragma("unroll") for (int j = 0; j < 8; ++j) y[8 + j] = t8[j]; } \
                float s_ = 0.f; _Pragma("unroll") for (int j = 0; j < 16; ++j) s_ += y[j]; \
                s_ = DPP_ADD(s_, 0xB1); s_ = DPP_ADD(s_, 0x4E); const float mean = s_ * (1.0f / 64.0f); float q_ = 0.f; \
                _Pragma("unroll") for (int j = 0; j < 16; ++j) { y[j] -= mean; q_ += y[j] * y[j]; } \
                q_ = DPP_ADD(q_, 0xB1); q_ = DPP_ADD(q_, 0x4E); const float rstd = __builtin_amdgcn_rsqf(q_ * (1.0f / 64.0f) + LNX_EPS); \
                _Pragma("unroll") for (int q = 0; q < 2; ++q) { float gg[8], vv[8], ov[8], lw_[8], lb_[8]; unp8(V[2 + q], gg); unp8(V[q], vv); ld8l(lnl + 16 * oq + 8 * q, lw_); ld8l(lnl + 64 + 16 * oq + 8 * q, lb_); \
                    _Pragma("unroll") for (int j = 0; j < 8; ++j) ov[j] = (y[8 * q + j] * rstd * lw_[j] + lb_[j] + vv[j]) * gg[j]; \
                    *(GAS v4u*)(A.QO + (size_t)(grow_) * D + 512 + cb + 8 * q) = pk8(ov); } } while (0)
#define P6B_STEP(c, SV) do { if ((c) >= NC) break; \
                LBAR(); \
                if ((c) > 0) { P6B_OUT(((c) - 1) & 1, SV, b * SEQ + ((c) - 1) * 64 + otok);         \
                               if ((c) + 2 < NC) P6B_LOADV((c) + 2, SV); } } while (0)
            v4u v0[4], v1[4], v2[4];
            P6B_LOADV(0, v0); P6B_LOADV(1, v1); P6B_LOADV(2, v2);
            for (int c = 0; c < NC; c += 3) { P6B_STEP(c, v2); P6B_STEP(c + 1, v0); P6B_STEP(c + 2, v1); }
#undef P6B_STEP
            LBAR();
            P6B_OUT((NC - 1) & 1, v1, b * SEQ + (NC - 1) * 64 + otok);
#undef P6B_LOADV
#undef P6B_OUT
        }
        LBAR();
    }
}

namespace sba {
using bf16x8 = __attribute__((ext_vector_type(8))) short;
using s16x4 = __attribute__((ext_vector_type(4))) short;
using f32x16 = __attribute__((ext_vector_type(16))) float;
using u32x4 = __attribute__((ext_vector_type(4))) unsigned;
constexpr int QB = 256, KVBLK = 64;
constexpr int LDS_K = 0, LDS_V = 16384, LDS_ST = 32768, ST_LD = 68, LDS_FLAG = LDS_ST + 8 * 32 * ST_LD * 4, LDS_BYTES_ATT = LDS_FLAG + 64;
constexpr float R_DEAD = -160.0f;
#define SBAR() __builtin_amdgcn_sched_barrier(0)
typedef float f32x2_t __attribute__((ext_vector_type(2))); typedef __bf16 bf16x2_t __attribute__((ext_vector_type(2)));
__device__ __forceinline__ unsigned cvtpk_s(float lo, float hi) { f32x2_t v = {lo, hi}; bf16x2_t b = __builtin_convertvector(v, bf16x2_t); return __builtin_bit_cast(unsigned, b); }
__device__ __forceinline__ void qkt(f32x16& p0, f32x16& p1, const char* Kslot, const bf16x8* qr, int r32, int hi) {
    const char* kb = Kslot + hi * 1024 + r32 * 16;
    const f32x16 z = f32x16{};
#pragma unroll
    for (int d0 = 0; d0 < 4; ++d0) {
        const bf16x8 b0 = *reinterpret_cast<const bf16x8*>(kb + d0 * 2048);
        const bf16x8 b1 = *reinterpret_cast<const bf16x8*>(kb + d0 * 2048 + 512);
        if (d0 == 0) { p0 = __builtin_amdgcn_mfma_f32_32x32x16_bf16(b0, qr[0], z, 0, 0, 0); p1 = __builtin_amdgcn_mfma_f32_32x32x16_bf16(b1, qr[0], z, 0, 0, 0); }
        else { p0 = __builtin_amdgcn_mfma_f32_32x32x16_bf16(b0, qr[d0], p0, 0, 0, 0); p1 = __builtin_amdgcn_mfma_f32_32x32x16_bf16(b1, qr[d0], p1, 0, 0, 0); }
    }
}
__device__ __forceinline__ void pv(f32x16* o, int vb, bf16x8 pa0, bf16x8 pa1, bf16x8 pa2, bf16x8 pa3) {
#pragma unroll
    for (int d0 = 0; d0 < 2; ++d0) { s16x4 lo[4], hi[4];
#pragma unroll
        for (int ks = 0; ks < 4; ++ks) {
            asm volatile("ds_read_b64_tr_b16 %0,%1 offset:%c2" : "=&v"(lo[ks]) : "v"(vb), "i"(d0 * 4096 + ks * 1024) : "memory");
            asm volatile("ds_read_b64_tr_b16 %0,%1 offset:%c2" : "=&v"(hi[ks]) : "v"(vb), "i"(d0 * 4096 + ks * 1024 + 512) : "memory"); }
        asm volatile("s_waitcnt lgkmcnt(0)" ::: "memory"); SBAR();
#define PK(k) (bf16x8){lo[k][0], lo[k][1], lo[k][2], lo[k][3], hi[k][0], hi[k][1], hi[k][2], hi[k][3]}
        o[d0] = __builtin_amdgcn_mfma_f32_32x32x16_bf16(pa0, PK(0), o[d0], 0, 0, 0);
        o[d0] = __builtin_amdgcn_mfma_f32_32x32x16_bf16(pa1, PK(1), o[d0], 0, 0, 0);
        o[d0] = __builtin_amdgcn_mfma_f32_32x32x16_bf16(pa2, PK(2), o[d0], 0, 0, 0);
        o[d0] = __builtin_amdgcn_mfma_f32_32x32x16_bf16(pa3, PK(3), o[d0], 0, 0, 0);
#undef PK
    }
}
__device__ __forceinline__ float swap_sum(float x, float& other_if_lo, int hi) {
    auto rr = __builtin_amdgcn_permlane32_swap(__float_as_uint(x), __float_as_uint(x), false, false);
    const float a = __uint_as_float(rr[0]), b = __uint_as_float(rr[1]);
    other_if_lo = hi ? 0.f : b;
    return a + b;
}
__device__ __forceinline__ float swap_prod(float x, float& other_if_lo, int hi) {
    auto rr = __builtin_amdgcn_permlane32_swap(__float_as_uint(x), __float_as_uint(x), false, false);
    const float a = __uint_as_float(rr[0]), b = __uint_as_float(rr[1]);
    other_if_lo = hi ? 1.0f : b;
    return a * b;
}
__device__ __forceinline__ void attn_wave_unit(int b, int h, int qblk, bf16* QO, const bf16* __restrict__ KB, const bf16* __restrict__ VB, const float* gout, char* wsm  ) {
    const int lane = threadIdx.x & 63, r32 = lane & 31, hi = lane >> 5;
    const long rowbase = (long)b * SEQ; const int q0 = qblk * 32;
    bf16* Qw = QO + (rowbase + q0) * D + h * HD;
    const bf16* Kh = KB + rowbase * SBW + h * HD; const bf16* Vh = VB + rowbase * SBW + h * HD;
    const unsigned lds0 = (unsigned)(uintptr_t)wsm;
    const int jtop = (q0 + 30) >> 6;
    const bf16* vsrc = Vh + (long)(lane >> 3) * SBW + (lane & 7) * 8;
    const int vdst0 = ((lane & 7) >> 2) * 4096 + ((lane >> 3) & 15) * 64 + (lane & 3) * 16;
    const int vb0 = (int)lds0 + ((lane >> 4) & 1) * 32 + (lane & 3) * 8 + (4 * hi + ((lane & 15) >> 2)) * 64;
    const bf16* ksrc = Kh + (long)(lane >> 3) * SBW + (lane & 7) * 8;
    const int kdst0 = 8192 + (lane >> 3) * 128 + (((lane & 7) ^ ((lane >> 3) & 7)) << 4);
    const int kfo = 8192 + r32 * 128, kx = r32 & 7;
    bf16x8 qr[4]; u32x4 kg[8], vr[8];
    {   u32x4 qg[4];
#pragma unroll
        for (int i = 0; i < 4; ++i) qg[i] = *(const u32x4*)(Qw + (long)(8 * i + (lane >> 3)) * D + (lane & 7) * 8);
#define SBA_LOAD(t) do { const bf16* kp_ = ksrc + (long)(t) * KVBLK * SBW; const bf16* vp_ = vsrc + (long)(t) * KVBLK * SBW; \
        _Pragma("unroll") for (int i = 0; i < 8; ++i) kg[i] = *(const u32x4*)(kp_ + (long)(8 * i) * SBW); \
        _Pragma("unroll") for (int i = 0; i < 8; ++i) vr[i] = *(const u32x4*)(vp_ + (long)(8 * i) * SBW); } while (0)
        SBA_LOAD(jtop);
#pragma unroll
        for (int i = 0; i < 4; ++i) *(u32x4*)(wsm + kdst0 + i * 1024) = qg[i];
#pragma unroll
        for (int d0 = 0; d0 < 4; ++d0) qr[d0] = *reinterpret_cast<const bf16x8*>(wsm + kfo + (((2 * d0 + hi) ^ kx) << 4));
    }
    float R = 0.f; f32x16 o[2]; o[0] = f32x16{}; o[1] = f32x16{};
    const int qrow = q0 + r32;
    for (int jt = jtop; jt >= 0; --jt) {
#pragma unroll
        for (int i = 0; i < 8; ++i) *(u32x4*)(wsm + kdst0 + i * 1024) = kg[i];
#pragma unroll
        for (int i = 0; i < 8; ++i) *(u32x4*)(wsm + vdst0 + (i >> 1) * 1024 + (i & 1) * 512) = vr[i];
        if (jt > 0) SBA_LOAD(jt - 1);
        bf16x8 kf[8];
#pragma unroll
        for (int d0 = 0; d0 < 4; ++d0) { kf[2 * d0] = *reinterpret_cast<const bf16x8*>(wsm + kfo + (((2 * d0 + hi) ^ kx) << 4)); kf[2 * d0 + 1] = *reinterpret_cast<const bf16x8*>(wsm + kfo + 4096 + (((2 * d0 + hi) ^ kx) << 4)); }
        f32x16 p0, p1;
        {   const f32x16 z = f32x16{};
            p0 = __builtin_amdgcn_mfma_f32_32x32x16_bf16(kf[0], qr[0], z, 0, 0, 0); p1 = __builtin_amdgcn_mfma_f32_32x32x16_bf16(kf[1], qr[0], z, 0, 0, 0);
#pragma unroll
            for (int d0 = 1; d0 < 4; ++d0) { p0 = __builtin_amdgcn_mfma_f32_32x32x16_bf16(kf[2 * d0], qr[d0], p0, 0, 0, 0); p1 = __builtin_amdgcn_mfma_f32_32x32x16_bf16(kf[2 * d0 + 1], qr[d0], p1, 0, 0, 0); } }
        const int kb = 64 * jt + 4 * hi; const bool diag = (jt == jtop);
#pragma unroll
        for (int r = 0; r < 16; ++r) {
            { float rr = __builtin_amdgcn_rcpf(1.0f + __builtin_amdgcn_exp2f(p0[r]));
              if (diag) { const int key = kb + (r & 3) + 8 * (r >> 2); if (key >= qrow) rr = 1.0f; }
              p0[r] = rr; }
            { float rr = __builtin_amdgcn_rcpf(1.0f + __builtin_amdgcn_exp2f(p1[r]));
              if (diag) { const int key = kb + 32 + (r & 3) + 8 * (r >> 2); if (key >= qrow) rr = 1.0f; }
              p1[r] = rr; }
        }
        float c0[4], c1[4], x0[4], x1[4];
#pragma unroll
        for (int g = 0; g < 4; ++g) {
            const float s0 = (p0[4 * g] * p0[4 * g + 1]) * (p0[4 * g + 2] * p0[4 * g + 3]);
            const float s1 = (p1[4 * g] * p1[4 * g + 1]) * (p1[4 * g + 2] * p1[4 * g + 3]);
            c0[g] = swap_prod(s0, x0[g], hi); c1[g] = swap_prod(s1, x1[g], hi);
        }
        const float Cr = __builtin_amdgcn_exp2f(R);
        float suf0[4], suf1[4];
        suf1[3] = Cr; suf1[2] = suf1[3] * c1[3]; suf1[1] = suf1[2] * c1[2]; suf1[0] = suf1[1] * c1[1];
        suf0[3] = suf1[0] * c1[0]; suf0[2] = suf0[3] * c0[3]; suf0[1] = suf0[2] * c0[2]; suf0[0] = suf0[1] * c0[1];
        R += __builtin_amdgcn_logf(((c0[0] * c0[1]) * (c0[2] * c0[3])) * ((c1[0] * c1[1]) * (c1[2] * c1[3])));
#pragma unroll
        for (int g = 0; g < 4; ++g) {
            { const float e3 = suf0[g] * x0[g], e2 = e3 * p0[4 * g + 3], e1 = e2 * p0[4 * g + 2], e0 = e1 * p0[4 * g + 1];
              p0[4 * g + 3] = (1.0f - p0[4 * g + 3]) * e3; p0[4 * g + 2] = (1.0f - p0[4 * g + 2]) * e2; p0[4 * g + 1] = (1.0f - p0[4 * g + 1]) * e1; p0[4 * g] = (1.0f - p0[4 * g]) * e0; }
            { const float e3 = suf1[g] * x1[g], e2 = e3 * p1[4 * g + 3], e1 = e2 * p1[4 * g + 2], e0 = e1 * p1[4 * g + 1];
              p1[4 * g + 3] = (1.0f - p1[4 * g + 3]) * e3; p1[4 * g + 2] = (1.0f - p1[4 * g + 2]) * e2; p1[4 * g + 1] = (1.0f - p1[4 * g + 1]) * e1; p1[4 * g] = (1.0f - p1[4 * g]) * e0; }
        }
#define PKW(P, B) cvtpk_s(P[B], P[B + 1])
        const u32x4 pw0 = (u32x4){PKW(p0, 0), PKW(p0, 2), PKW(p0, 4), PKW(p0, 6)}, pw1 = (u32x4){PKW(p0, 8), PKW(p0, 10), PKW(p0, 12), PKW(p0, 14)};
        const u32x4 pw2 = (u32x4){PKW(p1, 0), PKW(p1, 2), PKW(p1, 4), PKW(p1, 6)}, pw3 = (u32x4){PKW(p1, 8), PKW(p1, 10), PKW(p1, 12), PKW(p1, 14)};
#undef PKW
        SBAR();
        asm volatile("s_waitcnt lgkmcnt(0)" ::: "memory");
        pv(o, vb0, __builtin_bit_cast(bf16x8, pw0), __builtin_bit_cast(bf16x8, pw1), __builtin_bit_cast(bf16x8, pw2), __builtin_bit_cast(bf16x8, pw3));
        if (__all(R < R_DEAD)) break;
    }
#undef SBA_LOAD
    {
        float* stg = (float*)wsm;
        asm volatile("s_waitcnt lgkmcnt(0)" ::: "memory");
#pragma unroll
        for (int r = 0; r < 16; ++r) { const int orow = (r & 3) + 8 * (r >> 2) + 4 * hi;
#pragma unroll
            for (int d0 = 0; d0 < 2; ++d0) stg[orow * ST_LD + d0 * 32 + r32] = o[d0][r]; }
        asm volatile("s_waitcnt lgkmcnt(0)" ::: "memory");
        const int ch = lane & 7;
        const f32x4 ga = *(const f32x4*)(gout + h * HD + ch * 8), gb = *(const f32x4*)(gout + h * HD + ch * 8 + 4);
#pragma unroll
        for (int i = 0; i < 4; ++i) { const int row = i * 8 + (lane >> 3);
            const f32x4 a = *(const f32x4*)(stg + row * ST_LD + ch * 8), c = *(const f32x4*)(stg + row * ST_LD + ch * 8 + 4);
            float ss = (a.x * a.x + a.y * a.y) + (a.z * a.z + a.w * a.w) + (c.x * c.x + c.y * c.y) + (c.z * c.z + c.w * c.w);
            ss = sum8(ss);
            const float hs = __builtin_amdgcn_rsqf(ss * (1.0f / 64.0f) + 1e-6f);
            u32x4 w; w.x = cvtpk_s(a.x * hs * ga.x, a.y * hs * ga.y); w.y = cvtpk_s(a.z * hs * ga.z, a.w * hs * ga.w);
            w.z = cvtpk_s(c.x * hs * gb.x, c.y * hs * gb.y); w.w = cvtpk_s(c.z * hs * gb.z, c.w * hs * gb.w);
            *(u32x4*)(Qw + (long)row * D + ch * 8) = w; }
        asm volatile("s_waitcnt lgkmcnt(0)" ::: "memory");
    }
}
#undef SBAR
__device__ __forceinline__ void attn_phase(Frame& F, bf16* QO, const bf16* KB, const bf16* VB, const float* gout, unsigned* queue, int t0, int t1, int ticket_base) {
    char* wsm = (char*)F.lds + RING_OFF + F.wave * 16384;
    const int nunits = BATCH * NH * (SEQ / 32);
    int pend = -1; int ts0 = t0, ts1 = t1;
    for (;;) {
        int uu;
        if (pend >= 0) { uu = pend; pend = -1; }
        else { unsigned t;
               if (ts0 >= 0) { t = (unsigned)ts0; ts0 = -1; }
               else if (ts1 >= 0) { t = (unsigned)ts1; ts1 = -1; }
               else { t = 0u; if (F.lane == 0) t = __hip_atomic_fetch_add(queue, 1u, __ATOMIC_RELAXED, __HIP_MEMORY_SCOPE_AGENT); t = (unsigned)__builtin_amdgcn_readfirstlane((int)t) + (unsigned)ticket_base; }
               if (2u * t >= (unsigned)nunits) break; uu = (int)(2u * t); pend = uu + 1; }
        attn_wave_unit(uu >> 9, (uu >> 6) & 7, uu & 63, QO, KB, VB, gout, wsm);
    }
    __syncthreads();
}
}

struct Args { const float* in[26]; float* out; unsigned char* ws; int ph_lo, ph_hi, li, pad; };
__global__ void __launch_bounds__(NWAVES * 64, 2) skel_fwd(Args args) {
    extern __shared__ __attribute__((aligned(16))) unsigned char lds[];
    Frame F;
    F.lds = (LAS unsigned char*)lds;
    F.MISC = (volatile LAS unsigned*)(F.lds + MISC_OFF);
    F.tid = threadIdx.x; F.lane = F.tid & 63; F.wave = __builtin_amdgcn_readfirstlane(F.tid >> 6);
    F.G = gridDim.x; { const int bx = blockIdx.x; F.vcu = (F.G % 8 == 0) ? (bx % 8) * (F.G / 8) + bx / 8 : bx; }
    unsigned char* ws = args.ws;
    F.ctl = (gu32*)(ws + WS_CTL);
    const float* x = args.in[0];
    bf16* W1U = (bf16*)(ws + WS_W1U); bf16* W1D = (bf16*)(ws + WS_W1D); bf16* W2U = (bf16*)(ws + WS_W2U); bf16* W2D = (bf16*)(ws + WS_W2D);
    bf16* WIN = (bf16*)(ws + WS_WIN); bf16* WOUT = (bf16*)(ws + WS_WOUT); bf16* WLORA = (bf16*)(ws + WS_WLORA);
    bf16* XB = (bf16*)(ws + WS_XB); bf16* ACT = (bf16*)(ws + WS_ACT); bf16* QO = (bf16*)(ws + WS_QO); bf16* KB = (bf16*)(ws + WS_KB); bf16* VB = (bf16*)(ws + WS_VB);
    bf16* RW = (bf16*)(ws + WS_RW); bf16* ALORA = (bf16*)(ws + WS_ALORA); float* LW = (float*)(ws + WS_LW); bf16* AB = (bf16*)(ws + WS_AB); bf16* GB = (bf16*)(ws + WS_GB);
    float* SSQ = (float*)(ws + WS_SSQ); float* out = args.out;
    for (int u = F.tid; u < (LDS_BYTES - LDSCTL_OFF) / 4; u += NWAVES * 64) ((LAS unsigned*)(F.lds + LDSCTL_OFF))[u] = 0u;
    __syncthreads();
    XcdBarrier bar; bar.bar = (unsigned*)(F.ctl + CW_BAR); bar.x = 0; bar.st = nullptr;
    if (N_LAUNCHES != PER_PHASE) bar = xcd_barrier_post((unsigned*)(F.ctl + CW_BAR), F.MISC + 8);
#define GRID_BAR(seam) do { if (N_LAUNCHES == PER_PHASE) { if (F.tid == 0) __hip_atomic_store(F.ctl + CW_TMO, 0xBADBA0u | (unsigned)(seam), RLX_AGENT); } else { xcd_barrier(bar); } } while (0)
    const int lo = args.ph_lo, hi = args.ph_hi;
#define IN(k) (lo <= (k) && (k) < hi)
#define BOTH(k) (IN(k) && IN((k) + 1))
    if (IN(0)) {
        p0_prologue(F, x, args.in[1], args.in[2], args.in[3], args.in[4], args.in[5], args.in[6], args.in[12], args.in[14], args.in[15], args.in[21], args.in[22], args.in[23], args.in[24], args.in[25],
                    W1U, W1D, W2U, W2D, WIN, WOUT, WLORA, XB, SSQ); if (BOTH(0)) GRID_BAR(0);
    }
    if (IN(1)) {
        pg8::Gemm g{XB, W1U, M, 2 * FF, D}; pg8::StaticOrder S; S.init(M, 2 * FF, F.G, (int)blockIdx.x);
        pg8::EpiSwiGLU E{ACT, FF, SSQ};
        pg8::gemm_phase<pg8::EpiSwiGLU, pg8::StaticOrder, true, true>(F.lds + RING_OFF, g, S, E);
        if (BOTH(1)) GRID_BAR(1);
    }
    if (IN(2)) {
        pg8::Gemm g{ACT, W1D, M, D, FF, 0, 1}; pg8::StaticOrder S; S.init(M, D, F.G, (int)blockIdx.x, 1);
        pg8::EpiResid E{XB, nullptr, XB, SSQ, 0.5f, 1};
        pg8::gemm_phase<pg8::EpiResid, pg8::StaticOrder, true, true>(F.lds + RING_OFF, g, S, E);
        if (BOTH(2)) GRID_BAR(2);
    }
    if (IN(3)) {
        pg8::Gemm g{XB, WIN, M, PW, D}; pg8::StaticOrder S; S.init(M, PW, F.G, (int)blockIdx.x);
        pg8::EpiWin E{QO, KB, VB, RW, SSQ, args.in[7], args.in[8], 0.125f * 1.4426950408889634f};
        pg8::gemm_phase<pg8::EpiWin, pg8::StaticOrder, true, true>(F.lds + RING_OFF, g, S, E);
        if (F.G >= 256) {
            const int nlo = (M / 256) * (PW / 256) - 6 * F.G;
            if ((int)blockIdx.x >= nlo) { __syncthreads();
                p0_items(F, x, args.in[1], args.in[2], args.in[3], args.in[4], args.in[5], args.in[6], args.in[12], args.in[14], args.in[15], args.in[21], args.in[22], args.in[23], args.in[24], args.in[25],
                         W1U, W1D, W2U, W2D, WIN, WOUT, WLORA, XB, SSQ, 1, ((int)blockIdx.x - nlo) * NWAVES + F.wave, (F.G - nlo) * NWAVES); }
        }
        if (BOTH(3)) GRID_BAR(3);
    }
    if (IN(6)) {
        RwArgs A{RW, WLORA, WLORA + 512 * 64, WLORA + 2 * 512 * 64, args.in[11], args.in[13], QO, args.in[10], args.in[16], args.in[17], args.in[18], args.in[19], args.in[20]};
        bf16* ob = (bf16*)out;
        RwX X{ob + (size_t)32 * 1024 * 1024, ob + (size_t)48 * 1024 * 1024, (bf16*)LW, (bf16*)LW + (size_t)16 * 1024 * 1024, AB, AB + (size_t)8 * 1024 * 1024, SSQ, GB};
        p6a_rwkv_local(F, A, X);
        GRID_BAR(16);
        const int nseq = (F.G >= 2 * BATCH * NH) ? BATCH * NH : F.G;
        if ((int)blockIdx.x < nseq) { p6b_rwkv_seq(F, A, X, nseq); __syncthreads(); }
        const int nfree = (F.G - nseq) * NWAVES;
        {   const int nlate = nseq * NWAVES, wv = ((int)blockIdx.x >= nseq) ? ((int)blockIdx.x - nseq) * NWAVES + F.wave : (int)blockIdx.x * NWAVES + F.wave;
            const bool fr_ = ((int)blockIdx.x >= nseq);
            sba::attn_phase(F, QO, KB, VB, args.in[9], (unsigned*)(F.ctl + CW_QUEUE), fr_ ? wv : 2 * nfree + wv, fr_ ? nfree + wv : -1, 2 * nfree + nlate); }
        if (BOTH(6)) GRID_BAR(6);
    }
    if (IN(8)) {
        pg8::Gemm g{QO, WOUT, M, D, D}; pg8::StaticOrder S; S.init(M, D, F.G, (int)blockIdx.x, 1);
        pg8::EpiResid E{XB, nullptr, XB, SSQ, 1.0f, 1};
        pg8::gemm_phase<pg8::EpiResid, pg8::StaticOrder, true, true>(F.lds + RING_OFF, g, S, E);
        if (BOTH(8)) GRID_BAR(8);
    }
    if (IN(9)) {
        pg8::Gemm g{XB, W2U, M, 2 * FF, D}; pg8::StaticOrder S; S.init(M, 2 * FF, F.G, (int)blockIdx.x);
        pg8::EpiSwiGLU E{ACT, FF, SSQ};
        pg8::gemm_phase<pg8::EpiSwiGLU, pg8::StaticOrder, true, true>(F.lds + RING_OFF, g, S, E);
        if (BOTH(9)) GRID_BAR(9);
    }
    if (IN(10)) {
        pg8::Gemm g{ACT, W2D, M, D, FF, 0, 1}; pg8::StaticOrder S; S.init(M, D, F.G, (int)blockIdx.x, 1);
        pg8::EpiResid E{XB, out, nullptr, SSQ, 0.5f, 0};
        pg8::gemm_phase<pg8::EpiResid, pg8::StaticOrder, true, true>(F.lds + RING_OFF, g, S, E);
    }
#undef IN
#undef BOTH
}

extern "C" void kernel_launch(void* const* d_in, const int* in_sizes, int n_in, void* d_out, int out_size, void* d_ws, size_t ws_size, hipStream_t stream) {
    static int grid = 0;
    if (grid == 0) {
        if (n_in != 26 || in_sizes[0] != M * D || out_size != M * D || ws_size < WS_END) { fprintf(stderr, "kernel_launch: unexpected shapes: n_in %d in0 %d out %d ws %zu (need %zu)\n", n_in, n_in > 0 ? in_sizes[0] : -1, out_size, ws_size, (size_t)WS_END); grid = -1; return; }
        int dev = 0, cus = 0, per_cu = 0;
        if (hipGetDevice(&dev) != hipSuccess || hipDeviceGetAttribute(&cus, hipDeviceAttributeMultiprocessorCount, dev) != hipSuccess) { grid = -1; return; }
        if (hipFuncSetAttribute((const void*)skel_fwd, hipFuncAttributeMaxDynamicSharedMemorySize, LDS_BYTES) != hipSuccess) { fprintf(stderr, "kernel_launch: hipFuncSetAttribute failed\n"); grid = -1; return; }
        if (hipOccupancyMaxActiveBlocksPerMultiprocessor(&per_cu, (const void*)skel_fwd, NWAVES * 64, LDS_BYTES) != hipSuccess || per_cu < 1) { fprintf(stderr, "kernel_launch: occupancy query reports %d blocks per CU\n", per_cu); per_cu = 1; }
        (void)hipGetLastError();
        grid = cus;
    }
    if (grid < 0) return;
    if (hipMemsetAsync((char*)d_ws + WS_CTL, 0, CTL_ZERO_BYTES, stream) != hipSuccess) return;
    Args a{};
    for (int i = 0; i < 26; ++i) a.in[i] = (const float*)d_in[i];
    a.out = (float*)d_out; a.ws = (unsigned char*)d_ws;
    for (int li = 0; li < N_LAUNCHES; ++li) {
        a.ph_lo = (N_LAUNCHES == PER_PHASE) ? li : 0; a.ph_hi = (N_LAUNCHES == PER_PHASE) ? li + 1 : PER_PHASE; a.li = li;
        hipLaunchKernelGGL(skel_fwd, dim3(grid), dim3(NWAVES * 64), LDS_BYTES, stream, a);
    }
}
```

```cpp
#include <hip/hip_runtime.h>
#include <hip/hip_bf16.h>
#include <cstdio>
#include <cstdint>
#include <cmath>
namespace pg8 {
#define PG8_LAS __attribute__((address_space(3)))
typedef unsigned short bf16_t;
typedef short bf16x8 __attribute__((ext_vector_type(8)));
typedef float f32x4 __attribute__((ext_vector_type(4)));
typedef unsigned u32x4 __attribute__((ext_vector_type(4)));
constexpr int BM = 256, BK = 64, HALF = 128, HTB = HALF * BK * 2  , STAGE_BYTES = 8 * HTB, NXCD = 8, WGM = 4;

__host__ __device__ __forceinline__ int lds_byte(int r, int c) { const int st = (r >> 4) * 2 + (c >> 5), rr = r & 15, cc = c & 31, ob = rr * 64 + cc * 2; return st * 1024 + (ob ^ (((ob >> 9) & 1) << 5)); }
__host__ __device__ __forceinline__ void stage_rc(int b, int& R, int& C) { const int st = b / 1024, sb = b % 1024, swz = sb ^ (((sb >> 9) & 1) << 5); R = (st >> 1) * 16 + swz / 64; C = (st & 1) * 32 + (swz % 64) / 2; }
__host__ __device__ __forceinline__ int perm32(int rho) { const int n = rho >> 4, i = rho & 15; return 8 * (i >> 2) + 4 * n + (i & 3); }

__device__ __forceinline__ const void* uni_ptr(const void* p) { const unsigned long long a = (unsigned long long)p;
    return (const void*)(((unsigned long long)(unsigned)__builtin_amdgcn_readfirstlane((int)(a >> 32)) << 32) | (unsigned)__builtin_amdgcn_readfirstlane((int)a)); }
template <bool WT> __device__ __forceinline__ void st16(void* base, unsigned boff, const u32x4 w) {
    if constexpr (WT) asm volatile("s_nop 4\n\tglobal_store_dwordx4 %0, %1, %2 sc1\n\ts_nop 1" :: "v"(boff), "v"(w), "s"(uni_ptr(base)) : "memory"); else *(u32x4*)((char*)base + boff) = w; }
template <bool WT> __device__ __forceinline__ void st4f(float* base, unsigned boff, const float w) {
    if constexpr (WT) asm volatile("s_nop 4\n\tglobal_store_dword %0, %1, %2 sc1\n\ts_nop 1" :: "v"(boff), "v"(w), "s"(uni_ptr(base)) : "memory"); else *(float*)((char*)base + boff) = w; }
struct Unit { int pm, pn; };
struct Gemm { const bf16_t* A; const bf16_t* Bt; int M, N, K; int ld; int ablk; };

struct StaticOrder {
    int nM, nN, nwg, G, c, rev;
    __host__ __device__ void init(int M, int N, int G_, int c_, int rev_ = 0) { nM = M / BM; nN = N / BM; nwg = nM * nN; G = G_; c = c_; rev = (rev_ && nwg % G_ == 0) ? nwg / G_ : 0; }
    __host__ __device__ bool next(int i, Unit& u) const {
        if (rev) { if (i >= rev) return false; i = rev - 1 - i; }
        const long L = (long)i * G + c; if (L >= nwg) return false;
        int wgid = (int)L; { const int q = nwg / NXCD, r = nwg % NXCD, xcd = wgid % NXCD, off = wgid / NXCD; wgid = (xcd < r ? xcd * (q + 1) : r * (q + 1) + (xcd - r) * q) + off; }
        const int nig = WGM * nN, gid = wgid / nig, fm = gid * WGM, gsz = (nM - fm) < WGM ? (nM - fm) : WGM;
        u.pm = fm + ((wgid % nig) % gsz); u.pn = (wgid % nig) / gsz; return true;
    }
    __device__ __forceinline__ void a_ready(const Unit&) const {}
    __device__ __forceinline__ void done(const Unit&) const {}
};


__device__ __forceinline__ unsigned cvt_pk_bf16(float lo, float hi) { unsigned r; asm volatile("v_cvt_pk_bf16_f32 %0, %1, %2" : "=v"(r) : "v"(lo), "v"(hi)); return r; }
typedef unsigned u32x2 __attribute__((ext_vector_type(2)));
constexpr float RMS_EPS_F = 1e-6f;
constexpr float LOG2E_F = 1.4426950408889634f;
__device__ __forceinline__ f32x4 row_q(const float* ssqp, int row, int fq) { return *(const f32x4*)(ssqp + (size_t)row * 16 + 4 * fq); }
__device__ __forceinline__ float rs_fin(const f32x4 q) {
    float s = (q[0] + q[1]) + (q[2] + q[3]);
    auto a = __builtin_amdgcn_permlane16_swap(__float_as_uint(s), __float_as_uint(s), false, false); s = __uint_as_float(a[0]) + __uint_as_float(a[1]);
    auto b = __builtin_amdgcn_permlane32_swap(__float_as_uint(s), __float_as_uint(s), false, false); s = __uint_as_float(b[0]) + __uint_as_float(b[1]);
    return __builtin_amdgcn_rsqf(s * (1.0f / 1024.0f) + RMS_EPS_F);
}
__device__ __forceinline__ float silu_f(float g) { return g * __builtin_amdgcn_rcpf(1.0f + __builtin_amdgcn_exp2f(-g * LOG2E_F)); }
__device__ __forceinline__ float sigmoid_f(float g) { return __builtin_amdgcn_rcpf(1.0f + __builtin_amdgcn_exp2f(-g * LOG2E_F)); }

struct EpiSwiGLU {
    static constexpr bool PERM = true, AFTER_DRAIN = false; static constexpr int WTLAST = 1;
    bf16_t* O; int ldo; const float* ssqp;
    __device__ __forceinline__ static f32x4 swiglu4(const f32x4 g, const f32x4 uu, float nrs, float rs2) {
        const f32x4 t = g * nrs, gu = g * uu; f32x4 r;
#pragma unroll
        for (int i = 0; i < 4; ++i) r[i] = __builtin_amdgcn_rcpf(1.0f + __builtin_amdgcn_exp2f(t[i]));
        return gu * (r * rs2);
    }
    template <bool WT> __device__ __forceinline__ void run(const f32x4 (&acc)[2][2][4][2], const Unit& u, int wr, int wc, int fr, int fq) const {
        const int row0 = u.pm * BM + wr * 64 + fr;
        const size_t obase = ((size_t)u.pm * (ldo / BK) + 2 * u.pn + (wc >> 1)) * (BM * BK) + (wc & 1) * 32 + 8 * fq;
        f32x4 q[2][4];
#pragma unroll
        for (int ai = 0; ai < 2; ++ai)
#pragma unroll
            for (int m = 0; m < 4; ++m) q[ai][m] = row_q(ssqp, row0 + ai * HALF + m * 16, fq);
        float rsv[2][4];
#pragma unroll
        for (int ai = 0; ai < 2; ++ai)
#pragma unroll
            for (int m = 0; m < 4; ++m) rsv[ai][m] = rs_fin(q[ai][m]);
#pragma unroll
        for (int ai = 0; ai < 2; ++ai)
#pragma unroll
            for (int m = 0; m < 4; ++m) {
                const int row = row0 + ai * HALF + m * 16; const float rs = rsv[ai][m], nrs = -LOG2E_F * rs, rs2 = rs * rs;
                const f32x4 o0 = swiglu4(acc[ai][0][m][0], acc[ai][1][m][0], nrs, rs2), o1 = swiglu4(acc[ai][0][m][1], acc[ai][1][m][1], nrs, rs2);
                u32x4 w; w.x = cvt_pk_bf16(o0[0], o0[1]); w.y = cvt_pk_bf16(o0[2], o0[3]); w.z = cvt_pk_bf16(o1[0], o1[1]); w.w = cvt_pk_bf16(o1[2], o1[3]);
                st16<WT>(O, (unsigned)(obase + (size_t)(row - u.pm * BM) * BK) * 2u, w);
            }
    }
};

struct EpiResid {
    static constexpr bool PERM = true, AFTER_DRAIN = false; static constexpr int WTLAST = 0;
    const bf16_t* bhi; float* outf; bf16_t* ohi; float* ssqp; float alpha; int aux;
    __device__ __forceinline__ static f32x4 up_bf(unsigned a, unsigned b) { return (f32x4){__uint_as_float(a << 16), __uint_as_float(a & 0xffff0000u), __uint_as_float(b << 16), __uint_as_float(b & 0xffff0000u)}; }
    template <bool WT> __device__ __forceinline__ void run(const f32x4 (&acc)[2][2][4][2], const Unit& u, int wr, int wc, int fr, int fq) const {
        const int row0 = u.pm * BM + wr * 64 + fr, col0 = u.pn * BM + wc * 32 + 8 * fq;
        u32x4 bv[2][4][2];
#pragma unroll
        for (int ai = 0; ai < 2; ++ai)
#pragma unroll
            for (int m = 0; m < 4; ++m)
#pragma unroll
                for (int bj = 0; bj < 2; ++bj) bv[ai][m][bj] = *(const u32x4*)(bhi + (size_t)(row0 + ai * HALF + m * 16) * 1024 + col0 + bj * HALF);
        asm volatile("" ::: "memory");
#pragma unroll
        for (int ai = 0; ai < 2; ++ai)
#pragma unroll
            for (int m = 0; m < 4; ++m) {
                const int row = row0 + ai * HALF + m * 16; const size_t off = (size_t)row * 1024 + col0; float ss = 0.f;
#pragma unroll
                for (int bj = 0; bj < 2; ++bj) {
                    const u32x4 h = bv[ai][m][bj];
                    const f32x4 v0 = up_bf(h.x, h.y) + acc[ai][bj][m][0] * alpha, v1 = up_bf(h.z, h.w) + acc[ai][bj][m][1] * alpha;
                    if (aux) ss += ((v0[0] * v0[0] + v0[1] * v0[1]) + (v0[2] * v0[2] + v0[3] * v0[3])) + ((v1[0] * v1[0] + v1[1] * v1[1]) + (v1[2] * v1[2] + v1[3] * v1[3]));
                    if (outf) { *(f32x4*)(outf + off + bj * HALF) = v0; *(f32x4*)(outf + off + bj * HALF + 4) = v1; }
                    else { u32x4 w; w.x = cvt_pk_bf16(v0[0], v0[1]); w.y = cvt_pk_bf16(v0[2], v0[3]); w.z = cvt_pk_bf16(v1[0], v1[1]); w.w = cvt_pk_bf16(v1[2], v1[3]); st16<WT>(ohi, (unsigned)(off + bj * HALF) * 2u, w); }
                }
                if (aux) { ss += __shfl_xor(ss, 16); ss += __shfl_xor(ss, 32); if (fq == 0) st4f<WT>(ssqp, (unsigned)(row * 16 + u.pn * 4 + wc) * 4u, ss); }
            }
    }
};

struct EpiWin {
    static constexpr bool PERM = true, AFTER_DRAIN = false; static constexpr int WTLAST = 1;
    bf16_t* QO; bf16_t* KB; bf16_t* VB; bf16_t* RW; const float* ssqp; const float* gq; const float* gk; float qscale;
    template <bool WT> __device__ __forceinline__ void run(const f32x4 (&acc)[2][2][4][2], const Unit& u, int wr, int wc, int fr, int fq) const {
        const int row0 = u.pm * BM + wr * 64 + fr; const int pn = u.pn;
        f32x4 q[2][4];
#pragma unroll
        for (int ai = 0; ai < 2; ++ai)
#pragma unroll
            for (int m = 0; m < 4; ++m) q[ai][m] = row_q(ssqp, row0 + ai * HALF + m * 16, fq);
        float rsv[2][4];
#pragma unroll
        for (int ai = 0; ai < 2; ++ai)
#pragma unroll
            for (int m = 0; m < 4; ++m) rsv[ai][m] = rs_fin(q[ai][m]);
        if (pn < 4) {
            const float* gp = (pn < 2) ? gq : gk; const float osc = (pn < 2) ? qscale : 1.0f;
            f32x4 gv[2][2];
#pragma unroll
            for (int bj = 0; bj < 2; ++bj)
#pragma unroll
                for (int n = 0; n < 2; ++n) gv[bj][n] = *(const f32x4*)(gp + 32 * bj + 8 * fq + 4 * n) * osc;
            bf16_t* dst = (pn < 2) ? QO : KB; const int ld = (pn < 2) ? 1024 : 512; const int colh = 64 * (4 * (pn & 1) + wc) + 8 * fq;
#pragma unroll
            for (int ai = 0; ai < 2; ++ai)
#pragma unroll
                for (int m = 0; m < 4; ++m) {
                    const int row = row0 + ai * HALF + m * 16; const float rs = rsv[ai][m];
                    f32x4 y[2][2]; float ss = 0.f;
#pragma unroll
                    for (int bj = 0; bj < 2; ++bj)
#pragma unroll
                        for (int n = 0; n < 2; ++n) { y[bj][n] = acc[ai][bj][m][n] * rs; const f32x4 t = y[bj][n]; ss += (t[0] * t[0] + t[1] * t[1]) + (t[2] * t[2] + t[3] * t[3]); }
                    ss += __shfl_xor(ss, 16); ss += __shfl_xor(ss, 32);
                    const float hs = __builtin_amdgcn_rsqf(ss * (1.0f / 64.0f) + RMS_EPS_F);
#pragma unroll
                    for (int bj = 0; bj < 2; ++bj) {
                        const f32x4 a = y[bj][0] * gv[bj][0] * hs, b = y[bj][1] * gv[bj][1] * hs;
                        u32x4 w; w.x = cvt_pk_bf16(a[0], a[1]); w.y = cvt_pk_bf16(a[2], a[3]); w.z = cvt_pk_bf16(b[0], b[1]); w.w = cvt_pk_bf16(b[2], b[3]);
                        st16<WT>(dst, (unsigned)(row * ld + colh + 32 * bj) * 2u, w);
                    }
                }
        } else {
            bf16_t* dst = (pn < 6) ? VB : RW; const int ld = (pn < 6) ? 512 : 1792; const int colh = 256 * ((pn < 6) ? (pn - 4) : (pn - 6)) + 64 * wc + 8 * fq;
#pragma unroll
            for (int ai = 0; ai < 2; ++ai)
#pragma unroll
                for (int m = 0; m < 4; ++m) {
                    const int row = row0 + ai * HALF + m * 16; const float rs = rsv[ai][m];
#pragma unroll
                    for (int bj = 0; bj < 2; ++bj) {
                        const f32x4 a = acc[ai][bj][m][0] * rs, b = acc[ai][bj][m][1] * rs;
                        u32x4 w; w.x = cvt_pk_bf16(a[0], a[1]); w.y = cvt_pk_bf16(a[2], a[3]); w.z = cvt_pk_bf16(b[0], b[1]); w.w = cvt_pk_bf16(b[2], b[3]);
                        st16<WT>(dst, (unsigned)(row * ld + colh + 32 * bj) * 2u, w);
                    }
                }
        }
    }
};

template <class Epi, class Sched, bool ALIGN_EPI = false, bool SP2 = false>
__device__ __forceinline__ void gemm_phase(PG8_LAS unsigned char* lds, const Gemm g, const Sched& S, const Epi& E) {
    const int tid = threadIdx.x, wid = __builtin_amdgcn_readfirstlane(tid >> 6), lane = tid & 63, wr = wid >> 2, wc = wid & 3, fr = lane & 15, fq = lane >> 4;
    const int K = g.K, nt = K / BK, LDP = g.ld ? g.ld : g.K, LDA = g.ablk ? BK : LDP;
    unsigned voffA[2], voffB[2];
#pragma unroll
    for (int i = 0; i < 2; ++i) { int R, C; stage_rc(tid * 16 + i * 8192, R, C); const int Rb = Epi::PERM ? ((R & ~31) + perm32(R & 31)) : R;
        voffA[i] = (unsigned)(R * LDA + C) * 2u; voffB[i] = (unsigned)(Rb * LDP + C) * 2u; }
    const size_t kstep = (size_t)(BK * 2);
    const size_t hstep = (size_t)HALF * LDP * 2;
    const size_t tstep = 2 * hstep;
    const size_t kstepA = g.ablk ? (size_t)BM * BK * 2 : kstep, hstepA = (size_t)HALF * LDA * 2, tstepA = g.ablk ? (size_t)BM * K * 2 : tstep;
    const unsigned ldsw = (unsigned)wid * 1024u;
    const int aoff = lds_byte(wr * 64 + fr, fq * 8), boff = lds_byte(wc * 32 + fr, fq * 8);
#define PG8_SA(b, h) (((b) * 2 + (h)) * HTB)
#define PG8_SB(b, h) ((4 + (b) * 2 + (h)) * HTB)
#define PG8_STAGE(bufoff, gbase, voff) do { _Pragma("unroll") for (int _i = 0; _i < 2; ++_i) \
        __builtin_amdgcn_global_load_lds((const unsigned*)((const char*)(gbase) + (voff)[_i]), (PG8_LAS unsigned*)(lds + (bufoff) + ldsw + _i * 8192), 16, 0, 0); } while (0)
#define PG8_LDA(dst, b, h) do { _Pragma("unroll") for (int m = 0; m < 4; ++m) _Pragma("unroll") for (int k = 0; k < 2; ++k) dst[m][k] = *(const PG8_LAS bf16x8*)(lds + PG8_SA(b, h) + aoff + m * 2048 + k * 1024); } while (0)
#define PG8_LDB(dst, b, h) do { _Pragma("unroll") for (int n = 0; n < 2; ++n) _Pragma("unroll") for (int k = 0; k < 2; ++k) dst[n][k] = *(const PG8_LAS bf16x8*)(lds + PG8_SB(b, h) + boff + n * 2048 + k * 1024); } while (0)
#define PG8_MMA(ai, bj, At, Bt) do { __builtin_amdgcn_s_setprio(0); _Pragma("unroll") for (int m = 0; m < 4; ++m) _Pragma("unroll") for (int n = 0; n < 2; ++n) _Pragma("unroll") for (int k = 0; k < 2; ++k) \
        acc[ai][bj][m][n] = __builtin_amdgcn_mfma_f32_16x16x32_bf16(Bt[n][k], At[m][k], acc[ai][bj][m][n], 0, 0, 0); __builtin_amdgcn_s_setprio(1); } while (0)
#define PG8_WAIT_V(n) asm volatile("s_waitcnt vmcnt(" #n ")" ::: "memory")
#define PG8_WAIT_L(n) asm volatile("s_waitcnt lgkmcnt(" #n ")" ::: "memory")
#define PG8_BAR __builtin_amdgcn_s_barrier()
#define PG8_SCHED __builtin_amdgcn_sched_barrier(0)
    Unit cur, nxt; int ui = 0;
    if (!S.next(0, cur)) return;
    f32x4 acc[2][2][4][2];
#pragma unroll
    for (int a = 0; a < 2; ++a)
#pragma unroll
        for (int b = 0; b < 2; ++b)
#pragma unroll
            for (int m = 0; m < 4; ++m)
#pragma unroll
                for (int n = 0; n < 2; ++n) acc[a][b][m][n] = (f32x4){0.f, 0.f, 0.f, 0.f};
    bf16x8 At[4][2], B0[2][2], B1[2][2];
    const char* cA = (const char*)g.A + (size_t)cur.pm * tstepA; const char* cB = (const char*)g.Bt + (size_t)cur.pn * tstep;
    S.a_ready(cur);
    if constexpr (SP2) {
        PG8_STAGE(PG8_SB(0, 0), cB, voffB); PG8_STAGE(PG8_SB(0, 1), cB + hstep, voffB); PG8_STAGE(PG8_SA(0, 0), cA, voffA); PG8_STAGE(PG8_SA(0, 1), cA + hstepA, voffA);
        if (wr == 1) PG8_BAR;
        PG8_WAIT_V(2); PG8_BAR;
        PG8_STAGE(PG8_SB(1, 0), cB + kstep, voffB); PG8_STAGE(PG8_SA(1, 0), cA + kstepA, voffA); PG8_STAGE(PG8_SB(1, 1), cB + hstep + kstep, voffB);
        PG8_WAIT_V(6); PG8_BAR;
    } else {
        PG8_STAGE(PG8_SB(0, 0), cB, voffB); PG8_STAGE(PG8_SA(0, 0), cA, voffA); PG8_STAGE(PG8_SB(0, 1), cB + hstep, voffB); PG8_STAGE(PG8_SA(0, 1), cA + hstepA, voffA);
        if (wr == 1) PG8_BAR;
        PG8_WAIT_V(4); PG8_BAR;
        PG8_STAGE(PG8_SB(1, 0), cB + kstep, voffB); PG8_STAGE(PG8_SA(1, 0), cA + kstepA, voffA); PG8_STAGE(PG8_SB(1, 1), cB + hstep + kstep, voffB);
        PG8_WAIT_V(6); PG8_BAR;
    }
    for (;;) {
        const bool has_next = S.next(ui + 1, nxt);
        const char* nA = has_next ? (const char*)g.A + (size_t)nxt.pm * tstepA : cA; const char* nB = has_next ? (const char*)g.Bt + (size_t)nxt.pn * tstep : cB;
        for (int t = 0; t < nt; t += 2) {
            const bool last = (t == nt - 2);
            const char* a1 = cA + (size_t)(t + 1) * kstepA;
            const char* a2 = last ? nA : cA + (size_t)(t + 2) * kstepA; const char* b2 = last ? nB : cB + (size_t)(t + 2) * kstep;
            const char* a3 = a2 + kstepA; const char* b3 = b2 + kstep;
            if (last && has_next) S.a_ready(nxt);
            if constexpr (SP2) {
            PG8_LDB(B0, 0, 0); PG8_LDB(B1, 0, 1); PG8_SCHED; PG8_LDA(At, 0, 0); PG8_STAGE(PG8_SA(1, 1), a1 + hstepA, voffA);
            PG8_WAIT_V(8); PG8_WAIT_L(0); PG8_BAR; PG8_MMA(0, 0, At, B0); PG8_MMA(0, 1, At, B1); PG8_BAR; PG8_SCHED;
            PG8_LDA(At, 0, 1); PG8_STAGE(PG8_SB(0, 0), b2, voffB); PG8_STAGE(PG8_SB(0, 1), b2 + hstep, voffB); PG8_STAGE(PG8_SA(0, 0), a2, voffA);
            PG8_WAIT_V(8); PG8_WAIT_L(0); PG8_BAR; PG8_MMA(1, 0, At, B0); PG8_MMA(1, 1, At, B1); PG8_BAR; PG8_SCHED;
            PG8_LDB(B0, 1, 0); PG8_LDB(B1, 1, 1); PG8_SCHED; PG8_LDA(At, 1, 0); PG8_STAGE(PG8_SA(0, 1), a2 + hstepA, voffA);
            PG8_WAIT_V(8); PG8_WAIT_L(0); PG8_BAR; PG8_MMA(0, 0, At, B0); PG8_MMA(0, 1, At, B1); PG8_BAR; PG8_SCHED;
            PG8_LDA(At, 1, 1); PG8_STAGE(PG8_SB(1, 0), b3, voffB); PG8_STAGE(PG8_SB(1, 1), b3 + hstep, voffB); PG8_STAGE(PG8_SA(1, 0), a3, voffA);
            PG8_WAIT_V(8); PG8_WAIT_L(0); PG8_BAR; PG8_MMA(1, 0, At, B0); PG8_MMA(1, 1, At, B1); PG8_BAR; PG8_SCHED;
            } else {
            PG8_LDB(B0, 0, 0); PG8_SCHED; PG8_LDA(At, 0, 0); PG8_STAGE(PG8_SA(1, 1), a1 + hstepA, voffA);
            PG8_WAIT_L(8); PG8_BAR; PG8_WAIT_L(0); PG8_MMA(0, 0, At, B0); PG8_BAR; PG8_SCHED;
            PG8_LDB(B1, 0, 1); PG8_STAGE(PG8_SB(0, 0), b2, voffB);
            PG8_BAR; PG8_WAIT_L(0); PG8_MMA(0, 1, At, B1); PG8_BAR;
            PG8_LDA(At, 0, 1); PG8_STAGE(PG8_SA(0, 0), a2, voffA);
            PG8_BAR; PG8_WAIT_L(0); PG8_MMA(1, 0, At, B0); PG8_BAR; PG8_SCHED;
            PG8_STAGE(PG8_SB(0, 1), b2 + hstep, voffB);
            PG8_WAIT_V(6); PG8_BAR; PG8_MMA(1, 1, At, B1); PG8_BAR;
            PG8_LDB(B0, 1, 0); PG8_SCHED; PG8_LDA(At, 1, 0); PG8_STAGE(PG8_SA(0, 1), a2 + hstepA, voffA);
            PG8_WAIT_L(8); PG8_BAR; PG8_WAIT_L(0); PG8_MMA(0, 0, At, B0); PG8_BAR; PG8_SCHED;
            PG8_LDB(B1, 1, 1); PG8_STAGE(PG8_SB(1, 0), b3, voffB);
            PG8_BAR; PG8_WAIT_L(0); PG8_MMA(0, 1, At, B1); PG8_BAR;
            PG8_LDA(At, 1, 1); PG8_STAGE(PG8_SA(1, 0), a3, voffA);
            PG8_BAR; PG8_WAIT_L(0); PG8_MMA(1, 0, At, B0); PG8_BAR; PG8_SCHED;
            PG8_STAGE(PG8_SB(1, 1), b3 + hstep, voffB);
            PG8_WAIT_V(6); PG8_BAR; PG8_MMA(1, 1, At, B1); PG8_BAR;
            }
        }
        if constexpr (ALIGN_EPI) { if (wr == 0) PG8_BAR; }
        if constexpr (!Epi::AFTER_DRAIN) { if constexpr (Epi::WTLAST == 2) E.template run<true>(acc, cur, wr, wc, fr, fq); else { if (has_next || !Epi::WTLAST) E.template run<false>(acc, cur, wr, wc, fr, fq); else E.template run<true>(acc, cur, wr, wc, fr, fq); } S.done(cur); }
        if (!has_next) break;
#pragma unroll
        for (int a = 0; a < 2; ++a)
#pragma unroll
            for (int b = 0; b < 2; ++b)
#pragma unroll
                for (int m = 0; m < 4; ++m)
#pragma unroll
                    for (int n = 0; n < 2; ++n) acc[a][b][m][n] = (f32x4){0.f, 0.f, 0.f, 0.f};
        cur = nxt; cA = nA; cB = nB; ++ui;
        if constexpr (ALIGN_EPI) { if (wr == 1) PG8_BAR; }
    }
    __builtin_amdgcn_s_setprio(0);
    PG8_WAIT_V(0);
    if constexpr (!ALIGN_EPI) { if (wr == 0) PG8_BAR; }
    PG8_BAR;
    if constexpr (Epi::AFTER_DRAIN) { E.fused(acc, cur, wr, wc, fr, fq, lds, wid, lane); S.done(cur); }
#undef PG8_SA
#undef PG8_SB
#undef PG8_STAGE
#undef PG8_LDA
#undef PG8_LDB
#undef PG8_MMA
#undef PG8_WAIT_V
#undef PG8_WAIT_L
#undef PG8_BAR
#undef PG8_SCHED
}
}
#define GAS __attribute__((address_space(1)))
#define LAS __attribute__((address_space(3)))
typedef unsigned short bf16;
typedef unsigned v4u __attribute__((ext_vector_type(4)));
typedef float f32x4 __attribute__((ext_vector_type(4)));
typedef short bf16x8 __attribute__((ext_vector_type(8)));
typedef GAS unsigned gu32;
typedef GAS unsigned long long gu64;
#define RLX_AGENT __ATOMIC_RELAXED, __HIP_MEMORY_SCOPE_AGENT
#define LDS_WAIT() asm volatile("s_waitcnt lgkmcnt(0)" ::: "memory")
#define VM_WAIT() asm volatile("s_waitcnt vmcnt(0)" ::: "memory")
__device__ __forceinline__ unsigned long long rt() { return __builtin_amdgcn_s_memrealtime(); }
__device__ __forceinline__ unsigned f2bf(float f) { unsigned u = __builtin_bit_cast(unsigned, f); return (u + 0x7fffu + ((u >> 16) & 1u)) >> 16; }
__device__ __forceinline__ unsigned pk2(float lo, float hi) { return f2bf(lo) | (f2bf(hi) << 16); }

#define XB_TMO      128
#define XB_XCNT(j)  (256  + 64 * (j))
#define XB_XSUB(j)  (1280 + 64 * (j))
#define XB_XGEN(j)  (2304 + 64 * (j))
#define XB_TOP      3328
#define XB_TOPGEN   3392
#define XCD_BAR_WORDS 3456
#define XB_SPIN_CAP (1u << 18)

__device__ __forceinline__ unsigned xb_ld(unsigned* p)              { return __hip_atomic_load(p, __ATOMIC_RELAXED, __HIP_MEMORY_SCOPE_AGENT); }
__device__ __forceinline__ unsigned xb_add(unsigned* p, unsigned v) { return __hip_atomic_fetch_add(p, v, __ATOMIC_RELAXED, __HIP_MEMORY_SCOPE_AGENT); }
__device__ __forceinline__ unsigned xb_xcc_id() { return (unsigned)__builtin_amdgcn_s_getreg((3 << 11) | 20) & 0xFu; }
#define XB_SPIN(cond, bar) do { unsigned _sp = 0; while (cond) { __builtin_amdgcn_s_sleep(1); \
    if ((++_sp & 255u) == 0u) { if (xb_ld(&(bar)[XB_TMO])) break; if (_sp > XB_SPIN_CAP) { atomicAdd(&(bar)[XB_TMO], 1u); break; } } } } while (0)

struct XcdBarrier {
    unsigned* bar; unsigned x;
    volatile LAS unsigned* st;
};

__device__ __forceinline__ XcdBarrier xcd_barrier_post(unsigned* bar, volatile LAS unsigned* st) {
    XcdBarrier b; b.bar = bar; b.x = xb_xcc_id(); b.st = st;
    if (threadIdx.x == 0) (void)xb_add(&bar[XB_XCNT(b.x)], 1u);
    return b;
}
__device__ __forceinline__ void xcd_barrier_complete(unsigned* bar, unsigned x, unsigned& nloc, unsigned& nx) {
    const unsigned G = gridDim.x * gridDim.y * gridDim.z;
    unsigned sum, cnt, mine, sp = 0u;
    for (;;) {
        sum = 0u; cnt = 0u; mine = 0u;
#pragma unroll
        for (unsigned j = 0; j < 16; ++j) { const unsigned c = xb_ld(&bar[XB_XCNT(j)]); sum += c; cnt += (c > 0u) ? 1u : 0u; mine = (j == x) ? c : mine; }
        if (sum == G) break;
        __builtin_amdgcn_s_sleep(1);
        if ((++sp & 255u) == 0u) { if (xb_ld(&bar[XB_TMO])) break; if (sp > XB_SPIN_CAP) { atomicAdd(&bar[XB_TMO], 1u); break; } }
    }
    nloc = mine > 0u ? mine : 1u; nx = cnt > 0u ? cnt : 1u;
}

__device__ __forceinline__ void xcd_barrier(const XcdBarrier& b) {
    asm volatile("s_waitcnt vmcnt(0)" ::: "memory");
    __syncthreads();
    if (threadIdx.x == 0) {
        unsigned* bar = b.bar;
        __builtin_amdgcn_s_waitcnt(0);
        unsigned nloc = b.st[0], nx = b.st[1];
        if (nloc == 0u) { xcd_barrier_complete(bar, b.x, nloc, nx); b.st[0] = nloc; b.st[1] = nx; }
        const unsigned old = xb_add(&bar[XB_XSUB(b.x)], 1u);
        const unsigned gen = old / nloc;
        if (old + 1u == (gen + 1u) * nloc) {
            __builtin_amdgcn_fence(__ATOMIC_RELEASE, "agent");
            asm volatile("s_waitcnt vmcnt(0)" ::: "memory");
            const unsigned og = xb_add(&bar[XB_TOP], 1u);
            const unsigned tg = og / nx;
            if (og + 1u == (tg + 1u) * nx) xb_add(&bar[XB_TOPGEN], 1u);
            else XB_SPIN(xb_ld(&bar[XB_TOPGEN]) == tg, bar);
            __builtin_amdgcn_fence(__ATOMIC_ACQUIRE, "agent");
            asm volatile("s_waitcnt vmcnt(0)" ::: "memory");
        } else {
            XB_SPIN(xb_ld(&bar[XB_TOPGEN]) == gen, bar);
            __builtin_amdgcn_fence(__ATOMIC_ACQUIRE, "agent");
            asm volatile("s_waitcnt vmcnt(0)" ::: "memory");
        }
    }
    __syncthreads();
}

constexpr int NWAVES = 8;
#ifndef MK_N_LAUNCHES
#define MK_N_LAUNCHES 1
#endif
constexpr int PER_PHASE = 11;
constexpr int N_LAUNCHES = MK_N_LAUNCHES;

constexpr int BATCH = 16, SEQ = 2048, D = 1024, HD = 64, NH = 8, FF = 2816;
constexpr int M = BATCH * SEQ;
constexpr int SBW = 512, RWW = 512, RWP = 1792, PW = 3328, LORA_K = 256, LORA_N = 1536;
constexpr float LNX_EPS = 64e-5f;

constexpr size_t MiB = 1u << 20;
constexpr size_t WS_CTL = 0, CTL_ZERO_BYTES = 128 * 1024;
constexpr size_t WS_SSQ = 1 * MiB;
constexpr size_t WS_W1U = 4 * MiB;
constexpr size_t WS_W1D = 15 * MiB;
constexpr size_t WS_W2U = 21 * MiB;
constexpr size_t WS_W2D = 32 * MiB;
constexpr size_t WS_WIN = 38 * MiB;
constexpr size_t WS_WOUT = 45 * MiB;
constexpr size_t WS_WLORA = 47 * MiB;
constexpr size_t WS_XB = 48 * MiB;
constexpr size_t WS_ACT = 112 * MiB;
constexpr size_t WS_QO = 112 * MiB;
constexpr size_t WS_KB = 176 * MiB;
constexpr size_t WS_VB = 208 * MiB;
constexpr size_t WS_RW = 240 * MiB;
constexpr size_t WS_ALORA = 352 * MiB;
constexpr size_t WS_LW = 368 * MiB;
constexpr size_t WS_AB = 432 * MiB;
constexpr size_t WS_GB = 464 * MiB;
constexpr size_t WS_TAIL = 496 * MiB;
constexpr size_t WS_END = 512 * MiB;
constexpr int CW_TMO = 0, CW_CODE = 1;
constexpr int CW_BAR = 4096;
constexpr int CW_QUEUE = 16384;

constexpr int RING_OFF = 0, RING_BYTES = 155648;
constexpr int LDSCTL_OFF = RING_BYTES, MISC_OFF = LDSCTL_OFF;
constexpr int LDS_BYTES = 163840;

struct Frame {
    LAS unsigned char* lds;
    volatile LAS unsigned* MISC;
    gu32* ctl;
    int tid, lane, wave;
    int vcu, G;
};
typedef unsigned u32x2g __attribute__((ext_vector_type(2)));
__device__ __forceinline__ float bf2f(unsigned short h) { return __uint_as_float(((unsigned)h) << 16); }
typedef float f32x2h __attribute__((ext_vector_type(2))); typedef __bf16 bf16x2h __attribute__((ext_vector_type(2)));
__device__ __forceinline__ unsigned pkbf(float lo, float hi) { f32x2h v = {lo, hi}; bf16x2h b = __builtin_convertvector(v, bf16x2h); return __builtin_bit_cast(unsigned, b); }
__device__ __forceinline__ float bflo(unsigned w) { return __uint_as_float(w << 16); }
__device__ __forceinline__ float bfhi(unsigned w) { return __uint_as_float(w & 0xffff0000u); }
__device__ __forceinline__ float wave_sum(float v) {
#pragma unroll
    for (int o = 1; o < 64; o <<= 1) v += __shfl_xor(v, o);
    return v;
}
#define DPP_ADD(v, ctrl) ((v) + __int_as_float(__builtin_amdgcn_update_dpp(0, __float_as_int(v), (ctrl), 0xF, 0xF, true)))
__device__ __forceinline__ float sum8(float v) { v = DPP_ADD(v, 0xB1); v = DPP_ADD(v, 0x4E); v = DPP_ADD(v, 0x141); return v; }

struct TItem { const float* W; int ldw, k0, n0; const float* sc; bf16* WT; int Kd, rho0; };
__device__ __forceinline__ void ti_load(const TItem& T, float (&t)[32], int lane) {
#pragma unroll
    for (int i = 0; i < 32; ++i) t[i] = T.W[(size_t)(T.k0 + 2 * i + (lane >> 5)) * T.ldw + T.n0 + (lane & 31)];
}
template <bool WT> __device__ __forceinline__ void ti_finish(const TItem& T, const float (&t)[32], LAS float* scr, int lane) {
#pragma unroll
    for (int i = 0; i < 32; ++i) scr[(2 * i + (lane >> 5)) * 33 + (lane & 31)] = t[i];
    LDS_WAIT(); asm volatile("" ::: "memory");
    const int c = lane & 7;
    f32x4 s0 = (f32x4){1.f, 1.f, 1.f, 1.f}, s1 = s0;
    if (T.sc) { s0 = *(const f32x4*)(T.sc + T.k0 + 8 * c); s1 = *(const f32x4*)(T.sc + T.k0 + 8 * c + 4); }
#pragma unroll
    for (int j = 0; j < 4; ++j) { const int n = (lane >> 3) + 8 * j; const LAS float* s = scr + (8 * c) * 33 + n;
        v4u o; o.x = pkbf(s[0 * 33] * s0.x, s[1 * 33] * s0.y); o.y = pkbf(s[2 * 33] * s0.z, s[3 * 33] * s0.w); o.z = pkbf(s[4 * 33] * s1.x, s[5 * 33] * s1.y); o.w = pkbf(s[6 * 33] * s1.z, s[7 * 33] * s1.w);
        pg8::st16<WT>(T.WT, (unsigned)((T.rho0 + n) * T.Kd + T.k0 + 8 * c) * 2u, o); }
    LDS_WAIT(); asm volatile("" ::: "memory");
}
#define P0_PTRS const float* Ax, const float* An1, const float* Ag1, const float* Au1, const float* Ad1, const float* Anm, const float* Awin, const float* Aw2, const float* Aa2, const float* Ag2, const float* Awout, \
    const float* An2, const float* Ag2f, const float* Au2f, const float* Ad2f, bf16* AW1U, bf16* AW1D, bf16* AW2U, bf16* AW2D, bf16* AWIN, bf16* AWOUT, bf16* AWLORA, bf16* AXB, float* ASSQ
__device__ __forceinline__ void p0_items(Frame& F, P0_PTRS, int set, int gw, int NGW) {
    LAS float* scr = (LAS float*)(F.lds + RING_OFF + F.wave * 16384);
    constexpr int I_UP = 16 * 176, I_DN = 44 * 32, I_IN = 16 * 104, I_OUT = 16 * 32;
    const int NITEMS = set ? (I_UP + I_DN) : (I_UP + I_DN + I_IN + I_OUT);
#define P0_DECODE(it_, T) do { int r = (it_); const int l2 = set; \
        if (r < I_UP) { const int kb = r / 176, nb = r % 176, rho0 = 32 * nb, pn = rho0 >> 8, bj = (rho0 >> 7) & 1, j0 = rho0 & 127; \
            T = TItem{l2 ? (bj ? Au2f : Ag2f) : (bj ? Au1 : Ag1), FF, 64 * kb, 128 * pn + j0, l2 ? An2 : An1, l2 ? AW2U : AW1U, D, rho0}; } \
        else if ((r -= I_UP) < I_DN) { const int kb = r / 32, nb = r % 32; \
            T = TItem{l2 ? Ad2f : Ad1, D, 64 * kb, 32 * nb, nullptr, l2 ? AW2D : AW1D, FF, 32 * nb}; } \
        else if ((r -= I_DN) < I_IN) { const int kb = r / 104, nb = r % 104, rho0 = 32 * nb, pn = rho0 >> 8, rem = rho0 & 255, bj = rem >> 7, wc = (rem & 127) >> 5; \
            T = TItem{Awin, PW, 64 * kb, 256 * pn + 64 * wc + 32 * bj, Anm, AWIN, D, rho0}; } \
        else { r -= I_IN; const int kb = r / 32, nb = r % 32; T = TItem{Awout, D, 64 * kb, 32 * nb, nullptr, AWOUT, D, 32 * nb}; } } while (0)
    for (int it = gw; it < NITEMS; it += 2 * NGW) {
        TItem T0, T1; float t0[32], t1[32]; const bool two = (it + NGW < NITEMS);
        P0_DECODE(it, T0); ti_load(T0, t0, F.lane);
        if (two) { P0_DECODE(it + NGW, T1); ti_load(T1, t1, F.lane); }
        if (set) { ti_finish<true>(T0, t0, scr, F.lane); if (two) ti_finish<true>(T1, t1, scr, F.lane); }
        else { ti_finish<false>(T0, t0, scr, F.lane); if (two) ti_finish<false>(T1, t1, scr, F.lane); }
    }
#undef P0_DECODE
}
__device__ __forceinline__ void p0_prologue(Frame& F, P0_PTRS) {
    const int gw = F.vcu * NWAVES + F.wave, NGW = F.G * NWAVES;
    p0_items(F, Ax, An1, Ag1, Au1, Ad1, Anm, Awin, Aw2, Aa2, Ag2, Awout, An2, Ag2f, Au2f, Ad2f, AW1U, AW1D, AW2U, AW2D, AWIN, AWOUT, AWLORA, AXB, ASSQ, (F.G >= 256) ? 0 : 0, gw, NGW);
    if (F.G < 256) p0_items(F, Ax, An1, Ag1, Au1, Ad1, Anm, Awin, Aw2, Aa2, Ag2, Awout, An2, Ag2f, Au2f, Ad2f, AW1U, AW1D, AW2U, AW2D, AWIN, AWOUT, AWLORA, AXB, ASSQ, 1, gw, NGW);
    for (int it = F.vcu * (NWAVES * 64) + F.tid; it < 512 * 32; it += F.G * NWAVES * 64) {
        int ch, kc, Kk; const float* src; bf16* dst;
        if (it < 512 * 8) { ch = it >> 3; kc = (it & 7) * 8; Kk = 64; src = Aw2; dst = AWLORA; }
        else if (it < 512 * 16) { const int i2 = it - 512 * 8; ch = i2 >> 3; kc = (i2 & 7) * 8; Kk = 64; src = Aa2; dst = AWLORA + 512 * 64; }
        else { const int i2 = it - 512 * 16; ch = i2 >> 4; kc = (i2 & 15) * 8; Kk = 128; src = Ag2; dst = AWLORA + 2 * 512 * 64; }
        float v[8];
#pragma unroll
        for (int j = 0; j < 8; ++j) v[j] = src[(size_t)(kc + j) * 512 + ch];
        v4u o; o.x = pkbf(v[0], v[1]); o.y = pkbf(v[2], v[3]); o.z = pkbf(v[4], v[5]); o.w = pkbf(v[6], v[7]);
        *(GAS v4u*)(dst + (size_t)ch * Kk + kc) = o;
    }
    for (int mb = gw; mb < M; mb += 4 * NGW) {
        f32x4 v[4][4]; float s[4];
#pragma unroll
        for (int q = 0; q < 4; ++q) { const int m = mb + q * NGW; const GAS f32x4* xr = (const GAS f32x4*)(Ax + (size_t)(m < M ? m : mb) * D) + F.lane;
#pragma unroll
            for (int j = 0; j < 4; ++j) v[q][j] = xr[64 * j]; }
#pragma unroll
        for (int q = 0; q < 4; ++q) { float a = 0.f;
#pragma unroll
            for (int j = 0; j < 4; ++j) a += (v[q][j].x * v[q][j].x + v[q][j].y * v[q][j].y) + (v[q][j].z * v[q][j].z + v[q][j].w * v[q][j].w);
            s[q] = a; }
#pragma unroll
        for (int o = 1; o < 64; o <<= 1) {
#pragma unroll
            for (int q = 0; q < 4; ++q) s[q] += __shfl_xor(s[q], o); }
#pragma unroll
        for (int q = 0; q < 4; ++q) { const int m = mb + q * NGW; if (m < M) {
            GAS unsigned long long* o8 = (GAS unsigned long long*)(AXB + (size_t)m * D) + F.lane;
#pragma unroll
            for (int j = 0; j < 4; ++j) o8[64 * j] = (unsigned long long)pkbf(v[q][j].x, v[q][j].y) | ((unsigned long long)pkbf(v[q][j].z, v[q][j].w) << 32);
            if (F.lane < 16) ASSQ[(size_t)m * 16 + F.lane] = (F.lane == 0) ? s[q] : 0.f; } }
    }
}

struct RwArgs { const bf16* RW; const bf16* W2T; const bf16* A2T; const bf16* G2T; const float* w0; const float* a0; bf16* QO; const float *mu, *k_k, *k_a, *r_k, *ln_w, *ln_b; };
__device__ __forceinline__ void ld8bf(const bf16* p, float (&o)[8]) { const v4u w = *(const v4u*)p; o[0] = bflo(w.x); o[1] = bfhi(w.x); o[2] = bflo(w.y); o[3] = bfhi(w.y); o[4] = bflo(w.z); o[5] = bfhi(w.z); o[6] = bflo(w.w); o[7] = bfhi(w.w); }
__device__ __forceinline__ void ld8f(const float* p, float (&o)[8]) { const f32x4 a = *(const f32x4*)p, b = *(const f32x4*)(p + 4); o[0] = a.x; o[1] = a.y; o[2] = a.z; o[3] = a.w; o[4] = b.x; o[5] = b.y; o[6] = b.z; o[7] = b.w; }
__device__ __forceinline__ void ld8l(const LAS float* p, float (&o)[8]) { const f32x4 a = *(const LAS f32x4*)p, b = *(const LAS f32x4*)(p + 4); o[0] = a.x; o[1] = a.y; o[2] = a.z; o[3] = a.w; o[4] = b.x; o[5] = b.y; o[6] = b.z; o[7] = b.w; }
__device__ __forceinline__ void st8l(LAS float* p, const float (&o)[8]) { *(LAS f32x4*)p = (f32x4){o[0], o[1], o[2], o[3]}; *(LAS f32x4*)(p + 4) = (f32x4){o[4], o[5], o[6], o[7]}; }
namespace rwk {
typedef short bf16x8 __attribute__((ext_vector_type(8)));
typedef short s16x4 __attribute__((ext_vector_type(4)));
typedef short v4i16_t __attribute__((ext_vector_type(4)));
constexpr int SLOT = 8192;
#define RSL(s) (lds + (s) * SLOT)
#define RMFMA(a, b, c) __builtin_amdgcn_mfma_f32_16x16x32_bf16((a), (b), (c), 0, 0, 0)
__device__ __forceinline__ int swz(int row, int cb) { return row * 128 + (cb ^ ((row & 7) << 4)); }
struct Fr2 { bf16x8 k0, k1; };
__device__ __forceinline__ Fr2 ldf(const LAS unsigned char* base, int off) { Fr2 f; f.k0 = *(const LAS bf16x8*)(base + off); f.k1 = *(const LAS bf16x8*)(base + (off ^ 64)); return f; }
__device__ __forceinline__ s16x4 trd(const LAS unsigned char* p) { return __builtin_bit_cast(s16x4, __builtin_amdgcn_ds_read_tr16_b64_v4i16((LAS v4i16_t*)p)); }
__device__ __forceinline__ Fr2 ldt(const LAS unsigned char* base, int o0, int o1) {
    const s16x4 a = trd(base + o0), b = trd(base + o1), c = trd(base + o0 + 4096), d = trd(base + o1 + 4096);
    Fr2 f; f.k0 = (bf16x8){a[0], a[1], a[2], a[3], b[0], b[1], b[2], b[3]}; f.k1 = (bf16x8){c[0], c[1], c[2], c[3], d[0], d[1], d[2], d[3]}; return f; }
template <bool SWAP> __device__ __forceinline__ f32x4 mm(const Fr2& a, const Fr2& b, f32x4 c) {
    if (SWAP) { c = RMFMA(b.k0, a.k0, c); c = RMFMA(b.k1, a.k1, c); } else { c = RMFMA(a.k0, b.k0, c); c = RMFMA(a.k1, b.k1, c); } return c; }
__device__ __forceinline__ void st4(LAS unsigned char* slot, int off, f32x4 v) { u32x2g w; w.x = pkbf(v[0], v[1]); w.y = pkbf(v[2], v[3]); *(LAS u32x2g*)(slot + off) = w; }
__device__ __forceinline__ f32x4 M16(s16x4 a, s16x4 b, f32x4 c) { return __builtin_amdgcn_mfma_f32_16x16x16bf16_1k(a, b, c, 0, 0, 0); }
__device__ __forceinline__ s16x4 cv4(f32x4 v) { const u32x2g w = (u32x2g){pkbf(v[0], v[1]), pkbf(v[2], v[3])}; return __builtin_bit_cast(s16x4, w); }
__device__ __forceinline__ float bf1(short s) { return __uint_as_float(((unsigned)(unsigned short)s) << 16); }
__device__ __forceinline__ f32x4 ld4(const LAS unsigned char* slot, int off) { const u32x2g w = *(const LAS u32x2g*)(slot + off); return (f32x4){bflo(w.x), bfhi(w.x), bflo(w.y), bfhi(w.y)}; }
#define LBAR() asm volatile("s_waitcnt lgkmcnt(0)\n\ts_barrier" ::: "memory")
#define DPPF(x, ctrl, rmask) __int_as_float(__builtin_amdgcn_update_dpp(0, __float_as_int(x), (ctrl), (rmask), 0xF, true))
__device__ __forceinline__ float wave_scan(float x) {
    x += DPPF(x, 0x111, 0xF); x += DPPF(x, 0x112, 0xF); x += DPPF(x, 0x114, 0xF); x += DPPF(x, 0x118, 0xF);
    x += DPPF(x, 0x142, 0xA);
    x += DPPF(x, 0x143, 0xC);
    return x; }
__device__ __forceinline__ void unp8(const v4u w, float (&o)[8]) { o[0] = bflo(w.x); o[1] = bfhi(w.x); o[2] = bflo(w.y); o[3] = bfhi(w.y); o[4] = bflo(w.z); o[5] = bfhi(w.z); o[6] = bflo(w.w); o[7] = bfhi(w.w); }
__device__ __forceinline__ v4u pk8(const float (&o)[8]) { return (v4u){pkbf(o[0], o[1]), pkbf(o[2], o[3]), pkbf(o[4], o[5]), pkbf(o[6], o[7])}; }
}
struct RwX { bf16* P1; bf16* GT; bf16* Y0; bf16* H; bf16* VB0; bf16* VB1; float* GE; bf16* G; };
__device__ __forceinline__ void p6a_rwkv_local(Frame& F, const RwArgs& A, const RwX& X) {
    using namespace rwk;
    LAS unsigned char* lds = F.lds + RING_OFF;
    LAS float* part = (LAS float*)(F.lds + LDSCTL_OFF + 128);
    LAS float* cst = (LAS float*)(F.lds + LDSCTL_OFF + 128 + 4096 + 896);
    const int lane = F.lane, fr = lane & 15, fq = lane >> 4, w = F.wave, m0 = 16 * (w >> 1), n0a = 32 * (w & 1);
    const int fm = swz(m0 + fr, fq * 16);
    const int ta0 = swz(8 * fq + (fr >> 2), 2 * (m0 + 4 * (fr & 3))), ta1 = swz(8 * fq + 4 + (fr >> 2), 2 * (m0 + 4 * (fr & 3)));
    int fn[2], orm[2], otr[2], tb0[2], tb1[2];
#pragma unroll
    for (int t = 0; t < 2; ++t) { const int n0 = n0a + 16 * t; fn[t] = swz(n0 + fr, fq * 16); orm[t] = swz(m0 + fr, 2 * (n0 + 4 * fq)); otr[t] = swz(n0 + fr, 2 * (m0 + 4 * fq));
        tb0[t] = swz(8 * fq + (fr >> 2), 2 * (n0 + 4 * (fr & 3))); tb1[t] = swz(8 * fq + 4 + (fr >> 2), 2 * (n0 + 4 * (fr & 3))); }
    const int NJ = BATCH * NH * (SEQ / 64);
    const int tid = F.tid, ltok = tid >> 3, ldg = tid & 7;
    v4u g_r, g_k, g_v, g_xw, g_xa, g_xg0, g_xg1, g_pr;
#define P6A_LOAD(jj) do { const int u_ = (jj) >> 5, c_ = (jj) & 31; const size_t gr_ = (size_t)(u_ >> 3) * SEQ + c_ * 64 + ltok; const int cb_ = 64 * (u_ & 7) + 8 * ldg; const bf16* rp_ = A.RW + gr_ * RWP; \
        g_r = *(const v4u*)(rp_ + cb_); g_k = *(const v4u*)(rp_ + 512 + cb_); g_v = *(const v4u*)(rp_ + 1024 + cb_); \
        { const bf16* ap_ = A.RW + (size_t)M * RWP + gr_ * 256 + 8 * ldg;         \
          g_xw = *(const v4u*)(ap_); g_xa = *(const v4u*)(ap_ + 64); g_xg0 = *(const v4u*)(ap_ + 128); g_xg1 = *(const v4u*)(ap_ + 192); } \
        g_pr = (v4u){0u, 0u, 0u, 0u}; if (ltok < 7 && c_ > 0) g_pr = *(const v4u*)(A.RW + ((size_t)(u_ >> 3) * SEQ + c_ * 64 - 1) * RWP + (ltok < 3 ? 512 * ltok + cb_ : 1536 + 64 * (ltok - 3) + 8 * ldg)); } while (0)
    if ((int)blockIdx.x < NJ) P6A_LOAD((int)blockIdx.x);
    int hcur = -1;
    LAS unsigned char* prow = (LAS unsigned char*)(F.lds + LDSCTL_OFF + 128 + 4096);
    if (tid < 256) cst[512 + tid] = A.mu[1536 + tid];
    u32x2g s_p1[2], s_gt[2], s_y0[2], s_hh[2]; size_t s_jo = 0; bool s_have = false;
#define P6A_PK(S) ((v4u){S[0].x, S[0].y, S[1].x, S[1].y})
#define P6A_STORE() do { const size_t so_ = s_jo + (size_t)(w * 64 + lane) * 8; \
            pg8::st16<true>(X.P1, (unsigned)so_ * 2u, P6A_PK(s_p1)); pg8::st16<true>(X.GT, (unsigned)so_ * 2u, P6A_PK(s_gt)); pg8::st16<true>(X.Y0, (unsigned)so_ * 2u, P6A_PK(s_y0)); pg8::st16<true>(X.H, (unsigned)so_ * 2u, P6A_PK(s_hh)); } while (0)
    for (int job = blockIdx.x; job < NJ; job += F.G) {
        const int unit = job >> 5, c = job & 31; const int h = unit & 7; const int cb = 64 * h + 8 * w; const size_t jo = (size_t)job * 4096;
        {
            const int so = swz(ltok, 16 * ldg);
            *(LAS v4u*)(RSL(12) + so) = g_r; *(LAS v4u*)(RSL(2) + so) = g_k; *(LAS v4u*)(RSL(0) + so) = g_v;
            *(LAS v4u*)(RSL(14) + so) = g_xw; *(LAS v4u*)(RSL(13) + so) = g_xa; *(LAS v4u*)(RSL(7) + so) = g_xg0; *(LAS v4u*)(RSL(18) + so) = g_xg1;
            if (ltok < 7) *(LAS v4u*)(prow + ltok * 128 + 16 * ldg) = g_pr;
            if (h != hcur) {
                *(LAS v4u*)(RSL(16) + so) = *(const v4u*)(A.W2T + (size_t)(64 * h + ltok) * 64 + 8 * ldg); *(LAS v4u*)(RSL(17) + so) = *(const v4u*)(A.A2T + (size_t)(64 * h + ltok) * 64 + 8 * ldg);
                *(LAS v4u*)(RSL(10) + so) = *(const v4u*)(A.G2T + (size_t)(64 * h + ltok) * 128 + 8 * ldg); *(LAS v4u*)(RSL(11) + so) = *(const v4u*)(A.G2T + (size_t)(64 * h + ltok) * 128 + 64 + 8 * ldg);
                { const int a_ = tid >> 6, i_ = tid & 63;
                  const float* src_ = (a_ == 0) ? A.mu : (a_ == 1) ? A.mu + 512 : (a_ == 2) ? A.mu + 1024 : (a_ == 3) ? A.k_k : (a_ == 4) ? A.k_a : (a_ == 5) ? A.r_k : (a_ == 6) ? A.w0 : A.a0;
                  cst[a_ * 64 + i_] = src_[64 * h + i_]; } }
            hcur = h;
        }
        if (s_have) P6A_STORE();
        { const int nj = job + F.G; if (nj < NJ) P6A_LOAD(nj); }
        LBAR();
        float r[8], k[8], v[8];
        {
            const int so = swz(lane, 16 * w), sp = swz((lane + 63) & 63, 16 * w);
#define P6A_SHIFT(slot, pi, moff, dst) do { float c_[8], p_[8], m_[8]; v4u wc_ = *(const LAS v4u*)(RSL(slot) + so), wp_ = *(const LAS v4u*)(RSL(slot) + sp); \
                if (lane == 0) wp_ = *(const LAS v4u*)(prow + 128 * (pi) + 16 * w); \
                unp8(wc_, c_); unp8(wp_, p_); ld8l(cst + (moff) + 8 * w, m_); \
                _Pragma("unroll") for (int j = 0; j < 8; ++j) dst[j] = c_[j] + (p_[j] - c_[j]) * m_[j]; } while (0)
            P6A_SHIFT(12, 0, 0, r);
            P6A_SHIFT(2, 1, 64, k);
            { float kkc_[8]; ld8l(cst + 192 + 8 * w, kkc_); float ssp_ = 0.f;
#pragma unroll
              for (int j = 0; j < 8; ++j) { const float q_ = k[j] * kkc_[j]; ssp_ += q_ * q_; }
              part[w * 64 + lane] = ssp_; }
            P6A_SHIFT(0, 2, 128, v); asm volatile("" ::: "memory");
            if (tid < 256) { const int cl = tid & 63; const int sl = (w == 0) ? 14 : (w == 1) ? 13 : (w == 2) ? 7 : 18;
                LAS unsigned short* p0_ = (LAS unsigned short*)(RSL(sl) + 2 * cl);
                const float c_ = __uint_as_float((unsigned)*p0_ << 16), p_ = __uint_as_float((unsigned)*(const LAS unsigned short*)(prow + 128 * (3 + w) + 2 * cl) << 16);
                float s_ = c_ + (p_ - c_) * cst[512 + tid];
                if (w == 0) s_ = 2.0f * pg8::sigmoid_f(2.0f * s_) - 1.0f; else if (w >= 2) s_ = pg8::sigmoid_f(s_);
                *p0_ = (unsigned short)(pkbf(s_, s_) & 0xffffu); }
#undef P6A_SHIFT
        }
        LBAR();
        {
            const f32x4 z4 = (f32x4){0.f, 0.f, 0.f, 0.f};
            {   const Fr2 aW = ldf(RSL(14), fm), aA = ldf(RSL(13), fm); Fr2 bW[2], bA[2];
#pragma unroll
                for (int t = 0; t < 2; ++t) { bW[t] = ldf(RSL(16), fn[t]); bA[t] = ldf(RSL(17), fn[t]); }
#pragma unroll
                for (int t = 0; t < 2; ++t) { const int row = m0 + fr, ch = n0a + 16 * t + 4 * fq; const f32x4 lwq = mm<true>(aW, bW[t], z4), alq = mm<true>(aA, bA[t], z4);
                    const f32x4 w0c = *(const LAS f32x4*)(cst + 384 + ch), a0c = *(const LAS f32x4*)(cst + 448 + ch); f32x4 lwv, alv;
#pragma unroll
                    for (int x = 0; x < 4; ++x) { lwv[x] = -0.6065306597126334f * pg8::sigmoid_f(w0c[x] + lwq[x]); alv[x] = pg8::sigmoid_f(a0c[x] + alq[x]); }
                    const int fo = row * 256 + (((ch >> 3) ^ (row & 7)) << 5) + ((ch >> 2) & 1) * 16;
                    *(LAS f32x4*)(RSL(m0 < 32 ? 12 : 15) + fo - (m0 < 32 ? 0 : 8192)) = lwv; *(LAS f32x4*)(RSL(8) + fo) = alv; } }
            asm volatile("" ::: "memory");
            {   const Fr2 aG0 = ldf(RSL(7), fm), aG1 = ldf(RSL(18), fm); Fr2 bG0[2], bG1[2];
#pragma unroll
                for (int t = 0; t < 2; ++t) { bG0[t] = ldf(RSL(10), fn[t]); bG1[t] = ldf(RSL(11), fn[t]); }
#pragma unroll
                for (int t = 0; t < 2; ++t) st4(RSL(3), orm[t], mm<true>(aG1, bG1[t], mm<true>(aG0, bG0[t], z4))); }
        }
        LBAR();
        float kf[8], kk[8], al[8], lw[8]; float bpp = 0.f;
        {
            { const int fo = lane * 256 + ((w ^ (lane & 7)) << 5); const LAS unsigned char* lwp = RSL(lane < 32 ? 12 : 15) + fo - (lane < 32 ? 0 : 8192);
              const f32x4 a_ = *(const LAS f32x4*)(lwp), b_ = *(const LAS f32x4*)(lwp + 16), c_ = *(const LAS f32x4*)(RSL(8) + fo), d_ = *(const LAS f32x4*)(RSL(8) + fo + 16);
              lw[0] = a_.x; lw[1] = a_.y; lw[2] = a_.z; lw[3] = a_.w; lw[4] = b_.x; lw[5] = b_.y; lw[6] = b_.z; lw[7] = b_.w;
              al[0] = c_.x; al[1] = c_.y; al[2] = c_.z; al[3] = c_.w; al[4] = d_.x; al[5] = d_.y; al[6] = d_.z; al[7] = d_.w; }
            pg8::st16<true>(X.G, (unsigned)(jo + tid * 8) * 2u, *(const LAS v4u*)(RSL(3) + swz(ltok, 16 * ldg)));
            float ss = 0.f;
#pragma unroll
            for (int i = 0; i < 8; ++i) ss += part[i * 64 + lane];
            float kkc[8], kac[8], rkc[8]; ld8l(cst + 192 + 8 * w, kkc); ld8l(cst + 256 + 8 * w, kac); ld8l(cst + 320 + 8 * w, rkc);
#pragma unroll
            for (int j = 0; j < 8; ++j) { kk[j] = k[j] * kkc[j]; kf[j] = k[j] * (1.0f + (al[j] - 1.0f) * kac[j]); bpp += r[j] * kf[j] * rkc[j]; }
            part[512 + w * 64 + lane] = bpp;
            asm volatile("" ::: "memory");
            const float inv = 1.0f / fmaxf(sqrtf(ss), 1e-12f);
            float at[8], rt[8], bt[8], kt[8], bh[8], kh[8], ge[8];
#pragma unroll
            for (int j = 0; j < 8; ++j) {
                const float cs = wave_scan(lw[j]);
                const float e_cs = __builtin_amdgcn_exp2f(cs * 1.4426950408889634f);
                const float e_ce = __int_as_float(__builtin_amdgcn_readlane(__float_as_int(e_cs), 63));
                const float e_csm = __int_as_float(__builtin_amdgcn_update_dpp(0x3f800000, __float_as_int(e_cs), 0x138, 0xF, 0xF, false));
                const float e_neg = __builtin_amdgcn_rcpf(e_cs), e_end = e_ce * e_neg;
                const float kn = kk[j] * inv, bb = kn * al[j];
                at[j] = -kn * e_csm; rt[j] = r[j] * e_cs; bt[j] = bb * e_neg; kt[j] = kf[j] * e_neg; bh[j] = bb * e_end; kh[j] = kf[j] * e_end; ge[j] = e_cs;
            }
            const int ro = swz(lane, 16 * w);
            *(LAS v4u*)(RSL(0) + ro) = pk8(at); *(LAS v4u*)(RSL(1) + ro) = pk8(rt); *(LAS v4u*)(RSL(2) + ro) = pk8(bt); *(LAS v4u*)(RSL(18) + ro) = pk8(kt);
            *(LAS v4u*)(RSL(4) + ro) = pk8(bh); *(LAS v4u*)(RSL(5) + ro) = pk8(kh); *(LAS v4u*)(RSL(6) + ro) = pk8(v);
            if (lane == 63) { *(f32x4*)(X.GE + (size_t)job * 64 + 8 * w) = (f32x4){ge[0], ge[1], ge[2], ge[3]}; *(f32x4*)(X.GE + (size_t)job * 64 + 8 * w + 4) = (f32x4){ge[4], ge[5], ge[6], ge[7]}; }
        }
        LBAR();
        {
            {
                float bon = 0.f;
#pragma unroll
                for (int i = 0; i < 8; ++i) bon += part[512 + i * 64 + ltok];
                float vv[8]; unp8(*(const LAS v4u*)(RSL(6) + swz(ltok, 16 * ldg)), vv);
#pragma unroll
                for (int j = 0; j < 8; ++j) vv[j] *= bon;
                bf16* vbp = (job < 2048) ? (X.VB0 + jo) : (X.VB1 + (jo - (size_t)2048 * 4096)); *(v4u*)(vbp + tid * 8) = pk8(vv); }
            const f32x4 z4 = (f32x4){0.f, 0.f, 0.f, 0.f};
            const Fr2 aA = ldf(RSL(0), fm), aR = ldf(RSL(1), fm); Fr2 bB[2], bK[2];
#pragma unroll
            for (int t = 0; t < 2; ++t) { bB[t] = ldf(RSL(2), fn[t]); bK[t] = ldf(RSL(18), fn[t]); }
            f32x4 nab[2], nabT[2], nak[2], mrb[2], mrk[2];
#pragma unroll
            for (int t = 0; t < 2; ++t) { nab[t] = mm<true>(aA, bB[t], z4); nabT[t] = mm<false>(aA, bB[t], z4); nak[t] = mm<true>(aA, bK[t], z4); mrb[t] = mm<true>(aR, bB[t], z4); mrk[t] = mm<true>(aR, bK[t], z4); }
#pragma unroll
            for (int t = 0; t < 2; ++t) { const int n0 = n0a + 16 * t;
#pragma unroll
                for (int x = 0; x < 4; ++x) { const int i = m0 + fr, j = n0 + 4 * fq + x;
                    if (j >= i) { nab[t][x] = 0.f; nak[t][x] = 0.f; } if (j > i) { mrb[t][x] = 0.f; mrk[t][x] = 0.f; }
                    const int it = m0 + 4 * fq + x, jt = n0 + fr; if (jt >= it) nabT[t][x] = 0.f; }
                st4(RSL(12), orm[t], nab[t]);
                st4(RSL(7), orm[t], nak[t]); st4(RSL(8), orm[t], mrb[t]); st4(RSL(9), orm[t], mrk[t]); }
            const int dsel = (w == 2 || w == 7) ? 1 : 0;
            if (w == 0 || w == 2 || w == 5 || w == 7) {
                const f32x4 dPT = dsel ? nab[1] : nab[0], dP = dsel ? nabT[1] : nabT[0];
                f32x4 XT;
#pragma unroll
                for (int x = 0; x < 4; ++x) XT[x] = dPT[x] + ((4 * fq + x == fr) ? 1.0f : 0.f);
                const s16x4 bP = cv4(dP), bPT = cv4(dPT);
                const f32x4 P2 = M16(bPT, bP, z4), P2T = M16(bP, bPT, z4);
                const s16x4 bP2 = cv4(P2), bP2T = cv4(P2T);
                XT = M16(bP2, cv4(XT), XT);
                const f32x4 P4 = M16(bP2T, bP2, z4), P4T = M16(bP2, bP2T, z4);
                const s16x4 bP4 = cv4(P4), bP4T = cv4(P4T);
                XT = M16(bP4, cv4(XT), XT);
                const f32x4 P8 = M16(bP4T, bP4, z4);
                XT = M16(cv4(P8), cv4(XT), XT);
                *(LAS s16x4*)(RSL(13) + (m0 >> 4) * 512 + fr * 32 + fq * 8) = cv4(XT);
            }
        }
        LBAR();
        {
            const f32x4 z4 = (f32x4){0.f, 0.f, 0.f, 0.f};
            const int cs = 16 * (w & 3);
            s16x4 tA[4], nA[6];
#pragma unroll
            for (int i = 0; i < 4; ++i) tA[i] = *(const LAS s16x4*)(RSL(13) + i * 512 + fr * 32 + fq * 8);
            {   int q = 0;
#pragma unroll
                for (int i = 1; i < 4; ++i)
#pragma unroll
                    for (int j = 0; j < i; ++j) nA[q++] = *(const LAS s16x4*)(RSL(12) + swz(16 * i + fr, 2 * (16 * j + 4 * fq))); }
            f32x4 acc[4];
            if (w < 4) {
#pragma unroll
                for (int i = 0; i < 4; ++i) { const s16x4 r = trd(RSL(0) + swz(16 * i + 4 * fq + (fr >> 2), 2 * (cs + 4 * (fr & 3))));
                    acc[i] = (f32x4){bf1(r[0]), bf1(r[1]), bf1(r[2]), bf1(r[3])}; }
            } else {
                s16x4 vB[4], kA[10];
#pragma unroll
                for (int j = 0; j < 4; ++j) vB[j] = trd(RSL(6) + swz(16 * j + 4 * fq + (fr >> 2), 2 * (cs + 4 * (fr & 3))));
                {   int q = 0;
#pragma unroll
                    for (int i = 0; i < 4; ++i)
#pragma unroll
                        for (int j = 0; j <= i; ++j) kA[q++] = *(const LAS s16x4*)(RSL(7) + swz(16 * i + fr, 2 * (16 * j + 4 * fq))); }
                {   int q = 0;
#pragma unroll
                    for (int i = 0; i < 4; ++i) { acc[i] = z4;
#pragma unroll
                        for (int j = 0; j <= i; ++j) acc[i] = M16(kA[q++], vB[j], acc[i]); } }
            }
            s16x4 yB[4];
            {   int q = 0;
#pragma unroll
                for (int i = 0; i < 4; ++i) {
#pragma unroll
                    for (int j = 0; j < i; ++j) acc[i] = M16(nA[q++], yB[j], acc[i]);
                    const f32x4 y = M16(tA[i], cv4(acc[i]), z4); yB[i] = cv4(y);
                    *(LAS s16x4*)(RSL(w < 4 ? 3 : 15) + swz(cs + fr, 2 * (16 * i + 4 * fq))) = yB[i]; } }
        }
        LBAR();
        {
            const f32x4 z4 = (f32x4){0.f, 0.f, 0.f, 0.f};
            f32x4 p1[2], y0[2], gt[2], hh[2];
            {   const Fr2 aMb = ldf(RSL(8), fm), aMk = ldf(RSL(9), fm); Fr2 bW[2], bU[2], bV[2]; f32x4 cR[2];
#pragma unroll
                for (int t = 0; t < 2; ++t) { bW[t] = ldf(RSL(3), fn[t]); bU[t] = ldf(RSL(15), fn[t]); bV[t] = ldt(RSL(6), tb0[t], tb1[t]); cR[t] = ld4(RSL(1), orm[t]); }
#pragma unroll
                for (int t = 0; t < 2; ++t) { p1[t] = mm<true>(aMb, bW[t], cR[t]); y0[t] = mm<true>(aMk, bV[t], mm<true>(aMb, bU[t], z4)); } }
            {   const Fr2 aW = ldf(RSL(3), fm), aU = ldf(RSL(15), fm), aV = ldt(RSL(6), ta0, ta1); Fr2 bBh[2], bKh[2];
#pragma unroll
                for (int t = 0; t < 2; ++t) { bBh[t] = ldt(RSL(4), tb0[t], tb1[t]); bKh[t] = ldt(RSL(5), tb0[t], tb1[t]); }
#pragma unroll
                for (int t = 0; t < 2; ++t) { gt[t] = mm<false>(aW, bBh[t], z4); hh[t] = mm<true>(aV, bKh[t], mm<true>(aU, bBh[t], z4)); } }
#pragma unroll
            for (int t = 0; t < 2; ++t) {
                s_p1[t].x = pkbf(p1[t][0], p1[t][1]); s_p1[t].y = pkbf(p1[t][2], p1[t][3]); s_gt[t].x = pkbf(gt[t][0], gt[t][1]); s_gt[t].y = pkbf(gt[t][2], gt[t][3]);
                s_y0[t].x = pkbf(y0[t][0], y0[t][1]); s_y0[t].y = pkbf(y0[t][2], y0[t][3]); s_hh[t].x = pkbf(hh[t][0], hh[t][1]); s_hh[t].y = pkbf(hh[t][2], hh[t][3]); }
            s_jo = jo; s_have = true;
        }
    }
    if (s_have) P6A_STORE();
#undef P6A_LOAD
#undef P6A_STORE
#undef P6A_PK
    LBAR();
}
__device__ __forceinline__ void p6b_rwkv_seq(Frame& F, const RwArgs& A, const RwX& X, int nwg) {
    using namespace rwk;
    LAS unsigned char* lds = F.lds + RING_OFF;
    constexpr int YLD = 68, NC = SEQ / 64;
    LAS float* Yf0 = (LAS float*)RSL(6);
    LAS float* gel = (LAS float*)RSL(14); LAS float* lnl = gel + 128;
    const int tid = F.tid, lane = F.lane, fr = lane & 15, fq = lane >> 4;
    const int w = F.wave, ws = w & 3;
    const int t2 = tid & 255, otok = t2 >> 2, oq = t2 & 3;
    for (int unit = blockIdx.x; unit < BATCH * NH; unit += nwg) {
        const int b = unit >> 3, h = unit & 7; const int cb = 64 * h + 16 * oq;
        if (tid < 128) lnl[tid] = (tid < 64) ? A.ln_w[64 * h + tid] : A.ln_b[64 * h + tid - 64];
        if (w < 4) {
            int orm[4], otr[4];
#pragma unroll
            for (int i = 0; i < 4; ++i) { orm[i] = swz(16 * ws + fr, 2 * (16 * i + 4 * fq)); otr[i] = swz(16 * i + fr, 2 * (16 * ws + 4 * fq)); }
            f32x4 sT[4];
#pragma unroll
            for (int jb = 0; jb < 4; ++jb) sT[jb] = (f32x4){0.f, 0.f, 0.f, 0.f};
            struct Nx { v4u p1[2], gt[2], y0[2], h[2]; float ge; };
            Nx nA, nB, nC, nD;
#define P6B_FR(V, i) ((i) & 1 ? (u32x2g){V[(i) >> 1].z, V[(i) >> 1].w} : (u32x2g){V[(i) >> 1].x, V[(i) >> 1].y})
#define P6B_LOAD(cc, N) do { const int job_ = unit * 32 + (cc); const size_t jo_ = (size_t)job_ * 4096; \
                _Pragma("unroll") for (int q = 0; q < 2; ++q) { const int fo_ = ((2 * ws + q) * 64 + lane) * 8; \
                    N.p1[q] = *(const v4u*)(X.P1 + jo_ + fo_); N.gt[q] = *(const v4u*)(X.GT + jo_ + fo_); N.y0[q] = *(const v4u*)(X.Y0 + jo_ + fo_); N.h[q] = *(const v4u*)(X.H + jo_ + fo_); } \
                if (w == 0) N.ge = X.GE[(size_t)job_ * 64 + lane]; } while (0)
#define P6B_STEP(c, N) do { if ((c) >= NC) break; const int par = (c) & 1; \
                _Pragma("unroll") for (int i = 0; i < 4; ++i) { *(LAS u32x2g*)(RSL(par) + orm[i]) = P6B_FR(N.p1, i); *(LAS u32x2g*)(RSL(2 + par) + otr[i]) = P6B_FR(N.gt, i); *(LAS u32x2g*)(RSL(4 + par) + orm[i]) = P6B_FR(N.y0, i); } \
                if (w == 0) gel[par * 64 + lane] = N.ge; \
                u32x2g hc[4]; _Pragma("unroll") for (int i = 0; i < 4; ++i) hc[i] = P6B_FR(N.h, i); \
                if ((c) + 4 < NC) P6B_LOAD((c) + 4, N); \
                LBAR(); \
                s16x4 sb[4]; _Pragma("unroll") for (int jb = 0; jb < 4; ++jb) sb[jb] = cv4(sT[jb]);                     \
                _Pragma("unroll") for (int tb = 0; tb < 4; ++tb) { \
                    const s16x4 y0r = trd(RSL(4 + par) + swz(16 * tb + 4 * fq + (fr >> 2), 2 * (16 * ws + 4 * (fr & 3))));       \
                    f32x4 ya = (f32x4){bf1(y0r[0]), bf1(y0r[1]), bf1(y0r[2]), bf1(y0r[3])}; \
                    _Pragma("unroll") for (int jb = 0; jb < 4; ++jb) ya = M16(*(const LAS s16x4*)(RSL(par) + swz(16 * tb + fr, 2 * (16 * jb + 4 * fq))), sb[jb], ya); \
                    _Pragma("unroll") for (int x = 0; x < 4; ++x) Yf0[par * (64 * YLD) + (16 * tb + 4 * fq + x) * YLD + 16 * ws + fr] = ya[x]; } \
                _Pragma("unroll") for (int jb = 0; jb < 4; ++jb) { \
                    const f32x4 gej = *(const LAS f32x4*)(gel + par * 64 + 16 * jb + 4 * fq); \
                    f32x4 sa = sT[jb] * gej + (f32x4){bflo(hc[jb].x), bfhi(hc[jb].x), bflo(hc[jb].y), bfhi(hc[jb].y)}; \
                    _Pragma("unroll") for (int kb = 0; kb < 4; ++kb) sa = M16(*(const LAS s16x4*)(RSL(2 + par) + swz(16 * jb + fr, 2 * (16 * kb + 4 * fq))), sb[kb], sa); \
                    sT[jb] = sa; } } while (0)
            P6B_LOAD(0, nA); P6B_LOAD(1, nB); P6B_LOAD(2, nC); P6B_LOAD(3, nD);
            for (int c = 0; c < NC; c += 4) { P6B_STEP(c, nA); P6B_STEP(c + 1, nB); P6B_STEP(c + 2, nC); P6B_STEP(c + 3, nD); }
#undef P6B_STEP
#undef P6B_LOAD
#undef P6B_FR
            LBAR();
        } else {
#define P6B_LOADV(cc, V) do { const int job_ = unit * 32 + (cc); const size_t jo_ = (size_t)job_ * 4096; const bf16* vbp_ = (job_ < 2048) ? (X.VB0 + jo_) : (X.VB1 + (jo_ - (size_t)2048 * 4096)); \
                _Pragma("unroll") for (int q = 0; q < 2; ++q) { V[q] = *(const v4u*)(vbp_ + otok * 64 + 16 * oq + 8 * q); V[2 + q] = *(const v4u*)(X.G + jo_ + otok * 64 + 16 * oq + 8 * q); } } while (0)
#define P6B_OUT(par, V, grow_) do { float y[16]; \
                { float t8[8]; ld8l(Yf0 + (par) * (64 * YLD) + otok * YLD + 16 * oq, t8); _Pragma("unroll") for (int j = 0; j < 8; ++j) y[j] = t8[j]; \
                  ld8l(Yf0 + (par) * (64 * YLD) + otok * YLD + 16 * oq + 8, t8); _Pragma("unroll") for (int j = 0; j < 8; ++j) y[8 + j] = t8[j]; } \
                float s_ = 0.f; _Pragma("unroll") for (int j = 0; j < 16; ++j) s_ += y[j]; \
                s_ = DPP_ADD(s_, 0xB1); s_ = DPP_ADD(s_, 0x4E); const float mean = s_ * (1.0f / 64.0f); float q_ = 0.f; \
                _Pragma("unroll") for (int j = 0; j < 16; ++j) { y[j] -= mean; q_ += y[j] * y[j]; } \
                q_ = DPP_ADD(q_, 0xB1); q_ = DPP_ADD(q_, 0x4E); const float rstd = __builtin_amdgcn_rsqf(q_ * (1.0f / 64.0f) + LNX_EPS); \
                _Pragma("unroll") for (int q = 0; q < 2; ++q) { float gg[8], vv[8], ov[8], lw_[8], lb_[8]; unp8(V[2 + q], gg); unp8(V[q], vv); ld8l(lnl + 16 * oq + 8 * q, lw_); ld8l(lnl + 64 + 16 * oq + 8 * q, lb_); \
                    _Pragma("unroll") for (int j = 0; j < 8; ++j) ov[j] = (y[8 * q + j] * rstd * lw_[j] + lb_[j] + vv[j]) * gg[j]; \
                    *(GAS v4u*)(A.QO + (size_t)(grow_) * D + 512 + cb + 8 * q) = pk8(ov); } } while (0)
#define P6B_STEP(c, SV) do { if ((c) >= NC) break; \
                LBAR(); \
                if ((c) > 0) { P6B_OUT(((c) - 1) & 1, SV, b * SEQ + ((c) - 1) * 64 + otok);         \
                               if ((c) + 3 < NC) P6B_LOADV((c) + 3, SV); } } while (0)
            v4u v0[4], v1[4], v2[4], v3[4];
            P6B_LOADV(0, v0); P6B_LOADV(1, v1); P6B_LOADV(2, v2); P6B_LOADV(3, v3);
            for (int c = 0; c < NC; c += 4) { P6B_STEP(c, v3); P6B_STEP(c + 1, v0); P6B_STEP(c + 2, v1); P6B_STEP(c + 3, v2); }
#undef P6B_STEP
            LBAR();
            P6B_OUT((NC - 1) & 1, v3, b * SEQ + (NC - 1) * 64 + otok);
#undef P6B_LOADV
#undef P6B_OUT
        }
        LBAR();
    }
}

namespace sba {
using bf16x8 = __attribute__((ext_vector_type(8))) short;
using s16x4 = __attribute__((ext_vector_type(4))) short;
using f32x16 = __attribute__((ext_vector_type(16))) float;
using u32x4 = __attribute__((ext_vector_type(4))) unsigned;
constexpr int QB = 256, KVBLK = 64;
constexpr int LDS_K = 0, LDS_V = 16384, LDS_ST = 32768, ST_LD = 68, LDS_FLAG = LDS_ST + 8 * 32 * ST_LD * 4, LDS_BYTES_ATT = LDS_FLAG + 64;
constexpr float R_DEAD = -160.0f;
#define SBAR() __builtin_amdgcn_sched_barrier(0)
typedef float f32x2_t __attribute__((ext_vector_type(2))); typedef __bf16 bf16x2_t __attribute__((ext_vector_type(2)));
__device__ __forceinline__ unsigned cvtpk_s(float lo, float hi) { f32x2_t v = {lo, hi}; bf16x2_t b = __builtin_convertvector(v, bf16x2_t); return __builtin_bit_cast(unsigned, b); }
__device__ __forceinline__ void qkt(f32x16& p0, f32x16& p1, const char* Kslot, const bf16x8* qr, int r32, int hi) {
    const char* kb = Kslot + hi * 1024 + r32 * 16;
    const f32x16 z = f32x16{};
#pragma unroll
    for (int d0 = 0; d0 < 4; ++d0) {
        const bf16x8 b0 = *reinterpret_cast<const bf16x8*>(kb + d0 * 2048);
        const bf16x8 b1 = *reinterpret_cast<const bf16x8*>(kb + d0 * 2048 + 512);
        if (d0 == 0) { p0 = __builtin_amdgcn_mfma_f32_32x32x16_bf16(b0, qr[0], z, 0, 0, 0); p1 = __builtin_amdgcn_mfma_f32_32x32x16_bf16(b1, qr[0], z, 0, 0, 0); }
        else { p0 = __builtin_amdgcn_mfma_f32_32x32x16_bf16(b0, qr[d0], p0, 0, 0, 0); p1 = __builtin_amdgcn_mfma_f32_32x32x16_bf16(b1, qr[d0], p1, 0, 0, 0); }
    }
}
__device__ __forceinline__ void pv(f32x16* o, int vb, bf16x8 pa0, bf16x8 pa1, bf16x8 pa2, bf16x8 pa3) {
#pragma unroll
    for (int d0 = 0; d0 < 2; ++d0) { s16x4 lo[4], hi[4];
#pragma unroll
        for (int ks = 0; ks < 4; ++ks) {
            asm volatile("ds_read_b64_tr_b16 %0,%1 offset:%c2" : "=&v"(lo[ks]) : "v"(vb), "i"(d0 * 4096 + ks * 1024) : "memory");
            asm volatile("ds_read_b64_tr_b16 %0,%1 offset:%c2" : "=&v"(hi[ks]) : "v"(vb), "i"(d0 * 4096 + ks * 1024 + 512) : "memory"); }
        asm volatile("s_waitcnt lgkmcnt(0)" ::: "memory"); SBAR();
#define PK(k) (bf16x8){lo[k][0], lo[k][1], lo[k][2], lo[k][3], hi[k][0], hi[k][1], hi[k][2], hi[k][3]}
        o[d0] = __builtin_amdgcn_mfma_f32_32x32x16_bf16(pa0, PK(0), o[d0], 0, 0, 0);
        o[d0] = __builtin_amdgcn_mfma_f32_32x32x16_bf16(pa1, PK(1), o[d0], 0, 0, 0);
        o[d0] = __builtin_amdgcn_mfma_f32_32x32x16_bf16(pa2, PK(2), o[d0], 0, 0, 0);
        o[d0] = __builtin_amdgcn_mfma_f32_32x32x16_bf16(pa3, PK(3), o[d0], 0, 0, 0);
#undef PK
    }
}
__device__ __forceinline__ float swap_sum(float x, float& other_if_lo, int hi) {
    auto rr = __builtin_amdgcn_permlane32_swap(__float_as_uint(x), __float_as_uint(x), false, false);
    const float a = __uint_as_float(rr[0]), b = __uint_as_float(rr[1]);
    other_if_lo = hi ? 0.f : b;
    return a + b;
}
__device__ __forceinline__ float swap_prod(float x, float& other_if_lo, int hi) {
    auto rr = __builtin_amdgcn_permlane32_swap(__float_as_uint(x), __float_as_uint(x), false, false);
    const float a = __uint_as_float(rr[0]), b = __uint_as_float(rr[1]);
    other_if_lo = hi ? 1.0f : b;
    return a * b;
}
__device__ __forceinline__ void stick_tile(f32x16& p0, f32x16& p1, float& R, f32x16* o, int jt, bool diag, int qrow, int hi, int vb0) {
    const int kb = 64 * jt + 4 * hi;
#pragma unroll
    for (int r = 0; r < 16; ++r) {
        { float rr = __builtin_amdgcn_rcpf(1.0f + __builtin_amdgcn_exp2f(p0[r]));
          if (diag) { const int key = kb + (r & 3) + 8 * (r >> 2); if (key >= qrow) rr = 1.0f; }
          p0[r] = rr; }
        { float rr = __builtin_amdgcn_rcpf(1.0f + __builtin_amdgcn_exp2f(p1[r]));
          if (diag) { const int key = kb + 32 + (r & 3) + 8 * (r >> 2); if (key >= qrow) rr = 1.0f; }
          p1[r] = rr; }
    }
    float c0[4], c1[4], x0[4], x1[4];
#pragma unroll
    for (int g = 0; g < 4; ++g) {
        const float s0 = (p0[4 * g] * p0[4 * g + 1]) * (p0[4 * g + 2] * p0[4 * g + 3]);
        const float s1 = (p1[4 * g] * p1[4 * g + 1]) * (p1[4 * g + 2] * p1[4 * g + 3]);
        c0[g] = swap_prod(s0, x0[g], hi); c1[g] = swap_prod(s1, x1[g], hi);
    }
    const float Cr = __builtin_amdgcn_exp2f(R);
    float suf0[4], suf1[4];
    suf1[3] = Cr; suf1[2] = suf1[3] * c1[3]; suf1[1] = suf1[2] * c1[2]; suf1[0] = suf1[1] * c1[1];
    suf0[3] = suf1[0] * c1[0]; suf0[2] = suf0[3] * c0[3]; suf0[1] = suf0[2] * c0[2]; suf0[0] = suf0[1] * c0[1];
    R += __builtin_amdgcn_logf(((c0[0] * c0[1]) * (c0[2] * c0[3])) * ((c1[0] * c1[1]) * (c1[2] * c1[3])));
#pragma unroll
    for (int g = 0; g < 4; ++g) {
        { const float e3 = suf0[g] * x0[g], e2 = e3 * p0[4 * g + 3], e1 = e2 * p0[4 * g + 2], e0 = e1 * p0[4 * g + 1];
          p0[4 * g + 3] = (1.0f - p0[4 * g + 3]) * e3; p0[4 * g + 2] = (1.0f - p0[4 * g + 2]) * e2; p0[4 * g + 1] = (1.0f - p0[4 * g + 1]) * e1; p0[4 * g] = (1.0f - p0[4 * g]) * e0; }
        { const float e3 = suf1[g] * x1[g], e2 = e3 * p1[4 * g + 3], e1 = e2 * p1[4 * g + 2], e0 = e1 * p1[4 * g + 1];
          p1[4 * g + 3] = (1.0f - p1[4 * g + 3]) * e3; p1[4 * g + 2] = (1.0f - p1[4 * g + 2]) * e2; p1[4 * g + 1] = (1.0f - p1[4 * g + 1]) * e1; p1[4 * g] = (1.0f - p1[4 * g]) * e0; }
    }
#define PKW(P, B) cvtpk_s(P[B], P[B + 1])
    const u32x4 pw0 = (u32x4){PKW(p0, 0), PKW(p0, 2), PKW(p0, 4), PKW(p0, 6)}, pw1 = (u32x4){PKW(p0, 8), PKW(p0, 10), PKW(p0, 12), PKW(p0, 14)};
    const u32x4 pw2 = (u32x4){PKW(p1, 0), PKW(p1, 2), PKW(p1, 4), PKW(p1, 6)}, pw3 = (u32x4){PKW(p1, 8), PKW(p1, 10), PKW(p1, 12), PKW(p1, 14)};
#undef PKW
    SBAR();
    asm volatile("s_waitcnt lgkmcnt(0)" ::: "memory");
    pv(o, vb0, __builtin_bit_cast(bf16x8, pw0), __builtin_bit_cast(bf16x8, pw1), __builtin_bit_cast(bf16x8, pw2), __builtin_bit_cast(bf16x8, pw3));
}
__device__ __forceinline__ void attn_out(const f32x16* OO, bf16* QW, const float* gout, int h, char* wsm, int lane, int r32, int hi) {
    {
        float* stg = (float*)wsm;
        asm volatile("s_waitcnt lgkmcnt(0)" ::: "memory");
#pragma unroll
        for (int r = 0; r < 16; ++r) { const int orow = (r & 3) + 8 * (r >> 2) + 4 * hi;
#pragma unroll
            for (int d0 = 0; d0 < 2; ++d0) stg[orow * ST_LD + d0 * 32 + r32] = OO[d0][r]; }
        asm volatile("s_waitcnt lgkmcnt(0)" ::: "memory");
        const int ch = lane & 7;
        const f32x4 ga = *(const f32x4*)(gout + h * HD + ch * 8), gb = *(const f32x4*)(gout + h * HD + ch * 8 + 4);
#pragma unroll
        for (int i = 0; i < 4; ++i) { const int row = i * 8 + (lane >> 3);
            const f32x4 a = *(const f32x4*)(stg + row * ST_LD + ch * 8), c = *(const f32x4*)(stg + row * ST_LD + ch * 8 + 4);
            float ss = (a.x * a.x + a.y * a.y) + (a.z * a.z + a.w * a.w) + (c.x * c.x + c.y * c.y) + (c.z * c.z + c.w * c.w);
            ss = sum8(ss);
            const float hs = __builtin_amdgcn_rsqf(ss * (1.0f / 64.0f) + 1e-6f);
            u32x4 w; w.x = cvtpk_s(a.x * hs * ga.x, a.y * hs * ga.y); w.y = cvtpk_s(a.z * hs * ga.z, a.w * hs * ga.w);
            w.z = cvtpk_s(c.x * hs * gb.x, c.y * hs * gb.y); w.w = cvtpk_s(c.z * hs * gb.z, c.w * hs * gb.w);
            *(u32x4*)(QW + (long)row * D + ch * 8) = w; }
        asm volatile("s_waitcnt lgkmcnt(0)" ::: "memory");
    }
}
__device__ __forceinline__ void attn_wave_unit(int b, int h, int qb64, bf16* QO, const bf16* __restrict__ KB, const bf16* __restrict__ VB, const float* gout, char* wsm  , LAS unsigned char* wl  ) {
    const int lane = threadIdx.x & 63, r32 = lane & 31, hi = lane >> 5;
    const long rowbase = (long)b * SEQ; const int q0 = qb64 * 64;
    bf16* Qw = QO + (rowbase + q0) * D + h * HD;
    const bf16* Kh = KB + rowbase * SBW + h * HD; const bf16* Vh = VB + rowbase * SBW + h * HD;
    const unsigned lds0 = (unsigned)(uintptr_t)wsm;
    const int jtop = qb64;
    const bf16* vsrc = Vh + (long)(lane >> 3) * SBW + (lane & 7) * 8;
    const int vdst0 = ((lane & 7) >> 2) * 4096 + ((lane >> 3) & 15) * 64 + (lane & 3) * 16;
    const int vb0 = (int)lds0 + ((lane >> 4) & 1) * 32 + (lane & 3) * 8 + (4 * hi + ((lane & 15) >> 2)) * 64;
    const bf16* ksrc = Kh + (long)(lane >> 3) * SBW + (((lane & 7) ^ ((lane >> 3) & 7)) * 8);
    const int qdst0 = (lane >> 3) * 128 + (((lane & 7) ^ ((lane >> 3) & 7)) << 4);
    const int kfo = r32 * 128, kx = r32 & 7;
    bf16x8 qrA[4], qrB[4]; u32x4 vr[8];
#define SBA_KDMA(t) do { const bf16* kp_ = ksrc + (long)(t) * KVBLK * SBW; \
        _Pragma("unroll") for (int i = 0; i < 8; ++i) __builtin_amdgcn_global_load_lds((const unsigned*)(kp_ + (long)(8 * i) * SBW), (LAS unsigned*)(wl + 8192 + i * 1024), 16, 0, 0); } while (0)
#define SBA_VLOAD(t) do { const bf16* vp_ = vsrc + (long)(t) * KVBLK * SBW; \
        _Pragma("unroll") for (int i = 0; i < 8; ++i) vr[i] = *(const u32x4*)(vp_ + (long)(8 * i) * SBW); } while (0)
#define SBA_QK(P0, P1, QR) do { const f32x16 z_ = f32x16{}; \
        P0 = __builtin_amdgcn_mfma_f32_32x32x16_bf16(*reinterpret_cast<const bf16x8*>(wsm + 8192 + kfo + ((hi ^ kx) << 4)), QR[0], z_, 0, 0, 0); \
        P1 = __builtin_amdgcn_mfma_f32_32x32x16_bf16(*reinterpret_cast<const bf16x8*>(wsm + 8192 + 4096 + kfo + ((hi ^ kx) << 4)), QR[0], z_, 0, 0, 0); \
        _Pragma("unroll") for (int d0 = 1; d0 < 4; ++d0) { \
            P0 = __builtin_amdgcn_mfma_f32_32x32x16_bf16(*reinterpret_cast<const bf16x8*>(wsm + 8192 + kfo + (((2 * d0 + hi) ^ kx) << 4)), QR[d0], P0, 0, 0, 0); \
            P1 = __builtin_amdgcn_mfma_f32_32x32x16_bf16(*reinterpret_cast<const bf16x8*>(wsm + 8192 + 4096 + kfo + (((2 * d0 + hi) ^ kx) << 4)), QR[d0], P1, 0, 0, 0); } } while (0)
    {   u32x4 qg[8];
#pragma unroll
        for (int i = 0; i < 8; ++i) qg[i] = *(const u32x4*)(Qw + (long)(8 * i + (lane >> 3)) * D + (lane & 7) * 8);
        SBA_KDMA(jtop); SBA_VLOAD(jtop);
#pragma unroll
        for (int i = 0; i < 8; ++i) *(u32x4*)(wsm + qdst0 + i * 1024) = qg[i];
#pragma unroll
        for (int d0 = 0; d0 < 4; ++d0) { qrA[d0] = *reinterpret_cast<const bf16x8*>(wsm + kfo + (((2 * d0 + hi) ^ kx) << 4)); qrB[d0] = *reinterpret_cast<const bf16x8*>(wsm + 4096 + kfo + (((2 * d0 + hi) ^ kx) << 4)); }
    }
    float RA = 0.f, RB = 0.f; f32x16 oA[2], oB[2]; oA[0] = f32x16{}; oA[1] = f32x16{}; oB[0] = f32x16{}; oB[1] = f32x16{};
    const int qrowA = q0 + r32, qrowB = q0 + 32 + r32;
    bool liveA = true, liveB = true;
    for (int jt = jtop;; --jt) {
#pragma unroll
        for (int i = 0; i < 8; ++i) *(u32x4*)(wsm + vdst0 + (i >> 1) * 1024 + (i & 1) * 512) = vr[i];
        if (jt > 0) { SBA_VLOAD(jt - 1); asm volatile("s_waitcnt vmcnt(8)" ::: "memory"); }
        else asm volatile("s_waitcnt vmcnt(0)" ::: "memory");
        f32x16 p0, p1;
        if (liveA) { SBA_QK(p0, p1, qrA); if (!liveB && jt > 0) SBA_KDMA(jt - 1);
                     stick_tile(p0, p1, RA, oA, jt, jt == jtop, qrowA, hi, vb0); liveA = !__all(RA < R_DEAD); }
        if (liveB) { SBA_QK(p0, p1, qrB); if (jt > 0) SBA_KDMA(jt - 1);
                     stick_tile(p0, p1, RB, oB, jt, jt == jtop, qrowB, hi, vb0); liveB = !__all(RB < R_DEAD); }
        if (jt == 0 || !(liveA || liveB)) break;
    }
#undef SBA_QK
#undef SBA_VLOAD
#undef SBA_KDMA
    asm volatile("s_waitcnt vmcnt(0)" ::: "memory");
    attn_out(oA, Qw, gout, h, wsm, lane, r32, hi);
    attn_out(oB, Qw + 32 * D, gout, h, wsm, lane, r32, hi);
}
#undef SBAR
__device__ __forceinline__ void attn_phase(Frame& F, bf16* QO, const bf16* KB, const bf16* VB, const float* gout, unsigned* queue, int t0, int t1, int ticket_base) {
    char* wsm = (char*)F.lds + RING_OFF + F.wave * 16384;
    LAS unsigned char* wl = F.lds + RING_OFF + F.wave * 16384;
    const int nunits = BATCH * NH * (SEQ / 64);
    int ts0 = t0, ts1 = t1;
    for (;;) {
        unsigned t;
        if (ts0 >= 0) { t = (unsigned)ts0; ts0 = -1; }
        else if (ts1 >= 0) { t = (unsigned)ts1; ts1 = -1; }
        else { t = 0u; if (F.lane == 0) t = __hip_atomic_fetch_add(queue, 1u, __ATOMIC_RELAXED, __HIP_MEMORY_SCOPE_AGENT); t = (unsigned)__builtin_amdgcn_readfirstlane((int)t) + (unsigned)ticket_base; }
        if (t >= (unsigned)nunits) break;
        attn_wave_unit((int)(t >> 8), (int)(t >> 5) & 7, (int)t & 31, QO, KB, VB, gout, wsm, wl);
    }
    __syncthreads();
}
}

__device__ __forceinline__ void p3_lora_post(Frame& F, bf16* RW, const float* mu, const pg8::StaticOrder& S) {
    using namespace rwk;
    const int rg = F.lane & 15, cg = 4 * F.wave + (F.lane >> 4);
    float m8[8]; ld8f(mu + 1536 + 8 * cg, m8);
    bf16* AL = RW + (size_t)M * RWP;
    pg8::Unit u;
    for (int i = 0; S.next(i, u); ++i) {
        if (u.pn != 12) continue;
        const size_t row0 = (size_t)u.pm * 256 + 16 * rg;
        v4u pv = (v4u){0u, 0u, 0u, 0u};
        if (rg & 3) pv = *(const v4u*)(RW + (row0 - 1) * RWP + 1536 + 8 * cg);
        float p[8]; unp8(pv, p);
        v4u c[4];
#pragma unroll
        for (int r = 0; r < 4; ++r) c[r] = *(const v4u*)(RW + (row0 + r) * RWP + 1536 + 8 * cg);
#pragma unroll 1
        for (int r4 = 0; r4 < 16; r4 += 4) {
            v4u n[4];
            const size_t rn = row0 + (r4 + 4 < 16 ? r4 + 4 : r4);
#pragma unroll
            for (int r = 0; r < 4; ++r) n[r] = *(const v4u*)(RW + (rn + r) * RWP + 1536 + 8 * cg);
            asm volatile("" ::: "memory");
#pragma unroll
            for (int r = 0; r < 4; ++r) { float x[8], o[8]; unp8(c[r], x);
#pragma unroll
                for (int j = 0; j < 8; ++j) { float s = x[j] + (p[j] - x[j]) * m8[j];
                    if (F.wave < 2) s = 2.0f * pg8::sigmoid_f(2.0f * s) - 1.0f; else if (F.wave >= 4) s = pg8::sigmoid_f(s);
                    o[j] = s; p[j] = x[j]; }
                const bool raw = (r4 + r == 0) && ((rg & 3) == 0);
                *(GAS v4u*)(AL + (row0 + r4 + r) * 256 + 8 * cg) = raw ? c[r] : pk8(o); }
#pragma unroll
            for (int r = 0; r < 4; ++r) c[r] = n[r];
        }
    }
}

struct Args { const float* in[26]; float* out; unsigned char* ws; int ph_lo, ph_hi, li, pad; };
__global__ void __launch_bounds__(NWAVES * 64, 2) skel_fwd(Args args) {
    extern __shared__ __attribute__((aligned(16))) unsigned char lds[];
    Frame F;
    F.lds = (LAS unsigned char*)lds;
    F.MISC = (volatile LAS unsigned*)(F.lds + MISC_OFF);
    F.tid = threadIdx.x; F.lane = F.tid & 63; F.wave = __builtin_amdgcn_readfirstlane(F.tid >> 6);
    F.G = gridDim.x; { const int bx = blockIdx.x; F.vcu = (F.G % 8 == 0) ? (bx % 8) * (F.G / 8) + bx / 8 : bx; }
    unsigned char* ws = args.ws;
    F.ctl = (gu32*)(ws + WS_CTL);
    const float* x = args.in[0];
    bf16* W1U = (bf16*)(ws + WS_W1U); bf16* W1D = (bf16*)(ws + WS_W1D); bf16* W2U = (bf16*)(ws + WS_W2U); bf16* W2D = (bf16*)(ws + WS_W2D);
    bf16* WIN = (bf16*)(ws + WS_WIN); bf16* WOUT = (bf16*)(ws + WS_WOUT); bf16* WLORA = (bf16*)(ws + WS_WLORA);
    bf16* XB = (bf16*)(ws + WS_XB); bf16* ACT = (bf16*)(ws + WS_ACT); bf16* QO = (bf16*)(ws + WS_QO); bf16* KB = (bf16*)(ws + WS_KB); bf16* VB = (bf16*)(ws + WS_VB);
    bf16* RW = (bf16*)(ws + WS_RW); bf16* ALORA = (bf16*)(ws + WS_ALORA); float* LW = (float*)(ws + WS_LW); bf16* AB = (bf16*)(ws + WS_AB); bf16* GB = (bf16*)(ws + WS_GB);
    float* SSQ = (float*)(ws + WS_SSQ); float* out = args.out;
    for (int u = F.tid; u < (LDS_BYTES - LDSCTL_OFF) / 4; u += NWAVES * 64) ((LAS unsigned*)(F.lds + LDSCTL_OFF))[u] = 0u;
    __syncthreads();
    XcdBarrier bar; bar.bar = (unsigned*)(F.ctl + CW_BAR); bar.x = 0; bar.st = nullptr;
    if (N_LAUNCHES != PER_PHASE) bar = xcd_barrier_post((unsigned*)(F.ctl + CW_BAR), F.MISC + 8);
#define GRID_BAR(seam) do { if (N_LAUNCHES == PER_PHASE) { if (F.tid == 0) __hip_atomic_store(F.ctl + CW_TMO, 0xBADBA0u | (unsigned)(seam), RLX_AGENT); } else { xcd_barrier(bar); } } while (0)
    const int lo = args.ph_lo, hi = args.ph_hi;
#define IN(k) (lo <= (k) && (k) < hi)
#define BOTH(k) (IN(k) && IN((k) + 1))
    if (IN(0)) {
        p0_prologue(F, x, args.in[1], args.in[2], args.in[3], args.in[4], args.in[5], args.in[6], args.in[12], args.in[14], args.in[15], args.in[21], args.in[22], args.in[23], args.in[24], args.in[25],
                    W1U, W1D, W2U, W2D, WIN, WOUT, WLORA, XB, SSQ); if (BOTH(0)) GRID_BAR(0);
    }
    if (IN(1)) {
        pg8::Gemm g{XB, W1U, M, 2 * FF, D}; pg8::StaticOrder S; S.init(M, 2 * FF, F.G, (int)blockIdx.x);
        pg8::EpiSwiGLU E{ACT, FF, SSQ};
        pg8::gemm_phase<pg8::EpiSwiGLU, pg8::StaticOrder, true, true>(F.lds + RING_OFF, g, S, E);
        if (BOTH(1)) GRID_BAR(1);
    }
    if (IN(2)) {
        pg8::Gemm g{ACT, W1D, M, D, FF, 0, 1}; pg8::StaticOrder S; S.init(M, D, F.G, (int)blockIdx.x, 1);
        pg8::EpiResid E{XB, nullptr, XB, SSQ, 0.5f, 1};
        pg8::gemm_phase<pg8::EpiResid, pg8::StaticOrder, false, true>(F.lds + RING_OFF, g, S, E);
        if (BOTH(2)) GRID_BAR(2);
    }
    if (IN(3)) {
        pg8::Gemm g{XB, WIN, M, PW, D}; pg8::StaticOrder S; S.init(M, PW, F.G, (int)blockIdx.x);
        pg8::EpiWin E{QO, KB, VB, RW, SSQ, args.in[7], args.in[8], 0.125f * 1.4426950408889634f};
        pg8::gemm_phase<pg8::EpiWin, pg8::StaticOrder, true, true>(F.lds + RING_OFF, g, S, E);
        if (F.G >= 256) {
            const int nlo = (M / 256) * (PW / 256) - 6 * F.G;
            if ((int)blockIdx.x >= nlo) { __syncthreads();
                p0_items(F, x, args.in[1], args.in[2], args.in[3], args.in[4], args.in[5], args.in[6], args.in[12], args.in[14], args.in[15], args.in[21], args.in[22], args.in[23], args.in[24], args.in[25],
                         W1U, W1D, W2U, W2D, WIN, WOUT, WLORA, XB, SSQ, 1, ((int)blockIdx.x - nlo) * NWAVES + F.wave, (F.G - nlo) * NWAVES); }
        }
        p3_lora_post(F, RW, args.in[10], S);
        if (BOTH(3)) GRID_BAR(3);
    }
    if (IN(6)) {
        RwArgs A{RW, WLORA, WLORA + 512 * 64, WLORA + 2 * 512 * 64, args.in[11], args.in[13], QO, args.in[10], args.in[16], args.in[17], args.in[18], args.in[19], args.in[20]};
        bf16* ob = (bf16*)out;
        RwX X{ob + (size_t)32 * 1024 * 1024, ob + (size_t)48 * 1024 * 1024, (bf16*)LW, (bf16*)LW + (size_t)16 * 1024 * 1024, AB, AB + (size_t)8 * 1024 * 1024, SSQ, GB};
        p6a_rwkv_local(F, A, X);
        GRID_BAR(16);
        const int nseq = (F.G >= 2 * BATCH * NH) ? BATCH * NH : F.G;
        if ((int)blockIdx.x < nseq) { p6b_rwkv_seq(F, A, X, nseq); __syncthreads(); }
        const int nfree = (F.G - nseq) * NWAVES;
        {   const int nlate = nseq * NWAVES, wv = ((int)blockIdx.x >= nseq) ? ((int)blockIdx.x - nseq) * NWAVES + F.wave : (int)blockIdx.x * NWAVES + F.wave;
            const bool fr_ = ((int)blockIdx.x >= nseq);
            sba::attn_phase(F, QO, KB, VB, args.in[9], (unsigned*)(F.ctl + CW_QUEUE), fr_ ? wv : 2 * nfree + wv, fr_ ? nfree + wv : -1, 2 * nfree + nlate); }
        if (BOTH(6)) GRID_BAR(6);
    }
    if (IN(8)) {
        pg8::Gemm g{QO, WOUT, M, D, D}; pg8::StaticOrder S; S.init(M, D, F.G, (int)blockIdx.x, 1);
        pg8::EpiResid E{XB, nullptr, XB, SSQ, 1.0f, 1};
        pg8::gemm_phase<pg8::EpiResid, pg8::StaticOrder, false, true>(F.lds + RING_OFF, g, S, E);
        if (BOTH(8)) GRID_BAR(8);
    }
    if (IN(9)) {
        pg8::Gemm g{XB, W2U, M, 2 * FF, D}; pg8::StaticOrder S; S.init(M, 2 * FF, F.G, (int)blockIdx.x);
        pg8::EpiSwiGLU E{ACT, FF, SSQ};
        pg8::gemm_phase<pg8::EpiSwiGLU, pg8::StaticOrder, true, true>(F.lds + RING_OFF, g, S, E);
        if (BOTH(9)) GRID_BAR(9);
    }
    if (IN(10)) {
        pg8::Gemm g{ACT, W2D, M, D, FF, 0, 1}; pg8::StaticOrder S; S.init(M, D, F.G, (int)blockIdx.x, 1);
        pg8::EpiResid E{XB, out, nullptr, SSQ, 0.5f, 0};
        pg8::gemm_phase<pg8::EpiResid, pg8::StaticOrder, false, true>(F.lds + RING_OFF, g, S, E);
    }
#undef IN
#undef BOTH
}

extern "C" void kernel_launch(void* const* d_in, const int* in_sizes, int n_in, void* d_out, int out_size, void* d_ws, size_t ws_size, hipStream_t stream) {
    static int grid = 0;
    if (grid == 0) {
        if (n_in != 26 || in_sizes[0] != M * D || out_size != M * D || ws_size < WS_END) { fprintf(stderr, "kernel_launch: unexpected shapes: n_in %d in0 %d out %d ws %zu (need %zu)\n", n_in, n_in > 0 ? in_sizes[0] : -1, out_size, ws_size, (size_t)WS_END); grid = -1; return; }
        int dev = 0, cus = 0, per_cu = 0;
        if (hipGetDevice(&dev) != hipSuccess || hipDeviceGetAttribute(&cus, hipDeviceAttributeMultiprocessorCount, dev) != hipSuccess) { grid = -1; return; }
        if (hipFuncSetAttribute((const void*)skel_fwd, hipFuncAttributeMaxDynamicSharedMemorySize, LDS_BYTES) != hipSuccess) { fprintf(stderr, "kernel_launch: hipFuncSetAttribute failed\n"); grid = -1; return; }
        if (hipOccupancyMaxActiveBlocksPerMultiprocessor(&per_cu, (const void*)skel_fwd, NWAVES * 64, LDS_BYTES) != hipSuccess || per_cu < 1) { fprintf(stderr, "kernel_launch: occupancy query reports %d blocks per CU\n", per_cu); per_cu = 1; }
        (void)hipGetLastError();
        grid = cus;
    }
    if (grid < 0) return;
    if (hipMemsetAsync((char*)d_ws + WS_CTL, 0, CTL_ZERO_BYTES, stream) != hipSuccess) return;
    Args a{};
    for (int i = 0; i < 26; ++i) a.in[i] = (const float*)d_in[i];
    a.out = (float*)d_out; a.ws = (unsigned char*)d_ws;
    for (int li = 0; li < N_LAUNCHES; ++li) {
        a.ph_lo = (N_LAUNCHES == PER_PHASE) ? li : 0; a.ph_hi = (N_LAUNCHES == PER_PHASE) ? li + 1 : PER_PHASE; a.li = li;
        hipLaunchKernelGGL(skel_fwd, dim3(grid), dim3(NWAVES * 64), LDS_BYTES, stream, a);
    }
}
```
